# Optimizing an MI355X kernel written in HIP

```python
import math
import jax
import jax.numpy as jnp
from jax import lax
import numpy as np

D_MODEL = 1024
BATCH = 16
SEQ = 2048
DEPTH = 2

N_MIXERS = 2
N_NSA_LAYERS = (DEPTH + 1) // 2
N_HGRN_LAYERS = DEPTH // 2

NSA_HEADS = 16
NSA_KV_GROUPS = 4
NSA_GROUP_SIZE = NSA_HEADS // NSA_KV_GROUPS
NSA_HEAD_DIM = D_MODEL // NSA_HEADS
NSA_Q_DIM = NSA_HEADS * NSA_HEAD_DIM
NSA_KV_DIM = NSA_KV_GROUPS * NSA_HEAD_DIM
NSA_IN_DIM = NSA_Q_DIM + 6 * NSA_KV_DIM + 3 * NSA_HEADS
CMP_BLOCK = 32
CMP_STRIDE = 16
SEL_BLOCK = 64
N_SELECT = 8
WINDOW = 512
Q_BLOCK = 32
FORCED_SCORE = 1.0e4

REL_BUCKETS = 32
REL_MAX_DISTANCE = 1024

HGRN_EXPAND = 128
HGRN_HEADS = D_MODEL // HGRN_EXPAND
HGRN_KEY_DIM = HGRN_EXPAND
HGRN_VALUE_DIM = D_MODEL // HGRN_HEADS
HGRN_F_DIM = HGRN_HEADS * HGRN_KEY_DIM
HGRN_IN_DIM = 2 * HGRN_F_DIM + 2 * D_MODEL
HGRN_CHUNK = 32

MOE_GROUPS = 4
MOE_EXPERTS_PER_GROUP = 4
MOE_EXPERTS = MOE_GROUPS * MOE_EXPERTS_PER_GROUP
MOE_TOP_K = 2
MOE_FF = 512
MOE_ROW_BLOCK = 128

NORM_EPS = 1e-6

kernel_name = 'hybrid_nsa_hgrn2_hier_moe_adaln'


def rms_norm(x, gain):
    xf = x.astype(jnp.float32)
    y = xf * lax.rsqrt(jnp.mean(xf * xf, axis=-1, keepdims=True) + NORM_EPS)
    return (y * gain.astype(jnp.float32)).astype(x.dtype)


def masked_softmax(logits, mask):
    logits = jnp.where(mask, logits, -jnp.inf)
    m = jnp.max(logits, axis=-1, keepdims=True)
    m = jnp.where(jnp.isfinite(m), m, 0.0)
    e = jnp.exp(logits - m)
    return e / jnp.maximum(jnp.sum(e, axis=-1, keepdims=True), 1e-30)


def t5_bucket(dist):
    n = jnp.maximum(dist, 0)
    max_exact = REL_BUCKETS // 2
    nf = jnp.maximum(n, 1).astype(jnp.float32)
    large = max_exact + (jnp.log(nf / max_exact) / math.log(REL_MAX_DISTANCE / max_exact)
                         * (REL_BUCKETS - max_exact)).astype(jnp.int32)
    large = jnp.minimum(large, REL_BUCKETS - 1)
    return jnp.where(n < max_exact, n, large)


def compress_blocks(kv, pe, w1, w2):
    b, t, g, d = kv.shape
    n_cmp = (t - CMP_BLOCK) // CMP_STRIDE + 1
    idx = np.arange(n_cmp)[:, None] * CMP_STRIDE + np.arange(CMP_BLOCK)[None, :]
    blocks = kv[:, idx] + pe[None, None, :, None, :]
    flat = blocks.transpose(0, 1, 3, 2, 4).reshape(b, n_cmp, g, CMP_BLOCK * d)
    return jax.nn.silu(flat @ w1) @ w2


def cmp_to_sel_weights(n_cmp, n_sel):
    cs = np.arange(n_cmp) * CMP_STRIDE
    ss = np.arange(n_sel) * SEL_BLOCK
    shared = (np.minimum(cs[:, None] + CMP_BLOCK, ss[None, :] + SEL_BLOCK)
              - np.maximum(cs[:, None], ss[None, :]))
    return jnp.asarray(np.clip(shared, 0, None) / CMP_BLOCK, dtype=jnp.float32)


def nsa_mixer(h, rel_bias, w_in, q_gain, k_gain, cmp_pe, cmp_w1, cmp_w2, w_out):
    b, t, _ = h.shape
    G, R, Dh = NSA_KV_GROUPS, NSA_GROUP_SIZE, NSA_HEAD_DIM
    cuts = [NSA_Q_DIM + i * NSA_KV_DIM for i in range(7)]
    q, kc, vc, ks, vs, kw, vw, gl = jnp.split(h @ w_in, cuts, axis=-1)
    kvs = (b, t, G, Dh)
    q = rms_norm(q.reshape(b, t, G, R, Dh), q_gain)
    kc = rms_norm(compress_blocks(kc.reshape(kvs), cmp_pe[0], cmp_w1[0], cmp_w2[0]), k_gain[0])
    vc = compress_blocks(vc.reshape(kvs), cmp_pe[1], cmp_w1[1], cmp_w2[1])
    ks = rms_norm(ks.reshape(kvs), k_gain[1])
    vs = vs.reshape(kvs)
    kw = rms_norm(kw.reshape(kvs), k_gain[2])
    vw = vw.reshape(kvs)
    gates = jax.nn.sigmoid(gl.astype(jnp.float32)).reshape(b, t, G, R, 3)

    n_cmp = kc.shape[1]
    n_sel_blocks = t // SEL_BLOCK
    n_select = min(N_SELECT, n_sel_blocks)
    n_keys_sel = n_select * SEL_BLOCK
    cmp_end = jnp.arange(n_cmp) * CMP_STRIDE + (CMP_BLOCK - 1)
    cmp_to_sel = cmp_to_sel_weights(n_cmp, n_sel_blocks)
    ks_blk = ks.transpose(0, 2, 1, 3).reshape(b, G, n_sel_blocks, SEL_BLOCK, Dh)
    vs_blk = vs.transpose(0, 2, 1, 3).reshape(b, G, n_sel_blocks, SEL_BLOCK, Dh)
    kw_pad = jnp.pad(kw, ((0, 0), (WINDOW, 0), (0, 0), (0, 0)))
    vw_pad = jnp.pad(vw, ((0, 0), (WINDOW, 0), (0, 0), (0, 0)))
    bias_tbl = rel_bias.astype(jnp.float32).T.reshape(G, R, REL_BUCKETS)
    scale = NSA_HEAD_DIM ** -0.5
    blk_ids = jnp.arange(n_sel_blocks)
    b_ix = jnp.arange(b)[:, None, None, None]
    g_ix = jnp.arange(G)[None, :, None, None]
    g_ix5 = jnp.arange(G)[None, :, None, None, None]
    r_ix5 = jnp.arange(R)[None, None, :, None, None]

    def query_block(qb):
        t0 = qb * Q_BLOCK
        tq = t0 + jnp.arange(Q_BLOCK)
        q_b = lax.dynamic_slice_in_dim(q, t0, Q_BLOCK, axis=1)
        gate_b = lax.dynamic_slice_in_dim(gates, t0, Q_BLOCK, axis=1)

        dist_c = tq[:, None] - cmp_end[None, :]
        lg = (jnp.einsum('bqgrd,bngd->bgrqn', q_b, kc).astype(jnp.float32) * scale
              + bias_tbl[:, :, t5_bucket(dist_c)])
        p_c = masked_softmax(lg, dist_c >= 0)
        o_c = jnp.einsum('bgrqn,bngd->bqgrd', p_c.astype(vc.dtype), vc)

        imp = jnp.einsum('bgrqn,ns->bgqs', p_c, cmp_to_sel)
        cur = tq // SEL_BLOCK
        forced = ((blk_ids[None, :] == 0) | (blk_ids[None, :] == cur[:, None])
                  | (blk_ids[None, :] == cur[:, None] - 1))
        causal_blk = blk_ids[None, :] <= cur[:, None]
        score = jnp.where(forced, FORCED_SCORE, jnp.where(causal_blk, imp, -1.0))
        _, sel = lax.top_k(score, n_select)
        k_sel = ks_blk[b_ix, g_ix, sel].reshape(b, G, Q_BLOCK, n_keys_sel, Dh)
        v_sel = vs_blk[b_ix, g_ix, sel].reshape(b, G, Q_BLOCK, n_keys_sel, Dh)
        pos = (sel[..., None] * SEL_BLOCK + jnp.arange(SEL_BLOCK)).reshape(b, G, Q_BLOCK, n_keys_sel)
        dist_s = tq[None, None, :, None] - pos
        lg = (jnp.einsum('bqgrd,bgqkd->bgrqk', q_b, k_sel).astype(jnp.float32) * scale
              + bias_tbl[g_ix5, r_ix5, t5_bucket(dist_s)[:, :, None]])
        p_s = masked_softmax(lg, (dist_s >= 0)[:, :, None])
        o_s = jnp.einsum('bgrqk,bgqkd->bqgrd', p_s.astype(v_sel.dtype), v_sel)

        k_w = lax.dynamic_slice_in_dim(kw_pad, t0, Q_BLOCK + WINDOW, axis=1)
        v_w = lax.dynamic_slice_in_dim(vw_pad, t0, Q_BLOCK + WINDOW, axis=1)
        kpos = t0 - WINDOW + jnp.arange(Q_BLOCK + WINDOW)
        dist_w = tq[:, None] - kpos[None, :]
        mask_w = (dist_w >= 0) & (dist_w < WINDOW) & (kpos[None, :] >= 0)
        lg = (jnp.einsum('bqgrd,bkgd->bgrqk', q_b, k_w).astype(jnp.float32) * scale
              + bias_tbl[:, :, t5_bucket(dist_w)])
        p_w = masked_softmax(lg, mask_w)
        o_w = jnp.einsum('bgrqk,bkgd->bqgrd', p_w.astype(v_w.dtype), v_w)

        o = gate_b[..., 0:1] * o_c + gate_b[..., 1:2] * o_s + gate_b[..., 2:3] * o_w
        return o.astype(h.dtype).reshape(b, Q_BLOCK, NSA_Q_DIM)

    o = lax.map(query_block, jnp.arange(t // Q_BLOCK))
    o = o.transpose(1, 0, 2, 3).reshape(b, t, NSA_Q_DIM)
    return o @ w_out


def hgrn2_mixer(h, lower_bound, w_in, out_gain, w_out):
    b, t, _ = h.shape
    NH, dk, dv, C = HGRN_HEADS, HGRN_KEY_DIM, HGRN_VALUE_DIM, HGRN_CHUNK
    q, f, i, g = jnp.split(h @ w_in, [HGRN_F_DIM, 2 * HGRN_F_DIM, 2 * HGRN_F_DIM + D_MODEL], axis=-1)
    q = jax.nn.silu(q.astype(jnp.float32)).reshape(b, t, NH, dk)
    lb = lower_bound.astype(jnp.float32).reshape(NH, dk)
    log_f = jnp.logaddexp(jnp.log(lb), jnp.log1p(-lb)
                          + jax.nn.log_sigmoid(f.astype(jnp.float32).reshape(b, t, NH, dk)))
    k = -jnp.expm1(log_f)
    v = i.astype(jnp.float32).reshape(b, t, NH, dv)
    n_chunks = t // C

    def to_chunks(a):
        return a.reshape(b, n_chunks, C, NH, a.shape[-1]).transpose(1, 0, 3, 2, 4)

    causal = jnp.tril(jnp.ones((C, C), dtype=bool))

    def chunk_step(S, xs):
        q_c, k_c, v_c, lf_c = xs
        cum = jnp.cumsum(lf_c, axis=2)
        rel = jnp.where(causal[:, :, None], cum[:, :, :, None, :] - cum[:, :, None, :, :], -jnp.inf)
        attn = jnp.einsum('bhtd,bhsd,bhtsd->bhts', q_c, k_c, jnp.exp(rel))
        o = attn @ v_c + jnp.einsum('bhtd,bhde->bhte', q_c * jnp.exp(cum), S)
        last = cum[:, :, -1:, :]
        S = (jnp.exp(last[:, :, 0, :, None]) * S
             + jnp.einsum('bhsd,bhse->bhde', k_c * jnp.exp(last - cum), v_c))
        return S, o

    S0 = jnp.zeros((b, NH, dk, dv), jnp.float32)
    _, o = lax.scan(chunk_step, S0, (to_chunks(q), to_chunks(k), to_chunks(v), to_chunks(log_f)))
    o = o.transpose(1, 0, 3, 2, 4).reshape(b, t, NH, dv)
    o = rms_norm(o, out_gain) * jax.nn.silu(g.astype(jnp.float32).reshape(b, t, NH, dv))
    return o.reshape(b, t, D_MODEL).astype(h.dtype) @ w_out


def grouped_expert_ffn(tok, expert, weight, w1, w3, w2):
    n, d = tok.shape
    a = n * MOE_TOP_K
    flat_e = expert.reshape(a)
    flat_t = jnp.repeat(jnp.arange(n, dtype=jnp.int32), MOE_TOP_K)
    flat_w = weight.reshape(a)
    order = jnp.argsort(flat_e)
    e_sorted, t_sorted, w_sorted = flat_e[order], flat_t[order], flat_w[order]
    counts = jnp.bincount(flat_e, length=MOE_EXPERTS)
    padded = (counts + MOE_ROW_BLOCK - 1) // MOE_ROW_BLOCK * MOE_ROW_BLOCK
    pad_end = jnp.cumsum(padded)
    pad_start = pad_end - padded
    start = jnp.cumsum(counts) - counts
    dest = pad_start[e_sorted] + (jnp.arange(a) - start[e_sorted])
    n_blk = -(-(a + MOE_EXPERTS * (MOE_ROW_BLOCK - 1)) // MOE_ROW_BLOCK)
    p = n_blk * MOE_ROW_BLOCK
    buf_t = jnp.full((p,), n, dtype=jnp.int32).at[dest].set(t_sorted)
    buf_w = jnp.zeros((p,), tok.dtype).at[dest].set(w_sorted)
    blk_e = jnp.minimum(jnp.searchsorted(pad_end, jnp.arange(n_blk) * MOE_ROW_BLOCK, side='right'),
                        MOE_EXPERTS - 1)
    tok_pad = jnp.concatenate([tok, jnp.zeros((1, d), tok.dtype)], axis=0)
    xb = tok_pad[buf_t].reshape(n_blk, MOE_ROW_BLOCK, d)

    def expert_block(args):
        xblk, e = args
        return (jax.nn.silu(xblk @ w1[e]) * (xblk @ w3[e])) @ w2[e]

    yb = lax.map(expert_block, (xb, blk_e)).reshape(p, d)
    out = jnp.zeros((n + 1, d), tok.dtype).at[buf_t].add(yb * buf_w[:, None])
    return out[:n]


def hier_moe(h, w_router_group, w_router_expert, w1, w3, w2):
    b, t, d = h.shape
    n = b * t
    tok = h.reshape(n, d)
    p_group = jax.nn.softmax((tok @ w_router_group).astype(jnp.float32), axis=-1)
    grp = jnp.argmax(p_group, axis=-1).astype(jnp.int32)
    p_grp_sel = jnp.take_along_axis(p_group, grp[:, None], axis=-1)
    e_logits = (tok @ w_router_expert).astype(jnp.float32).reshape(n, MOE_GROUPS, MOE_EXPERTS_PER_GROUP)
    e_logits = jnp.take_along_axis(e_logits, grp[:, None, None], axis=1)[:, 0]
    top_p, top_i = lax.top_k(jax.nn.softmax(e_logits, axis=-1), MOE_TOP_K)
    weight = p_grp_sel * top_p / jnp.sum(top_p, axis=-1, keepdims=True)
    expert = grp[:, None] * MOE_EXPERTS_PER_GROUP + top_i.astype(jnp.int32)
    y = grouped_expert_ffn(tok, expert, weight.astype(h.dtype), w1, w3, w2)
    return y.reshape(b, t, d)


def setup_inputs(seed: int = 0) -> dict:
    key = jax.random.key(seed)
    ks = jax.random.split(key, 24)
    f32 = jnp.float32
    D = D_MODEL

    def nrm(k, shape, s):
        return jax.random.normal(k, shape, f32) * s

    return {
        'x': nrm(ks[0], (BATCH, SEQ, D), 1.0),
        'c': nrm(ks[1], (BATCH, D), 1.0),
        'ada_w': nrm(ks[2], (DEPTH, 2, D, 3 * D), 0.5 * D ** -0.5),
        'ada_b': nrm(ks[3], (DEPTH, 2, 3 * D), 0.01),
        'norm_g': 1.0 + nrm(ks[4], (DEPTH, 2, D), 0.01),
        'rel_bias': nrm(ks[5], (REL_BUCKETS, NSA_HEADS), 0.5),
        'nsa_w_in': nrm(ks[6], (N_NSA_LAYERS, D, NSA_IN_DIM), D ** -0.5),
        'nsa_q_gain': 1.0 + nrm(ks[7], (N_NSA_LAYERS, NSA_HEAD_DIM), 0.01),
        'nsa_k_gain': 1.0 + nrm(ks[8], (N_NSA_LAYERS, 3, NSA_HEAD_DIM), 0.01),
        'nsa_cmp_pe': nrm(ks[9], (N_NSA_LAYERS, 2, CMP_BLOCK, NSA_HEAD_DIM), 0.02),
        'nsa_cmp_w1': nrm(ks[10], (N_NSA_LAYERS, 2, CMP_BLOCK * NSA_HEAD_DIM, NSA_HEAD_DIM),
                          (CMP_BLOCK * NSA_HEAD_DIM) ** -0.5),
        'nsa_cmp_w2': nrm(ks[11], (N_NSA_LAYERS, 2, NSA_HEAD_DIM, NSA_HEAD_DIM), NSA_HEAD_DIM ** -0.5),
        'nsa_w_out': nrm(ks[12], (N_NSA_LAYERS, NSA_Q_DIM, D), NSA_Q_DIM ** -0.5),
        'hgrn_w_in': nrm(ks[13], (N_HGRN_LAYERS, D, HGRN_IN_DIM), D ** -0.5),
        'hgrn_lower_bounds': 1.0 + nrm(ks[14], (DEPTH, HGRN_F_DIM), 0.1),
        'hgrn_out_gain': 1.0 + nrm(ks[15], (N_HGRN_LAYERS, HGRN_VALUE_DIM), 0.01),
        'hgrn_w_out': nrm(ks[16], (N_HGRN_LAYERS, D, D), D ** -0.5),
        'moe_router_group': nrm(ks[17], (DEPTH, D, MOE_GROUPS), D ** -0.5),
        'moe_router_expert': nrm(ks[18], (DEPTH, D, MOE_EXPERTS), D ** -0.5),
        'moe_w1': nrm(ks[19], (DEPTH, MOE_EXPERTS, D, MOE_FF), D ** -0.5),
        'moe_w3': nrm(ks[20], (DEPTH, MOE_EXPERTS, D, MOE_FF), D ** -0.5),
        'moe_w2': nrm(ks[21], (DEPTH, MOE_EXPERTS, MOE_FF, D), MOE_FF ** -0.5),
    }


def reference(x, c, ada_w, ada_b, norm_g, rel_bias, nsa_w_in, nsa_q_gain, nsa_k_gain,
              nsa_cmp_pe, nsa_cmp_w1, nsa_cmp_w2, nsa_w_out, hgrn_w_in, hgrn_lower_bounds,
              hgrn_out_gain, hgrn_w_out, moe_router_group, moe_router_expert,
              moe_w1, moe_w3, moe_w2):
    lb_soft = jax.nn.softmax(hgrn_lower_bounds.astype(jnp.float32), axis=0)
    lb_all = jnp.cumsum(lb_soft, axis=0) - lb_soft[0]
    cond = jax.nn.silu(c)
    for layer in range(DEPTH):
        mod = jnp.einsum('bd,sde->sbe', cond, ada_w[layer]) + ada_b[layer][:, None, :]
        j = layer // N_MIXERS

        shift, scale, gate = jnp.split(mod[0], 3, axis=-1)
        h = rms_norm(x, norm_g[layer, 0]) * (1.0 + scale[:, None, :]) + shift[:, None, :]
        if layer % N_MIXERS == 0:
            y = nsa_mixer(h, rel_bias, nsa_w_in[j], nsa_q_gain[j], nsa_k_gain[j],
                          nsa_cmp_pe[j], nsa_cmp_w1[j], nsa_cmp_w2[j], nsa_w_out[j])
        else:
            y = hgrn2_mixer(h, lb_all[layer], hgrn_w_in[j], hgrn_out_gain[j], hgrn_w_out[j])
        x = x + gate[:, None, :] * y

        shift, scale, gate = jnp.split(mod[1], 3, axis=-1)
        h = rms_norm(x, norm_g[layer, 1]) * (1.0 + scale[:, None, :]) + shift[:, None, :]
        y = hier_moe(h, moe_router_group[layer], moe_router_expert[layer],
                     moe_w1[layer], moe_w3[layer], moe_w2[layer])
        x = x + gate[:, None, :] * y
    return x
```

```cpp
#include <hip/hip_runtime.h>
#include <hip/hip_cooperative_groups.h>
#include <cstdio>
#include <cstdint>
namespace cg = cooperative_groups;

#ifndef MULTI_LAUNCH
#define MULTI_LAUNCH 0
#endif

typedef unsigned short bf16_t;
typedef short bf16x8 __attribute__((ext_vector_type(8)));
typedef float f32x4 __attribute__((ext_vector_type(4)));

constexpr int NTOK = 32768, DM = 1024, SEQ = 2048, NBATCH = 16;
constexpr int NSA_IN = 2608, NSA_IN_PAD = 2688;
constexpr float EPS = 1e-6f;
constexpr size_t MiB = 1ull << 20;

constexpr size_t OFF_CNT = 0;
constexpr size_t OFF_MOD = 4096;
constexpr size_t OFF_LB = OFF_MOD + 786432;
constexpr size_t OFF_PEB = OFF_LB + 4096;
constexpr size_t OFF_W_NSA_IN = 1 * MiB;
constexpr size_t OFF_W_NSA_OUT = OFF_W_NSA_IN + 2688ull * 1024 * 2;
constexpr size_t OFF_W_HG_IN = OFF_W_NSA_OUT + 1024ull * 1024 * 2;
constexpr size_t OFF_W_HG_OUT = OFF_W_HG_IN + 4096ull * 1024 * 2;
constexpr size_t OFF_W_CMP1 = OFF_W_HG_OUT + 1024ull * 1024 * 2;
constexpr size_t OFF_W_UP = OFF_W_CMP1 + 2ull * 128 * 2048 * 2;
constexpr size_t OFF_W_DN = OFF_W_UP + 32ull * 1024 * 1024 * 2;
constexpr size_t OFF_W_END = OFF_W_DN + 32ull * 1024 * 512 * 2;
constexpr size_t OFF_HA = 116 * MiB;
static_assert(OFF_W_END <= OFF_HA, "weights overflow");
constexpr size_t OFF_SCR = 180 * MiB;
constexpr size_t OFF_Q = OFF_SCR;
constexpr size_t OFF_KCRAW = OFF_Q + 64 * MiB;
constexpr size_t OFF_VCRAW = OFF_KCRAW + 17 * MiB;
constexpr size_t OFF_KS = OFF_VCRAW + 17 * MiB;
constexpr size_t OFF_VS = OFF_KS + 16 * MiB;
constexpr size_t OFF_KW = OFF_VS + 16 * MiB;
constexpr size_t OFF_VW = OFF_KW + 16 * MiB;
constexpr size_t OFF_GATES = OFF_VW + 16 * MiB;
constexpr size_t OFF_T1 = OFF_GATES + 6 * MiB;
constexpr size_t OFF_KC = OFF_T1 + 4 * MiB;
constexpr size_t OFF_VC = OFF_KC + 1 * MiB;
constexpr size_t OFF_H1 = OFF_SCR;
constexpr size_t OFF_Y = OFF_H1 + 64 * MiB;
constexpr size_t OFF_LTOK = OFF_Y + 128 * MiB;
constexpr size_t OFF_LW = OFF_LTOK + 2 * MiB;
constexpr size_t OFF_TSLOT = OFF_LW + 2 * MiB;
constexpr size_t OFF_QH = OFF_SCR;
constexpr size_t OFF_LF = OFF_QH + 64 * MiB;
constexpr size_t OFF_V = OFF_LF + 128 * MiB;
constexpr size_t OFF_G = OFF_V + 64 * MiB;
constexpr size_t WS_NEED = OFF_G + 64 * MiB;
static_assert(WS_NEED <= 512 * MiB, "ws overflow");

constexpr int LDS_BYTES = 40960;
constexpr int NPHASE = 18;

struct Params {
    const float *x, *c, *ada_w, *ada_b, *norm_g, *rel_bias, *nsa_w_in, *nsa_q_gain, *nsa_k_gain, *nsa_cmp_pe, *nsa_cmp_w1,
        *nsa_cmp_w2, *nsa_w_out, *hgrn_w_in, *hgrn_lb, *hgrn_out_gain, *hgrn_w_out, *moe_rg, *moe_re, *moe_w1, *moe_w3, *moe_w2;
    float* out;
    char* ws;
    int p_begin, p_end;
};

__device__ __forceinline__ float bf2f(unsigned short h) { return __uint_as_float((unsigned)h << 16); }
__device__ __forceinline__ unsigned short f2bf(float f) {
    unsigned u = __float_as_uint(f);
    u += 0x7fffu + ((u >> 16) & 1u);
    return (unsigned short)(u >> 16);
}
__device__ __forceinline__ unsigned pack2(float a, float b) { return (unsigned)f2bf(a) | ((unsigned)f2bf(b) << 16); }
__device__ __forceinline__ float wave_sum(float v) {
#pragma unroll
    for (int o = 32; o; o >>= 1) v += __shfl_xor(v, o);
    return v;
}
__device__ __forceinline__ float wave_max(float v) {
#pragma unroll
    for (int o = 32; o; o >>= 1) v = fmaxf(v, __shfl_xor(v, o));
    return v;
}
__device__ __forceinline__ float silu_f(float x) { return x / (1.f + __expf(-x)); }
__device__ __forceinline__ float sigmoid_f(float x) { return 1.f / (1.f + __expf(-x)); }
__device__ __forceinline__ void glds16(const void* g, void* l) {
    __builtin_amdgcn_global_load_lds((const unsigned*)g, (unsigned*)l, 16, 0, 0);
}
__device__ __forceinline__ int t5_bucket(int n) {
    if (n < 16) return n;
    int b = 16;
    b += (n >= 21); b += (n >= 27); b += (n >= 35); b += (n >= 46); b += (n >= 59); b += (n >= 77); b += (n >= 99); b += (n >= 128);
    b += (n >= 166); b += (n >= 216); b += (n >= 280); b += (n >= 363); b += (n >= 470); b += (n >= 609); b += (n >= 790);
    return b;
}

struct Ctx {
    int G, vbid, tid, wid, lane;
};

constexpr int P0_MOD_ITEMS = 192;
constexpr int TS0 = 84 * 16, TS1 = 32 * 16, TS2 = 128 * 16, TS3 = 32 * 16, TS4 = 2 * 4 * 32, TS5 = 32 * 32 * 16, TS6 = 32 * 32 * 8;
constexpr int TC0 = 0, TC1 = TC0 + TS0, TC2 = TC1 + TS1, TC3 = TC2 + TS2, TC4 = TC3 + TS3, TC5 = TC4 + TS4, TC6 = TC5 + TS5, TC_END = TC6 + TS6;
constexpr int P0_ITEMS = P0_MOD_ITEMS + TC_END + 1;

__device__ void transpose_tile(const float* __restrict__ src, int ld, int c0, int ncols_valid, int k0, bf16_t* __restrict__ dst, int dstld,
                               char* lds, int tid) {
    float* tl = (float*)lds;
    {
        const int k = tid >> 2, cc = (tid & 3) * 8;
        const float* s = src + (size_t)(k0 + k) * ld + c0 + cc;
#pragma unroll
        for (int i = 0; i < 8; ++i) {
            float v = (c0 + cc + i < ncols_valid) ? s[i] : 0.f;
            tl[k * 33 + cc + i] = v;
        }
    }
    __syncthreads();
    {
        const int n = tid >> 3, kc = (tid & 7) * 8;
        unsigned w[4];
#pragma unroll
        for (int i = 0; i < 4; ++i) w[i] = pack2(tl[(kc + 2 * i) * 33 + n], tl[(kc + 2 * i + 1) * 33 + n]);
        uint4 o; o.x = w[0]; o.y = w[1]; o.z = w[2]; o.w = w[3];
        *(uint4*)(dst + (size_t)n * dstld + kc) = o;
    }
    __syncthreads();
}

__device__ void phase0(const Params& p, const Ctx& cx, char* lds) {
    const int tid = cx.tid, wid = cx.wid, lane = cx.lane;
    for (int it = cx.vbid; it < P0_ITEMS; it += cx.G) {
        if (it < P0_MOD_ITEMS) {
            const int colbase = it * 64, ls = colbase / 3072, e0 = colbase % 3072;
            const float* W = p.ada_w + (size_t)ls * 1024 * 3072 + e0 + lane;
            float* cs = (float*)lds + wid * 1024;
            float* red = (float*)lds + 4096;
            float acc[16];
#pragma unroll
            for (int b = 0; b < 16; ++b) acc[b] = 0.f;
            for (int sub = 0; sub < 4; ++sub) {
                const int kb = wid * 256 + sub * 64;
#pragma unroll
                for (int b = 0; b < 16; ++b) cs[lane * 16 + b] = silu_f(p.c[b * 1024 + kb + lane]);
                __builtin_amdgcn_wave_barrier();
                for (int kk = 0; kk < 64; ++kk) {
                    const float w = W[(size_t)(kb + kk) * 3072];
                    const f32x4* cv = (const f32x4*)(cs + kk * 16);
#pragma unroll
                    for (int q = 0; q < 4; ++q) {
                        f32x4 c4 = cv[q];
                        acc[q * 4 + 0] += c4[0] * w; acc[q * 4 + 1] += c4[1] * w; acc[q * 4 + 2] += c4[2] * w; acc[q * 4 + 3] += c4[3] * w;
                    }
                }
                __builtin_amdgcn_wave_barrier();
            }
#pragma unroll
            for (int b = 0; b < 16; ++b) red[(wid * 16 + b) * 64 + lane] = acc[b];
            __syncthreads();
            float* mod = (float*)(p.ws + OFF_MOD);
#pragma unroll
            for (int i = 0; i < 4; ++i) {
                const int o = tid + i * 256, b = o >> 6, e = o & 63;
                float s = red[(0 * 16 + b) * 64 + e] + red[(1 * 16 + b) * 64 + e] + red[(2 * 16 + b) * 64 + e] + red[(3 * 16 + b) * 64 + e];
                mod[((size_t)ls * 16 + b) * 3072 + e0 + e] = s + p.ada_b[ls * 3072 + e0 + e];
            }
            __syncthreads();
        } else if (it < P0_MOD_ITEMS + TC_END) {
            const int tt = it - P0_MOD_ITEMS;
            if (tt < TC1) {
                const int nt = tt / 16, kt = tt % 16;
                transpose_tile(p.nsa_w_in, NSA_IN, nt * 32, NSA_IN, kt * 64, (bf16_t*)(p.ws + OFF_W_NSA_IN) + (size_t)nt * 32 * 1024 + kt * 64, 1024, lds, tid);
            } else if (tt < TC2) {
                const int u = tt - TC1, nt = u / 16, kt = u % 16;
                transpose_tile(p.nsa_w_out, 1024, nt * 32, 1024, kt * 64, (bf16_t*)(p.ws + OFF_W_NSA_OUT) + (size_t)nt * 32 * 1024 + kt * 64, 1024, lds, tid);
            } else if (tt < TC3) {
                const int u = tt - TC2, nt = u / 16, kt = u % 16;
                transpose_tile(p.hgrn_w_in, 4096, nt * 32, 4096, kt * 64, (bf16_t*)(p.ws + OFF_W_HG_IN) + (size_t)nt * 32 * 1024 + kt * 64, 1024, lds, tid);
            } else if (tt < TC4) {
                const int u = tt - TC3, nt = u / 16, kt = u % 16;
                transpose_tile(p.hgrn_w_out, 1024, nt * 32, 1024, kt * 64, (bf16_t*)(p.ws + OFF_W_HG_OUT) + (size_t)nt * 32 * 1024 + kt * 64, 1024, lds, tid);
            } else if (tt < TC5) {
                const int u = tt - TC4, kv = u / 128, r = u % 128, nt = r / 32, kt = r % 32;
                transpose_tile(p.nsa_cmp_w1 + (size_t)kv * 2048 * 64, 64, nt * 32, 64, kt * 64,
                               (bf16_t*)(p.ws + OFF_W_CMP1) + ((size_t)kv * 128 + nt * 32) * 2048 + kt * 64, 2048, lds, tid);
            } else if (tt < TC6) {
                const int u = tt - TC5, le = u / 512, r = u % 512, gr = r / 16, kt = r % 16;
                const int t = gr >> 2, wc = (gr >> 1) & 1, which = gr & 1;
                const float* src = (which ? p.moe_w3 : p.moe_w1) + (size_t)le * 1024 * 512;
                transpose_tile(src, 512, (t * 2 + wc) * 32, 512, kt * 64, (bf16_t*)(p.ws + OFF_W_UP) + ((size_t)le * 1024 + gr * 32) * 1024 + kt * 64, 1024, lds, tid);
            } else {
                const int u = tt - TC6, le = u / 256, r = u % 256, nt = r / 8, kt = r % 8;
                transpose_tile(p.moe_w2 + (size_t)le * 512 * 1024, 1024, nt * 32, 1024, kt * 64,
                               (bf16_t*)(p.ws + OFF_W_DN) + ((size_t)le * 1024 + nt * 32) * 512 + kt * 64, 512, lds, tid);
            }
        } else {
            float* lb = (float*)(p.ws + OFF_LB);
            for (int i = tid; i < 1024; i += 256) lb[i] = sigmoid_f(p.hgrn_lb[1024 + i] - p.hgrn_lb[i]);
            if (tid < 128) {
                const int kv = tid >> 6, d = tid & 63;
                const float* pe = p.nsa_cmp_pe + kv * 2048;
                const float* w1 = p.nsa_cmp_w1 + (size_t)kv * 2048 * 64 + d;
                float s = 0.f;
                for (int k = 0; k < 2048; ++k) s += pe[k] * w1[(size_t)k * 64];
                ((float*)(p.ws + OFF_PEB))[tid] = s;
            }
            if (tid < 32) ((int*)(p.ws + OFF_CNT))[tid] = 0;
        }
    }
}

template <bool COMBINE, bool NORM, bool ROUTER>
__device__ void rows_phase(const Params& p, const Ctx& cx, char* lds, const float* __restrict__ src, float* __restrict__ xdst,
                           int ls_comb, int ls_norm, int layer_router, int layer_comb) {
    const int lane = cx.lane;
    const float* mod = (const float*)(p.ws + OFF_MOD);
    int my_off = 0;
    if (COMBINE) {
        const int* cnt = (const int*)(p.ws + OFF_CNT) + layer_comb * 16;
        int cv = (lane < 16) ? cnt[lane] : 0;
        int incl = cv;
#pragma unroll
        for (int o = 1; o < 16; o <<= 1) { int t = __shfl_up(incl, o); if (lane >= o) incl += t; }
        my_off = incl - cv;
    }
    for (int row = cx.vbid * 4 + cx.wid; row < NTOK; row += cx.G * 4) {
        const int b = row >> 11;
        f32x4 v[4];
#pragma unroll
        for (int i = 0; i < 4; ++i) v[i] = *(const f32x4*)(src + (size_t)row * 1024 + (i * 64 + lane) * 4);
        if (COMBINE) {
            const int* ts = (const int*)(p.ws + OFF_TSLOT) + row * 2;
            const int s0 = ts[0], s1 = ts[1];
            const int r0 = __shfl(my_off, s0 >> 16) + (s0 & 0xffff), r1 = __shfl(my_off, s1 >> 16) + (s1 & 0xffff);
            const bf16_t* Y = (const bf16_t*)(p.ws + OFF_Y);
            const float* gate = mod + ((size_t)ls_comb * 16 + b) * 3072 + 2048;
#pragma unroll
            for (int i = 0; i < 4; ++i) {
                const int col = (i * 64 + lane) * 4;
                uint2 a = *(const uint2*)(Y + (size_t)r0 * 1024 + col), c = *(const uint2*)(Y + (size_t)r1 * 1024 + col);
                f32x4 g = *(const f32x4*)(gate + col);
                v[i][0] += g[0] * (bf2f(a.x & 0xffff) + bf2f(c.x & 0xffff));
                v[i][1] += g[1] * (bf2f(a.x >> 16) + bf2f(c.x >> 16));
                v[i][2] += g[2] * (bf2f(a.y & 0xffff) + bf2f(c.y & 0xffff));
                v[i][3] += g[3] * (bf2f(a.y >> 16) + bf2f(c.y >> 16));
                *(f32x4*)(xdst + (size_t)row * 1024 + col) = v[i];
            }
        }
        if (NORM) {
            float ss = 0.f;
#pragma unroll
            for (int i = 0; i < 4; ++i) ss += v[i][0] * v[i][0] + v[i][1] * v[i][1] + v[i][2] * v[i][2] + v[i][3] * v[i][3];
            ss = wave_sum(ss);
            const float r = rsqrtf(ss * (1.f / 1024.f) + EPS);
            const float* gain = p.norm_g + ls_norm * 1024;
            const float* shift = mod + ((size_t)ls_norm * 16 + b) * 3072;
            const float* scale = shift + 1024;
            bf16_t* hA = (bf16_t*)(p.ws + OFF_HA);
            f32x4 rg4 = {0.f, 0.f, 0.f, 0.f}, re0 = rg4, re1 = rg4, re2 = rg4, re3 = rg4;
#pragma unroll
            for (int i = 0; i < 4; ++i) {
                const int col = (i * 64 + lane) * 4;
                f32x4 g = *(const f32x4*)(gain + col), sc = *(const f32x4*)(scale + col), sh = *(const f32x4*)(shift + col);
                f32x4 h;
#pragma unroll
                for (int j = 0; j < 4; ++j) h[j] = v[i][j] * r * g[j] * (1.f + sc[j]) + sh[j];
                uint2 o; o.x = pack2(h[0], h[1]); o.y = pack2(h[2], h[3]);
                *(uint2*)(hA + (size_t)row * 1024 + col) = o;
                if (ROUTER) {
                    const float* rg = p.moe_rg + (size_t)layer_router * 1024 * 4;
                    const float* re = p.moe_re + (size_t)layer_router * 1024 * 16;
#pragma unroll
                    for (int j = 0; j < 4; ++j) {
                        rg4 += h[j] * *(const f32x4*)(rg + (col + j) * 4);
                        re0 += h[j] * *(const f32x4*)(re + (col + j) * 16 + 0);
                        re1 += h[j] * *(const f32x4*)(re + (col + j) * 16 + 4);
                        re2 += h[j] * *(const f32x4*)(re + (col + j) * 16 + 8);
                        re3 += h[j] * *(const f32x4*)(re + (col + j) * 16 + 12);
                    }
                }
            }
            if (ROUTER) {
                float rl[4];
                f32x4 rs0, rs1, rs2, rs3;
#pragma unroll
                for (int j = 0; j < 4; ++j) { rl[j] = wave_sum(rg4[j]); rs0[j] = wave_sum(re0[j]); rs1[j] = wave_sum(re1[j]); rs2[j] = wave_sum(re2[j]); rs3[j] = wave_sum(re3[j]); }
                float gm = fmaxf(fmaxf(rl[0], rl[1]), fmaxf(rl[2], rl[3]));
                float e0 = __expf(rl[0] - gm), e1 = __expf(rl[1] - gm), e2 = __expf(rl[2] - gm), e3 = __expf(rl[3] - gm);
                float gs = e0 + e1 + e2 + e3;
                int grp = 0; float best = rl[0];
                if (rl[1] > best) { best = rl[1]; grp = 1; }
                if (rl[2] > best) { best = rl[2]; grp = 2; }
                if (rl[3] > best) { best = rl[3]; grp = 3; }
                const float pg = __expf(best - gm) / gs;
                const f32x4 lsel = (grp == 0) ? rs0 : (grp == 1) ? rs1 : (grp == 2) ? rs2 : rs3;
                const float l0 = lsel[0], l1 = lsel[1], l2 = lsel[2], l3 = lsel[3];
                const float em = fmaxf(fmaxf(l0, l1), fmaxf(l2, l3));
                float q0 = __expf(l0 - em), q1 = __expf(l1 - em), q2 = __expf(l2 - em), q3 = __expf(l3 - em);
                int i1 = 0; float b1 = q0;
                if (q1 > b1) { b1 = q1; i1 = 1; }
                if (q2 > b1) { b1 = q2; i1 = 2; }
                if (q3 > b1) { b1 = q3; i1 = 3; }
                int i2 = -1; float b2 = -1.f;
                if (i1 != 0 && q0 > b2) { b2 = q0; i2 = 0; }
                if (i1 != 1 && q1 > b2) { b2 = q1; i2 = 1; }
                if (i1 != 2 && q2 > b2) { b2 = q2; i2 = 2; }
                if (i1 != 3 && q3 > b2) { b2 = q3; i2 = 3; }
                const float inv = pg / (b1 + b2);
                if (lane == 0) {
                    int* cnt = (int*)(p.ws + OFF_CNT) + layer_router * 16;
                    int* ltok = (int*)(p.ws + OFF_LTOK);
                    float* lw = (float*)(p.ws + OFF_LW);
                    int* ts = (int*)(p.ws + OFF_TSLOT) + row * 2;
                    const int ea = grp * 4 + i1, eb = grp * 4 + i2;
                    const int pa = atomicAdd(cnt + ea, 1);
                    const int pb = atomicAdd(cnt + eb, 1);
                    ltok[(size_t)ea * NTOK + pa] = row; lw[(size_t)ea * NTOK + pa] = b1 * inv;
                    ltok[(size_t)eb * NTOK + pb] = row; lw[(size_t)eb * NTOK + pb] = b2 * inv;
                    ts[0] = (ea << 16) | pa; ts[1] = (eb << 16) | pb;
                }
            }
        }
    }
}

template <class Epi>
__device__ __forceinline__ void gemm_tile(const bf16_t* a0, const bf16_t* a1, const bf16_t* b0, const bf16_t* b1, int K, char* lds, const Ctx& cx,
                                          Epi&& epi) {
    const int tid = cx.tid, lane = cx.lane, wr = cx.wid >> 1, wc = cx.wid & 1, fr = lane & 15, fq = lane >> 4;
    f32x4 acc[4][4];
#pragma unroll
    for (int m = 0; m < 4; ++m)
#pragma unroll
        for (int n = 0; n < 4; ++n) acc[m][n] = (f32x4){0.f, 0.f, 0.f, 0.f};
    const int nt = K / 32;
    {
        char* SA = lds; char* SB = lds + 8192;
        glds16(a0, SA + tid * 16); glds16(a1, SA + tid * 16 + 4096);
        glds16(b0, SB + tid * 16); glds16(b1, SB + tid * 16 + 4096);
    }
    asm volatile("s_waitcnt vmcnt(0)" ::: "memory");
    __syncthreads();
    for (int kt = 0; kt < nt; ++kt) {
        const int cur = kt & 1;
        if (kt + 1 < nt) {
            char* SA = lds + (cur ^ 1) * 16384; char* SB = SA + 8192;
            const int ko = (kt + 1) * 32;
            glds16(a0 + ko, SA + tid * 16); glds16(a1 + ko, SA + tid * 16 + 4096);
            glds16(b0 + ko, SB + tid * 16); glds16(b1 + ko, SB + tid * 16 + 4096);
        }
        const char* SA = lds + cur * 16384; const char* SB = SA + 8192;
        bf16x8 Af[4], Bf[4];
#pragma unroll
        for (int m = 0; m < 4; ++m) Af[m] = *(const bf16x8*)(SA + (wr * 64 + m * 16 + fr) * 64 + fq * 16);
#pragma unroll
        for (int n = 0; n < 4; ++n) Bf[n] = *(const bf16x8*)(SB + (wc * 64 + n * 16 + fr) * 64 + fq * 16);
#pragma unroll
        for (int m = 0; m < 4; ++m)
#pragma unroll
            for (int n = 0; n < 4; ++n) acc[m][n] = __builtin_amdgcn_mfma_f32_16x16x32_bf16(Bf[n], Af[m], acc[m][n], 0, 0, 0);
        asm volatile("s_waitcnt vmcnt(0)" ::: "memory");
        __syncthreads();
    }
    epi(acc, wr, wc, fr, fq);
}

template <class EpiFactory>
__device__ void gemm_phase_dense(const bf16_t* A, int lda, const bf16_t* Bt, int K, int nrt, int nct, char* lds, const Ctx& cx, EpiFactory&& mk) {
    const int tid = cx.tid;
    const int ntiles = nrt * nct;
    for (int tile = cx.vbid; tile < ntiles; tile += cx.G) {
        const int rt = tile / nct, ct = tile % nct;
        const bf16_t* a0 = A + (size_t)(rt * 128 + (tid >> 2)) * lda + (tid & 3) * 8;
        const bf16_t* a1 = a0 + (size_t)64 * lda;
        const bf16_t* b0 = Bt + (size_t)(ct * 128 + (tid >> 2)) * K + (tid & 3) * 8;
        const bf16_t* b1 = b0 + (size_t)64 * K;
        gemm_tile(a0, a1, b0, b1, K, lds, cx, mk(rt * 128, ct * 128));
    }
}

__device__ void phase_nsa_inproj(const Params& p, const Ctx& cx, char* lds) {
    const bf16_t* A = (const bf16_t*)(p.ws + OFF_HA);
    const bf16_t* Bt = (const bf16_t*)(p.ws + OFF_W_NSA_IN);
    char* ws = p.ws;
    const float* qg = p.nsa_q_gain;
    const float* kg = p.nsa_k_gain;
    gemm_phase_dense(A, 1024, Bt, 1024, NTOK / 128, NSA_IN_PAD / 128, lds, cx, [=](int row0, int col0) {
        return [=](f32x4 (&acc)[4][4], int wr, int wc, int fr, int fq) {
            const int gc0 = col0 + wc * 64;
            if (gc0 >= NSA_IN) return;
            if (gc0 < 1024 || (gc0 >= 1536 && gc0 < 1792) || (gc0 >= 2048 && gc0 < 2304)) {
                const float* gain; float post; bf16_t* dstb; size_t rstride; size_t coff; bool tokmajor;
                if (gc0 < 1024) { gain = qg; post = 0.125f; }
                else if (gc0 < 1792) { gain = kg + 64; post = 1.f; }
                else { gain = kg + 128; post = 1.f; }
#pragma unroll
                for (int m = 0; m < 4; ++m) {
                    float ss = 0.f;
#pragma unroll
                    for (int n = 0; n < 4; ++n) ss += acc[m][n][0] * acc[m][n][0] + acc[m][n][1] * acc[m][n][1] + acc[m][n][2] * acc[m][n][2] + acc[m][n][3] * acc[m][n][3];
                    ss += __shfl_xor(ss, 16); ss += __shfl_xor(ss, 32);
                    const float r = rsqrtf(ss * (1.f / 64.f) + EPS) * post;
                    const int row = row0 + wr * 64 + m * 16 + fr;
                    bf16_t* dst;
                    if (gc0 < 1024) dst = (bf16_t*)(ws + OFF_Q) + (size_t)row * 1024 + gc0;
                    else {
                        const int g = ((gc0 - 1024) & 255) >> 6, b = row >> 11, t = row & 2047;
                        dst = (bf16_t*)(ws + (gc0 < 1792 ? OFF_KS : OFF_KW)) + ((size_t)(b * 4 + g) * 2048 + t) * 64;
                    }
#pragma unroll
                    for (int n = 0; n < 4; ++n) {
                        const int c = n * 16 + fq * 4;
                        f32x4 g4 = *(const f32x4*)(gain + c);
                        uint2 o; o.x = pack2(acc[m][n][0] * r * g4[0], acc[m][n][1] * r * g4[1]); o.y = pack2(acc[m][n][2] * r * g4[2], acc[m][n][3] * r * g4[3]);
                        *(uint2*)(dst + c) = o;
                    }
                }
            } else if (gc0 < 2560) {
                const int seg = (gc0 - 1024) >> 8;
                const size_t off = seg == 0 ? OFF_KCRAW : seg == 1 ? OFF_VCRAW : seg == 3 ? OFF_VS : OFF_VW;
                const int g = ((gc0 - 1024) & 255) >> 6;
#pragma unroll
                for (int m = 0; m < 4; ++m) {
                    const int row = row0 + wr * 64 + m * 16 + fr, b = row >> 11, t = row & 2047;
                    bf16_t* dst = (bf16_t*)(ws + off) + ((size_t)(b * 4 + g) * 2048 + t) * 64;
#pragma unroll
                    for (int n = 0; n < 4; ++n) {
                        const int c = n * 16 + fq * 4;
                        uint2 o; o.x = pack2(acc[m][n][0], acc[m][n][1]); o.y = pack2(acc[m][n][2], acc[m][n][3]);
                        *(uint2*)(dst + c) = o;
                    }
                }
            } else {
#pragma unroll
                for (int m = 0; m < 4; ++m) {
                    const int row = row0 + wr * 64 + m * 16 + fr;
                    float* dst = (float*)(ws + OFF_GATES) + (size_t)row * 48;
#pragma unroll
                    for (int n = 0; n < 3; ++n) {
                        const int c = n * 16 + fq * 4;
                        f32x4 o;
#pragma unroll
                        for (int j = 0; j < 4; ++j) o[j] = sigmoid_f(acc[m][n][j]);
                        *(f32x4*)(dst + c) = o;
                    }
                }
            }
        };
    });
}

__device__ void phase_cmp1(const Params& p, const Ctx& cx, char* lds) {
    const int tid = cx.tid;
    const float* peb = (const float*)(p.ws + OFF_PEB);
    float* T1 = (float*)(p.ws + OFF_T1);
    for (int tile = cx.vbid; tile < 128; tile += cx.G) {
        const int kv = tile >> 6, bg = tile & 63;
        const bf16_t* raw = (const bf16_t*)(p.ws + (kv ? OFF_VCRAW : OFF_KCRAW)) + (size_t)bg * 2048 * 64;
        const bf16_t* a0 = raw + (size_t)(tid >> 2) * 1024 + (tid & 3) * 8;
        const bf16_t* a1 = a0 + (size_t)64 * 1024;
        const bf16_t* b0 = (const bf16_t*)(p.ws + OFF_W_CMP1) + ((size_t)kv * 128 + (tid >> 2)) * 2048 + (tid & 3) * 8;
        const bf16_t* b1 = b0 + (size_t)64 * 2048;
        gemm_tile(a0, a1, b0, b1, 2048, lds, cx, [=](f32x4 (&acc)[4][4], int wr, int wc, int fr, int fq) {
            if (wc != 0) return;
#pragma unroll
            for (int m = 0; m < 4; ++m) {
                const int n_ = wr * 64 + m * 16 + fr;
                float* dst = T1 + ((size_t)kv * 8192 + bg * 128 + n_) * 64;
#pragma unroll
                for (int n = 0; n < 4; ++n) {
                    const int c = n * 16 + fq * 4;
                    f32x4 pb = *(const f32x4*)(peb + kv * 64 + c);
                    *(f32x4*)(dst + c) = acc[m][n] + pb;
                }
            }
        });
    }
}

__device__ void phase_cmp2(const Params& p, const Ctx& cx) {
    const int lane = cx.lane;
    const float* T1 = (const float*)(p.ws + OFF_T1);
    for (int r = cx.vbid * 4 + cx.wid; r < 2 * 8192; r += cx.G * 4) {
        const int kv = r >> 13, rr = r & 8191, n_ = rr & 127;
        const float s = silu_f(T1[(size_t)r * 64 + lane]);
        const float* w2 = p.nsa_cmp_w2 + kv * 4096 + lane;
        float o = 0.f;
#pragma unroll 8
        for (int j = 0; j < 64; ++j) o += __shfl(s, j) * w2[j * 64];
        if (kv == 0) {
            const float ss = wave_sum(o * o);
            o = o * rsqrtf(ss * (1.f / 64.f) + EPS) * p.nsa_k_gain[lane];
        }
        if (n_ == 127) o = 0.f;
        ((bf16_t*)(p.ws + (kv ? OFF_VC : OFF_KC)))[(size_t)rr * 64 + lane] = f2bf(o);
    }
}

__device__ void phase_attn_naive(const Params& p, const Ctx& cx, char* lds) {
    const int tid = cx.tid, lane = cx.lane, wid = cx.wid;
    unsigned char* bkt = (unsigned char*)lds;
    float* bias_s = (float*)(lds + 2048);
    float* qs = (float*)(lds + 4096) + wid * 256;
    float* pl = (float*)(lds + 8192) + wid * 2048;
    for (int i = tid; i < 2048; i += 256) bkt[i] = (unsigned char)t5_bucket(i);
    for (int i = tid; i < 512; i += 256) { const int h = i >> 5, bk = i & 31; bias_s[i] = p.rel_bias[bk * 16 + h]; }
    __syncthreads();
    const bf16_t* Qb = (const bf16_t*)(p.ws + OFF_Q);
    const bf16_t* KC = (const bf16_t*)(p.ws + OFF_KC);
    const bf16_t* VC = (const bf16_t*)(p.ws + OFF_VC);
    const bf16_t* KS = (const bf16_t*)(p.ws + OFF_KS);
    const bf16_t* VS = (const bf16_t*)(p.ws + OFF_VS);
    const bf16_t* KW = (const bf16_t*)(p.ws + OFF_KW);
    const bf16_t* VW = (const bf16_t*)(p.ws + OFF_VW);
    const float* GT = (const float*)(p.ws + OFF_GATES);
    bf16_t* O = (bf16_t*)(p.ws + OFF_HA);

    auto qk4 = [&](const bf16_t* krow, float (&lg)[4]) {
        lg[0] = lg[1] = lg[2] = lg[3] = 0.f;
#pragma unroll 2
        for (int c8 = 0; c8 < 8; ++c8) {
            uint4 kk = *(const uint4*)(krow + c8 * 8);
            float kf[8] = {bf2f(kk.x & 0xffff), bf2f(kk.x >> 16), bf2f(kk.y & 0xffff), bf2f(kk.y >> 16),
                           bf2f(kk.z & 0xffff), bf2f(kk.z >> 16), bf2f(kk.w & 0xffff), bf2f(kk.w >> 16)};
#pragma unroll
            for (int h = 0; h < 4; ++h) {
                f32x4 qa = *(const f32x4*)(qs + h * 64 + c8 * 8), qb = *(const f32x4*)(qs + h * 64 + c8 * 8 + 4);
                lg[h] += kf[0] * qa[0] + kf[1] * qa[1] + kf[2] * qa[2] + kf[3] * qa[3] + kf[4] * qb[0] + kf[5] * qb[1] + kf[6] * qb[2] + kf[7] * qb[3];
            }
        }
    };
    auto softmax4 = [&](int nchunks) {
        float m[4] = {-INFINITY, -INFINITY, -INFINITY, -INFINITY};
        for (int c = 0; c < nchunks; ++c) {
            f32x4 l = *(const f32x4*)(pl + (c * 64 + lane) * 4);
#pragma unroll
            for (int h = 0; h < 4; ++h) m[h] = fmaxf(m[h], l[h]);
        }
        float s[4];
#pragma unroll
        for (int h = 0; h < 4; ++h) { m[h] = wave_max(m[h]); if (m[h] == -INFINITY) m[h] = 0.f; s[h] = 0.f; }
        for (int c = 0; c < nchunks; ++c) {
            f32x4 l = *(const f32x4*)(pl + (c * 64 + lane) * 4);
#pragma unroll
            for (int h = 0; h < 4; ++h) { l[h] = __expf(l[h] - m[h]); s[h] += l[h]; }
            *(f32x4*)(pl + (c * 64 + lane) * 4) = l;
        }
#pragma unroll
        for (int h = 0; h < 4; ++h) s[h] = 1.f / fmaxf(wave_sum(s[h]), 1e-30f);
        for (int c = 0; c < nchunks; ++c) {
            f32x4 l = *(const f32x4*)(pl + (c * 64 + lane) * 4);
#pragma unroll
            for (int h = 0; h < 4; ++h) l[h] *= s[h];
            *(f32x4*)(pl + (c * 64 + lane) * 4) = l;
        }
        __builtin_amdgcn_wave_barrier();
    };

    for (int item = cx.vbid * 4 + wid; item < NBATCH * 4 * SEQ; item += cx.G * 4) {
        const int t = item & 2047, bg = item >> 11, b = bg >> 2, g = bg & 3;
        const int row = b * SEQ + t;
        __builtin_amdgcn_wave_barrier();
        {
            uint2 qq = *(const uint2*)(Qb + (size_t)row * 1024 + g * 256 + lane * 4);
            f32x4 qv = {bf2f(qq.x & 0xffff), bf2f(qq.x >> 16), bf2f(qq.y & 0xffff), bf2f(qq.y >> 16)};
            *(f32x4*)(qs + lane * 4) = qv;
        }
        __builtin_amdgcn_wave_barrier();
        const float* bs = bias_s + (g * 4) * 32;
        float oacc[4] = {0.f, 0.f, 0.f, 0.f};
        const float* gt = GT + (size_t)row * 48 + g * 12;

        const int nvis = (t >= 31) ? min((t - 31) / 16 + 1, 127) : 0;
#pragma unroll 1
        for (int c = 0; c < 2; ++c) {
            const int n = c * 64 + lane;
            const bool valid = n < nvis;
            float lg[4];
            qk4(KC + ((size_t)bg * 128 + min(n, 126)) * 64, lg);
            const int dist = t - (16 * n + 31);
            const int bk = valid ? bkt[dist] : 0;
            f32x4 l;
#pragma unroll
            for (int h = 0; h < 4; ++h) l[h] = valid ? lg[h] + bs[h * 32 + bk] : -INFINITY;
            *(f32x4*)(pl + n * 4) = l;
        }
        __builtin_amdgcn_wave_barrier();
        softmax4(2);
        {
            float a[4] = {0.f, 0.f, 0.f, 0.f};
            const bf16_t* vb = VC + (size_t)bg * 128 * 64 + lane;
            for (int n = 0; n < nvis; ++n) {
                const float v = bf2f(vb[n * 64]);
                f32x4 pp = *(const f32x4*)(pl + n * 4);
#pragma unroll
                for (int h = 0; h < 4; ++h) a[h] += pp[h] * v;
            }
#pragma unroll
            for (int h = 0; h < 4; ++h) oacc[h] += gt[h * 3 + 0] * a[h];
        }
        unsigned selmask;
        {
            float imp = 0.f;
            if (lane < 32) {
                const int s4 = lane * 4;
#pragma unroll
                for (int h = 0; h < 4; ++h) {
                    float v = pl[(s4 + 0) * 4 + h] + pl[(s4 + 1) * 4 + h] + pl[(s4 + 2) * 4 + h] + 0.5f * pl[(s4 + 3) * 4 + h];
                    if (lane > 0) v += 0.5f * pl[(s4 - 1) * 4 + h];
                    imp += v;
                }
            }
            const int cur = t >> 6;
            const int s = lane & 31;
            const bool forced = (s == 0) || (s == cur) || (s == cur - 1);
            const float score = forced ? 1.0e4f : (s <= cur ? imp : -1.0f);
            int rank = 0;
            for (int j = 0; j < 32; ++j) {
                const float sj = __shfl(score, j);
                rank += (sj > score || (sj == score && j < s)) ? 1 : 0;
            }
            const unsigned long long bal = __ballot(rank < 8 && lane < 32);
            selmask = (unsigned)bal;
        }
        __builtin_amdgcn_wave_barrier();
        {
            const int cur = t >> 6;
            unsigned mm = selmask;
#pragma unroll 1
            for (int c = 0; c < 8; ++c) {
                const int sb = __builtin_ctz(mm); mm &= mm - 1;
                const int pos = sb * 64 + lane;
                const bool valid = pos <= t;
                f32x4 l = {-INFINITY, -INFINITY, -INFINITY, -INFINITY};
                if (sb <= cur) {
                    float lg[4];
                    qk4(KS + ((size_t)bg * 2048 + pos) * 64, lg);
                    const int bk = valid ? bkt[t - pos] : 0;
#pragma unroll
                    for (int h = 0; h < 4; ++h) l[h] = valid ? lg[h] + bs[h * 32 + bk] : -INFINITY;
                }
                *(f32x4*)(pl + (c * 64 + lane) * 4) = l;
            }
            __builtin_amdgcn_wave_barrier();
            softmax4(8);
            float a[4] = {0.f, 0.f, 0.f, 0.f};
            mm = selmask;
            for (int c = 0; c < 8; ++c) {
                const int sb = __builtin_ctz(mm); mm &= mm - 1;
                if (sb > cur) continue;
                const int nk = min(64, t - sb * 64 + 1);
                const bf16_t* vb = VS + ((size_t)bg * 2048 + sb * 64) * 64 + lane;
                for (int j = 0; j < nk; ++j) {
                    const float v = bf2f(vb[j * 64]);
                    f32x4 pp = *(const f32x4*)(pl + (c * 64 + j) * 4);
#pragma unroll
                    for (int h = 0; h < 4; ++h) a[h] += pp[h] * v;
                }
            }
#pragma unroll
            for (int h = 0; h < 4; ++h) oacc[h] += gt[h * 3 + 1] * a[h];
        }
        __builtin_amdgcn_wave_barrier();
        {
            const int lo = max(0, t - 511), nk = t - lo + 1;
#pragma unroll 1
            for (int c = 0; c < 8; ++c) {
                const int j = c * 64 + lane;
                const bool valid = j < nk;
                f32x4 l = {-INFINITY, -INFINITY, -INFINITY, -INFINITY};
                if (c * 64 < nk) {
                    const int pos = lo + min(j, nk - 1);
                    float lg[4];
                    qk4(KW + ((size_t)bg * 2048 + pos) * 64, lg);
                    const int bk = bkt[t - pos];
#pragma unroll
                    for (int h = 0; h < 4; ++h) l[h] = valid ? lg[h] + bs[h * 32 + bk] : -INFINITY;
                }
                *(f32x4*)(pl + j * 4) = l;
            }
            __builtin_amdgcn_wave_barrier();
            softmax4(8);
            float a[4] = {0.f, 0.f, 0.f, 0.f};
            const bf16_t* vb = VW + ((size_t)bg * 2048 + lo) * 64 + lane;
            for (int j = 0; j < nk; ++j) {
                const float v = bf2f(vb[j * 64]);
                f32x4 pp = *(const f32x4*)(pl + j * 4);
#pragma unroll
                for (int h = 0; h < 4; ++h) a[h] += pp[h] * v;
            }
#pragma unroll
            for (int h = 0; h < 4; ++h) oacc[h] += gt[h * 3 + 2] * a[h];
        }
#pragma unroll
        for (int h = 0; h < 4; ++h) O[(size_t)row * 1024 + (g * 4 + h) * 64 + lane] = f2bf(oacc[h]);
    }
}

__device__ void phase_outproj(const Params& p, const Ctx& cx, char* lds, const bf16_t* Bt, const float* xin, int ls) {
    const bf16_t* A = (const bf16_t*)(p.ws + OFF_HA);
    const float* mod = (const float*)(p.ws + OFF_MOD);
    float* xo = p.out;
    gemm_phase_dense(A, 1024, Bt, 1024, NTOK / 128, 8, lds, cx, [=](int row0, int col0) {
        return [=](f32x4 (&acc)[4][4], int wr, int wc, int fr, int fq) {
#pragma unroll
            for (int m = 0; m < 4; ++m) {
                const int row = row0 + wr * 64 + m * 16 + fr, b = row >> 11;
                const float* gate = mod + ((size_t)ls * 16 + b) * 3072 + 2048;
#pragma unroll
                for (int n = 0; n < 4; ++n) {
                    const int col = col0 + wc * 64 + n * 16 + fq * 4;
                    f32x4 g = *(const f32x4*)(gate + col);
                    f32x4 xi = *(const f32x4*)(xin + (size_t)row * 1024 + col);
                    f32x4 o;
#pragma unroll
                    for (int j = 0; j < 4; ++j) o[j] = xi[j] + g[j] * acc[m][n][j];
                    *(f32x4*)(xo + (size_t)row * 1024 + col) = o;
                }
            }
        };
    });
}

__device__ __forceinline__ void moe_tables(const Params& p, int layer, char* lds, int tid, int* s_cnt, int* s_off, int* s_toff) {
    if (tid == 0) {
        const int* cnt = (const int*)(p.ws + OFF_CNT) + layer * 16;
        int o = 0, to = 0;
        for (int e = 0; e < 16; ++e) { const int c = cnt[e]; s_cnt[e] = c; s_off[e] = o; s_toff[e] = to; o += c; to += ((c + 127) >> 7) * 8; }
        s_off[16] = o; s_toff[16] = to;
    }
    __syncthreads();
}

__device__ void phase_moe_up(const Params& p, const Ctx& cx, char* lds, int layer) {
    const int tid = cx.tid;
    int* s_cnt = (int*)(lds + 32768); int* s_off = s_cnt + 16; int* s_toff = s_off + 17;
    moe_tables(p, layer, lds, tid, s_cnt, s_off, s_toff);
    const int ntiles = s_toff[16];
    const bf16_t* hA = (const bf16_t*)(p.ws + OFF_HA);
    const int* ltok = (const int*)(p.ws + OFF_LTOK);
    bf16_t* H1 = (bf16_t*)(p.ws + OFF_H1);
    for (int tile = cx.vbid; tile < ntiles; tile += cx.G) {
        int e = 0;
        while (tile >= s_toff[e + 1]) ++e;
        const int lt = tile - s_toff[e], rt = lt >> 3, ct = lt & 7, cnt = s_cnt[e], off = s_off[e];
        const int p0 = min(rt * 128 + (tid >> 2), cnt - 1), p1 = min(rt * 128 + (tid >> 2) + 64, cnt - 1);
        const bf16_t* a0 = hA + (size_t)ltok[(size_t)e * NTOK + p0] * 1024 + (tid & 3) * 8;
        const bf16_t* a1 = hA + (size_t)ltok[(size_t)e * NTOK + p1] * 1024 + (tid & 3) * 8;
        const bf16_t* b0 = (const bf16_t*)(p.ws + OFF_W_UP) + ((size_t)(layer * 16 + e) * 1024 + ct * 128 + (tid >> 2)) * 1024 + (tid & 3) * 8;
        const bf16_t* b1 = b0 + (size_t)64 * 1024;
        gemm_tile(a0, a1, b0, b1, 1024, lds, cx, [=](f32x4 (&acc)[4][4], int wr, int wc, int fr, int fq) {
#pragma unroll
            for (int m = 0; m < 4; ++m) {
                const int pos = rt * 128 + wr * 64 + m * 16 + fr;
                if (pos < cnt) {
                    bf16_t* dst = H1 + (size_t)(off + pos) * 512 + ct * 64 + wc * 32 + fq * 4;
#pragma unroll
                    for (int n = 0; n < 2; ++n) {
                        float h[4];
#pragma unroll
                        for (int j = 0; j < 4; ++j) h[j] = silu_f(acc[m][n][j]) * acc[m][n + 2][j];
                        uint2 o; o.x = pack2(h[0], h[1]); o.y = pack2(h[2], h[3]);
                        *(uint2*)(dst + n * 16) = o;
                    }
                }
            }
        });
    }
}

__device__ void phase_moe_down(const Params& p, const Ctx& cx, char* lds, int layer) {
    const int tid = cx.tid;
    int* s_cnt = (int*)(lds + 32768); int* s_off = s_cnt + 16; int* s_toff = s_off + 17;
    moe_tables(p, layer, lds, tid, s_cnt, s_off, s_toff);
    const int ntiles = s_toff[16];
    const bf16_t* H1 = (const bf16_t*)(p.ws + OFF_H1);
    const float* lw = (const float*)(p.ws + OFF_LW);
    bf16_t* Y = (bf16_t*)(p.ws + OFF_Y);
    for (int tile = cx.vbid; tile < ntiles; tile += cx.G) {
        int e = 0;
        while (tile >= s_toff[e + 1]) ++e;
        const int lt = tile - s_toff[e], rt = lt >> 3, ct = lt & 7, cnt = s_cnt[e], off = s_off[e];
        const int p0 = min(rt * 128 + (tid >> 2), cnt - 1), p1 = min(rt * 128 + (tid >> 2) + 64, cnt - 1);
        const bf16_t* a0 = H1 + (size_t)(off + p0) * 512 + (tid & 3) * 8;
        const bf16_t* a1 = H1 + (size_t)(off + p1) * 512 + (tid & 3) * 8;
        const bf16_t* b0 = (const bf16_t*)(p.ws + OFF_W_DN) + ((size_t)(layer * 16 + e) * 1024 + ct * 128 + (tid >> 2)) * 512 + (tid & 3) * 8;
        const bf16_t* b1 = b0 + (size_t)64 * 512;
        gemm_tile(a0, a1, b0, b1, 512, lds, cx, [=](f32x4 (&acc)[4][4], int wr, int wc, int fr, int fq) {
#pragma unroll
            for (int m = 0; m < 4; ++m) {
                const int pos = rt * 128 + wr * 64 + m * 16 + fr;
                if (pos < cnt) {
                    const float w = lw[(size_t)e * NTOK + pos];
                    bf16_t* dst = Y + (size_t)(off + pos) * 1024 + ct * 128 + wc * 64 + fq * 4;
#pragma unroll
                    for (int n = 0; n < 4; ++n) {
                        uint2 o; o.x = pack2(w * acc[m][n][0], w * acc[m][n][1]); o.y = pack2(w * acc[m][n][2], w * acc[m][n][3]);
                        *(uint2*)(dst + n * 16) = o;
                    }
                }
            }
        });
    }
}

__device__ void phase_hgrn_inproj(const Params& p, const Ctx& cx, char* lds) {
    const bf16_t* A = (const bf16_t*)(p.ws + OFF_HA);
    const bf16_t* Bt = (const bf16_t*)(p.ws + OFF_W_HG_IN);
    char* ws = p.ws;
    const float* lb = (const float*)(p.ws + OFF_LB);
    gemm_phase_dense(A, 1024, Bt, 1024, NTOK / 128, 32, lds, cx, [=](int row0, int col0) {
        return [=](f32x4 (&acc)[4][4], int wr, int wc, int fr, int fq) {
            const int gc0 = col0 + wc * 64, seg = gc0 >> 10, c0 = gc0 & 1023;
#pragma unroll
            for (int m = 0; m < 4; ++m) {
                const int row = row0 + wr * 64 + m * 16 + fr;
#pragma unroll
                for (int n = 0; n < 4; ++n) {
                    const int c = c0 + n * 16 + fq * 4;
                    if (seg == 1) {
                        f32x4 l4 = *(const f32x4*)(lb + c), o;
#pragma unroll
                        for (int j = 0; j < 4; ++j) o[j] = __logf(l4[j] + (1.f - l4[j]) * sigmoid_f(acc[m][n][j]));
                        *(f32x4*)((float*)(ws + OFF_LF) + (size_t)row * 1024 + c) = o;
                    } else {
                        float h[4];
#pragma unroll
                        for (int j = 0; j < 4; ++j) h[j] = (seg == 2) ? acc[m][n][j] : silu_f(acc[m][n][j]);
                        uint2 o; o.x = pack2(h[0], h[1]); o.y = pack2(h[2], h[3]);
                        bf16_t* dst = (bf16_t*)(ws + (seg == 0 ? OFF_QH : seg == 2 ? OFF_V : OFF_G));
                        *(uint2*)(dst + (size_t)row * 1024 + c) = o;
                    }
                }
            }
        };
    });
}

__device__ void phase_hgrn_rec_naive(const Params& p, const Ctx& cx, char* lds) {
    const int tid = cx.tid, lane = cx.lane, wid = cx.wid;
    float* Fs = (float*)lds;
    float* Qs = Fs + 2048;
    float* Vs = Qs + 2048;
    float* Op = Vs + 2048;
    const bf16_t* QH = (const bf16_t*)(p.ws + OFF_QH);
    const float* LF = (const float*)(p.ws + OFF_LF);
    const bf16_t* V = (const bf16_t*)(p.ws + OFF_V);
    const bf16_t* Gt = (const bf16_t*)(p.ws + OFF_G);
    bf16_t* OA = (bf16_t*)(p.ws + OFF_HA);
    const int j = tid & 127, half = tid >> 7;
    for (int item = cx.vbid; item < 128; item += cx.G) {
        const int b = item >> 3, h = item & 7;
        float S[64];
#pragma unroll
        for (int i = 0; i < 64; ++i) S[i] = 0.f;
        for (int t0 = 0; t0 < SEQ; t0 += 16) {
            __syncthreads();
            for (int i = tid; i < 2048; i += 256) {
                const int tt = i >> 7, d = i & 127;
                const size_t gi = (size_t)(b * SEQ + t0 + tt) * 1024 + h * 128 + d;
                Fs[i] = __expf(LF[gi]); Qs[i] = bf2f(QH[gi]); Vs[i] = bf2f(V[gi]);
            }
            __syncthreads();
            for (int tt = 0; tt < 16; ++tt) {
                const float v = Vs[tt * 128 + j];
                float o = 0.f;
                const float* fr_ = Fs + tt * 128 + half * 64;
                const float* qr_ = Qs + tt * 128 + half * 64;
#pragma unroll
                for (int d4 = 0; d4 < 16; ++d4) {
                    f32x4 f4 = *(const f32x4*)(fr_ + d4 * 4), q4 = *(const f32x4*)(qr_ + d4 * 4);
#pragma unroll
                    for (int k = 0; k < 4; ++k) {
                        const float f = f4[k];
                        S[d4 * 4 + k] = f * S[d4 * 4 + k] + (1.f - f) * v;
                        o += q4[k] * S[d4 * 4 + k];
                    }
                }
                Op[(half * 16 + tt) * 128 + j] = o;
            }
            __syncthreads();
            for (int tt = wid; tt < 16; tt += 4) {
                const float o0 = Op[tt * 128 + lane] + Op[(16 + tt) * 128 + lane];
                const float o1 = Op[tt * 128 + 64 + lane] + Op[(16 + tt) * 128 + 64 + lane];
                const float ss = wave_sum(o0 * o0 + o1 * o1);
                const float r = rsqrtf(ss * (1.f / 128.f) + EPS);
                const size_t gi = (size_t)(b * SEQ + t0 + tt) * 1024 + h * 128;
                OA[gi + lane] = f2bf(o0 * r * p.hgrn_out_gain[lane] * bf2f(Gt[gi + lane]));
                OA[gi + 64 + lane] = f2bf(o1 * r * p.hgrn_out_gain[64 + lane] * bf2f(Gt[gi + 64 + lane]));
            }
        }
    }
}

template <int PH>
__device__ __forceinline__ void run_phase(const Params& p, const Ctx& cx, char* lds) {
    if constexpr (PH == 0) phase0(p, cx, lds);
    else if constexpr (PH == 1) rows_phase<false, true, false>(p, cx, lds, p.x, nullptr, 0, 0, 0, 0);
    else if constexpr (PH == 2) phase_nsa_inproj(p, cx, lds);
    else if constexpr (PH == 3) phase_cmp1(p, cx, lds);
    else if constexpr (PH == 4) phase_cmp2(p, cx);
    else if constexpr (PH == 5) phase_attn_naive(p, cx, lds);
    else if constexpr (PH == 6) phase_outproj(p, cx, lds, (const bf16_t*)(p.ws + OFF_W_NSA_OUT), p.x, 0);
    else if constexpr (PH == 7) rows_phase<false, true, true>(p, cx, lds, p.out, nullptr, 0, 1, 0, 0);
    else if constexpr (PH == 8) phase_moe_up(p, cx, lds, 0);
    else if constexpr (PH == 9) phase_moe_down(p, cx, lds, 0);
    else if constexpr (PH == 10) rows_phase<true, true, false>(p, cx, lds, p.out, p.out, 1, 2, 0, 0);
    else if constexpr (PH == 11) phase_hgrn_inproj(p, cx, lds);
    else if constexpr (PH == 12) phase_hgrn_rec_naive(p, cx, lds);
    else if constexpr (PH == 13) phase_outproj(p, cx, lds, (const bf16_t*)(p.ws + OFF_W_HG_OUT), p.out, 2);
    else if constexpr (PH == 14) rows_phase<false, true, true>(p, cx, lds, p.out, nullptr, 0, 3, 1, 0);
    else if constexpr (PH == 15) phase_moe_up(p, cx, lds, 1);
    else if constexpr (PH == 16) phase_moe_down(p, cx, lds, 1);
    else if constexpr (PH == 17) rows_phase<true, false, false>(p, cx, lds, p.out, p.out, 3, 0, 0, 1);
}

__device__ __forceinline__ Ctx make_ctx() {
    Ctx cx;
    cx.G = gridDim.x; cx.tid = threadIdx.x; cx.wid = threadIdx.x >> 6; cx.lane = threadIdx.x & 63;
    cx.vbid = (cx.G % 8 == 0) ? (blockIdx.x % 8) * (cx.G / 8) + blockIdx.x / 8 : blockIdx.x;
    return cx;
}

#if MULTI_LAUNCH
template <int PH>
__global__ void __launch_bounds__(256, 2) phase_kernel(Params p) {
    __shared__ __attribute__((aligned(16))) char lds[LDS_BYTES];
    const Ctx cx = make_ctx();
    run_phase<PH>(p, cx, lds);
}
template <int PH>
static void launch_phases(const Params& p, int grid, hipStream_t stream) {
    hipLaunchKernelGGL(phase_kernel<PH>, dim3(grid), dim3(256), 0, stream, p);
    if constexpr (PH + 1 < NPHASE) launch_phases<PH + 1>(p, grid, stream);
}
#else
template <int PH>
__device__ __forceinline__ void run_from(const Params& p, const Ctx& cx, char* lds, cg::grid_group& grid) {
    run_phase<PH>(p, cx, lds);
    if constexpr (PH + 1 < NPHASE) {
        grid.sync();
        run_from<PH + 1>(p, cx, lds, grid);
    }
}
__global__ void __launch_bounds__(256, 2) mega_kernel(Params p) {
    __shared__ __attribute__((aligned(16))) char lds[LDS_BYTES];
    cg::grid_group grid = cg::this_grid();
    const Ctx cx = make_ctx();
    run_from<0>(p, cx, lds, grid);
}
#endif

extern "C" void kernel_launch(void* const* d_in, const int* in_sizes, int n_in, void* d_out, int out_size, void* d_ws, size_t ws_size,
                              hipStream_t stream) {
    static int grid = 0;
    if (!grid) {
        int dev = 0, cus = 0, per_cu = 0;
        (void)hipGetDevice(&dev);
        (void)hipDeviceGetAttribute(&cus, hipDeviceAttributeMultiprocessorCount, dev);
#if MULTI_LAUNCH
        per_cu = 2;
#else
        (void)hipOccupancyMaxActiveBlocksPerMultiprocessor(&per_cu, mega_kernel, 256, 0);
        if (per_cu > 2) per_cu = 2;
        if (per_cu < 1) per_cu = 1;
#endif
        if (cus <= 0) cus = 256;
        grid = cus * per_cu;
        if (ws_size < WS_NEED) fprintf(stderr, "kernel_launch: workspace too small: %zu < %zu\n", ws_size, (size_t)WS_NEED);
    }
    Params p{};
    p.x = (const float*)d_in[0]; p.c = (const float*)d_in[1]; p.ada_w = (const float*)d_in[2]; p.ada_b = (const float*)d_in[3];
    p.norm_g = (const float*)d_in[4]; p.rel_bias = (const float*)d_in[5]; p.nsa_w_in = (const float*)d_in[6]; p.nsa_q_gain = (const float*)d_in[7];
    p.nsa_k_gain = (const float*)d_in[8]; p.nsa_cmp_pe = (const float*)d_in[9]; p.nsa_cmp_w1 = (const float*)d_in[10]; p.nsa_cmp_w2 = (const float*)d_in[11];
    p.nsa_w_out = (const float*)d_in[12]; p.hgrn_w_in = (const float*)d_in[13]; p.hgrn_lb = (const float*)d_in[14]; p.hgrn_out_gain = (const float*)d_in[15];
    p.hgrn_w_out = (const float*)d_in[16]; p.moe_rg = (const float*)d_in[17]; p.moe_re = (const float*)d_in[18]; p.moe_w1 = (const float*)d_in[19];
    p.moe_w3 = (const float*)d_in[20]; p.moe_w2 = (const float*)d_in[21];
    p.out = (float*)d_out; p.ws = (char*)d_ws;
#if MULTI_LAUNCH
    launch_phases<0>(p, grid, stream);
#else
    p.p_begin = 0; p.p_end = NPHASE;
    void* args[] = {&p};
    hipError_t e = hipLaunchCooperativeKernel((void*)mega_kernel, dim3(grid), dim3(256), args, 0, stream);
    if (e != hipSuccess) fprintf(stderr, "cooperative launch failed: %s (grid %d)\n", hipGetErrorString(e), grid);
#endif
}
```

```cpp
#include <hip/hip_runtime.h>
#include <hip/hip_cooperative_groups.h>
#include <cstdio>
#include <cstdint>
namespace cg = cooperative_groups;

#ifndef MULTI_LAUNCH
#define MULTI_LAUNCH 0
#endif

typedef unsigned short bf16_t;
typedef short bf16x8 __attribute__((ext_vector_type(8)));
typedef float f32x4 __attribute__((ext_vector_type(4)));
typedef float f32x16 __attribute__((ext_vector_type(16)));

constexpr int NTOK = 32768, DM = 1024, SEQ = 2048, NBATCH = 16;
constexpr int NSA_IN = 2608, NSA_IN_PAD = 2688;
constexpr float EPS = 1e-6f;
constexpr size_t MiB = 1ull << 20;

constexpr size_t OFF_CNT = 0;
constexpr size_t OFF_MOD = 4096;
constexpr size_t OFF_LB = OFF_MOD + 786432;
constexpr size_t OFF_PEB = OFF_LB + 4096;
constexpr size_t OFF_W_NSA_IN = 1 * MiB;
constexpr size_t OFF_W_NSA_OUT = OFF_W_NSA_IN + 2688ull * 1024 * 2;
constexpr size_t OFF_W_HG_IN = OFF_W_NSA_OUT + 1024ull * 1024 * 2;
constexpr size_t OFF_W_HG_OUT = OFF_W_HG_IN + 4096ull * 1024 * 2;
constexpr size_t OFF_W_CMP1 = OFF_W_HG_OUT + 1024ull * 1024 * 2;
constexpr size_t OFF_W_UP = OFF_W_CMP1 + 2ull * 128 * 2048 * 2;
constexpr size_t OFF_W_DN = OFF_W_UP + 32ull * 1024 * 1024 * 2;
constexpr size_t OFF_W_END = OFF_W_DN + 32ull * 1024 * 512 * 2;
constexpr size_t OFF_HA = 116 * MiB;
static_assert(OFF_W_END <= OFF_HA, "weights overflow");
constexpr size_t OFF_SCR = 180 * MiB;
constexpr size_t OFF_Q = OFF_SCR;
constexpr size_t OFF_KCRAW = OFF_Q + 64 * MiB;
constexpr size_t OFF_VCRAW = OFF_KCRAW + 17 * MiB;
constexpr size_t OFF_KS = OFF_VCRAW + 17 * MiB;
constexpr size_t OFF_VS = OFF_KS + 16 * MiB;
constexpr size_t OFF_KW = OFF_VS + 16 * MiB;
constexpr size_t OFF_VW = OFF_KW + 16 * MiB;
constexpr size_t OFF_GATES = OFF_VW + 16 * MiB;
constexpr size_t OFF_T1 = OFF_GATES + 6 * MiB;
constexpr size_t OFF_KC = OFF_T1 + 4 * MiB;
constexpr size_t OFF_VC = OFF_KC + 1 * MiB;
constexpr size_t OFF_H1 = OFF_SCR;
constexpr size_t OFF_Y = OFF_H1 + 64 * MiB;
constexpr size_t OFF_LTOK = OFF_Y + 128 * MiB;
constexpr size_t OFF_LW = OFF_LTOK + 2 * MiB;
constexpr size_t OFF_TSLOT = OFF_LW + 2 * MiB;
constexpr size_t OFF_QH = OFF_SCR;
constexpr size_t OFF_LF = OFF_QH + 64 * MiB;
constexpr size_t OFF_V = OFF_LF + 128 * MiB;
constexpr size_t OFF_G = OFF_V + 64 * MiB;
constexpr size_t WS_NEED = OFF_G + 64 * MiB;
static_assert(WS_NEED <= 512 * MiB, "ws overflow");

constexpr int LDS_BYTES = 64512;
constexpr int NPHASE = 18;

struct Params {
    const float *x, *c, *ada_w, *ada_b, *norm_g, *rel_bias, *nsa_w_in, *nsa_q_gain, *nsa_k_gain, *nsa_cmp_pe, *nsa_cmp_w1,
        *nsa_cmp_w2, *nsa_w_out, *hgrn_w_in, *hgrn_lb, *hgrn_out_gain, *hgrn_w_out, *moe_rg, *moe_re, *moe_w1, *moe_w3, *moe_w2;
    float* out;
    char* ws;
    int p_begin, p_end;
};

__device__ __forceinline__ float bf2f(unsigned short h) { return __uint_as_float((unsigned)h << 16); }
__device__ __forceinline__ unsigned short f2bf(float f) {
    unsigned u = __float_as_uint(f);
    u += 0x7fffu + ((u >> 16) & 1u);
    return (unsigned short)(u >> 16);
}
typedef __bf16 bf2_t __attribute__((ext_vector_type(2)));
typedef float f2_t __attribute__((ext_vector_type(2)));
__device__ __forceinline__ unsigned pack2(float a, float b) {
    f2_t v = {a, b};
    return __builtin_bit_cast(unsigned, __builtin_convertvector(v, bf2_t));
}
__device__ __forceinline__ float wave_sum(float v) {
#pragma unroll
    for (int o = 32; o; o >>= 1) v += __shfl_xor(v, o);
    return v;
}
__device__ __forceinline__ float wave_max(float v) {
#pragma unroll
    for (int o = 32; o; o >>= 1) v = fmaxf(v, __shfl_xor(v, o));
    return v;
}
__device__ __forceinline__ float silu_f(float x) { return x / (1.f + __expf(-x)); }
__device__ __forceinline__ float sigmoid_f(float x) { return 1.f / (1.f + __expf(-x)); }
__device__ __forceinline__ void glds16(const void* g, void* l) {
    __builtin_amdgcn_global_load_lds((const unsigned*)g, (unsigned*)l, 16, 0, 0);
}
__device__ __forceinline__ int t5_bucket(int n) {
    if (n < 16) return n;
    int b = 16;
    b += (n >= 21); b += (n >= 27); b += (n >= 35); b += (n >= 46); b += (n >= 59); b += (n >= 77); b += (n >= 99); b += (n >= 128);
    b += (n >= 166); b += (n >= 216); b += (n >= 280); b += (n >= 363); b += (n >= 470); b += (n >= 609); b += (n >= 790);
    return b;
}

struct Ctx {
    int G, vbid, tid, wid, lane;
};

constexpr int P0_MOD_ITEMS = 192;
constexpr int TS0 = 84 * 16, TS1 = 32 * 16, TS2 = 128 * 16, TS3 = 32 * 16, TS4 = 2 * 4 * 32, TS5 = 32 * 32 * 16, TS6 = 32 * 32 * 8;
constexpr int TC0 = 0, TC1 = TC0 + TS0, TC2 = TC1 + TS1, TC3 = TC2 + TS2, TC4 = TC3 + TS3, TC5 = TC4 + TS4, TC6 = TC5 + TS5, TC_END = TC6 + TS6;
constexpr int P0_ITEMS = P0_MOD_ITEMS + TC_END + 1;

__device__ void transpose_tile(const float* __restrict__ src, int ld, int c0, int ncols_valid, int k0, bf16_t* __restrict__ dst, int dstld,
                               char* lds, int tid) {
    float* tl = (float*)lds;
    {
        const int k = tid >> 2, cc = (tid & 3) * 8;
        const float* s = src + (size_t)(k0 + k) * ld + c0 + cc;
#pragma unroll
        for (int i = 0; i < 8; ++i) {
            float v = (c0 + cc + i < ncols_valid) ? s[i] : 0.f;
            tl[k * 33 + cc + i] = v;
        }
    }
    __syncthreads();
    {
        const int n = tid >> 3, kc = (tid & 7) * 8;
        unsigned w[4];
#pragma unroll
        for (int i = 0; i < 4; ++i) w[i] = pack2(tl[(kc + 2 * i) * 33 + n], tl[(kc + 2 * i + 1) * 33 + n]);
        uint4 o; o.x = w[0]; o.y = w[1]; o.z = w[2]; o.w = w[3];
        *(uint4*)(dst + (size_t)n * dstld + kc) = o;
    }
    __syncthreads();
}

__device__ void phase0(const Params& p, const Ctx& cx, char* lds) {
    const int tid = cx.tid, wid = cx.wid, lane = cx.lane;
    for (int it = cx.vbid; it < P0_ITEMS; it += cx.G) {
        if (it < P0_MOD_ITEMS) {
            const int colbase = it * 64, ls = colbase / 3072, e0 = colbase % 3072;
            const float* W = p.ada_w + (size_t)ls * 1024 * 3072 + e0 + lane;
            float* cs = (float*)lds + wid * 1024;
            float* red = (float*)lds + 4096;
            float acc[16];
#pragma unroll
            for (int b = 0; b < 16; ++b) acc[b] = 0.f;
            for (int sub = 0; sub < 4; ++sub) {
                const int kb = wid * 256 + sub * 64;
#pragma unroll
                for (int b = 0; b < 16; ++b) cs[lane * 16 + b] = silu_f(p.c[b * 1024 + kb + lane]);
                __builtin_amdgcn_wave_barrier();
                for (int kk = 0; kk < 64; ++kk) {
                    const float w = W[(size_t)(kb + kk) * 3072];
                    const f32x4* cv = (const f32x4*)(cs + kk * 16);
#pragma unroll
                    for (int q = 0; q < 4; ++q) {
                        f32x4 c4 = cv[q];
                        acc[q * 4 + 0] += c4[0] * w; acc[q * 4 + 1] += c4[1] * w; acc[q * 4 + 2] += c4[2] * w; acc[q * 4 + 3] += c4[3] * w;
                    }
                }
                __builtin_amdgcn_wave_barrier();
            }
#pragma unroll
            for (int b = 0; b < 16; ++b) red[(wid * 16 + b) * 64 + lane] = acc[b];
            __syncthreads();
            float* mod = (float*)(p.ws + OFF_MOD);
#pragma unroll
            for (int i = 0; i < 4; ++i) {
                const int o = tid + i * 256, b = o >> 6, e = o & 63;
                float s = red[(0 * 16 + b) * 64 + e] + red[(1 * 16 + b) * 64 + e] + red[(2 * 16 + b) * 64 + e] + red[(3 * 16 + b) * 64 + e];
                mod[((size_t)ls * 16 + b) * 3072 + e0 + e] = s + p.ada_b[ls * 3072 + e0 + e];
            }
            __syncthreads();
        } else if (it < P0_MOD_ITEMS + TC_END) {
            const int tt = it - P0_MOD_ITEMS;
            if (tt < TC1) {
                const int nt = tt / 16, kt = tt % 16;
                transpose_tile(p.nsa_w_in, NSA_IN, nt * 32, NSA_IN, kt * 64, (bf16_t*)(p.ws + OFF_W_NSA_IN) + (size_t)nt * 32 * 1024 + kt * 64, 1024, lds, tid);
            } else if (tt < TC2) {
                const int u = tt - TC1, nt = u / 16, kt = u % 16;
                transpose_tile(p.nsa_w_out, 1024, nt * 32, 1024, kt * 64, (bf16_t*)(p.ws + OFF_W_NSA_OUT) + (size_t)nt * 32 * 1024 + kt * 64, 1024, lds, tid);
            } else if (tt < TC3) {
                const int u = tt - TC2, nt = u / 16, kt = u % 16;
                transpose_tile(p.hgrn_w_in, 4096, nt * 32, 4096, kt * 64, (bf16_t*)(p.ws + OFF_W_HG_IN) + (size_t)nt * 32 * 1024 + kt * 64, 1024, lds, tid);
            } else if (tt < TC4) {
                const int u = tt - TC3, nt = u / 16, kt = u % 16;
                transpose_tile(p.hgrn_w_out, 1024, nt * 32, 1024, kt * 64, (bf16_t*)(p.ws + OFF_W_HG_OUT) + (size_t)nt * 32 * 1024 + kt * 64, 1024, lds, tid);
            } else if (tt < TC5) {
                const int u = tt - TC4, kv = u / 128, r = u % 128, nt = r / 32, kt = r % 32;
                transpose_tile(p.nsa_cmp_w1 + (size_t)kv * 2048 * 64, 64, nt * 32, 64, kt * 64,
                               (bf16_t*)(p.ws + OFF_W_CMP1) + ((size_t)kv * 128 + nt * 32) * 2048 + kt * 64, 2048, lds, tid);
            } else if (tt < TC6) {
                const int u = tt - TC5, le = u / 512, r = u % 512, gr = r / 16, kt = r % 16;
                const int t = gr >> 2, wc = (gr >> 1) & 1, which = gr & 1;
                const float* src = (which ? p.moe_w3 : p.moe_w1) + (size_t)le * 1024 * 512;
                transpose_tile(src, 512, (t * 2 + wc) * 32, 512, kt * 64, (bf16_t*)(p.ws + OFF_W_UP) + ((size_t)le * 1024 + gr * 32) * 1024 + kt * 64, 1024, lds, tid);
            } else {
                const int u = tt - TC6, le = u / 256, r = u % 256, nt = r / 8, kt = r % 8;
                transpose_tile(p.moe_w2 + (size_t)le * 512 * 1024, 1024, nt * 32, 1024, kt * 64,
                               (bf16_t*)(p.ws + OFF_W_DN) + ((size_t)le * 1024 + nt * 32) * 512 + kt * 64, 512, lds, tid);
            }
        } else {
            float* lb = (float*)(p.ws + OFF_LB);
            for (int i = tid; i < 1024; i += 256) lb[i] = sigmoid_f(p.hgrn_lb[1024 + i] - p.hgrn_lb[i]);
            if (tid < 128) {
                const int kv = tid >> 6, d = tid & 63;
                const float* pe = p.nsa_cmp_pe + kv * 2048;
                const float* w1 = p.nsa_cmp_w1 + (size_t)kv * 2048 * 64 + d;
                float s = 0.f;
                for (int k = 0; k < 2048; ++k) s += pe[k] * w1[(size_t)k * 64];
                ((float*)(p.ws + OFF_PEB))[tid] = s;
            }
            if (tid < 32) ((int*)(p.ws + OFF_CNT))[tid] = 0;
        }
    }
}

template <bool COMBINE, bool NORM, bool ROUTER>
__device__ void rows_phase(const Params& p, const Ctx& cx, char* lds, const float* __restrict__ src, float* __restrict__ xdst,
                           int ls_comb, int ls_norm, int layer_router, int layer_comb) {
    const int lane = cx.lane;
    const float* mod = (const float*)(p.ws + OFF_MOD);
    int my_off = 0;
    if (COMBINE) {
        const int* cnt = (const int*)(p.ws + OFF_CNT) + layer_comb * 16;
        int cv = (lane < 16) ? cnt[lane] : 0;
        int incl = cv;
#pragma unroll
        for (int o = 1; o < 16; o <<= 1) { int t = __shfl_up(incl, o); if (lane >= o) incl += t; }
        my_off = incl - cv;
    }
    for (int row = cx.vbid * 4 + cx.wid; row < NTOK; row += cx.G * 4) {
        const int b = row >> 11;
        f32x4 v[4];
#pragma unroll
        for (int i = 0; i < 4; ++i) v[i] = *(const f32x4*)(src + (size_t)row * 1024 + (i * 64 + lane) * 4);
        if (COMBINE) {
            const int* ts = (const int*)(p.ws + OFF_TSLOT) + row * 2;
            const int s0 = ts[0], s1 = ts[1];
            const int r0 = __shfl(my_off, s0 >> 16) + (s0 & 0xffff), r1 = __shfl(my_off, s1 >> 16) + (s1 & 0xffff);
            const bf16_t* Y = (const bf16_t*)(p.ws + OFF_Y);
            const float* gate = mod + ((size_t)ls_comb * 16 + b) * 3072 + 2048;
#pragma unroll
            for (int i = 0; i < 4; ++i) {
                const int col = (i * 64 + lane) * 4;
                uint2 a = *(const uint2*)(Y + (size_t)r0 * 1024 + col), c = *(const uint2*)(Y + (size_t)r1 * 1024 + col);
                f32x4 g = *(const f32x4*)(gate + col);
                v[i][0] += g[0] * (bf2f(a.x & 0xffff) + bf2f(c.x & 0xffff));
                v[i][1] += g[1] * (bf2f(a.x >> 16) + bf2f(c.x >> 16));
                v[i][2] += g[2] * (bf2f(a.y & 0xffff) + bf2f(c.y & 0xffff));
                v[i][3] += g[3] * (bf2f(a.y >> 16) + bf2f(c.y >> 16));
                *(f32x4*)(xdst + (size_t)row * 1024 + col) = v[i];
            }
        }
        if (NORM) {
            float ss = 0.f;
#pragma unroll
            for (int i = 0; i < 4; ++i) ss += v[i][0] * v[i][0] + v[i][1] * v[i][1] + v[i][2] * v[i][2] + v[i][3] * v[i][3];
            ss = wave_sum(ss);
            const float r = rsqrtf(ss * (1.f / 1024.f) + EPS);
            const float* gain = p.norm_g + ls_norm * 1024;
            const float* shift = mod + ((size_t)ls_norm * 16 + b) * 3072;
            const float* scale = shift + 1024;
            bf16_t* hA = (bf16_t*)(p.ws + OFF_HA);
            f32x4 rg4 = {0.f, 0.f, 0.f, 0.f}, re0 = rg4, re1 = rg4, re2 = rg4, re3 = rg4;
#pragma unroll
            for (int i = 0; i < 4; ++i) {
                const int col = (i * 64 + lane) * 4;
                f32x4 g = *(const f32x4*)(gain + col), sc = *(const f32x4*)(scale + col), sh = *(const f32x4*)(shift + col);
                f32x4 h;
#pragma unroll
                for (int j = 0; j < 4; ++j) h[j] = v[i][j] * r * g[j] * (1.f + sc[j]) + sh[j];
                uint2 o; o.x = pack2(h[0], h[1]); o.y = pack2(h[2], h[3]);
                *(uint2*)(hA + (size_t)row * 1024 + col) = o;
                if (ROUTER) {
                    const float* rg = p.moe_rg + (size_t)layer_router * 1024 * 4;
                    const float* re = p.moe_re + (size_t)layer_router * 1024 * 16;
#pragma unroll
                    for (int j = 0; j < 4; ++j) {
                        rg4 += h[j] * *(const f32x4*)(rg + (col + j) * 4);
                        re0 += h[j] * *(const f32x4*)(re + (col + j) * 16 + 0);
                        re1 += h[j] * *(const f32x4*)(re + (col + j) * 16 + 4);
                        re2 += h[j] * *(const f32x4*)(re + (col + j) * 16 + 8);
                        re3 += h[j] * *(const f32x4*)(re + (col + j) * 16 + 12);
                    }
                }
            }
            if (ROUTER) {
                float rl[4];
                f32x4 rs0, rs1, rs2, rs3;
#pragma unroll
                for (int j = 0; j < 4; ++j) { rl[j] = wave_sum(rg4[j]); rs0[j] = wave_sum(re0[j]); rs1[j] = wave_sum(re1[j]); rs2[j] = wave_sum(re2[j]); rs3[j] = wave_sum(re3[j]); }
                float gm = fmaxf(fmaxf(rl[0], rl[1]), fmaxf(rl[2], rl[3]));
                float e0 = __expf(rl[0] - gm), e1 = __expf(rl[1] - gm), e2 = __expf(rl[2] - gm), e3 = __expf(rl[3] - gm);
                float gs = e0 + e1 + e2 + e3;
                int grp = 0; float best = rl[0];
                if (rl[1] > best) { best = rl[1]; grp = 1; }
                if (rl[2] > best) { best = rl[2]; grp = 2; }
                if (rl[3] > best) { best = rl[3]; grp = 3; }
                const float pg = __expf(best - gm) / gs;
                const f32x4 lsel = (grp == 0) ? rs0 : (grp == 1) ? rs1 : (grp == 2) ? rs2 : rs3;
                const float l0 = lsel[0], l1 = lsel[1], l2 = lsel[2], l3 = lsel[3];
                const float em = fmaxf(fmaxf(l0, l1), fmaxf(l2, l3));
                float q0 = __expf(l0 - em), q1 = __expf(l1 - em), q2 = __expf(l2 - em), q3 = __expf(l3 - em);
                int i1 = 0; float b1 = q0;
                if (q1 > b1) { b1 = q1; i1 = 1; }
                if (q2 > b1) { b1 = q2; i1 = 2; }
                if (q3 > b1) { b1 = q3; i1 = 3; }
                int i2 = -1; float b2 = -1.f;
                if (i1 != 0 && q0 > b2) { b2 = q0; i2 = 0; }
                if (i1 != 1 && q1 > b2) { b2 = q1; i2 = 1; }
                if (i1 != 2 && q2 > b2) { b2 = q2; i2 = 2; }
                if (i1 != 3 && q3 > b2) { b2 = q3; i2 = 3; }
                const float inv = pg / (b1 + b2);
                if (lane == 0) {
                    int* cnt = (int*)(p.ws + OFF_CNT) + layer_router * 16;
                    int* ltok = (int*)(p.ws + OFF_LTOK);
                    float* lw = (float*)(p.ws + OFF_LW);
                    int* ts = (int*)(p.ws + OFF_TSLOT) + row * 2;
                    const int ea = grp * 4 + i1, eb = grp * 4 + i2;
                    const int pa = atomicAdd(cnt + ea, 1);
                    const int pb = atomicAdd(cnt + eb, 1);
                    ltok[(size_t)ea * NTOK + pa] = row; lw[(size_t)ea * NTOK + pa] = b1 * inv;
                    ltok[(size_t)eb * NTOK + pb] = row; lw[(size_t)eb * NTOK + pb] = b2 * inv;
                    ts[0] = (ea << 16) | pa; ts[1] = (eb << 16) | pb;
                }
            }
        }
    }
}

template <class Epi>
__device__ __forceinline__ void gemm_tile(const bf16_t* a0, const bf16_t* a1, const bf16_t* b0, const bf16_t* b1, int K, char* lds, const Ctx& cx,
                                          Epi&& epi) {
    const int tid = cx.tid, lane = cx.lane, wr = cx.wid >> 1, wc = cx.wid & 1, fr = lane & 15, fq = lane >> 4;
    f32x4 acc[4][4];
#pragma unroll
    for (int m = 0; m < 4; ++m)
#pragma unroll
        for (int n = 0; n < 4; ++n) acc[m][n] = (f32x4){0.f, 0.f, 0.f, 0.f};
    const int nt = K / 32;
    {
        char* SA = lds; char* SB = lds + 8192;
        glds16(a0, SA + tid * 16); glds16(a1, SA + tid * 16 + 4096);
        glds16(b0, SB + tid * 16); glds16(b1, SB + tid * 16 + 4096);
    }
    asm volatile("s_waitcnt vmcnt(0)" ::: "memory");
    __syncthreads();
    for (int kt = 0; kt < nt; ++kt) {
        const int cur = kt & 1;
        if (kt + 1 < nt) {
            char* SA = lds + (cur ^ 1) * 16384; char* SB = SA + 8192;
            const int ko = (kt + 1) * 32;
            glds16(a0 + ko, SA + tid * 16); glds16(a1 + ko, SA + tid * 16 + 4096);
            glds16(b0 + ko, SB + tid * 16); glds16(b1 + ko, SB + tid * 16 + 4096);
        }
        const char* SA = lds + cur * 16384; const char* SB = SA + 8192;
        bf16x8 Af[4], Bf[4];
#pragma unroll
        for (int m = 0; m < 4; ++m) Af[m] = *(const bf16x8*)(SA + (wr * 64 + m * 16 + fr) * 64 + fq * 16);
#pragma unroll
        for (int n = 0; n < 4; ++n) Bf[n] = *(const bf16x8*)(SB + (wc * 64 + n * 16 + fr) * 64 + fq * 16);
#pragma unroll
        for (int m = 0; m < 4; ++m)
#pragma unroll
            for (int n = 0; n < 4; ++n) acc[m][n] = __builtin_amdgcn_mfma_f32_16x16x32_bf16(Bf[n], Af[m], acc[m][n], 0, 0, 0);
        asm volatile("s_waitcnt vmcnt(0)" ::: "memory");
        __syncthreads();
    }
    epi(acc, wr, wc, fr, fq);
}

template <class EpiFactory>
__device__ void gemm_phase_dense(const bf16_t* A, int lda, const bf16_t* Bt, int K, int nrt, int nct, char* lds, const Ctx& cx, EpiFactory&& mk) {
    const int tid = cx.tid;
    const int ntiles = nrt * nct;
    for (int tile = cx.vbid; tile < ntiles; tile += cx.G) {
        const int rt = tile / nct, ct = tile % nct;
        const bf16_t* a0 = A + (size_t)(rt * 128 + (tid >> 2)) * lda + (tid & 3) * 8;
        const bf16_t* a1 = a0 + (size_t)64 * lda;
        const bf16_t* b0 = Bt + (size_t)(ct * 128 + (tid >> 2)) * K + (tid & 3) * 8;
        const bf16_t* b1 = b0 + (size_t)64 * K;
        gemm_tile(a0, a1, b0, b1, K, lds, cx, mk(rt * 128, ct * 128));
    }
}

__device__ void phase_nsa_inproj(const Params& p, const Ctx& cx, char* lds) {
    const bf16_t* A = (const bf16_t*)(p.ws + OFF_HA);
    const bf16_t* Bt = (const bf16_t*)(p.ws + OFF_W_NSA_IN);
    char* ws = p.ws;
    const float* qg = p.nsa_q_gain;
    const float* kg = p.nsa_k_gain;
    gemm_phase_dense(A, 1024, Bt, 1024, NTOK / 128, NSA_IN_PAD / 128, lds, cx, [=](int row0, int col0) {
        return [=](f32x4 (&acc)[4][4], int wr, int wc, int fr, int fq) {
            const int gc0 = col0 + wc * 64;
            if (gc0 >= NSA_IN) return;
            if (gc0 < 1024 || (gc0 >= 1536 && gc0 < 1792) || (gc0 >= 2048 && gc0 < 2304)) {
                const float* gain; float post; bf16_t* dstb; size_t rstride; size_t coff; bool tokmajor;
                if (gc0 < 1024) { gain = qg; post = 0.125f * 1.4426950408889634f; }
                else if (gc0 < 1792) { gain = kg + 64; post = 1.f; }
                else { gain = kg + 128; post = 1.f; }
#pragma unroll
                for (int m = 0; m < 4; ++m) {
                    float ss = 0.f;
#pragma unroll
                    for (int n = 0; n < 4; ++n) ss += acc[m][n][0] * acc[m][n][0] + acc[m][n][1] * acc[m][n][1] + acc[m][n][2] * acc[m][n][2] + acc[m][n][3] * acc[m][n][3];
                    ss += __shfl_xor(ss, 16); ss += __shfl_xor(ss, 32);
                    const float r = rsqrtf(ss * (1.f / 64.f) + EPS) * post;
                    const int row = row0 + wr * 64 + m * 16 + fr;
                    bf16_t* dst;
                    if (gc0 < 1024) dst = (bf16_t*)(ws + OFF_Q) + (size_t)row * 1024 + gc0;
                    else {
                        const int g = ((gc0 - 1024) & 255) >> 6, b = row >> 11, t = row & 2047;
                        dst = (bf16_t*)(ws + (gc0 < 1792 ? OFF_KS : OFF_KW)) + ((size_t)(b * 4 + g) * 2048 + t) * 64;
                    }
#pragma unroll
                    for (int n = 0; n < 4; ++n) {
                        const int c = n * 16 + fq * 4;
                        f32x4 g4 = *(const f32x4*)(gain + c);
                        uint2 o; o.x = pack2(acc[m][n][0] * r * g4[0], acc[m][n][1] * r * g4[1]); o.y = pack2(acc[m][n][2] * r * g4[2], acc[m][n][3] * r * g4[3]);
                        *(uint2*)(dst + c) = o;
                    }
                }
            } else if (gc0 < 2560) {
                const int seg = (gc0 - 1024) >> 8;
                const int g = ((gc0 - 1024) & 255) >> 6;
                if (seg < 2) {
                    const size_t off = seg == 0 ? OFF_KCRAW : OFF_VCRAW;
#pragma unroll
                    for (int m = 0; m < 4; ++m) {
                        const int row = row0 + wr * 64 + m * 16 + fr, b = row >> 11, t = row & 2047;
                        bf16_t* dst = (bf16_t*)(ws + off) + ((size_t)(b * 4 + g) * 2048 + t) * 64;
#pragma unroll
                        for (int n = 0; n < 4; ++n) {
                            const int c = n * 16 + fq * 4;
                            uint2 o; o.x = pack2(acc[m][n][0], acc[m][n][1]); o.y = pack2(acc[m][n][2], acc[m][n][3]);
                            *(uint2*)(dst + c) = o;
                        }
                    }
                } else {
                    const size_t off = seg == 3 ? OFF_VS : OFF_VW;
#pragma unroll
                    for (int m = 0; m < 4; ++m) {
                        const int row = row0 + wr * 64 + m * 16 + fr, b = row >> 11, t = row & 2047;
                        bf16_t* dst = (bf16_t*)(ws + off) + (size_t)(b * 4 + g) * 64 * 2048 + t;
#pragma unroll
                        for (int n = 0; n < 4; ++n)
#pragma unroll
                            for (int j = 0; j < 4; ++j) dst[(size_t)(n * 16 + fq * 4 + j) * 2048] = f2bf(acc[m][n][j]);
                    }
                }
            } else {
#pragma unroll
                for (int m = 0; m < 4; ++m) {
                    const int row = row0 + wr * 64 + m * 16 + fr;
                    float* dst = (float*)(ws + OFF_GATES) + (size_t)row * 48;
#pragma unroll
                    for (int n = 0; n < 3; ++n) {
                        const int c = n * 16 + fq * 4;
                        f32x4 o;
#pragma unroll
                        for (int j = 0; j < 4; ++j) o[j] = sigmoid_f(acc[m][n][j]);
                        *(f32x4*)(dst + c) = o;
                    }
                }
            }
        };
    });
}

__device__ void phase_cmp1(const Params& p, const Ctx& cx, char* lds) {
    const int tid = cx.tid;
    const float* peb = (const float*)(p.ws + OFF_PEB);
    float* T1 = (float*)(p.ws + OFF_T1);
    for (int tile = cx.vbid; tile < 128; tile += cx.G) {
        const int kv = tile >> 6, bg = tile & 63;
        const bf16_t* raw = (const bf16_t*)(p.ws + (kv ? OFF_VCRAW : OFF_KCRAW)) + (size_t)bg * 2048 * 64;
        const bf16_t* a0 = raw + (size_t)(tid >> 2) * 1024 + (tid & 3) * 8;
        const bf16_t* a1 = a0 + (size_t)64 * 1024;
        const bf16_t* b0 = (const bf16_t*)(p.ws + OFF_W_CMP1) + ((size_t)kv * 128 + (tid >> 2)) * 2048 + (tid & 3) * 8;
        const bf16_t* b1 = b0 + (size_t)64 * 2048;
        gemm_tile(a0, a1, b0, b1, 2048, lds, cx, [=](f32x4 (&acc)[4][4], int wr, int wc, int fr, int fq) {
            if (wc != 0) return;
#pragma unroll
            for (int m = 0; m < 4; ++m) {
                const int n_ = wr * 64 + m * 16 + fr;
                float* dst = T1 + ((size_t)kv * 8192 + bg * 128 + n_) * 64;
#pragma unroll
                for (int n = 0; n < 4; ++n) {
                    const int c = n * 16 + fq * 4;
                    f32x4 pb = *(const f32x4*)(peb + kv * 64 + c);
                    *(f32x4*)(dst + c) = acc[m][n] + pb;
                }
            }
        });
    }
}

__device__ void phase_cmp2(const Params& p, const Ctx& cx) {
    const int lane = cx.lane;
    const float* T1 = (const float*)(p.ws + OFF_T1);
    for (int r = cx.vbid * 4 + cx.wid; r < 2 * 8192; r += cx.G * 4) {
        const int kv = r >> 13, rr = r & 8191, n_ = rr & 127;
        const float s = silu_f(T1[(size_t)r * 64 + lane]);
        const float* w2 = p.nsa_cmp_w2 + kv * 4096 + lane;
        float o = 0.f;
#pragma unroll 8
        for (int j = 0; j < 64; ++j) o += __shfl(s, j) * w2[j * 64];
        if (kv == 0) {
            const float ss = wave_sum(o * o);
            o = o * rsqrtf(ss * (1.f / 64.f) + EPS) * p.nsa_k_gain[lane];
        }
        if (n_ == 127) o = 0.f;
        if (kv == 0) ((bf16_t*)(p.ws + OFF_KC))[(size_t)rr * 64 + lane] = f2bf(o);
        else ((bf16_t*)(p.ws + OFF_VC))[((size_t)(rr >> 7) * 64 + lane) * 128 + n_] = f2bf(o);
    }
}

constexpr int ATT_K_OFF = 0, ATT_K_STRIDE = 144, ATT_V_OFF = 9216, ATT_V_STRIDE = 136, ATT_LUT_OFF = 17920, LUT_N = 2128, LUT_PAD = 80;
constexpr int ATT_SC_OFF = ATT_LUT_OFF + 4 * LUT_N * 4;
static_assert(ATT_SC_OFF + 4 * 3072 <= LDS_BYTES, "attention LDS");
#define MFMA32(a, b, c) __builtin_amdgcn_mfma_f32_32x32x16_bf16((a), (b), (c), 0, 0, 0)

__device__ void phase_attn(const Params& p, const Ctx& cx, char* lds) {
    const int tid = cx.tid, lane = cx.lane, wid = cx.wid;
    const int g = cx.vbid & 3;
    const int ql = lane & 7, head = (lane & 31) >> 3, h2 = lane >> 5, l31 = lane & 31;
    float* lut = (float*)(lds + ATT_LUT_OFF);
    for (int i = tid; i < 4 * LUT_N; i += 256) {
        const int h = i / LUT_N, dist = i % LUT_N - LUT_PAD;
        lut[i] = dist >= 0 ? p.rel_bias[t5_bucket(dist) * 16 + g * 4 + h] * 1.4426950408889634f : 0.f;
    }
    __syncthreads();
    const float* lutp = lut + head * LUT_N + LUT_PAD;
    const bf16_t* Qb = (const bf16_t*)(p.ws + OFF_Q);
    const bf16_t* KC = (const bf16_t*)(p.ws + OFF_KC);
    const bf16_t* VCT = (const bf16_t*)(p.ws + OFF_VC);
    const bf16_t* KS = (const bf16_t*)(p.ws + OFF_KS);
    const bf16_t* VST = (const bf16_t*)(p.ws + OFF_VS);
    const bf16_t* KW = (const bf16_t*)(p.ws + OFF_KW);
    const bf16_t* VWT = (const bf16_t*)(p.ws + OFF_VW);
    const float* GT = (const float*)(p.ws + OFF_GATES);
    bf16_t* Og = (bf16_t*)(p.ws + OFF_HA);
    float* scw = (float*)(lds + ATT_SC_OFF) + wid * 768;
    const bool flip_ok = (cx.G % 256) == 0;

    for (int it = 0;; ++it) {
        const int u = cx.vbid + it * cx.G;
        if (u >= 4096) break;
        const int rest = u >> 2, b = rest >> 6, qtb = rest & 63;
        const int qt = (flip_ok && (it & 1)) ? 63 - qtb : qtb;
        const int t0 = qt * 32, cur = qt >> 1, bg = b * 4 + g;
        const int tq = t0 + wid * 8 + ql;
        const size_t rowtok = (size_t)b * SEQ + tq;
        bf16x8 Qf[4];
        {
            const bf16_t* qp = Qb + rowtok * 1024 + (g * 4 + head) * 64 + 8 * h2;
#pragma unroll
            for (int ks = 0; ks < 4; ++ks) Qf[ks] = *(const bf16x8*)(qp + 16 * ks);
        }
        const float* gt = GT + rowtok * 48 + (g * 4 + head) * 3;
        const float gate_c = gt[0], gate_s = gt[1], gate_w = gt[2];
        const int wlo = max(0, (t0 - 511) >> 6);
        const int nW = cur - wlo + 1;
        const int NT = 4 + nW + cur + 1;

        uint4 kr0, kr1, vr0, vr1;
        auto issue_load = [&](int i) {
            const bf16_t* ksrc; const bf16_t* vsrc; int vstride;
            if (i < 4) { const int ci = i & 1; ksrc = KC + ((size_t)bg * 128 + ci * 64) * 64; vsrc = VCT + (size_t)bg * 64 * 128 + ci * 64; vstride = 128; }
            else if (i < 4 + nW) { const int kb = wlo + i - 4; ksrc = KW + ((size_t)bg * 2048 + kb * 64) * 64; vsrc = VWT + (size_t)bg * 64 * 2048 + kb * 64; vstride = 2048; }
            else { const int kb = i - 4 - nW; ksrc = KS + ((size_t)bg * 2048 + kb * 64) * 64; vsrc = VST + (size_t)bg * 64 * 2048 + kb * 64; vstride = 2048; }
            kr0 = *(const uint4*)(ksrc + tid * 8);
            kr1 = *(const uint4*)(ksrc + (tid + 256) * 8);
            vr0 = *(const uint4*)(vsrc + (size_t)(tid >> 3) * vstride + (tid & 7) * 8);
            vr1 = *(const uint4*)(vsrc + (size_t)((tid >> 3) + 32) * vstride + (tid & 7) * 8);
        };
        auto write_lds = [&]() {
            *(uint4*)(lds + ATT_K_OFF + (tid >> 3) * ATT_K_STRIDE + (tid & 7) * 16) = kr0;
            *(uint4*)(lds + ATT_K_OFF + ((tid >> 3) + 32) * ATT_K_STRIDE + (tid & 7) * 16) = kr1;
            char* va = lds + ATT_V_OFF + (tid >> 3) * ATT_V_STRIDE + (tid & 7) * 16;
            uint2 t;
            t.x = vr0.x; t.y = vr0.y; *(uint2*)va = t;
            t.x = vr0.z; t.y = vr0.w; *(uint2*)(va + 8) = t;
            t.x = vr1.x; t.y = vr1.y; *(uint2*)(va + 32 * ATT_V_STRIDE) = t;
            t.x = vr1.z; t.y = vr1.w; *(uint2*)(va + 32 * ATT_V_STRIDE + 8) = t;
        };
        f32x16 O0, O1, OUT0, OUT1;
#pragma unroll
        for (int r = 0; r < 16; ++r) { O0[r] = 0.f; O1[r] = 0.f; }
        float lsum = 0.f;

        auto qk = [&](int kt2) -> f32x16 {
            f32x16 S;
#pragma unroll
            for (int r = 0; r < 16; ++r) S[r] = 0.f;
            const char* kp = lds + ATT_K_OFF + (32 * kt2 + l31) * ATT_K_STRIDE + 16 * h2;
#pragma unroll
            for (int ks = 0; ks < 4; ++ks) S = MFMA32(*(const bf16x8*)(kp + 32 * ks), Qf[ks], S);
            return S;
        };
        auto pv = [&](int kt2, const f32x16& P) {
#pragma unroll
            for (int s2 = 0; s2 < 2; ++s2) {
                uint4 pk;
                pk.x = pack2(P[8 * s2 + 0], P[8 * s2 + 1]); pk.y = pack2(P[8 * s2 + 2], P[8 * s2 + 3]);
                pk.z = pack2(P[8 * s2 + 4], P[8 * s2 + 5]); pk.w = pack2(P[8 * s2 + 6], P[8 * s2 + 7]);
                const bf16x8 Pf = __builtin_bit_cast(bf16x8, pk);
                const char* vp = lds + ATT_V_OFF + l31 * ATT_V_STRIDE + (32 * kt2 + 16 * s2 + 4 * h2) * 2;
                {
                    uint2 lo = *(const uint2*)vp, hi = *(const uint2*)(vp + 16);
                    uint4 a; a.x = lo.x; a.y = lo.y; a.z = hi.x; a.w = hi.y;
                    O0 = MFMA32(__builtin_bit_cast(bf16x8, a), Pf, O0);
                }
                {
                    uint2 lo = *(const uint2*)(vp + 32 * ATT_V_STRIDE), hi = *(const uint2*)(vp + 32 * ATT_V_STRIDE + 16);
                    uint4 a; a.x = lo.x; a.y = lo.y; a.z = hi.x; a.w = hi.y;
                    O1 = MFMA32(__builtin_bit_cast(bf16x8, a), Pf, O1);
                }
            }
        };
        auto finalize = [&](float gate, bool first) {
            const float Z = lsum + __shfl_xor(lsum, 32);
            const float f = Z > 0.f ? gate / Z : 0.f;
#pragma unroll
            for (int r = 0; r < 16; ++r) {
                if (first) { OUT0[r] = f * O0[r]; OUT1[r] = f * O1[r]; }
                else { OUT0[r] += f * O0[r]; OUT1[r] += f * O1[r]; }
                O0[r] = 0.f; O1[r] = 0.f;
            }
            lsum = 0.f;
        };

        const int nvis = (tq >= 31) ? min((tq - 31) / 16 + 1, 127) : 0;
        float inv_c = 0.f;
        unsigned selmask = 0u;
        float* sown = scw + ql * 32;
        float* stail = scw + 256 + ql * 32;
        float* ssc = scw + 512 + ql * 32;
        issue_load(0);
        for (int i = 0; i < NT; ++i) {
            __syncthreads();
            write_lds();
            __syncthreads();
            if (i + 1 < NT) issue_load(i + 1);
            if (i < 4) {
                const int ci = i & 1;
#pragma unroll 1
                for (int kt2 = 0; kt2 < 2; ++kt2) {
                    f32x16 S = qk(kt2);
                    const int n0 = 64 * ci + 32 * kt2 + 4 * h2;
                    const int d0 = tq - 31 - 16 * n0;
#pragma unroll
                    for (int r = 0; r < 16; ++r) {
                        const int cr = (r & 3) + 8 * (r >> 2);
                        const float bias = lutp[max(d0 - 16 * cr, -LUT_PAD)];
                        S[r] = __builtin_amdgcn_exp2f(S[r] + bias + ((n0 + cr) < nvis ? 0.f : -INFINITY));
                        lsum += S[r];
                    }
                    if (i >= 2) {
                        pv(kt2, S);
#pragma unroll
                        for (int rq = 0; rq < 4; ++rq) {
                            float gsum = (S[4 * rq] + S[4 * rq + 1] + S[4 * rq + 2] + 0.5f * S[4 * rq + 3]) * inv_c;
                            float tl = 0.5f * S[4 * rq + 3] * inv_c;
                            gsum += __shfl_xor(gsum, 8); gsum += __shfl_xor(gsum, 16);
                            tl += __shfl_xor(tl, 8); tl += __shfl_xor(tl, 16);
                            const int sblk = 8 * (2 * ci + kt2) + 2 * rq + h2;
                            if (head == 0) {
                                sown[sblk] = gsum;
                                if (sblk < 31) stail[sblk + 1] = tl;
                            }
                        }
                    }
                }
                if (i == 1) {
                    const float Z = lsum + __shfl_xor(lsum, 32);
                    inv_c = Z > 0.f ? 1.f / Z : 0.f;
                    lsum = 0.f;
                }
                if (i == 3) {
                    if (head == 0 && h2 == 0) stail[0] = 0.f;
                    __builtin_amdgcn_wave_barrier();
                    const int j8 = head * 2 + h2;
                    {
                        const f32x4 a = *(const f32x4*)(sown + 4 * j8), t4 = *(const f32x4*)(stail + 4 * j8);
                        f32x4 sc;
#pragma unroll
                        for (int q = 0; q < 4; ++q) {
                            const int sblk = 4 * j8 + q;
                            const bool forced = (sblk == 0) || (sblk == cur) || (sblk == cur - 1);
                            sc[q] = forced ? 1.0e4f : (sblk <= cur ? a[q] + t4[q] : -1.0f);
                        }
                        *(f32x4*)(ssc + 4 * j8) = sc;
                    }
                    __builtin_amdgcn_wave_barrier();
                    const f32x4 own = *(const f32x4*)(ssc + 4 * j8);
                    int rk0 = 0, rk1 = 0, rk2 = 0, rk3 = 0;
                    const int so0 = 4 * j8;
#pragma unroll
                    for (int m4 = 0; m4 < 8; ++m4) {
                        const f32x4 v = *(const f32x4*)(ssc + 4 * m4);
#pragma unroll
                        for (int q = 0; q < 4; ++q) {
                            const int sm = 4 * m4 + q;
                            const float vm = v[q];
                            rk0 += (vm > own[0] || (vm == own[0] && sm < so0)) ? 1 : 0;
                            rk1 += (vm > own[1] || (vm == own[1] && sm < so0 + 1)) ? 1 : 0;
                            rk2 += (vm > own[2] || (vm == own[2] && sm < so0 + 2)) ? 1 : 0;
                            rk3 += (vm > own[3] || (vm == own[3] && sm < so0 + 3)) ? 1 : 0;
                        }
                    }
                    unsigned mk = ((rk0 < 8 ? 1u : 0u) | (rk1 < 8 ? 2u : 0u) | (rk2 < 8 ? 4u : 0u) | (rk3 < 8 ? 8u : 0u)) << so0;
                    mk |= __shfl_xor(mk, 8); mk |= __shfl_xor(mk, 16); mk |= __shfl_xor(mk, 32);
                    selmask = mk;
                    __builtin_amdgcn_wave_barrier();
                    finalize(gate_c, true);
                }
            } else {
                const bool isw = i < 4 + nW;
                const int kb = isw ? wlo + i - 4 : i - 4 - nW;
                const bool sel = isw ? true : ((selmask >> kb) & 1u) != 0;
                if (__ballot(sel) != 0ull) {
                    const int dhi = isw ? 512 : 0x7fffffff;
#pragma unroll 1
                    for (int kt2 = 0; kt2 < 2; ++kt2) {
                        f32x16 S = qk(kt2);
                        const int d0 = tq - (64 * kb + 32 * kt2 + 4 * h2);
                        const float* lp = lutp + (d0 - 27);
#pragma unroll
                        for (int r = 0; r < 16; ++r) {
                            const int cr = (r & 3) + 8 * (r >> 2);
                            const int dist = d0 - cr;
                            const float bias = lp[27 - cr];
                            const bool valid = sel && dist >= 0 && dist < dhi;
                            S[r] = __builtin_amdgcn_exp2f(S[r] + bias + (valid ? 0.f : -INFINITY));
                            lsum += S[r];
                        }
                        pv(kt2, S);
                    }
                }
                if (i == 3 + nW) finalize(gate_w, false);
            }
        }
        finalize(gate_s, false);
        {
            bf16_t* op = Og + rowtok * 1024 + (g * 4 + head) * 64 + 4 * h2;
#pragma unroll
            for (int rq = 0; rq < 4; ++rq) {
                uint2 o0; o0.x = pack2(OUT0[4 * rq], OUT0[4 * rq + 1]); o0.y = pack2(OUT0[4 * rq + 2], OUT0[4 * rq + 3]);
                uint2 o1; o1.x = pack2(OUT1[4 * rq], OUT1[4 * rq + 1]); o1.y = pack2(OUT1[4 * rq + 2], OUT1[4 * rq + 3]);
                *(uint2*)(op + 8 * rq) = o0;
                *(uint2*)(op + 32 + 8 * rq) = o1;
            }
        }
    }
}

__device__ void phase_outproj(const Params& p, const Ctx& cx, char* lds, const bf16_t* Bt, const float* xin, int ls) {
    const bf16_t* A = (const bf16_t*)(p.ws + OFF_HA);
    const float* mod = (const float*)(p.ws + OFF_MOD);
    float* xo = p.out;
    gemm_phase_dense(A, 1024, Bt, 1024, NTOK / 128, 8, lds, cx, [=](int row0, int col0) {
        return [=](f32x4 (&acc)[4][4], int wr, int wc, int fr, int fq) {
#pragma unroll
            for (int m = 0; m < 4; ++m) {
                const int row = row0 + wr * 64 + m * 16 + fr, b = row >> 11;
                const float* gate = mod + ((size_t)ls * 16 + b) * 3072 + 2048;
#pragma unroll
                for (int n = 0; n < 4; ++n) {
                    const int col = col0 + wc * 64 + n * 16 + fq * 4;
                    f32x4 g = *(const f32x4*)(gate + col);
                    f32x4 xi = *(const f32x4*)(xin + (size_t)row * 1024 + col);
                    f32x4 o;
#pragma unroll
                    for (int j = 0; j < 4; ++j) o[j] = xi[j] + g[j] * acc[m][n][j];
                    *(f32x4*)(xo + (size_t)row * 1024 + col) = o;
                }
            }
        };
    });
}

__device__ __forceinline__ void moe_tables(const Params& p, int layer, char* lds, int tid, int* s_cnt, int* s_off, int* s_toff) {
    if (tid == 0) {
        const int* cnt = (const int*)(p.ws + OFF_CNT) + layer * 16;
        int o = 0, to = 0;
        for (int e = 0; e < 16; ++e) { const int c = cnt[e]; s_cnt[e] = c; s_off[e] = o; s_toff[e] = to; o += c; to += ((c + 127) >> 7) * 8; }
        s_off[16] = o; s_toff[16] = to;
    }
    __syncthreads();
}

__device__ void phase_moe_up(const Params& p, const Ctx& cx, char* lds, int layer) {
    const int tid = cx.tid;
    int* s_cnt = (int*)(lds + 32768); int* s_off = s_cnt + 16; int* s_toff = s_off + 17;
    moe_tables(p, layer, lds, tid, s_cnt, s_off, s_toff);
    const int ntiles = s_toff[16];
    const bf16_t* hA = (const bf16_t*)(p.ws + OFF_HA);
    const int* ltok = (const int*)(p.ws + OFF_LTOK);
    bf16_t* H1 = (bf16_t*)(p.ws + OFF_H1);
    for (int tile = cx.vbid; tile < ntiles; tile += cx.G) {
        int e = 0;
        while (tile >= s_toff[e + 1]) ++e;
        const int lt = tile - s_toff[e], rt = lt >> 3, ct = lt & 7, cnt = s_cnt[e], off = s_off[e];
        const int p0 = min(rt * 128 + (tid >> 2), cnt - 1), p1 = min(rt * 128 + (tid >> 2) + 64, cnt - 1);
        const bf16_t* a0 = hA + (size_t)ltok[(size_t)e * NTOK + p0] * 1024 + (tid & 3) * 8;
        const bf16_t* a1 = hA + (size_t)ltok[(size_t)e * NTOK + p1] * 1024 + (tid & 3) * 8;
        const bf16_t* b0 = (const bf16_t*)(p.ws + OFF_W_UP) + ((size_t)(layer * 16 + e) * 1024 + ct * 128 + (tid >> 2)) * 1024 + (tid & 3) * 8;
        const bf16_t* b1 = b0 + (size_t)64 * 1024;
        gemm_tile(a0, a1, b0, b1, 1024, lds, cx, [=](f32x4 (&acc)[4][4], int wr, int wc, int fr, int fq) {
#pragma unroll
            for (int m = 0; m < 4; ++m) {
                const int pos = rt * 128 + wr * 64 + m * 16 + fr;
                if (pos < cnt) {
                    bf16_t* dst = H1 + (size_t)(off + pos) * 512 + ct * 64 + wc * 32 + fq * 4;
#pragma unroll
                    for (int n = 0; n < 2; ++n) {
                        float h[4];
#pragma unroll
                        for (int j = 0; j < 4; ++j) h[j] = silu_f(acc[m][n][j]) * acc[m][n + 2][j];
                        uint2 o; o.x = pack2(h[0], h[1]); o.y = pack2(h[2], h[3]);
                        *(uint2*)(dst + n * 16) = o;
                    }
                }
            }
        });
    }
}

__device__ void phase_moe_down(const Params& p, const Ctx& cx, char* lds, int layer) {
    const int tid = cx.tid;
    int* s_cnt = (int*)(lds + 32768); int* s_off = s_cnt + 16; int* s_toff = s_off + 17;
    moe_tables(p, layer, lds, tid, s_cnt, s_off, s_toff);
    const int ntiles = s_toff[16];
    const bf16_t* H1 = (const bf16_t*)(p.ws + OFF_H1);
    const float* lw = (const float*)(p.ws + OFF_LW);
    bf16_t* Y = (bf16_t*)(p.ws + OFF_Y);
    for (int tile = cx.vbid; tile < ntiles; tile += cx.G) {
        int e = 0;
        while (tile >= s_toff[e + 1]) ++e;
        const int lt = tile - s_toff[e], rt = lt >> 3, ct = lt & 7, cnt = s_cnt[e], off = s_off[e];
        const int p0 = min(rt * 128 + (tid >> 2), cnt - 1), p1 = min(rt * 128 + (tid >> 2) + 64, cnt - 1);
        const bf16_t* a0 = H1 + (size_t)(off + p0) * 512 + (tid & 3) * 8;
        const bf16_t* a1 = H1 + (size_t)(off + p1) * 512 + (tid & 3) * 8;
        const bf16_t* b0 = (const bf16_t*)(p.ws + OFF_W_DN) + ((size_t)(layer * 16 + e) * 1024 + ct * 128 + (tid >> 2)) * 512 + (tid & 3) * 8;
        const bf16_t* b1 = b0 + (size_t)64 * 512;
        gemm_tile(a0, a1, b0, b1, 512, lds, cx, [=](f32x4 (&acc)[4][4], int wr, int wc, int fr, int fq) {
#pragma unroll
            for (int m = 0; m < 4; ++m) {
                const int pos = rt * 128 + wr * 64 + m * 16 + fr;
                if (pos < cnt) {
                    const float w = lw[(size_t)e * NTOK + pos];
                    bf16_t* dst = Y + (size_t)(off + pos) * 1024 + ct * 128 + wc * 64 + fq * 4;
#pragma unroll
                    for (int n = 0; n < 4; ++n) {
                        uint2 o; o.x = pack2(w * acc[m][n][0], w * acc[m][n][1]); o.y = pack2(w * acc[m][n][2], w * acc[m][n][3]);
                        *(uint2*)(dst + n * 16) = o;
                    }
                }
            }
        });
    }
}

__device__ void phase_hgrn_inproj(const Params& p, const Ctx& cx, char* lds) {
    const bf16_t* A = (const bf16_t*)(p.ws + OFF_HA);
    const bf16_t* Bt = (const bf16_t*)(p.ws + OFF_W_HG_IN);
    char* ws = p.ws;
    const float* lb = (const float*)(p.ws + OFF_LB);
    gemm_phase_dense(A, 1024, Bt, 1024, NTOK / 128, 32, lds, cx, [=](int row0, int col0) {
        return [=](f32x4 (&acc)[4][4], int wr, int wc, int fr, int fq) {
            const int gc0 = col0 + wc * 64, seg = gc0 >> 10, c0 = gc0 & 1023;
#pragma unroll
            for (int m = 0; m < 4; ++m) {
                const int row = row0 + wr * 64 + m * 16 + fr;
#pragma unroll
                for (int n = 0; n < 4; ++n) {
                    const int c = c0 + n * 16 + fq * 4;
                    if (seg == 1) {
                        f32x4 l4 = *(const f32x4*)(lb + c), o;
#pragma unroll
                        for (int j = 0; j < 4; ++j) o[j] = __logf(l4[j] + (1.f - l4[j]) * sigmoid_f(acc[m][n][j]));
                        *(f32x4*)((float*)(ws + OFF_LF) + (size_t)row * 1024 + c) = o;
                    } else {
                        float h[4];
#pragma unroll
                        for (int j = 0; j < 4; ++j) h[j] = (seg == 2) ? acc[m][n][j] : silu_f(acc[m][n][j]);
                        uint2 o; o.x = pack2(h[0], h[1]); o.y = pack2(h[2], h[3]);
                        bf16_t* dst = (bf16_t*)(ws + (seg == 0 ? OFF_QH : seg == 2 ? OFF_V : OFF_G));
                        *(uint2*)(dst + (size_t)row * 1024 + c) = o;
                    }
                }
            }
        };
    });
}

__device__ void phase_hgrn_rec_naive(const Params& p, const Ctx& cx, char* lds) {
    const int tid = cx.tid, lane = cx.lane, wid = cx.wid;
    float* Fs = (float*)lds;
    float* Qs = Fs + 2048;
    float* Vs = Qs + 2048;
    float* Op = Vs + 2048;
    const bf16_t* QH = (const bf16_t*)(p.ws + OFF_QH);
    const float* LF = (const float*)(p.ws + OFF_LF);
    const bf16_t* V = (const bf16_t*)(p.ws + OFF_V);
    const bf16_t* Gt = (const bf16_t*)(p.ws + OFF_G);
    bf16_t* OA = (bf16_t*)(p.ws + OFF_HA);
    const int j = tid & 127, half = tid >> 7;
    for (int item = cx.vbid; item < 128; item += cx.G) {
        const int b = item >> 3, h = item & 7;
        float S[64];
#pragma unroll
        for (int i = 0; i < 64; ++i) S[i] = 0.f;
        for (int t0 = 0; t0 < SEQ; t0 += 16) {
            __syncthreads();
            for (int i = tid; i < 2048; i += 256) {
                const int tt = i >> 7, d = i & 127;
                const size_t gi = (size_t)(b * SEQ + t0 + tt) * 1024 + h * 128 + d;
                Fs[i] = __expf(LF[gi]); Qs[i] = bf2f(QH[gi]); Vs[i] = bf2f(V[gi]);
            }
            __syncthreads();
            for (int tt = 0; tt < 16; ++tt) {
                const float v = Vs[tt * 128 + j];
                float o = 0.f;
                const float* fr_ = Fs + tt * 128 + half * 64;
                const float* qr_ = Qs + tt * 128 + half * 64;
#pragma unroll
                for (int d4 = 0; d4 < 16; ++d4) {
                    f32x4 f4 = *(const f32x4*)(fr_ + d4 * 4), q4 = *(const f32x4*)(qr_ + d4 * 4);
#pragma unroll
                    for (int k = 0; k < 4; ++k) {
                        const float f = f4[k];
                        S[d4 * 4 + k] = f * S[d4 * 4 + k] + (1.f - f) * v;
                        o += q4[k] * S[d4 * 4 + k];
                    }
                }
                Op[(half * 16 + tt) * 128 + j] = o;
            }
            __syncthreads();
            for (int tt = wid; tt < 16; tt += 4) {
                const float o0 = Op[tt * 128 + lane] + Op[(16 + tt) * 128 + lane];
                const float o1 = Op[tt * 128 + 64 + lane] + Op[(16 + tt) * 128 + 64 + lane];
                const float ss = wave_sum(o0 * o0 + o1 * o1);
                const float r = rsqrtf(ss * (1.f / 128.f) + EPS);
                const size_t gi = (size_t)(b * SEQ + t0 + tt) * 1024 + h * 128;
                OA[gi + lane] = f2bf(o0 * r * p.hgrn_out_gain[lane] * bf2f(Gt[gi + lane]));
                OA[gi + 64 + lane] = f2bf(o1 * r * p.hgrn_out_gain[64 + lane] * bf2f(Gt[gi + 64 + lane]));
            }
        }
    }
}

template <int PH>
__device__ __forceinline__ void run_phase(const Params& p, const Ctx& cx, char* lds) {
    if constexpr (PH == 0) phase0(p, cx, lds);
    else if constexpr (PH == 1) rows_phase<false, true, false>(p, cx, lds, p.x, nullptr, 0, 0, 0, 0);
    else if constexpr (PH == 2) phase_nsa_inproj(p, cx, lds);
    else if constexpr (PH == 3) phase_cmp1(p, cx, lds);
    else if constexpr (PH == 4) phase_cmp2(p, cx);
    else if constexpr (PH == 5) phase_attn(p, cx, lds);
    else if constexpr (PH == 6) phase_outproj(p, cx, lds, (const bf16_t*)(p.ws + OFF_W_NSA_OUT), p.x, 0);
    else if constexpr (PH == 7) rows_phase<false, true, true>(p, cx, lds, p.out, nullptr, 0, 1, 0, 0);
    else if constexpr (PH == 8) phase_moe_up(p, cx, lds, 0);
    else if constexpr (PH == 9) phase_moe_down(p, cx, lds, 0);
    else if constexpr (PH == 10) rows_phase<true, true, false>(p, cx, lds, p.out, p.out, 1, 2, 0, 0);
    else if constexpr (PH == 11) phase_hgrn_inproj(p, cx, lds);
    else if constexpr (PH == 12) phase_hgrn_rec_naive(p, cx, lds);
    else if constexpr (PH == 13) phase_outproj(p, cx, lds, (const bf16_t*)(p.ws + OFF_W_HG_OUT), p.out, 2);
    else if constexpr (PH == 14) rows_phase<false, true, true>(p, cx, lds, p.out, nullptr, 0, 3, 1, 0);
    else if constexpr (PH == 15) phase_moe_up(p, cx, lds, 1);
    else if constexpr (PH == 16) phase_moe_down(p, cx, lds, 1);
    else if constexpr (PH == 17) rows_phase<true, false, false>(p, cx, lds, p.out, p.out, 3, 0, 0, 1);
}

__device__ __forceinline__ Ctx make_ctx() {
    Ctx cx;
    cx.G = gridDim.x; cx.tid = threadIdx.x; cx.wid = threadIdx.x >> 6; cx.lane = threadIdx.x & 63;
    cx.vbid = (cx.G % 8 == 0) ? (blockIdx.x % 8) * (cx.G / 8) + blockIdx.x / 8 : blockIdx.x;
    return cx;
}

#if MULTI_LAUNCH
template <int PH>
__global__ void __launch_bounds__(256, 2) phase_kernel(Params p) {
    __shared__ __attribute__((aligned(16))) char lds[LDS_BYTES];
    const Ctx cx = make_ctx();
    run_phase<PH>(p, cx, lds);
}
template <int PH>
static void launch_phases(const Params& p, int grid, hipStream_t stream) {
    hipLaunchKernelGGL(phase_kernel<PH>, dim3(grid), dim3(256), 0, stream, p);
    if constexpr (PH + 1 < NPHASE) launch_phases<PH + 1>(p, grid, stream);
}
#else
template <int PH>
__device__ __forceinline__ void run_from(const Params& p, const Ctx& cx, char* lds, cg::grid_group& grid) {
    run_phase<PH>(p, cx, lds);
    if constexpr (PH + 1 < NPHASE) {
        grid.sync();
        run_from<PH + 1>(p, cx, lds, grid);
    }
}
__global__ void __launch_bounds__(256, 2) mega_kernel(Params p) {
    __shared__ __attribute__((aligned(16))) char lds[LDS_BYTES];
    cg::grid_group grid = cg::this_grid();
    const Ctx cx = make_ctx();
    run_from<0>(p, cx, lds, grid);
}
#endif

extern "C" void kernel_launch(void* const* d_in, const int* in_sizes, int n_in, void* d_out, int out_size, void* d_ws, size_t ws_size,
                              hipStream_t stream) {
    static int grid = 0;
    if (!grid) {
        int dev = 0, cus = 0, per_cu = 0;
        (void)hipGetDevice(&dev);
        (void)hipDeviceGetAttribute(&cus, hipDeviceAttributeMultiprocessorCount, dev);
#if MULTI_LAUNCH
        per_cu = 2;
#else
        (void)hipOccupancyMaxActiveBlocksPerMultiprocessor(&per_cu, mega_kernel, 256, 0);
        if (per_cu > 2) per_cu = 2;
        if (per_cu < 1) per_cu = 1;
#endif
        if (cus <= 0) cus = 256;
        grid = cus * per_cu;
        if (ws_size < WS_NEED) fprintf(stderr, "kernel_launch: workspace too small: %zu < %zu\n", ws_size, (size_t)WS_NEED);
    }
    Params p{};
    p.x = (const float*)d_in[0]; p.c = (const float*)d_in[1]; p.ada_w = (const float*)d_in[2]; p.ada_b = (const float*)d_in[3];
    p.norm_g = (const float*)d_in[4]; p.rel_bias = (const float*)d_in[5]; p.nsa_w_in = (const float*)d_in[6]; p.nsa_q_gain = (const float*)d_in[7];
    p.nsa_k_gain = (const float*)d_in[8]; p.nsa_cmp_pe = (const float*)d_in[9]; p.nsa_cmp_w1 = (const float*)d_in[10]; p.nsa_cmp_w2 = (const float*)d_in[11];
    p.nsa_w_out = (const float*)d_in[12]; p.hgrn_w_in = (const float*)d_in[13]; p.hgrn_lb = (const float*)d_in[14]; p.hgrn_out_gain = (const float*)d_in[15];
    p.hgrn_w_out = (const float*)d_in[16]; p.moe_rg = (const float*)d_in[17]; p.moe_re = (const float*)d_in[18]; p.moe_w1 = (const float*)d_in[19];
    p.moe_w3 = (const float*)d_in[20]; p.moe_w2 = (const float*)d_in[21];
    p.out = (float*)d_out; p.ws = (char*)d_ws;
#if MULTI_LAUNCH
    launch_phases<0>(p, grid, stream);
#else
    p.p_begin = 0; p.p_end = NPHASE;
    void* args[] = {&p};
    hipError_t e = hipLaunchCooperativeKernel((void*)mega_kernel, dim3(grid), dim3(256), args, 0, stream);
    if (e != hipSuccess) fprintf(stderr, "cooperative launch failed: %s (grid %d)\n", hipGetErrorString(e), grid);
#endif
}
```

```cpp
#include <hip/hip_runtime.h>
#include <hip/hip_cooperative_groups.h>
#include <cstdio>
#include <cstdint>
namespace cg = cooperative_groups;

#ifndef MULTI_LAUNCH
#define MULTI_LAUNCH 0
#endif

typedef unsigned short bf16_t;
typedef short bf16x8 __attribute__((ext_vector_type(8)));
typedef float f32x4 __attribute__((ext_vector_type(4)));
typedef float f32x16 __attribute__((ext_vector_type(16)));

constexpr int NTOK = 32768, DM = 1024, SEQ = 2048, NBATCH = 16;
constexpr int NSA_IN = 2608, NSA_IN_PAD = 2688;
constexpr float EPS = 1e-6f;
constexpr size_t MiB = 1ull << 20;

constexpr size_t OFF_CNT = 0;
constexpr size_t OFF_MOD = 4096;
constexpr size_t OFF_LB = OFF_MOD + 786432;
constexpr size_t OFF_PEB = OFF_LB + 4096;
constexpr size_t OFF_W_NSA_IN = 1 * MiB;
constexpr size_t OFF_W_NSA_OUT = OFF_W_NSA_IN + 2688ull * 1024 * 2;
constexpr size_t OFF_W_HG_IN = OFF_W_NSA_OUT + 1024ull * 1024 * 2;
constexpr size_t OFF_W_HG_OUT = OFF_W_HG_IN + 4096ull * 1024 * 2;
constexpr size_t OFF_W_CMP1 = OFF_W_HG_OUT + 1024ull * 1024 * 2;
constexpr size_t OFF_W_UP = OFF_W_CMP1 + 2ull * 128 * 2048 * 2;
constexpr size_t OFF_W_DN = OFF_W_UP + 32ull * 1024 * 1024 * 2;
constexpr size_t OFF_W_END = OFF_W_DN + 32ull * 1024 * 512 * 2;
constexpr size_t OFF_HA = 116 * MiB;
static_assert(OFF_W_END <= OFF_HA, "weights overflow");
constexpr size_t OFF_SCR = 180 * MiB;
constexpr size_t OFF_Q = OFF_SCR;
constexpr size_t OFF_KCRAW = OFF_Q + 64 * MiB;
constexpr size_t OFF_VCRAW = OFF_KCRAW + 17 * MiB;
constexpr size_t OFF_KS = OFF_VCRAW + 17 * MiB;
constexpr size_t OFF_VS = OFF_KS + 16 * MiB;
constexpr size_t OFF_KW = OFF_VS + 16 * MiB;
constexpr size_t OFF_VW = OFF_KW + 16 * MiB;
constexpr size_t OFF_GATES = OFF_VW + 16 * MiB;
constexpr size_t OFF_T1 = OFF_GATES + 6 * MiB;
constexpr size_t OFF_KC = OFF_T1 + 4 * MiB;
constexpr size_t OFF_VC = OFF_KC + 1 * MiB;
constexpr size_t OFF_H1 = OFF_SCR;
constexpr size_t OFF_Y = OFF_H1 + 64 * MiB;
constexpr size_t OFF_LTOK = OFF_Y + 128 * MiB;
constexpr size_t OFF_LW = OFF_LTOK + 2 * MiB;
constexpr size_t OFF_TSLOT = OFF_LW + 2 * MiB;
constexpr size_t OFF_QH = OFF_SCR;
constexpr size_t OFF_LF = OFF_QH + 64 * MiB;
constexpr size_t OFF_V = OFF_LF + 128 * MiB;
constexpr size_t OFF_G = OFF_V + 64 * MiB;
constexpr size_t WS_NEED = OFF_G + 64 * MiB;
static_assert(WS_NEED <= 512 * MiB, "ws overflow");

constexpr int LDS_BYTES = 64512;
constexpr int NPHASE = 19;

struct Params {
    const float *x, *c, *ada_w, *ada_b, *norm_g, *rel_bias, *nsa_w_in, *nsa_q_gain, *nsa_k_gain, *nsa_cmp_pe, *nsa_cmp_w1,
        *nsa_cmp_w2, *nsa_w_out, *hgrn_w_in, *hgrn_lb, *hgrn_out_gain, *hgrn_w_out, *moe_rg, *moe_re, *moe_w1, *moe_w3, *moe_w2;
    float* out;
    char* ws;
    int p_begin, p_end;
};

__device__ __forceinline__ float bf2f(unsigned short h) { return __uint_as_float((unsigned)h << 16); }
__device__ __forceinline__ unsigned short f2bf(float f) {
    unsigned u = __float_as_uint(f);
    u += 0x7fffu + ((u >> 16) & 1u);
    return (unsigned short)(u >> 16);
}
typedef __bf16 bf2_t __attribute__((ext_vector_type(2)));
typedef float f2_t __attribute__((ext_vector_type(2)));
__device__ __forceinline__ unsigned pack2(float a, float b) {
    f2_t v = {a, b};
    return __builtin_bit_cast(unsigned, __builtin_convertvector(v, bf2_t));
}
__device__ __forceinline__ float wave_sum(float v) {
#pragma unroll
    for (int o = 32; o; o >>= 1) v += __shfl_xor(v, o);
    return v;
}
__device__ __forceinline__ float wave_max(float v) {
#pragma unroll
    for (int o = 32; o; o >>= 1) v = fmaxf(v, __shfl_xor(v, o));
    return v;
}
__device__ __forceinline__ float silu_f(float x) { return x / (1.f + __expf(-x)); }
__device__ __forceinline__ float sigmoid_f(float x) { return 1.f / (1.f + __expf(-x)); }
__device__ __forceinline__ void glds16(const void* g, void* l) {
    __builtin_amdgcn_global_load_lds((const unsigned*)g, (unsigned*)l, 16, 0, 0);
}
__device__ __forceinline__ int t5_bucket(int n) {
    if (n < 16) return n;
    int b = 16;
    b += (n >= 21); b += (n >= 27); b += (n >= 35); b += (n >= 46); b += (n >= 59); b += (n >= 77); b += (n >= 99); b += (n >= 128);
    b += (n >= 166); b += (n >= 216); b += (n >= 280); b += (n >= 363); b += (n >= 470); b += (n >= 609); b += (n >= 790);
    return b;
}

struct Ctx {
    int G, vbid, tid, wid, lane;
};

constexpr int P0_MOD_ITEMS = 192;
constexpr int TS0 = 84 * 16, TS1 = 32 * 16, TS2 = 128 * 16, TS3 = 32 * 16, TS4 = 2 * 4 * 32, TS5 = 32 * 32 * 16, TS6 = 32 * 32 * 8;
constexpr int TC0 = 0, TC1 = TC0 + TS0, TC2 = TC1 + TS1, TC3 = TC2 + TS2, TC4 = TC3 + TS3, TC5 = TC4 + TS4, TC6 = TC5 + TS5, TC_END = TC6 + TS6;
constexpr int P0_ITEMS = P0_MOD_ITEMS + TC_END + 1;

__device__ void transpose_tile(const float* __restrict__ src, int ld, int c0, int ncols_valid, int k0, bf16_t* __restrict__ dst, int dstld,
                               char* lds, int tid) {
    float* tl = (float*)lds;
    {
        const int k = tid >> 2, cc = (tid & 3) * 8;
        const float* s = src + (size_t)(k0 + k) * ld + c0 + cc;
#pragma unroll
        for (int i = 0; i < 8; ++i) {
            float v = (c0 + cc + i < ncols_valid) ? s[i] : 0.f;
            tl[k * 33 + cc + i] = v;
        }
    }
    __syncthreads();
    {
        const int n = tid >> 3, kc = (tid & 7) * 8;
        unsigned w[4];
#pragma unroll
        for (int i = 0; i < 4; ++i) w[i] = pack2(tl[(kc + 2 * i) * 33 + n], tl[(kc + 2 * i + 1) * 33 + n]);
        uint4 o; o.x = w[0]; o.y = w[1]; o.z = w[2]; o.w = w[3];
        *(uint4*)(dst + (size_t)n * dstld + kc) = o;
    }
    __syncthreads();
}

__device__ void phase0(const Params& p, const Ctx& cx, char* lds) {
    const int tid = cx.tid, wid = cx.wid, lane = cx.lane;
    for (int it = cx.vbid; it < P0_ITEMS; it += cx.G) {
        if (it < P0_MOD_ITEMS) {
            const int colbase = it * 64, ls = colbase / 3072, e0 = colbase % 3072;
            const float* W = p.ada_w + (size_t)ls * 1024 * 3072 + e0 + lane;
            float* cs = (float*)lds + wid * 1024;
            float* red = (float*)lds + 4096;
            float acc[16];
#pragma unroll
            for (int b = 0; b < 16; ++b) acc[b] = 0.f;
            for (int sub = 0; sub < 4; ++sub) {
                const int kb = wid * 256 + sub * 64;
#pragma unroll
                for (int b = 0; b < 16; ++b) cs[lane * 16 + b] = silu_f(p.c[b * 1024 + kb + lane]);
                __builtin_amdgcn_wave_barrier();
                for (int kk = 0; kk < 64; ++kk) {
                    const float w = W[(size_t)(kb + kk) * 3072];
                    const f32x4* cv = (const f32x4*)(cs + kk * 16);
#pragma unroll
                    for (int q = 0; q < 4; ++q) {
                        f32x4 c4 = cv[q];
                        acc[q * 4 + 0] += c4[0] * w; acc[q * 4 + 1] += c4[1] * w; acc[q * 4 + 2] += c4[2] * w; acc[q * 4 + 3] += c4[3] * w;
                    }
                }
                __builtin_amdgcn_wave_barrier();
            }
#pragma unroll
            for (int b = 0; b < 16; ++b) red[(wid * 16 + b) * 64 + lane] = acc[b];
            __syncthreads();
            float* mod = (float*)(p.ws + OFF_MOD);
#pragma unroll
            for (int i = 0; i < 4; ++i) {
                const int o = tid + i * 256, b = o >> 6, e = o & 63;
                float s = red[(0 * 16 + b) * 64 + e] + red[(1 * 16 + b) * 64 + e] + red[(2 * 16 + b) * 64 + e] + red[(3 * 16 + b) * 64 + e];
                mod[((size_t)ls * 16 + b) * 3072 + e0 + e] = s + p.ada_b[ls * 3072 + e0 + e];
            }
            __syncthreads();
        } else if (it < P0_MOD_ITEMS + TC_END) {
            const int tt = it - P0_MOD_ITEMS;
            if (tt < TC1) {
                const int nt = tt / 16, kt = tt % 16;
                transpose_tile(p.nsa_w_in, NSA_IN, nt * 32, NSA_IN, kt * 64, (bf16_t*)(p.ws + OFF_W_NSA_IN) + (size_t)nt * 32 * 1024 + kt * 64, 1024, lds, tid);
            } else if (tt < TC2) {
                const int u = tt - TC1, nt = u / 16, kt = u % 16;
                transpose_tile(p.nsa_w_out, 1024, nt * 32, 1024, kt * 64, (bf16_t*)(p.ws + OFF_W_NSA_OUT) + (size_t)nt * 32 * 1024 + kt * 64, 1024, lds, tid);
            } else if (tt < TC3) {
                const int u = tt - TC2, nt = u / 16, kt = u % 16;
                transpose_tile(p.hgrn_w_in, 4096, nt * 32, 4096, kt * 64, (bf16_t*)(p.ws + OFF_W_HG_IN) + (size_t)nt * 32 * 1024 + kt * 64, 1024, lds, tid);
            } else if (tt < TC4) {
                const int u = tt - TC3, nt = u / 16, kt = u % 16;
                transpose_tile(p.hgrn_w_out, 1024, nt * 32, 1024, kt * 64, (bf16_t*)(p.ws + OFF_W_HG_OUT) + (size_t)nt * 32 * 1024 + kt * 64, 1024, lds, tid);
            } else if (tt < TC5) {
                const int u = tt - TC4, kv = u / 128, r = u % 128, nt = r / 32, kt = r % 32;
                transpose_tile(p.nsa_cmp_w1 + (size_t)kv * 2048 * 64, 64, nt * 32, 64, kt * 64,
                               (bf16_t*)(p.ws + OFF_W_CMP1) + ((size_t)kv * 128 + nt * 32) * 2048 + kt * 64, 2048, lds, tid);
            } else if (tt < TC6) {
                const int u = tt - TC5, le = u / 512, r = u % 512, gr = r / 16, kt = r % 16;
                const int t = gr >> 2, wc = (gr >> 1) & 1, which = gr & 1;
                const float* src = (which ? p.moe_w3 : p.moe_w1) + (size_t)le * 1024 * 512;
                transpose_tile(src, 512, (t * 2 + wc) * 32, 512, kt * 64, (bf16_t*)(p.ws + OFF_W_UP) + ((size_t)le * 1024 + gr * 32) * 1024 + kt * 64, 1024, lds, tid);
            } else {
                const int u = tt - TC6, le = u / 256, r = u % 256, nt = r / 8, kt = r % 8;
                transpose_tile(p.moe_w2 + (size_t)le * 512 * 1024, 1024, nt * 32, 1024, kt * 64,
                               (bf16_t*)(p.ws + OFF_W_DN) + ((size_t)le * 1024 + nt * 32) * 512 + kt * 64, 512, lds, tid);
            }
        } else {
            float* lb = (float*)(p.ws + OFF_LB);
            for (int i = tid; i < 1024; i += 256) lb[i] = sigmoid_f(p.hgrn_lb[1024 + i] - p.hgrn_lb[i]);
            if (tid < 128) {
                const int kv = tid >> 6, d = tid & 63;
                const float* pe = p.nsa_cmp_pe + kv * 2048;
                const float* w1 = p.nsa_cmp_w1 + (size_t)kv * 2048 * 64 + d;
                float s = 0.f;
                for (int k = 0; k < 2048; ++k) s += pe[k] * w1[(size_t)k * 64];
                ((float*)(p.ws + OFF_PEB))[tid] = s;
            }
            if (tid < 32) ((int*)(p.ws + OFF_CNT))[tid] = 0;
        }
    }
}

template <bool COMBINE, bool NORM, bool ROUTER>
__device__ void rows_phase(const Params& p, const Ctx& cx, char* lds, const float* __restrict__ src, float* __restrict__ xdst,
                           int ls_comb, int ls_norm, int layer_router, int layer_comb) {
    const int lane = cx.lane;
    const float* mod = (const float*)(p.ws + OFF_MOD);
    int my_off = 0;
    if (COMBINE) {
        const int* cnt = (const int*)(p.ws + OFF_CNT) + layer_comb * 16;
        int cv = (lane < 16) ? cnt[lane] : 0;
        int incl = cv;
#pragma unroll
        for (int o = 1; o < 16; o <<= 1) { int t = __shfl_up(incl, o); if (lane >= o) incl += t; }
        my_off = incl - cv;
    }
    for (int row = cx.vbid * 4 + cx.wid; row < NTOK; row += cx.G * 4) {
        const int b = row >> 11;
        f32x4 v[4];
#pragma unroll
        for (int i = 0; i < 4; ++i) v[i] = *(const f32x4*)(src + (size_t)row * 1024 + (i * 64 + lane) * 4);
        if (COMBINE) {
            const int* ts = (const int*)(p.ws + OFF_TSLOT) + row * 2;
            const int s0 = ts[0], s1 = ts[1];
            const int r0 = __shfl(my_off, s0 >> 16) + (s0 & 0xffff), r1 = __shfl(my_off, s1 >> 16) + (s1 & 0xffff);
            const bf16_t* Y = (const bf16_t*)(p.ws + OFF_Y);
            const float* gate = mod + ((size_t)ls_comb * 16 + b) * 3072 + 2048;
#pragma unroll
            for (int i = 0; i < 4; ++i) {
                const int col = (i * 64 + lane) * 4;
                uint2 a = *(const uint2*)(Y + (size_t)r0 * 1024 + col), c = *(const uint2*)(Y + (size_t)r1 * 1024 + col);
                f32x4 g = *(const f32x4*)(gate + col);
                v[i][0] += g[0] * (bf2f(a.x & 0xffff) + bf2f(c.x & 0xffff));
                v[i][1] += g[1] * (bf2f(a.x >> 16) + bf2f(c.x >> 16));
                v[i][2] += g[2] * (bf2f(a.y & 0xffff) + bf2f(c.y & 0xffff));
                v[i][3] += g[3] * (bf2f(a.y >> 16) + bf2f(c.y >> 16));
                *(f32x4*)(xdst + (size_t)row * 1024 + col) = v[i];
            }
        }
        if (NORM) {
            float ss = 0.f;
#pragma unroll
            for (int i = 0; i < 4; ++i) ss += v[i][0] * v[i][0] + v[i][1] * v[i][1] + v[i][2] * v[i][2] + v[i][3] * v[i][3];
            ss = wave_sum(ss);
            const float r = rsqrtf(ss * (1.f / 1024.f) + EPS);
            const float* gain = p.norm_g + ls_norm * 1024;
            const float* shift = mod + ((size_t)ls_norm * 16 + b) * 3072;
            const float* scale = shift + 1024;
            bf16_t* hA = (bf16_t*)(p.ws + OFF_HA);
            f32x4 rg4 = {0.f, 0.f, 0.f, 0.f}, re0 = rg4, re1 = rg4, re2 = rg4, re3 = rg4;
#pragma unroll
            for (int i = 0; i < 4; ++i) {
                const int col = (i * 64 + lane) * 4;
                f32x4 g = *(const f32x4*)(gain + col), sc = *(const f32x4*)(scale + col), sh = *(const f32x4*)(shift + col);
                f32x4 h;
#pragma unroll
                for (int j = 0; j < 4; ++j) h[j] = v[i][j] * r * g[j] * (1.f + sc[j]) + sh[j];
                uint2 o; o.x = pack2(h[0], h[1]); o.y = pack2(h[2], h[3]);
                *(uint2*)(hA + (size_t)row * 1024 + col) = o;
                if (ROUTER) {
                    const float* rg = p.moe_rg + (size_t)layer_router * 1024 * 4;
                    const float* re = p.moe_re + (size_t)layer_router * 1024 * 16;
#pragma unroll
                    for (int j = 0; j < 4; ++j) {
                        rg4 += h[j] * *(const f32x4*)(rg + (col + j) * 4);
                        re0 += h[j] * *(const f32x4*)(re + (col + j) * 16 + 0);
                        re1 += h[j] * *(const f32x4*)(re + (col + j) * 16 + 4);
                        re2 += h[j] * *(const f32x4*)(re + (col + j) * 16 + 8);
                        re3 += h[j] * *(const f32x4*)(re + (col + j) * 16 + 12);
                    }
                }
            }
            if (ROUTER) {
                float rl[4];
                f32x4 rs0, rs1, rs2, rs3;
#pragma unroll
                for (int j = 0; j < 4; ++j) { rl[j] = wave_sum(rg4[j]); rs0[j] = wave_sum(re0[j]); rs1[j] = wave_sum(re1[j]); rs2[j] = wave_sum(re2[j]); rs3[j] = wave_sum(re3[j]); }
                float gm = fmaxf(fmaxf(rl[0], rl[1]), fmaxf(rl[2], rl[3]));
                float e0 = __expf(rl[0] - gm), e1 = __expf(rl[1] - gm), e2 = __expf(rl[2] - gm), e3 = __expf(rl[3] - gm);
                float gs = e0 + e1 + e2 + e3;
                int grp = 0; float best = rl[0];
                if (rl[1] > best) { best = rl[1]; grp = 1; }
                if (rl[2] > best) { best = rl[2]; grp = 2; }
                if (rl[3] > best) { best = rl[3]; grp = 3; }
                const float pg = __expf(best - gm) / gs;
                const f32x4 lsel = (grp == 0) ? rs0 : (grp == 1) ? rs1 : (grp == 2) ? rs2 : rs3;
                const float l0 = lsel[0], l1 = lsel[1], l2 = lsel[2], l3 = lsel[3];
                const float em = fmaxf(fmaxf(l0, l1), fmaxf(l2, l3));
                float q0 = __expf(l0 - em), q1 = __expf(l1 - em), q2 = __expf(l2 - em), q3 = __expf(l3 - em);
                int i1 = 0; float b1 = q0;
                if (q1 > b1) { b1 = q1; i1 = 1; }
                if (q2 > b1) { b1 = q2; i1 = 2; }
                if (q3 > b1) { b1 = q3; i1 = 3; }
                int i2 = -1; float b2 = -1.f;
                if (i1 != 0 && q0 > b2) { b2 = q0; i2 = 0; }
                if (i1 != 1 && q1 > b2) { b2 = q1; i2 = 1; }
                if (i1 != 2 && q2 > b2) { b2 = q2; i2 = 2; }
                if (i1 != 3 && q3 > b2) { b2 = q3; i2 = 3; }
                const float inv = pg / (b1 + b2);
                if (lane == 0) {
                    int* cnt = (int*)(p.ws + OFF_CNT) + layer_router * 16;
                    int* ltok = (int*)(p.ws + OFF_LTOK);
                    float* lw = (float*)(p.ws + OFF_LW);
                    int* ts = (int*)(p.ws + OFF_TSLOT) + row * 2;
                    const int ea = grp * 4 + i1, eb = grp * 4 + i2;
                    const int pa = atomicAdd(cnt + ea, 1);
                    const int pb = atomicAdd(cnt + eb, 1);
                    ltok[(size_t)ea * NTOK + pa] = row; lw[(size_t)ea * NTOK + pa] = b1 * inv;
                    ltok[(size_t)eb * NTOK + pb] = row; lw[(size_t)eb * NTOK + pb] = b2 * inv;
                    ts[0] = (ea << 16) | pa; ts[1] = (eb << 16) | pb;
                }
            }
        }
    }
}

template <class Epi>
__device__ __forceinline__ void gemm_tile(const bf16_t* a0, const bf16_t* a1, const bf16_t* b0, const bf16_t* b1, int K, char* lds, const Ctx& cx,
                                          Epi&& epi) {
    const int tid = cx.tid, lane = cx.lane, wr = cx.wid >> 1, wc = cx.wid & 1, fr = lane & 15, fq = lane >> 4;
    f32x4 acc[4][4];
#pragma unroll
    for (int m = 0; m < 4; ++m)
#pragma unroll
        for (int n = 0; n < 4; ++n) acc[m][n] = (f32x4){0.f, 0.f, 0.f, 0.f};
    const int nt = K / 32;
    {
        char* SA = lds; char* SB = lds + 8192;
        glds16(a0, SA + tid * 16); glds16(a1, SA + tid * 16 + 4096);
        glds16(b0, SB + tid * 16); glds16(b1, SB + tid * 16 + 4096);
    }
    asm volatile("s_waitcnt vmcnt(0)" ::: "memory");
    __syncthreads();
    for (int kt = 0; kt < nt; ++kt) {
        const int cur = kt & 1;
        if (kt + 1 < nt) {
            char* SA = lds + (cur ^ 1) * 16384; char* SB = SA + 8192;
            const int ko = (kt + 1) * 32;
            glds16(a0 + ko, SA + tid * 16); glds16(a1 + ko, SA + tid * 16 + 4096);
            glds16(b0 + ko, SB + tid * 16); glds16(b1 + ko, SB + tid * 16 + 4096);
        }
        const char* SA = lds + cur * 16384; const char* SB = SA + 8192;
        bf16x8 Af[4], Bf[4];
#pragma unroll
        for (int m = 0; m < 4; ++m) Af[m] = *(const bf16x8*)(SA + (wr * 64 + m * 16 + fr) * 64 + fq * 16);
#pragma unroll
        for (int n = 0; n < 4; ++n) Bf[n] = *(const bf16x8*)(SB + (wc * 64 + n * 16 + fr) * 64 + fq * 16);
#pragma unroll
        for (int m = 0; m < 4; ++m)
#pragma unroll
            for (int n = 0; n < 4; ++n) acc[m][n] = __builtin_amdgcn_mfma_f32_16x16x32_bf16(Bf[n], Af[m], acc[m][n], 0, 0, 0);
        asm volatile("s_waitcnt vmcnt(0)" ::: "memory");
        __syncthreads();
    }
    epi(acc, wr, wc, fr, fq);
}

template <class EpiFactory>
__device__ void gemm_phase_dense(const bf16_t* A, int lda, const bf16_t* Bt, int K, int nrt, int nct, char* lds, const Ctx& cx, EpiFactory&& mk) {
    const int tid = cx.tid;
    const int ntiles = nrt * nct;
    for (int tile = cx.vbid; tile < ntiles; tile += cx.G) {
        const int rt = tile / nct, ct = tile % nct;
        const bf16_t* a0 = A + (size_t)(rt * 128 + (tid >> 2)) * lda + (tid & 3) * 8;
        const bf16_t* a1 = a0 + (size_t)64 * lda;
        const bf16_t* b0 = Bt + (size_t)(ct * 128 + (tid >> 2)) * K + (tid & 3) * 8;
        const bf16_t* b1 = b0 + (size_t)64 * K;
        gemm_tile(a0, a1, b0, b1, K, lds, cx, mk(rt * 128, ct * 128));
    }
}

__device__ void phase_nsa_inproj(const Params& p, const Ctx& cx, char* lds) {
    const bf16_t* A = (const bf16_t*)(p.ws + OFF_HA);
    const bf16_t* Bt = (const bf16_t*)(p.ws + OFF_W_NSA_IN);
    char* ws = p.ws;
    const float* qg = p.nsa_q_gain;
    const float* kg = p.nsa_k_gain;
    gemm_phase_dense(A, 1024, Bt, 1024, NTOK / 128, NSA_IN_PAD / 128, lds, cx, [=](int row0, int col0) {
        return [=](f32x4 (&acc)[4][4], int wr, int wc, int fr, int fq) {
            const int gc0 = col0 + wc * 64;
            if (gc0 >= NSA_IN) return;
            if (gc0 < 1024 || (gc0 >= 1536 && gc0 < 1792) || (gc0 >= 2048 && gc0 < 2304)) {
                const float* gain; float post; bf16_t* dstb; size_t rstride; size_t coff; bool tokmajor;
                if (gc0 < 1024) { gain = qg; post = 0.125f * 1.4426950408889634f; }
                else if (gc0 < 1792) { gain = kg + 64; post = 1.f; }
                else { gain = kg + 128; post = 1.f; }
#pragma unroll
                for (int m = 0; m < 4; ++m) {
                    float ss = 0.f;
#pragma unroll
                    for (int n = 0; n < 4; ++n) ss += acc[m][n][0] * acc[m][n][0] + acc[m][n][1] * acc[m][n][1] + acc[m][n][2] * acc[m][n][2] + acc[m][n][3] * acc[m][n][3];
                    ss += __shfl_xor(ss, 16); ss += __shfl_xor(ss, 32);
                    const float r = rsqrtf(ss * (1.f / 64.f) + EPS) * post;
                    const int row = row0 + wr * 64 + m * 16 + fr;
                    bf16_t* dst;
                    if (gc0 < 1024) dst = (bf16_t*)(ws + OFF_Q) + (size_t)row * 1024 + gc0;
                    else {
                        const int g = ((gc0 - 1024) & 255) >> 6, b = row >> 11, t = row & 2047;
                        dst = (bf16_t*)(ws + (gc0 < 1792 ? OFF_KS : OFF_KW)) + ((size_t)(b * 4 + g) * 2048 + t) * 64;
                    }
#pragma unroll
                    for (int n = 0; n < 4; ++n) {
                        const int c = n * 16 + fq * 4;
                        f32x4 g4 = *(const f32x4*)(gain + c);
                        uint2 o; o.x = pack2(acc[m][n][0] * r * g4[0], acc[m][n][1] * r * g4[1]); o.y = pack2(acc[m][n][2] * r * g4[2], acc[m][n][3] * r * g4[3]);
                        *(uint2*)(dst + c) = o;
                    }
                }
            } else if (gc0 < 2560) {
                const int seg = (gc0 - 1024) >> 8;
                const int g = ((gc0 - 1024) & 255) >> 6;
                if (seg < 2) {
                    const size_t off = seg == 0 ? OFF_KCRAW : OFF_VCRAW;
#pragma unroll
                    for (int m = 0; m < 4; ++m) {
                        const int row = row0 + wr * 64 + m * 16 + fr, b = row >> 11, t = row & 2047;
                        bf16_t* dst = (bf16_t*)(ws + off) + ((size_t)(b * 4 + g) * 2048 + t) * 64;
#pragma unroll
                        for (int n = 0; n < 4; ++n) {
                            const int c = n * 16 + fq * 4;
                            uint2 o; o.x = pack2(acc[m][n][0], acc[m][n][1]); o.y = pack2(acc[m][n][2], acc[m][n][3]);
                            *(uint2*)(dst + c) = o;
                        }
                    }
                } else {
                    const size_t off = seg == 3 ? OFF_VS : OFF_VW;
#pragma unroll
                    for (int m = 0; m < 4; ++m) {
                        const int row = row0 + wr * 64 + m * 16 + fr, b = row >> 11, t = row & 2047;
                        bf16_t* dst = (bf16_t*)(ws + off) + (size_t)(b * 4 + g) * 64 * 2048 + t;
#pragma unroll
                        for (int n = 0; n < 4; ++n)
#pragma unroll
                            for (int j = 0; j < 4; ++j) dst[(size_t)(n * 16 + fq * 4 + j) * 2048] = f2bf(acc[m][n][j]);
                    }
                }
            } else {
#pragma unroll
                for (int m = 0; m < 4; ++m) {
                    const int row = row0 + wr * 64 + m * 16 + fr;
                    float* dst = (float*)(ws + OFF_GATES) + (size_t)row * 48;
#pragma unroll
                    for (int n = 0; n < 3; ++n) {
                        const int c = n * 16 + fq * 4;
                        f32x4 o;
#pragma unroll
                        for (int j = 0; j < 4; ++j) o[j] = sigmoid_f(acc[m][n][j]);
                        *(f32x4*)(dst + c) = o;
                    }
                }
            }
        };
    });
}

__device__ void phase_cmp1(const Params& p, const Ctx& cx, char* lds) {
    const int tid = cx.tid;
    const float* peb = (const float*)(p.ws + OFF_PEB);
    float* T1 = (float*)(p.ws + OFF_T1);
    for (int tile = cx.vbid; tile < 128; tile += cx.G) {
        const int kv = tile >> 6, bg = tile & 63;
        const bf16_t* raw = (const bf16_t*)(p.ws + (kv ? OFF_VCRAW : OFF_KCRAW)) + (size_t)bg * 2048 * 64;
        const bf16_t* a0 = raw + (size_t)(tid >> 2) * 1024 + (tid & 3) * 8;
        const bf16_t* a1 = a0 + (size_t)64 * 1024;
        const bf16_t* b0 = (const bf16_t*)(p.ws + OFF_W_CMP1) + ((size_t)kv * 128 + (tid >> 2)) * 2048 + (tid & 3) * 8;
        const bf16_t* b1 = b0 + (size_t)64 * 2048;
        gemm_tile(a0, a1, b0, b1, 2048, lds, cx, [=](f32x4 (&acc)[4][4], int wr, int wc, int fr, int fq) {
            if (wc != 0) return;
#pragma unroll
            for (int m = 0; m < 4; ++m) {
                const int n_ = wr * 64 + m * 16 + fr;
                float* dst = T1 + ((size_t)kv * 8192 + bg * 128 + n_) * 64;
#pragma unroll
                for (int n = 0; n < 4; ++n) {
                    const int c = n * 16 + fq * 4;
                    f32x4 pb = *(const f32x4*)(peb + kv * 64 + c);
                    *(f32x4*)(dst + c) = acc[m][n] + pb;
                }
            }
        });
    }
}

__device__ void phase_cmp2(const Params& p, const Ctx& cx) {
    const int lane = cx.lane;
    const float* T1 = (const float*)(p.ws + OFF_T1);
    for (int r = cx.vbid * 4 + cx.wid; r < 2 * 8192; r += cx.G * 4) {
        const int kv = r >> 13, rr = r & 8191, n_ = rr & 127;
        const float s = silu_f(T1[(size_t)r * 64 + lane]);
        const float* w2 = p.nsa_cmp_w2 + kv * 4096 + lane;
        float o = 0.f;
#pragma unroll 8
        for (int j = 0; j < 64; ++j) o += __shfl(s, j) * w2[j * 64];
        if (kv == 0) {
            const float ss = wave_sum(o * o);
            o = o * rsqrtf(ss * (1.f / 64.f) + EPS) * p.nsa_k_gain[lane];
        }
        if (n_ == 127) o = 0.f;
        if (kv == 0) ((bf16_t*)(p.ws + OFF_KC))[(size_t)rr * 64 + lane] = f2bf(o);
        else ((bf16_t*)(p.ws + OFF_VC))[((size_t)(rr >> 7) * 64 + lane) * 128 + n_] = f2bf(o);
    }
}

constexpr int ATT_K_OFF = 0, ATT_K_STRIDE = 144, ATT_V_OFF = 9216, ATT_V_STRIDE = 136, ATT_LUT_OFF = 17920, LUT_N = 2128, LUT_PAD = 80;
constexpr int ATT_SC_OFF = ATT_LUT_OFF + 4 * LUT_N * 4;
static_assert(ATT_SC_OFF + 4 * 3072 <= LDS_BYTES, "attention LDS");
#define MFMA32(a, b, c) __builtin_amdgcn_mfma_f32_32x32x16_bf16((a), (b), (c), 0, 0, 0)

__device__ void phase_attn(const Params& p, const Ctx& cx, char* lds) {
    const int tid = cx.tid, lane = cx.lane, wid = cx.wid;
    const int g = cx.vbid & 3;
    const int ql = lane & 7, head = (lane & 31) >> 3, h2 = lane >> 5, l31 = lane & 31;
    float* lut = (float*)(lds + ATT_LUT_OFF);
    for (int i = tid; i < 4 * LUT_N; i += 256) {
        const int h = i / LUT_N, dist = i % LUT_N - LUT_PAD;
        lut[i] = dist >= 0 ? p.rel_bias[t5_bucket(dist) * 16 + g * 4 + h] * 1.4426950408889634f : 0.f;
    }
    __syncthreads();
    const float* lutp = lut + head * LUT_N + LUT_PAD;
    const bf16_t* Qb = (const bf16_t*)(p.ws + OFF_Q);
    const bf16_t* KC = (const bf16_t*)(p.ws + OFF_KC);
    const bf16_t* VCT = (const bf16_t*)(p.ws + OFF_VC);
    const bf16_t* KS = (const bf16_t*)(p.ws + OFF_KS);
    const bf16_t* VST = (const bf16_t*)(p.ws + OFF_VS);
    const bf16_t* KW = (const bf16_t*)(p.ws + OFF_KW);
    const bf16_t* VWT = (const bf16_t*)(p.ws + OFF_VW);
    const float* GT = (const float*)(p.ws + OFF_GATES);
    bf16_t* Og = (bf16_t*)(p.ws + OFF_HA);
    float* scw = (float*)(lds + ATT_SC_OFF) + wid * 768;
    const bool flip_ok = (cx.G % 256) == 0;

    for (int it = 0;; ++it) {
        const int u = cx.vbid + it * cx.G;
        if (u >= 4096) break;
        const int rest = u >> 2, b = rest >> 6, qtb = rest & 63;
        const int qt = (flip_ok && (it & 1)) ? 63 - qtb : qtb;
        const int t0 = qt * 32, cur = qt >> 1, bg = b * 4 + g;
        const int tq = t0 + wid * 8 + ql;
        const size_t rowtok = (size_t)b * SEQ + tq;
        bf16x8 Qf[4];
        {
            const bf16_t* qp = Qb + rowtok * 1024 + (g * 4 + head) * 64 + 8 * h2;
#pragma unroll
            for (int ks = 0; ks < 4; ++ks) Qf[ks] = *(const bf16x8*)(qp + 16 * ks);
        }
        const float* gt = GT + rowtok * 48 + (g * 4 + head) * 3;
        const float gate_c = gt[0], gate_s = gt[1], gate_w = gt[2];
        const int wlo = max(0, (t0 - 511) >> 6);
        const int nW = cur - wlo + 1;
        const int NT = 4 + nW + cur + 1;

        uint4 kr0, kr1, vr0, vr1;
        auto issue_load = [&](int i) {
            const bf16_t* ksrc; const bf16_t* vsrc; int vstride;
            if (i < 4) { const int ci = i & 1; ksrc = KC + ((size_t)bg * 128 + ci * 64) * 64; vsrc = VCT + (size_t)bg * 64 * 128 + ci * 64; vstride = 128; }
            else if (i < 4 + nW) { const int kb = wlo + i - 4; ksrc = KW + ((size_t)bg * 2048 + kb * 64) * 64; vsrc = VWT + (size_t)bg * 64 * 2048 + kb * 64; vstride = 2048; }
            else { const int kb = i - 4 - nW; ksrc = KS + ((size_t)bg * 2048 + kb * 64) * 64; vsrc = VST + (size_t)bg * 64 * 2048 + kb * 64; vstride = 2048; }
            kr0 = *(const uint4*)(ksrc + tid * 8);
            kr1 = *(const uint4*)(ksrc + (tid + 256) * 8);
            vr0 = *(const uint4*)(vsrc + (size_t)(tid >> 3) * vstride + (tid & 7) * 8);
            vr1 = *(const uint4*)(vsrc + (size_t)((tid >> 3) + 32) * vstride + (tid & 7) * 8);
        };
        auto write_lds = [&]() {
            *(uint4*)(lds + ATT_K_OFF + (tid >> 3) * ATT_K_STRIDE + (tid & 7) * 16) = kr0;
            *(uint4*)(lds + ATT_K_OFF + ((tid >> 3) + 32) * ATT_K_STRIDE + (tid & 7) * 16) = kr1;
            char* va = lds + ATT_V_OFF + (tid >> 3) * ATT_V_STRIDE + (tid & 7) * 16;
            uint2 t;
            t.x = vr0.x; t.y = vr0.y; *(uint2*)va = t;
            t.x = vr0.z; t.y = vr0.w; *(uint2*)(va + 8) = t;
            t.x = vr1.x; t.y = vr1.y; *(uint2*)(va + 32 * ATT_V_STRIDE) = t;
            t.x = vr1.z; t.y = vr1.w; *(uint2*)(va + 32 * ATT_V_STRIDE + 8) = t;
        };
        f32x16 O0, O1, OUT0, OUT1;
#pragma unroll
        for (int r = 0; r < 16; ++r) { O0[r] = 0.f; O1[r] = 0.f; }
        float lsum = 0.f;

        auto qk = [&](int kt2) -> f32x16 {
            f32x16 S;
#pragma unroll
            for (int r = 0; r < 16; ++r) S[r] = 0.f;
            const char* kp = lds + ATT_K_OFF + (32 * kt2 + l31) * ATT_K_STRIDE + 16 * h2;
#pragma unroll
            for (int ks = 0; ks < 4; ++ks) S = MFMA32(*(const bf16x8*)(kp + 32 * ks), Qf[ks], S);
            return S;
        };
        auto pv = [&](int kt2, const f32x16& P) {
#pragma unroll
            for (int s2 = 0; s2 < 2; ++s2) {
                uint4 pk;
                pk.x = pack2(P[8 * s2 + 0], P[8 * s2 + 1]); pk.y = pack2(P[8 * s2 + 2], P[8 * s2 + 3]);
                pk.z = pack2(P[8 * s2 + 4], P[8 * s2 + 5]); pk.w = pack2(P[8 * s2 + 6], P[8 * s2 + 7]);
                const bf16x8 Pf = __builtin_bit_cast(bf16x8, pk);
                const char* vp = lds + ATT_V_OFF + l31 * ATT_V_STRIDE + (32 * kt2 + 16 * s2 + 4 * h2) * 2;
                {
                    uint2 lo = *(const uint2*)vp, hi = *(const uint2*)(vp + 16);
                    uint4 a; a.x = lo.x; a.y = lo.y; a.z = hi.x; a.w = hi.y;
                    O0 = MFMA32(__builtin_bit_cast(bf16x8, a), Pf, O0);
                }
                {
                    uint2 lo = *(const uint2*)(vp + 32 * ATT_V_STRIDE), hi = *(const uint2*)(vp + 32 * ATT_V_STRIDE + 16);
                    uint4 a; a.x = lo.x; a.y = lo.y; a.z = hi.x; a.w = hi.y;
                    O1 = MFMA32(__builtin_bit_cast(bf16x8, a), Pf, O1);
                }
            }
        };
        auto finalize = [&](float gate, bool first) {
            const float Z = lsum + __shfl_xor(lsum, 32);
            const float f = Z > 0.f ? gate / Z : 0.f;
#pragma unroll
            for (int r = 0; r < 16; ++r) {
                if (first) { OUT0[r] = f * O0[r]; OUT1[r] = f * O1[r]; }
                else { OUT0[r] += f * O0[r]; OUT1[r] += f * O1[r]; }
                O0[r] = 0.f; O1[r] = 0.f;
            }
            lsum = 0.f;
        };

        const int nvis = (tq >= 31) ? min((tq - 31) / 16 + 1, 127) : 0;
        float inv_c = 0.f;
        unsigned selmask = 0u;
        float* sown = scw + ql * 32;
        float* stail = scw + 256 + ql * 32;
        float* ssc = scw + 512 + ql * 32;
        issue_load(0);
        for (int i = 0; i < NT; ++i) {
            __syncthreads();
            write_lds();
            __syncthreads();
            if (i + 1 < NT) issue_load(i + 1);
            if (i < 4) {
                const int ci = i & 1;
#pragma unroll 1
                for (int kt2 = 0; kt2 < 2; ++kt2) {
                    f32x16 S = qk(kt2);
                    const int n0 = 64 * ci + 32 * kt2 + 4 * h2;
                    const int d0 = tq - 31 - 16 * n0;
#pragma unroll
                    for (int r = 0; r < 16; ++r) {
                        const int cr = (r & 3) + 8 * (r >> 2);
                        const float bias = lutp[max(d0 - 16 * cr, -LUT_PAD)];
                        S[r] = __builtin_amdgcn_exp2f(S[r] + bias + ((n0 + cr) < nvis ? 0.f : -INFINITY));
                        lsum += S[r];
                    }
                    if (i >= 2) {
                        pv(kt2, S);
#pragma unroll
                        for (int rq = 0; rq < 4; ++rq) {
                            float gsum = (S[4 * rq] + S[4 * rq + 1] + S[4 * rq + 2] + 0.5f * S[4 * rq + 3]) * inv_c;
                            float tl = 0.5f * S[4 * rq + 3] * inv_c;
                            gsum += __shfl_xor(gsum, 8); gsum += __shfl_xor(gsum, 16);
                            tl += __shfl_xor(tl, 8); tl += __shfl_xor(tl, 16);
                            const int sblk = 8 * (2 * ci + kt2) + 2 * rq + h2;
                            if (head == 0) {
                                sown[sblk] = gsum;
                                if (sblk < 31) stail[sblk + 1] = tl;
                            }
                        }
                    }
                }
                if (i == 1) {
                    const float Z = lsum + __shfl_xor(lsum, 32);
                    inv_c = Z > 0.f ? 1.f / Z : 0.f;
                    lsum = 0.f;
                }
                if (i == 3) {
                    if (head == 0 && h2 == 0) stail[0] = 0.f;
                    __builtin_amdgcn_wave_barrier();
                    const int j8 = head * 2 + h2;
                    {
                        const f32x4 a = *(const f32x4*)(sown + 4 * j8), t4 = *(const f32x4*)(stail + 4 * j8);
                        f32x4 sc;
#pragma unroll
                        for (int q = 0; q < 4; ++q) {
                            const int sblk = 4 * j8 + q;
                            const bool forced = (sblk == 0) || (sblk == cur) || (sblk == cur - 1);
                            sc[q] = forced ? 1.0e4f : (sblk <= cur ? a[q] + t4[q] : -1.0f);
                        }
                        *(f32x4*)(ssc + 4 * j8) = sc;
                    }
                    __builtin_amdgcn_wave_barrier();
                    const f32x4 own = *(const f32x4*)(ssc + 4 * j8);
                    int rk0 = 0, rk1 = 0, rk2 = 0, rk3 = 0;
                    const int so0 = 4 * j8;
#pragma unroll
                    for (int m4 = 0; m4 < 8; ++m4) {
                        const f32x4 v = *(const f32x4*)(ssc + 4 * m4);
#pragma unroll
                        for (int q = 0; q < 4; ++q) {
                            const int sm = 4 * m4 + q;
                            const float vm = v[q];
                            rk0 += (vm > own[0] || (vm == own[0] && sm < so0)) ? 1 : 0;
                            rk1 += (vm > own[1] || (vm == own[1] && sm < so0 + 1)) ? 1 : 0;
                            rk2 += (vm > own[2] || (vm == own[2] && sm < so0 + 2)) ? 1 : 0;
                            rk3 += (vm > own[3] || (vm == own[3] && sm < so0 + 3)) ? 1 : 0;
                        }
                    }
                    unsigned mk = ((rk0 < 8 ? 1u : 0u) | (rk1 < 8 ? 2u : 0u) | (rk2 < 8 ? 4u : 0u) | (rk3 < 8 ? 8u : 0u)) << so0;
                    mk |= __shfl_xor(mk, 8); mk |= __shfl_xor(mk, 16); mk |= __shfl_xor(mk, 32);
                    selmask = mk;
                    __builtin_amdgcn_wave_barrier();
                    finalize(gate_c, true);
                }
            } else {
                const bool isw = i < 4 + nW;
                const int kb = isw ? wlo + i - 4 : i - 4 - nW;
                const bool sel = isw ? true : ((selmask >> kb) & 1u) != 0;
                if (__ballot(sel) != 0ull) {
                    const int dhi = isw ? 512 : 0x7fffffff;
#pragma unroll 1
                    for (int kt2 = 0; kt2 < 2; ++kt2) {
                        f32x16 S = qk(kt2);
                        const int d0 = tq - (64 * kb + 32 * kt2 + 4 * h2);
                        const float* lp = lutp + (d0 - 27);
#pragma unroll
                        for (int r = 0; r < 16; ++r) {
                            const int cr = (r & 3) + 8 * (r >> 2);
                            const int dist = d0 - cr;
                            const float bias = lp[27 - cr];
                            const bool valid = sel && dist >= 0 && dist < dhi;
                            S[r] = __builtin_amdgcn_exp2f(S[r] + bias + (valid ? 0.f : -INFINITY));
                            lsum += S[r];
                        }
                        pv(kt2, S);
                    }
                }
                if (i == 3 + nW) finalize(gate_w, false);
            }
        }
        finalize(gate_s, false);
        {
            bf16_t* op = Og + rowtok * 1024 + (g * 4 + head) * 64 + 4 * h2;
#pragma unroll
            for (int rq = 0; rq < 4; ++rq) {
                uint2 o0; o0.x = pack2(OUT0[4 * rq], OUT0[4 * rq + 1]); o0.y = pack2(OUT0[4 * rq + 2], OUT0[4 * rq + 3]);
                uint2 o1; o1.x = pack2(OUT1[4 * rq], OUT1[4 * rq + 1]); o1.y = pack2(OUT1[4 * rq + 2], OUT1[4 * rq + 3]);
                *(uint2*)(op + 8 * rq) = o0;
                *(uint2*)(op + 32 + 8 * rq) = o1;
            }
        }
    }
}

__device__ void phase_outproj(const Params& p, const Ctx& cx, char* lds, const bf16_t* A, const bf16_t* Bt, const float* xin, int ls) {
    const float* mod = (const float*)(p.ws + OFF_MOD);
    float* xo = p.out;
    gemm_phase_dense(A, 1024, Bt, 1024, NTOK / 128, 8, lds, cx, [=](int row0, int col0) {
        return [=](f32x4 (&acc)[4][4], int wr, int wc, int fr, int fq) {
#pragma unroll
            for (int m = 0; m < 4; ++m) {
                const int row = row0 + wr * 64 + m * 16 + fr, b = row >> 11;
                const float* gate = mod + ((size_t)ls * 16 + b) * 3072 + 2048;
#pragma unroll
                for (int n = 0; n < 4; ++n) {
                    const int col = col0 + wc * 64 + n * 16 + fq * 4;
                    f32x4 g = *(const f32x4*)(gate + col);
                    f32x4 xi = *(const f32x4*)(xin + (size_t)row * 1024 + col);
                    f32x4 o;
#pragma unroll
                    for (int j = 0; j < 4; ++j) o[j] = xi[j] + g[j] * acc[m][n][j];
                    *(f32x4*)(xo + (size_t)row * 1024 + col) = o;
                }
            }
        };
    });
}

__device__ __forceinline__ void moe_tables(const Params& p, int layer, char* lds, int tid, int* s_cnt, int* s_off, int* s_toff) {
    if (tid == 0) {
        const int* cnt = (const int*)(p.ws + OFF_CNT) + layer * 16;
        int o = 0, to = 0;
        for (int e = 0; e < 16; ++e) { const int c = cnt[e]; s_cnt[e] = c; s_off[e] = o; s_toff[e] = to; o += c; to += ((c + 127) >> 7) * 8; }
        s_off[16] = o; s_toff[16] = to;
    }
    __syncthreads();
}

__device__ void phase_moe_up(const Params& p, const Ctx& cx, char* lds, int layer) {
    const int tid = cx.tid;
    int* s_cnt = (int*)(lds + 32768); int* s_off = s_cnt + 16; int* s_toff = s_off + 17;
    moe_tables(p, layer, lds, tid, s_cnt, s_off, s_toff);
    const int ntiles = s_toff[16];
    const bf16_t* hA = (const bf16_t*)(p.ws + OFF_HA);
    const int* ltok = (const int*)(p.ws + OFF_LTOK);
    bf16_t* H1 = (bf16_t*)(p.ws + OFF_H1);
    for (int tile = cx.vbid; tile < ntiles; tile += cx.G) {
        int e = 0;
        while (tile >= s_toff[e + 1]) ++e;
        const int lt = tile - s_toff[e], rt = lt >> 3, ct = lt & 7, cnt = s_cnt[e], off = s_off[e];
        const int p0 = min(rt * 128 + (tid >> 2), cnt - 1), p1 = min(rt * 128 + (tid >> 2) + 64, cnt - 1);
        const bf16_t* a0 = hA + (size_t)ltok[(size_t)e * NTOK + p0] * 1024 + (tid & 3) * 8;
        const bf16_t* a1 = hA + (size_t)ltok[(size_t)e * NTOK + p1] * 1024 + (tid & 3) * 8;
        const bf16_t* b0 = (const bf16_t*)(p.ws + OFF_W_UP) + ((size_t)(layer * 16 + e) * 1024 + ct * 128 + (tid >> 2)) * 1024 + (tid & 3) * 8;
        const bf16_t* b1 = b0 + (size_t)64 * 1024;
        gemm_tile(a0, a1, b0, b1, 1024, lds, cx, [=](f32x4 (&acc)[4][4], int wr, int wc, int fr, int fq) {
#pragma unroll
            for (int m = 0; m < 4; ++m) {
                const int pos = rt * 128 + wr * 64 + m * 16 + fr;
                if (pos < cnt) {
                    bf16_t* dst = H1 + (size_t)(off + pos) * 512 + ct * 64 + wc * 32 + fq * 4;
#pragma unroll
                    for (int n = 0; n < 2; ++n) {
                        float h[4];
#pragma unroll
                        for (int j = 0; j < 4; ++j) h[j] = silu_f(acc[m][n][j]) * acc[m][n + 2][j];
                        uint2 o; o.x = pack2(h[0], h[1]); o.y = pack2(h[2], h[3]);
                        *(uint2*)(dst + n * 16) = o;
                    }
                }
            }
        });
    }
}

__device__ void phase_moe_down(const Params& p, const Ctx& cx, char* lds, int layer) {
    const int tid = cx.tid;
    int* s_cnt = (int*)(lds + 32768); int* s_off = s_cnt + 16; int* s_toff = s_off + 17;
    moe_tables(p, layer, lds, tid, s_cnt, s_off, s_toff);
    const int ntiles = s_toff[16];
    const bf16_t* H1 = (const bf16_t*)(p.ws + OFF_H1);
    const float* lw = (const float*)(p.ws + OFF_LW);
    bf16_t* Y = (bf16_t*)(p.ws + OFF_Y);
    for (int tile = cx.vbid; tile < ntiles; tile += cx.G) {
        int e = 0;
        while (tile >= s_toff[e + 1]) ++e;
        const int lt = tile - s_toff[e], rt = lt >> 3, ct = lt & 7, cnt = s_cnt[e], off = s_off[e];
        const int p0 = min(rt * 128 + (tid >> 2), cnt - 1), p1 = min(rt * 128 + (tid >> 2) + 64, cnt - 1);
        const bf16_t* a0 = H1 + (size_t)(off + p0) * 512 + (tid & 3) * 8;
        const bf16_t* a1 = H1 + (size_t)(off + p1) * 512 + (tid & 3) * 8;
        const bf16_t* b0 = (const bf16_t*)(p.ws + OFF_W_DN) + ((size_t)(layer * 16 + e) * 1024 + ct * 128 + (tid >> 2)) * 512 + (tid & 3) * 8;
        const bf16_t* b1 = b0 + (size_t)64 * 512;
        gemm_tile(a0, a1, b0, b1, 512, lds, cx, [=](f32x4 (&acc)[4][4], int wr, int wc, int fr, int fq) {
#pragma unroll
            for (int m = 0; m < 4; ++m) {
                const int pos = rt * 128 + wr * 64 + m * 16 + fr;
                if (pos < cnt) {
                    const float w = lw[(size_t)e * NTOK + pos];
                    bf16_t* dst = Y + (size_t)(off + pos) * 1024 + ct * 128 + wc * 64 + fq * 4;
#pragma unroll
                    for (int n = 0; n < 4; ++n) {
                        uint2 o; o.x = pack2(w * acc[m][n][0], w * acc[m][n][1]); o.y = pack2(w * acc[m][n][2], w * acc[m][n][3]);
                        *(uint2*)(dst + n * 16) = o;
                    }
                }
            }
        });
    }
}

__device__ void phase_hgrn_inproj(const Params& p, const Ctx& cx, char* lds) {
    const bf16_t* A = (const bf16_t*)(p.ws + OFF_HA);
    const bf16_t* Bt = (const bf16_t*)(p.ws + OFF_W_HG_IN);
    char* ws = p.ws;
    const float* lb = (const float*)(p.ws + OFF_LB);
    gemm_phase_dense(A, 1024, Bt, 1024, NTOK / 128, 32, lds, cx, [=](int row0, int col0) {
        return [=](f32x4 (&acc)[4][4], int wr, int wc, int fr, int fq) {
            const int gc0 = col0 + wc * 64, seg = gc0 >> 10, c0 = gc0 & 1023;
#pragma unroll
            for (int m = 0; m < 4; ++m) {
                const int row = row0 + wr * 64 + m * 16 + fr;
#pragma unroll
                for (int n = 0; n < 4; ++n) {
                    const int c = c0 + n * 16 + fq * 4;
                    if (seg == 1) {
                        f32x4 l4 = *(const f32x4*)(lb + c), o;
#pragma unroll
                        for (int j = 0; j < 4; ++j) o[j] = __logf(l4[j] + (1.f - l4[j]) * sigmoid_f(acc[m][n][j]));
                        *(f32x4*)((float*)(ws + OFF_LF) + (size_t)row * 1024 + c) = o;
                    } else {
                        float h[4];
#pragma unroll
                        for (int j = 0; j < 4; ++j) h[j] = (seg == 2) ? acc[m][n][j] : silu_f(acc[m][n][j]);
                        uint2 o; o.x = pack2(h[0], h[1]); o.y = pack2(h[2], h[3]);
                        bf16_t* dst = (bf16_t*)(ws + (seg == 0 ? OFF_QH : seg == 2 ? OFF_V : OFF_G));
                        *(uint2*)(dst + (size_t)row * 1024 + c) = o;
                    }
                }
            }
        };
    });
}

constexpr int HG_QD_OFF = 0, HG_KD_OFF = 8704, HG_K2T_OFF = 17408, HG_VT_OFF = 27648, HG_O_OFF = 37888, HG_DEC_OFF = 54784, HG_TOT_OFF = 55296;
constexpr int HG_ROW = 272, HG_TROW = 80, HG_OROW = 528;
static_assert(HG_TOT_OFF + 1024 <= LDS_BYTES, "hgrn LDS");

__device__ void phase_hgrn_rec(const Params& p, const Ctx& cx, char* lds) {
    const int tid = cx.tid, lane = cx.lane, wid = cx.wid;
    const int l31 = lane & 31, h2 = lane >> 5;
    const int widu = __builtin_amdgcn_readfirstlane(cx.wid);
    const int d0 = 2 * lane;
    const bf16_t* QH = (const bf16_t*)(p.ws + OFF_QH);
    const float* LF = (const float*)(p.ws + OFF_LF);
    const bf16_t* V = (const bf16_t*)(p.ws + OFF_V);
    bf16_t* OR = (bf16_t*)(p.ws + OFF_HA);
    float* dec = (float*)(lds + HG_DEC_OFF);
    float* tot = (float*)(lds + HG_TOT_OFF);
    for (int item = cx.vbid; item < 128; item += cx.G) {
        const int b = item >> 3, h = item & 7;
        f32x16 S0, S1, S2, S3;
#pragma unroll
        for (int r = 0; r < 16; ++r) { S0[r] = 0.f; S1[r] = 0.f; S2[r] = 0.f; S3[r] = 0.f; }
        f2_t lf[8]; unsigned qv[8], vv[8];
        const size_t gbase = (size_t)(b * SEQ + widu * 8) * 1024 + h * 128;
#pragma unroll
        for (int i = 0; i < 8; ++i) {
            lf[i] = *(const f2_t*)(LF + gbase + (size_t)i * 1024 + d0);
            qv[i] = *(const unsigned*)(QH + gbase + (size_t)i * 1024 + d0);
            vv[i] = *(const unsigned*)(V + gbase + (size_t)i * 1024 + d0);
        }
        for (int c = 0; c < SEQ / 32; ++c) {
            f2_t run = {0.f, 0.f};
#pragma unroll
            for (int i = 0; i < 8; ++i) run += lf[i];
            *(f2_t*)(tot + wid * 128 + d0) = run;
            __syncthreads();
            f2_t pre = {0.f, 0.f}, last = {0.f, 0.f};
#pragma unroll
            for (int q = 0; q < 4; ++q) {
                const f2_t tq_ = *(const f2_t*)(tot + q * 128 + d0);
                last += tq_;
                if (q < widu) pre += tq_;
            }
            if (widu == 0) { f2_t dv; dv.x = __expf(last.x); dv.y = __expf(last.y); *(f2_t*)(dec + d0) = dv; }
            {
                float k2a[8], k2b[8];
                f2_t rc = pre;
#pragma unroll
                for (int i = 0; i < 8; ++i) {
                    rc += lf[i];
                    const float cu0 = rc.x, cu1 = rc.y;
                    const float kk0 = 1.f - __expf(lf[i].x), kk1 = 1.f - __expf(lf[i].y);
                    const float q0 = bf2f((unsigned short)(qv[i] & 0xffff)) * __expf(cu0), q1 = bf2f((unsigned short)(qv[i] >> 16)) * __expf(cu1);
                    const float kd0 = kk0 * __expf(-cu0), kd1 = kk1 * __expf(-cu1);
                    k2a[i] = kk0 * __expf(last.x - cu0); k2b[i] = kk1 * __expf(last.y - cu1);
                    const int tl = wid * 8 + i;
                    *(unsigned*)(lds + HG_QD_OFF + tl * HG_ROW + d0 * 2) = pack2(q0, q1);
                    *(unsigned*)(lds + HG_KD_OFF + tl * HG_ROW + d0 * 2) = pack2(kd0, kd1);
                }
                uint4 a, bq, va, vb;
                a.x = pack2(k2a[0], k2a[1]); a.y = pack2(k2a[2], k2a[3]); a.z = pack2(k2a[4], k2a[5]); a.w = pack2(k2a[6], k2a[7]);
                bq.x = pack2(k2b[0], k2b[1]); bq.y = pack2(k2b[2], k2b[3]); bq.z = pack2(k2b[4], k2b[5]); bq.w = pack2(k2b[6], k2b[7]);
                va.x = (vv[0] & 0xffffu) | (vv[1] << 16); va.y = (vv[2] & 0xffffu) | (vv[3] << 16); va.z = (vv[4] & 0xffffu) | (vv[5] << 16); va.w = (vv[6] & 0xffffu) | (vv[7] << 16);
                vb.x = (vv[0] >> 16) | (vv[1] & 0xffff0000u); vb.y = (vv[2] >> 16) | (vv[3] & 0xffff0000u); vb.z = (vv[4] >> 16) | (vv[5] & 0xffff0000u); vb.w = (vv[6] >> 16) | (vv[7] & 0xffff0000u);
                *(uint4*)(lds + HG_K2T_OFF + d0 * HG_TROW + wid * 16) = a;
                *(uint4*)(lds + HG_K2T_OFF + (d0 + 1) * HG_TROW + wid * 16) = bq;
                *(uint4*)(lds + HG_VT_OFF + d0 * HG_TROW + wid * 16) = va;
                *(uint4*)(lds + HG_VT_OFF + (d0 + 1) * HG_TROW + wid * 16) = vb;
            }
            __builtin_amdgcn_sched_barrier(0);
            if (c + 1 < SEQ / 32) {
                const size_t gn = gbase + (size_t)(c + 1) * 32 * 1024;
#pragma unroll
                for (int i = 0; i < 8; ++i) {
                    lf[i] = *(const f2_t*)(LF + gn + (size_t)i * 1024 + d0);
                    qv[i] = *(const unsigned*)(QH + gn + (size_t)i * 1024 + d0);
                    vv[i] = *(const unsigned*)(V + gn + (size_t)i * 1024 + d0);
                }
            }
            __syncthreads();
            f32x16 X;
#pragma unroll
            for (int r = 0; r < 16; ++r) X[r] = 0.f;
            {
                const char* ka = lds + HG_KD_OFF + l31 * HG_ROW + 16 * h2;
                const char* qa = lds + HG_QD_OFF + l31 * HG_ROW + 16 * h2;
#pragma unroll 2
                for (int ks = 0; ks < 8; ++ks) X = MFMA32(*(const bf16x8*)(ka + 32 * ks), *(const bf16x8*)(qa + 32 * ks), X);
#pragma unroll
                for (int r = 0; r < 16; ++r) { const int srow = (r & 3) + 8 * (r >> 2) + 4 * h2; X[r] = (srow <= l31) ? X[r] : 0.f; }
            }
            f32x16 Oa;
#pragma unroll
            for (int r = 0; r < 16; ++r) Oa[r] = 0.f;
            const int jrow = 32 * wid + l31;
#pragma unroll
            for (int s2 = 0; s2 < 2; ++s2) {
                uint4 xk;
                xk.x = pack2(X[8 * s2], X[8 * s2 + 1]); xk.y = pack2(X[8 * s2 + 2], X[8 * s2 + 3]); xk.z = pack2(X[8 * s2 + 4], X[8 * s2 + 5]); xk.w = pack2(X[8 * s2 + 6], X[8 * s2 + 7]);
                const char* va = lds + HG_VT_OFF + jrow * HG_TROW + (16 * s2 + 4 * h2) * 2;
                const uint2 lo = *(const uint2*)va, hi = *(const uint2*)(va + 16);
                uint4 vb; vb.x = lo.x; vb.y = lo.y; vb.z = hi.x; vb.w = hi.y;
                Oa = MFMA32(__builtin_bit_cast(bf16x8, xk), __builtin_bit_cast(bf16x8, vb), Oa);
            }
            auto qs_term = [&](const f32x16& St, int dt) {
#pragma unroll
                for (int s2 = 0; s2 < 2; ++s2) {
                    uint4 sk;
                    sk.x = pack2(St[8 * s2], St[8 * s2 + 1]); sk.y = pack2(St[8 * s2 + 2], St[8 * s2 + 3]); sk.z = pack2(St[8 * s2 + 4], St[8 * s2 + 5]); sk.w = pack2(St[8 * s2 + 6], St[8 * s2 + 7]);
                    const char* qa = lds + HG_QD_OFF + l31 * HG_ROW + (32 * dt + 16 * s2 + 4 * h2) * 2;
                    const uint2 lo = *(const uint2*)qa, hi = *(const uint2*)(qa + 16);
                    uint4 qb; qb.x = lo.x; qb.y = lo.y; qb.z = hi.x; qb.w = hi.y;
                    Oa = MFMA32(__builtin_bit_cast(bf16x8, qb), __builtin_bit_cast(bf16x8, sk), Oa);
                }
            };
            __builtin_amdgcn_sched_barrier(0);
            qs_term(S0, 0); qs_term(S1, 1);
            __builtin_amdgcn_sched_barrier(0);
            qs_term(S2, 2); qs_term(S3, 3);
            __builtin_amdgcn_sched_barrier(0);
            {
                bf16_t* orow = OR + (size_t)(b * SEQ + c * 32 + 4 * h2) * 1024 + h * 128 + jrow;
#pragma unroll
                for (int r = 0; r < 16; ++r) orow[(size_t)((r & 3) + 8 * (r >> 2)) * 1024] = f2bf(Oa[r]);
            }
            auto s_update = [&](f32x16& St, int dt) {
#pragma unroll
                for (int rq = 0; rq < 4; ++rq) {
                    const f32x4 dc = *(const f32x4*)(dec + 32 * dt + 8 * rq + 4 * h2);
                    St[4 * rq] *= dc[0]; St[4 * rq + 1] *= dc[1]; St[4 * rq + 2] *= dc[2]; St[4 * rq + 3] *= dc[3];
                }
#pragma unroll
                for (int s2 = 0; s2 < 2; ++s2) {
                    const bf16x8 ka = *(const bf16x8*)(lds + HG_K2T_OFF + (32 * dt + l31) * HG_TROW + (16 * s2 + 8 * h2) * 2);
                    const bf16x8 vb = *(const bf16x8*)(lds + HG_VT_OFF + jrow * HG_TROW + (16 * s2 + 8 * h2) * 2);
                    St = MFMA32(ka, vb, St);
                }
            };
            __builtin_amdgcn_sched_barrier(0);
            s_update(S0, 0); s_update(S1, 1);
            __builtin_amdgcn_sched_barrier(0);
            s_update(S2, 2); s_update(S3, 3);
            __builtin_amdgcn_sched_barrier(0);
        }
        __syncthreads();
    }
}

__device__ void phase_hgrn_post(const Params& p, const Ctx& cx) {
    const int lane = cx.lane;
    const bf16_t* OR = (const bf16_t*)(p.ws + OFF_HA);
    const bf16_t* Gt = (const bf16_t*)(p.ws + OFF_G);
    bf16_t* OA = (bf16_t*)(p.ws + OFF_QH);
    const int col = lane * 16;
    float gn[16];
#pragma unroll
    for (int i = 0; i < 16; ++i) gn[i] = p.hgrn_out_gain[(col & 127) + i];
    for (int row = cx.vbid * 4 + cx.wid; row < NTOK; row += cx.G * 4) {
        const uint4 a0 = *(const uint4*)(OR + (size_t)row * 1024 + col), a1 = *(const uint4*)(OR + (size_t)row * 1024 + col + 8);
        const uint4 g0 = *(const uint4*)(Gt + (size_t)row * 1024 + col), g1 = *(const uint4*)(Gt + (size_t)row * 1024 + col + 8);
        const unsigned aw[8] = {a0.x, a0.y, a0.z, a0.w, a1.x, a1.y, a1.z, a1.w};
        const unsigned gw[8] = {g0.x, g0.y, g0.z, g0.w, g1.x, g1.y, g1.z, g1.w};
        float o[16];
        float ss = 0.f;
#pragma unroll
        for (int i = 0; i < 8; ++i) { o[2 * i] = bf2f((unsigned short)(aw[i] & 0xffff)); o[2 * i + 1] = bf2f((unsigned short)(aw[i] >> 16)); ss += o[2 * i] * o[2 * i] + o[2 * i + 1] * o[2 * i + 1]; }
        ss += __shfl_xor(ss, 1); ss += __shfl_xor(ss, 2); ss += __shfl_xor(ss, 4);
        const float r = rsqrtf(ss * (1.f / 128.f) + EPS);
        unsigned w[8];
#pragma unroll
        for (int i = 0; i < 8; ++i)
            w[i] = pack2(o[2 * i] * r * gn[2 * i] * bf2f((unsigned short)(gw[i] & 0xffff)), o[2 * i + 1] * r * gn[2 * i + 1] * bf2f((unsigned short)(gw[i] >> 16)));
        uint4 o0, o1; o0.x = w[0]; o0.y = w[1]; o0.z = w[2]; o0.w = w[3]; o1.x = w[4]; o1.y = w[5]; o1.z = w[6]; o1.w = w[7];
        *(uint4*)(OA + (size_t)row * 1024 + col) = o0;
        *(uint4*)(OA + (size_t)row * 1024 + col + 8) = o1;
    }
}

template <int PH>
__device__ __forceinline__ void run_phase(const Params& p, const Ctx& cx, char* lds) {
    if constexpr (PH == 0) phase0(p, cx, lds);
    else if constexpr (PH == 1) rows_phase<false, true, false>(p, cx, lds, p.x, nullptr, 0, 0, 0, 0);
    else if constexpr (PH == 2) phase_nsa_inproj(p, cx, lds);
    else if constexpr (PH == 3) phase_cmp1(p, cx, lds);
    else if constexpr (PH == 4) phase_cmp2(p, cx);
    else if constexpr (PH == 5) phase_attn(p, cx, lds);
    else if constexpr (PH == 6) phase_outproj(p, cx, lds, (const bf16_t*)(p.ws + OFF_HA), (const bf16_t*)(p.ws + OFF_W_NSA_OUT), p.x, 0);
    else if constexpr (PH == 7) rows_phase<false, true, true>(p, cx, lds, p.out, nullptr, 0, 1, 0, 0);
    else if constexpr (PH == 8) phase_moe_up(p, cx, lds, 0);
    else if constexpr (PH == 9) phase_moe_down(p, cx, lds, 0);
    else if constexpr (PH == 10) rows_phase<true, true, false>(p, cx, lds, p.out, p.out, 1, 2, 0, 0);
    else if constexpr (PH == 11) phase_hgrn_inproj(p, cx, lds);
    else if constexpr (PH == 12) phase_hgrn_rec(p, cx, lds);
    else if constexpr (PH == 13) phase_hgrn_post(p, cx);
    else if constexpr (PH == 14) phase_outproj(p, cx, lds, (const bf16_t*)(p.ws + OFF_QH), (const bf16_t*)(p.ws + OFF_W_HG_OUT), p.out, 2);
    else if constexpr (PH == 15) rows_phase<false, true, true>(p, cx, lds, p.out, nullptr, 0, 3, 1, 0);
    else if constexpr (PH == 16) phase_moe_up(p, cx, lds, 1);
    else if constexpr (PH == 17) phase_moe_down(p, cx, lds, 1);
    else if constexpr (PH == 18) rows_phase<true, false, false>(p, cx, lds, p.out, p.out, 3, 0, 0, 1);
}

__device__ __forceinline__ Ctx make_ctx() {
    Ctx cx;
    cx.G = gridDim.x; cx.tid = threadIdx.x; cx.wid = threadIdx.x >> 6; cx.lane = threadIdx.x & 63;
    cx.vbid = (cx.G % 8 == 0) ? (blockIdx.x % 8) * (cx.G / 8) + blockIdx.x / 8 : blockIdx.x;
    return cx;
}

#if MULTI_LAUNCH
template <int PH>
__global__ void __launch_bounds__(256, 2) phase_kernel(Params p) {
    __shared__ __attribute__((aligned(16))) char lds[LDS_BYTES];
    const Ctx cx = make_ctx();
    run_phase<PH>(p, cx, lds);
}
template <int PH>
static void launch_phases(const Params& p, int grid, hipStream_t stream) {
    hipLaunchKernelGGL(phase_kernel<PH>, dim3(grid), dim3(256), 0, stream, p);
    if constexpr (PH + 1 < NPHASE) launch_phases<PH + 1>(p, grid, stream);
}
#else
template <int PH>
__device__ __forceinline__ void run_from(const Params& p, const Ctx& cx, char* lds, cg::grid_group& grid) {
    run_phase<PH>(p, cx, lds);
#ifdef PROBE_MASK
    if constexpr ((PROBE_MASK >> PH) & 1) { grid.sync(); run_phase<PH>(p, cx, lds); }
#endif
    if constexpr (PH + 1 < NPHASE) {
        grid.sync();
        run_from<PH + 1>(p, cx, lds, grid);
    }
}
__global__ void __launch_bounds__(256, 2) mega_kernel(Params p) {
    __shared__ __attribute__((aligned(16))) char lds[LDS_BYTES];
    cg::grid_group grid = cg::this_grid();
    const Ctx cx = make_ctx();
    run_from<0>(p, cx, lds, grid);
}
#endif

extern "C" void kernel_launch(void* const* d_in, const int* in_sizes, int n_in, void* d_out, int out_size, void* d_ws, size_t ws_size,
                              hipStream_t stream) {
    static int grid = 0;
    if (!grid) {
        int dev = 0, cus = 0, per_cu = 0;
        (void)hipGetDevice(&dev);
        (void)hipDeviceGetAttribute(&cus, hipDeviceAttributeMultiprocessorCount, dev);
#if MULTI_LAUNCH
        per_cu = 2;
#else
        (void)hipOccupancyMaxActiveBlocksPerMultiprocessor(&per_cu, mega_kernel, 256, 0);
        if (per_cu > 2) per_cu = 2;
        if (per_cu < 1) per_cu = 1;
#endif
        if (cus <= 0) cus = 256;
        grid = cus * per_cu;
        if (ws_size < WS_NEED) fprintf(stderr, "kernel_launch: workspace too small: %zu < %zu\n", ws_size, (size_t)WS_NEED);
    }
    Params p{};
    p.x = (const float*)d_in[0]; p.c = (const float*)d_in[1]; p.ada_w = (const float*)d_in[2]; p.ada_b = (const float*)d_in[3];
    p.norm_g = (const float*)d_in[4]; p.rel_bias = (const float*)d_in[5]; p.nsa_w_in = (const float*)d_in[6]; p.nsa_q_gain = (const float*)d_in[7];
    p.nsa_k_gain = (const float*)d_in[8]; p.nsa_cmp_pe = (const float*)d_in[9]; p.nsa_cmp_w1 = (const float*)d_in[10]; p.nsa_cmp_w2 = (const float*)d_in[11];
    p.nsa_w_out = (const float*)d_in[12]; p.hgrn_w_in = (const float*)d_in[13]; p.hgrn_lb = (const float*)d_in[14]; p.hgrn_out_gain = (const float*)d_in[15];
    p.hgrn_w_out = (const float*)d_in[16]; p.moe_rg = (const float*)d_in[17]; p.moe_re = (const float*)d_in[18]; p.moe_w1 = (const float*)d_in[19];
    p.moe_w3 = (const float*)d_in[20]; p.moe_w2 = (const float*)d_in[21];
    p.out = (float*)d_out; p.ws = (char*)d_ws;
#if MULTI_LAUNCH
    launch_phases<0>(p, grid, stream);
#else
    p.p_begin = 0; p.p_end = NPHASE;
    void* args[] = {&p};
    hipError_t e = hipLaunchCooperativeKernel((void*)mega_kernel, dim3(grid), dim3(256), args, 0, stream);
    if (e != hipSuccess) fprintf(stderr, "cooperative launch failed: %s (grid %d)\n", hipGetErrorString(e), grid);
#endif
}
```

```cpp
#include <hip/hip_runtime.h>
#include <hip/hip_cooperative_groups.h>
#include <cstdio>
#include <cstdint>
namespace cg = cooperative_groups;

#ifndef MULTI_LAUNCH
#define MULTI_LAUNCH 0
#endif

typedef unsigned short bf16_t;
typedef short bf16x8 __attribute__((ext_vector_type(8)));
typedef float f32x4 __attribute__((ext_vector_type(4)));
typedef float f32x16 __attribute__((ext_vector_type(16)));

constexpr int NTOK = 32768, DM = 1024, SEQ = 2048, NBATCH = 16;
constexpr int NSA_IN = 2608, NSA_IN_PAD = 2688;
constexpr float EPS = 1e-6f;
constexpr size_t MiB = 1ull << 20;

constexpr size_t OFF_CNT = 0;
constexpr size_t OFF_MOD = 4096;
constexpr size_t OFF_LB = OFF_MOD + 786432;
constexpr size_t OFF_PEB = OFF_LB + 4096;
constexpr size_t OFF_BAR = 921600;
constexpr size_t OFF_W_NSA_IN = 1 * MiB;
constexpr size_t OFF_W_NSA_OUT = OFF_W_NSA_IN + 2688ull * 1024 * 2;
constexpr size_t OFF_W_HG_IN = OFF_W_NSA_OUT + 1024ull * 1024 * 2;
constexpr size_t OFF_W_HG_OUT = OFF_W_HG_IN + 4096ull * 1024 * 2;
constexpr size_t OFF_W_CMP1 = OFF_W_HG_OUT + 1024ull * 1024 * 2;
constexpr size_t OFF_W_UP = OFF_W_CMP1 + 2ull * 128 * 2048 * 2;
constexpr size_t OFF_W_DN = OFF_W_UP + 32ull * 1024 * 1024 * 2;
constexpr size_t OFF_W_END = OFF_W_DN + 32ull * 1024 * 512 * 2;
constexpr size_t OFF_HA = 116 * MiB;
static_assert(OFF_W_END <= OFF_HA, "weights overflow");
constexpr size_t OFF_SCR = 180 * MiB;
constexpr size_t OFF_Q = OFF_SCR;
constexpr size_t OFF_KCRAW = OFF_Q + 64 * MiB;
constexpr size_t OFF_VCRAW = OFF_KCRAW + 17 * MiB;
constexpr size_t OFF_KS = OFF_VCRAW + 17 * MiB;
constexpr size_t OFF_VS = OFF_KS + 16 * MiB;
constexpr size_t OFF_KW = OFF_VS + 16 * MiB;
constexpr size_t OFF_VW = OFF_KW + 16 * MiB;
constexpr size_t OFF_GATES = OFF_VW + 16 * MiB;
constexpr size_t OFF_T1 = OFF_GATES + 6 * MiB;
constexpr size_t OFF_KC = OFF_T1 + 4 * MiB;
constexpr size_t OFF_VC = OFF_KC + 1 * MiB;
constexpr size_t OFF_H1 = OFF_SCR;
constexpr size_t OFF_Y = OFF_H1 + 64 * MiB;
constexpr size_t OFF_LTOK = OFF_Y + 128 * MiB;
constexpr size_t OFF_LW = OFF_LTOK + 2 * MiB;
constexpr size_t OFF_TSLOT = OFF_LW + 2 * MiB;
constexpr size_t OFF_QH = OFF_SCR;
constexpr size_t OFF_LF = OFF_QH + 64 * MiB;
constexpr size_t OFF_V = OFF_LF + 128 * MiB;
constexpr size_t OFF_G = OFF_V + 64 * MiB;
constexpr size_t WS_NEED = OFF_G + 64 * MiB;
static_assert(WS_NEED <= 512 * MiB, "ws overflow");

constexpr int LDS_BYTES = 64512;
constexpr int NPHASE = 19;

struct Params {
    const float *x, *c, *ada_w, *ada_b, *norm_g, *rel_bias, *nsa_w_in, *nsa_q_gain, *nsa_k_gain, *nsa_cmp_pe, *nsa_cmp_w1,
        *nsa_cmp_w2, *nsa_w_out, *hgrn_w_in, *hgrn_lb, *hgrn_out_gain, *hgrn_w_out, *moe_rg, *moe_re, *moe_w1, *moe_w3, *moe_w2;
    float* out;
    char* ws;
    int p_begin, p_end;
};

__device__ __forceinline__ float bf2f(unsigned short h) { return __uint_as_float((unsigned)h << 16); }
__device__ __forceinline__ unsigned short f2bf(float f) {
    unsigned u = __float_as_uint(f);
    u += 0x7fffu + ((u >> 16) & 1u);
    return (unsigned short)(u >> 16);
}
typedef __bf16 bf2_t __attribute__((ext_vector_type(2)));
typedef float f2_t __attribute__((ext_vector_type(2)));
__device__ __forceinline__ unsigned pack2(float a, float b) {
    f2_t v = {a, b};
    return __builtin_bit_cast(unsigned, __builtin_convertvector(v, bf2_t));
}
__device__ __forceinline__ float wave_sum(float v) {
#pragma unroll
    for (int o = 32; o; o >>= 1) v += __shfl_xor(v, o);
    return v;
}
__device__ __forceinline__ float wave_max(float v) {
#pragma unroll
    for (int o = 32; o; o >>= 1) v = fmaxf(v, __shfl_xor(v, o));
    return v;
}
__device__ __forceinline__ float silu_f(float x) { return x / (1.f + __expf(-x)); }
__device__ __forceinline__ float sigmoid_f(float x) { return 1.f / (1.f + __expf(-x)); }
__device__ __forceinline__ void glds16(const void* g, void* l) {
    __builtin_amdgcn_global_load_lds((const unsigned*)g, (unsigned*)l, 16, 0, 0);
}
__device__ __forceinline__ int t5_bucket(int n) {
    if (n < 16) return n;
    int b = 16;
    b += (n >= 21); b += (n >= 27); b += (n >= 35); b += (n >= 46); b += (n >= 59); b += (n >= 77); b += (n >= 99); b += (n >= 128);
    b += (n >= 166); b += (n >= 216); b += (n >= 280); b += (n >= 363); b += (n >= 470); b += (n >= 609); b += (n >= 790);
    return b;
}

struct Ctx {
    int G, vbid, tid, wid, lane;
};

constexpr int P0_MOD_ITEMS = 192;
constexpr int TS0 = 84 * 16, TS1 = 32 * 16, TS2 = 128 * 16, TS3 = 32 * 16, TS4 = 2 * 4 * 32, TS5 = 32 * 32 * 16, TS6 = 32 * 32 * 8;
constexpr int TC0 = 0, TC1 = TC0 + TS0, TC2 = TC1 + TS1, TC3 = TC2 + TS2, TC4 = TC3 + TS3, TC5 = TC4 + TS4, TC6 = TC5 + TS5, TC_END = TC6 + TS6;
constexpr int P0_ITEMS = P0_MOD_ITEMS + TC_END + 1;

__device__ __forceinline__ void transpose_tile(const float* __restrict__ src, int ld, int c0, int ncols_valid, int k0, bf16_t* __restrict__ dst, int dstld,
                               char* lds, int tid) {
    float* tl = (float*)lds;
    {
        const int k = tid >> 2, cc = (tid & 3) * 8;
        const float* s = src + (size_t)(k0 + k) * ld + c0 + cc;
#pragma unroll
        for (int i = 0; i < 8; ++i) {
            float v = (c0 + cc + i < ncols_valid) ? s[i] : 0.f;
            tl[k * 33 + cc + i] = v;
        }
    }
    __syncthreads();
    {
        const int n = tid >> 3, kc = (tid & 7) * 8;
        unsigned w[4];
#pragma unroll
        for (int i = 0; i < 4; ++i) w[i] = pack2(tl[(kc + 2 * i) * 33 + n], tl[(kc + 2 * i + 1) * 33 + n]);
        uint4 o; o.x = w[0]; o.y = w[1]; o.z = w[2]; o.w = w[3];
        *(uint4*)(dst + (size_t)n * dstld + kc) = o;
    }
    __syncthreads();
}

__device__ __forceinline__ void phase0(const Params& p, const Ctx& cx, char* lds) {
    const int tid = cx.tid, wid = cx.wid, lane = cx.lane;
    for (int it = cx.vbid; it < P0_ITEMS; it += cx.G) {
        if (it < P0_MOD_ITEMS) {
            const int colbase = it * 64, ls = colbase / 3072, e0 = colbase % 3072;
            const float* W = p.ada_w + (size_t)ls * 1024 * 3072 + e0 + lane;
            float* cs = (float*)lds + wid * 1024;
            float* red = (float*)lds + 4096;
            float acc[16];
#pragma unroll
            for (int b = 0; b < 16; ++b) acc[b] = 0.f;
            for (int sub = 0; sub < 4; ++sub) {
                const int kb = wid * 256 + sub * 64;
#pragma unroll
                for (int b = 0; b < 16; ++b) cs[lane * 16 + b] = silu_f(p.c[b * 1024 + kb + lane]);
                __builtin_amdgcn_wave_barrier();
                for (int kk = 0; kk < 64; ++kk) {
                    const float w = W[(size_t)(kb + kk) * 3072];
                    const f32x4* cv = (const f32x4*)(cs + kk * 16);
#pragma unroll
                    for (int q = 0; q < 4; ++q) {
                        f32x4 c4 = cv[q];
                        acc[q * 4 + 0] += c4[0] * w; acc[q * 4 + 1] += c4[1] * w; acc[q * 4 + 2] += c4[2] * w; acc[q * 4 + 3] += c4[3] * w;
                    }
                }
                __builtin_amdgcn_wave_barrier();
            }
#pragma unroll
            for (int b = 0; b < 16; ++b) red[(wid * 16 + b) * 64 + lane] = acc[b];
            __syncthreads();
            float* mod = (float*)(p.ws + OFF_MOD);
#pragma unroll
            for (int i = 0; i < 4; ++i) {
                const int o = tid + i * 256, b = o >> 6, e = o & 63;
                float s = red[(0 * 16 + b) * 64 + e] + red[(1 * 16 + b) * 64 + e] + red[(2 * 16 + b) * 64 + e] + red[(3 * 16 + b) * 64 + e];
                mod[((size_t)ls * 16 + b) * 3072 + e0 + e] = s + p.ada_b[ls * 3072 + e0 + e];
            }
            __syncthreads();
        } else if (it < P0_MOD_ITEMS + TC_END) {
            const int tt = it - P0_MOD_ITEMS;
            if (tt < TC1) {
                const int nt = tt / 16, kt = tt % 16;
                transpose_tile(p.nsa_w_in, NSA_IN, nt * 32, NSA_IN, kt * 64, (bf16_t*)(p.ws + OFF_W_NSA_IN) + (size_t)nt * 32 * 1024 + kt * 64, 1024, lds, tid);
            } else if (tt < TC2) {
                const int u = tt - TC1, nt = u / 16, kt = u % 16;
                transpose_tile(p.nsa_w_out, 1024, nt * 32, 1024, kt * 64, (bf16_t*)(p.ws + OFF_W_NSA_OUT) + (size_t)nt * 32 * 1024 + kt * 64, 1024, lds, tid);
            } else if (tt < TC3) {
                const int u = tt - TC2, nt = u / 16, kt = u % 16;
                transpose_tile(p.hgrn_w_in, 4096, nt * 32, 4096, kt * 64, (bf16_t*)(p.ws + OFF_W_HG_IN) + (size_t)nt * 32 * 1024 + kt * 64, 1024, lds, tid);
            } else if (tt < TC4) {
                const int u = tt - TC3, nt = u / 16, kt = u % 16;
                transpose_tile(p.hgrn_w_out, 1024, nt * 32, 1024, kt * 64, (bf16_t*)(p.ws + OFF_W_HG_OUT) + (size_t)nt * 32 * 1024 + kt * 64, 1024, lds, tid);
            } else if (tt < TC5) {
                const int u = tt - TC4, kv = u / 128, r = u % 128, nt = r / 32, kt = r % 32;
                transpose_tile(p.nsa_cmp_w1 + (size_t)kv * 2048 * 64, 64, nt * 32, 64, kt * 64,
                               (bf16_t*)(p.ws + OFF_W_CMP1) + ((size_t)kv * 128 + nt * 32) * 2048 + kt * 64, 2048, lds, tid);
            } else if (tt < TC6) {
                const int u = tt - TC5, le = u / 512, r = u % 512, gr = r / 16, kt = r % 16;
                const int t = gr >> 2, wc = (gr >> 1) & 1, which = gr & 1;
                const float* src = (which ? p.moe_w3 : p.moe_w1) + (size_t)le * 1024 * 512;
                transpose_tile(src, 512, (t * 2 + wc) * 32, 512, kt * 64, (bf16_t*)(p.ws + OFF_W_UP) + ((size_t)le * 1024 + gr * 32) * 1024 + kt * 64, 1024, lds, tid);
            } else {
                const int u = tt - TC6, le = u / 256, r = u % 256, nt = r / 8, kt = r % 8;
                transpose_tile(p.moe_w2 + (size_t)le * 512 * 1024, 1024, nt * 32, 1024, kt * 64,
                               (bf16_t*)(p.ws + OFF_W_DN) + ((size_t)le * 1024 + nt * 32) * 512 + kt * 64, 512, lds, tid);
            }
        } else {
            float* lb = (float*)(p.ws + OFF_LB);
            for (int i = tid; i < 1024; i += 256) lb[i] = sigmoid_f(p.hgrn_lb[1024 + i] - p.hgrn_lb[i]);
            if (tid < 128) {
                const int kv = tid >> 6, d = tid & 63;
                const float* pe = p.nsa_cmp_pe + kv * 2048;
                const float* w1 = p.nsa_cmp_w1 + (size_t)kv * 2048 * 64 + d;
                float s = 0.f;
                for (int k = 0; k < 2048; ++k) s += pe[k] * w1[(size_t)k * 64];
                ((float*)(p.ws + OFF_PEB))[tid] = s;
            }
            if (tid < 32) ((int*)(p.ws + OFF_CNT))[tid] = 0;
        }
    }
}

template <bool COMBINE, bool NORM, bool ROUTER>
__device__ __forceinline__ void rows_phase(const Params& p, const Ctx& cx, char* lds, const float* __restrict__ src, float* __restrict__ xdst,
                           int ls_comb, int ls_norm, int layer_router, int layer_comb) {
    const int lane = cx.lane;
    const float* mod = (const float*)(p.ws + OFF_MOD);
    int my_off = 0;
    if (COMBINE) {
        const int* cnt = (const int*)(p.ws + OFF_CNT) + layer_comb * 16;
        int cv = (lane < 16) ? cnt[lane] : 0;
        int incl = cv;
#pragma unroll
        for (int o = 1; o < 16; o <<= 1) { int t = __shfl_up(incl, o); if (lane >= o) incl += t; }
        my_off = incl - cv;
    }
    for (int row = cx.vbid * 4 + cx.wid; row < NTOK; row += cx.G * 4) {
        const int b = row >> 11;
        f32x4 v[4];
#pragma unroll
        for (int i = 0; i < 4; ++i) v[i] = *(const f32x4*)(src + (size_t)row * 1024 + (i * 64 + lane) * 4);
        if (COMBINE) {
            const int* ts = (const int*)(p.ws + OFF_TSLOT) + row * 2;
            const int s0 = ts[0], s1 = ts[1];
            const int r0 = __shfl(my_off, s0 >> 16) + (s0 & 0xffff), r1 = __shfl(my_off, s1 >> 16) + (s1 & 0xffff);
            const bf16_t* Y = (const bf16_t*)(p.ws + OFF_Y);
            const float* gate = mod + ((size_t)ls_comb * 16 + b) * 3072 + 2048;
#pragma unroll
            for (int i = 0; i < 4; ++i) {
                const int col = (i * 64 + lane) * 4;
                uint2 a = *(const uint2*)(Y + (size_t)r0 * 1024 + col), c = *(const uint2*)(Y + (size_t)r1 * 1024 + col);
                f32x4 g = *(const f32x4*)(gate + col);
                v[i][0] += g[0] * (bf2f(a.x & 0xffff) + bf2f(c.x & 0xffff));
                v[i][1] += g[1] * (bf2f(a.x >> 16) + bf2f(c.x >> 16));
                v[i][2] += g[2] * (bf2f(a.y & 0xffff) + bf2f(c.y & 0xffff));
                v[i][3] += g[3] * (bf2f(a.y >> 16) + bf2f(c.y >> 16));
                *(f32x4*)(xdst + (size_t)row * 1024 + col) = v[i];
            }
        }
        if (NORM) {
            float ss = 0.f;
#pragma unroll
            for (int i = 0; i < 4; ++i) ss += v[i][0] * v[i][0] + v[i][1] * v[i][1] + v[i][2] * v[i][2] + v[i][3] * v[i][3];
            ss = wave_sum(ss);
            const float r = rsqrtf(ss * (1.f / 1024.f) + EPS);
            const float* gain = p.norm_g + ls_norm * 1024;
            const float* shift = mod + ((size_t)ls_norm * 16 + b) * 3072;
            const float* scale = shift + 1024;
            bf16_t* hA = (bf16_t*)(p.ws + OFF_HA);
            f32x4 rg4 = {0.f, 0.f, 0.f, 0.f}, re0 = rg4, re1 = rg4, re2 = rg4, re3 = rg4;
#pragma unroll
            for (int i = 0; i < 4; ++i) {
                const int col = (i * 64 + lane) * 4;
                f32x4 g = *(const f32x4*)(gain + col), sc = *(const f32x4*)(scale + col), sh = *(const f32x4*)(shift + col);
                f32x4 h;
#pragma unroll
                for (int j = 0; j < 4; ++j) h[j] = v[i][j] * r * g[j] * (1.f + sc[j]) + sh[j];
                uint2 o; o.x = pack2(h[0], h[1]); o.y = pack2(h[2], h[3]);
                *(uint2*)(hA + (size_t)row * 1024 + col) = o;
                if (ROUTER) {
                    const float* rg = p.moe_rg + (size_t)layer_router * 1024 * 4;
                    const float* re = p.moe_re + (size_t)layer_router * 1024 * 16;
#pragma unroll
                    for (int j = 0; j < 4; ++j) {
                        rg4 += h[j] * *(const f32x4*)(rg + (col + j) * 4);
                        re0 += h[j] * *(const f32x4*)(re + (col + j) * 16 + 0);
                        re1 += h[j] * *(const f32x4*)(re + (col + j) * 16 + 4);
                        re2 += h[j] * *(const f32x4*)(re + (col + j) * 16 + 8);
                        re3 += h[j] * *(const f32x4*)(re + (col + j) * 16 + 12);
                    }
                }
            }
            if (ROUTER) {
                float rl[4];
                f32x4 rs0, rs1, rs2, rs3;
#pragma unroll
                for (int j = 0; j < 4; ++j) { rl[j] = wave_sum(rg4[j]); rs0[j] = wave_sum(re0[j]); rs1[j] = wave_sum(re1[j]); rs2[j] = wave_sum(re2[j]); rs3[j] = wave_sum(re3[j]); }
                float gm = fmaxf(fmaxf(rl[0], rl[1]), fmaxf(rl[2], rl[3]));
                float e0 = __expf(rl[0] - gm), e1 = __expf(rl[1] - gm), e2 = __expf(rl[2] - gm), e3 = __expf(rl[3] - gm);
                float gs = e0 + e1 + e2 + e3;
                int grp = 0; float best = rl[0];
                if (rl[1] > best) { best = rl[1]; grp = 1; }
                if (rl[2] > best) { best = rl[2]; grp = 2; }
                if (rl[3] > best) { best = rl[3]; grp = 3; }
                const float pg = __expf(best - gm) / gs;
                const f32x4 lsel = (grp == 0) ? rs0 : (grp == 1) ? rs1 : (grp == 2) ? rs2 : rs3;
                const float l0 = lsel[0], l1 = lsel[1], l2 = lsel[2], l3 = lsel[3];
                const float em = fmaxf(fmaxf(l0, l1), fmaxf(l2, l3));
                float q0 = __expf(l0 - em), q1 = __expf(l1 - em), q2 = __expf(l2 - em), q3 = __expf(l3 - em);
                int i1 = 0; float b1 = q0;
                if (q1 > b1) { b1 = q1; i1 = 1; }
                if (q2 > b1) { b1 = q2; i1 = 2; }
                if (q3 > b1) { b1 = q3; i1 = 3; }
                int i2 = -1; float b2 = -1.f;
                if (i1 != 0 && q0 > b2) { b2 = q0; i2 = 0; }
                if (i1 != 1 && q1 > b2) { b2 = q1; i2 = 1; }
                if (i1 != 2 && q2 > b2) { b2 = q2; i2 = 2; }
                if (i1 != 3 && q3 > b2) { b2 = q3; i2 = 3; }
                const float inv = pg / (b1 + b2);
                if (lane == 0) {
                    int* cnt = (int*)(p.ws + OFF_CNT) + layer_router * 16;
                    int* ltok = (int*)(p.ws + OFF_LTOK);
                    float* lw = (float*)(p.ws + OFF_LW);
                    int* ts = (int*)(p.ws + OFF_TSLOT) + row * 2;
                    const int ea = grp * 4 + i1, eb = grp * 4 + i2;
                    const int pa = atomicAdd(cnt + ea, 1);
                    const int pb = atomicAdd(cnt + eb, 1);
                    ltok[(size_t)ea * NTOK + pa] = row; lw[(size_t)ea * NTOK + pa] = b1 * inv;
                    ltok[(size_t)eb * NTOK + pb] = row; lw[(size_t)eb * NTOK + pb] = b2 * inv;
                    ts[0] = (ea << 16) | pa; ts[1] = (eb << 16) | pb;
                }
            }
        }
    }
}

__device__ __forceinline__ void rows_router_phase(const Params& p, const Ctx& cx, char* lds, const float* __restrict__ src, int ls_norm, int layer) {
    const int lane = cx.lane, tid = cx.tid;
    const int widu = __builtin_amdgcn_readfirstlane(cx.wid);
    const float* mod = (const float*)(p.ws + OFF_MOD);
    const float* rg = p.moe_rg + (size_t)layer * 1024 * 4;
    const float* re = p.moe_re + (size_t)layer * 1024 * 16;
    float* logit_s = (float*)lds;
    float wr[16][5];
#pragma unroll
    for (int i = 0; i < 4; ++i)
#pragma unroll
        for (int j = 0; j < 4; ++j) {
            const int k = (i * 64 + lane) * 4 + j;
#pragma unroll
            for (int q = 0; q < 5; ++q) {
                const int o = 5 * widu + q;
                wr[i * 4 + j][q] = (o < 4) ? rg[k * 4 + o] : re[k * 16 + o - 4];
            }
        }
    const float* gain = p.norm_g + ls_norm * 1024;
    bf16_t* hA = (bf16_t*)(p.ws + OFF_HA);
    for (int blk = cx.vbid; blk < NTOK / 16; blk += cx.G) {
        const int R0 = blk * 16, b = R0 >> 11;
        const float* shift = mod + ((size_t)ls_norm * 16 + b) * 3072;
        const float* scale = shift + 1024;
#pragma unroll 1
        for (int r = 0; r < 16; ++r) {
            const int row = R0 + r;
            f32x4 v[4];
#pragma unroll
            for (int i = 0; i < 4; ++i) v[i] = *(const f32x4*)(src + (size_t)row * 1024 + (i * 64 + lane) * 4);
            float ss = 0.f;
#pragma unroll
            for (int i = 0; i < 4; ++i) ss += v[i][0] * v[i][0] + v[i][1] * v[i][1] + v[i][2] * v[i][2] + v[i][3] * v[i][3];
            ss = wave_sum(ss);
            const float rr = rsqrtf(ss * (1.f / 1024.f) + EPS);
            float acc[5] = {0.f, 0.f, 0.f, 0.f, 0.f};
#pragma unroll
            for (int i = 0; i < 4; ++i) {
                const int col = (i * 64 + lane) * 4;
                const f32x4 g = *(const f32x4*)(gain + col), sc = *(const f32x4*)(scale + col), sh = *(const f32x4*)(shift + col);
                f32x4 h;
#pragma unroll
                for (int j = 0; j < 4; ++j) {
                    h[j] = v[i][j] * rr * g[j] * (1.f + sc[j]) + sh[j];
#pragma unroll
                    for (int q = 0; q < 5; ++q) acc[q] += h[j] * wr[i * 4 + j][q];
                }
                if ((r & 3) == widu) {
                    uint2 o; o.x = pack2(h[0], h[1]); o.y = pack2(h[2], h[3]);
                    *(uint2*)(hA + (size_t)row * 1024 + col) = o;
                }
            }
#pragma unroll
            for (int q = 0; q < 5; ++q) acc[q] = wave_sum(acc[q]);
            if (lane == 0) {
#pragma unroll
                for (int q = 0; q < 5; ++q) logit_s[r * 20 + 5 * widu + q] = acc[q];
            }
        }
        __syncthreads();
        if (tid < 16) {
            const int row = R0 + tid;
            const float* rl = logit_s + tid * 20;
            const float gm = fmaxf(fmaxf(rl[0], rl[1]), fmaxf(rl[2], rl[3]));
            const float gs = __expf(rl[0] - gm) + __expf(rl[1] - gm) + __expf(rl[2] - gm) + __expf(rl[3] - gm);
            int grp = 0; float best = rl[0];
            if (rl[1] > best) { best = rl[1]; grp = 1; }
            if (rl[2] > best) { best = rl[2]; grp = 2; }
            if (rl[3] > best) { best = rl[3]; grp = 3; }
            const float pg = __expf(best - gm) / gs;
            const f32x4 lsel = *(const f32x4*)(rl + 4 + 4 * grp);
            const float l0 = lsel[0], l1 = lsel[1], l2 = lsel[2], l3 = lsel[3];
            const float em = fmaxf(fmaxf(l0, l1), fmaxf(l2, l3));
            const float q0 = __expf(l0 - em), q1 = __expf(l1 - em), q2 = __expf(l2 - em), q3 = __expf(l3 - em);
            int i1 = 0; float b1 = q0;
            if (q1 > b1) { b1 = q1; i1 = 1; }
            if (q2 > b1) { b1 = q2; i1 = 2; }
            if (q3 > b1) { b1 = q3; i1 = 3; }
            int i2 = -1; float b2 = -1.f;
            if (i1 != 0 && q0 > b2) { b2 = q0; i2 = 0; }
            if (i1 != 1 && q1 > b2) { b2 = q1; i2 = 1; }
            if (i1 != 2 && q2 > b2) { b2 = q2; i2 = 2; }
            if (i1 != 3 && q3 > b2) { b2 = q3; i2 = 3; }
            const float inv = pg / (b1 + b2);
            int* cnt = (int*)(p.ws + OFF_CNT) + layer * 16;
            int* ltok = (int*)(p.ws + OFF_LTOK);
            float* lw = (float*)(p.ws + OFF_LW);
            int* ts = (int*)(p.ws + OFF_TSLOT) + row * 2;
            const int ea = grp * 4 + i1, eb = grp * 4 + i2;
            const int pa = atomicAdd(cnt + ea, 1);
            const int pb = atomicAdd(cnt + eb, 1);
            ltok[(size_t)ea * NTOK + pa] = row; lw[(size_t)ea * NTOK + pa] = b1 * inv;
            ltok[(size_t)eb * NTOK + pb] = row; lw[(size_t)eb * NTOK + pb] = b2 * inv;
            ts[0] = (ea << 16) | pa; ts[1] = (eb << 16) | pb;
        }
        __syncthreads();
    }
}

template <class Epi>
__device__ __forceinline__ void gemm_tile(const bf16_t* a0, const bf16_t* a1, const bf16_t* b0, const bf16_t* b1, int K, char* lds, const Ctx& cx,
                                          Epi&& epi) {
    const int tid = cx.tid, lane = cx.lane, wr = cx.wid >> 1, wc = cx.wid & 1, fr = lane & 15, fq = lane >> 4;
    f32x4 acc[4][4];
#pragma unroll
    for (int m = 0; m < 4; ++m)
#pragma unroll
        for (int n = 0; n < 4; ++n) acc[m][n] = (f32x4){0.f, 0.f, 0.f, 0.f};
    const int nt = K / 32;
    {
        char* SA = lds; char* SB = lds + 8192;
        glds16(a0, SA + tid * 16); glds16(a1, SA + tid * 16 + 4096);
        glds16(b0, SB + tid * 16); glds16(b1, SB + tid * 16 + 4096);
    }
    asm volatile("s_waitcnt vmcnt(0)" ::: "memory");
    __syncthreads();
    for (int kt = 0; kt < nt; ++kt) {
        const int cur = kt & 1;
        if (kt + 1 < nt) {
            char* SA = lds + (cur ^ 1) * 16384; char* SB = SA + 8192;
            const int ko = (kt + 1) * 32;
            glds16(a0 + ko, SA + tid * 16); glds16(a1 + ko, SA + tid * 16 + 4096);
            glds16(b0 + ko, SB + tid * 16); glds16(b1 + ko, SB + tid * 16 + 4096);
        }
        const char* SA = lds + cur * 16384; const char* SB = SA + 8192;
        bf16x8 Af[4], Bf[4];
#pragma unroll
        for (int m = 0; m < 4; ++m) Af[m] = *(const bf16x8*)(SA + (wr * 64 + m * 16 + fr) * 64 + fq * 16);
#pragma unroll
        for (int n = 0; n < 4; ++n) Bf[n] = *(const bf16x8*)(SB + (wc * 64 + n * 16 + fr) * 64 + fq * 16);
#pragma unroll
        for (int m = 0; m < 4; ++m)
#pragma unroll
            for (int n = 0; n < 4; ++n) acc[m][n] = __builtin_amdgcn_mfma_f32_16x16x32_bf16(Bf[n], Af[m], acc[m][n], 0, 0, 0);
        asm volatile("s_waitcnt vmcnt(0)" ::: "memory");
        __syncthreads();
    }
    epi(acc, wr, wc, fr, fq);
}

template <class EpiFactory>
__device__ __forceinline__ void gemm_phase_dense(const bf16_t* A, int lda, const bf16_t* Bt, int K, int nrt, int nct, char* lds, const Ctx& cx, EpiFactory&& mk) {
    const int tid = cx.tid;
    const int ntiles = nrt * nct;
    for (int tile = cx.vbid; tile < ntiles; tile += cx.G) {
        const int rt = tile / nct, ct = tile % nct;
        const bf16_t* a0 = A + (size_t)(rt * 128 + (tid >> 2)) * lda + (tid & 3) * 8;
        const bf16_t* a1 = a0 + (size_t)64 * lda;
        const bf16_t* b0 = Bt + (size_t)(ct * 128 + (tid >> 2)) * K + (tid & 3) * 8;
        const bf16_t* b1 = b0 + (size_t)64 * K;
        gemm_tile(a0, a1, b0, b1, K, lds, cx, mk(rt * 128, ct * 128));
    }
}

__device__ __forceinline__ void phase_nsa_inproj(const Params& p, const Ctx& cx, char* lds) {
    const bf16_t* A = (const bf16_t*)(p.ws + OFF_HA);
    const bf16_t* Bt = (const bf16_t*)(p.ws + OFF_W_NSA_IN);
    char* ws = p.ws;
    const float* qg = p.nsa_q_gain;
    const float* kg = p.nsa_k_gain;
    gemm_phase_dense(A, 1024, Bt, 1024, NTOK / 128, NSA_IN_PAD / 128, lds, cx, [=](int row0, int col0) {
        return [=](f32x4 (&acc)[4][4], int wr, int wc, int fr, int fq) {
            const int gc0 = col0 + wc * 64;
            if (gc0 >= NSA_IN) return;
            if (gc0 < 1024 || (gc0 >= 1536 && gc0 < 1792) || (gc0 >= 2048 && gc0 < 2304)) {
                const float* gain; float post; bf16_t* dstb; size_t rstride; size_t coff; bool tokmajor;
                if (gc0 < 1024) { gain = qg; post = 0.125f * 1.4426950408889634f; }
                else if (gc0 < 1792) { gain = kg + 64; post = 1.f; }
                else { gain = kg + 128; post = 1.f; }
#pragma unroll
                for (int m = 0; m < 4; ++m) {
                    float ss = 0.f;
#pragma unroll
                    for (int n = 0; n < 4; ++n) ss += acc[m][n][0] * acc[m][n][0] + acc[m][n][1] * acc[m][n][1] + acc[m][n][2] * acc[m][n][2] + acc[m][n][3] * acc[m][n][3];
                    ss += __shfl_xor(ss, 16); ss += __shfl_xor(ss, 32);
                    const float r = rsqrtf(ss * (1.f / 64.f) + EPS) * post;
                    const int row = row0 + wr * 64 + m * 16 + fr;
                    bf16_t* dst;
                    if (gc0 < 1024) dst = (bf16_t*)(ws + OFF_Q) + (size_t)row * 1024 + gc0;
                    else {
                        const int g = ((gc0 - 1024) & 255) >> 6, b = row >> 11, t = row & 2047;
                        dst = (bf16_t*)(ws + (gc0 < 1792 ? OFF_KS : OFF_KW)) + ((size_t)(b * 4 + g) * 2048 + t) * 64;
                    }
#pragma unroll
                    for (int n = 0; n < 4; ++n) {
                        const int c = n * 16 + fq * 4;
                        f32x4 g4 = *(const f32x4*)(gain + c);
                        uint2 o; o.x = pack2(acc[m][n][0] * r * g4[0], acc[m][n][1] * r * g4[1]); o.y = pack2(acc[m][n][2] * r * g4[2], acc[m][n][3] * r * g4[3]);
                        *(uint2*)(dst + c) = o;
                    }
                }
            } else if (gc0 < 2560) {
                const int seg = (gc0 - 1024) >> 8;
                const int g = ((gc0 - 1024) & 255) >> 6;
                if (seg < 2) {
                    const size_t off = seg == 0 ? OFF_KCRAW : OFF_VCRAW;
#pragma unroll
                    for (int m = 0; m < 4; ++m) {
                        const int row = row0 + wr * 64 + m * 16 + fr, b = row >> 11, t = row & 2047;
                        bf16_t* dst = (bf16_t*)(ws + off) + ((size_t)(b * 4 + g) * 2048 + t) * 64;
#pragma unroll
                        for (int n = 0; n < 4; ++n) {
                            const int c = n * 16 + fq * 4;
                            uint2 o; o.x = pack2(acc[m][n][0], acc[m][n][1]); o.y = pack2(acc[m][n][2], acc[m][n][3]);
                            *(uint2*)(dst + c) = o;
                        }
                    }
                } else {
                    const size_t off = seg == 3 ? OFF_VS : OFF_VW;
#pragma unroll
                    for (int m = 0; m < 4; ++m) {
                        const int row = row0 + wr * 64 + m * 16 + fr, b = row >> 11, t = row & 2047;
                        bf16_t* dst = (bf16_t*)(ws + off) + (size_t)(b * 4 + g) * 64 * 2048 + t;
#pragma unroll
                        for (int n = 0; n < 4; ++n)
#pragma unroll
                            for (int j = 0; j < 4; ++j) dst[(size_t)(n * 16 + fq * 4 + j) * 2048] = f2bf(acc[m][n][j]);
                    }
                }
            } else {
#pragma unroll
                for (int m = 0; m < 4; ++m) {
                    const int row = row0 + wr * 64 + m * 16 + fr;
                    float* dst = (float*)(ws + OFF_GATES) + (size_t)row * 48;
#pragma unroll
                    for (int n = 0; n < 3; ++n) {
                        const int c = n * 16 + fq * 4;
                        f32x4 o;
#pragma unroll
                        for (int j = 0; j < 4; ++j) o[j] = sigmoid_f(acc[m][n][j]);
                        *(f32x4*)(dst + c) = o;
                    }
                }
            }
        };
    });
}

__device__ __forceinline__ void phase_cmp1(const Params& p, const Ctx& cx, char* lds) {
    const int tid = cx.tid;
    const float* peb = (const float*)(p.ws + OFF_PEB);
    float* T1 = (float*)(p.ws + OFF_T1);
    for (int tile = cx.vbid; tile < 128; tile += cx.G) {
        const int kv = tile >> 6, bg = tile & 63;
        const bf16_t* raw = (const bf16_t*)(p.ws + (kv ? OFF_VCRAW : OFF_KCRAW)) + (size_t)bg * 2048 * 64;
        const bf16_t* a0 = raw + (size_t)(tid >> 2) * 1024 + (tid & 3) * 8;
        const bf16_t* a1 = a0 + (size_t)64 * 1024;
        const bf16_t* b0 = (const bf16_t*)(p.ws + OFF_W_CMP1) + ((size_t)kv * 128 + (tid >> 2)) * 2048 + (tid & 3) * 8;
        const bf16_t* b1 = b0 + (size_t)64 * 2048;
        gemm_tile(a0, a1, b0, b1, 2048, lds, cx, [=](f32x4 (&acc)[4][4], int wr, int wc, int fr, int fq) {
            if (wc != 0) return;
#pragma unroll
            for (int m = 0; m < 4; ++m) {
                const int n_ = wr * 64 + m * 16 + fr;
                float* dst = T1 + ((size_t)kv * 8192 + bg * 128 + n_) * 64;
#pragma unroll
                for (int n = 0; n < 4; ++n) {
                    const int c = n * 16 + fq * 4;
                    f32x4 pb = *(const f32x4*)(peb + kv * 64 + c);
                    *(f32x4*)(dst + c) = acc[m][n] + pb;
                }
            }
        });
    }
}

__device__ __forceinline__ void phase_cmp2(const Params& p, const Ctx& cx) {
    const int lane = cx.lane;
    const float* T1 = (const float*)(p.ws + OFF_T1);
    for (int r = cx.vbid * 4 + cx.wid; r < 2 * 8192; r += cx.G * 4) {
        const int kv = r >> 13, rr = r & 8191, n_ = rr & 127;
        const float s = silu_f(T1[(size_t)r * 64 + lane]);
        const float* w2 = p.nsa_cmp_w2 + kv * 4096 + lane;
        float o = 0.f;
#pragma unroll 8
        for (int j = 0; j < 64; ++j) o += __shfl(s, j) * w2[j * 64];
        if (kv == 0) {
            const float ss = wave_sum(o * o);
            o = o * rsqrtf(ss * (1.f / 64.f) + EPS) * p.nsa_k_gain[lane];
        }
        if (n_ == 127) o = 0.f;
        if (kv == 0) ((bf16_t*)(p.ws + OFF_KC))[(size_t)rr * 64 + lane] = f2bf(o);
        else ((bf16_t*)(p.ws + OFF_VC))[((size_t)(rr >> 7) * 64 + lane) * 128 + n_] = f2bf(o);
    }
}

constexpr int ATT_K_OFF = 0, ATT_K_STRIDE = 144, ATT_V_OFF = 9216, ATT_V_STRIDE = 136, ATT_LUT_OFF = 17920, LUT_N = 2128, LUT_PAD = 80;
constexpr int ATT_SC_OFF = ATT_LUT_OFF + 4 * LUT_N * 4;
static_assert(ATT_SC_OFF + 4 * 3072 <= LDS_BYTES, "attention LDS");
#define MFMA32(a, b, c) __builtin_amdgcn_mfma_f32_32x32x16_bf16((a), (b), (c), 0, 0, 0)

__device__ __forceinline__ void phase_attn(const Params& p, const Ctx& cx, char* lds) {
    const int tid = cx.tid, lane = cx.lane, wid = cx.wid;
    const int g = cx.vbid & 3;
    const int ql = lane & 7, head = (lane & 31) >> 3, h2 = lane >> 5, l31 = lane & 31;
    float* lut = (float*)(lds + ATT_LUT_OFF);
    for (int i = tid; i < 4 * LUT_N; i += 256) {
        const int h = i / LUT_N, dist = i % LUT_N - LUT_PAD;
        lut[i] = dist >= 0 ? p.rel_bias[t5_bucket(dist) * 16 + g * 4 + h] * 1.4426950408889634f : 0.f;
    }
    __syncthreads();
    const float* lutp = lut + head * LUT_N + LUT_PAD;
    const bf16_t* Qb = (const bf16_t*)(p.ws + OFF_Q);
    const bf16_t* KC = (const bf16_t*)(p.ws + OFF_KC);
    const bf16_t* VCT = (const bf16_t*)(p.ws + OFF_VC);
    const bf16_t* KS = (const bf16_t*)(p.ws + OFF_KS);
    const bf16_t* VST = (const bf16_t*)(p.ws + OFF_VS);
    const bf16_t* KW = (const bf16_t*)(p.ws + OFF_KW);
    const bf16_t* VWT = (const bf16_t*)(p.ws + OFF_VW);
    const float* GT = (const float*)(p.ws + OFF_GATES);
    bf16_t* Og = (bf16_t*)(p.ws + OFF_HA);
    float* scw = (float*)(lds + ATT_SC_OFF) + wid * 768;
    const bool flip_ok = (cx.G % 256) == 0;

    for (int it = 0;; ++it) {
        const int u = cx.vbid + it * cx.G;
        if (u >= 4096) break;
        const int rest = u >> 2, b = rest >> 6, qtb = rest & 63;
        const int qt = (flip_ok && (it & 1)) ? 63 - qtb : qtb;
        const int t0 = qt * 32, cur = qt >> 1, bg = b * 4 + g;
        const int tq = t0 + wid * 8 + ql;
        const size_t rowtok = (size_t)b * SEQ + tq;
        bf16x8 Qf[4];
        {
            const bf16_t* qp = Qb + rowtok * 1024 + (g * 4 + head) * 64 + 8 * h2;
#pragma unroll
            for (int ks = 0; ks < 4; ++ks) Qf[ks] = *(const bf16x8*)(qp + 16 * ks);
        }
        const float* gt = GT + rowtok * 48 + (g * 4 + head) * 3;
        const float gate_c = gt[0], gate_s = gt[1], gate_w = gt[2];
        const int wlo = max(0, (t0 - 511) >> 6);
        const int nW = cur - wlo + 1;
        const int NT = 4 + nW + cur + 1;

        uint4 kr0, kr1, vr0, vr1;
        auto issue_load = [&](int i) {
            const bf16_t* ksrc; const bf16_t* vsrc; int vstride;
            if (i < 4) { const int ci = i & 1; ksrc = KC + ((size_t)bg * 128 + ci * 64) * 64; vsrc = VCT + (size_t)bg * 64 * 128 + ci * 64; vstride = 128; }
            else if (i < 4 + nW) { const int kb = wlo + i - 4; ksrc = KW + ((size_t)bg * 2048 + kb * 64) * 64; vsrc = VWT + (size_t)bg * 64 * 2048 + kb * 64; vstride = 2048; }
            else { const int kb = i - 4 - nW; ksrc = KS + ((size_t)bg * 2048 + kb * 64) * 64; vsrc = VST + (size_t)bg * 64 * 2048 + kb * 64; vstride = 2048; }
            kr0 = *(const uint4*)(ksrc + tid * 8);
            kr1 = *(const uint4*)(ksrc + (tid + 256) * 8);
            vr0 = *(const uint4*)(vsrc + (size_t)(tid >> 3) * vstride + (tid & 7) * 8);
            vr1 = *(const uint4*)(vsrc + (size_t)((tid >> 3) + 32) * vstride + (tid & 7) * 8);
        };
        auto write_lds = [&]() {
            *(uint4*)(lds + ATT_K_OFF + (tid >> 3) * ATT_K_STRIDE + (tid & 7) * 16) = kr0;
            *(uint4*)(lds + ATT_K_OFF + ((tid >> 3) + 32) * ATT_K_STRIDE + (tid & 7) * 16) = kr1;
            char* va = lds + ATT_V_OFF + (tid >> 3) * ATT_V_STRIDE + (tid & 7) * 16;
            uint2 t;
            t.x = vr0.x; t.y = vr0.y; *(uint2*)va = t;
            t.x = vr0.z; t.y = vr0.w; *(uint2*)(va + 8) = t;
            t.x = vr1.x; t.y = vr1.y; *(uint2*)(va + 32 * ATT_V_STRIDE) = t;
            t.x = vr1.z; t.y = vr1.w; *(uint2*)(va + 32 * ATT_V_STRIDE + 8) = t;
        };
        f32x16 O0, O1, OUT0, OUT1;
#pragma unroll
        for (int r = 0; r < 16; ++r) { O0[r] = 0.f; O1[r] = 0.f; }
        float lsum = 0.f;

        auto qk = [&](int kt2) -> f32x16 {
            f32x16 S;
#pragma unroll
            for (int r = 0; r < 16; ++r) S[r] = 0.f;
            const char* kp = lds + ATT_K_OFF + (32 * kt2 + l31) * ATT_K_STRIDE + 16 * h2;
#pragma unroll
            for (int ks = 0; ks < 4; ++ks) S = MFMA32(*(const bf16x8*)(kp + 32 * ks), Qf[ks], S);
            return S;
        };
        auto pv = [&](int kt2, const f32x16& P) {
#pragma unroll
            for (int s2 = 0; s2 < 2; ++s2) {
                uint4 pk;
                pk.x = pack2(P[8 * s2 + 0], P[8 * s2 + 1]); pk.y = pack2(P[8 * s2 + 2], P[8 * s2 + 3]);
                pk.z = pack2(P[8 * s2 + 4], P[8 * s2 + 5]); pk.w = pack2(P[8 * s2 + 6], P[8 * s2 + 7]);
                const bf16x8 Pf = __builtin_bit_cast(bf16x8, pk);
                const char* vp = lds + ATT_V_OFF + l31 * ATT_V_STRIDE + (32 * kt2 + 16 * s2 + 4 * h2) * 2;
                {
                    uint2 lo = *(const uint2*)vp, hi = *(const uint2*)(vp + 16);
                    uint4 a; a.x = lo.x; a.y = lo.y; a.z = hi.x; a.w = hi.y;
                    O0 = MFMA32(__builtin_bit_cast(bf16x8, a), Pf, O0);
                }
                {
                    uint2 lo = *(const uint2*)(vp + 32 * ATT_V_STRIDE), hi = *(const uint2*)(vp + 32 * ATT_V_STRIDE + 16);
                    uint4 a; a.x = lo.x; a.y = lo.y; a.z = hi.x; a.w = hi.y;
                    O1 = MFMA32(__builtin_bit_cast(bf16x8, a), Pf, O1);
                }
            }
        };
        auto finalize = [&](float gate, bool first) {
            const float Z = lsum + __shfl_xor(lsum, 32);
            const float f = Z > 0.f ? gate / Z : 0.f;
#pragma unroll
            for (int r = 0; r < 16; ++r) {
                if (first) { OUT0[r] = f * O0[r]; OUT1[r] = f * O1[r]; }
                else { OUT0[r] += f * O0[r]; OUT1[r] += f * O1[r]; }
                O0[r] = 0.f; O1[r] = 0.f;
            }
            lsum = 0.f;
        };

        const int nvis = (tq >= 31) ? min((tq - 31) / 16 + 1, 127) : 0;
        float inv_c = 0.f;
        unsigned selmask = 0u;
        float* sown = scw + ql * 32;
        float* stail = scw + 256 + ql * 32;
        float* ssc = scw + 512 + ql * 32;
        issue_load(0);
        for (int i = 0; i < NT; ++i) {
            __syncthreads();
            write_lds();
            __syncthreads();
            if (i + 1 < NT) issue_load(i + 1);
            if (i < 4) {
                const int ci = i & 1;
#pragma unroll 1
                for (int kt2 = 0; kt2 < 2; ++kt2) {
                    f32x16 S = qk(kt2);
                    const int n0 = 64 * ci + 32 * kt2 + 4 * h2;
                    const int d0 = tq - 31 - 16 * n0;
#pragma unroll
                    for (int r = 0; r < 16; ++r) {
                        const int cr = (r & 3) + 8 * (r >> 2);
                        const float bias = lutp[max(d0 - 16 * cr, -LUT_PAD)];
                        S[r] = __builtin_amdgcn_exp2f(S[r] + bias + ((n0 + cr) < nvis ? 0.f : -INFINITY));
                        lsum += S[r];
                    }
                    if (i >= 2) {
                        pv(kt2, S);
#pragma unroll
                        for (int rq = 0; rq < 4; ++rq) {
                            float gsum = (S[4 * rq] + S[4 * rq + 1] + S[4 * rq + 2] + 0.5f * S[4 * rq + 3]) * inv_c;
                            float tl = 0.5f * S[4 * rq + 3] * inv_c;
                            gsum += __shfl_xor(gsum, 8); gsum += __shfl_xor(gsum, 16);
                            tl += __shfl_xor(tl, 8); tl += __shfl_xor(tl, 16);
                            const int sblk = 8 * (2 * ci + kt2) + 2 * rq + h2;
                            if (head == 0) {
                                sown[sblk] = gsum;
                                if (sblk < 31) stail[sblk + 1] = tl;
                            }
                        }
                    }
                }
                if (i == 1) {
                    const float Z = lsum + __shfl_xor(lsum, 32);
                    inv_c = Z > 0.f ? 1.f / Z : 0.f;
                    lsum = 0.f;
                }
                if (i == 3) {
                    if (head == 0 && h2 == 0) stail[0] = 0.f;
                    __builtin_amdgcn_wave_barrier();
                    const int j8 = head * 2 + h2;
                    {
                        const f32x4 a = *(const f32x4*)(sown + 4 * j8), t4 = *(const f32x4*)(stail + 4 * j8);
                        f32x4 sc;
#pragma unroll
                        for (int q = 0; q < 4; ++q) {
                            const int sblk = 4 * j8 + q;
                            const bool forced = (sblk == 0) || (sblk == cur) || (sblk == cur - 1);
                            sc[q] = forced ? 1.0e4f : (sblk <= cur ? a[q] + t4[q] : -1.0f);
                        }
                        *(f32x4*)(ssc + 4 * j8) = sc;
                    }
                    __builtin_amdgcn_wave_barrier();
                    const f32x4 own = *(const f32x4*)(ssc + 4 * j8);
                    int rk0 = 0, rk1 = 0, rk2 = 0, rk3 = 0;
                    const int so0 = 4 * j8;
#pragma unroll
                    for (int m4 = 0; m4 < 8; ++m4) {
                        const f32x4 v = *(const f32x4*)(ssc + 4 * m4);
#pragma unroll
                        for (int q = 0; q < 4; ++q) {
                            const int sm = 4 * m4 + q;
                            const float vm = v[q];
                            rk0 += (vm > own[0] || (vm == own[0] && sm < so0)) ? 1 : 0;
                            rk1 += (vm > own[1] || (vm == own[1] && sm < so0 + 1)) ? 1 : 0;
                            rk2 += (vm > own[2] || (vm == own[2] && sm < so0 + 2)) ? 1 : 0;
                            rk3 += (vm > own[3] || (vm == own[3] && sm < so0 + 3)) ? 1 : 0;
                        }
                    }
                    unsigned mk = ((rk0 < 8 ? 1u : 0u) | (rk1 < 8 ? 2u : 0u) | (rk2 < 8 ? 4u : 0u) | (rk3 < 8 ? 8u : 0u)) << so0;
                    mk |= __shfl_xor(mk, 8); mk |= __shfl_xor(mk, 16); mk |= __shfl_xor(mk, 32);
                    selmask = mk;
                    __builtin_amdgcn_wave_barrier();
                    finalize(gate_c, true);
                }
            } else {
                const bool isw = i < 4 + nW;
                const int kb = isw ? wlo + i - 4 : i - 4 - nW;
                const bool sel = isw ? true : ((selmask >> kb) & 1u) != 0;
                if (__ballot(sel) != 0ull) {
                    const int dhi = isw ? 512 : 0x7fffffff;
#pragma unroll 1
                    for (int kt2 = 0; kt2 < 2; ++kt2) {
                        f32x16 S = qk(kt2);
                        const int d0 = tq - (64 * kb + 32 * kt2 + 4 * h2);
                        const float* lp = lutp + (d0 - 27);
#pragma unroll
                        for (int r = 0; r < 16; ++r) {
                            const int cr = (r & 3) + 8 * (r >> 2);
                            const int dist = d0 - cr;
                            const float bias = lp[27 - cr];
                            const bool valid = sel && dist >= 0 && dist < dhi;
                            S[r] = __builtin_amdgcn_exp2f(S[r] + bias + (valid ? 0.f : -INFINITY));
                            lsum += S[r];
                        }
                        pv(kt2, S);
                    }
                }
                if (i == 3 + nW) finalize(gate_w, false);
            }
        }
        finalize(gate_s, false);
        {
            bf16_t* op = Og + rowtok * 1024 + (g * 4 + head) * 64 + 4 * h2;
#pragma unroll
            for (int rq = 0; rq < 4; ++rq) {
                uint2 o0; o0.x = pack2(OUT0[4 * rq], OUT0[4 * rq + 1]); o0.y = pack2(OUT0[4 * rq + 2], OUT0[4 * rq + 3]);
                uint2 o1; o1.x = pack2(OUT1[4 * rq], OUT1[4 * rq + 1]); o1.y = pack2(OUT1[4 * rq + 2], OUT1[4 * rq + 3]);
                *(uint2*)(op + 8 * rq) = o0;
                *(uint2*)(op + 32 + 8 * rq) = o1;
            }
        }
    }
}

__device__ __forceinline__ void phase_outproj(const Params& p, const Ctx& cx, char* lds, const bf16_t* A, const bf16_t* Bt, const float* xin, int ls) {
    const float* mod = (const float*)(p.ws + OFF_MOD);
    float* xo = p.out;
    gemm_phase_dense(A, 1024, Bt, 1024, NTOK / 128, 8, lds, cx, [=](int row0, int col0) {
        return [=](f32x4 (&acc)[4][4], int wr, int wc, int fr, int fq) {
#pragma unroll
            for (int m = 0; m < 4; ++m) {
                const int row = row0 + wr * 64 + m * 16 + fr, b = row >> 11;
                const float* gate = mod + ((size_t)ls * 16 + b) * 3072 + 2048;
#pragma unroll
                for (int n = 0; n < 4; ++n) {
                    const int col = col0 + wc * 64 + n * 16 + fq * 4;
                    f32x4 g = *(const f32x4*)(gate + col);
                    f32x4 xi = *(const f32x4*)(xin + (size_t)row * 1024 + col);
                    f32x4 o;
#pragma unroll
                    for (int j = 0; j < 4; ++j) o[j] = xi[j] + g[j] * acc[m][n][j];
                    *(f32x4*)(xo + (size_t)row * 1024 + col) = o;
                }
            }
        };
    });
}

__device__ __forceinline__ void moe_tables(const Params& p, int layer, char* lds, int tid, int* s_cnt, int* s_off, int* s_toff) {
    if (tid == 0) {
        const int* cnt = (const int*)(p.ws + OFF_CNT) + layer * 16;
        int o = 0, to = 0;
        for (int e = 0; e < 16; ++e) { const int c = cnt[e]; s_cnt[e] = c; s_off[e] = o; s_toff[e] = to; o += c; to += ((c + 127) >> 7) * 8; }
        s_off[16] = o; s_toff[16] = to;
    }
    __syncthreads();
}

__device__ __forceinline__ void phase_moe_up(const Params& p, const Ctx& cx, char* lds, int layer) {
    const int tid = cx.tid;
    int* s_cnt = (int*)(lds + 32768); int* s_off = s_cnt + 16; int* s_toff = s_off + 17;
    moe_tables(p, layer, lds, tid, s_cnt, s_off, s_toff);
    const int ntiles = s_toff[16];
    const bf16_t* hA = (const bf16_t*)(p.ws + OFF_HA);
    const int* ltok = (const int*)(p.ws + OFF_LTOK);
    bf16_t* H1 = (bf16_t*)(p.ws + OFF_H1);
    for (int tile = cx.vbid; tile < ntiles; tile += cx.G) {
        int e = 0;
        while (tile >= s_toff[e + 1]) ++e;
        const int lt = tile - s_toff[e], rt = lt >> 3, ct = lt & 7, cnt = s_cnt[e], off = s_off[e];
        const int p0 = min(rt * 128 + (tid >> 2), cnt - 1), p1 = min(rt * 128 + (tid >> 2) + 64, cnt - 1);
        const bf16_t* a0 = hA + (size_t)ltok[(size_t)e * NTOK + p0] * 1024 + (tid & 3) * 8;
        const bf16_t* a1 = hA + (size_t)ltok[(size_t)e * NTOK + p1] * 1024 + (tid & 3) * 8;
        const bf16_t* b0 = (const bf16_t*)(p.ws + OFF_W_UP) + ((size_t)(layer * 16 + e) * 1024 + ct * 128 + (tid >> 2)) * 1024 + (tid & 3) * 8;
        const bf16_t* b1 = b0 + (size_t)64 * 1024;
        gemm_tile(a0, a1, b0, b1, 1024, lds, cx, [=](f32x4 (&acc)[4][4], int wr, int wc, int fr, int fq) {
#pragma unroll
            for (int m = 0; m < 4; ++m) {
                const int pos = rt * 128 + wr * 64 + m * 16 + fr;
                if (pos < cnt) {
                    bf16_t* dst = H1 + (size_t)(off + pos) * 512 + ct * 64 + wc * 32 + fq * 4;
#pragma unroll
                    for (int n = 0; n < 2; ++n) {
                        float h[4];
#pragma unroll
                        for (int j = 0; j < 4; ++j) h[j] = silu_f(acc[m][n][j]) * acc[m][n + 2][j];
                        uint2 o; o.x = pack2(h[0], h[1]); o.y = pack2(h[2], h[3]);
                        *(uint2*)(dst + n * 16) = o;
                    }
                }
            }
        });
    }
}

__device__ __forceinline__ void phase_moe_down(const Params& p, const Ctx& cx, char* lds, int layer) {
    const int tid = cx.tid;
    int* s_cnt = (int*)(lds + 32768); int* s_off = s_cnt + 16; int* s_toff = s_off + 17;
    moe_tables(p, layer, lds, tid, s_cnt, s_off, s_toff);
    const int ntiles = s_toff[16];
    const bf16_t* H1 = (const bf16_t*)(p.ws + OFF_H1);
    const float* lw = (const float*)(p.ws + OFF_LW);
    bf16_t* Y = (bf16_t*)(p.ws + OFF_Y);
    for (int tile = cx.vbid; tile < ntiles; tile += cx.G) {
        int e = 0;
        while (tile >= s_toff[e + 1]) ++e;
        const int lt = tile - s_toff[e], rt = lt >> 3, ct = lt & 7, cnt = s_cnt[e], off = s_off[e];
        const int p0 = min(rt * 128 + (tid >> 2), cnt - 1), p1 = min(rt * 128 + (tid >> 2) + 64, cnt - 1);
        const bf16_t* a0 = H1 + (size_t)(off + p0) * 512 + (tid & 3) * 8;
        const bf16_t* a1 = H1 + (size_t)(off + p1) * 512 + (tid & 3) * 8;
        const bf16_t* b0 = (const bf16_t*)(p.ws + OFF_W_DN) + ((size_t)(layer * 16 + e) * 1024 + ct * 128 + (tid >> 2)) * 512 + (tid & 3) * 8;
        const bf16_t* b1 = b0 + (size_t)64 * 512;
        gemm_tile(a0, a1, b0, b1, 512, lds, cx, [=](f32x4 (&acc)[4][4], int wr, int wc, int fr, int fq) {
#pragma unroll
            for (int m = 0; m < 4; ++m) {
                const int pos = rt * 128 + wr * 64 + m * 16 + fr;
                if (pos < cnt) {
                    const float w = lw[(size_t)e * NTOK + pos];
                    bf16_t* dst = Y + (size_t)(off + pos) * 1024 + ct * 128 + wc * 64 + fq * 4;
#pragma unroll
                    for (int n = 0; n < 4; ++n) {
                        uint2 o; o.x = pack2(w * acc[m][n][0], w * acc[m][n][1]); o.y = pack2(w * acc[m][n][2], w * acc[m][n][3]);
                        *(uint2*)(dst + n * 16) = o;
                    }
                }
            }
        });
    }
}

__device__ __forceinline__ void phase_hgrn_inproj(const Params& p, const Ctx& cx, char* lds) {
    const bf16_t* A = (const bf16_t*)(p.ws + OFF_HA);
    const bf16_t* Bt = (const bf16_t*)(p.ws + OFF_W_HG_IN);
    char* ws = p.ws;
    const float* lb = (const float*)(p.ws + OFF_LB);
    gemm_phase_dense(A, 1024, Bt, 1024, NTOK / 128, 32, lds, cx, [=](int row0, int col0) {
        return [=](f32x4 (&acc)[4][4], int wr, int wc, int fr, int fq) {
            const int gc0 = col0 + wc * 64, seg = gc0 >> 10, c0 = gc0 & 1023;
#pragma unroll
            for (int m = 0; m < 4; ++m) {
                const int row = row0 + wr * 64 + m * 16 + fr;
#pragma unroll
                for (int n = 0; n < 4; ++n) {
                    const int c = c0 + n * 16 + fq * 4;
                    if (seg == 1) {
                        f32x4 l4 = *(const f32x4*)(lb + c), o;
#pragma unroll
                        for (int j = 0; j < 4; ++j) o[j] = __logf(l4[j] + (1.f - l4[j]) * sigmoid_f(acc[m][n][j]));
                        *(f32x4*)((float*)(ws + OFF_LF) + (size_t)row * 1024 + c) = o;
                    } else {
                        float h[4];
#pragma unroll
                        for (int j = 0; j < 4; ++j) h[j] = (seg == 2) ? acc[m][n][j] : silu_f(acc[m][n][j]);
                        uint2 o; o.x = pack2(h[0], h[1]); o.y = pack2(h[2], h[3]);
                        bf16_t* dst = (bf16_t*)(ws + (seg == 0 ? OFF_QH : seg == 2 ? OFF_V : OFF_G));
                        *(uint2*)(dst + (size_t)row * 1024 + c) = o;
                    }
                }
            }
        };
    });
}

constexpr int HG_QD_OFF = 0, HG_KD_OFF = 8704, HG_K2T_OFF = 17408, HG_VT_OFF = 27648, HG_O_OFF = 37888, HG_DEC_OFF = 54784, HG_TOT_OFF = 55296;
constexpr int HG_ROW = 272, HG_TROW = 80, HG_OROW = 528;
static_assert(HG_TOT_OFF + 1024 <= LDS_BYTES, "hgrn LDS");

__device__ __forceinline__ void phase_hgrn_rec(const Params& p, const Ctx& cx, char* lds) {
    const int tid = cx.tid, lane = cx.lane, wid = cx.wid;
    const int l31 = lane & 31, h2 = lane >> 5;
    const int widu = __builtin_amdgcn_readfirstlane(cx.wid);
    const int d0 = 2 * lane;
    const bf16_t* QH = (const bf16_t*)(p.ws + OFF_QH);
    const float* LF = (const float*)(p.ws + OFF_LF);
    const bf16_t* V = (const bf16_t*)(p.ws + OFF_V);
    bf16_t* OR = (bf16_t*)(p.ws + OFF_HA);
    float* dec = (float*)(lds + HG_DEC_OFF);
    float* tot = (float*)(lds + HG_TOT_OFF);
    for (int item = cx.vbid; item < 128; item += cx.G) {
        const int b = item >> 3, h = item & 7;
        f32x16 S0, S1, S2, S3;
#pragma unroll
        for (int r = 0; r < 16; ++r) { S0[r] = 0.f; S1[r] = 0.f; S2[r] = 0.f; S3[r] = 0.f; }
        f2_t lf[8]; unsigned qv[8], vv[8];
        const size_t gbase = (size_t)(b * SEQ + widu * 8) * 1024 + h * 128;
#pragma unroll
        for (int i = 0; i < 8; ++i) {
            lf[i] = *(const f2_t*)(LF + gbase + (size_t)i * 1024 + d0);
            qv[i] = *(const unsigned*)(QH + gbase + (size_t)i * 1024 + d0);
            vv[i] = *(const unsigned*)(V + gbase + (size_t)i * 1024 + d0);
        }
        for (int c = 0; c < SEQ / 32; ++c) {
            f2_t run = {0.f, 0.f};
#pragma unroll
            for (int i = 0; i < 8; ++i) run += lf[i];
            *(f2_t*)(tot + wid * 128 + d0) = run;
            __syncthreads();
            f2_t pre = {0.f, 0.f}, last = {0.f, 0.f};
#pragma unroll
            for (int q = 0; q < 4; ++q) {
                const f2_t tq_ = *(const f2_t*)(tot + q * 128 + d0);
                last += tq_;
                if (q < widu) pre += tq_;
            }
            if (widu == 0) { f2_t dv; dv.x = __expf(last.x); dv.y = __expf(last.y); *(f2_t*)(dec + d0) = dv; }
            {
                float k2a[8], k2b[8];
                f2_t rc = pre;
#pragma unroll
                for (int i = 0; i < 8; ++i) {
                    rc += lf[i];
                    const float cu0 = rc.x, cu1 = rc.y;
                    const float kk0 = 1.f - __expf(lf[i].x), kk1 = 1.f - __expf(lf[i].y);
                    const float q0 = bf2f((unsigned short)(qv[i] & 0xffff)) * __expf(cu0), q1 = bf2f((unsigned short)(qv[i] >> 16)) * __expf(cu1);
                    const float kd0 = kk0 * __expf(-cu0), kd1 = kk1 * __expf(-cu1);
                    k2a[i] = kk0 * __expf(last.x - cu0); k2b[i] = kk1 * __expf(last.y - cu1);
                    const int tl = wid * 8 + i;
                    *(unsigned*)(lds + HG_QD_OFF + tl * HG_ROW + d0 * 2) = pack2(q0, q1);
                    *(unsigned*)(lds + HG_KD_OFF + tl * HG_ROW + d0 * 2) = pack2(kd0, kd1);
                }
                uint4 a, bq, va, vb;
                a.x = pack2(k2a[0], k2a[1]); a.y = pack2(k2a[2], k2a[3]); a.z = pack2(k2a[4], k2a[5]); a.w = pack2(k2a[6], k2a[7]);
                bq.x = pack2(k2b[0], k2b[1]); bq.y = pack2(k2b[2], k2b[3]); bq.z = pack2(k2b[4], k2b[5]); bq.w = pack2(k2b[6], k2b[7]);
                va.x = (vv[0] & 0xffffu) | (vv[1] << 16); va.y = (vv[2] & 0xffffu) | (vv[3] << 16); va.z = (vv[4] & 0xffffu) | (vv[5] << 16); va.w = (vv[6] & 0xffffu) | (vv[7] << 16);
                vb.x = (vv[0] >> 16) | (vv[1] & 0xffff0000u); vb.y = (vv[2] >> 16) | (vv[3] & 0xffff0000u); vb.z = (vv[4] >> 16) | (vv[5] & 0xffff0000u); vb.w = (vv[6] >> 16) | (vv[7] & 0xffff0000u);
                *(uint4*)(lds + HG_K2T_OFF + d0 * HG_TROW + wid * 16) = a;
                *(uint4*)(lds + HG_K2T_OFF + (d0 + 1) * HG_TROW + wid * 16) = bq;
                *(uint4*)(lds + HG_VT_OFF + d0 * HG_TROW + wid * 16) = va;
                *(uint4*)(lds + HG_VT_OFF + (d0 + 1) * HG_TROW + wid * 16) = vb;
            }
            __builtin_amdgcn_sched_barrier(0);
            if (c + 1 < SEQ / 32) {
                const size_t gn = gbase + (size_t)(c + 1) * 32 * 1024;
#pragma unroll
                for (int i = 0; i < 8; ++i) {
                    lf[i] = *(const f2_t*)(LF + gn + (size_t)i * 1024 + d0);
                    qv[i] = *(const unsigned*)(QH + gn + (size_t)i * 1024 + d0);
                    vv[i] = *(const unsigned*)(V + gn + (size_t)i * 1024 + d0);
                }
            }
            __syncthreads();
            f32x16 X;
#pragma unroll
            for (int r = 0; r < 16; ++r) X[r] = 0.f;
            {
                const char* ka = lds + HG_KD_OFF + l31 * HG_ROW + 16 * h2;
                const char* qa = lds + HG_QD_OFF + l31 * HG_ROW + 16 * h2;
#pragma unroll 2
                for (int ks = 0; ks < 8; ++ks) X = MFMA32(*(const bf16x8*)(ka + 32 * ks), *(const bf16x8*)(qa + 32 * ks), X);
#pragma unroll
                for (int r = 0; r < 16; ++r) { const int srow = (r & 3) + 8 * (r >> 2) + 4 * h2; X[r] = (srow <= l31) ? X[r] : 0.f; }
            }
            f32x16 Oa;
#pragma unroll
            for (int r = 0; r < 16; ++r) Oa[r] = 0.f;
            const int jrow = 32 * wid + l31;
#pragma unroll
            for (int s2 = 0; s2 < 2; ++s2) {
                uint4 xk;
                xk.x = pack2(X[8 * s2], X[8 * s2 + 1]); xk.y = pack2(X[8 * s2 + 2], X[8 * s2 + 3]); xk.z = pack2(X[8 * s2 + 4], X[8 * s2 + 5]); xk.w = pack2(X[8 * s2 + 6], X[8 * s2 + 7]);
                const char* va = lds + HG_VT_OFF + jrow * HG_TROW + (16 * s2 + 4 * h2) * 2;
                const uint2 lo = *(const uint2*)va, hi = *(const uint2*)(va + 16);
                uint4 vb; vb.x = lo.x; vb.y = lo.y; vb.z = hi.x; vb.w = hi.y;
                Oa = MFMA32(__builtin_bit_cast(bf16x8, xk), __builtin_bit_cast(bf16x8, vb), Oa);
            }
            auto qs_term = [&](const f32x16& St, int dt) {
#pragma unroll
                for (int s2 = 0; s2 < 2; ++s2) {
                    uint4 sk;
                    sk.x = pack2(St[8 * s2], St[8 * s2 + 1]); sk.y = pack2(St[8 * s2 + 2], St[8 * s2 + 3]); sk.z = pack2(St[8 * s2 + 4], St[8 * s2 + 5]); sk.w = pack2(St[8 * s2 + 6], St[8 * s2 + 7]);
                    const char* qa = lds + HG_QD_OFF + l31 * HG_ROW + (32 * dt + 16 * s2 + 4 * h2) * 2;
                    const uint2 lo = *(const uint2*)qa, hi = *(const uint2*)(qa + 16);
                    uint4 qb; qb.x = lo.x; qb.y = lo.y; qb.z = hi.x; qb.w = hi.y;
                    Oa = MFMA32(__builtin_bit_cast(bf16x8, qb), __builtin_bit_cast(bf16x8, sk), Oa);
                }
            };
            __builtin_amdgcn_sched_barrier(0);
            qs_term(S0, 0); qs_term(S1, 1);
            __builtin_amdgcn_sched_barrier(0);
            qs_term(S2, 2); qs_term(S3, 3);
            __builtin_amdgcn_sched_barrier(0);
            {
                bf16_t* orow = OR + (size_t)(b * SEQ + c * 32 + 4 * h2) * 1024 + h * 128 + jrow;
#pragma unroll
                for (int r = 0; r < 16; ++r) orow[(size_t)((r & 3) + 8 * (r >> 2)) * 1024] = f2bf(Oa[r]);
            }
            auto s_update = [&](f32x16& St, int dt) {
#pragma unroll
                for (int rq = 0; rq < 4; ++rq) {
                    const f32x4 dc = *(const f32x4*)(dec + 32 * dt + 8 * rq + 4 * h2);
                    St[4 * rq] *= dc[0]; St[4 * rq + 1] *= dc[1]; St[4 * rq + 2] *= dc[2]; St[4 * rq + 3] *= dc[3];
                }
#pragma unroll
                for (int s2 = 0; s2 < 2; ++s2) {
                    const bf16x8 ka = *(const bf16x8*)(lds + HG_K2T_OFF + (32 * dt + l31) * HG_TROW + (16 * s2 + 8 * h2) * 2);
                    const bf16x8 vb = *(const bf16x8*)(lds + HG_VT_OFF + jrow * HG_TROW + (16 * s2 + 8 * h2) * 2);
                    St = MFMA32(ka, vb, St);
                }
            };
            __builtin_amdgcn_sched_barrier(0);
            s_update(S0, 0); s_update(S1, 1);
            __builtin_amdgcn_sched_barrier(0);
            s_update(S2, 2); s_update(S3, 3);
            __builtin_amdgcn_sched_barrier(0);
        }
        __syncthreads();
    }
}

__device__ __forceinline__ void phase_hgrn_post(const Params& p, const Ctx& cx) {
    const int lane = cx.lane;
    const bf16_t* OR = (const bf16_t*)(p.ws + OFF_HA);
    const bf16_t* Gt = (const bf16_t*)(p.ws + OFF_G);
    bf16_t* OA = (bf16_t*)(p.ws + OFF_QH);
    const int col = lane * 16;
    float gn[16];
#pragma unroll
    for (int i = 0; i < 16; ++i) gn[i] = p.hgrn_out_gain[(col & 127) + i];
    for (int row = cx.vbid * 4 + cx.wid; row < NTOK; row += cx.G * 4) {
        const uint4 a0 = *(const uint4*)(OR + (size_t)row * 1024 + col), a1 = *(const uint4*)(OR + (size_t)row * 1024 + col + 8);
        const uint4 g0 = *(const uint4*)(Gt + (size_t)row * 1024 + col), g1 = *(const uint4*)(Gt + (size_t)row * 1024 + col + 8);
        const unsigned aw[8] = {a0.x, a0.y, a0.z, a0.w, a1.x, a1.y, a1.z, a1.w};
        const unsigned gw[8] = {g0.x, g0.y, g0.z, g0.w, g1.x, g1.y, g1.z, g1.w};
        float o[16];
        float ss = 0.f;
#pragma unroll
        for (int i = 0; i < 8; ++i) { o[2 * i] = bf2f((unsigned short)(aw[i] & 0xffff)); o[2 * i + 1] = bf2f((unsigned short)(aw[i] >> 16)); ss += o[2 * i] * o[2 * i] + o[2 * i + 1] * o[2 * i + 1]; }
        ss += __shfl_xor(ss, 1); ss += __shfl_xor(ss, 2); ss += __shfl_xor(ss, 4);
        const float r = rsqrtf(ss * (1.f / 128.f) + EPS);
        unsigned w[8];
#pragma unroll
        for (int i = 0; i < 8; ++i)
            w[i] = pack2(o[2 * i] * r * gn[2 * i] * bf2f((unsigned short)(gw[i] & 0xffff)), o[2 * i + 1] * r * gn[2 * i + 1] * bf2f((unsigned short)(gw[i] >> 16)));
        uint4 o0, o1; o0.x = w[0]; o0.y = w[1]; o0.z = w[2]; o0.w = w[3]; o1.x = w[4]; o1.y = w[5]; o1.z = w[6]; o1.w = w[7];
        *(uint4*)(OA + (size_t)row * 1024 + col) = o0;
        *(uint4*)(OA + (size_t)row * 1024 + col + 8) = o1;
    }
}


#define XB_TMO      128
#define XB_XCNT(j)  (256  + 64 * (j))
#define XB_XSUB(j)  (1280 + 64 * (j))
#define XB_XGEN(j)  (2304 + 64 * (j))
#define XB_TOP      3328
#define XB_TOPGEN   3392
#define XCD_BAR_WORDS 3456
#define XB_SPIN_CAP (1u << 20)
#define LAS __attribute__((address_space(3)))
__device__ __forceinline__ unsigned xb_ld(unsigned* p)              { return __hip_atomic_load(p, __ATOMIC_RELAXED, __HIP_MEMORY_SCOPE_AGENT); }
__device__ __forceinline__ unsigned xb_add(unsigned* p, unsigned v) { return __hip_atomic_fetch_add(p, v, __ATOMIC_RELAXED, __HIP_MEMORY_SCOPE_AGENT); }
__device__ __forceinline__ unsigned xb_xcc_id() { return (unsigned)__builtin_amdgcn_s_getreg((3 << 11) | 20) & 0xFu; }
#define XB_SPIN(cond, bar) do { unsigned _sp = 0; while (cond) { __builtin_amdgcn_s_sleep(1); \
    if ((++_sp & 255u) == 0u) { if (xb_ld(&(bar)[XB_TMO])) break; if (_sp > XB_SPIN_CAP) { atomicAdd(&(bar)[XB_TMO], 1u); break; } } } } while (0)
struct XcdBarrier { unsigned* bar; unsigned x; volatile unsigned* st; };
__device__ __forceinline__ XcdBarrier xcd_barrier_post(unsigned* bar, volatile unsigned* st) {
    XcdBarrier b; b.bar = bar; b.x = xb_xcc_id(); b.st = st;
    if (threadIdx.x == 0) (void)xb_add(&bar[XB_XCNT(b.x)], 1u);
    return b;
}
__device__ __forceinline__ void xcd_barrier_complete(unsigned* bar, unsigned x, unsigned& nloc, unsigned& nx) {
    const unsigned G = gridDim.x * gridDim.y * gridDim.z;
    unsigned sum, cnt, mine, sp = 0u;
    for (;;) {
        sum = 0u; cnt = 0u; mine = 0u;
#pragma unroll
        for (unsigned j = 0; j < 16; ++j) { const unsigned c = xb_ld(&bar[XB_XCNT(j)]); sum += c; cnt += (c > 0u) ? 1u : 0u; mine = (j == x) ? c : mine; }
        if (sum == G) break;
        __builtin_amdgcn_s_sleep(1);
        if ((++sp & 255u) == 0u) { if (xb_ld(&bar[XB_TMO])) break; if (sp > XB_SPIN_CAP) { atomicAdd(&bar[XB_TMO], 1u); break; } }
    }
    nloc = mine > 0u ? mine : 1u; nx = cnt > 0u ? cnt : 1u;
}
__device__ __forceinline__ void xcd_barrier(const XcdBarrier& b) {
    asm volatile("s_waitcnt vmcnt(0)" ::: "memory");
    __syncthreads();
    if (threadIdx.x == 0) {
        unsigned* bar = b.bar;
        __builtin_amdgcn_s_waitcnt(0);
        unsigned nloc = b.st[0], nx = b.st[1];
        if (nloc == 0u) { xcd_barrier_complete(bar, b.x, nloc, nx); b.st[0] = nloc; b.st[1] = nx; }
        const unsigned old = xb_add(&bar[XB_XSUB(b.x)], 1u);
        const unsigned gen = old / nloc;
        if (old + 1u == (gen + 1u) * nloc) {
            __builtin_amdgcn_fence(__ATOMIC_RELEASE, "agent");
            asm volatile("s_waitcnt vmcnt(0)" ::: "memory");
            const unsigned og = xb_add(&bar[XB_TOP], 1u);
            const unsigned tg = og / nx;
            if (og + 1u == (tg + 1u) * nx) xb_add(&bar[XB_TOPGEN], 1u);
            else XB_SPIN(xb_ld(&bar[XB_TOPGEN]) == tg, bar);
            __builtin_amdgcn_fence(__ATOMIC_ACQUIRE, "agent");
            xb_add(&bar[XB_XGEN(b.x)], 1u);
            asm volatile("s_waitcnt vmcnt(0)" ::: "memory");
        } else {
            XB_SPIN(xb_ld(&bar[XB_XGEN(b.x)]) == gen, bar);
            __builtin_amdgcn_fence(__ATOMIC_ACQUIRE, "agent");
            asm volatile("s_waitcnt vmcnt(0)" ::: "memory");
        }
    }
    __syncthreads();
}

template <int PH>
__device__ __forceinline__ void run_phase(const Params& p, const Ctx& cx, char* lds) {
    if constexpr (PH == 0) phase0(p, cx, lds);
    else if constexpr (PH == 1) rows_phase<false, true, false>(p, cx, lds, p.x, nullptr, 0, 0, 0, 0);
    else if constexpr (PH == 2) phase_nsa_inproj(p, cx, lds);
    else if constexpr (PH == 3) phase_cmp1(p, cx, lds);
    else if constexpr (PH == 4) phase_cmp2(p, cx);
    else if constexpr (PH == 5) phase_attn(p, cx, lds);
    else if constexpr (PH == 6) phase_outproj(p, cx, lds, (const bf16_t*)(p.ws + OFF_HA), (const bf16_t*)(p.ws + OFF_W_NSA_OUT), p.x, 0);
    else if constexpr (PH == 7) rows_router_phase(p, cx, lds, p.out, 1, 0);
    else if constexpr (PH == 8) phase_moe_up(p, cx, lds, 0);
    else if constexpr (PH == 9) phase_moe_down(p, cx, lds, 0);
    else if constexpr (PH == 10) rows_phase<true, true, false>(p, cx, lds, p.out, p.out, 1, 2, 0, 0);
    else if constexpr (PH == 11) phase_hgrn_inproj(p, cx, lds);
    else if constexpr (PH == 12) phase_hgrn_rec(p, cx, lds);
    else if constexpr (PH == 13) phase_hgrn_post(p, cx);
    else if constexpr (PH == 14) phase_outproj(p, cx, lds, (const bf16_t*)(p.ws + OFF_QH), (const bf16_t*)(p.ws + OFF_W_HG_OUT), p.out, 2);
    else if constexpr (PH == 15) rows_router_phase(p, cx, lds, p.out, 3, 1);
    else if constexpr (PH == 16) phase_moe_up(p, cx, lds, 1);
    else if constexpr (PH == 17) phase_moe_down(p, cx, lds, 1);
    else if constexpr (PH == 18) rows_phase<true, false, false>(p, cx, lds, p.out, p.out, 3, 0, 0, 1);
}

__device__ __forceinline__ Ctx make_ctx() {
    Ctx cx;
    cx.G = gridDim.x; cx.tid = threadIdx.x; cx.wid = threadIdx.x >> 6; cx.lane = threadIdx.x & 63;
    cx.vbid = (cx.G % 8 == 0) ? (blockIdx.x % 8) * (cx.G / 8) + blockIdx.x / 8 : blockIdx.x;
    return cx;
}

#if MULTI_LAUNCH
template <int PH>
__global__ void __launch_bounds__(256, 2) phase_kernel(Params p) {
    __shared__ __attribute__((aligned(16))) char lds[LDS_BYTES];
    const Ctx cx = make_ctx();
    run_phase<PH>(p, cx, lds);
}
template <int PH>
static void launch_phases(const Params& p, int grid, hipStream_t stream) {
    hipLaunchKernelGGL(phase_kernel<PH>, dim3(grid), dim3(256), 0, stream, p);
    if constexpr (PH + 1 < NPHASE) launch_phases<PH + 1>(p, grid, stream);
}
#else
template <int PH>
__device__ __forceinline__ void run_from(const Params& p, const Ctx& cx, char* lds, cg::grid_group& grid, const XcdBarrier& xb) {
    run_phase<PH>(p, cx, lds);
#ifdef PROBE_MASK
    if constexpr ((PROBE_MASK >> PH) & 1) { xcd_barrier(xb); run_phase<PH>(p, cx, lds); }
#endif
    if constexpr (PH + 1 < NPHASE) {
        if constexpr (PH == 0) grid.sync();
        else xcd_barrier(xb);
        run_from<PH + 1>(p, cx, lds, grid, xb);
    }
}
__global__ void __launch_bounds__(256, 2) mega_kernel(Params p) {
    __shared__ __attribute__((aligned(16))) char lds[LDS_BYTES];
    cg::grid_group grid = cg::this_grid();
    const Ctx cx = make_ctx();
    volatile unsigned* st = (volatile unsigned*)(lds + LDS_BYTES - 16);
    if (threadIdx.x == 0) { st[0] = 0u; st[1] = 0u; }
    __syncthreads();
    const XcdBarrier xb = xcd_barrier_post((unsigned*)(p.ws + OFF_BAR), st);
    run_from<0>(p, cx, lds, grid, xb);
}
#endif

extern "C" void kernel_launch(void* const* d_in, const int* in_sizes, int n_in, void* d_out, int out_size, void* d_ws, size_t ws_size,
                              hipStream_t stream) {
    static int grid = 0;
    if (!grid) {
        int dev = 0, cus = 0, per_cu = 0;
        (void)hipGetDevice(&dev);
        (void)hipDeviceGetAttribute(&cus, hipDeviceAttributeMultiprocessorCount, dev);
#if MULTI_LAUNCH
        per_cu = 2;
#else
        (void)hipOccupancyMaxActiveBlocksPerMultiprocessor(&per_cu, mega_kernel, 256, 0);
        if (per_cu > 2) per_cu = 2;
        if (per_cu < 1) per_cu = 1;
#endif
        if (cus <= 0) cus = 256;
        grid = cus * per_cu;
        if (ws_size < WS_NEED) fprintf(stderr, "kernel_launch: workspace too small: %zu < %zu\n", ws_size, (size_t)WS_NEED);
    }
    Params p{};
    p.x = (const float*)d_in[0]; p.c = (const float*)d_in[1]; p.ada_w = (const float*)d_in[2]; p.ada_b = (const float*)d_in[3];
    p.norm_g = (const float*)d_in[4]; p.rel_bias = (const float*)d_in[5]; p.nsa_w_in = (const float*)d_in[6]; p.nsa_q_gain = (const float*)d_in[7];
    p.nsa_k_gain = (const float*)d_in[8]; p.nsa_cmp_pe = (const float*)d_in[9]; p.nsa_cmp_w1 = (const float*)d_in[10]; p.nsa_cmp_w2 = (const float*)d_in[11];
    p.nsa_w_out = (const float*)d_in[12]; p.hgrn_w_in = (const float*)d_in[13]; p.hgrn_lb = (const float*)d_in[14]; p.hgrn_out_gain = (const float*)d_in[15];
    p.hgrn_w_out = (const float*)d_in[16]; p.moe_rg = (const float*)d_in[17]; p.moe_re = (const float*)d_in[18]; p.moe_w1 = (const float*)d_in[19];
    p.moe_w3 = (const float*)d_in[20]; p.moe_w2 = (const float*)d_in[21];
    p.out = (float*)d_out; p.ws = (char*)d_ws;
#if MULTI_LAUNCH
    launch_phases<0>(p, grid, stream);
#else
    p.p_begin = 0; p.p_end = NPHASE;
    (void)hipMemsetAsync((char*)d_ws + OFF_BAR, 0, XCD_BAR_WORDS * 4, stream);
    void* args[] = {&p};
    hipError_t e = hipLaunchCooperativeKernel((void*)mega_kernel, dim3(grid), dim3(256), args, 0, stream);
    if (e != hipSuccess) fprintf(stderr, "cooperative launch failed: %s (grid %d)\n", hipGetErrorString(e), grid);
#endif
}
```

```cpp
#include <hip/hip_runtime.h>
#include <hip/hip_cooperative_groups.h>
#include <cstdio>
#include <cstdint>
namespace cg = cooperative_groups;

#ifndef MULTI_LAUNCH
#define MULTI_LAUNCH 0
#endif

typedef unsigned short bf16_t;
typedef short bf16x8 __attribute__((ext_vector_type(8)));
typedef float f32x4 __attribute__((ext_vector_type(4)));
typedef float f32x16 __attribute__((ext_vector_type(16)));

constexpr int NTOK = 32768, DM = 1024, SEQ = 2048, NBATCH = 16;
constexpr int NSA_IN = 2608, NSA_IN_PAD = 2688;
constexpr float EPS = 1e-6f;
constexpr size_t MiB = 1ull << 20;

constexpr size_t OFF_CNT = 0;
constexpr size_t OFF_MOD = 4096;
constexpr size_t OFF_LB = OFF_MOD + 786432;
constexpr size_t OFF_PEB = OFF_LB + 4096;
constexpr size_t OFF_BAR = 921600;
constexpr size_t OFF_W_NSA_IN = 1 * MiB;
constexpr size_t OFF_W_NSA_OUT = OFF_W_NSA_IN + 2688ull * 1024 * 2;
constexpr size_t OFF_W_HG_IN = OFF_W_NSA_OUT + 1024ull * 1024 * 2;
constexpr size_t OFF_W_HG_OUT = OFF_W_HG_IN + 4096ull * 1024 * 2;
constexpr size_t OFF_W_CMP1 = OFF_W_HG_OUT + 1024ull * 1024 * 2;
constexpr size_t OFF_W_UP = OFF_W_CMP1 + 2ull * 128 * 2048 * 2;
constexpr size_t OFF_W_DN = OFF_W_UP + 32ull * 1024 * 1024 * 2;
constexpr size_t OFF_W_END = OFF_W_DN + 32ull * 1024 * 512 * 2;
constexpr size_t OFF_HA = 116 * MiB;
static_assert(OFF_W_END <= OFF_HA, "weights overflow");
constexpr size_t OFF_SCR = 180 * MiB;
constexpr size_t OFF_Q = OFF_SCR;
constexpr size_t OFF_KCRAW = OFF_Q + 64 * MiB;
constexpr size_t OFF_VCRAW = OFF_KCRAW + 17 * MiB;
constexpr size_t OFF_KS = OFF_VCRAW + 17 * MiB;
constexpr size_t OFF_VS = OFF_KS + 16 * MiB;
constexpr size_t OFF_KW = OFF_VS + 16 * MiB;
constexpr size_t OFF_VW = OFF_KW + 16 * MiB;
constexpr size_t OFF_GATES = OFF_VW + 16 * MiB;
constexpr size_t OFF_T1 = OFF_GATES + 6 * MiB;
constexpr size_t OFF_KC = OFF_T1 + 4 * MiB;
constexpr size_t OFF_VC = OFF_KC + 1 * MiB;
constexpr size_t OFF_H1 = OFF_SCR;
constexpr size_t OFF_Y = OFF_H1 + 64 * MiB;
constexpr size_t OFF_LTOK = OFF_Y + 128 * MiB;
constexpr size_t OFF_LW = OFF_LTOK + 2 * MiB;
constexpr size_t OFF_TSLOT = OFF_LW + 2 * MiB;
constexpr size_t OFF_QH = OFF_SCR;
constexpr size_t OFF_LF = OFF_QH + 64 * MiB;
constexpr size_t OFF_V = OFF_LF + 128 * MiB;
constexpr size_t OFF_G = OFF_V + 64 * MiB;
constexpr size_t WS_NEED = OFF_G + 64 * MiB;
static_assert(WS_NEED <= 512 * MiB, "ws overflow");

constexpr int NTHR = 512, NWAVE = 8;
constexpr int GEMM_STAGE = 49152, GEMM_NSTAGE = 3;
constexpr int LDS_TAB_OFF = GEMM_STAGE * GEMM_NSTAGE;
constexpr int LDS_BYTES = LDS_TAB_OFF + 256 + 16;
constexpr int NPHASE = 19;

struct Params {
    const float *x, *c, *ada_w, *ada_b, *norm_g, *rel_bias, *nsa_w_in, *nsa_q_gain, *nsa_k_gain, *nsa_cmp_pe, *nsa_cmp_w1,
        *nsa_cmp_w2, *nsa_w_out, *hgrn_w_in, *hgrn_lb, *hgrn_out_gain, *hgrn_w_out, *moe_rg, *moe_re, *moe_w1, *moe_w3, *moe_w2;
    float* out;
    char* ws;
    int p_begin, p_end;
};

__device__ __forceinline__ float bf2f(unsigned short h) { return __uint_as_float((unsigned)h << 16); }
__device__ __forceinline__ unsigned short f2bf(float f) {
    unsigned u = __float_as_uint(f);
    u += 0x7fffu + ((u >> 16) & 1u);
    return (unsigned short)(u >> 16);
}
typedef __bf16 bf2_t __attribute__((ext_vector_type(2)));
typedef float f2_t __attribute__((ext_vector_type(2)));
__device__ __forceinline__ unsigned pack2(float a, float b) {
    f2_t v = {a, b};
    return __builtin_bit_cast(unsigned, __builtin_convertvector(v, bf2_t));
}
__device__ __forceinline__ float wave_sum(float v) {
#pragma unroll
    for (int o = 32; o; o >>= 1) v += __shfl_xor(v, o);
    return v;
}
__device__ __forceinline__ float wave_max(float v) {
#pragma unroll
    for (int o = 32; o; o >>= 1) v = fmaxf(v, __shfl_xor(v, o));
    return v;
}
__device__ __forceinline__ float silu_f(float x) { return x / (1.f + __expf(-x)); }
__device__ __forceinline__ float sigmoid_f(float x) { return 1.f / (1.f + __expf(-x)); }
__device__ __forceinline__ void glds16(const void* g, void* l) {
    __builtin_amdgcn_global_load_lds((const unsigned*)g, (unsigned*)l, 16, 0, 0);
}
__device__ __forceinline__ int t5_bucket(int n) {
    if (n < 16) return n;
    int b = 16;
    b += (n >= 21); b += (n >= 27); b += (n >= 35); b += (n >= 46); b += (n >= 59); b += (n >= 77); b += (n >= 99); b += (n >= 128);
    b += (n >= 166); b += (n >= 216); b += (n >= 280); b += (n >= 363); b += (n >= 470); b += (n >= 609); b += (n >= 790);
    return b;
}

struct Ctx {
    int G, vbid, tid, wid, lane;
};

constexpr int P0_MOD_ITEMS = 192;
constexpr int TS0 = 84 * 16, TS1 = 32 * 16, TS2 = 128 * 16, TS3 = 32 * 16, TS4 = 2 * 4 * 32, TS5 = 32 * 32 * 16, TS6 = 32 * 32 * 8;
constexpr int TC0 = 0, TC1 = TC0 + TS0, TC2 = TC1 + TS1, TC3 = TC2 + TS2, TC4 = TC3 + TS3, TC5 = TC4 + TS4, TC6 = TC5 + TS5, TC_END = TC6 + TS6;

struct TrJob { const float* src; int ld, c0, ncols_valid, k0; bf16_t* dst; int dstld; };
__device__ __forceinline__ void tr_load(const TrJob& j, float* tl, int htid) {
    const int k = htid >> 2, cc = (htid & 3) * 8;
    const float* s = j.src + (size_t)(j.k0 + k) * j.ld + j.c0 + cc;
#pragma unroll
    for (int i = 0; i < 8; ++i) tl[k * 33 + cc + i] = (j.c0 + cc + i < j.ncols_valid) ? s[i] : 0.f;
}
__device__ __forceinline__ void tr_store(const TrJob& j, const float* tl, int htid) {
    const int n = htid >> 3, kc = (htid & 7) * 8;
    uint4 o;
    o.x = pack2(tl[(kc + 0) * 33 + n], tl[(kc + 1) * 33 + n]); o.y = pack2(tl[(kc + 2) * 33 + n], tl[(kc + 3) * 33 + n]);
    o.z = pack2(tl[(kc + 4) * 33 + n], tl[(kc + 5) * 33 + n]); o.w = pack2(tl[(kc + 6) * 33 + n], tl[(kc + 7) * 33 + n]);
    *(uint4*)(j.dst + (size_t)n * j.dstld + kc) = o;
}
__device__ __forceinline__ TrJob tr_job(const Params& p, int tt) {
    TrJob j;
    if (tt < TC1) {
        const int nt = tt / 16, kt = tt % 16;
        j = {p.nsa_w_in, NSA_IN, nt * 32, NSA_IN, kt * 64, (bf16_t*)(p.ws + OFF_W_NSA_IN) + (size_t)nt * 32 * 1024 + kt * 64, 1024};
    } else if (tt < TC2) {
        const int u = tt - TC1, nt = u / 16, kt = u % 16;
        j = {p.nsa_w_out, 1024, nt * 32, 1024, kt * 64, (bf16_t*)(p.ws + OFF_W_NSA_OUT) + (size_t)nt * 32 * 1024 + kt * 64, 1024};
    } else if (tt < TC3) {
        const int u = tt - TC2, nt = u / 16, kt = u % 16;
        j = {p.hgrn_w_in, 4096, nt * 32, 4096, kt * 64, (bf16_t*)(p.ws + OFF_W_HG_IN) + (size_t)nt * 32 * 1024 + kt * 64, 1024};
    } else if (tt < TC4) {
        const int u = tt - TC3, nt = u / 16, kt = u % 16;
        j = {p.hgrn_w_out, 1024, nt * 32, 1024, kt * 64, (bf16_t*)(p.ws + OFF_W_HG_OUT) + (size_t)nt * 32 * 1024 + kt * 64, 1024};
    } else if (tt < TC5) {
        const int u = tt - TC4, kv = u / 128, r = u % 128, nt = r / 32, kt = r % 32;
        j = {p.nsa_cmp_w1 + (size_t)kv * 2048 * 64, 64, nt * 32, 64, kt * 64, (bf16_t*)(p.ws + OFF_W_CMP1) + ((size_t)kv * 128 + nt * 32) * 2048 + kt * 64, 2048};
    } else if (tt < TC6) {
        const int u = tt - TC5, le = u / 512, r = u % 512, gr = r / 16, kt = r % 16;
        const int t = gr >> 2, wc = (gr >> 1) & 1, which = gr & 1;
        const float* src = (which ? p.moe_w3 : p.moe_w1) + (size_t)le * 1024 * 512;
        j = {src, 512, (t * 2 + wc) * 32, 512, kt * 64, (bf16_t*)(p.ws + OFF_W_UP) + ((size_t)le * 1024 + gr * 32) * 1024 + kt * 64, 1024};
    } else {
        const int u = tt - TC6, le = u / 256, r = u % 256, nt = r / 8, kt = r % 8;
        j = {p.moe_w2 + (size_t)le * 512 * 1024, 1024, nt * 32, 1024, kt * 64, (bf16_t*)(p.ws + OFF_W_DN) + ((size_t)le * 1024 + nt * 32) * 512 + kt * 64, 512};
    }
    return j;
}

__device__ __forceinline__ void phase0(const Params& p, const Ctx& cx, char* lds) {
    const int tid = cx.tid, wid = cx.wid, lane = cx.lane;
    for (int it = cx.vbid; it < P0_MOD_ITEMS; it += cx.G) {
        const int colbase = it * 64, ls = colbase / 3072, e0 = colbase % 3072;
        const float* W = p.ada_w + (size_t)ls * 1024 * 3072 + e0 + lane;
        float* cs = (float*)lds + wid * 1024;
        float* red = (float*)lds + 8192;
        float acc[16];
#pragma unroll
        for (int b = 0; b < 16; ++b) acc[b] = 0.f;
        for (int sub = 0; sub < 2; ++sub) {
            const int kb = wid * 128 + sub * 64;
#pragma unroll
            for (int b = 0; b < 16; ++b) cs[lane * 16 + b] = silu_f(p.c[b * 1024 + kb + lane]);
            __builtin_amdgcn_wave_barrier();
            for (int kk = 0; kk < 64; ++kk) {
                const float w = W[(size_t)(kb + kk) * 3072];
                const f32x4* cv = (const f32x4*)(cs + kk * 16);
#pragma unroll
                for (int q = 0; q < 4; ++q) {
                    f32x4 c4 = cv[q];
                    acc[q * 4 + 0] += c4[0] * w; acc[q * 4 + 1] += c4[1] * w; acc[q * 4 + 2] += c4[2] * w; acc[q * 4 + 3] += c4[3] * w;
                }
            }
            __builtin_amdgcn_wave_barrier();
        }
#pragma unroll
        for (int b = 0; b < 16; ++b) red[(wid * 16 + b) * 64 + lane] = acc[b];
        __syncthreads();
        float* mod = (float*)(p.ws + OFF_MOD);
#pragma unroll
        for (int i = 0; i < 2; ++i) {
            const int o = tid + i * NTHR, b = o >> 6, e = o & 63;
            float sm = 0.f;
#pragma unroll
            for (int w = 0; w < 8; ++w) sm += red[(w * 16 + b) * 64 + e];
            mod[((size_t)ls * 16 + b) * 3072 + e0 + e] = sm + p.ada_b[ls * 3072 + e0 + e];
        }
        __syncthreads();
    }
    {
        const int half = tid >> 8, htid = tid & 255;
        float* tl = (float*)lds + half * (64 * 33);
        for (int base = cx.vbid * 2; base < TC_END; base += cx.G * 2) {
            const int tt = base + half;
            const bool on = tt < TC_END;
            TrJob j = tr_job(p, on ? tt : 0);
            if (on) tr_load(j, tl, htid);
            __syncthreads();
            if (on) tr_store(j, tl, htid);
            __syncthreads();
        }
    }
    if (cx.vbid == cx.G - 1) {
        float* lb = (float*)(p.ws + OFF_LB);
        for (int i = tid; i < 1024; i += NTHR) lb[i] = sigmoid_f(p.hgrn_lb[1024 + i] - p.hgrn_lb[i]);
        if (tid < 128) {
            const int kv = tid >> 6, d = tid & 63;
            const float* pe = p.nsa_cmp_pe + kv * 2048;
            const float* w1 = p.nsa_cmp_w1 + (size_t)kv * 2048 * 64 + d;
            float sm = 0.f;
            for (int k = 0; k < 2048; ++k) sm += pe[k] * w1[(size_t)k * 64];
            ((float*)(p.ws + OFF_PEB))[tid] = sm;
        }
        if (tid < 32) ((int*)(p.ws + OFF_CNT))[tid] = 0;
    }
}

template <bool COMBINE, bool NORM, bool ROUTER>
__device__ __forceinline__ void rows_phase(const Params& p, const Ctx& cx, char* lds, const float* __restrict__ src, float* __restrict__ xdst,
                           int ls_comb, int ls_norm, int layer_router, int layer_comb) {
    const int lane = cx.lane;
    const float* mod = (const float*)(p.ws + OFF_MOD);
    int my_off = 0;
    if (COMBINE) {
        const int* cnt = (const int*)(p.ws + OFF_CNT) + layer_comb * 16;
        int cv = (lane < 16) ? cnt[lane] : 0;
        int incl = cv;
#pragma unroll
        for (int o = 1; o < 16; o <<= 1) { int t = __shfl_up(incl, o); if (lane >= o) incl += t; }
        my_off = incl - cv;
    }
    for (int row = cx.vbid * NWAVE + cx.wid; row < NTOK; row += cx.G * NWAVE) {
        const int b = row >> 11;
        f32x4 v[4];
#pragma unroll
        for (int i = 0; i < 4; ++i) v[i] = *(const f32x4*)(src + (size_t)row * 1024 + (i * 64 + lane) * 4);
        if (COMBINE) {
            const int* ts = (const int*)(p.ws + OFF_TSLOT) + row * 2;
            const int s0 = ts[0], s1 = ts[1];
            const int r0 = __shfl(my_off, s0 >> 16) + (s0 & 0xffff), r1 = __shfl(my_off, s1 >> 16) + (s1 & 0xffff);
            const bf16_t* Y = (const bf16_t*)(p.ws + OFF_Y);
            const float* gate = mod + ((size_t)ls_comb * 16 + b) * 3072 + 2048;
#pragma unroll
            for (int i = 0; i < 4; ++i) {
                const int col = (i * 64 + lane) * 4;
                uint2 a = *(const uint2*)(Y + (size_t)r0 * 1024 + col), c = *(const uint2*)(Y + (size_t)r1 * 1024 + col);
                f32x4 g = *(const f32x4*)(gate + col);
                v[i][0] += g[0] * (bf2f(a.x & 0xffff) + bf2f(c.x & 0xffff));
                v[i][1] += g[1] * (bf2f(a.x >> 16) + bf2f(c.x >> 16));
                v[i][2] += g[2] * (bf2f(a.y & 0xffff) + bf2f(c.y & 0xffff));
                v[i][3] += g[3] * (bf2f(a.y >> 16) + bf2f(c.y >> 16));
                *(f32x4*)(xdst + (size_t)row * 1024 + col) = v[i];
            }
        }
        if (NORM) {
            float ss = 0.f;
#pragma unroll
            for (int i = 0; i < 4; ++i) ss += v[i][0] * v[i][0] + v[i][1] * v[i][1] + v[i][2] * v[i][2] + v[i][3] * v[i][3];
            ss = wave_sum(ss);
            const float r = rsqrtf(ss * (1.f / 1024.f) + EPS);
            const float* gain = p.norm_g + ls_norm * 1024;
            const float* shift = mod + ((size_t)ls_norm * 16 + b) * 3072;
            const float* scale = shift + 1024;
            bf16_t* hA = (bf16_t*)(p.ws + OFF_HA);
            f32x4 rg4 = {0.f, 0.f, 0.f, 0.f}, re0 = rg4, re1 = rg4, re2 = rg4, re3 = rg4;
#pragma unroll
            for (int i = 0; i < 4; ++i) {
                const int col = (i * 64 + lane) * 4;
                f32x4 g = *(const f32x4*)(gain + col), sc = *(const f32x4*)(scale + col), sh = *(const f32x4*)(shift + col);
                f32x4 h;
#pragma unroll
                for (int j = 0; j < 4; ++j) h[j] = v[i][j] * r * g[j] * (1.f + sc[j]) + sh[j];
                uint2 o; o.x = pack2(h[0], h[1]); o.y = pack2(h[2], h[3]);
                *(uint2*)(hA + (size_t)row * 1024 + col) = o;
                if (ROUTER) {
                    const float* rg = p.moe_rg + (size_t)layer_router * 1024 * 4;
                    const float* re = p.moe_re + (size_t)layer_router * 1024 * 16;
#pragma unroll
                    for (int j = 0; j < 4; ++j) {
                        rg4 += h[j] * *(const f32x4*)(rg + (col + j) * 4);
                        re0 += h[j] * *(const f32x4*)(re + (col + j) * 16 + 0);
                        re1 += h[j] * *(const f32x4*)(re + (col + j) * 16 + 4);
                        re2 += h[j] * *(const f32x4*)(re + (col + j) * 16 + 8);
                        re3 += h[j] * *(const f32x4*)(re + (col + j) * 16 + 12);
                    }
                }
            }
            if (ROUTER) {
                float rl[4];
                f32x4 rs0, rs1, rs2, rs3;
#pragma unroll
                for (int j = 0; j < 4; ++j) { rl[j] = wave_sum(rg4[j]); rs0[j] = wave_sum(re0[j]); rs1[j] = wave_sum(re1[j]); rs2[j] = wave_sum(re2[j]); rs3[j] = wave_sum(re3[j]); }
                float gm = fmaxf(fmaxf(rl[0], rl[1]), fmaxf(rl[2], rl[3]));
                float e0 = __expf(rl[0] - gm), e1 = __expf(rl[1] - gm), e2 = __expf(rl[2] - gm), e3 = __expf(rl[3] - gm);
                float gs = e0 + e1 + e2 + e3;
                int grp = 0; float best = rl[0];
                if (rl[1] > best) { best = rl[1]; grp = 1; }
                if (rl[2] > best) { best = rl[2]; grp = 2; }
                if (rl[3] > best) { best = rl[3]; grp = 3; }
                const float pg = __expf(best - gm) / gs;
                const f32x4 lsel = (grp == 0) ? rs0 : (grp == 1) ? rs1 : (grp == 2) ? rs2 : rs3;
                const float l0 = lsel[0], l1 = lsel[1], l2 = lsel[2], l3 = lsel[3];
                const float em = fmaxf(fmaxf(l0, l1), fmaxf(l2, l3));
                float q0 = __expf(l0 - em), q1 = __expf(l1 - em), q2 = __expf(l2 - em), q3 = __expf(l3 - em);
                int i1 = 0; float b1 = q0;
                if (q1 > b1) { b1 = q1; i1 = 1; }
                if (q2 > b1) { b1 = q2; i1 = 2; }
                if (q3 > b1) { b1 = q3; i1 = 3; }
                int i2 = -1; float b2 = -1.f;
                if (i1 != 0 && q0 > b2) { b2 = q0; i2 = 0; }
                if (i1 != 1 && q1 > b2) { b2 = q1; i2 = 1; }
                if (i1 != 2 && q2 > b2) { b2 = q2; i2 = 2; }
                if (i1 != 3 && q3 > b2) { b2 = q3; i2 = 3; }
                const float inv = pg / (b1 + b2);
                if (lane == 0) {
                    int* cnt = (int*)(p.ws + OFF_CNT) + layer_router * 16;
                    int* ltok = (int*)(p.ws + OFF_LTOK);
                    float* lw = (float*)(p.ws + OFF_LW);
                    int* ts = (int*)(p.ws + OFF_TSLOT) + row * 2;
                    const int ea = grp * 4 + i1, eb = grp * 4 + i2;
                    const int pa = atomicAdd(cnt + ea, 1);
                    const int pb = atomicAdd(cnt + eb, 1);
                    ltok[(size_t)ea * NTOK + pa] = row; lw[(size_t)ea * NTOK + pa] = b1 * inv;
                    ltok[(size_t)eb * NTOK + pb] = row; lw[(size_t)eb * NTOK + pb] = b2 * inv;
                    ts[0] = (ea << 16) | pa; ts[1] = (eb << 16) | pb;
                }
            }
        }
    }
}

__device__ __forceinline__ void rows_router_phase(const Params& p, const Ctx& cx, char* lds, const float* __restrict__ src, int ls_norm, int layer) {
    const int lane = cx.lane, tid = cx.tid;
    const int widu = __builtin_amdgcn_readfirstlane(cx.wid);
    const int wq = widu & 3, grp4 = widu >> 2;
    const float* mod = (const float*)(p.ws + OFF_MOD);
    const float* rg = p.moe_rg + (size_t)layer * 1024 * 4;
    const float* re = p.moe_re + (size_t)layer * 1024 * 16;
    float* logit_s = (float*)lds;
    float wr[16][5];
#pragma unroll
    for (int i = 0; i < 4; ++i)
#pragma unroll
        for (int j = 0; j < 4; ++j) {
            const int k = (i * 64 + lane) * 4 + j;
#pragma unroll
            for (int q = 0; q < 5; ++q) {
                const int o = 5 * wq + q;
                wr[i * 4 + j][q] = (o < 4) ? rg[k * 4 + o] : re[k * 16 + o - 4];
            }
        }
    const float* gain = p.norm_g + ls_norm * 1024;
    bf16_t* hA = (bf16_t*)(p.ws + OFF_HA);
    for (int blk = cx.vbid; blk < NTOK / 32; blk += cx.G) {
        const int R0 = blk * 32, b = R0 >> 11;
        const float* shift = mod + ((size_t)ls_norm * 16 + b) * 3072;
        const float* scale = shift + 1024;
#pragma unroll 1
        for (int r = 0; r < 16; ++r) {
            const int rl_ = grp4 * 16 + r, row = R0 + rl_;
            f32x4 v[4];
#pragma unroll
            for (int i = 0; i < 4; ++i) v[i] = *(const f32x4*)(src + (size_t)row * 1024 + (i * 64 + lane) * 4);
            float ss = 0.f;
#pragma unroll
            for (int i = 0; i < 4; ++i) ss += v[i][0] * v[i][0] + v[i][1] * v[i][1] + v[i][2] * v[i][2] + v[i][3] * v[i][3];
            ss = wave_sum(ss);
            const float rr = rsqrtf(ss * (1.f / 1024.f) + EPS);
            float acc[5] = {0.f, 0.f, 0.f, 0.f, 0.f};
#pragma unroll
            for (int i = 0; i < 4; ++i) {
                const int col = (i * 64 + lane) * 4;
                const f32x4 g = *(const f32x4*)(gain + col), sc = *(const f32x4*)(scale + col), sh = *(const f32x4*)(shift + col);
                f32x4 h;
#pragma unroll
                for (int j = 0; j < 4; ++j) {
                    h[j] = v[i][j] * rr * g[j] * (1.f + sc[j]) + sh[j];
#pragma unroll
                    for (int q = 0; q < 5; ++q) acc[q] += h[j] * wr[i * 4 + j][q];
                }
                if ((r & 3) == wq) {
                    uint2 o; o.x = pack2(h[0], h[1]); o.y = pack2(h[2], h[3]);
                    *(uint2*)(hA + (size_t)row * 1024 + col) = o;
                }
            }
#pragma unroll
            for (int q = 0; q < 5; ++q) acc[q] = wave_sum(acc[q]);
            if (lane == 0) {
#pragma unroll
                for (int q = 0; q < 5; ++q) logit_s[rl_ * 20 + 5 * wq + q] = acc[q];
            }
        }
        __syncthreads();
        if (tid < 32) {
            const int row = R0 + tid;
            const float* rl = logit_s + tid * 20;
            const float gm = fmaxf(fmaxf(rl[0], rl[1]), fmaxf(rl[2], rl[3]));
            const float gs = __expf(rl[0] - gm) + __expf(rl[1] - gm) + __expf(rl[2] - gm) + __expf(rl[3] - gm);
            int grp = 0; float best = rl[0];
            if (rl[1] > best) { best = rl[1]; grp = 1; }
            if (rl[2] > best) { best = rl[2]; grp = 2; }
            if (rl[3] > best) { best = rl[3]; grp = 3; }
            const float pg = __expf(best - gm) / gs;
            const f32x4 lsel = *(const f32x4*)(rl + 4 + 4 * grp);
            const float l0 = lsel[0], l1 = lsel[1], l2 = lsel[2], l3 = lsel[3];
            const float em = fmaxf(fmaxf(l0, l1), fmaxf(l2, l3));
            const float q0 = __expf(l0 - em), q1 = __expf(l1 - em), q2 = __expf(l2 - em), q3 = __expf(l3 - em);
            int i1 = 0; float b1 = q0;
            if (q1 > b1) { b1 = q1; i1 = 1; }
            if (q2 > b1) { b1 = q2; i1 = 2; }
            if (q3 > b1) { b1 = q3; i1 = 3; }
            int i2 = -1; float b2 = -1.f;
            if (i1 != 0 && q0 > b2) { b2 = q0; i2 = 0; }
            if (i1 != 1 && q1 > b2) { b2 = q1; i2 = 1; }
            if (i1 != 2 && q2 > b2) { b2 = q2; i2 = 2; }
            if (i1 != 3 && q3 > b2) { b2 = q3; i2 = 3; }
            const float inv = pg / (b1 + b2);
            int* cnt = (int*)(p.ws + OFF_CNT) + layer * 16;
            int* ltok = (int*)(p.ws + OFF_LTOK);
            float* lw = (float*)(p.ws + OFF_LW);
            int* ts = (int*)(p.ws + OFF_TSLOT) + row * 2;
            const int ea = grp * 4 + i1, eb = grp * 4 + i2;
            const int pa = atomicAdd(cnt + ea, 1);
            const int pb = atomicAdd(cnt + eb, 1);
            ltok[(size_t)ea * NTOK + pa] = row; lw[(size_t)ea * NTOK + pa] = b1 * inv;
            ltok[(size_t)eb * NTOK + pb] = row; lw[(size_t)eb * NTOK + pb] = b2 * inv;
            ts[0] = (ea << 16) | pa; ts[1] = (eb << 16) | pb;
        }
        __syncthreads();
    }
}

__device__ __forceinline__ int stage_col(int tid) { return ((tid & 7) ^ ((tid >> 3) & 7)) * 8; }

template <class Epi>
__device__ __forceinline__ void gemm_tile(const bf16_t* const (&ap)[4], const bf16_t* const (&bp)[2], int K, char* lds, const Ctx& cx, Epi&& epi) {
    const int tid = cx.tid, lane = cx.lane, wr = cx.wid >> 1, wc = cx.wid & 1, fr = lane & 15, fq = lane >> 4;
    f32x4 acc[4][4];
#pragma unroll
    for (int m = 0; m < 4; ++m)
#pragma unroll
        for (int n = 0; n < 4; ++n) acc[m][n] = (f32x4){0.f, 0.f, 0.f, 0.f};
    const int nt = K / 64;
    auto stage = [&](int t, int slot) {
        char* SA = lds + slot * GEMM_STAGE + tid * 16; char* SB = SA + 32768;
        const int ko = t * 64;
#pragma unroll
        for (int i = 0; i < 4; ++i) glds16(ap[i] + ko, SA + i * 8192);
#pragma unroll
        for (int i = 0; i < 2; ++i) glds16(bp[i] + ko, SB + i * 8192);
    };
    __syncthreads();
    stage(0, 0);
    if (nt > 1) stage(1, 1);
    const int x7 = fr & 7;
    const int aoff = (wr * 64 + fr) * 128, boff = 32768 + (wc * 64 + fr) * 128;
    int slot = 0;
    for (int kt = 0; kt < nt; ++kt) {
        if (kt + 1 < nt) asm volatile("s_waitcnt vmcnt(6)" ::: "memory");
        else asm volatile("s_waitcnt vmcnt(0)" ::: "memory");
        __builtin_amdgcn_s_barrier();
        if (kt + 2 < nt) stage(kt + 2, slot >= 1 ? slot - 1 : 2);
        const char* S = lds + slot * GEMM_STAGE;
#pragma unroll
        for (int ks = 0; ks < 2; ++ks) {
            const int pc = ((ks * 4 + fq) ^ x7) * 16;
            bf16x8 Af[4], Bf[4];
#pragma unroll
            for (int m = 0; m < 4; ++m) Af[m] = *(const bf16x8*)(S + aoff + m * 2048 + pc);
#pragma unroll
            for (int n = 0; n < 4; ++n) Bf[n] = *(const bf16x8*)(S + boff + n * 2048 + pc);
#pragma unroll
            for (int m = 0; m < 4; ++m)
#pragma unroll
                for (int n = 0; n < 4; ++n) acc[m][n] = __builtin_amdgcn_mfma_f32_16x16x32_bf16(Bf[n], Af[m], acc[m][n], 0, 0, 0);
        }
        slot = slot == 2 ? 0 : slot + 1;
    }
    epi(acc, wr, wc, fr, fq);
}

template <class EpiFactory>
__device__ __forceinline__ void gemm_phase_dense(const bf16_t* A, int lda, const bf16_t* Bt, int K, int nrt, int nct, char* lds, const Ctx& cx, EpiFactory&& mk) {
    const int tid = cx.tid;
    const int ntiles = nrt * nct;
    const int sc = stage_col(tid), sr = tid >> 3;
    for (int tile = cx.vbid; tile < ntiles; tile += cx.G) {
        const int rt = tile / nct, ct = tile % nct;
        const bf16_t* a0 = A + (size_t)(rt * 256 + sr) * lda + sc;
        const bf16_t* b0 = Bt + (size_t)(ct * 128 + sr) * K + sc;
        const bf16_t* const ap[4] = {a0, a0 + (size_t)64 * lda, a0 + (size_t)128 * lda, a0 + (size_t)192 * lda};
        const bf16_t* const bp[2] = {b0, b0 + (size_t)64 * K};
        gemm_tile(ap, bp, K, lds, cx, mk(rt * 256, ct * 128));
    }
}

__device__ __forceinline__ void phase_nsa_inproj(const Params& p, const Ctx& cx, char* lds) {
    const bf16_t* A = (const bf16_t*)(p.ws + OFF_HA);
    const bf16_t* Bt = (const bf16_t*)(p.ws + OFF_W_NSA_IN);
    char* ws = p.ws;
    const float* qg = p.nsa_q_gain;
    const float* kg = p.nsa_k_gain;
    gemm_phase_dense(A, 1024, Bt, 1024, NTOK / 256, NSA_IN_PAD / 128, lds, cx, [=](int row0, int col0) {
        return [=](f32x4 (&acc)[4][4], int wr, int wc, int fr, int fq) {
            const int gc0 = col0 + wc * 64;
            if (gc0 >= NSA_IN) return;
            if (gc0 < 1024 || (gc0 >= 1536 && gc0 < 1792) || (gc0 >= 2048 && gc0 < 2304)) {
                const float* gain; float post; bf16_t* dstb; size_t rstride; size_t coff; bool tokmajor;
                if (gc0 < 1024) { gain = qg; post = 0.125f * 1.4426950408889634f; }
                else if (gc0 < 1792) { gain = kg + 64; post = 1.f; }
                else { gain = kg + 128; post = 1.f; }
#pragma unroll
                for (int m = 0; m < 4; ++m) {
                    float ss = 0.f;
#pragma unroll
                    for (int n = 0; n < 4; ++n) ss += acc[m][n][0] * acc[m][n][0] + acc[m][n][1] * acc[m][n][1] + acc[m][n][2] * acc[m][n][2] + acc[m][n][3] * acc[m][n][3];
                    ss += __shfl_xor(ss, 16); ss += __shfl_xor(ss, 32);
                    const float r = rsqrtf(ss * (1.f / 64.f) + EPS) * post;
                    const int row = row0 + wr * 64 + m * 16 + fr;
                    bf16_t* dst;
                    if (gc0 < 1024) dst = (bf16_t*)(ws + OFF_Q) + (size_t)row * 1024 + gc0;
                    else {
                        const int g = ((gc0 - 1024) & 255) >> 6, b = row >> 11, t = row & 2047;
                        dst = (bf16_t*)(ws + (gc0 < 1792 ? OFF_KS : OFF_KW)) + ((size_t)(b * 4 + g) * 2048 + t) * 64;
                    }
#pragma unroll
                    for (int n = 0; n < 4; ++n) {
                        const int c = n * 16 + fq * 4;
                        f32x4 g4 = *(const f32x4*)(gain + c);
                        uint2 o; o.x = pack2(acc[m][n][0] * r * g4[0], acc[m][n][1] * r * g4[1]); o.y = pack2(acc[m][n][2] * r * g4[2], acc[m][n][3] * r * g4[3]);
                        *(uint2*)(dst + c) = o;
                    }
                }
            } else if (gc0 < 2560) {
                const int seg = (gc0 - 1024) >> 8;
                const int g = ((gc0 - 1024) & 255) >> 6;
                if (seg < 2) {
                    const size_t off = seg == 0 ? OFF_KCRAW : OFF_VCRAW;
#pragma unroll
                    for (int m = 0; m < 4; ++m) {
                        const int row = row0 + wr * 64 + m * 16 + fr, b = row >> 11, t = row & 2047;
                        bf16_t* dst = (bf16_t*)(ws + off) + ((size_t)(b * 4 + g) * 2048 + t) * 64;
#pragma unroll
                        for (int n = 0; n < 4; ++n) {
                            const int c = n * 16 + fq * 4;
                            uint2 o; o.x = pack2(acc[m][n][0], acc[m][n][1]); o.y = pack2(acc[m][n][2], acc[m][n][3]);
                            *(uint2*)(dst + c) = o;
                        }
                    }
                } else {
                    const size_t off = seg == 3 ? OFF_VS : OFF_VW;
#pragma unroll
                    for (int m = 0; m < 4; ++m) {
                        const int row = row0 + wr * 64 + m * 16 + fr, b = row >> 11, t = row & 2047;
                        bf16_t* dst = (bf16_t*)(ws + off) + (size_t)(b * 4 + g) * 64 * 2048 + t;
#pragma unroll
                        for (int n = 0; n < 4; ++n)
#pragma unroll
                            for (int j = 0; j < 4; ++j) dst[(size_t)(n * 16 + fq * 4 + j) * 2048] = f2bf(acc[m][n][j]);
                    }
                }
            } else {
#pragma unroll
                for (int m = 0; m < 4; ++m) {
                    const int row = row0 + wr * 64 + m * 16 + fr;
                    float* dst = (float*)(ws + OFF_GATES) + (size_t)row * 48;
#pragma unroll
                    for (int n = 0; n < 3; ++n) {
                        const int c = n * 16 + fq * 4;
                        f32x4 o;
#pragma unroll
                        for (int j = 0; j < 4; ++j) o[j] = sigmoid_f(acc[m][n][j]);
                        *(f32x4*)(dst + c) = o;
                    }
                }
            }
        };
    });
}

__device__ __forceinline__ void phase_cmp1(const Params& p, const Ctx& cx, char* lds) {
    const int tid = cx.tid;
    const float* peb = (const float*)(p.ws + OFF_PEB);
    float* T1 = (float*)(p.ws + OFF_T1);
    const int sc = stage_col(tid), sr = tid >> 3;
    for (int tile = cx.vbid; tile < 64; tile += cx.G) {
        const int kv = tile >> 5, bg2 = tile & 31;
        const bf16_t* raw = (const bf16_t*)(p.ws + (kv ? OFF_VCRAW : OFF_KCRAW)) + (size_t)bg2 * 2 * 2048 * 64;
        const bf16_t* a0 = raw + (size_t)sr * 1024 + sc;
        const bf16_t* a2 = raw + (size_t)2048 * 64 + (size_t)sr * 1024 + sc;
        const bf16_t* b0 = (const bf16_t*)(p.ws + OFF_W_CMP1) + ((size_t)kv * 128 + sr) * 2048 + sc;
        const bf16_t* const ap[4] = {a0, a0 + (size_t)64 * 1024, a2, a2 + (size_t)64 * 1024};
        const bf16_t* const bp[2] = {b0, b0 + (size_t)64 * 2048};
        gemm_tile(ap, bp, 2048, lds, cx, [=](f32x4 (&acc)[4][4], int wr, int wc, int fr, int fq) {
            if (wc != 0) return;
#pragma unroll
            for (int m = 0; m < 4; ++m) {
                const int r = wr * 64 + m * 16 + fr;
                float* dst = T1 + ((size_t)kv * 8192 + (bg2 * 2 + (r >> 7)) * 128 + (r & 127)) * 64;
#pragma unroll
                for (int n = 0; n < 4; ++n) {
                    const int c = n * 16 + fq * 4;
                    f32x4 pb = *(const f32x4*)(peb + kv * 64 + c);
                    *(f32x4*)(dst + c) = acc[m][n] + pb;
                }
            }
        });
    }
}

__device__ __forceinline__ void phase_cmp2(const Params& p, const Ctx& cx) {
    const int lane = cx.lane;
    const float* T1 = (const float*)(p.ws + OFF_T1);
    for (int r = cx.vbid * NWAVE + cx.wid; r < 2 * 8192; r += cx.G * NWAVE) {
        const int kv = r >> 13, rr = r & 8191, n_ = rr & 127;
        const float s = silu_f(T1[(size_t)r * 64 + lane]);
        const float* w2 = p.nsa_cmp_w2 + kv * 4096 + lane;
        float o = 0.f;
#pragma unroll 8
        for (int j = 0; j < 64; ++j) o += __shfl(s, j) * w2[j * 64];
        if (kv == 0) {
            const float ss = wave_sum(o * o);
            o = o * rsqrtf(ss * (1.f / 64.f) + EPS) * p.nsa_k_gain[lane];
        }
        if (n_ == 127) o = 0.f;
        if (kv == 0) ((bf16_t*)(p.ws + OFF_KC))[(size_t)rr * 64 + lane] = f2bf(o);
        else ((bf16_t*)(p.ws + OFF_VC))[((size_t)(rr >> 7) * 64 + lane) * 128 + n_] = f2bf(o);
    }
}

constexpr int ATT_K_OFF = 0, ATT_K_STRIDE = 144, ATT_V_OFF = 9216, ATT_V_STRIDE = 136, ATT_LUT_OFF = 17920, LUT_N = 2136, LUT_PAD = 80;
constexpr int ATT_SC_OFF = ATT_LUT_OFF + 4 * LUT_N * 4;
static_assert(ATT_SC_OFF + NWAVE * 3072 <= LDS_TAB_OFF, "attention LDS");
#define MFMA32(a, b, c) __builtin_amdgcn_mfma_f32_32x32x16_bf16((a), (b), (c), 0, 0, 0)

__device__ __forceinline__ void phase_attn(const Params& p, const Ctx& cx, char* lds) {
    const int tid = cx.tid, lane = cx.lane, wid = cx.wid;
    const int g = cx.vbid & 3;
    const int ql = lane & 7, head = (lane & 31) >> 3, h2 = lane >> 5, l31 = lane & 31;
    float* lut = (float*)(lds + ATT_LUT_OFF);
    for (int i = tid; i < 4 * LUT_N; i += NTHR) {
        const int h = i / LUT_N, dist = i % LUT_N - LUT_PAD;
        lut[i] = dist >= 0 ? p.rel_bias[t5_bucket(dist) * 16 + g * 4 + h] * 1.4426950408889634f : 0.f;
    }
    __syncthreads();
    const float* lutp = lut + head * LUT_N + LUT_PAD;
    const bf16_t* Qb = (const bf16_t*)(p.ws + OFF_Q);
    const bf16_t* KC = (const bf16_t*)(p.ws + OFF_KC);
    const bf16_t* VCT = (const bf16_t*)(p.ws + OFF_VC);
    const bf16_t* KS = (const bf16_t*)(p.ws + OFF_KS);
    const bf16_t* VST = (const bf16_t*)(p.ws + OFF_VS);
    const bf16_t* KW = (const bf16_t*)(p.ws + OFF_KW);
    const bf16_t* VWT = (const bf16_t*)(p.ws + OFF_VW);
    const float* GT = (const float*)(p.ws + OFF_GATES);
    bf16_t* Og = (bf16_t*)(p.ws + OFF_HA);
    float* scw = (float*)(lds + ATT_SC_OFF) + wid * 768;
    const bool flip_ok = (cx.G % 128) == 0;

    for (int it = 0;; ++it) {
        const int u = cx.vbid + it * cx.G;
        if (u >= 2048) break;
        const int rest = u >> 2, b = rest >> 5, qtb = rest & 31;
        const int qt = (flip_ok && (it & 1)) ? 31 - qtb : qtb;
        const int t0 = qt * 64, cur = qt, bg = b * 4 + g;
        const int tq = t0 + wid * 8 + ql;
        const size_t rowtok = (size_t)b * SEQ + tq;
        bf16x8 Qf[4];
        {
            const bf16_t* qp = Qb + rowtok * 1024 + (g * 4 + head) * 64 + 8 * h2;
#pragma unroll
            for (int ks = 0; ks < 4; ++ks) Qf[ks] = *(const bf16x8*)(qp + 16 * ks);
        }
        const float* gt = GT + rowtok * 48 + (g * 4 + head) * 3;
        const float gate_c = gt[0], gate_s = gt[1], gate_w = gt[2];
        const int wlo = max(0, (t0 - 511) >> 6);
        const int nW = cur - wlo + 1;
        const int NT = 4 + nW + cur + 1;

        uint4 kr0, vr0;
        auto issue_load = [&](int i) {
            const bf16_t* ksrc; const bf16_t* vsrc; int vstride;
            if (i < 4) { const int ci = i & 1; ksrc = KC + ((size_t)bg * 128 + ci * 64) * 64; vsrc = VCT + (size_t)bg * 64 * 128 + ci * 64; vstride = 128; }
            else if (i < 4 + nW) { const int kb = wlo + i - 4; ksrc = KW + ((size_t)bg * 2048 + kb * 64) * 64; vsrc = VWT + (size_t)bg * 64 * 2048 + kb * 64; vstride = 2048; }
            else { const int kb = i - 4 - nW; ksrc = KS + ((size_t)bg * 2048 + kb * 64) * 64; vsrc = VST + (size_t)bg * 64 * 2048 + kb * 64; vstride = 2048; }
            kr0 = *(const uint4*)(ksrc + tid * 8);
            vr0 = *(const uint4*)(vsrc + (size_t)(tid >> 3) * vstride + (tid & 7) * 8);
        };
        auto write_lds = [&]() {
            *(uint4*)(lds + ATT_K_OFF + (tid >> 3) * ATT_K_STRIDE + (tid & 7) * 16) = kr0;
            char* va = lds + ATT_V_OFF + (tid >> 3) * ATT_V_STRIDE + (tid & 7) * 16;
            uint2 t;
            t.x = vr0.x; t.y = vr0.y; *(uint2*)va = t;
            t.x = vr0.z; t.y = vr0.w; *(uint2*)(va + 8) = t;
        };
        f32x16 O0, O1, OUT0, OUT1;
#pragma unroll
        for (int r = 0; r < 16; ++r) { O0[r] = 0.f; O1[r] = 0.f; }
        float lsum = 0.f;

        auto qk = [&](int kt2) -> f32x16 {
            f32x16 S;
#pragma unroll
            for (int r = 0; r < 16; ++r) S[r] = 0.f;
            const char* kp = lds + ATT_K_OFF + (32 * kt2 + l31) * ATT_K_STRIDE + 16 * h2;
#pragma unroll
            for (int ks = 0; ks < 4; ++ks) S = MFMA32(*(const bf16x8*)(kp + 32 * ks), Qf[ks], S);
            return S;
        };
        auto pv = [&](int kt2, const f32x16& P) {
#pragma unroll
            for (int s2 = 0; s2 < 2; ++s2) {
                uint4 pk;
                pk.x = pack2(P[8 * s2 + 0], P[8 * s2 + 1]); pk.y = pack2(P[8 * s2 + 2], P[8 * s2 + 3]);
                pk.z = pack2(P[8 * s2 + 4], P[8 * s2 + 5]); pk.w = pack2(P[8 * s2 + 6], P[8 * s2 + 7]);
                const bf16x8 Pf = __builtin_bit_cast(bf16x8, pk);
                const char* vp = lds + ATT_V_OFF + l31 * ATT_V_STRIDE + (32 * kt2 + 16 * s2 + 4 * h2) * 2;
                {
                    uint2 lo = *(const uint2*)vp, hi = *(const uint2*)(vp + 16);
                    uint4 a; a.x = lo.x; a.y = lo.y; a.z = hi.x; a.w = hi.y;
                    O0 = MFMA32(__builtin_bit_cast(bf16x8, a), Pf, O0);
                }
                {
                    uint2 lo = *(const uint2*)(vp + 32 * ATT_V_STRIDE), hi = *(const uint2*)(vp + 32 * ATT_V_STRIDE + 16);
                    uint4 a; a.x = lo.x; a.y = lo.y; a.z = hi.x; a.w = hi.y;
                    O1 = MFMA32(__builtin_bit_cast(bf16x8, a), Pf, O1);
                }
            }
        };
        auto finalize = [&](float gate, bool first) {
            const float Z = lsum + __shfl_xor(lsum, 32);
            const float f = Z > 0.f ? gate / Z : 0.f;
#pragma unroll
            for (int r = 0; r < 16; ++r) {
                if (first) { OUT0[r] = f * O0[r]; OUT1[r] = f * O1[r]; }
                else { OUT0[r] += f * O0[r]; OUT1[r] += f * O1[r]; }
                O0[r] = 0.f; O1[r] = 0.f;
            }
            lsum = 0.f;
        };

        const int nvis = (tq >= 31) ? min((tq - 31) / 16 + 1, 127) : 0;
        float inv_c = 0.f;
        unsigned selmask = 0u;
        float* sown = scw + ql * 32;
        float* stail = scw + 256 + ql * 32;
        float* ssc = scw + 512 + ql * 32;
        issue_load(0);
        for (int i = 0; i < NT; ++i) {
            __syncthreads();
            write_lds();
            __syncthreads();
            if (i + 1 < NT) issue_load(i + 1);
            if (i < 4) {
                const int ci = i & 1;
#pragma unroll 1
                for (int kt2 = 0; kt2 < 2; ++kt2) {
                    f32x16 S = qk(kt2);
                    const int n0 = 64 * ci + 32 * kt2 + 4 * h2;
                    const int d0 = tq - 31 - 16 * n0;
#pragma unroll
                    for (int r = 0; r < 16; ++r) {
                        const int cr = (r & 3) + 8 * (r >> 2);
                        const float bias = lutp[max(d0 - 16 * cr, -LUT_PAD)];
                        S[r] = __builtin_amdgcn_exp2f(S[r] + bias + ((n0 + cr) < nvis ? 0.f : -INFINITY));
                        lsum += S[r];
                    }
                    if (i >= 2) {
                        pv(kt2, S);
#pragma unroll
                        for (int rq = 0; rq < 4; ++rq) {
                            float gsum = (S[4 * rq] + S[4 * rq + 1] + S[4 * rq + 2] + 0.5f * S[4 * rq + 3]) * inv_c;
                            float tl = 0.5f * S[4 * rq + 3] * inv_c;
                            gsum += __shfl_xor(gsum, 8); gsum += __shfl_xor(gsum, 16);
                            tl += __shfl_xor(tl, 8); tl += __shfl_xor(tl, 16);
                            const int sblk = 8 * (2 * ci + kt2) + 2 * rq + h2;
                            if (head == 0) {
                                sown[sblk] = gsum;
                                if (sblk < 31) stail[sblk + 1] = tl;
                            }
                        }
                    }
                }
                if (i == 1) {
                    const float Z = lsum + __shfl_xor(lsum, 32);
                    inv_c = Z > 0.f ? 1.f / Z : 0.f;
                    lsum = 0.f;
                }
                if (i == 3) {
                    if (head == 0 && h2 == 0) stail[0] = 0.f;
                    __builtin_amdgcn_wave_barrier();
                    const int j8 = head * 2 + h2;
                    {
                        const f32x4 a = *(const f32x4*)(sown + 4 * j8), t4 = *(const f32x4*)(stail + 4 * j8);
                        f32x4 sc;
#pragma unroll
                        for (int q = 0; q < 4; ++q) {
                            const int sblk = 4 * j8 + q;
                            const bool forced = (sblk == 0) || (sblk == cur) || (sblk == cur - 1);
                            sc[q] = forced ? 1.0e4f : (sblk <= cur ? a[q] + t4[q] : -1.0f);
                        }
                        *(f32x4*)(ssc + 4 * j8) = sc;
                    }
                    __builtin_amdgcn_wave_barrier();
                    const f32x4 own = *(const f32x4*)(ssc + 4 * j8);
                    int rk0 = 0, rk1 = 0, rk2 = 0, rk3 = 0;
                    const int so0 = 4 * j8;
#pragma unroll
                    for (int m4 = 0; m4 < 8; ++m4) {
                        const f32x4 v = *(const f32x4*)(ssc + 4 * m4);
#pragma unroll
                        for (int q = 0; q < 4; ++q) {
                            const int sm = 4 * m4 + q;
                            const float vm = v[q];
                            rk0 += (vm > own[0] || (vm == own[0] && sm < so0)) ? 1 : 0;
                            rk1 += (vm > own[1] || (vm == own[1] && sm < so0 + 1)) ? 1 : 0;
                            rk2 += (vm > own[2] || (vm == own[2] && sm < so0 + 2)) ? 1 : 0;
                            rk3 += (vm > own[3] || (vm == own[3] && sm < so0 + 3)) ? 1 : 0;
                        }
                    }
                    unsigned mk = ((rk0 < 8 ? 1u : 0u) | (rk1 < 8 ? 2u : 0u) | (rk2 < 8 ? 4u : 0u) | (rk3 < 8 ? 8u : 0u)) << so0;
                    mk |= __shfl_xor(mk, 8); mk |= __shfl_xor(mk, 16); mk |= __shfl_xor(mk, 32);
                    selmask = mk;
                    __builtin_amdgcn_wave_barrier();
                    finalize(gate_c, true);
                }
            } else {
                const bool isw = i < 4 + nW;
                const int kb = isw ? wlo + i - 4 : i - 4 - nW;
                const bool sel = isw ? true : ((selmask >> kb) & 1u) != 0;
                if (__ballot(sel) != 0ull) {
                    const int dhi = isw ? 512 : 0x7fffffff;
#pragma unroll 1
                    for (int kt2 = 0; kt2 < 2; ++kt2) {
                        f32x16 S = qk(kt2);
                        const int d0 = tq - (64 * kb + 32 * kt2 + 4 * h2);
                        const float* lp = lutp + (d0 - 27);
#pragma unroll
                        for (int r = 0; r < 16; ++r) {
                            const int cr = (r & 3) + 8 * (r >> 2);
                            const int dist = d0 - cr;
                            const float bias = lp[27 - cr];
                            const bool valid = sel && dist >= 0 && dist < dhi;
                            S[r] = __builtin_amdgcn_exp2f(S[r] + bias + (valid ? 0.f : -INFINITY));
                            lsum += S[r];
                        }
                        pv(kt2, S);
                    }
                }
                if (i == 3 + nW) finalize(gate_w, false);
            }
        }
        finalize(gate_s, false);
        {
            bf16_t* op = Og + rowtok * 1024 + (g * 4 + head) * 64 + 4 * h2;
#pragma unroll
            for (int rq = 0; rq < 4; ++rq) {
                uint2 o0; o0.x = pack2(OUT0[4 * rq], OUT0[4 * rq + 1]); o0.y = pack2(OUT0[4 * rq + 2], OUT0[4 * rq + 3]);
                uint2 o1; o1.x = pack2(OUT1[4 * rq], OUT1[4 * rq + 1]); o1.y = pack2(OUT1[4 * rq + 2], OUT1[4 * rq + 3]);
                *(uint2*)(op + 8 * rq) = o0;
                *(uint2*)(op + 32 + 8 * rq) = o1;
            }
        }
    }
}

__device__ __forceinline__ void phase_outproj(const Params& p, const Ctx& cx, char* lds, const bf16_t* A, const bf16_t* Bt, const float* xin, int ls) {
    const float* mod = (const float*)(p.ws + OFF_MOD);
    float* xo = p.out;
    gemm_phase_dense(A, 1024, Bt, 1024, NTOK / 256, 8, lds, cx, [=](int row0, int col0) {
        return [=](f32x4 (&acc)[4][4], int wr, int wc, int fr, int fq) {
#pragma unroll
            for (int m = 0; m < 4; ++m) {
                const int row = row0 + wr * 64 + m * 16 + fr, b = row >> 11;
                const float* gate = mod + ((size_t)ls * 16 + b) * 3072 + 2048;
#pragma unroll
                for (int n = 0; n < 4; ++n) {
                    const int col = col0 + wc * 64 + n * 16 + fq * 4;
                    f32x4 g = *(const f32x4*)(gate + col);
                    f32x4 xi = *(const f32x4*)(xin + (size_t)row * 1024 + col);
                    f32x4 o;
#pragma unroll
                    for (int j = 0; j < 4; ++j) o[j] = xi[j] + g[j] * acc[m][n][j];
                    *(f32x4*)(xo + (size_t)row * 1024 + col) = o;
                }
            }
        };
    });
}

__device__ __forceinline__ void moe_tables(const Params& p, int layer, int tid, int* s_cnt, int* s_off, int* s_toff) {
    __syncthreads();
    if (tid == 0) {
        const int* cnt = (const int*)(p.ws + OFF_CNT) + layer * 16;
        int o = 0, to = 0;
        for (int e = 0; e < 16; ++e) { const int c = cnt[e]; s_cnt[e] = c; s_off[e] = o; s_toff[e] = to; o += c; to += ((c + 255) >> 8) * 8; }
        s_off[16] = o; s_toff[16] = to;
    }
    __syncthreads();
}

__device__ __forceinline__ void phase_moe_up(const Params& p, const Ctx& cx, char* lds, int layer) {
    const int tid = cx.tid;
    int* s_cnt = (int*)(lds + LDS_TAB_OFF); int* s_off = s_cnt + 16; int* s_toff = s_off + 17;
    moe_tables(p, layer, tid, s_cnt, s_off, s_toff);
    const int ntiles = s_toff[16];
    const bf16_t* hA = (const bf16_t*)(p.ws + OFF_HA);
    const int* ltok = (const int*)(p.ws + OFF_LTOK);
    bf16_t* H1 = (bf16_t*)(p.ws + OFF_H1);
    const int sc = stage_col(tid), sr = tid >> 3;
    for (int tile = cx.vbid; tile < ntiles; tile += cx.G) {
        int e = 0;
        while (tile >= s_toff[e + 1]) ++e;
        const int lt = tile - s_toff[e], rt = lt >> 3, ct = lt & 7, cnt = s_cnt[e], off = s_off[e];
        const int* lt_e = ltok + (size_t)e * NTOK;
        const bf16_t* const ap[4] = {hA + (size_t)lt_e[min(rt * 256 + sr, cnt - 1)] * 1024 + sc, hA + (size_t)lt_e[min(rt * 256 + sr + 64, cnt - 1)] * 1024 + sc,
                                     hA + (size_t)lt_e[min(rt * 256 + sr + 128, cnt - 1)] * 1024 + sc, hA + (size_t)lt_e[min(rt * 256 + sr + 192, cnt - 1)] * 1024 + sc};
        const bf16_t* b0 = (const bf16_t*)(p.ws + OFF_W_UP) + ((size_t)(layer * 16 + e) * 1024 + ct * 128 + sr) * 1024 + sc;
        const bf16_t* const bp[2] = {b0, b0 + (size_t)64 * 1024};
        gemm_tile(ap, bp, 1024, lds, cx, [=](f32x4 (&acc)[4][4], int wr, int wc, int fr, int fq) {
#pragma unroll
            for (int m = 0; m < 4; ++m) {
                const int pos = rt * 256 + wr * 64 + m * 16 + fr;
                if (pos < cnt) {
                    bf16_t* dst = H1 + (size_t)(off + pos) * 512 + ct * 64 + wc * 32 + fq * 4;
#pragma unroll
                    for (int n = 0; n < 2; ++n) {
                        float h[4];
#pragma unroll
                        for (int j = 0; j < 4; ++j) h[j] = silu_f(acc[m][n][j]) * acc[m][n + 2][j];
                        uint2 o; o.x = pack2(h[0], h[1]); o.y = pack2(h[2], h[3]);
                        *(uint2*)(dst + n * 16) = o;
                    }
                }
            }
        });
    }
}

__device__ __forceinline__ void phase_moe_down(const Params& p, const Ctx& cx, char* lds, int layer) {
    const int tid = cx.tid;
    int* s_cnt = (int*)(lds + LDS_TAB_OFF); int* s_off = s_cnt + 16; int* s_toff = s_off + 17;
    moe_tables(p, layer, tid, s_cnt, s_off, s_toff);
    const int ntiles = s_toff[16];
    const bf16_t* H1 = (const bf16_t*)(p.ws + OFF_H1);
    const float* lw = (const float*)(p.ws + OFF_LW);
    bf16_t* Y = (bf16_t*)(p.ws + OFF_Y);
    const int sc = stage_col(tid), sr = tid >> 3;
    for (int tile = cx.vbid; tile < ntiles; tile += cx.G) {
        int e = 0;
        while (tile >= s_toff[e + 1]) ++e;
        const int lt = tile - s_toff[e], rt = lt >> 3, ct = lt & 7, cnt = s_cnt[e], off = s_off[e];
        const bf16_t* const ap[4] = {H1 + (size_t)(off + min(rt * 256 + sr, cnt - 1)) * 512 + sc, H1 + (size_t)(off + min(rt * 256 + sr + 64, cnt - 1)) * 512 + sc,
                                     H1 + (size_t)(off + min(rt * 256 + sr + 128, cnt - 1)) * 512 + sc, H1 + (size_t)(off + min(rt * 256 + sr + 192, cnt - 1)) * 512 + sc};
        const bf16_t* b0 = (const bf16_t*)(p.ws + OFF_W_DN) + ((size_t)(layer * 16 + e) * 1024 + ct * 128 + sr) * 512 + sc;
        const bf16_t* const bp[2] = {b0, b0 + (size_t)64 * 512};
        gemm_tile(ap, bp, 512, lds, cx, [=](f32x4 (&acc)[4][4], int wr, int wc, int fr, int fq) {
#pragma unroll
            for (int m = 0; m < 4; ++m) {
                const int pos = rt * 256 + wr * 64 + m * 16 + fr;
                if (pos < cnt) {
                    const float w = lw[(size_t)e * NTOK + pos];
                    bf16_t* dst = Y + (size_t)(off + pos) * 1024 + ct * 128 + wc * 64 + fq * 4;
#pragma unroll
                    for (int n = 0; n < 4; ++n) {
                        uint2 o; o.x = pack2(w * acc[m][n][0], w * acc[m][n][1]); o.y = pack2(w * acc[m][n][2], w * acc[m][n][3]);
                        *(uint2*)(dst + n * 16) = o;
                    }
                }
            }
        });
    }
}

__device__ __forceinline__ void phase_hgrn_inproj(const Params& p, const Ctx& cx, char* lds) {
    const bf16_t* A = (const bf16_t*)(p.ws + OFF_HA);
    const bf16_t* Bt = (const bf16_t*)(p.ws + OFF_W_HG_IN);
    char* ws = p.ws;
    const float* lb = (const float*)(p.ws + OFF_LB);
    gemm_phase_dense(A, 1024, Bt, 1024, NTOK / 256, 32, lds, cx, [=](int row0, int col0) {
        return [=](f32x4 (&acc)[4][4], int wr, int wc, int fr, int fq) {
            const int gc0 = col0 + wc * 64, seg = gc0 >> 10, c0 = gc0 & 1023;
#pragma unroll
            for (int m = 0; m < 4; ++m) {
                const int row = row0 + wr * 64 + m * 16 + fr;
#pragma unroll
                for (int n = 0; n < 4; ++n) {
                    const int c = c0 + n * 16 + fq * 4;
                    if (seg == 1) {
                        f32x4 l4 = *(const f32x4*)(lb + c), o;
#pragma unroll
                        for (int j = 0; j < 4; ++j) o[j] = __logf(l4[j] + (1.f - l4[j]) * sigmoid_f(acc[m][n][j]));
                        *(f32x4*)((float*)(ws + OFF_LF) + (size_t)row * 1024 + c) = o;
                    } else {
                        float h[4];
#pragma unroll
                        for (int j = 0; j < 4; ++j) h[j] = (seg == 2) ? acc[m][n][j] : silu_f(acc[m][n][j]);
                        uint2 o; o.x = pack2(h[0], h[1]); o.y = pack2(h[2], h[3]);
                        bf16_t* dst = (bf16_t*)(ws + (seg == 0 ? OFF_QH : seg == 2 ? OFF_V : OFF_G));
                        *(uint2*)(dst + (size_t)row * 1024 + c) = o;
                    }
                }
            }
        };
    });
}

constexpr int HG_QD_OFF = 0, HG_KD_OFF = 8704, HG_K2T_OFF = 17408, HG_VT_OFF = 27648, HG_O_OFF = 37888, HG_DEC_OFF = 54784, HG_TOT_OFF = 55296;
constexpr int HG_ROW = 272, HG_TROW = 80, HG_OROW = 528;
static_assert(HG_TOT_OFF + 4096 <= LDS_TAB_OFF, "hgrn LDS");

__device__ __forceinline__ void phase_hgrn_rec(const Params& p, const Ctx& cx, char* lds) {
    const int tid = cx.tid, lane = cx.lane, wid = cx.wid;
    const int l31 = lane & 31, h2 = lane >> 5;
    const int widu = __builtin_amdgcn_readfirstlane(cx.wid);
    const int d0 = 2 * lane;
    const bf16_t* QH = (const bf16_t*)(p.ws + OFF_QH);
    const float* LF = (const float*)(p.ws + OFF_LF);
    const bf16_t* V = (const bf16_t*)(p.ws + OFF_V);
    bf16_t* OR = (bf16_t*)(p.ws + OFF_HA);
    float* dec = (float*)(lds + HG_DEC_OFF);
    float* tot = (float*)(lds + HG_TOT_OFF);
    for (int item = blockIdx.x; item < 128; item += cx.G) {
        const int b = item >> 3, h = item & 7;
        f32x16 S0, S1, S2, S3;
#pragma unroll
        for (int r = 0; r < 16; ++r) { S0[r] = 0.f; S1[r] = 0.f; S2[r] = 0.f; S3[r] = 0.f; }
        f2_t lf[4]; unsigned qv[4], vv[4];
        const size_t gbase = (size_t)(b * SEQ + widu * 4) * 1024 + h * 128;
#pragma unroll
        for (int i = 0; i < 4; ++i) {
            lf[i] = *(const f2_t*)(LF + gbase + (size_t)i * 1024 + d0);
            qv[i] = *(const unsigned*)(QH + gbase + (size_t)i * 1024 + d0);
            vv[i] = *(const unsigned*)(V + gbase + (size_t)i * 1024 + d0);
        }
        for (int c = 0; c < SEQ / 32; ++c) {
            f2_t run = {0.f, 0.f};
#pragma unroll
            for (int i = 0; i < 4; ++i) run += lf[i];
            *(f2_t*)(tot + wid * 128 + d0) = run;
            __syncthreads();
            f2_t pre = {0.f, 0.f}, last = {0.f, 0.f};
#pragma unroll
            for (int q = 0; q < 8; ++q) {
                const f2_t tq_ = *(const f2_t*)(tot + q * 128 + d0);
                last += tq_;
                if (q < widu) pre += tq_;
            }
            if (widu == 0) { f2_t dv; dv.x = __expf(last.x); dv.y = __expf(last.y); *(f2_t*)(dec + d0) = dv; }
            {
                float k2a[4], k2b[4];
                f2_t rc = pre;
#pragma unroll
                for (int i = 0; i < 4; ++i) {
                    rc += lf[i];
                    const float cu0 = rc.x, cu1 = rc.y;
                    const float kk0 = 1.f - __expf(lf[i].x), kk1 = 1.f - __expf(lf[i].y);
                    const float q0 = bf2f((unsigned short)(qv[i] & 0xffff)) * __expf(cu0), q1 = bf2f((unsigned short)(qv[i] >> 16)) * __expf(cu1);
                    const float kd0 = kk0 * __expf(-cu0), kd1 = kk1 * __expf(-cu1);
                    k2a[i] = kk0 * __expf(last.x - cu0); k2b[i] = kk1 * __expf(last.y - cu1);
                    const int tl = wid * 4 + i;
                    *(unsigned*)(lds + HG_QD_OFF + tl * HG_ROW + d0 * 2) = pack2(q0, q1);
                    *(unsigned*)(lds + HG_KD_OFF + tl * HG_ROW + d0 * 2) = pack2(kd0, kd1);
                }
                uint2 a, bq, va, vb;
                a.x = pack2(k2a[0], k2a[1]); a.y = pack2(k2a[2], k2a[3]);
                bq.x = pack2(k2b[0], k2b[1]); bq.y = pack2(k2b[2], k2b[3]);
                va.x = (vv[0] & 0xffffu) | (vv[1] << 16); va.y = (vv[2] & 0xffffu) | (vv[3] << 16);
                vb.x = (vv[0] >> 16) | (vv[1] & 0xffff0000u); vb.y = (vv[2] >> 16) | (vv[3] & 0xffff0000u);
                *(uint2*)(lds + HG_K2T_OFF + d0 * HG_TROW + wid * 8) = a;
                *(uint2*)(lds + HG_K2T_OFF + (d0 + 1) * HG_TROW + wid * 8) = bq;
                *(uint2*)(lds + HG_VT_OFF + d0 * HG_TROW + wid * 8) = va;
                *(uint2*)(lds + HG_VT_OFF + (d0 + 1) * HG_TROW + wid * 8) = vb;
            }
            __builtin_amdgcn_sched_barrier(0);
            if (c + 1 < SEQ / 32) {
                const size_t gn = gbase + (size_t)(c + 1) * 32 * 1024;
#pragma unroll
                for (int i = 0; i < 4; ++i) {
                    lf[i] = *(const f2_t*)(LF + gn + (size_t)i * 1024 + d0);
                    qv[i] = *(const unsigned*)(QH + gn + (size_t)i * 1024 + d0);
                    vv[i] = *(const unsigned*)(V + gn + (size_t)i * 1024 + d0);
                }
            }
            __syncthreads();
            if (widu < 4) {
            f32x16 X;
#pragma unroll
            for (int r = 0; r < 16; ++r) X[r] = 0.f;
            {
                const char* ka = lds + HG_KD_OFF + l31 * HG_ROW + 16 * h2;
                const char* qa = lds + HG_QD_OFF + l31 * HG_ROW + 16 * h2;
#pragma unroll 2
                for (int ks = 0; ks < 8; ++ks) X = MFMA32(*(const bf16x8*)(ka + 32 * ks), *(const bf16x8*)(qa + 32 * ks), X);
#pragma unroll
                for (int r = 0; r < 16; ++r) { const int srow = (r & 3) + 8 * (r >> 2) + 4 * h2; X[r] = (srow <= l31) ? X[r] : 0.f; }
            }
            f32x16 Oa;
#pragma unroll
            for (int r = 0; r < 16; ++r) Oa[r] = 0.f;
            const int jrow = 32 * wid + l31;
#pragma unroll
            for (int s2 = 0; s2 < 2; ++s2) {
                uint4 xk;
                xk.x = pack2(X[8 * s2], X[8 * s2 + 1]); xk.y = pack2(X[8 * s2 + 2], X[8 * s2 + 3]); xk.z = pack2(X[8 * s2 + 4], X[8 * s2 + 5]); xk.w = pack2(X[8 * s2 + 6], X[8 * s2 + 7]);
                const char* va = lds + HG_VT_OFF + jrow * HG_TROW + (16 * s2 + 4 * h2) * 2;
                const uint2 lo = *(const uint2*)va, hi = *(const uint2*)(va + 16);
                uint4 vb; vb.x = lo.x; vb.y = lo.y; vb.z = hi.x; vb.w = hi.y;
                Oa = MFMA32(__builtin_bit_cast(bf16x8, xk), __builtin_bit_cast(bf16x8, vb), Oa);
            }
            auto qs_term = [&](const f32x16& St, int dt) {
#pragma unroll
                for (int s2 = 0; s2 < 2; ++s2) {
                    uint4 sk;
                    sk.x = pack2(St[8 * s2], St[8 * s2 + 1]); sk.y = pack2(St[8 * s2 + 2], St[8 * s2 + 3]); sk.z = pack2(St[8 * s2 + 4], St[8 * s2 + 5]); sk.w = pack2(St[8 * s2 + 6], St[8 * s2 + 7]);
                    const char* qa = lds + HG_QD_OFF + l31 * HG_ROW + (32 * dt + 16 * s2 + 4 * h2) * 2;
                    const uint2 lo = *(const uint2*)qa, hi = *(const uint2*)(qa + 16);
                    uint4 qb; qb.x = lo.x; qb.y = lo.y; qb.z = hi.x; qb.w = hi.y;
                    Oa = MFMA32(__builtin_bit_cast(bf16x8, qb), __builtin_bit_cast(bf16x8, sk), Oa);
                }
            };
            __builtin_amdgcn_sched_barrier(0);
            qs_term(S0, 0); qs_term(S1, 1);
            __builtin_amdgcn_sched_barrier(0);
            qs_term(S2, 2); qs_term(S3, 3);
            __builtin_amdgcn_sched_barrier(0);
            {
                bf16_t* orow = OR + (size_t)(b * SEQ + c * 32 + 4 * h2) * 1024 + h * 128 + jrow;
#pragma unroll
                for (int r = 0; r < 16; ++r) orow[(size_t)((r & 3) + 8 * (r >> 2)) * 1024] = f2bf(Oa[r]);
            }
            auto s_update = [&](f32x16& St, int dt) {
#pragma unroll
                for (int rq = 0; rq < 4; ++rq) {
                    const f32x4 dc = *(const f32x4*)(dec + 32 * dt + 8 * rq + 4 * h2);
                    St[4 * rq] *= dc[0]; St[4 * rq + 1] *= dc[1]; St[4 * rq + 2] *= dc[2]; St[4 * rq + 3] *= dc[3];
                }
#pragma unroll
                for (int s2 = 0; s2 < 2; ++s2) {
                    const bf16x8 ka = *(const bf16x8*)(lds + HG_K2T_OFF + (32 * dt + l31) * HG_TROW + (16 * s2 + 8 * h2) * 2);
                    const bf16x8 vb = *(const bf16x8*)(lds + HG_VT_OFF + jrow * HG_TROW + (16 * s2 + 8 * h2) * 2);
                    St = MFMA32(ka, vb, St);
                }
            };
            __builtin_amdgcn_sched_barrier(0);
            s_update(S0, 0); s_update(S1, 1);
            __builtin_amdgcn_sched_barrier(0);
            s_update(S2, 2); s_update(S3, 3);
            __builtin_amdgcn_sched_barrier(0);
            }
        }
        __syncthreads();
    }
}

__device__ __forceinline__ void phase_hgrn_post(const Params& p, const Ctx& cx) {
    const int lane = cx.lane;
    const bf16_t* OR = (const bf16_t*)(p.ws + OFF_HA);
    const bf16_t* Gt = (const bf16_t*)(p.ws + OFF_G);
    bf16_t* OA = (bf16_t*)(p.ws + OFF_QH);
    const int col = lane * 16;
    float gn[16];
#pragma unroll
    for (int i = 0; i < 16; ++i) gn[i] = p.hgrn_out_gain[(col & 127) + i];
    for (int row = cx.vbid * NWAVE + cx.wid; row < NTOK; row += cx.G * NWAVE) {
        const uint4 a0 = *(const uint4*)(OR + (size_t)row * 1024 + col), a1 = *(const uint4*)(OR + (size_t)row * 1024 + col + 8);
        const uint4 g0 = *(const uint4*)(Gt + (size_t)row * 1024 + col), g1 = *(const uint4*)(Gt + (size_t)row * 1024 + col + 8);
        const unsigned aw[8] = {a0.x, a0.y, a0.z, a0.w, a1.x, a1.y, a1.z, a1.w};
        const unsigned gw[8] = {g0.x, g0.y, g0.z, g0.w, g1.x, g1.y, g1.z, g1.w};
        float o[16];
        float ss = 0.f;
#pragma unroll
        for (int i = 0; i < 8; ++i) { o[2 * i] = bf2f((unsigned short)(aw[i] & 0xffff)); o[2 * i + 1] = bf2f((unsigned short)(aw[i] >> 16)); ss += o[2 * i] * o[2 * i] + o[2 * i + 1] * o[2 * i + 1]; }
        ss += __shfl_xor(ss, 1); ss += __shfl_xor(ss, 2); ss += __shfl_xor(ss, 4);
        const float r = rsqrtf(ss * (1.f / 128.f) + EPS);
        unsigned w[8];
#pragma unroll
        for (int i = 0; i < 8; ++i)
            w[i] = pack2(o[2 * i] * r * gn[2 * i] * bf2f((unsigned short)(gw[i] & 0xffff)), o[2 * i + 1] * r * gn[2 * i + 1] * bf2f((unsigned short)(gw[i] >> 16)));
        uint4 o0, o1; o0.x = w[0]; o0.y = w[1]; o0.z = w[2]; o0.w = w[3]; o1.x = w[4]; o1.y = w[5]; o1.z = w[6]; o1.w = w[7];
        *(uint4*)(OA + (size_t)row * 1024 + col) = o0;
        *(uint4*)(OA + (size_t)row * 1024 + col + 8) = o1;
    }
}


#define XB_TMO      128
#define XB_XCNT(j)  (256  + 64 * (j))
#define XB_XSUB(j)  (1280 + 64 * (j))
#define XB_XGEN(j)  (2304 + 64 * (j))
#define XB_TOP      3328
#define XB_TOPGEN   3392
#define XCD_BAR_WORDS 3456
#define XB_SPIN_CAP (1u << 20)
#define LAS __attribute__((address_space(3)))
__device__ __forceinline__ unsigned xb_ld(unsigned* p)              { return __hip_atomic_load(p, __ATOMIC_RELAXED, __HIP_MEMORY_SCOPE_AGENT); }
__device__ __forceinline__ unsigned xb_add(unsigned* p, unsigned v) { return __hip_atomic_fetch_add(p, v, __ATOMIC_RELAXED, __HIP_MEMORY_SCOPE_AGENT); }
__device__ __forceinline__ unsigned xb_xcc_id() { return (unsigned)__builtin_amdgcn_s_getreg((3 << 11) | 20) & 0xFu; }
#define XB_SPIN(cond, bar) do { unsigned _sp = 0; while (cond) { __builtin_amdgcn_s_sleep(1); \
    if ((++_sp & 255u) == 0u) { if (xb_ld(&(bar)[XB_TMO])) break; if (_sp > XB_SPIN_CAP) { atomicAdd(&(bar)[XB_TMO], 1u); break; } } } } while (0)
struct XcdBarrier { unsigned* bar; unsigned x; volatile unsigned* st; };
__device__ __forceinline__ XcdBarrier xcd_barrier_post(unsigned* bar, volatile unsigned* st) {
    XcdBarrier b; b.bar = bar; b.x = xb_xcc_id(); b.st = st;
    if (threadIdx.x == 0) (void)xb_add(&bar[XB_XCNT(b.x)], 1u);
    return b;
}
__device__ __forceinline__ void xcd_barrier_complete(unsigned* bar, unsigned x, unsigned& nloc, unsigned& nx) {
    const unsigned G = gridDim.x * gridDim.y * gridDim.z;
    unsigned sum, cnt, mine, sp = 0u;
    for (;;) {
        sum = 0u; cnt = 0u; mine = 0u;
#pragma unroll
        for (unsigned j = 0; j < 16; ++j) { const unsigned c = xb_ld(&bar[XB_XCNT(j)]); sum += c; cnt += (c > 0u) ? 1u : 0u; mine = (j == x) ? c : mine; }
        if (sum == G) break;
        __builtin_amdgcn_s_sleep(1);
        if ((++sp & 255u) == 0u) { if (xb_ld(&bar[XB_TMO])) break; if (sp > XB_SPIN_CAP) { atomicAdd(&bar[XB_TMO], 1u); break; } }
    }
    nloc = mine > 0u ? mine : 1u; nx = cnt > 0u ? cnt : 1u;
}
__device__ __forceinline__ void xcd_barrier(const XcdBarrier& b) {
    asm volatile("s_waitcnt vmcnt(0)" ::: "memory");
    __syncthreads();
    if (threadIdx.x == 0) {
        unsigned* bar = b.bar;
        __builtin_amdgcn_s_waitcnt(0);
        unsigned nloc = b.st[0], nx = b.st[1];
        if (nloc == 0u) { xcd_barrier_complete(bar, b.x, nloc, nx); b.st[0] = nloc; b.st[1] = nx; }
        const unsigned old = xb_add(&bar[XB_XSUB(b.x)], 1u);
        const unsigned gen = old / nloc;
        if (old + 1u == (gen + 1u) * nloc) {
            __builtin_amdgcn_fence(__ATOMIC_RELEASE, "agent");
            asm volatile("s_waitcnt vmcnt(0)" ::: "memory");
            const unsigned og = xb_add(&bar[XB_TOP], 1u);
            const unsigned tg = og / nx;
            if (og + 1u == (tg + 1u) * nx) xb_add(&bar[XB_TOPGEN], 1u);
            else XB_SPIN(xb_ld(&bar[XB_TOPGEN]) == tg, bar);
            __builtin_amdgcn_fence(__ATOMIC_ACQUIRE, "agent");
            xb_add(&bar[XB_XGEN(b.x)], 1u);
            asm volatile("s_waitcnt vmcnt(0)" ::: "memory");
        } else {
            XB_SPIN(xb_ld(&bar[XB_XGEN(b.x)]) == gen, bar);
            __builtin_amdgcn_fence(__ATOMIC_ACQUIRE, "agent");
            asm volatile("s_waitcnt vmcnt(0)" ::: "memory");
        }
    }
    __syncthreads();
}

template <int PH>
__device__ __forceinline__ void run_phase(const Params& p, const Ctx& cx, char* lds) {
    if constexpr (PH == 0) phase0(p, cx, lds);
    else if constexpr (PH == 1) rows_phase<false, true, false>(p, cx, lds, p.x, nullptr, 0, 0, 0, 0);
    else if constexpr (PH == 2) phase_nsa_inproj(p, cx, lds);
    else if constexpr (PH == 3) phase_cmp1(p, cx, lds);
    else if constexpr (PH == 4) phase_cmp2(p, cx);
    else if constexpr (PH == 5) phase_attn(p, cx, lds);
    else if constexpr (PH == 6) phase_outproj(p, cx, lds, (const bf16_t*)(p.ws + OFF_HA), (const bf16_t*)(p.ws + OFF_W_NSA_OUT), p.x, 0);
    else if constexpr (PH == 7) rows_router_phase(p, cx, lds, p.out, 1, 0);
    else if constexpr (PH == 8) phase_moe_up(p, cx, lds, 0);
    else if constexpr (PH == 9) phase_moe_down(p, cx, lds, 0);
    else if constexpr (PH == 10) rows_phase<true, true, false>(p, cx, lds, p.out, p.out, 1, 2, 0, 0);
    else if constexpr (PH == 11) phase_hgrn_inproj(p, cx, lds);
    else if constexpr (PH == 12) phase_hgrn_rec(p, cx, lds);
    else if constexpr (PH == 13) phase_hgrn_post(p, cx);
    else if constexpr (PH == 14) phase_outproj(p, cx, lds, (const bf16_t*)(p.ws + OFF_QH), (const bf16_t*)(p.ws + OFF_W_HG_OUT), p.out, 2);
    else if constexpr (PH == 15) rows_router_phase(p, cx, lds, p.out, 3, 1);
    else if constexpr (PH == 16) phase_moe_up(p, cx, lds, 1);
    else if constexpr (PH == 17) phase_moe_down(p, cx, lds, 1);
    else if constexpr (PH == 18) rows_phase<true, false, false>(p, cx, lds, p.out, p.out, 3, 0, 0, 1);
}

__device__ __forceinline__ Ctx make_ctx() {
    Ctx cx;
    cx.G = gridDim.x; cx.tid = threadIdx.x; cx.wid = threadIdx.x >> 6; cx.lane = threadIdx.x & 63;
    cx.vbid = (cx.G % 8 == 0) ? (blockIdx.x % 8) * (cx.G / 8) + blockIdx.x / 8 : blockIdx.x;
    return cx;
}

#if MULTI_LAUNCH
template <int PH>
__global__ void __launch_bounds__(NTHR, 2) phase_kernel(Params p) {
    extern __shared__ __attribute__((aligned(16))) char lds[];
    const Ctx cx = make_ctx();
    run_phase<PH>(p, cx, lds);
}
template <int PH>
static void launch_phases(const Params& p, int grid, hipStream_t stream) {
    (void)hipFuncSetAttribute((const void*)phase_kernel<PH>, hipFuncAttributeMaxDynamicSharedMemorySize, LDS_BYTES);
    hipLaunchKernelGGL(phase_kernel<PH>, dim3(grid), dim3(NTHR), LDS_BYTES, stream, p);
    if constexpr (PH + 1 < NPHASE) launch_phases<PH + 1>(p, grid, stream);
}
#else
template <int PH>
__device__ __forceinline__ void run_from(const Params& p, const Ctx& cx, char* lds, cg::grid_group& grid, const XcdBarrier& xb) {
    run_phase<PH>(p, cx, lds);
#ifdef PROBE_MASK
    if constexpr ((PROBE_MASK >> PH) & 1) { xcd_barrier(xb); run_phase<PH>(p, cx, lds); }
#endif
    if constexpr (PH + 1 < NPHASE) {
        if constexpr (PH == 0) grid.sync();
        else xcd_barrier(xb);
        run_from<PH + 1>(p, cx, lds, grid, xb);
    }
}
__global__ void __launch_bounds__(NTHR, 2) mega_kernel(Params p) {
    extern __shared__ __attribute__((aligned(16))) char lds[];
    cg::grid_group grid = cg::this_grid();
    const Ctx cx = make_ctx();
    volatile unsigned* st = (volatile unsigned*)(lds + LDS_BYTES - 16);
    if (threadIdx.x == 0) { st[0] = 0u; st[1] = 0u; }
    __syncthreads();
    const XcdBarrier xb = xcd_barrier_post((unsigned*)(p.ws + OFF_BAR), st);
    run_from<0>(p, cx, lds, grid, xb);
}
#endif

extern "C" void kernel_launch(void* const* d_in, const int* in_sizes, int n_in, void* d_out, int out_size, void* d_ws, size_t ws_size,
                              hipStream_t stream) {
    static int grid = 0;
    if (!grid) {
        int dev = 0, cus = 0, per_cu = 0;
        (void)hipGetDevice(&dev);
        (void)hipDeviceGetAttribute(&cus, hipDeviceAttributeMultiprocessorCount, dev);
#if MULTI_LAUNCH
        per_cu = 1;
#else
        (void)hipFuncSetAttribute((const void*)mega_kernel, hipFuncAttributeMaxDynamicSharedMemorySize, LDS_BYTES);
        (void)hipOccupancyMaxActiveBlocksPerMultiprocessor(&per_cu, mega_kernel, NTHR, LDS_BYTES);
        if (per_cu > 1) per_cu = 1;
        if (per_cu < 1) { fprintf(stderr, "kernel_launch: occupancy query says 0 blocks per CU (LDS %d B)\n", LDS_BYTES); per_cu = 1; }
#endif
        if (cus <= 0) cus = 256;
        grid = cus * per_cu;
        if (ws_size < WS_NEED) fprintf(stderr, "kernel_launch: workspace too small: %zu < %zu\n", ws_size, (size_t)WS_NEED);
    }
    Params p{};
    p.x = (const float*)d_in[0]; p.c = (const float*)d_in[1]; p.ada_w = (const float*)d_in[2]; p.ada_b = (const float*)d_in[3];
    p.norm_g = (const float*)d_in[4]; p.rel_bias = (const float*)d_in[5]; p.nsa_w_in = (const float*)d_in[6]; p.nsa_q_gain = (const float*)d_in[7];
    p.nsa_k_gain = (const float*)d_in[8]; p.nsa_cmp_pe = (const float*)d_in[9]; p.nsa_cmp_w1 = (const float*)d_in[10]; p.nsa_cmp_w2 = (const float*)d_in[11];
    p.nsa_w_out = (const float*)d_in[12]; p.hgrn_w_in = (const float*)d_in[13]; p.hgrn_lb = (const float*)d_in[14]; p.hgrn_out_gain = (const float*)d_in[15];
    p.hgrn_w_out = (const float*)d_in[16]; p.moe_rg = (const float*)d_in[17]; p.moe_re = (const float*)d_in[18]; p.moe_w1 = (const float*)d_in[19];
    p.moe_w3 = (const float*)d_in[20]; p.moe_w2 = (const float*)d_in[21];
    p.out = (float*)d_out; p.ws = (char*)d_ws;
#if MULTI_LAUNCH
    launch_phases<0>(p, grid, stream);
#else
    p.p_begin = 0; p.p_end = NPHASE;
    (void)hipMemsetAsync((char*)d_ws + OFF_BAR, 0, XCD_BAR_WORDS * 4, stream);
    void* args[] = {&p};
    hipError_t e = hipLaunchCooperativeKernel((void*)mega_kernel, dim3(grid), dim3(NTHR), args, LDS_BYTES, stream);
    if (e != hipSuccess) fprintf(stderr, "cooperative launch failed: %s (grid %d)\n", hipGetErrorString(e), grid);
#endif
}
```

```cpp
#include <hip/hip_runtime.h>
#include <hip/hip_cooperative_groups.h>
#include <cstdio>
#include <cstdint>
namespace cg = cooperative_groups;

#ifndef MULTI_LAUNCH
#define MULTI_LAUNCH 0
#endif

typedef unsigned short bf16_t;
typedef short bf16x8 __attribute__((ext_vector_type(8)));
typedef float f32x4 __attribute__((ext_vector_type(4)));
typedef float f32x16 __attribute__((ext_vector_type(16)));

constexpr int NTOK = 32768, DM = 1024, SEQ = 2048, NBATCH = 16;
constexpr int NSA_IN = 2608, NSA_IN_PAD = 2816;
constexpr float EPS = 1e-6f;
constexpr size_t MiB = 1ull << 20;

constexpr size_t OFF_CNT = 0;
constexpr size_t OFF_MOD = 4096;
constexpr size_t OFF_LB = OFF_MOD + 786432;
constexpr size_t OFF_PEB = OFF_LB + 4096;
constexpr size_t OFF_BAR = 921600;
constexpr size_t OFF_W_NSA_IN = 1 * MiB;
constexpr size_t OFF_W_NSA_OUT = OFF_W_NSA_IN + 2816ull * 1024 * 2;
constexpr size_t OFF_W_HG_IN = OFF_W_NSA_OUT + 1024ull * 1024 * 2;
constexpr size_t OFF_W_HG_OUT = OFF_W_HG_IN + 4096ull * 1024 * 2;
constexpr size_t OFF_W_CMP1 = OFF_W_HG_OUT + 1024ull * 1024 * 2;
constexpr size_t OFF_W_UP = OFF_W_CMP1 + 2ull * 128 * 2048 * 2;
constexpr size_t OFF_W_DN = OFF_W_UP + 32ull * 1024 * 1024 * 2;
constexpr size_t OFF_W_END = OFF_W_DN + 32ull * 1024 * 512 * 2;
constexpr size_t OFF_HA = 116 * MiB;
static_assert(OFF_W_END <= OFF_HA, "weights overflow");
constexpr size_t OFF_SCR = 180 * MiB;
constexpr size_t OFF_Q = OFF_SCR;
constexpr size_t OFF_KCRAW = OFF_Q + 64 * MiB;
constexpr size_t OFF_VCRAW = OFF_KCRAW + 17 * MiB;
constexpr size_t OFF_KS = OFF_VCRAW + 17 * MiB;
constexpr size_t OFF_VS = OFF_KS + 16 * MiB;
constexpr size_t OFF_KW = OFF_VS + 16 * MiB;
constexpr size_t OFF_VW = OFF_KW + 16 * MiB;
constexpr size_t OFF_GATES = OFF_VW + 16 * MiB;
constexpr size_t OFF_T1 = OFF_GATES + 6 * MiB;
constexpr size_t OFF_KC = OFF_T1 + 4 * MiB;
constexpr size_t OFF_VC = OFF_KC + 1 * MiB;
constexpr size_t OFF_H1 = OFF_SCR;
constexpr size_t OFF_Y = OFF_H1 + 64 * MiB;
constexpr size_t OFF_LTOK = OFF_Y + 128 * MiB;
constexpr size_t OFF_LW = OFF_LTOK + 2 * MiB;
constexpr size_t OFF_TSLOT = OFF_LW + 2 * MiB;
constexpr size_t OFF_QH = OFF_SCR;
constexpr size_t OFF_LF = OFF_QH + 64 * MiB;
constexpr size_t OFF_V = OFF_LF + 128 * MiB;
constexpr size_t OFF_G = OFF_V + 64 * MiB;
constexpr size_t WS_NEED = OFF_G + 64 * MiB;
static_assert(WS_NEED <= 512 * MiB, "ws overflow");

constexpr int NTHR = 512, NWAVE = 8;
constexpr int GEMM_STAGE = 49152, GEMM_NSTAGE = 3;
constexpr int LDS_TAB_OFF = GEMM_STAGE * GEMM_NSTAGE;
constexpr int LDS_BYTES = LDS_TAB_OFF + 256 + 16;
constexpr int NPHASE = 19;

struct Params {
    const float *x, *c, *ada_w, *ada_b, *norm_g, *rel_bias, *nsa_w_in, *nsa_q_gain, *nsa_k_gain, *nsa_cmp_pe, *nsa_cmp_w1,
        *nsa_cmp_w2, *nsa_w_out, *hgrn_w_in, *hgrn_lb, *hgrn_out_gain, *hgrn_w_out, *moe_rg, *moe_re, *moe_w1, *moe_w3, *moe_w2;
    float* out;
    char* ws;
    int p_begin, p_end;
};

__device__ __forceinline__ float bf2f(unsigned short h) { return __uint_as_float((unsigned)h << 16); }
__device__ __forceinline__ unsigned short f2bf(float f) {
    unsigned u = __float_as_uint(f);
    u += 0x7fffu + ((u >> 16) & 1u);
    return (unsigned short)(u >> 16);
}
typedef __bf16 bf2_t __attribute__((ext_vector_type(2)));
typedef float f2_t __attribute__((ext_vector_type(2)));
__device__ __forceinline__ unsigned pack2(float a, float b) {
    f2_t v = {a, b};
    return __builtin_bit_cast(unsigned, __builtin_convertvector(v, bf2_t));
}
__device__ __forceinline__ float wave_sum(float v) {
#pragma unroll
    for (int o = 32; o; o >>= 1) v += __shfl_xor(v, o);
    return v;
}
__device__ __forceinline__ float wave_max(float v) {
#pragma unroll
    for (int o = 32; o; o >>= 1) v = fmaxf(v, __shfl_xor(v, o));
    return v;
}
__device__ __forceinline__ float silu_f(float x) { return x / (1.f + __expf(-x)); }
__device__ __forceinline__ float sigmoid_f(float x) { return 1.f / (1.f + __expf(-x)); }
__device__ __forceinline__ void glds16(const void* g, void* l) {
    __builtin_amdgcn_global_load_lds((const unsigned*)g, (unsigned*)l, 16, 0, 0);
}
__device__ __forceinline__ int t5_bucket(int n) {
    if (n < 16) return n;
    int b = 16;
    b += (n >= 21); b += (n >= 27); b += (n >= 35); b += (n >= 46); b += (n >= 59); b += (n >= 77); b += (n >= 99); b += (n >= 128);
    b += (n >= 166); b += (n >= 216); b += (n >= 280); b += (n >= 363); b += (n >= 470); b += (n >= 609); b += (n >= 790);
    return b;
}

struct Ctx {
    int G, vbid, tid, wid, lane;
};

constexpr int P0_MOD_ITEMS = 192;
constexpr int TS0 = 88 * 16, TS1 = 32 * 16, TS2 = 128 * 16, TS3 = 32 * 16, TS4 = 2 * 4 * 32, TS5 = 32 * 32 * 16, TS6 = 32 * 32 * 8;
constexpr int TC0 = 0, TC1 = TC0 + TS0, TC2 = TC1 + TS1, TC3 = TC2 + TS2, TC4 = TC3 + TS3, TC5 = TC4 + TS4, TC6 = TC5 + TS5, TC_END = TC6 + TS6;

struct TrJob { const float* src; int ld, c0, ncols_valid, k0; bf16_t* dst; int dstld; };
__device__ __forceinline__ void tr_load(const TrJob& j, float* tl, int htid) {
    const int k = htid >> 2, cc = (htid & 3) * 8;
    const float* s = j.src + (size_t)(j.k0 + k) * j.ld + j.c0 + cc;
#pragma unroll
    for (int i = 0; i < 8; ++i) tl[k * 33 + cc + i] = (j.c0 + cc + i < j.ncols_valid) ? s[i] : 0.f;
}
__device__ __forceinline__ void tr_store(const TrJob& j, const float* tl, int htid) {
    const int n = htid >> 3, kc = (htid & 7) * 8;
    uint4 o;
    o.x = pack2(tl[(kc + 0) * 33 + n], tl[(kc + 1) * 33 + n]); o.y = pack2(tl[(kc + 2) * 33 + n], tl[(kc + 3) * 33 + n]);
    o.z = pack2(tl[(kc + 4) * 33 + n], tl[(kc + 5) * 33 + n]); o.w = pack2(tl[(kc + 6) * 33 + n], tl[(kc + 7) * 33 + n]);
    *(uint4*)(j.dst + (size_t)n * j.dstld + kc) = o;
}
__device__ __forceinline__ TrJob tr_job(const Params& p, int tt) {
    TrJob j;
    if (tt < TC1) {
        const int nt = tt / 16, kt = tt % 16;
        j = {p.nsa_w_in, NSA_IN, nt * 32, NSA_IN, kt * 64, (bf16_t*)(p.ws + OFF_W_NSA_IN) + (size_t)nt * 32 * 1024 + kt * 64, 1024};
    } else if (tt < TC2) {
        const int u = tt - TC1, nt = u / 16, kt = u % 16;
        j = {p.nsa_w_out, 1024, nt * 32, 1024, kt * 64, (bf16_t*)(p.ws + OFF_W_NSA_OUT) + (size_t)nt * 32 * 1024 + kt * 64, 1024};
    } else if (tt < TC3) {
        const int u = tt - TC2, nt = u / 16, kt = u % 16;
        j = {p.hgrn_w_in, 4096, nt * 32, 4096, kt * 64, (bf16_t*)(p.ws + OFF_W_HG_IN) + (size_t)nt * 32 * 1024 + kt * 64, 1024};
    } else if (tt < TC4) {
        const int u = tt - TC3, nt = u / 16, kt = u % 16;
        j = {p.hgrn_w_out, 1024, nt * 32, 1024, kt * 64, (bf16_t*)(p.ws + OFF_W_HG_OUT) + (size_t)nt * 32 * 1024 + kt * 64, 1024};
    } else if (tt < TC5) {
        const int u = tt - TC4, kv = u / 128, r = u % 128, nt = r / 32, kt = r % 32;
        j = {p.nsa_cmp_w1 + (size_t)kv * 2048 * 64, 64, nt * 32, 64, kt * 64, (bf16_t*)(p.ws + OFF_W_CMP1) + ((size_t)kv * 128 + nt * 32) * 2048 + kt * 64, 2048};
    } else if (tt < TC6) {
        const int u = tt - TC5, le = u / 512, r = u % 512, gr = r / 16, kt = r % 16;
        const int t = gr >> 2, wc = (gr >> 1) & 1, which = gr & 1;
        const float* src = (which ? p.moe_w3 : p.moe_w1) + (size_t)le * 1024 * 512;
        j = {src, 512, (t * 2 + wc) * 32, 512, kt * 64, (bf16_t*)(p.ws + OFF_W_UP) + ((size_t)le * 1024 + gr * 32) * 1024 + kt * 64, 1024};
    } else {
        const int u = tt - TC6, le = u / 256, r = u % 256, nt = r / 8, kt = r % 8;
        j = {p.moe_w2 + (size_t)le * 512 * 1024, 1024, nt * 32, 1024, kt * 64, (bf16_t*)(p.ws + OFF_W_DN) + ((size_t)le * 1024 + nt * 32) * 512 + kt * 64, 512};
    }
    return j;
}

__device__ __forceinline__ void phase0(const Params& p, const Ctx& cx, char* lds) {
    const int tid = cx.tid, wid = cx.wid, lane = cx.lane;
    for (int it = cx.vbid; it < P0_MOD_ITEMS; it += cx.G) {
        const int colbase = it * 64, ls = colbase / 3072, e0 = colbase % 3072;
        const float* W = p.ada_w + (size_t)ls * 1024 * 3072 + e0 + lane;
        float* cs = (float*)lds + wid * 1024;
        float* red = (float*)lds + 8192;
        float acc[16];
#pragma unroll
        for (int b = 0; b < 16; ++b) acc[b] = 0.f;
        for (int sub = 0; sub < 2; ++sub) {
            const int kb = wid * 128 + sub * 64;
#pragma unroll
            for (int b = 0; b < 16; ++b) cs[lane * 16 + b] = silu_f(p.c[b * 1024 + kb + lane]);
            __builtin_amdgcn_wave_barrier();
            for (int kk = 0; kk < 64; ++kk) {
                const float w = W[(size_t)(kb + kk) * 3072];
                const f32x4* cv = (const f32x4*)(cs + kk * 16);
#pragma unroll
                for (int q = 0; q < 4; ++q) {
                    f32x4 c4 = cv[q];
                    acc[q * 4 + 0] += c4[0] * w; acc[q * 4 + 1] += c4[1] * w; acc[q * 4 + 2] += c4[2] * w; acc[q * 4 + 3] += c4[3] * w;
                }
            }
            __builtin_amdgcn_wave_barrier();
        }
#pragma unroll
        for (int b = 0; b < 16; ++b) red[(wid * 16 + b) * 64 + lane] = acc[b];
        __syncthreads();
        float* mod = (float*)(p.ws + OFF_MOD);
#pragma unroll
        for (int i = 0; i < 2; ++i) {
            const int o = tid + i * NTHR, b = o >> 6, e = o & 63;
            float sm = 0.f;
#pragma unroll
            for (int w = 0; w < 8; ++w) sm += red[(w * 16 + b) * 64 + e];
            mod[((size_t)ls * 16 + b) * 3072 + e0 + e] = sm + p.ada_b[ls * 3072 + e0 + e];
        }
        __syncthreads();
    }
    {
        const int half = tid >> 8, htid = tid & 255;
        float* tl = (float*)lds + half * (64 * 33);
        for (int base = cx.vbid * 2; base < TC_END; base += cx.G * 2) {
            const int tt = base + half;
            const bool on = tt < TC_END;
            TrJob j = tr_job(p, on ? tt : 0);
            if (on) tr_load(j, tl, htid);
            __syncthreads();
            if (on) tr_store(j, tl, htid);
            __syncthreads();
        }
    }
    if (cx.vbid == cx.G - 1) {
        float* lb = (float*)(p.ws + OFF_LB);
        for (int i = tid; i < 1024; i += NTHR) lb[i] = sigmoid_f(p.hgrn_lb[1024 + i] - p.hgrn_lb[i]);
        if (tid < 128) {
            const int kv = tid >> 6, d = tid & 63;
            const float* pe = p.nsa_cmp_pe + kv * 2048;
            const float* w1 = p.nsa_cmp_w1 + (size_t)kv * 2048 * 64 + d;
            float sm = 0.f;
            for (int k = 0; k < 2048; ++k) sm += pe[k] * w1[(size_t)k * 64];
            ((float*)(p.ws + OFF_PEB))[tid] = sm;
        }
        if (tid < 32) ((int*)(p.ws + OFF_CNT))[tid] = 0;
    }
}

template <bool COMBINE, bool NORM, bool ROUTER>
__device__ __forceinline__ void rows_phase(const Params& p, const Ctx& cx, char* lds, const float* __restrict__ src, float* __restrict__ xdst,
                           int ls_comb, int ls_norm, int layer_router, int layer_comb) {
    const int lane = cx.lane;
    const float* mod = (const float*)(p.ws + OFF_MOD);
    int my_off = 0;
    if (COMBINE) {
        const int* cnt = (const int*)(p.ws + OFF_CNT) + layer_comb * 16;
        int cv = (lane < 16) ? cnt[lane] : 0;
        int incl = cv;
#pragma unroll
        for (int o = 1; o < 16; o <<= 1) { int t = __shfl_up(incl, o); if (lane >= o) incl += t; }
        my_off = incl - cv;
    }
    for (int row = cx.vbid * NWAVE + cx.wid; row < NTOK; row += cx.G * NWAVE) {
        const int b = row >> 11;
        f32x4 v[4];
#pragma unroll
        for (int i = 0; i < 4; ++i) v[i] = *(const f32x4*)(src + (size_t)row * 1024 + (i * 64 + lane) * 4);
        if (COMBINE) {
            const int* ts = (const int*)(p.ws + OFF_TSLOT) + row * 2;
            const int s0 = ts[0], s1 = ts[1];
            const int r0 = __shfl(my_off, s0 >> 16) + (s0 & 0xffff), r1 = __shfl(my_off, s1 >> 16) + (s1 & 0xffff);
            const bf16_t* Y = (const bf16_t*)(p.ws + OFF_Y);
            const float* gate = mod + ((size_t)ls_comb * 16 + b) * 3072 + 2048;
#pragma unroll
            for (int i = 0; i < 4; ++i) {
                const int col = (i * 64 + lane) * 4;
                uint2 a = *(const uint2*)(Y + (size_t)r0 * 1024 + col), c = *(const uint2*)(Y + (size_t)r1 * 1024 + col);
                f32x4 g = *(const f32x4*)(gate + col);
                v[i][0] += g[0] * (bf2f(a.x & 0xffff) + bf2f(c.x & 0xffff));
                v[i][1] += g[1] * (bf2f(a.x >> 16) + bf2f(c.x >> 16));
                v[i][2] += g[2] * (bf2f(a.y & 0xffff) + bf2f(c.y & 0xffff));
                v[i][3] += g[3] * (bf2f(a.y >> 16) + bf2f(c.y >> 16));
                *(f32x4*)(xdst + (size_t)row * 1024 + col) = v[i];
            }
        }
        if (NORM) {
            float ss = 0.f;
#pragma unroll
            for (int i = 0; i < 4; ++i) ss += v[i][0] * v[i][0] + v[i][1] * v[i][1] + v[i][2] * v[i][2] + v[i][3] * v[i][3];
            ss = wave_sum(ss);
            const float r = rsqrtf(ss * (1.f / 1024.f) + EPS);
            const float* gain = p.norm_g + ls_norm * 1024;
            const float* shift = mod + ((size_t)ls_norm * 16 + b) * 3072;
            const float* scale = shift + 1024;
            bf16_t* hA = (bf16_t*)(p.ws + OFF_HA);
            f32x4 rg4 = {0.f, 0.f, 0.f, 0.f}, re0 = rg4, re1 = rg4, re2 = rg4, re3 = rg4;
#pragma unroll
            for (int i = 0; i < 4; ++i) {
                const int col = (i * 64 + lane) * 4;
                f32x4 g = *(const f32x4*)(gain + col), sc = *(const f32x4*)(scale + col), sh = *(const f32x4*)(shift + col);
                f32x4 h;
#pragma unroll
                for (int j = 0; j < 4; ++j) h[j] = v[i][j] * r * g[j] * (1.f + sc[j]) + sh[j];
                uint2 o; o.x = pack2(h[0], h[1]); o.y = pack2(h[2], h[3]);
                *(uint2*)(hA + (size_t)row * 1024 + col) = o;
                if (ROUTER) {
                    const float* rg = p.moe_rg + (size_t)layer_router * 1024 * 4;
                    const float* re = p.moe_re + (size_t)layer_router * 1024 * 16;
#pragma unroll
                    for (int j = 0; j < 4; ++j) {
                        rg4 += h[j] * *(const f32x4*)(rg + (col + j) * 4);
                        re0 += h[j] * *(const f32x4*)(re + (col + j) * 16 + 0);
                        re1 += h[j] * *(const f32x4*)(re + (col + j) * 16 + 4);
                        re2 += h[j] * *(const f32x4*)(re + (col + j) * 16 + 8);
                        re3 += h[j] * *(const f32x4*)(re + (col + j) * 16 + 12);
                    }
                }
            }
            if (ROUTER) {
                float rl[4];
                f32x4 rs0, rs1, rs2, rs3;
#pragma unroll
                for (int j = 0; j < 4; ++j) { rl[j] = wave_sum(rg4[j]); rs0[j] = wave_sum(re0[j]); rs1[j] = wave_sum(re1[j]); rs2[j] = wave_sum(re2[j]); rs3[j] = wave_sum(re3[j]); }
                float gm = fmaxf(fmaxf(rl[0], rl[1]), fmaxf(rl[2], rl[3]));
                float e0 = __expf(rl[0] - gm), e1 = __expf(rl[1] - gm), e2 = __expf(rl[2] - gm), e3 = __expf(rl[3] - gm);
                float gs = e0 + e1 + e2 + e3;
                int grp = 0; float best = rl[0];
                if (rl[1] > best) { best = rl[1]; grp = 1; }
                if (rl[2] > best) { best = rl[2]; grp = 2; }
                if (rl[3] > best) { best = rl[3]; grp = 3; }
                const float pg = __expf(best - gm) / gs;
                const f32x4 lsel = (grp == 0) ? rs0 : (grp == 1) ? rs1 : (grp == 2) ? rs2 : rs3;
                const float l0 = lsel[0], l1 = lsel[1], l2 = lsel[2], l3 = lsel[3];
                const float em = fmaxf(fmaxf(l0, l1), fmaxf(l2, l3));
                float q0 = __expf(l0 - em), q1 = __expf(l1 - em), q2 = __expf(l2 - em), q3 = __expf(l3 - em);
                int i1 = 0; float b1 = q0;
                if (q1 > b1) { b1 = q1; i1 = 1; }
                if (q2 > b1) { b1 = q2; i1 = 2; }
                if (q3 > b1) { b1 = q3; i1 = 3; }
                int i2 = -1; float b2 = -1.f;
                if (i1 != 0 && q0 > b2) { b2 = q0; i2 = 0; }
                if (i1 != 1 && q1 > b2) { b2 = q1; i2 = 1; }
                if (i1 != 2 && q2 > b2) { b2 = q2; i2 = 2; }
                if (i1 != 3 && q3 > b2) { b2 = q3; i2 = 3; }
                const float inv = pg / (b1 + b2);
                if (lane == 0) {
                    int* cnt = (int*)(p.ws + OFF_CNT) + layer_router * 16;
                    int* ltok = (int*)(p.ws + OFF_LTOK);
                    float* lw = (float*)(p.ws + OFF_LW);
                    int* ts = (int*)(p.ws + OFF_TSLOT) + row * 2;
                    const int ea = grp * 4 + i1, eb = grp * 4 + i2;
                    const int pa = atomicAdd(cnt + ea, 1);
                    const int pb = atomicAdd(cnt + eb, 1);
                    ltok[(size_t)ea * NTOK + pa] = row; lw[(size_t)ea * NTOK + pa] = b1 * inv;
                    ltok[(size_t)eb * NTOK + pb] = row; lw[(size_t)eb * NTOK + pb] = b2 * inv;
                    ts[0] = (ea << 16) | pa; ts[1] = (eb << 16) | pb;
                }
            }
        }
    }
}

__device__ __forceinline__ void rows_router_phase(const Params& p, const Ctx& cx, char* lds, const float* __restrict__ src, int ls_norm, int layer) {
    const int lane = cx.lane, tid = cx.tid;
    const int widu = __builtin_amdgcn_readfirstlane(cx.wid);
    const int wq = widu & 3, grp4 = widu >> 2;
    const float* mod = (const float*)(p.ws + OFF_MOD);
    const float* rg = p.moe_rg + (size_t)layer * 1024 * 4;
    const float* re = p.moe_re + (size_t)layer * 1024 * 16;
    float* logit_s = (float*)lds;
    float wr[16][5];
#pragma unroll
    for (int i = 0; i < 4; ++i)
#pragma unroll
        for (int j = 0; j < 4; ++j) {
            const int k = (i * 64 + lane) * 4 + j;
#pragma unroll
            for (int q = 0; q < 5; ++q) {
                const int o = 5 * wq + q;
                wr[i * 4 + j][q] = (o < 4) ? rg[k * 4 + o] : re[k * 16 + o - 4];
            }
            __builtin_amdgcn_sched_barrier(0);
        }
    const float* gain = p.norm_g + ls_norm * 1024;
    bf16_t* hA = (bf16_t*)(p.ws + OFF_HA);
    for (int blk = cx.vbid; blk < NTOK / 32; blk += cx.G) {
        const int R0 = blk * 32, b = R0 >> 11;
        const float* shift = mod + ((size_t)ls_norm * 16 + b) * 3072;
        const float* scale = shift + 1024;
#pragma unroll 1
        for (int r = 0; r < 16; ++r) {
            const int rl_ = grp4 * 16 + r, row = R0 + rl_;
            f32x4 v[4];
#pragma unroll
            for (int i = 0; i < 4; ++i) v[i] = *(const f32x4*)(src + (size_t)row * 1024 + (i * 64 + lane) * 4);
            float ss = 0.f;
#pragma unroll
            for (int i = 0; i < 4; ++i) ss += v[i][0] * v[i][0] + v[i][1] * v[i][1] + v[i][2] * v[i][2] + v[i][3] * v[i][3];
            ss = wave_sum(ss);
            const float rr = rsqrtf(ss * (1.f / 1024.f) + EPS);
            float acc[5] = {0.f, 0.f, 0.f, 0.f, 0.f};
#pragma unroll
            for (int i = 0; i < 4; ++i) {
                const int col = (i * 64 + lane) * 4;
                const f32x4 g = *(const f32x4*)(gain + col), sc = *(const f32x4*)(scale + col), sh = *(const f32x4*)(shift + col);
                f32x4 h;
#pragma unroll
                for (int j = 0; j < 4; ++j) {
                    h[j] = v[i][j] * rr * g[j] * (1.f + sc[j]) + sh[j];
#pragma unroll
                    for (int q = 0; q < 5; ++q) acc[q] += h[j] * wr[i * 4 + j][q];
                }
                if ((r & 3) == wq) {
                    uint2 o; o.x = pack2(h[0], h[1]); o.y = pack2(h[2], h[3]);
                    *(uint2*)(hA + (size_t)row * 1024 + col) = o;
                }
            }
#pragma unroll
            for (int q = 0; q < 5; ++q) acc[q] = wave_sum(acc[q]);
            if (lane == 0) {
#pragma unroll
                for (int q = 0; q < 5; ++q) logit_s[rl_ * 20 + 5 * wq + q] = acc[q];
            }
        }
        __syncthreads();
        if (tid < 32) {
            const int row = R0 + tid;
            const float* rl = logit_s + tid * 20;
            const float gm = fmaxf(fmaxf(rl[0], rl[1]), fmaxf(rl[2], rl[3]));
            const float gs = __expf(rl[0] - gm) + __expf(rl[1] - gm) + __expf(rl[2] - gm) + __expf(rl[3] - gm);
            int grp = 0; float best = rl[0];
            if (rl[1] > best) { best = rl[1]; grp = 1; }
            if (rl[2] > best) { best = rl[2]; grp = 2; }
            if (rl[3] > best) { best = rl[3]; grp = 3; }
            const float pg = __expf(best - gm) / gs;
            const f32x4 lsel = *(const f32x4*)(rl + 4 + 4 * grp);
            const float l0 = lsel[0], l1 = lsel[1], l2 = lsel[2], l3 = lsel[3];
            const float em = fmaxf(fmaxf(l0, l1), fmaxf(l2, l3));
            const float q0 = __expf(l0 - em), q1 = __expf(l1 - em), q2 = __expf(l2 - em), q3 = __expf(l3 - em);
            int i1 = 0; float b1 = q0;
            if (q1 > b1) { b1 = q1; i1 = 1; }
            if (q2 > b1) { b1 = q2; i1 = 2; }
            if (q3 > b1) { b1 = q3; i1 = 3; }
            int i2 = -1; float b2 = -1.f;
            if (i1 != 0 && q0 > b2) { b2 = q0; i2 = 0; }
            if (i1 != 1 && q1 > b2) { b2 = q1; i2 = 1; }
            if (i1 != 2 && q2 > b2) { b2 = q2; i2 = 2; }
            if (i1 != 3 && q3 > b2) { b2 = q3; i2 = 3; }
            const float inv = pg / (b1 + b2);
            int* cnt = (int*)(p.ws + OFF_CNT) + layer * 16;
            int* ltok = (int*)(p.ws + OFF_LTOK);
            float* lw = (float*)(p.ws + OFF_LW);
            int* ts = (int*)(p.ws + OFF_TSLOT) + row * 2;
            const int ea = grp * 4 + i1, eb = grp * 4 + i2;
            const int pa = atomicAdd(cnt + ea, 1);
            const int pb = atomicAdd(cnt + eb, 1);
            ltok[(size_t)ea * NTOK + pa] = row; lw[(size_t)ea * NTOK + pa] = b1 * inv;
            ltok[(size_t)eb * NTOK + pb] = row; lw[(size_t)eb * NTOK + pb] = b2 * inv;
            ts[0] = (ea << 16) | pa; ts[1] = (eb << 16) | pb;
        }
        __syncthreads();
    }
}

__device__ __forceinline__ int stage_col(int tid) { return ((tid & 7) ^ ((tid >> 3) & 7)) * 8; }

template <class Epi>
__device__ __forceinline__ void gemm_tile(const bf16_t* const (&ap)[4], const bf16_t* const (&bp)[2], int K, char* lds, const Ctx& cx, Epi&& epi) {
    const int tid = cx.tid, lane = cx.lane, wr = cx.wid >> 1, wc = cx.wid & 1, fr = lane & 15, fq = lane >> 4;
    f32x4 acc[4][4];
#pragma unroll
    for (int m = 0; m < 4; ++m)
#pragma unroll
        for (int n = 0; n < 4; ++n) acc[m][n] = (f32x4){0.f, 0.f, 0.f, 0.f};
    const int nt = K / 64;
    auto stage = [&](int t, int slot) {
        char* SA = lds + slot * GEMM_STAGE + tid * 16; char* SB = SA + 32768;
        const int ko = t * 64;
#pragma unroll
        for (int i = 0; i < 4; ++i) glds16(ap[i] + ko, SA + i * 8192);
#pragma unroll
        for (int i = 0; i < 2; ++i) glds16(bp[i] + ko, SB + i * 8192);
    };
    __syncthreads();
    stage(0, 0);
    if (nt > 1) stage(1, 1);
    const int x7 = fr & 7;
    const int aoff = (wr * 64 + fr) * 128, boff = 32768 + (wc * 64 + fr) * 128;
    int slot = 0;
    for (int kt = 0; kt < nt; ++kt) {
        if (kt + 1 < nt) asm volatile("s_waitcnt vmcnt(6)" ::: "memory");
        else asm volatile("s_waitcnt vmcnt(0)" ::: "memory");
        __builtin_amdgcn_s_barrier();
        if (kt + 2 < nt) stage(kt + 2, slot >= 1 ? slot - 1 : 2);
        const char* S = lds + slot * GEMM_STAGE;
#pragma unroll
        for (int ks = 0; ks < 2; ++ks) {
            const int pc = ((ks * 4 + fq) ^ x7) * 16;
            bf16x8 Af[4], Bf[4];
#pragma unroll
            for (int m = 0; m < 4; ++m) Af[m] = *(const bf16x8*)(S + aoff + m * 2048 + pc);
#pragma unroll
            for (int n = 0; n < 4; ++n) Bf[n] = *(const bf16x8*)(S + boff + n * 2048 + pc);
#pragma unroll
            for (int m = 0; m < 4; ++m)
#pragma unroll
                for (int n = 0; n < 4; ++n) acc[m][n] = __builtin_amdgcn_mfma_f32_16x16x32_bf16(Bf[n], Af[m], acc[m][n], 0, 0, 0);
        }
        slot = slot == 2 ? 0 : slot + 1;
    }
    epi(acc, wr, wc, fr, fq);
}

__device__ __forceinline__ int swz_g(int q) { return (0x1320 >> (4 * q)) & 3; }
__device__ __forceinline__ int stage_col2(int tid) { return ((tid & 3) ^ swz_g((tid >> 4) & 3)) * 8; }

template <int MODE = 0, class Epi>
__device__ __forceinline__ void gemm_tile2(const bf16_t* const (&ap)[2], const bf16_t* const (&bp)[2], int K, char* lds, const Ctx& cx, Epi&& epi) {
    const int tid = cx.tid, lane = cx.lane, wc = cx.wid & 3, fr = lane & 15, fq = lane >> 4;
    const int wr = __builtin_amdgcn_readfirstlane(cx.wid >> 2);
    f32x4 acc[8][4];
#pragma unroll
    for (int m = 0; m < 8; ++m)
#pragma unroll
        for (int n = 0; n < 4; ++n) acc[m][n] = (f32x4){0.f, 0.f, 0.f, 0.f};
    const int nt = K / 32;
    auto stage = [&](int t) {
        char* SA = lds + (t & 3) * 32768 + tid * 16; char* SB = SA + 16384;
        const int ko = t * 32;
        glds16(ap[0] + ko, SA); glds16(ap[1] + ko, SA + 8192);
        glds16(bp[0] + ko, SB); glds16(bp[1] + ko, SB + 8192);
    };
    __syncthreads();
    stage(0);
    if (nt > 1) stage(1);
    if (nt > 2) stage(2);
    const int pc = (fq ^ swz_g((fr >> 2) & 3)) * 16;
    const int aoff = (wr * 128 + fr) * 64 + pc, boff = 16384 + (wc * 64 + fr) * 64 + pc;
    bf16x8 Af[8], Bf[4];
    auto load_frags = [&](int kt) {
        const char* S = lds + (kt & 3) * 32768;
#pragma unroll
        for (int n = 0; n < 4; ++n) Bf[n] = *(const bf16x8*)(S + boff + n * 1024);
#pragma unroll
        for (int m = 0; m < 8; ++m) Af[m] = *(const bf16x8*)(S + aoff + m * 1024);
        asm volatile("s_waitcnt lgkmcnt(0)" ::: "memory");
    };
    auto mma = [&]() {
        __builtin_amdgcn_s_setprio(1);
#pragma unroll
        for (int m = 0; m < 8; ++m)
#pragma unroll
            for (int n = 0; n < 4; ++n) acc[m][n] = __builtin_amdgcn_mfma_f32_16x16x32_bf16(Bf[n], Af[m], acc[m][n], 0, 0, 0);
        __builtin_amdgcn_s_setprio(0);
    };
    if (nt > 2) asm volatile("s_waitcnt vmcnt(8)" ::: "memory");
    else if (nt == 2) asm volatile("s_waitcnt vmcnt(4)" ::: "memory");
    else asm volatile("s_waitcnt vmcnt(0)" ::: "memory");
    if (wr == 1) __builtin_amdgcn_s_barrier();
    for (int kt = 0; kt < nt; ++kt) {
        const int rem = nt - 1 - kt;
        if (rem >= 2) asm volatile("s_waitcnt vmcnt(8)" ::: "memory");
        else if (rem == 1) asm volatile("s_waitcnt vmcnt(4)" ::: "memory");
        else asm volatile("s_waitcnt vmcnt(0)" ::: "memory");
        __builtin_amdgcn_s_barrier();
        if (kt + 3 < nt) stage(kt + 3);
        load_frags(kt);
        if (rem >= 3) asm volatile("s_waitcnt vmcnt(8)" ::: "memory");
        else if (rem == 2) asm volatile("s_waitcnt vmcnt(4)" ::: "memory");
        else asm volatile("s_waitcnt vmcnt(0)" ::: "memory");
        __builtin_amdgcn_s_barrier();
        mma();
    }
    if (wr == 0) __builtin_amdgcn_s_barrier();
    if (MODE == 0) epi(acc, wr, wc, fr, fq);
    else {
#pragma unroll
        for (int m = 0; m < 8; ++m)
#pragma unroll
            for (int n = 0; n < 4; ++n) asm volatile("" :: "v"(acc[m][n]));
    }
}

template <int MODE = 0, class EpiFactory>
__device__ __forceinline__ void gemm_phase_dense2(const bf16_t* A, int lda, const bf16_t* Bt, int K, int nrt, int nct, char* lds, const Ctx& cx, EpiFactory&& mk) {
    const int tid = cx.tid;
    const int ntiles = nrt * nct;
    const int sc = stage_col2(tid), sr = tid >> 2;
    for (int tile = cx.vbid; tile < ntiles; tile += cx.G) {
        const int rt = tile / nct, ct = tile % nct;
        const bf16_t* a0 = A + (size_t)(rt * 256 + sr) * lda + sc;
        const bf16_t* b0 = Bt + (size_t)(ct * 256 + sr) * K + sc;
        const bf16_t* const ap[2] = {a0, a0 + (size_t)128 * lda};
        const bf16_t* const bp[2] = {b0, b0 + (size_t)128 * K};
        gemm_tile2<MODE>(ap, bp, K, lds, cx, mk(rt * 256, ct * 256));
    }
}

template <class EpiFactory>
__device__ __forceinline__ void gemm_phase_dense(const bf16_t* A, int lda, const bf16_t* Bt, int K, int nrt, int nct, char* lds, const Ctx& cx, EpiFactory&& mk) {
    const int tid = cx.tid;
    const int ntiles = nrt * nct;
    const int sc = stage_col(tid), sr = tid >> 3;
    for (int tile = cx.vbid; tile < ntiles; tile += cx.G) {
        const int rt = tile / nct, ct = tile % nct;
        const bf16_t* a0 = A + (size_t)(rt * 256 + sr) * lda + sc;
        const bf16_t* b0 = Bt + (size_t)(ct * 128 + sr) * K + sc;
        const bf16_t* const ap[4] = {a0, a0 + (size_t)64 * lda, a0 + (size_t)128 * lda, a0 + (size_t)192 * lda};
        const bf16_t* const bp[2] = {b0, b0 + (size_t)64 * K};
        gemm_tile(ap, bp, K, lds, cx, mk(rt * 256, ct * 128));
    }
}

__device__ __forceinline__ void phase_nsa_inproj(const Params& p, const Ctx& cx, char* lds) {
    const bf16_t* A = (const bf16_t*)(p.ws + OFF_HA);
    const bf16_t* Bt = (const bf16_t*)(p.ws + OFF_W_NSA_IN);
    char* ws = p.ws;
    const float* qg = p.nsa_q_gain;
    const float* kg = p.nsa_k_gain;
    gemm_phase_dense2(A, 1024, Bt, 1024, NTOK / 256, NSA_IN_PAD / 256, lds, cx, [=](int row0, int col0) {
        return [=](f32x4 (&acc)[8][4], int wr, int wc, int fr, int fq) {
            const int gc0 = col0 + wc * 64;
            if (gc0 >= NSA_IN) return;
            if (gc0 < 1024 || (gc0 >= 1536 && gc0 < 1792) || (gc0 >= 2048 && gc0 < 2304)) {
                const float* gain; float post; bf16_t* dstb; size_t rstride; size_t coff; bool tokmajor;
                if (gc0 < 1024) { gain = qg; post = 0.125f * 1.4426950408889634f; }
                else if (gc0 < 1792) { gain = kg + 64; post = 1.f; }
                else { gain = kg + 128; post = 1.f; }
#pragma unroll
                for (int m = 0; m < 8; ++m) {
                    __builtin_amdgcn_sched_barrier(0);
                    float ss = 0.f;
#pragma unroll
                    for (int n = 0; n < 4; ++n) ss += acc[m][n][0] * acc[m][n][0] + acc[m][n][1] * acc[m][n][1] + acc[m][n][2] * acc[m][n][2] + acc[m][n][3] * acc[m][n][3];
                    ss += __shfl_xor(ss, 16); ss += __shfl_xor(ss, 32);
                    const float r = rsqrtf(ss * (1.f / 64.f) + EPS) * post;
                    const int row = row0 + wr * 128 + m * 16 + fr;
                    bf16_t* dst;
                    if (gc0 < 1024) dst = (bf16_t*)(ws + OFF_Q) + (size_t)row * 1024 + gc0;
                    else {
                        const int g = ((gc0 - 1024) & 255) >> 6, b = row >> 11, t = row & 2047;
                        dst = (bf16_t*)(ws + (gc0 < 1792 ? OFF_KS : OFF_KW)) + ((size_t)(b * 4 + g) * 2048 + t) * 64;
                    }
#pragma unroll
                    for (int n = 0; n < 4; ++n) {
                        const int c = n * 16 + fq * 4;
                        f32x4 g4 = *(const f32x4*)(gain + c);
                        uint2 o; o.x = pack2(acc[m][n][0] * r * g4[0], acc[m][n][1] * r * g4[1]); o.y = pack2(acc[m][n][2] * r * g4[2], acc[m][n][3] * r * g4[3]);
                        *(uint2*)(dst + c) = o;
                    }
                }
            } else if (gc0 < 2560) {
                const int seg = (gc0 - 1024) >> 8;
                const int g = ((gc0 - 1024) & 255) >> 6;
                if (seg < 2) {
                    const size_t off = seg == 0 ? OFF_KCRAW : OFF_VCRAW;
#pragma unroll
                    for (int m = 0; m < 8; ++m) {
                        __builtin_amdgcn_sched_barrier(0);
                    __builtin_amdgcn_sched_barrier(0);
                        const int row = row0 + wr * 128 + m * 16 + fr, b = row >> 11, t = row & 2047;
                        bf16_t* dst = (bf16_t*)(ws + off) + ((size_t)(b * 4 + g) * 2048 + t) * 64;
#pragma unroll
                        for (int n = 0; n < 4; ++n) {
                            const int c = n * 16 + fq * 4;
                            uint2 o; o.x = pack2(acc[m][n][0], acc[m][n][1]); o.y = pack2(acc[m][n][2], acc[m][n][3]);
                            *(uint2*)(dst + c) = o;
                        }
                    }
                } else {
                    const size_t off = seg == 3 ? OFF_VS : OFF_VW;
#pragma unroll
                    for (int m = 0; m < 8; ++m) {
                        __builtin_amdgcn_sched_barrier(0);
                    __builtin_amdgcn_sched_barrier(0);
                        const int row = row0 + wr * 128 + m * 16 + fr, b = row >> 11, t = row & 2047;
                        bf16_t* dst = (bf16_t*)(ws + off) + (size_t)(b * 4 + g) * 64 * 2048 + t;
#pragma unroll
                        for (int n = 0; n < 4; ++n)
#pragma unroll
                            for (int j = 0; j < 4; ++j) dst[(size_t)(n * 16 + fq * 4 + j) * 2048] = f2bf(acc[m][n][j]);
                    }
                }
            } else {
#pragma unroll
                for (int m = 0; m < 8; ++m) {
                    __builtin_amdgcn_sched_barrier(0);
                    const int row = row0 + wr * 128 + m * 16 + fr;
                    float* dst = (float*)(ws + OFF_GATES) + (size_t)row * 48;
#pragma unroll
                    for (int n = 0; n < 3; ++n) {
                        const int c = n * 16 + fq * 4;
                        f32x4 o;
#pragma unroll
                        for (int j = 0; j < 4; ++j) o[j] = sigmoid_f(acc[m][n][j]);
                        *(f32x4*)(dst + c) = o;
                    }
                }
            }
        };
    });
}

__device__ __forceinline__ void phase_cmp1(const Params& p, const Ctx& cx, char* lds) {
    const int tid = cx.tid;
    const float* peb = (const float*)(p.ws + OFF_PEB);
    float* T1 = (float*)(p.ws + OFF_T1);
    const int sc = stage_col(tid), sr = tid >> 3;
    for (int tile = cx.vbid; tile < 64; tile += cx.G) {
        const int kv = tile >> 5, bg2 = tile & 31;
        const bf16_t* raw = (const bf16_t*)(p.ws + (kv ? OFF_VCRAW : OFF_KCRAW)) + (size_t)bg2 * 2 * 2048 * 64;
        const bf16_t* a0 = raw + (size_t)sr * 1024 + sc;
        const bf16_t* a2 = raw + (size_t)2048 * 64 + (size_t)sr * 1024 + sc;
        const bf16_t* b0 = (const bf16_t*)(p.ws + OFF_W_CMP1) + ((size_t)kv * 128 + sr) * 2048 + sc;
        const bf16_t* const ap[4] = {a0, a0 + (size_t)64 * 1024, a2, a2 + (size_t)64 * 1024};
        const bf16_t* const bp[2] = {b0, b0 + (size_t)64 * 2048};
        gemm_tile(ap, bp, 2048, lds, cx, [=](f32x4 (&acc)[4][4], int wr, int wc, int fr, int fq) {
            if (wc != 0) return;
#pragma unroll
            for (int m = 0; m < 4; ++m) {
                const int r = wr * 64 + m * 16 + fr;
                float* dst = T1 + ((size_t)kv * 8192 + (bg2 * 2 + (r >> 7)) * 128 + (r & 127)) * 64;
#pragma unroll
                for (int n = 0; n < 4; ++n) {
                    const int c = n * 16 + fq * 4;
                    f32x4 pb = *(const f32x4*)(peb + kv * 64 + c);
                    *(f32x4*)(dst + c) = acc[m][n] + pb;
                }
            }
        });
    }
}

__device__ __forceinline__ void phase_cmp2(const Params& p, const Ctx& cx) {
    const int lane = cx.lane;
    const float* T1 = (const float*)(p.ws + OFF_T1);
    for (int r = cx.vbid * NWAVE + cx.wid; r < 2 * 8192; r += cx.G * NWAVE) {
        const int kv = r >> 13, rr = r & 8191, n_ = rr & 127;
        const float s = silu_f(T1[(size_t)r * 64 + lane]);
        const float* w2 = p.nsa_cmp_w2 + kv * 4096 + lane;
        float o = 0.f;
#pragma unroll 8
        for (int j = 0; j < 64; ++j) o += __shfl(s, j) * w2[j * 64];
        if (kv == 0) {
            const float ss = wave_sum(o * o);
            o = o * rsqrtf(ss * (1.f / 64.f) + EPS) * p.nsa_k_gain[lane];
        }
        if (n_ == 127) o = 0.f;
        if (kv == 0) ((bf16_t*)(p.ws + OFF_KC))[(size_t)rr * 64 + lane] = f2bf(o);
        else ((bf16_t*)(p.ws + OFF_VC))[((size_t)(rr >> 7) * 64 + lane) * 128 + n_] = f2bf(o);
    }
}

constexpr int ATT_BUF = 17920, ATT_K_STRIDE = 144, ATT_V_OFF = 9216, ATT_V_STRIDE = 136, ATT_LUT_OFF = 2 * ATT_BUF, LUT_N = 2136, LUT_PAD = 80;
constexpr int ATT_SC_OFF = ATT_LUT_OFF + 4 * LUT_N * 4;
static_assert(ATT_SC_OFF + NWAVE * 8192 <= LDS_TAB_OFF, "attention LDS");
#define MFMA32(a, b, c) __builtin_amdgcn_mfma_f32_32x32x16_bf16((a), (b), (c), 0, 0, 0)
template <int V> struct IC { static constexpr int value = V; };

__device__ __forceinline__ void phase_attn(const Params& p, const Ctx& cx, char* lds) {
    const int tid = cx.tid, lane = cx.lane, wid = cx.wid;
    const int g = cx.vbid & 3;
    const int ql = lane & 7, head = (lane & 31) >> 3, h2 = lane >> 5, l31 = lane & 31;
    float* lut = (float*)(lds + ATT_LUT_OFF);
    for (int i = tid; i < 4 * LUT_N; i += NTHR) {
        const int h = i / LUT_N, dist = i % LUT_N - LUT_PAD;
        lut[i] = dist >= 0 ? p.rel_bias[t5_bucket(dist) * 16 + g * 4 + h] * 1.4426950408889634f : 0.f;
    }
    __syncthreads();
    const float* lutp = lut + head * LUT_N + LUT_PAD;
    const float b31 = lutp[2047];
    const bf16_t* Qb = (const bf16_t*)(p.ws + OFF_Q);
    const bf16_t* KC = (const bf16_t*)(p.ws + OFF_KC);
    const bf16_t* VCT = (const bf16_t*)(p.ws + OFF_VC);
    const bf16_t* KS = (const bf16_t*)(p.ws + OFF_KS);
    const bf16_t* VST = (const bf16_t*)(p.ws + OFF_VS);
    const bf16_t* KW = (const bf16_t*)(p.ws + OFF_KW);
    const bf16_t* VWT = (const bf16_t*)(p.ws + OFF_VW);
    const float* GT = (const float*)(p.ws + OFF_GATES);
    bf16_t* Og = (bf16_t*)(p.ws + OFF_HA);
    float* scw = (float*)(lds + ATT_SC_OFF) + wid * 2048;
    f32x4* outw = (f32x4*)(lds + ATT_SC_OFF + wid * 8192) + lane;
    const bool flip_ok = (cx.G % 128) == 0;
    const int widu = __builtin_amdgcn_readfirstlane(wid);

    for (int it = 0;; ++it) {
        const int u = cx.vbid + it * cx.G;
        if (u >= 2048) break;
        const int rest = u >> 2, b = rest >> 5, qtb = rest & 31;
        const int qt = (flip_ok && (it & 1)) ? 31 - qtb : qtb;
        const int t0 = qt * 64, cur = qt, bg = b * 4 + g;
        const int tq = t0 + wid * 8 + ql;
        const size_t rowtok = (size_t)b * SEQ + tq;
        bf16x8 Qf[4];
        {
            const bf16_t* qp = Qb + rowtok * 1024 + (g * 4 + head) * 64 + 8 * h2;
#pragma unroll
            for (int ks = 0; ks < 4; ++ks) Qf[ks] = *(const bf16x8*)(qp + 16 * ks);
        }
        const float* gt = GT + rowtok * 48 + (g * 4 + head) * 3;
        const float gate_c = gt[0], gate_s = gt[1], gate_w = gt[2];
        const int wlo = max(0, qt - 8);
        const int nW = cur - wlo + 1;
        const int NT = 4 + nW + cur + 1;

        uint4 kr0, vr0;
        auto issue_load = [&](int i) {
            const bf16_t* ksrc; const bf16_t* vsrc; int vstride;
            if (i < 4) { const int ci = i & 1; ksrc = KC + ((size_t)bg * 128 + ci * 64) * 64; vsrc = VCT + (size_t)bg * 64 * 128 + ci * 64; vstride = 128; }
            else if (i < 4 + nW) { const int kb = wlo + i - 4; ksrc = KW + ((size_t)bg * 2048 + kb * 64) * 64; vsrc = VWT + (size_t)bg * 64 * 2048 + kb * 64; vstride = 2048; }
            else { const int kb = i - 4 - nW; ksrc = KS + ((size_t)bg * 2048 + kb * 64) * 64; vsrc = VST + (size_t)bg * 64 * 2048 + kb * 64; vstride = 2048; }
            kr0 = *(const uint4*)(ksrc + tid * 8);
            vr0 = *(const uint4*)(vsrc + (size_t)(tid >> 3) * vstride + (tid & 7) * 8);
        };
        auto write_lds = [&](int i) {
            char* bufp = lds + (i & 1) * ATT_BUF;
            *(uint4*)(bufp + (tid >> 3) * ATT_K_STRIDE + (tid & 7) * 16) = kr0;
            char* va = bufp + ATT_V_OFF + (tid >> 3) * ATT_V_STRIDE + (tid & 7) * 16;
            uint2 t;
            t.x = vr0.x; t.y = vr0.y; *(uint2*)va = t;
            t.x = vr0.z; t.y = vr0.w; *(uint2*)(va + 8) = t;
        };
        f32x16 O0, O1;
#pragma unroll
        for (int r = 0; r < 16; ++r) { O0[r] = 0.f; O1[r] = 0.f; }
        float lsum = 0.f;

        auto qk = [&](const char* bufp, int kt2, float init) -> f32x16 {
            f32x16 S;
#pragma unroll
            for (int r = 0; r < 16; ++r) S[r] = init;
            const char* kp = bufp + (32 * kt2 + l31) * ATT_K_STRIDE + 16 * h2;
#pragma unroll
            for (int ks = 0; ks < 4; ++ks) S = MFMA32(*(const bf16x8*)(kp + 32 * ks), Qf[ks], S);
            return S;
        };
        auto pv = [&](const char* bufp, int kt2, const f32x16& P) {
#pragma unroll
            for (int s2 = 0; s2 < 2; ++s2) {
                uint4 pk;
                pk.x = pack2(P[8 * s2 + 0], P[8 * s2 + 1]); pk.y = pack2(P[8 * s2 + 2], P[8 * s2 + 3]);
                pk.z = pack2(P[8 * s2 + 4], P[8 * s2 + 5]); pk.w = pack2(P[8 * s2 + 6], P[8 * s2 + 7]);
                const bf16x8 Pf = __builtin_bit_cast(bf16x8, pk);
                const char* vp = bufp + ATT_V_OFF + l31 * ATT_V_STRIDE + (32 * kt2 + 16 * s2 + 4 * h2) * 2;
                {
                    uint2 lo = *(const uint2*)vp, hi = *(const uint2*)(vp + 16);
                    uint4 a; a.x = lo.x; a.y = lo.y; a.z = hi.x; a.w = hi.y;
                    O0 = MFMA32(__builtin_bit_cast(bf16x8, a), Pf, O0);
                }
                {
                    uint2 lo = *(const uint2*)(vp + 32 * ATT_V_STRIDE), hi = *(const uint2*)(vp + 32 * ATT_V_STRIDE + 16);
                    uint4 a; a.x = lo.x; a.y = lo.y; a.z = hi.x; a.w = hi.y;
                    O1 = MFMA32(__builtin_bit_cast(bf16x8, a), Pf, O1);
                }
            }
        };
        auto finalize = [&](float gate, int mode) {
            const float Z = lsum + __shfl_xor(lsum, 32);
            const float f = Z > 0.f ? gate / Z : 0.f;
#pragma unroll
            for (int v4 = 0; v4 < 4; ++v4) {
                f32x4 a = {f * O0[4 * v4], f * O0[4 * v4 + 1], f * O0[4 * v4 + 2], f * O0[4 * v4 + 3]};
                f32x4 c = {f * O1[4 * v4], f * O1[4 * v4 + 1], f * O1[4 * v4 + 2], f * O1[4 * v4 + 3]};
                if (mode != 0) { a += outw[v4 * 64]; c += outw[(4 + v4) * 64]; }
                if (mode != 2) { outw[v4 * 64] = a; outw[(4 + v4) * 64] = c; }
                else { O0[4 * v4] = a[0]; O0[4 * v4 + 1] = a[1]; O0[4 * v4 + 2] = a[2]; O0[4 * v4 + 3] = a[3];
                       O1[4 * v4] = c[0]; O1[4 * v4 + 1] = c[1]; O1[4 * v4 + 2] = c[2]; O1[4 * v4 + 3] = c[3]; }
            }
            if (mode != 2) {
#pragma unroll
                for (int r = 0; r < 16; ++r) { O0[r] = 0.f; O1[r] = 0.f; }
            }
            lsum = 0.f;
        };
        auto tile_ws = [&](const char* bufp, int kb, float cinit, auto MMc, auto BMc) {
            constexpr int MM = decltype(MMc)::value, BM = decltype(BMc)::value;
#pragma unroll 1
            for (int kt2 = 0; kt2 < 2; ++kt2) {
                const int d0 = tq - (64 * kb + 32 * kt2 + 4 * h2);
                const float* lp = lutp + (d0 - 27);
                float bv[16];
                if (BM == 0) {
#pragma unroll
                    for (int r = 0; r < 16; ++r) bv[r] = lp[27 - ((r & 3) + 8 * (r >> 2))];
                    __builtin_amdgcn_sched_barrier(0);
                }
                f32x16 S = qk(bufp, kt2, cinit);
#pragma unroll
                for (int r = 0; r < 16; ++r) {
                    const int cr = (r & 3) + 8 * (r >> 2);
                    float x = S[r];
                    if (BM == 0) x += bv[r];
                    if (MM == 1) x += (d0 - cr < 512) ? 0.f : -INFINITY;
                    if (MM == 2) x += (d0 - cr >= 0) ? 0.f : -INFINITY;
                    S[r] = __builtin_amdgcn_exp2f(x);
                    lsum += S[r];
                }
                pv(bufp, kt2, S);
            }
        };

        const int nvis = (tq >= 31) ? min((tq - 31) / 16 + 1, 127) : 0;
        float inv_c = 0.f;
        unsigned selmask = 0u;
        float* sown = scw + ql * 32;
        float* stail = scw + 256 + ql * 32;
        float* ssc = scw + 512 + ql * 32;
        issue_load(0);
        __syncthreads();
        write_lds(0);
        issue_load(1);
        for (int i = 0; i < NT; ++i) {
            __syncthreads();
            const char* bufp = lds + (i & 1) * ATT_BUF;
            if (i < 4) {
                const int ci = i & 1;
#pragma unroll 1
                for (int kt2 = 0; kt2 < 2; ++kt2) {
                    f32x16 S = qk(bufp, kt2, 0.f);
                    const int n0 = 64 * ci + 32 * kt2 + 4 * h2;
                    const int d0 = tq - 31 - 16 * n0;
#pragma unroll
                    for (int r = 0; r < 16; ++r) {
                        const int cr = (r & 3) + 8 * (r >> 2);
                        const float bias = lutp[max(d0 - 16 * cr, -LUT_PAD)];
                        S[r] = __builtin_amdgcn_exp2f(S[r] + bias + ((n0 + cr) < nvis ? 0.f : -INFINITY));
                        lsum += S[r];
                    }
                    if (i >= 2) {
                        pv(bufp, kt2, S);
#pragma unroll
                        for (int rq = 0; rq < 4; ++rq) {
                            float gsum = (S[4 * rq] + S[4 * rq + 1] + S[4 * rq + 2] + 0.5f * S[4 * rq + 3]) * inv_c;
                            float tl = 0.5f * S[4 * rq + 3] * inv_c;
                            gsum += __shfl_xor(gsum, 8); gsum += __shfl_xor(gsum, 16);
                            tl += __shfl_xor(tl, 8); tl += __shfl_xor(tl, 16);
                            const int sblk = 8 * (2 * ci + kt2) + 2 * rq + h2;
                            if (head == 0) {
                                sown[sblk] = gsum;
                                if (sblk < 31) stail[sblk + 1] = tl;
                            }
                        }
                    }
                }
                if (i == 1) {
                    const float Z = lsum + __shfl_xor(lsum, 32);
                    inv_c = Z > 0.f ? 1.f / Z : 0.f;
                    lsum = 0.f;
                }
                if (i == 3) {
                    if (head == 0 && h2 == 0) stail[0] = 0.f;
                    __builtin_amdgcn_wave_barrier();
                    const int j8 = head * 2 + h2;
                    {
                        const f32x4 a = *(const f32x4*)(sown + 4 * j8), t4 = *(const f32x4*)(stail + 4 * j8);
                        f32x4 sc;
#pragma unroll
                        for (int q = 0; q < 4; ++q) {
                            const int sblk = 4 * j8 + q;
                            const bool forced = (sblk == 0) || (sblk == cur) || (sblk == cur - 1);
                            sc[q] = forced ? 1.0e4f : (sblk <= cur ? a[q] + t4[q] : -1.0f);
                        }
                        *(f32x4*)(ssc + 4 * j8) = sc;
                    }
                    __builtin_amdgcn_wave_barrier();
                    const f32x4 own = *(const f32x4*)(ssc + 4 * j8);
                    int rk0 = 0, rk1 = 0, rk2 = 0, rk3 = 0;
                    const int so0 = 4 * j8;
#pragma unroll
                    for (int m4 = 0; m4 < 8; ++m4) {
                        const f32x4 v = *(const f32x4*)(ssc + 4 * m4);
#pragma unroll
                        for (int q = 0; q < 4; ++q) {
                            const int sm = 4 * m4 + q;
                            const float vm = v[q];
                            rk0 += (vm > own[0] || (vm == own[0] && sm < so0)) ? 1 : 0;
                            rk1 += (vm > own[1] || (vm == own[1] && sm < so0 + 1)) ? 1 : 0;
                            rk2 += (vm > own[2] || (vm == own[2] && sm < so0 + 2)) ? 1 : 0;
                            rk3 += (vm > own[3] || (vm == own[3] && sm < so0 + 3)) ? 1 : 0;
                        }
                    }
                    unsigned mk = ((rk0 < 8 ? 1u : 0u) | (rk1 < 8 ? 2u : 0u) | (rk2 < 8 ? 4u : 0u) | (rk3 < 8 ? 8u : 0u)) << so0;
                    mk |= __shfl_xor(mk, 8); mk |= __shfl_xor(mk, 16); mk |= __shfl_xor(mk, 32);
                    selmask = mk;
                    __builtin_amdgcn_wave_barrier();
                    finalize(gate_c, 0);
                }
            } else if (i < 4 + nW) {
                const int kb = wlo + i - 4;
                if (kb == cur) tile_ws(bufp, kb, 0.f, IC<2>{}, IC<0>{});
                else if (kb == cur - 8) tile_ws(bufp, kb, 0.f, IC<1>{}, IC<0>{});
                else tile_ws(bufp, kb, 0.f, IC<0>{}, IC<0>{});
                if (i == 3 + nW) finalize(gate_w, 1);
            } else {
                const int kb = i - 4 - nW;
                const bool sel = ((selmask >> kb) & 1u) != 0;
                if (__ballot(sel) != 0ull) {
                    const float neg = sel ? 0.f : -INFINITY;
                    if (kb == cur) tile_ws(bufp, kb, neg, IC<2>{}, IC<0>{});
                    else if (t0 + 8 * widu - (64 * kb + 63) >= 790) tile_ws(bufp, kb, neg + b31, IC<0>{}, IC<1>{});
                    else tile_ws(bufp, kb, neg, IC<0>{}, IC<0>{});
                }
            }
            if (i + 1 < NT) {
                write_lds(i + 1);
                if (i + 2 < NT) issue_load(i + 2);
            }
        }
        finalize(gate_s, 2);
        {
            bf16_t* op = Og + rowtok * 1024 + (g * 4 + head) * 64 + 4 * h2;
#pragma unroll
            for (int rq = 0; rq < 4; ++rq) {
                uint2 o0; o0.x = pack2(O0[4 * rq], O0[4 * rq + 1]); o0.y = pack2(O0[4 * rq + 2], O0[4 * rq + 3]);
                uint2 o1; o1.x = pack2(O1[4 * rq], O1[4 * rq + 1]); o1.y = pack2(O1[4 * rq + 2], O1[4 * rq + 3]);
                *(uint2*)(op + 8 * rq) = o0;
                *(uint2*)(op + 32 + 8 * rq) = o1;
            }
        }
    }
}

__device__ __forceinline__ void phase_outproj(const Params& p, const Ctx& cx, char* lds, const bf16_t* A, const bf16_t* Bt, const float* xin, int ls) {
    const float* mod = (const float*)(p.ws + OFF_MOD);
    float* xo = p.out;
    gemm_phase_dense2(A, 1024, Bt, 1024, NTOK / 256, 4, lds, cx, [=](int row0, int col0) {
        return [=](f32x4 (&acc)[8][4], int wr, int wc, int fr, int fq) {
#pragma unroll
            for (int m = 0; m < 8; ++m) {
                const int row = row0 + wr * 128 + m * 16 + fr, b = row >> 11;
                const float* gate = mod + ((size_t)ls * 16 + b) * 3072 + 2048;
#pragma unroll
                for (int n = 0; n < 4; ++n) {
                    const int col = col0 + wc * 64 + n * 16 + fq * 4;
                    f32x4 g = *(const f32x4*)(gate + col);
                    f32x4 xi = *(const f32x4*)(xin + (size_t)row * 1024 + col);
                    f32x4 o;
#pragma unroll
                    for (int j = 0; j < 4; ++j) o[j] = xi[j] + g[j] * acc[m][n][j];
                    *(f32x4*)(xo + (size_t)row * 1024 + col) = o;
                }
            }
        };
    });
}

__device__ __forceinline__ void moe_tables(const Params& p, int layer, int tid, int* s_cnt, int* s_off, int* s_toff) {
    __syncthreads();
    if (tid == 0) {
        const int* cnt = (const int*)(p.ws + OFF_CNT) + layer * 16;
        int o = 0, to = 0;
        for (int e = 0; e < 16; ++e) { const int c = cnt[e]; s_cnt[e] = c; s_off[e] = o; s_toff[e] = to; o += c; to += ((c + 255) >> 8) * 4; }
        s_off[16] = o; s_toff[16] = to;
    }
    __syncthreads();
}

__device__ __forceinline__ void phase_moe_up(const Params& p, const Ctx& cx, char* lds, int layer) {
    const int tid = cx.tid;
    int* s_cnt = (int*)(lds + LDS_TAB_OFF); int* s_off = s_cnt + 16; int* s_toff = s_off + 17;
    moe_tables(p, layer, tid, s_cnt, s_off, s_toff);
    const int ntiles = s_toff[16];
    const bf16_t* hA = (const bf16_t*)(p.ws + OFF_HA);
    const int* ltok = (const int*)(p.ws + OFF_LTOK);
    bf16_t* H1 = (bf16_t*)(p.ws + OFF_H1);
    const int sc = stage_col2(tid), sr = tid >> 2;
    for (int tile = cx.vbid; tile < ntiles; tile += cx.G) {
        int e = 0;
        while (tile >= s_toff[e + 1]) ++e;
        const int lt = tile - s_toff[e], rt = lt >> 2, ct = lt & 3, cnt = s_cnt[e], off = s_off[e];
        const int* lt_e = ltok + (size_t)e * NTOK;
        const bf16_t* const ap[2] = {hA + (size_t)lt_e[min(rt * 256 + sr, cnt - 1)] * 1024 + sc, hA + (size_t)lt_e[min(rt * 256 + sr + 128, cnt - 1)] * 1024 + sc};
        const bf16_t* b0 = (const bf16_t*)(p.ws + OFF_W_UP) + ((size_t)(layer * 16 + e) * 1024 + ct * 256 + sr) * 1024 + sc;
        const bf16_t* const bp[2] = {b0, b0 + (size_t)128 * 1024};
        gemm_tile2(ap, bp, 1024, lds, cx, [=](f32x4 (&acc)[8][4], int wr, int wc, int fr, int fq) {
#pragma unroll
            for (int m = 0; m < 8; ++m) {
                const int pos = rt * 256 + wr * 128 + m * 16 + fr;
                if (pos < cnt) {
                    bf16_t* dst = H1 + (size_t)(off + pos) * 512 + ct * 128 + wc * 32 + fq * 4;
#pragma unroll
                    for (int n = 0; n < 2; ++n) {
                        float h[4];
#pragma unroll
                        for (int j = 0; j < 4; ++j) h[j] = silu_f(acc[m][n][j]) * acc[m][n + 2][j];
                        uint2 o; o.x = pack2(h[0], h[1]); o.y = pack2(h[2], h[3]);
                        *(uint2*)(dst + n * 16) = o;
                    }
                }
            }
        });
    }
}

__device__ __forceinline__ void phase_moe_down(const Params& p, const Ctx& cx, char* lds, int layer) {
    const int tid = cx.tid;
    int* s_cnt = (int*)(lds + LDS_TAB_OFF); int* s_off = s_cnt + 16; int* s_toff = s_off + 17;
    moe_tables(p, layer, tid, s_cnt, s_off, s_toff);
    const int ntiles = s_toff[16];
    const bf16_t* H1 = (const bf16_t*)(p.ws + OFF_H1);
    const float* lw = (const float*)(p.ws + OFF_LW);
    bf16_t* Y = (bf16_t*)(p.ws + OFF_Y);
    const int sc = stage_col2(tid), sr = tid >> 2;
    for (int tile = cx.vbid; tile < ntiles; tile += cx.G) {
        int e = 0;
        while (tile >= s_toff[e + 1]) ++e;
        const int lt = tile - s_toff[e], rt = lt >> 2, ct = lt & 3, cnt = s_cnt[e], off = s_off[e];
        const bf16_t* const ap[2] = {H1 + (size_t)(off + min(rt * 256 + sr, cnt - 1)) * 512 + sc, H1 + (size_t)(off + min(rt * 256 + sr + 128, cnt - 1)) * 512 + sc};
        const bf16_t* b0 = (const bf16_t*)(p.ws + OFF_W_DN) + ((size_t)(layer * 16 + e) * 1024 + ct * 256 + sr) * 512 + sc;
        const bf16_t* const bp[2] = {b0, b0 + (size_t)128 * 512};
        gemm_tile2(ap, bp, 512, lds, cx, [=](f32x4 (&acc)[8][4], int wr, int wc, int fr, int fq) {
#pragma unroll
            for (int m = 0; m < 8; ++m) {
                const int pos = rt * 256 + wr * 128 + m * 16 + fr;
                if (pos < cnt) {
                    const float w = lw[(size_t)e * NTOK + pos];
                    bf16_t* dst = Y + (size_t)(off + pos) * 1024 + ct * 256 + wc * 64 + fq * 4;
#pragma unroll
                    for (int n = 0; n < 4; ++n) {
                        uint2 o; o.x = pack2(w * acc[m][n][0], w * acc[m][n][1]); o.y = pack2(w * acc[m][n][2], w * acc[m][n][3]);
                        *(uint2*)(dst + n * 16) = o;
                    }
                }
            }
        });
    }
}

template <int MODE = 0>
__device__ __forceinline__ void phase_hgrn_inproj(const Params& p, const Ctx& cx, char* lds) {
    const bf16_t* A = (const bf16_t*)(p.ws + OFF_HA);
    const bf16_t* Bt = (const bf16_t*)(p.ws + OFF_W_HG_IN);
    char* ws = p.ws;
    const float* lb = (const float*)(p.ws + OFF_LB);
    gemm_phase_dense2<MODE>(A, 1024, Bt, 1024, NTOK / 256, 16, lds, cx, [=](int row0, int col0) {
        return [=](f32x4 (&acc)[8][4], int wr, int wc, int fr, int fq) {
            const int gc0 = col0 + wc * 64, seg = gc0 >> 10, c0 = gc0 & 1023;
#pragma unroll
            for (int m = 0; m < 8; ++m) {
                const int row = row0 + wr * 128 + m * 16 + fr;
#pragma unroll
                for (int n = 0; n < 4; ++n) {
                    const int c = c0 + n * 16 + fq * 4;
                    if (seg == 1) {
                        f32x4 l4 = *(const f32x4*)(lb + c), o;
#pragma unroll
                        for (int j = 0; j < 4; ++j) o[j] = __logf(l4[j] + (1.f - l4[j]) * sigmoid_f(acc[m][n][j]));
                        *(f32x4*)((float*)(ws + OFF_LF) + (size_t)row * 1024 + c) = o;
                    } else {
                        float h[4];
#pragma unroll
                        for (int j = 0; j < 4; ++j) h[j] = (seg == 2) ? acc[m][n][j] : silu_f(acc[m][n][j]);
                        uint2 o; o.x = pack2(h[0], h[1]); o.y = pack2(h[2], h[3]);
                        bf16_t* dst = (bf16_t*)(ws + (seg == 0 ? OFF_QH : seg == 2 ? OFF_V : OFF_G));
                        *(uint2*)(dst + (size_t)row * 1024 + c) = o;
                    }
                }
            }
        };
    });
}

constexpr int HG_QD_OFF = 0, HG_KD_OFF = 8704, HG_K2T_OFF = 17408, HG_VT_OFF = 27648, HG_O_OFF = 37888, HG_DEC_OFF = 54784, HG_TOT_OFF = 55296;
constexpr int HG_ROW = 272, HG_TROW = 80, HG_OROW = 528;
static_assert(HG_TOT_OFF + 4096 <= LDS_TAB_OFF, "hgrn LDS");

__device__ __forceinline__ void phase_hgrn_rec(const Params& p, const Ctx& cx, char* lds) {
    const int tid = cx.tid, lane = cx.lane, wid = cx.wid;
    const int l31 = lane & 31, h2 = lane >> 5;
    const int widu = __builtin_amdgcn_readfirstlane(cx.wid);
    const int d0 = 2 * lane;
    const bf16_t* QH = (const bf16_t*)(p.ws + OFF_QH);
    const float* LF = (const float*)(p.ws + OFF_LF);
    const bf16_t* V = (const bf16_t*)(p.ws + OFF_V);
    bf16_t* OR = (bf16_t*)(p.ws + OFF_HA);
    float* dec = (float*)(lds + HG_DEC_OFF);
    float* tot = (float*)(lds + HG_TOT_OFF);
    for (int item = blockIdx.x; item < 128; item += cx.G) {
        const int b = item >> 3, h = item & 7;
        f32x16 S0, S1, S2, S3;
#pragma unroll
        for (int r = 0; r < 16; ++r) { S0[r] = 0.f; S1[r] = 0.f; S2[r] = 0.f; S3[r] = 0.f; }
        f2_t lf[4]; unsigned qv[4], vv[4];
        const size_t gbase = (size_t)(b * SEQ + widu * 4) * 1024 + h * 128;
#pragma unroll
        for (int i = 0; i < 4; ++i) {
            lf[i] = *(const f2_t*)(LF + gbase + (size_t)i * 1024 + d0);
            qv[i] = *(const unsigned*)(QH + gbase + (size_t)i * 1024 + d0);
            vv[i] = *(const unsigned*)(V + gbase + (size_t)i * 1024 + d0);
        }
        for (int c = 0; c < SEQ / 32; ++c) {
            f2_t run = {0.f, 0.f};
#pragma unroll
            for (int i = 0; i < 4; ++i) run += lf[i];
            *(f2_t*)(tot + wid * 128 + d0) = run;
            __syncthreads();
            f2_t pre = {0.f, 0.f}, last = {0.f, 0.f};
#pragma unroll
            for (int q = 0; q < 8; ++q) {
                const f2_t tq_ = *(const f2_t*)(tot + q * 128 + d0);
                last += tq_;
                if (q < widu) pre += tq_;
            }
            if (widu == 0) { f2_t dv; dv.x = __expf(last.x); dv.y = __expf(last.y); *(f2_t*)(dec + d0) = dv; }
            {
                float k2a[4], k2b[4];
                f2_t rc = pre;
#pragma unroll
                for (int i = 0; i < 4; ++i) {
                    rc += lf[i];
                    const float cu0 = rc.x, cu1 = rc.y;
                    const float kk0 = 1.f - __expf(lf[i].x), kk1 = 1.f - __expf(lf[i].y);
                    const float q0 = bf2f((unsigned short)(qv[i] & 0xffff)) * __expf(cu0), q1 = bf2f((unsigned short)(qv[i] >> 16)) * __expf(cu1);
                    const float kd0 = kk0 * __expf(-cu0), kd1 = kk1 * __expf(-cu1);
                    k2a[i] = kk0 * __expf(last.x - cu0); k2b[i] = kk1 * __expf(last.y - cu1);
                    const int tl = wid * 4 + i;
                    *(unsigned*)(lds + HG_QD_OFF + tl * HG_ROW + d0 * 2) = pack2(q0, q1);
                    *(unsigned*)(lds + HG_KD_OFF + tl * HG_ROW + d0 * 2) = pack2(kd0, kd1);
                }
                uint2 a, bq, va, vb;
                a.x = pack2(k2a[0], k2a[1]); a.y = pack2(k2a[2], k2a[3]);
                bq.x = pack2(k2b[0], k2b[1]); bq.y = pack2(k2b[2], k2b[3]);
                va.x = (vv[0] & 0xffffu) | (vv[1] << 16); va.y = (vv[2] & 0xffffu) | (vv[3] << 16);
                vb.x = (vv[0] >> 16) | (vv[1] & 0xffff0000u); vb.y = (vv[2] >> 16) | (vv[3] & 0xffff0000u);
                *(uint2*)(lds + HG_K2T_OFF + d0 * HG_TROW + wid * 8) = a;
                *(uint2*)(lds + HG_K2T_OFF + (d0 + 1) * HG_TROW + wid * 8) = bq;
                *(uint2*)(lds + HG_VT_OFF + d0 * HG_TROW + wid * 8) = va;
                *(uint2*)(lds + HG_VT_OFF + (d0 + 1) * HG_TROW + wid * 8) = vb;
            }
            __builtin_amdgcn_sched_barrier(0);
            if (c + 1 < SEQ / 32) {
                const size_t gn = gbase + (size_t)(c + 1) * 32 * 1024;
#pragma unroll
                for (int i = 0; i < 4; ++i) {
                    lf[i] = *(const f2_t*)(LF + gn + (size_t)i * 1024 + d0);
                    qv[i] = *(const unsigned*)(QH + gn + (size_t)i * 1024 + d0);
                    vv[i] = *(const unsigned*)(V + gn + (size_t)i * 1024 + d0);
                }
            }
            __syncthreads();
            if (widu < 4) {
            f32x16 X;
#pragma unroll
            for (int r = 0; r < 16; ++r) X[r] = 0.f;
            {
                const char* ka = lds + HG_KD_OFF + l31 * HG_ROW + 16 * h2;
                const char* qa = lds + HG_QD_OFF + l31 * HG_ROW + 16 * h2;
#pragma unroll 2
                for (int ks = 0; ks < 8; ++ks) X = MFMA32(*(const bf16x8*)(ka + 32 * ks), *(const bf16x8*)(qa + 32 * ks), X);
#pragma unroll
                for (int r = 0; r < 16; ++r) { const int srow = (r & 3) + 8 * (r >> 2) + 4 * h2; X[r] = (srow <= l31) ? X[r] : 0.f; }
            }
            f32x16 Oa;
#pragma unroll
            for (int r = 0; r < 16; ++r) Oa[r] = 0.f;
            const int jrow = 32 * wid + l31;
#pragma unroll
            for (int s2 = 0; s2 < 2; ++s2) {
                uint4 xk;
                xk.x = pack2(X[8 * s2], X[8 * s2 + 1]); xk.y = pack2(X[8 * s2 + 2], X[8 * s2 + 3]); xk.z = pack2(X[8 * s2 + 4], X[8 * s2 + 5]); xk.w = pack2(X[8 * s2 + 6], X[8 * s2 + 7]);
                const char* va = lds + HG_VT_OFF + jrow * HG_TROW + (16 * s2 + 4 * h2) * 2;
                const uint2 lo = *(const uint2*)va, hi = *(const uint2*)(va + 16);
                uint4 vb; vb.x = lo.x; vb.y = lo.y; vb.z = hi.x; vb.w = hi.y;
                Oa = MFMA32(__builtin_bit_cast(bf16x8, xk), __builtin_bit_cast(bf16x8, vb), Oa);
            }
            auto qs_term = [&](const f32x16& St, int dt) {
#pragma unroll
                for (int s2 = 0; s2 < 2; ++s2) {
                    uint4 sk;
                    sk.x = pack2(St[8 * s2], St[8 * s2 + 1]); sk.y = pack2(St[8 * s2 + 2], St[8 * s2 + 3]); sk.z = pack2(St[8 * s2 + 4], St[8 * s2 + 5]); sk.w = pack2(St[8 * s2 + 6], St[8 * s2 + 7]);
                    const char* qa = lds + HG_QD_OFF + l31 * HG_ROW + (32 * dt + 16 * s2 + 4 * h2) * 2;
                    const uint2 lo = *(const uint2*)qa, hi = *(const uint2*)(qa + 16);
                    uint4 qb; qb.x = lo.x; qb.y = lo.y; qb.z = hi.x; qb.w = hi.y;
                    Oa = MFMA32(__builtin_bit_cast(bf16x8, qb), __builtin_bit_cast(bf16x8, sk), Oa);
                }
            };
            __builtin_amdgcn_sched_barrier(0);
            qs_term(S0, 0); qs_term(S1, 1);
            __builtin_amdgcn_sched_barrier(0);
            qs_term(S2, 2); qs_term(S3, 3);
            __builtin_amdgcn_sched_barrier(0);
            {
                bf16_t* orow = OR + (size_t)(b * SEQ + c * 32 + 4 * h2) * 1024 + h * 128 + jrow;
#pragma unroll
                for (int r = 0; r < 16; ++r) orow[(size_t)((r & 3) + 8 * (r >> 2)) * 1024] = f2bf(Oa[r]);
            }
            auto s_update = [&](f32x16& St, int dt) {
#pragma unroll
                for (int rq = 0; rq < 4; ++rq) {
                    const f32x4 dc = *(const f32x4*)(dec + 32 * dt + 8 * rq + 4 * h2);
                    St[4 * rq] *= dc[0]; St[4 * rq + 1] *= dc[1]; St[4 * rq + 2] *= dc[2]; St[4 * rq + 3] *= dc[3];
                }
#pragma unroll
                for (int s2 = 0; s2 < 2; ++s2) {
                    const bf16x8 ka = *(const bf16x8*)(lds + HG_K2T_OFF + (32 * dt + l31) * HG_TROW + (16 * s2 + 8 * h2) * 2);
                    const bf16x8 vb = *(const bf16x8*)(lds + HG_VT_OFF + jrow * HG_TROW + (16 * s2 + 8 * h2) * 2);
                    St = MFMA32(ka, vb, St);
                }
            };
            __builtin_amdgcn_sched_barrier(0);
            s_update(S0, 0); s_update(S1, 1);
            __builtin_amdgcn_sched_barrier(0);
            s_update(S2, 2); s_update(S3, 3);
            __builtin_amdgcn_sched_barrier(0);
            }
        }
        __syncthreads();
    }
}

__device__ __forceinline__ void phase_hgrn_post(const Params& p, const Ctx& cx) {
    const int lane = cx.lane;
    const bf16_t* OR = (const bf16_t*)(p.ws + OFF_HA);
    const bf16_t* Gt = (const bf16_t*)(p.ws + OFF_G);
    bf16_t* OA = (bf16_t*)(p.ws + OFF_QH);
    const int col = lane * 16;
    float gn[16];
#pragma unroll
    for (int i = 0; i < 16; ++i) gn[i] = p.hgrn_out_gain[(col & 127) + i];
    for (int row = cx.vbid * NWAVE + cx.wid; row < NTOK; row += cx.G * NWAVE) {
        const uint4 a0 = *(const uint4*)(OR + (size_t)row * 1024 + col), a1 = *(const uint4*)(OR + (size_t)row * 1024 + col + 8);
        const uint4 g0 = *(const uint4*)(Gt + (size_t)row * 1024 + col), g1 = *(const uint4*)(Gt + (size_t)row * 1024 + col + 8);
        const unsigned aw[8] = {a0.x, a0.y, a0.z, a0.w, a1.x, a1.y, a1.z, a1.w};
        const unsigned gw[8] = {g0.x, g0.y, g0.z, g0.w, g1.x, g1.y, g1.z, g1.w};
        float o[16];
        float ss = 0.f;
#pragma unroll
        for (int i = 0; i < 8; ++i) { o[2 * i] = bf2f((unsigned short)(aw[i] & 0xffff)); o[2 * i + 1] = bf2f((unsigned short)(aw[i] >> 16)); ss += o[2 * i] * o[2 * i] + o[2 * i + 1] * o[2 * i + 1]; }
        ss += __shfl_xor(ss, 1); ss += __shfl_xor(ss, 2); ss += __shfl_xor(ss, 4);
        const float r = rsqrtf(ss * (1.f / 128.f) + EPS);
        unsigned w[8];
#pragma unroll
        for (int i = 0; i < 8; ++i)
            w[i] = pack2(o[2 * i] * r * gn[2 * i] * bf2f((unsigned short)(gw[i] & 0xffff)), o[2 * i + 1] * r * gn[2 * i + 1] * bf2f((unsigned short)(gw[i] >> 16)));
        uint4 o0, o1; o0.x = w[0]; o0.y = w[1]; o0.z = w[2]; o0.w = w[3]; o1.x = w[4]; o1.y = w[5]; o1.z = w[6]; o1.w = w[7];
        *(uint4*)(OA + (size_t)row * 1024 + col) = o0;
        *(uint4*)(OA + (size_t)row * 1024 + col + 8) = o1;
    }
}


#define XB_TMO      128
#define XB_XCNT(j)  (256  + 64 * (j))
#define XB_XSUB(j)  (1280 + 64 * (j))
#define XB_XGEN(j)  (2304 + 64 * (j))
#define XB_TOP      3328
#define XB_TOPGEN   3392
#define XCD_BAR_WORDS 3456
#define XB_SPIN_CAP (1u << 20)
#define LAS __attribute__((address_space(3)))
__device__ __forceinline__ unsigned xb_ld(unsigned* p)              { return __hip_atomic_load(p, __ATOMIC_RELAXED, __HIP_MEMORY_SCOPE_AGENT); }
__device__ __forceinline__ unsigned xb_add(unsigned* p, unsigned v) { return __hip_atomic_fetch_add(p, v, __ATOMIC_RELAXED, __HIP_MEMORY_SCOPE_AGENT); }
__device__ __forceinline__ unsigned xb_xcc_id() { return (unsigned)__builtin_amdgcn_s_getreg((3 << 11) | 20) & 0xFu; }
#define XB_SPIN(cond, bar) do { unsigned _sp = 0; while (cond) { __builtin_amdgcn_s_sleep(1); \
    if ((++_sp & 255u) == 0u) { if (xb_ld(&(bar)[XB_TMO])) break; if (_sp > XB_SPIN_CAP) { atomicAdd(&(bar)[XB_TMO], 1u); break; } } } } while (0)
struct XcdBarrier { unsigned* bar; unsigned x; volatile unsigned* st; };
__device__ __forceinline__ XcdBarrier xcd_barrier_post(unsigned* bar, volatile unsigned* st) {
    XcdBarrier b; b.bar = bar; b.x = xb_xcc_id(); b.st = st;
    if (threadIdx.x == 0) (void)xb_add(&bar[XB_XCNT(b.x)], 1u);
    return b;
}
__device__ __forceinline__ void xcd_barrier_complete(unsigned* bar, unsigned x, unsigned& nloc, unsigned& nx) {
    const unsigned G = gridDim.x * gridDim.y * gridDim.z;
    unsigned sum, cnt, mine, sp = 0u;
    for (;;) {
        sum = 0u; cnt = 0u; mine = 0u;
#pragma unroll
        for (unsigned j = 0; j < 16; ++j) { const unsigned c = xb_ld(&bar[XB_XCNT(j)]); sum += c; cnt += (c > 0u) ? 1u : 0u; mine = (j == x) ? c : mine; }
        if (sum == G) break;
        __builtin_amdgcn_s_sleep(1);
        if ((++sp & 255u) == 0u) { if (xb_ld(&bar[XB_TMO])) break; if (sp > XB_SPIN_CAP) { atomicAdd(&bar[XB_TMO], 1u); break; } }
    }
    nloc = mine > 0u ? mine : 1u; nx = cnt > 0u ? cnt : 1u;
}
__device__ __forceinline__ void xcd_barrier(const XcdBarrier& b) {
    asm volatile("s_waitcnt vmcnt(0)" ::: "memory");
    __syncthreads();
    if (threadIdx.x == 0) {
        unsigned* bar = b.bar;
        __builtin_amdgcn_s_waitcnt(0);
        unsigned nloc = b.st[0], nx = b.st[1];
        if (nloc == 0u) { xcd_barrier_complete(bar, b.x, nloc, nx); b.st[0] = nloc; b.st[1] = nx; }
        const unsigned old = xb_add(&bar[XB_XSUB(b.x)], 1u);
        const unsigned gen = old / nloc;
        if (old + 1u == (gen + 1u) * nloc) {
            __builtin_amdgcn_fence(__ATOMIC_RELEASE, "agent");
            asm volatile("s_waitcnt vmcnt(0)" ::: "memory");
            const unsigned og = xb_add(&bar[XB_TOP], 1u);
            const unsigned tg = og / nx;
            if (og + 1u == (tg + 1u) * nx) xb_add(&bar[XB_TOPGEN], 1u);
            else XB_SPIN(xb_ld(&bar[XB_TOPGEN]) == tg, bar);
            __builtin_amdgcn_fence(__ATOMIC_ACQUIRE, "agent");
            xb_add(&bar[XB_XGEN(b.x)], 1u);
            asm volatile("s_waitcnt vmcnt(0)" ::: "memory");
        } else {
            XB_SPIN(xb_ld(&bar[XB_XGEN(b.x)]) == gen, bar);
            __builtin_amdgcn_fence(__ATOMIC_ACQUIRE, "agent");
            asm volatile("s_waitcnt vmcnt(0)" ::: "memory");
        }
    }
    __syncthreads();
}

template <int PH>
__device__ __forceinline__ void run_phase(const Params& p, const Ctx& cx, char* lds) {
    if constexpr (PH == 0) phase0(p, cx, lds);
    else if constexpr (PH == 1) rows_phase<false, true, false>(p, cx, lds, p.x, nullptr, 0, 0, 0, 0);
    else if constexpr (PH == 2) phase_nsa_inproj(p, cx, lds);
    else if constexpr (PH == 3) phase_cmp1(p, cx, lds);
    else if constexpr (PH == 4) phase_cmp2(p, cx);
    else if constexpr (PH == 5) phase_attn(p, cx, lds);
    else if constexpr (PH == 6) phase_outproj(p, cx, lds, (const bf16_t*)(p.ws + OFF_HA), (const bf16_t*)(p.ws + OFF_W_NSA_OUT), p.x, 0);
    else if constexpr (PH == 7) rows_router_phase(p, cx, lds, p.out, 1, 0);
    else if constexpr (PH == 8) phase_moe_up(p, cx, lds, 0);
    else if constexpr (PH == 9) phase_moe_down(p, cx, lds, 0);
    else if constexpr (PH == 10) rows_phase<true, true, false>(p, cx, lds, p.out, p.out, 1, 2, 0, 0);
#ifdef PROBE_GEMM_MODE
    else if constexpr (PH == 11) { phase_hgrn_inproj<PROBE_GEMM_MODE>(p, cx, lds); __syncthreads(); phase_hgrn_inproj<0>(p, cx, lds); }
#else
    else if constexpr (PH == 11) phase_hgrn_inproj<0>(p, cx, lds);
#endif
    else if constexpr (PH == 12) phase_hgrn_rec(p, cx, lds);
    else if constexpr (PH == 13) phase_hgrn_post(p, cx);
    else if constexpr (PH == 14) phase_outproj(p, cx, lds, (const bf16_t*)(p.ws + OFF_QH), (const bf16_t*)(p.ws + OFF_W_HG_OUT), p.out, 2);
    else if constexpr (PH == 15) rows_router_phase(p, cx, lds, p.out, 3, 1);
    else if constexpr (PH == 16) phase_moe_up(p, cx, lds, 1);
    else if constexpr (PH == 17) phase_moe_down(p, cx, lds, 1);
    else if constexpr (PH == 18) rows_phase<true, false, false>(p, cx, lds, p.out, p.out, 3, 0, 0, 1);
}

__device__ __forceinline__ Ctx make_ctx() {
    Ctx cx;
    cx.G = gridDim.x; cx.tid = threadIdx.x; cx.wid = threadIdx.x >> 6; cx.lane = threadIdx.x & 63;
    cx.vbid = (cx.G % 8 == 0) ? (blockIdx.x % 8) * (cx.G / 8) + blockIdx.x / 8 : blockIdx.x;
    return cx;
}

#if MULTI_LAUNCH
template <int PH>
__global__ void __launch_bounds__(NTHR, 2) phase_kernel(Params p) {
    extern __shared__ __attribute__((aligned(16))) char lds[];
    const Ctx cx = make_ctx();
    run_phase<PH>(p, cx, lds);
}
template <int PH>
static void launch_phases(const Params& p, int grid, hipStream_t stream) {
    (void)hipFuncSetAttribute((const void*)phase_kernel<PH>, hipFuncAttributeMaxDynamicSharedMemorySize, LDS_BYTES);
    hipLaunchKernelGGL(phase_kernel<PH>, dim3(grid), dim3(NTHR), LDS_BYTES, stream, p);
    if constexpr (PH + 1 < NPHASE) launch_phases<PH + 1>(p, grid, stream);
}
#else
template <int PH>
__device__ __forceinline__ void run_from(const Params& p, const Ctx& cx, char* lds, cg::grid_group& grid, const XcdBarrier& xb) {
    {
        Ctx c2 = cx;
        asm volatile("" : "+v"(c2.tid), "+v"(c2.lane));
        run_phase<PH>(p, c2, lds);
#ifdef PROBE_MASK
        if constexpr ((PROBE_MASK >> PH) & 1) { xcd_barrier(xb); run_phase<PH>(p, c2, lds); }
#endif
    }
    if constexpr (PH + 1 < NPHASE) {
        if constexpr (PH == 0) grid.sync();
        else xcd_barrier(xb);
        run_from<PH + 1>(p, cx, lds, grid, xb);
    }
}
__global__ void __launch_bounds__(NTHR, 2) mega_kernel(Params p) {
    extern __shared__ __attribute__((aligned(16))) char lds[];
    cg::grid_group grid = cg::this_grid();
    const Ctx cx = make_ctx();
    volatile unsigned* st = (volatile unsigned*)(lds + LDS_BYTES - 16);
    if (threadIdx.x == 0) { st[0] = 0u; st[1] = 0u; }
    __syncthreads();
    const XcdBarrier xb = xcd_barrier_post((unsigned*)(p.ws + OFF_BAR), st);
    run_from<0>(p, cx, lds, grid, xb);
}
#endif

extern "C" void kernel_launch(void* const* d_in, const int* in_sizes, int n_in, void* d_out, int out_size, void* d_ws, size_t ws_size,
                              hipStream_t stream) {
    static int grid = 0;
    if (!grid) {
        int dev = 0, cus = 0, per_cu = 0;
        (void)hipGetDevice(&dev);
        (void)hipDeviceGetAttribute(&cus, hipDeviceAttributeMultiprocessorCount, dev);
#if MULTI_LAUNCH
        per_cu = 1;
#else
        (void)hipFuncSetAttribute((const void*)mega_kernel, hipFuncAttributeMaxDynamicSharedMemorySize, LDS_BYTES);
        (void)hipOccupancyMaxActiveBlocksPerMultiprocessor(&per_cu, mega_kernel, NTHR, LDS_BYTES);
        if (per_cu > 1) per_cu = 1;
        if (per_cu < 1) { fprintf(stderr, "kernel_launch: occupancy query says 0 blocks per CU (LDS %d B)\n", LDS_BYTES); per_cu = 1; }
#endif
        if (cus <= 0) cus = 256;
        grid = cus * per_cu;
        if (ws_size < WS_NEED) fprintf(stderr, "kernel_launch: workspace too small: %zu < %zu\n", ws_size, (size_t)WS_NEED);
    }
    Params p{};
    p.x = (const float*)d_in[0]; p.c = (const float*)d_in[1]; p.ada_w = (const float*)d_in[2]; p.ada_b = (const float*)d_in[3];
    p.norm_g = (const float*)d_in[4]; p.rel_bias = (const float*)d_in[5]; p.nsa_w_in = (const float*)d_in[6]; p.nsa_q_gain = (const float*)d_in[7];
    p.nsa_k_gain = (const float*)d_in[8]; p.nsa_cmp_pe = (const float*)d_in[9]; p.nsa_cmp_w1 = (const float*)d_in[10]; p.nsa_cmp_w2 = (const float*)d_in[11];
    p.nsa_w_out = (const float*)d_in[12]; p.hgrn_w_in = (const float*)d_in[13]; p.hgrn_lb = (const float*)d_in[14]; p.hgrn_out_gain = (const float*)d_in[15];
    p.hgrn_w_out = (const float*)d_in[16]; p.moe_rg = (const float*)d_in[17]; p.moe_re = (const float*)d_in[18]; p.moe_w1 = (const float*)d_in[19];
    p.moe_w3 = (const float*)d_in[20]; p.moe_w2 = (const float*)d_in[21];
    p.out = (float*)d_out; p.ws = (char*)d_ws;
#if MULTI_LAUNCH
    launch_phases<0>(p, grid, stream);
#else
    p.p_begin = 0; p.p_end = NPHASE;
    (void)hipMemsetAsync((char*)d_ws + OFF_BAR, 0, XCD_BAR_WORDS * 4, stream);
    void* args[] = {&p};
    hipError_t e = hipLaunchCooperativeKernel((void*)mega_kernel, dim3(grid), dim3(NTHR), args, LDS_BYTES, stream);
    if (e != hipSuccess) fprintf(stderr, "cooperative launch failed: %s (grid %d)\n", hipGetErrorString(e), grid);
#endif
}
```

```cpp
#include <hip/hip_runtime.h>
#include <hip/hip_cooperative_groups.h>
#include <cstdio>
#include <cstdint>
namespace cg = cooperative_groups;

#ifndef MULTI_LAUNCH
#define MULTI_LAUNCH 0
#endif

typedef unsigned short bf16_t;
typedef short bf16x8 __attribute__((ext_vector_type(8)));
typedef float f32x4 __attribute__((ext_vector_type(4)));
typedef float f32x16 __attribute__((ext_vector_type(16)));

constexpr int NTOK = 32768, DM = 1024, SEQ = 2048, NBATCH = 16;
constexpr int NSA_IN = 2608, NSA_IN_PAD = 2816;
constexpr float EPS = 1e-6f;
constexpr size_t MiB = 1ull << 20;

constexpr size_t OFF_CNT = 0;
constexpr size_t OFF_MOD = 4096;
constexpr size_t OFF_LB = OFF_MOD + 786432;
constexpr size_t OFF_PEB = OFF_LB + 4096;
constexpr size_t OFF_BAR = 921600;
constexpr size_t OFF_W_NSA_IN = 1 * MiB;
constexpr size_t OFF_W_NSA_OUT = OFF_W_NSA_IN + 2816ull * 1024 * 2;
constexpr size_t OFF_W_HG_IN = OFF_W_NSA_OUT + 1024ull * 1024 * 2;
constexpr size_t OFF_W_HG_OUT = OFF_W_HG_IN + 4096ull * 1024 * 2;
constexpr size_t OFF_W_CMP1 = OFF_W_HG_OUT + 1024ull * 1024 * 2;
constexpr size_t OFF_W_UP = OFF_W_CMP1 + 2ull * 128 * 2048 * 2;
constexpr size_t OFF_W_DN = OFF_W_UP + 32ull * 1024 * 1024 * 2;
constexpr size_t OFF_W_END = OFF_W_DN + 32ull * 1024 * 512 * 2;
constexpr size_t OFF_HA = 116 * MiB;
static_assert(OFF_W_END <= OFF_HA, "weights overflow");
constexpr size_t OFF_SCR = 180 * MiB;
constexpr size_t OFF_Q = OFF_SCR;
constexpr size_t OFF_KCRAW = OFF_Q + 64 * MiB;
constexpr size_t OFF_VCRAW = OFF_KCRAW + 17 * MiB;
constexpr size_t OFF_KS = OFF_VCRAW + 17 * MiB;
constexpr size_t OFF_VS = OFF_KS + 16 * MiB;
constexpr size_t OFF_KW = OFF_VS + 16 * MiB;
constexpr size_t OFF_VW = OFF_KW + 16 * MiB;
constexpr size_t OFF_GATES = OFF_VW + 16 * MiB;
constexpr size_t OFF_T1 = OFF_GATES + 6 * MiB;
constexpr size_t OFF_KC = OFF_T1 + 4 * MiB;
constexpr size_t OFF_VC = OFF_KC + 1 * MiB;
constexpr size_t OFF_H1 = OFF_SCR;
constexpr size_t OFF_Y = OFF_H1 + 64 * MiB;
constexpr size_t OFF_LTOK = OFF_Y + 128 * MiB;
constexpr size_t OFF_LW = OFF_LTOK + 2 * MiB;
constexpr size_t OFF_TSLOT = OFF_LW + 2 * MiB;
constexpr size_t OFF_QH = OFF_SCR;
constexpr size_t OFF_LF = OFF_QH + 64 * MiB;
constexpr size_t OFF_V = OFF_LF + 128 * MiB;
constexpr size_t OFF_G = OFF_V + 64 * MiB;
constexpr size_t WS_NEED = OFF_G + 64 * MiB;
static_assert(WS_NEED <= 512 * MiB, "ws overflow");

constexpr int NTHR = 512, NWAVE = 8;
constexpr int GEMM_STAGE = 49152, GEMM_NSTAGE = 3;
constexpr int LDS_TAB_OFF = GEMM_STAGE * GEMM_NSTAGE;
constexpr int LDS_BYTES = LDS_TAB_OFF + 256 + 16;
constexpr int NPHASE = 19;

struct Params {
    const float *x, *c, *ada_w, *ada_b, *norm_g, *rel_bias, *nsa_w_in, *nsa_q_gain, *nsa_k_gain, *nsa_cmp_pe, *nsa_cmp_w1,
        *nsa_cmp_w2, *nsa_w_out, *hgrn_w_in, *hgrn_lb, *hgrn_out_gain, *hgrn_w_out, *moe_rg, *moe_re, *moe_w1, *moe_w3, *moe_w2;
    float* out;
    char* ws;
    int p_begin, p_end;
};

__device__ __forceinline__ float bf2f(unsigned short h) { return __uint_as_float((unsigned)h << 16); }
__device__ __forceinline__ unsigned short f2bf(float f) {
    unsigned u = __float_as_uint(f);
    u += 0x7fffu + ((u >> 16) & 1u);
    return (unsigned short)(u >> 16);
}
typedef __bf16 bf2_t __attribute__((ext_vector_type(2)));
typedef float f2_t __attribute__((ext_vector_type(2)));
__device__ __forceinline__ unsigned pack2(float a, float b) {
    f2_t v = {a, b};
    return __builtin_bit_cast(unsigned, __builtin_convertvector(v, bf2_t));
}
typedef _Float16 h2_t __attribute__((ext_vector_type(2)));
__device__ __forceinline__ unsigned packh2(float a, float b) { f2_t v = {a, b}; return __builtin_bit_cast(unsigned, __builtin_convertvector(v, h2_t)); }
__device__ __forceinline__ f2_t unpackh2(unsigned u) { return __builtin_convertvector(__builtin_bit_cast(h2_t, u), f2_t); }
__device__ __forceinline__ float wave_sum(float v) {
#pragma unroll
    for (int o = 32; o; o >>= 1) v += __shfl_xor(v, o);
    return v;
}
__device__ __forceinline__ float wave_max(float v) {
#pragma unroll
    for (int o = 32; o; o >>= 1) v = fmaxf(v, __shfl_xor(v, o));
    return v;
}
__device__ __forceinline__ float silu_f(float x) { return x / (1.f + __expf(-x)); }
__device__ __forceinline__ float sigmoid_f(float x) { return 1.f / (1.f + __expf(-x)); }
__device__ __forceinline__ void glds16(const void* g, void* l) {
    __builtin_amdgcn_global_load_lds((const unsigned*)g, (unsigned*)l, 16, 0, 0);
}
__device__ __forceinline__ int t5_bucket(int n) {
    if (n < 16) return n;
    int b = 16;
    b += (n >= 21); b += (n >= 27); b += (n >= 35); b += (n >= 46); b += (n >= 59); b += (n >= 77); b += (n >= 99); b += (n >= 128);
    b += (n >= 166); b += (n >= 216); b += (n >= 280); b += (n >= 363); b += (n >= 470); b += (n >= 609); b += (n >= 790);
    return b;
}

struct Ctx {
    int G, vbid, tid, wid, lane;
};

constexpr int P0_MOD_ITEMS = 192;
constexpr int TS0 = 88 * 16, TS1 = 32 * 16, TS2 = 128 * 16, TS3 = 32 * 16, TS4 = 2 * 4 * 32, TS5 = 32 * 32 * 16, TS6 = 32 * 32 * 8;
constexpr int TC0 = 0, TC1 = TC0 + TS0, TC2 = TC1 + TS1, TC3 = TC2 + TS2, TC4 = TC3 + TS3, TC5 = TC4 + TS4, TC6 = TC5 + TS5, TC_END = TC6 + TS6;

struct TrJob { const float* src; int ld, c0, ncols_valid, k0; bf16_t* dst; int dstld; };
__device__ __forceinline__ void tr_load(const TrJob& j, float* tl, int htid) {
    const int k = htid >> 2, cc = (htid & 3) * 8;
    const float* s = j.src + (size_t)(j.k0 + k) * j.ld + j.c0 + cc;
    f32x4 a = {0.f, 0.f, 0.f, 0.f}, c = a;
    if (j.c0 + 32 <= j.ncols_valid) { a = *(const f32x4*)s; c = *(const f32x4*)(s + 4); }
    else {
#pragma unroll
        for (int i = 0; i < 4; ++i) { if (j.c0 + cc + i < j.ncols_valid) a[i] = s[i]; if (j.c0 + cc + 4 + i < j.ncols_valid) c[i] = s[4 + i]; }
    }
#pragma unroll
    for (int i = 0; i < 4; ++i) { tl[k * 33 + cc + i] = a[i]; tl[k * 33 + cc + 4 + i] = c[i]; }
}
__device__ __forceinline__ void tr_store(const TrJob& j, const float* tl, int htid) {
    const int n = htid >> 3, kc = (htid & 7) * 8;
    uint4 o;
    o.x = pack2(tl[(kc + 0) * 33 + n], tl[(kc + 1) * 33 + n]); o.y = pack2(tl[(kc + 2) * 33 + n], tl[(kc + 3) * 33 + n]);
    o.z = pack2(tl[(kc + 4) * 33 + n], tl[(kc + 5) * 33 + n]); o.w = pack2(tl[(kc + 6) * 33 + n], tl[(kc + 7) * 33 + n]);
    *(uint4*)(j.dst + (size_t)n * j.dstld + kc) = o;
}
__device__ __forceinline__ TrJob tr_job(const Params& p, int tt) {
    TrJob j;
    if (tt < TC1) {
        const int nt = tt / 16, kt = tt % 16;
        j = {p.nsa_w_in, NSA_IN, nt * 32, NSA_IN, kt * 64, (bf16_t*)(p.ws + OFF_W_NSA_IN) + (size_t)nt * 32 * 1024 + kt * 64, 1024};
    } else if (tt < TC2) {
        const int u = tt - TC1, nt = u / 16, kt = u % 16;
        j = {p.nsa_w_out, 1024, nt * 32, 1024, kt * 64, (bf16_t*)(p.ws + OFF_W_NSA_OUT) + (size_t)nt * 32 * 1024 + kt * 64, 1024};
    } else if (tt < TC3) {
        const int u = tt - TC2, nt = u / 16, kt = u % 16;
        j = {p.hgrn_w_in, 4096, nt * 32, 4096, kt * 64, (bf16_t*)(p.ws + OFF_W_HG_IN) + (size_t)nt * 32 * 1024 + kt * 64, 1024};
    } else if (tt < TC4) {
        const int u = tt - TC3, nt = u / 16, kt = u % 16;
        j = {p.hgrn_w_out, 1024, nt * 32, 1024, kt * 64, (bf16_t*)(p.ws + OFF_W_HG_OUT) + (size_t)nt * 32 * 1024 + kt * 64, 1024};
    } else if (tt < TC5) {
        const int u = tt - TC4, kv = u / 128, r = u % 128, nt = r / 32, kt = r % 32;
        j = {p.nsa_cmp_w1 + (size_t)kv * 2048 * 64, 64, nt * 32, 64, kt * 64, (bf16_t*)(p.ws + OFF_W_CMP1) + ((size_t)kv * 128 + nt * 32) * 2048 + kt * 64, 2048};
    } else if (tt < TC6) {
        const int u = tt - TC5, le = u / 512, r = u % 512, gr = r / 16, kt = r % 16;
        const int t = gr >> 2, wc = (gr >> 1) & 1, which = gr & 1;
        const float* src = (which ? p.moe_w3 : p.moe_w1) + (size_t)le * 1024 * 512;
        j = {src, 512, (t * 2 + wc) * 32, 512, kt * 64, (bf16_t*)(p.ws + OFF_W_UP) + ((size_t)le * 1024 + gr * 32) * 1024 + kt * 64, 1024};
    } else {
        const int u = tt - TC6, le = u / 256, r = u % 256, nt = r / 8, kt = r % 8;
        j = {p.moe_w2 + (size_t)le * 512 * 1024, 1024, nt * 32, 1024, kt * 64, (bf16_t*)(p.ws + OFF_W_DN) + ((size_t)le * 1024 + nt * 32) * 512 + kt * 64, 512};
    }
    return j;
}

__device__ __forceinline__ void phase0(const Params& p, const Ctx& cx, char* lds) {
    const int tid = cx.tid, wid = cx.wid, lane = cx.lane;
    for (int it = cx.vbid; it < P0_MOD_ITEMS; it += cx.G) {
        const int colbase = it * 64, ls = colbase / 3072, e0 = colbase % 3072;
        const float* W = p.ada_w + (size_t)ls * 1024 * 3072 + e0 + lane;
        float* cs = (float*)lds + wid * 1024;
        float* red = (float*)lds + 8192;
        float acc[16];
#pragma unroll
        for (int b = 0; b < 16; ++b) acc[b] = 0.f;
        for (int sub = 0; sub < 2; ++sub) {
            const int kb = wid * 128 + sub * 64;
#pragma unroll
            for (int b = 0; b < 16; ++b) cs[lane * 16 + b] = silu_f(p.c[b * 1024 + kb + lane]);
            __builtin_amdgcn_wave_barrier();
#pragma unroll 1
            for (int k16 = 0; k16 < 64; k16 += 16) {
                float wv[16];
#pragma unroll
                for (int u = 0; u < 16; ++u) wv[u] = W[(size_t)(kb + k16 + u) * 3072];
#pragma unroll
                for (int u = 0; u < 16; ++u) {
                    const float w = wv[u];
                    const f32x4* cv = (const f32x4*)(cs + (k16 + u) * 16);
#pragma unroll
                    for (int q = 0; q < 4; ++q) {
                        f32x4 c4 = cv[q];
                        acc[q * 4 + 0] += c4[0] * w; acc[q * 4 + 1] += c4[1] * w; acc[q * 4 + 2] += c4[2] * w; acc[q * 4 + 3] += c4[3] * w;
                    }
                }
            }
            __builtin_amdgcn_wave_barrier();
        }
#pragma unroll
        for (int b = 0; b < 16; ++b) red[(wid * 16 + b) * 64 + lane] = acc[b];
        __syncthreads();
        float* mod = (float*)(p.ws + OFF_MOD);
#pragma unroll
        for (int i = 0; i < 2; ++i) {
            const int o = tid + i * NTHR, b = o >> 6, e = o & 63;
            float sm = 0.f;
#pragma unroll
            for (int w = 0; w < 8; ++w) sm += red[(w * 16 + b) * 64 + e];
            mod[((size_t)ls * 16 + b) * 3072 + e0 + e] = sm + p.ada_b[ls * 3072 + e0 + e];
        }
        __syncthreads();
    }
    {
        constexpr int TPH = 4;
        const int half = tid >> 8, htid = tid & 255;
        float* tl = (float*)lds + half * (TPH * 64 * 33);
        for (int base = cx.vbid * 2 * TPH; base < TC_END; base += cx.G * 2 * TPH) {
#pragma unroll
            for (int q = 0; q < TPH; ++q) {
                const int tt = base + half * TPH + q;
                if (tt < TC_END) { const TrJob j = tr_job(p, tt); tr_load(j, tl + q * (64 * 33), htid); }
            }
            __syncthreads();
#pragma unroll
            for (int q = 0; q < TPH; ++q) {
                const int tt = base + half * TPH + q;
                if (tt < TC_END) { const TrJob j = tr_job(p, tt); tr_store(j, tl + q * (64 * 33), htid); }
            }
            __syncthreads();
        }
    }
    if (cx.vbid == cx.G - 1) {
        float* lb = (float*)(p.ws + OFF_LB);
        for (int i = tid; i < 1024; i += NTHR) lb[i] = sigmoid_f(p.hgrn_lb[1024 + i] - p.hgrn_lb[i]);
        if (tid < 128) {
            const int kv = tid >> 6, d = tid & 63;
            const float* pe = p.nsa_cmp_pe + kv * 2048;
            const float* w1 = p.nsa_cmp_w1 + (size_t)kv * 2048 * 64 + d;
            float sm = 0.f;
            for (int k = 0; k < 2048; ++k) sm += pe[k] * w1[(size_t)k * 64];
            ((float*)(p.ws + OFF_PEB))[tid] = sm;
        }
        if (tid < 32) ((int*)(p.ws + OFF_CNT))[tid] = 0;
    }
}

template <bool COMBINE, bool NORM, bool ROUTER>
__device__ __forceinline__ void rows_phase(const Params& p, const Ctx& cx, char* lds, const float* __restrict__ src, float* __restrict__ xdst,
                           int ls_comb, int ls_norm, int layer_router, int layer_comb) {
    const int lane = cx.lane;
    const float* mod = (const float*)(p.ws + OFF_MOD);
    int my_off = 0;
    if (COMBINE) {
        const int* cnt = (const int*)(p.ws + OFF_CNT) + layer_comb * 16;
        int cv = (lane < 16) ? cnt[lane] : 0;
        int incl = cv;
#pragma unroll
        for (int o = 1; o < 16; o <<= 1) { int t = __shfl_up(incl, o); if (lane >= o) incl += t; }
        my_off = incl - cv;
    }
    const int row_first = cx.vbid * NWAVE + cx.wid, row_step = cx.G * NWAVE;
    f32x4 vn[4];
    int sn0 = 0, sn1 = 0;
    if (row_first < NTOK) {
#pragma unroll
        for (int i = 0; i < 4; ++i) vn[i] = *(const f32x4*)(src + (size_t)row_first * 1024 + (i * 64 + lane) * 4);
        if (COMBINE) { const int* ts = (const int*)(p.ws + OFF_TSLOT) + row_first * 2; sn0 = ts[0]; sn1 = ts[1]; }
    }
    for (int row = row_first; row < NTOK; row += row_step) {
        const int b = row >> 11;
        f32x4 v[4];
#pragma unroll
        for (int i = 0; i < 4; ++i) v[i] = vn[i];
        const int s0 = sn0, s1 = sn1;
        {
            const int nrow = row + row_step;
            if (nrow < NTOK) {
#pragma unroll
                for (int i = 0; i < 4; ++i) vn[i] = *(const f32x4*)(src + (size_t)nrow * 1024 + (i * 64 + lane) * 4);
                if (COMBINE) { const int* ts = (const int*)(p.ws + OFF_TSLOT) + nrow * 2; sn0 = ts[0]; sn1 = ts[1]; }
            }
        }
        if (COMBINE) {
            const int r0 = __shfl(my_off, s0 >> 16) + (s0 & 0xffff), r1 = __shfl(my_off, s1 >> 16) + (s1 & 0xffff);
            const bf16_t* Y = (const bf16_t*)(p.ws + OFF_Y);
            const float* gate = mod + ((size_t)ls_comb * 16 + b) * 3072 + 2048;
#pragma unroll
            for (int i = 0; i < 4; ++i) {
                const int col = (i * 64 + lane) * 4;
                uint2 a = *(const uint2*)(Y + (size_t)r0 * 1024 + col), c = *(const uint2*)(Y + (size_t)r1 * 1024 + col);
                f32x4 g = *(const f32x4*)(gate + col);
                v[i][0] += g[0] * (bf2f(a.x & 0xffff) + bf2f(c.x & 0xffff));
                v[i][1] += g[1] * (bf2f(a.x >> 16) + bf2f(c.x >> 16));
                v[i][2] += g[2] * (bf2f(a.y & 0xffff) + bf2f(c.y & 0xffff));
                v[i][3] += g[3] * (bf2f(a.y >> 16) + bf2f(c.y >> 16));
                *(f32x4*)(xdst + (size_t)row * 1024 + col) = v[i];
            }
        }
        if (NORM) {
            float ss = 0.f;
#pragma unroll
            for (int i = 0; i < 4; ++i) ss += v[i][0] * v[i][0] + v[i][1] * v[i][1] + v[i][2] * v[i][2] + v[i][3] * v[i][3];
            ss = wave_sum(ss);
            const float r = rsqrtf(ss * (1.f / 1024.f) + EPS);
            const float* gain = p.norm_g + ls_norm * 1024;
            const float* shift = mod + ((size_t)ls_norm * 16 + b) * 3072;
            const float* scale = shift + 1024;
            bf16_t* hA = (bf16_t*)(p.ws + OFF_HA);
            f32x4 rg4 = {0.f, 0.f, 0.f, 0.f}, re0 = rg4, re1 = rg4, re2 = rg4, re3 = rg4;
#pragma unroll
            for (int i = 0; i < 4; ++i) {
                const int col = (i * 64 + lane) * 4;
                f32x4 g = *(const f32x4*)(gain + col), sc = *(const f32x4*)(scale + col), sh = *(const f32x4*)(shift + col);
                f32x4 h;
#pragma unroll
                for (int j = 0; j < 4; ++j) h[j] = v[i][j] * r * g[j] * (1.f + sc[j]) + sh[j];
                uint2 o; o.x = pack2(h[0], h[1]); o.y = pack2(h[2], h[3]);
                *(uint2*)(hA + (size_t)row * 1024 + col) = o;
                if (ROUTER) {
                    const float* rg = p.moe_rg + (size_t)layer_router * 1024 * 4;
                    const float* re = p.moe_re + (size_t)layer_router * 1024 * 16;
#pragma unroll
                    for (int j = 0; j < 4; ++j) {
                        rg4 += h[j] * *(const f32x4*)(rg + (col + j) * 4);
                        re0 += h[j] * *(const f32x4*)(re + (col + j) * 16 + 0);
                        re1 += h[j] * *(const f32x4*)(re + (col + j) * 16 + 4);
                        re2 += h[j] * *(const f32x4*)(re + (col + j) * 16 + 8);
                        re3 += h[j] * *(const f32x4*)(re + (col + j) * 16 + 12);
                    }
                }
            }
            if (ROUTER) {
                float rl[4];
                f32x4 rs0, rs1, rs2, rs3;
#pragma unroll
                for (int j = 0; j < 4; ++j) { rl[j] = wave_sum(rg4[j]); rs0[j] = wave_sum(re0[j]); rs1[j] = wave_sum(re1[j]); rs2[j] = wave_sum(re2[j]); rs3[j] = wave_sum(re3[j]); }
                float gm = fmaxf(fmaxf(rl[0], rl[1]), fmaxf(rl[2], rl[3]));
                float e0 = __expf(rl[0] - gm), e1 = __expf(rl[1] - gm), e2 = __expf(rl[2] - gm), e3 = __expf(rl[3] - gm);
                float gs = e0 + e1 + e2 + e3;
                int grp = 0; float best = rl[0];
                if (rl[1] > best) { best = rl[1]; grp = 1; }
                if (rl[2] > best) { best = rl[2]; grp = 2; }
                if (rl[3] > best) { best = rl[3]; grp = 3; }
                const float pg = __expf(best - gm) / gs;
                const f32x4 lsel = (grp == 0) ? rs0 : (grp == 1) ? rs1 : (grp == 2) ? rs2 : rs3;
                const float l0 = lsel[0], l1 = lsel[1], l2 = lsel[2], l3 = lsel[3];
                const float em = fmaxf(fmaxf(l0, l1), fmaxf(l2, l3));
                float q0 = __expf(l0 - em), q1 = __expf(l1 - em), q2 = __expf(l2 - em), q3 = __expf(l3 - em);
                int i1 = 0; float b1 = q0;
                if (q1 > b1) { b1 = q1; i1 = 1; }
                if (q2 > b1) { b1 = q2; i1 = 2; }
                if (q3 > b1) { b1 = q3; i1 = 3; }
                int i2 = -1; float b2 = -1.f;
                if (i1 != 0 && q0 > b2) { b2 = q0; i2 = 0; }
                if (i1 != 1 && q1 > b2) { b2 = q1; i2 = 1; }
                if (i1 != 2 && q2 > b2) { b2 = q2; i2 = 2; }
                if (i1 != 3 && q3 > b2) { b2 = q3; i2 = 3; }
                const float inv = pg / (b1 + b2);
                if (lane == 0) {
                    int* cnt = (int*)(p.ws + OFF_CNT) + layer_router * 16;
                    int* ltok = (int*)(p.ws + OFF_LTOK);
                    float* lw = (float*)(p.ws + OFF_LW);
                    int* ts = (int*)(p.ws + OFF_TSLOT) + row * 2;
                    const int ea = grp * 4 + i1, eb = grp * 4 + i2;
                    const int pa = atomicAdd(cnt + ea, 1);
                    const int pb = atomicAdd(cnt + eb, 1);
                    ltok[(size_t)ea * NTOK + pa] = row; lw[(size_t)ea * NTOK + pa] = b1 * inv;
                    ltok[(size_t)eb * NTOK + pb] = row; lw[(size_t)eb * NTOK + pb] = b2 * inv;
                    ts[0] = (ea << 16) | pa; ts[1] = (eb << 16) | pb;
                }
            }
        }
    }
}

__device__ __forceinline__ void rows_router_phase(const Params& p, const Ctx& cx, char* lds, const float* __restrict__ src, int ls_norm, int layer) {
    const int lane = cx.lane, tid = cx.tid;
    const int widu = __builtin_amdgcn_readfirstlane(cx.wid);
    const int wq = widu & 3, grp4 = widu >> 2;
    const float* mod = (const float*)(p.ws + OFF_MOD);
    const float* rg = p.moe_rg + (size_t)layer * 1024 * 4;
    const float* re = p.moe_re + (size_t)layer * 1024 * 16;
    float* logit_s = (float*)lds;
    float wr[16][5];
#pragma unroll
    for (int i = 0; i < 4; ++i)
#pragma unroll
        for (int j = 0; j < 4; ++j) {
            const int k = (i * 64 + lane) * 4 + j;
#pragma unroll
            for (int q = 0; q < 5; ++q) {
                const int o = 5 * wq + q;
                wr[i * 4 + j][q] = (o < 4) ? rg[k * 4 + o] : re[k * 16 + o - 4];
            }
            __builtin_amdgcn_sched_barrier(0);
        }
    const float* gain = p.norm_g + ls_norm * 1024;
    bf16_t* hA = (bf16_t*)(p.ws + OFF_HA);
    for (int blk = cx.vbid; blk < NTOK / 32; blk += cx.G) {
        const int R0 = blk * 32, b = R0 >> 11;
        const float* shift = mod + ((size_t)ls_norm * 16 + b) * 3072;
        const float* scale = shift + 1024;
#pragma unroll 1
        for (int r = 0; r < 16; ++r) {
            const int rl_ = grp4 * 16 + r, row = R0 + rl_;
            f32x4 v[4];
#pragma unroll
            for (int i = 0; i < 4; ++i) v[i] = *(const f32x4*)(src + (size_t)row * 1024 + (i * 64 + lane) * 4);
            float ss = 0.f;
#pragma unroll
            for (int i = 0; i < 4; ++i) ss += v[i][0] * v[i][0] + v[i][1] * v[i][1] + v[i][2] * v[i][2] + v[i][3] * v[i][3];
            ss = wave_sum(ss);
            const float rr = rsqrtf(ss * (1.f / 1024.f) + EPS);
            float acc[5] = {0.f, 0.f, 0.f, 0.f, 0.f};
#pragma unroll
            for (int i = 0; i < 4; ++i) {
                const int col = (i * 64 + lane) * 4;
                const f32x4 g = *(const f32x4*)(gain + col), sc = *(const f32x4*)(scale + col), sh = *(const f32x4*)(shift + col);
                f32x4 h;
#pragma unroll
                for (int j = 0; j < 4; ++j) {
                    h[j] = v[i][j] * rr * g[j] * (1.f + sc[j]) + sh[j];
#pragma unroll
                    for (int q = 0; q < 5; ++q) acc[q] += h[j] * wr[i * 4 + j][q];
                }
                if ((r & 3) == wq) {
                    uint2 o; o.x = pack2(h[0], h[1]); o.y = pack2(h[2], h[3]);
                    *(uint2*)(hA + (size_t)row * 1024 + col) = o;
                }
            }
#pragma unroll
            for (int q = 0; q < 5; ++q) acc[q] = wave_sum(acc[q]);
            if (lane == 0) {
#pragma unroll
                for (int q = 0; q < 5; ++q) logit_s[rl_ * 20 + 5 * wq + q] = acc[q];
            }
        }
        __syncthreads();
        if (tid < 32) {
            const int row = R0 + tid;
            const float* rl = logit_s + tid * 20;
            const float gm = fmaxf(fmaxf(rl[0], rl[1]), fmaxf(rl[2], rl[3]));
            const float gs = __expf(rl[0] - gm) + __expf(rl[1] - gm) + __expf(rl[2] - gm) + __expf(rl[3] - gm);
            int grp = 0; float best = rl[0];
            if (rl[1] > best) { best = rl[1]; grp = 1; }
            if (rl[2] > best) { best = rl[2]; grp = 2; }
            if (rl[3] > best) { best = rl[3]; grp = 3; }
            const float pg = __expf(best - gm) / gs;
            const f32x4 lsel = *(const f32x4*)(rl + 4 + 4 * grp);
            const float l0 = lsel[0], l1 = lsel[1], l2 = lsel[2], l3 = lsel[3];
            const float em = fmaxf(fmaxf(l0, l1), fmaxf(l2, l3));
            const float q0 = __expf(l0 - em), q1 = __expf(l1 - em), q2 = __expf(l2 - em), q3 = __expf(l3 - em);
            int i1 = 0; float b1 = q0;
            if (q1 > b1) { b1 = q1; i1 = 1; }
            if (q2 > b1) { b1 = q2; i1 = 2; }
            if (q3 > b1) { b1 = q3; i1 = 3; }
            int i2 = -1; float b2 = -1.f;
            if (i1 != 0 && q0 > b2) { b2 = q0; i2 = 0; }
            if (i1 != 1 && q1 > b2) { b2 = q1; i2 = 1; }
            if (i1 != 2 && q2 > b2) { b2 = q2; i2 = 2; }
            if (i1 != 3 && q3 > b2) { b2 = q3; i2 = 3; }
            const float inv = pg / (b1 + b2);
            int* cnt = (int*)(p.ws + OFF_CNT) + layer * 16;
            int* ltok = (int*)(p.ws + OFF_LTOK);
            float* lw = (float*)(p.ws + OFF_LW);
            int* ts = (int*)(p.ws + OFF_TSLOT) + row * 2;
            const int ea = grp * 4 + i1, eb = grp * 4 + i2;
            const int pa = atomicAdd(cnt + ea, 1);
            const int pb = atomicAdd(cnt + eb, 1);
            ltok[(size_t)ea * NTOK + pa] = row; lw[(size_t)ea * NTOK + pa] = b1 * inv;
            ltok[(size_t)eb * NTOK + pb] = row; lw[(size_t)eb * NTOK + pb] = b2 * inv;
            ts[0] = (ea << 16) | pa; ts[1] = (eb << 16) | pb;
        }
        __syncthreads();
    }
}

__device__ __forceinline__ int stage_col(int tid) { return ((tid & 7) ^ ((tid >> 3) & 7)) * 8; }

template <class Epi>
__device__ __forceinline__ void gemm_tile(const bf16_t* const (&ap)[4], const bf16_t* const (&bp)[2], int K, char* lds, const Ctx& cx, Epi&& epi) {
    const int tid = cx.tid, lane = cx.lane, wr = cx.wid >> 1, wc = cx.wid & 1, fr = lane & 15, fq = lane >> 4;
    f32x4 acc[4][4];
#pragma unroll
    for (int m = 0; m < 4; ++m)
#pragma unroll
        for (int n = 0; n < 4; ++n) acc[m][n] = (f32x4){0.f, 0.f, 0.f, 0.f};
    const int nt = K / 64;
    auto stage = [&](int t, int slot) {
        char* SA = lds + slot * GEMM_STAGE + tid * 16; char* SB = SA + 32768;
        const int ko = t * 64;
#pragma unroll
        for (int i = 0; i < 4; ++i) glds16(ap[i] + ko, SA + i * 8192);
#pragma unroll
        for (int i = 0; i < 2; ++i) glds16(bp[i] + ko, SB + i * 8192);
    };
    __syncthreads();
    stage(0, 0);
    if (nt > 1) stage(1, 1);
    const int x7 = fr & 7;
    const int aoff = (wr * 64 + fr) * 128, boff = 32768 + (wc * 64 + fr) * 128;
    int slot = 0;
    for (int kt = 0; kt < nt; ++kt) {
        if (kt + 1 < nt) asm volatile("s_waitcnt vmcnt(6)" ::: "memory");
        else asm volatile("s_waitcnt vmcnt(0)" ::: "memory");
        __builtin_amdgcn_s_barrier();
        if (kt + 2 < nt) stage(kt + 2, slot >= 1 ? slot - 1 : 2);
        const char* S = lds + slot * GEMM_STAGE;
#pragma unroll
        for (int ks = 0; ks < 2; ++ks) {
            const int pc = ((ks * 4 + fq) ^ x7) * 16;
            bf16x8 Af[4], Bf[4];
#pragma unroll
            for (int m = 0; m < 4; ++m) Af[m] = *(const bf16x8*)(S + aoff + m * 2048 + pc);
#pragma unroll
            for (int n = 0; n < 4; ++n) Bf[n] = *(const bf16x8*)(S + boff + n * 2048 + pc);
#pragma unroll
            for (int m = 0; m < 4; ++m)
#pragma unroll
                for (int n = 0; n < 4; ++n) acc[m][n] = __builtin_amdgcn_mfma_f32_16x16x32_bf16(Bf[n], Af[m], acc[m][n], 0, 0, 0);
        }
        slot = slot == 2 ? 0 : slot + 1;
    }
    epi(acc, wr, wc, fr, fq);
}

__device__ __forceinline__ int swz_g(int q) { return (0x1320 >> (4 * q)) & 3; }
__device__ __forceinline__ int stage_col2(int tid) { return ((tid & 3) ^ swz_g((tid >> 4) & 3)) * 8; }

template <int MODE = 0, class Epi>
__device__ __forceinline__ void gemm_tile2(const bf16_t* const (&ap)[2], const bf16_t* const (&bp)[2], int K, char* lds, const Ctx& cx, Epi&& epi) {
    const int tid = cx.tid, lane = cx.lane, wc = cx.wid & 3, fr = lane & 15, fq = lane >> 4;
    const int wr = __builtin_amdgcn_readfirstlane(cx.wid >> 2);
    f32x4 acc[8][4];
#pragma unroll
    for (int m = 0; m < 8; ++m)
#pragma unroll
        for (int n = 0; n < 4; ++n) acc[m][n] = (f32x4){0.f, 0.f, 0.f, 0.f};
    const int nt = K / 32;
    auto stage = [&](int t) {
        char* SA = lds + (t & 3) * 32768 + tid * 16; char* SB = SA + 16384;
        const int ko = t * 32;
        glds16(ap[0] + ko, SA); glds16(ap[1] + ko, SA + 8192);
        glds16(bp[0] + ko, SB); glds16(bp[1] + ko, SB + 8192);
    };
    __syncthreads();
    stage(0);
    if (nt > 1) stage(1);
    if (nt > 2) stage(2);
    const int pc = (fq ^ swz_g((fr >> 2) & 3)) * 16;
    const int aoff = (wr * 128 + fr) * 64 + pc, boff = 16384 + (wc * 64 + fr) * 64 + pc;
    bf16x8 Af[8], Bf[4];
    auto load_frags = [&](int kt) {
        const char* S = lds + (kt & 3) * 32768;
#pragma unroll
        for (int n = 0; n < 4; ++n) Bf[n] = *(const bf16x8*)(S + boff + n * 1024);
#pragma unroll
        for (int m = 0; m < 8; ++m) Af[m] = *(const bf16x8*)(S + aoff + m * 1024);
        asm volatile("s_waitcnt lgkmcnt(0)" ::: "memory");
    };
    auto mma = [&]() {
        __builtin_amdgcn_s_setprio(1);
#pragma unroll
        for (int m = 0; m < 8; ++m)
#pragma unroll
            for (int n = 0; n < 4; ++n) acc[m][n] = __builtin_amdgcn_mfma_f32_16x16x32_bf16(Bf[n], Af[m], acc[m][n], 0, 0, 0);
        __builtin_amdgcn_s_setprio(0);
    };
    if (nt > 2) asm volatile("s_waitcnt vmcnt(8)" ::: "memory");
    else if (nt == 2) asm volatile("s_waitcnt vmcnt(4)" ::: "memory");
    else asm volatile("s_waitcnt vmcnt(0)" ::: "memory");
    if (wr == 1) __builtin_amdgcn_s_barrier();
    for (int kt = 0; kt < nt; ++kt) {
        const int rem = nt - 1 - kt;
        if (rem >= 2) asm volatile("s_waitcnt vmcnt(8)" ::: "memory");
        else if (rem == 1) asm volatile("s_waitcnt vmcnt(4)" ::: "memory");
        else asm volatile("s_waitcnt vmcnt(0)" ::: "memory");
        __builtin_amdgcn_s_barrier();
        if (kt + 3 < nt) stage(kt + 3);
        load_frags(kt);
        if (rem >= 3) asm volatile("s_waitcnt vmcnt(8)" ::: "memory");
        else if (rem == 2) asm volatile("s_waitcnt vmcnt(4)" ::: "memory");
        else asm volatile("s_waitcnt vmcnt(0)" ::: "memory");
        __builtin_amdgcn_s_barrier();
        mma();
    }
    if (wr == 0) __builtin_amdgcn_s_barrier();
    if (MODE == 0) epi(acc, wr, wc, fr, fq);
    else {
#pragma unroll
        for (int m = 0; m < 8; ++m)
#pragma unroll
            for (int n = 0; n < 4; ++n) asm volatile("" :: "v"(acc[m][n]));
    }
}

template <int MODE = 0, class EpiFactory>
__device__ __forceinline__ void gemm_phase_dense2(const bf16_t* A, int lda, const bf16_t* Bt, int K, int nrt, int nct, char* lds, const Ctx& cx, EpiFactory&& mk) {
    const int tid = cx.tid;
    const int ntiles = nrt * nct;
    const int sc = stage_col2(tid), sr = tid >> 2;
    for (int tile = cx.vbid; tile < ntiles; tile += cx.G) {
        const int rt = tile / nct, ct = tile % nct;
        const bf16_t* a0 = A + (size_t)(rt * 256 + sr) * lda + sc;
        const bf16_t* b0 = Bt + (size_t)(ct * 256 + sr) * K + sc;
        const bf16_t* const ap[2] = {a0, a0 + (size_t)128 * lda};
        const bf16_t* const bp[2] = {b0, b0 + (size_t)128 * K};
        gemm_tile2<MODE>(ap, bp, K, lds, cx, mk(rt * 256, ct * 256));
    }
}

template <class EpiFactory>
__device__ __forceinline__ void gemm_phase_dense(const bf16_t* A, int lda, const bf16_t* Bt, int K, int nrt, int nct, char* lds, const Ctx& cx, EpiFactory&& mk) {
    const int tid = cx.tid;
    const int ntiles = nrt * nct;
    const int sc = stage_col(tid), sr = tid >> 3;
    for (int tile = cx.vbid; tile < ntiles; tile += cx.G) {
        const int rt = tile / nct, ct = tile % nct;
        const bf16_t* a0 = A + (size_t)(rt * 256 + sr) * lda + sc;
        const bf16_t* b0 = Bt + (size_t)(ct * 128 + sr) * K + sc;
        const bf16_t* const ap[4] = {a0, a0 + (size_t)64 * lda, a0 + (size_t)128 * lda, a0 + (size_t)192 * lda};
        const bf16_t* const bp[2] = {b0, b0 + (size_t)64 * K};
        gemm_tile(ap, bp, K, lds, cx, mk(rt * 256, ct * 128));
    }
}

__device__ __forceinline__ void phase_nsa_inproj(const Params& p, const Ctx& cx, char* lds) {
    const bf16_t* A = (const bf16_t*)(p.ws + OFF_HA);
    const bf16_t* Bt = (const bf16_t*)(p.ws + OFF_W_NSA_IN);
    char* ws = p.ws;
    const float* qg = p.nsa_q_gain;
    const float* kg = p.nsa_k_gain;
    gemm_phase_dense2(A, 1024, Bt, 1024, NTOK / 256, NSA_IN_PAD / 256, lds, cx, [=](int row0, int col0) {
        return [=](f32x4 (&acc)[8][4], int wr, int wc, int fr, int fq) {
            const int gc0 = col0 + wc * 64;
            if (gc0 >= NSA_IN) return;
            if (gc0 < 1024 || (gc0 >= 1536 && gc0 < 1792) || (gc0 >= 2048 && gc0 < 2304)) {
                const float* gain; float post; bf16_t* dstb; size_t rstride; size_t coff; bool tokmajor;
                if (gc0 < 1024) { gain = qg; post = 0.125f * 1.4426950408889634f; }
                else if (gc0 < 1792) { gain = kg + 64; post = 1.f; }
                else { gain = kg + 128; post = 1.f; }
#pragma unroll
                for (int m = 0; m < 8; ++m) {
                    __builtin_amdgcn_sched_barrier(0);
                    float ss = 0.f;
#pragma unroll
                    for (int n = 0; n < 4; ++n) ss += acc[m][n][0] * acc[m][n][0] + acc[m][n][1] * acc[m][n][1] + acc[m][n][2] * acc[m][n][2] + acc[m][n][3] * acc[m][n][3];
                    ss += __shfl_xor(ss, 16); ss += __shfl_xor(ss, 32);
                    const float r = rsqrtf(ss * (1.f / 64.f) + EPS) * post;
                    const int row = row0 + wr * 128 + m * 16 + fr;
                    bf16_t* dst;
                    if (gc0 < 1024) dst = (bf16_t*)(ws + OFF_Q) + (size_t)row * 1024 + gc0;
                    else {
                        const int g = ((gc0 - 1024) & 255) >> 6, b = row >> 11, t = row & 2047;
                        dst = (bf16_t*)(ws + (gc0 < 1792 ? OFF_KS : OFF_KW)) + ((size_t)(b * 4 + g) * 2048 + t) * 64;
                    }
#pragma unroll
                    for (int n = 0; n < 4; ++n) {
                        const int c = n * 16 + fq * 4;
                        f32x4 g4 = *(const f32x4*)(gain + c);
                        uint2 o; o.x = pack2(acc[m][n][0] * r * g4[0], acc[m][n][1] * r * g4[1]); o.y = pack2(acc[m][n][2] * r * g4[2], acc[m][n][3] * r * g4[3]);
                        *(uint2*)(dst + c) = o;
                    }
                }
            } else if (gc0 < 2560) {
                const int seg = (gc0 - 1024) >> 8;
                const int g = ((gc0 - 1024) & 255) >> 6;
                if (seg < 2) {
                    const size_t off = seg == 0 ? OFF_KCRAW : OFF_VCRAW;
#pragma unroll
                    for (int m = 0; m < 8; ++m) {
                        __builtin_amdgcn_sched_barrier(0);
                    __builtin_amdgcn_sched_barrier(0);
                        const int row = row0 + wr * 128 + m * 16 + fr, b = row >> 11, t = row & 2047;
                        bf16_t* dst = (bf16_t*)(ws + off) + ((size_t)(b * 4 + g) * 2048 + t) * 64;
#pragma unroll
                        for (int n = 0; n < 4; ++n) {
                            const int c = n * 16 + fq * 4;
                            uint2 o; o.x = pack2(acc[m][n][0], acc[m][n][1]); o.y = pack2(acc[m][n][2], acc[m][n][3]);
                            *(uint2*)(dst + c) = o;
                        }
                    }
                } else {
                    const size_t off = seg == 3 ? OFF_VS : OFF_VW;
#pragma unroll
                    for (int m = 0; m < 8; ++m) {
                        __builtin_amdgcn_sched_barrier(0);
                    __builtin_amdgcn_sched_barrier(0);
                        const int row = row0 + wr * 128 + m * 16 + fr, b = row >> 11, t = row & 2047;
                        bf16_t* dst = (bf16_t*)(ws + off) + (size_t)(b * 4 + g) * 64 * 2048 + t;
#pragma unroll
                        for (int n = 0; n < 4; ++n)
#pragma unroll
                            for (int j = 0; j < 4; ++j) dst[(size_t)(n * 16 + fq * 4 + j) * 2048] = f2bf(acc[m][n][j]);
                    }
                }
            } else {
#pragma unroll
                for (int m = 0; m < 8; ++m) {
                    __builtin_amdgcn_sched_barrier(0);
                    const int row = row0 + wr * 128 + m * 16 + fr;
                    float* dst = (float*)(ws + OFF_GATES) + (size_t)row * 48;
#pragma unroll
                    for (int n = 0; n < 3; ++n) {
                        const int c = n * 16 + fq * 4;
                        f32x4 o;
#pragma unroll
                        for (int j = 0; j < 4; ++j) o[j] = sigmoid_f(acc[m][n][j]);
                        *(f32x4*)(dst + c) = o;
                    }
                }
            }
        };
    });
}

__device__ __forceinline__ void phase_cmp1(const Params& p, const Ctx& cx, char* lds) {
    const int tid = cx.tid;
    const float* peb = (const float*)(p.ws + OFF_PEB);
    float* T1 = (float*)(p.ws + OFF_T1);
    const int sc = stage_col(tid), sr = tid >> 3;
    for (int tile = cx.vbid; tile < 64; tile += cx.G) {
        const int kv = tile >> 5, bg2 = tile & 31;
        const bf16_t* raw = (const bf16_t*)(p.ws + (kv ? OFF_VCRAW : OFF_KCRAW)) + (size_t)bg2 * 2 * 2048 * 64;
        const bf16_t* a0 = raw + (size_t)sr * 1024 + sc;
        const bf16_t* a2 = raw + (size_t)2048 * 64 + (size_t)sr * 1024 + sc;
        const bf16_t* b0 = (const bf16_t*)(p.ws + OFF_W_CMP1) + ((size_t)kv * 128 + sr) * 2048 + sc;
        const bf16_t* const ap[4] = {a0, a0 + (size_t)64 * 1024, a2, a2 + (size_t)64 * 1024};
        const bf16_t* const bp[2] = {b0, b0 + (size_t)64 * 2048};
        gemm_tile(ap, bp, 2048, lds, cx, [=](f32x4 (&acc)[4][4], int wr, int wc, int fr, int fq) {
            if (wc != 0) return;
#pragma unroll
            for (int m = 0; m < 4; ++m) {
                const int r = wr * 64 + m * 16 + fr;
                float* dst = T1 + ((size_t)kv * 8192 + (bg2 * 2 + (r >> 7)) * 128 + (r & 127)) * 64;
#pragma unroll
                for (int n = 0; n < 4; ++n) {
                    const int c = n * 16 + fq * 4;
                    f32x4 pb = *(const f32x4*)(peb + kv * 64 + c);
                    *(f32x4*)(dst + c) = acc[m][n] + pb;
                }
            }
        });
    }
}

__device__ __forceinline__ void phase_cmp2(const Params& p, const Ctx& cx) {
    const int lane = cx.lane;
    const float* T1 = (const float*)(p.ws + OFF_T1);
    for (int r = cx.vbid * NWAVE + cx.wid; r < 2 * 8192; r += cx.G * NWAVE) {
        const int kv = r >> 13, rr = r & 8191, n_ = rr & 127;
        const float s = silu_f(T1[(size_t)r * 64 + lane]);
        const float* w2 = p.nsa_cmp_w2 + kv * 4096 + lane;
        float o = 0.f;
#pragma unroll 8
        for (int j = 0; j < 64; ++j) o += __shfl(s, j) * w2[j * 64];
        if (kv == 0) {
            const float ss = wave_sum(o * o);
            o = o * rsqrtf(ss * (1.f / 64.f) + EPS) * p.nsa_k_gain[lane];
        }
        if (n_ == 127) o = 0.f;
        if (kv == 0) ((bf16_t*)(p.ws + OFF_KC))[(size_t)rr * 64 + lane] = f2bf(o);
        else ((bf16_t*)(p.ws + OFF_VC))[((size_t)(rr >> 7) * 64 + lane) * 128 + n_] = f2bf(o);
    }
}

constexpr int ATT_BUF = 17920, ATT_K_STRIDE = 144, ATT_V_OFF = 9216, ATT_V_STRIDE = 136, ATT_LUT_OFF = 2 * ATT_BUF, LUT_N = 2136, LUT_PAD = 80;
constexpr int ATT_SC_OFF = ATT_LUT_OFF + 4 * LUT_N * 4;
static_assert(ATT_SC_OFF + NWAVE * 8192 <= LDS_TAB_OFF, "attention LDS");
#define MFMA32(a, b, c) __builtin_amdgcn_mfma_f32_32x32x16_bf16((a), (b), (c), 0, 0, 0)
template <int V> struct IC { static constexpr int value = V; };

__device__ __forceinline__ void phase_attn(const Params& p, const Ctx& cx, char* lds) {
    const int tid = cx.tid, lane = cx.lane, wid = cx.wid;
    const int g = cx.vbid & 3;
    const int ql = lane & 7, head = (lane & 31) >> 3, h2 = lane >> 5, l31 = lane & 31;
    float* lut = (float*)(lds + ATT_LUT_OFF);
    for (int i = tid; i < 4 * LUT_N; i += NTHR) {
        const int h = i / LUT_N, dist = i % LUT_N - LUT_PAD;
        lut[i] = dist >= 0 ? p.rel_bias[t5_bucket(dist) * 16 + g * 4 + h] * 1.4426950408889634f : 0.f;
    }
    __syncthreads();
    const float* lutp = lut + head * LUT_N + LUT_PAD;
    const float b31 = lutp[2047];
    const bf16_t* Qb = (const bf16_t*)(p.ws + OFF_Q);
    const bf16_t* KC = (const bf16_t*)(p.ws + OFF_KC);
    const bf16_t* VCT = (const bf16_t*)(p.ws + OFF_VC);
    const bf16_t* KS = (const bf16_t*)(p.ws + OFF_KS);
    const bf16_t* VST = (const bf16_t*)(p.ws + OFF_VS);
    const bf16_t* KW = (const bf16_t*)(p.ws + OFF_KW);
    const bf16_t* VWT = (const bf16_t*)(p.ws + OFF_VW);
    const float* GT = (const float*)(p.ws + OFF_GATES);
    bf16_t* Og = (bf16_t*)(p.ws + OFF_HA);
    float* scw = (float*)(lds + ATT_SC_OFF) + wid * 2048;
    f32x4* outw = (f32x4*)(lds + ATT_SC_OFF + wid * 8192) + lane;
    const bool flip_ok = (cx.G % 128) == 0;
    const int widu = __builtin_amdgcn_readfirstlane(wid);

    for (int it = 0;; ++it) {
        const int u = cx.vbid + it * cx.G;
        if (u >= 2048) break;
        const int rest = u >> 2, b = rest >> 5, qtb = rest & 31;
        const int qt = (flip_ok && (it & 1)) ? 31 - qtb : qtb;
        const int t0 = qt * 64, cur = qt, bg = b * 4 + g;
        const int tq = t0 + wid * 8 + ql;
        const size_t rowtok = (size_t)b * SEQ + tq;
        bf16x8 Qf[4];
        {
            const bf16_t* qp = Qb + rowtok * 1024 + (g * 4 + head) * 64 + 8 * h2;
#pragma unroll
            for (int ks = 0; ks < 4; ++ks) Qf[ks] = *(const bf16x8*)(qp + 16 * ks);
        }
        const float* gt = GT + rowtok * 48 + (g * 4 + head) * 3;
        const float gate_c = gt[0], gate_s = gt[1], gate_w = gt[2];
        const int wlo = max(0, qt - 8);
        const int nW = cur - wlo + 1;
        const int NT = 4 + nW + cur + 1;

        uint4 kr0, vr0;
        auto issue_load = [&](int i) {
            const bf16_t* ksrc; const bf16_t* vsrc; int vstride;
            if (i < 4) { const int ci = i & 1; ksrc = KC + ((size_t)bg * 128 + ci * 64) * 64; vsrc = VCT + (size_t)bg * 64 * 128 + ci * 64; vstride = 128; }
            else if (i < 4 + nW) { const int kb = wlo + i - 4; ksrc = KW + ((size_t)bg * 2048 + kb * 64) * 64; vsrc = VWT + (size_t)bg * 64 * 2048 + kb * 64; vstride = 2048; }
            else { const int kb = i - 4 - nW; ksrc = KS + ((size_t)bg * 2048 + kb * 64) * 64; vsrc = VST + (size_t)bg * 64 * 2048 + kb * 64; vstride = 2048; }
            kr0 = *(const uint4*)(ksrc + tid * 8);
            vr0 = *(const uint4*)(vsrc + (size_t)(tid >> 3) * vstride + (tid & 7) * 8);
        };
        auto write_lds = [&](int i) {
            char* bufp = lds + (i & 1) * ATT_BUF;
            *(uint4*)(bufp + (tid >> 3) * ATT_K_STRIDE + (tid & 7) * 16) = kr0;
            char* va = bufp + ATT_V_OFF + (tid >> 3) * ATT_V_STRIDE + (tid & 7) * 16;
            uint2 t;
            t.x = vr0.x; t.y = vr0.y; *(uint2*)va = t;
            t.x = vr0.z; t.y = vr0.w; *(uint2*)(va + 8) = t;
        };
        f32x16 O0, O1;
#pragma unroll
        for (int r = 0; r < 16; ++r) { O0[r] = 0.f; O1[r] = 0.f; }
        float lsum = 0.f;

        auto qk = [&](const char* bufp, int kt2, float init) -> f32x16 {
            f32x16 S;
#pragma unroll
            for (int r = 0; r < 16; ++r) S[r] = init;
            const char* kp = bufp + (32 * kt2 + l31) * ATT_K_STRIDE + 16 * h2;
#pragma unroll
            for (int ks = 0; ks < 4; ++ks) S = MFMA32(*(const bf16x8*)(kp + 32 * ks), Qf[ks], S);
            return S;
        };
        auto pv = [&](const char* bufp, int kt2, const f32x16& P) {
#pragma unroll
            for (int s2 = 0; s2 < 2; ++s2) {
                uint4 pk;
                pk.x = pack2(P[8 * s2 + 0], P[8 * s2 + 1]); pk.y = pack2(P[8 * s2 + 2], P[8 * s2 + 3]);
                pk.z = pack2(P[8 * s2 + 4], P[8 * s2 + 5]); pk.w = pack2(P[8 * s2 + 6], P[8 * s2 + 7]);
                const bf16x8 Pf = __builtin_bit_cast(bf16x8, pk);
                const char* vp = bufp + ATT_V_OFF + l31 * ATT_V_STRIDE + (32 * kt2 + 16 * s2 + 4 * h2) * 2;
                {
                    uint2 lo = *(const uint2*)vp, hi = *(const uint2*)(vp + 16);
                    uint4 a; a.x = lo.x; a.y = lo.y; a.z = hi.x; a.w = hi.y;
                    O0 = MFMA32(__builtin_bit_cast(bf16x8, a), Pf, O0);
                }
                {
                    uint2 lo = *(const uint2*)(vp + 32 * ATT_V_STRIDE), hi = *(const uint2*)(vp + 32 * ATT_V_STRIDE + 16);
                    uint4 a; a.x = lo.x; a.y = lo.y; a.z = hi.x; a.w = hi.y;
                    O1 = MFMA32(__builtin_bit_cast(bf16x8, a), Pf, O1);
                }
            }
        };
        auto finalize = [&](float gate, int mode) {
            const float Z = lsum + __shfl_xor(lsum, 32);
            const float f = Z > 0.f ? gate / Z : 0.f;
#pragma unroll
            for (int v4 = 0; v4 < 4; ++v4) {
                f32x4 a = {f * O0[4 * v4], f * O0[4 * v4 + 1], f * O0[4 * v4 + 2], f * O0[4 * v4 + 3]};
                f32x4 c = {f * O1[4 * v4], f * O1[4 * v4 + 1], f * O1[4 * v4 + 2], f * O1[4 * v4 + 3]};
                if (mode != 0) { a += outw[v4 * 64]; c += outw[(4 + v4) * 64]; }
                if (mode != 2) { outw[v4 * 64] = a; outw[(4 + v4) * 64] = c; }
                else { O0[4 * v4] = a[0]; O0[4 * v4 + 1] = a[1]; O0[4 * v4 + 2] = a[2]; O0[4 * v4 + 3] = a[3];
                       O1[4 * v4] = c[0]; O1[4 * v4 + 1] = c[1]; O1[4 * v4 + 2] = c[2]; O1[4 * v4 + 3] = c[3]; }
            }
            if (mode != 2) {
#pragma unroll
                for (int r = 0; r < 16; ++r) { O0[r] = 0.f; O1[r] = 0.f; }
            }
            lsum = 0.f;
        };
        auto tile_ws = [&](const char* bufp, int kb, float cinit, auto MMc, auto BMc) {
            constexpr int MM = decltype(MMc)::value, BM = decltype(BMc)::value;
#pragma unroll 1
            for (int kt2 = 0; kt2 < 2; ++kt2) {
                const int d0 = tq - (64 * kb + 32 * kt2 + 4 * h2);
                const float* lp = lutp + (d0 - 27);
                float bv[16];
                if (BM == 0) {
#pragma unroll
                    for (int r = 0; r < 16; ++r) bv[r] = lp[27 - ((r & 3) + 8 * (r >> 2))];
                    __builtin_amdgcn_sched_barrier(0);
                }
                f32x16 S = qk(bufp, kt2, cinit);
#pragma unroll
                for (int r = 0; r < 16; ++r) {
                    const int cr = (r & 3) + 8 * (r >> 2);
                    float x = S[r];
                    if (BM == 0) x += bv[r];
                    if (MM == 1) x += (d0 - cr < 512) ? 0.f : -INFINITY;
                    if (MM == 2) x += (d0 - cr >= 0) ? 0.f : -INFINITY;
                    S[r] = __builtin_amdgcn_exp2f(x);
                    lsum += S[r];
                }
                pv(bufp, kt2, S);
            }
        };

        const int nvis = (tq >= 31) ? min((tq - 31) / 16 + 1, 127) : 0;
        float inv_c = 0.f;
        unsigned selmask = 0u;
        float* sown = scw + ql * 32;
        float* stail = scw + 256 + ql * 32;
        float* ssc = scw + 512 + ql * 32;
        issue_load(0);
        __syncthreads();
        write_lds(0);
        issue_load(1);
        for (int i = 0; i < NT; ++i) {
            __syncthreads();
            const char* bufp = lds + (i & 1) * ATT_BUF;
            if (i < 4) {
                const int ci = i & 1;
#pragma unroll 1
                for (int kt2 = 0; kt2 < 2; ++kt2) {
                    f32x16 S = qk(bufp, kt2, 0.f);
                    const int n0 = 64 * ci + 32 * kt2 + 4 * h2;
                    const int d0 = tq - 31 - 16 * n0;
#pragma unroll
                    for (int r = 0; r < 16; ++r) {
                        const int cr = (r & 3) + 8 * (r >> 2);
                        const float bias = lutp[max(d0 - 16 * cr, -LUT_PAD)];
                        S[r] = __builtin_amdgcn_exp2f(S[r] + bias + ((n0 + cr) < nvis ? 0.f : -INFINITY));
                        lsum += S[r];
                    }
                    if (i >= 2) {
                        pv(bufp, kt2, S);
#pragma unroll
                        for (int rq = 0; rq < 4; ++rq) {
                            float gsum = (S[4 * rq] + S[4 * rq + 1] + S[4 * rq + 2] + 0.5f * S[4 * rq + 3]) * inv_c;
                            float tl = 0.5f * S[4 * rq + 3] * inv_c;
                            gsum += __shfl_xor(gsum, 8); gsum += __shfl_xor(gsum, 16);
                            tl += __shfl_xor(tl, 8); tl += __shfl_xor(tl, 16);
                            const int sblk = 8 * (2 * ci + kt2) + 2 * rq + h2;
                            if (head == 0) {
                                sown[sblk] = gsum;
                                if (sblk < 31) stail[sblk + 1] = tl;
                            }
                        }
                    }
                }
                if (i == 1) {
                    const float Z = lsum + __shfl_xor(lsum, 32);
                    inv_c = Z > 0.f ? 1.f / Z : 0.f;
                    lsum = 0.f;
                }
                if (i == 3) {
                    if (head == 0 && h2 == 0) stail[0] = 0.f;
                    __builtin_amdgcn_wave_barrier();
                    const int j8 = head * 2 + h2;
                    {
                        const f32x4 a = *(const f32x4*)(sown + 4 * j8), t4 = *(const f32x4*)(stail + 4 * j8);
                        f32x4 sc;
#pragma unroll
                        for (int q = 0; q < 4; ++q) {
                            const int sblk = 4 * j8 + q;
                            const bool forced = (sblk == 0) || (sblk == cur) || (sblk == cur - 1);
                            sc[q] = forced ? 1.0e4f : (sblk <= cur ? a[q] + t4[q] : -1.0f);
                        }
                        *(f32x4*)(ssc + 4 * j8) = sc;
                    }
                    __builtin_amdgcn_wave_barrier();
                    const f32x4 own = *(const f32x4*)(ssc + 4 * j8);
                    int rk0 = 0, rk1 = 0, rk2 = 0, rk3 = 0;
                    const int so0 = 4 * j8;
#pragma unroll
                    for (int m4 = 0; m4 < 8; ++m4) {
                        const f32x4 v = *(const f32x4*)(ssc + 4 * m4);
#pragma unroll
                        for (int q = 0; q < 4; ++q) {
                            const int sm = 4 * m4 + q;
                            const float vm = v[q];
                            rk0 += (vm > own[0] || (vm == own[0] && sm < so0)) ? 1 : 0;
                            rk1 += (vm > own[1] || (vm == own[1] && sm < so0 + 1)) ? 1 : 0;
                            rk2 += (vm > own[2] || (vm == own[2] && sm < so0 + 2)) ? 1 : 0;
                            rk3 += (vm > own[3] || (vm == own[3] && sm < so0 + 3)) ? 1 : 0;
                        }
                    }
                    unsigned mk = ((rk0 < 8 ? 1u : 0u) | (rk1 < 8 ? 2u : 0u) | (rk2 < 8 ? 4u : 0u) | (rk3 < 8 ? 8u : 0u)) << so0;
                    mk |= __shfl_xor(mk, 8); mk |= __shfl_xor(mk, 16); mk |= __shfl_xor(mk, 32);
                    selmask = mk;
                    __builtin_amdgcn_wave_barrier();
                    finalize(gate_c, 0);
                }
            } else if (i < 4 + nW) {
                const int kb = wlo + i - 4;
                if (kb == cur) tile_ws(bufp, kb, 0.f, IC<2>{}, IC<0>{});
                else if (kb == cur - 8) tile_ws(bufp, kb, 0.f, IC<1>{}, IC<0>{});
                else tile_ws(bufp, kb, 0.f, IC<0>{}, IC<0>{});
                if (i == 3 + nW) finalize(gate_w, 1);
            } else {
                const int kb = i - 4 - nW;
                const bool sel = ((selmask >> kb) & 1u) != 0;
                if (__ballot(sel) != 0ull) {
                    const float neg = sel ? 0.f : -INFINITY;
                    if (kb == cur) tile_ws(bufp, kb, neg, IC<2>{}, IC<0>{});
                    else if (t0 + 8 * widu - (64 * kb + 63) >= 790) tile_ws(bufp, kb, neg + b31, IC<0>{}, IC<1>{});
                    else tile_ws(bufp, kb, neg, IC<0>{}, IC<0>{});
                }
            }
            if (i + 1 < NT) {
                write_lds(i + 1);
                if (i + 2 < NT) issue_load(i + 2);
            }
        }
        finalize(gate_s, 2);
        {
            bf16_t* op = Og + rowtok * 1024 + (g * 4 + head) * 64 + 4 * h2;
#pragma unroll
            for (int rq = 0; rq < 4; ++rq) {
                uint2 o0; o0.x = pack2(O0[4 * rq], O0[4 * rq + 1]); o0.y = pack2(O0[4 * rq + 2], O0[4 * rq + 3]);
                uint2 o1; o1.x = pack2(O1[4 * rq], O1[4 * rq + 1]); o1.y = pack2(O1[4 * rq + 2], O1[4 * rq + 3]);
                *(uint2*)(op + 8 * rq) = o0;
                *(uint2*)(op + 32 + 8 * rq) = o1;
            }
        }
    }
}

__device__ __forceinline__ void phase_outproj(const Params& p, const Ctx& cx, char* lds, const bf16_t* A, const bf16_t* Bt, const float* xin, int ls) {
    const float* mod = (const float*)(p.ws + OFF_MOD);
    float* xo = p.out;
    gemm_phase_dense2(A, 1024, Bt, 1024, NTOK / 256, 4, lds, cx, [=](int row0, int col0) {
        return [=](f32x4 (&acc)[8][4], int wr, int wc, int fr, int fq) {
#pragma unroll
            for (int m = 0; m < 8; ++m) {
                const int row = row0 + wr * 128 + m * 16 + fr, b = row >> 11;
                const float* gate = mod + ((size_t)ls * 16 + b) * 3072 + 2048;
#pragma unroll
                for (int n = 0; n < 4; ++n) {
                    const int col = col0 + wc * 64 + n * 16 + fq * 4;
                    f32x4 g = *(const f32x4*)(gate + col);
                    f32x4 xi = *(const f32x4*)(xin + (size_t)row * 1024 + col);
                    f32x4 o;
#pragma unroll
                    for (int j = 0; j < 4; ++j) o[j] = xi[j] + g[j] * acc[m][n][j];
                    *(f32x4*)(xo + (size_t)row * 1024 + col) = o;
                }
            }
        };
    });
}

__device__ __forceinline__ void moe_tables(const Params& p, int layer, int tid, int* s_cnt, int* s_off, int* s_toff) {
    __syncthreads();
    if (tid == 0) {
        const int* cnt = (const int*)(p.ws + OFF_CNT) + layer * 16;
        int o = 0, to = 0;
        for (int e = 0; e < 16; ++e) { const int c = cnt[e]; s_cnt[e] = c; s_off[e] = o; s_toff[e] = to; o += c; to += ((c + 255) >> 8) * 4; }
        s_off[16] = o; s_toff[16] = to;
    }
    __syncthreads();
}

__device__ __forceinline__ void phase_moe_up(const Params& p, const Ctx& cx, char* lds, int layer) {
    const int tid = cx.tid;
    int* s_cnt = (int*)(lds + LDS_TAB_OFF); int* s_off = s_cnt + 16; int* s_toff = s_off + 17;
    moe_tables(p, layer, tid, s_cnt, s_off, s_toff);
    const int ntiles = s_toff[16];
    const bf16_t* hA = (const bf16_t*)(p.ws + OFF_HA);
    const int* ltok = (const int*)(p.ws + OFF_LTOK);
    bf16_t* H1 = (bf16_t*)(p.ws + OFF_H1);
    const int sc = stage_col2(tid), sr = tid >> 2;
    for (int tile = cx.vbid; tile < ntiles; tile += cx.G) {
        int e = 0;
        while (tile >= s_toff[e + 1]) ++e;
        const int lt = tile - s_toff[e], rt = lt >> 2, ct = lt & 3, cnt = s_cnt[e], off = s_off[e];
        const int* lt_e = ltok + (size_t)e * NTOK;
        const bf16_t* const ap[2] = {hA + (size_t)lt_e[min(rt * 256 + sr, cnt - 1)] * 1024 + sc, hA + (size_t)lt_e[min(rt * 256 + sr + 128, cnt - 1)] * 1024 + sc};
        const bf16_t* b0 = (const bf16_t*)(p.ws + OFF_W_UP) + ((size_t)(layer * 16 + e) * 1024 + ct * 256 + sr) * 1024 + sc;
        const bf16_t* const bp[2] = {b0, b0 + (size_t)128 * 1024};
        gemm_tile2(ap, bp, 1024, lds, cx, [=](f32x4 (&acc)[8][4], int wr, int wc, int fr, int fq) {
#pragma unroll
            for (int m = 0; m < 8; ++m) {
                const int pos = rt * 256 + wr * 128 + m * 16 + fr;
                if (pos < cnt) {
                    bf16_t* dst = H1 + (size_t)(off + pos) * 512 + ct * 128 + wc * 32 + fq * 4;
#pragma unroll
                    for (int n = 0; n < 2; ++n) {
                        float h[4];
#pragma unroll
                        for (int j = 0; j < 4; ++j) h[j] = silu_f(acc[m][n][j]) * acc[m][n + 2][j];
                        uint2 o; o.x = pack2(h[0], h[1]); o.y = pack2(h[2], h[3]);
                        *(uint2*)(dst + n * 16) = o;
                    }
                }
            }
        });
    }
}

__device__ __forceinline__ void phase_moe_down(const Params& p, const Ctx& cx, char* lds, int layer) {
    const int tid = cx.tid;
    int* s_cnt = (int*)(lds + LDS_TAB_OFF); int* s_off = s_cnt + 16; int* s_toff = s_off + 17;
    moe_tables(p, layer, tid, s_cnt, s_off, s_toff);
    const int ntiles = s_toff[16];
    const bf16_t* H1 = (const bf16_t*)(p.ws + OFF_H1);
    const float* lw = (const float*)(p.ws + OFF_LW);
    bf16_t* Y = (bf16_t*)(p.ws + OFF_Y);
    const int sc = stage_col2(tid), sr = tid >> 2;
    for (int tile = cx.vbid; tile < ntiles; tile += cx.G) {
        int e = 0;
        while (tile >= s_toff[e + 1]) ++e;
        const int lt = tile - s_toff[e], rt = lt >> 2, ct = lt & 3, cnt = s_cnt[e], off = s_off[e];
        const bf16_t* const ap[2] = {H1 + (size_t)(off + min(rt * 256 + sr, cnt - 1)) * 512 + sc, H1 + (size_t)(off + min(rt * 256 + sr + 128, cnt - 1)) * 512 + sc};
        const bf16_t* b0 = (const bf16_t*)(p.ws + OFF_W_DN) + ((size_t)(layer * 16 + e) * 1024 + ct * 256 + sr) * 512 + sc;
        const bf16_t* const bp[2] = {b0, b0 + (size_t)128 * 512};
        gemm_tile2(ap, bp, 512, lds, cx, [=](f32x4 (&acc)[8][4], int wr, int wc, int fr, int fq) {
#pragma unroll
            for (int m = 0; m < 8; ++m) {
                const int pos = rt * 256 + wr * 128 + m * 16 + fr;
                if (pos < cnt) {
                    const float w = lw[(size_t)e * NTOK + pos];
                    bf16_t* dst = Y + (size_t)(off + pos) * 1024 + ct * 256 + wc * 64 + fq * 4;
#pragma unroll
                    for (int n = 0; n < 4; ++n) {
                        uint2 o; o.x = pack2(w * acc[m][n][0], w * acc[m][n][1]); o.y = pack2(w * acc[m][n][2], w * acc[m][n][3]);
                        *(uint2*)(dst + n * 16) = o;
                    }
                }
            }
        });
    }
}

template <int MODE = 0>
__device__ __forceinline__ void phase_hgrn_inproj(const Params& p, const Ctx& cx, char* lds) {
    const bf16_t* A = (const bf16_t*)(p.ws + OFF_HA);
    const bf16_t* Bt = (const bf16_t*)(p.ws + OFF_W_HG_IN);
    char* ws = p.ws;
    const float* lb = (const float*)(p.ws + OFF_LB);
    gemm_phase_dense2<MODE>(A, 1024, Bt, 1024, NTOK / 256, 16, lds, cx, [=](int row0, int col0) {
        return [=](f32x4 (&acc)[8][4], int wr, int wc, int fr, int fq) {
            const int gc0 = col0 + wc * 64, seg = gc0 >> 10, c0 = gc0 & 1023;
#pragma unroll
            for (int m = 0; m < 8; ++m) {
                const int row = row0 + wr * 128 + m * 16 + fr;
#pragma unroll
                for (int n = 0; n < 4; ++n) {
                    const int c = c0 + n * 16 + fq * 4;
                    if (seg == 1) {
                        f32x4 l4 = *(const f32x4*)(lb + c), o;
#pragma unroll
                        for (int j = 0; j < 4; ++j) o[j] = __logf(l4[j] + (1.f - l4[j]) * sigmoid_f(acc[m][n][j]));
                        uint2 oh; oh.x = packh2(o[0], o[1]); oh.y = packh2(o[2], o[3]);
                        *(uint2*)((unsigned short*)(ws + OFF_LF) + (size_t)row * 1024 + c) = oh;
                    } else {
                        float h[4];
#pragma unroll
                        for (int j = 0; j < 4; ++j) h[j] = (seg == 2) ? acc[m][n][j] : silu_f(acc[m][n][j]);
                        uint2 o; o.x = pack2(h[0], h[1]); o.y = pack2(h[2], h[3]);
                        bf16_t* dst = (bf16_t*)(ws + (seg == 0 ? OFF_QH : seg == 2 ? OFF_V : OFF_G));
                        *(uint2*)(dst + (size_t)row * 1024 + c) = o;
                    }
                }
            }
        };
    });
}

constexpr int HG_QD_OFF = 0, HG_KD_OFF = 8704, HG_K2T_OFF = 17408, HG_VT_OFF = 27648, HG_DEC_OFF = 37888, HG_BUF = 38400, HG_TOT_OFF = 2 * HG_BUF;
constexpr int HG_ROW = 272, HG_TROW = 80;
static_assert(HG_TOT_OFF + 2048 <= LDS_TAB_OFF, "hgrn LDS");

__device__ __forceinline__ void phase_hgrn_rec(const Params& p, const Ctx& cx, char* lds) {
    const int lane = cx.lane;
    const int l31 = lane & 31, h2 = lane >> 5;
    const int widu = __builtin_amdgcn_readfirstlane(cx.wid);
    const bool producer = widu >= 4;
    const int pw = widu & 3;
    const int d0 = 2 * lane;
    const bf16_t* QH = (const bf16_t*)(p.ws + OFF_QH);
    const unsigned short* LF = (const unsigned short*)(p.ws + OFF_LF);
    const bf16_t* V = (const bf16_t*)(p.ws + OFF_V);
    bf16_t* OR = (bf16_t*)(p.ws + OFF_HA);
    float* tot = (float*)(lds + HG_TOT_OFF);
    for (int item = blockIdx.x; item < 128; item += cx.G) {
        const int b = item >> 3, h = item & 7;
        f32x16 S0, S1, S2, S3;
#pragma unroll
        for (int r = 0; r < 16; ++r) { S0[r] = 0.f; S1[r] = 0.f; S2[r] = 0.f; S3[r] = 0.f; }
        unsigned lfA[8], lfB[8], qv[8], vv[8];
        const size_t gbase = (size_t)(b * SEQ + pw * 8) * 1024 + h * 128;
        if (producer) {
#pragma unroll
            for (int i = 0; i < 8; ++i) {
                lfA[i] = *(const unsigned*)(LF + gbase + (size_t)i * 1024 + d0);
                qv[i] = *(const unsigned*)(QH + gbase + (size_t)i * 1024 + d0);
                vv[i] = *(const unsigned*)(V + gbase + (size_t)i * 1024 + d0);
            }
#pragma unroll
            for (int i = 0; i < 8; ++i) lfB[i] = *(const unsigned*)(LF + gbase + (size_t)(32 + i) * 1024 + d0);
        }
        __syncthreads();
        for (int c = 0; c <= SEQ / 32; ++c) {
            unsigned lf[8];
#pragma unroll
            for (int i = 0; i < 8; ++i) lf[i] = (c & 1) ? lfB[i] : lfA[i];
            f2_t run = {0.f, 0.f};
            if (producer && c < SEQ / 32) {
#pragma unroll
                for (int i = 0; i < 8; ++i) run += unpackh2(lf[i]);
                *(f2_t*)(tot + pw * 128 + d0) = run;
            }
            __syncthreads();
            if (producer) {
                if (c < SEQ / 32) {
                    char* bufp = lds + (c & 1) * HG_BUF;
                    f2_t pre = {0.f, 0.f}, last = {0.f, 0.f};
#pragma unroll
                    for (int q = 0; q < 4; ++q) {
                        const f2_t tq_ = *(const f2_t*)(tot + q * 128 + d0);
                        last += tq_;
                        if (q < pw) pre += tq_;
                    }
                    if (pw == 0) { f2_t dv; dv.x = __expf(last.x); dv.y = __expf(last.y); *(f2_t*)(bufp + HG_DEC_OFF + d0 * 4) = dv; }
                    float k2a[8], k2b[8];
                    f2_t rc = pre;
#pragma unroll
                    for (int i = 0; i < 8; ++i) {
                        const f2_t lfi = unpackh2(lf[i]);
                        rc += lfi;
                        const float cu0 = rc.x, cu1 = rc.y;
                        const float kk0 = 1.f - __expf(lfi.x), kk1 = 1.f - __expf(lfi.y);
                        const float q0 = bf2f((unsigned short)(qv[i] & 0xffff)) * __expf(cu0), q1 = bf2f((unsigned short)(qv[i] >> 16)) * __expf(cu1);
                        const float kd0 = kk0 * __expf(-cu0), kd1 = kk1 * __expf(-cu1);
                        k2a[i] = kk0 * __expf(last.x - cu0); k2b[i] = kk1 * __expf(last.y - cu1);
                        const int tl = pw * 8 + i;
                        *(unsigned*)(bufp + HG_QD_OFF + tl * HG_ROW + d0 * 2) = pack2(q0, q1);
                        *(unsigned*)(bufp + HG_KD_OFF + tl * HG_ROW + d0 * 2) = pack2(kd0, kd1);
                    }
                    uint4 a, bq, va, vb;
                    a.x = pack2(k2a[0], k2a[1]); a.y = pack2(k2a[2], k2a[3]); a.z = pack2(k2a[4], k2a[5]); a.w = pack2(k2a[6], k2a[7]);
                    bq.x = pack2(k2b[0], k2b[1]); bq.y = pack2(k2b[2], k2b[3]); bq.z = pack2(k2b[4], k2b[5]); bq.w = pack2(k2b[6], k2b[7]);
                    va.x = (vv[0] & 0xffffu) | (vv[1] << 16); va.y = (vv[2] & 0xffffu) | (vv[3] << 16); va.z = (vv[4] & 0xffffu) | (vv[5] << 16); va.w = (vv[6] & 0xffffu) | (vv[7] << 16);
                    vb.x = (vv[0] >> 16) | (vv[1] & 0xffff0000u); vb.y = (vv[2] >> 16) | (vv[3] & 0xffff0000u); vb.z = (vv[4] >> 16) | (vv[5] & 0xffff0000u); vb.w = (vv[6] >> 16) | (vv[7] & 0xffff0000u);
                    *(uint4*)(bufp + HG_K2T_OFF + d0 * HG_TROW + pw * 16) = a;
                    *(uint4*)(bufp + HG_K2T_OFF + (d0 + 1) * HG_TROW + pw * 16) = bq;
                    *(uint4*)(bufp + HG_VT_OFF + d0 * HG_TROW + pw * 16) = va;
                    *(uint4*)(bufp + HG_VT_OFF + (d0 + 1) * HG_TROW + pw * 16) = vb;
                    __builtin_amdgcn_sched_barrier(0);
                    if (c + 1 < SEQ / 32) {
                        const size_t gn = gbase + (size_t)(c + 1) * 32 * 1024;
#pragma unroll
                        for (int i = 0; i < 8; ++i) {
                            qv[i] = *(const unsigned*)(QH + gn + (size_t)i * 1024 + d0);
                            vv[i] = *(const unsigned*)(V + gn + (size_t)i * 1024 + d0);
                        }
                    }
                    if (c + 2 < SEQ / 32) {
                        const size_t gn = gbase + (size_t)(c + 2) * 32 * 1024;
                        if (c & 1) {
#pragma unroll
                            for (int i = 0; i < 8; ++i) lfB[i] = *(const unsigned*)(LF + gn + (size_t)i * 1024 + d0);
                        } else {
#pragma unroll
                            for (int i = 0; i < 8; ++i) lfA[i] = *(const unsigned*)(LF + gn + (size_t)i * 1024 + d0);
                        }
                    }
                }
            } else if (c >= 1) {
                const int cc = c - 1;
                const char* bufp = lds + (cc & 1) * HG_BUF;
                const float* dec = (const float*)(bufp + HG_DEC_OFF);
                f32x16 X;
#pragma unroll
                for (int r = 0; r < 16; ++r) X[r] = 0.f;
                {
                    const char* ka = bufp + HG_KD_OFF + l31 * HG_ROW + 16 * h2;
                    const char* qa = bufp + HG_QD_OFF + l31 * HG_ROW + 16 * h2;
#pragma unroll 2
                    for (int ks = 0; ks < 8; ++ks) X = MFMA32(*(const bf16x8*)(ka + 32 * ks), *(const bf16x8*)(qa + 32 * ks), X);
#pragma unroll
                    for (int r = 0; r < 16; ++r) { const int srow = (r & 3) + 8 * (r >> 2) + 4 * h2; X[r] = (srow <= l31) ? X[r] : 0.f; }
                }
                f32x16 Oa;
#pragma unroll
                for (int r = 0; r < 16; ++r) Oa[r] = 0.f;
                const int jrow = 32 * pw + l31;
#pragma unroll
                for (int s2 = 0; s2 < 2; ++s2) {
                    uint4 xk;
                    xk.x = pack2(X[8 * s2], X[8 * s2 + 1]); xk.y = pack2(X[8 * s2 + 2], X[8 * s2 + 3]); xk.z = pack2(X[8 * s2 + 4], X[8 * s2 + 5]); xk.w = pack2(X[8 * s2 + 6], X[8 * s2 + 7]);
                    const char* va = bufp + HG_VT_OFF + jrow * HG_TROW + (16 * s2 + 4 * h2) * 2;
                    const uint2 lo = *(const uint2*)va, hi = *(const uint2*)(va + 16);
                    uint4 vb; vb.x = lo.x; vb.y = lo.y; vb.z = hi.x; vb.w = hi.y;
                    Oa = MFMA32(__builtin_bit_cast(bf16x8, xk), __builtin_bit_cast(bf16x8, vb), Oa);
                }
                auto qs_term = [&](const f32x16& St, int dt) {
#pragma unroll
                    for (int s2 = 0; s2 < 2; ++s2) {
                        uint4 sk;
                        sk.x = pack2(St[8 * s2], St[8 * s2 + 1]); sk.y = pack2(St[8 * s2 + 2], St[8 * s2 + 3]); sk.z = pack2(St[8 * s2 + 4], St[8 * s2 + 5]); sk.w = pack2(St[8 * s2 + 6], St[8 * s2 + 7]);
                        const char* qa = bufp + HG_QD_OFF + l31 * HG_ROW + (32 * dt + 16 * s2 + 4 * h2) * 2;
                        const uint2 lo = *(const uint2*)qa, hi = *(const uint2*)(qa + 16);
                        uint4 qb; qb.x = lo.x; qb.y = lo.y; qb.z = hi.x; qb.w = hi.y;
                        Oa = MFMA32(__builtin_bit_cast(bf16x8, qb), __builtin_bit_cast(bf16x8, sk), Oa);
                    }
                };
                __builtin_amdgcn_sched_barrier(0);
                qs_term(S0, 0); qs_term(S1, 1);
                __builtin_amdgcn_sched_barrier(0);
                qs_term(S2, 2); qs_term(S3, 3);
                __builtin_amdgcn_sched_barrier(0);
                {
                    bf16_t* orow = OR + (size_t)(b * SEQ + cc * 32 + 4 * h2) * 1024 + h * 128 + jrow;
#pragma unroll
                    for (int r = 0; r < 16; ++r) orow[(size_t)((r & 3) + 8 * (r >> 2)) * 1024] = f2bf(Oa[r]);
                }
                auto s_update = [&](f32x16& St, int dt) {
#pragma unroll
                    for (int rq = 0; rq < 4; ++rq) {
                        const f32x4 dc = *(const f32x4*)(dec + 32 * dt + 8 * rq + 4 * h2);
                        St[4 * rq] *= dc[0]; St[4 * rq + 1] *= dc[1]; St[4 * rq + 2] *= dc[2]; St[4 * rq + 3] *= dc[3];
                    }
#pragma unroll
                    for (int s2 = 0; s2 < 2; ++s2) {
                        const bf16x8 ka = *(const bf16x8*)(bufp + HG_K2T_OFF + (32 * dt + l31) * HG_TROW + (16 * s2 + 8 * h2) * 2);
                        const bf16x8 vb = *(const bf16x8*)(bufp + HG_VT_OFF + jrow * HG_TROW + (16 * s2 + 8 * h2) * 2);
                        St = MFMA32(ka, vb, St);
                    }
                };
                __builtin_amdgcn_sched_barrier(0);
                s_update(S0, 0); s_update(S1, 1);
                __builtin_amdgcn_sched_barrier(0);
                s_update(S2, 2); s_update(S3, 3);
                __builtin_amdgcn_sched_barrier(0);
            }
            __syncthreads();
        }
    }
}

__device__ __forceinline__ void phase_hgrn_post(const Params& p, const Ctx& cx) {
    const int lane = cx.lane;
    const bf16_t* OR = (const bf16_t*)(p.ws + OFF_HA);
    const bf16_t* Gt = (const bf16_t*)(p.ws + OFF_G);
    bf16_t* OA = (bf16_t*)(p.ws + OFF_QH);
    const int col = lane * 16;
    float gn[16];
#pragma unroll
    for (int i = 0; i < 16; ++i) gn[i] = p.hgrn_out_gain[(col & 127) + i];
    for (int row = cx.vbid * NWAVE + cx.wid; row < NTOK; row += cx.G * NWAVE) {
        const uint4 a0 = *(const uint4*)(OR + (size_t)row * 1024 + col), a1 = *(const uint4*)(OR + (size_t)row * 1024 + col + 8);
        const uint4 g0 = *(const uint4*)(Gt + (size_t)row * 1024 + col), g1 = *(const uint4*)(Gt + (size_t)row * 1024 + col + 8);
        const unsigned aw[8] = {a0.x, a0.y, a0.z, a0.w, a1.x, a1.y, a1.z, a1.w};
        const unsigned gw[8] = {g0.x, g0.y, g0.z, g0.w, g1.x, g1.y, g1.z, g1.w};
        float o[16];
        float ss = 0.f;
#pragma unroll
        for (int i = 0; i < 8; ++i) { o[2 * i] = bf2f((unsigned short)(aw[i] & 0xffff)); o[2 * i + 1] = bf2f((unsigned short)(aw[i] >> 16)); ss += o[2 * i] * o[2 * i] + o[2 * i + 1] * o[2 * i + 1]; }
        ss += __shfl_xor(ss, 1); ss += __shfl_xor(ss, 2); ss += __shfl_xor(ss, 4);
        const float r = rsqrtf(ss * (1.f / 128.f) + EPS);
        unsigned w[8];
#pragma unroll
        for (int i = 0; i < 8; ++i)
            w[i] = pack2(o[2 * i] * r * gn[2 * i] * bf2f((unsigned short)(gw[i] & 0xffff)), o[2 * i + 1] * r * gn[2 * i + 1] * bf2f((unsigned short)(gw[i] >> 16)));
        uint4 o0, o1; o0.x = w[0]; o0.y = w[1]; o0.z = w[2]; o0.w = w[3]; o1.x = w[4]; o1.y = w[5]; o1.z = w[6]; o1.w = w[7];
        *(uint4*)(OA + (size_t)row * 1024 + col) = o0;
        *(uint4*)(OA + (size_t)row * 1024 + col + 8) = o1;
    }
}


#define XB_TMO      128
#define XB_XCNT(j)  (256  + 64 * (j))
#define XB_XSUB(j)  (1280 + 64 * (j))
#define XB_XGEN(j)  (2304 + 64 * (j))
#define XB_TOP      3328
#define XB_TOPGEN   3392
#define XCD_BAR_WORDS 3456
#define XB_SPIN_CAP (1u << 20)
#define LAS __attribute__((address_space(3)))
__device__ __forceinline__ unsigned xb_ld(unsigned* p)              { return __hip_atomic_load(p, __ATOMIC_RELAXED, __HIP_MEMORY_SCOPE_AGENT); }
__device__ __forceinline__ unsigned xb_add(unsigned* p, unsigned v) { return __hip_atomic_fetch_add(p, v, __ATOMIC_RELAXED, __HIP_MEMORY_SCOPE_AGENT); }
__device__ __forceinline__ unsigned xb_xcc_id() { return (unsigned)__builtin_amdgcn_s_getreg((3 << 11) | 20) & 0xFu; }
#define XB_SPIN(cond, bar) do { unsigned _sp = 0; while (cond) { __builtin_amdgcn_s_sleep(1); \
    if ((++_sp & 255u) == 0u) { if (xb_ld(&(bar)[XB_TMO])) break; if (_sp > XB_SPIN_CAP) { atomicAdd(&(bar)[XB_TMO], 1u); break; } } } } while (0)
struct XcdBarrier { unsigned* bar; unsigned x; volatile unsigned* st; };
__device__ __forceinline__ XcdBarrier xcd_barrier_post(unsigned* bar, volatile unsigned* st) {
    XcdBarrier b; b.bar = bar; b.x = xb_xcc_id(); b.st = st;
    if (threadIdx.x == 0) (void)xb_add(&bar[XB_XCNT(b.x)], 1u);
    return b;
}
__device__ __forceinline__ void xcd_barrier_complete(unsigned* bar, unsigned x, unsigned& nloc, unsigned& nx) {
    const unsigned G = gridDim.x * gridDim.y * gridDim.z;
    unsigned sum, cnt, mine, sp = 0u;
    for (;;) {
        sum = 0u; cnt = 0u; mine = 0u;
#pragma unroll
        for (unsigned j = 0; j < 16; ++j) { const unsigned c = xb_ld(&bar[XB_XCNT(j)]); sum += c; cnt += (c > 0u) ? 1u : 0u; mine = (j == x) ? c : mine; }
        if (sum == G) break;
        __builtin_amdgcn_s_sleep(1);
        if ((++sp & 255u) == 0u) { if (xb_ld(&bar[XB_TMO])) break; if (sp > XB_SPIN_CAP) { atomicAdd(&bar[XB_TMO], 1u); break; } }
    }
    nloc = mine > 0u ? mine : 1u; nx = cnt > 0u ? cnt : 1u;
}
__device__ __forceinline__ void xcd_barrier(const XcdBarrier& b) {
    asm volatile("s_waitcnt vmcnt(0)" ::: "memory");
    __syncthreads();
    if (threadIdx.x == 0) {
        unsigned* bar = b.bar;
        __builtin_amdgcn_s_waitcnt(0);
        unsigned nloc = b.st[0], nx = b.st[1];
        if (nloc == 0u) { xcd_barrier_complete(bar, b.x, nloc, nx); b.st[0] = nloc; b.st[1] = nx; }
        const unsigned old = xb_add(&bar[XB_XSUB(b.x)], 1u);
        const unsigned gen = old / nloc;
        if (old + 1u == (gen + 1u) * nloc) {
            __builtin_amdgcn_fence(__ATOMIC_RELEASE, "agent");
            asm volatile("s_waitcnt vmcnt(0)" ::: "memory");
            const unsigned og = xb_add(&bar[XB_TOP], 1u);
            const unsigned tg = og / nx;
            if (og + 1u == (tg + 1u) * nx) xb_add(&bar[XB_TOPGEN], 1u);
            else XB_SPIN(xb_ld(&bar[XB_TOPGEN]) == tg, bar);
            __builtin_amdgcn_fence(__ATOMIC_ACQUIRE, "agent");
            xb_add(&bar[XB_XGEN(b.x)], 1u);
            asm volatile("s_waitcnt vmcnt(0)" ::: "memory");
        } else {
            XB_SPIN(xb_ld(&bar[XB_XGEN(b.x)]) == gen, bar);
            __builtin_amdgcn_fence(__ATOMIC_ACQUIRE, "agent");
            asm volatile("s_waitcnt vmcnt(0)" ::: "memory");
        }
    }
    __syncthreads();
}

template <int PH>
__device__ __forceinline__ void run_phase(const Params& p, const Ctx& cx, char* lds) {
    if constexpr (PH == 0) phase0(p, cx, lds);
    else if constexpr (PH == 1) rows_phase<false, true, false>(p, cx, lds, p.x, nullptr, 0, 0, 0, 0);
    else if constexpr (PH == 2) phase_nsa_inproj(p, cx, lds);
    else if constexpr (PH == 3) phase_cmp1(p, cx, lds);
    else if constexpr (PH == 4) phase_cmp2(p, cx);
    else if constexpr (PH == 5) phase_attn(p, cx, lds);
    else if constexpr (PH == 6) phase_outproj(p, cx, lds, (const bf16_t*)(p.ws + OFF_HA), (const bf16_t*)(p.ws + OFF_W_NSA_OUT), p.x, 0);
    else if constexpr (PH == 7) rows_router_phase(p, cx, lds, p.out, 1, 0);
    else if constexpr (PH == 8) phase_moe_up(p, cx, lds, 0);
    else if constexpr (PH == 9) phase_moe_down(p, cx, lds, 0);
    else if constexpr (PH == 10) rows_phase<true, true, false>(p, cx, lds, p.out, p.out, 1, 2, 0, 0);
#ifdef PROBE_GEMM_MODE
    else if constexpr (PH == 11) { phase_hgrn_inproj<PROBE_GEMM_MODE>(p, cx, lds); __syncthreads(); phase_hgrn_inproj<0>(p, cx, lds); }
#else
    else if constexpr (PH == 11) phase_hgrn_inproj<0>(p, cx, lds);
#endif
    else if constexpr (PH == 12) phase_hgrn_rec(p, cx, lds);
    else if constexpr (PH == 13) phase_hgrn_post(p, cx);
    else if constexpr (PH == 14) phase_outproj(p, cx, lds, (const bf16_t*)(p.ws + OFF_QH), (const bf16_t*)(p.ws + OFF_W_HG_OUT), p.out, 2);
    else if constexpr (PH == 15) rows_router_phase(p, cx, lds, p.out, 3, 1);
    else if constexpr (PH == 16) phase_moe_up(p, cx, lds, 1);
    else if constexpr (PH == 17) phase_moe_down(p, cx, lds, 1);
    else if constexpr (PH == 18) rows_phase<true, false, false>(p, cx, lds, p.out, p.out, 3, 0, 0, 1);
}

__device__ __forceinline__ Ctx make_ctx() {
    Ctx cx;
    cx.G = gridDim.x; cx.tid = threadIdx.x; cx.wid = threadIdx.x >> 6; cx.lane = threadIdx.x & 63;
    cx.vbid = (cx.G % 8 == 0) ? (blockIdx.x % 8) * (cx.G / 8) + blockIdx.x / 8 : blockIdx.x;
    return cx;
}

#if MULTI_LAUNCH
template <int PH>
__global__ void __launch_bounds__(NTHR, 2) phase_kernel(Params p) {
    extern __shared__ __attribute__((aligned(16))) char lds[];
    const Ctx cx = make_ctx();
    run_phase<PH>(p, cx, lds);
}
template <int PH>
static void launch_phases(const Params& p, int grid, hipStream_t stream) {
    (void)hipFuncSetAttribute((const void*)phase_kernel<PH>, hipFuncAttributeMaxDynamicSharedMemorySize, LDS_BYTES);
    hipLaunchKernelGGL(phase_kernel<PH>, dim3(grid), dim3(NTHR), LDS_BYTES, stream, p);
    if constexpr (PH + 1 < NPHASE) launch_phases<PH + 1>(p, grid, stream);
}
#else
template <int PH>
__device__ __forceinline__ void run_from(const Params& p, const Ctx& cx, char* lds, cg::grid_group& grid, const XcdBarrier& xb) {
    {
        Ctx c2 = cx;
        asm volatile("" : "+v"(c2.tid), "+v"(c2.lane));
        run_phase<PH>(p, c2, lds);
#ifdef PROBE_MASK
        if constexpr ((PROBE_MASK >> PH) & 1) { xcd_barrier(xb); run_phase<PH>(p, c2, lds); }
#endif
    }
    if constexpr (PH + 1 < NPHASE) {
        if constexpr (PH == 0) grid.sync();
        else xcd_barrier(xb);
        run_from<PH + 1>(p, cx, lds, grid, xb);
    }
}
__global__ void __launch_bounds__(NTHR, 2) mega_kernel(Params p) {
    extern __shared__ __attribute__((aligned(16))) char lds[];
    cg::grid_group grid = cg::this_grid();
    const Ctx cx = make_ctx();
    volatile unsigned* st = (volatile unsigned*)(lds + LDS_BYTES - 16);
    if (threadIdx.x == 0) { st[0] = 0u; st[1] = 0u; }
    __syncthreads();
    const XcdBarrier xb = xcd_barrier_post((unsigned*)(p.ws + OFF_BAR), st);
    run_from<0>(p, cx, lds, grid, xb);
}
#endif

extern "C" void kernel_launch(void* const* d_in, const int* in_sizes, int n_in, void* d_out, int out_size, void* d_ws, size_t ws_size,
                              hipStream_t stream) {
    static int grid = 0;
    if (!grid) {
        int dev = 0, cus = 0, per_cu = 0;
        (void)hipGetDevice(&dev);
        (void)hipDeviceGetAttribute(&cus, hipDeviceAttributeMultiprocessorCount, dev);
#if MULTI_LAUNCH
        per_cu = 1;
#else
        (void)hipFuncSetAttribute((const void*)mega_kernel, hipFuncAttributeMaxDynamicSharedMemorySize, LDS_BYTES);
        (void)hipOccupancyMaxActiveBlocksPerMultiprocessor(&per_cu, mega_kernel, NTHR, LDS_BYTES);
        if (per_cu > 1) per_cu = 1;
        if (per_cu < 1) { fprintf(stderr, "kernel_launch: occupancy query says 0 blocks per CU (LDS %d B)\n", LDS_BYTES); per_cu = 1; }
#endif
        if (cus <= 0) cus = 256;
        grid = cus * per_cu;
        if (ws_size < WS_NEED) fprintf(stderr, "kernel_launch: workspace too small: %zu < %zu\n", ws_size, (size_t)WS_NEED);
    }
    Params p{};
    p.x = (const float*)d_in[0]; p.c = (const float*)d_in[1]; p.ada_w = (const float*)d_in[2]; p.ada_b = (const float*)d_in[3];
    p.norm_g = (const float*)d_in[4]; p.rel_bias = (const float*)d_in[5]; p.nsa_w_in = (const float*)d_in[6]; p.nsa_q_gain = (const float*)d_in[7];
    p.nsa_k_gain = (const float*)d_in[8]; p.nsa_cmp_pe = (const float*)d_in[9]; p.nsa_cmp_w1 = (const float*)d_in[10]; p.nsa_cmp_w2 = (const float*)d_in[11];
    p.nsa_w_out = (const float*)d_in[12]; p.hgrn_w_in = (const float*)d_in[13]; p.hgrn_lb = (const float*)d_in[14]; p.hgrn_out_gain = (const float*)d_in[15];
    p.hgrn_w_out = (const float*)d_in[16]; p.moe_rg = (const float*)d_in[17]; p.moe_re = (const float*)d_in[18]; p.moe_w1 = (const float*)d_in[19];
    p.moe_w3 = (const float*)d_in[20]; p.moe_w2 = (const float*)d_in[21];
    p.out = (float*)d_out; p.ws = (char*)d_ws;
#if MULTI_LAUNCH
    launch_phases<0>(p, grid, stream);
#else
    p.p_begin = 0; p.p_end = NPHASE;
    (void)hipMemsetAsync((char*)d_ws + OFF_BAR, 0, XCD_BAR_WORDS * 4, stream);
    void* args[] = {&p};
    hipError_t e = hipLaunchCooperativeKernel((void*)mega_kernel, dim3(grid), dim3(NTHR), args, LDS_BYTES, stream);
    if (e != hipSuccess) fprintf(stderr, "cooperative launch failed: %s (grid %d)\n", hipGetErrorString(e), grid);
#endif
}
```

```cpp
#include <hip/hip_runtime.h>
#include <hip/hip_cooperative_groups.h>
#include <cstdio>
#include <cstdint>
namespace cg = cooperative_groups;

#ifndef MULTI_LAUNCH
#define MULTI_LAUNCH 0
#endif

typedef unsigned short bf16_t;
typedef short bf16x8 __attribute__((ext_vector_type(8)));
typedef float f32x4 __attribute__((ext_vector_type(4)));
typedef float f32x16 __attribute__((ext_vector_type(16)));

constexpr int NTOK = 32768, DM = 1024, SEQ = 2048, NBATCH = 16;
constexpr int NSA_IN = 2608, NSA_IN_PAD = 2816;
constexpr float EPS = 1e-6f;
constexpr size_t MiB = 1ull << 20;

constexpr size_t OFF_CNT = 0;
constexpr size_t OFF_MOD = 4096;
constexpr size_t OFF_LB = OFF_MOD + 786432;
constexpr size_t OFF_PEB = OFF_LB + 4096;
constexpr size_t OFF_BAR = 921600;
constexpr size_t OFF_W_NSA_IN = 1 * MiB;
constexpr size_t OFF_W_NSA_OUT = OFF_W_NSA_IN + 2816ull * 1024 * 2;
constexpr size_t OFF_W_HG_IN = OFF_W_NSA_OUT + 1024ull * 1024 * 2;
constexpr size_t OFF_W_HG_OUT = OFF_W_HG_IN + 4096ull * 1024 * 2;
constexpr size_t OFF_W_CMP1 = OFF_W_HG_OUT + 1024ull * 1024 * 2;
constexpr size_t OFF_W_UP = OFF_W_CMP1 + 2ull * 128 * 2048 * 2;
constexpr size_t OFF_W_DN = OFF_W_UP + 32ull * 1024 * 1024 * 2;
constexpr size_t OFF_W_END = OFF_W_DN + 32ull * 1024 * 512 * 2;
constexpr size_t OFF_HA = 116 * MiB;
static_assert(OFF_W_END <= OFF_HA, "weights overflow");
constexpr size_t OFF_SCR = 180 * MiB;
constexpr size_t OFF_Q = OFF_SCR;
constexpr size_t OFF_KCRAW = OFF_Q + 64 * MiB;
constexpr size_t OFF_VCRAW = OFF_KCRAW + 17 * MiB;
constexpr size_t OFF_KS = OFF_VCRAW + 17 * MiB;
constexpr size_t OFF_VS = OFF_KS + 16 * MiB;
constexpr size_t OFF_KW = OFF_VS + 16 * MiB;
constexpr size_t OFF_VW = OFF_KW + 16 * MiB;
constexpr size_t OFF_GATES = OFF_VW + 16 * MiB;
constexpr size_t OFF_T1 = OFF_GATES + 6 * MiB;
constexpr size_t OFF_KC = OFF_T1 + 4 * MiB;
constexpr size_t OFF_VC = OFF_KC + 1 * MiB;
constexpr size_t OFF_H1 = OFF_SCR;
constexpr size_t OFF_Y = OFF_H1 + 64 * MiB;
constexpr size_t OFF_LTOK = OFF_Y + 128 * MiB;
constexpr size_t OFF_LW = OFF_LTOK + 2 * MiB;
constexpr size_t OFF_TSLOT = OFF_LW + 2 * MiB;
constexpr size_t OFF_QH = OFF_SCR;
constexpr size_t OFF_LF = OFF_QH + 64 * MiB;
constexpr size_t OFF_V = OFF_LF + 128 * MiB;
constexpr size_t OFF_G = OFF_V + 64 * MiB;
constexpr size_t WS_NEED = OFF_G + 64 * MiB;
static_assert(WS_NEED <= 512 * MiB, "ws overflow");

constexpr int NTHR = 512, NWAVE = 8;
constexpr int GEMM_STAGE = 49152, GEMM_NSTAGE = 3;
constexpr int LDS_TAB_OFF = GEMM_STAGE * GEMM_NSTAGE;
constexpr int LDS_BYTES = LDS_TAB_OFF + 256 + 16;
constexpr int NPHASE = 19;

struct Params {
    const float *x, *c, *ada_w, *ada_b, *norm_g, *rel_bias, *nsa_w_in, *nsa_q_gain, *nsa_k_gain, *nsa_cmp_pe, *nsa_cmp_w1,
        *nsa_cmp_w2, *nsa_w_out, *hgrn_w_in, *hgrn_lb, *hgrn_out_gain, *hgrn_w_out, *moe_rg, *moe_re, *moe_w1, *moe_w3, *moe_w2;
    float* out;
    char* ws;
    int p_begin, p_end;
};

__device__ __forceinline__ float bf2f(unsigned short h) { return __uint_as_float((unsigned)h << 16); }
__device__ __forceinline__ unsigned short f2bf(float f) {
    unsigned u = __float_as_uint(f);
    u += 0x7fffu + ((u >> 16) & 1u);
    return (unsigned short)(u >> 16);
}
typedef __bf16 bf2_t __attribute__((ext_vector_type(2)));
typedef float f2_t __attribute__((ext_vector_type(2)));
__device__ __forceinline__ unsigned pack2(float a, float b) {
    f2_t v = {a, b};
    return __builtin_bit_cast(unsigned, __builtin_convertvector(v, bf2_t));
}
typedef _Float16 h2_t __attribute__((ext_vector_type(2)));
__device__ __forceinline__ unsigned packh2(float a, float b) { f2_t v = {a, b}; return __builtin_bit_cast(unsigned, __builtin_convertvector(v, h2_t)); }
__device__ __forceinline__ f2_t unpackh2(unsigned u) { return __builtin_convertvector(__builtin_bit_cast(h2_t, u), f2_t); }
__device__ __forceinline__ float wave_sum(float v) {
#pragma unroll
    for (int o = 32; o; o >>= 1) v += __shfl_xor(v, o);
    return v;
}
__device__ __forceinline__ float wave_max(float v) {
#pragma unroll
    for (int o = 32; o; o >>= 1) v = fmaxf(v, __shfl_xor(v, o));
    return v;
}
__device__ __forceinline__ float silu_f(float x) { return x / (1.f + __expf(-x)); }
__device__ __forceinline__ float sigmoid_f(float x) { return 1.f / (1.f + __expf(-x)); }
__device__ __forceinline__ void glds16(const void* g, void* l) {
    __builtin_amdgcn_global_load_lds((const unsigned*)g, (unsigned*)l, 16, 0, 0);
}
__device__ __forceinline__ int t5_bucket(int n) {
    if (n < 16) return n;
    int b = 16;
    b += (n >= 21); b += (n >= 27); b += (n >= 35); b += (n >= 46); b += (n >= 59); b += (n >= 77); b += (n >= 99); b += (n >= 128);
    b += (n >= 166); b += (n >= 216); b += (n >= 280); b += (n >= 363); b += (n >= 470); b += (n >= 609); b += (n >= 790);
    return b;
}

struct Ctx {
    int G, vbid, tid, wid, lane;
};

constexpr int P0_MOD_ITEMS = 192;
constexpr int TS0 = 88 * 16, TS1 = 32 * 16, TS2 = 128 * 16, TS3 = 32 * 16, TS4 = 2 * 4 * 32, TS5 = 32 * 32 * 16, TS6 = 32 * 32 * 8;
constexpr int TC0 = 0, TC1 = TC0 + TS0, TC2 = TC1 + TS1, TC3 = TC2 + TS2, TC4 = TC3 + TS3, TC5 = TC4 + TS4, TC6 = TC5 + TS5, TC_END = TC6 + TS6;

struct TrJob { const float* src; int ld, c0, ncols_valid, k0; bf16_t* dst; int dstld; };
__device__ __forceinline__ void tr_load(const TrJob& j, float* tl, int htid) {
    const int k = htid >> 2, cc = (htid & 3) * 8;
    const float* s = j.src + (size_t)(j.k0 + k) * j.ld + j.c0 + cc;
    f32x4 a = {0.f, 0.f, 0.f, 0.f}, c = a;
    if (j.c0 + 32 <= j.ncols_valid) { a = *(const f32x4*)s; c = *(const f32x4*)(s + 4); }
    else {
#pragma unroll
        for (int i = 0; i < 4; ++i) { if (j.c0 + cc + i < j.ncols_valid) a[i] = s[i]; if (j.c0 + cc + 4 + i < j.ncols_valid) c[i] = s[4 + i]; }
    }
#pragma unroll
    for (int i = 0; i < 4; ++i) { tl[k * 33 + cc + i] = a[i]; tl[k * 33 + cc + 4 + i] = c[i]; }
}
__device__ __forceinline__ void tr_store(const TrJob& j, const float* tl, int htid) {
    const int n = htid >> 3, kc = (htid & 7) * 8;
    uint4 o;
    o.x = pack2(tl[(kc + 0) * 33 + n], tl[(kc + 1) * 33 + n]); o.y = pack2(tl[(kc + 2) * 33 + n], tl[(kc + 3) * 33 + n]);
    o.z = pack2(tl[(kc + 4) * 33 + n], tl[(kc + 5) * 33 + n]); o.w = pack2(tl[(kc + 6) * 33 + n], tl[(kc + 7) * 33 + n]);
    *(uint4*)(j.dst + (size_t)n * j.dstld + kc) = o;
}
__device__ __forceinline__ TrJob tr_job(const Params& p, int tt) {
    TrJob j;
    if (tt < TC1) {
        const int nt = tt / 16, kt = tt % 16;
        j = {p.nsa_w_in, NSA_IN, nt * 32, NSA_IN, kt * 64, (bf16_t*)(p.ws + OFF_W_NSA_IN) + (size_t)nt * 32 * 1024 + kt * 64, 1024};
    } else if (tt < TC2) {
        const int u = tt - TC1, nt = u / 16, kt = u % 16;
        j = {p.nsa_w_out, 1024, nt * 32, 1024, kt * 64, (bf16_t*)(p.ws + OFF_W_NSA_OUT) + (size_t)nt * 32 * 1024 + kt * 64, 1024};
    } else if (tt < TC3) {
        const int u = tt - TC2, nt = u / 16, kt = u % 16;
        j = {p.hgrn_w_in, 4096, nt * 32, 4096, kt * 64, (bf16_t*)(p.ws + OFF_W_HG_IN) + (size_t)nt * 32 * 1024 + kt * 64, 1024};
    } else if (tt < TC4) {
        const int u = tt - TC3, nt = u / 16, kt = u % 16;
        j = {p.hgrn_w_out, 1024, nt * 32, 1024, kt * 64, (bf16_t*)(p.ws + OFF_W_HG_OUT) + (size_t)nt * 32 * 1024 + kt * 64, 1024};
    } else if (tt < TC5) {
        const int u = tt - TC4, kv = u / 128, r = u % 128, nt = r / 32, kt = r % 32;
        j = {p.nsa_cmp_w1 + (size_t)kv * 2048 * 64, 64, nt * 32, 64, kt * 64, (bf16_t*)(p.ws + OFF_W_CMP1) + ((size_t)kv * 128 + nt * 32) * 2048 + kt * 64, 2048};
    } else if (tt < TC6) {
        const int u = tt - TC5, le = u / 512, r = u % 512, gr = r / 16, kt = r % 16;
        const int t = gr >> 2, wc = (gr >> 1) & 1, which = gr & 1;
        const float* src = (which ? p.moe_w3 : p.moe_w1) + (size_t)le * 1024 * 512;
        j = {src, 512, (t * 2 + wc) * 32, 512, kt * 64, (bf16_t*)(p.ws + OFF_W_UP) + ((size_t)le * 1024 + gr * 32) * 1024 + kt * 64, 1024};
    } else {
        const int u = tt - TC6, le = u / 256, r = u % 256, nt = r / 8, kt = r % 8;
        j = {p.moe_w2 + (size_t)le * 512 * 1024, 1024, nt * 32, 1024, kt * 64, (bf16_t*)(p.ws + OFF_W_DN) + ((size_t)le * 1024 + nt * 32) * 512 + kt * 64, 512};
    }
    return j;
}

__device__ __forceinline__ void phase0(const Params& p, const Ctx& cx, char* lds) {
    const int tid = cx.tid, wid = cx.wid, lane = cx.lane;
    for (int it = cx.vbid; it < P0_MOD_ITEMS; it += cx.G) {
        const int colbase = it * 64, ls = colbase / 3072, e0 = colbase % 3072;
        const float* W = p.ada_w + (size_t)ls * 1024 * 3072 + e0 + lane;
        float* cs = (float*)lds + wid * 1024;
        float* red = (float*)lds + 8192;
        float acc[16];
#pragma unroll
        for (int b = 0; b < 16; ++b) acc[b] = 0.f;
        for (int sub = 0; sub < 2; ++sub) {
            const int kb = wid * 128 + sub * 64;
#pragma unroll
            for (int b = 0; b < 16; ++b) cs[lane * 16 + b] = silu_f(p.c[b * 1024 + kb + lane]);
            __builtin_amdgcn_wave_barrier();
#pragma unroll 1
            for (int k16 = 0; k16 < 64; k16 += 16) {
                float wv[16];
#pragma unroll
                for (int u = 0; u < 16; ++u) wv[u] = W[(size_t)(kb + k16 + u) * 3072];
#pragma unroll
                for (int u = 0; u < 16; ++u) {
                    const float w = wv[u];
                    const f32x4* cv = (const f32x4*)(cs + (k16 + u) * 16);
#pragma unroll
                    for (int q = 0; q < 4; ++q) {
                        f32x4 c4 = cv[q];
                        acc[q * 4 + 0] += c4[0] * w; acc[q * 4 + 1] += c4[1] * w; acc[q * 4 + 2] += c4[2] * w; acc[q * 4 + 3] += c4[3] * w;
                    }
                }
            }
            __builtin_amdgcn_wave_barrier();
        }
#pragma unroll
        for (int b = 0; b < 16; ++b) red[(wid * 16 + b) * 64 + lane] = acc[b];
        __syncthreads();
        float* mod = (float*)(p.ws + OFF_MOD);
#pragma unroll
        for (int i = 0; i < 2; ++i) {
            const int o = tid + i * NTHR, b = o >> 6, e = o & 63;
            float sm = 0.f;
#pragma unroll
            for (int w = 0; w < 8; ++w) sm += red[(w * 16 + b) * 64 + e];
            mod[((size_t)ls * 16 + b) * 3072 + e0 + e] = sm + p.ada_b[ls * 3072 + e0 + e];
        }
        __syncthreads();
    }
    {
        constexpr int TPH = 4;
        const int half = tid >> 8, htid = tid & 255;
        float* tl = (float*)lds + half * (TPH * 64 * 33);
        for (int base = cx.vbid * 2 * TPH; base < TC_END; base += cx.G * 2 * TPH) {
#pragma unroll
            for (int q = 0; q < TPH; ++q) {
                const int tt = base + half * TPH + q;
                if (tt < TC_END) { const TrJob j = tr_job(p, tt); tr_load(j, tl + q * (64 * 33), htid); }
            }
            __syncthreads();
#pragma unroll
            for (int q = 0; q < TPH; ++q) {
                const int tt = base + half * TPH + q;
                if (tt < TC_END) { const TrJob j = tr_job(p, tt); tr_store(j, tl + q * (64 * 33), htid); }
            }
            __syncthreads();
        }
    }
    if (cx.vbid == cx.G - 1) {
        float* lb = (float*)(p.ws + OFF_LB);
        for (int i = tid; i < 1024; i += NTHR) lb[i] = sigmoid_f(p.hgrn_lb[1024 + i] - p.hgrn_lb[i]);
        if (tid < 128) {
            const int kv = tid >> 6, d = tid & 63;
            const float* pe = p.nsa_cmp_pe + kv * 2048;
            const float* w1 = p.nsa_cmp_w1 + (size_t)kv * 2048 * 64 + d;
            float sm = 0.f;
            for (int k = 0; k < 2048; ++k) sm += pe[k] * w1[(size_t)k * 64];
            ((float*)(p.ws + OFF_PEB))[tid] = sm;
        }
        if (tid < 32) ((int*)(p.ws + OFF_CNT))[tid] = 0;
    }
}

template <bool COMBINE, bool NORM, bool ROUTER>
__device__ __forceinline__ void rows_phase(const Params& p, const Ctx& cx, char* lds, const float* __restrict__ src, float* __restrict__ xdst,
                           int ls_comb, int ls_norm, int layer_router, int layer_comb) {
    const int lane = cx.lane;
    const float* mod = (const float*)(p.ws + OFF_MOD);
    int my_off = 0;
    if (COMBINE) {
        const int* cnt = (const int*)(p.ws + OFF_CNT) + layer_comb * 16;
        int cv = (lane < 16) ? cnt[lane] : 0;
        int incl = cv;
#pragma unroll
        for (int o = 1; o < 16; o <<= 1) { int t = __shfl_up(incl, o); if (lane >= o) incl += t; }
        my_off = incl - cv;
    }
    const int row_first = cx.vbid * NWAVE + cx.wid, row_step = cx.G * NWAVE;
    f32x4 vn[4];
    int sn0 = 0, sn1 = 0;
    if (row_first < NTOK) {
#pragma unroll
        for (int i = 0; i < 4; ++i) vn[i] = *(const f32x4*)(src + (size_t)row_first * 1024 + (i * 64 + lane) * 4);
        if (COMBINE) { const int* ts = (const int*)(p.ws + OFF_TSLOT) + row_first * 2; sn0 = ts[0]; sn1 = ts[1]; }
    }
    for (int row = row_first; row < NTOK; row += row_step) {
        const int b = row >> 11;
        f32x4 v[4];
#pragma unroll
        for (int i = 0; i < 4; ++i) v[i] = vn[i];
        const int s0 = sn0, s1 = sn1;
        {
            const int nrow = row + row_step;
            if (nrow < NTOK) {
#pragma unroll
                for (int i = 0; i < 4; ++i) vn[i] = *(const f32x4*)(src + (size_t)nrow * 1024 + (i * 64 + lane) * 4);
                if (COMBINE) { const int* ts = (const int*)(p.ws + OFF_TSLOT) + nrow * 2; sn0 = ts[0]; sn1 = ts[1]; }
            }
        }
        if (COMBINE) {
            const int r0 = __shfl(my_off, s0 >> 16) + (s0 & 0xffff), r1 = __shfl(my_off, s1 >> 16) + (s1 & 0xffff);
            const bf16_t* Y = (const bf16_t*)(p.ws + OFF_Y);
            const float* gate = mod + ((size_t)ls_comb * 16 + b) * 3072 + 2048;
#pragma unroll
            for (int i = 0; i < 4; ++i) {
                const int col = (i * 64 + lane) * 4;
                uint2 a = *(const uint2*)(Y + (size_t)r0 * 1024 + col), c = *(const uint2*)(Y + (size_t)r1 * 1024 + col);
                f32x4 g = *(const f32x4*)(gate + col);
                v[i][0] += g[0] * (bf2f(a.x & 0xffff) + bf2f(c.x & 0xffff));
                v[i][1] += g[1] * (bf2f(a.x >> 16) + bf2f(c.x >> 16));
                v[i][2] += g[2] * (bf2f(a.y & 0xffff) + bf2f(c.y & 0xffff));
                v[i][3] += g[3] * (bf2f(a.y >> 16) + bf2f(c.y >> 16));
                *(f32x4*)(xdst + (size_t)row * 1024 + col) = v[i];
            }
        }
        if (NORM) {
            float ss = 0.f;
#pragma unroll
            for (int i = 0; i < 4; ++i) ss += v[i][0] * v[i][0] + v[i][1] * v[i][1] + v[i][2] * v[i][2] + v[i][3] * v[i][3];
            ss = wave_sum(ss);
            const float r = rsqrtf(ss * (1.f / 1024.f) + EPS);
            const float* gain = p.norm_g + ls_norm * 1024;
            const float* shift = mod + ((size_t)ls_norm * 16 + b) * 3072;
            const float* scale = shift + 1024;
            bf16_t* hA = (bf16_t*)(p.ws + OFF_HA);
            f32x4 rg4 = {0.f, 0.f, 0.f, 0.f}, re0 = rg4, re1 = rg4, re2 = rg4, re3 = rg4;
#pragma unroll
            for (int i = 0; i < 4; ++i) {
                const int col = (i * 64 + lane) * 4;
                f32x4 g = *(const f32x4*)(gain + col), sc = *(const f32x4*)(scale + col), sh = *(const f32x4*)(shift + col);
                f32x4 h;
#pragma unroll
                for (int j = 0; j < 4; ++j) h[j] = v[i][j] * r * g[j] * (1.f + sc[j]) + sh[j];
                uint2 o; o.x = pack2(h[0], h[1]); o.y = pack2(h[2], h[3]);
                *(uint2*)(hA + (size_t)row * 1024 + col) = o;
                if (ROUTER) {
                    const float* rg = p.moe_rg + (size_t)layer_router * 1024 * 4;
                    const float* re = p.moe_re + (size_t)layer_router * 1024 * 16;
#pragma unroll
                    for (int j = 0; j < 4; ++j) {
                        rg4 += h[j] * *(const f32x4*)(rg + (col + j) * 4);
                        re0 += h[j] * *(const f32x4*)(re + (col + j) * 16 + 0);
                        re1 += h[j] * *(const f32x4*)(re + (col + j) * 16 + 4);
                        re2 += h[j] * *(const f32x4*)(re + (col + j) * 16 + 8);
                        re3 += h[j] * *(const f32x4*)(re + (col + j) * 16 + 12);
                    }
                }
            }
            if (ROUTER) {
                float rl[4];
                f32x4 rs0, rs1, rs2, rs3;
#pragma unroll
                for (int j = 0; j < 4; ++j) { rl[j] = wave_sum(rg4[j]); rs0[j] = wave_sum(re0[j]); rs1[j] = wave_sum(re1[j]); rs2[j] = wave_sum(re2[j]); rs3[j] = wave_sum(re3[j]); }
                float gm = fmaxf(fmaxf(rl[0], rl[1]), fmaxf(rl[2], rl[3]));
                float e0 = __expf(rl[0] - gm), e1 = __expf(rl[1] - gm), e2 = __expf(rl[2] - gm), e3 = __expf(rl[3] - gm);
                float gs = e0 + e1 + e2 + e3;
                int grp = 0; float best = rl[0];
                if (rl[1] > best) { best = rl[1]; grp = 1; }
                if (rl[2] > best) { best = rl[2]; grp = 2; }
                if (rl[3] > best) { best = rl[3]; grp = 3; }
                const float pg = __expf(best - gm) / gs;
                const f32x4 lsel = (grp == 0) ? rs0 : (grp == 1) ? rs1 : (grp == 2) ? rs2 : rs3;
                const float l0 = lsel[0], l1 = lsel[1], l2 = lsel[2], l3 = lsel[3];
                const float em = fmaxf(fmaxf(l0, l1), fmaxf(l2, l3));
                float q0 = __expf(l0 - em), q1 = __expf(l1 - em), q2 = __expf(l2 - em), q3 = __expf(l3 - em);
                int i1 = 0; float b1 = q0;
                if (q1 > b1) { b1 = q1; i1 = 1; }
                if (q2 > b1) { b1 = q2; i1 = 2; }
                if (q3 > b1) { b1 = q3; i1 = 3; }
                int i2 = -1; float b2 = -1.f;
                if (i1 != 0 && q0 > b2) { b2 = q0; i2 = 0; }
                if (i1 != 1 && q1 > b2) { b2 = q1; i2 = 1; }
                if (i1 != 2 && q2 > b2) { b2 = q2; i2 = 2; }
                if (i1 != 3 && q3 > b2) { b2 = q3; i2 = 3; }
                const float inv = pg / (b1 + b2);
                if (lane == 0) {
                    int* cnt = (int*)(p.ws + OFF_CNT) + layer_router * 16;
                    int* ltok = (int*)(p.ws + OFF_LTOK);
                    float* lw = (float*)(p.ws + OFF_LW);
                    int* ts = (int*)(p.ws + OFF_TSLOT) + row * 2;
                    const int ea = grp * 4 + i1, eb = grp * 4 + i2;
                    const int pa = atomicAdd(cnt + ea, 1);
                    const int pb = atomicAdd(cnt + eb, 1);
                    ltok[(size_t)ea * NTOK + pa] = row; lw[(size_t)ea * NTOK + pa] = b1 * inv;
                    ltok[(size_t)eb * NTOK + pb] = row; lw[(size_t)eb * NTOK + pb] = b2 * inv;
                    ts[0] = (ea << 16) | pa; ts[1] = (eb << 16) | pb;
                }
            }
        }
    }
}

__device__ __forceinline__ void rows_router_phase(const Params& p, const Ctx& cx, char* lds, const float* __restrict__ src, int ls_norm, int layer) {
    const int lane = cx.lane, tid = cx.tid;
    const int widu = __builtin_amdgcn_readfirstlane(cx.wid);
    const int wq = widu & 3, grp4 = widu >> 2;
    const float* mod = (const float*)(p.ws + OFF_MOD);
    const float* rg = p.moe_rg + (size_t)layer * 1024 * 4;
    const float* re = p.moe_re + (size_t)layer * 1024 * 16;
    float* logit_s = (float*)lds;
    float wr[16][5];
#pragma unroll
    for (int i = 0; i < 4; ++i)
#pragma unroll
        for (int j = 0; j < 4; ++j) {
            const int k = (i * 64 + lane) * 4 + j;
#pragma unroll
            for (int q = 0; q < 5; ++q) {
                const int o = 5 * wq + q;
                wr[i * 4 + j][q] = (o < 4) ? rg[k * 4 + o] : re[k * 16 + o - 4];
            }
            __builtin_amdgcn_sched_barrier(0);
        }
    const float* gain = p.norm_g + ls_norm * 1024;
    bf16_t* hA = (bf16_t*)(p.ws + OFF_HA);
    int* lcnt = (int*)(lds + 16384);
    if (tid < 32) lcnt[tid] = 0;
    int nstep = 0;
    for (int blk = cx.vbid; blk < NTOK / 32; blk += cx.G, ++nstep) {
        const int R0 = blk * 32, b = R0 >> 11;
        const float* shift = mod + ((size_t)ls_norm * 16 + b) * 3072;
        const float* scale = shift + 1024;
        f32x4 ca[4], cb[4];
#pragma unroll
        for (int i = 0; i < 4; ++i) {
            const int col = (i * 64 + lane) * 4;
            const f32x4 g = *(const f32x4*)(gain + col), sc = *(const f32x4*)(scale + col);
            ca[i] = g * (sc + 1.f);
            cb[i] = *(const f32x4*)(shift + col);
        }
        const float* srow = src + (size_t)(R0 + grp4 * 16) * 1024 + lane * 4;
        f32x4 vnA[4], vnB[4];
#pragma unroll
        for (int i = 0; i < 4; ++i) { vnA[i] = *(const f32x4*)(srow + i * 256); vnB[i] = *(const f32x4*)(srow + 1024 + i * 256); }
#pragma unroll 1
        for (int r = 0; r < 16; r += 2) {
            const int rlA = grp4 * 16 + r;
            f32x4 vA[4], vB[4];
#pragma unroll
            for (int i = 0; i < 4; ++i) { vA[i] = vnA[i]; vB[i] = vnB[i]; }
            if (r < 14) {
#pragma unroll
                for (int i = 0; i < 4; ++i) { vnA[i] = *(const f32x4*)(srow + (size_t)(r + 2) * 1024 + i * 256); vnB[i] = *(const f32x4*)(srow + (size_t)(r + 3) * 1024 + i * 256); }
            }
            float ssA = 0.f, ssB = 0.f;
#pragma unroll
            for (int i = 0; i < 4; ++i) {
                ssA += vA[i][0] * vA[i][0] + vA[i][1] * vA[i][1] + vA[i][2] * vA[i][2] + vA[i][3] * vA[i][3];
                ssB += vB[i][0] * vB[i][0] + vB[i][1] * vB[i][1] + vB[i][2] * vB[i][2] + vB[i][3] * vB[i][3];
            }
#pragma unroll
            for (int o = 32; o; o >>= 1) { ssA += __shfl_xor(ssA, o); ssB += __shfl_xor(ssB, o); }
            const float rrA = rsqrtf(ssA * (1.f / 1024.f) + EPS), rrB = rsqrtf(ssB * (1.f / 1024.f) + EPS);
            float accA[5] = {0.f, 0.f, 0.f, 0.f, 0.f}, accB[5] = {0.f, 0.f, 0.f, 0.f, 0.f};
#pragma unroll
            for (int i = 0; i < 4; ++i) {
                const int col = (i * 64 + lane) * 4;
                f32x4 hA_, hB_;
#pragma unroll
                for (int j = 0; j < 4; ++j) {
                    hA_[j] = vA[i][j] * rrA * ca[i][j] + cb[i][j];
                    hB_[j] = vB[i][j] * rrB * ca[i][j] + cb[i][j];
#pragma unroll
                    for (int q = 0; q < 5; ++q) { accA[q] += hA_[j] * wr[i * 4 + j][q]; accB[q] += hB_[j] * wr[i * 4 + j][q]; }
                }
                if ((r & 3) == wq) { uint2 o; o.x = pack2(hA_[0], hA_[1]); o.y = pack2(hA_[2], hA_[3]); *(uint2*)(hA + (size_t)(R0 + rlA) * 1024 + col) = o; }
                if (((r + 1) & 3) == wq) { uint2 o; o.x = pack2(hB_[0], hB_[1]); o.y = pack2(hB_[2], hB_[3]); *(uint2*)(hA + (size_t)(R0 + rlA + 1) * 1024 + col) = o; }
            }
#pragma unroll
            for (int o = 32; o; o >>= 1) {
#pragma unroll
                for (int q = 0; q < 5; ++q) { accA[q] += __shfl_xor(accA[q], o); accB[q] += __shfl_xor(accB[q], o); }
            }
            if (lane == 0) {
#pragma unroll
                for (int q = 0; q < 5; ++q) { logit_s[(nstep * 32 + rlA) * 20 + 5 * wq + q] = accA[q]; logit_s[(nstep * 32 + rlA + 1) * 20 + 5 * wq + q] = accB[q]; }
            }
        }
    }
    __syncthreads();
    const int nrows = nstep * 32;
    int ea = 0, eb = 0, la = 0, lb_ = 0, row = 0; float wa = 0.f, wb = 0.f;
    if (tid < nrows) {
        row = (cx.vbid + (tid >> 5) * cx.G) * 32 + (tid & 31);
        const float* rl = logit_s + tid * 20;
        const float gm = fmaxf(fmaxf(rl[0], rl[1]), fmaxf(rl[2], rl[3]));
        const float gs = __expf(rl[0] - gm) + __expf(rl[1] - gm) + __expf(rl[2] - gm) + __expf(rl[3] - gm);
        int grp = 0; float best = rl[0];
        if (rl[1] > best) { best = rl[1]; grp = 1; }
        if (rl[2] > best) { best = rl[2]; grp = 2; }
        if (rl[3] > best) { best = rl[3]; grp = 3; }
        const float pg = __expf(best - gm) / gs;
        const f32x4 lsel = *(const f32x4*)(rl + 4 + 4 * grp);
        const float l0 = lsel[0], l1 = lsel[1], l2 = lsel[2], l3 = lsel[3];
        const float em = fmaxf(fmaxf(l0, l1), fmaxf(l2, l3));
        const float q0 = __expf(l0 - em), q1 = __expf(l1 - em), q2 = __expf(l2 - em), q3 = __expf(l3 - em);
        int i1 = 0; float b1 = q0;
        if (q1 > b1) { b1 = q1; i1 = 1; }
        if (q2 > b1) { b1 = q2; i1 = 2; }
        if (q3 > b1) { b1 = q3; i1 = 3; }
        int i2 = -1; float b2 = -1.f;
        if (i1 != 0 && q0 > b2) { b2 = q0; i2 = 0; }
        if (i1 != 1 && q1 > b2) { b2 = q1; i2 = 1; }
        if (i1 != 2 && q2 > b2) { b2 = q2; i2 = 2; }
        if (i1 != 3 && q3 > b2) { b2 = q3; i2 = 3; }
        const float inv = pg / (b1 + b2);
        ea = grp * 4 + i1; eb = grp * 4 + i2; wa = b1 * inv; wb = b2 * inv;
        la = atomicAdd(lcnt + ea, 1);
        lb_ = atomicAdd(lcnt + eb, 1);
    }
    __syncthreads();
    if (tid < 16) lcnt[16 + tid] = atomicAdd((int*)(p.ws + OFF_CNT) + layer * 16 + tid, lcnt[tid]);
    __syncthreads();
    if (tid < nrows) {
        int* ltok = (int*)(p.ws + OFF_LTOK);
        float* lw = (float*)(p.ws + OFF_LW);
        int* ts = (int*)(p.ws + OFF_TSLOT) + row * 2;
        const int pa = lcnt[16 + ea] + la, pb = lcnt[16 + eb] + lb_;
        ltok[(size_t)ea * NTOK + pa] = row; lw[(size_t)ea * NTOK + pa] = wa;
        ltok[(size_t)eb * NTOK + pb] = row; lw[(size_t)eb * NTOK + pb] = wb;
        ts[0] = (ea << 16) | pa; ts[1] = (eb << 16) | pb;
    }
    __syncthreads();
}

__device__ __forceinline__ int stage_col(int tid) { return ((tid & 7) ^ ((tid >> 3) & 7)) * 8; }

template <class Epi>
__device__ __forceinline__ void gemm_tile(const bf16_t* const (&ap)[4], const bf16_t* const (&bp)[2], int K, char* lds, const Ctx& cx, Epi&& epi) {
    const int tid = cx.tid, lane = cx.lane, wr = cx.wid >> 1, wc = cx.wid & 1, fr = lane & 15, fq = lane >> 4;
    f32x4 acc[4][4];
#pragma unroll
    for (int m = 0; m < 4; ++m)
#pragma unroll
        for (int n = 0; n < 4; ++n) acc[m][n] = (f32x4){0.f, 0.f, 0.f, 0.f};
    const int nt = K / 64;
    auto stage = [&](int t, int slot) {
        char* SA = lds + slot * GEMM_STAGE + tid * 16; char* SB = SA + 32768;
        const int ko = t * 64;
#pragma unroll
        for (int i = 0; i < 4; ++i) glds16(ap[i] + ko, SA + i * 8192);
#pragma unroll
        for (int i = 0; i < 2; ++i) glds16(bp[i] + ko, SB + i * 8192);
    };
    __syncthreads();
    stage(0, 0);
    if (nt > 1) stage(1, 1);
    const int x7 = fr & 7;
    const int aoff = (wr * 64 + fr) * 128, boff = 32768 + (wc * 64 + fr) * 128;
    int slot = 0;
    for (int kt = 0; kt < nt; ++kt) {
        if (kt + 1 < nt) asm volatile("s_waitcnt vmcnt(6)" ::: "memory");
        else asm volatile("s_waitcnt vmcnt(0)" ::: "memory");
        __builtin_amdgcn_s_barrier();
        if (kt + 2 < nt) stage(kt + 2, slot >= 1 ? slot - 1 : 2);
        const char* S = lds + slot * GEMM_STAGE;
#pragma unroll
        for (int ks = 0; ks < 2; ++ks) {
            const int pc = ((ks * 4 + fq) ^ x7) * 16;
            bf16x8 Af[4], Bf[4];
#pragma unroll
            for (int m = 0; m < 4; ++m) Af[m] = *(const bf16x8*)(S + aoff + m * 2048 + pc);
#pragma unroll
            for (int n = 0; n < 4; ++n) Bf[n] = *(const bf16x8*)(S + boff + n * 2048 + pc);
#pragma unroll
            for (int m = 0; m < 4; ++m)
#pragma unroll
                for (int n = 0; n < 4; ++n) acc[m][n] = __builtin_amdgcn_mfma_f32_16x16x32_bf16(Bf[n], Af[m], acc[m][n], 0, 0, 0);
        }
        slot = slot == 2 ? 0 : slot + 1;
    }
    epi(acc, wr, wc, fr, fq);
}

__device__ __forceinline__ int swz_g(int q) { return (0x1320 >> (4 * q)) & 3; }
__device__ __forceinline__ int stage_col2(int tid) { return ((tid & 3) ^ swz_g((tid >> 4) & 3)) * 8; }

template <int MODE = 0, class Epi>
__device__ __forceinline__ void gemm_tile2(const bf16_t* const (&ap)[2], const bf16_t* const (&bp)[2], int K, char* lds, const Ctx& cx, Epi&& epi) {
    const int tid = cx.tid, lane = cx.lane, wc = cx.wid & 3, fr = lane & 15, fq = lane >> 4;
    const int wr = __builtin_amdgcn_readfirstlane(cx.wid >> 2);
    f32x4 acc[8][4];
#pragma unroll
    for (int m = 0; m < 8; ++m)
#pragma unroll
        for (int n = 0; n < 4; ++n) acc[m][n] = (f32x4){0.f, 0.f, 0.f, 0.f};
    const int nt = K / 32;
    auto stage = [&](int t) {
        char* SA = lds + (t & 3) * 32768 + tid * 16; char* SB = SA + 16384;
        const int ko = t * 32;
        glds16(ap[0] + ko, SA); glds16(ap[1] + ko, SA + 8192);
        glds16(bp[0] + ko, SB); glds16(bp[1] + ko, SB + 8192);
    };
    __syncthreads();
    stage(0);
    if (nt > 1) stage(1);
    if (nt > 2) stage(2);
    const int pc = (fq ^ swz_g((fr >> 2) & 3)) * 16;
    const int aoff = (wr * 128 + fr) * 64 + pc, boff = 16384 + (wc * 64 + fr) * 64 + pc;
    bf16x8 Af[8], Bf[4];
    auto load_frags = [&](int kt) {
        const char* S = lds + (kt & 3) * 32768;
#pragma unroll
        for (int n = 0; n < 4; ++n) Bf[n] = *(const bf16x8*)(S + boff + n * 1024);
#pragma unroll
        for (int m = 0; m < 8; ++m) Af[m] = *(const bf16x8*)(S + aoff + m * 1024);
        asm volatile("s_waitcnt lgkmcnt(0)" ::: "memory");
    };
    auto mma = [&]() {
        __builtin_amdgcn_s_setprio(1);
#pragma unroll
        for (int m = 0; m < 8; ++m)
#pragma unroll
            for (int n = 0; n < 4; ++n) acc[m][n] = __builtin_amdgcn_mfma_f32_16x16x32_bf16(Bf[n], Af[m], acc[m][n], 0, 0, 0);
        __builtin_amdgcn_s_setprio(0);
    };
    if (nt > 2) asm volatile("s_waitcnt vmcnt(8)" ::: "memory");
    else if (nt == 2) asm volatile("s_waitcnt vmcnt(4)" ::: "memory");
    else asm volatile("s_waitcnt vmcnt(0)" ::: "memory");
    if (wr == 1) __builtin_amdgcn_s_barrier();
    for (int kt = 0; kt < nt; ++kt) {
        const int rem = nt - 1 - kt;
        if (rem >= 2) asm volatile("s_waitcnt vmcnt(8)" ::: "memory");
        else if (rem == 1) asm volatile("s_waitcnt vmcnt(4)" ::: "memory");
        else asm volatile("s_waitcnt vmcnt(0)" ::: "memory");
        __builtin_amdgcn_s_barrier();
        if (kt + 3 < nt) stage(kt + 3);
        load_frags(kt);
        if (rem >= 3) asm volatile("s_waitcnt vmcnt(8)" ::: "memory");
        else if (rem == 2) asm volatile("s_waitcnt vmcnt(4)" ::: "memory");
        else asm volatile("s_waitcnt vmcnt(0)" ::: "memory");
        __builtin_amdgcn_s_barrier();
        mma();
    }
    if (wr == 0) __builtin_amdgcn_s_barrier();
    if (MODE == 0) epi(acc, wr, wc, fr, fq);
    else {
#pragma unroll
        for (int m = 0; m < 8; ++m)
#pragma unroll
            for (int n = 0; n < 4; ++n) asm volatile("" :: "v"(acc[m][n]));
    }
}

template <class GetFn, class EpiFn>
__device__ __forceinline__ void gemm_stream2(int my_tiles, int K, char* lds, const Ctx& cx, GetFn&& get, EpiFn&& epi) {
    if (my_tiles <= 0) return;
    const int tid = cx.tid, lane = cx.lane, wc = cx.wid & 3, fr = lane & 15, fq = lane >> 4;
    const int wr = __builtin_amdgcn_readfirstlane(cx.wid >> 2);
    f32x4 acc[8][4];
#pragma unroll
    for (int m = 0; m < 8; ++m)
#pragma unroll
        for (int n = 0; n < 4; ++n) acc[m][n] = (f32x4){0.f, 0.f, 0.f, 0.f};
    const int nt = K / 32, S = my_tiles * nt;
    const bf16_t* sap[2]; const bf16_t* sbp[2];
    int sj = 0, skt = 0, sg = 0;
    get(0, sap, sbp);
    auto stage_next = [&]() {
        char* SA = lds + (sg & 3) * 32768 + tid * 16; char* SB = SA + 16384;
        const int ko = skt * 32;
        glds16(sap[0] + ko, SA); glds16(sap[1] + ko, SA + 8192);
        glds16(sbp[0] + ko, SB); glds16(sbp[1] + ko, SB + 8192);
        ++sg; ++skt;
        if (skt == nt) { skt = 0; ++sj; if (sj < my_tiles) get(sj, sap, sbp); }
    };
    __syncthreads();
    stage_next();
    if (S > 1) stage_next();
    if (S > 2) stage_next();
    const int pc = (fq ^ swz_g((fr >> 2) & 3)) * 16;
    const int aoff = (wr * 128 + fr) * 64 + pc, boff = 16384 + (wc * 64 + fr) * 64 + pc;
    bf16x8 Af[8], Bf[4];
    int g = 0;
    for (int cj = 0; cj < my_tiles; ++cj) {
        {
            const int rem0 = S - 1 - g;
            if (rem0 >= 2) asm volatile("s_waitcnt vmcnt(8)" ::: "memory");
            else if (rem0 == 1) asm volatile("s_waitcnt vmcnt(4)" ::: "memory");
            else asm volatile("s_waitcnt vmcnt(0)" ::: "memory");
        }
        if (wr == 1) __builtin_amdgcn_s_barrier();
        for (int kt = 0; kt < nt; ++kt, ++g) {
            const int rem = S - 1 - g;
            if (rem >= 2) asm volatile("s_waitcnt vmcnt(8)" ::: "memory");
            else if (rem == 1) asm volatile("s_waitcnt vmcnt(4)" ::: "memory");
            else asm volatile("s_waitcnt vmcnt(0)" ::: "memory");
            __builtin_amdgcn_s_barrier();
            if (g + 3 < S) stage_next();
            {
                const char* Sx = lds + (g & 3) * 32768;
#pragma unroll
                for (int n = 0; n < 4; ++n) Bf[n] = *(const bf16x8*)(Sx + boff + n * 1024);
#pragma unroll
                for (int m = 0; m < 8; ++m) Af[m] = *(const bf16x8*)(Sx + aoff + m * 1024);
                asm volatile("s_waitcnt lgkmcnt(0)" ::: "memory");
            }
            if (rem >= 3) asm volatile("s_waitcnt vmcnt(8)" ::: "memory");
            else if (rem == 2) asm volatile("s_waitcnt vmcnt(4)" ::: "memory");
            else asm volatile("s_waitcnt vmcnt(0)" ::: "memory");
            __builtin_amdgcn_s_barrier();
            __builtin_amdgcn_s_setprio(1);
#pragma unroll
            for (int m = 0; m < 8; ++m)
#pragma unroll
                for (int n = 0; n < 4; ++n) acc[m][n] = __builtin_amdgcn_mfma_f32_16x16x32_bf16(Bf[n], Af[m], acc[m][n], 0, 0, 0);
            __builtin_amdgcn_s_setprio(0);
        }
        if (wr == 0) __builtin_amdgcn_s_barrier();
        epi(cj, acc, wr, wc, fr, fq);
#pragma unroll
        for (int m = 0; m < 8; ++m)
#pragma unroll
            for (int n = 0; n < 4; ++n) acc[m][n] = (f32x4){0.f, 0.f, 0.f, 0.f};
    }
}

template <int MODE = 0, class EpiFactory>
__device__ __forceinline__ void gemm_phase_dense2(const bf16_t* A, int lda, const bf16_t* Bt, int K, int nrt, int nct, char* lds, const Ctx& cx, EpiFactory&& mk) {
    const int tid = cx.tid;
    const int ntiles = nrt * nct;
    const int sc = stage_col2(tid), sr = tid >> 2;
    const int my_tiles = cx.vbid < ntiles ? (ntiles - cx.vbid + cx.G - 1) / cx.G : 0;
    const int vb = cx.vbid, G = cx.G;
    gemm_stream2(my_tiles, K, lds, cx,
        [=](int j, const bf16_t* (&ap)[2], const bf16_t* (&bp)[2]) {
            const int tile = vb + j * G, rt = tile / nct, ct = tile % nct;
            ap[0] = A + (size_t)(rt * 256 + sr) * lda + sc; ap[1] = ap[0] + (size_t)128 * lda;
            bp[0] = Bt + (size_t)(ct * 256 + sr) * K + sc; bp[1] = bp[0] + (size_t)128 * K;
        },
        [=](int j, f32x4 (&acc)[8][4], int wr, int wc, int fr, int fq) {
            const int tile = vb + j * G, rt = tile / nct, ct = tile % nct;
            mk(rt * 256, ct * 256)(acc, wr, wc, fr, fq);
        });
}

__device__ __forceinline__ void phase_nsa_inproj(const Params& p, const Ctx& cx, char* lds) {
    const bf16_t* A = (const bf16_t*)(p.ws + OFF_HA);
    const bf16_t* Bt = (const bf16_t*)(p.ws + OFF_W_NSA_IN);
    char* ws = p.ws;
    const float* qg = p.nsa_q_gain;
    const float* kg = p.nsa_k_gain;
    gemm_phase_dense2(A, 1024, Bt, 1024, NTOK / 256, NSA_IN_PAD / 256, lds, cx, [=](int row0, int col0) {
        return [=](f32x4 (&acc)[8][4], int wr, int wc, int fr, int fq) {
            const int gc0 = col0 + wc * 64;
            if (gc0 >= NSA_IN) return;
            if (gc0 < 1024 || (gc0 >= 1536 && gc0 < 1792) || (gc0 >= 2048 && gc0 < 2304)) {
                const float* gain; float post; bf16_t* dstb; size_t rstride; size_t coff; bool tokmajor;
                if (gc0 < 1024) { gain = qg; post = 0.125f * 1.4426950408889634f; }
                else if (gc0 < 1792) { gain = kg + 64; post = 1.f; }
                else { gain = kg + 128; post = 1.f; }
#pragma unroll
                for (int m = 0; m < 8; ++m) {
                    __builtin_amdgcn_sched_barrier(0);
                    float ss = 0.f;
#pragma unroll
                    for (int n = 0; n < 4; ++n) ss += acc[m][n][0] * acc[m][n][0] + acc[m][n][1] * acc[m][n][1] + acc[m][n][2] * acc[m][n][2] + acc[m][n][3] * acc[m][n][3];
                    ss += __shfl_xor(ss, 16); ss += __shfl_xor(ss, 32);
                    const float r = rsqrtf(ss * (1.f / 64.f) + EPS) * post;
                    const int row = row0 + wr * 128 + m * 16 + fr;
                    bf16_t* dst;
                    if (gc0 < 1024) dst = (bf16_t*)(ws + OFF_Q) + (size_t)row * 1024 + gc0;
                    else {
                        const int g = ((gc0 - 1024) & 255) >> 6, b = row >> 11, t = row & 2047;
                        dst = (bf16_t*)(ws + (gc0 < 1792 ? OFF_KS : OFF_KW)) + ((size_t)(b * 4 + g) * 2048 + t) * 64;
                    }
#pragma unroll
                    for (int n = 0; n < 4; ++n) {
                        const int c = n * 16 + fq * 4;
                        f32x4 g4 = *(const f32x4*)(gain + c);
                        uint2 o; o.x = pack2(acc[m][n][0] * r * g4[0], acc[m][n][1] * r * g4[1]); o.y = pack2(acc[m][n][2] * r * g4[2], acc[m][n][3] * r * g4[3]);
                        *(uint2*)(dst + c) = o;
                    }
                }
            } else if (gc0 < 2560) {
                const int seg = (gc0 - 1024) >> 8;
                const int g = ((gc0 - 1024) & 255) >> 6;
                if (seg < 2) {
                    const size_t off = seg == 0 ? OFF_KCRAW : OFF_VCRAW;
#pragma unroll
                    for (int m = 0; m < 8; ++m) {
                        __builtin_amdgcn_sched_barrier(0);
                    __builtin_amdgcn_sched_barrier(0);
                        const int row = row0 + wr * 128 + m * 16 + fr, b = row >> 11, t = row & 2047;
                        bf16_t* dst = (bf16_t*)(ws + off) + ((size_t)(b * 4 + g) * 2048 + t) * 64;
#pragma unroll
                        for (int n = 0; n < 4; ++n) {
                            const int c = n * 16 + fq * 4;
                            uint2 o; o.x = pack2(acc[m][n][0], acc[m][n][1]); o.y = pack2(acc[m][n][2], acc[m][n][3]);
                            *(uint2*)(dst + c) = o;
                        }
                    }
                } else {
                    const size_t off = seg == 3 ? OFF_VS : OFF_VW;
#pragma unroll
                    for (int m = 0; m < 8; ++m) {
                        __builtin_amdgcn_sched_barrier(0);
                    __builtin_amdgcn_sched_barrier(0);
                        const int row = row0 + wr * 128 + m * 16 + fr, b = row >> 11, t = row & 2047;
                        bf16_t* dst = (bf16_t*)(ws + off) + (size_t)(b * 4 + g) * 64 * 2048 + t;
#pragma unroll
                        for (int n = 0; n < 4; ++n)
#pragma unroll
                            for (int j = 0; j < 4; ++j) dst[(size_t)(n * 16 + fq * 4 + j) * 2048] = f2bf(acc[m][n][j]);
                    }
                }
            } else {
#pragma unroll
                for (int m = 0; m < 8; ++m) {
                    __builtin_amdgcn_sched_barrier(0);
                    const int row = row0 + wr * 128 + m * 16 + fr;
                    float* dst = (float*)(ws + OFF_GATES) + (size_t)row * 48;
#pragma unroll
                    for (int n = 0; n < 3; ++n) {
                        const int c = n * 16 + fq * 4;
                        f32x4 o;
#pragma unroll
                        for (int j = 0; j < 4; ++j) o[j] = sigmoid_f(acc[m][n][j]);
                        *(f32x4*)(dst + c) = o;
                    }
                }
            }
        };
    });
}

__device__ __forceinline__ void phase_cmp1(const Params& p, const Ctx& cx, char* lds) {
    const int tid = cx.tid;
    const float* peb = (const float*)(p.ws + OFF_PEB);
    float* T1 = (float*)(p.ws + OFF_T1);
    const int sc = stage_col(tid), sr = tid >> 3;
    for (int tile = cx.vbid; tile < 64; tile += cx.G) {
        const int kv = tile >> 5, bg2 = tile & 31;
        const bf16_t* raw = (const bf16_t*)(p.ws + (kv ? OFF_VCRAW : OFF_KCRAW)) + (size_t)bg2 * 2 * 2048 * 64;
        const bf16_t* a0 = raw + (size_t)sr * 1024 + sc;
        const bf16_t* a2 = raw + (size_t)2048 * 64 + (size_t)sr * 1024 + sc;
        const bf16_t* b0 = (const bf16_t*)(p.ws + OFF_W_CMP1) + ((size_t)kv * 128 + sr) * 2048 + sc;
        const bf16_t* const ap[4] = {a0, a0 + (size_t)64 * 1024, a2, a2 + (size_t)64 * 1024};
        const bf16_t* const bp[2] = {b0, b0 + (size_t)64 * 2048};
        gemm_tile(ap, bp, 2048, lds, cx, [=](f32x4 (&acc)[4][4], int wr, int wc, int fr, int fq) {
            if (wc != 0) return;
#pragma unroll
            for (int m = 0; m < 4; ++m) {
                const int r = wr * 64 + m * 16 + fr;
                float* dst = T1 + ((size_t)kv * 8192 + (bg2 * 2 + (r >> 7)) * 128 + (r & 127)) * 64;
#pragma unroll
                for (int n = 0; n < 4; ++n) {
                    const int c = n * 16 + fq * 4;
                    f32x4 pb = *(const f32x4*)(peb + kv * 64 + c);
                    *(f32x4*)(dst + c) = acc[m][n] + pb;
                }
            }
        });
    }
}

__device__ __forceinline__ void phase_cmp2(const Params& p, const Ctx& cx) {
    const int lane = cx.lane;
    const float* T1 = (const float*)(p.ws + OFF_T1);
    for (int r = cx.vbid * NWAVE + cx.wid; r < 2 * 8192; r += cx.G * NWAVE) {
        const int kv = r >> 13, rr = r & 8191, n_ = rr & 127;
        const float s = silu_f(T1[(size_t)r * 64 + lane]);
        const float* w2 = p.nsa_cmp_w2 + kv * 4096 + lane;
        float o = 0.f;
#pragma unroll 8
        for (int j = 0; j < 64; ++j) o += __shfl(s, j) * w2[j * 64];
        if (kv == 0) {
            const float ss = wave_sum(o * o);
            o = o * rsqrtf(ss * (1.f / 64.f) + EPS) * p.nsa_k_gain[lane];
        }
        if (n_ == 127) o = 0.f;
        if (kv == 0) ((bf16_t*)(p.ws + OFF_KC))[(size_t)rr * 64 + lane] = f2bf(o);
        else ((bf16_t*)(p.ws + OFF_VC))[((size_t)(rr >> 7) * 64 + lane) * 128 + n_] = f2bf(o);
    }
}

constexpr int ATT_BUF = 17920, ATT_K_STRIDE = 144, ATT_V_OFF = 9216, ATT_V_STRIDE = 136, ATT_LUT_OFF = 2 * ATT_BUF, LUT_N = 2136, LUT_PAD = 80;
constexpr int ATT_SC_OFF = ATT_LUT_OFF + 4 * LUT_N * 4;
static_assert(ATT_SC_OFF + NWAVE * 8192 <= LDS_TAB_OFF, "attention LDS");
#define MFMA32(a, b, c) __builtin_amdgcn_mfma_f32_32x32x16_bf16((a), (b), (c), 0, 0, 0)
template <int V> struct IC { static constexpr int value = V; };

__device__ __forceinline__ void phase_attn(const Params& p, const Ctx& cx, char* lds) {
    const int tid = cx.tid, lane = cx.lane, wid = cx.wid;
    const int g = cx.vbid & 3;
    const int ql = lane & 7, head = (lane & 31) >> 3, h2 = lane >> 5, l31 = lane & 31;
    float* lut = (float*)(lds + ATT_LUT_OFF);
    for (int i = tid; i < 4 * LUT_N; i += NTHR) {
        const int h = i / LUT_N, dist = i % LUT_N - LUT_PAD;
        lut[i] = dist >= 0 ? p.rel_bias[t5_bucket(dist) * 16 + g * 4 + h] * 1.4426950408889634f : 0.f;
    }
    __syncthreads();
    const float* lutp = lut + head * LUT_N + LUT_PAD;
    const float b31 = lutp[2047];
    const bf16_t* Qb = (const bf16_t*)(p.ws + OFF_Q);
    const bf16_t* KC = (const bf16_t*)(p.ws + OFF_KC);
    const bf16_t* VCT = (const bf16_t*)(p.ws + OFF_VC);
    const bf16_t* KS = (const bf16_t*)(p.ws + OFF_KS);
    const bf16_t* VST = (const bf16_t*)(p.ws + OFF_VS);
    const bf16_t* KW = (const bf16_t*)(p.ws + OFF_KW);
    const bf16_t* VWT = (const bf16_t*)(p.ws + OFF_VW);
    const float* GT = (const float*)(p.ws + OFF_GATES);
    bf16_t* Og = (bf16_t*)(p.ws + OFF_HA);
    float* scw = (float*)(lds + ATT_SC_OFF) + wid * 2048;
    f32x4* outw = (f32x4*)(lds + ATT_SC_OFF + wid * 8192) + lane;
    const bool flip_ok = (cx.G % 128) == 0;
    const int widu = __builtin_amdgcn_readfirstlane(wid);

    for (int it = 0;; ++it) {
        const int u = cx.vbid + it * cx.G;
        if (u >= 2048) break;
        const int rest = u >> 2, b = rest >> 5, qtb = rest & 31;
        const int qt = (flip_ok && (it & 1)) ? 31 - qtb : qtb;
        const int t0 = qt * 64, cur = qt, bg = b * 4 + g;
        const int tq = t0 + wid * 8 + ql;
        const size_t rowtok = (size_t)b * SEQ + tq;
        bf16x8 Qf[4];
        {
            const bf16_t* qp = Qb + rowtok * 1024 + (g * 4 + head) * 64 + 8 * h2;
#pragma unroll
            for (int ks = 0; ks < 4; ++ks) Qf[ks] = *(const bf16x8*)(qp + 16 * ks);
        }
        const float* gt = GT + rowtok * 48 + (g * 4 + head) * 3;
        const float gate_c = gt[0], gate_s = gt[1], gate_w = gt[2];
        const int wlo = max(0, qt - 8);
        const int nW = cur - wlo + 1;
        const int NT = 4 + nW + cur + 1;

        uint4 kr0, vr0;
        auto issue_load = [&](int i) {
            const bf16_t* ksrc; const bf16_t* vsrc; int vstride;
            if (i < 4) { const int ci = i & 1; ksrc = KC + ((size_t)bg * 128 + ci * 64) * 64; vsrc = VCT + (size_t)bg * 64 * 128 + ci * 64; vstride = 128; }
            else if (i < 4 + nW) { const int kb = wlo + i - 4; ksrc = KW + ((size_t)bg * 2048 + kb * 64) * 64; vsrc = VWT + (size_t)bg * 64 * 2048 + kb * 64; vstride = 2048; }
            else { const int kb = i - 4 - nW; ksrc = KS + ((size_t)bg * 2048 + kb * 64) * 64; vsrc = VST + (size_t)bg * 64 * 2048 + kb * 64; vstride = 2048; }
            kr0 = *(const uint4*)(ksrc + tid * 8);
            vr0 = *(const uint4*)(vsrc + (size_t)(tid >> 3) * vstride + (tid & 7) * 8);
        };
        auto write_lds = [&](int i) {
            char* bufp = lds + (i & 1) * ATT_BUF;
            *(uint4*)(bufp + (tid >> 3) * ATT_K_STRIDE + (tid & 7) * 16) = kr0;
            char* va = bufp + ATT_V_OFF + (tid >> 3) * ATT_V_STRIDE + (tid & 7) * 16;
            uint2 t;
            t.x = vr0.x; t.y = vr0.y; *(uint2*)va = t;
            t.x = vr0.z; t.y = vr0.w; *(uint2*)(va + 8) = t;
        };
        f32x16 O0, O1;
#pragma unroll
        for (int r = 0; r < 16; ++r) { O0[r] = 0.f; O1[r] = 0.f; }
        float lsum = 0.f;

        auto qk = [&](const char* bufp, int kt2, float init) -> f32x16 {
            f32x16 S;
#pragma unroll
            for (int r = 0; r < 16; ++r) S[r] = init;
            const char* kp = bufp + (32 * kt2 + l31) * ATT_K_STRIDE + 16 * h2;
            bf16x8 kf[4];
#pragma unroll
            for (int ks = 0; ks < 4; ++ks) kf[ks] = *(const bf16x8*)(kp + 32 * ks);
            __builtin_amdgcn_sched_barrier(0);
#pragma unroll
            for (int ks = 0; ks < 4; ++ks) S = MFMA32(kf[ks], Qf[ks], S);
            return S;
        };
        auto pv = [&](const char* bufp, int kt2, const f32x16& P) {
            const char* vp = bufp + ATT_V_OFF + l31 * ATT_V_STRIDE + (32 * kt2 + 4 * h2) * 2;
            uint2 va[2][2][2];
#pragma unroll
            for (int s2 = 0; s2 < 2; ++s2)
#pragma unroll
                for (int dt = 0; dt < 2; ++dt) {
                    va[s2][dt][0] = *(const uint2*)(vp + dt * 32 * ATT_V_STRIDE + s2 * 32);
                    va[s2][dt][1] = *(const uint2*)(vp + dt * 32 * ATT_V_STRIDE + s2 * 32 + 16);
                }
            __builtin_amdgcn_sched_barrier(0);
#pragma unroll
            for (int s2 = 0; s2 < 2; ++s2) {
                uint4 pk;
                pk.x = pack2(P[8 * s2 + 0], P[8 * s2 + 1]); pk.y = pack2(P[8 * s2 + 2], P[8 * s2 + 3]);
                pk.z = pack2(P[8 * s2 + 4], P[8 * s2 + 5]); pk.w = pack2(P[8 * s2 + 6], P[8 * s2 + 7]);
                const bf16x8 Pf = __builtin_bit_cast(bf16x8, pk);
                uint4 a0, a1;
                a0.x = va[s2][0][0].x; a0.y = va[s2][0][0].y; a0.z = va[s2][0][1].x; a0.w = va[s2][0][1].y;
                a1.x = va[s2][1][0].x; a1.y = va[s2][1][0].y; a1.z = va[s2][1][1].x; a1.w = va[s2][1][1].y;
                O0 = MFMA32(__builtin_bit_cast(bf16x8, a0), Pf, O0);
                O1 = MFMA32(__builtin_bit_cast(bf16x8, a1), Pf, O1);
            }
        };
        auto finalize = [&](float gate, int mode) {
            const float Z = lsum + __shfl_xor(lsum, 32);
            const float f = Z > 0.f ? gate / Z : 0.f;
#pragma unroll
            for (int v4 = 0; v4 < 4; ++v4) {
                f32x4 a = {f * O0[4 * v4], f * O0[4 * v4 + 1], f * O0[4 * v4 + 2], f * O0[4 * v4 + 3]};
                f32x4 c = {f * O1[4 * v4], f * O1[4 * v4 + 1], f * O1[4 * v4 + 2], f * O1[4 * v4 + 3]};
                if (mode != 0) { a += outw[v4 * 64]; c += outw[(4 + v4) * 64]; }
                if (mode != 2) { outw[v4 * 64] = a; outw[(4 + v4) * 64] = c; }
                else { O0[4 * v4] = a[0]; O0[4 * v4 + 1] = a[1]; O0[4 * v4 + 2] = a[2]; O0[4 * v4 + 3] = a[3];
                       O1[4 * v4] = c[0]; O1[4 * v4 + 1] = c[1]; O1[4 * v4 + 2] = c[2]; O1[4 * v4 + 3] = c[3]; }
            }
            if (mode != 2) {
#pragma unroll
                for (int r = 0; r < 16; ++r) { O0[r] = 0.f; O1[r] = 0.f; }
            }
            lsum = 0.f;
        };
        auto tile_ws = [&](const char* bufp, int kb, float cinit, auto MMc, auto BMc) {
            constexpr int MM = decltype(MMc)::value, BM = decltype(BMc)::value;
#pragma unroll 1
            for (int kt2 = 0; kt2 < 2; ++kt2) {
                const int d0 = tq - (64 * kb + 32 * kt2 + 4 * h2);
                const float* lp = lutp + (d0 - 27);
                float bv[16];
                if (BM == 0) {
#pragma unroll
                    for (int r = 0; r < 16; ++r) bv[r] = lp[27 - ((r & 3) + 8 * (r >> 2))];
                    __builtin_amdgcn_sched_barrier(0);
                }
                f32x16 S = qk(bufp, kt2, cinit);
#pragma unroll
                for (int r = 0; r < 16; ++r) {
                    const int cr = (r & 3) + 8 * (r >> 2);
                    float x = S[r];
                    if (BM == 0) x += bv[r];
                    if (MM == 1) x += (d0 - cr < 512) ? 0.f : -INFINITY;
                    if (MM == 2) x += (d0 - cr >= 0) ? 0.f : -INFINITY;
                    S[r] = __builtin_amdgcn_exp2f(x);
                    lsum += S[r];
                }
                pv(bufp, kt2, S);
            }
        };

        const int nvis = (tq >= 31) ? min((tq - 31) / 16 + 1, 127) : 0;
        float inv_c = 0.f;
        unsigned selmask = 0u;
        float* sown = scw + ql * 32;
        float* stail = scw + 256 + ql * 32;
        float* ssc = scw + 512 + ql * 32;
        issue_load(0);
        __syncthreads();
        write_lds(0);
        issue_load(1);
        for (int i = 0; i < NT; ++i) {
            __syncthreads();
            const char* bufp = lds + (i & 1) * ATT_BUF;
            if (i < 4) {
                const int ci = i & 1;
#pragma unroll 1
                for (int kt2 = 0; kt2 < 2; ++kt2) {
                    const int n0 = 64 * ci + 32 * kt2 + 4 * h2;
                    const int d0 = tq - 31 - 16 * n0;
                    float bv[16];
#pragma unroll
                    for (int r = 0; r < 16; ++r) bv[r] = lutp[max(d0 - 16 * ((r & 3) + 8 * (r >> 2)), -LUT_PAD)];
                    __builtin_amdgcn_sched_barrier(0);
                    f32x16 S = qk(bufp, kt2, 0.f);
#pragma unroll
                    for (int r = 0; r < 16; ++r) {
                        const int cr = (r & 3) + 8 * (r >> 2);
                        S[r] = __builtin_amdgcn_exp2f(S[r] + bv[r] + ((n0 + cr) < nvis ? 0.f : -INFINITY));
                        lsum += S[r];
                    }
                    if (i >= 2) {
                        pv(bufp, kt2, S);
#pragma unroll
                        for (int rq = 0; rq < 4; ++rq) {
                            float gsum = (S[4 * rq] + S[4 * rq + 1] + S[4 * rq + 2] + 0.5f * S[4 * rq + 3]) * inv_c;
                            float tl = 0.5f * S[4 * rq + 3] * inv_c;
                            gsum += __shfl_xor(gsum, 8); gsum += __shfl_xor(gsum, 16);
                            tl += __shfl_xor(tl, 8); tl += __shfl_xor(tl, 16);
                            const int sblk = 8 * (2 * ci + kt2) + 2 * rq + h2;
                            if (head == 0) {
                                sown[sblk] = gsum;
                                if (sblk < 31) stail[sblk + 1] = tl;
                            }
                        }
                    }
                }
                if (i == 1) {
                    const float Z = lsum + __shfl_xor(lsum, 32);
                    inv_c = Z > 0.f ? 1.f / Z : 0.f;
                    lsum = 0.f;
                }
                if (i == 3) {
                    if (head == 0 && h2 == 0) stail[0] = 0.f;
                    __builtin_amdgcn_wave_barrier();
                    const int j8 = head * 2 + h2;
                    {
                        const f32x4 a = *(const f32x4*)(sown + 4 * j8), t4 = *(const f32x4*)(stail + 4 * j8);
                        f32x4 sc;
#pragma unroll
                        for (int q = 0; q < 4; ++q) {
                            const int sblk = 4 * j8 + q;
                            const bool forced = (sblk == 0) || (sblk == cur) || (sblk == cur - 1);
                            sc[q] = forced ? 1.0e4f : (sblk <= cur ? a[q] + t4[q] : -1.0f);
                        }
                        *(f32x4*)(ssc + 4 * j8) = sc;
                    }
                    __builtin_amdgcn_wave_barrier();
                    const f32x4 own = *(const f32x4*)(ssc + 4 * j8);
                    int rk0 = 0, rk1 = 0, rk2 = 0, rk3 = 0;
                    const int so0 = 4 * j8;
#pragma unroll
                    for (int m4 = 0; m4 < 8; ++m4) {
                        const f32x4 v = *(const f32x4*)(ssc + 4 * m4);
#pragma unroll
                        for (int q = 0; q < 4; ++q) {
                            const int sm = 4 * m4 + q;
                            const float vm = v[q];
                            rk0 += (vm > own[0] || (vm == own[0] && sm < so0)) ? 1 : 0;
                            rk1 += (vm > own[1] || (vm == own[1] && sm < so0 + 1)) ? 1 : 0;
                            rk2 += (vm > own[2] || (vm == own[2] && sm < so0 + 2)) ? 1 : 0;
                            rk3 += (vm > own[3] || (vm == own[3] && sm < so0 + 3)) ? 1 : 0;
                        }
                    }
                    unsigned mk = ((rk0 < 8 ? 1u : 0u) | (rk1 < 8 ? 2u : 0u) | (rk2 < 8 ? 4u : 0u) | (rk3 < 8 ? 8u : 0u)) << so0;
                    mk |= __shfl_xor(mk, 8); mk |= __shfl_xor(mk, 16); mk |= __shfl_xor(mk, 32);
                    selmask = mk;
                    __builtin_amdgcn_wave_barrier();
                    finalize(gate_c, 0);
                }
            } else if (i < 4 + nW) {
                const int kb = wlo + i - 4;
                if (kb == cur) tile_ws(bufp, kb, 0.f, IC<2>{}, IC<0>{});
                else if (kb == cur - 8) tile_ws(bufp, kb, 0.f, IC<1>{}, IC<0>{});
                else tile_ws(bufp, kb, 0.f, IC<0>{}, IC<0>{});
                if (i == 3 + nW) finalize(gate_w, 1);
            } else {
                const int kb = i - 4 - nW;
                const bool sel = ((selmask >> kb) & 1u) != 0;
                if (__ballot(sel) != 0ull) {
                    const float neg = sel ? 0.f : -INFINITY;
                    if (kb == cur) tile_ws(bufp, kb, neg, IC<2>{}, IC<0>{});
                    else if (t0 + 8 * widu - (64 * kb + 63) >= 790) tile_ws(bufp, kb, neg + b31, IC<0>{}, IC<1>{});
                    else tile_ws(bufp, kb, neg, IC<0>{}, IC<0>{});
                }
            }
            if (i + 1 < NT) {
                write_lds(i + 1);
                if (i + 2 < NT) issue_load(i + 2);
            }
        }
        finalize(gate_s, 2);
        {
            bf16_t* op = Og + rowtok * 1024 + (g * 4 + head) * 64 + 4 * h2;
#pragma unroll
            for (int rq = 0; rq < 4; ++rq) {
                uint2 o0; o0.x = pack2(O0[4 * rq], O0[4 * rq + 1]); o0.y = pack2(O0[4 * rq + 2], O0[4 * rq + 3]);
                uint2 o1; o1.x = pack2(O1[4 * rq], O1[4 * rq + 1]); o1.y = pack2(O1[4 * rq + 2], O1[4 * rq + 3]);
                *(uint2*)(op + 8 * rq) = o0;
                *(uint2*)(op + 32 + 8 * rq) = o1;
            }
        }
    }
}

__device__ __forceinline__ void phase_outproj(const Params& p, const Ctx& cx, char* lds, const bf16_t* A, const bf16_t* Bt, const float* xin, int ls) {
    const float* mod = (const float*)(p.ws + OFF_MOD);
    float* xo = p.out;
    gemm_phase_dense2(A, 1024, Bt, 1024, NTOK / 256, 4, lds, cx, [=](int row0, int col0) {
        return [=](f32x4 (&acc)[8][4], int wr, int wc, int fr, int fq) {
#pragma unroll
            for (int m = 0; m < 8; ++m) {
                const int row = row0 + wr * 128 + m * 16 + fr, b = row >> 11;
                const float* gate = mod + ((size_t)ls * 16 + b) * 3072 + 2048;
#pragma unroll
                for (int n = 0; n < 4; ++n) {
                    const int col = col0 + wc * 64 + n * 16 + fq * 4;
                    f32x4 g = *(const f32x4*)(gate + col);
                    f32x4 xi = *(const f32x4*)(xin + (size_t)row * 1024 + col);
                    f32x4 o;
#pragma unroll
                    for (int j = 0; j < 4; ++j) o[j] = xi[j] + g[j] * acc[m][n][j];
                    *(f32x4*)(xo + (size_t)row * 1024 + col) = o;
                }
            }
        };
    });
}

__device__ __forceinline__ void moe_tables(const Params& p, int layer, int tid, int* s_cnt, int* s_off, int* s_toff) {
    __syncthreads();
    if (tid == 0) {
        const int* cnt = (const int*)(p.ws + OFF_CNT) + layer * 16;
        int o = 0, to = 0;
        for (int e = 0; e < 16; ++e) { const int c = cnt[e]; s_cnt[e] = c; s_off[e] = o; s_toff[e] = to; o += c; to += ((c + 255) >> 8) * 4; }
        s_off[16] = o; s_toff[16] = to;
    }
    __syncthreads();
}

constexpr int LDS_ROWIDX_OFF = 131072, LDS_LW_OFF = 131072 + 8192;
static_assert(LDS_LW_OFF + 8192 <= LDS_TAB_OFF, "moe caches");

__device__ __forceinline__ void phase_moe_up(const Params& p, const Ctx& cx, char* lds, int layer) {
    const int tid = cx.tid;
    int* s_cnt = (int*)(lds + LDS_TAB_OFF); int* s_off = s_cnt + 16; int* s_toff = s_off + 17;
    moe_tables(p, layer, tid, s_cnt, s_off, s_toff);
    const int ntiles = s_toff[16];
    const bf16_t* hA = (const bf16_t*)(p.ws + OFF_HA);
    const int* ltok = (const int*)(p.ws + OFF_LTOK);
    bf16_t* H1 = (bf16_t*)(p.ws + OFF_H1);
    int* rowidx = (int*)(lds + LDS_ROWIDX_OFF);
    const int sc = stage_col2(tid), sr = tid >> 2;
    const int vb = cx.vbid, G = cx.G;
    const int my_tiles = min(8, vb < ntiles ? (ntiles - vb + G - 1) / G : 0);
    auto locate = [=](int j, int& e, int& rt, int& ct) { const int tile = vb + j * G; e = 0; while (tile >= s_toff[e + 1]) ++e; const int lt = tile - s_toff[e]; rt = lt >> 2; ct = lt & 3; };
    for (int i = tid; i < my_tiles * 256; i += NTHR) {
        const int j = i >> 8, r = i & 255; int e, rt, ct; locate(j, e, rt, ct);
        rowidx[i] = ltok[(size_t)e * NTOK + min(rt * 256 + r, s_cnt[e] - 1)];
    }
    __syncthreads();
    const bf16_t* Wup = (const bf16_t*)(p.ws + OFF_W_UP) + (size_t)layer * 16 * 1024 * 1024;
    gemm_stream2(my_tiles, 1024, lds, cx,
        [=](int j, const bf16_t* (&ap)[2], const bf16_t* (&bp)[2]) {
            int e, rt, ct; locate(j, e, rt, ct);
            ap[0] = hA + (size_t)rowidx[j * 256 + sr] * 1024 + sc; ap[1] = hA + (size_t)rowidx[j * 256 + sr + 128] * 1024 + sc;
            bp[0] = Wup + ((size_t)e * 1024 + ct * 256 + sr) * 1024 + sc; bp[1] = bp[0] + (size_t)128 * 1024;
        },
        [=](int j, f32x4 (&acc)[8][4], int wr, int wc, int fr, int fq) {
            int e, rt, ct; locate(j, e, rt, ct);
            const int cnt = s_cnt[e], off = s_off[e];
#pragma unroll
            for (int m = 0; m < 8; ++m) {
                const int pos = rt * 256 + wr * 128 + m * 16 + fr;
                if (pos < cnt) {
                    bf16_t* dst = H1 + (size_t)(off + pos) * 512 + ct * 128 + wc * 32 + fq * 4;
#pragma unroll
                    for (int n = 0; n < 2; ++n) {
                        float h[4];
#pragma unroll
                        for (int jj = 0; jj < 4; ++jj) h[jj] = silu_f(acc[m][n][jj]) * acc[m][n + 2][jj];
                        uint2 o; o.x = pack2(h[0], h[1]); o.y = pack2(h[2], h[3]);
                        *(uint2*)(dst + n * 16) = o;
                    }
                }
            }
        });
}

__device__ __forceinline__ void phase_moe_down(const Params& p, const Ctx& cx, char* lds, int layer) {
    const int tid = cx.tid;
    int* s_cnt = (int*)(lds + LDS_TAB_OFF); int* s_off = s_cnt + 16; int* s_toff = s_off + 17;
    moe_tables(p, layer, tid, s_cnt, s_off, s_toff);
    const int ntiles = s_toff[16];
    const bf16_t* H1 = (const bf16_t*)(p.ws + OFF_H1);
    const float* lw = (const float*)(p.ws + OFF_LW);
    bf16_t* Y = (bf16_t*)(p.ws + OFF_Y);
    float* lwc = (float*)(lds + LDS_LW_OFF);
    const int sc = stage_col2(tid), sr = tid >> 2;
    const int vb = cx.vbid, G = cx.G;
    const int my_tiles = min(8, vb < ntiles ? (ntiles - vb + G - 1) / G : 0);
    auto locate = [=](int j, int& e, int& rt, int& ct) { const int tile = vb + j * G; e = 0; while (tile >= s_toff[e + 1]) ++e; const int lt = tile - s_toff[e]; rt = lt >> 2; ct = lt & 3; };
    for (int i = tid; i < my_tiles * 256; i += NTHR) {
        const int j = i >> 8, r = i & 255; int e, rt, ct; locate(j, e, rt, ct);
        lwc[i] = lw[(size_t)e * NTOK + min(rt * 256 + r, s_cnt[e] - 1)];
    }
    __syncthreads();
    const bf16_t* Wdn = (const bf16_t*)(p.ws + OFF_W_DN) + (size_t)layer * 16 * 1024 * 512;
    gemm_stream2(my_tiles, 512, lds, cx,
        [=](int j, const bf16_t* (&ap)[2], const bf16_t* (&bp)[2]) {
            int e, rt, ct; locate(j, e, rt, ct);
            const int cnt = s_cnt[e], off = s_off[e];
            ap[0] = H1 + (size_t)(off + min(rt * 256 + sr, cnt - 1)) * 512 + sc; ap[1] = H1 + (size_t)(off + min(rt * 256 + sr + 128, cnt - 1)) * 512 + sc;
            bp[0] = Wdn + ((size_t)e * 1024 + ct * 256 + sr) * 512 + sc; bp[1] = bp[0] + (size_t)128 * 512;
        },
        [=](int j, f32x4 (&acc)[8][4], int wr, int wc, int fr, int fq) {
            int e, rt, ct; locate(j, e, rt, ct);
            const int cnt = s_cnt[e], off = s_off[e];
#pragma unroll
            for (int m = 0; m < 8; ++m) {
                const int rl_ = wr * 128 + m * 16 + fr, pos = rt * 256 + rl_;
                if (pos < cnt) {
                    const float w = lwc[j * 256 + rl_];
                    bf16_t* dst = Y + (size_t)(off + pos) * 1024 + ct * 256 + wc * 64 + fq * 4;
#pragma unroll
                    for (int n = 0; n < 4; ++n) {
                        uint2 o; o.x = pack2(w * acc[m][n][0], w * acc[m][n][1]); o.y = pack2(w * acc[m][n][2], w * acc[m][n][3]);
                        *(uint2*)(dst + n * 16) = o;
                    }
                }
            }
        });
}

template <int MODE = 0>
__device__ __forceinline__ void phase_hgrn_inproj(const Params& p, const Ctx& cx, char* lds) {
    const bf16_t* A = (const bf16_t*)(p.ws + OFF_HA);
    const bf16_t* Bt = (const bf16_t*)(p.ws + OFF_W_HG_IN);
    char* ws = p.ws;
    const float* lb = (const float*)(p.ws + OFF_LB);
    gemm_phase_dense2(A, 1024, Bt, 1024, NTOK / 256, 16, lds, cx, [=](int row0, int col0) {
        return [=](f32x4 (&acc)[8][4], int wr, int wc, int fr, int fq) {
            const int gc0 = col0 + wc * 64, seg = gc0 >> 10, c0 = gc0 & 1023;
#pragma unroll
            for (int m = 0; m < 8; ++m) {
                const int row = row0 + wr * 128 + m * 16 + fr;
#pragma unroll
                for (int n = 0; n < 4; ++n) {
                    const int c = c0 + n * 16 + fq * 4;
                    if (seg == 1) {
                        f32x4 l4 = *(const f32x4*)(lb + c), o;
#pragma unroll
                        for (int j = 0; j < 4; ++j) o[j] = __logf(l4[j] + (1.f - l4[j]) * sigmoid_f(acc[m][n][j]));
                        uint2 oh; oh.x = packh2(o[0], o[1]); oh.y = packh2(o[2], o[3]);
                        *(uint2*)((unsigned short*)(ws + OFF_LF) + (size_t)row * 1024 + c) = oh;
                    } else {
                        float h[4];
#pragma unroll
                        for (int j = 0; j < 4; ++j) h[j] = (seg == 2) ? acc[m][n][j] : silu_f(acc[m][n][j]);
                        uint2 o; o.x = pack2(h[0], h[1]); o.y = pack2(h[2], h[3]);
                        bf16_t* dst = (bf16_t*)(ws + (seg == 0 ? OFF_QH : seg == 2 ? OFF_V : OFF_G));
                        *(uint2*)(dst + (size_t)row * 1024 + c) = o;
                    }
                }
            }
        };
    });
}

constexpr int HG_QD_OFF = 0, HG_KD_OFF = 8704, HG_K2T_OFF = 17408, HG_VT_OFF = 27648, HG_DEC_OFF = 37888, HG_BUF = 38400, HG_TOT_OFF = 2 * HG_BUF;
constexpr int HG_ROW = 272, HG_TROW = 80;
static_assert(HG_TOT_OFF + 2048 <= LDS_TAB_OFF, "hgrn LDS");

__device__ __forceinline__ void phase_hgrn_rec(const Params& p, const Ctx& cx, char* lds) {
    const int lane = cx.lane;
    const int l31 = lane & 31, h2 = lane >> 5;
    const int widu = __builtin_amdgcn_readfirstlane(cx.wid);
    const bool producer = widu >= 4;
    const int pw = widu & 3;
    const int d0 = 2 * lane;
    const bf16_t* QH = (const bf16_t*)(p.ws + OFF_QH);
    const unsigned short* LF = (const unsigned short*)(p.ws + OFF_LF);
    const bf16_t* V = (const bf16_t*)(p.ws + OFF_V);
    bf16_t* OR = (bf16_t*)(p.ws + OFF_HA);
    float* tot = (float*)(lds + HG_TOT_OFF);
    for (int item = blockIdx.x; item < 128; item += cx.G) {
        const int b = item >> 3, h = item & 7;
        f32x16 S0, S1, S2, S3;
#pragma unroll
        for (int r = 0; r < 16; ++r) { S0[r] = 0.f; S1[r] = 0.f; S2[r] = 0.f; S3[r] = 0.f; }
        unsigned lfA[8], lfB[8], qv[8], vv[8];
        const size_t gbase = (size_t)(b * SEQ + pw * 8) * 1024 + h * 128;
        if (producer) {
#pragma unroll
            for (int i = 0; i < 8; ++i) {
                lfA[i] = *(const unsigned*)(LF + gbase + (size_t)i * 1024 + d0);
                qv[i] = *(const unsigned*)(QH + gbase + (size_t)i * 1024 + d0);
                vv[i] = *(const unsigned*)(V + gbase + (size_t)i * 1024 + d0);
            }
#pragma unroll
            for (int i = 0; i < 8; ++i) lfB[i] = *(const unsigned*)(LF + gbase + (size_t)(32 + i) * 1024 + d0);
        }
        __syncthreads();
        for (int c = 0; c <= SEQ / 32; ++c) {
            unsigned lf[8];
#pragma unroll
            for (int i = 0; i < 8; ++i) lf[i] = (c & 1) ? lfB[i] : lfA[i];
            f2_t run = {0.f, 0.f};
            if (producer && c < SEQ / 32) {
#pragma unroll
                for (int i = 0; i < 8; ++i) run += unpackh2(lf[i]);
                *(f2_t*)(tot + pw * 128 + d0) = run;
            }
            __syncthreads();
            if (producer) {
                if (c < SEQ / 32) {
                    char* bufp = lds + (c & 1) * HG_BUF;
                    f2_t pre = {0.f, 0.f}, last = {0.f, 0.f};
#pragma unroll
                    for (int q = 0; q < 4; ++q) {
                        const f2_t tq_ = *(const f2_t*)(tot + q * 128 + d0);
                        last += tq_;
                        if (q < pw) pre += tq_;
                    }
                    if (pw == 0) { f2_t dv; dv.x = __expf(last.x); dv.y = __expf(last.y); *(f2_t*)(bufp + HG_DEC_OFF + d0 * 4) = dv; }
                    float k2a[8], k2b[8];
                    f2_t rc = pre;
#pragma unroll
                    for (int i = 0; i < 8; ++i) {
                        const f2_t lfi = unpackh2(lf[i]);
                        rc += lfi;
                        const float cu0 = rc.x, cu1 = rc.y;
                        const float kk0 = 1.f - __expf(lfi.x), kk1 = 1.f - __expf(lfi.y);
                        const float q0 = bf2f((unsigned short)(qv[i] & 0xffff)) * __expf(cu0), q1 = bf2f((unsigned short)(qv[i] >> 16)) * __expf(cu1);
                        const float kd0 = kk0 * __expf(-cu0), kd1 = kk1 * __expf(-cu1);
                        k2a[i] = kk0 * __expf(last.x - cu0); k2b[i] = kk1 * __expf(last.y - cu1);
                        const int tl = pw * 8 + i;
                        *(unsigned*)(bufp + HG_QD_OFF + tl * HG_ROW + d0 * 2) = pack2(q0, q1);
                        *(unsigned*)(bufp + HG_KD_OFF + tl * HG_ROW + d0 * 2) = pack2(kd0, kd1);
                    }
                    uint4 a, bq, va, vb;
                    a.x = pack2(k2a[0], k2a[1]); a.y = pack2(k2a[2], k2a[3]); a.z = pack2(k2a[4], k2a[5]); a.w = pack2(k2a[6], k2a[7]);
                    bq.x = pack2(k2b[0], k2b[1]); bq.y = pack2(k2b[2], k2b[3]); bq.z = pack2(k2b[4], k2b[5]); bq.w = pack2(k2b[6], k2b[7]);
                    va.x = (vv[0] & 0xffffu) | (vv[1] << 16); va.y = (vv[2] & 0xffffu) | (vv[3] << 16); va.z = (vv[4] & 0xffffu) | (vv[5] << 16); va.w = (vv[6] & 0xffffu) | (vv[7] << 16);
                    vb.x = (vv[0] >> 16) | (vv[1] & 0xffff0000u); vb.y = (vv[2] >> 16) | (vv[3] & 0xffff0000u); vb.z = (vv[4] >> 16) | (vv[5] & 0xffff0000u); vb.w = (vv[6] >> 16) | (vv[7] & 0xffff0000u);
                    *(uint4*)(bufp + HG_K2T_OFF + d0 * HG_TROW + pw * 16) = a;
                    *(uint4*)(bufp + HG_K2T_OFF + (d0 + 1) * HG_TROW + pw * 16) = bq;
                    *(uint4*)(bufp + HG_VT_OFF + d0 * HG_TROW + pw * 16) = va;
                    *(uint4*)(bufp + HG_VT_OFF + (d0 + 1) * HG_TROW + pw * 16) = vb;
                    __builtin_amdgcn_sched_barrier(0);
                    if (c + 1 < SEQ / 32) {
                        const size_t gn = gbase + (size_t)(c + 1) * 32 * 1024;
#pragma unroll
                        for (int i = 0; i < 8; ++i) {
                            qv[i] = *(const unsigned*)(QH + gn + (size_t)i * 1024 + d0);
                            vv[i] = *(const unsigned*)(V + gn + (size_t)i * 1024 + d0);
                        }
                    }
                    if (c + 2 < SEQ / 32) {
                        const size_t gn = gbase + (size_t)(c + 2) * 32 * 1024;
                        if (c & 1) {
#pragma unroll
                            for (int i = 0; i < 8; ++i) lfB[i] = *(const unsigned*)(LF + gn + (size_t)i * 1024 + d0);
                        } else {
#pragma unroll
                            for (int i = 0; i < 8; ++i) lfA[i] = *(const unsigned*)(LF + gn + (size_t)i * 1024 + d0);
                        }
                    }
                }
            } else if (c >= 1) {
                const int cc = c - 1;
                const char* bufp = lds + (cc & 1) * HG_BUF;
                const float* dec = (const float*)(bufp + HG_DEC_OFF);
                f32x16 X;
#pragma unroll
                for (int r = 0; r < 16; ++r) X[r] = 0.f;
                {
                    const char* ka = bufp + HG_KD_OFF + l31 * HG_ROW + 16 * h2;
                    const char* qa = bufp + HG_QD_OFF + l31 * HG_ROW + 16 * h2;
#pragma unroll 2
                    for (int ks = 0; ks < 8; ++ks) X = MFMA32(*(const bf16x8*)(ka + 32 * ks), *(const bf16x8*)(qa + 32 * ks), X);
#pragma unroll
                    for (int r = 0; r < 16; ++r) { const int srow = (r & 3) + 8 * (r >> 2) + 4 * h2; X[r] = (srow <= l31) ? X[r] : 0.f; }
                }
                f32x16 Oa;
#pragma unroll
                for (int r = 0; r < 16; ++r) Oa[r] = 0.f;
                const int jrow = 32 * pw + l31;
#pragma unroll
                for (int s2 = 0; s2 < 2; ++s2) {
                    uint4 xk;
                    xk.x = pack2(X[8 * s2], X[8 * s2 + 1]); xk.y = pack2(X[8 * s2 + 2], X[8 * s2 + 3]); xk.z = pack2(X[8 * s2 + 4], X[8 * s2 + 5]); xk.w = pack2(X[8 * s2 + 6], X[8 * s2 + 7]);
                    const char* va = bufp + HG_VT_OFF + jrow * HG_TROW + (16 * s2 + 4 * h2) * 2;
                    const uint2 lo = *(const uint2*)va, hi = *(const uint2*)(va + 16);
                    uint4 vb; vb.x = lo.x; vb.y = lo.y; vb.z = hi.x; vb.w = hi.y;
                    Oa = MFMA32(__builtin_bit_cast(bf16x8, xk), __builtin_bit_cast(bf16x8, vb), Oa);
                }
                auto qs_term = [&](const f32x16& St, int dt) {
#pragma unroll
                    for (int s2 = 0; s2 < 2; ++s2) {
                        uint4 sk;
                        sk.x = pack2(St[8 * s2], St[8 * s2 + 1]); sk.y = pack2(St[8 * s2 + 2], St[8 * s2 + 3]); sk.z = pack2(St[8 * s2 + 4], St[8 * s2 + 5]); sk.w = pack2(St[8 * s2 + 6], St[8 * s2 + 7]);
                        const char* qa = bufp + HG_QD_OFF + l31 * HG_ROW + (32 * dt + 16 * s2 + 4 * h2) * 2;
                        const uint2 lo = *(const uint2*)qa, hi = *(const uint2*)(qa + 16);
                        uint4 qb; qb.x = lo.x; qb.y = lo.y; qb.z = hi.x; qb.w = hi.y;
                        Oa = MFMA32(__builtin_bit_cast(bf16x8, qb), __builtin_bit_cast(bf16x8, sk), Oa);
                    }
                };
                __builtin_amdgcn_sched_barrier(0);
                qs_term(S0, 0); qs_term(S1, 1);
                __builtin_amdgcn_sched_barrier(0);
                qs_term(S2, 2); qs_term(S3, 3);
                __builtin_amdgcn_sched_barrier(0);
                {
                    bf16_t* orow = OR + (size_t)(b * SEQ + cc * 32 + 4 * h2) * 1024 + h * 128 + jrow;
#pragma unroll
                    for (int r = 0; r < 16; ++r) orow[(size_t)((r & 3) + 8 * (r >> 2)) * 1024] = f2bf(Oa[r]);
                }
                auto s_update = [&](f32x16& St, int dt) {
#pragma unroll
                    for (int rq = 0; rq < 4; ++rq) {
                        const f32x4 dc = *(const f32x4*)(dec + 32 * dt + 8 * rq + 4 * h2);
                        St[4 * rq] *= dc[0]; St[4 * rq + 1] *= dc[1]; St[4 * rq + 2] *= dc[2]; St[4 * rq + 3] *= dc[3];
                    }
#pragma unroll
                    for (int s2 = 0; s2 < 2; ++s2) {
                        const bf16x8 ka = *(const bf16x8*)(bufp + HG_K2T_OFF + (32 * dt + l31) * HG_TROW + (16 * s2 + 8 * h2) * 2);
                        const bf16x8 vb = *(const bf16x8*)(bufp + HG_VT_OFF + jrow * HG_TROW + (16 * s2 + 8 * h2) * 2);
                        St = MFMA32(ka, vb, St);
                    }
                };
                __builtin_amdgcn_sched_barrier(0);
                s_update(S0, 0); s_update(S1, 1);
                __builtin_amdgcn_sched_barrier(0);
                s_update(S2, 2); s_update(S3, 3);
                __builtin_amdgcn_sched_barrier(0);
            }
            __syncthreads();
        }
    }
}

__device__ __forceinline__ void phase_hgrn_post(const Params& p, const Ctx& cx) {
    const int lane = cx.lane;
    const bf16_t* OR = (const bf16_t*)(p.ws + OFF_HA);
    const bf16_t* Gt = (const bf16_t*)(p.ws + OFF_G);
    bf16_t* OA = (bf16_t*)(p.ws + OFF_QH);
    const int col = lane * 16;
    float gn[16];
#pragma unroll
    for (int i = 0; i < 16; ++i) gn[i] = p.hgrn_out_gain[(col & 127) + i];
    for (int row = cx.vbid * NWAVE + cx.wid; row < NTOK; row += cx.G * NWAVE) {
        const uint4 a0 = *(const uint4*)(OR + (size_t)row * 1024 + col), a1 = *(const uint4*)(OR + (size_t)row * 1024 + col + 8);
        const uint4 g0 = *(const uint4*)(Gt + (size_t)row * 1024 + col), g1 = *(const uint4*)(Gt + (size_t)row * 1024 + col + 8);
        const unsigned aw[8] = {a0.x, a0.y, a0.z, a0.w, a1.x, a1.y, a1.z, a1.w};
        const unsigned gw[8] = {g0.x, g0.y, g0.z, g0.w, g1.x, g1.y, g1.z, g1.w};
        float o[16];
        float ss = 0.f;
#pragma unroll
        for (int i = 0; i < 8; ++i) { o[2 * i] = bf2f((unsigned short)(aw[i] & 0xffff)); o[2 * i + 1] = bf2f((unsigned short)(aw[i] >> 16)); ss += o[2 * i] * o[2 * i] + o[2 * i + 1] * o[2 * i + 1]; }
        ss += __shfl_xor(ss, 1); ss += __shfl_xor(ss, 2); ss += __shfl_xor(ss, 4);
        const float r = rsqrtf(ss * (1.f / 128.f) + EPS);
        unsigned w[8];
#pragma unroll
        for (int i = 0; i < 8; ++i)
            w[i] = pack2(o[2 * i] * r * gn[2 * i] * bf2f((unsigned short)(gw[i] & 0xffff)), o[2 * i + 1] * r * gn[2 * i + 1] * bf2f((unsigned short)(gw[i] >> 16)));
        uint4 o0, o1; o0.x = w[0]; o0.y = w[1]; o0.z = w[2]; o0.w = w[3]; o1.x = w[4]; o1.y = w[5]; o1.z = w[6]; o1.w = w[7];
        *(uint4*)(OA + (size_t)row * 1024 + col) = o0;
        *(uint4*)(OA + (size_t)row * 1024 + col + 8) = o1;
    }
}


#define XB_TMO      128
#define XB_XCNT(j)  (256  + 64 * (j))
#define XB_XSUB(j)  (1280 + 64 * (j))
#define XB_XGEN(j)  (2304 + 64 * (j))
#define XB_TOP      3328
#define XB_TOPGEN   3392
#define XCD_BAR_WORDS 3456
#define XB_SPIN_CAP (1u << 20)
#define LAS __attribute__((address_space(3)))
__device__ __forceinline__ unsigned xb_ld(unsigned* p)              { return __hip_atomic_load(p, __ATOMIC_RELAXED, __HIP_MEMORY_SCOPE_AGENT); }
__device__ __forceinline__ unsigned xb_add(unsigned* p, unsigned v) { return __hip_atomic_fetch_add(p, v, __ATOMIC_RELAXED, __HIP_MEMORY_SCOPE_AGENT); }
__device__ __forceinline__ unsigned xb_xcc_id() { return (unsigned)__builtin_amdgcn_s_getreg((3 << 11) | 20) & 0xFu; }
#define XB_SPIN(cond, bar) do { unsigned _sp = 0; while (cond) { __builtin_amdgcn_s_sleep(1); \
    if ((++_sp & 255u) == 0u) { if (xb_ld(&(bar)[XB_TMO])) break; if (_sp > XB_SPIN_CAP) { atomicAdd(&(bar)[XB_TMO], 1u); break; } } } } while (0)
struct XcdBarrier { unsigned* bar; unsigned x; volatile unsigned* st; };
__device__ __forceinline__ XcdBarrier xcd_barrier_post(unsigned* bar, volatile unsigned* st) {
    XcdBarrier b; b.bar = bar; b.x = xb_xcc_id(); b.st = st;
    if (threadIdx.x == 0) (void)xb_add(&bar[XB_XCNT(b.x)], 1u);
    return b;
}
__device__ __forceinline__ void xcd_barrier_complete(unsigned* bar, unsigned x, unsigned& nloc, unsigned& nx) {
    const unsigned G = gridDim.x * gridDim.y * gridDim.z;
    unsigned sum, cnt, mine, sp = 0u;
    for (;;) {
        sum = 0u; cnt = 0u; mine = 0u;
#pragma unroll
        for (unsigned j = 0; j < 16; ++j) { const unsigned c = xb_ld(&bar[XB_XCNT(j)]); sum += c; cnt += (c > 0u) ? 1u : 0u; mine = (j == x) ? c : mine; }
        if (sum == G) break;
        __builtin_amdgcn_s_sleep(1);
        if ((++sp & 255u) == 0u) { if (xb_ld(&bar[XB_TMO])) break; if (sp > XB_SPIN_CAP) { atomicAdd(&bar[XB_TMO], 1u); break; } }
    }
    nloc = mine > 0u ? mine : 1u; nx = cnt > 0u ? cnt : 1u;
}
__device__ __forceinline__ void xcd_barrier(const XcdBarrier& b) {
    asm volatile("s_waitcnt vmcnt(0)" ::: "memory");
    __syncthreads();
    if (threadIdx.x == 0) {
        unsigned* bar = b.bar;
        __builtin_amdgcn_s_waitcnt(0);
        unsigned nloc = b.st[0], nx = b.st[1];
        if (nloc == 0u) { xcd_barrier_complete(bar, b.x, nloc, nx); b.st[0] = nloc; b.st[1] = nx; }
        const unsigned old = xb_add(&bar[XB_XSUB(b.x)], 1u);
        const unsigned gen = old / nloc;
        if (old + 1u == (gen + 1u) * nloc) {
            __builtin_amdgcn_fence(__ATOMIC_RELEASE, "agent");
            asm volatile("s_waitcnt vmcnt(0)" ::: "memory");
            const unsigned og = xb_add(&bar[XB_TOP], 1u);
            const unsigned tg = og / nx;
            if (og + 1u == (tg + 1u) * nx) xb_add(&bar[XB_TOPGEN], 1u);
            else XB_SPIN(xb_ld(&bar[XB_TOPGEN]) == tg, bar);
            __builtin_amdgcn_fence(__ATOMIC_ACQUIRE, "agent");
            xb_add(&bar[XB_XGEN(b.x)], 1u);
            asm volatile("s_waitcnt vmcnt(0)" ::: "memory");
        } else {
            XB_SPIN(xb_ld(&bar[XB_XGEN(b.x)]) == gen, bar);
            __builtin_amdgcn_fence(__ATOMIC_ACQUIRE, "agent");
            asm volatile("s_waitcnt vmcnt(0)" ::: "memory");
        }
    }
    __syncthreads();
}

template <int PH>
__device__ __forceinline__ void run_phase(const Params& p, const Ctx& cx, char* lds) {
    if constexpr (PH == 0) phase0(p, cx, lds);
    else if constexpr (PH == 1) rows_phase<false, true, false>(p, cx, lds, p.x, nullptr, 0, 0, 0, 0);
    else if constexpr (PH == 2) phase_nsa_inproj(p, cx, lds);
    else if constexpr (PH == 3) phase_cmp1(p, cx, lds);
    else if constexpr (PH == 4) phase_cmp2(p, cx);
    else if constexpr (PH == 5) phase_attn(p, cx, lds);
    else if constexpr (PH == 6) phase_outproj(p, cx, lds, (const bf16_t*)(p.ws + OFF_HA), (const bf16_t*)(p.ws + OFF_W_NSA_OUT), p.x, 0);
    else if constexpr (PH == 7) rows_router_phase(p, cx, lds, p.out, 1, 0);
    else if constexpr (PH == 8) phase_moe_up(p, cx, lds, 0);
    else if constexpr (PH == 9) phase_moe_down(p, cx, lds, 0);
    else if constexpr (PH == 10) rows_phase<true, true, false>(p, cx, lds, p.out, p.out, 1, 2, 0, 0);
    else if constexpr (PH == 11) phase_hgrn_inproj<0>(p, cx, lds);
    else if constexpr (PH == 12) phase_hgrn_rec(p, cx, lds);
    else if constexpr (PH == 13) phase_hgrn_post(p, cx);
    else if constexpr (PH == 14) phase_outproj(p, cx, lds, (const bf16_t*)(p.ws + OFF_QH), (const bf16_t*)(p.ws + OFF_W_HG_OUT), p.out, 2);
    else if constexpr (PH == 15) rows_router_phase(p, cx, lds, p.out, 3, 1);
    else if constexpr (PH == 16) phase_moe_up(p, cx, lds, 1);
    else if constexpr (PH == 17) phase_moe_down(p, cx, lds, 1);
    else if constexpr (PH == 18) rows_phase<true, false, false>(p, cx, lds, p.out, p.out, 3, 0, 0, 1);
}

__device__ __forceinline__ Ctx make_ctx() {
    Ctx cx;
    cx.G = gridDim.x; cx.tid = threadIdx.x; cx.wid = threadIdx.x >> 6; cx.lane = threadIdx.x & 63;
    cx.vbid = (cx.G % 8 == 0) ? (blockIdx.x % 8) * (cx.G / 8) + blockIdx.x / 8 : blockIdx.x;
    return cx;
}

#if MULTI_LAUNCH
template <int PH>
__global__ void __launch_bounds__(NTHR, 2) phase_kernel(Params p) {
    extern __shared__ __attribute__((aligned(16))) char lds[];
    const Ctx cx = make_ctx();
    run_phase<PH>(p, cx, lds);
}
template <int PH>
static void launch_phases(const Params& p, int grid, hipStream_t stream) {
    (void)hipFuncSetAttribute((const void*)phase_kernel<PH>, hipFuncAttributeMaxDynamicSharedMemorySize, LDS_BYTES);
    hipLaunchKernelGGL(phase_kernel<PH>, dim3(grid), dim3(NTHR), LDS_BYTES, stream, p);
    if constexpr (PH + 1 < NPHASE) launch_phases<PH + 1>(p, grid, stream);
}
#else
template <int PH>
__device__ __forceinline__ void run_from(const Params& p, const Ctx& cx, char* lds, cg::grid_group& grid, const XcdBarrier& xb) {
    {
        Ctx c2 = cx;
        asm volatile("" : "+v"(c2.tid), "+v"(c2.lane));
        run_phase<PH>(p, c2, lds);
#ifdef PROBE_MASK
        if constexpr ((PROBE_MASK >> PH) & 1) { xcd_barrier(xb); run_phase<PH>(p, c2, lds); }
#endif
    }
    if constexpr (PH + 1 < NPHASE) {
        if constexpr (PH == 0) grid.sync();
        else xcd_barrier(xb);
        run_from<PH + 1>(p, cx, lds, grid, xb);
    }
}
__global__ void __launch_bounds__(NTHR, 2) mega_kernel(Params p) {
    extern __shared__ __attribute__((aligned(16))) char lds[];
    cg::grid_group grid = cg::this_grid();
    const Ctx cx = make_ctx();
    volatile unsigned* st = (volatile unsigned*)(lds + LDS_BYTES - 16);
    if (threadIdx.x == 0) { st[0] = 0u; st[1] = 0u; }
    __syncthreads();
    const XcdBarrier xb = xcd_barrier_post((unsigned*)(p.ws + OFF_BAR), st);
    run_from<0>(p, cx, lds, grid, xb);
}
#endif

extern "C" void kernel_launch(void* const* d_in, const int* in_sizes, int n_in, void* d_out, int out_size, void* d_ws, size_t ws_size,
                              hipStream_t stream) {
    static int grid = 0;
    if (!grid) {
        int dev = 0, cus = 0, per_cu = 0;
        (void)hipGetDevice(&dev);
        (void)hipDeviceGetAttribute(&cus, hipDeviceAttributeMultiprocessorCount, dev);
#if MULTI_LAUNCH
        per_cu = 1;
#else
        (void)hipFuncSetAttribute((const void*)mega_kernel, hipFuncAttributeMaxDynamicSharedMemorySize, LDS_BYTES);
        (void)hipOccupancyMaxActiveBlocksPerMultiprocessor(&per_cu, mega_kernel, NTHR, LDS_BYTES);
        if (per_cu > 1) per_cu = 1;
        if (per_cu < 1) { fprintf(stderr, "kernel_launch: occupancy query says 0 blocks per CU (LDS %d B)\n", LDS_BYTES); per_cu = 1; }
#endif
        if (cus <= 0) cus = 256;
        grid = cus * per_cu;
        if (ws_size < WS_NEED) fprintf(stderr, "kernel_launch: workspace too small: %zu < %zu\n", ws_size, (size_t)WS_NEED);
    }
    Params p{};
    p.x = (const float*)d_in[0]; p.c = (const float*)d_in[1]; p.ada_w = (const float*)d_in[2]; p.ada_b = (const float*)d_in[3];
    p.norm_g = (const float*)d_in[4]; p.rel_bias = (const float*)d_in[5]; p.nsa_w_in = (const float*)d_in[6]; p.nsa_q_gain = (const float*)d_in[7];
    p.nsa_k_gain = (const float*)d_in[8]; p.nsa_cmp_pe = (const float*)d_in[9]; p.nsa_cmp_w1 = (const float*)d_in[10]; p.nsa_cmp_w2 = (const float*)d_in[11];
    p.nsa_w_out = (const float*)d_in[12]; p.hgrn_w_in = (const float*)d_in[13]; p.hgrn_lb = (const float*)d_in[14]; p.hgrn_out_gain = (const float*)d_in[15];
    p.hgrn_w_out = (const float*)d_in[16]; p.moe_rg = (const float*)d_in[17]; p.moe_re = (const float*)d_in[18]; p.moe_w1 = (const float*)d_in[19];
    p.moe_w3 = (const float*)d_in[20]; p.moe_w2 = (const float*)d_in[21];
    p.out = (float*)d_out; p.ws = (char*)d_ws;
#if MULTI_LAUNCH
    launch_phases<0>(p, grid, stream);
#else
    p.p_begin = 0; p.p_end = NPHASE;
    (void)hipMemsetAsync((char*)d_ws + OFF_BAR, 0, XCD_BAR_WORDS * 4, stream);
    void* args[] = {&p};
    hipError_t e = hipLaunchCooperativeKernel((void*)mega_kernel, dim3(grid), dim3(NTHR), args, LDS_BYTES, stream);
    if (e != hipSuccess) fprintf(stderr, "cooperative launch failed: %s (grid %d)\n", hipGetErrorString(e), grid);
#endif
}
```

```cpp
#include <hip/hip_runtime.h>
#include <hip/hip_cooperative_groups.h>
#include <cstdio>
#include <cstdint>
namespace cg = cooperative_groups;

#ifndef MULTI_LAUNCH
#define MULTI_LAUNCH 0
#endif

typedef unsigned short bf16_t;
typedef short bf16x8 __attribute__((ext_vector_type(8)));
typedef float f32x4 __attribute__((ext_vector_type(4)));
typedef float f32x16 __attribute__((ext_vector_type(16)));

constexpr int NTOK = 32768, DM = 1024, SEQ = 2048, NBATCH = 16;
constexpr int NSA_IN = 2608, NSA_IN_PAD = 2816;
constexpr float EPS = 1e-6f;
constexpr size_t MiB = 1ull << 20;

constexpr size_t OFF_CNT = 0;
constexpr size_t OFF_MOD = 4096;
constexpr size_t OFF_LB = OFF_MOD + 786432;
constexpr size_t OFF_PEB = OFF_LB + 4096;
constexpr size_t OFF_BAR = 921600;
constexpr size_t OFF_W_NSA_IN = 1 * MiB;
constexpr size_t OFF_W_NSA_OUT = OFF_W_NSA_IN + 2816ull * 1024 * 2;
constexpr size_t OFF_W_HG_IN = OFF_W_NSA_OUT + 1024ull * 1024 * 2;
constexpr size_t OFF_W_HG_OUT = OFF_W_HG_IN + 4096ull * 1024 * 2;
constexpr size_t OFF_W_CMP1 = OFF_W_HG_OUT + 1024ull * 1024 * 2;
constexpr size_t OFF_W_UP = OFF_W_CMP1 + 2ull * 128 * 2048 * 2;
constexpr size_t OFF_W_DN = OFF_W_UP + 32ull * 1024 * 1024 * 2;
constexpr size_t OFF_W_END = OFF_W_DN + 32ull * 1024 * 512 * 2;
constexpr size_t OFF_HA = 116 * MiB;
static_assert(OFF_W_END <= OFF_HA, "weights overflow");
constexpr size_t OFF_SCR = 180 * MiB;
constexpr size_t OFF_Q = OFF_SCR;
constexpr size_t OFF_KCRAW = OFF_Q + 64 * MiB;
constexpr size_t OFF_VCRAW = OFF_KCRAW + 17 * MiB;
constexpr size_t OFF_KS = OFF_VCRAW + 17 * MiB;
constexpr size_t OFF_VS = OFF_KS + 16 * MiB;
constexpr size_t OFF_KW = OFF_VS + 16 * MiB;
constexpr size_t OFF_VW = OFF_KW + 16 * MiB;
constexpr size_t OFF_GATES = OFF_VW + 16 * MiB;
constexpr size_t OFF_T1 = OFF_GATES + 6 * MiB;
constexpr size_t OFF_KC = OFF_T1 + 4 * MiB;
constexpr size_t OFF_VC = OFF_KC + 1 * MiB;
constexpr size_t OFF_H1 = OFF_SCR;
constexpr size_t OFF_Y = OFF_H1 + 64 * MiB;
constexpr size_t OFF_LTOK = OFF_Y + 128 * MiB;
constexpr size_t OFF_LW = OFF_LTOK + 2 * MiB;
constexpr size_t OFF_TSLOT = OFF_LW + 2 * MiB;
constexpr size_t OFF_QH = OFF_SCR;
constexpr size_t OFF_LF = OFF_QH + 64 * MiB;
constexpr size_t OFF_V = OFF_LF + 128 * MiB;
constexpr size_t OFF_G = OFF_V + 64 * MiB;
constexpr size_t WS_NEED = OFF_G + 64 * MiB;
static_assert(WS_NEED <= 512 * MiB, "ws overflow");

constexpr int NTHR = 512, NWAVE = 8;
constexpr int GEMM_STAGE = 49152, GEMM_NSTAGE = 3;
constexpr int LDS_TAB_OFF = GEMM_STAGE * GEMM_NSTAGE;
constexpr int LDS_BYTES = LDS_TAB_OFF + 256 + 16;
constexpr int NPHASE = 19;

struct Params {
    const float *x, *c, *ada_w, *ada_b, *norm_g, *rel_bias, *nsa_w_in, *nsa_q_gain, *nsa_k_gain, *nsa_cmp_pe, *nsa_cmp_w1,
        *nsa_cmp_w2, *nsa_w_out, *hgrn_w_in, *hgrn_lb, *hgrn_out_gain, *hgrn_w_out, *moe_rg, *moe_re, *moe_w1, *moe_w3, *moe_w2;
    float* out;
    char* ws;
    int p_begin, p_end;
};

__device__ __forceinline__ float bf2f(unsigned short h) { return __uint_as_float((unsigned)h << 16); }
__device__ __forceinline__ unsigned short f2bf(float f) {
    unsigned u = __float_as_uint(f);
    u += 0x7fffu + ((u >> 16) & 1u);
    return (unsigned short)(u >> 16);
}
typedef __bf16 bf2_t __attribute__((ext_vector_type(2)));
typedef float f2_t __attribute__((ext_vector_type(2)));
__device__ __forceinline__ unsigned pack2(float a, float b) {
    f2_t v = {a, b};
    return __builtin_bit_cast(unsigned, __builtin_convertvector(v, bf2_t));
}
typedef _Float16 h2_t __attribute__((ext_vector_type(2)));
__device__ __forceinline__ unsigned packh2(float a, float b) { f2_t v = {a, b}; return __builtin_bit_cast(unsigned, __builtin_convertvector(v, h2_t)); }
__device__ __forceinline__ f2_t unpackh2(unsigned u) { return __builtin_convertvector(__builtin_bit_cast(h2_t, u), f2_t); }
__device__ __forceinline__ float wave_sum(float v) {
#pragma unroll
    for (int o = 32; o; o >>= 1) v += __shfl_xor(v, o);
    return v;
}
__device__ __forceinline__ float wave_max(float v) {
#pragma unroll
    for (int o = 32; o; o >>= 1) v = fmaxf(v, __shfl_xor(v, o));
    return v;
}
__device__ __forceinline__ float silu_f(float x) { return x / (1.f + __expf(-x)); }
__device__ __forceinline__ float sigmoid_f(float x) { return 1.f / (1.f + __expf(-x)); }
__device__ __forceinline__ void glds16(const void* g, void* l) {
    __builtin_amdgcn_global_load_lds((const unsigned*)g, (unsigned*)l, 16, 0, 0);
}
__device__ __forceinline__ int t5_bucket(int n) {
    if (n < 16) return n;
    int b = 16;
    b += (n >= 21); b += (n >= 27); b += (n >= 35); b += (n >= 46); b += (n >= 59); b += (n >= 77); b += (n >= 99); b += (n >= 128);
    b += (n >= 166); b += (n >= 216); b += (n >= 280); b += (n >= 363); b += (n >= 470); b += (n >= 609); b += (n >= 790);
    return b;
}

struct Ctx {
    int G, vbid, tid, wid, lane;
};

constexpr int P0_MOD_ITEMS = 192;
constexpr int TS0 = 88 * 16, TS1 = 32 * 16, TS2 = 128 * 16, TS3 = 32 * 16, TS4 = 2 * 4 * 32, TS5 = 32 * 32 * 16, TS6 = 32 * 32 * 8;
constexpr int TC0 = 0, TC1 = TC0 + TS0, TC2 = TC1 + TS1, TC3 = TC2 + TS2, TC4 = TC3 + TS3, TC5 = TC4 + TS4, TC6 = TC5 + TS5, TC_END = TC6 + TS6;

struct TrJob { const float* src; int ld, c0, ncols_valid, k0; bf16_t* dst; int dstld; };
__device__ __forceinline__ void tr_load(const TrJob& j, float* tl, int htid) {
    const int k = htid >> 2, cc = (htid & 3) * 8;
    const float* s = j.src + (size_t)(j.k0 + k) * j.ld + j.c0 + cc;
    f32x4 a = {0.f, 0.f, 0.f, 0.f}, c = a;
    if (j.c0 + 32 <= j.ncols_valid) { a = *(const f32x4*)s; c = *(const f32x4*)(s + 4); }
    else {
#pragma unroll
        for (int i = 0; i < 4; ++i) { if (j.c0 + cc + i < j.ncols_valid) a[i] = s[i]; if (j.c0 + cc + 4 + i < j.ncols_valid) c[i] = s[4 + i]; }
    }
#pragma unroll
    for (int i = 0; i < 4; ++i) { tl[k * 33 + cc + i] = a[i]; tl[k * 33 + cc + 4 + i] = c[i]; }
}
__device__ __forceinline__ void tr_store(const TrJob& j, const float* tl, int htid) {
    const int n = htid >> 3, kc = (htid & 7) * 8;
    uint4 o;
    o.x = pack2(tl[(kc + 0) * 33 + n], tl[(kc + 1) * 33 + n]); o.y = pack2(tl[(kc + 2) * 33 + n], tl[(kc + 3) * 33 + n]);
    o.z = pack2(tl[(kc + 4) * 33 + n], tl[(kc + 5) * 33 + n]); o.w = pack2(tl[(kc + 6) * 33 + n], tl[(kc + 7) * 33 + n]);
    *(uint4*)(j.dst + (size_t)n * j.dstld + kc) = o;
}
__device__ __forceinline__ TrJob tr_job(const Params& p, int tt) {
    TrJob j;
    if (tt < TC1) {
        const int nt = tt / 16, kt = tt % 16;
        j = {p.nsa_w_in, NSA_IN, nt * 32, NSA_IN, kt * 64, (bf16_t*)(p.ws + OFF_W_NSA_IN) + (size_t)nt * 32 * 1024 + kt * 64, 1024};
    } else if (tt < TC2) {
        const int u = tt - TC1, nt = u / 16, kt = u % 16;
        j = {p.nsa_w_out, 1024, nt * 32, 1024, kt * 64, (bf16_t*)(p.ws + OFF_W_NSA_OUT) + (size_t)nt * 32 * 1024 + kt * 64, 1024};
    } else if (tt < TC3) {
        const int u = tt - TC2, nt = u / 16, kt = u % 16;
        j = {p.hgrn_w_in, 4096, nt * 32, 4096, kt * 64, (bf16_t*)(p.ws + OFF_W_HG_IN) + (size_t)nt * 32 * 1024 + kt * 64, 1024};
    } else if (tt < TC4) {
        const int u = tt - TC3, nt = u / 16, kt = u % 16;
        j = {p.hgrn_w_out, 1024, nt * 32, 1024, kt * 64, (bf16_t*)(p.ws + OFF_W_HG_OUT) + (size_t)nt * 32 * 1024 + kt * 64, 1024};
    } else if (tt < TC5) {
        const int u = tt - TC4, kv = u / 128, r = u % 128, nt = r / 32, kt = r % 32;
        j = {p.nsa_cmp_w1 + (size_t)kv * 2048 * 64, 64, nt * 32, 64, kt * 64, (bf16_t*)(p.ws + OFF_W_CMP1) + ((size_t)kv * 128 + nt * 32) * 2048 + kt * 64, 2048};
    } else if (tt < TC6) {
        const int u = tt - TC5, le = u / 512, r = u % 512, gr = r / 16, kt = r % 16;
        const int t = gr >> 2, wc = (gr >> 1) & 1, which = gr & 1;
        const float* src = (which ? p.moe_w3 : p.moe_w1) + (size_t)le * 1024 * 512;
        j = {src, 512, (t * 2 + wc) * 32, 512, kt * 64, (bf16_t*)(p.ws + OFF_W_UP) + ((size_t)le * 1024 + gr * 32) * 1024 + kt * 64, 1024};
    } else {
        const int u = tt - TC6, le = u / 256, r = u % 256, nt = r / 8, kt = r % 8;
        j = {p.moe_w2 + (size_t)le * 512 * 1024, 1024, nt * 32, 1024, kt * 64, (bf16_t*)(p.ws + OFF_W_DN) + ((size_t)le * 1024 + nt * 32) * 512 + kt * 64, 512};
    }
    return j;
}

__device__ __forceinline__ void phase0(const Params& p, const Ctx& cx, char* lds) {
    const int tid = cx.tid, wid = cx.wid, lane = cx.lane;
    for (int it = cx.vbid; it < P0_MOD_ITEMS; it += cx.G) {
        const int colbase = it * 64, ls = colbase / 3072, e0 = colbase % 3072;
        const float* W = p.ada_w + (size_t)ls * 1024 * 3072 + e0 + lane;
        float* cs = (float*)lds + wid * 1024;
        float* red = (float*)lds + 8192;
        float acc[16];
#pragma unroll
        for (int b = 0; b < 16; ++b) acc[b] = 0.f;
        for (int sub = 0; sub < 2; ++sub) {
            const int kb = wid * 128 + sub * 64;
#pragma unroll
            for (int b = 0; b < 16; ++b) cs[lane * 16 + b] = silu_f(p.c[b * 1024 + kb + lane]);
            __builtin_amdgcn_wave_barrier();
#pragma unroll 1
            for (int k16 = 0; k16 < 64; k16 += 16) {
                float wv[16];
#pragma unroll
                for (int u = 0; u < 16; ++u) wv[u] = W[(size_t)(kb + k16 + u) * 3072];
#pragma unroll
                for (int u = 0; u < 16; ++u) {
                    const float w = wv[u];
                    const f32x4* cv = (const f32x4*)(cs + (k16 + u) * 16);
#pragma unroll
                    for (int q = 0; q < 4; ++q) {
                        f32x4 c4 = cv[q];
                        acc[q * 4 + 0] += c4[0] * w; acc[q * 4 + 1] += c4[1] * w; acc[q * 4 + 2] += c4[2] * w; acc[q * 4 + 3] += c4[3] * w;
                    }
                }
            }
            __builtin_amdgcn_wave_barrier();
        }
#pragma unroll
        for (int b = 0; b < 16; ++b) red[(wid * 16 + b) * 64 + lane] = acc[b];
        __syncthreads();
        float* mod = (float*)(p.ws + OFF_MOD);
#pragma unroll
        for (int i = 0; i < 2; ++i) {
            const int o = tid + i * NTHR, b = o >> 6, e = o & 63;
            float sm = 0.f;
#pragma unroll
            for (int w = 0; w < 8; ++w) sm += red[(w * 16 + b) * 64 + e];
            mod[((size_t)ls * 16 + b) * 3072 + e0 + e] = sm + p.ada_b[ls * 3072 + e0 + e];
        }
        __syncthreads();
    }
    {
        constexpr int TPH = 4;
        const int half = tid >> 8, htid = tid & 255;
        float* tl = (float*)lds + half * (TPH * 64 * 33);
        for (int base = cx.vbid * 2 * TPH; base < TC_END; base += cx.G * 2 * TPH) {
#pragma unroll
            for (int q = 0; q < TPH; ++q) {
                const int tt = base + half * TPH + q;
                if (tt < TC_END) { const TrJob j = tr_job(p, tt); tr_load(j, tl + q * (64 * 33), htid); }
            }
            __syncthreads();
#pragma unroll
            for (int q = 0; q < TPH; ++q) {
                const int tt = base + half * TPH + q;
                if (tt < TC_END) { const TrJob j = tr_job(p, tt); tr_store(j, tl + q * (64 * 33), htid); }
            }
            __syncthreads();
        }
    }
    if (cx.vbid == cx.G - 1) {
        float* lb = (float*)(p.ws + OFF_LB);
        for (int i = tid; i < 1024; i += NTHR) lb[i] = sigmoid_f(p.hgrn_lb[1024 + i] - p.hgrn_lb[i]);
        if (tid < 128) {
            const int kv = tid >> 6, d = tid & 63;
            const float* pe = p.nsa_cmp_pe + kv * 2048;
            const float* w1 = p.nsa_cmp_w1 + (size_t)kv * 2048 * 64 + d;
            float sm = 0.f;
            for (int k = 0; k < 2048; ++k) sm += pe[k] * w1[(size_t)k * 64];
            ((float*)(p.ws + OFF_PEB))[tid] = sm;
        }
        if (tid < 32) ((int*)(p.ws + OFF_CNT))[tid] = 0;
    }
}

template <bool COMBINE, bool NORM, bool ROUTER>
__device__ __forceinline__ void rows_phase(const Params& p, const Ctx& cx, char* lds, const float* __restrict__ src, float* __restrict__ xdst,
                           int ls_comb, int ls_norm, int layer_router, int layer_comb) {
    static_assert(!ROUTER, "router rows use rows_router_phase");
    const int lane = cx.lane;
    const float* mod = (const float*)(p.ws + OFF_MOD);
    int my_off = 0;
    if (COMBINE) {
        const int* cnt = (const int*)(p.ws + OFF_CNT) + layer_comb * 16;
        int cv = (lane < 16) ? cnt[lane] : 0;
        int incl = cv;
#pragma unroll
        for (int o = 1; o < 16; o <<= 1) { int t = __shfl_up(incl, o); if (lane >= o) incl += t; }
        my_off = incl - cv;
    }
    const int rpw = (NTOK + cx.G * NWAVE - 1) / (cx.G * NWAVE);
    const int row_begin = (cx.vbid * NWAVE + cx.wid) * rpw, row_end = min(NTOK, row_begin + rpw);
    if (row_begin >= row_end) return;
    const bf16_t* Y = (const bf16_t*)(p.ws + OFF_Y);
    const int* tsl = (const int*)(p.ws + OFF_TSLOT);
    bf16_t* hA = (bf16_t*)(p.ws + OFF_HA);
    const float* gain = p.norm_g + ls_norm * 1024;
    auto yrow = [&](int sw) -> size_t { return (size_t)(__shfl(my_off, sw >> 16) + (sw & 0xffff)) * 1024; };
    f32x4 vn[4];
    uint2 yan[4], ycn[4];
    int t0n = 0, t1n = 0;
#pragma unroll
    for (int i = 0; i < 4; ++i) vn[i] = *(const f32x4*)(src + (size_t)row_begin * 1024 + (i * 64 + lane) * 4);
    if (COMBINE) {
        const size_t ra = yrow(tsl[row_begin * 2]), rc = yrow(tsl[row_begin * 2 + 1]);
#pragma unroll
        for (int i = 0; i < 4; ++i) { yan[i] = *(const uint2*)(Y + ra + (i * 64 + lane) * 4); ycn[i] = *(const uint2*)(Y + rc + (i * 64 + lane) * 4); }
        if (row_begin + 1 < row_end) { t0n = tsl[(row_begin + 1) * 2]; t1n = tsl[(row_begin + 1) * 2 + 1]; }
    }
    f32x4 gt[4], ca[4], cb[4];
    int bcur = -1;
    for (int row = row_begin; row < row_end; ++row) {
        const int b = row >> 11;
        if (b != bcur) {
            bcur = b;
#pragma unroll
            for (int i = 0; i < 4; ++i) {
                const int col = (i * 64 + lane) * 4;
                if (COMBINE) gt[i] = *(const f32x4*)(mod + ((size_t)ls_comb * 16 + b) * 3072 + 2048 + col);
                if (NORM) {
                    const float* shift = mod + ((size_t)ls_norm * 16 + b) * 3072;
                    const f32x4 g = *(const f32x4*)(gain + col), sc = *(const f32x4*)(shift + 1024 + col);
                    ca[i] = g * (sc + 1.f);
                    cb[i] = *(const f32x4*)(shift + col);
                }
            }
        }
        f32x4 v[4];
        uint2 ya[4], yc[4];
#pragma unroll
        for (int i = 0; i < 4; ++i) { v[i] = vn[i]; if (COMBINE) { ya[i] = yan[i]; yc[i] = ycn[i]; } }
        if (row + 1 < row_end) {
#pragma unroll
            for (int i = 0; i < 4; ++i) vn[i] = *(const f32x4*)(src + (size_t)(row + 1) * 1024 + (i * 64 + lane) * 4);
            if (COMBINE) {
                const size_t ra = yrow(t0n), rc = yrow(t1n);
#pragma unroll
                for (int i = 0; i < 4; ++i) { yan[i] = *(const uint2*)(Y + ra + (i * 64 + lane) * 4); ycn[i] = *(const uint2*)(Y + rc + (i * 64 + lane) * 4); }
                if (row + 2 < row_end) { t0n = tsl[(row + 2) * 2]; t1n = tsl[(row + 2) * 2 + 1]; }
            }
        }
        if (COMBINE) {
#pragma unroll
            for (int i = 0; i < 4; ++i) {
                const int col = (i * 64 + lane) * 4;
                v[i][0] += gt[i][0] * (bf2f(ya[i].x & 0xffff) + bf2f(yc[i].x & 0xffff));
                v[i][1] += gt[i][1] * (bf2f(ya[i].x >> 16) + bf2f(yc[i].x >> 16));
                v[i][2] += gt[i][2] * (bf2f(ya[i].y & 0xffff) + bf2f(yc[i].y & 0xffff));
                v[i][3] += gt[i][3] * (bf2f(ya[i].y >> 16) + bf2f(yc[i].y >> 16));
                *(f32x4*)(xdst + (size_t)row * 1024 + col) = v[i];
            }
        }
        if (NORM) {
            float ss = 0.f;
#pragma unroll
            for (int i = 0; i < 4; ++i) ss += v[i][0] * v[i][0] + v[i][1] * v[i][1] + v[i][2] * v[i][2] + v[i][3] * v[i][3];
            ss = wave_sum(ss);
            const float r = rsqrtf(ss * (1.f / 1024.f) + EPS);
#pragma unroll
            for (int i = 0; i < 4; ++i) {
                const int col = (i * 64 + lane) * 4;
                f32x4 h;
#pragma unroll
                for (int j = 0; j < 4; ++j) h[j] = v[i][j] * r * ca[i][j] + cb[i][j];
                uint2 o; o.x = pack2(h[0], h[1]); o.y = pack2(h[2], h[3]);
                *(uint2*)(hA + (size_t)row * 1024 + col) = o;
            }
        }
    }
}

__device__ __forceinline__ void rows_router_phase(const Params& p, const Ctx& cx, char* lds, const float* __restrict__ src, int ls_norm, int layer) {
    const int lane = cx.lane, tid = cx.tid;
    const int widu = __builtin_amdgcn_readfirstlane(cx.wid);
    const int wq = widu & 3, grp4 = widu >> 2;
    const float* mod = (const float*)(p.ws + OFF_MOD);
    const float* rg = p.moe_rg + (size_t)layer * 1024 * 4;
    const float* re = p.moe_re + (size_t)layer * 1024 * 16;
    float* logit_s = (float*)lds;
    float wr[16][5];
#pragma unroll
    for (int i = 0; i < 4; ++i)
#pragma unroll
        for (int j = 0; j < 4; ++j) {
            const int k = (i * 64 + lane) * 4 + j;
#pragma unroll
            for (int q = 0; q < 5; ++q) {
                const int o = 5 * wq + q;
                wr[i * 4 + j][q] = (o < 4) ? rg[k * 4 + o] : re[k * 16 + o - 4];
            }
            __builtin_amdgcn_sched_barrier(0);
        }
    const float* gain = p.norm_g + ls_norm * 1024;
    bf16_t* hA = (bf16_t*)(p.ws + OFF_HA);
    int* lcnt = (int*)(lds + 16384);
    if (tid < 32) lcnt[tid] = 0;
    int nstep = 0;
    for (int blk = cx.vbid; blk < NTOK / 32; blk += cx.G, ++nstep) {
        const int R0 = blk * 32, b = R0 >> 11;
        const float* shift = mod + ((size_t)ls_norm * 16 + b) * 3072;
        const float* scale = shift + 1024;
        f32x4 ca[4], cb[4];
#pragma unroll
        for (int i = 0; i < 4; ++i) {
            const int col = (i * 64 + lane) * 4;
            const f32x4 g = *(const f32x4*)(gain + col), sc = *(const f32x4*)(scale + col);
            ca[i] = g * (sc + 1.f);
            cb[i] = *(const f32x4*)(shift + col);
        }
        const float* srow = src + (size_t)(R0 + grp4 * 16) * 1024 + lane * 4;
        f32x4 vnA[4], vnB[4];
#pragma unroll
        for (int i = 0; i < 4; ++i) { vnA[i] = *(const f32x4*)(srow + i * 256); vnB[i] = *(const f32x4*)(srow + 1024 + i * 256); }
#pragma unroll 1
        for (int r = 0; r < 16; r += 2) {
            const int rlA = grp4 * 16 + r;
            f32x4 vA[4], vB[4];
#pragma unroll
            for (int i = 0; i < 4; ++i) { vA[i] = vnA[i]; vB[i] = vnB[i]; }
            if (r < 14) {
#pragma unroll
                for (int i = 0; i < 4; ++i) { vnA[i] = *(const f32x4*)(srow + (size_t)(r + 2) * 1024 + i * 256); vnB[i] = *(const f32x4*)(srow + (size_t)(r + 3) * 1024 + i * 256); }
            }
            float ssA = 0.f, ssB = 0.f;
#pragma unroll
            for (int i = 0; i < 4; ++i) {
                ssA += vA[i][0] * vA[i][0] + vA[i][1] * vA[i][1] + vA[i][2] * vA[i][2] + vA[i][3] * vA[i][3];
                ssB += vB[i][0] * vB[i][0] + vB[i][1] * vB[i][1] + vB[i][2] * vB[i][2] + vB[i][3] * vB[i][3];
            }
#pragma unroll
            for (int o = 32; o; o >>= 1) { ssA += __shfl_xor(ssA, o); ssB += __shfl_xor(ssB, o); }
            const float rrA = rsqrtf(ssA * (1.f / 1024.f) + EPS), rrB = rsqrtf(ssB * (1.f / 1024.f) + EPS);
            float accA[5] = {0.f, 0.f, 0.f, 0.f, 0.f}, accB[5] = {0.f, 0.f, 0.f, 0.f, 0.f};
#pragma unroll
            for (int i = 0; i < 4; ++i) {
                const int col = (i * 64 + lane) * 4;
                f32x4 hA_, hB_;
#pragma unroll
                for (int j = 0; j < 4; ++j) {
                    hA_[j] = vA[i][j] * rrA * ca[i][j] + cb[i][j];
                    hB_[j] = vB[i][j] * rrB * ca[i][j] + cb[i][j];
#pragma unroll
                    for (int q = 0; q < 5; ++q) { accA[q] += hA_[j] * wr[i * 4 + j][q]; accB[q] += hB_[j] * wr[i * 4 + j][q]; }
                }
                if ((r & 3) == wq) { uint2 o; o.x = pack2(hA_[0], hA_[1]); o.y = pack2(hA_[2], hA_[3]); *(uint2*)(hA + (size_t)(R0 + rlA) * 1024 + col) = o; }
                if (((r + 1) & 3) == wq) { uint2 o; o.x = pack2(hB_[0], hB_[1]); o.y = pack2(hB_[2], hB_[3]); *(uint2*)(hA + (size_t)(R0 + rlA + 1) * 1024 + col) = o; }
            }
#pragma unroll
            for (int o = 32; o; o >>= 1) {
#pragma unroll
                for (int q = 0; q < 5; ++q) { accA[q] += __shfl_xor(accA[q], o); accB[q] += __shfl_xor(accB[q], o); }
            }
            if (lane == 0) {
#pragma unroll
                for (int q = 0; q < 5; ++q) { logit_s[(nstep * 32 + rlA) * 20 + 5 * wq + q] = accA[q]; logit_s[(nstep * 32 + rlA + 1) * 20 + 5 * wq + q] = accB[q]; }
            }
        }
    }
    __syncthreads();
    const int nrows = nstep * 32;
    int ea = 0, eb = 0, la = 0, lb_ = 0, row = 0; float wa = 0.f, wb = 0.f;
    if (tid < nrows) {
        row = (cx.vbid + (tid >> 5) * cx.G) * 32 + (tid & 31);
        const float* rl = logit_s + tid * 20;
        const float gm = fmaxf(fmaxf(rl[0], rl[1]), fmaxf(rl[2], rl[3]));
        const float gs = __expf(rl[0] - gm) + __expf(rl[1] - gm) + __expf(rl[2] - gm) + __expf(rl[3] - gm);
        int grp = 0; float best = rl[0];
        if (rl[1] > best) { best = rl[1]; grp = 1; }
        if (rl[2] > best) { best = rl[2]; grp = 2; }
        if (rl[3] > best) { best = rl[3]; grp = 3; }
        const float pg = __expf(best - gm) / gs;
        const f32x4 lsel = *(const f32x4*)(rl + 4 + 4 * grp);
        const float l0 = lsel[0], l1 = lsel[1], l2 = lsel[2], l3 = lsel[3];
        const float em = fmaxf(fmaxf(l0, l1), fmaxf(l2, l3));
        const float q0 = __expf(l0 - em), q1 = __expf(l1 - em), q2 = __expf(l2 - em), q3 = __expf(l3 - em);
        int i1 = 0; float b1 = q0;
        if (q1 > b1) { b1 = q1; i1 = 1; }
        if (q2 > b1) { b1 = q2; i1 = 2; }
        if (q3 > b1) { b1 = q3; i1 = 3; }
        int i2 = -1; float b2 = -1.f;
        if (i1 != 0 && q0 > b2) { b2 = q0; i2 = 0; }
        if (i1 != 1 && q1 > b2) { b2 = q1; i2 = 1; }
        if (i1 != 2 && q2 > b2) { b2 = q2; i2 = 2; }
        if (i1 != 3 && q3 > b2) { b2 = q3; i2 = 3; }
        const float inv = pg / (b1 + b2);
        ea = grp * 4 + i1; eb = grp * 4 + i2; wa = b1 * inv; wb = b2 * inv;
        la = atomicAdd(lcnt + ea, 1);
        lb_ = atomicAdd(lcnt + eb, 1);
    }
    __syncthreads();
    if (tid < 16) lcnt[16 + tid] = atomicAdd((int*)(p.ws + OFF_CNT) + layer * 16 + tid, lcnt[tid]);
    __syncthreads();
    if (tid < nrows) {
        int* ltok = (int*)(p.ws + OFF_LTOK);
        float* lw = (float*)(p.ws + OFF_LW);
        int* ts = (int*)(p.ws + OFF_TSLOT) + row * 2;
        const int pa = lcnt[16 + ea] + la, pb = lcnt[16 + eb] + lb_;
        ltok[(size_t)ea * NTOK + pa] = row; lw[(size_t)ea * NTOK + pa] = wa;
        ltok[(size_t)eb * NTOK + pb] = row; lw[(size_t)eb * NTOK + pb] = wb;
        ts[0] = (ea << 16) | pa; ts[1] = (eb << 16) | pb;
    }
    __syncthreads();
}

__device__ __forceinline__ int stage_col(int tid) { return ((tid & 7) ^ ((tid >> 3) & 7)) * 8; }

template <class Epi>
__device__ __forceinline__ void gemm_tile(const bf16_t* const (&ap)[4], const bf16_t* const (&bp)[2], int K, char* lds, const Ctx& cx, Epi&& epi) {
    const int tid = cx.tid, lane = cx.lane, wr = cx.wid >> 1, wc = cx.wid & 1, fr = lane & 15, fq = lane >> 4;
    f32x4 acc[4][4];
#pragma unroll
    for (int m = 0; m < 4; ++m)
#pragma unroll
        for (int n = 0; n < 4; ++n) acc[m][n] = (f32x4){0.f, 0.f, 0.f, 0.f};
    const int nt = K / 64;
    auto stage = [&](int t, int slot) {
        char* SA = lds + slot * GEMM_STAGE + tid * 16; char* SB = SA + 32768;
        const int ko = t * 64;
#pragma unroll
        for (int i = 0; i < 4; ++i) glds16(ap[i] + ko, SA + i * 8192);
#pragma unroll
        for (int i = 0; i < 2; ++i) glds16(bp[i] + ko, SB + i * 8192);
    };
    __syncthreads();
    stage(0, 0);
    if (nt > 1) stage(1, 1);
    const int x7 = fr & 7;
    const int aoff = (wr * 64 + fr) * 128, boff = 32768 + (wc * 64 + fr) * 128;
    int slot = 0;
    for (int kt = 0; kt < nt; ++kt) {
        if (kt + 1 < nt) asm volatile("s_waitcnt vmcnt(6)" ::: "memory");
        else asm volatile("s_waitcnt vmcnt(0)" ::: "memory");
        __builtin_amdgcn_s_barrier();
        if (kt + 2 < nt) stage(kt + 2, slot >= 1 ? slot - 1 : 2);
        const char* S = lds + slot * GEMM_STAGE;
#pragma unroll
        for (int ks = 0; ks < 2; ++ks) {
            const int pc = ((ks * 4 + fq) ^ x7) * 16;
            bf16x8 Af[4], Bf[4];
#pragma unroll
            for (int m = 0; m < 4; ++m) Af[m] = *(const bf16x8*)(S + aoff + m * 2048 + pc);
#pragma unroll
            for (int n = 0; n < 4; ++n) Bf[n] = *(const bf16x8*)(S + boff + n * 2048 + pc);
#pragma unroll
            for (int m = 0; m < 4; ++m)
#pragma unroll
                for (int n = 0; n < 4; ++n) acc[m][n] = __builtin_amdgcn_mfma_f32_16x16x32_bf16(Bf[n], Af[m], acc[m][n], 0, 0, 0);
        }
        slot = slot == 2 ? 0 : slot + 1;
    }
    epi(acc, wr, wc, fr, fq);
}

__device__ __forceinline__ int swz_g(int q) { return (0x1320 >> (4 * q)) & 3; }
__device__ __forceinline__ int stage_col2(int tid) { return ((tid & 3) ^ swz_g((tid >> 4) & 3)) * 8; }

template <int MODE = 0, class Epi>
__device__ __forceinline__ void gemm_tile2(const bf16_t* const (&ap)[2], const bf16_t* const (&bp)[2], int K, char* lds, const Ctx& cx, Epi&& epi) {
    const int tid = cx.tid, lane = cx.lane, wc = cx.wid & 3, fr = lane & 15, fq = lane >> 4;
    const int wr = __builtin_amdgcn_readfirstlane(cx.wid >> 2);
    f32x4 acc[8][4];
#pragma unroll
    for (int m = 0; m < 8; ++m)
#pragma unroll
        for (int n = 0; n < 4; ++n) acc[m][n] = (f32x4){0.f, 0.f, 0.f, 0.f};
    const int nt = K / 32;
    auto stage = [&](int t) {
        char* SA = lds + (t & 3) * 32768 + tid * 16; char* SB = SA + 16384;
        const int ko = t * 32;
        glds16(ap[0] + ko, SA); glds16(ap[1] + ko, SA + 8192);
        glds16(bp[0] + ko, SB); glds16(bp[1] + ko, SB + 8192);
    };
    __syncthreads();
    stage(0);
    if (nt > 1) stage(1);
    if (nt > 2) stage(2);
    const int pc = (fq ^ swz_g((fr >> 2) & 3)) * 16;
    const int aoff = (wr * 128 + fr) * 64 + pc, boff = 16384 + (wc * 64 + fr) * 64 + pc;
    bf16x8 Af[8], Bf[4];
    auto load_frags = [&](int kt) {
        const char* S = lds + (kt & 3) * 32768;
#pragma unroll
        for (int n = 0; n < 4; ++n) Bf[n] = *(const bf16x8*)(S + boff + n * 1024);
#pragma unroll
        for (int m = 0; m < 8; ++m) Af[m] = *(const bf16x8*)(S + aoff + m * 1024);
        asm volatile("s_waitcnt lgkmcnt(0)" ::: "memory");
    };
    auto mma = [&]() {
        __builtin_amdgcn_s_setprio(1);
#pragma unroll
        for (int m = 0; m < 8; ++m)
#pragma unroll
            for (int n = 0; n < 4; ++n) acc[m][n] = __builtin_amdgcn_mfma_f32_16x16x32_bf16(Bf[n], Af[m], acc[m][n], 0, 0, 0);
        __builtin_amdgcn_s_setprio(0);
    };
    if (nt > 2) asm volatile("s_waitcnt vmcnt(8)" ::: "memory");
    else if (nt == 2) asm volatile("s_waitcnt vmcnt(4)" ::: "memory");
    else asm volatile("s_waitcnt vmcnt(0)" ::: "memory");
    if (wr == 1) __builtin_amdgcn_s_barrier();
    for (int kt = 0; kt < nt; ++kt) {
        const int rem = nt - 1 - kt;
        if (rem >= 2) asm volatile("s_waitcnt vmcnt(8)" ::: "memory");
        else if (rem == 1) asm volatile("s_waitcnt vmcnt(4)" ::: "memory");
        else asm volatile("s_waitcnt vmcnt(0)" ::: "memory");
        __builtin_amdgcn_s_barrier();
        if (kt + 3 < nt) stage(kt + 3);
        load_frags(kt);
        if (rem >= 3) asm volatile("s_waitcnt vmcnt(8)" ::: "memory");
        else if (rem == 2) asm volatile("s_waitcnt vmcnt(4)" ::: "memory");
        else asm volatile("s_waitcnt vmcnt(0)" ::: "memory");
        __builtin_amdgcn_s_barrier();
        mma();
    }
    if (wr == 0) __builtin_amdgcn_s_barrier();
    if (MODE == 0) epi(acc, wr, wc, fr, fq);
    else {
#pragma unroll
        for (int m = 0; m < 8; ++m)
#pragma unroll
            for (int n = 0; n < 4; ++n) asm volatile("" :: "v"(acc[m][n]));
    }
}

template <class GetFn, class EpiFn>
__device__ __forceinline__ void gemm_stream2(int my_tiles, int K, char* lds, const Ctx& cx, GetFn&& get, EpiFn&& epi) {
    if (my_tiles <= 0) return;
    const int tid = cx.tid, lane = cx.lane, wc = cx.wid & 3, fr = lane & 15, fq = lane >> 4;
    const int wr = __builtin_amdgcn_readfirstlane(cx.wid >> 2);
    f32x4 acc[8][4];
#pragma unroll
    for (int m = 0; m < 8; ++m)
#pragma unroll
        for (int n = 0; n < 4; ++n) acc[m][n] = (f32x4){0.f, 0.f, 0.f, 0.f};
    const int nt = K / 32, S = my_tiles * nt;
    const bf16_t* sap[2]; const bf16_t* sbp[2];
    int sj = 0, skt = 0, sg = 0;
    get(0, sap, sbp);
    auto stage_next = [&]() {
        char* SA = lds + (sg & 3) * 32768 + tid * 16; char* SB = SA + 16384;
        const int ko = skt * 32;
        glds16(sap[0] + ko, SA); glds16(sap[1] + ko, SA + 8192);
        glds16(sbp[0] + ko, SB); glds16(sbp[1] + ko, SB + 8192);
        ++sg; ++skt;
        if (skt == nt) { skt = 0; ++sj; if (sj < my_tiles) get(sj, sap, sbp); }
    };
    __syncthreads();
    stage_next();
    if (S > 1) stage_next();
    if (S > 2) stage_next();
    const int pc = (fq ^ swz_g((fr >> 2) & 3)) * 16;
    const int aoff = (wr * 128 + fr) * 64 + pc, boff = 16384 + (wc * 64 + fr) * 64 + pc;
    bf16x8 Af[8], Bf[4];
    int g = 0;
    for (int cj = 0; cj < my_tiles; ++cj) {
        {
            const int rem0 = S - 1 - g;
            if (rem0 >= 2) asm volatile("s_waitcnt vmcnt(8)" ::: "memory");
            else if (rem0 == 1) asm volatile("s_waitcnt vmcnt(4)" ::: "memory");
            else asm volatile("s_waitcnt vmcnt(0)" ::: "memory");
        }
        if (wr == 1) __builtin_amdgcn_s_barrier();
        for (int kt = 0; kt < nt; ++kt, ++g) {
            const int rem = S - 1 - g;
            if (rem >= 2) asm volatile("s_waitcnt vmcnt(8)" ::: "memory");
            else if (rem == 1) asm volatile("s_waitcnt vmcnt(4)" ::: "memory");
            else asm volatile("s_waitcnt vmcnt(0)" ::: "memory");
            __builtin_amdgcn_s_barrier();
            if (g + 3 < S) stage_next();
            {
                const char* Sx = lds + (g & 3) * 32768;
#pragma unroll
                for (int n = 0; n < 4; ++n) Bf[n] = *(const bf16x8*)(Sx + boff + n * 1024);
#pragma unroll
                for (int m = 0; m < 8; ++m) Af[m] = *(const bf16x8*)(Sx + aoff + m * 1024);
                asm volatile("s_waitcnt lgkmcnt(0)" ::: "memory");
            }
            if (rem >= 3) asm volatile("s_waitcnt vmcnt(8)" ::: "memory");
            else if (rem == 2) asm volatile("s_waitcnt vmcnt(4)" ::: "memory");
            else asm volatile("s_waitcnt vmcnt(0)" ::: "memory");
            __builtin_amdgcn_s_barrier();
            __builtin_amdgcn_s_setprio(1);
#pragma unroll
            for (int m = 0; m < 8; ++m)
#pragma unroll
                for (int n = 0; n < 4; ++n) acc[m][n] = __builtin_amdgcn_mfma_f32_16x16x32_bf16(Bf[n], Af[m], acc[m][n], 0, 0, 0);
            __builtin_amdgcn_s_setprio(0);
        }
        if (wr == 0) __builtin_amdgcn_s_barrier();
        epi(cj, acc, wr, wc, fr, fq);
#pragma unroll
        for (int m = 0; m < 8; ++m)
#pragma unroll
            for (int n = 0; n < 4; ++n) acc[m][n] = (f32x4){0.f, 0.f, 0.f, 0.f};
    }
}

template <int MODE = 0, class EpiFactory>
__device__ __forceinline__ void gemm_phase_dense2(const bf16_t* A, int lda, const bf16_t* Bt, int K, int nrt, int nct, char* lds, const Ctx& cx, EpiFactory&& mk) {
    const int tid = cx.tid;
    const int ntiles = nrt * nct;
    const int sc = stage_col2(tid), sr = tid >> 2;
    const int my_tiles = cx.vbid < ntiles ? (ntiles - cx.vbid + cx.G - 1) / cx.G : 0;
    const int vb = cx.vbid, G = cx.G;
    gemm_stream2(my_tiles, K, lds, cx,
        [=](int j, const bf16_t* (&ap)[2], const bf16_t* (&bp)[2]) {
            const int tile = vb + j * G, rt = tile / nct, ct = tile % nct;
            ap[0] = A + (size_t)(rt * 256 + sr) * lda + sc; ap[1] = ap[0] + (size_t)128 * lda;
            bp[0] = Bt + (size_t)(ct * 256 + sr) * K + sc; bp[1] = bp[0] + (size_t)128 * K;
        },
        [=](int j, f32x4 (&acc)[8][4], int wr, int wc, int fr, int fq) {
            const int tile = vb + j * G, rt = tile / nct, ct = tile % nct;
            mk(rt * 256, ct * 256)(acc, wr, wc, fr, fq);
        });
}

__device__ __forceinline__ void phase_nsa_inproj(const Params& p, const Ctx& cx, char* lds) {
    const bf16_t* A = (const bf16_t*)(p.ws + OFF_HA);
    const bf16_t* Bt = (const bf16_t*)(p.ws + OFF_W_NSA_IN);
    char* ws = p.ws;
    const float* qg = p.nsa_q_gain;
    const float* kg = p.nsa_k_gain;
    gemm_phase_dense2(A, 1024, Bt, 1024, NTOK / 256, NSA_IN_PAD / 256, lds, cx, [=](int row0, int col0) {
        return [=](f32x4 (&acc)[8][4], int wr, int wc, int fr, int fq) {
            const int gc0 = col0 + wc * 64;
            if (gc0 >= NSA_IN) return;
            if (gc0 < 1024 || (gc0 >= 1536 && gc0 < 1792) || (gc0 >= 2048 && gc0 < 2304)) {
                const float* gain; float post; bf16_t* dstb; size_t rstride; size_t coff; bool tokmajor;
                if (gc0 < 1024) { gain = qg; post = 0.125f * 1.4426950408889634f; }
                else if (gc0 < 1792) { gain = kg + 64; post = 1.f; }
                else { gain = kg + 128; post = 1.f; }
#pragma unroll
                for (int m = 0; m < 8; ++m) {
                    __builtin_amdgcn_sched_barrier(0);
                    float ss = 0.f;
#pragma unroll
                    for (int n = 0; n < 4; ++n) ss += acc[m][n][0] * acc[m][n][0] + acc[m][n][1] * acc[m][n][1] + acc[m][n][2] * acc[m][n][2] + acc[m][n][3] * acc[m][n][3];
                    ss += __shfl_xor(ss, 16); ss += __shfl_xor(ss, 32);
                    const float r = rsqrtf(ss * (1.f / 64.f) + EPS) * post;
                    const int row = row0 + wr * 128 + m * 16 + fr;
                    bf16_t* dst;
                    if (gc0 < 1024) dst = (bf16_t*)(ws + OFF_Q) + (size_t)row * 1024 + gc0;
                    else {
                        const int g = ((gc0 - 1024) & 255) >> 6, b = row >> 11, t = row & 2047;
                        dst = (bf16_t*)(ws + (gc0 < 1792 ? OFF_KS : OFF_KW)) + ((size_t)(b * 4 + g) * 2048 + t) * 64;
                    }
#pragma unroll
                    for (int n = 0; n < 4; ++n) {
                        const int c = n * 16 + fq * 4;
                        f32x4 g4 = *(const f32x4*)(gain + c);
                        uint2 o; o.x = pack2(acc[m][n][0] * r * g4[0], acc[m][n][1] * r * g4[1]); o.y = pack2(acc[m][n][2] * r * g4[2], acc[m][n][3] * r * g4[3]);
                        *(uint2*)(dst + c) = o;
                    }
                }
            } else if (gc0 < 2560) {
                const int seg = (gc0 - 1024) >> 8;
                const int g = ((gc0 - 1024) & 255) >> 6;
                if (seg < 2) {
                    const size_t off = seg == 0 ? OFF_KCRAW : OFF_VCRAW;
#pragma unroll
                    for (int m = 0; m < 8; ++m) {
                        __builtin_amdgcn_sched_barrier(0);
                    __builtin_amdgcn_sched_barrier(0);
                        const int row = row0 + wr * 128 + m * 16 + fr, b = row >> 11, t = row & 2047;
                        bf16_t* dst = (bf16_t*)(ws + off) + ((size_t)(b * 4 + g) * 2048 + t) * 64;
#pragma unroll
                        for (int n = 0; n < 4; ++n) {
                            const int c = n * 16 + fq * 4;
                            uint2 o; o.x = pack2(acc[m][n][0], acc[m][n][1]); o.y = pack2(acc[m][n][2], acc[m][n][3]);
                            *(uint2*)(dst + c) = o;
                        }
                    }
                } else {
                    const size_t off = seg == 3 ? OFF_VS : OFF_VW;
#pragma unroll
                    for (int m = 0; m < 8; ++m) {
                        __builtin_amdgcn_sched_barrier(0);
                    __builtin_amdgcn_sched_barrier(0);
                        const int row = row0 + wr * 128 + m * 16 + fr, b = row >> 11, t = row & 2047;
                        bf16_t* dst = (bf16_t*)(ws + off) + (size_t)(b * 4 + g) * 64 * 2048 + t;
#pragma unroll
                        for (int n = 0; n < 4; ++n)
#pragma unroll
                            for (int j = 0; j < 4; ++j) dst[(size_t)(n * 16 + fq * 4 + j) * 2048] = f2bf(acc[m][n][j]);
                    }
                }
            } else {
#pragma unroll
                for (int m = 0; m < 8; ++m) {
                    __builtin_amdgcn_sched_barrier(0);
                    const int row = row0 + wr * 128 + m * 16 + fr;
                    float* dst = (float*)(ws + OFF_GATES) + (size_t)row * 48;
#pragma unroll
                    for (int n = 0; n < 3; ++n) {
                        const int c = n * 16 + fq * 4;
                        f32x4 o;
#pragma unroll
                        for (int j = 0; j < 4; ++j) o[j] = sigmoid_f(acc[m][n][j]);
                        *(f32x4*)(dst + c) = o;
                    }
                }
            }
        };
    });
}

__device__ __forceinline__ void phase_cmp1(const Params& p, const Ctx& cx, char* lds) {
    const int tid = cx.tid;
    const float* peb = (const float*)(p.ws + OFF_PEB);
    float* T1 = (float*)(p.ws + OFF_T1);
    const int sc = stage_col(tid), sr = tid >> 3;
    for (int tile = cx.vbid; tile < 64; tile += cx.G) {
        const int kv = tile >> 5, bg2 = tile & 31;
        const bf16_t* raw = (const bf16_t*)(p.ws + (kv ? OFF_VCRAW : OFF_KCRAW)) + (size_t)bg2 * 2 * 2048 * 64;
        const bf16_t* a0 = raw + (size_t)sr * 1024 + sc;
        const bf16_t* a2 = raw + (size_t)2048 * 64 + (size_t)sr * 1024 + sc;
        const bf16_t* b0 = (const bf16_t*)(p.ws + OFF_W_CMP1) + ((size_t)kv * 128 + sr) * 2048 + sc;
        const bf16_t* const ap[4] = {a0, a0 + (size_t)64 * 1024, a2, a2 + (size_t)64 * 1024};
        const bf16_t* const bp[2] = {b0, b0 + (size_t)64 * 2048};
        gemm_tile(ap, bp, 2048, lds, cx, [=](f32x4 (&acc)[4][4], int wr, int wc, int fr, int fq) {
            if (wc != 0) return;
#pragma unroll
            for (int m = 0; m < 4; ++m) {
                const int r = wr * 64 + m * 16 + fr;
                float* dst = T1 + ((size_t)kv * 8192 + (bg2 * 2 + (r >> 7)) * 128 + (r & 127)) * 64;
#pragma unroll
                for (int n = 0; n < 4; ++n) {
                    const int c = n * 16 + fq * 4;
                    f32x4 pb = *(const f32x4*)(peb + kv * 64 + c);
                    *(f32x4*)(dst + c) = acc[m][n] + pb;
                }
            }
        });
    }
}

__device__ __forceinline__ void phase_cmp2(const Params& p, const Ctx& cx) {
    const int lane = cx.lane;
    const float* T1 = (const float*)(p.ws + OFF_T1);
    for (int r = cx.vbid * NWAVE + cx.wid; r < 2 * 8192; r += cx.G * NWAVE) {
        const int kv = r >> 13, rr = r & 8191, n_ = rr & 127;
        const float s = silu_f(T1[(size_t)r * 64 + lane]);
        const float* w2 = p.nsa_cmp_w2 + kv * 4096 + lane;
        float o = 0.f;
#pragma unroll 8
        for (int j = 0; j < 64; ++j) o += __shfl(s, j) * w2[j * 64];
        if (kv == 0) {
            const float ss = wave_sum(o * o);
            o = o * rsqrtf(ss * (1.f / 64.f) + EPS) * p.nsa_k_gain[lane];
        }
        if (n_ == 127) o = 0.f;
        if (kv == 0) ((bf16_t*)(p.ws + OFF_KC))[(size_t)rr * 64 + lane] = f2bf(o);
        else ((bf16_t*)(p.ws + OFF_VC))[((size_t)(rr >> 7) * 64 + lane) * 128 + n_] = f2bf(o);
    }
}

constexpr int ATT_BUF = 17920, ATT_K_STRIDE = 144, ATT_V_OFF = 9216, ATT_V_STRIDE = 136, ATT_LUT_OFF = 2 * ATT_BUF, LUT_N = 2136, LUT_PAD = 80;
constexpr int ATT_SC_OFF = ATT_LUT_OFF + 4 * LUT_N * 4;
static_assert(ATT_SC_OFF + NWAVE * 8192 <= LDS_TAB_OFF, "attention LDS");
#define MFMA32(a, b, c) __builtin_amdgcn_mfma_f32_32x32x16_bf16((a), (b), (c), 0, 0, 0)
template <int V> struct IC { static constexpr int value = V; };

__device__ __forceinline__ void phase_attn(const Params& p, const Ctx& cx, char* lds) {
    const int tid = cx.tid, lane = cx.lane, wid = cx.wid;
    const int g = cx.vbid & 3;
    const int ql = lane & 7, head = (lane & 31) >> 3, h2 = lane >> 5, l31 = lane & 31;
    float* lut = (float*)(lds + ATT_LUT_OFF);
    for (int i = tid; i < 4 * LUT_N; i += NTHR) {
        const int h = i / LUT_N, dist = i % LUT_N - LUT_PAD;
        lut[i] = dist >= 0 ? p.rel_bias[t5_bucket(dist) * 16 + g * 4 + h] * 1.4426950408889634f : 0.f;
    }
    __syncthreads();
    const float* lutp = lut + head * LUT_N + LUT_PAD;
    const float b31 = lutp[2047];
    const bf16_t* Qb = (const bf16_t*)(p.ws + OFF_Q);
    const bf16_t* KC = (const bf16_t*)(p.ws + OFF_KC);
    const bf16_t* VCT = (const bf16_t*)(p.ws + OFF_VC);
    const bf16_t* KS = (const bf16_t*)(p.ws + OFF_KS);
    const bf16_t* VST = (const bf16_t*)(p.ws + OFF_VS);
    const bf16_t* KW = (const bf16_t*)(p.ws + OFF_KW);
    const bf16_t* VWT = (const bf16_t*)(p.ws + OFF_VW);
    const float* GT = (const float*)(p.ws + OFF_GATES);
    bf16_t* Og = (bf16_t*)(p.ws + OFF_HA);
    float* scw = (float*)(lds + ATT_SC_OFF) + wid * 2048;
    f32x4* outw = (f32x4*)(lds + ATT_SC_OFF + wid * 8192) + lane;
    const bool flip_ok = (cx.G % 128) == 0;
    const int widu = __builtin_amdgcn_readfirstlane(wid);

    for (int it = 0;; ++it) {
        const int u = cx.vbid + it * cx.G;
        if (u >= 2048) break;
        const int rest = u >> 2, b = rest >> 5, qtb = rest & 31;
        const int qt = (flip_ok && (it & 1)) ? 31 - qtb : qtb;
        const int t0 = qt * 64, cur = qt, bg = b * 4 + g;
        const int tq = t0 + wid * 8 + ql;
        const size_t rowtok = (size_t)b * SEQ + tq;
        bf16x8 Qf[4];
        {
            const bf16_t* qp = Qb + rowtok * 1024 + (g * 4 + head) * 64 + 8 * h2;
#pragma unroll
            for (int ks = 0; ks < 4; ++ks) Qf[ks] = *(const bf16x8*)(qp + 16 * ks);
        }
        const float* gt = GT + rowtok * 48 + (g * 4 + head) * 3;
        const float gate_c = gt[0], gate_s = gt[1], gate_w = gt[2];
        const int wlo = max(0, qt - 8);
        const int nW = cur - wlo + 1;
        const int ncp = (t0 + 63 >= 31 + 16 * 64) ? 2 : 1;
        const int NC = ncp;
        const int NT = NC + nW + cur + 1;

        uint4 kr0, vr0;
        auto issue_load = [&](int i) {
            const bf16_t* ksrc; const bf16_t* vsrc; int vstride;
            if (i < NC) { const int ci = i; ksrc = KC + ((size_t)bg * 128 + ci * 64) * 64; vsrc = VCT + (size_t)bg * 64 * 128 + ci * 64; vstride = 128; }
            else if (i < NC + nW) { const int kb = wlo + i - NC; ksrc = KW + ((size_t)bg * 2048 + kb * 64) * 64; vsrc = VWT + (size_t)bg * 64 * 2048 + kb * 64; vstride = 2048; }
            else { const int kb = i - NC - nW; ksrc = KS + ((size_t)bg * 2048 + kb * 64) * 64; vsrc = VST + (size_t)bg * 64 * 2048 + kb * 64; vstride = 2048; }
            kr0 = *(const uint4*)(ksrc + tid * 8);
            vr0 = *(const uint4*)(vsrc + (size_t)(tid >> 3) * vstride + (tid & 7) * 8);
        };
        auto write_lds = [&](int i) {
            char* bufp = lds + (i & 1) * ATT_BUF;
            *(uint4*)(bufp + (tid >> 3) * ATT_K_STRIDE + (tid & 7) * 16) = kr0;
            char* va = bufp + ATT_V_OFF + (tid >> 3) * ATT_V_STRIDE + (tid & 7) * 16;
            uint2 t;
            t.x = vr0.x; t.y = vr0.y; *(uint2*)va = t;
            t.x = vr0.z; t.y = vr0.w; *(uint2*)(va + 8) = t;
        };
        f32x16 O0, O1;
#pragma unroll
        for (int r = 0; r < 16; ++r) { O0[r] = 0.f; O1[r] = 0.f; }
        float lsum = 0.f;

        auto qk = [&](const char* bufp, int kt2, float init) -> f32x16 {
            f32x16 S;
#pragma unroll
            for (int r = 0; r < 16; ++r) S[r] = init;
            const char* kp = bufp + (32 * kt2 + l31) * ATT_K_STRIDE + 16 * h2;
            bf16x8 kf[4];
#pragma unroll
            for (int ks = 0; ks < 4; ++ks) kf[ks] = *(const bf16x8*)(kp + 32 * ks);
            __builtin_amdgcn_sched_barrier(0);
#pragma unroll
            for (int ks = 0; ks < 4; ++ks) S = MFMA32(kf[ks], Qf[ks], S);
            return S;
        };
        auto pv = [&](const char* bufp, int kt2, const f32x16& P) {
            const char* vp = bufp + ATT_V_OFF + l31 * ATT_V_STRIDE + (32 * kt2 + 4 * h2) * 2;
            uint2 va[2][2][2];
#pragma unroll
            for (int s2 = 0; s2 < 2; ++s2)
#pragma unroll
                for (int dt = 0; dt < 2; ++dt) {
                    va[s2][dt][0] = *(const uint2*)(vp + dt * 32 * ATT_V_STRIDE + s2 * 32);
                    va[s2][dt][1] = *(const uint2*)(vp + dt * 32 * ATT_V_STRIDE + s2 * 32 + 16);
                }
            __builtin_amdgcn_sched_barrier(0);
#pragma unroll
            for (int s2 = 0; s2 < 2; ++s2) {
                uint4 pk;
                pk.x = pack2(P[8 * s2 + 0], P[8 * s2 + 1]); pk.y = pack2(P[8 * s2 + 2], P[8 * s2 + 3]);
                pk.z = pack2(P[8 * s2 + 4], P[8 * s2 + 5]); pk.w = pack2(P[8 * s2 + 6], P[8 * s2 + 7]);
                const bf16x8 Pf = __builtin_bit_cast(bf16x8, pk);
                uint4 a0, a1;
                a0.x = va[s2][0][0].x; a0.y = va[s2][0][0].y; a0.z = va[s2][0][1].x; a0.w = va[s2][0][1].y;
                a1.x = va[s2][1][0].x; a1.y = va[s2][1][0].y; a1.z = va[s2][1][1].x; a1.w = va[s2][1][1].y;
                O0 = MFMA32(__builtin_bit_cast(bf16x8, a0), Pf, O0);
                O1 = MFMA32(__builtin_bit_cast(bf16x8, a1), Pf, O1);
            }
        };
        auto finalize = [&](float gate, int mode) {
            const float Z = lsum + __shfl_xor(lsum, 32);
            const float f = Z > 0.f ? gate / Z : 0.f;
#pragma unroll
            for (int v4 = 0; v4 < 4; ++v4) {
                f32x4 a = {f * O0[4 * v4], f * O0[4 * v4 + 1], f * O0[4 * v4 + 2], f * O0[4 * v4 + 3]};
                f32x4 c = {f * O1[4 * v4], f * O1[4 * v4 + 1], f * O1[4 * v4 + 2], f * O1[4 * v4 + 3]};
                if (mode != 0) { a += outw[v4 * 64]; c += outw[(4 + v4) * 64]; }
                if (mode != 2) { outw[v4 * 64] = a; outw[(4 + v4) * 64] = c; }
                else { O0[4 * v4] = a[0]; O0[4 * v4 + 1] = a[1]; O0[4 * v4 + 2] = a[2]; O0[4 * v4 + 3] = a[3];
                       O1[4 * v4] = c[0]; O1[4 * v4 + 1] = c[1]; O1[4 * v4 + 2] = c[2]; O1[4 * v4 + 3] = c[3]; }
            }
            if (mode != 2) {
#pragma unroll
                for (int r = 0; r < 16; ++r) { O0[r] = 0.f; O1[r] = 0.f; }
            }
            lsum = 0.f;
        };
        auto tile_ws = [&](const char* bufp, int kb, float cinit, auto MMc, auto BMc) {
            constexpr int MM = decltype(MMc)::value, BM = decltype(BMc)::value;
#pragma unroll 1
            for (int kt2 = 0; kt2 < 2; ++kt2) {
                const int d0 = tq - (64 * kb + 32 * kt2 + 4 * h2);
                const float* lp = lutp + (d0 - 27);
                float bv[16];
                if (BM == 0) {
#pragma unroll
                    for (int r = 0; r < 16; ++r) bv[r] = lp[27 - ((r & 3) + 8 * (r >> 2))];
                    __builtin_amdgcn_sched_barrier(0);
                }
                f32x16 S = qk(bufp, kt2, cinit);
#pragma unroll
                for (int r = 0; r < 16; ++r) {
                    const int cr = (r & 3) + 8 * (r >> 2);
                    float x = S[r];
                    if (BM == 0) x += bv[r];
                    if (MM == 1) x += (d0 - cr < 512) ? 0.f : -INFINITY;
                    if (MM == 2) x += (d0 - cr >= 0) ? 0.f : -INFINITY;
                    S[r] = __builtin_amdgcn_exp2f(x);
                    lsum += S[r];
                }
                pv(bufp, kt2, S);
            }
        };

        const int nvis = (tq >= 31) ? min((tq - 31) / 16 + 1, 127) : 0;
        unsigned selmask = 0u;
        float* sown = scw + (head * 8 + ql) * 32;
        float* stail = scw + 1024 + (head * 8 + ql) * 32;
        float* ssc = scw + ql * 32;
        issue_load(0);
        __syncthreads();
        write_lds(0);
        issue_load(1);
        for (int i = 0; i < NT; ++i) {
            __syncthreads();
            const char* bufp = lds + (i & 1) * ATT_BUF;
            if (i < NC) {
                const int ci = i;
#pragma unroll 1
                for (int kt2 = 0; kt2 < 2; ++kt2) {
                    const int n0 = 64 * ci + 32 * kt2 + 4 * h2;
                    const int d0 = tq - 31 - 16 * n0;
                    float bv[16];
#pragma unroll
                    for (int r = 0; r < 16; ++r) bv[r] = lutp[max(d0 - 16 * ((r & 3) + 8 * (r >> 2)), -LUT_PAD)];
                    __builtin_amdgcn_sched_barrier(0);
                    f32x16 S = qk(bufp, kt2, 0.f);
#pragma unroll
                    for (int r = 0; r < 16; ++r) {
                        const int cr = (r & 3) + 8 * (r >> 2);
                        S[r] = __builtin_amdgcn_exp2f(S[r] + bv[r] + ((n0 + cr) < nvis ? 0.f : -INFINITY));
                        lsum += S[r];
                    }
                    pv(bufp, kt2, S);
#pragma unroll
                    for (int rq = 0; rq < 4; ++rq) {
                        const int sblk = 8 * (2 * ci + kt2) + 2 * rq + h2;
                        sown[sblk] = S[4 * rq] + S[4 * rq + 1] + S[4 * rq + 2] + 0.5f * S[4 * rq + 3];
                        if (sblk < 31) stail[sblk + 1] = 0.5f * S[4 * rq + 3];
                    }
                }
                if (i == NC - 1) {
                    const float Z = lsum + __shfl_xor(lsum, 32);
                    const float inv_mine = Z > 0.f ? 1.f / Z : 0.f;
                    if (h2 == 0) stail[0] = 0.f;
                    __builtin_amdgcn_wave_barrier();
                    const int j8 = head * 2 + h2;
                    {
                        f32x4 sc = {0.f, 0.f, 0.f, 0.f};
#pragma unroll
                        for (int hh = 0; hh < 4; ++hh) {
                            const float invh = __shfl(inv_mine, hh * 8 + ql);
                            const f32x4 a = *(const f32x4*)(scw + (hh * 8 + ql) * 32 + 4 * j8), t4 = *(const f32x4*)(scw + 1024 + (hh * 8 + ql) * 32 + 4 * j8);
                            sc += (a + t4) * invh;
                        }
#pragma unroll
                        for (int q = 0; q < 4; ++q) {
                            const int sblk = 4 * j8 + q;
                            const bool forced = (sblk == 0) || (sblk == cur) || (sblk == cur - 1);
                            sc[q] = forced ? 1.0e4f : (sblk <= cur ? sc[q] : -1.0f);
                        }
                        __builtin_amdgcn_wave_barrier();
                        *(f32x4*)(ssc + 4 * j8) = sc;
                    }
                    __builtin_amdgcn_wave_barrier();
                    const f32x4 own = *(const f32x4*)(ssc + 4 * j8);
                    int rk0 = 0, rk1 = 0, rk2 = 0, rk3 = 0;
                    const int so0 = 4 * j8;
#pragma unroll
                    for (int m4 = 0; m4 < 8; ++m4) {
                        const f32x4 v = *(const f32x4*)(ssc + 4 * m4);
#pragma unroll
                        for (int q = 0; q < 4; ++q) {
                            const int sm = 4 * m4 + q;
                            const float vm = v[q];
                            rk0 += (vm > own[0] || (vm == own[0] && sm < so0)) ? 1 : 0;
                            rk1 += (vm > own[1] || (vm == own[1] && sm < so0 + 1)) ? 1 : 0;
                            rk2 += (vm > own[2] || (vm == own[2] && sm < so0 + 2)) ? 1 : 0;
                            rk3 += (vm > own[3] || (vm == own[3] && sm < so0 + 3)) ? 1 : 0;
                        }
                    }
                    unsigned mk = ((rk0 < 8 ? 1u : 0u) | (rk1 < 8 ? 2u : 0u) | (rk2 < 8 ? 4u : 0u) | (rk3 < 8 ? 8u : 0u)) << so0;
                    mk |= __shfl_xor(mk, 8); mk |= __shfl_xor(mk, 16); mk |= __shfl_xor(mk, 32);
                    selmask = mk;
                    __builtin_amdgcn_wave_barrier();
                    finalize(gate_c, 0);
                }
            } else if (i < NC + nW) {
                const int kb = wlo + i - NC;
                if (kb == cur) tile_ws(bufp, kb, 0.f, IC<2>{}, IC<0>{});
                else if (kb == cur - 8) tile_ws(bufp, kb, 0.f, IC<1>{}, IC<0>{});
                else tile_ws(bufp, kb, 0.f, IC<0>{}, IC<0>{});
                if (i == NC - 1 + nW) finalize(gate_w, 1);
            } else {
                const int kb = i - NC - nW;
                const bool sel = ((selmask >> kb) & 1u) != 0;
                if (__ballot(sel) != 0ull) {
                    const float neg = sel ? 0.f : -INFINITY;
                    if (kb == cur) tile_ws(bufp, kb, neg, IC<2>{}, IC<0>{});
                    else if (t0 + 8 * widu - (64 * kb + 63) >= 790) tile_ws(bufp, kb, neg + b31, IC<0>{}, IC<1>{});
                    else tile_ws(bufp, kb, neg, IC<0>{}, IC<0>{});
                }
            }
            if (i + 1 < NT) {
                write_lds(i + 1);
                if (i + 2 < NT) issue_load(i + 2);
            }
        }
        finalize(gate_s, 2);
        {
            bf16_t* op = Og + rowtok * 1024 + (g * 4 + head) * 64 + 4 * h2;
#pragma unroll
            for (int rq = 0; rq < 4; ++rq) {
                uint2 o0; o0.x = pack2(O0[4 * rq], O0[4 * rq + 1]); o0.y = pack2(O0[4 * rq + 2], O0[4 * rq + 3]);
                uint2 o1; o1.x = pack2(O1[4 * rq], O1[4 * rq + 1]); o1.y = pack2(O1[4 * rq + 2], O1[4 * rq + 3]);
                *(uint2*)(op + 8 * rq) = o0;
                *(uint2*)(op + 32 + 8 * rq) = o1;
            }
        }
    }
}

__device__ __forceinline__ void phase_outproj(const Params& p, const Ctx& cx, char* lds, const bf16_t* A, const bf16_t* Bt, const float* xin, int ls) {
    const float* mod = (const float*)(p.ws + OFF_MOD);
    float* xo = p.out;
    gemm_phase_dense2(A, 1024, Bt, 1024, NTOK / 256, 4, lds, cx, [=](int row0, int col0) {
        return [=](f32x4 (&acc)[8][4], int wr, int wc, int fr, int fq) {
            const int b = row0 >> 11;
            const float* gate = mod + ((size_t)ls * 16 + b) * 3072 + 2048 + col0 + wc * 64 + fq * 4;
            f32x4 g[4];
#pragma unroll
            for (int n = 0; n < 4; ++n) g[n] = *(const f32x4*)(gate + n * 16);
#pragma unroll
            for (int m2 = 0; m2 < 8; m2 += 2) {
                f32x4 xi[2][4];
#pragma unroll
                for (int mm = 0; mm < 2; ++mm)
#pragma unroll
                    for (int n = 0; n < 4; ++n)
                        xi[mm][n] = *(const f32x4*)(xin + (size_t)(row0 + wr * 128 + (m2 + mm) * 16 + fr) * 1024 + col0 + wc * 64 + n * 16 + fq * 4);
                __builtin_amdgcn_sched_barrier(0);
#pragma unroll
                for (int mm = 0; mm < 2; ++mm)
#pragma unroll
                    for (int n = 0; n < 4; ++n) {
                        f32x4 o;
#pragma unroll
                        for (int j = 0; j < 4; ++j) o[j] = xi[mm][n][j] + g[n][j] * acc[m2 + mm][n][j];
                        *(f32x4*)(xo + (size_t)(row0 + wr * 128 + (m2 + mm) * 16 + fr) * 1024 + col0 + wc * 64 + n * 16 + fq * 4) = o;
                    }
                __builtin_amdgcn_sched_barrier(0);
            }
        };
    });
}

__device__ __forceinline__ void moe_tables(const Params& p, int layer, int tid, int* s_cnt, int* s_off, int* s_toff) {
    __syncthreads();
    if (tid == 0) {
        const int* cnt = (const int*)(p.ws + OFF_CNT) + layer * 16;
        int o = 0, to = 0;
        for (int e = 0; e < 16; ++e) { const int c = cnt[e]; s_cnt[e] = c; s_off[e] = o; s_toff[e] = to; o += c; to += ((c + 255) >> 8) * 4; }
        s_off[16] = o; s_toff[16] = to;
    }
    __syncthreads();
}

constexpr int LDS_ROWIDX_OFF = 131072, LDS_LW_OFF = 131072 + 8192;
static_assert(LDS_LW_OFF + 8192 <= LDS_TAB_OFF, "moe caches");

__device__ __forceinline__ void phase_moe_up(const Params& p, const Ctx& cx, char* lds, int layer) {
    const int tid = cx.tid;
    int* s_cnt = (int*)(lds + LDS_TAB_OFF); int* s_off = s_cnt + 16; int* s_toff = s_off + 17;
    moe_tables(p, layer, tid, s_cnt, s_off, s_toff);
    const int ntiles = s_toff[16];
    const bf16_t* hA = (const bf16_t*)(p.ws + OFF_HA);
    const int* ltok = (const int*)(p.ws + OFF_LTOK);
    bf16_t* H1 = (bf16_t*)(p.ws + OFF_H1);
    int* rowidx = (int*)(lds + LDS_ROWIDX_OFF);
    const int sc = stage_col2(tid), sr = tid >> 2;
    const int vb = cx.vbid, G = cx.G;
    const int my_tiles = min(8, vb < ntiles ? (ntiles - vb + G - 1) / G : 0);
    auto locate = [=](int j, int& e, int& rt, int& ct) { const int tile = vb + j * G; e = 0; while (tile >= s_toff[e + 1]) ++e; const int lt = tile - s_toff[e]; rt = lt >> 2; ct = lt & 3; };
    for (int i = tid; i < my_tiles * 256; i += NTHR) {
        const int j = i >> 8, r = i & 255; int e, rt, ct; locate(j, e, rt, ct);
        rowidx[i] = ltok[(size_t)e * NTOK + min(rt * 256 + r, s_cnt[e] - 1)];
    }
    __syncthreads();
    const bf16_t* Wup = (const bf16_t*)(p.ws + OFF_W_UP) + (size_t)layer * 16 * 1024 * 1024;
    gemm_stream2(my_tiles, 1024, lds, cx,
        [=](int j, const bf16_t* (&ap)[2], const bf16_t* (&bp)[2]) {
            int e, rt, ct; locate(j, e, rt, ct);
            ap[0] = hA + (size_t)rowidx[j * 256 + sr] * 1024 + sc; ap[1] = hA + (size_t)rowidx[j * 256 + sr + 128] * 1024 + sc;
            bp[0] = Wup + ((size_t)e * 1024 + ct * 256 + sr) * 1024 + sc; bp[1] = bp[0] + (size_t)128 * 1024;
        },
        [=](int j, f32x4 (&acc)[8][4], int wr, int wc, int fr, int fq) {
            int e, rt, ct; locate(j, e, rt, ct);
            const int cnt = s_cnt[e], off = s_off[e];
#pragma unroll
            for (int m = 0; m < 8; ++m) {
                const int pos = rt * 256 + wr * 128 + m * 16 + fr;
                if (pos < cnt) {
                    bf16_t* dst = H1 + (size_t)(off + pos) * 512 + ct * 128 + wc * 32 + fq * 4;
#pragma unroll
                    for (int n = 0; n < 2; ++n) {
                        float h[4];
#pragma unroll
                        for (int jj = 0; jj < 4; ++jj) h[jj] = silu_f(acc[m][n][jj]) * acc[m][n + 2][jj];
                        uint2 o; o.x = pack2(h[0], h[1]); o.y = pack2(h[2], h[3]);
                        *(uint2*)(dst + n * 16) = o;
                    }
                }
            }
        });
}

__device__ __forceinline__ void phase_moe_down(const Params& p, const Ctx& cx, char* lds, int layer) {
    const int tid = cx.tid;
    int* s_cnt = (int*)(lds + LDS_TAB_OFF); int* s_off = s_cnt + 16; int* s_toff = s_off + 17;
    moe_tables(p, layer, tid, s_cnt, s_off, s_toff);
    const int ntiles = s_toff[16];
    const bf16_t* H1 = (const bf16_t*)(p.ws + OFF_H1);
    const float* lw = (const float*)(p.ws + OFF_LW);
    bf16_t* Y = (bf16_t*)(p.ws + OFF_Y);
    float* lwc = (float*)(lds + LDS_LW_OFF);
    const int sc = stage_col2(tid), sr = tid >> 2;
    const int vb = cx.vbid, G = cx.G;
    const int my_tiles = min(8, vb < ntiles ? (ntiles - vb + G - 1) / G : 0);
    auto locate = [=](int j, int& e, int& rt, int& ct) { const int tile = vb + j * G; e = 0; while (tile >= s_toff[e + 1]) ++e; const int lt = tile - s_toff[e]; rt = lt >> 2; ct = lt & 3; };
    for (int i = tid; i < my_tiles * 256; i += NTHR) {
        const int j = i >> 8, r = i & 255; int e, rt, ct; locate(j, e, rt, ct);
        lwc[i] = lw[(size_t)e * NTOK + min(rt * 256 + r, s_cnt[e] - 1)];
    }
    __syncthreads();
    const bf16_t* Wdn = (const bf16_t*)(p.ws + OFF_W_DN) + (size_t)layer * 16 * 1024 * 512;
    gemm_stream2(my_tiles, 512, lds, cx,
        [=](int j, const bf16_t* (&ap)[2], const bf16_t* (&bp)[2]) {
            int e, rt, ct; locate(j, e, rt, ct);
            const int cnt = s_cnt[e], off = s_off[e];
            ap[0] = H1 + (size_t)(off + min(rt * 256 + sr, cnt - 1)) * 512 + sc; ap[1] = H1 + (size_t)(off + min(rt * 256 + sr + 128, cnt - 1)) * 512 + sc;
            bp[0] = Wdn + ((size_t)e * 1024 + ct * 256 + sr) * 512 + sc; bp[1] = bp[0] + (size_t)128 * 512;
        },
        [=](int j, f32x4 (&acc)[8][4], int wr, int wc, int fr, int fq) {
            int e, rt, ct; locate(j, e, rt, ct);
            const int cnt = s_cnt[e], off = s_off[e];
#pragma unroll
            for (int m = 0; m < 8; ++m) {
                const int rl_ = wr * 128 + m * 16 + fr, pos = rt * 256 + rl_;
                if (pos < cnt) {
                    const float w = lwc[j * 256 + rl_];
                    bf16_t* dst = Y + (size_t)(off + pos) * 1024 + ct * 256 + wc * 64 + fq * 4;
#pragma unroll
                    for (int n = 0; n < 4; ++n) {
                        uint2 o; o.x = pack2(w * acc[m][n][0], w * acc[m][n][1]); o.y = pack2(w * acc[m][n][2], w * acc[m][n][3]);
                        *(uint2*)(dst + n * 16) = o;
                    }
                }
            }
        });
}

template <int MODE = 0>
__device__ __forceinline__ void phase_hgrn_inproj(const Params& p, const Ctx& cx, char* lds) {
    const bf16_t* A = (const bf16_t*)(p.ws + OFF_HA);
    const bf16_t* Bt = (const bf16_t*)(p.ws + OFF_W_HG_IN);
    char* ws = p.ws;
    const float* lb = (const float*)(p.ws + OFF_LB);
    gemm_phase_dense2(A, 1024, Bt, 1024, NTOK / 256, 16, lds, cx, [=](int row0, int col0) {
        return [=](f32x4 (&acc)[8][4], int wr, int wc, int fr, int fq) {
            const int gc0 = col0 + wc * 64, seg = gc0 >> 10, c0 = gc0 & 1023;
#pragma unroll
            for (int m = 0; m < 8; ++m) {
                const int row = row0 + wr * 128 + m * 16 + fr;
#pragma unroll
                for (int n = 0; n < 4; ++n) {
                    const int c = c0 + n * 16 + fq * 4;
                    if (seg == 1) {
                        f32x4 l4 = *(const f32x4*)(lb + c), o;
#pragma unroll
                        for (int j = 0; j < 4; ++j) o[j] = __logf(l4[j] + (1.f - l4[j]) * sigmoid_f(acc[m][n][j]));
                        uint2 oh; oh.x = packh2(o[0], o[1]); oh.y = packh2(o[2], o[3]);
                        *(uint2*)((unsigned short*)(ws + OFF_LF) + (size_t)row * 1024 + c) = oh;
                    } else {
                        float h[4];
#pragma unroll
                        for (int j = 0; j < 4; ++j) h[j] = (seg == 2) ? acc[m][n][j] : silu_f(acc[m][n][j]);
                        uint2 o; o.x = pack2(h[0], h[1]); o.y = pack2(h[2], h[3]);
                        bf16_t* dst = (bf16_t*)(ws + (seg == 0 ? OFF_QH : seg == 2 ? OFF_V : OFF_G));
                        *(uint2*)(dst + (size_t)row * 1024 + c) = o;
                    }
                }
            }
        };
    });
}

constexpr int HG_QD_OFF = 0, HG_KD_OFF = 8704, HG_K2T_OFF = 17408, HG_VT_OFF = 27648, HG_DEC_OFF = 37888, HG_BUF = 38400, HG_TOT_OFF = 2 * HG_BUF;
constexpr int HG_ROW = 272, HG_TROW = 80;
static_assert(HG_TOT_OFF + 2048 <= LDS_TAB_OFF, "hgrn LDS");

__device__ __forceinline__ void phase_hgrn_rec(const Params& p, const Ctx& cx, char* lds) {
    const int lane = cx.lane;
    const int l31 = lane & 31, h2 = lane >> 5;
    const int widu = __builtin_amdgcn_readfirstlane(cx.wid);
    const bool producer = widu >= 4;
    const int pw = widu & 3;
    const int d0 = 2 * lane;
    const bf16_t* QH = (const bf16_t*)(p.ws + OFF_QH);
    const unsigned short* LF = (const unsigned short*)(p.ws + OFF_LF);
    const bf16_t* V = (const bf16_t*)(p.ws + OFF_V);
    bf16_t* OR = (bf16_t*)(p.ws + OFF_HA);
    float* tot = (float*)(lds + HG_TOT_OFF);
    for (int item = blockIdx.x; item < 128; item += cx.G) {
        const int b = item >> 3, h = item & 7;
        f32x16 S0, S1, S2, S3;
#pragma unroll
        for (int r = 0; r < 16; ++r) { S0[r] = 0.f; S1[r] = 0.f; S2[r] = 0.f; S3[r] = 0.f; }
        unsigned lfA[8], lfB[8], qv[8], vv[8];
        const size_t gbase = (size_t)(b * SEQ + pw * 8) * 1024 + h * 128;
        if (producer) {
#pragma unroll
            for (int i = 0; i < 8; ++i) {
                lfA[i] = *(const unsigned*)(LF + gbase + (size_t)i * 1024 + d0);
                qv[i] = *(const unsigned*)(QH + gbase + (size_t)i * 1024 + d0);
                vv[i] = *(const unsigned*)(V + gbase + (size_t)i * 1024 + d0);
            }
#pragma unroll
            for (int i = 0; i < 8; ++i) lfB[i] = *(const unsigned*)(LF + gbase + (size_t)(32 + i) * 1024 + d0);
        }
        __syncthreads();
        for (int c = 0; c <= SEQ / 32; ++c) {
            unsigned lf[8];
#pragma unroll
            for (int i = 0; i < 8; ++i) lf[i] = (c & 1) ? lfB[i] : lfA[i];
            f2_t run = {0.f, 0.f};
            if (producer && c < SEQ / 32) {
#pragma unroll
                for (int i = 0; i < 8; ++i) run += unpackh2(lf[i]);
                *(f2_t*)(tot + pw * 128 + d0) = run;
            }
            __syncthreads();
            if (producer) {
                if (c < SEQ / 32) {
                    char* bufp = lds + (c & 1) * HG_BUF;
                    f2_t pre = {0.f, 0.f}, last = {0.f, 0.f};
#pragma unroll
                    for (int q = 0; q < 4; ++q) {
                        const f2_t tq_ = *(const f2_t*)(tot + q * 128 + d0);
                        last += tq_;
                        if (q < pw) pre += tq_;
                    }
                    if (pw == 0) { f2_t dv; dv.x = __expf(last.x); dv.y = __expf(last.y); *(f2_t*)(bufp + HG_DEC_OFF + d0 * 4) = dv; }
                    float k2a[8], k2b[8];
                    f2_t rc = pre;
#pragma unroll
                    for (int i = 0; i < 8; ++i) {
                        const f2_t lfi = unpackh2(lf[i]);
                        rc += lfi;
                        const float cu0 = rc.x, cu1 = rc.y;
                        const float kk0 = 1.f - __expf(lfi.x), kk1 = 1.f - __expf(lfi.y);
                        const float q0 = bf2f((unsigned short)(qv[i] & 0xffff)) * __expf(cu0), q1 = bf2f((unsigned short)(qv[i] >> 16)) * __expf(cu1);
                        const float kd0 = kk0 * __expf(-cu0), kd1 = kk1 * __expf(-cu1);
                        k2a[i] = kk0 * __expf(last.x - cu0); k2b[i] = kk1 * __expf(last.y - cu1);
                        const int tl = pw * 8 + i;
                        *(unsigned*)(bufp + HG_QD_OFF + tl * HG_ROW + d0 * 2) = pack2(q0, q1);
                        *(unsigned*)(bufp + HG_KD_OFF + tl * HG_ROW + d0 * 2) = pack2(kd0, kd1);
                    }
                    uint4 a, bq, va, vb;
                    a.x = pack2(k2a[0], k2a[1]); a.y = pack2(k2a[2], k2a[3]); a.z = pack2(k2a[4], k2a[5]); a.w = pack2(k2a[6], k2a[7]);
                    bq.x = pack2(k2b[0], k2b[1]); bq.y = pack2(k2b[2], k2b[3]); bq.z = pack2(k2b[4], k2b[5]); bq.w = pack2(k2b[6], k2b[7]);
                    va.x = (vv[0] & 0xffffu) | (vv[1] << 16); va.y = (vv[2] & 0xffffu) | (vv[3] << 16); va.z = (vv[4] & 0xffffu) | (vv[5] << 16); va.w = (vv[6] & 0xffffu) | (vv[7] << 16);
                    vb.x = (vv[0] >> 16) | (vv[1] & 0xffff0000u); vb.y = (vv[2] >> 16) | (vv[3] & 0xffff0000u); vb.z = (vv[4] >> 16) | (vv[5] & 0xffff0000u); vb.w = (vv[6] >> 16) | (vv[7] & 0xffff0000u);
                    *(uint4*)(bufp + HG_K2T_OFF + d0 * HG_TROW + pw * 16) = a;
                    *(uint4*)(bufp + HG_K2T_OFF + (d0 + 1) * HG_TROW + pw * 16) = bq;
                    *(uint4*)(bufp + HG_VT_OFF + d0 * HG_TROW + pw * 16) = va;
                    *(uint4*)(bufp + HG_VT_OFF + (d0 + 1) * HG_TROW + pw * 16) = vb;
                    __builtin_amdgcn_sched_barrier(0);
                    if (c + 1 < SEQ / 32) {
                        const size_t gn = gbase + (size_t)(c + 1) * 32 * 1024;
#pragma unroll
                        for (int i = 0; i < 8; ++i) {
                            qv[i] = *(const unsigned*)(QH + gn + (size_t)i * 1024 + d0);
                            vv[i] = *(const unsigned*)(V + gn + (size_t)i * 1024 + d0);
                        }
                    }
                    if (c + 2 < SEQ / 32) {
                        const size_t gn = gbase + (size_t)(c + 2) * 32 * 1024;
                        if (c & 1) {
#pragma unroll
                            for (int i = 0; i < 8; ++i) lfB[i] = *(const unsigned*)(LF + gn + (size_t)i * 1024 + d0);
                        } else {
#pragma unroll
                            for (int i = 0; i < 8; ++i) lfA[i] = *(const unsigned*)(LF + gn + (size_t)i * 1024 + d0);
                        }
                    }
                }
            } else if (c >= 1) {
                const int cc = c - 1;
                const char* bufp = lds + (cc & 1) * HG_BUF;
                const float* dec = (const float*)(bufp + HG_DEC_OFF);
                f32x16 X;
#pragma unroll
                for (int r = 0; r < 16; ++r) X[r] = 0.f;
                {
                    const char* ka = bufp + HG_KD_OFF + l31 * HG_ROW + 16 * h2;
                    const char* qa = bufp + HG_QD_OFF + l31 * HG_ROW + 16 * h2;
#pragma unroll 2
                    for (int ks = 0; ks < 8; ++ks) X = MFMA32(*(const bf16x8*)(ka + 32 * ks), *(const bf16x8*)(qa + 32 * ks), X);
#pragma unroll
                    for (int r = 0; r < 16; ++r) { const int srow = (r & 3) + 8 * (r >> 2) + 4 * h2; X[r] = (srow <= l31) ? X[r] : 0.f; }
                }
                f32x16 Oa;
#pragma unroll
                for (int r = 0; r < 16; ++r) Oa[r] = 0.f;
                const int jrow = 32 * pw + l31;
#pragma unroll
                for (int s2 = 0; s2 < 2; ++s2) {
                    uint4 xk;
                    xk.x = pack2(X[8 * s2], X[8 * s2 + 1]); xk.y = pack2(X[8 * s2 + 2], X[8 * s2 + 3]); xk.z = pack2(X[8 * s2 + 4], X[8 * s2 + 5]); xk.w = pack2(X[8 * s2 + 6], X[8 * s2 + 7]);
                    const char* va = bufp + HG_VT_OFF + jrow * HG_TROW + (16 * s2 + 4 * h2) * 2;
                    const uint2 lo = *(const uint2*)va, hi = *(const uint2*)(va + 16);
                    uint4 vb; vb.x = lo.x; vb.y = lo.y; vb.z = hi.x; vb.w = hi.y;
                    Oa = MFMA32(__builtin_bit_cast(bf16x8, xk), __builtin_bit_cast(bf16x8, vb), Oa);
                }
                auto qs_term = [&](const f32x16& St, int dt) {
#pragma unroll
                    for (int s2 = 0; s2 < 2; ++s2) {
                        uint4 sk;
                        sk.x = pack2(St[8 * s2], St[8 * s2 + 1]); sk.y = pack2(St[8 * s2 + 2], St[8 * s2 + 3]); sk.z = pack2(St[8 * s2 + 4], St[8 * s2 + 5]); sk.w = pack2(St[8 * s2 + 6], St[8 * s2 + 7]);
                        const char* qa = bufp + HG_QD_OFF + l31 * HG_ROW + (32 * dt + 16 * s2 + 4 * h2) * 2;
                        const uint2 lo = *(const uint2*)qa, hi = *(const uint2*)(qa + 16);
                        uint4 qb; qb.x = lo.x; qb.y = lo.y; qb.z = hi.x; qb.w = hi.y;
                        Oa = MFMA32(__builtin_bit_cast(bf16x8, qb), __builtin_bit_cast(bf16x8, sk), Oa);
                    }
                };
                __builtin_amdgcn_sched_barrier(0);
                qs_term(S0, 0); qs_term(S1, 1);
                __builtin_amdgcn_sched_barrier(0);
                qs_term(S2, 2); qs_term(S3, 3);
                __builtin_amdgcn_sched_barrier(0);
                {
                    bf16_t* orow = OR + (size_t)(b * SEQ + cc * 32 + 4 * h2) * 1024 + h * 128 + jrow;
#pragma unroll
                    for (int r = 0; r < 16; ++r) orow[(size_t)((r & 3) + 8 * (r >> 2)) * 1024] = f2bf(Oa[r]);
                }
                auto s_update = [&](f32x16& St, int dt) {
#pragma unroll
                    for (int rq = 0; rq < 4; ++rq) {
                        const f32x4 dc = *(const f32x4*)(dec + 32 * dt + 8 * rq + 4 * h2);
                        St[4 * rq] *= dc[0]; St[4 * rq + 1] *= dc[1]; St[4 * rq + 2] *= dc[2]; St[4 * rq + 3] *= dc[3];
                    }
#pragma unroll
                    for (int s2 = 0; s2 < 2; ++s2) {
                        const bf16x8 ka = *(const bf16x8*)(bufp + HG_K2T_OFF + (32 * dt + l31) * HG_TROW + (16 * s2 + 8 * h2) * 2);
                        const bf16x8 vb = *(const bf16x8*)(bufp + HG_VT_OFF + jrow * HG_TROW + (16 * s2 + 8 * h2) * 2);
                        St = MFMA32(ka, vb, St);
                    }
                };
                __builtin_amdgcn_sched_barrier(0);
                s_update(S0, 0); s_update(S1, 1);
                __builtin_amdgcn_sched_barrier(0);
                s_update(S2, 2); s_update(S3, 3);
                __builtin_amdgcn_sched_barrier(0);
            }
            __syncthreads();
        }
    }
}

__device__ __forceinline__ void phase_hgrn_post(const Params& p, const Ctx& cx) {
    const int lane = cx.lane;
    const bf16_t* OR = (const bf16_t*)(p.ws + OFF_HA);
    const bf16_t* Gt = (const bf16_t*)(p.ws + OFF_G);
    bf16_t* OA = (bf16_t*)(p.ws + OFF_QH);
    const int col = lane * 16;
    float gn[16];
#pragma unroll
    for (int i = 0; i < 16; ++i) gn[i] = p.hgrn_out_gain[(col & 127) + i];
    for (int row = cx.vbid * NWAVE + cx.wid; row < NTOK; row += cx.G * NWAVE) {
        const uint4 a0 = *(const uint4*)(OR + (size_t)row * 1024 + col), a1 = *(const uint4*)(OR + (size_t)row * 1024 + col + 8);
        const uint4 g0 = *(const uint4*)(Gt + (size_t)row * 1024 + col), g1 = *(const uint4*)(Gt + (size_t)row * 1024 + col + 8);
        const unsigned aw[8] = {a0.x, a0.y, a0.z, a0.w, a1.x, a1.y, a1.z, a1.w};
        const unsigned gw[8] = {g0.x, g0.y, g0.z, g0.w, g1.x, g1.y, g1.z, g1.w};
        float o[16];
        float ss = 0.f;
#pragma unroll
        for (int i = 0; i < 8; ++i) { o[2 * i] = bf2f((unsigned short)(aw[i] & 0xffff)); o[2 * i + 1] = bf2f((unsigned short)(aw[i] >> 16)); ss += o[2 * i] * o[2 * i] + o[2 * i + 1] * o[2 * i + 1]; }
        ss += __shfl_xor(ss, 1); ss += __shfl_xor(ss, 2); ss += __shfl_xor(ss, 4);
        const float r = rsqrtf(ss * (1.f / 128.f) + EPS);
        unsigned w[8];
#pragma unroll
        for (int i = 0; i < 8; ++i)
            w[i] = pack2(o[2 * i] * r * gn[2 * i] * bf2f((unsigned short)(gw[i] & 0xffff)), o[2 * i + 1] * r * gn[2 * i + 1] * bf2f((unsigned short)(gw[i] >> 16)));
        uint4 o0, o1; o0.x = w[0]; o0.y = w[1]; o0.z = w[2]; o0.w = w[3]; o1.x = w[4]; o1.y = w[5]; o1.z = w[6]; o1.w = w[7];
        *(uint4*)(OA + (size_t)row * 1024 + col) = o0;
        *(uint4*)(OA + (size_t)row * 1024 + col + 8) = o1;
    }
}


#define XB_TMO      128
#define XB_XCNT(j)  (256  + 64 * (j))
#define XB_XSUB(j)  (1280 + 64 * (j))
#define XB_XGEN(j)  (2304 + 64 * (j))
#define XB_TOP      3328
#define XB_TOPGEN   3392
#define XCD_BAR_WORDS 3456
#define XB_SPIN_CAP (1u << 20)
#define LAS __attribute__((address_space(3)))
__device__ __forceinline__ unsigned xb_ld(unsigned* p)              { return __hip_atomic_load(p, __ATOMIC_RELAXED, __HIP_MEMORY_SCOPE_AGENT); }
__device__ __forceinline__ unsigned xb_add(unsigned* p, unsigned v) { return __hip_atomic_fetch_add(p, v, __ATOMIC_RELAXED, __HIP_MEMORY_SCOPE_AGENT); }
__device__ __forceinline__ unsigned xb_xcc_id() { return (unsigned)__builtin_amdgcn_s_getreg((3 << 11) | 20) & 0xFu; }
#define XB_SPIN(cond, bar) do { unsigned _sp = 0; while (cond) { __builtin_amdgcn_s_sleep(1); \
    if ((++_sp & 255u) == 0u) { if (xb_ld(&(bar)[XB_TMO])) break; if (_sp > XB_SPIN_CAP) { atomicAdd(&(bar)[XB_TMO], 1u); break; } } } } while (0)
struct XcdBarrier { unsigned* bar; unsigned x; volatile unsigned* st; };
__device__ __forceinline__ XcdBarrier xcd_barrier_post(unsigned* bar, volatile unsigned* st) {
    XcdBarrier b; b.bar = bar; b.x = xb_xcc_id(); b.st = st;
    if (threadIdx.x == 0) (void)xb_add(&bar[XB_XCNT(b.x)], 1u);
    return b;
}
__device__ __forceinline__ void xcd_barrier_complete(unsigned* bar, unsigned x, unsigned& nloc, unsigned& nx) {
    const unsigned G = gridDim.x * gridDim.y * gridDim.z;
    unsigned sum, cnt, mine, sp = 0u;
    for (;;) {
        sum = 0u; cnt = 0u; mine = 0u;
#pragma unroll
        for (unsigned j = 0; j < 16; ++j) { const unsigned c = xb_ld(&bar[XB_XCNT(j)]); sum += c; cnt += (c > 0u) ? 1u : 0u; mine = (j == x) ? c : mine; }
        if (sum == G) break;
        __builtin_amdgcn_s_sleep(1);
        if ((++sp & 255u) == 0u) { if (xb_ld(&bar[XB_TMO])) break; if (sp > XB_SPIN_CAP) { atomicAdd(&bar[XB_TMO], 1u); break; } }
    }
    nloc = mine > 0u ? mine : 1u; nx = cnt > 0u ? cnt : 1u;
}
__device__ __forceinline__ void xcd_barrier(const XcdBarrier& b) {
    asm volatile("s_waitcnt vmcnt(0)" ::: "memory");
    __syncthreads();
    if (threadIdx.x == 0) {
        unsigned* bar = b.bar;
        __builtin_amdgcn_s_waitcnt(0);
        unsigned nloc = b.st[0], nx = b.st[1];
        if (nloc == 0u) { xcd_barrier_complete(bar, b.x, nloc, nx); b.st[0] = nloc; b.st[1] = nx; }
        const unsigned old = xb_add(&bar[XB_XSUB(b.x)], 1u);
        const unsigned gen = old / nloc;
        if (old + 1u == (gen + 1u) * nloc) {
            __builtin_amdgcn_fence(__ATOMIC_RELEASE, "agent");
            asm volatile("s_waitcnt vmcnt(0)" ::: "memory");
            const unsigned og = xb_add(&bar[XB_TOP], 1u);
            const unsigned tg = og / nx;
            if (og + 1u == (tg + 1u) * nx) xb_add(&bar[XB_TOPGEN], 1u);
            else XB_SPIN(xb_ld(&bar[XB_TOPGEN]) == tg, bar);
            __builtin_amdgcn_fence(__ATOMIC_ACQUIRE, "agent");
            xb_add(&bar[XB_XGEN(b.x)], 1u);
            asm volatile("s_waitcnt vmcnt(0)" ::: "memory");
        } else {
            XB_SPIN(xb_ld(&bar[XB_XGEN(b.x)]) == gen, bar);
            __builtin_amdgcn_fence(__ATOMIC_ACQUIRE, "agent");
            asm volatile("s_waitcnt vmcnt(0)" ::: "memory");
        }
    }
    __syncthreads();
}

template <int PH>
__device__ __forceinline__ void run_phase(const Params& p, const Ctx& cx, char* lds) {
    if constexpr (PH == 0) phase0(p, cx, lds);
    else if constexpr (PH == 1) rows_phase<false, true, false>(p, cx, lds, p.x, nullptr, 0, 0, 0, 0);
    else if constexpr (PH == 2) phase_nsa_inproj(p, cx, lds);
    else if constexpr (PH == 3) phase_cmp1(p, cx, lds);
    else if constexpr (PH == 4) phase_cmp2(p, cx);
    else if constexpr (PH == 5) phase_attn(p, cx, lds);
    else if constexpr (PH == 6) phase_outproj(p, cx, lds, (const bf16_t*)(p.ws + OFF_HA), (const bf16_t*)(p.ws + OFF_W_NSA_OUT), p.x, 0);
    else if constexpr (PH == 7) rows_router_phase(p, cx, lds, p.out, 1, 0);
    else if constexpr (PH == 8) phase_moe_up(p, cx, lds, 0);
    else if constexpr (PH == 9) phase_moe_down(p, cx, lds, 0);
    else if constexpr (PH == 10) rows_phase<true, true, false>(p, cx, lds, p.out, p.out, 1, 2, 0, 0);
    else if constexpr (PH == 11) phase_hgrn_inproj<0>(p, cx, lds);
    else if constexpr (PH == 12) phase_hgrn_rec(p, cx, lds);
    else if constexpr (PH == 13) phase_hgrn_post(p, cx);
    else if constexpr (PH == 14) phase_outproj(p, cx, lds, (const bf16_t*)(p.ws + OFF_QH), (const bf16_t*)(p.ws + OFF_W_HG_OUT), p.out, 2);
    else if constexpr (PH == 15) rows_router_phase(p, cx, lds, p.out, 3, 1);
    else if constexpr (PH == 16) phase_moe_up(p, cx, lds, 1);
    else if constexpr (PH == 17) phase_moe_down(p, cx, lds, 1);
    else if constexpr (PH == 18) rows_phase<true, false, false>(p, cx, lds, p.out, p.out, 3, 0, 0, 1);
}

__device__ __forceinline__ Ctx make_ctx() {
    Ctx cx;
    cx.G = gridDim.x; cx.tid = threadIdx.x; cx.wid = threadIdx.x >> 6; cx.lane = threadIdx.x & 63;
    cx.vbid = (cx.G % 8 == 0) ? (blockIdx.x % 8) * (cx.G / 8) + blockIdx.x / 8 : blockIdx.x;
    return cx;
}

#if MULTI_LAUNCH
template <int PH>
__global__ void __launch_bounds__(NTHR, 2) phase_kernel(Params p) {
    extern __shared__ __attribute__((aligned(16))) char lds[];
    const Ctx cx = make_ctx();
    run_phase<PH>(p, cx, lds);
}
template <int PH>
static void launch_phases(const Params& p, int grid, hipStream_t stream) {
    (void)hipFuncSetAttribute((const void*)phase_kernel<PH>, hipFuncAttributeMaxDynamicSharedMemorySize, LDS_BYTES);
    hipLaunchKernelGGL(phase_kernel<PH>, dim3(grid), dim3(NTHR), LDS_BYTES, stream, p);
    if constexpr (PH + 1 < NPHASE) launch_phases<PH + 1>(p, grid, stream);
}
#else
template <int PH>
__device__ __forceinline__ void run_from(const Params& p, const Ctx& cx, char* lds, cg::grid_group& grid, const XcdBarrier& xb) {
    {
        Ctx c2 = cx;
        asm volatile("" : "+v"(c2.tid), "+v"(c2.lane));
        run_phase<PH>(p, c2, lds);
#ifdef PROBE_MASK
        if constexpr ((PROBE_MASK >> PH) & 1) { xcd_barrier(xb); run_phase<PH>(p, c2, lds); }
#endif
    }
    if constexpr (PH + 1 < NPHASE) {
        if constexpr (PH == 0) grid.sync();
        else xcd_barrier(xb);
        run_from<PH + 1>(p, cx, lds, grid, xb);
    }
}
__global__ void __launch_bounds__(NTHR, 2) mega_kernel(Params p) {
    extern __shared__ __attribute__((aligned(16))) char lds[];
    cg::grid_group grid = cg::this_grid();
    const Ctx cx = make_ctx();
    volatile unsigned* st = (volatile unsigned*)(lds + LDS_BYTES - 16);
    if (threadIdx.x == 0) { st[0] = 0u; st[1] = 0u; }
    __syncthreads();
    const XcdBarrier xb = xcd_barrier_post((unsigned*)(p.ws + OFF_BAR), st);
    run_from<0>(p, cx, lds, grid, xb);
}
#endif

extern "C" void kernel_launch(void* const* d_in, const int* in_sizes, int n_in, void* d_out, int out_size, void* d_ws, size_t ws_size,
                              hipStream_t stream) {
    static int grid = 0;
    if (!grid) {
        int dev = 0, cus = 0, per_cu = 0;
        (void)hipGetDevice(&dev);
        (void)hipDeviceGetAttribute(&cus, hipDeviceAttributeMultiprocessorCount, dev);
#if MULTI_LAUNCH
        per_cu = 1;
#else
        (void)hipFuncSetAttribute((const void*)mega_kernel, hipFuncAttributeMaxDynamicSharedMemorySize, LDS_BYTES);
        (void)hipOccupancyMaxActiveBlocksPerMultiprocessor(&per_cu, mega_kernel, NTHR, LDS_BYTES);
        if (per_cu > 1) per_cu = 1;
        if (per_cu < 1) { fprintf(stderr, "kernel_launch: occupancy query says 0 blocks per CU (LDS %d B)\n", LDS_BYTES); per_cu = 1; }
#endif
        if (cus <= 0) cus = 256;
        grid = cus * per_cu;
        if (ws_size < WS_NEED) fprintf(stderr, "kernel_launch: workspace too small: %zu < %zu\n", ws_size, (size_t)WS_NEED);
    }
    Params p{};
    p.x = (const float*)d_in[0]; p.c = (const float*)d_in[1]; p.ada_w = (const float*)d_in[2]; p.ada_b = (const float*)d_in[3];
    p.norm_g = (const float*)d_in[4]; p.rel_bias = (const float*)d_in[5]; p.nsa_w_in = (const float*)d_in[6]; p.nsa_q_gain = (const float*)d_in[7];
    p.nsa_k_gain = (const float*)d_in[8]; p.nsa_cmp_pe = (const float*)d_in[9]; p.nsa_cmp_w1 = (const float*)d_in[10]; p.nsa_cmp_w2 = (const float*)d_in[11];
    p.nsa_w_out = (const float*)d_in[12]; p.hgrn_w_in = (const float*)d_in[13]; p.hgrn_lb = (const float*)d_in[14]; p.hgrn_out_gain = (const float*)d_in[15];
    p.hgrn_w_out = (const float*)d_in[16]; p.moe_rg = (const float*)d_in[17]; p.moe_re = (const float*)d_in[18]; p.moe_w1 = (const float*)d_in[19];
    p.moe_w3 = (const float*)d_in[20]; p.moe_w2 = (const float*)d_in[21];
    p.out = (float*)d_out; p.ws = (char*)d_ws;
#if MULTI_LAUNCH
    launch_phases<0>(p, grid, stream);
#else
    p.p_begin = 0; p.p_end = NPHASE;
    (void)hipMemsetAsync((char*)d_ws + OFF_BAR, 0, XCD_BAR_WORDS * 4, stream);
    void* args[] = {&p};
    hipError_t e = hipLaunchCooperativeKernel((void*)mega_kernel, dim3(grid), dim3(NTHR), args, LDS_BYTES, stream);
    if (e != hipSuccess) fprintf(stderr, "cooperative launch failed: %s (grid %d)\n", hipGetErrorString(e), grid);
#endif
}
```

```cpp
#include <hip/hip_runtime.h>
#include <hip/hip_cooperative_groups.h>
#include <cstdio>
#include <cstdint>
namespace cg = cooperative_groups;

#ifndef MULTI_LAUNCH
#define MULTI_LAUNCH 0
#endif

typedef unsigned short bf16_t;
typedef short bf16x8 __attribute__((ext_vector_type(8)));
typedef float f32x4 __attribute__((ext_vector_type(4)));
typedef float f32x16 __attribute__((ext_vector_type(16)));

constexpr int NTOK = 32768, DM = 1024, SEQ = 2048, NBATCH = 16;
constexpr int NSA_IN = 2608, NSA_IN_PAD = 2816;
constexpr float EPS = 1e-6f;
constexpr size_t MiB = 1ull << 20;

constexpr size_t OFF_CNT = 0;
constexpr size_t OFF_MOD = 4096;
constexpr size_t OFF_LB = OFF_MOD + 786432;
constexpr size_t OFF_PEB = OFF_LB + 4096;
constexpr size_t OFF_BAR = 921600;
constexpr size_t OFF_W_NSA_IN = 1 * MiB;
constexpr size_t OFF_W_NSA_OUT = OFF_W_NSA_IN + 2816ull * 1024 * 2;
constexpr size_t OFF_W_HG_IN = OFF_W_NSA_OUT + 1024ull * 1024 * 2;
constexpr size_t OFF_W_HG_OUT = OFF_W_HG_IN + 4096ull * 1024 * 2;
constexpr size_t OFF_W_CMP1 = OFF_W_HG_OUT + 1024ull * 1024 * 2;
constexpr size_t OFF_W_UP = OFF_W_CMP1 + 2ull * 128 * 2048 * 2;
constexpr size_t OFF_W_DN = OFF_W_UP + 32ull * 1024 * 1024 * 2;
constexpr size_t OFF_W_END = OFF_W_DN + 32ull * 1024 * 512 * 2;
constexpr size_t OFF_HA = 116 * MiB;
static_assert(OFF_W_END <= OFF_HA, "weights overflow");
constexpr size_t OFF_SCR = 180 * MiB;
constexpr size_t OFF_Q = OFF_SCR;
constexpr size_t OFF_KCRAW = OFF_Q + 64 * MiB;
constexpr size_t OFF_VCRAW = OFF_KCRAW + 17 * MiB;
constexpr size_t OFF_KS = OFF_VCRAW + 17 * MiB;
constexpr size_t OFF_VS = OFF_KS + 16 * MiB;
constexpr size_t OFF_KW = OFF_VS + 16 * MiB;
constexpr size_t OFF_VW = OFF_KW + 16 * MiB;
constexpr size_t OFF_GATES = OFF_VW + 16 * MiB;
constexpr size_t OFF_T1 = OFF_GATES + 6 * MiB;
constexpr size_t OFF_KC = OFF_T1 + 4 * MiB;
constexpr size_t OFF_VC = OFF_KC + 1 * MiB;
constexpr size_t OFF_H1 = OFF_SCR;
constexpr size_t OFF_Y = OFF_H1 + 64 * MiB;
constexpr size_t OFF_LTOK = OFF_Y + 128 * MiB;
constexpr size_t OFF_LW = OFF_LTOK + 2 * MiB;
constexpr size_t OFF_TSLOT = OFF_LW + 2 * MiB;
constexpr size_t OFF_QH = OFF_SCR;
constexpr size_t OFF_LF = OFF_QH + 64 * MiB;
constexpr size_t OFF_V = OFF_LF + 128 * MiB;
constexpr size_t OFF_G = OFF_V + 64 * MiB;
constexpr size_t WS_NEED = OFF_G + 64 * MiB;
static_assert(WS_NEED <= 512 * MiB, "ws overflow");

constexpr int NTHR = 512, NWAVE = 8;
constexpr int GEMM_STAGE = 49152, GEMM_NSTAGE = 3;
constexpr int LDS_TAB_OFF = GEMM_STAGE * GEMM_NSTAGE;
constexpr int LDS_BYTES = LDS_TAB_OFF + 256 + 16;
constexpr int NPHASE = 19;

struct Params {
    const float *x, *c, *ada_w, *ada_b, *norm_g, *rel_bias, *nsa_w_in, *nsa_q_gain, *nsa_k_gain, *nsa_cmp_pe, *nsa_cmp_w1,
        *nsa_cmp_w2, *nsa_w_out, *hgrn_w_in, *hgrn_lb, *hgrn_out_gain, *hgrn_w_out, *moe_rg, *moe_re, *moe_w1, *moe_w3, *moe_w2;
    float* out;
    char* ws;
    int p_begin, p_end;
};

__device__ __forceinline__ float bf2f(unsigned short h) { return __uint_as_float((unsigned)h << 16); }
__device__ __forceinline__ unsigned short f2bf(float f) {
    unsigned u = __float_as_uint(f);
    u += 0x7fffu + ((u >> 16) & 1u);
    return (unsigned short)(u >> 16);
}
typedef __bf16 bf2_t __attribute__((ext_vector_type(2)));
typedef float f2_t __attribute__((ext_vector_type(2)));
__device__ __forceinline__ unsigned pack2(float a, float b) {
    f2_t v = {a, b};
    return __builtin_bit_cast(unsigned, __builtin_convertvector(v, bf2_t));
}
typedef _Float16 h2_t __attribute__((ext_vector_type(2)));
__device__ __forceinline__ unsigned packh2(float a, float b) { f2_t v = {a, b}; return __builtin_bit_cast(unsigned, __builtin_convertvector(v, h2_t)); }
__device__ __forceinline__ f2_t unpackh2(unsigned u) { return __builtin_convertvector(__builtin_bit_cast(h2_t, u), f2_t); }
__device__ __forceinline__ float wave_sum(float v) {
#pragma unroll
    for (int o = 32; o; o >>= 1) v += __shfl_xor(v, o);
    return v;
}
__device__ __forceinline__ float wave_max(float v) {
#pragma unroll
    for (int o = 32; o; o >>= 1) v = fmaxf(v, __shfl_xor(v, o));
    return v;
}
__device__ __forceinline__ float silu_f(float x) { return x / (1.f + __expf(-x)); }
__device__ __forceinline__ float sigmoid_f(float x) { return 1.f / (1.f + __expf(-x)); }
__device__ __forceinline__ void glds16(const void* g, void* l) {
    __builtin_amdgcn_global_load_lds((const unsigned*)g, (unsigned*)l, 16, 0, 0);
}
__device__ __forceinline__ int t5_bucket(int n) {
    if (n < 16) return n;
    int b = 16;
    b += (n >= 21); b += (n >= 27); b += (n >= 35); b += (n >= 46); b += (n >= 59); b += (n >= 77); b += (n >= 99); b += (n >= 128);
    b += (n >= 166); b += (n >= 216); b += (n >= 280); b += (n >= 363); b += (n >= 470); b += (n >= 609); b += (n >= 790);
    return b;
}

struct Ctx {
    int G, vbid, tid, wid, lane;
};

constexpr int P0_MOD_ITEMS = 192;
constexpr int TS0 = 88 * 16, TS1 = 32 * 16, TS2 = 128 * 16, TS3 = 32 * 16, TS4 = 2 * 4 * 32, TS5 = 32 * 32 * 16, TS6 = 32 * 32 * 8;
constexpr int TC0 = 0, TC1 = TC0 + TS0, TC2 = TC1 + TS1, TC3 = TC2 + TS2, TC4 = TC3 + TS3, TC5 = TC4 + TS4, TC6 = TC5 + TS5, TC_END = TC6 + TS6;

struct TrJob { const float* src; int ld, c0, ncols_valid, k0; bf16_t* dst; int dstld; int perm; };
__device__ __forceinline__ int pcol(int n, int fq) { return (n >> 1) * 32 + fq * 8 + (n & 1) * 4; }
__device__ __forceinline__ void tr_load(const TrJob& j, float* tl, int htid) {
    const int k = htid >> 2, cc = (htid & 3) * 8;
    const float* s = j.src + (size_t)(j.k0 + k) * j.ld + j.c0 + cc;
    f32x4 a = {0.f, 0.f, 0.f, 0.f}, c = a;
    if (j.c0 + 32 <= j.ncols_valid) { a = *(const f32x4*)s; c = *(const f32x4*)(s + 4); }
    else {
#pragma unroll
        for (int i = 0; i < 4; ++i) { if (j.c0 + cc + i < j.ncols_valid) a[i] = s[i]; if (j.c0 + cc + 4 + i < j.ncols_valid) c[i] = s[4 + i]; }
    }
#pragma unroll
    for (int i = 0; i < 4; ++i) { tl[k * 33 + cc + i] = a[i]; tl[k * 33 + cc + 4 + i] = c[i]; }
}
__device__ __forceinline__ void tr_store(const TrJob& j, const float* tl, int htid) {
    const int nsrc = htid >> 3, kc = (htid & 7) * 8;
    const int n = nsrc;
    const int nd = j.perm ? (((nsrc >> 2) & 1) * 16 + (nsrc >> 3) * 4 + (nsrc & 3)) : nsrc;
    uint4 o;
    o.x = pack2(tl[(kc + 0) * 33 + n], tl[(kc + 1) * 33 + n]); o.y = pack2(tl[(kc + 2) * 33 + n], tl[(kc + 3) * 33 + n]);
    o.z = pack2(tl[(kc + 4) * 33 + n], tl[(kc + 5) * 33 + n]); o.w = pack2(tl[(kc + 6) * 33 + n], tl[(kc + 7) * 33 + n]);
    *(uint4*)(j.dst + (size_t)nd * j.dstld + kc) = o;
}
__device__ __forceinline__ TrJob tr_job(const Params& p, int tt) {
    TrJob j;
    if (tt < TC1) {
        const int nt = tt / 16, kt = tt % 16;
        j = {p.nsa_w_in, NSA_IN, nt * 32, NSA_IN, kt * 64, (bf16_t*)(p.ws + OFF_W_NSA_IN) + (size_t)nt * 32 * 1024 + kt * 64, 1024, 1};
    } else if (tt < TC2) {
        const int u = tt - TC1, nt = u / 16, kt = u % 16;
        j = {p.nsa_w_out, 1024, nt * 32, 1024, kt * 64, (bf16_t*)(p.ws + OFF_W_NSA_OUT) + (size_t)nt * 32 * 1024 + kt * 64, 1024, 1};
    } else if (tt < TC3) {
        const int u = tt - TC2, nt = u / 16, kt = u % 16;
        j = {p.hgrn_w_in, 4096, nt * 32, 4096, kt * 64, (bf16_t*)(p.ws + OFF_W_HG_IN) + (size_t)nt * 32 * 1024 + kt * 64, 1024, 1};
    } else if (tt < TC4) {
        const int u = tt - TC3, nt = u / 16, kt = u % 16;
        j = {p.hgrn_w_out, 1024, nt * 32, 1024, kt * 64, (bf16_t*)(p.ws + OFF_W_HG_OUT) + (size_t)nt * 32 * 1024 + kt * 64, 1024, 1};
    } else if (tt < TC5) {
        const int u = tt - TC4, kv = u / 128, r = u % 128, nt = r / 32, kt = r % 32;
        j = {p.nsa_cmp_w1 + (size_t)kv * 2048 * 64, 64, nt * 32, 64, kt * 64, (bf16_t*)(p.ws + OFF_W_CMP1) + ((size_t)kv * 128 + nt * 32) * 2048 + kt * 64, 2048, 0};
    } else if (tt < TC6) {
        const int u = tt - TC5, le = u / 512, r = u % 512, gr = r / 16, kt = r % 16;
        const int t = gr >> 2, wc = (gr >> 1) & 1, which = gr & 1;
        const float* src = (which ? p.moe_w3 : p.moe_w1) + (size_t)le * 1024 * 512;
        j = {src, 512, (t * 2 + wc) * 32, 512, kt * 64, (bf16_t*)(p.ws + OFF_W_UP) + ((size_t)le * 1024 + gr * 32) * 1024 + kt * 64, 1024, 1};
    } else {
        const int u = tt - TC6, le = u / 256, r = u % 256, nt = r / 8, kt = r % 8;
        j = {p.moe_w2 + (size_t)le * 512 * 1024, 1024, nt * 32, 1024, kt * 64, (bf16_t*)(p.ws + OFF_W_DN) + ((size_t)le * 1024 + nt * 32) * 512 + kt * 64, 512, 1};
    }
    return j;
}

__device__ __forceinline__ void phase0(const Params& p, const Ctx& cx, char* lds) {
    const int tid = cx.tid, wid = cx.wid, lane = cx.lane;
    for (int it = cx.vbid; it < P0_MOD_ITEMS; it += cx.G) {
        const int colbase = it * 64, ls = colbase / 3072, e0 = colbase % 3072;
        const float* W = p.ada_w + (size_t)ls * 1024 * 3072 + e0 + lane;
        float* cs = (float*)lds + wid * 1024;
        float* red = (float*)lds + 8192;
        float acc[16];
#pragma unroll
        for (int b = 0; b < 16; ++b) acc[b] = 0.f;
        for (int sub = 0; sub < 2; ++sub) {
            const int kb = wid * 128 + sub * 64;
#pragma unroll
            for (int b = 0; b < 16; ++b) cs[lane * 16 + b] = silu_f(p.c[b * 1024 + kb + lane]);
            __builtin_amdgcn_wave_barrier();
#pragma unroll 1
            for (int k16 = 0; k16 < 64; k16 += 16) {
                float wv[16];
#pragma unroll
                for (int u = 0; u < 16; ++u) wv[u] = W[(size_t)(kb + k16 + u) * 3072];
#pragma unroll
                for (int u = 0; u < 16; ++u) {
                    const float w = wv[u];
                    const f32x4* cv = (const f32x4*)(cs + (k16 + u) * 16);
#pragma unroll
                    for (int q = 0; q < 4; ++q) {
                        f32x4 c4 = cv[q];
                        acc[q * 4 + 0] += c4[0] * w; acc[q * 4 + 1] += c4[1] * w; acc[q * 4 + 2] += c4[2] * w; acc[q * 4 + 3] += c4[3] * w;
                    }
                }
            }
            __builtin_amdgcn_wave_barrier();
        }
#pragma unroll
        for (int b = 0; b < 16; ++b) red[(wid * 16 + b) * 64 + lane] = acc[b];
        __syncthreads();
        float* mod = (float*)(p.ws + OFF_MOD);
#pragma unroll
        for (int i = 0; i < 2; ++i) {
            const int o = tid + i * NTHR, b = o >> 6, e = o & 63;
            float sm = 0.f;
#pragma unroll
            for (int w = 0; w < 8; ++w) sm += red[(w * 16 + b) * 64 + e];
            mod[((size_t)ls * 16 + b) * 3072 + e0 + e] = sm + p.ada_b[ls * 3072 + e0 + e];
        }
        __syncthreads();
    }
    {
        constexpr int TPH = 4;
        const int half = tid >> 8, htid = tid & 255;
        float* tl = (float*)lds + half * (TPH * 64 * 33);
        for (int base = cx.vbid * 2 * TPH; base < TC_END; base += cx.G * 2 * TPH) {
#pragma unroll
            for (int q = 0; q < TPH; ++q) {
                const int tt = base + half * TPH + q;
                if (tt < TC_END) { const TrJob j = tr_job(p, tt); tr_load(j, tl + q * (64 * 33), htid); }
            }
            __syncthreads();
#pragma unroll
            for (int q = 0; q < TPH; ++q) {
                const int tt = base + half * TPH + q;
                if (tt < TC_END) { const TrJob j = tr_job(p, tt); tr_store(j, tl + q * (64 * 33), htid); }
            }
            __syncthreads();
        }
    }
    if (cx.vbid == cx.G - 1) {
        float* lb = (float*)(p.ws + OFF_LB);
        for (int i = tid; i < 1024; i += NTHR) lb[i] = sigmoid_f(p.hgrn_lb[1024 + i] - p.hgrn_lb[i]);
        if (tid < 128) {
            const int kv = tid >> 6, d = tid & 63;
            const float* pe = p.nsa_cmp_pe + kv * 2048;
            const float* w1 = p.nsa_cmp_w1 + (size_t)kv * 2048 * 64 + d;
            float sm = 0.f;
            for (int k = 0; k < 2048; ++k) sm += pe[k] * w1[(size_t)k * 64];
            ((float*)(p.ws + OFF_PEB))[tid] = sm;
        }
        if (tid < 32) ((int*)(p.ws + OFF_CNT))[tid] = 0;
    }
}

template <bool COMBINE, bool NORM, bool ROUTER>
__device__ __forceinline__ void rows_phase(const Params& p, const Ctx& cx, char* lds, const float* __restrict__ src, float* __restrict__ xdst,
                           int ls_comb, int ls_norm, int layer_router, int layer_comb) {
    static_assert(!ROUTER, "router rows use rows_router_phase");
    const int lane = cx.lane;
    const float* mod = (const float*)(p.ws + OFF_MOD);
    int my_off = 0;
    if (COMBINE) {
        const int* cnt = (const int*)(p.ws + OFF_CNT) + layer_comb * 16;
        int cv = (lane < 16) ? cnt[lane] : 0;
        int incl = cv;
#pragma unroll
        for (int o = 1; o < 16; o <<= 1) { int t = __shfl_up(incl, o); if (lane >= o) incl += t; }
        my_off = incl - cv;
    }
    const int rpw = (NTOK + cx.G * NWAVE - 1) / (cx.G * NWAVE);
    const int row_begin = (cx.vbid * NWAVE + cx.wid) * rpw, row_end = min(NTOK, row_begin + rpw);
    if (row_begin >= row_end) return;
    const bf16_t* Y = (const bf16_t*)(p.ws + OFF_Y);
    const int* tsl = (const int*)(p.ws + OFF_TSLOT);
    bf16_t* hA = (bf16_t*)(p.ws + OFF_HA);
    const float* gain = p.norm_g + ls_norm * 1024;
    auto yrow = [&](int sw) -> size_t { return (size_t)(__shfl(my_off, sw >> 16) + (sw & 0xffff)) * 1024; };
    f32x4 vn[4];
    uint2 yan[4], ycn[4];
    int t0n = 0, t1n = 0;
#pragma unroll
    for (int i = 0; i < 4; ++i) vn[i] = *(const f32x4*)(src + (size_t)row_begin * 1024 + (i * 64 + lane) * 4);
    if (COMBINE) {
        const size_t ra = yrow(tsl[row_begin * 2]), rc = yrow(tsl[row_begin * 2 + 1]);
#pragma unroll
        for (int i = 0; i < 4; ++i) { yan[i] = *(const uint2*)(Y + ra + (i * 64 + lane) * 4); ycn[i] = *(const uint2*)(Y + rc + (i * 64 + lane) * 4); }
        if (row_begin + 1 < row_end) { t0n = tsl[(row_begin + 1) * 2]; t1n = tsl[(row_begin + 1) * 2 + 1]; }
    }
    f32x4 gt[4], ca[4], cb[4];
    int bcur = -1;
    for (int row = row_begin; row < row_end; ++row) {
        const int b = row >> 11;
        if (b != bcur) {
            bcur = b;
#pragma unroll
            for (int i = 0; i < 4; ++i) {
                const int col = (i * 64 + lane) * 4;
                if (COMBINE) gt[i] = *(const f32x4*)(mod + ((size_t)ls_comb * 16 + b) * 3072 + 2048 + col);
                if (NORM) {
                    const float* shift = mod + ((size_t)ls_norm * 16 + b) * 3072;
                    const f32x4 g = *(const f32x4*)(gain + col), sc = *(const f32x4*)(shift + 1024 + col);
                    ca[i] = g * (sc + 1.f);
                    cb[i] = *(const f32x4*)(shift + col);
                }
            }
        }
        f32x4 v[4];
        uint2 ya[4], yc[4];
#pragma unroll
        for (int i = 0; i < 4; ++i) { v[i] = vn[i]; if (COMBINE) { ya[i] = yan[i]; yc[i] = ycn[i]; } }
        if (row + 1 < row_end) {
#pragma unroll
            for (int i = 0; i < 4; ++i) vn[i] = *(const f32x4*)(src + (size_t)(row + 1) * 1024 + (i * 64 + lane) * 4);
            if (COMBINE) {
                const size_t ra = yrow(t0n), rc = yrow(t1n);
#pragma unroll
                for (int i = 0; i < 4; ++i) { yan[i] = *(const uint2*)(Y + ra + (i * 64 + lane) * 4); ycn[i] = *(const uint2*)(Y + rc + (i * 64 + lane) * 4); }
                if (row + 2 < row_end) { t0n = tsl[(row + 2) * 2]; t1n = tsl[(row + 2) * 2 + 1]; }
            }
        }
        if (COMBINE) {
#pragma unroll
            for (int i = 0; i < 4; ++i) {
                const int col = (i * 64 + lane) * 4;
                v[i][0] += gt[i][0] * (bf2f(ya[i].x & 0xffff) + bf2f(yc[i].x & 0xffff));
                v[i][1] += gt[i][1] * (bf2f(ya[i].x >> 16) + bf2f(yc[i].x >> 16));
                v[i][2] += gt[i][2] * (bf2f(ya[i].y & 0xffff) + bf2f(yc[i].y & 0xffff));
                v[i][3] += gt[i][3] * (bf2f(ya[i].y >> 16) + bf2f(yc[i].y >> 16));
                *(f32x4*)(xdst + (size_t)row * 1024 + col) = v[i];
            }
        }
        if (NORM) {
            float ss = 0.f;
#pragma unroll
            for (int i = 0; i < 4; ++i) ss += v[i][0] * v[i][0] + v[i][1] * v[i][1] + v[i][2] * v[i][2] + v[i][3] * v[i][3];
            ss = wave_sum(ss);
            const float r = rsqrtf(ss * (1.f / 1024.f) + EPS);
#pragma unroll
            for (int i = 0; i < 4; ++i) {
                const int col = (i * 64 + lane) * 4;
                f32x4 h;
#pragma unroll
                for (int j = 0; j < 4; ++j) h[j] = v[i][j] * r * ca[i][j] + cb[i][j];
                uint2 o; o.x = pack2(h[0], h[1]); o.y = pack2(h[2], h[3]);
                *(uint2*)(hA + (size_t)row * 1024 + col) = o;
            }
        }
    }
}

__device__ __forceinline__ void rows_router_phase(const Params& p, const Ctx& cx, char* lds, const float* __restrict__ src, int ls_norm, int layer) {
    const int lane = cx.lane, tid = cx.tid;
    const int widu = __builtin_amdgcn_readfirstlane(cx.wid);
    const int wq = widu & 3, grp4 = widu >> 2;
    const float* mod = (const float*)(p.ws + OFF_MOD);
    const float* rg = p.moe_rg + (size_t)layer * 1024 * 4;
    const float* re = p.moe_re + (size_t)layer * 1024 * 16;
    float* logit_s = (float*)lds;
    float wr[16][5];
#pragma unroll
    for (int i = 0; i < 4; ++i)
#pragma unroll
        for (int j = 0; j < 4; ++j) {
            const int k = (i * 64 + lane) * 4 + j;
#pragma unroll
            for (int q = 0; q < 5; ++q) {
                const int o = 5 * wq + q;
                wr[i * 4 + j][q] = (o < 4) ? rg[k * 4 + o] : re[k * 16 + o - 4];
            }
            __builtin_amdgcn_sched_barrier(0);
        }
    const float* gain = p.norm_g + ls_norm * 1024;
    bf16_t* hA = (bf16_t*)(p.ws + OFF_HA);
    int* lcnt = (int*)(lds + 16384);
    if (tid < 32) lcnt[tid] = 0;
    int nstep = 0;
    for (int blk = cx.vbid; blk < NTOK / 32; blk += cx.G, ++nstep) {
        const int R0 = blk * 32, b = R0 >> 11;
        const float* shift = mod + ((size_t)ls_norm * 16 + b) * 3072;
        const float* scale = shift + 1024;
        f32x4 ca[4], cb[4];
#pragma unroll
        for (int i = 0; i < 4; ++i) {
            const int col = (i * 64 + lane) * 4;
            const f32x4 g = *(const f32x4*)(gain + col), sc = *(const f32x4*)(scale + col);
            ca[i] = g * (sc + 1.f);
            cb[i] = *(const f32x4*)(shift + col);
        }
        const float* srow = src + (size_t)(R0 + grp4 * 16) * 1024 + lane * 4;
        f32x4 vnA[4], vnB[4];
#pragma unroll
        for (int i = 0; i < 4; ++i) { vnA[i] = *(const f32x4*)(srow + i * 256); vnB[i] = *(const f32x4*)(srow + 1024 + i * 256); }
#pragma unroll 1
        for (int r = 0; r < 16; r += 2) {
            const int rlA = grp4 * 16 + r;
            f32x4 vA[4], vB[4];
#pragma unroll
            for (int i = 0; i < 4; ++i) { vA[i] = vnA[i]; vB[i] = vnB[i]; }
            if (r < 14) {
#pragma unroll
                for (int i = 0; i < 4; ++i) { vnA[i] = *(const f32x4*)(srow + (size_t)(r + 2) * 1024 + i * 256); vnB[i] = *(const f32x4*)(srow + (size_t)(r + 3) * 1024 + i * 256); }
            }
            float ssA = 0.f, ssB = 0.f;
#pragma unroll
            for (int i = 0; i < 4; ++i) {
                ssA += vA[i][0] * vA[i][0] + vA[i][1] * vA[i][1] + vA[i][2] * vA[i][2] + vA[i][3] * vA[i][3];
                ssB += vB[i][0] * vB[i][0] + vB[i][1] * vB[i][1] + vB[i][2] * vB[i][2] + vB[i][3] * vB[i][3];
            }
#pragma unroll
            for (int o = 32; o; o >>= 1) { ssA += __shfl_xor(ssA, o); ssB += __shfl_xor(ssB, o); }
            const float rrA = rsqrtf(ssA * (1.f / 1024.f) + EPS), rrB = rsqrtf(ssB * (1.f / 1024.f) + EPS);
            float accA[5] = {0.f, 0.f, 0.f, 0.f, 0.f}, accB[5] = {0.f, 0.f, 0.f, 0.f, 0.f};
#pragma unroll
            for (int i = 0; i < 4; ++i) {
                const int col = (i * 64 + lane) * 4;
                f32x4 hA_, hB_;
#pragma unroll
                for (int j = 0; j < 4; ++j) {
                    hA_[j] = vA[i][j] * rrA * ca[i][j] + cb[i][j];
                    hB_[j] = vB[i][j] * rrB * ca[i][j] + cb[i][j];
#pragma unroll
                    for (int q = 0; q < 5; ++q) { accA[q] += hA_[j] * wr[i * 4 + j][q]; accB[q] += hB_[j] * wr[i * 4 + j][q]; }
                }
                if ((r & 3) == wq) { uint2 o; o.x = pack2(hA_[0], hA_[1]); o.y = pack2(hA_[2], hA_[3]); *(uint2*)(hA + (size_t)(R0 + rlA) * 1024 + col) = o; }
                if (((r + 1) & 3) == wq) { uint2 o; o.x = pack2(hB_[0], hB_[1]); o.y = pack2(hB_[2], hB_[3]); *(uint2*)(hA + (size_t)(R0 + rlA + 1) * 1024 + col) = o; }
            }
#pragma unroll
            for (int o = 32; o; o >>= 1) {
#pragma unroll
                for (int q = 0; q < 5; ++q) { accA[q] += __shfl_xor(accA[q], o); accB[q] += __shfl_xor(accB[q], o); }
            }
            if (lane == 0) {
#pragma unroll
                for (int q = 0; q < 5; ++q) { logit_s[(nstep * 32 + rlA) * 20 + 5 * wq + q] = accA[q]; logit_s[(nstep * 32 + rlA + 1) * 20 + 5 * wq + q] = accB[q]; }
            }
        }
    }
    __syncthreads();
    const int nrows = nstep * 32;
    int ea = 0, eb = 0, la = 0, lb_ = 0, row = 0; float wa = 0.f, wb = 0.f;
    if (tid < nrows) {
        row = (cx.vbid + (tid >> 5) * cx.G) * 32 + (tid & 31);
        const float* rl = logit_s + tid * 20;
        const float gm = fmaxf(fmaxf(rl[0], rl[1]), fmaxf(rl[2], rl[3]));
        const float gs = __expf(rl[0] - gm) + __expf(rl[1] - gm) + __expf(rl[2] - gm) + __expf(rl[3] - gm);
        int grp = 0; float best = rl[0];
        if (rl[1] > best) { best = rl[1]; grp = 1; }
        if (rl[2] > best) { best = rl[2]; grp = 2; }
        if (rl[3] > best) { best = rl[3]; grp = 3; }
        const float pg = __expf(best - gm) / gs;
        const f32x4 lsel = *(const f32x4*)(rl + 4 + 4 * grp);
        const float l0 = lsel[0], l1 = lsel[1], l2 = lsel[2], l3 = lsel[3];
        const float em = fmaxf(fmaxf(l0, l1), fmaxf(l2, l3));
        const float q0 = __expf(l0 - em), q1 = __expf(l1 - em), q2 = __expf(l2 - em), q3 = __expf(l3 - em);
        int i1 = 0; float b1 = q0;
        if (q1 > b1) { b1 = q1; i1 = 1; }
        if (q2 > b1) { b1 = q2; i1 = 2; }
        if (q3 > b1) { b1 = q3; i1 = 3; }
        int i2 = -1; float b2 = -1.f;
        if (i1 != 0 && q0 > b2) { b2 = q0; i2 = 0; }
        if (i1 != 1 && q1 > b2) { b2 = q1; i2 = 1; }
        if (i1 != 2 && q2 > b2) { b2 = q2; i2 = 2; }
        if (i1 != 3 && q3 > b2) { b2 = q3; i2 = 3; }
        const float inv = pg / (b1 + b2);
        ea = grp * 4 + i1; eb = grp * 4 + i2; wa = b1 * inv; wb = b2 * inv;
        la = atomicAdd(lcnt + ea, 1);
        lb_ = atomicAdd(lcnt + eb, 1);
    }
    __syncthreads();
    if (tid < 16) lcnt[16 + tid] = atomicAdd((int*)(p.ws + OFF_CNT) + layer * 16 + tid, lcnt[tid]);
    __syncthreads();
    if (tid < nrows) {
        int* ltok = (int*)(p.ws + OFF_LTOK);
        float* lw = (float*)(p.ws + OFF_LW);
        int* ts = (int*)(p.ws + OFF_TSLOT) + row * 2;
        const int pa = lcnt[16 + ea] + la, pb = lcnt[16 + eb] + lb_;
        ltok[(size_t)ea * NTOK + pa] = row; lw[(size_t)ea * NTOK + pa] = wa;
        ltok[(size_t)eb * NTOK + pb] = row; lw[(size_t)eb * NTOK + pb] = wb;
        ts[0] = (ea << 16) | pa; ts[1] = (eb << 16) | pb;
    }
    __syncthreads();
}

__device__ __forceinline__ int stage_col(int tid) { return ((tid & 7) ^ ((tid >> 3) & 7)) * 8; }

template <class Epi>
__device__ __forceinline__ void gemm_tile(const bf16_t* const (&ap)[4], const bf16_t* const (&bp)[2], int K, char* lds, const Ctx& cx, Epi&& epi) {
    const int tid = cx.tid, lane = cx.lane, wr = cx.wid >> 1, wc = cx.wid & 1, fr = lane & 15, fq = lane >> 4;
    f32x4 acc[4][4];
#pragma unroll
    for (int m = 0; m < 4; ++m)
#pragma unroll
        for (int n = 0; n < 4; ++n) acc[m][n] = (f32x4){0.f, 0.f, 0.f, 0.f};
    const int nt = K / 64;
    auto stage = [&](int t, int slot) {
        char* SA = lds + slot * GEMM_STAGE + tid * 16; char* SB = SA + 32768;
        const int ko = t * 64;
#pragma unroll
        for (int i = 0; i < 4; ++i) glds16(ap[i] + ko, SA + i * 8192);
#pragma unroll
        for (int i = 0; i < 2; ++i) glds16(bp[i] + ko, SB + i * 8192);
    };
    __syncthreads();
    stage(0, 0);
    if (nt > 1) stage(1, 1);
    const int x7 = fr & 7;
    const int aoff = (wr * 64 + fr) * 128, boff = 32768 + (wc * 64 + fr) * 128;
    int slot = 0;
    for (int kt = 0; kt < nt; ++kt) {
        if (kt + 1 < nt) asm volatile("s_waitcnt vmcnt(6)" ::: "memory");
        else asm volatile("s_waitcnt vmcnt(0)" ::: "memory");
        __builtin_amdgcn_s_barrier();
        if (kt + 2 < nt) stage(kt + 2, slot >= 1 ? slot - 1 : 2);
        const char* S = lds + slot * GEMM_STAGE;
#pragma unroll
        for (int ks = 0; ks < 2; ++ks) {
            const int pc = ((ks * 4 + fq) ^ x7) * 16;
            bf16x8 Af[4], Bf[4];
#pragma unroll
            for (int m = 0; m < 4; ++m) Af[m] = *(const bf16x8*)(S + aoff + m * 2048 + pc);
#pragma unroll
            for (int n = 0; n < 4; ++n) Bf[n] = *(const bf16x8*)(S + boff + n * 2048 + pc);
#pragma unroll
            for (int m = 0; m < 4; ++m)
#pragma unroll
                for (int n = 0; n < 4; ++n) acc[m][n] = __builtin_amdgcn_mfma_f32_16x16x32_bf16(Bf[n], Af[m], acc[m][n], 0, 0, 0);
        }
        slot = slot == 2 ? 0 : slot + 1;
    }
    epi(acc, wr, wc, fr, fq);
}

__device__ __forceinline__ int swz_g(int q) { return (0x1320 >> (4 * q)) & 3; }
__device__ __forceinline__ int stage_col2(int tid) { return ((tid & 3) ^ swz_g((tid >> 4) & 3)) * 8; }

template <int MODE = 0, class Epi>
__device__ __forceinline__ void gemm_tile2(const bf16_t* const (&ap)[2], const bf16_t* const (&bp)[2], int K, char* lds, const Ctx& cx, Epi&& epi) {
    const int tid = cx.tid, lane = cx.lane, wc = cx.wid & 3, fr = lane & 15, fq = lane >> 4;
    const int wr = __builtin_amdgcn_readfirstlane(cx.wid >> 2);
    f32x4 acc[8][4];
#pragma unroll
    for (int m = 0; m < 8; ++m)
#pragma unroll
        for (int n = 0; n < 4; ++n) acc[m][n] = (f32x4){0.f, 0.f, 0.f, 0.f};
    const int nt = K / 32;
    auto stage = [&](int t) {
        char* SA = lds + (t & 3) * 32768 + tid * 16; char* SB = SA + 16384;
        const int ko = t * 32;
        glds16(ap[0] + ko, SA); glds16(ap[1] + ko, SA + 8192);
        glds16(bp[0] + ko, SB); glds16(bp[1] + ko, SB + 8192);
    };
    __syncthreads();
    stage(0);
    if (nt > 1) stage(1);
    if (nt > 2) stage(2);
    const int pc = (fq ^ swz_g((fr >> 2) & 3)) * 16;
    const int aoff = (wr * 128 + fr) * 64 + pc, boff = 16384 + (wc * 64 + fr) * 64 + pc;
    bf16x8 Af[8], Bf[4];
    auto load_frags = [&](int kt) {
        const char* S = lds + (kt & 3) * 32768;
#pragma unroll
        for (int n = 0; n < 4; ++n) Bf[n] = *(const bf16x8*)(S + boff + n * 1024);
#pragma unroll
        for (int m = 0; m < 8; ++m) Af[m] = *(const bf16x8*)(S + aoff + m * 1024);
        asm volatile("s_waitcnt lgkmcnt(0)" ::: "memory");
    };
    auto mma = [&]() {
        __builtin_amdgcn_s_setprio(1);
#pragma unroll
        for (int m = 0; m < 8; ++m)
#pragma unroll
            for (int n = 0; n < 4; ++n) acc[m][n] = __builtin_amdgcn_mfma_f32_16x16x32_bf16(Bf[n], Af[m], acc[m][n], 0, 0, 0);
        __builtin_amdgcn_s_setprio(0);
    };
    if (nt > 2) asm volatile("s_waitcnt vmcnt(8)" ::: "memory");
    else if (nt == 2) asm volatile("s_waitcnt vmcnt(4)" ::: "memory");
    else asm volatile("s_waitcnt vmcnt(0)" ::: "memory");
    if (wr == 1) __builtin_amdgcn_s_barrier();
    for (int kt = 0; kt < nt; ++kt) {
        const int rem = nt - 1 - kt;
        if (rem >= 2) asm volatile("s_waitcnt vmcnt(8)" ::: "memory");
        else if (rem == 1) asm volatile("s_waitcnt vmcnt(4)" ::: "memory");
        else asm volatile("s_waitcnt vmcnt(0)" ::: "memory");
        __builtin_amdgcn_s_barrier();
        if (kt + 3 < nt) stage(kt + 3);
        load_frags(kt);
        if (rem >= 3) asm volatile("s_waitcnt vmcnt(8)" ::: "memory");
        else if (rem == 2) asm volatile("s_waitcnt vmcnt(4)" ::: "memory");
        else asm volatile("s_waitcnt vmcnt(0)" ::: "memory");
        __builtin_amdgcn_s_barrier();
        mma();
    }
    if (wr == 0) __builtin_amdgcn_s_barrier();
    if (MODE == 0) epi(acc, wr, wc, fr, fq);
    else {
#pragma unroll
        for (int m = 0; m < 8; ++m)
#pragma unroll
            for (int n = 0; n < 4; ++n) asm volatile("" :: "v"(acc[m][n]));
    }
}

template <class GetFn, class EpiFn>
__device__ __forceinline__ void gemm_stream2(int my_tiles, int K, char* lds, const Ctx& cx, GetFn&& get, EpiFn&& epi) {
    if (my_tiles <= 0) return;
    const int tid = cx.tid, lane = cx.lane, wc = cx.wid & 3, fr = lane & 15, fq = lane >> 4;
    const int wr = __builtin_amdgcn_readfirstlane(cx.wid >> 2);
    f32x4 acc[8][4];
#pragma unroll
    for (int m = 0; m < 8; ++m)
#pragma unroll
        for (int n = 0; n < 4; ++n) acc[m][n] = (f32x4){0.f, 0.f, 0.f, 0.f};
    const int nt = K / 32, S = my_tiles * nt;
    const bf16_t* sap[2]; const bf16_t* sbp[2];
    int sj = 0, skt = 0, sg = 0;
    get(0, sap, sbp);
    auto stage_next = [&]() {
        char* SA = lds + (sg & 3) * 32768 + tid * 16; char* SB = SA + 16384;
        const int ko = skt * 32;
        glds16(sap[0] + ko, SA); glds16(sap[1] + ko, SA + 8192);
        glds16(sbp[0] + ko, SB); glds16(sbp[1] + ko, SB + 8192);
        ++sg; ++skt;
        if (skt == nt) { skt = 0; ++sj; if (sj < my_tiles) get(sj, sap, sbp); }
    };
    __syncthreads();
    stage_next();
    if (S > 1) stage_next();
    if (S > 2) stage_next();
    const int pc = (fq ^ swz_g((fr >> 2) & 3)) * 16;
    const int aoff = (wr * 128 + fr) * 64 + pc, boff = 16384 + (wc * 64 + fr) * 64 + pc;
    bf16x8 Af[8], Bf[4];
    int g = 0;
    for (int cj = 0; cj < my_tiles; ++cj) {
        {
            const int rem0 = S - 1 - g;
            if (rem0 >= 2) asm volatile("s_waitcnt vmcnt(8)" ::: "memory");
            else if (rem0 == 1) asm volatile("s_waitcnt vmcnt(4)" ::: "memory");
            else asm volatile("s_waitcnt vmcnt(0)" ::: "memory");
        }
        if (wr == 1) __builtin_amdgcn_s_barrier();
        for (int kt = 0; kt < nt; ++kt, ++g) {
            const int rem = S - 1 - g;
            if (rem >= 2) asm volatile("s_waitcnt vmcnt(8)" ::: "memory");
            else if (rem == 1) asm volatile("s_waitcnt vmcnt(4)" ::: "memory");
            else asm volatile("s_waitcnt vmcnt(0)" ::: "memory");
            __builtin_amdgcn_s_barrier();
            if (g + 3 < S) stage_next();
            {
                const char* Sx = lds + (g & 3) * 32768;
#pragma unroll
                for (int n = 0; n < 4; ++n) Bf[n] = *(const bf16x8*)(Sx + boff + n * 1024);
#pragma unroll
                for (int m = 0; m < 8; ++m) Af[m] = *(const bf16x8*)(Sx + aoff + m * 1024);
                asm volatile("s_waitcnt lgkmcnt(0)" ::: "memory");
            }
            if (rem >= 3) asm volatile("s_waitcnt vmcnt(8)" ::: "memory");
            else if (rem == 2) asm volatile("s_waitcnt vmcnt(4)" ::: "memory");
            else asm volatile("s_waitcnt vmcnt(0)" ::: "memory");
            __builtin_amdgcn_s_barrier();
            __builtin_amdgcn_s_setprio(1);
#pragma unroll
            for (int m = 0; m < 8; ++m)
#pragma unroll
                for (int n = 0; n < 4; ++n) acc[m][n] = __builtin_amdgcn_mfma_f32_16x16x32_bf16(Bf[n], Af[m], acc[m][n], 0, 0, 0);
            __builtin_amdgcn_s_setprio(0);
        }
        if (wr == 0) __builtin_amdgcn_s_barrier();
        epi(cj, acc, wr, wc, fr, fq);
#pragma unroll
        for (int m = 0; m < 8; ++m)
#pragma unroll
            for (int n = 0; n < 4; ++n) acc[m][n] = (f32x4){0.f, 0.f, 0.f, 0.f};
    }
}

template <int MODE = 0, class EpiFactory>
__device__ __forceinline__ void gemm_phase_dense2(const bf16_t* A, int lda, const bf16_t* Bt, int K, int nrt, int nct, char* lds, const Ctx& cx, EpiFactory&& mk) {
    const int tid = cx.tid;
    const int ntiles = nrt * nct;
    const int sc = stage_col2(tid), sr = tid >> 2;
    const int my_tiles = cx.vbid < ntiles ? (ntiles - cx.vbid + cx.G - 1) / cx.G : 0;
    const int vb = cx.vbid, G = cx.G;
    gemm_stream2(my_tiles, K, lds, cx,
        [=](int j, const bf16_t* (&ap)[2], const bf16_t* (&bp)[2]) {
            const int tile = vb + j * G, rt = tile / nct, ct = tile % nct;
            ap[0] = A + (size_t)(rt * 256 + sr) * lda + sc; ap[1] = ap[0] + (size_t)128 * lda;
            bp[0] = Bt + (size_t)(ct * 256 + sr) * K + sc; bp[1] = bp[0] + (size_t)128 * K;
        },
        [=](int j, f32x4 (&acc)[8][4], int wr, int wc, int fr, int fq) {
            const int tile = vb + j * G, rt = tile / nct, ct = tile % nct;
            mk(rt * 256, ct * 256)(acc, wr, wc, fr, fq);
        });
}

__device__ __forceinline__ void phase_nsa_inproj(const Params& p, const Ctx& cx, char* lds) {
    const bf16_t* A = (const bf16_t*)(p.ws + OFF_HA);
    const bf16_t* Bt = (const bf16_t*)(p.ws + OFF_W_NSA_IN);
    char* ws = p.ws;
    const float* qg = p.nsa_q_gain;
    const float* kg = p.nsa_k_gain;
    gemm_phase_dense2(A, 1024, Bt, 1024, NTOK / 256, NSA_IN_PAD / 256, lds, cx, [=](int row0, int col0) {
        return [=](f32x4 (&acc)[8][4], int wr, int wc, int fr, int fq) {
            const int gc0 = col0 + wc * 64;
            if (gc0 >= NSA_IN) return;
            if (gc0 < 1024 || (gc0 >= 1536 && gc0 < 1792) || (gc0 >= 2048 && gc0 < 2304)) {
                const float* gain; float post; bf16_t* dstb; size_t rstride; size_t coff; bool tokmajor;
                if (gc0 < 1024) { gain = qg; post = 0.125f * 1.4426950408889634f; }
                else if (gc0 < 1792) { gain = kg + 64; post = 1.f; }
                else { gain = kg + 128; post = 1.f; }
#pragma unroll
                for (int m = 0; m < 8; ++m) {
                    __builtin_amdgcn_sched_barrier(0);
                    float ss = 0.f;
#pragma unroll
                    for (int n = 0; n < 4; ++n) ss += acc[m][n][0] * acc[m][n][0] + acc[m][n][1] * acc[m][n][1] + acc[m][n][2] * acc[m][n][2] + acc[m][n][3] * acc[m][n][3];
                    ss += __shfl_xor(ss, 16); ss += __shfl_xor(ss, 32);
                    const float r = rsqrtf(ss * (1.f / 64.f) + EPS) * post;
                    const int row = row0 + wr * 128 + m * 16 + fr;
                    bf16_t* dst;
                    if (gc0 < 1024) dst = (bf16_t*)(ws + OFF_Q) + (size_t)row * 1024 + gc0;
                    else {
                        const int g = ((gc0 - 1024) & 255) >> 6, b = row >> 11, t = row & 2047;
                        dst = (bf16_t*)(ws + (gc0 < 1792 ? OFF_KS : OFF_KW)) + ((size_t)(b * 4 + g) * 2048 + t) * 64;
                    }
#pragma unroll
                    for (int pp = 0; pp < 2; ++pp) {
                        const int c = pp * 32 + fq * 8;
                        const f32x4 ga = *(const f32x4*)(gain + c), gb = *(const f32x4*)(gain + c + 4);
                        const f32x4 a = acc[m][2 * pp], bb = acc[m][2 * pp + 1];
                        uint4 o; o.x = pack2(a[0] * r * ga[0], a[1] * r * ga[1]); o.y = pack2(a[2] * r * ga[2], a[3] * r * ga[3]);
                        o.z = pack2(bb[0] * r * gb[0], bb[1] * r * gb[1]); o.w = pack2(bb[2] * r * gb[2], bb[3] * r * gb[3]);
                        *(uint4*)(dst + c) = o;
                    }
                }
            } else if (gc0 < 2560) {
                const int seg = (gc0 - 1024) >> 8;
                const int g = ((gc0 - 1024) & 255) >> 6;
                if (seg < 2) {
                    const size_t off = seg == 0 ? OFF_KCRAW : OFF_VCRAW;
#pragma unroll
                    for (int m = 0; m < 8; ++m) {
                        __builtin_amdgcn_sched_barrier(0);
                    __builtin_amdgcn_sched_barrier(0);
                        const int row = row0 + wr * 128 + m * 16 + fr, b = row >> 11, t = row & 2047;
                        bf16_t* dst = (bf16_t*)(ws + off) + ((size_t)(b * 4 + g) * 2048 + t) * 64;
#pragma unroll
                        for (int pp = 0; pp < 2; ++pp) {
                            const f32x4 a = acc[m][2 * pp], bb = acc[m][2 * pp + 1];
                            uint4 o; o.x = pack2(a[0], a[1]); o.y = pack2(a[2], a[3]); o.z = pack2(bb[0], bb[1]); o.w = pack2(bb[2], bb[3]);
                            *(uint4*)(dst + pp * 32 + fq * 8) = o;
                        }
                    }
                } else {
                    const size_t off = seg == 3 ? OFF_VS : OFF_VW;
#pragma unroll
                    for (int m = 0; m < 8; ++m) {
                        __builtin_amdgcn_sched_barrier(0);
                    __builtin_amdgcn_sched_barrier(0);
                        const int row = row0 + wr * 128 + m * 16 + fr, b = row >> 11, t = row & 2047;
                        bf16_t* dst = (bf16_t*)(ws + off) + (size_t)(b * 4 + g) * 64 * 2048 + t;
#pragma unroll
                        for (int n = 0; n < 4; ++n)
#pragma unroll
                            for (int j = 0; j < 4; ++j) dst[(size_t)(pcol(n, fq) + j) * 2048] = f2bf(acc[m][n][j]);
                    }
                }
            } else {
#pragma unroll
                for (int m = 0; m < 8; ++m) {
                    __builtin_amdgcn_sched_barrier(0);
                    const int row = row0 + wr * 128 + m * 16 + fr;
                    float* dst = (float*)(ws + OFF_GATES) + (size_t)row * 48;
#pragma unroll
                    for (int n = 0; n < 4; ++n) {
                        const int c = pcol(n, fq);
                        f32x4 o;
#pragma unroll
                        for (int j = 0; j < 4; ++j) o[j] = sigmoid_f(acc[m][n][j]);
                        if (c < 48) *(f32x4*)(dst + c) = o;
                    }
                }
            }
        };
    });
}

__device__ __forceinline__ void phase_cmp1(const Params& p, const Ctx& cx, char* lds) {
    const int tid = cx.tid;
    const float* peb = (const float*)(p.ws + OFF_PEB);
    float* T1 = (float*)(p.ws + OFF_T1);
    const int sc = stage_col(tid), sr = tid >> 3;
    for (int tile = cx.vbid; tile < 64; tile += cx.G) {
        const int kv = tile >> 5, bg2 = tile & 31;
        const bf16_t* raw = (const bf16_t*)(p.ws + (kv ? OFF_VCRAW : OFF_KCRAW)) + (size_t)bg2 * 2 * 2048 * 64;
        const bf16_t* a0 = raw + (size_t)sr * 1024 + sc;
        const bf16_t* a2 = raw + (size_t)2048 * 64 + (size_t)sr * 1024 + sc;
        const bf16_t* b0 = (const bf16_t*)(p.ws + OFF_W_CMP1) + ((size_t)kv * 128 + sr) * 2048 + sc;
        const bf16_t* const ap[4] = {a0, a0 + (size_t)64 * 1024, a2, a2 + (size_t)64 * 1024};
        const bf16_t* const bp[2] = {b0, b0 + (size_t)64 * 2048};
        gemm_tile(ap, bp, 2048, lds, cx, [=](f32x4 (&acc)[4][4], int wr, int wc, int fr, int fq) {
            if (wc != 0) return;
#pragma unroll
            for (int m = 0; m < 4; ++m) {
                const int r = wr * 64 + m * 16 + fr;
                float* dst = T1 + ((size_t)kv * 8192 + (bg2 * 2 + (r >> 7)) * 128 + (r & 127)) * 64;
#pragma unroll
                for (int n = 0; n < 4; ++n) {
                    const int c = n * 16 + fq * 4;
                    f32x4 pb = *(const f32x4*)(peb + kv * 64 + c);
                    *(f32x4*)(dst + c) = acc[m][n] + pb;
                }
            }
        });
    }
}

__device__ __forceinline__ void phase_cmp2(const Params& p, const Ctx& cx) {
    const int lane = cx.lane;
    const float* T1 = (const float*)(p.ws + OFF_T1);
    for (int r = cx.vbid * NWAVE + cx.wid; r < 2 * 8192; r += cx.G * NWAVE) {
        const int kv = r >> 13, rr = r & 8191, n_ = rr & 127;
        const float s = silu_f(T1[(size_t)r * 64 + lane]);
        const float* w2 = p.nsa_cmp_w2 + kv * 4096 + lane;
        float o = 0.f;
#pragma unroll 8
        for (int j = 0; j < 64; ++j) o += __shfl(s, j) * w2[j * 64];
        if (kv == 0) {
            const float ss = wave_sum(o * o);
            o = o * rsqrtf(ss * (1.f / 64.f) + EPS) * p.nsa_k_gain[lane];
        }
        if (n_ == 127) o = 0.f;
        if (kv == 0) ((bf16_t*)(p.ws + OFF_KC))[(size_t)rr * 64 + lane] = f2bf(o);
        else ((bf16_t*)(p.ws + OFF_VC))[((size_t)(rr >> 7) * 64 + lane) * 128 + n_] = f2bf(o);
    }
}

constexpr int ATT_BUF = 17920, ATT_K_STRIDE = 144, ATT_V_OFF = 9216, ATT_V_STRIDE = 136, ATT_LUT_OFF = 2 * ATT_BUF, LUT_N = 2136, LUT_PAD = 80;
constexpr int ATT_SC_OFF = ATT_LUT_OFF + 4 * LUT_N * 4;
static_assert(ATT_SC_OFF + NWAVE * 8192 <= LDS_TAB_OFF, "attention LDS");
#define MFMA32(a, b, c) __builtin_amdgcn_mfma_f32_32x32x16_bf16((a), (b), (c), 0, 0, 0)
template <int V> struct IC { static constexpr int value = V; };

__device__ __forceinline__ void phase_attn(const Params& p, const Ctx& cx, char* lds) {
    const int tid = cx.tid, lane = cx.lane, wid = cx.wid;
    const int g = cx.vbid & 3;
    const int ql = lane & 7, head = (lane & 31) >> 3, h2 = lane >> 5, l31 = lane & 31;
    float* lut = (float*)(lds + ATT_LUT_OFF);
    for (int i = tid; i < 4 * LUT_N; i += NTHR) {
        const int h = i / LUT_N, dist = i % LUT_N - LUT_PAD;
        lut[i] = dist >= 0 ? p.rel_bias[t5_bucket(dist) * 16 + g * 4 + h] * 1.4426950408889634f : 0.f;
    }
    __syncthreads();
    const float* lutp = lut + head * LUT_N + LUT_PAD;
    const float b31 = lutp[2047];
    const bf16_t* Qb = (const bf16_t*)(p.ws + OFF_Q);
    const bf16_t* KC = (const bf16_t*)(p.ws + OFF_KC);
    const bf16_t* VCT = (const bf16_t*)(p.ws + OFF_VC);
    const bf16_t* KS = (const bf16_t*)(p.ws + OFF_KS);
    const bf16_t* VST = (const bf16_t*)(p.ws + OFF_VS);
    const bf16_t* KW = (const bf16_t*)(p.ws + OFF_KW);
    const bf16_t* VWT = (const bf16_t*)(p.ws + OFF_VW);
    const float* GT = (const float*)(p.ws + OFF_GATES);
    bf16_t* Og = (bf16_t*)(p.ws + OFF_HA);
    float* scw = (float*)(lds + ATT_SC_OFF) + wid * 2048;
    f32x4* outw = (f32x4*)(lds + ATT_SC_OFF + wid * 8192) + lane;
    const bool flip_ok = (cx.G % 128) == 0;
    const int widu = __builtin_amdgcn_readfirstlane(wid);

    for (int it = 0;; ++it) {
        const int u = cx.vbid + it * cx.G;
        if (u >= 2048) break;
        const int rest = u >> 2, b = rest >> 5, qtb = rest & 31;
        const int qt = (flip_ok && (it & 1)) ? 31 - qtb : qtb;
        const int t0 = qt * 64, cur = qt, bg = b * 4 + g;
        const int tq = t0 + wid * 8 + ql;
        const size_t rowtok = (size_t)b * SEQ + tq;
        bf16x8 Qf[4];
        {
            const bf16_t* qp = Qb + rowtok * 1024 + (g * 4 + head) * 64 + 8 * h2;
#pragma unroll
            for (int ks = 0; ks < 4; ++ks) Qf[ks] = *(const bf16x8*)(qp + 16 * ks);
        }
        const float* gt = GT + rowtok * 48 + (g * 4 + head) * 3;
        const float gate_c = gt[0], gate_s = gt[1], gate_w = gt[2];
        const int wlo = max(0, qt - 8);
        const int nW = cur - wlo + 1;
        const int ncp = (t0 + 63 >= 31 + 16 * 64) ? 2 : 1;
        const int NC = ncp;
        const int NT = NC + nW + cur + 1;

        uint4 kr0, vr0;
        auto issue_load = [&](int i) {
            const bf16_t* ksrc; const bf16_t* vsrc; int vstride;
            if (i < NC) { const int ci = i; ksrc = KC + ((size_t)bg * 128 + ci * 64) * 64; vsrc = VCT + (size_t)bg * 64 * 128 + ci * 64; vstride = 128; }
            else if (i < NC + nW) { const int kb = wlo + i - NC; ksrc = KW + ((size_t)bg * 2048 + kb * 64) * 64; vsrc = VWT + (size_t)bg * 64 * 2048 + kb * 64; vstride = 2048; }
            else { const int kb = i - NC - nW; ksrc = KS + ((size_t)bg * 2048 + kb * 64) * 64; vsrc = VST + (size_t)bg * 64 * 2048 + kb * 64; vstride = 2048; }
            kr0 = *(const uint4*)(ksrc + tid * 8);
            vr0 = *(const uint4*)(vsrc + (size_t)(tid >> 3) * vstride + (tid & 7) * 8);
        };
        auto write_lds = [&](int i) {
            char* bufp = lds + (i & 1) * ATT_BUF;
            *(uint4*)(bufp + (tid >> 3) * ATT_K_STRIDE + (tid & 7) * 16) = kr0;
            char* va = bufp + ATT_V_OFF + (tid >> 3) * ATT_V_STRIDE + (tid & 7) * 16;
            uint2 t;
            t.x = vr0.x; t.y = vr0.y; *(uint2*)va = t;
            t.x = vr0.z; t.y = vr0.w; *(uint2*)(va + 8) = t;
        };
        f32x16 O0, O1;
#pragma unroll
        for (int r = 0; r < 16; ++r) { O0[r] = 0.f; O1[r] = 0.f; }
        float lsum = 0.f;

        auto qk = [&](const char* bufp, int kt2, float init) -> f32x16 {
            f32x16 S;
#pragma unroll
            for (int r = 0; r < 16; ++r) S[r] = init;
            const char* kp = bufp + (32 * kt2 + l31) * ATT_K_STRIDE + 16 * h2;
            bf16x8 kf[4];
#pragma unroll
            for (int ks = 0; ks < 4; ++ks) kf[ks] = *(const bf16x8*)(kp + 32 * ks);
            __builtin_amdgcn_sched_barrier(0);
#pragma unroll
            for (int ks = 0; ks < 4; ++ks) S = MFMA32(kf[ks], Qf[ks], S);
            return S;
        };
        auto pv = [&](const char* bufp, int kt2, const f32x16& P) {
            const char* vp = bufp + ATT_V_OFF + l31 * ATT_V_STRIDE + (32 * kt2 + 4 * h2) * 2;
            uint2 va[2][2][2];
#pragma unroll
            for (int s2 = 0; s2 < 2; ++s2)
#pragma unroll
                for (int dt = 0; dt < 2; ++dt) {
                    va[s2][dt][0] = *(const uint2*)(vp + dt * 32 * ATT_V_STRIDE + s2 * 32);
                    va[s2][dt][1] = *(const uint2*)(vp + dt * 32 * ATT_V_STRIDE + s2 * 32 + 16);
                }
            __builtin_amdgcn_sched_barrier(0);
#pragma unroll
            for (int s2 = 0; s2 < 2; ++s2) {
                uint4 pk;
                pk.x = pack2(P[8 * s2 + 0], P[8 * s2 + 1]); pk.y = pack2(P[8 * s2 + 2], P[8 * s2 + 3]);
                pk.z = pack2(P[8 * s2 + 4], P[8 * s2 + 5]); pk.w = pack2(P[8 * s2 + 6], P[8 * s2 + 7]);
                const bf16x8 Pf = __builtin_bit_cast(bf16x8, pk);
                uint4 a0, a1;
                a0.x = va[s2][0][0].x; a0.y = va[s2][0][0].y; a0.z = va[s2][0][1].x; a0.w = va[s2][0][1].y;
                a1.x = va[s2][1][0].x; a1.y = va[s2][1][0].y; a1.z = va[s2][1][1].x; a1.w = va[s2][1][1].y;
                O0 = MFMA32(__builtin_bit_cast(bf16x8, a0), Pf, O0);
                O1 = MFMA32(__builtin_bit_cast(bf16x8, a1), Pf, O1);
            }
        };
        auto finalize = [&](float gate, int mode) {
            const float Z = lsum + __shfl_xor(lsum, 32);
            const float f = Z > 0.f ? gate / Z : 0.f;
#pragma unroll
            for (int v4 = 0; v4 < 4; ++v4) {
                f32x4 a = {f * O0[4 * v4], f * O0[4 * v4 + 1], f * O0[4 * v4 + 2], f * O0[4 * v4 + 3]};
                f32x4 c = {f * O1[4 * v4], f * O1[4 * v4 + 1], f * O1[4 * v4 + 2], f * O1[4 * v4 + 3]};
                if (mode != 0) { a += outw[v4 * 64]; c += outw[(4 + v4) * 64]; }
                if (mode != 2) { outw[v4 * 64] = a; outw[(4 + v4) * 64] = c; }
                else { O0[4 * v4] = a[0]; O0[4 * v4 + 1] = a[1]; O0[4 * v4 + 2] = a[2]; O0[4 * v4 + 3] = a[3];
                       O1[4 * v4] = c[0]; O1[4 * v4 + 1] = c[1]; O1[4 * v4 + 2] = c[2]; O1[4 * v4 + 3] = c[3]; }
            }
            if (mode != 2) {
#pragma unroll
                for (int r = 0; r < 16; ++r) { O0[r] = 0.f; O1[r] = 0.f; }
            }
            lsum = 0.f;
        };
        auto tile_ws = [&](const char* bufp, int kb, float cinit, auto MMc, auto BMc) {
            constexpr int MM = decltype(MMc)::value, BM = decltype(BMc)::value;
#pragma unroll 1
            for (int kt2 = 0; kt2 < 2; ++kt2) {
                const int d0 = tq - (64 * kb + 32 * kt2 + 4 * h2);
                const float* lp = lutp + (d0 - 27);
                float bv[16];
                if (BM == 0) {
#pragma unroll
                    for (int r = 0; r < 16; ++r) bv[r] = lp[27 - ((r & 3) + 8 * (r >> 2))];
                    __builtin_amdgcn_sched_barrier(0);
                }
                f32x16 S = qk(bufp, kt2, cinit);
#pragma unroll
                for (int r = 0; r < 16; ++r) {
                    const int cr = (r & 3) + 8 * (r >> 2);
                    float x = S[r];
                    if (BM == 0) x += bv[r];
                    if (MM == 1) x += (d0 - cr < 512) ? 0.f : -INFINITY;
                    if (MM == 2) x += (d0 - cr >= 0) ? 0.f : -INFINITY;
                    S[r] = __builtin_amdgcn_exp2f(x);
                    lsum += S[r];
                }
                pv(bufp, kt2, S);
            }
        };

        const int nvis = (tq >= 31) ? min((tq - 31) / 16 + 1, 127) : 0;
        unsigned selmask = 0u;
        float* sown = scw + (head * 8 + ql) * 32;
        float* stail = scw + 1024 + (head * 8 + ql) * 32;
        float* ssc = scw + ql * 32;
        issue_load(0);
        __syncthreads();
        write_lds(0);
        issue_load(1);
        for (int i = 0; i < NT; ++i) {
            __syncthreads();
            const char* bufp = lds + (i & 1) * ATT_BUF;
            if (i < NC) {
                const int ci = i;
#pragma unroll 1
                for (int kt2 = 0; kt2 < 2; ++kt2) {
                    const int n0 = 64 * ci + 32 * kt2 + 4 * h2;
                    const int d0 = tq - 31 - 16 * n0;
                    float bv[16];
#pragma unroll
                    for (int r = 0; r < 16; ++r) bv[r] = lutp[max(d0 - 16 * ((r & 3) + 8 * (r >> 2)), -LUT_PAD)];
                    __builtin_amdgcn_sched_barrier(0);
                    f32x16 S = qk(bufp, kt2, 0.f);
#pragma unroll
                    for (int r = 0; r < 16; ++r) {
                        const int cr = (r & 3) + 8 * (r >> 2);
                        S[r] = __builtin_amdgcn_exp2f(S[r] + bv[r] + ((n0 + cr) < nvis ? 0.f : -INFINITY));
                        lsum += S[r];
                    }
                    pv(bufp, kt2, S);
#pragma unroll
                    for (int rq = 0; rq < 4; ++rq) {
                        const int sblk = 8 * (2 * ci + kt2) + 2 * rq + h2;
                        sown[sblk] = S[4 * rq] + S[4 * rq + 1] + S[4 * rq + 2] + 0.5f * S[4 * rq + 3];
                        if (sblk < 31) stail[sblk + 1] = 0.5f * S[4 * rq + 3];
                    }
                }
                if (i == NC - 1) {
                    const float Z = lsum + __shfl_xor(lsum, 32);
                    const float inv_mine = Z > 0.f ? 1.f / Z : 0.f;
                    if (h2 == 0) stail[0] = 0.f;
                    __builtin_amdgcn_wave_barrier();
                    const int j8 = head * 2 + h2;
                    {
                        f32x4 sc = {0.f, 0.f, 0.f, 0.f};
#pragma unroll
                        for (int hh = 0; hh < 4; ++hh) {
                            const float invh = __shfl(inv_mine, hh * 8 + ql);
                            const f32x4 a = *(const f32x4*)(scw + (hh * 8 + ql) * 32 + 4 * j8), t4 = *(const f32x4*)(scw + 1024 + (hh * 8 + ql) * 32 + 4 * j8);
                            sc += (a + t4) * invh;
                        }
#pragma unroll
                        for (int q = 0; q < 4; ++q) {
                            const int sblk = 4 * j8 + q;
                            const bool forced = (sblk == 0) || (sblk == cur) || (sblk == cur - 1);
                            sc[q] = forced ? 1.0e4f : (sblk <= cur ? sc[q] : -1.0f);
                        }
                        __builtin_amdgcn_wave_barrier();
                        *(f32x4*)(ssc + 4 * j8) = sc;
                    }
                    __builtin_amdgcn_wave_barrier();
                    const f32x4 own = *(const f32x4*)(ssc + 4 * j8);
                    int rk0 = 0, rk1 = 0, rk2 = 0, rk3 = 0;
                    const int so0 = 4 * j8;
#pragma unroll
                    for (int m4 = 0; m4 < 8; ++m4) {
                        const f32x4 v = *(const f32x4*)(ssc + 4 * m4);
#pragma unroll
                        for (int q = 0; q < 4; ++q) {
                            const int sm = 4 * m4 + q;
                            const float vm = v[q];
                            rk0 += (vm > own[0] || (vm == own[0] && sm < so0)) ? 1 : 0;
                            rk1 += (vm > own[1] || (vm == own[1] && sm < so0 + 1)) ? 1 : 0;
                            rk2 += (vm > own[2] || (vm == own[2] && sm < so0 + 2)) ? 1 : 0;
                            rk3 += (vm > own[3] || (vm == own[3] && sm < so0 + 3)) ? 1 : 0;
                        }
                    }
                    unsigned mk = ((rk0 < 8 ? 1u : 0u) | (rk1 < 8 ? 2u : 0u) | (rk2 < 8 ? 4u : 0u) | (rk3 < 8 ? 8u : 0u)) << so0;
                    mk |= __shfl_xor(mk, 8); mk |= __shfl_xor(mk, 16); mk |= __shfl_xor(mk, 32);
                    selmask = mk;
                    __builtin_amdgcn_wave_barrier();
                    finalize(gate_c, 0);
                }
            } else if (i < NC + nW) {
                const int kb = wlo + i - NC;
                if (kb == cur) tile_ws(bufp, kb, 0.f, IC<2>{}, IC<0>{});
                else if (kb == cur - 8) tile_ws(bufp, kb, 0.f, IC<1>{}, IC<0>{});
                else tile_ws(bufp, kb, 0.f, IC<0>{}, IC<0>{});
                if (i == NC - 1 + nW) finalize(gate_w, 1);
            } else {
                const int kb = i - NC - nW;
                const bool sel = ((selmask >> kb) & 1u) != 0;
                if (__ballot(sel) != 0ull) {
                    const float neg = sel ? 0.f : -INFINITY;
                    if (kb == cur) tile_ws(bufp, kb, neg, IC<2>{}, IC<0>{});
                    else if (t0 + 8 * widu - (64 * kb + 63) >= 790) tile_ws(bufp, kb, neg + b31, IC<0>{}, IC<1>{});
                    else tile_ws(bufp, kb, neg, IC<0>{}, IC<0>{});
                }
            }
            if (i + 1 < NT) {
                write_lds(i + 1);
                if (i + 2 < NT) issue_load(i + 2);
            }
        }
        finalize(gate_s, 2);
        {
            bf16_t* op = Og + rowtok * 1024 + (g * 4 + head) * 64 + 4 * h2;
#pragma unroll
            for (int rq = 0; rq < 4; ++rq) {
                uint2 o0; o0.x = pack2(O0[4 * rq], O0[4 * rq + 1]); o0.y = pack2(O0[4 * rq + 2], O0[4 * rq + 3]);
                uint2 o1; o1.x = pack2(O1[4 * rq], O1[4 * rq + 1]); o1.y = pack2(O1[4 * rq + 2], O1[4 * rq + 3]);
                *(uint2*)(op + 8 * rq) = o0;
                *(uint2*)(op + 32 + 8 * rq) = o1;
            }
        }
    }
}

__device__ __forceinline__ void phase_outproj(const Params& p, const Ctx& cx, char* lds, const bf16_t* A, const bf16_t* Bt, const float* xin, int ls) {
    const float* mod = (const float*)(p.ws + OFF_MOD);
    float* xo = p.out;
    gemm_phase_dense2(A, 1024, Bt, 1024, NTOK / 256, 4, lds, cx, [=](int row0, int col0) {
        return [=](f32x4 (&acc)[8][4], int wr, int wc, int fr, int fq) {
            const int b = row0 >> 11;
            const float* gate = mod + ((size_t)ls * 16 + b) * 3072 + 2048 + col0 + wc * 64;
            f32x4 g[4];
#pragma unroll
            for (int n = 0; n < 4; ++n) g[n] = *(const f32x4*)(gate + pcol(n, fq));
#pragma unroll
            for (int m2 = 0; m2 < 8; m2 += 2) {
                f32x4 xi[2][4];
#pragma unroll
                for (int mm = 0; mm < 2; ++mm)
#pragma unroll
                    for (int n = 0; n < 4; ++n)
                        xi[mm][n] = *(const f32x4*)(xin + (size_t)(row0 + wr * 128 + (m2 + mm) * 16 + fr) * 1024 + col0 + wc * 64 + pcol(n, fq));
                __builtin_amdgcn_sched_barrier(0);
#pragma unroll
                for (int mm = 0; mm < 2; ++mm)
#pragma unroll
                    for (int n = 0; n < 4; ++n) {
                        f32x4 o;
#pragma unroll
                        for (int j = 0; j < 4; ++j) o[j] = xi[mm][n][j] + g[n][j] * acc[m2 + mm][n][j];
                        *(f32x4*)(xo + (size_t)(row0 + wr * 128 + (m2 + mm) * 16 + fr) * 1024 + col0 + wc * 64 + pcol(n, fq)) = o;
                    }
                __builtin_amdgcn_sched_barrier(0);
            }
        };
    });
}

__device__ __forceinline__ void moe_tables(const Params& p, int layer, int tid, int* s_cnt, int* s_off, int* s_toff) {
    __syncthreads();
    if (tid == 0) {
        const int* cnt = (const int*)(p.ws + OFF_CNT) + layer * 16;
        int o = 0, to = 0;
        for (int e = 0; e < 16; ++e) { const int c = cnt[e]; s_cnt[e] = c; s_off[e] = o; s_toff[e] = to; o += c; to += ((c + 255) >> 8) * 4; }
        s_off[16] = o; s_toff[16] = to;
    }
    __syncthreads();
}

constexpr int LDS_ROWIDX_OFF = 131072, LDS_LW_OFF = 131072 + 8192;
static_assert(LDS_LW_OFF + 8192 <= LDS_TAB_OFF, "moe caches");

__device__ __forceinline__ void phase_moe_up(const Params& p, const Ctx& cx, char* lds, int layer) {
    const int tid = cx.tid;
    int* s_cnt = (int*)(lds + LDS_TAB_OFF); int* s_off = s_cnt + 16; int* s_toff = s_off + 17;
    moe_tables(p, layer, tid, s_cnt, s_off, s_toff);
    const int ntiles = s_toff[16];
    const bf16_t* hA = (const bf16_t*)(p.ws + OFF_HA);
    const int* ltok = (const int*)(p.ws + OFF_LTOK);
    bf16_t* H1 = (bf16_t*)(p.ws + OFF_H1);
    int* rowidx = (int*)(lds + LDS_ROWIDX_OFF);
    const int sc = stage_col2(tid), sr = tid >> 2;
    const int vb = cx.vbid, G = cx.G;
    const int my_tiles = min(8, vb < ntiles ? (ntiles - vb + G - 1) / G : 0);
    auto locate = [=](int j, int& e, int& rt, int& ct) { const int tile = vb + j * G; e = 0; while (tile >= s_toff[e + 1]) ++e; const int lt = tile - s_toff[e]; rt = lt >> 2; ct = lt & 3; };
    for (int i = tid; i < my_tiles * 256; i += NTHR) {
        const int j = i >> 8, r = i & 255; int e, rt, ct; locate(j, e, rt, ct);
        rowidx[i] = ltok[(size_t)e * NTOK + min(rt * 256 + r, s_cnt[e] - 1)];
    }
    __syncthreads();
    const bf16_t* Wup = (const bf16_t*)(p.ws + OFF_W_UP) + (size_t)layer * 16 * 1024 * 1024;
    gemm_stream2(my_tiles, 1024, lds, cx,
        [=](int j, const bf16_t* (&ap)[2], const bf16_t* (&bp)[2]) {
            int e, rt, ct; locate(j, e, rt, ct);
            ap[0] = hA + (size_t)rowidx[j * 256 + sr] * 1024 + sc; ap[1] = hA + (size_t)rowidx[j * 256 + sr + 128] * 1024 + sc;
            bp[0] = Wup + ((size_t)e * 1024 + ct * 256 + sr) * 1024 + sc; bp[1] = bp[0] + (size_t)128 * 1024;
        },
        [=](int j, f32x4 (&acc)[8][4], int wr, int wc, int fr, int fq) {
            int e, rt, ct; locate(j, e, rt, ct);
            const int cnt = s_cnt[e], off = s_off[e];
#pragma unroll
            for (int m = 0; m < 8; ++m) {
                const int pos = rt * 256 + wr * 128 + m * 16 + fr;
                if (pos < cnt) {
                    bf16_t* dst = H1 + (size_t)(off + pos) * 512 + ct * 128 + wc * 32 + fq * 8;
                    float h[8];
#pragma unroll
                    for (int n = 0; n < 2; ++n)
#pragma unroll
                        for (int jj = 0; jj < 4; ++jj) h[n * 4 + jj] = silu_f(acc[m][n][jj]) * acc[m][n + 2][jj];
                    uint4 o; o.x = pack2(h[0], h[1]); o.y = pack2(h[2], h[3]); o.z = pack2(h[4], h[5]); o.w = pack2(h[6], h[7]);
                    *(uint4*)dst = o;
                }
            }
        });
}

__device__ __forceinline__ void phase_moe_down(const Params& p, const Ctx& cx, char* lds, int layer) {
    const int tid = cx.tid;
    int* s_cnt = (int*)(lds + LDS_TAB_OFF); int* s_off = s_cnt + 16; int* s_toff = s_off + 17;
    moe_tables(p, layer, tid, s_cnt, s_off, s_toff);
    const int ntiles = s_toff[16];
    const bf16_t* H1 = (const bf16_t*)(p.ws + OFF_H1);
    const float* lw = (const float*)(p.ws + OFF_LW);
    bf16_t* Y = (bf16_t*)(p.ws + OFF_Y);
    float* lwc = (float*)(lds + LDS_LW_OFF);
    const int sc = stage_col2(tid), sr = tid >> 2;
    const int vb = cx.vbid, G = cx.G;
    const int my_tiles = min(8, vb < ntiles ? (ntiles - vb + G - 1) / G : 0);
    auto locate = [=](int j, int& e, int& rt, int& ct) { const int tile = vb + j * G; e = 0; while (tile >= s_toff[e + 1]) ++e; const int lt = tile - s_toff[e]; rt = lt >> 2; ct = lt & 3; };
    for (int i = tid; i < my_tiles * 256; i += NTHR) {
        const int j = i >> 8, r = i & 255; int e, rt, ct; locate(j, e, rt, ct);
        lwc[i] = lw[(size_t)e * NTOK + min(rt * 256 + r, s_cnt[e] - 1)];
    }
    __syncthreads();
    const bf16_t* Wdn = (const bf16_t*)(p.ws + OFF_W_DN) + (size_t)layer * 16 * 1024 * 512;
    gemm_stream2(my_tiles, 512, lds, cx,
        [=](int j, const bf16_t* (&ap)[2], const bf16_t* (&bp)[2]) {
            int e, rt, ct; locate(j, e, rt, ct);
            const int cnt = s_cnt[e], off = s_off[e];
            ap[0] = H1 + (size_t)(off + min(rt * 256 + sr, cnt - 1)) * 512 + sc; ap[1] = H1 + (size_t)(off + min(rt * 256 + sr + 128, cnt - 1)) * 512 + sc;
            bp[0] = Wdn + ((size_t)e * 1024 + ct * 256 + sr) * 512 + sc; bp[1] = bp[0] + (size_t)128 * 512;
        },
        [=](int j, f32x4 (&acc)[8][4], int wr, int wc, int fr, int fq) {
            int e, rt, ct; locate(j, e, rt, ct);
            const int cnt = s_cnt[e], off = s_off[e];
#pragma unroll
            for (int m = 0; m < 8; ++m) {
                const int rl_ = wr * 128 + m * 16 + fr, pos = rt * 256 + rl_;
                if (pos < cnt) {
                    const float w = lwc[j * 256 + rl_];
                    bf16_t* dst = Y + (size_t)(off + pos) * 1024 + ct * 256 + wc * 64;
#pragma unroll
                    for (int pp = 0; pp < 2; ++pp) {
                        const f32x4 a = acc[m][2 * pp], bb = acc[m][2 * pp + 1];
                        uint4 o; o.x = pack2(w * a[0], w * a[1]); o.y = pack2(w * a[2], w * a[3]); o.z = pack2(w * bb[0], w * bb[1]); o.w = pack2(w * bb[2], w * bb[3]);
                        *(uint4*)(dst + pp * 32 + fq * 8) = o;
                    }
                }
            }
        });
}

template <int MODE = 0>
__device__ __forceinline__ void phase_hgrn_inproj(const Params& p, const Ctx& cx, char* lds) {
    const bf16_t* A = (const bf16_t*)(p.ws + OFF_HA);
    const bf16_t* Bt = (const bf16_t*)(p.ws + OFF_W_HG_IN);
    char* ws = p.ws;
    const float* lb = (const float*)(p.ws + OFF_LB);
    gemm_phase_dense2(A, 1024, Bt, 1024, NTOK / 256, 16, lds, cx, [=](int row0, int col0) {
        return [=](f32x4 (&acc)[8][4], int wr, int wc, int fr, int fq) {
            const int gc0 = col0 + wc * 64, seg = gc0 >> 10, c0 = gc0 & 1023;
#pragma unroll
            for (int m = 0; m < 8; ++m) {
                const int row = row0 + wr * 128 + m * 16 + fr;
#pragma unroll
                for (int pp = 0; pp < 2; ++pp) {
                    const int c = c0 + pp * 32 + fq * 8;
                    float h[8];
                    if (seg == 1) {
                        const f32x4 la = *(const f32x4*)(lb + c), lbb = *(const f32x4*)(lb + c + 4);
#pragma unroll
                        for (int j = 0; j < 4; ++j) {
                            h[j] = __logf(la[j] + (1.f - la[j]) * sigmoid_f(acc[m][2 * pp][j]));
                            h[4 + j] = __logf(lbb[j] + (1.f - lbb[j]) * sigmoid_f(acc[m][2 * pp + 1][j]));
                        }
                        uint4 oh; oh.x = packh2(h[0], h[1]); oh.y = packh2(h[2], h[3]); oh.z = packh2(h[4], h[5]); oh.w = packh2(h[6], h[7]);
                        *(uint4*)((unsigned short*)(ws + OFF_LF) + (size_t)row * 1024 + c) = oh;
                    } else {
#pragma unroll
                        for (int j = 0; j < 4; ++j) {
                            h[j] = (seg == 2) ? acc[m][2 * pp][j] : silu_f(acc[m][2 * pp][j]);
                            h[4 + j] = (seg == 2) ? acc[m][2 * pp + 1][j] : silu_f(acc[m][2 * pp + 1][j]);
                        }
                        uint4 o; o.x = pack2(h[0], h[1]); o.y = pack2(h[2], h[3]); o.z = pack2(h[4], h[5]); o.w = pack2(h[6], h[7]);
                        bf16_t* dst = (bf16_t*)(ws + (seg == 0 ? OFF_QH : seg == 2 ? OFF_V : OFF_G));
                        *(uint4*)(dst + (size_t)row * 1024 + c) = o;
                    }
                }
            }
        };
    });
}

constexpr int HG_QD_OFF = 0, HG_KD_OFF = 8704, HG_K2T_OFF = 17408, HG_VT_OFF = 27648, HG_DEC_OFF = 37888, HG_BUF = 38400, HG_TOT_OFF = 2 * HG_BUF;
constexpr int HG_ROW = 272, HG_TROW = 80;
static_assert(HG_TOT_OFF + 2048 <= LDS_TAB_OFF, "hgrn LDS");

__device__ __forceinline__ void phase_hgrn_rec(const Params& p, const Ctx& cx, char* lds) {
    const int lane = cx.lane;
    const int l31 = lane & 31, h2 = lane >> 5;
    const int widu = __builtin_amdgcn_readfirstlane(cx.wid);
    const bool producer = widu >= 4;
    const int pw = widu & 3;
    const int d0 = 2 * lane;
    const bf16_t* QH = (const bf16_t*)(p.ws + OFF_QH);
    const unsigned short* LF = (const unsigned short*)(p.ws + OFF_LF);
    const bf16_t* V = (const bf16_t*)(p.ws + OFF_V);
    bf16_t* OR = (bf16_t*)(p.ws + OFF_HA);
    float* tot = (float*)(lds + HG_TOT_OFF);
    for (int item = blockIdx.x; item < 128; item += cx.G) {
        const int b = item >> 3, h = item & 7;
        f32x16 S0, S1, S2, S3;
#pragma unroll
        for (int r = 0; r < 16; ++r) { S0[r] = 0.f; S1[r] = 0.f; S2[r] = 0.f; S3[r] = 0.f; }
        unsigned lfA[8], lfB[8], qv[8], vv[8];
        const size_t gbase = (size_t)(b * SEQ + pw * 8) * 1024 + h * 128;
        if (producer) {
#pragma unroll
            for (int i = 0; i < 8; ++i) {
                lfA[i] = *(const unsigned*)(LF + gbase + (size_t)i * 1024 + d0);
                qv[i] = *(const unsigned*)(QH + gbase + (size_t)i * 1024 + d0);
                vv[i] = *(const unsigned*)(V + gbase + (size_t)i * 1024 + d0);
            }
#pragma unroll
            for (int i = 0; i < 8; ++i) lfB[i] = *(const unsigned*)(LF + gbase + (size_t)(32 + i) * 1024 + d0);
        }
        __syncthreads();
        for (int c = 0; c <= SEQ / 32; ++c) {
            unsigned lf[8];
#pragma unroll
            for (int i = 0; i < 8; ++i) lf[i] = (c & 1) ? lfB[i] : lfA[i];
            f2_t run = {0.f, 0.f};
            if (producer && c < SEQ / 32) {
#pragma unroll
                for (int i = 0; i < 8; ++i) run += unpackh2(lf[i]);
                *(f2_t*)(tot + pw * 128 + d0) = run;
            }
            __syncthreads();
            if (producer) {
                if (c < SEQ / 32) {
                    char* bufp = lds + (c & 1) * HG_BUF;
                    f2_t pre = {0.f, 0.f}, last = {0.f, 0.f};
#pragma unroll
                    for (int q = 0; q < 4; ++q) {
                        const f2_t tq_ = *(const f2_t*)(tot + q * 128 + d0);
                        last += tq_;
                        if (q < pw) pre += tq_;
                    }
                    if (pw == 0) { f2_t dv; dv.x = __expf(last.x); dv.y = __expf(last.y); *(f2_t*)(bufp + HG_DEC_OFF + d0 * 4) = dv; }
                    float k2a[8], k2b[8];
                    f2_t rc = pre;
#pragma unroll
                    for (int i = 0; i < 8; ++i) {
                        const f2_t lfi = unpackh2(lf[i]);
                        rc += lfi;
                        const float cu0 = rc.x, cu1 = rc.y;
                        const float kk0 = 1.f - __expf(lfi.x), kk1 = 1.f - __expf(lfi.y);
                        const float q0 = bf2f((unsigned short)(qv[i] & 0xffff)) * __expf(cu0), q1 = bf2f((unsigned short)(qv[i] >> 16)) * __expf(cu1);
                        const float kd0 = kk0 * __expf(-cu0), kd1 = kk1 * __expf(-cu1);
                        k2a[i] = kk0 * __expf(last.x - cu0); k2b[i] = kk1 * __expf(last.y - cu1);
                        const int tl = pw * 8 + i;
                        *(unsigned*)(bufp + HG_QD_OFF + tl * HG_ROW + d0 * 2) = pack2(q0, q1);
                        *(unsigned*)(bufp + HG_KD_OFF + tl * HG_ROW + d0 * 2) = pack2(kd0, kd1);
                    }
                    uint4 a, bq, va, vb;
                    a.x = pack2(k2a[0], k2a[1]); a.y = pack2(k2a[2], k2a[3]); a.z = pack2(k2a[4], k2a[5]); a.w = pack2(k2a[6], k2a[7]);
                    bq.x = pack2(k2b[0], k2b[1]); bq.y = pack2(k2b[2], k2b[3]); bq.z = pack2(k2b[4], k2b[5]); bq.w = pack2(k2b[6], k2b[7]);
                    va.x = (vv[0] & 0xffffu) | (vv[1] << 16); va.y = (vv[2] & 0xffffu) | (vv[3] << 16); va.z = (vv[4] & 0xffffu) | (vv[5] << 16); va.w = (vv[6] & 0xffffu) | (vv[7] << 16);
                    vb.x = (vv[0] >> 16) | (vv[1] & 0xffff0000u); vb.y = (vv[2] >> 16) | (vv[3] & 0xffff0000u); vb.z = (vv[4] >> 16) | (vv[5] & 0xffff0000u); vb.w = (vv[6] >> 16) | (vv[7] & 0xffff0000u);
                    *(uint4*)(bufp + HG_K2T_OFF + d0 * HG_TROW + pw * 16) = a;
                    *(uint4*)(bufp + HG_K2T_OFF + (d0 + 1) * HG_TROW + pw * 16) = bq;
                    *(uint4*)(bufp + HG_VT_OFF + d0 * HG_TROW + pw * 16) = va;
                    *(uint4*)(bufp + HG_VT_OFF + (d0 + 1) * HG_TROW + pw * 16) = vb;
                    __builtin_amdgcn_sched_barrier(0);
                    if (c + 1 < SEQ / 32) {
                        const size_t gn = gbase + (size_t)(c + 1) * 32 * 1024;
#pragma unroll
                        for (int i = 0; i < 8; ++i) {
                            qv[i] = *(const unsigned*)(QH + gn + (size_t)i * 1024 + d0);
                            vv[i] = *(const unsigned*)(V + gn + (size_t)i * 1024 + d0);
                        }
                    }
                    if (c + 2 < SEQ / 32) {
                        const size_t gn = gbase + (size_t)(c + 2) * 32 * 1024;
                        if (c & 1) {
#pragma unroll
                            for (int i = 0; i < 8; ++i) lfB[i] = *(const unsigned*)(LF + gn + (size_t)i * 1024 + d0);
                        } else {
#pragma unroll
                            for (int i = 0; i < 8; ++i) lfA[i] = *(const unsigned*)(LF + gn + (size_t)i * 1024 + d0);
                        }
                    }
                }
            } else if (c >= 1) {
                const int cc = c - 1;
                const char* bufp = lds + (cc & 1) * HG_BUF;
                const float* dec = (const float*)(bufp + HG_DEC_OFF);
                f32x16 X;
#pragma unroll
                for (int r = 0; r < 16; ++r) X[r] = 0.f;
                {
                    const char* ka = bufp + HG_KD_OFF + l31 * HG_ROW + 16 * h2;
                    const char* qa = bufp + HG_QD_OFF + l31 * HG_ROW + 16 * h2;
#pragma unroll 2
                    for (int ks = 0; ks < 8; ++ks) X = MFMA32(*(const bf16x8*)(ka + 32 * ks), *(const bf16x8*)(qa + 32 * ks), X);
#pragma unroll
                    for (int r = 0; r < 16; ++r) { const int srow = (r & 3) + 8 * (r >> 2) + 4 * h2; X[r] = (srow <= l31) ? X[r] : 0.f; }
                }
                f32x16 Oa;
#pragma unroll
                for (int r = 0; r < 16; ++r) Oa[r] = 0.f;
                const int jrow = 32 * pw + l31;
#pragma unroll
                for (int s2 = 0; s2 < 2; ++s2) {
                    uint4 xk;
                    xk.x = pack2(X[8 * s2], X[8 * s2 + 1]); xk.y = pack2(X[8 * s2 + 2], X[8 * s2 + 3]); xk.z = pack2(X[8 * s2 + 4], X[8 * s2 + 5]); xk.w = pack2(X[8 * s2 + 6], X[8 * s2 + 7]);
                    const char* va = bufp + HG_VT_OFF + jrow * HG_TROW + (16 * s2 + 4 * h2) * 2;
                    const uint2 lo = *(const uint2*)va, hi = *(const uint2*)(va + 16);
                    uint4 vb; vb.x = lo.x; vb.y = lo.y; vb.z = hi.x; vb.w = hi.y;
                    Oa = MFMA32(__builtin_bit_cast(bf16x8, xk), __builtin_bit_cast(bf16x8, vb), Oa);
                }
                auto qs_term = [&](const f32x16& St, int dt) {
#pragma unroll
                    for (int s2 = 0; s2 < 2; ++s2) {
                        uint4 sk;
                        sk.x = pack2(St[8 * s2], St[8 * s2 + 1]); sk.y = pack2(St[8 * s2 + 2], St[8 * s2 + 3]); sk.z = pack2(St[8 * s2 + 4], St[8 * s2 + 5]); sk.w = pack2(St[8 * s2 + 6], St[8 * s2 + 7]);
                        const char* qa = bufp + HG_QD_OFF + l31 * HG_ROW + (32 * dt + 16 * s2 + 4 * h2) * 2;
                        const uint2 lo = *(const uint2*)qa, hi = *(const uint2*)(qa + 16);
                        uint4 qb; qb.x = lo.x; qb.y = lo.y; qb.z = hi.x; qb.w = hi.y;
                        Oa = MFMA32(__builtin_bit_cast(bf16x8, qb), __builtin_bit_cast(bf16x8, sk), Oa);
                    }
                };
                __builtin_amdgcn_sched_barrier(0);
                qs_term(S0, 0); qs_term(S1, 1);
                __builtin_amdgcn_sched_barrier(0);
                qs_term(S2, 2); qs_term(S3, 3);
                __builtin_amdgcn_sched_barrier(0);
                {
                    bf16_t* orow = OR + (size_t)(b * SEQ + cc * 32 + 4 * h2) * 1024 + h * 128 + jrow;
#pragma unroll
                    for (int r = 0; r < 16; ++r) orow[(size_t)((r & 3) + 8 * (r >> 2)) * 1024] = f2bf(Oa[r]);
                }
                auto s_update = [&](f32x16& St, int dt) {
#pragma unroll
                    for (int rq = 0; rq < 4; ++rq) {
                        const f32x4 dc = *(const f32x4*)(dec + 32 * dt + 8 * rq + 4 * h2);
                        St[4 * rq] *= dc[0]; St[4 * rq + 1] *= dc[1]; St[4 * rq + 2] *= dc[2]; St[4 * rq + 3] *= dc[3];
                    }
#pragma unroll
                    for (int s2 = 0; s2 < 2; ++s2) {
                        const bf16x8 ka = *(const bf16x8*)(bufp + HG_K2T_OFF + (32 * dt + l31) * HG_TROW + (16 * s2 + 8 * h2) * 2);
                        const bf16x8 vb = *(const bf16x8*)(bufp + HG_VT_OFF + jrow * HG_TROW + (16 * s2 + 8 * h2) * 2);
                        St = MFMA32(ka, vb, St);
                    }
                };
                __builtin_amdgcn_sched_barrier(0);
                s_update(S0, 0); s_update(S1, 1);
                __builtin_amdgcn_sched_barrier(0);
                s_update(S2, 2); s_update(S3, 3);
                __builtin_amdgcn_sched_barrier(0);
            }
            __syncthreads();
        }
    }
}

__device__ __forceinline__ void phase_hgrn_post(const Params& p, const Ctx& cx) {
    const int lane = cx.lane;
    const bf16_t* OR = (const bf16_t*)(p.ws + OFF_HA);
    const bf16_t* Gt = (const bf16_t*)(p.ws + OFF_G);
    bf16_t* OA = (bf16_t*)(p.ws + OFF_QH);
    const int col = lane * 16;
    float gn[16];
#pragma unroll
    for (int i = 0; i < 16; ++i) gn[i] = p.hgrn_out_gain[(col & 127) + i];
    for (int row = cx.vbid * NWAVE + cx.wid; row < NTOK; row += cx.G * NWAVE) {
        const uint4 a0 = *(const uint4*)(OR + (size_t)row * 1024 + col), a1 = *(const uint4*)(OR + (size_t)row * 1024 + col + 8);
        const uint4 g0 = *(const uint4*)(Gt + (size_t)row * 1024 + col), g1 = *(const uint4*)(Gt + (size_t)row * 1024 + col + 8);
        const unsigned aw[8] = {a0.x, a0.y, a0.z, a0.w, a1.x, a1.y, a1.z, a1.w};
        const unsigned gw[8] = {g0.x, g0.y, g0.z, g0.w, g1.x, g1.y, g1.z, g1.w};
        float o[16];
        float ss = 0.f;
#pragma unroll
        for (int i = 0; i < 8; ++i) { o[2 * i] = bf2f((unsigned short)(aw[i] & 0xffff)); o[2 * i + 1] = bf2f((unsigned short)(aw[i] >> 16)); ss += o[2 * i] * o[2 * i] + o[2 * i + 1] * o[2 * i + 1]; }
        ss += __shfl_xor(ss, 1); ss += __shfl_xor(ss, 2); ss += __shfl_xor(ss, 4);
        const float r = rsqrtf(ss * (1.f / 128.f) + EPS);
        unsigned w[8];
#pragma unroll
        for (int i = 0; i < 8; ++i)
            w[i] = pack2(o[2 * i] * r * gn[2 * i] * bf2f((unsigned short)(gw[i] & 0xffff)), o[2 * i + 1] * r * gn[2 * i + 1] * bf2f((unsigned short)(gw[i] >> 16)));
        uint4 o0, o1; o0.x = w[0]; o0.y = w[1]; o0.z = w[2]; o0.w = w[3]; o1.x = w[4]; o1.y = w[5]; o1.z = w[6]; o1.w = w[7];
        *(uint4*)(OA + (size_t)row * 1024 + col) = o0;
        *(uint4*)(OA + (size_t)row * 1024 + col + 8) = o1;
    }
}


#define XB_TMO      128
#define XB_XCNT(j)  (256  + 64 * (j))
#define XB_XSUB(j)  (1280 + 64 * (j))
#define XB_XGEN(j)  (2304 + 64 * (j))
#define XB_TOP      3328
#define XB_TOPGEN   3392
#define XCD_BAR_WORDS 3456
#define XB_SPIN_CAP (1u << 20)
#define LAS __attribute__((address_space(3)))
__device__ __forceinline__ unsigned xb_ld(unsigned* p)              { return __hip_atomic_load(p, __ATOMIC_RELAXED, __HIP_MEMORY_SCOPE_AGENT); }
__device__ __forceinline__ unsigned xb_add(unsigned* p, unsigned v) { return __hip_atomic_fetch_add(p, v, __ATOMIC_RELAXED, __HIP_MEMORY_SCOPE_AGENT); }
__device__ __forceinline__ unsigned xb_xcc_id() { return (unsigned)__builtin_amdgcn_s_getreg((3 << 11) | 20) & 0xFu; }
#define XB_SPIN(cond, bar) do { unsigned _sp = 0; while (cond) { __builtin_amdgcn_s_sleep(1); \
    if ((++_sp & 255u) == 0u) { if (xb_ld(&(bar)[XB_TMO])) break; if (_sp > XB_SPIN_CAP) { atomicAdd(&(bar)[XB_TMO], 1u); break; } } } } while (0)
struct XcdBarrier { unsigned* bar; unsigned x; volatile unsigned* st; };
__device__ __forceinline__ XcdBarrier xcd_barrier_post(unsigned* bar, volatile unsigned* st) {
    XcdBarrier b; b.bar = bar; b.x = xb_xcc_id(); b.st = st;
    if (threadIdx.x == 0) (void)xb_add(&bar[XB_XCNT(b.x)], 1u);
    return b;
}
__device__ __forceinline__ void xcd_barrier_complete(unsigned* bar, unsigned x, unsigned& nloc, unsigned& nx) {
    const unsigned G = gridDim.x * gridDim.y * gridDim.z;
    unsigned sum, cnt, mine, sp = 0u;
    for (;;) {
        sum = 0u; cnt = 0u; mine = 0u;
#pragma unroll
        for (unsigned j = 0; j < 16; ++j) { const unsigned c = xb_ld(&bar[XB_XCNT(j)]); sum += c; cnt += (c > 0u) ? 1u : 0u; mine = (j == x) ? c : mine; }
        if (sum == G) break;
        __builtin_amdgcn_s_sleep(1);
        if ((++sp & 255u) == 0u) { if (xb_ld(&bar[XB_TMO])) break; if (sp > XB_SPIN_CAP) { atomicAdd(&bar[XB_TMO], 1u); break; } }
    }
    nloc = mine > 0u ? mine : 1u; nx = cnt > 0u ? cnt : 1u;
}
__device__ __forceinline__ void xcd_barrier(const XcdBarrier& b) {
    asm volatile("s_waitcnt vmcnt(0)" ::: "memory");
    __syncthreads();
    if (threadIdx.x == 0) {
        unsigned* bar = b.bar;
        __builtin_amdgcn_s_waitcnt(0);
        unsigned nloc = b.st[0], nx = b.st[1];
        if (nloc == 0u) { xcd_barrier_complete(bar, b.x, nloc, nx); b.st[0] = nloc; b.st[1] = nx; }
        const unsigned old = xb_add(&bar[XB_XSUB(b.x)], 1u);
        const unsigned gen = old / nloc;
        if (old + 1u == (gen + 1u) * nloc) {
            __builtin_amdgcn_fence(__ATOMIC_RELEASE, "agent");
            asm volatile("s_waitcnt vmcnt(0)" ::: "memory");
            const unsigned og = xb_add(&bar[XB_TOP], 1u);
            const unsigned tg = og / nx;
            if (og + 1u == (tg + 1u) * nx) xb_add(&bar[XB_TOPGEN], 1u);
            else XB_SPIN(xb_ld(&bar[XB_TOPGEN]) == tg, bar);
            __builtin_amdgcn_fence(__ATOMIC_ACQUIRE, "agent");
            xb_add(&bar[XB_XGEN(b.x)], 1u);
            asm volatile("s_waitcnt vmcnt(0)" ::: "memory");
        } else {
            XB_SPIN(xb_ld(&bar[XB_XGEN(b.x)]) == gen, bar);
            __builtin_amdgcn_fence(__ATOMIC_ACQUIRE, "agent");
            asm volatile("s_waitcnt vmcnt(0)" ::: "memory");
        }
    }
    __syncthreads();
}

template <int PH>
__device__ __forceinline__ void run_phase(const Params& p, const Ctx& cx, char* lds) {
    if constexpr (PH == 0) phase0(p, cx, lds);
    else if constexpr (PH == 1) rows_phase<false, true, false>(p, cx, lds, p.x, nullptr, 0, 0, 0, 0);
    else if constexpr (PH == 2) phase_nsa_inproj(p, cx, lds);
    else if constexpr (PH == 3) phase_cmp1(p, cx, lds);
    else if constexpr (PH == 4) phase_cmp2(p, cx);
    else if constexpr (PH == 5) phase_attn(p, cx, lds);
    else if constexpr (PH == 6) phase_outproj(p, cx, lds, (const bf16_t*)(p.ws + OFF_HA), (const bf16_t*)(p.ws + OFF_W_NSA_OUT), p.x, 0);
    else if constexpr (PH == 7) rows_router_phase(p, cx, lds, p.out, 1, 0);
    else if constexpr (PH == 8) phase_moe_up(p, cx, lds, 0);
    else if constexpr (PH == 9) phase_moe_down(p, cx, lds, 0);
    else if constexpr (PH == 10) rows_phase<true, true, false>(p, cx, lds, p.out, p.out, 1, 2, 0, 0);
    else if constexpr (PH == 11) phase_hgrn_inproj<0>(p, cx, lds);
    else if constexpr (PH == 12) phase_hgrn_rec(p, cx, lds);
    else if constexpr (PH == 13) phase_hgrn_post(p, cx);
    else if constexpr (PH == 14) phase_outproj(p, cx, lds, (const bf16_t*)(p.ws + OFF_QH), (const bf16_t*)(p.ws + OFF_W_HG_OUT), p.out, 2);
    else if constexpr (PH == 15) rows_router_phase(p, cx, lds, p.out, 3, 1);
    else if constexpr (PH == 16) phase_moe_up(p, cx, lds, 1);
    else if constexpr (PH == 17) phase_moe_down(p, cx, lds, 1);
    else if constexpr (PH == 18) rows_phase<true, false, false>(p, cx, lds, p.out, p.out, 3, 0, 0, 1);
}

__device__ __forceinline__ Ctx make_ctx() {
    Ctx cx;
    cx.G = gridDim.x; cx.tid = threadIdx.x; cx.wid = threadIdx.x >> 6; cx.lane = threadIdx.x & 63;
    cx.vbid = (cx.G % 8 == 0) ? (blockIdx.x % 8) * (cx.G / 8) + blockIdx.x / 8 : blockIdx.x;
    return cx;
}

#if MULTI_LAUNCH
template <int PH>
__global__ void __launch_bounds__(NTHR, 2) phase_kernel(Params p) {
    extern __shared__ __attribute__((aligned(16))) char lds[];
    const Ctx cx = make_ctx();
    run_phase<PH>(p, cx, lds);
}
template <int PH>
static void launch_phases(const Params& p, int grid, hipStream_t stream) {
    (void)hipFuncSetAttribute((const void*)phase_kernel<PH>, hipFuncAttributeMaxDynamicSharedMemorySize, LDS_BYTES);
    hipLaunchKernelGGL(phase_kernel<PH>, dim3(grid), dim3(NTHR), LDS_BYTES, stream, p);
    if constexpr (PH + 1 < NPHASE) launch_phases<PH + 1>(p, grid, stream);
}
#else
template <int PH>
__device__ __forceinline__ void run_from(const Params& p, const Ctx& cx, char* lds, cg::grid_group& grid, const XcdBarrier& xb) {
    {
        Ctx c2 = cx;
        asm volatile("" : "+v"(c2.tid), "+v"(c2.lane));
        run_phase<PH>(p, c2, lds);
#ifdef PROBE_MASK
        if constexpr ((PROBE_MASK >> PH) & 1) { xcd_barrier(xb); run_phase<PH>(p, c2, lds); }
#endif
    }
    if constexpr (PH + 1 < NPHASE) {
        if constexpr (PH == 0) grid.sync();
        else xcd_barrier(xb);
        run_from<PH + 1>(p, cx, lds, grid, xb);
    }
}
__global__ void __launch_bounds__(NTHR, 2) mega_kernel(Params p) {
    extern __shared__ __attribute__((aligned(16))) char lds[];
    cg::grid_group grid = cg::this_grid();
    const Ctx cx = make_ctx();
    volatile unsigned* st = (volatile unsigned*)(lds + LDS_BYTES - 16);
    if (threadIdx.x == 0) { st[0] = 0u; st[1] = 0u; }
    __syncthreads();
    const XcdBarrier xb = xcd_barrier_post((unsigned*)(p.ws + OFF_BAR), st);
    run_from<0>(p, cx, lds, grid, xb);
}
#endif

extern "C" void kernel_launch(void* const* d_in, const int* in_sizes, int n_in, void* d_out, int out_size, void* d_ws, size_t ws_size,
                              hipStream_t stream) {
    static int grid = 0;
    if (!grid) {
        int dev = 0, cus = 0, per_cu = 0;
        (void)hipGetDevice(&dev);
        (void)hipDeviceGetAttribute(&cus, hipDeviceAttributeMultiprocessorCount, dev);
#if MULTI_LAUNCH
        per_cu = 1;
#else
        (void)hipFuncSetAttribute((const void*)mega_kernel, hipFuncAttributeMaxDynamicSharedMemorySize, LDS_BYTES);
        (void)hipOccupancyMaxActiveBlocksPerMultiprocessor(&per_cu, mega_kernel, NTHR, LDS_BYTES);
        if (per_cu > 1) per_cu = 1;
        if (per_cu < 1) { fprintf(stderr, "kernel_launch: occupancy query says 0 blocks per CU (LDS %d B)\n", LDS_BYTES); per_cu = 1; }
#endif
        if (cus <= 0) cus = 256;
        grid = cus * per_cu;
        if (ws_size < WS_NEED) fprintf(stderr, "kernel_launch: workspace too small: %zu < %zu\n", ws_size, (size_t)WS_NEED);
    }
    Params p{};
    p.x = (const float*)d_in[0]; p.c = (const float*)d_in[1]; p.ada_w = (const float*)d_in[2]; p.ada_b = (const float*)d_in[3];
    p.norm_g = (const float*)d_in[4]; p.rel_bias = (const float*)d_in[5]; p.nsa_w_in = (const float*)d_in[6]; p.nsa_q_gain = (const float*)d_in[7];
    p.nsa_k_gain = (const float*)d_in[8]; p.nsa_cmp_pe = (const float*)d_in[9]; p.nsa_cmp_w1 = (const float*)d_in[10]; p.nsa_cmp_w2 = (const float*)d_in[11];
    p.nsa_w_out = (const float*)d_in[12]; p.hgrn_w_in = (const float*)d_in[13]; p.hgrn_lb = (const float*)d_in[14]; p.hgrn_out_gain = (const float*)d_in[15];
    p.hgrn_w_out = (const float*)d_in[16]; p.moe_rg = (const float*)d_in[17]; p.moe_re = (const float*)d_in[18]; p.moe_w1 = (const float*)d_in[19];
    p.moe_w3 = (const float*)d_in[20]; p.moe_w2 = (const float*)d_in[21];
    p.out = (float*)d_out; p.ws = (char*)d_ws;
#if MULTI_LAUNCH
    launch_phases<0>(p, grid, stream);
#else
    p.p_begin = 0; p.p_end = NPHASE;
    (void)hipMemsetAsync((char*)d_ws + OFF_BAR, 0, XCD_BAR_WORDS * 4, stream);
    void* args[] = {&p};
    hipError_t e = hipLaunchCooperativeKernel((void*)mega_kernel, dim3(grid), dim3(NTHR), args, LDS_BYTES, stream);
    if (e != hipSuccess) fprintf(stderr, "cooperative launch failed: %s (grid %d)\n", hipGetErrorString(e), grid);
#endif
}
```

```cpp
#include <hip/hip_runtime.h>
#include <hip/hip_cooperative_groups.h>
#include <cstdio>
#include <cstdint>
namespace cg = cooperative_groups;

#ifndef MULTI_LAUNCH
#define MULTI_LAUNCH 0
#endif

typedef unsigned short bf16_t;
typedef short bf16x8 __attribute__((ext_vector_type(8)));
typedef float f32x4 __attribute__((ext_vector_type(4)));
typedef float f32x16 __attribute__((ext_vector_type(16)));

constexpr int NTOK = 32768, DM = 1024, SEQ = 2048, NBATCH = 16;
constexpr int NSA_IN = 2608, NSA_IN_PAD = 2816;
constexpr float EPS = 1e-6f;
constexpr size_t MiB = 1ull << 20;

constexpr size_t OFF_CNT = 0;
constexpr size_t OFF_MOD = 4096;
constexpr size_t OFF_LB = OFF_MOD + 786432;
constexpr size_t OFF_PEB = OFF_LB + 4096;
constexpr size_t OFF_BAR = 921600;
constexpr size_t OFF_W_NSA_IN = 1 * MiB;
constexpr size_t OFF_W_NSA_OUT = OFF_W_NSA_IN + 2816ull * 1024 * 2;
constexpr size_t OFF_W_HG_IN = OFF_W_NSA_OUT + 1024ull * 1024 * 2;
constexpr size_t OFF_W_HG_OUT = OFF_W_HG_IN + 4096ull * 1024 * 2;
constexpr size_t OFF_W_CMP1 = OFF_W_HG_OUT + 1024ull * 1024 * 2;
constexpr size_t OFF_W_UP = OFF_W_CMP1 + 2ull * 128 * 2048 * 2;
constexpr size_t OFF_W_DN = OFF_W_UP + 32ull * 1024 * 1024 * 2;
constexpr size_t OFF_W_END = OFF_W_DN + 32ull * 1024 * 512 * 2;
constexpr size_t OFF_HA = 116 * MiB;
static_assert(OFF_W_END <= OFF_HA, "weights overflow");
constexpr size_t OFF_SCR = 180 * MiB;
constexpr size_t OFF_Q = OFF_SCR;
constexpr size_t OFF_KCRAW = OFF_Q + 64 * MiB;
constexpr size_t OFF_VCRAW = OFF_KCRAW + 17 * MiB;
constexpr size_t OFF_KS = OFF_VCRAW + 17 * MiB;
constexpr size_t OFF_VS = OFF_KS + 16 * MiB;
constexpr size_t OFF_KW = OFF_VS + 16 * MiB;
constexpr size_t OFF_VW = OFF_KW + 16 * MiB;
constexpr size_t OFF_GATES = OFF_VW + 16 * MiB;
constexpr size_t OFF_T1 = OFF_GATES + 6 * MiB;
constexpr size_t OFF_KC = OFF_T1 + 4 * MiB;
constexpr size_t OFF_VC = OFF_KC + 1 * MiB;
constexpr size_t OFF_H1 = OFF_SCR;
constexpr size_t OFF_Y = OFF_H1 + 64 * MiB;
constexpr size_t OFF_LTOK = OFF_Y + 128 * MiB;
constexpr size_t OFF_LW = OFF_LTOK + 2 * MiB;
constexpr size_t OFF_TSLOT = OFF_LW + 2 * MiB;
constexpr size_t OFF_QH = OFF_SCR;
constexpr size_t OFF_LF = OFF_QH + 64 * MiB;
constexpr size_t OFF_V = OFF_LF + 128 * MiB;
constexpr size_t OFF_G = OFF_V + 64 * MiB;
constexpr size_t WS_NEED = OFF_G + 64 * MiB;
static_assert(WS_NEED <= 512 * MiB, "ws overflow");

constexpr int NTHR = 512, NWAVE = 8;
constexpr int GEMM_STAGE = 49152, GEMM_NSTAGE = 3;
constexpr int LDS_TAB_OFF = GEMM_STAGE * GEMM_NSTAGE;
constexpr int LDS_BYTES = LDS_TAB_OFF + 256 + 16;
constexpr int NPHASE = 19;

struct Params {
    const float *x, *c, *ada_w, *ada_b, *norm_g, *rel_bias, *nsa_w_in, *nsa_q_gain, *nsa_k_gain, *nsa_cmp_pe, *nsa_cmp_w1,
        *nsa_cmp_w2, *nsa_w_out, *hgrn_w_in, *hgrn_lb, *hgrn_out_gain, *hgrn_w_out, *moe_rg, *moe_re, *moe_w1, *moe_w3, *moe_w2;
    float* out;
    char* ws;
    int p_begin, p_end;
};

__device__ __forceinline__ float bf2f(unsigned short h) { return __uint_as_float((unsigned)h << 16); }
__device__ __forceinline__ unsigned short f2bf(float f) {
    unsigned u = __float_as_uint(f);
    u += 0x7fffu + ((u >> 16) & 1u);
    return (unsigned short)(u >> 16);
}
typedef __bf16 bf2_t __attribute__((ext_vector_type(2)));
typedef float f2_t __attribute__((ext_vector_type(2)));
__device__ __forceinline__ unsigned pack2(float a, float b) {
    f2_t v = {a, b};
    return __builtin_bit_cast(unsigned, __builtin_convertvector(v, bf2_t));
}
typedef _Float16 h2_t __attribute__((ext_vector_type(2)));
__device__ __forceinline__ unsigned packh2(float a, float b) { f2_t v = {a, b}; return __builtin_bit_cast(unsigned, __builtin_convertvector(v, h2_t)); }
__device__ __forceinline__ f2_t unpackh2(unsigned u) { return __builtin_convertvector(__builtin_bit_cast(h2_t, u), f2_t); }
__device__ __forceinline__ float wave_sum(float v) {
#pragma unroll
    for (int o = 32; o; o >>= 1) v += __shfl_xor(v, o);
    return v;
}
__device__ __forceinline__ float wave_max(float v) {
#pragma unroll
    for (int o = 32; o; o >>= 1) v = fmaxf(v, __shfl_xor(v, o));
    return v;
}
__device__ __forceinline__ float silu_f(float x) { return x * __builtin_amdgcn_rcpf(1.f + __builtin_amdgcn_exp2f(-1.4426950408889634f * x)); }
__device__ __forceinline__ float sigmoid_f(float x) { return __builtin_amdgcn_rcpf(1.f + __builtin_amdgcn_exp2f(-1.4426950408889634f * x)); }
__device__ __forceinline__ void glds16(const void* g, void* l) {
    __builtin_amdgcn_global_load_lds((const unsigned*)g, (unsigned*)l, 16, 0, 0);
}
__device__ __forceinline__ int t5_bucket(int n) {
    if (n < 16) return n;
    int b = 16;
    b += (n >= 21); b += (n >= 27); b += (n >= 35); b += (n >= 46); b += (n >= 59); b += (n >= 77); b += (n >= 99); b += (n >= 128);
    b += (n >= 166); b += (n >= 216); b += (n >= 280); b += (n >= 363); b += (n >= 470); b += (n >= 609); b += (n >= 790);
    return b;
}

struct Ctx {
    int G, vbid, tid, wid, lane;
};

constexpr int P0_MOD_ITEMS = 192;
constexpr int TS0 = 88 * 16, TS1 = 32 * 16, TS2 = 128 * 16, TS3 = 32 * 16, TS4 = 2 * 4 * 32, TS5 = 32 * 32 * 16, TS6 = 32 * 32 * 8;
constexpr int TC0 = 0, TC1 = TC0 + TS0, TC2 = TC1 + TS1, TC3 = TC2 + TS2, TC4 = TC3 + TS3, TC5 = TC4 + TS4, TC6 = TC5 + TS5, TC_END = TC6 + TS6;

struct TrJob { const float* src; int ld, c0, ncols_valid, k0; bf16_t* dst; int dstld; int perm; };
__device__ __forceinline__ int pcol(int n, int fq) { return (n >> 1) * 32 + fq * 8 + (n & 1) * 4; }
__device__ __forceinline__ void tr_load(const TrJob& j, float* tl, int htid) {
    const int k = htid >> 2, cc = (htid & 3) * 8;
    const float* s = j.src + (size_t)(j.k0 + k) * j.ld + j.c0 + cc;
    f32x4 a = {0.f, 0.f, 0.f, 0.f}, c = a;
    if (j.c0 + 32 <= j.ncols_valid) { a = *(const f32x4*)s; c = *(const f32x4*)(s + 4); }
    else {
#pragma unroll
        for (int i = 0; i < 4; ++i) { if (j.c0 + cc + i < j.ncols_valid) a[i] = s[i]; if (j.c0 + cc + 4 + i < j.ncols_valid) c[i] = s[4 + i]; }
    }
#pragma unroll
    for (int i = 0; i < 4; ++i) { tl[k * 33 + cc + i] = a[i]; tl[k * 33 + cc + 4 + i] = c[i]; }
}
__device__ __forceinline__ void tr_store(const TrJob& j, const float* tl, int htid) {
    const int nsrc = htid >> 3, kc = (htid & 7) * 8;
    const int n = nsrc;
    const int nd = j.perm ? (((nsrc >> 2) & 1) * 16 + (nsrc >> 3) * 4 + (nsrc & 3)) : nsrc;
    uint4 o;
    o.x = pack2(tl[(kc + 0) * 33 + n], tl[(kc + 1) * 33 + n]); o.y = pack2(tl[(kc + 2) * 33 + n], tl[(kc + 3) * 33 + n]);
    o.z = pack2(tl[(kc + 4) * 33 + n], tl[(kc + 5) * 33 + n]); o.w = pack2(tl[(kc + 6) * 33 + n], tl[(kc + 7) * 33 + n]);
    *(uint4*)(j.dst + (size_t)nd * j.dstld + kc) = o;
}
__device__ __forceinline__ TrJob tr_job(const Params& p, int tt) {
    TrJob j;
    if (tt < TC1) {
        const int nt = tt / 16, kt = tt % 16;
        j = {p.nsa_w_in, NSA_IN, nt * 32, NSA_IN, kt * 64, (bf16_t*)(p.ws + OFF_W_NSA_IN) + (size_t)nt * 32 * 1024 + kt * 64, 1024, 1};
    } else if (tt < TC2) {
        const int u = tt - TC1, nt = u / 16, kt = u % 16;
        j = {p.nsa_w_out, 1024, nt * 32, 1024, kt * 64, (bf16_t*)(p.ws + OFF_W_NSA_OUT) + (size_t)nt * 32 * 1024 + kt * 64, 1024, 1};
    } else if (tt < TC3) {
        const int u = tt - TC2, nt = u / 16, kt = u % 16;
        j = {p.hgrn_w_in, 4096, nt * 32, 4096, kt * 64, (bf16_t*)(p.ws + OFF_W_HG_IN) + (size_t)nt * 32 * 1024 + kt * 64, 1024, 1};
    } else if (tt < TC4) {
        const int u = tt - TC3, nt = u / 16, kt = u % 16;
        j = {p.hgrn_w_out, 1024, nt * 32, 1024, kt * 64, (bf16_t*)(p.ws + OFF_W_HG_OUT) + (size_t)nt * 32 * 1024 + kt * 64, 1024, 1};
    } else if (tt < TC5) {
        const int u = tt - TC4, kv = u / 128, r = u % 128, nt = r / 32, kt = r % 32;
        j = {p.nsa_cmp_w1 + (size_t)kv * 2048 * 64, 64, nt * 32, 64, kt * 64, (bf16_t*)(p.ws + OFF_W_CMP1) + ((size_t)kv * 128 + nt * 32) * 2048 + kt * 64, 2048, 0};
    } else if (tt < TC6) {
        const int u = tt - TC5, le = u / 512, r = u % 512, gr = r / 16, kt = r % 16;
        const int t = gr >> 2, wc = (gr >> 1) & 1, which = gr & 1;
        const float* src = (which ? p.moe_w3 : p.moe_w1) + (size_t)le * 1024 * 512;
        j = {src, 512, (t * 2 + wc) * 32, 512, kt * 64, (bf16_t*)(p.ws + OFF_W_UP) + ((size_t)le * 1024 + gr * 32) * 1024 + kt * 64, 1024, 1};
    } else {
        const int u = tt - TC6, le = u / 256, r = u % 256, nt = r / 8, kt = r % 8;
        j = {p.moe_w2 + (size_t)le * 512 * 1024, 1024, nt * 32, 1024, kt * 64, (bf16_t*)(p.ws + OFF_W_DN) + ((size_t)le * 1024 + nt * 32) * 512 + kt * 64, 512, 1};
    }
    return j;
}

__device__ __forceinline__ void phase0(const Params& p, const Ctx& cx, char* lds) {
    const int tid = cx.tid, wid = cx.wid, lane = cx.lane;
    for (int it = cx.vbid; it < P0_MOD_ITEMS; it += cx.G) {
        const int colbase = it * 64, ls = colbase / 3072, e0 = colbase % 3072;
        const float* W = p.ada_w + (size_t)ls * 1024 * 3072 + e0 + lane;
        float* cs = (float*)lds + wid * 1024;
        float* red = (float*)lds + 8192;
        float acc[16];
#pragma unroll
        for (int b = 0; b < 16; ++b) acc[b] = 0.f;
        for (int sub = 0; sub < 2; ++sub) {
            const int kb = wid * 128 + sub * 64;
#pragma unroll
            for (int b = 0; b < 16; ++b) cs[lane * 16 + b] = silu_f(p.c[b * 1024 + kb + lane]);
            __builtin_amdgcn_wave_barrier();
#pragma unroll 1
            for (int k16 = 0; k16 < 64; k16 += 16) {
                float wv[16];
#pragma unroll
                for (int u = 0; u < 16; ++u) wv[u] = W[(size_t)(kb + k16 + u) * 3072];
#pragma unroll
                for (int u = 0; u < 16; ++u) {
                    const float w = wv[u];
                    const f32x4* cv = (const f32x4*)(cs + (k16 + u) * 16);
#pragma unroll
                    for (int q = 0; q < 4; ++q) {
                        f32x4 c4 = cv[q];
                        acc[q * 4 + 0] += c4[0] * w; acc[q * 4 + 1] += c4[1] * w; acc[q * 4 + 2] += c4[2] * w; acc[q * 4 + 3] += c4[3] * w;
                    }
                }
            }
            __builtin_amdgcn_wave_barrier();
        }
#pragma unroll
        for (int b = 0; b < 16; ++b) red[(wid * 16 + b) * 64 + lane] = acc[b];
        __syncthreads();
        float* mod = (float*)(p.ws + OFF_MOD);
#pragma unroll
        for (int i = 0; i < 2; ++i) {
            const int o = tid + i * NTHR, b = o >> 6, e = o & 63;
            float sm = 0.f;
#pragma unroll
            for (int w = 0; w < 8; ++w) sm += red[(w * 16 + b) * 64 + e];
            mod[((size_t)ls * 16 + b) * 3072 + e0 + e] = sm + p.ada_b[ls * 3072 + e0 + e];
        }
        __syncthreads();
    }
    {
        constexpr int TPH = 4;
        const int half = tid >> 8, htid = tid & 255;
        float* tl = (float*)lds + half * (TPH * 64 * 33);
        for (int base = cx.vbid * 2 * TPH; base < TC_END; base += cx.G * 2 * TPH) {
#pragma unroll
            for (int q = 0; q < TPH; ++q) {
                const int tt = base + half * TPH + q;
                if (tt < TC_END) { const TrJob j = tr_job(p, tt); tr_load(j, tl + q * (64 * 33), htid); }
            }
            __syncthreads();
#pragma unroll
            for (int q = 0; q < TPH; ++q) {
                const int tt = base + half * TPH + q;
                if (tt < TC_END) { const TrJob j = tr_job(p, tt); tr_store(j, tl + q * (64 * 33), htid); }
            }
            __syncthreads();
        }
    }
    if (cx.vbid == cx.G - 1) {
        float* lb = (float*)(p.ws + OFF_LB);
        for (int i = tid; i < 1024; i += NTHR) lb[i] = sigmoid_f(p.hgrn_lb[1024 + i] - p.hgrn_lb[i]);
        if (tid < 128) {
            const int kv = tid >> 6, d = tid & 63;
            const float* pe = p.nsa_cmp_pe + kv * 2048;
            const float* w1 = p.nsa_cmp_w1 + (size_t)kv * 2048 * 64 + d;
            float sm = 0.f;
            for (int k = 0; k < 2048; ++k) sm += pe[k] * w1[(size_t)k * 64];
            ((float*)(p.ws + OFF_PEB))[tid] = sm;
        }
        if (tid < 32) ((int*)(p.ws + OFF_CNT))[tid] = 0;
    }
}

template <bool COMBINE, bool NORM, bool ROUTER>
__device__ __forceinline__ void rows_phase(const Params& p, const Ctx& cx, char* lds, const float* __restrict__ src, float* __restrict__ xdst,
                           int ls_comb, int ls_norm, int layer_router, int layer_comb) {
    static_assert(!ROUTER, "router rows use rows_router_phase");
    const int lane = cx.lane;
    const float* mod = (const float*)(p.ws + OFF_MOD);
    int my_off = 0;
    if (COMBINE) {
        const int* cnt = (const int*)(p.ws + OFF_CNT) + layer_comb * 16;
        int cv[15];
#pragma unroll
        for (int e = 0; e < 15; ++e) cv[e] = cnt[e];
#pragma unroll
        for (int e = 0; e < 15; ++e) my_off += (e < lane) ? cv[e] : 0;
    }
    const int rpw = (NTOK + cx.G * NWAVE - 1) / (cx.G * NWAVE);
    const int row_begin = (cx.vbid * NWAVE + cx.wid) * rpw, row_end = min(NTOK, row_begin + rpw);
    if (row_begin >= row_end) return;
    const bf16_t* Y = (const bf16_t*)(p.ws + OFF_Y);
    const int* tsl = (const int*)(p.ws + OFF_TSLOT);
    bf16_t* hA = (bf16_t*)(p.ws + OFF_HA);
    const float* gain = p.norm_g + ls_norm * 1024;
    auto yrow = [&](int sw) -> size_t { return (size_t)(__shfl(my_off, sw >> 16) + (sw & 0xffff)) * 1024; };
    f32x4 vn[4];
    uint2 yan[4], ycn[4];
    int t0n = 0, t1n = 0;
#pragma unroll
    for (int i = 0; i < 4; ++i) vn[i] = *(const f32x4*)(src + (size_t)row_begin * 1024 + (i * 64 + lane) * 4);
    if (COMBINE) {
        const size_t ra = yrow(tsl[row_begin * 2]), rc = yrow(tsl[row_begin * 2 + 1]);
#pragma unroll
        for (int i = 0; i < 4; ++i) { yan[i] = *(const uint2*)(Y + ra + (i * 64 + lane) * 4); ycn[i] = *(const uint2*)(Y + rc + (i * 64 + lane) * 4); }
        if (row_begin + 1 < row_end) { t0n = tsl[(row_begin + 1) * 2]; t1n = tsl[(row_begin + 1) * 2 + 1]; }
    }
    f32x4 gt[4], ca[4], cb[4];
    int bcur = -1;
    for (int row = row_begin; row < row_end; ++row) {
        const int b = row >> 11;
        if (b != bcur) {
            bcur = b;
#pragma unroll
            for (int i = 0; i < 4; ++i) {
                const int col = (i * 64 + lane) * 4;
                if (COMBINE) gt[i] = *(const f32x4*)(mod + ((size_t)ls_comb * 16 + b) * 3072 + 2048 + col);
                if (NORM) {
                    const float* shift = mod + ((size_t)ls_norm * 16 + b) * 3072;
                    const f32x4 g = *(const f32x4*)(gain + col), sc = *(const f32x4*)(shift + 1024 + col);
                    ca[i] = g * (sc + 1.f);
                    cb[i] = *(const f32x4*)(shift + col);
                }
            }
        }
        f32x4 v[4];
        uint2 ya[4], yc[4];
#pragma unroll
        for (int i = 0; i < 4; ++i) { v[i] = vn[i]; if (COMBINE) { ya[i] = yan[i]; yc[i] = ycn[i]; } }
        if (row + 1 < row_end) {
#pragma unroll
            for (int i = 0; i < 4; ++i) vn[i] = *(const f32x4*)(src + (size_t)(row + 1) * 1024 + (i * 64 + lane) * 4);
            if (COMBINE) {
                const size_t ra = yrow(t0n), rc = yrow(t1n);
#pragma unroll
                for (int i = 0; i < 4; ++i) { yan[i] = *(const uint2*)(Y + ra + (i * 64 + lane) * 4); ycn[i] = *(const uint2*)(Y + rc + (i * 64 + lane) * 4); }
                if (row + 2 < row_end) { t0n = tsl[(row + 2) * 2]; t1n = tsl[(row + 2) * 2 + 1]; }
            }
        }
        if (COMBINE) {
#pragma unroll
            for (int i = 0; i < 4; ++i) {
                const int col = (i * 64 + lane) * 4;
                v[i][0] += gt[i][0] * (bf2f(ya[i].x & 0xffff) + bf2f(yc[i].x & 0xffff));
                v[i][1] += gt[i][1] * (bf2f(ya[i].x >> 16) + bf2f(yc[i].x >> 16));
                v[i][2] += gt[i][2] * (bf2f(ya[i].y & 0xffff) + bf2f(yc[i].y & 0xffff));
                v[i][3] += gt[i][3] * (bf2f(ya[i].y >> 16) + bf2f(yc[i].y >> 16));
                *(f32x4*)(xdst + (size_t)row * 1024 + col) = v[i];
            }
        }
        if (NORM) {
            float ss = 0.f;
#pragma unroll
            for (int i = 0; i < 4; ++i) ss += v[i][0] * v[i][0] + v[i][1] * v[i][1] + v[i][2] * v[i][2] + v[i][3] * v[i][3];
            ss = wave_sum(ss);
            const float r = rsqrtf(ss * (1.f / 1024.f) + EPS);
#pragma unroll
            for (int i = 0; i < 4; ++i) {
                const int col = (i * 64 + lane) * 4;
                f32x4 h;
#pragma unroll
                for (int j = 0; j < 4; ++j) h[j] = v[i][j] * r * ca[i][j] + cb[i][j];
                uint2 o; o.x = pack2(h[0], h[1]); o.y = pack2(h[2], h[3]);
                *(uint2*)(hA + (size_t)row * 1024 + col) = o;
            }
        }
    }
}

__device__ __forceinline__ void rows_router_phase(const Params& p, const Ctx& cx, char* lds, const float* __restrict__ src, int ls_norm, int layer) {
    const int lane = cx.lane, tid = cx.tid;
    const int widu = __builtin_amdgcn_readfirstlane(cx.wid);
    const int wq = widu & 3, grp4 = widu >> 2;
    const float* mod = (const float*)(p.ws + OFF_MOD);
    const float* rg = p.moe_rg + (size_t)layer * 1024 * 4;
    const float* re = p.moe_re + (size_t)layer * 1024 * 16;
    float* logit_s = (float*)lds;
    float wr[16][5];
#pragma unroll
    for (int i = 0; i < 4; ++i)
#pragma unroll
        for (int j = 0; j < 4; ++j) {
            const int k = (i * 64 + lane) * 4 + j;
#pragma unroll
            for (int q = 0; q < 5; ++q) {
                const int o = 5 * wq + q;
                wr[i * 4 + j][q] = (o < 4) ? rg[k * 4 + o] : re[k * 16 + o - 4];
            }
            __builtin_amdgcn_sched_barrier(0);
        }
    const float* gain = p.norm_g + ls_norm * 1024;
    bf16_t* hA = (bf16_t*)(p.ws + OFF_HA);
    int* lcnt = (int*)(lds + 16384);
    if (tid < 32) lcnt[tid] = 0;
    int nstep = 0;
    for (int blk = cx.vbid; blk < NTOK / 32; blk += cx.G, ++nstep) {
        const int R0 = blk * 32, b = R0 >> 11;
        const float* shift = mod + ((size_t)ls_norm * 16 + b) * 3072;
        const float* scale = shift + 1024;
        f32x4 ca[4], cb[4];
#pragma unroll
        for (int i = 0; i < 4; ++i) {
            const int col = (i * 64 + lane) * 4;
            const f32x4 g = *(const f32x4*)(gain + col), sc = *(const f32x4*)(scale + col);
            ca[i] = g * (sc + 1.f);
            cb[i] = *(const f32x4*)(shift + col);
        }
        const float* srow = src + (size_t)(R0 + grp4 * 16) * 1024 + lane * 4;
        f32x4 vnA[4], vnB[4];
#pragma unroll
        for (int i = 0; i < 4; ++i) { vnA[i] = *(const f32x4*)(srow + i * 256); vnB[i] = *(const f32x4*)(srow + 1024 + i * 256); }
#pragma unroll 1
        for (int r = 0; r < 16; r += 2) {
            const int rlA = grp4 * 16 + r;
            f32x4 vA[4], vB[4];
#pragma unroll
            for (int i = 0; i < 4; ++i) { vA[i] = vnA[i]; vB[i] = vnB[i]; }
            if (r < 14) {
#pragma unroll
                for (int i = 0; i < 4; ++i) { vnA[i] = *(const f32x4*)(srow + (size_t)(r + 2) * 1024 + i * 256); vnB[i] = *(const f32x4*)(srow + (size_t)(r + 3) * 1024 + i * 256); }
            }
            float ssA = 0.f, ssB = 0.f;
#pragma unroll
            for (int i = 0; i < 4; ++i) {
                ssA += vA[i][0] * vA[i][0] + vA[i][1] * vA[i][1] + vA[i][2] * vA[i][2] + vA[i][3] * vA[i][3];
                ssB += vB[i][0] * vB[i][0] + vB[i][1] * vB[i][1] + vB[i][2] * vB[i][2] + vB[i][3] * vB[i][3];
            }
#pragma unroll
            for (int o = 32; o; o >>= 1) { ssA += __shfl_xor(ssA, o); ssB += __shfl_xor(ssB, o); }
            const float rrA = rsqrtf(ssA * (1.f / 1024.f) + EPS), rrB = rsqrtf(ssB * (1.f / 1024.f) + EPS);
            float accA[5] = {0.f, 0.f, 0.f, 0.f, 0.f}, accB[5] = {0.f, 0.f, 0.f, 0.f, 0.f};
#pragma unroll
            for (int i = 0; i < 4; ++i) {
                const int col = (i * 64 + lane) * 4;
                f32x4 hA_, hB_;
#pragma unroll
                for (int j = 0; j < 4; ++j) {
                    hA_[j] = vA[i][j] * rrA * ca[i][j] + cb[i][j];
                    hB_[j] = vB[i][j] * rrB * ca[i][j] + cb[i][j];
#pragma unroll
                    for (int q = 0; q < 5; ++q) { accA[q] += hA_[j] * wr[i * 4 + j][q]; accB[q] += hB_[j] * wr[i * 4 + j][q]; }
                }
                if ((r & 3) == wq) { uint2 o; o.x = pack2(hA_[0], hA_[1]); o.y = pack2(hA_[2], hA_[3]); *(uint2*)(hA + (size_t)(R0 + rlA) * 1024 + col) = o; }
                if (((r + 1) & 3) == wq) { uint2 o; o.x = pack2(hB_[0], hB_[1]); o.y = pack2(hB_[2], hB_[3]); *(uint2*)(hA + (size_t)(R0 + rlA + 1) * 1024 + col) = o; }
            }
#pragma unroll
            for (int o = 32; o; o >>= 1) {
#pragma unroll
                for (int q = 0; q < 5; ++q) { accA[q] += __shfl_xor(accA[q], o); accB[q] += __shfl_xor(accB[q], o); }
            }
            if (lane == 0) {
#pragma unroll
                for (int q = 0; q < 5; ++q) { logit_s[(nstep * 32 + rlA) * 20 + 5 * wq + q] = accA[q]; logit_s[(nstep * 32 + rlA + 1) * 20 + 5 * wq + q] = accB[q]; }
            }
        }
    }
    __syncthreads();
    const int nrows = nstep * 32;
    int ea = 0, eb = 0, la = 0, lb_ = 0, row = 0; float wa = 0.f, wb = 0.f;
    if (tid < nrows) {
        row = (cx.vbid + (tid >> 5) * cx.G) * 32 + (tid & 31);
        const float* rl = logit_s + tid * 20;
        const float gm = fmaxf(fmaxf(rl[0], rl[1]), fmaxf(rl[2], rl[3]));
        const float gs = __expf(rl[0] - gm) + __expf(rl[1] - gm) + __expf(rl[2] - gm) + __expf(rl[3] - gm);
        int grp = 0; float best = rl[0];
        if (rl[1] > best) { best = rl[1]; grp = 1; }
        if (rl[2] > best) { best = rl[2]; grp = 2; }
        if (rl[3] > best) { best = rl[3]; grp = 3; }
        const float pg = __expf(best - gm) / gs;
        const f32x4 lsel = *(const f32x4*)(rl + 4 + 4 * grp);
        const float l0 = lsel[0], l1 = lsel[1], l2 = lsel[2], l3 = lsel[3];
        const float em = fmaxf(fmaxf(l0, l1), fmaxf(l2, l3));
        const float q0 = __expf(l0 - em), q1 = __expf(l1 - em), q2 = __expf(l2 - em), q3 = __expf(l3 - em);
        int i1 = 0; float b1 = q0;
        if (q1 > b1) { b1 = q1; i1 = 1; }
        if (q2 > b1) { b1 = q2; i1 = 2; }
        if (q3 > b1) { b1 = q3; i1 = 3; }
        int i2 = -1; float b2 = -1.f;
        if (i1 != 0 && q0 > b2) { b2 = q0; i2 = 0; }
        if (i1 != 1 && q1 > b2) { b2 = q1; i2 = 1; }
        if (i1 != 2 && q2 > b2) { b2 = q2; i2 = 2; }
        if (i1 != 3 && q3 > b2) { b2 = q3; i2 = 3; }
        const float inv = pg / (b1 + b2);
        ea = grp * 4 + i1; eb = grp * 4 + i2; wa = b1 * inv; wb = b2 * inv;
        la = atomicAdd(lcnt + ea, 1);
        lb_ = atomicAdd(lcnt + eb, 1);
    }
    __syncthreads();
    if (tid < 16) lcnt[16 + tid] = atomicAdd((int*)(p.ws + OFF_CNT) + layer * 16 + tid, lcnt[tid]);
    __syncthreads();
    if (tid < nrows) {
        int* ltok = (int*)(p.ws + OFF_LTOK);
        float* lw = (float*)(p.ws + OFF_LW);
        int* ts = (int*)(p.ws + OFF_TSLOT) + row * 2;
        const int pa = lcnt[16 + ea] + la, pb = lcnt[16 + eb] + lb_;
        ltok[(size_t)ea * NTOK + pa] = row; lw[(size_t)ea * NTOK + pa] = wa;
        ltok[(size_t)eb * NTOK + pb] = row; lw[(size_t)eb * NTOK + pb] = wb;
        ts[0] = (ea << 16) | pa; ts[1] = (eb << 16) | pb;
    }
    __syncthreads();
}

__device__ __forceinline__ int stage_col(int tid) { return ((tid & 7) ^ ((tid >> 3) & 7)) * 8; }

template <class Epi>
__device__ __forceinline__ void gemm_tile(const bf16_t* const (&ap)[4], const bf16_t* const (&bp)[2], int K, char* lds, const Ctx& cx, Epi&& epi) {
    const int tid = cx.tid, lane = cx.lane, wr = cx.wid >> 1, wc = cx.wid & 1, fr = lane & 15, fq = lane >> 4;
    f32x4 acc[4][4];
#pragma unroll
    for (int m = 0; m < 4; ++m)
#pragma unroll
        for (int n = 0; n < 4; ++n) acc[m][n] = (f32x4){0.f, 0.f, 0.f, 0.f};
    const int nt = K / 64;
    auto stage = [&](int t, int slot) {
        char* SA = lds + slot * GEMM_STAGE + tid * 16; char* SB = SA + 32768;
        const int ko = t * 64;
#pragma unroll
        for (int i = 0; i < 4; ++i) glds16(ap[i] + ko, SA + i * 8192);
#pragma unroll
        for (int i = 0; i < 2; ++i) glds16(bp[i] + ko, SB + i * 8192);
    };
    __syncthreads();
    stage(0, 0);
    if (nt > 1) stage(1, 1);
    const int x7 = fr & 7;
    const int aoff = (wr * 64 + fr) * 128, boff = 32768 + (wc * 64 + fr) * 128;
    int slot = 0;
    for (int kt = 0; kt < nt; ++kt) {
        if (kt + 1 < nt) asm volatile("s_waitcnt vmcnt(6)" ::: "memory");
        else asm volatile("s_waitcnt vmcnt(0)" ::: "memory");
        __builtin_amdgcn_s_barrier();
        if (kt + 2 < nt) stage(kt + 2, slot >= 1 ? slot - 1 : 2);
        const char* S = lds + slot * GEMM_STAGE;
#pragma unroll
        for (int ks = 0; ks < 2; ++ks) {
            const int pc = ((ks * 4 + fq) ^ x7) * 16;
            bf16x8 Af[4], Bf[4];
#pragma unroll
            for (int m = 0; m < 4; ++m) Af[m] = *(const bf16x8*)(S + aoff + m * 2048 + pc);
#pragma unroll
            for (int n = 0; n < 4; ++n) Bf[n] = *(const bf16x8*)(S + boff + n * 2048 + pc);
#pragma unroll
            for (int m = 0; m < 4; ++m)
#pragma unroll
                for (int n = 0; n < 4; ++n) acc[m][n] = __builtin_amdgcn_mfma_f32_16x16x32_bf16(Bf[n], Af[m], acc[m][n], 0, 0, 0);
        }
        slot = slot == 2 ? 0 : slot + 1;
    }
    epi(acc, wr, wc, fr, fq);
}

__device__ __forceinline__ int swz_g(int q) { return (0x1320 >> (4 * q)) & 3; }
__device__ __forceinline__ int stage_col2(int tid) { return ((tid & 3) ^ swz_g((tid >> 4) & 3)) * 8; }

template <int MODE = 0, class Epi>
__device__ __forceinline__ void gemm_tile2(const bf16_t* const (&ap)[2], const bf16_t* const (&bp)[2], int K, char* lds, const Ctx& cx, Epi&& epi) {
    const int tid = cx.tid, lane = cx.lane, wc = cx.wid & 3, fr = lane & 15, fq = lane >> 4;
    const int wr = __builtin_amdgcn_readfirstlane(cx.wid >> 2);
    f32x4 acc[8][4];
#pragma unroll
    for (int m = 0; m < 8; ++m)
#pragma unroll
        for (int n = 0; n < 4; ++n) acc[m][n] = (f32x4){0.f, 0.f, 0.f, 0.f};
    const int nt = K / 32;
    auto stage = [&](int t) {
        char* SA = lds + (t & 3) * 32768 + tid * 16; char* SB = SA + 16384;
        const int ko = t * 32;
        glds16(ap[0] + ko, SA); glds16(ap[1] + ko, SA + 8192);
        glds16(bp[0] + ko, SB); glds16(bp[1] + ko, SB + 8192);
    };
    __syncthreads();
    stage(0);
    if (nt > 1) stage(1);
    if (nt > 2) stage(2);
    const int pc = (fq ^ swz_g((fr >> 2) & 3)) * 16;
    const int aoff = (wr * 128 + fr) * 64 + pc, boff = 16384 + (wc * 64 + fr) * 64 + pc;
    bf16x8 Af[8], Bf[4];
    auto load_frags = [&](int kt) {
        const char* S = lds + (kt & 3) * 32768;
#pragma unroll
        for (int n = 0; n < 4; ++n) Bf[n] = *(const bf16x8*)(S + boff + n * 1024);
#pragma unroll
        for (int m = 0; m < 8; ++m) Af[m] = *(const bf16x8*)(S + aoff + m * 1024);
        asm volatile("s_waitcnt lgkmcnt(0)" ::: "memory");
    };
    auto mma = [&]() {
        __builtin_amdgcn_s_setprio(1);
#pragma unroll
        for (int m = 0; m < 8; ++m)
#pragma unroll
            for (int n = 0; n < 4; ++n) acc[m][n] = __builtin_amdgcn_mfma_f32_16x16x32_bf16(Bf[n], Af[m], acc[m][n], 0, 0, 0);
        __builtin_amdgcn_s_setprio(0);
    };
    if (nt > 2) asm volatile("s_waitcnt vmcnt(8)" ::: "memory");
    else if (nt == 2) asm volatile("s_waitcnt vmcnt(4)" ::: "memory");
    else asm volatile("s_waitcnt vmcnt(0)" ::: "memory");
    if (wr == 1) __builtin_amdgcn_s_barrier();
    for (int kt = 0; kt < nt; ++kt) {
        const int rem = nt - 1 - kt;
        if (rem >= 2) asm volatile("s_waitcnt vmcnt(8)" ::: "memory");
        else if (rem == 1) asm volatile("s_waitcnt vmcnt(4)" ::: "memory");
        else asm volatile("s_waitcnt vmcnt(0)" ::: "memory");
        __builtin_amdgcn_s_barrier();
        if (kt + 3 < nt) stage(kt + 3);
        load_frags(kt);
        if (rem >= 3) asm volatile("s_waitcnt vmcnt(8)" ::: "memory");
        else if (rem == 2) asm volatile("s_waitcnt vmcnt(4)" ::: "memory");
        else asm volatile("s_waitcnt vmcnt(0)" ::: "memory");
        __builtin_amdgcn_s_barrier();
        mma();
    }
    if (wr == 0) __builtin_amdgcn_s_barrier();
    if (MODE == 0) epi(acc, wr, wc, fr, fq);
    else {
#pragma unroll
        for (int m = 0; m < 8; ++m)
#pragma unroll
            for (int n = 0; n < 4; ++n) asm volatile("" :: "v"(acc[m][n]));
    }
}

template <class GetFn, class EpiFn>
__device__ __forceinline__ void gemm_stream2(int my_tiles, int K, char* lds, const Ctx& cx, GetFn&& get, EpiFn&& epi) {
    if (my_tiles <= 0) return;
    const int tid = cx.tid, lane = cx.lane, wc = cx.wid & 3, fr = lane & 15, fq = lane >> 4;
    const int wr = __builtin_amdgcn_readfirstlane(cx.wid >> 2);
    f32x4 acc[8][4];
#pragma unroll
    for (int m = 0; m < 8; ++m)
#pragma unroll
        for (int n = 0; n < 4; ++n) acc[m][n] = (f32x4){0.f, 0.f, 0.f, 0.f};
    const int nt = K / 32, S = my_tiles * nt;
    const bf16_t* sap[2]; const bf16_t* sbp[2];
    int sj = 0, skt = 0, sg = 0;
    get(0, sap, sbp);
    auto stage_next = [&]() {
        char* SA = lds + (sg & 3) * 32768 + tid * 16; char* SB = SA + 16384;
        const int ko = skt * 32;
        glds16(sap[0] + ko, SA); glds16(sap[1] + ko, SA + 8192);
        glds16(sbp[0] + ko, SB); glds16(sbp[1] + ko, SB + 8192);
        ++sg; ++skt;
        if (skt == nt) { skt = 0; ++sj; if (sj < my_tiles) get(sj, sap, sbp); }
    };
    __syncthreads();
    stage_next();
    if (S > 1) stage_next();
    if (S > 2) stage_next();
    const int pc = (fq ^ swz_g((fr >> 2) & 3)) * 16;
    const int aoff = (wr * 128 + fr) * 64 + pc, boff = 16384 + (wc * 64 + fr) * 64 + pc;
    bf16x8 Af[8], Bf[4];
    int g = 0;
    for (int cj = 0; cj < my_tiles; ++cj) {
        {
            const int rem0 = S - 1 - g;
            if (rem0 >= 2) asm volatile("s_waitcnt vmcnt(8)" ::: "memory");
            else if (rem0 == 1) asm volatile("s_waitcnt vmcnt(4)" ::: "memory");
            else asm volatile("s_waitcnt vmcnt(0)" ::: "memory");
        }
        if (wr == 1) __builtin_amdgcn_s_barrier();
        for (int kt = 0; kt < nt; ++kt, ++g) {
            const int rem = S - 1 - g;
            if (rem >= 2) asm volatile("s_waitcnt vmcnt(8)" ::: "memory");
            else if (rem == 1) asm volatile("s_waitcnt vmcnt(4)" ::: "memory");
            else asm volatile("s_waitcnt vmcnt(0)" ::: "memory");
            __builtin_amdgcn_s_barrier();
            if (g + 3 < S) stage_next();
            {
                const char* Sx = lds + (g & 3) * 32768;
#pragma unroll
                for (int n = 0; n < 4; ++n) Bf[n] = *(const bf16x8*)(Sx + boff + n * 1024);
#pragma unroll
                for (int m = 0; m < 8; ++m) Af[m] = *(const bf16x8*)(Sx + aoff + m * 1024);
                asm volatile("s_waitcnt lgkmcnt(0)" ::: "memory");
            }
            if (rem >= 3) asm volatile("s_waitcnt vmcnt(8)" ::: "memory");
            else if (rem == 2) asm volatile("s_waitcnt vmcnt(4)" ::: "memory");
            else asm volatile("s_waitcnt vmcnt(0)" ::: "memory");
            __builtin_amdgcn_s_barrier();
            __builtin_amdgcn_s_setprio(1);
#pragma unroll
            for (int m = 0; m < 8; ++m)
#pragma unroll
                for (int n = 0; n < 4; ++n) acc[m][n] = __builtin_amdgcn_mfma_f32_16x16x32_bf16(Bf[n], Af[m], acc[m][n], 0, 0, 0);
            __builtin_amdgcn_s_setprio(0);
        }
        if (wr == 0) __builtin_amdgcn_s_barrier();
        epi(cj, acc, wr, wc, fr, fq);
#pragma unroll
        for (int m = 0; m < 8; ++m)
#pragma unroll
            for (int n = 0; n < 4; ++n) acc[m][n] = (f32x4){0.f, 0.f, 0.f, 0.f};
    }
}

template <int MODE = 0, class EpiFactory>
__device__ __forceinline__ void gemm_phase_dense2(const bf16_t* A, int lda, const bf16_t* Bt, int K, int nrt, int nct, char* lds, const Ctx& cx, EpiFactory&& mk) {
    const int tid = cx.tid;
    const int ntiles = nrt * nct;
    const int sc = stage_col2(tid), sr = tid >> 2;
    const int my_tiles = cx.vbid < ntiles ? (ntiles - cx.vbid + cx.G - 1) / cx.G : 0;
    const int vb = cx.vbid, G = cx.G;
    gemm_stream2(my_tiles, K, lds, cx,
        [=](int j, const bf16_t* (&ap)[2], const bf16_t* (&bp)[2]) {
            const int tile = vb + j * G, rt = tile / nct, ct = tile % nct;
            ap[0] = A + (size_t)(rt * 256 + sr) * lda + sc; ap[1] = ap[0] + (size_t)128 * lda;
            bp[0] = Bt + (size_t)(ct * 256 + sr) * K + sc; bp[1] = bp[0] + (size_t)128 * K;
        },
        [=](int j, f32x4 (&acc)[8][4], int wr, int wc, int fr, int fq) {
            const int tile = vb + j * G, rt = tile / nct, ct = tile % nct;
            mk(rt * 256, ct * 256)(acc, wr, wc, fr, fq);
        });
}

__device__ __forceinline__ void phase_nsa_inproj(const Params& p, const Ctx& cx, char* lds) {
    const bf16_t* A = (const bf16_t*)(p.ws + OFF_HA);
    const bf16_t* Bt = (const bf16_t*)(p.ws + OFF_W_NSA_IN);
    char* ws = p.ws;
    const float* qg = p.nsa_q_gain;
    const float* kg = p.nsa_k_gain;
    gemm_phase_dense2(A, 1024, Bt, 1024, NTOK / 256, NSA_IN_PAD / 256, lds, cx, [=](int row0, int col0) {
        return [=](f32x4 (&acc)[8][4], int wr, int wc, int fr, int fq) {
            const int gc0 = col0 + wc * 64;
            if (gc0 >= NSA_IN) return;
            if (gc0 < 1024 || (gc0 >= 1536 && gc0 < 1792) || (gc0 >= 2048 && gc0 < 2304)) {
                const float* gain; float post; bf16_t* dstb; size_t rstride; size_t coff; bool tokmajor;
                if (gc0 < 1024) { gain = qg; post = 0.125f * 1.4426950408889634f; }
                else if (gc0 < 1792) { gain = kg + 64; post = 1.f; }
                else { gain = kg + 128; post = 1.f; }
#pragma unroll
                for (int m = 0; m < 8; ++m) {
                    __builtin_amdgcn_sched_barrier(0);
                    float ss = 0.f;
#pragma unroll
                    for (int n = 0; n < 4; ++n) ss += acc[m][n][0] * acc[m][n][0] + acc[m][n][1] * acc[m][n][1] + acc[m][n][2] * acc[m][n][2] + acc[m][n][3] * acc[m][n][3];
                    ss += __shfl_xor(ss, 16); ss += __shfl_xor(ss, 32);
                    const float r = rsqrtf(ss * (1.f / 64.f) + EPS) * post;
                    const int row = row0 + wr * 128 + m * 16 + fr;
                    bf16_t* dst;
                    if (gc0 < 1024) dst = (bf16_t*)(ws + OFF_Q) + (size_t)row * 1024 + gc0;
                    else {
                        const int g = ((gc0 - 1024) & 255) >> 6, b = row >> 11, t = row & 2047;
                        dst = (bf16_t*)(ws + (gc0 < 1792 ? OFF_KS : OFF_KW)) + ((size_t)(b * 4 + g) * 2048 + t) * 64;
                    }
#pragma unroll
                    for (int pp = 0; pp < 2; ++pp) {
                        const int c = pp * 32 + fq * 8;
                        const f32x4 ga = *(const f32x4*)(gain + c), gb = *(const f32x4*)(gain + c + 4);
                        const f32x4 a = acc[m][2 * pp], bb = acc[m][2 * pp + 1];
                        uint4 o; o.x = pack2(a[0] * r * ga[0], a[1] * r * ga[1]); o.y = pack2(a[2] * r * ga[2], a[3] * r * ga[3]);
                        o.z = pack2(bb[0] * r * gb[0], bb[1] * r * gb[1]); o.w = pack2(bb[2] * r * gb[2], bb[3] * r * gb[3]);
                        *(uint4*)(dst + c) = o;
                    }
                }
            } else if (gc0 < 2560) {
                const int seg = (gc0 - 1024) >> 8;
                const int g = ((gc0 - 1024) & 255) >> 6;
                if (seg < 2) {
                    const size_t off = seg == 0 ? OFF_KCRAW : OFF_VCRAW;
#pragma unroll
                    for (int m = 0; m < 8; ++m) {
                        __builtin_amdgcn_sched_barrier(0);
                    __builtin_amdgcn_sched_barrier(0);
                        const int row = row0 + wr * 128 + m * 16 + fr, b = row >> 11, t = row & 2047;
                        bf16_t* dst = (bf16_t*)(ws + off) + ((size_t)(b * 4 + g) * 2048 + t) * 64;
#pragma unroll
                        for (int pp = 0; pp < 2; ++pp) {
                            const f32x4 a = acc[m][2 * pp], bb = acc[m][2 * pp + 1];
                            uint4 o; o.x = pack2(a[0], a[1]); o.y = pack2(a[2], a[3]); o.z = pack2(bb[0], bb[1]); o.w = pack2(bb[2], bb[3]);
                            *(uint4*)(dst + pp * 32 + fq * 8) = o;
                        }
                    }
                } else {
                    const size_t off = seg == 3 ? OFF_VS : OFF_VW;
#pragma unroll
                    for (int m = 0; m < 8; ++m) {
                        __builtin_amdgcn_sched_barrier(0);
                    __builtin_amdgcn_sched_barrier(0);
                        const int row = row0 + wr * 128 + m * 16 + fr, b = row >> 11, t = row & 2047;
                        bf16_t* dst = (bf16_t*)(ws + off) + (size_t)(b * 4 + g) * 64 * 2048 + t;
#pragma unroll
                        for (int n = 0; n < 4; ++n)
#pragma unroll
                            for (int j = 0; j < 4; ++j) dst[(size_t)(pcol(n, fq) + j) * 2048] = f2bf(acc[m][n][j]);
                    }
                }
            } else {
#pragma unroll
                for (int m = 0; m < 8; ++m) {
                    __builtin_amdgcn_sched_barrier(0);
                    const int row = row0 + wr * 128 + m * 16 + fr;
                    float* dst = (float*)(ws + OFF_GATES) + (size_t)row * 48;
#pragma unroll
                    for (int n = 0; n < 4; ++n) {
                        const int c = pcol(n, fq);
                        f32x4 o;
#pragma unroll
                        for (int j = 0; j < 4; ++j) o[j] = sigmoid_f(acc[m][n][j]);
                        if (c < 48) *(f32x4*)(dst + c) = o;
                    }
                }
            }
        };
    });
}

__device__ __forceinline__ void phase_cmp1(const Params& p, const Ctx& cx, char* lds) {
    const int tid = cx.tid;
    const float* peb = (const float*)(p.ws + OFF_PEB);
    float* T1 = (float*)(p.ws + OFF_T1);
    const int sc = stage_col(tid), sr = tid >> 3;
    for (int tile = cx.vbid; tile < 64; tile += cx.G) {
        const int kv = tile >> 5, bg2 = tile & 31;
        const bf16_t* raw = (const bf16_t*)(p.ws + (kv ? OFF_VCRAW : OFF_KCRAW)) + (size_t)bg2 * 2 * 2048 * 64;
        const bf16_t* a0 = raw + (size_t)sr * 1024 + sc;
        const bf16_t* a2 = raw + (size_t)2048 * 64 + (size_t)sr * 1024 + sc;
        const bf16_t* b0 = (const bf16_t*)(p.ws + OFF_W_CMP1) + ((size_t)kv * 128 + sr) * 2048 + sc;
        const bf16_t* const ap[4] = {a0, a0 + (size_t)64 * 1024, a2, a2 + (size_t)64 * 1024};
        const bf16_t* const bp[2] = {b0, b0 + (size_t)64 * 2048};
        gemm_tile(ap, bp, 2048, lds, cx, [=](f32x4 (&acc)[4][4], int wr, int wc, int fr, int fq) {
            if (wc != 0) return;
#pragma unroll
            for (int m = 0; m < 4; ++m) {
                const int r = wr * 64 + m * 16 + fr;
                float* dst = T1 + ((size_t)kv * 8192 + (bg2 * 2 + (r >> 7)) * 128 + (r & 127)) * 64;
#pragma unroll
                for (int n = 0; n < 4; ++n) {
                    const int c = n * 16 + fq * 4;
                    f32x4 pb = *(const f32x4*)(peb + kv * 64 + c);
                    *(f32x4*)(dst + c) = acc[m][n] + pb;
                }
            }
        });
    }
}

__device__ __forceinline__ void phase_cmp2(const Params& p, const Ctx& cx) {
    const int lane = cx.lane;
    const float* T1 = (const float*)(p.ws + OFF_T1);
    for (int r = cx.vbid * NWAVE + cx.wid; r < 2 * 8192; r += cx.G * NWAVE) {
        const int kv = r >> 13, rr = r & 8191, n_ = rr & 127;
        const float s = silu_f(T1[(size_t)r * 64 + lane]);
        const float* w2 = p.nsa_cmp_w2 + kv * 4096 + lane;
        float o = 0.f;
#pragma unroll 8
        for (int j = 0; j < 64; ++j) o += __shfl(s, j) * w2[j * 64];
        if (kv == 0) {
            const float ss = wave_sum(o * o);
            o = o * rsqrtf(ss * (1.f / 64.f) + EPS) * p.nsa_k_gain[lane];
        }
        if (n_ == 127) o = 0.f;
        if (kv == 0) ((bf16_t*)(p.ws + OFF_KC))[(size_t)rr * 64 + lane] = f2bf(o);
        else ((bf16_t*)(p.ws + OFF_VC))[((size_t)(rr >> 7) * 64 + lane) * 128 + n_] = f2bf(o);
    }
}

constexpr int ATT_BUF = 17920, ATT_K_STRIDE = 144, ATT_V_OFF = 9216, ATT_V_STRIDE = 136, ATT_LUT_OFF = 2 * ATT_BUF, LUT_N = 2136, LUT_PAD = 80;
constexpr int ATT_SC_OFF = ATT_LUT_OFF + 4 * LUT_N * 4;
static_assert(ATT_SC_OFF + NWAVE * 8192 <= LDS_TAB_OFF, "attention LDS");
#define MFMA32(a, b, c) __builtin_amdgcn_mfma_f32_32x32x16_bf16((a), (b), (c), 0, 0, 0)
template <int V> struct IC { static constexpr int value = V; };

__device__ __forceinline__ void phase_attn(const Params& p, const Ctx& cx, char* lds) {
    const int tid = cx.tid, lane = cx.lane, wid = cx.wid;
    const int g = cx.vbid & 3;
    const int ql = lane & 7, head = (lane & 31) >> 3, h2 = lane >> 5, l31 = lane & 31;
    float* lut = (float*)(lds + ATT_LUT_OFF);
    for (int i = tid; i < 4 * LUT_N; i += NTHR) {
        const int h = i / LUT_N, dist = i % LUT_N - LUT_PAD;
        lut[i] = dist >= 0 ? p.rel_bias[t5_bucket(dist) * 16 + g * 4 + h] * 1.4426950408889634f : 0.f;
    }
    __syncthreads();
    const float* lutp = lut + head * LUT_N + LUT_PAD;
    const float b31 = lutp[2047];
    const bf16_t* Qb = (const bf16_t*)(p.ws + OFF_Q);
    const bf16_t* KC = (const bf16_t*)(p.ws + OFF_KC);
    const bf16_t* VCT = (const bf16_t*)(p.ws + OFF_VC);
    const bf16_t* KS = (const bf16_t*)(p.ws + OFF_KS);
    const bf16_t* VST = (const bf16_t*)(p.ws + OFF_VS);
    const bf16_t* KW = (const bf16_t*)(p.ws + OFF_KW);
    const bf16_t* VWT = (const bf16_t*)(p.ws + OFF_VW);
    const float* GT = (const float*)(p.ws + OFF_GATES);
    bf16_t* Og = (bf16_t*)(p.ws + OFF_HA);
    float* scw = (float*)(lds + ATT_SC_OFF) + wid * 2048;
    f32x4* outw = (f32x4*)(lds + ATT_SC_OFF + wid * 8192) + lane;
    const bool flip_ok = (cx.G % 128) == 0;
    const int widu = __builtin_amdgcn_readfirstlane(wid);

    for (int it = 0;; ++it) {
        const int u = cx.vbid + it * cx.G;
        if (u >= 2048) break;
        const int rest = u >> 2, b = rest >> 5, qtb = rest & 31;
        const int qt = (flip_ok && (it & 1)) ? 31 - qtb : qtb;
        const int t0 = qt * 64, cur = qt, bg = b * 4 + g;
        const int tq = t0 + wid * 8 + ql;
        const size_t rowtok = (size_t)b * SEQ + tq;
        bf16x8 Qf[4];
        {
            const bf16_t* qp = Qb + rowtok * 1024 + (g * 4 + head) * 64 + 8 * h2;
#pragma unroll
            for (int ks = 0; ks < 4; ++ks) Qf[ks] = *(const bf16x8*)(qp + 16 * ks);
        }
        const float* gt = GT + rowtok * 48 + (g * 4 + head) * 3;
        const float gate_c = gt[0], gate_s = gt[1], gate_w = gt[2];
        const int wlo = max(0, qt - 8);
        const int nW = cur - wlo + 1;
        const int ncp = (t0 + 63 >= 31 + 16 * 64) ? 2 : 1;
        const int NC = ncp;
        const int NT = NC + nW + cur + 1;

        uint4 kr0, vr0;
        auto issue_load = [&](int i) {
            const bf16_t* ksrc; const bf16_t* vsrc; int vstride;
            if (i < NC) { const int ci = i; ksrc = KC + ((size_t)bg * 128 + ci * 64) * 64; vsrc = VCT + (size_t)bg * 64 * 128 + ci * 64; vstride = 128; }
            else if (i < NC + nW) { const int kb = wlo + i - NC; ksrc = KW + ((size_t)bg * 2048 + kb * 64) * 64; vsrc = VWT + (size_t)bg * 64 * 2048 + kb * 64; vstride = 2048; }
            else { const int kb = i - NC - nW; ksrc = KS + ((size_t)bg * 2048 + kb * 64) * 64; vsrc = VST + (size_t)bg * 64 * 2048 + kb * 64; vstride = 2048; }
            kr0 = *(const uint4*)(ksrc + tid * 8);
            vr0 = *(const uint4*)(vsrc + (size_t)(tid >> 3) * vstride + (tid & 7) * 8);
        };
        auto write_lds = [&](int i) {
            char* bufp = lds + (i & 1) * ATT_BUF;
            *(uint4*)(bufp + (tid >> 3) * ATT_K_STRIDE + (tid & 7) * 16) = kr0;
            char* va = bufp + ATT_V_OFF + (tid >> 3) * ATT_V_STRIDE + (tid & 7) * 16;
            uint2 t;
            t.x = vr0.x; t.y = vr0.y; *(uint2*)va = t;
            t.x = vr0.z; t.y = vr0.w; *(uint2*)(va + 8) = t;
        };
        f32x16 O0, O1;
#pragma unroll
        for (int r = 0; r < 16; ++r) { O0[r] = 0.f; O1[r] = 0.f; }
        float lsum = 0.f;

        auto qk = [&](const char* bufp, int kt2, float init) -> f32x16 {
            f32x16 S;
#pragma unroll
            for (int r = 0; r < 16; ++r) S[r] = init;
            const char* kp = bufp + (32 * kt2 + l31) * ATT_K_STRIDE + 16 * h2;
            bf16x8 kf[4];
#pragma unroll
            for (int ks = 0; ks < 4; ++ks) kf[ks] = *(const bf16x8*)(kp + 32 * ks);
            __builtin_amdgcn_sched_barrier(0);
#pragma unroll
            for (int ks = 0; ks < 4; ++ks) S = MFMA32(kf[ks], Qf[ks], S);
            return S;
        };
        auto pv = [&](const char* bufp, int kt2, const f32x16& P) {
            const char* vp = bufp + ATT_V_OFF + l31 * ATT_V_STRIDE + (32 * kt2 + 4 * h2) * 2;
            uint2 va[2][2][2];
#pragma unroll
            for (int s2 = 0; s2 < 2; ++s2)
#pragma unroll
                for (int dt = 0; dt < 2; ++dt) {
                    va[s2][dt][0] = *(const uint2*)(vp + dt * 32 * ATT_V_STRIDE + s2 * 32);
                    va[s2][dt][1] = *(const uint2*)(vp + dt * 32 * ATT_V_STRIDE + s2 * 32 + 16);
                }
            __builtin_amdgcn_sched_barrier(0);
#pragma unroll
            for (int s2 = 0; s2 < 2; ++s2) {
                uint4 pk;
                pk.x = pack2(P[8 * s2 + 0], P[8 * s2 + 1]); pk.y = pack2(P[8 * s2 + 2], P[8 * s2 + 3]);
                pk.z = pack2(P[8 * s2 + 4], P[8 * s2 + 5]); pk.w = pack2(P[8 * s2 + 6], P[8 * s2 + 7]);
                const bf16x8 Pf = __builtin_bit_cast(bf16x8, pk);
                uint4 a0, a1;
                a0.x = va[s2][0][0].x; a0.y = va[s2][0][0].y; a0.z = va[s2][0][1].x; a0.w = va[s2][0][1].y;
                a1.x = va[s2][1][0].x; a1.y = va[s2][1][0].y; a1.z = va[s2][1][1].x; a1.w = va[s2][1][1].y;
                O0 = MFMA32(__builtin_bit_cast(bf16x8, a0), Pf, O0);
                O1 = MFMA32(__builtin_bit_cast(bf16x8, a1), Pf, O1);
            }
        };
        auto finalize = [&](float gate, int mode) {
            const float Z = lsum + __shfl_xor(lsum, 32);
            const float f = Z > 0.f ? gate / Z : 0.f;
#pragma unroll
            for (int v4 = 0; v4 < 4; ++v4) {
                f32x4 a = {f * O0[4 * v4], f * O0[4 * v4 + 1], f * O0[4 * v4 + 2], f * O0[4 * v4 + 3]};
                f32x4 c = {f * O1[4 * v4], f * O1[4 * v4 + 1], f * O1[4 * v4 + 2], f * O1[4 * v4 + 3]};
                if (mode != 0) { a += outw[v4 * 64]; c += outw[(4 + v4) * 64]; }
                if (mode != 2) { outw[v4 * 64] = a; outw[(4 + v4) * 64] = c; }
                else { O0[4 * v4] = a[0]; O0[4 * v4 + 1] = a[1]; O0[4 * v4 + 2] = a[2]; O0[4 * v4 + 3] = a[3];
                       O1[4 * v4] = c[0]; O1[4 * v4 + 1] = c[1]; O1[4 * v4 + 2] = c[2]; O1[4 * v4 + 3] = c[3]; }
            }
            if (mode != 2) {
#pragma unroll
                for (int r = 0; r < 16; ++r) { O0[r] = 0.f; O1[r] = 0.f; }
            }
            lsum = 0.f;
        };
        auto tile_ws = [&](const char* bufp, int kb, float cinit, auto MMc, auto BMc) {
            constexpr int MM = decltype(MMc)::value, BM = decltype(BMc)::value;
#pragma unroll 1
            for (int kt2 = 0; kt2 < 2; ++kt2) {
                const int d0 = tq - (64 * kb + 32 * kt2 + 4 * h2);
                const float* lp = lutp + (d0 - 27);
                float bv[16];
                if (BM == 0) {
#pragma unroll
                    for (int r = 0; r < 16; ++r) bv[r] = lp[27 - ((r & 3) + 8 * (r >> 2))];
                    __builtin_amdgcn_sched_barrier(0);
                }
                f32x16 S = qk(bufp, kt2, cinit);
#pragma unroll
                for (int r = 0; r < 16; ++r) {
                    const int cr = (r & 3) + 8 * (r >> 2);
                    float x = S[r];
                    if (BM == 0) x += bv[r];
                    if (MM == 1) x += (d0 - cr < 512) ? 0.f : -INFINITY;
                    if (MM == 2) x += (d0 - cr >= 0) ? 0.f : -INFINITY;
                    S[r] = __builtin_amdgcn_exp2f(x);
                    lsum += S[r];
                }
                pv(bufp, kt2, S);
            }
        };

        const int nvis = (tq >= 31) ? min((tq - 31) / 16 + 1, 127) : 0;
        unsigned selmask = 0u;
        float* sown = scw + (head * 8 + ql) * 32;
        float* stail = scw + 1024 + (head * 8 + ql) * 32;
        float* ssc = scw + ql * 32;
        issue_load(0);
        __syncthreads();
        write_lds(0);
        issue_load(1);
        for (int i = 0; i < NT; ++i) {
            __syncthreads();
            const char* bufp = lds + (i & 1) * ATT_BUF;
            if (i < NC) {
                const int ci = i;
#pragma unroll 1
                for (int kt2 = 0; kt2 < 2; ++kt2) {
                    const int n0 = 64 * ci + 32 * kt2 + 4 * h2;
                    const int d0 = tq - 31 - 16 * n0;
                    float bv[16];
#pragma unroll
                    for (int r = 0; r < 16; ++r) bv[r] = lutp[max(d0 - 16 * ((r & 3) + 8 * (r >> 2)), -LUT_PAD)];
                    __builtin_amdgcn_sched_barrier(0);
                    f32x16 S = qk(bufp, kt2, 0.f);
#pragma unroll
                    for (int r = 0; r < 16; ++r) {
                        const int cr = (r & 3) + 8 * (r >> 2);
                        S[r] = __builtin_amdgcn_exp2f(S[r] + bv[r] + ((n0 + cr) < nvis ? 0.f : -INFINITY));
                        lsum += S[r];
                    }
                    pv(bufp, kt2, S);
#pragma unroll
                    for (int rq = 0; rq < 4; ++rq) {
                        const int sblk = 8 * (2 * ci + kt2) + 2 * rq + h2;
                        sown[sblk] = S[4 * rq] + S[4 * rq + 1] + S[4 * rq + 2] + 0.5f * S[4 * rq + 3];
                        if (sblk < 31) stail[sblk + 1] = 0.5f * S[4 * rq + 3];
                    }
                }
                if (i == NC - 1) {
                    const float Z = lsum + __shfl_xor(lsum, 32);
                    const float inv_mine = Z > 0.f ? 1.f / Z : 0.f;
                    if (h2 == 0) stail[0] = 0.f;
                    __builtin_amdgcn_wave_barrier();
                    const int j8 = head * 2 + h2;
                    {
                        f32x4 sc = {0.f, 0.f, 0.f, 0.f};
#pragma unroll
                        for (int hh = 0; hh < 4; ++hh) {
                            const float invh = __shfl(inv_mine, hh * 8 + ql);
                            const f32x4 a = *(const f32x4*)(scw + (hh * 8 + ql) * 32 + 4 * j8), t4 = *(const f32x4*)(scw + 1024 + (hh * 8 + ql) * 32 + 4 * j8);
                            sc += (a + t4) * invh;
                        }
#pragma unroll
                        for (int q = 0; q < 4; ++q) {
                            const int sblk = 4 * j8 + q;
                            const bool forced = (sblk == 0) || (sblk == cur) || (sblk == cur - 1);
                            sc[q] = forced ? 1.0e4f : (sblk <= cur ? sc[q] : -1.0f);
                        }
                        __builtin_amdgcn_wave_barrier();
                        *(f32x4*)(ssc + 4 * j8) = sc;
                    }
                    __builtin_amdgcn_wave_barrier();
                    const f32x4 own = *(const f32x4*)(ssc + 4 * j8);
                    int rk0 = 0, rk1 = 0, rk2 = 0, rk3 = 0;
                    const int so0 = 4 * j8;
#pragma unroll
                    for (int m4 = 0; m4 < 8; ++m4) {
                        const f32x4 v = *(const f32x4*)(ssc + 4 * m4);
#pragma unroll
                        for (int q = 0; q < 4; ++q) {
                            const int sm = 4 * m4 + q;
                            const float vm = v[q];
                            rk0 += (vm > own[0] || (vm == own[0] && sm < so0)) ? 1 : 0;
                            rk1 += (vm > own[1] || (vm == own[1] && sm < so0 + 1)) ? 1 : 0;
                            rk2 += (vm > own[2] || (vm == own[2] && sm < so0 + 2)) ? 1 : 0;
                            rk3 += (vm > own[3] || (vm == own[3] && sm < so0 + 3)) ? 1 : 0;
                        }
                    }
                    unsigned mk = ((rk0 < 8 ? 1u : 0u) | (rk1 < 8 ? 2u : 0u) | (rk2 < 8 ? 4u : 0u) | (rk3 < 8 ? 8u : 0u)) << so0;
                    mk |= __shfl_xor(mk, 8); mk |= __shfl_xor(mk, 16); mk |= __shfl_xor(mk, 32);
                    selmask = mk;
                    __builtin_amdgcn_wave_barrier();
                    finalize(gate_c, 0);
                }
            } else if (i < NC + nW) {
                const int kb = wlo + i - NC;
                if (kb == cur) tile_ws(bufp, kb, 0.f, IC<2>{}, IC<0>{});
                else if (kb == cur - 8) tile_ws(bufp, kb, 0.f, IC<1>{}, IC<0>{});
                else tile_ws(bufp, kb, 0.f, IC<0>{}, IC<0>{});
                if (i == NC - 1 + nW) finalize(gate_w, 1);
            } else {
                const int kb = i - NC - nW;
                const bool sel = ((selmask >> kb) & 1u) != 0;
                if (__ballot(sel) != 0ull) {
                    const float neg = sel ? 0.f : -INFINITY;
                    if (kb == cur) tile_ws(bufp, kb, neg, IC<2>{}, IC<0>{});
                    else if (t0 + 8 * widu - (64 * kb + 63) >= 790) tile_ws(bufp, kb, neg + b31, IC<0>{}, IC<1>{});
                    else tile_ws(bufp, kb, neg, IC<0>{}, IC<0>{});
                }
            }
            if (i + 1 < NT) {
                write_lds(i + 1);
                if (i + 2 < NT) issue_load(i + 2);
            }
        }
        finalize(gate_s, 2);
        {
            bf16_t* op = Og + rowtok * 1024 + (g * 4 + head) * 64 + 4 * h2;
#pragma unroll
            for (int rq = 0; rq < 4; ++rq) {
                uint2 o0; o0.x = pack2(O0[4 * rq], O0[4 * rq + 1]); o0.y = pack2(O0[4 * rq + 2], O0[4 * rq + 3]);
                uint2 o1; o1.x = pack2(O1[4 * rq], O1[4 * rq + 1]); o1.y = pack2(O1[4 * rq + 2], O1[4 * rq + 3]);
                *(uint2*)(op + 8 * rq) = o0;
                *(uint2*)(op + 32 + 8 * rq) = o1;
            }
        }
    }
}

__device__ __forceinline__ void phase_outproj(const Params& p, const Ctx& cx, char* lds, const bf16_t* A, const bf16_t* Bt, const float* xin, int ls) {
    const float* mod = (const float*)(p.ws + OFF_MOD);
    float* xo = p.out;
    gemm_phase_dense2(A, 1024, Bt, 1024, NTOK / 256, 4, lds, cx, [=](int row0, int col0) {
        return [=](f32x4 (&acc)[8][4], int wr, int wc, int fr, int fq) {
            const int b = row0 >> 11;
            const float* gate = mod + ((size_t)ls * 16 + b) * 3072 + 2048 + col0 + wc * 64;
            f32x4 g[4];
#pragma unroll
            for (int n = 0; n < 4; ++n) g[n] = *(const f32x4*)(gate + pcol(n, fq));
#pragma unroll
            for (int m2 = 0; m2 < 8; m2 += 2) {
                f32x4 xi[2][4];
#pragma unroll
                for (int mm = 0; mm < 2; ++mm)
#pragma unroll
                    for (int n = 0; n < 4; ++n)
                        xi[mm][n] = *(const f32x4*)(xin + (size_t)(row0 + wr * 128 + (m2 + mm) * 16 + fr) * 1024 + col0 + wc * 64 + pcol(n, fq));
                __builtin_amdgcn_sched_barrier(0);
#pragma unroll
                for (int mm = 0; mm < 2; ++mm)
#pragma unroll
                    for (int n = 0; n < 4; ++n) {
                        f32x4 o;
#pragma unroll
                        for (int j = 0; j < 4; ++j) o[j] = xi[mm][n][j] + g[n][j] * acc[m2 + mm][n][j];
                        *(f32x4*)(xo + (size_t)(row0 + wr * 128 + (m2 + mm) * 16 + fr) * 1024 + col0 + wc * 64 + pcol(n, fq)) = o;
                    }
                __builtin_amdgcn_sched_barrier(0);
            }
        };
    });
}

__device__ __forceinline__ void moe_tables(const Params& p, int layer, int tid, int* s_cnt, int* s_off, int* s_toff) {
    __syncthreads();
    if (tid == 0) {
        const int* cnt = (const int*)(p.ws + OFF_CNT) + layer * 16;
        int o = 0, to = 0;
        for (int e = 0; e < 16; ++e) { const int c = cnt[e]; s_cnt[e] = c; s_off[e] = o; s_toff[e] = to; o += c; to += ((c + 255) >> 8) * 4; }
        s_off[16] = o; s_toff[16] = to;
    }
    __syncthreads();
}

constexpr int LDS_ROWIDX_OFF = 131072, LDS_LW_OFF = 131072 + 8192;
static_assert(LDS_LW_OFF + 8192 <= LDS_TAB_OFF, "moe caches");

__device__ __forceinline__ void phase_moe_up(const Params& p, const Ctx& cx, char* lds, int layer) {
    const int tid = cx.tid;
    int* s_cnt = (int*)(lds + LDS_TAB_OFF); int* s_off = s_cnt + 16; int* s_toff = s_off + 17;
    moe_tables(p, layer, tid, s_cnt, s_off, s_toff);
    const int ntiles = s_toff[16];
    const bf16_t* hA = (const bf16_t*)(p.ws + OFF_HA);
    const int* ltok = (const int*)(p.ws + OFF_LTOK);
    bf16_t* H1 = (bf16_t*)(p.ws + OFF_H1);
    int* rowidx = (int*)(lds + LDS_ROWIDX_OFF);
    const int sc = stage_col2(tid), sr = tid >> 2;
    const int vb = cx.vbid, G = cx.G;
    const int my_tiles = min(8, vb < ntiles ? (ntiles - vb + G - 1) / G : 0);
    auto locate = [=](int j, int& e, int& rt, int& ct) { const int tile = vb + j * G; e = 0; while (tile >= s_toff[e + 1]) ++e; const int lt = tile - s_toff[e]; rt = lt >> 2; ct = lt & 3; };
    for (int i = tid; i < my_tiles * 256; i += NTHR) {
        const int j = i >> 8, r = i & 255; int e, rt, ct; locate(j, e, rt, ct);
        rowidx[i] = ltok[(size_t)e * NTOK + min(rt * 256 + r, s_cnt[e] - 1)];
    }
    __syncthreads();
    const bf16_t* Wup = (const bf16_t*)(p.ws + OFF_W_UP) + (size_t)layer * 16 * 1024 * 1024;
    gemm_stream2(my_tiles, 1024, lds, cx,
        [=](int j, const bf16_t* (&ap)[2], const bf16_t* (&bp)[2]) {
            int e, rt, ct; locate(j, e, rt, ct);
            ap[0] = hA + (size_t)rowidx[j * 256 + sr] * 1024 + sc; ap[1] = hA + (size_t)rowidx[j * 256 + sr + 128] * 1024 + sc;
            bp[0] = Wup + ((size_t)e * 1024 + ct * 256 + sr) * 1024 + sc; bp[1] = bp[0] + (size_t)128 * 1024;
        },
        [=](int j, f32x4 (&acc)[8][4], int wr, int wc, int fr, int fq) {
            int e, rt, ct; locate(j, e, rt, ct);
            const int cnt = s_cnt[e], off = s_off[e];
#pragma unroll
            for (int m = 0; m < 8; ++m) {
                const int pos = rt * 256 + wr * 128 + m * 16 + fr;
                if (pos < cnt) {
                    bf16_t* dst = H1 + (size_t)(off + pos) * 512 + ct * 128 + wc * 32 + fq * 8;
                    float h[8];
#pragma unroll
                    for (int n = 0; n < 2; ++n)
#pragma unroll
                        for (int jj = 0; jj < 4; ++jj) h[n * 4 + jj] = silu_f(acc[m][n][jj]) * acc[m][n + 2][jj];
                    uint4 o; o.x = pack2(h[0], h[1]); o.y = pack2(h[2], h[3]); o.z = pack2(h[4], h[5]); o.w = pack2(h[6], h[7]);
                    *(uint4*)dst = o;
                }
            }
        });
}

__device__ __forceinline__ void phase_moe_down(const Params& p, const Ctx& cx, char* lds, int layer) {
    const int tid = cx.tid;
    int* s_cnt = (int*)(lds + LDS_TAB_OFF); int* s_off = s_cnt + 16; int* s_toff = s_off + 17;
    moe_tables(p, layer, tid, s_cnt, s_off, s_toff);
    const int ntiles = s_toff[16];
    const bf16_t* H1 = (const bf16_t*)(p.ws + OFF_H1);
    const float* lw = (const float*)(p.ws + OFF_LW);
    bf16_t* Y = (bf16_t*)(p.ws + OFF_Y);
    float* lwc = (float*)(lds + LDS_LW_OFF);
    const int sc = stage_col2(tid), sr = tid >> 2;
    const int vb = cx.vbid, G = cx.G;
    const int my_tiles = min(8, vb < ntiles ? (ntiles - vb + G - 1) / G : 0);
    auto locate = [=](int j, int& e, int& rt, int& ct) { const int tile = vb + j * G; e = 0; while (tile >= s_toff[e + 1]) ++e; const int lt = tile - s_toff[e]; rt = lt >> 2; ct = lt & 3; };
    for (int i = tid; i < my_tiles * 256; i += NTHR) {
        const int j = i >> 8, r = i & 255; int e, rt, ct; locate(j, e, rt, ct);
        lwc[i] = lw[(size_t)e * NTOK + min(rt * 256 + r, s_cnt[e] - 1)];
    }
    __syncthreads();
    const bf16_t* Wdn = (const bf16_t*)(p.ws + OFF_W_DN) + (size_t)layer * 16 * 1024 * 512;
    gemm_stream2(my_tiles, 512, lds, cx,
        [=](int j, const bf16_t* (&ap)[2], const bf16_t* (&bp)[2]) {
            int e, rt, ct; locate(j, e, rt, ct);
            const int cnt = s_cnt[e], off = s_off[e];
            ap[0] = H1 + (size_t)(off + min(rt * 256 + sr, cnt - 1)) * 512 + sc; ap[1] = H1 + (size_t)(off + min(rt * 256 + sr + 128, cnt - 1)) * 512 + sc;
            bp[0] = Wdn + ((size_t)e * 1024 + ct * 256 + sr) * 512 + sc; bp[1] = bp[0] + (size_t)128 * 512;
        },
        [=](int j, f32x4 (&acc)[8][4], int wr, int wc, int fr, int fq) {
            int e, rt, ct; locate(j, e, rt, ct);
            const int cnt = s_cnt[e], off = s_off[e];
#pragma unroll
            for (int m = 0; m < 8; ++m) {
                const int rl_ = wr * 128 + m * 16 + fr, pos = rt * 256 + rl_;
                if (pos < cnt) {
                    const float w = lwc[j * 256 + rl_];
                    bf16_t* dst = Y + (size_t)(off + pos) * 1024 + ct * 256 + wc * 64;
#pragma unroll
                    for (int pp = 0; pp < 2; ++pp) {
                        const f32x4 a = acc[m][2 * pp], bb = acc[m][2 * pp + 1];
                        uint4 o; o.x = pack2(w * a[0], w * a[1]); o.y = pack2(w * a[2], w * a[3]); o.z = pack2(w * bb[0], w * bb[1]); o.w = pack2(w * bb[2], w * bb[3]);
                        *(uint4*)(dst + pp * 32 + fq * 8) = o;
                    }
                }
            }
        });
}


namespace pg8 {
#define PG8_LAS __attribute__((address_space(3)))
typedef unsigned short bf16_t;
typedef short bf16x8 __attribute__((ext_vector_type(8)));
typedef float f32x4 __attribute__((ext_vector_type(4)));
typedef unsigned u32x4 __attribute__((ext_vector_type(4)));
constexpr int BM = 256, BK = 64, HALF = 128, HTB = HALF * BK * 2  , STAGE_BYTES = 8 * HTB, NXCD = 8, WGM = 8;

__host__ __device__ __forceinline__ int lds_byte(int r, int c) { const int st = (r >> 4) * 2 + (c >> 5), rr = r & 15, cc = c & 31, ob = rr * 64 + cc * 2; return st * 1024 + (ob ^ (((ob >> 9) & 1) << 5)); }
__host__ __device__ __forceinline__ void stage_rc(int b, int& R, int& C) { const int st = b / 1024, sb = b % 1024, swz = sb ^ (((sb >> 9) & 1) << 5); R = (st >> 1) * 16 + swz / 64; C = (st & 1) * 32 + (swz % 64) / 2; }
__host__ __device__ __forceinline__ int perm32(int rho) { const int n = rho >> 4, i = rho & 15; return 8 * (i >> 2) + 4 * n + (i & 3); }

struct Unit { int pm, pn; };
struct Gemm { const bf16_t* A; const bf16_t* Bt; int M, N, K; };

struct StaticOrder {
    int nM, nN, nwg, G, c;
    __host__ __device__ void init(int M, int N, int G_, int c_) { nM = M / BM; nN = N / BM; nwg = nM * nN; G = G_; c = c_; }
    __host__ __device__ bool next(int i, Unit& u) const {
        const long L = (long)i * G + c; if (L >= nwg) return false;
        int wgid = (int)L; { const int q = nwg / NXCD, r = nwg % NXCD, xcd = wgid % NXCD, off = wgid / NXCD; wgid = (xcd < r ? xcd * (q + 1) : r * (q + 1) + (xcd - r) * q) + off; }
        const int nig = WGM * nN, gid = wgid / nig, fm = gid * WGM, gsz = (nM - fm) < WGM ? (nM - fm) : WGM;
        u.pm = fm + ((wgid % nig) % gsz); u.pn = (wgid % nig) / gsz; return true;
    }
    __device__ __forceinline__ void a_ready(const Unit&) const {}
    __device__ __forceinline__ void done(const Unit&) const {}
};

template <class Epi, class Sched, bool ALIGN_EPI = false, bool SP2 = false>
__device__ __forceinline__ void gemm_phase(PG8_LAS unsigned char* lds, const Gemm g, const Sched& S, const Epi& E) {
    const int tid = threadIdx.x, wid = __builtin_amdgcn_readfirstlane(tid >> 6), lane = tid & 63, wr = wid >> 2, wc = wid & 3, fr = lane & 15, fq = lane >> 4;
    const int K = g.K, nt = K / BK;
    unsigned voffA[2], voffB[2];
#pragma unroll
    for (int i = 0; i < 2; ++i) { int R, C; stage_rc(tid * 16 + i * 8192, R, C); const int Rb = Epi::PERM ? ((R & ~31) + perm32(R & 31)) : R;
        voffA[i] = (unsigned)(R * K + C) * 2u; voffB[i] = (unsigned)(Rb * K + C) * 2u; }
    const size_t kstep = (size_t)(BK * 2);
    const size_t hstep = (size_t)HALF * K * 2;
    const size_t tstep = 2 * hstep;
    const unsigned ldsw = (unsigned)wid * 1024u;
    const int aoff = lds_byte(wr * 64 + fr, fq * 8), boff = lds_byte(wc * 32 + fr, fq * 8);
#define PG8_SA(b, h) (((b) * 2 + (h)) * HTB)
#define PG8_SB(b, h) ((4 + (b) * 2 + (h)) * HTB)
#define PG8_STAGE(bufoff, gbase, voff) do { _Pragma("unroll") for (int _i = 0; _i < 2; ++_i) \
        __builtin_amdgcn_global_load_lds((const unsigned*)((const char*)(gbase) + (voff)[_i]), (PG8_LAS unsigned*)(lds + (bufoff) + ldsw + _i * 8192), 16, 0, 0); } while (0)
#define PG8_LDA(dst, b, h) do { _Pragma("unroll") for (int m = 0; m < 4; ++m) _Pragma("unroll") for (int k = 0; k < 2; ++k) dst[m][k] = *(const PG8_LAS bf16x8*)(lds + PG8_SA(b, h) + aoff + m * 2048 + k * 1024); } while (0)
#define PG8_LDB(dst, b, h) do { _Pragma("unroll") for (int n = 0; n < 2; ++n) _Pragma("unroll") for (int k = 0; k < 2; ++k) dst[n][k] = *(const PG8_LAS bf16x8*)(lds + PG8_SB(b, h) + boff + n * 2048 + k * 1024); } while (0)
#define PG8_MMA(ai, bj, At, Bt) do { __builtin_amdgcn_s_setprio(1); _Pragma("unroll") for (int m = 0; m < 4; ++m) _Pragma("unroll") for (int n = 0; n < 2; ++n) _Pragma("unroll") for (int k = 0; k < 2; ++k) \
        acc[ai][bj][m][n] = __builtin_amdgcn_mfma_f32_16x16x32_bf16(Bt[n][k], At[m][k], acc[ai][bj][m][n], 0, 0, 0); __builtin_amdgcn_s_setprio(0); } while (0)
#define PG8_WAIT_V(n) asm volatile("s_waitcnt vmcnt(" #n ")" ::: "memory")
#define PG8_WAIT_L(n) asm volatile("s_waitcnt lgkmcnt(" #n ")" ::: "memory")
#define PG8_BAR __builtin_amdgcn_s_barrier()
#define PG8_SCHED __builtin_amdgcn_sched_barrier(0)
    Unit cur, nxt; int ui = 0;
    if (!S.next(0, cur)) return;
    f32x4 acc[2][2][4][2];
#pragma unroll
    for (int a = 0; a < 2; ++a)
#pragma unroll
        for (int b = 0; b < 2; ++b)
#pragma unroll
            for (int m = 0; m < 4; ++m)
#pragma unroll
                for (int n = 0; n < 2; ++n) acc[a][b][m][n] = (f32x4){0.f, 0.f, 0.f, 0.f};
    bf16x8 At[4][2], B0[2][2], B1[2][2];
    const char* cA = (const char*)g.A + (size_t)cur.pm * tstep; const char* cB = (const char*)g.Bt + (size_t)cur.pn * tstep;
    S.a_ready(cur);
    if constexpr (SP2) {
        PG8_STAGE(PG8_SB(0, 0), cB, voffB); PG8_STAGE(PG8_SB(0, 1), cB + hstep, voffB); PG8_STAGE(PG8_SA(0, 0), cA, voffA); PG8_STAGE(PG8_SA(0, 1), cA + hstep, voffA);
        if (wr == 1) PG8_BAR;
        PG8_WAIT_V(2); PG8_BAR;
        PG8_STAGE(PG8_SB(1, 0), cB + kstep, voffB); PG8_STAGE(PG8_SA(1, 0), cA + kstep, voffA); PG8_STAGE(PG8_SB(1, 1), cB + hstep + kstep, voffB);
        PG8_WAIT_V(6); PG8_BAR;
    } else {
        PG8_STAGE(PG8_SB(0, 0), cB, voffB); PG8_STAGE(PG8_SA(0, 0), cA, voffA); PG8_STAGE(PG8_SB(0, 1), cB + hstep, voffB); PG8_STAGE(PG8_SA(0, 1), cA + hstep, voffA);
        if (wr == 1) PG8_BAR;
        PG8_WAIT_V(4); PG8_BAR;
        PG8_STAGE(PG8_SB(1, 0), cB + kstep, voffB); PG8_STAGE(PG8_SA(1, 0), cA + kstep, voffA); PG8_STAGE(PG8_SB(1, 1), cB + hstep + kstep, voffB);
        PG8_WAIT_V(6); PG8_BAR;
    }
    for (;;) {
        const bool has_next = S.next(ui + 1, nxt);
        const char* nA = has_next ? (const char*)g.A + (size_t)nxt.pm * tstep : cA; const char* nB = has_next ? (const char*)g.Bt + (size_t)nxt.pn * tstep : cB;
        for (int t = 0; t < nt; t += 2) {
            const bool last = (t == nt - 2);
            const char* a1 = cA + (size_t)(t + 1) * kstep;
            const char* a2 = last ? nA : cA + (size_t)(t + 2) * kstep; const char* b2 = last ? nB : cB + (size_t)(t + 2) * kstep;
            const char* a3 = a2 + kstep; const char* b3 = b2 + kstep;
            if (last && has_next) S.a_ready(nxt);
            if constexpr (SP2) {
            PG8_LDB(B0, 0, 0); PG8_LDB(B1, 0, 1); PG8_SCHED; PG8_LDA(At, 0, 0); PG8_STAGE(PG8_SA(1, 1), a1 + hstep, voffA);
            PG8_WAIT_V(8); PG8_WAIT_L(0); PG8_BAR; PG8_MMA(0, 0, At, B0); PG8_MMA(0, 1, At, B1); PG8_BAR; PG8_SCHED;
            PG8_LDA(At, 0, 1); PG8_STAGE(PG8_SB(0, 0), b2, voffB); PG8_STAGE(PG8_SB(0, 1), b2 + hstep, voffB); PG8_STAGE(PG8_SA(0, 0), a2, voffA);
            PG8_WAIT_V(8); PG8_WAIT_L(0); PG8_BAR; PG8_MMA(1, 0, At, B0); PG8_MMA(1, 1, At, B1); PG8_BAR; PG8_SCHED;
            PG8_LDB(B0, 1, 0); PG8_LDB(B1, 1, 1); PG8_SCHED; PG8_LDA(At, 1, 0); PG8_STAGE(PG8_SA(0, 1), a2 + hstep, voffA);
            PG8_WAIT_V(8); PG8_WAIT_L(0); PG8_BAR; PG8_MMA(0, 0, At, B0); PG8_MMA(0, 1, At, B1); PG8_BAR; PG8_SCHED;
            PG8_LDA(At, 1, 1); PG8_STAGE(PG8_SB(1, 0), b3, voffB); PG8_STAGE(PG8_SB(1, 1), b3 + hstep, voffB); PG8_STAGE(PG8_SA(1, 0), a3, voffA);
            PG8_WAIT_V(8); PG8_WAIT_L(0); PG8_BAR; PG8_MMA(1, 0, At, B0); PG8_MMA(1, 1, At, B1); PG8_BAR; PG8_SCHED;
            } else {
            PG8_LDB(B0, 0, 0); PG8_SCHED; PG8_LDA(At, 0, 0); PG8_STAGE(PG8_SA(1, 1), a1 + hstep, voffA);
            PG8_WAIT_L(8); PG8_BAR; PG8_WAIT_L(0); PG8_MMA(0, 0, At, B0); PG8_BAR; PG8_SCHED;
            PG8_LDB(B1, 0, 1); PG8_STAGE(PG8_SB(0, 0), b2, voffB);
            PG8_BAR; PG8_WAIT_L(0); PG8_MMA(0, 1, At, B1); PG8_BAR;
            PG8_LDA(At, 0, 1); PG8_STAGE(PG8_SA(0, 0), a2, voffA);
            PG8_BAR; PG8_WAIT_L(0); PG8_MMA(1, 0, At, B0); PG8_BAR; PG8_SCHED;
            PG8_STAGE(PG8_SB(0, 1), b2 + hstep, voffB);
            PG8_WAIT_V(6); PG8_BAR; PG8_MMA(1, 1, At, B1); PG8_BAR;
            PG8_LDB(B0, 1, 0); PG8_SCHED; PG8_LDA(At, 1, 0); PG8_STAGE(PG8_SA(0, 1), a2 + hstep, voffA);
            PG8_WAIT_L(8); PG8_BAR; PG8_WAIT_L(0); PG8_MMA(0, 0, At, B0); PG8_BAR; PG8_SCHED;
            PG8_LDB(B1, 1, 1); PG8_STAGE(PG8_SB(1, 0), b3, voffB);
            PG8_BAR; PG8_WAIT_L(0); PG8_MMA(0, 1, At, B1); PG8_BAR;
            PG8_LDA(At, 1, 1); PG8_STAGE(PG8_SA(1, 0), a3, voffA);
            PG8_BAR; PG8_WAIT_L(0); PG8_MMA(1, 0, At, B0); PG8_BAR; PG8_SCHED;
            PG8_STAGE(PG8_SB(1, 1), b3 + hstep, voffB);
            PG8_WAIT_V(6); PG8_BAR; PG8_MMA(1, 1, At, B1); PG8_BAR;
            }
        }
        if constexpr (ALIGN_EPI) { if (wr == 0) PG8_BAR; }
        if constexpr (!Epi::AFTER_DRAIN) { E(acc, cur, wr, wc, fr, fq); S.done(cur); }
        if (!has_next) break;
#pragma unroll
        for (int a = 0; a < 2; ++a)
#pragma unroll
            for (int b = 0; b < 2; ++b)
#pragma unroll
                for (int m = 0; m < 4; ++m)
#pragma unroll
                    for (int n = 0; n < 2; ++n) acc[a][b][m][n] = (f32x4){0.f, 0.f, 0.f, 0.f};
        cur = nxt; cA = nA; cB = nB; ++ui;
        if constexpr (ALIGN_EPI) { if (wr == 1) PG8_BAR; }
    }
    PG8_WAIT_V(0);
    if constexpr (!ALIGN_EPI) { if (wr == 0) PG8_BAR; }
    PG8_BAR;
    if constexpr (Epi::AFTER_DRAIN) { E.fused(acc, cur, wr, wc, fr, fq, lds, wid, lane); S.done(cur); }
#undef PG8_SA
#undef PG8_SB
#undef PG8_STAGE
#undef PG8_LDA
#undef PG8_LDB
#undef PG8_MMA
#undef PG8_WAIT_V
#undef PG8_WAIT_L
#undef PG8_BAR
#undef PG8_SCHED
}
}

#ifndef PG8_SP2
#define PG8_SP2 true
#endif
struct EpiHgrnIn {
    static constexpr bool PERM = false, AFTER_DRAIN = false;
    char* ws; const float* lb;
    __device__ __forceinline__ void operator()(const pg8::f32x4 (&acc)[2][2][4][2], const pg8::Unit& u, int wr, int wc, int fr, int fq) const {
#pragma unroll
        for (int ai = 0; ai < 2; ++ai)
#pragma unroll
            for (int m = 0; m < 4; ++m) {
                const int row = u.pm * 256 + ai * 128 + wr * 64 + m * 16 + fr;
#pragma unroll
                for (int bj = 0; bj < 2; ++bj) {
                    const int gc = u.pn * 256 + bj * 128 + wc * 32 + fq * 8, seg = gc >> 10, c = gc & 1023;
                    const f32x4 a0 = acc[ai][bj][m][0], a1 = acc[ai][bj][m][1];
                    float h[8];
                    if (seg == 1) {
                        const f32x4 la = *(const f32x4*)(lb + c), lbb = *(const f32x4*)(lb + c + 4);
#pragma unroll
                        for (int j = 0; j < 4; ++j) {
                            h[j] = __logf(la[j] + (1.f - la[j]) * sigmoid_f(a0[j]));
                            h[4 + j] = __logf(lbb[j] + (1.f - lbb[j]) * sigmoid_f(a1[j]));
                        }
                        uint4 oh; oh.x = packh2(h[0], h[1]); oh.y = packh2(h[2], h[3]); oh.z = packh2(h[4], h[5]); oh.w = packh2(h[6], h[7]);
                        *(uint4*)((unsigned short*)(ws + OFF_LF) + (size_t)row * 1024 + c) = oh;
                    } else {
#pragma unroll
                        for (int j = 0; j < 4; ++j) {
                            h[j] = (seg == 2) ? a0[j] : silu_f(a0[j]);
                            h[4 + j] = (seg == 2) ? a1[j] : silu_f(a1[j]);
                        }
                        uint4 o; o.x = pack2(h[0], h[1]); o.y = pack2(h[2], h[3]); o.z = pack2(h[4], h[5]); o.w = pack2(h[6], h[7]);
                        bf16_t* dst = (bf16_t*)(ws + (seg == 0 ? OFF_QH : seg == 2 ? OFF_V : OFF_G));
                        *(uint4*)(dst + (size_t)row * 1024 + c) = o;
                    }
                }
            }
    }
};

struct EpiOutProj {
    static constexpr bool PERM = false, AFTER_DRAIN = false;
    const float* mod; const float* xin; float* xo; int ls;
    __device__ __forceinline__ void operator()(const pg8::f32x4 (&acc)[2][2][4][2], const pg8::Unit& u, int wr, int wc, int fr, int fq) const {
        const int b = (u.pm * 256) >> 11;
        const float* gate = mod + ((size_t)ls * 16 + b) * 3072 + 2048 + u.pn * 256 + wc * 32 + fq * 8;
        f32x4 g[2][2];
#pragma unroll
        for (int bj = 0; bj < 2; ++bj) { g[bj][0] = *(const f32x4*)(gate + bj * 128); g[bj][1] = *(const f32x4*)(gate + bj * 128 + 4); }
#pragma unroll
        for (int ai = 0; ai < 2; ++ai)
#pragma unroll
            for (int m = 0; m < 4; ++m) {
                const size_t ro = (size_t)(u.pm * 256 + ai * 128 + wr * 64 + m * 16 + fr) * 1024 + u.pn * 256 + wc * 32 + fq * 8;
                f32x4 xi[2][2];
#pragma unroll
                for (int bj = 0; bj < 2; ++bj) { xi[bj][0] = *(const f32x4*)(xin + ro + bj * 128); xi[bj][1] = *(const f32x4*)(xin + ro + bj * 128 + 4); }
#pragma unroll
                for (int bj = 0; bj < 2; ++bj)
#pragma unroll
                    for (int n = 0; n < 2; ++n) {
                        f32x4 o;
#pragma unroll
                        for (int j = 0; j < 4; ++j) o[j] = xi[bj][n][j] + g[bj][n][j] * acc[ai][bj][m][n][j];
                        *(f32x4*)(xo + ro + bj * 128 + n * 4) = o;
                    }
            }
    }
};

__device__ __forceinline__ void phase_outproj8(const Params& p, const Ctx& cx, char* lds, const bf16_t* A, const bf16_t* Bt, const float* xin, int ls) {
    pg8::Gemm g{A, Bt, NTOK, 1024, 1024};
    pg8::StaticOrder S; S.init(NTOK, 1024, cx.G, (int)blockIdx.x);
    EpiOutProj E{(const float*)(p.ws + OFF_MOD), xin, p.out, ls};
    __syncthreads();
    pg8::gemm_phase<EpiOutProj, pg8::StaticOrder, true, PG8_SP2>((PG8_LAS unsigned char*)lds, g, S, E);
    __syncthreads();
}

__device__ __forceinline__ void phase_hgrn_inproj8(const Params& p, const Ctx& cx, char* lds) {
    pg8::Gemm g{(const bf16_t*)(p.ws + OFF_HA), (const bf16_t*)(p.ws + OFF_W_HG_IN), NTOK, 4096, 1024};
    pg8::StaticOrder S; S.init(NTOK, 4096, cx.G, (int)blockIdx.x);
    EpiHgrnIn E{p.ws, (const float*)(p.ws + OFF_LB)};
    __syncthreads();
    pg8::gemm_phase<EpiHgrnIn, pg8::StaticOrder, true, PG8_SP2>((PG8_LAS unsigned char*)lds, g, S, E);
    __syncthreads();
}

template <int MODE = 0>
__device__ __forceinline__ void phase_hgrn_inproj(const Params& p, const Ctx& cx, char* lds) {
    const bf16_t* A = (const bf16_t*)(p.ws + OFF_HA);
    const bf16_t* Bt = (const bf16_t*)(p.ws + OFF_W_HG_IN);
    char* ws = p.ws;
    const float* lb = (const float*)(p.ws + OFF_LB);
    gemm_phase_dense2(A, 1024, Bt, 1024, NTOK / 256, 16, lds, cx, [=](int row0, int col0) {
        return [=](f32x4 (&acc)[8][4], int wr, int wc, int fr, int fq) {
            const int gc0 = col0 + wc * 64, seg = gc0 >> 10, c0 = gc0 & 1023;
#pragma unroll
            for (int m = 0; m < 8; ++m) {
                const int row = row0 + wr * 128 + m * 16 + fr;
#pragma unroll
                for (int pp = 0; pp < 2; ++pp) {
                    const int c = c0 + pp * 32 + fq * 8;
                    float h[8];
                    if (seg == 1) {
                        const f32x4 la = *(const f32x4*)(lb + c), lbb = *(const f32x4*)(lb + c + 4);
#pragma unroll
                        for (int j = 0; j < 4; ++j) {
                            h[j] = __logf(la[j] + (1.f - la[j]) * sigmoid_f(acc[m][2 * pp][j]));
                            h[4 + j] = __logf(lbb[j] + (1.f - lbb[j]) * sigmoid_f(acc[m][2 * pp + 1][j]));
                        }
                        uint4 oh; oh.x = packh2(h[0], h[1]); oh.y = packh2(h[2], h[3]); oh.z = packh2(h[4], h[5]); oh.w = packh2(h[6], h[7]);
                        *(uint4*)((unsigned short*)(ws + OFF_LF) + (size_t)row * 1024 + c) = oh;
                    } else {
#pragma unroll
                        for (int j = 0; j < 4; ++j) {
                            h[j] = (seg == 2) ? acc[m][2 * pp][j] : silu_f(acc[m][2 * pp][j]);
                            h[4 + j] = (seg == 2) ? acc[m][2 * pp + 1][j] : silu_f(acc[m][2 * pp + 1][j]);
                        }
                        uint4 o; o.x = pack2(h[0], h[1]); o.y = pack2(h[2], h[3]); o.z = pack2(h[4], h[5]); o.w = pack2(h[6], h[7]);
                        bf16_t* dst = (bf16_t*)(ws + (seg == 0 ? OFF_QH : seg == 2 ? OFF_V : OFF_G));
                        *(uint4*)(dst + (size_t)row * 1024 + c) = o;
                    }
                }
            }
        };
    });
}

constexpr int HG_QD_OFF = 0, HG_KD_OFF = 8704, HG_K2T_OFF = 17408, HG_VT_OFF = 27648, HG_DEC_OFF = 37888, HG_BUF = 38400, HG_TOT_OFF = 2 * HG_BUF;
constexpr int HG_ROW = 272, HG_TROW = 80;
static_assert(HG_TOT_OFF + 2048 <= LDS_TAB_OFF, "hgrn LDS");

__device__ __forceinline__ void phase_hgrn_rec(const Params& p, const Ctx& cx, char* lds) {
    const int lane = cx.lane;
    const int l31 = lane & 31, h2 = lane >> 5;
    const int widu = __builtin_amdgcn_readfirstlane(cx.wid);
    const bool producer = widu >= 4;
    const int pw = widu & 3;
    const int d0 = 2 * lane;
    const bf16_t* QH = (const bf16_t*)(p.ws + OFF_QH);
    const unsigned short* LF = (const unsigned short*)(p.ws + OFF_LF);
    const bf16_t* V = (const bf16_t*)(p.ws + OFF_V);
    bf16_t* OR = (bf16_t*)(p.ws + OFF_HA);
    float* tot = (float*)(lds + HG_TOT_OFF);
    for (int item = blockIdx.x; item < 128; item += cx.G) {
        const int b = item >> 3, h = item & 7;
        f32x16 S0, S1, S2, S3;
#pragma unroll
        for (int r = 0; r < 16; ++r) { S0[r] = 0.f; S1[r] = 0.f; S2[r] = 0.f; S3[r] = 0.f; }
        unsigned lfA[8], lfB[8], qv[8], vv[8];
        const size_t gbase = (size_t)(b * SEQ + pw * 8) * 1024 + h * 128;
        if (producer) {
#pragma unroll
            for (int i = 0; i < 8; ++i) {
                lfA[i] = *(const unsigned*)(LF + gbase + (size_t)i * 1024 + d0);
                qv[i] = *(const unsigned*)(QH + gbase + (size_t)i * 1024 + d0);
                vv[i] = *(const unsigned*)(V + gbase + (size_t)i * 1024 + d0);
            }
#pragma unroll
            for (int i = 0; i < 8; ++i) lfB[i] = *(const unsigned*)(LF + gbase + (size_t)(32 + i) * 1024 + d0);
        }
        __syncthreads();
        for (int c = 0; c <= SEQ / 32; ++c) {
            unsigned lf[8];
#pragma unroll
            for (int i = 0; i < 8; ++i) lf[i] = (c & 1) ? lfB[i] : lfA[i];
            f2_t run = {0.f, 0.f};
            if (producer && c < SEQ / 32) {
#pragma unroll
                for (int i = 0; i < 8; ++i) run += unpackh2(lf[i]);
                *(f2_t*)(tot + pw * 128 + d0) = run;
            }
            __syncthreads();
            if (producer) {
                if (c < SEQ / 32) {
                    char* bufp = lds + (c & 1) * HG_BUF;
                    f2_t pre = {0.f, 0.f}, last = {0.f, 0.f};
#pragma unroll
                    for (int q = 0; q < 4; ++q) {
                        const f2_t tq_ = *(const f2_t*)(tot + q * 128 + d0);
                        last += tq_;
                        if (q < pw) pre += tq_;
                    }
                    if (pw == 0) { f2_t dv; dv.x = __expf(last.x); dv.y = __expf(last.y); *(f2_t*)(bufp + HG_DEC_OFF + d0 * 4) = dv; }
                    float k2a[8], k2b[8];
                    f2_t rc = pre;
#pragma unroll
                    for (int i = 0; i < 8; ++i) {
                        const f2_t lfi = unpackh2(lf[i]);
                        rc += lfi;
                        const float cu0 = rc.x, cu1 = rc.y;
                        const float kk0 = 1.f - __expf(lfi.x), kk1 = 1.f - __expf(lfi.y);
                        const float q0 = bf2f((unsigned short)(qv[i] & 0xffff)) * __expf(cu0), q1 = bf2f((unsigned short)(qv[i] >> 16)) * __expf(cu1);
                        const float kd0 = kk0 * __expf(-cu0), kd1 = kk1 * __expf(-cu1);
                        k2a[i] = kk0 * __expf(last.x - cu0); k2b[i] = kk1 * __expf(last.y - cu1);
                        const int tl = pw * 8 + i;
                        *(unsigned*)(bufp + HG_QD_OFF + tl * HG_ROW + d0 * 2) = pack2(q0, q1);
                        *(unsigned*)(bufp + HG_KD_OFF + tl * HG_ROW + d0 * 2) = pack2(kd0, kd1);
                    }
                    uint4 a, bq, va, vb;
                    a.x = pack2(k2a[0], k2a[1]); a.y = pack2(k2a[2], k2a[3]); a.z = pack2(k2a[4], k2a[5]); a.w = pack2(k2a[6], k2a[7]);
                    bq.x = pack2(k2b[0], k2b[1]); bq.y = pack2(k2b[2], k2b[3]); bq.z = pack2(k2b[4], k2b[5]); bq.w = pack2(k2b[6], k2b[7]);
                    va.x = (vv[0] & 0xffffu) | (vv[1] << 16); va.y = (vv[2] & 0xffffu) | (vv[3] << 16); va.z = (vv[4] & 0xffffu) | (vv[5] << 16); va.w = (vv[6] & 0xffffu) | (vv[7] << 16);
                    vb.x = (vv[0] >> 16) | (vv[1] & 0xffff0000u); vb.y = (vv[2] >> 16) | (vv[3] & 0xffff0000u); vb.z = (vv[4] >> 16) | (vv[5] & 0xffff0000u); vb.w = (vv[6] >> 16) | (vv[7] & 0xffff0000u);
                    *(uint4*)(bufp + HG_K2T_OFF + d0 * HG_TROW + pw * 16) = a;
                    *(uint4*)(bufp + HG_K2T_OFF + (d0 + 1) * HG_TROW + pw * 16) = bq;
                    *(uint4*)(bufp + HG_VT_OFF + d0 * HG_TROW + pw * 16) = va;
                    *(uint4*)(bufp + HG_VT_OFF + (d0 + 1) * HG_TROW + pw * 16) = vb;
                    __builtin_amdgcn_sched_barrier(0);
                    if (c + 1 < SEQ / 32) {
                        const size_t gn = gbase + (size_t)(c + 1) * 32 * 1024;
#pragma unroll
                        for (int i = 0; i < 8; ++i) {
                            qv[i] = *(const unsigned*)(QH + gn + (size_t)i * 1024 + d0);
                            vv[i] = *(const unsigned*)(V + gn + (size_t)i * 1024 + d0);
                        }
                    }
                    if (c + 2 < SEQ / 32) {
                        const size_t gn = gbase + (size_t)(c + 2) * 32 * 1024;
                        if (c & 1) {
#pragma unroll
                            for (int i = 0; i < 8; ++i) lfB[i] = *(const unsigned*)(LF + gn + (size_t)i * 1024 + d0);
                        } else {
#pragma unroll
                            for (int i = 0; i < 8; ++i) lfA[i] = *(const unsigned*)(LF + gn + (size_t)i * 1024 + d0);
                        }
                    }
                }
            } else if (c >= 1) {
                const int cc = c - 1;
                const char* bufp = lds + (cc & 1) * HG_BUF;
                const float* dec = (const float*)(bufp + HG_DEC_OFF);
                f32x16 X;
#pragma unroll
                for (int r = 0; r < 16; ++r) X[r] = 0.f;
                {
                    const char* ka = bufp + HG_KD_OFF + l31 * HG_ROW + 16 * h2;
                    const char* qa = bufp + HG_QD_OFF + l31 * HG_ROW + 16 * h2;
#pragma unroll 2
                    for (int ks = 0; ks < 8; ++ks) X = MFMA32(*(const bf16x8*)(ka + 32 * ks), *(const bf16x8*)(qa + 32 * ks), X);
#pragma unroll
                    for (int r = 0; r < 16; ++r) { const int srow = (r & 3) + 8 * (r >> 2) + 4 * h2; X[r] = (srow <= l31) ? X[r] : 0.f; }
                }
                f32x16 Oa;
#pragma unroll
                for (int r = 0; r < 16; ++r) Oa[r] = 0.f;
                const int jrow = 32 * pw + l31;
#pragma unroll
                for (int s2 = 0; s2 < 2; ++s2) {
                    uint4 xk;
                    xk.x = pack2(X[8 * s2], X[8 * s2 + 1]); xk.y = pack2(X[8 * s2 + 2], X[8 * s2 + 3]); xk.z = pack2(X[8 * s2 + 4], X[8 * s2 + 5]); xk.w = pack2(X[8 * s2 + 6], X[8 * s2 + 7]);
                    const char* va = bufp + HG_VT_OFF + jrow * HG_TROW + (16 * s2 + 4 * h2) * 2;
                    const uint2 lo = *(const uint2*)va, hi = *(const uint2*)(va + 16);
                    uint4 vb; vb.x = lo.x; vb.y = lo.y; vb.z = hi.x; vb.w = hi.y;
                    Oa = MFMA32(__builtin_bit_cast(bf16x8, xk), __builtin_bit_cast(bf16x8, vb), Oa);
                }
                auto qs_term = [&](const f32x16& St, int dt) {
#pragma unroll
                    for (int s2 = 0; s2 < 2; ++s2) {
                        uint4 sk;
                        sk.x = pack2(St[8 * s2], St[8 * s2 + 1]); sk.y = pack2(St[8 * s2 + 2], St[8 * s2 + 3]); sk.z = pack2(St[8 * s2 + 4], St[8 * s2 + 5]); sk.w = pack2(St[8 * s2 + 6], St[8 * s2 + 7]);
                        const char* qa = bufp + HG_QD_OFF + l31 * HG_ROW + (32 * dt + 16 * s2 + 4 * h2) * 2;
                        const uint2 lo = *(const uint2*)qa, hi = *(const uint2*)(qa + 16);
                        uint4 qb; qb.x = lo.x; qb.y = lo.y; qb.z = hi.x; qb.w = hi.y;
                        Oa = MFMA32(__builtin_bit_cast(bf16x8, qb), __builtin_bit_cast(bf16x8, sk), Oa);
                    }
                };
                __builtin_amdgcn_sched_barrier(0);
                qs_term(S0, 0); qs_term(S1, 1);
                __builtin_amdgcn_sched_barrier(0);
                qs_term(S2, 2); qs_term(S3, 3);
                __builtin_amdgcn_sched_barrier(0);
                {
                    bf16_t* orow = OR + (size_t)(b * SEQ + cc * 32 + 4 * h2) * 1024 + h * 128 + jrow;
#pragma unroll
                    for (int r = 0; r < 16; ++r) orow[(size_t)((r & 3) + 8 * (r >> 2)) * 1024] = f2bf(Oa[r]);
                }
                auto s_update = [&](f32x16& St, int dt) {
#pragma unroll
                    for (int rq = 0; rq < 4; ++rq) {
                        const f32x4 dc = *(const f32x4*)(dec + 32 * dt + 8 * rq + 4 * h2);
                        St[4 * rq] *= dc[0]; St[4 * rq + 1] *= dc[1]; St[4 * rq + 2] *= dc[2]; St[4 * rq + 3] *= dc[3];
                    }
#pragma unroll
                    for (int s2 = 0; s2 < 2; ++s2) {
                        const bf16x8 ka = *(const bf16x8*)(bufp + HG_K2T_OFF + (32 * dt + l31) * HG_TROW + (16 * s2 + 8 * h2) * 2);
                        const bf16x8 vb = *(const bf16x8*)(bufp + HG_VT_OFF + jrow * HG_TROW + (16 * s2 + 8 * h2) * 2);
                        St = MFMA32(ka, vb, St);
                    }
                };
                __builtin_amdgcn_sched_barrier(0);
                s_update(S0, 0); s_update(S1, 1);
                __builtin_amdgcn_sched_barrier(0);
                s_update(S2, 2); s_update(S3, 3);
                __builtin_amdgcn_sched_barrier(0);
            }
            __syncthreads();
        }
    }
}

__device__ __forceinline__ void phase_hgrn_post(const Params& p, const Ctx& cx) {
    const int lane = cx.lane;
    const bf16_t* OR = (const bf16_t*)(p.ws + OFF_HA);
    const bf16_t* Gt = (const bf16_t*)(p.ws + OFF_G);
    bf16_t* OA = (bf16_t*)(p.ws + OFF_QH);
    const int col = lane * 16;
    float gn[16];
#pragma unroll
    for (int i = 0; i < 16; ++i) gn[i] = p.hgrn_out_gain[(col & 127) + i];
    for (int row = cx.vbid * NWAVE + cx.wid; row < NTOK; row += cx.G * NWAVE) {
        const uint4 a0 = *(const uint4*)(OR + (size_t)row * 1024 + col), a1 = *(const uint4*)(OR + (size_t)row * 1024 + col + 8);
        const uint4 g0 = *(const uint4*)(Gt + (size_t)row * 1024 + col), g1 = *(const uint4*)(Gt + (size_t)row * 1024 + col + 8);
        const unsigned aw[8] = {a0.x, a0.y, a0.z, a0.w, a1.x, a1.y, a1.z, a1.w};
        const unsigned gw[8] = {g0.x, g0.y, g0.z, g0.w, g1.x, g1.y, g1.z, g1.w};
        float o[16];
        float ss = 0.f;
#pragma unroll
        for (int i = 0; i < 8; ++i) { o[2 * i] = bf2f((unsigned short)(aw[i] & 0xffff)); o[2 * i + 1] = bf2f((unsigned short)(aw[i] >> 16)); ss += o[2 * i] * o[2 * i] + o[2 * i + 1] * o[2 * i + 1]; }
        ss += __shfl_xor(ss, 1); ss += __shfl_xor(ss, 2); ss += __shfl_xor(ss, 4);
        const float r = rsqrtf(ss * (1.f / 128.f) + EPS);
        unsigned w[8];
#pragma unroll
        for (int i = 0; i < 8; ++i)
            w[i] = pack2(o[2 * i] * r * gn[2 * i] * bf2f((unsigned short)(gw[i] & 0xffff)), o[2 * i + 1] * r * gn[2 * i + 1] * bf2f((unsigned short)(gw[i] >> 16)));
        uint4 o0, o1; o0.x = w[0]; o0.y = w[1]; o0.z = w[2]; o0.w = w[3]; o1.x = w[4]; o1.y = w[5]; o1.z = w[6]; o1.w = w[7];
        *(uint4*)(OA + (size_t)row * 1024 + col) = o0;
        *(uint4*)(OA + (size_t)row * 1024 + col + 8) = o1;
    }
}


#define XB_TMO      128
#define XB_XCNT(j)  (256  + 64 * (j))
#define XB_XSUB(j)  (1280 + 64 * (j))
#define XB_XGEN(j)  (2304 + 64 * (j))
#define XB_TOP      3328
#define XB_TOPGEN   3392
#define XCD_BAR_WORDS 3456
#define XB_SPIN_CAP (1u << 20)
#define LAS __attribute__((address_space(3)))
__device__ __forceinline__ unsigned xb_ld(unsigned* p)              { return __hip_atomic_load(p, __ATOMIC_RELAXED, __HIP_MEMORY_SCOPE_AGENT); }
__device__ __forceinline__ unsigned xb_add(unsigned* p, unsigned v) { return __hip_atomic_fetch_add(p, v, __ATOMIC_RELAXED, __HIP_MEMORY_SCOPE_AGENT); }
__device__ __forceinline__ unsigned xb_xcc_id() { return (unsigned)__builtin_amdgcn_s_getreg((3 << 11) | 20) & 0xFu; }
#define XB_SPIN(cond, bar) do { unsigned _sp = 0; while (cond) { __builtin_amdgcn_s_sleep(1); \
    if ((++_sp & 255u) == 0u) { if (xb_ld(&(bar)[XB_TMO])) break; if (_sp > XB_SPIN_CAP) { atomicAdd(&(bar)[XB_TMO], 1u); break; } } } } while (0)
struct XcdBarrier { unsigned* bar; unsigned x; volatile unsigned* st; };
__device__ __forceinline__ XcdBarrier xcd_barrier_post(unsigned* bar, volatile unsigned* st) {
    XcdBarrier b; b.bar = bar; b.x = xb_xcc_id(); b.st = st;
    if (threadIdx.x == 0) (void)xb_add(&bar[XB_XCNT(b.x)], 1u);
    return b;
}
__device__ __forceinline__ void xcd_barrier_complete(unsigned* bar, unsigned x, unsigned& nloc, unsigned& nx) {
    const unsigned G = gridDim.x * gridDim.y * gridDim.z;
    unsigned sum, cnt, mine, sp = 0u;
    for (;;) {
        sum = 0u; cnt = 0u; mine = 0u;
#pragma unroll
        for (unsigned j = 0; j < 16; ++j) { const unsigned c = xb_ld(&bar[XB_XCNT(j)]); sum += c; cnt += (c > 0u) ? 1u : 0u; mine = (j == x) ? c : mine; }
        if (sum == G) break;
        __builtin_amdgcn_s_sleep(1);
        if ((++sp & 255u) == 0u) { if (xb_ld(&bar[XB_TMO])) break; if (sp > XB_SPIN_CAP) { atomicAdd(&bar[XB_TMO], 1u); break; } }
    }
    nloc = mine > 0u ? mine : 1u; nx = cnt > 0u ? cnt : 1u;
}
__device__ __forceinline__ void xcd_barrier(const XcdBarrier& b) {
    asm volatile("s_waitcnt vmcnt(0)" ::: "memory");
    __syncthreads();
    if (threadIdx.x == 0) {
        unsigned* bar = b.bar;
        __builtin_amdgcn_s_waitcnt(0);
        unsigned nloc = b.st[0], nx = b.st[1];
        if (nloc == 0u) { xcd_barrier_complete(bar, b.x, nloc, nx); b.st[0] = nloc; b.st[1] = nx; }
        const unsigned old = xb_add(&bar[XB_XSUB(b.x)], 1u);
        const unsigned gen = old / nloc;
        if (old + 1u == (gen + 1u) * nloc) {
            __builtin_amdgcn_fence(__ATOMIC_RELEASE, "agent");
            asm volatile("s_waitcnt vmcnt(0)" ::: "memory");
            const unsigned og = xb_add(&bar[XB_TOP], 1u);
            const unsigned tg = og / nx;
            if (og + 1u == (tg + 1u) * nx) xb_add(&bar[XB_TOPGEN], 1u);
            else XB_SPIN(xb_ld(&bar[XB_TOPGEN]) == tg, bar);
            __builtin_amdgcn_fence(__ATOMIC_ACQUIRE, "agent");
            xb_add(&bar[XB_XGEN(b.x)], 1u);
            asm volatile("s_waitcnt vmcnt(0)" ::: "memory");
        } else {
            XB_SPIN(xb_ld(&bar[XB_XGEN(b.x)]) == gen, bar);
            __builtin_amdgcn_fence(__ATOMIC_ACQUIRE, "agent");
            asm volatile("s_waitcnt vmcnt(0)" ::: "memory");
        }
    }
    __syncthreads();
}

template <int PH>
__device__ __forceinline__ void run_phase(const Params& p, const Ctx& cx, char* lds) {
    if constexpr (PH == 0) phase0(p, cx, lds);
    else if constexpr (PH == 1) rows_phase<false, true, false>(p, cx, lds, p.x, nullptr, 0, 0, 0, 0);
    else if constexpr (PH == 2) phase_nsa_inproj(p, cx, lds);
    else if constexpr (PH == 3) phase_cmp1(p, cx, lds);
    else if constexpr (PH == 4) phase_cmp2(p, cx);
    else if constexpr (PH == 5) phase_attn(p, cx, lds);
    else if constexpr (PH == 6) phase_outproj8(p, cx, lds, (const bf16_t*)(p.ws + OFF_HA), (const bf16_t*)(p.ws + OFF_W_NSA_OUT), p.x, 0);
    else if constexpr (PH == 7) rows_router_phase(p, cx, lds, p.out, 1, 0);
    else if constexpr (PH == 8) phase_moe_up(p, cx, lds, 0);
    else if constexpr (PH == 9) phase_moe_down(p, cx, lds, 0);
    else if constexpr (PH == 10) { float* xo = p.out; asm volatile("" : "+s"(xo)); rows_phase<true, true, false>(p, cx, lds, xo, xo, 1, 2, 0, 0); }
    else if constexpr (PH == 11) phase_hgrn_inproj8(p, cx, lds);
    else if constexpr (PH == 12) phase_hgrn_rec(p, cx, lds);
    else if constexpr (PH == 13) phase_hgrn_post(p, cx);
    else if constexpr (PH == 14) phase_outproj8(p, cx, lds, (const bf16_t*)(p.ws + OFF_QH), (const bf16_t*)(p.ws + OFF_W_HG_OUT), p.out, 2);
    else if constexpr (PH == 15) rows_router_phase(p, cx, lds, p.out, 3, 1);
    else if constexpr (PH == 16) phase_moe_up(p, cx, lds, 1);
    else if constexpr (PH == 17) phase_moe_down(p, cx, lds, 1);
    else if constexpr (PH == 18) { float* xo = p.out; asm volatile("" : "+s"(xo)); rows_phase<true, false, false>(p, cx, lds, xo, xo, 3, 0, 0, 1); }
}

__device__ __forceinline__ Ctx make_ctx() {
    Ctx cx;
    cx.G = gridDim.x; cx.tid = threadIdx.x; cx.wid = threadIdx.x >> 6; cx.lane = threadIdx.x & 63;
    cx.vbid = (cx.G % 8 == 0) ? (blockIdx.x % 8) * (cx.G / 8) + blockIdx.x / 8 : blockIdx.x;
    return cx;
}

#if MULTI_LAUNCH
template <int PH>
__global__ void __launch_bounds__(NTHR, 2) phase_kernel(Params p) {
    extern __shared__ __attribute__((aligned(16))) char lds[];
    const Ctx cx = make_ctx();
    run_phase<PH>(p, cx, lds);
}
template <int PH>
static void launch_phases(const Params& p, int grid, hipStream_t stream) {
    (void)hipFuncSetAttribute((const void*)phase_kernel<PH>, hipFuncAttributeMaxDynamicSharedMemorySize, LDS_BYTES);
    hipLaunchKernelGGL(phase_kernel<PH>, dim3(grid), dim3(NTHR), LDS_BYTES, stream, p);
    if constexpr (PH + 1 < NPHASE) launch_phases<PH + 1>(p, grid, stream);
}
#else
template <int PH>
__device__ __forceinline__ void run_from(const Params& p, const Ctx& cx, char* lds, cg::grid_group& grid, const XcdBarrier& xb) {
    {
        int t_ = threadIdx.x, b_ = blockIdx.x;
        asm volatile("" : "+v"(t_), "+s"(b_));
        Ctx c2;
        c2.G = gridDim.x; c2.tid = t_; c2.wid = t_ >> 6; c2.lane = t_ & 63;
        c2.vbid = (c2.G % 8 == 0) ? (b_ % 8) * (c2.G / 8) + b_ / 8 : b_;
        run_phase<PH>(p, c2, lds);
#ifdef PROBE_MASK
        if constexpr ((PROBE_MASK >> PH) & 1) { xcd_barrier(xb); run_phase<PH>(p, c2, lds); }
#endif
    }
    if constexpr (PH + 1 < NPHASE) {
        if constexpr (PH == 0) grid.sync();
        else xcd_barrier(xb);
        run_from<PH + 1>(p, cx, lds, grid, xb);
    }
}
__global__ void __launch_bounds__(NTHR, 2) mega_kernel(Params p) {
    extern __shared__ __attribute__((aligned(16))) char lds[];
    cg::grid_group grid = cg::this_grid();
    const Ctx cx = make_ctx();
    volatile unsigned* st = (volatile unsigned*)(lds + LDS_BYTES - 16);
    if (threadIdx.x == 0) { st[0] = 0u; st[1] = 0u; }
    __syncthreads();
    const XcdBarrier xb = xcd_barrier_post((unsigned*)(p.ws + OFF_BAR), st);
    run_from<0>(p, cx, lds, grid, xb);
}
#endif

extern "C" void kernel_launch(void* const* d_in, const int* in_sizes, int n_in, void* d_out, int out_size, void* d_ws, size_t ws_size,
                              hipStream_t stream) {
    static int grid = 0;
    if (!grid) {
        int dev = 0, cus = 0, per_cu = 0;
        (void)hipGetDevice(&dev);
        (void)hipDeviceGetAttribute(&cus, hipDeviceAttributeMultiprocessorCount, dev);
#if MULTI_LAUNCH
        per_cu = 1;
#else
        (void)hipFuncSetAttribute((const void*)mega_kernel, hipFuncAttributeMaxDynamicSharedMemorySize, LDS_BYTES);
        (void)hipOccupancyMaxActiveBlocksPerMultiprocessor(&per_cu, mega_kernel, NTHR, LDS_BYTES);
        if (per_cu > 1) per_cu = 1;
        if (per_cu < 1) { fprintf(stderr, "kernel_launch: occupancy query says 0 blocks per CU (LDS %d B)\n", LDS_BYTES); per_cu = 1; }
#endif
        if (cus <= 0) cus = 256;
        grid = cus * per_cu;
        if (ws_size < WS_NEED) fprintf(stderr, "kernel_launch: workspace too small: %zu < %zu\n", ws_size, (size_t)WS_NEED);
    }
    Params p{};
    p.x = (const float*)d_in[0]; p.c = (const float*)d_in[1]; p.ada_w = (const float*)d_in[2]; p.ada_b = (const float*)d_in[3];
    p.norm_g = (const float*)d_in[4]; p.rel_bias = (const float*)d_in[5]; p.nsa_w_in = (const float*)d_in[6]; p.nsa_q_gain = (const float*)d_in[7];
    p.nsa_k_gain = (const float*)d_in[8]; p.nsa_cmp_pe = (const float*)d_in[9]; p.nsa_cmp_w1 = (const float*)d_in[10]; p.nsa_cmp_w2 = (const float*)d_in[11];
    p.nsa_w_out = (const float*)d_in[12]; p.hgrn_w_in = (const float*)d_in[13]; p.hgrn_lb = (const float*)d_in[14]; p.hgrn_out_gain = (const float*)d_in[15];
    p.hgrn_w_out = (const float*)d_in[16]; p.moe_rg = (const float*)d_in[17]; p.moe_re = (const float*)d_in[18]; p.moe_w1 = (const float*)d_in[19];
    p.moe_w3 = (const float*)d_in[20]; p.moe_w2 = (const float*)d_in[21];
    p.out = (float*)d_out; p.ws = (char*)d_ws;
#if MULTI_LAUNCH
    launch_phases<0>(p, grid, stream);
#else
    p.p_begin = 0; p.p_end = NPHASE;
    (void)hipMemsetAsync((char*)d_ws + OFF_BAR, 0, XCD_BAR_WORDS * 4, stream);
    void* args[] = {&p};
    hipError_t e = hipLaunchCooperativeKernel((void*)mega_kernel, dim3(grid), dim3(NTHR), args, LDS_BYTES, stream);
    if (e != hipSuccess) fprintf(stderr, "cooperative launch failed: %s (grid %d)\n", hipGetErrorString(e), grid);
#endif
}
```

```cpp
#include <hip/hip_runtime.h>
#include <hip/hip_cooperative_groups.h>
#include <cstdio>
#include <cstdint>
namespace cg = cooperative_groups;

#ifndef MULTI_LAUNCH
#define MULTI_LAUNCH 0
#endif

typedef unsigned short bf16_t;
typedef short bf16x8 __attribute__((ext_vector_type(8)));
typedef float f32x4 __attribute__((ext_vector_type(4)));
typedef float f32x16 __attribute__((ext_vector_type(16)));

constexpr int NTOK = 32768, DM = 1024, SEQ = 2048, NBATCH = 16;
constexpr int NSA_IN = 2608, NSA_IN_PAD = 2816;
constexpr float EPS = 1e-6f;
constexpr size_t MiB = 1ull << 20;

constexpr size_t OFF_CNT = 0;
constexpr size_t OFF_MOD = 4096;
constexpr size_t OFF_LB = OFF_MOD + 786432;
constexpr size_t OFF_PEB = OFF_LB + 4096;
constexpr size_t OFF_BAR = 921600;
constexpr size_t OFF_W_NSA_IN = 1 * MiB;
constexpr size_t OFF_W_NSA_OUT = OFF_W_NSA_IN + 2816ull * 1024 * 2;
constexpr size_t OFF_W_HG_IN = OFF_W_NSA_OUT + 1024ull * 1024 * 2;
constexpr size_t OFF_W_HG_OUT = OFF_W_HG_IN + 4096ull * 1024 * 2;
constexpr size_t OFF_W_CMP1 = OFF_W_HG_OUT + 1024ull * 1024 * 2;
constexpr size_t OFF_W_UP = OFF_W_CMP1 + 2ull * 128 * 2048 * 2;
constexpr size_t OFF_W_DN = OFF_W_UP + 32ull * 1024 * 1024 * 2;
constexpr size_t OFF_W_END = OFF_W_DN + 32ull * 1024 * 512 * 2;
constexpr size_t OFF_HA = 116 * MiB;
static_assert(OFF_W_END <= OFF_HA, "weights overflow");
constexpr size_t OFF_SCR = 180 * MiB;
constexpr size_t OFF_Q = OFF_SCR;
constexpr size_t OFF_KCRAW = OFF_Q + 64 * MiB;
constexpr size_t OFF_VCRAW = OFF_KCRAW + 17 * MiB;
constexpr size_t OFF_KS = OFF_VCRAW + 17 * MiB;
constexpr size_t OFF_VS = OFF_KS + 16 * MiB;
constexpr size_t OFF_KW = OFF_VS + 16 * MiB;
constexpr size_t OFF_VW = OFF_KW + 16 * MiB;
constexpr size_t OFF_GATES = OFF_VW + 16 * MiB;
constexpr size_t OFF_T1 = OFF_GATES + 6 * MiB;
constexpr size_t OFF_KC = OFF_T1 + 4 * MiB;
constexpr size_t OFF_VC = OFF_KC + 1 * MiB;
constexpr size_t OFF_H1 = OFF_SCR;
constexpr size_t OFF_Y = OFF_H1 + 64 * MiB;
constexpr size_t OFF_LTOK = OFF_Y + 128 * MiB;
constexpr size_t OFF_LW = OFF_LTOK + 2 * MiB;
constexpr size_t OFF_TSLOT = OFF_LW + 2 * MiB;
constexpr size_t OFF_QH = OFF_SCR;
constexpr size_t OFF_LF = OFF_QH + 64 * MiB;
constexpr size_t OFF_V = OFF_LF + 128 * MiB;
constexpr size_t OFF_G = OFF_V + 64 * MiB;
constexpr size_t WS_NEED = OFF_G + 64 * MiB;
static_assert(WS_NEED <= 512 * MiB, "ws overflow");

constexpr int NTHR = 512, NWAVE = 8;
constexpr int GEMM_STAGE = 49152, GEMM_NSTAGE = 3;
constexpr int LDS_TAB_OFF = GEMM_STAGE * GEMM_NSTAGE;
constexpr int LDS_BYTES = LDS_TAB_OFF + 256 + 16;
constexpr int NPHASE = 19;

struct Params {
    const float *x, *c, *ada_w, *ada_b, *norm_g, *rel_bias, *nsa_w_in, *nsa_q_gain, *nsa_k_gain, *nsa_cmp_pe, *nsa_cmp_w1,
        *nsa_cmp_w2, *nsa_w_out, *hgrn_w_in, *hgrn_lb, *hgrn_out_gain, *hgrn_w_out, *moe_rg, *moe_re, *moe_w1, *moe_w3, *moe_w2;
    float* out;
    char* ws;
    int p_begin, p_end;
};

__device__ __forceinline__ float bf2f(unsigned short h) { return __uint_as_float((unsigned)h << 16); }
__device__ __forceinline__ unsigned short f2bf(float f) {
    unsigned u = __float_as_uint(f);
    u += 0x7fffu + ((u >> 16) & 1u);
    return (unsigned short)(u >> 16);
}
typedef __bf16 bf2_t __attribute__((ext_vector_type(2)));
typedef float f2_t __attribute__((ext_vector_type(2)));
__device__ __forceinline__ unsigned pack2(float a, float b) {
    f2_t v = {a, b};
    return __builtin_bit_cast(unsigned, __builtin_convertvector(v, bf2_t));
}
typedef _Float16 h2_t __attribute__((ext_vector_type(2)));
__device__ __forceinline__ unsigned packh2(float a, float b) { f2_t v = {a, b}; return __builtin_bit_cast(unsigned, __builtin_convertvector(v, h2_t)); }
__device__ __forceinline__ f2_t unpackh2(unsigned u) { return __builtin_convertvector(__builtin_bit_cast(h2_t, u), f2_t); }
__device__ __forceinline__ float wave_sum(float v) {
#pragma unroll
    for (int o = 32; o; o >>= 1) v += __shfl_xor(v, o);
    return v;
}
__device__ __forceinline__ float wave_max(float v) {
#pragma unroll
    for (int o = 32; o; o >>= 1) v = fmaxf(v, __shfl_xor(v, o));
    return v;
}
__device__ __forceinline__ float silu_f(float x) { return x * __builtin_amdgcn_rcpf(1.f + __builtin_amdgcn_exp2f(-1.4426950408889634f * x)); }
__device__ __forceinline__ float sigmoid_f(float x) { return __builtin_amdgcn_rcpf(1.f + __builtin_amdgcn_exp2f(-1.4426950408889634f * x)); }
__device__ __forceinline__ void glds16(const void* g, void* l) {
    __builtin_amdgcn_global_load_lds((const unsigned*)g, (unsigned*)l, 16, 0, 0);
}
__device__ __forceinline__ int t5_bucket(int n) {
    if (n < 16) return n;
    int b = 16;
    b += (n >= 21); b += (n >= 27); b += (n >= 35); b += (n >= 46); b += (n >= 59); b += (n >= 77); b += (n >= 99); b += (n >= 128);
    b += (n >= 166); b += (n >= 216); b += (n >= 280); b += (n >= 363); b += (n >= 470); b += (n >= 609); b += (n >= 790);
    return b;
}

struct Ctx {
    int G, vbid, tid, wid, lane;
};

constexpr int P0_MOD_ITEMS = 192;
constexpr int TS0 = 88 * 16, TS1 = 32 * 16, TS2 = 128 * 16, TS3 = 32 * 16, TS4 = 2 * 4 * 32, TS5 = 32 * 32 * 16, TS6 = 32 * 32 * 8;
constexpr int TC0 = 0, TC1 = TC0 + TS0, TC2 = TC1 + TS1, TC3 = TC2 + TS2, TC4 = TC3 + TS3, TC5 = TC4 + TS4, TC6 = TC5 + TS5, TC_END = TC6 + TS6;

struct TrJob { const float* src; int ld, c0, ncols_valid, k0; bf16_t* dst; int dstld; int perm; };
__device__ __forceinline__ int pcol(int n, int fq) { return (n >> 1) * 32 + fq * 8 + (n & 1) * 4; }
__device__ __forceinline__ void tr_load(const TrJob& j, float* tl, int htid) {
    const int k = htid >> 2, cc = (htid & 3) * 8;
    const float* s = j.src + (size_t)(j.k0 + k) * j.ld + j.c0 + cc;
    f32x4 a = {0.f, 0.f, 0.f, 0.f}, c = a;
    if (j.c0 + 32 <= j.ncols_valid) { a = *(const f32x4*)s; c = *(const f32x4*)(s + 4); }
    else {
#pragma unroll
        for (int i = 0; i < 4; ++i) { if (j.c0 + cc + i < j.ncols_valid) a[i] = s[i]; if (j.c0 + cc + 4 + i < j.ncols_valid) c[i] = s[4 + i]; }
    }
#pragma unroll
    for (int i = 0; i < 4; ++i) { tl[k * 33 + cc + i] = a[i]; tl[k * 33 + cc + 4 + i] = c[i]; }
}
__device__ __forceinline__ void tr_store(const TrJob& j, const float* tl, int htid) {
    const int nsrc = htid >> 3, kc = (htid & 7) * 8;
    const int n = nsrc;
    const int nd = j.perm ? (((nsrc >> 2) & 1) * 16 + (nsrc >> 3) * 4 + (nsrc & 3)) : nsrc;
    uint4 o;
    o.x = pack2(tl[(kc + 0) * 33 + n], tl[(kc + 1) * 33 + n]); o.y = pack2(tl[(kc + 2) * 33 + n], tl[(kc + 3) * 33 + n]);
    o.z = pack2(tl[(kc + 4) * 33 + n], tl[(kc + 5) * 33 + n]); o.w = pack2(tl[(kc + 6) * 33 + n], tl[(kc + 7) * 33 + n]);
    *(uint4*)(j.dst + (size_t)nd * j.dstld + kc) = o;
}
__device__ __forceinline__ TrJob tr_job(const Params& p, int tt) {
    TrJob j;
    if (tt < TC1) {
        const int nt = tt / 16, kt = tt % 16;
        j = {p.nsa_w_in, NSA_IN, nt * 32, NSA_IN, kt * 64, (bf16_t*)(p.ws + OFF_W_NSA_IN) + (size_t)nt * 32 * 1024 + kt * 64, 1024, 1};
    } else if (tt < TC2) {
        const int u = tt - TC1, nt = u / 16, kt = u % 16;
        j = {p.nsa_w_out, 1024, nt * 32, 1024, kt * 64, (bf16_t*)(p.ws + OFF_W_NSA_OUT) + (size_t)nt * 32 * 1024 + kt * 64, 1024, 1};
    } else if (tt < TC3) {
        const int u = tt - TC2, nt = u / 16, kt = u % 16;
        j = {p.hgrn_w_in, 4096, nt * 32, 4096, kt * 64, (bf16_t*)(p.ws + OFF_W_HG_IN) + (size_t)nt * 32 * 1024 + kt * 64, 1024, 1};
    } else if (tt < TC4) {
        const int u = tt - TC3, nt = u / 16, kt = u % 16;
        j = {p.hgrn_w_out, 1024, nt * 32, 1024, kt * 64, (bf16_t*)(p.ws + OFF_W_HG_OUT) + (size_t)nt * 32 * 1024 + kt * 64, 1024, 1};
    } else if (tt < TC5) {
        const int u = tt - TC4, kv = u / 128, r = u % 128, nt = r / 32, kt = r % 32;
        j = {p.nsa_cmp_w1 + (size_t)kv * 2048 * 64, 64, nt * 32, 64, kt * 64, (bf16_t*)(p.ws + OFF_W_CMP1) + ((size_t)kv * 128 + nt * 32) * 2048 + kt * 64, 2048, 0};
    } else if (tt < TC6) {
        const int u = tt - TC5, le = u / 512, r = u % 512, gr = r / 16, kt = r % 16;
        const int t = gr >> 2, wc = (gr >> 1) & 1, which = gr & 1;
        const float* src = (which ? p.moe_w3 : p.moe_w1) + (size_t)le * 1024 * 512;
        j = {src, 512, (t * 2 + wc) * 32, 512, kt * 64, (bf16_t*)(p.ws + OFF_W_UP) + ((size_t)le * 1024 + gr * 32) * 1024 + kt * 64, 1024, 1};
    } else {
        const int u = tt - TC6, le = u / 256, r = u % 256, nt = r / 8, kt = r % 8;
        j = {p.moe_w2 + (size_t)le * 512 * 1024, 1024, nt * 32, 1024, kt * 64, (bf16_t*)(p.ws + OFF_W_DN) + ((size_t)le * 1024 + nt * 32) * 512 + kt * 64, 512, 1};
    }
    return j;
}

__device__ __forceinline__ void transpose_range(const Params& p, char* lds, int tid, int worker, int nworkers, int lo, int hi) {
    if (worker < 0) return;
    constexpr int TPH = 4;
    const int half = tid >> 8, htid = tid & 255;
    float* tl = (float*)lds + half * (TPH * 64 * 33);
    for (int base = lo + worker * 2 * TPH; base < hi; base += nworkers * 2 * TPH) {
#pragma unroll
        for (int q = 0; q < TPH; ++q) {
            const int tt = base + half * TPH + q;
            if (tt < hi) { const TrJob j = tr_job(p, tt); tr_load(j, tl + q * (64 * 33), htid); }
        }
        __syncthreads();
#pragma unroll
        for (int q = 0; q < TPH; ++q) {
            const int tt = base + half * TPH + q;
            if (tt < hi) { const TrJob j = tr_job(p, tt); tr_store(j, tl + q * (64 * 33), htid); }
        }
        __syncthreads();
    }
}
constexpr int TC_UP1 = TC5 + 16 * 512, TC_DN1 = TC6 + 16 * 256;

__device__ __forceinline__ void phase0(const Params& p, const Ctx& cx, char* lds) {
    const int tid = cx.tid, wid = cx.wid, lane = cx.lane;
    for (int it = cx.vbid; it < P0_MOD_ITEMS; it += cx.G) {
        const int colbase = it * 64, ls = colbase / 3072, e0 = colbase % 3072;
        const float* W = p.ada_w + (size_t)ls * 1024 * 3072 + e0 + lane;
        float* cs = (float*)lds + wid * 1024;
        float* red = (float*)lds + 8192;
        float acc[16];
#pragma unroll
        for (int b = 0; b < 16; ++b) acc[b] = 0.f;
        for (int sub = 0; sub < 2; ++sub) {
            const int kb = wid * 128 + sub * 64;
#pragma unroll
            for (int b = 0; b < 16; ++b) cs[lane * 16 + b] = silu_f(p.c[b * 1024 + kb + lane]);
            __builtin_amdgcn_wave_barrier();
#pragma unroll 1
            for (int k16 = 0; k16 < 64; k16 += 16) {
                float wv[16];
#pragma unroll
                for (int u = 0; u < 16; ++u) wv[u] = W[(size_t)(kb + k16 + u) * 3072];
#pragma unroll
                for (int u = 0; u < 16; ++u) {
                    const float w = wv[u];
                    const f32x4* cv = (const f32x4*)(cs + (k16 + u) * 16);
#pragma unroll
                    for (int q = 0; q < 4; ++q) {
                        f32x4 c4 = cv[q];
                        acc[q * 4 + 0] += c4[0] * w; acc[q * 4 + 1] += c4[1] * w; acc[q * 4 + 2] += c4[2] * w; acc[q * 4 + 3] += c4[3] * w;
                    }
                }
            }
            __builtin_amdgcn_wave_barrier();
        }
#pragma unroll
        for (int b = 0; b < 16; ++b) red[(wid * 16 + b) * 64 + lane] = acc[b];
        __syncthreads();
        float* mod = (float*)(p.ws + OFF_MOD);
#pragma unroll
        for (int i = 0; i < 2; ++i) {
            const int o = tid + i * NTHR, b = o >> 6, e = o & 63;
            float sm = 0.f;
#pragma unroll
            for (int w = 0; w < 8; ++w) sm += red[(w * 16 + b) * 64 + e];
            mod[((size_t)ls * 16 + b) * 3072 + e0 + e] = sm + p.ada_b[ls * 3072 + e0 + e];
        }
        __syncthreads();
    }
    transpose_range(p, lds, tid, cx.vbid, cx.G, TC0, TC2);
    transpose_range(p, lds, tid, cx.vbid, cx.G, TC4, TC5);
    if (cx.vbid == cx.G - 1) {
        float* lb = (float*)(p.ws + OFF_LB);
        for (int i = tid; i < 1024; i += NTHR) lb[i] = sigmoid_f(p.hgrn_lb[1024 + i] - p.hgrn_lb[i]);
        if (tid < 128) {
            const int kv = tid >> 6, d = tid & 63;
            const float* pe = p.nsa_cmp_pe + kv * 2048;
            const float* w1 = p.nsa_cmp_w1 + (size_t)kv * 2048 * 64 + d;
            float sm = 0.f;
            for (int k = 0; k < 2048; ++k) sm += pe[k] * w1[(size_t)k * 64];
            ((float*)(p.ws + OFF_PEB))[tid] = sm;
        }
        if (tid < 32) ((int*)(p.ws + OFF_CNT))[tid] = 0;
    }
}

template <bool COMBINE, bool NORM, bool ROUTER>
__device__ __forceinline__ void rows_phase(const Params& p, const Ctx& cx, char* lds, const float* __restrict__ src, float* __restrict__ xdst,
                           int ls_comb, int ls_norm, int layer_router, int layer_comb) {
    static_assert(!ROUTER, "router rows use rows_router_phase");
    const int lane = cx.lane;
    const float* mod = (const float*)(p.ws + OFF_MOD);
    int my_off = 0;
    if (COMBINE) {
        const int* cnt = (const int*)(p.ws + OFF_CNT) + layer_comb * 16;
        int cv[15];
#pragma unroll
        for (int e = 0; e < 15; ++e) cv[e] = cnt[e];
#pragma unroll
        for (int e = 0; e < 15; ++e) my_off += (e < lane) ? cv[e] : 0;
    }
    const int rpw = (NTOK + cx.G * NWAVE - 1) / (cx.G * NWAVE);
    const int row_begin = (cx.vbid * NWAVE + cx.wid) * rpw, row_end = min(NTOK, row_begin + rpw);
    if (row_begin >= row_end) return;
    const bf16_t* Y = (const bf16_t*)(p.ws + OFF_Y);
    const int* tsl = (const int*)(p.ws + OFF_TSLOT);
    bf16_t* hA = (bf16_t*)(p.ws + OFF_HA);
    const float* gain = p.norm_g + ls_norm * 1024;
    auto yrow = [&](int sw) -> size_t { return (size_t)(__shfl(my_off, sw >> 16) + (sw & 0xffff)) * 1024; };
    f32x4 vn[4];
    uint2 yan[4], ycn[4];
    int t0n = 0, t1n = 0;
#pragma unroll
    for (int i = 0; i < 4; ++i) vn[i] = *(const f32x4*)(src + (size_t)row_begin * 1024 + (i * 64 + lane) * 4);
    if (COMBINE) {
        const size_t ra = yrow(tsl[row_begin * 2]), rc = yrow(tsl[row_begin * 2 + 1]);
#pragma unroll
        for (int i = 0; i < 4; ++i) { yan[i] = *(const uint2*)(Y + ra + (i * 64 + lane) * 4); ycn[i] = *(const uint2*)(Y + rc + (i * 64 + lane) * 4); }
        if (row_begin + 1 < row_end) { t0n = tsl[(row_begin + 1) * 2]; t1n = tsl[(row_begin + 1) * 2 + 1]; }
    }
    f32x4 gt[4], ca[4], cb[4];
    int bcur = -1;
    for (int row = row_begin; row < row_end; ++row) {
        const int b = row >> 11;
        if (b != bcur) {
            bcur = b;
#pragma unroll
            for (int i = 0; i < 4; ++i) {
                const int col = (i * 64 + lane) * 4;
                if (COMBINE) gt[i] = *(const f32x4*)(mod + ((size_t)ls_comb * 16 + b) * 3072 + 2048 + col);
                if (NORM) {
                    const float* shift = mod + ((size_t)ls_norm * 16 + b) * 3072;
                    const f32x4 g = *(const f32x4*)(gain + col), sc = *(const f32x4*)(shift + 1024 + col);
                    ca[i] = g * (sc + 1.f);
                    cb[i] = *(const f32x4*)(shift + col);
                }
            }
        }
        f32x4 v[4];
        uint2 ya[4], yc[4];
#pragma unroll
        for (int i = 0; i < 4; ++i) { v[i] = vn[i]; if (COMBINE) { ya[i] = yan[i]; yc[i] = ycn[i]; } }
        if (row + 1 < row_end) {
#pragma unroll
            for (int i = 0; i < 4; ++i) vn[i] = *(const f32x4*)(src + (size_t)(row + 1) * 1024 + (i * 64 + lane) * 4);
            if (COMBINE) {
                const size_t ra = yrow(t0n), rc = yrow(t1n);
#pragma unroll
                for (int i = 0; i < 4; ++i) { yan[i] = *(const uint2*)(Y + ra + (i * 64 + lane) * 4); ycn[i] = *(const uint2*)(Y + rc + (i * 64 + lane) * 4); }
                if (row + 2 < row_end) { t0n = tsl[(row + 2) * 2]; t1n = tsl[(row + 2) * 2 + 1]; }
            }
        }
        if (COMBINE) {
#pragma unroll
            for (int i = 0; i < 4; ++i) {
                const int col = (i * 64 + lane) * 4;
                v[i][0] += gt[i][0] * (bf2f(ya[i].x & 0xffff) + bf2f(yc[i].x & 0xffff));
                v[i][1] += gt[i][1] * (bf2f(ya[i].x >> 16) + bf2f(yc[i].x >> 16));
                v[i][2] += gt[i][2] * (bf2f(ya[i].y & 0xffff) + bf2f(yc[i].y & 0xffff));
                v[i][3] += gt[i][3] * (bf2f(ya[i].y >> 16) + bf2f(yc[i].y >> 16));
                *(f32x4*)(xdst + (size_t)row * 1024 + col) = v[i];
            }
        }
        if (NORM) {
            float ss = 0.f;
#pragma unroll
            for (int i = 0; i < 4; ++i) ss += v[i][0] * v[i][0] + v[i][1] * v[i][1] + v[i][2] * v[i][2] + v[i][3] * v[i][3];
            ss = wave_sum(ss);
            const float r = rsqrtf(ss * (1.f / 1024.f) + EPS);
#pragma unroll
            for (int i = 0; i < 4; ++i) {
                const int col = (i * 64 + lane) * 4;
                f32x4 h;
#pragma unroll
                for (int j = 0; j < 4; ++j) h[j] = v[i][j] * r * ca[i][j] + cb[i][j];
                uint2 o; o.x = pack2(h[0], h[1]); o.y = pack2(h[2], h[3]);
                *(uint2*)(hA + (size_t)row * 1024 + col) = o;
            }
        }
    }
}

__device__ __forceinline__ void rows_router_phase(const Params& p, const Ctx& cx, char* lds, const float* __restrict__ src, int ls_norm, int layer) {
    const int lane = cx.lane, tid = cx.tid;
    const int widu = __builtin_amdgcn_readfirstlane(cx.wid);
    const int wq = widu & 3, grp4 = widu >> 2;
    const float* mod = (const float*)(p.ws + OFF_MOD);
    const float* rg = p.moe_rg + (size_t)layer * 1024 * 4;
    const float* re = p.moe_re + (size_t)layer * 1024 * 16;
    float* logit_s = (float*)lds;
    float wr[16][5];
#pragma unroll
    for (int i = 0; i < 4; ++i)
#pragma unroll
        for (int j = 0; j < 4; ++j) {
            const int k = (i * 64 + lane) * 4 + j;
#pragma unroll
            for (int q = 0; q < 5; ++q) {
                const int o = 5 * wq + q;
                wr[i * 4 + j][q] = (o < 4) ? rg[k * 4 + o] : re[k * 16 + o - 4];
            }
            __builtin_amdgcn_sched_barrier(0);
        }
    const float* gain = p.norm_g + ls_norm * 1024;
    bf16_t* hA = (bf16_t*)(p.ws + OFF_HA);
    int* lcnt = (int*)(lds + 16384);
    if (tid < 32) lcnt[tid] = 0;
    int nstep = 0;
    for (int blk = cx.vbid; blk < NTOK / 32; blk += cx.G, ++nstep) {
        const int R0 = blk * 32, b = R0 >> 11;
        const float* shift = mod + ((size_t)ls_norm * 16 + b) * 3072;
        const float* scale = shift + 1024;
        f32x4 ca[4], cb[4];
#pragma unroll
        for (int i = 0; i < 4; ++i) {
            const int col = (i * 64 + lane) * 4;
            const f32x4 g = *(const f32x4*)(gain + col), sc = *(const f32x4*)(scale + col);
            ca[i] = g * (sc + 1.f);
            cb[i] = *(const f32x4*)(shift + col);
        }
        const float* srow = src + (size_t)(R0 + grp4 * 16) * 1024 + lane * 4;
        f32x4 vnA[4], vnB[4];
#pragma unroll
        for (int i = 0; i < 4; ++i) { vnA[i] = *(const f32x4*)(srow + i * 256); vnB[i] = *(const f32x4*)(srow + 1024 + i * 256); }
#pragma unroll 1
        for (int r = 0; r < 16; r += 2) {
            const int rlA = grp4 * 16 + r;
            f32x4 vA[4], vB[4];
#pragma unroll
            for (int i = 0; i < 4; ++i) { vA[i] = vnA[i]; vB[i] = vnB[i]; }
            if (r < 14) {
#pragma unroll
                for (int i = 0; i < 4; ++i) { vnA[i] = *(const f32x4*)(srow + (size_t)(r + 2) * 1024 + i * 256); vnB[i] = *(const f32x4*)(srow + (size_t)(r + 3) * 1024 + i * 256); }
            }
            float ssA = 0.f, ssB = 0.f;
#pragma unroll
            for (int i = 0; i < 4; ++i) {
                ssA += vA[i][0] * vA[i][0] + vA[i][1] * vA[i][1] + vA[i][2] * vA[i][2] + vA[i][3] * vA[i][3];
                ssB += vB[i][0] * vB[i][0] + vB[i][1] * vB[i][1] + vB[i][2] * vB[i][2] + vB[i][3] * vB[i][3];
            }
#pragma unroll
            for (int o = 32; o; o >>= 1) { ssA += __shfl_xor(ssA, o); ssB += __shfl_xor(ssB, o); }
            const float rrA = rsqrtf(ssA * (1.f / 1024.f) + EPS), rrB = rsqrtf(ssB * (1.f / 1024.f) + EPS);
            float accA[5] = {0.f, 0.f, 0.f, 0.f, 0.f}, accB[5] = {0.f, 0.f, 0.f, 0.f, 0.f};
#pragma unroll
            for (int i = 0; i < 4; ++i) {
                const int col = (i * 64 + lane) * 4;
                f32x4 hA_, hB_;
#pragma unroll
                for (int j = 0; j < 4; ++j) {
                    hA_[j] = vA[i][j] * rrA * ca[i][j] + cb[i][j];
                    hB_[j] = vB[i][j] * rrB * ca[i][j] + cb[i][j];
#pragma unroll
                    for (int q = 0; q < 5; ++q) { accA[q] += hA_[j] * wr[i * 4 + j][q]; accB[q] += hB_[j] * wr[i * 4 + j][q]; }
                }
                if ((r & 3) == wq) { uint2 o; o.x = pack2(hA_[0], hA_[1]); o.y = pack2(hA_[2], hA_[3]); *(uint2*)(hA + (size_t)(R0 + rlA) * 1024 + col) = o; }
                if (((r + 1) & 3) == wq) { uint2 o; o.x = pack2(hB_[0], hB_[1]); o.y = pack2(hB_[2], hB_[3]); *(uint2*)(hA + (size_t)(R0 + rlA + 1) * 1024 + col) = o; }
            }
#pragma unroll
            for (int o = 32; o; o >>= 1) {
#pragma unroll
                for (int q = 0; q < 5; ++q) { accA[q] += __shfl_xor(accA[q], o); accB[q] += __shfl_xor(accB[q], o); }
            }
            if (lane == 0) {
#pragma unroll
                for (int q = 0; q < 5; ++q) { logit_s[(nstep * 32 + rlA) * 20 + 5 * wq + q] = accA[q]; logit_s[(nstep * 32 + rlA + 1) * 20 + 5 * wq + q] = accB[q]; }
            }
        }
    }
    __syncthreads();
    const int nrows = nstep * 32;
    int ea = 0, eb = 0, la = 0, lb_ = 0, row = 0; float wa = 0.f, wb = 0.f;
    if (tid < nrows) {
        row = (cx.vbid + (tid >> 5) * cx.G) * 32 + (tid & 31);
        const float* rl = logit_s + tid * 20;
        const float gm = fmaxf(fmaxf(rl[0], rl[1]), fmaxf(rl[2], rl[3]));
        const float gs = __expf(rl[0] - gm) + __expf(rl[1] - gm) + __expf(rl[2] - gm) + __expf(rl[3] - gm);
        int grp = 0; float best = rl[0];
        if (rl[1] > best) { best = rl[1]; grp = 1; }
        if (rl[2] > best) { best = rl[2]; grp = 2; }
        if (rl[3] > best) { best = rl[3]; grp = 3; }
        const float pg = __expf(best - gm) / gs;
        const f32x4 lsel = *(const f32x4*)(rl + 4 + 4 * grp);
        const float l0 = lsel[0], l1 = lsel[1], l2 = lsel[2], l3 = lsel[3];
        const float em = fmaxf(fmaxf(l0, l1), fmaxf(l2, l3));
        const float q0 = __expf(l0 - em), q1 = __expf(l1 - em), q2 = __expf(l2 - em), q3 = __expf(l3 - em);
        int i1 = 0; float b1 = q0;
        if (q1 > b1) { b1 = q1; i1 = 1; }
        if (q2 > b1) { b1 = q2; i1 = 2; }
        if (q3 > b1) { b1 = q3; i1 = 3; }
        int i2 = -1; float b2 = -1.f;
        if (i1 != 0 && q0 > b2) { b2 = q0; i2 = 0; }
        if (i1 != 1 && q1 > b2) { b2 = q1; i2 = 1; }
        if (i1 != 2 && q2 > b2) { b2 = q2; i2 = 2; }
        if (i1 != 3 && q3 > b2) { b2 = q3; i2 = 3; }
        const float inv = pg / (b1 + b2);
        ea = grp * 4 + i1; eb = grp * 4 + i2; wa = b1 * inv; wb = b2 * inv;
        la = atomicAdd(lcnt + ea, 1);
        lb_ = atomicAdd(lcnt + eb, 1);
    }
    __syncthreads();
    if (tid < 16) lcnt[16 + tid] = atomicAdd((int*)(p.ws + OFF_CNT) + layer * 16 + tid, lcnt[tid]);
    __syncthreads();
    if (tid < nrows) {
        int* ltok = (int*)(p.ws + OFF_LTOK);
        float* lw = (float*)(p.ws + OFF_LW);
        int* ts = (int*)(p.ws + OFF_TSLOT) + row * 2;
        const int pa = lcnt[16 + ea] + la, pb = lcnt[16 + eb] + lb_;
        ltok[(size_t)ea * NTOK + pa] = row; lw[(size_t)ea * NTOK + pa] = wa;
        ltok[(size_t)eb * NTOK + pb] = row; lw[(size_t)eb * NTOK + pb] = wb;
        ts[0] = (ea << 16) | pa; ts[1] = (eb << 16) | pb;
    }
    __syncthreads();
}

__device__ __forceinline__ int stage_col(int tid) { return ((tid & 7) ^ ((tid >> 3) & 7)) * 8; }

template <class Epi>
__device__ __forceinline__ void gemm_tile(const bf16_t* const (&ap)[4], const bf16_t* const (&bp)[2], int K, char* lds, const Ctx& cx, Epi&& epi) {
    const int tid = cx.tid, lane = cx.lane, wr = cx.wid >> 1, wc = cx.wid & 1, fr = lane & 15, fq = lane >> 4;
    f32x4 acc[4][4];
#pragma unroll
    for (int m = 0; m < 4; ++m)
#pragma unroll
        for (int n = 0; n < 4; ++n) acc[m][n] = (f32x4){0.f, 0.f, 0.f, 0.f};
    const int nt = K / 64;
    auto stage = [&](int t, int slot) {
        char* SA = lds + slot * GEMM_STAGE + tid * 16; char* SB = SA + 32768;
        const int ko = t * 64;
#pragma unroll
        for (int i = 0; i < 4; ++i) glds16(ap[i] + ko, SA + i * 8192);
#pragma unroll
        for (int i = 0; i < 2; ++i) glds16(bp[i] + ko, SB + i * 8192);
    };
    __syncthreads();
    stage(0, 0);
    if (nt > 1) stage(1, 1);
    const int x7 = fr & 7;
    const int aoff = (wr * 64 + fr) * 128, boff = 32768 + (wc * 64 + fr) * 128;
    int slot = 0;
    for (int kt = 0; kt < nt; ++kt) {
        if (kt + 1 < nt) asm volatile("s_waitcnt vmcnt(6)" ::: "memory");
        else asm volatile("s_waitcnt vmcnt(0)" ::: "memory");
        __builtin_amdgcn_s_barrier();
        if (kt + 2 < nt) stage(kt + 2, slot >= 1 ? slot - 1 : 2);
        const char* S = lds + slot * GEMM_STAGE;
#pragma unroll
        for (int ks = 0; ks < 2; ++ks) {
            const int pc = ((ks * 4 + fq) ^ x7) * 16;
            bf16x8 Af[4], Bf[4];
#pragma unroll
            for (int m = 0; m < 4; ++m) Af[m] = *(const bf16x8*)(S + aoff + m * 2048 + pc);
#pragma unroll
            for (int n = 0; n < 4; ++n) Bf[n] = *(const bf16x8*)(S + boff + n * 2048 + pc);
#pragma unroll
            for (int m = 0; m < 4; ++m)
#pragma unroll
                for (int n = 0; n < 4; ++n) acc[m][n] = __builtin_amdgcn_mfma_f32_16x16x32_bf16(Bf[n], Af[m], acc[m][n], 0, 0, 0);
        }
        slot = slot == 2 ? 0 : slot + 1;
    }
    epi(acc, wr, wc, fr, fq);
}

__device__ __forceinline__ int swz_g(int q) { return (0x1320 >> (4 * q)) & 3; }
__device__ __forceinline__ int stage_col2(int tid) { return ((tid & 3) ^ swz_g((tid >> 4) & 3)) * 8; }

template <int MODE = 0, class Epi>
__device__ __forceinline__ void gemm_tile2(const bf16_t* const (&ap)[2], const bf16_t* const (&bp)[2], int K, char* lds, const Ctx& cx, Epi&& epi) {
    const int tid = cx.tid, lane = cx.lane, wc = cx.wid & 3, fr = lane & 15, fq = lane >> 4;
    const int wr = __builtin_amdgcn_readfirstlane(cx.wid >> 2);
    f32x4 acc[8][4];
#pragma unroll
    for (int m = 0; m < 8; ++m)
#pragma unroll
        for (int n = 0; n < 4; ++n) acc[m][n] = (f32x4){0.f, 0.f, 0.f, 0.f};
    const int nt = K / 32;
    auto stage = [&](int t) {
        char* SA = lds + (t & 3) * 32768 + tid * 16; char* SB = SA + 16384;
        const int ko = t * 32;
        glds16(ap[0] + ko, SA); glds16(ap[1] + ko, SA + 8192);
        glds16(bp[0] + ko, SB); glds16(bp[1] + ko, SB + 8192);
    };
    __syncthreads();
    stage(0);
    if (nt > 1) stage(1);
    if (nt > 2) stage(2);
    const int pc = (fq ^ swz_g((fr >> 2) & 3)) * 16;
    const int aoff = (wr * 128 + fr) * 64 + pc, boff = 16384 + (wc * 64 + fr) * 64 + pc;
    bf16x8 Af[8], Bf[4];
    auto load_frags = [&](int kt) {
        const char* S = lds + (kt & 3) * 32768;
#pragma unroll
        for (int n = 0; n < 4; ++n) Bf[n] = *(const bf16x8*)(S + boff + n * 1024);
#pragma unroll
        for (int m = 0; m < 8; ++m) Af[m] = *(const bf16x8*)(S + aoff + m * 1024);
        asm volatile("s_waitcnt lgkmcnt(0)" ::: "memory");
    };
    auto mma = [&]() {
        __builtin_amdgcn_s_setprio(1);
#pragma unroll
        for (int m = 0; m < 8; ++m)
#pragma unroll
            for (int n = 0; n < 4; ++n) acc[m][n] = __builtin_amdgcn_mfma_f32_16x16x32_bf16(Bf[n], Af[m], acc[m][n], 0, 0, 0);
        __builtin_amdgcn_s_setprio(0);
    };
    if (nt > 2) asm volatile("s_waitcnt vmcnt(8)" ::: "memory");
    else if (nt == 2) asm volatile("s_waitcnt vmcnt(4)" ::: "memory");
    else asm volatile("s_waitcnt vmcnt(0)" ::: "memory");
    if (wr == 1) __builtin_amdgcn_s_barrier();
    for (int kt = 0; kt < nt; ++kt) {
        const int rem = nt - 1 - kt;
        if (rem >= 2) asm volatile("s_waitcnt vmcnt(8)" ::: "memory");
        else if (rem == 1) asm volatile("s_waitcnt vmcnt(4)" ::: "memory");
        else asm volatile("s_waitcnt vmcnt(0)" ::: "memory");
        __builtin_amdgcn_s_barrier();
        if (kt + 3 < nt) stage(kt + 3);
        load_frags(kt);
        if (rem >= 3) asm volatile("s_waitcnt vmcnt(8)" ::: "memory");
        else if (rem == 2) asm volatile("s_waitcnt vmcnt(4)" ::: "memory");
        else asm volatile("s_waitcnt vmcnt(0)" ::: "memory");
        __builtin_amdgcn_s_barrier();
        mma();
    }
    if (wr == 0) __builtin_amdgcn_s_barrier();
    if (MODE == 0) epi(acc, wr, wc, fr, fq);
    else {
#pragma unroll
        for (int m = 0; m < 8; ++m)
#pragma unroll
            for (int n = 0; n < 4; ++n) asm volatile("" :: "v"(acc[m][n]));
    }
}

template <class GetFn, class EpiFn>
__device__ __forceinline__ void gemm_stream2(int my_tiles, int K, char* lds, const Ctx& cx, GetFn&& get, EpiFn&& epi) {
    if (my_tiles <= 0) return;
    const int tid = cx.tid, lane = cx.lane, wc = cx.wid & 3, fr = lane & 15, fq = lane >> 4;
    const int wr = __builtin_amdgcn_readfirstlane(cx.wid >> 2);
    f32x4 acc[8][4];
#pragma unroll
    for (int m = 0; m < 8; ++m)
#pragma unroll
        for (int n = 0; n < 4; ++n) acc[m][n] = (f32x4){0.f, 0.f, 0.f, 0.f};
    const int nt = K / 32, S = my_tiles * nt;
    const bf16_t* sap[2]; const bf16_t* sbp[2];
    int sj = 0, skt = 0, sg = 0;
    get(0, sap, sbp);
    auto stage_next = [&]() {
        char* SA = lds + (sg & 3) * 32768 + tid * 16; char* SB = SA + 16384;
        const int ko = skt * 32;
        glds16(sap[0] + ko, SA); glds16(sap[1] + ko, SA + 8192);
        glds16(sbp[0] + ko, SB); glds16(sbp[1] + ko, SB + 8192);
        ++sg; ++skt;
        if (skt == nt) { skt = 0; ++sj; if (sj < my_tiles) get(sj, sap, sbp); }
    };
    __syncthreads();
    stage_next();
    if (S > 1) stage_next();
    if (S > 2) stage_next();
    const int pc = (fq ^ swz_g((fr >> 2) & 3)) * 16;
    const int aoff = (wr * 128 + fr) * 64 + pc, boff = 16384 + (wc * 64 + fr) * 64 + pc;
    bf16x8 Af[8], Bf[4];
    int g = 0;
    for (int cj = 0; cj < my_tiles; ++cj) {
        {
            const int rem0 = S - 1 - g;
            if (rem0 >= 2) asm volatile("s_waitcnt vmcnt(8)" ::: "memory");
            else if (rem0 == 1) asm volatile("s_waitcnt vmcnt(4)" ::: "memory");
            else asm volatile("s_waitcnt vmcnt(0)" ::: "memory");
        }
        if (wr == 1) __builtin_amdgcn_s_barrier();
        for (int kt = 0; kt < nt; ++kt, ++g) {
            const int rem = S - 1 - g;
            if (rem >= 2) asm volatile("s_waitcnt vmcnt(8)" ::: "memory");
            else if (rem == 1) asm volatile("s_waitcnt vmcnt(4)" ::: "memory");
            else asm volatile("s_waitcnt vmcnt(0)" ::: "memory");
            __builtin_amdgcn_s_barrier();
            if (g + 3 < S) stage_next();
            {
                const char* Sx = lds + (g & 3) * 32768;
#pragma unroll
                for (int n = 0; n < 4; ++n) Bf[n] = *(const bf16x8*)(Sx + boff + n * 1024);
#pragma unroll
                for (int m = 0; m < 8; ++m) Af[m] = *(const bf16x8*)(Sx + aoff + m * 1024);
                asm volatile("s_waitcnt lgkmcnt(0)" ::: "memory");
            }
            if (rem >= 3) asm volatile("s_waitcnt vmcnt(8)" ::: "memory");
            else if (rem == 2) asm volatile("s_waitcnt vmcnt(4)" ::: "memory");
            else asm volatile("s_waitcnt vmcnt(0)" ::: "memory");
            __builtin_amdgcn_s_barrier();
            __builtin_amdgcn_s_setprio(1);
#pragma unroll
            for (int m = 0; m < 8; ++m)
#pragma unroll
                for (int n = 0; n < 4; ++n) acc[m][n] = __builtin_amdgcn_mfma_f32_16x16x32_bf16(Bf[n], Af[m], acc[m][n], 0, 0, 0);
            __builtin_amdgcn_s_setprio(0);
        }
        if (wr == 0) __builtin_amdgcn_s_barrier();
        epi(cj, acc, wr, wc, fr, fq);
#pragma unroll
        for (int m = 0; m < 8; ++m)
#pragma unroll
            for (int n = 0; n < 4; ++n) acc[m][n] = (f32x4){0.f, 0.f, 0.f, 0.f};
    }
}

template <int MODE = 0, class EpiFactory>
__device__ __forceinline__ void gemm_phase_dense2(const bf16_t* A, int lda, const bf16_t* Bt, int K, int nrt, int nct, char* lds, const Ctx& cx, EpiFactory&& mk) {
    const int tid = cx.tid;
    const int ntiles = nrt * nct;
    const int sc = stage_col2(tid), sr = tid >> 2;
    const int my_tiles = cx.vbid < ntiles ? (ntiles - cx.vbid + cx.G - 1) / cx.G : 0;
    const int vb = cx.vbid, G = cx.G;
    gemm_stream2(my_tiles, K, lds, cx,
        [=](int j, const bf16_t* (&ap)[2], const bf16_t* (&bp)[2]) {
            const int tile = vb + j * G, rt = tile / nct, ct = tile % nct;
            ap[0] = A + (size_t)(rt * 256 + sr) * lda + sc; ap[1] = ap[0] + (size_t)128 * lda;
            bp[0] = Bt + (size_t)(ct * 256 + sr) * K + sc; bp[1] = bp[0] + (size_t)128 * K;
        },
        [=](int j, f32x4 (&acc)[8][4], int wr, int wc, int fr, int fq) {
            const int tile = vb + j * G, rt = tile / nct, ct = tile % nct;
            mk(rt * 256, ct * 256)(acc, wr, wc, fr, fq);
        });
}

__device__ __forceinline__ void phase_nsa_inproj(const Params& p, const Ctx& cx, char* lds) {
    const bf16_t* A = (const bf16_t*)(p.ws + OFF_HA);
    const bf16_t* Bt = (const bf16_t*)(p.ws + OFF_W_NSA_IN);
    char* ws = p.ws;
    const float* qg = p.nsa_q_gain;
    const float* kg = p.nsa_k_gain;
    gemm_phase_dense2(A, 1024, Bt, 1024, NTOK / 256, NSA_IN_PAD / 256, lds, cx, [=](int row0, int col0) {
        return [=](f32x4 (&acc)[8][4], int wr, int wc, int fr, int fq) {
            const int gc0 = col0 + wc * 64;
            if (gc0 >= NSA_IN) return;
            if (gc0 < 1024 || (gc0 >= 1536 && gc0 < 1792) || (gc0 >= 2048 && gc0 < 2304)) {
                const float* gain; float post; bf16_t* dstb; size_t rstride; size_t coff; bool tokmajor;
                if (gc0 < 1024) { gain = qg; post = 0.125f * 1.4426950408889634f; }
                else if (gc0 < 1792) { gain = kg + 64; post = 1.f; }
                else { gain = kg + 128; post = 1.f; }
#pragma unroll
                for (int m = 0; m < 8; ++m) {
                    __builtin_amdgcn_sched_barrier(0);
                    float ss = 0.f;
#pragma unroll
                    for (int n = 0; n < 4; ++n) ss += acc[m][n][0] * acc[m][n][0] + acc[m][n][1] * acc[m][n][1] + acc[m][n][2] * acc[m][n][2] + acc[m][n][3] * acc[m][n][3];
                    ss += __shfl_xor(ss, 16); ss += __shfl_xor(ss, 32);
                    const float r = rsqrtf(ss * (1.f / 64.f) + EPS) * post;
                    const int row = row0 + wr * 128 + m * 16 + fr;
                    bf16_t* dst;
                    if (gc0 < 1024) dst = (bf16_t*)(ws + OFF_Q) + (size_t)row * 1024 + gc0;
                    else {
                        const int g = ((gc0 - 1024) & 255) >> 6, b = row >> 11, t = row & 2047;
                        dst = (bf16_t*)(ws + (gc0 < 1792 ? OFF_KS : OFF_KW)) + ((size_t)(b * 4 + g) * 2048 + t) * 64;
                    }
#pragma unroll
                    for (int pp = 0; pp < 2; ++pp) {
                        const int c = pp * 32 + fq * 8;
                        const f32x4 ga = *(const f32x4*)(gain + c), gb = *(const f32x4*)(gain + c + 4);
                        const f32x4 a = acc[m][2 * pp], bb = acc[m][2 * pp + 1];
                        uint4 o; o.x = pack2(a[0] * r * ga[0], a[1] * r * ga[1]); o.y = pack2(a[2] * r * ga[2], a[3] * r * ga[3]);
                        o.z = pack2(bb[0] * r * gb[0], bb[1] * r * gb[1]); o.w = pack2(bb[2] * r * gb[2], bb[3] * r * gb[3]);
                        *(uint4*)(dst + c) = o;
                    }
                }
            } else if (gc0 < 2560) {
                const int seg = (gc0 - 1024) >> 8;
                const int g = ((gc0 - 1024) & 255) >> 6;
                if (seg < 2) {
                    const size_t off = seg == 0 ? OFF_KCRAW : OFF_VCRAW;
#pragma unroll
                    for (int m = 0; m < 8; ++m) {
                        __builtin_amdgcn_sched_barrier(0);
                    __builtin_amdgcn_sched_barrier(0);
                        const int row = row0 + wr * 128 + m * 16 + fr, b = row >> 11, t = row & 2047;
                        bf16_t* dst = (bf16_t*)(ws + off) + ((size_t)(b * 4 + g) * 2048 + t) * 64;
#pragma unroll
                        for (int pp = 0; pp < 2; ++pp) {
                            const f32x4 a = acc[m][2 * pp], bb = acc[m][2 * pp + 1];
                            uint4 o; o.x = pack2(a[0], a[1]); o.y = pack2(a[2], a[3]); o.z = pack2(bb[0], bb[1]); o.w = pack2(bb[2], bb[3]);
                            *(uint4*)(dst + pp * 32 + fq * 8) = o;
                        }
                    }
                } else {
                    const size_t off = seg == 3 ? OFF_VS : OFF_VW;
#pragma unroll
                    for (int m = 0; m < 8; ++m) {
                        __builtin_amdgcn_sched_barrier(0);
                    __builtin_amdgcn_sched_barrier(0);
                        const int row = row0 + wr * 128 + m * 16 + fr, b = row >> 11, t = row & 2047;
                        bf16_t* dst = (bf16_t*)(ws + off) + (size_t)(b * 4 + g) * 64 * 2048 + t;
#pragma unroll
                        for (int n = 0; n < 4; ++n)
#pragma unroll
                            for (int j = 0; j < 4; ++j) dst[(size_t)(pcol(n, fq) + j) * 2048] = f2bf(acc[m][n][j]);
                    }
                }
            } else {
#pragma unroll
                for (int m = 0; m < 8; ++m) {
                    __builtin_amdgcn_sched_barrier(0);
                    const int row = row0 + wr * 128 + m * 16 + fr;
                    float* dst = (float*)(ws + OFF_GATES) + (size_t)row * 48;
#pragma unroll
                    for (int n = 0; n < 4; ++n) {
                        const int c = pcol(n, fq);
                        f32x4 o;
#pragma unroll
                        for (int j = 0; j < 4; ++j) o[j] = sigmoid_f(acc[m][n][j]);
                        if (c < 48) *(f32x4*)(dst + c) = o;
                    }
                }
            }
        };
    });
}

__device__ __forceinline__ void phase_cmp1(const Params& p, const Ctx& cx, char* lds) {
    const int tid = cx.tid;
    const float* peb = (const float*)(p.ws + OFF_PEB);
    float* T1 = (float*)(p.ws + OFF_T1);
    const int sc = stage_col(tid), sr = tid >> 3;
    for (int tile = cx.vbid; tile < 64; tile += cx.G) {
        const int kv = tile >> 5, bg2 = tile & 31;
        const bf16_t* raw = (const bf16_t*)(p.ws + (kv ? OFF_VCRAW : OFF_KCRAW)) + (size_t)bg2 * 2 * 2048 * 64;
        const bf16_t* a0 = raw + (size_t)sr * 1024 + sc;
        const bf16_t* a2 = raw + (size_t)2048 * 64 + (size_t)sr * 1024 + sc;
        const bf16_t* b0 = (const bf16_t*)(p.ws + OFF_W_CMP1) + ((size_t)kv * 128 + sr) * 2048 + sc;
        const bf16_t* const ap[4] = {a0, a0 + (size_t)64 * 1024, a2, a2 + (size_t)64 * 1024};
        const bf16_t* const bp[2] = {b0, b0 + (size_t)64 * 2048};
        gemm_tile(ap, bp, 2048, lds, cx, [=](f32x4 (&acc)[4][4], int wr, int wc, int fr, int fq) {
            if (wc != 0) return;
#pragma unroll
            for (int m = 0; m < 4; ++m) {
                const int r = wr * 64 + m * 16 + fr;
                float* dst = T1 + ((size_t)kv * 8192 + (bg2 * 2 + (r >> 7)) * 128 + (r & 127)) * 64;
#pragma unroll
                for (int n = 0; n < 4; ++n) {
                    const int c = n * 16 + fq * 4;
                    f32x4 pb = *(const f32x4*)(peb + kv * 64 + c);
                    *(f32x4*)(dst + c) = acc[m][n] + pb;
                }
            }
        });
    }
}

__device__ __forceinline__ void phase_cmp2(const Params& p, const Ctx& cx) {
    const int lane = cx.lane;
    const float* T1 = (const float*)(p.ws + OFF_T1);
    for (int r = cx.vbid * NWAVE + cx.wid; r < 2 * 8192; r += cx.G * NWAVE) {
        const int kv = r >> 13, rr = r & 8191, n_ = rr & 127;
        const float s = silu_f(T1[(size_t)r * 64 + lane]);
        const float* w2 = p.nsa_cmp_w2 + kv * 4096 + lane;
        float o = 0.f;
#pragma unroll 8
        for (int j = 0; j < 64; ++j) o += __shfl(s, j) * w2[j * 64];
        if (kv == 0) {
            const float ss = wave_sum(o * o);
            o = o * rsqrtf(ss * (1.f / 64.f) + EPS) * p.nsa_k_gain[lane];
        }
        if (n_ == 127) o = 0.f;
        if (kv == 0) ((bf16_t*)(p.ws + OFF_KC))[(size_t)rr * 64 + lane] = f2bf(o);
        else ((bf16_t*)(p.ws + OFF_VC))[((size_t)(rr >> 7) * 64 + lane) * 128 + n_] = f2bf(o);
    }
}

constexpr int ATT_BUF = 17920, ATT_K_STRIDE = 144, ATT_V_OFF = 9216, ATT_V_STRIDE = 136, ATT_LUT_OFF = 2 * ATT_BUF, LUT_N = 2136, LUT_PAD = 80;
constexpr int ATT_SC_OFF = ATT_LUT_OFF + 4 * LUT_N * 4;
static_assert(ATT_SC_OFF + NWAVE * 8192 <= LDS_TAB_OFF, "attention LDS");
#define MFMA32(a, b, c) __builtin_amdgcn_mfma_f32_32x32x16_bf16((a), (b), (c), 0, 0, 0)
template <int V> struct IC { static constexpr int value = V; };

__device__ __forceinline__ void phase_attn(const Params& p, const Ctx& cx, char* lds) {
    const int tid = cx.tid, lane = cx.lane, wid = cx.wid;
    const int g = cx.vbid & 3;
    const int ql = lane & 7, head = (lane & 31) >> 3, h2 = lane >> 5, l31 = lane & 31;
    float* lut = (float*)(lds + ATT_LUT_OFF);
    for (int i = tid; i < 4 * LUT_N; i += NTHR) {
        const int h = i / LUT_N, dist = i % LUT_N - LUT_PAD;
        lut[i] = dist >= 0 ? p.rel_bias[t5_bucket(dist) * 16 + g * 4 + h] * 1.4426950408889634f : 0.f;
    }
    __syncthreads();
    const float* lutp = lut + head * LUT_N + LUT_PAD;
    const float b31 = lutp[2047];
    const bf16_t* Qb = (const bf16_t*)(p.ws + OFF_Q);
    const bf16_t* KC = (const bf16_t*)(p.ws + OFF_KC);
    const bf16_t* VCT = (const bf16_t*)(p.ws + OFF_VC);
    const bf16_t* KS = (const bf16_t*)(p.ws + OFF_KS);
    const bf16_t* VST = (const bf16_t*)(p.ws + OFF_VS);
    const bf16_t* KW = (const bf16_t*)(p.ws + OFF_KW);
    const bf16_t* VWT = (const bf16_t*)(p.ws + OFF_VW);
    const float* GT = (const float*)(p.ws + OFF_GATES);
    bf16_t* Og = (bf16_t*)(p.ws + OFF_HA);
    float* scw = (float*)(lds + ATT_SC_OFF) + wid * 2048;
    f32x4* outw = (f32x4*)(lds + ATT_SC_OFF + wid * 8192) + lane;
    const bool flip_ok = (cx.G % 128) == 0;
    const int widu = __builtin_amdgcn_readfirstlane(wid);

    for (int it = 0;; ++it) {
        const int u = cx.vbid + it * cx.G;
        if (u >= 2048) break;
        const int rest = u >> 2, b = rest >> 5, qtb = rest & 31;
        const int qt = (flip_ok && (it & 1)) ? 31 - qtb : qtb;
        const int t0 = qt * 64, cur = qt, bg = b * 4 + g;
        const int tq = t0 + wid * 8 + ql;
        const size_t rowtok = (size_t)b * SEQ + tq;
        bf16x8 Qf[4];
        {
            const bf16_t* qp = Qb + rowtok * 1024 + (g * 4 + head) * 64 + 8 * h2;
#pragma unroll
            for (int ks = 0; ks < 4; ++ks) Qf[ks] = *(const bf16x8*)(qp + 16 * ks);
        }
        const float* gt = GT + rowtok * 48 + (g * 4 + head) * 3;
        const float gate_c = gt[0], gate_s = gt[1], gate_w = gt[2];
        const int wlo = max(0, qt - 8);
        const int nW = cur - wlo + 1;
        const int ncp = (t0 + 63 >= 31 + 16 * 64) ? 2 : 1;
        const int NC = ncp;
        const int NT = NC + nW + cur + 1;

        uint4 kr0, vr0;
        auto issue_load = [&](int i) {
            const bf16_t* ksrc; const bf16_t* vsrc; int vstride;
            if (i < NC) { const int ci = i; ksrc = KC + ((size_t)bg * 128 + ci * 64) * 64; vsrc = VCT + (size_t)bg * 64 * 128 + ci * 64; vstride = 128; }
            else if (i < NC + nW) { const int kb = wlo + i - NC; ksrc = KW + ((size_t)bg * 2048 + kb * 64) * 64; vsrc = VWT + (size_t)bg * 64 * 2048 + kb * 64; vstride = 2048; }
            else { const int kb = i - NC - nW; ksrc = KS + ((size_t)bg * 2048 + kb * 64) * 64; vsrc = VST + (size_t)bg * 64 * 2048 + kb * 64; vstride = 2048; }
            kr0 = *(const uint4*)(ksrc + tid * 8);
            vr0 = *(const uint4*)(vsrc + (size_t)(tid >> 3) * vstride + (tid & 7) * 8);
        };
        auto write_lds = [&](int i) {
            char* bufp = lds + (i & 1) * ATT_BUF;
            *(uint4*)(bufp + (tid >> 3) * ATT_K_STRIDE + (tid & 7) * 16) = kr0;
            char* va = bufp + ATT_V_OFF + (tid >> 3) * ATT_V_STRIDE + (tid & 7) * 16;
            uint2 t;
            t.x = vr0.x; t.y = vr0.y; *(uint2*)va = t;
            t.x = vr0.z; t.y = vr0.w; *(uint2*)(va + 8) = t;
        };
        f32x16 O0, O1;
#pragma unroll
        for (int r = 0; r < 16; ++r) { O0[r] = 0.f; O1[r] = 0.f; }
        float lsum = 0.f;

        auto qk = [&](const char* bufp, int kt2, float init) -> f32x16 {
            f32x16 S;
#pragma unroll
            for (int r = 0; r < 16; ++r) S[r] = init;
            const char* kp = bufp + (32 * kt2 + l31) * ATT_K_STRIDE + 16 * h2;
            bf16x8 kf[4];
#pragma unroll
            for (int ks = 0; ks < 4; ++ks) kf[ks] = *(const bf16x8*)(kp + 32 * ks);
            __builtin_amdgcn_sched_barrier(0);
#pragma unroll
            for (int ks = 0; ks < 4; ++ks) S = MFMA32(kf[ks], Qf[ks], S);
            return S;
        };
        auto pv = [&](const char* bufp, int kt2, const f32x16& P) {
            const char* vp = bufp + ATT_V_OFF + l31 * ATT_V_STRIDE + (32 * kt2 + 4 * h2) * 2;
            uint2 va[2][2][2];
#pragma unroll
            for (int s2 = 0; s2 < 2; ++s2)
#pragma unroll
                for (int dt = 0; dt < 2; ++dt) {
                    va[s2][dt][0] = *(const uint2*)(vp + dt * 32 * ATT_V_STRIDE + s2 * 32);
                    va[s2][dt][1] = *(const uint2*)(vp + dt * 32 * ATT_V_STRIDE + s2 * 32 + 16);
                }
            __builtin_amdgcn_sched_barrier(0);
#pragma unroll
            for (int s2 = 0; s2 < 2; ++s2) {
                uint4 pk;
                pk.x = pack2(P[8 * s2 + 0], P[8 * s2 + 1]); pk.y = pack2(P[8 * s2 + 2], P[8 * s2 + 3]);
                pk.z = pack2(P[8 * s2 + 4], P[8 * s2 + 5]); pk.w = pack2(P[8 * s2 + 6], P[8 * s2 + 7]);
                const bf16x8 Pf = __builtin_bit_cast(bf16x8, pk);
                uint4 a0, a1;
                a0.x = va[s2][0][0].x; a0.y = va[s2][0][0].y; a0.z = va[s2][0][1].x; a0.w = va[s2][0][1].y;
                a1.x = va[s2][1][0].x; a1.y = va[s2][1][0].y; a1.z = va[s2][1][1].x; a1.w = va[s2][1][1].y;
                O0 = MFMA32(__builtin_bit_cast(bf16x8, a0), Pf, O0);
                O1 = MFMA32(__builtin_bit_cast(bf16x8, a1), Pf, O1);
            }
        };
        auto finalize = [&](float gate, int mode) {
            const float Z = lsum + __shfl_xor(lsum, 32);
            const float f = Z > 0.f ? gate / Z : 0.f;
#pragma unroll
            for (int v4 = 0; v4 < 4; ++v4) {
                f32x4 a = {f * O0[4 * v4], f * O0[4 * v4 + 1], f * O0[4 * v4 + 2], f * O0[4 * v4 + 3]};
                f32x4 c = {f * O1[4 * v4], f * O1[4 * v4 + 1], f * O1[4 * v4 + 2], f * O1[4 * v4 + 3]};
                if (mode != 0) { a += outw[v4 * 64]; c += outw[(4 + v4) * 64]; }
                if (mode != 2) { outw[v4 * 64] = a; outw[(4 + v4) * 64] = c; }
                else { O0[4 * v4] = a[0]; O0[4 * v4 + 1] = a[1]; O0[4 * v4 + 2] = a[2]; O0[4 * v4 + 3] = a[3];
                       O1[4 * v4] = c[0]; O1[4 * v4 + 1] = c[1]; O1[4 * v4 + 2] = c[2]; O1[4 * v4 + 3] = c[3]; }
            }
            if (mode != 2) {
#pragma unroll
                for (int r = 0; r < 16; ++r) { O0[r] = 0.f; O1[r] = 0.f; }
            }
            lsum = 0.f;
        };
        auto tile_ws = [&](const char* bufp, int kb, float cinit, auto MMc, auto BMc) {
            constexpr int MM = decltype(MMc)::value, BM = decltype(BMc)::value;
#pragma unroll 1
            for (int kt2 = 0; kt2 < 2; ++kt2) {
                const int d0 = tq - (64 * kb + 32 * kt2 + 4 * h2);
                const float* lp = lutp + (d0 - 27);
                float bv[16];
                if (BM == 0) {
#pragma unroll
                    for (int r = 0; r < 16; ++r) bv[r] = lp[27 - ((r & 3) + 8 * (r >> 2))];
                    __builtin_amdgcn_sched_barrier(0);
                }
                f32x16 S = qk(bufp, kt2, cinit);
#pragma unroll
                for (int r = 0; r < 16; ++r) {
                    const int cr = (r & 3) + 8 * (r >> 2);
                    float x = S[r];
                    if (BM == 0) x += bv[r];
                    if (MM == 1) x += (d0 - cr < 512) ? 0.f : -INFINITY;
                    if (MM == 2) x += (d0 - cr >= 0) ? 0.f : -INFINITY;
                    S[r] = __builtin_amdgcn_exp2f(x);
                    lsum += S[r];
                }
                pv(bufp, kt2, S);
            }
        };

        const int nvis = (tq >= 31) ? min((tq - 31) / 16 + 1, 127) : 0;
        unsigned selmask = 0u;
        float* sown = scw + (head * 8 + ql) * 32;
        float* stail = scw + 1024 + (head * 8 + ql) * 32;
        float* ssc = scw + ql * 32;
        issue_load(0);
        __syncthreads();
        write_lds(0);
        issue_load(1);
        for (int i = 0; i < NT; ++i) {
            __syncthreads();
            const char* bufp = lds + (i & 1) * ATT_BUF;
            if (i < NC) {
                const int ci = i;
#pragma unroll 1
                for (int kt2 = 0; kt2 < 2; ++kt2) {
                    const int n0 = 64 * ci + 32 * kt2 + 4 * h2;
                    const int d0 = tq - 31 - 16 * n0;
                    float bv[16];
#pragma unroll
                    for (int r = 0; r < 16; ++r) bv[r] = lutp[max(d0 - 16 * ((r & 3) + 8 * (r >> 2)), -LUT_PAD)];
                    __builtin_amdgcn_sched_barrier(0);
                    f32x16 S = qk(bufp, kt2, 0.f);
#pragma unroll
                    for (int r = 0; r < 16; ++r) {
                        const int cr = (r & 3) + 8 * (r >> 2);
                        S[r] = __builtin_amdgcn_exp2f(S[r] + bv[r] + ((n0 + cr) < nvis ? 0.f : -INFINITY));
                        lsum += S[r];
                    }
                    pv(bufp, kt2, S);
#pragma unroll
                    for (int rq = 0; rq < 4; ++rq) {
                        const int sblk = 8 * (2 * ci + kt2) + 2 * rq + h2;
                        sown[sblk] = S[4 * rq] + S[4 * rq + 1] + S[4 * rq + 2] + 0.5f * S[4 * rq + 3];
                        if (sblk < 31) stail[sblk + 1] = 0.5f * S[4 * rq + 3];
                    }
                }
                if (i == NC - 1) {
                    const float Z = lsum + __shfl_xor(lsum, 32);
                    const float inv_mine = Z > 0.f ? 1.f / Z : 0.f;
                    if (h2 == 0) stail[0] = 0.f;
                    __builtin_amdgcn_wave_barrier();
                    const int j8 = head * 2 + h2;
                    {
                        f32x4 sc = {0.f, 0.f, 0.f, 0.f};
#pragma unroll
                        for (int hh = 0; hh < 4; ++hh) {
                            const float invh = __shfl(inv_mine, hh * 8 + ql);
                            const f32x4 a = *(const f32x4*)(scw + (hh * 8 + ql) * 32 + 4 * j8), t4 = *(const f32x4*)(scw + 1024 + (hh * 8 + ql) * 32 + 4 * j8);
                            sc += (a + t4) * invh;
                        }
#pragma unroll
                        for (int q = 0; q < 4; ++q) {
                            const int sblk = 4 * j8 + q;
                            const bool forced = (sblk == 0) || (sblk == cur) || (sblk == cur - 1);
                            sc[q] = forced ? 1.0e4f : (sblk <= cur ? sc[q] : -1.0f);
                        }
                        __builtin_amdgcn_wave_barrier();
                        *(f32x4*)(ssc + 4 * j8) = sc;
                    }
                    __builtin_amdgcn_wave_barrier();
                    const f32x4 own = *(const f32x4*)(ssc + 4 * j8);
                    int rk0 = 0, rk1 = 0, rk2 = 0, rk3 = 0;
                    const int so0 = 4 * j8;
#pragma unroll
                    for (int m4 = 0; m4 < 8; ++m4) {
                        const f32x4 v = *(const f32x4*)(ssc + 4 * m4);
#pragma unroll
                        for (int q = 0; q < 4; ++q) {
                            const int sm = 4 * m4 + q;
                            const float vm = v[q];
                            rk0 += (vm > own[0] || (vm == own[0] && sm < so0)) ? 1 : 0;
                            rk1 += (vm > own[1] || (vm == own[1] && sm < so0 + 1)) ? 1 : 0;
                            rk2 += (vm > own[2] || (vm == own[2] && sm < so0 + 2)) ? 1 : 0;
                            rk3 += (vm > own[3] || (vm == own[3] && sm < so0 + 3)) ? 1 : 0;
                        }
                    }
                    unsigned mk = ((rk0 < 8 ? 1u : 0u) | (rk1 < 8 ? 2u : 0u) | (rk2 < 8 ? 4u : 0u) | (rk3 < 8 ? 8u : 0u)) << so0;
                    mk |= __shfl_xor(mk, 8); mk |= __shfl_xor(mk, 16); mk |= __shfl_xor(mk, 32);
                    selmask = mk;
                    __builtin_amdgcn_wave_barrier();
                    finalize(gate_c, 0);
                }
            } else if (i < NC + nW) {
                const int kb = wlo + i - NC;
                if (kb == cur) tile_ws(bufp, kb, 0.f, IC<2>{}, IC<0>{});
                else if (kb == cur - 8) tile_ws(bufp, kb, 0.f, IC<1>{}, IC<0>{});
                else tile_ws(bufp, kb, 0.f, IC<0>{}, IC<0>{});
                if (i == NC - 1 + nW) finalize(gate_w, 1);
            } else {
                const int kb = i - NC - nW;
                const bool sel = ((selmask >> kb) & 1u) != 0;
                if (__ballot(sel) != 0ull) {
                    const float neg = sel ? 0.f : -INFINITY;
                    if (kb == cur) tile_ws(bufp, kb, neg, IC<2>{}, IC<0>{});
                    else if (t0 + 8 * widu - (64 * kb + 63) >= 790) tile_ws(bufp, kb, neg + b31, IC<0>{}, IC<1>{});
                    else tile_ws(bufp, kb, neg, IC<0>{}, IC<0>{});
                }
            }
            if (i + 1 < NT) {
                write_lds(i + 1);
                if (i + 2 < NT) issue_load(i + 2);
            }
        }
        finalize(gate_s, 2);
        {
            bf16_t* op = Og + rowtok * 1024 + (g * 4 + head) * 64 + 4 * h2;
#pragma unroll
            for (int rq = 0; rq < 4; ++rq) {
                uint2 o0; o0.x = pack2(O0[4 * rq], O0[4 * rq + 1]); o0.y = pack2(O0[4 * rq + 2], O0[4 * rq + 3]);
                uint2 o1; o1.x = pack2(O1[4 * rq], O1[4 * rq + 1]); o1.y = pack2(O1[4 * rq + 2], O1[4 * rq + 3]);
                *(uint2*)(op + 8 * rq) = o0;
                *(uint2*)(op + 32 + 8 * rq) = o1;
            }
        }
    }
}

__device__ __forceinline__ void phase_outproj(const Params& p, const Ctx& cx, char* lds, const bf16_t* A, const bf16_t* Bt, const float* xin, int ls) {
    const float* mod = (const float*)(p.ws + OFF_MOD);
    float* xo = p.out;
    gemm_phase_dense2(A, 1024, Bt, 1024, NTOK / 256, 4, lds, cx, [=](int row0, int col0) {
        return [=](f32x4 (&acc)[8][4], int wr, int wc, int fr, int fq) {
            const int b = row0 >> 11;
            const float* gate = mod + ((size_t)ls * 16 + b) * 3072 + 2048 + col0 + wc * 64;
            f32x4 g[4];
#pragma unroll
            for (int n = 0; n < 4; ++n) g[n] = *(const f32x4*)(gate + pcol(n, fq));
#pragma unroll
            for (int m2 = 0; m2 < 8; m2 += 2) {
                f32x4 xi[2][4];
#pragma unroll
                for (int mm = 0; mm < 2; ++mm)
#pragma unroll
                    for (int n = 0; n < 4; ++n)
                        xi[mm][n] = *(const f32x4*)(xin + (size_t)(row0 + wr * 128 + (m2 + mm) * 16 + fr) * 1024 + col0 + wc * 64 + pcol(n, fq));
                __builtin_amdgcn_sched_barrier(0);
#pragma unroll
                for (int mm = 0; mm < 2; ++mm)
#pragma unroll
                    for (int n = 0; n < 4; ++n) {
                        f32x4 o;
#pragma unroll
                        for (int j = 0; j < 4; ++j) o[j] = xi[mm][n][j] + g[n][j] * acc[m2 + mm][n][j];
                        *(f32x4*)(xo + (size_t)(row0 + wr * 128 + (m2 + mm) * 16 + fr) * 1024 + col0 + wc * 64 + pcol(n, fq)) = o;
                    }
                __builtin_amdgcn_sched_barrier(0);
            }
        };
    });
}

__device__ __forceinline__ void moe_tables(const Params& p, int layer, int tid, int* s_cnt, int* s_off, int* s_toff) {
    __syncthreads();
    if (tid == 0) {
        const int* cnt = (const int*)(p.ws + OFF_CNT) + layer * 16;
        int o = 0, to = 0;
        for (int e = 0; e < 16; ++e) { const int c = cnt[e]; s_cnt[e] = c; s_off[e] = o; s_toff[e] = to; o += c; to += ((c + 255) >> 8) * 4; }
        s_off[16] = o; s_toff[16] = to;
    }
    __syncthreads();
}

constexpr int LDS_ROWIDX_OFF = 131072, LDS_LW_OFF = 131072 + 8192;
static_assert(LDS_LW_OFF + 8192 <= LDS_TAB_OFF, "moe caches");

__device__ __forceinline__ void phase_moe_up(const Params& p, const Ctx& cx, char* lds, int layer) {
    const int tid = cx.tid;
    int* s_cnt = (int*)(lds + LDS_TAB_OFF); int* s_off = s_cnt + 16; int* s_toff = s_off + 17;
    moe_tables(p, layer, tid, s_cnt, s_off, s_toff);
    const int ntiles = s_toff[16];
    const bf16_t* hA = (const bf16_t*)(p.ws + OFF_HA);
    const int* ltok = (const int*)(p.ws + OFF_LTOK);
    bf16_t* H1 = (bf16_t*)(p.ws + OFF_H1);
    int* rowidx = (int*)(lds + LDS_ROWIDX_OFF);
    const int sc = stage_col2(tid), sr = tid >> 2;
    const int vb = cx.vbid, G = cx.G;
    const int my_tiles = min(8, vb < ntiles ? (ntiles - vb + G - 1) / G : 0);
    auto locate = [=](int j, int& e, int& rt, int& ct) { const int tile = vb + j * G; e = 0; while (tile >= s_toff[e + 1]) ++e; const int lt = tile - s_toff[e]; rt = lt >> 2; ct = lt & 3; };
    for (int i = tid; i < my_tiles * 256; i += NTHR) {
        const int j = i >> 8, r = i & 255; int e, rt, ct; locate(j, e, rt, ct);
        rowidx[i] = ltok[(size_t)e * NTOK + min(rt * 256 + r, s_cnt[e] - 1)];
    }
    __syncthreads();
    const bf16_t* Wup = (const bf16_t*)(p.ws + OFF_W_UP) + (size_t)layer * 16 * 1024 * 1024;
    gemm_stream2(my_tiles, 1024, lds, cx,
        [=](int j, const bf16_t* (&ap)[2], const bf16_t* (&bp)[2]) {
            int e, rt, ct; locate(j, e, rt, ct);
            ap[0] = hA + (size_t)rowidx[j * 256 + sr] * 1024 + sc; ap[1] = hA + (size_t)rowidx[j * 256 + sr + 128] * 1024 + sc;
            bp[0] = Wup + ((size_t)e * 1024 + ct * 256 + sr) * 1024 + sc; bp[1] = bp[0] + (size_t)128 * 1024;
        },
        [=](int j, f32x4 (&acc)[8][4], int wr, int wc, int fr, int fq) {
            int e, rt, ct; locate(j, e, rt, ct);
            const int cnt = s_cnt[e], off = s_off[e];
#pragma unroll
            for (int m = 0; m < 8; ++m) {
                const int pos = rt * 256 + wr * 128 + m * 16 + fr;
                if (pos < cnt) {
                    bf16_t* dst = H1 + (size_t)(off + pos) * 512 + ct * 128 + wc * 32 + fq * 8;
                    float h[8];
#pragma unroll
                    for (int n = 0; n < 2; ++n)
#pragma unroll
                        for (int jj = 0; jj < 4; ++jj) h[n * 4 + jj] = silu_f(acc[m][n][jj]) * acc[m][n + 2][jj];
                    uint4 o; o.x = pack2(h[0], h[1]); o.y = pack2(h[2], h[3]); o.z = pack2(h[4], h[5]); o.w = pack2(h[6], h[7]);
                    *(uint4*)dst = o;
                }
            }
        });
}

__device__ __forceinline__ void phase_moe_down(const Params& p, const Ctx& cx, char* lds, int layer) {
    const int tid = cx.tid;
    int* s_cnt = (int*)(lds + LDS_TAB_OFF); int* s_off = s_cnt + 16; int* s_toff = s_off + 17;
    moe_tables(p, layer, tid, s_cnt, s_off, s_toff);
    const int ntiles = s_toff[16];
    const bf16_t* H1 = (const bf16_t*)(p.ws + OFF_H1);
    const float* lw = (const float*)(p.ws + OFF_LW);
    bf16_t* Y = (bf16_t*)(p.ws + OFF_Y);
    float* lwc = (float*)(lds + LDS_LW_OFF);
    const int sc = stage_col2(tid), sr = tid >> 2;
    const int vb = cx.vbid, G = cx.G;
    const int my_tiles = min(8, vb < ntiles ? (ntiles - vb + G - 1) / G : 0);
    auto locate = [=](int j, int& e, int& rt, int& ct) { const int tile = vb + j * G; e = 0; while (tile >= s_toff[e + 1]) ++e; const int lt = tile - s_toff[e]; rt = lt >> 2; ct = lt & 3; };
    for (int i = tid; i < my_tiles * 256; i += NTHR) {
        const int j = i >> 8, r = i & 255; int e, rt, ct; locate(j, e, rt, ct);
        lwc[i] = lw[(size_t)e * NTOK + min(rt * 256 + r, s_cnt[e] - 1)];
    }
    __syncthreads();
    const bf16_t* Wdn = (const bf16_t*)(p.ws + OFF_W_DN) + (size_t)layer * 16 * 1024 * 512;
    gemm_stream2(my_tiles, 512, lds, cx,
        [=](int j, const bf16_t* (&ap)[2], const bf16_t* (&bp)[2]) {
            int e, rt, ct; locate(j, e, rt, ct);
            const int cnt = s_cnt[e], off = s_off[e];
            ap[0] = H1 + (size_t)(off + min(rt * 256 + sr, cnt - 1)) * 512 + sc; ap[1] = H1 + (size_t)(off + min(rt * 256 + sr + 128, cnt - 1)) * 512 + sc;
            bp[0] = Wdn + ((size_t)e * 1024 + ct * 256 + sr) * 512 + sc; bp[1] = bp[0] + (size_t)128 * 512;
        },
        [=](int j, f32x4 (&acc)[8][4], int wr, int wc, int fr, int fq) {
            int e, rt, ct; locate(j, e, rt, ct);
            const int cnt = s_cnt[e], off = s_off[e];
#pragma unroll
            for (int m = 0; m < 8; ++m) {
                const int rl_ = wr * 128 + m * 16 + fr, pos = rt * 256 + rl_;
                if (pos < cnt) {
                    const float w = lwc[j * 256 + rl_];
                    bf16_t* dst = Y + (size_t)(off + pos) * 1024 + ct * 256 + wc * 64;
#pragma unroll
                    for (int pp = 0; pp < 2; ++pp) {
                        const f32x4 a = acc[m][2 * pp], bb = acc[m][2 * pp + 1];
                        uint4 o; o.x = pack2(w * a[0], w * a[1]); o.y = pack2(w * a[2], w * a[3]); o.z = pack2(w * bb[0], w * bb[1]); o.w = pack2(w * bb[2], w * bb[3]);
                        *(uint4*)(dst + pp * 32 + fq * 8) = o;
                    }
                }
            }
        });
}


namespace pg8 {
#define PG8_LAS __attribute__((address_space(3)))
typedef unsigned short bf16_t;
typedef short bf16x8 __attribute__((ext_vector_type(8)));
typedef float f32x4 __attribute__((ext_vector_type(4)));
typedef unsigned u32x4 __attribute__((ext_vector_type(4)));
constexpr int BM = 256, BK = 64, HALF = 128, HTB = HALF * BK * 2  , STAGE_BYTES = 8 * HTB, NXCD = 8, WGM = 8;

__host__ __device__ __forceinline__ int lds_byte(int r, int c) { const int st = (r >> 4) * 2 + (c >> 5), rr = r & 15, cc = c & 31, ob = rr * 64 + cc * 2; return st * 1024 + (ob ^ (((ob >> 9) & 1) << 5)); }
__host__ __device__ __forceinline__ void stage_rc(int b, int& R, int& C) { const int st = b / 1024, sb = b % 1024, swz = sb ^ (((sb >> 9) & 1) << 5); R = (st >> 1) * 16 + swz / 64; C = (st & 1) * 32 + (swz % 64) / 2; }
__host__ __device__ __forceinline__ int perm32(int rho) { const int n = rho >> 4, i = rho & 15; return 8 * (i >> 2) + 4 * n + (i & 3); }

struct Unit { int pm, pn; };
struct Gemm { const bf16_t* A; const bf16_t* Bt; int M, N, K; };

struct StaticOrder {
    int nM, nN, nwg, G, c;
    __host__ __device__ void init(int M, int N, int G_, int c_) { nM = M / BM; nN = N / BM; nwg = nM * nN; G = G_; c = c_; }
    __host__ __device__ bool next(int i, Unit& u) const {
        const long L = (long)i * G + c; if (L >= nwg) return false;
        int wgid = (int)L; { const int q = nwg / NXCD, r = nwg % NXCD, xcd = wgid % NXCD, off = wgid / NXCD; wgid = (xcd < r ? xcd * (q + 1) : r * (q + 1) + (xcd - r) * q) + off; }
        const int nig = WGM * nN, gid = wgid / nig, fm = gid * WGM, gsz = (nM - fm) < WGM ? (nM - fm) : WGM;
        u.pm = fm + ((wgid % nig) % gsz); u.pn = (wgid % nig) / gsz; return true;
    }
    __device__ __forceinline__ void a_ready(const Unit&) const {}
    __device__ __forceinline__ void done(const Unit&) const {}
};

template <class Epi, class Sched, bool ALIGN_EPI = false, bool SP2 = false>
__device__ __forceinline__ void gemm_phase(PG8_LAS unsigned char* lds, const Gemm g, const Sched& S, const Epi& E) {
    const int tid = threadIdx.x, wid = __builtin_amdgcn_readfirstlane(tid >> 6), lane = tid & 63, wr = wid >> 2, wc = wid & 3, fr = lane & 15, fq = lane >> 4;
    const int K = g.K, nt = K / BK;
    unsigned voffA[2], voffB[2];
#pragma unroll
    for (int i = 0; i < 2; ++i) { int R, C; stage_rc(tid * 16 + i * 8192, R, C); const int Rb = Epi::PERM ? ((R & ~31) + perm32(R & 31)) : R;
        voffA[i] = (unsigned)(R * K + C) * 2u; voffB[i] = (unsigned)(Rb * K + C) * 2u; }
    const size_t kstep = (size_t)(BK * 2);
    const size_t hstep = (size_t)HALF * K * 2;
    const size_t tstep = 2 * hstep;
    const unsigned ldsw = (unsigned)wid * 1024u;
    const int aoff = lds_byte(wr * 64 + fr, fq * 8), boff = lds_byte(wc * 32 + fr, fq * 8);
#define PG8_SA(b, h) (((b) * 2 + (h)) * HTB)
#define PG8_SB(b, h) ((4 + (b) * 2 + (h)) * HTB)
#define PG8_STAGE(bufoff, gbase, voff) do { _Pragma("unroll") for (int _i = 0; _i < 2; ++_i) \
        __builtin_amdgcn_global_load_lds((const unsigned*)((const char*)(gbase) + (voff)[_i]), (PG8_LAS unsigned*)(lds + (bufoff) + ldsw + _i * 8192), 16, 0, 0); } while (0)
#define PG8_LDA(dst, b, h) do { _Pragma("unroll") for (int m = 0; m < 4; ++m) _Pragma("unroll") for (int k = 0; k < 2; ++k) dst[m][k] = *(const PG8_LAS bf16x8*)(lds + PG8_SA(b, h) + aoff + m * 2048 + k * 1024); } while (0)
#define PG8_LDB(dst, b, h) do { _Pragma("unroll") for (int n = 0; n < 2; ++n) _Pragma("unroll") for (int k = 0; k < 2; ++k) dst[n][k] = *(const PG8_LAS bf16x8*)(lds + PG8_SB(b, h) + boff + n * 2048 + k * 1024); } while (0)
#define PG8_MMA(ai, bj, At, Bt) do { __builtin_amdgcn_s_setprio(1); _Pragma("unroll") for (int m = 0; m < 4; ++m) _Pragma("unroll") for (int n = 0; n < 2; ++n) _Pragma("unroll") for (int k = 0; k < 2; ++k) \
        acc[ai][bj][m][n] = __builtin_amdgcn_mfma_f32_16x16x32_bf16(Bt[n][k], At[m][k], acc[ai][bj][m][n], 0, 0, 0); __builtin_amdgcn_s_setprio(0); } while (0)
#define PG8_WAIT_V(n) asm volatile("s_waitcnt vmcnt(" #n ")" ::: "memory")
#define PG8_WAIT_L(n) asm volatile("s_waitcnt lgkmcnt(" #n ")" ::: "memory")
#define PG8_BAR __builtin_amdgcn_s_barrier()
#define PG8_SCHED __builtin_amdgcn_sched_barrier(0)
    Unit cur, nxt; int ui = 0;
    if (!S.next(0, cur)) return;
    f32x4 acc[2][2][4][2];
#pragma unroll
    for (int a = 0; a < 2; ++a)
#pragma unroll
        for (int b = 0; b < 2; ++b)
#pragma unroll
            for (int m = 0; m < 4; ++m)
#pragma unroll
                for (int n = 0; n < 2; ++n) acc[a][b][m][n] = (f32x4){0.f, 0.f, 0.f, 0.f};
    bf16x8 At[4][2], B0[2][2], B1[2][2];
    const char* cA = (const char*)g.A + (size_t)cur.pm * tstep; const char* cB = (const char*)g.Bt + (size_t)cur.pn * tstep;
    S.a_ready(cur);
    if constexpr (SP2) {
        PG8_STAGE(PG8_SB(0, 0), cB, voffB); PG8_STAGE(PG8_SB(0, 1), cB + hstep, voffB); PG8_STAGE(PG8_SA(0, 0), cA, voffA); PG8_STAGE(PG8_SA(0, 1), cA + hstep, voffA);
        if (wr == 1) PG8_BAR;
        PG8_WAIT_V(2); PG8_BAR;
        PG8_STAGE(PG8_SB(1, 0), cB + kstep, voffB); PG8_STAGE(PG8_SA(1, 0), cA + kstep, voffA); PG8_STAGE(PG8_SB(1, 1), cB + hstep + kstep, voffB);
        PG8_WAIT_V(6); PG8_BAR;
    } else {
        PG8_STAGE(PG8_SB(0, 0), cB, voffB); PG8_STAGE(PG8_SA(0, 0), cA, voffA); PG8_STAGE(PG8_SB(0, 1), cB + hstep, voffB); PG8_STAGE(PG8_SA(0, 1), cA + hstep, voffA);
        if (wr == 1) PG8_BAR;
        PG8_WAIT_V(4); PG8_BAR;
        PG8_STAGE(PG8_SB(1, 0), cB + kstep, voffB); PG8_STAGE(PG8_SA(1, 0), cA + kstep, voffA); PG8_STAGE(PG8_SB(1, 1), cB + hstep + kstep, voffB);
        PG8_WAIT_V(6); PG8_BAR;
    }
    for (;;) {
        const bool has_next = S.next(ui + 1, nxt);
        const char* nA = has_next ? (const char*)g.A + (size_t)nxt.pm * tstep : cA; const char* nB = has_next ? (const char*)g.Bt + (size_t)nxt.pn * tstep : cB;
        for (int t = 0; t < nt; t += 2) {
            const bool last = (t == nt - 2);
            const char* a1 = cA + (size_t)(t + 1) * kstep;
            const char* a2 = last ? nA : cA + (size_t)(t + 2) * kstep; const char* b2 = last ? nB : cB + (size_t)(t + 2) * kstep;
            const char* a3 = a2 + kstep; const char* b3 = b2 + kstep;
            if (last && has_next) S.a_ready(nxt);
            if constexpr (SP2) {
            PG8_LDB(B0, 0, 0); PG8_LDB(B1, 0, 1); PG8_SCHED; PG8_LDA(At, 0, 0); PG8_STAGE(PG8_SA(1, 1), a1 + hstep, voffA);
            PG8_WAIT_V(8); PG8_WAIT_L(0); PG8_BAR; PG8_MMA(0, 0, At, B0); PG8_MMA(0, 1, At, B1); PG8_BAR; PG8_SCHED;
            PG8_LDA(At, 0, 1); PG8_STAGE(PG8_SB(0, 0), b2, voffB); PG8_STAGE(PG8_SB(0, 1), b2 + hstep, voffB); PG8_STAGE(PG8_SA(0, 0), a2, voffA);
            PG8_WAIT_V(8); PG8_WAIT_L(0); PG8_BAR; PG8_MMA(1, 0, At, B0); PG8_MMA(1, 1, At, B1); PG8_BAR; PG8_SCHED;
            PG8_LDB(B0, 1, 0); PG8_LDB(B1, 1, 1); PG8_SCHED; PG8_LDA(At, 1, 0); PG8_STAGE(PG8_SA(0, 1), a2 + hstep, voffA);
            PG8_WAIT_V(8); PG8_WAIT_L(0); PG8_BAR; PG8_MMA(0, 0, At, B0); PG8_MMA(0, 1, At, B1); PG8_BAR; PG8_SCHED;
            PG8_LDA(At, 1, 1); PG8_STAGE(PG8_SB(1, 0), b3, voffB); PG8_STAGE(PG8_SB(1, 1), b3 + hstep, voffB); PG8_STAGE(PG8_SA(1, 0), a3, voffA);
            PG8_WAIT_V(8); PG8_WAIT_L(0); PG8_BAR; PG8_MMA(1, 0, At, B0); PG8_MMA(1, 1, At, B1); PG8_BAR; PG8_SCHED;
            } else {
            PG8_LDB(B0, 0, 0); PG8_SCHED; PG8_LDA(At, 0, 0); PG8_STAGE(PG8_SA(1, 1), a1 + hstep, voffA);
            PG8_WAIT_L(8); PG8_BAR; PG8_WAIT_L(0); PG8_MMA(0, 0, At, B0); PG8_BAR; PG8_SCHED;
            PG8_LDB(B1, 0, 1); PG8_STAGE(PG8_SB(0, 0), b2, voffB);
            PG8_BAR; PG8_WAIT_L(0); PG8_MMA(0, 1, At, B1); PG8_BAR;
            PG8_LDA(At, 0, 1); PG8_STAGE(PG8_SA(0, 0), a2, voffA);
            PG8_BAR; PG8_WAIT_L(0); PG8_MMA(1, 0, At, B0); PG8_BAR; PG8_SCHED;
            PG8_STAGE(PG8_SB(0, 1), b2 + hstep, voffB);
            PG8_WAIT_V(6); PG8_BAR; PG8_MMA(1, 1, At, B1); PG8_BAR;
            PG8_LDB(B0, 1, 0); PG8_SCHED; PG8_LDA(At, 1, 0); PG8_STAGE(PG8_SA(0, 1), a2 + hstep, voffA);
            PG8_WAIT_L(8); PG8_BAR; PG8_WAIT_L(0); PG8_MMA(0, 0, At, B0); PG8_BAR; PG8_SCHED;
            PG8_LDB(B1, 1, 1); PG8_STAGE(PG8_SB(1, 0), b3, voffB);
            PG8_BAR; PG8_WAIT_L(0); PG8_MMA(0, 1, At, B1); PG8_BAR;
            PG8_LDA(At, 1, 1); PG8_STAGE(PG8_SA(1, 0), a3, voffA);
            PG8_BAR; PG8_WAIT_L(0); PG8_MMA(1, 0, At, B0); PG8_BAR; PG8_SCHED;
            PG8_STAGE(PG8_SB(1, 1), b3 + hstep, voffB);
            PG8_WAIT_V(6); PG8_BAR; PG8_MMA(1, 1, At, B1); PG8_BAR;
            }
        }
        if constexpr (ALIGN_EPI) { if (wr == 0) PG8_BAR; }
        if constexpr (!Epi::AFTER_DRAIN) { E(acc, cur, wr, wc, fr, fq); S.done(cur); }
        if (!has_next) break;
#pragma unroll
        for (int a = 0; a < 2; ++a)
#pragma unroll
            for (int b = 0; b < 2; ++b)
#pragma unroll
                for (int m = 0; m < 4; ++m)
#pragma unroll
                    for (int n = 0; n < 2; ++n) acc[a][b][m][n] = (f32x4){0.f, 0.f, 0.f, 0.f};
        cur = nxt; cA = nA; cB = nB; ++ui;
        if constexpr (ALIGN_EPI) { if (wr == 1) PG8_BAR; }
    }
    PG8_WAIT_V(0);
    if constexpr (!ALIGN_EPI) { if (wr == 0) PG8_BAR; }
    PG8_BAR;
    if constexpr (Epi::AFTER_DRAIN) { E.fused(acc, cur, wr, wc, fr, fq, lds, wid, lane); S.done(cur); }
#undef PG8_SA
#undef PG8_SB
#undef PG8_STAGE
#undef PG8_LDA
#undef PG8_LDB
#undef PG8_MMA
#undef PG8_WAIT_V
#undef PG8_WAIT_L
#undef PG8_BAR
#undef PG8_SCHED
}
}

#ifndef PG8_SP2
#define PG8_SP2 true
#endif
struct EpiHgrnIn {
    static constexpr bool PERM = false, AFTER_DRAIN = false;
    char* ws; const float* lb;
    __device__ __forceinline__ void operator()(const pg8::f32x4 (&acc)[2][2][4][2], const pg8::Unit& u, int wr, int wc, int fr, int fq) const {
#pragma unroll
        for (int ai = 0; ai < 2; ++ai)
#pragma unroll
            for (int m = 0; m < 4; ++m) {
                const int row = u.pm * 256 + ai * 128 + wr * 64 + m * 16 + fr;
#pragma unroll
                for (int bj = 0; bj < 2; ++bj) {
                    const int gc = u.pn * 256 + bj * 128 + wc * 32 + fq * 8, seg = gc >> 10, c = gc & 1023;
                    const f32x4 a0 = acc[ai][bj][m][0], a1 = acc[ai][bj][m][1];
                    float h[8];
                    if (seg == 1) {
                        const f32x4 la = *(const f32x4*)(lb + c), lbb = *(const f32x4*)(lb + c + 4);
#pragma unroll
                        for (int j = 0; j < 4; ++j) {
                            h[j] = __logf(la[j] + (1.f - la[j]) * sigmoid_f(a0[j]));
                            h[4 + j] = __logf(lbb[j] + (1.f - lbb[j]) * sigmoid_f(a1[j]));
                        }
                        uint4 oh; oh.x = packh2(h[0], h[1]); oh.y = packh2(h[2], h[3]); oh.z = packh2(h[4], h[5]); oh.w = packh2(h[6], h[7]);
                        *(uint4*)((unsigned short*)(ws + OFF_LF) + (size_t)row * 1024 + c) = oh;
                    } else {
#pragma unroll
                        for (int j = 0; j < 4; ++j) {
                            h[j] = (seg == 2) ? a0[j] : silu_f(a0[j]);
                            h[4 + j] = (seg == 2) ? a1[j] : silu_f(a1[j]);
                        }
                        uint4 o; o.x = pack2(h[0], h[1]); o.y = pack2(h[2], h[3]); o.z = pack2(h[4], h[5]); o.w = pack2(h[6], h[7]);
                        bf16_t* dst = (bf16_t*)(ws + (seg == 0 ? OFF_QH : seg == 2 ? OFF_V : OFF_G));
                        *(uint4*)(dst + (size_t)row * 1024 + c) = o;
                    }
                }
            }
    }
};

struct EpiOutProj {
    static constexpr bool PERM = false, AFTER_DRAIN = false;
    const float* mod; const float* xin; float* xo; int ls;
    __device__ __forceinline__ void operator()(const pg8::f32x4 (&acc)[2][2][4][2], const pg8::Unit& u, int wr, int wc, int fr, int fq) const {
        const int b = (u.pm * 256) >> 11;
        const float* gate = mod + ((size_t)ls * 16 + b) * 3072 + 2048 + u.pn * 256 + wc * 32 + fq * 8;
        f32x4 g[2][2];
#pragma unroll
        for (int bj = 0; bj < 2; ++bj) { g[bj][0] = *(const f32x4*)(gate + bj * 128); g[bj][1] = *(const f32x4*)(gate + bj * 128 + 4); }
#pragma unroll
        for (int ai = 0; ai < 2; ++ai)
#pragma unroll
            for (int m = 0; m < 4; ++m) {
                const size_t ro = (size_t)(u.pm * 256 + ai * 128 + wr * 64 + m * 16 + fr) * 1024 + u.pn * 256 + wc * 32 + fq * 8;
                f32x4 xi[2][2];
#pragma unroll
                for (int bj = 0; bj < 2; ++bj) { xi[bj][0] = *(const f32x4*)(xin + ro + bj * 128); xi[bj][1] = *(const f32x4*)(xin + ro + bj * 128 + 4); }
#pragma unroll
                for (int bj = 0; bj < 2; ++bj)
#pragma unroll
                    for (int n = 0; n < 2; ++n) {
                        f32x4 o;
#pragma unroll
                        for (int j = 0; j < 4; ++j) o[j] = xi[bj][n][j] + g[bj][n][j] * acc[ai][bj][m][n][j];
                        *(f32x4*)(xo + ro + bj * 128 + n * 4) = o;
                    }
            }
    }
};

__device__ __forceinline__ void phase_outproj8(const Params& p, const Ctx& cx, char* lds, const bf16_t* A, const bf16_t* Bt, const float* xin, int ls) {
    pg8::Gemm g{A, Bt, NTOK, 1024, 1024};
    pg8::StaticOrder S; S.init(NTOK, 1024, cx.G, (int)blockIdx.x);
    EpiOutProj E{(const float*)(p.ws + OFF_MOD), xin, p.out, ls};
    __syncthreads();
    pg8::gemm_phase<EpiOutProj, pg8::StaticOrder, true, PG8_SP2>((PG8_LAS unsigned char*)lds, g, S, E);
    __syncthreads();
}

__device__ __forceinline__ void phase_hgrn_inproj8(const Params& p, const Ctx& cx, char* lds) {
    pg8::Gemm g{(const bf16_t*)(p.ws + OFF_HA), (const bf16_t*)(p.ws + OFF_W_HG_IN), NTOK, 4096, 1024};
    pg8::StaticOrder S; S.init(NTOK, 4096, cx.G, (int)blockIdx.x);
    EpiHgrnIn E{p.ws, (const float*)(p.ws + OFF_LB)};
    __syncthreads();
    pg8::gemm_phase<EpiHgrnIn, pg8::StaticOrder, true, PG8_SP2>((PG8_LAS unsigned char*)lds, g, S, E);
    __syncthreads();
}

template <int MODE = 0>
__device__ __forceinline__ void phase_hgrn_inproj(const Params& p, const Ctx& cx, char* lds) {
    const bf16_t* A = (const bf16_t*)(p.ws + OFF_HA);
    const bf16_t* Bt = (const bf16_t*)(p.ws + OFF_W_HG_IN);
    char* ws = p.ws;
    const float* lb = (const float*)(p.ws + OFF_LB);
    gemm_phase_dense2(A, 1024, Bt, 1024, NTOK / 256, 16, lds, cx, [=](int row0, int col0) {
        return [=](f32x4 (&acc)[8][4], int wr, int wc, int fr, int fq) {
            const int gc0 = col0 + wc * 64, seg = gc0 >> 10, c0 = gc0 & 1023;
#pragma unroll
            for (int m = 0; m < 8; ++m) {
                const int row = row0 + wr * 128 + m * 16 + fr;
#pragma unroll
                for (int pp = 0; pp < 2; ++pp) {
                    const int c = c0 + pp * 32 + fq * 8;
                    float h[8];
                    if (seg == 1) {
                        const f32x4 la = *(const f32x4*)(lb + c), lbb = *(const f32x4*)(lb + c + 4);
#pragma unroll
                        for (int j = 0; j < 4; ++j) {
                            h[j] = __logf(la[j] + (1.f - la[j]) * sigmoid_f(acc[m][2 * pp][j]));
                            h[4 + j] = __logf(lbb[j] + (1.f - lbb[j]) * sigmoid_f(acc[m][2 * pp + 1][j]));
                        }
                        uint4 oh; oh.x = packh2(h[0], h[1]); oh.y = packh2(h[2], h[3]); oh.z = packh2(h[4], h[5]); oh.w = packh2(h[6], h[7]);
                        *(uint4*)((unsigned short*)(ws + OFF_LF) + (size_t)row * 1024 + c) = oh;
                    } else {
#pragma unroll
                        for (int j = 0; j < 4; ++j) {
                            h[j] = (seg == 2) ? acc[m][2 * pp][j] : silu_f(acc[m][2 * pp][j]);
                            h[4 + j] = (seg == 2) ? acc[m][2 * pp + 1][j] : silu_f(acc[m][2 * pp + 1][j]);
                        }
                        uint4 o; o.x = pack2(h[0], h[1]); o.y = pack2(h[2], h[3]); o.z = pack2(h[4], h[5]); o.w = pack2(h[6], h[7]);
                        bf16_t* dst = (bf16_t*)(ws + (seg == 0 ? OFF_QH : seg == 2 ? OFF_V : OFF_G));
                        *(uint4*)(dst + (size_t)row * 1024 + c) = o;
                    }
                }
            }
        };
    });
}

constexpr int HG_QD_OFF = 0, HG_KD_OFF = 8704, HG_K2T_OFF = 17408, HG_VT_OFF = 27648, HG_DEC_OFF = 37888, HG_BUF = 38400, HG_TOT_OFF = 2 * HG_BUF;
constexpr int HG_ROW = 272, HG_TROW = 80;
static_assert(HG_TOT_OFF + 2048 <= LDS_TAB_OFF, "hgrn LDS");

__device__ __forceinline__ void phase_hgrn_rec(const Params& p, const Ctx& cx, char* lds) {
    const int lane = cx.lane;
    const int l31 = lane & 31, h2 = lane >> 5;
    const int widu = __builtin_amdgcn_readfirstlane(cx.wid);
    const bool producer = widu >= 4;
    const int pw = widu & 3;
    const int d0 = 2 * lane;
    const bf16_t* QH = (const bf16_t*)(p.ws + OFF_QH);
    const unsigned short* LF = (const unsigned short*)(p.ws + OFF_LF);
    const bf16_t* V = (const bf16_t*)(p.ws + OFF_V);
    bf16_t* OR = (bf16_t*)(p.ws + OFF_HA);
    float* tot = (float*)(lds + HG_TOT_OFF);
    for (int item = blockIdx.x; item < 128; item += cx.G) {
        const int b = item >> 3, h = item & 7;
        f32x16 S0, S1, S2, S3;
#pragma unroll
        for (int r = 0; r < 16; ++r) { S0[r] = 0.f; S1[r] = 0.f; S2[r] = 0.f; S3[r] = 0.f; }
        unsigned lfA[8], lfB[8], qv[8], vv[8];
        const size_t gbase = (size_t)(b * SEQ + pw * 8) * 1024 + h * 128;
        if (producer) {
#pragma unroll
            for (int i = 0; i < 8; ++i) {
                lfA[i] = *(const unsigned*)(LF + gbase + (size_t)i * 1024 + d0);
                qv[i] = *(const unsigned*)(QH + gbase + (size_t)i * 1024 + d0);
                vv[i] = *(const unsigned*)(V + gbase + (size_t)i * 1024 + d0);
            }
#pragma unroll
            for (int i = 0; i < 8; ++i) lfB[i] = *(const unsigned*)(LF + gbase + (size_t)(32 + i) * 1024 + d0);
        }
        __syncthreads();
        for (int c = 0; c <= SEQ / 32; ++c) {
            unsigned lf[8];
#pragma unroll
            for (int i = 0; i < 8; ++i) lf[i] = (c & 1) ? lfB[i] : lfA[i];
            f2_t run = {0.f, 0.f};
            if (producer && c < SEQ / 32) {
#pragma unroll
                for (int i = 0; i < 8; ++i) run += unpackh2(lf[i]);
                *(f2_t*)(tot + pw * 128 + d0) = run;
            }
            __syncthreads();
            if (producer) {
                if (c < SEQ / 32) {
                    char* bufp = lds + (c & 1) * HG_BUF;
                    f2_t pre = {0.f, 0.f}, last = {0.f, 0.f};
#pragma unroll
                    for (int q = 0; q < 4; ++q) {
                        const f2_t tq_ = *(const f2_t*)(tot + q * 128 + d0);
                        last += tq_;
                        if (q < pw) pre += tq_;
                    }
                    if (pw == 0) { f2_t dv; dv.x = __expf(last.x); dv.y = __expf(last.y); *(f2_t*)(bufp + HG_DEC_OFF + d0 * 4) = dv; }
                    float k2a[8], k2b[8];
                    f2_t rc = pre;
#pragma unroll
                    for (int i = 0; i < 8; ++i) {
                        const f2_t lfi = unpackh2(lf[i]);
                        rc += lfi;
                        const float cu0 = rc.x, cu1 = rc.y;
                        const float kk0 = 1.f - __expf(lfi.x), kk1 = 1.f - __expf(lfi.y);
                        const float q0 = bf2f((unsigned short)(qv[i] & 0xffff)) * __expf(cu0), q1 = bf2f((unsigned short)(qv[i] >> 16)) * __expf(cu1);
                        const float kd0 = kk0 * __expf(-cu0), kd1 = kk1 * __expf(-cu1);
                        k2a[i] = kk0 * __expf(last.x - cu0); k2b[i] = kk1 * __expf(last.y - cu1);
                        const int tl = pw * 8 + i;
                        *(unsigned*)(bufp + HG_QD_OFF + tl * HG_ROW + d0 * 2) = pack2(q0, q1);
                        *(unsigned*)(bufp + HG_KD_OFF + tl * HG_ROW + d0 * 2) = pack2(kd0, kd1);
                    }
                    uint4 a, bq, va, vb;
                    a.x = pack2(k2a[0], k2a[1]); a.y = pack2(k2a[2], k2a[3]); a.z = pack2(k2a[4], k2a[5]); a.w = pack2(k2a[6], k2a[7]);
                    bq.x = pack2(k2b[0], k2b[1]); bq.y = pack2(k2b[2], k2b[3]); bq.z = pack2(k2b[4], k2b[5]); bq.w = pack2(k2b[6], k2b[7]);
                    va.x = (vv[0] & 0xffffu) | (vv[1] << 16); va.y = (vv[2] & 0xffffu) | (vv[3] << 16); va.z = (vv[4] & 0xffffu) | (vv[5] << 16); va.w = (vv[6] & 0xffffu) | (vv[7] << 16);
                    vb.x = (vv[0] >> 16) | (vv[1] & 0xffff0000u); vb.y = (vv[2] >> 16) | (vv[3] & 0xffff0000u); vb.z = (vv[4] >> 16) | (vv[5] & 0xffff0000u); vb.w = (vv[6] >> 16) | (vv[7] & 0xffff0000u);
                    *(uint4*)(bufp + HG_K2T_OFF + d0 * HG_TROW + pw * 16) = a;
                    *(uint4*)(bufp + HG_K2T_OFF + (d0 + 1) * HG_TROW + pw * 16) = bq;
                    *(uint4*)(bufp + HG_VT_OFF + d0 * HG_TROW + pw * 16) = va;
                    *(uint4*)(bufp + HG_VT_OFF + (d0 + 1) * HG_TROW + pw * 16) = vb;
                    __builtin_amdgcn_sched_barrier(0);
                    if (c + 1 < SEQ / 32) {
                        const size_t gn = gbase + (size_t)(c + 1) * 32 * 1024;
#pragma unroll
                        for (int i = 0; i < 8; ++i) {
                            qv[i] = *(const unsigned*)(QH + gn + (size_t)i * 1024 + d0);
                            vv[i] = *(const unsigned*)(V + gn + (size_t)i * 1024 + d0);
                        }
                    }
                    if (c + 2 < SEQ / 32) {
                        const size_t gn = gbase + (size_t)(c + 2) * 32 * 1024;
                        if (c & 1) {
#pragma unroll
                            for (int i = 0; i < 8; ++i) lfB[i] = *(const unsigned*)(LF + gn + (size_t)i * 1024 + d0);
                        } else {
#pragma unroll
                            for (int i = 0; i < 8; ++i) lfA[i] = *(const unsigned*)(LF + gn + (size_t)i * 1024 + d0);
                        }
                    }
                }
            } else if (c >= 1) {
                const int cc = c - 1;
                const char* bufp = lds + (cc & 1) * HG_BUF;
                const float* dec = (const float*)(bufp + HG_DEC_OFF);
                f32x16 X;
#pragma unroll
                for (int r = 0; r < 16; ++r) X[r] = 0.f;
                {
                    const char* ka = bufp + HG_KD_OFF + l31 * HG_ROW + 16 * h2;
                    const char* qa = bufp + HG_QD_OFF + l31 * HG_ROW + 16 * h2;
#pragma unroll 2
                    for (int ks = 0; ks < 8; ++ks) X = MFMA32(*(const bf16x8*)(ka + 32 * ks), *(const bf16x8*)(qa + 32 * ks), X);
#pragma unroll
                    for (int r = 0; r < 16; ++r) { const int srow = (r & 3) + 8 * (r >> 2) + 4 * h2; X[r] = (srow <= l31) ? X[r] : 0.f; }
                }
                f32x16 Oa;
#pragma unroll
                for (int r = 0; r < 16; ++r) Oa[r] = 0.f;
                const int jrow = 32 * pw + l31;
#pragma unroll
                for (int s2 = 0; s2 < 2; ++s2) {
                    uint4 xk;
                    xk.x = pack2(X[8 * s2], X[8 * s2 + 1]); xk.y = pack2(X[8 * s2 + 2], X[8 * s2 + 3]); xk.z = pack2(X[8 * s2 + 4], X[8 * s2 + 5]); xk.w = pack2(X[8 * s2 + 6], X[8 * s2 + 7]);
                    const char* va = bufp + HG_VT_OFF + jrow * HG_TROW + (16 * s2 + 4 * h2) * 2;
                    const uint2 lo = *(const uint2*)va, hi = *(const uint2*)(va + 16);
                    uint4 vb; vb.x = lo.x; vb.y = lo.y; vb.z = hi.x; vb.w = hi.y;
                    Oa = MFMA32(__builtin_bit_cast(bf16x8, xk), __builtin_bit_cast(bf16x8, vb), Oa);
                }
                auto qs_term = [&](const f32x16& St, int dt) {
#pragma unroll
                    for (int s2 = 0; s2 < 2; ++s2) {
                        uint4 sk;
                        sk.x = pack2(St[8 * s2], St[8 * s2 + 1]); sk.y = pack2(St[8 * s2 + 2], St[8 * s2 + 3]); sk.z = pack2(St[8 * s2 + 4], St[8 * s2 + 5]); sk.w = pack2(St[8 * s2 + 6], St[8 * s2 + 7]);
                        const char* qa = bufp + HG_QD_OFF + l31 * HG_ROW + (32 * dt + 16 * s2 + 4 * h2) * 2;
                        const uint2 lo = *(const uint2*)qa, hi = *(const uint2*)(qa + 16);
                        uint4 qb; qb.x = lo.x; qb.y = lo.y; qb.z = hi.x; qb.w = hi.y;
                        Oa = MFMA32(__builtin_bit_cast(bf16x8, qb), __builtin_bit_cast(bf16x8, sk), Oa);
                    }
                };
                __builtin_amdgcn_sched_barrier(0);
                qs_term(S0, 0); qs_term(S1, 1);
                __builtin_amdgcn_sched_barrier(0);
                qs_term(S2, 2); qs_term(S3, 3);
                __builtin_amdgcn_sched_barrier(0);
                {
                    bf16_t* orow = OR + (size_t)(b * SEQ + cc * 32 + 4 * h2) * 1024 + h * 128 + jrow;
#pragma unroll
                    for (int r = 0; r < 16; ++r) orow[(size_t)((r & 3) + 8 * (r >> 2)) * 1024] = f2bf(Oa[r]);
                }
                auto s_update = [&](f32x16& St, int dt) {
#pragma unroll
                    for (int rq = 0; rq < 4; ++rq) {
                        const f32x4 dc = *(const f32x4*)(dec + 32 * dt + 8 * rq + 4 * h2);
                        St[4 * rq] *= dc[0]; St[4 * rq + 1] *= dc[1]; St[4 * rq + 2] *= dc[2]; St[4 * rq + 3] *= dc[3];
                    }
#pragma unroll
                    for (int s2 = 0; s2 < 2; ++s2) {
                        const bf16x8 ka = *(const bf16x8*)(bufp + HG_K2T_OFF + (32 * dt + l31) * HG_TROW + (16 * s2 + 8 * h2) * 2);
                        const bf16x8 vb = *(const bf16x8*)(bufp + HG_VT_OFF + jrow * HG_TROW + (16 * s2 + 8 * h2) * 2);
                        St = MFMA32(ka, vb, St);
                    }
                };
                __builtin_amdgcn_sched_barrier(0);
                s_update(S0, 0); s_update(S1, 1);
                __builtin_amdgcn_sched_barrier(0);
                s_update(S2, 2); s_update(S3, 3);
                __builtin_amdgcn_sched_barrier(0);
            }
            __syncthreads();
        }
    }
}

__device__ __forceinline__ void phase_hgrn_post(const Params& p, const Ctx& cx) {
    const int lane = cx.lane;
    const bf16_t* OR = (const bf16_t*)(p.ws + OFF_HA);
    const bf16_t* Gt = (const bf16_t*)(p.ws + OFF_G);
    bf16_t* OA = (bf16_t*)(p.ws + OFF_QH);
    const int col = lane * 16;
    float gn[16];
#pragma unroll
    for (int i = 0; i < 16; ++i) gn[i] = p.hgrn_out_gain[(col & 127) + i];
    for (int row = cx.vbid * NWAVE + cx.wid; row < NTOK; row += cx.G * NWAVE) {
        const uint4 a0 = *(const uint4*)(OR + (size_t)row * 1024 + col), a1 = *(const uint4*)(OR + (size_t)row * 1024 + col + 8);
        const uint4 g0 = *(const uint4*)(Gt + (size_t)row * 1024 + col), g1 = *(const uint4*)(Gt + (size_t)row * 1024 + col + 8);
        const unsigned aw[8] = {a0.x, a0.y, a0.z, a0.w, a1.x, a1.y, a1.z, a1.w};
        const unsigned gw[8] = {g0.x, g0.y, g0.z, g0.w, g1.x, g1.y, g1.z, g1.w};
        float o[16];
        float ss = 0.f;
#pragma unroll
        for (int i = 0; i < 8; ++i) { o[2 * i] = bf2f((unsigned short)(aw[i] & 0xffff)); o[2 * i + 1] = bf2f((unsigned short)(aw[i] >> 16)); ss += o[2 * i] * o[2 * i] + o[2 * i + 1] * o[2 * i + 1]; }
        ss += __shfl_xor(ss, 1); ss += __shfl_xor(ss, 2); ss += __shfl_xor(ss, 4);
        const float r = rsqrtf(ss * (1.f / 128.f) + EPS);
        unsigned w[8];
#pragma unroll
        for (int i = 0; i < 8; ++i)
            w[i] = pack2(o[2 * i] * r * gn[2 * i] * bf2f((unsigned short)(gw[i] & 0xffff)), o[2 * i + 1] * r * gn[2 * i + 1] * bf2f((unsigned short)(gw[i] >> 16)));
        uint4 o0, o1; o0.x = w[0]; o0.y = w[1]; o0.z = w[2]; o0.w = w[3]; o1.x = w[4]; o1.y = w[5]; o1.z = w[6]; o1.w = w[7];
        *(uint4*)(OA + (size_t)row * 1024 + col) = o0;
        *(uint4*)(OA + (size_t)row * 1024 + col + 8) = o1;
    }
}


#define XB_TMO      128
#define XB_XCNT(j)  (256  + 64 * (j))
#define XB_XSUB(j)  (1280 + 64 * (j))
#define XB_XGEN(j)  (2304 + 64 * (j))
#define XB_TOP      3328
#define XB_TOPGEN   3392
#define XCD_BAR_WORDS 3456
#define XB_SPIN_CAP (1u << 20)
#define LAS __attribute__((address_space(3)))
__device__ __forceinline__ unsigned xb_ld(unsigned* p)              { return __hip_atomic_load(p, __ATOMIC_RELAXED, __HIP_MEMORY_SCOPE_AGENT); }
__device__ __forceinline__ unsigned xb_add(unsigned* p, unsigned v) { return __hip_atomic_fetch_add(p, v, __ATOMIC_RELAXED, __HIP_MEMORY_SCOPE_AGENT); }
__device__ __forceinline__ unsigned xb_xcc_id() { return (unsigned)__builtin_amdgcn_s_getreg((3 << 11) | 20) & 0xFu; }
#define XB_SPIN(cond, bar) do { unsigned _sp = 0; while (cond) { __builtin_amdgcn_s_sleep(1); \
    if ((++_sp & 255u) == 0u) { if (xb_ld(&(bar)[XB_TMO])) break; if (_sp > XB_SPIN_CAP) { atomicAdd(&(bar)[XB_TMO], 1u); break; } } } } while (0)
struct XcdBarrier { unsigned* bar; unsigned x; volatile unsigned* st; };
__device__ __forceinline__ XcdBarrier xcd_barrier_post(unsigned* bar, volatile unsigned* st) {
    XcdBarrier b; b.bar = bar; b.x = xb_xcc_id(); b.st = st;
    if (threadIdx.x == 0) (void)xb_add(&bar[XB_XCNT(b.x)], 1u);
    return b;
}
__device__ __forceinline__ void xcd_barrier_complete(unsigned* bar, unsigned x, unsigned& nloc, unsigned& nx) {
    const unsigned G = gridDim.x * gridDim.y * gridDim.z;
    unsigned sum, cnt, mine, sp = 0u;
    for (;;) {
        sum = 0u; cnt = 0u; mine = 0u;
#pragma unroll
        for (unsigned j = 0; j < 16; ++j) { const unsigned c = xb_ld(&bar[XB_XCNT(j)]); sum += c; cnt += (c > 0u) ? 1u : 0u; mine = (j == x) ? c : mine; }
        if (sum == G) break;
        __builtin_amdgcn_s_sleep(1);
        if ((++sp & 255u) == 0u) { if (xb_ld(&bar[XB_TMO])) break; if (sp > XB_SPIN_CAP) { atomicAdd(&bar[XB_TMO], 1u); break; } }
    }
    nloc = mine > 0u ? mine : 1u; nx = cnt > 0u ? cnt : 1u;
}
__device__ __forceinline__ void xcd_barrier(const XcdBarrier& b) {
    asm volatile("s_waitcnt vmcnt(0)" ::: "memory");
    __syncthreads();
    if (threadIdx.x == 0) {
        unsigned* bar = b.bar;
        __builtin_amdgcn_s_waitcnt(0);
        unsigned nloc = b.st[0], nx = b.st[1];
        if (nloc == 0u) { xcd_barrier_complete(bar, b.x, nloc, nx); b.st[0] = nloc; b.st[1] = nx; }
        const unsigned old = xb_add(&bar[XB_XSUB(b.x)], 1u);
        const unsigned gen = old / nloc;
        if (old + 1u == (gen + 1u) * nloc) {
            __builtin_amdgcn_fence(__ATOMIC_RELEASE, "agent");
            asm volatile("s_waitcnt vmcnt(0)" ::: "memory");
            const unsigned og = xb_add(&bar[XB_TOP], 1u);
            const unsigned tg = og / nx;
            if (og + 1u == (tg + 1u) * nx) xb_add(&bar[XB_TOPGEN], 1u);
            else XB_SPIN(xb_ld(&bar[XB_TOPGEN]) == tg, bar);
            __builtin_amdgcn_fence(__ATOMIC_ACQUIRE, "agent");
            xb_add(&bar[XB_XGEN(b.x)], 1u);
            asm volatile("s_waitcnt vmcnt(0)" ::: "memory");
        } else {
            XB_SPIN(xb_ld(&bar[XB_XGEN(b.x)]) == gen, bar);
            __builtin_amdgcn_fence(__ATOMIC_ACQUIRE, "agent");
            asm volatile("s_waitcnt vmcnt(0)" ::: "memory");
        }
    }
    __syncthreads();
}

template <int PH>
__device__ __forceinline__ void run_phase(const Params& p, const Ctx& cx, char* lds) {
    if constexpr (PH == 0) phase0(p, cx, lds);
    else if constexpr (PH == 1) rows_phase<false, true, false>(p, cx, lds, p.x, nullptr, 0, 0, 0, 0);
    else if constexpr (PH == 2) phase_nsa_inproj(p, cx, lds);
    else if constexpr (PH == 3) {
        phase_cmp1(p, cx, lds);
        const int w = cx.vbid >= 64 ? cx.vbid - 64 : -1, nw = cx.G - 64;
        transpose_range(p, lds, cx.tid, w, nw, TC2, TC4);
        transpose_range(p, lds, cx.tid, w, nw, TC5, TC_UP1);
        transpose_range(p, lds, cx.tid, w, nw, TC6, TC_DN1);
    }
    else if constexpr (PH == 4) phase_cmp2(p, cx);
    else if constexpr (PH == 5) phase_attn(p, cx, lds);
    else if constexpr (PH == 6) phase_outproj8(p, cx, lds, (const bf16_t*)(p.ws + OFF_HA), (const bf16_t*)(p.ws + OFF_W_NSA_OUT), p.x, 0);
    else if constexpr (PH == 7) rows_router_phase(p, cx, lds, p.out, 1, 0);
    else if constexpr (PH == 8) phase_moe_up(p, cx, lds, 0);
    else if constexpr (PH == 9) phase_moe_down(p, cx, lds, 0);
    else if constexpr (PH == 10) { float* xo = p.out; asm volatile("" : "+s"(xo)); rows_phase<true, true, false>(p, cx, lds, xo, xo, 1, 2, 0, 0); }
    else if constexpr (PH == 11) phase_hgrn_inproj8(p, cx, lds);
    else if constexpr (PH == 12) {
        phase_hgrn_rec(p, cx, lds);
        const int w = (int)blockIdx.x >= 128 ? (int)blockIdx.x - 128 : -1, nw = cx.G - 128;
        transpose_range(p, lds, cx.tid, w, nw, TC_UP1, TC6);
        transpose_range(p, lds, cx.tid, w, nw, TC_DN1, TC_END);
    }
    else if constexpr (PH == 13) phase_hgrn_post(p, cx);
    else if constexpr (PH == 14) phase_outproj8(p, cx, lds, (const bf16_t*)(p.ws + OFF_QH), (const bf16_t*)(p.ws + OFF_W_HG_OUT), p.out, 2);
    else if constexpr (PH == 15) rows_router_phase(p, cx, lds, p.out, 3, 1);
    else if constexpr (PH == 16) phase_moe_up(p, cx, lds, 1);
    else if constexpr (PH == 17) phase_moe_down(p, cx, lds, 1);
    else if constexpr (PH == 18) { float* xo = p.out; asm volatile("" : "+s"(xo)); rows_phase<true, false, false>(p, cx, lds, xo, xo, 3, 0, 0, 1); }
}

__device__ __forceinline__ Ctx make_ctx() {
    Ctx cx;
    cx.G = gridDim.x; cx.tid = threadIdx.x; cx.wid = threadIdx.x >> 6; cx.lane = threadIdx.x & 63;
    cx.vbid = (cx.G % 8 == 0) ? (blockIdx.x % 8) * (cx.G / 8) + blockIdx.x / 8 : blockIdx.x;
    return cx;
}

#if MULTI_LAUNCH
template <int PH>
__global__ void __launch_bounds__(NTHR, 2) phase_kernel(Params p) {
    extern __shared__ __attribute__((aligned(16))) char lds[];
    const Ctx cx = make_ctx();
    run_phase<PH>(p, cx, lds);
}
template <int PH>
static void launch_phases(const Params& p, int grid, hipStream_t stream) {
    (void)hipFuncSetAttribute((const void*)phase_kernel<PH>, hipFuncAttributeMaxDynamicSharedMemorySize, LDS_BYTES);
    hipLaunchKernelGGL(phase_kernel<PH>, dim3(grid), dim3(NTHR), LDS_BYTES, stream, p);
    if constexpr (PH + 1 < NPHASE) launch_phases<PH + 1>(p, grid, stream);
}
#else
template <int PH>
__device__ __forceinline__ void run_from(const Params& p, const Ctx& cx, char* lds, cg::grid_group& grid, const XcdBarrier& xb) {
    {
        int t_ = threadIdx.x, b_ = blockIdx.x;
        asm volatile("" : "+v"(t_), "+s"(b_));
        Ctx c2;
        c2.G = gridDim.x; c2.tid = t_; c2.wid = t_ >> 6; c2.lane = t_ & 63;
        c2.vbid = (c2.G % 8 == 0) ? (b_ % 8) * (c2.G / 8) + b_ / 8 : b_;
        run_phase<PH>(p, c2, lds);
#ifdef PROBE_MASK
        if constexpr ((PROBE_MASK >> PH) & 1) { xcd_barrier(xb); run_phase<PH>(p, c2, lds); }
#endif
    }
    if constexpr (PH + 1 < NPHASE) {
        if constexpr (PH == 0) grid.sync();
        else xcd_barrier(xb);
        run_from<PH + 1>(p, cx, lds, grid, xb);
    }
}
__global__ void __launch_bounds__(NTHR, 2) mega_kernel(Params p) {
    extern __shared__ __attribute__((aligned(16))) char lds[];
    cg::grid_group grid = cg::this_grid();
    const Ctx cx = make_ctx();
    volatile unsigned* st = (volatile unsigned*)(lds + LDS_BYTES - 16);
    if (threadIdx.x == 0) { st[0] = 0u; st[1] = 0u; }
    __syncthreads();
    const XcdBarrier xb = xcd_barrier_post((unsigned*)(p.ws + OFF_BAR), st);
    run_from<0>(p, cx, lds, grid, xb);
}
#endif

extern "C" void kernel_launch(void* const* d_in, const int* in_sizes, int n_in, void* d_out, int out_size, void* d_ws, size_t ws_size,
                              hipStream_t stream) {
    static int grid = 0;
    if (!grid) {
        int dev = 0, cus = 0, per_cu = 0;
        (void)hipGetDevice(&dev);
        (void)hipDeviceGetAttribute(&cus, hipDeviceAttributeMultiprocessorCount, dev);
#if MULTI_LAUNCH
        per_cu = 1;
#else
        (void)hipFuncSetAttribute((const void*)mega_kernel, hipFuncAttributeMaxDynamicSharedMemorySize, LDS_BYTES);
        (void)hipOccupancyMaxActiveBlocksPerMultiprocessor(&per_cu, mega_kernel, NTHR, LDS_BYTES);
        if (per_cu > 1) per_cu = 1;
        if (per_cu < 1) { fprintf(stderr, "kernel_launch: occupancy query says 0 blocks per CU (LDS %d B)\n", LDS_BYTES); per_cu = 1; }
#endif
        if (cus <= 0) cus = 256;
        grid = cus * per_cu;
        if (ws_size < WS_NEED) fprintf(stderr, "kernel_launch: workspace too small: %zu < %zu\n", ws_size, (size_t)WS_NEED);
    }
    Params p{};
    p.x = (const float*)d_in[0]; p.c = (const float*)d_in[1]; p.ada_w = (const float*)d_in[2]; p.ada_b = (const float*)d_in[3];
    p.norm_g = (const float*)d_in[4]; p.rel_bias = (const float*)d_in[5]; p.nsa_w_in = (const float*)d_in[6]; p.nsa_q_gain = (const float*)d_in[7];
    p.nsa_k_gain = (const float*)d_in[8]; p.nsa_cmp_pe = (const float*)d_in[9]; p.nsa_cmp_w1 = (const float*)d_in[10]; p.nsa_cmp_w2 = (const float*)d_in[11];
    p.nsa_w_out = (const float*)d_in[12]; p.hgrn_w_in = (const float*)d_in[13]; p.hgrn_lb = (const float*)d_in[14]; p.hgrn_out_gain = (const float*)d_in[15];
    p.hgrn_w_out = (const float*)d_in[16]; p.moe_rg = (const float*)d_in[17]; p.moe_re = (const float*)d_in[18]; p.moe_w1 = (const float*)d_in[19];
    p.moe_w3 = (const float*)d_in[20]; p.moe_w2 = (const float*)d_in[21];
    p.out = (float*)d_out; p.ws = (char*)d_ws;
#if MULTI_LAUNCH
    launch_phases<0>(p, grid, stream);
#else
    p.p_begin = 0; p.p_end = NPHASE;
    (void)hipMemsetAsync((char*)d_ws + OFF_BAR, 0, XCD_BAR_WORDS * 4, stream);
    void* args[] = {&p};
    hipError_t e = hipLaunchCooperativeKernel((void*)mega_kernel, dim3(grid), dim3(NTHR), args, LDS_BYTES, stream);
    if (e != hipSuccess) fprintf(stderr, "cooperative launch failed: %s (grid %d)\n", hipGetErrorString(e), grid);
#endif
}
```

```cpp
#include <hip/hip_runtime.h>
#include <hip/hip_cooperative_groups.h>
#include <cstdio>
#include <cstdint>
namespace cg = cooperative_groups;

#ifndef MULTI_LAUNCH
#define MULTI_LAUNCH 0
#endif

typedef unsigned short bf16_t;
typedef short bf16x8 __attribute__((ext_vector_type(8)));
typedef float f32x4 __attribute__((ext_vector_type(4)));
typedef float f32x16 __attribute__((ext_vector_type(16)));

constexpr int NTOK = 32768, DM = 1024, SEQ = 2048, NBATCH = 16;
constexpr int NSA_IN = 2608, NSA_IN_PAD = 2816;
constexpr float EPS = 1e-6f;
constexpr size_t MiB = 1ull << 20;

constexpr size_t OFF_CNT = 0;
constexpr size_t OFF_MOD = 4096;
constexpr size_t OFF_LB = OFF_MOD + 786432;
constexpr size_t OFF_PEB = OFF_LB + 4096;
constexpr size_t OFF_BAR = 921600;
constexpr size_t OFF_W_NSA_IN = 1 * MiB;
constexpr size_t OFF_W_NSA_OUT = OFF_W_NSA_IN + 2816ull * 1024 * 2;
constexpr size_t OFF_W_HG_IN = OFF_W_NSA_OUT + 1024ull * 1024 * 2;
constexpr size_t OFF_W_HG_OUT = OFF_W_HG_IN + 4096ull * 1024 * 2;
constexpr size_t OFF_W_CMP1 = OFF_W_HG_OUT + 1024ull * 1024 * 2;
constexpr size_t OFF_W_UP = OFF_W_CMP1 + 2ull * 128 * 2048 * 2;
constexpr size_t OFF_W_DN = OFF_W_UP + 32ull * 1024 * 1024 * 2;
constexpr size_t OFF_W_END = OFF_W_DN + 32ull * 1024 * 512 * 2;
constexpr size_t OFF_HA = 116 * MiB;
static_assert(OFF_W_END <= OFF_HA, "weights overflow");
constexpr size_t OFF_SCR = 180 * MiB;
constexpr size_t OFF_Q = OFF_SCR;
constexpr size_t OFF_KCRAW = OFF_Q + 64 * MiB;
constexpr size_t OFF_VCRAW = OFF_KCRAW + 17 * MiB;
constexpr size_t OFF_KS = OFF_VCRAW + 17 * MiB;
constexpr size_t OFF_VS = OFF_KS + 16 * MiB;
constexpr size_t OFF_KW = OFF_VS + 16 * MiB;
constexpr size_t OFF_VW = OFF_KW + 16 * MiB;
constexpr size_t OFF_GATES = OFF_VW + 16 * MiB;
constexpr size_t OFF_T1 = OFF_GATES + 6 * MiB;
constexpr size_t OFF_KC = OFF_T1 + 4 * MiB;
constexpr size_t OFF_VC = OFF_KC + 1 * MiB;
constexpr size_t OFF_H1 = OFF_SCR;
constexpr size_t OFF_Y = OFF_H1 + 64 * MiB;
constexpr size_t OFF_LTOK = OFF_Y + 128 * MiB;
constexpr size_t OFF_LW = OFF_LTOK + 2 * MiB;
constexpr size_t OFF_TSLOT = OFF_LW + 2 * MiB;
constexpr size_t OFF_QH = OFF_SCR;
constexpr size_t OFF_LF = OFF_QH + 64 * MiB;
constexpr size_t OFF_V = OFF_LF + 128 * MiB;
constexpr size_t OFF_G = OFF_V + 64 * MiB;
constexpr size_t WS_NEED = OFF_G + 64 * MiB;
static_assert(WS_NEED <= 512 * MiB, "ws overflow");

constexpr int NTHR = 512, NWAVE = 8;
constexpr int GEMM_STAGE = 49152, GEMM_NSTAGE = 3;
constexpr int LDS_TAB_OFF = GEMM_STAGE * GEMM_NSTAGE;
constexpr int LDS_BYTES = LDS_TAB_OFF + 256 + 16;
constexpr int NPHASE = 19;

struct Params {
    const float *x, *c, *ada_w, *ada_b, *norm_g, *rel_bias, *nsa_w_in, *nsa_q_gain, *nsa_k_gain, *nsa_cmp_pe, *nsa_cmp_w1,
        *nsa_cmp_w2, *nsa_w_out, *hgrn_w_in, *hgrn_lb, *hgrn_out_gain, *hgrn_w_out, *moe_rg, *moe_re, *moe_w1, *moe_w3, *moe_w2;
    float* out;
    char* ws;
    int p_begin, p_end;
};

__device__ __forceinline__ float bf2f(unsigned short h) { return __uint_as_float((unsigned)h << 16); }
__device__ __forceinline__ unsigned short f2bf(float f) {
    unsigned u = __float_as_uint(f);
    u += 0x7fffu + ((u >> 16) & 1u);
    return (unsigned short)(u >> 16);
}
typedef __bf16 bf2_t __attribute__((ext_vector_type(2)));
typedef float f2_t __attribute__((ext_vector_type(2)));
__device__ __forceinline__ unsigned pack2(float a, float b) {
    f2_t v = {a, b};
    return __builtin_bit_cast(unsigned, __builtin_convertvector(v, bf2_t));
}
typedef _Float16 h2_t __attribute__((ext_vector_type(2)));
__device__ __forceinline__ unsigned packh2(float a, float b) { f2_t v = {a, b}; return __builtin_bit_cast(unsigned, __builtin_convertvector(v, h2_t)); }
__device__ __forceinline__ f2_t unpackh2(unsigned u) { return __builtin_convertvector(__builtin_bit_cast(h2_t, u), f2_t); }
__device__ __forceinline__ float wave_sum(float v) {
#pragma unroll
    for (int o = 32; o; o >>= 1) v += __shfl_xor(v, o);
    return v;
}
__device__ __forceinline__ float wave_max(float v) {
#pragma unroll
    for (int o = 32; o; o >>= 1) v = fmaxf(v, __shfl_xor(v, o));
    return v;
}
__device__ __forceinline__ float silu_f(float x) { return x * __builtin_amdgcn_rcpf(1.f + __builtin_amdgcn_exp2f(-1.4426950408889634f * x)); }
__device__ __forceinline__ float sigmoid_f(float x) { return __builtin_amdgcn_rcpf(1.f + __builtin_amdgcn_exp2f(-1.4426950408889634f * x)); }
__device__ __forceinline__ void glds16(const void* g, void* l) {
    __builtin_amdgcn_global_load_lds((const unsigned*)g, (unsigned*)l, 16, 0, 0);
}
__device__ __forceinline__ int t5_bucket(int n) {
    if (n < 16) return n;
    int b = 16;
    b += (n >= 21); b += (n >= 27); b += (n >= 35); b += (n >= 46); b += (n >= 59); b += (n >= 77); b += (n >= 99); b += (n >= 128);
    b += (n >= 166); b += (n >= 216); b += (n >= 280); b += (n >= 363); b += (n >= 470); b += (n >= 609); b += (n >= 790);
    return b;
}

struct Ctx {
    int G, vbid, tid, wid, lane;
};

constexpr int P0_MOD_ITEMS = 192;
constexpr int TS0 = 88 * 16, TS1 = 32 * 16, TS2 = 128 * 16, TS3 = 32 * 16, TS4 = 2 * 4 * 32, TS5 = 32 * 32 * 16, TS6 = 32 * 32 * 8;
constexpr int TC0 = 0, TC1 = TC0 + TS0, TC2 = TC1 + TS1, TC3 = TC2 + TS2, TC4 = TC3 + TS3, TC5 = TC4 + TS4, TC6 = TC5 + TS5, TC_END = TC6 + TS6;

struct TrJob { const float* src; int ld, c0, ncols_valid, k0; bf16_t* dst; int dstld; int perm; };
__device__ __forceinline__ int pcol(int n, int fq) { return (n >> 1) * 32 + fq * 8 + (n & 1) * 4; }
__device__ __forceinline__ void tr_load(const TrJob& j, float* tl, int htid) {
    const int k = htid >> 2, cc = (htid & 3) * 8;
    const float* s = j.src + (size_t)(j.k0 + k) * j.ld + j.c0 + cc;
    f32x4 a = {0.f, 0.f, 0.f, 0.f}, c = a;
    if (j.c0 + 32 <= j.ncols_valid) { a = *(const f32x4*)s; c = *(const f32x4*)(s + 4); }
    else {
#pragma unroll
        for (int i = 0; i < 4; ++i) { if (j.c0 + cc + i < j.ncols_valid) a[i] = s[i]; if (j.c0 + cc + 4 + i < j.ncols_valid) c[i] = s[4 + i]; }
    }
#pragma unroll
    for (int i = 0; i < 4; ++i) { tl[k * 33 + cc + i] = a[i]; tl[k * 33 + cc + 4 + i] = c[i]; }
}
__device__ __forceinline__ void tr_store(const TrJob& j, const float* tl, int htid) {
    const int nsrc = htid >> 3, kc = (htid & 7) * 8;
    const int n = nsrc;
    const int nd = j.perm ? (((nsrc >> 2) & 1) * 16 + (nsrc >> 3) * 4 + (nsrc & 3)) : nsrc;
    uint4 o;
    o.x = pack2(tl[(kc + 0) * 33 + n], tl[(kc + 1) * 33 + n]); o.y = pack2(tl[(kc + 2) * 33 + n], tl[(kc + 3) * 33 + n]);
    o.z = pack2(tl[(kc + 4) * 33 + n], tl[(kc + 5) * 33 + n]); o.w = pack2(tl[(kc + 6) * 33 + n], tl[(kc + 7) * 33 + n]);
    *(uint4*)(j.dst + (size_t)nd * j.dstld + kc) = o;
}
__device__ __forceinline__ TrJob tr_job(const Params& p, int tt) {
    TrJob j;
    if (tt < TC1) {
        const int nt = tt / 16, kt = tt % 16;
        j = {p.nsa_w_in, NSA_IN, nt * 32, NSA_IN, kt * 64, (bf16_t*)(p.ws + OFF_W_NSA_IN) + (size_t)nt * 32 * 1024 + kt * 64, 1024, 1};
    } else if (tt < TC2) {
        const int u = tt - TC1, nt = u / 16, kt = u % 16;
        j = {p.nsa_w_out, 1024, nt * 32, 1024, kt * 64, (bf16_t*)(p.ws + OFF_W_NSA_OUT) + (size_t)nt * 32 * 1024 + kt * 64, 1024, 1};
    } else if (tt < TC3) {
        const int u = tt - TC2, nt = u / 16, kt = u % 16;
        j = {p.hgrn_w_in, 4096, nt * 32, 4096, kt * 64, (bf16_t*)(p.ws + OFF_W_HG_IN) + (size_t)nt * 32 * 1024 + kt * 64, 1024, 1};
    } else if (tt < TC4) {
        const int u = tt - TC3, nt = u / 16, kt = u % 16;
        j = {p.hgrn_w_out, 1024, nt * 32, 1024, kt * 64, (bf16_t*)(p.ws + OFF_W_HG_OUT) + (size_t)nt * 32 * 1024 + kt * 64, 1024, 1};
    } else if (tt < TC5) {
        const int u = tt - TC4, kv = u / 128, r = u % 128, nt = r / 32, kt = r % 32;
        j = {p.nsa_cmp_w1 + (size_t)kv * 2048 * 64, 64, nt * 32, 64, kt * 64, (bf16_t*)(p.ws + OFF_W_CMP1) + ((size_t)kv * 128 + nt * 32) * 2048 + kt * 64, 2048, 0};
    } else if (tt < TC6) {
        const int u = tt - TC5, le = u / 512, r = u % 512, gr = r / 16, kt = r % 16;
        const int t = gr >> 2, wc = (gr >> 1) & 1, which = gr & 1;
        const float* src = (which ? p.moe_w3 : p.moe_w1) + (size_t)le * 1024 * 512;
        j = {src, 512, (t * 2 + wc) * 32, 512, kt * 64, (bf16_t*)(p.ws + OFF_W_UP) + ((size_t)le * 1024 + gr * 32) * 1024 + kt * 64, 1024, 1};
    } else {
        const int u = tt - TC6, le = u / 256, r = u % 256, nt = r / 8, kt = r % 8;
        j = {p.moe_w2 + (size_t)le * 512 * 1024, 1024, nt * 32, 1024, kt * 64, (bf16_t*)(p.ws + OFF_W_DN) + ((size_t)le * 1024 + nt * 32) * 512 + kt * 64, 512, 1};
    }
    return j;
}

__device__ __forceinline__ void transpose_range(const Params& p, char* lds, int tid, int worker, int nworkers, int lo, int hi) {
    if (worker < 0) return;
    constexpr int TPH = 4;
    const int half = tid >> 8, htid = tid & 255;
    float* tl = (float*)lds + half * (TPH * 64 * 33);
    for (int base = lo + worker * 2 * TPH; base < hi; base += nworkers * 2 * TPH) {
#pragma unroll
        for (int q = 0; q < TPH; ++q) {
            const int tt = base + half * TPH + q;
            if (tt < hi) { const TrJob j = tr_job(p, tt); tr_load(j, tl + q * (64 * 33), htid); }
        }
        __syncthreads();
#pragma unroll
        for (int q = 0; q < TPH; ++q) {
            const int tt = base + half * TPH + q;
            if (tt < hi) { const TrJob j = tr_job(p, tt); tr_store(j, tl + q * (64 * 33), htid); }
        }
        __syncthreads();
    }
}
constexpr int TC_UP1 = TC5 + 16 * 512, TC_DN1 = TC6 + 16 * 256;

__device__ __forceinline__ void phase0(const Params& p, const Ctx& cx, char* lds) {
    const int tid = cx.tid, wid = cx.wid, lane = cx.lane;
    for (int it = cx.vbid; it < P0_MOD_ITEMS; it += cx.G) {
        const int colbase = it * 64, ls = colbase / 3072, e0 = colbase % 3072;
        const float* W = p.ada_w + (size_t)ls * 1024 * 3072 + e0 + lane;
        float* cs = (float*)lds + wid * 1024;
        float* red = (float*)lds + 8192;
        float acc[16];
#pragma unroll
        for (int b = 0; b < 16; ++b) acc[b] = 0.f;
        for (int sub = 0; sub < 2; ++sub) {
            const int kb = wid * 128 + sub * 64;
#pragma unroll
            for (int b = 0; b < 16; ++b) cs[lane * 16 + b] = silu_f(p.c[b * 1024 + kb + lane]);
            __builtin_amdgcn_wave_barrier();
#pragma unroll 1
            for (int k16 = 0; k16 < 64; k16 += 16) {
                float wv[16];
#pragma unroll
                for (int u = 0; u < 16; ++u) wv[u] = W[(size_t)(kb + k16 + u) * 3072];
#pragma unroll
                for (int u = 0; u < 16; ++u) {
                    const float w = wv[u];
                    const f32x4* cv = (const f32x4*)(cs + (k16 + u) * 16);
#pragma unroll
                    for (int q = 0; q < 4; ++q) {
                        f32x4 c4 = cv[q];
                        acc[q * 4 + 0] += c4[0] * w; acc[q * 4 + 1] += c4[1] * w; acc[q * 4 + 2] += c4[2] * w; acc[q * 4 + 3] += c4[3] * w;
                    }
                }
            }
            __builtin_amdgcn_wave_barrier();
        }
#pragma unroll
        for (int b = 0; b < 16; ++b) red[(wid * 16 + b) * 64 + lane] = acc[b];
        __syncthreads();
        float* mod = (float*)(p.ws + OFF_MOD);
#pragma unroll
        for (int i = 0; i < 2; ++i) {
            const int o = tid + i * NTHR, b = o >> 6, e = o & 63;
            float sm = 0.f;
#pragma unroll
            for (int w = 0; w < 8; ++w) sm += red[(w * 16 + b) * 64 + e];
            mod[((size_t)ls * 16 + b) * 3072 + e0 + e] = sm + p.ada_b[ls * 3072 + e0 + e];
        }
        __syncthreads();
    }
    transpose_range(p, lds, tid, cx.vbid, cx.G, TC0, TC2);
    transpose_range(p, lds, tid, cx.vbid, cx.G, TC4, TC5);
    if (cx.vbid == cx.G - 1) {
        float* lb = (float*)(p.ws + OFF_LB);
        for (int i = tid; i < 1024; i += NTHR) lb[i] = sigmoid_f(p.hgrn_lb[1024 + i] - p.hgrn_lb[i]);
        if (tid < 128) {
            const int kv = tid >> 6, d = tid & 63;
            const float* pe = p.nsa_cmp_pe + kv * 2048;
            const float* w1 = p.nsa_cmp_w1 + (size_t)kv * 2048 * 64 + d;
            float sm = 0.f;
            for (int k = 0; k < 2048; ++k) sm += pe[k] * w1[(size_t)k * 64];
            ((float*)(p.ws + OFF_PEB))[tid] = sm;
        }
        if (tid < 32) ((int*)(p.ws + OFF_CNT))[tid] = 0;
    }
}

template <bool COMBINE, bool NORM, bool ROUTER>
__device__ __forceinline__ void rows_phase(const Params& p, const Ctx& cx, char* lds, const float* __restrict__ src, float* __restrict__ xdst,
                           int ls_comb, int ls_norm, int layer_router, int layer_comb) {
    static_assert(!ROUTER, "router rows use rows_router_phase");
    const int lane = cx.lane;
    const float* mod = (const float*)(p.ws + OFF_MOD);
    int my_off = 0;
    if (COMBINE) {
        const int* cnt = (const int*)(p.ws + OFF_CNT) + layer_comb * 16;
        int cv[15];
#pragma unroll
        for (int e = 0; e < 15; ++e) cv[e] = cnt[e];
#pragma unroll
        for (int e = 0; e < 15; ++e) my_off += (e < lane) ? cv[e] : 0;
    }
    const int rpw = (NTOK + cx.G * NWAVE - 1) / (cx.G * NWAVE);
    const int row_begin = (cx.vbid * NWAVE + cx.wid) * rpw, row_end = min(NTOK, row_begin + rpw);
    if (row_begin >= row_end) return;
    const bf16_t* Y = (const bf16_t*)(p.ws + OFF_Y);
    const int* tsl = (const int*)(p.ws + OFF_TSLOT);
    bf16_t* hA = (bf16_t*)(p.ws + OFF_HA);
    const float* gain = p.norm_g + ls_norm * 1024;
    auto yrow = [&](int sw) -> size_t { return (size_t)(__shfl(my_off, sw >> 16) + (sw & 0xffff)) * 1024; };
    f32x4 vn[4];
    uint2 yan[4], ycn[4];
    int t0n = 0, t1n = 0;
#pragma unroll
    for (int i = 0; i < 4; ++i) vn[i] = *(const f32x4*)(src + (size_t)row_begin * 1024 + (i * 64 + lane) * 4);
    if (COMBINE) {
        const size_t ra = yrow(tsl[row_begin * 2]), rc = yrow(tsl[row_begin * 2 + 1]);
#pragma unroll
        for (int i = 0; i < 4; ++i) { yan[i] = *(const uint2*)(Y + ra + (i * 64 + lane) * 4); ycn[i] = *(const uint2*)(Y + rc + (i * 64 + lane) * 4); }
        if (row_begin + 1 < row_end) { t0n = tsl[(row_begin + 1) * 2]; t1n = tsl[(row_begin + 1) * 2 + 1]; }
    }
    f32x4 gt[4], ca[4], cb[4];
    int bcur = -1;
    for (int row = row_begin; row < row_end; ++row) {
        const int b = row >> 11;
        if (b != bcur) {
            bcur = b;
#pragma unroll
            for (int i = 0; i < 4; ++i) {
                const int col = (i * 64 + lane) * 4;
                if (COMBINE) gt[i] = *(const f32x4*)(mod + ((size_t)ls_comb * 16 + b) * 3072 + 2048 + col);
                if (NORM) {
                    const float* shift = mod + ((size_t)ls_norm * 16 + b) * 3072;
                    const f32x4 g = *(const f32x4*)(gain + col), sc = *(const f32x4*)(shift + 1024 + col);
                    ca[i] = g * (sc + 1.f);
                    cb[i] = *(const f32x4*)(shift + col);
                }
            }
        }
        f32x4 v[4];
        uint2 ya[4], yc[4];
#pragma unroll
        for (int i = 0; i < 4; ++i) { v[i] = vn[i]; if (COMBINE) { ya[i] = yan[i]; yc[i] = ycn[i]; } }
        if (row + 1 < row_end) {
#pragma unroll
            for (int i = 0; i < 4; ++i) vn[i] = *(const f32x4*)(src + (size_t)(row + 1) * 1024 + (i * 64 + lane) * 4);
            if (COMBINE) {
                const size_t ra = yrow(t0n), rc = yrow(t1n);
#pragma unroll
                for (int i = 0; i < 4; ++i) { yan[i] = *(const uint2*)(Y + ra + (i * 64 + lane) * 4); ycn[i] = *(const uint2*)(Y + rc + (i * 64 + lane) * 4); }
                if (row + 2 < row_end) { t0n = tsl[(row + 2) * 2]; t1n = tsl[(row + 2) * 2 + 1]; }
            }
        }
        if (COMBINE) {
#pragma unroll
            for (int i = 0; i < 4; ++i) {
                const int col = (i * 64 + lane) * 4;
                v[i][0] += gt[i][0] * (bf2f(ya[i].x & 0xffff) + bf2f(yc[i].x & 0xffff));
                v[i][1] += gt[i][1] * (bf2f(ya[i].x >> 16) + bf2f(yc[i].x >> 16));
                v[i][2] += gt[i][2] * (bf2f(ya[i].y & 0xffff) + bf2f(yc[i].y & 0xffff));
                v[i][3] += gt[i][3] * (bf2f(ya[i].y >> 16) + bf2f(yc[i].y >> 16));
                *(f32x4*)(xdst + (size_t)row * 1024 + col) = v[i];
            }
        }
        if (NORM) {
            float ss = 0.f;
#pragma unroll
            for (int i = 0; i < 4; ++i) ss += v[i][0] * v[i][0] + v[i][1] * v[i][1] + v[i][2] * v[i][2] + v[i][3] * v[i][3];
            ss = wave_sum(ss);
            const float r = rsqrtf(ss * (1.f / 1024.f) + EPS);
#pragma unroll
            for (int i = 0; i < 4; ++i) {
                const int col = (i * 64 + lane) * 4;
                f32x4 h;
#pragma unroll
                for (int j = 0; j < 4; ++j) h[j] = v[i][j] * r * ca[i][j] + cb[i][j];
                uint2 o; o.x = pack2(h[0], h[1]); o.y = pack2(h[2], h[3]);
                *(uint2*)(hA + (size_t)row * 1024 + col) = o;
            }
        }
    }
}

__device__ __forceinline__ void rows_router_phase(const Params& p, const Ctx& cx, char* lds, const float* __restrict__ src, int ls_norm, int layer) {
    const int lane = cx.lane, tid = cx.tid;
    const int widu = __builtin_amdgcn_readfirstlane(cx.wid);
    const int wq = widu & 3, grp4 = widu >> 2;
    const float* mod = (const float*)(p.ws + OFF_MOD);
    const float* rg = p.moe_rg + (size_t)layer * 1024 * 4;
    const float* re = p.moe_re + (size_t)layer * 1024 * 16;
    float* logit_s = (float*)lds;
    float wr[16][5];
#pragma unroll
    for (int i = 0; i < 4; ++i)
#pragma unroll
        for (int j = 0; j < 4; ++j) {
            const int k = (i * 64 + lane) * 4 + j;
#pragma unroll
            for (int q = 0; q < 5; ++q) {
                const int o = 5 * wq + q;
                wr[i * 4 + j][q] = (o < 4) ? rg[k * 4 + o] : re[k * 16 + o - 4];
            }
            __builtin_amdgcn_sched_barrier(0);
        }
    const float* gain = p.norm_g + ls_norm * 1024;
    bf16_t* hA = (bf16_t*)(p.ws + OFF_HA);
    int* lcnt = (int*)(lds + 16384);
    if (tid < 32) lcnt[tid] = 0;
    int nstep = 0;
    for (int blk = cx.vbid; blk < NTOK / 32; blk += cx.G, ++nstep) {
        const int R0 = blk * 32, b = R0 >> 11;
        const float* shift = mod + ((size_t)ls_norm * 16 + b) * 3072;
        const float* scale = shift + 1024;
        f32x4 ca[4], cb[4];
#pragma unroll
        for (int i = 0; i < 4; ++i) {
            const int col = (i * 64 + lane) * 4;
            const f32x4 g = *(const f32x4*)(gain + col), sc = *(const f32x4*)(scale + col);
            ca[i] = g * (sc + 1.f);
            cb[i] = *(const f32x4*)(shift + col);
        }
        const float* srow = src + (size_t)(R0 + grp4 * 16) * 1024 + lane * 4;
        f32x4 vnA[4], vnB[4];
#pragma unroll
        for (int i = 0; i < 4; ++i) { vnA[i] = *(const f32x4*)(srow + i * 256); vnB[i] = *(const f32x4*)(srow + 1024 + i * 256); }
#pragma unroll 1
        for (int r = 0; r < 16; r += 2) {
            const int rlA = grp4 * 16 + r;
            f32x4 vA[4], vB[4];
#pragma unroll
            for (int i = 0; i < 4; ++i) { vA[i] = vnA[i]; vB[i] = vnB[i]; }
            if (r < 14) {
#pragma unroll
                for (int i = 0; i < 4; ++i) { vnA[i] = *(const f32x4*)(srow + (size_t)(r + 2) * 1024 + i * 256); vnB[i] = *(const f32x4*)(srow + (size_t)(r + 3) * 1024 + i * 256); }
            }
            float ssA = 0.f, ssB = 0.f;
#pragma unroll
            for (int i = 0; i < 4; ++i) {
                ssA += vA[i][0] * vA[i][0] + vA[i][1] * vA[i][1] + vA[i][2] * vA[i][2] + vA[i][3] * vA[i][3];
                ssB += vB[i][0] * vB[i][0] + vB[i][1] * vB[i][1] + vB[i][2] * vB[i][2] + vB[i][3] * vB[i][3];
            }
#pragma unroll
            for (int o = 32; o; o >>= 1) { ssA += __shfl_xor(ssA, o); ssB += __shfl_xor(ssB, o); }
            const float rrA = rsqrtf(ssA * (1.f / 1024.f) + EPS), rrB = rsqrtf(ssB * (1.f / 1024.f) + EPS);
            float accA[5] = {0.f, 0.f, 0.f, 0.f, 0.f}, accB[5] = {0.f, 0.f, 0.f, 0.f, 0.f};
#pragma unroll
            for (int i = 0; i < 4; ++i) {
                const int col = (i * 64 + lane) * 4;
                f32x4 hA_, hB_;
#pragma unroll
                for (int j = 0; j < 4; ++j) {
                    hA_[j] = vA[i][j] * rrA * ca[i][j] + cb[i][j];
                    hB_[j] = vB[i][j] * rrB * ca[i][j] + cb[i][j];
#pragma unroll
                    for (int q = 0; q < 5; ++q) { accA[q] += hA_[j] * wr[i * 4 + j][q]; accB[q] += hB_[j] * wr[i * 4 + j][q]; }
                }
                if ((r & 3) == wq) { uint2 o; o.x = pack2(hA_[0], hA_[1]); o.y = pack2(hA_[2], hA_[3]); *(uint2*)(hA + (size_t)(R0 + rlA) * 1024 + col) = o; }
                if (((r + 1) & 3) == wq) { uint2 o; o.x = pack2(hB_[0], hB_[1]); o.y = pack2(hB_[2], hB_[3]); *(uint2*)(hA + (size_t)(R0 + rlA + 1) * 1024 + col) = o; }
            }
            {
                float v[16];
#pragma unroll
                for (int q = 0; q < 5; ++q) { v[q] = accA[q]; v[5 + q] = accB[q]; }
#pragma unroll
                for (int q = 10; q < 16; ++q) v[q] = 0.f;
#pragma unroll
                for (int t = 0; t < 8; ++t) { const bool up = lane & 32; const float send = up ? v[t] : v[t + 8], keep = up ? v[t + 8] : v[t]; v[t] = keep + __shfl_xor(send, 32); }
#pragma unroll
                for (int t = 0; t < 4; ++t) { const bool up = lane & 16; const float send = up ? v[t] : v[t + 4], keep = up ? v[t + 4] : v[t]; v[t] = keep + __shfl_xor(send, 16); }
#pragma unroll
                for (int t = 0; t < 2; ++t) { const bool up = lane & 8; const float send = up ? v[t] : v[t + 2], keep = up ? v[t + 2] : v[t]; v[t] = keep + __shfl_xor(send, 8); }
                { const bool up = lane & 4; const float send = up ? v[0] : v[1], keep = up ? v[1] : v[0]; v[0] = keep + __shfl_xor(send, 4); }
                v[0] += __shfl_xor(v[0], 2);
                v[0] += __shfl_xor(v[0], 1);
                const int idx = ((lane >> 5) & 1) * 8 + ((lane >> 4) & 1) * 4 + ((lane >> 3) & 1) * 2 + ((lane >> 2) & 1);
                if ((lane & 3) == 0 && idx < 10) {
                    const int rsel = idx >= 5, q = idx - 5 * rsel;
                    logit_s[(nstep * 32 + rlA + rsel) * 20 + 5 * wq + q] = v[0];
                }
            }
        }
    }
    __syncthreads();
    const int nrows = nstep * 32;
    int ea = 0, eb = 0, la = 0, lb_ = 0, row = 0; float wa = 0.f, wb = 0.f;
    if (tid < nrows) {
        row = (cx.vbid + (tid >> 5) * cx.G) * 32 + (tid & 31);
        const float* rl = logit_s + tid * 20;
        const float gm = fmaxf(fmaxf(rl[0], rl[1]), fmaxf(rl[2], rl[3]));
        const float gs = __expf(rl[0] - gm) + __expf(rl[1] - gm) + __expf(rl[2] - gm) + __expf(rl[3] - gm);
        int grp = 0; float best = rl[0];
        if (rl[1] > best) { best = rl[1]; grp = 1; }
        if (rl[2] > best) { best = rl[2]; grp = 2; }
        if (rl[3] > best) { best = rl[3]; grp = 3; }
        const float pg = __expf(best - gm) / gs;
        const f32x4 lsel = *(const f32x4*)(rl + 4 + 4 * grp);
        const float l0 = lsel[0], l1 = lsel[1], l2 = lsel[2], l3 = lsel[3];
        const float em = fmaxf(fmaxf(l0, l1), fmaxf(l2, l3));
        const float q0 = __expf(l0 - em), q1 = __expf(l1 - em), q2 = __expf(l2 - em), q3 = __expf(l3 - em);
        int i1 = 0; float b1 = q0;
        if (q1 > b1) { b1 = q1; i1 = 1; }
        if (q2 > b1) { b1 = q2; i1 = 2; }
        if (q3 > b1) { b1 = q3; i1 = 3; }
        int i2 = -1; float b2 = -1.f;
        if (i1 != 0 && q0 > b2) { b2 = q0; i2 = 0; }
        if (i1 != 1 && q1 > b2) { b2 = q1; i2 = 1; }
        if (i1 != 2 && q2 > b2) { b2 = q2; i2 = 2; }
        if (i1 != 3 && q3 > b2) { b2 = q3; i2 = 3; }
        const float inv = pg / (b1 + b2);
        ea = grp * 4 + i1; eb = grp * 4 + i2; wa = b1 * inv; wb = b2 * inv;
        la = atomicAdd(lcnt + ea, 1);
        lb_ = atomicAdd(lcnt + eb, 1);
    }
    __syncthreads();
    if (tid < 16) lcnt[16 + tid] = atomicAdd((int*)(p.ws + OFF_CNT) + layer * 16 + tid, lcnt[tid]);
    __syncthreads();
    if (tid < nrows) {
        int* ltok = (int*)(p.ws + OFF_LTOK);
        float* lw = (float*)(p.ws + OFF_LW);
        int* ts = (int*)(p.ws + OFF_TSLOT) + row * 2;
        const int pa = lcnt[16 + ea] + la, pb = lcnt[16 + eb] + lb_;
        ltok[(size_t)ea * NTOK + pa] = row; lw[(size_t)ea * NTOK + pa] = wa;
        ltok[(size_t)eb * NTOK + pb] = row; lw[(size_t)eb * NTOK + pb] = wb;
        ts[0] = (ea << 16) | pa; ts[1] = (eb << 16) | pb;
    }
    __syncthreads();
}

__device__ __forceinline__ int stage_col(int tid) { return ((tid & 7) ^ ((tid >> 3) & 7)) * 8; }

template <class Epi>
__device__ __forceinline__ void gemm_tile(const bf16_t* const (&ap)[4], const bf16_t* const (&bp)[2], int K, char* lds, const Ctx& cx, Epi&& epi) {
    const int tid = cx.tid, lane = cx.lane, wr = cx.wid >> 1, wc = cx.wid & 1, fr = lane & 15, fq = lane >> 4;
    f32x4 acc[4][4];
#pragma unroll
    for (int m = 0; m < 4; ++m)
#pragma unroll
        for (int n = 0; n < 4; ++n) acc[m][n] = (f32x4){0.f, 0.f, 0.f, 0.f};
    const int nt = K / 64;
    auto stage = [&](int t, int slot) {
        char* SA = lds + slot * GEMM_STAGE + tid * 16; char* SB = SA + 32768;
        const int ko = t * 64;
#pragma unroll
        for (int i = 0; i < 4; ++i) glds16(ap[i] + ko, SA + i * 8192);
#pragma unroll
        for (int i = 0; i < 2; ++i) glds16(bp[i] + ko, SB + i * 8192);
    };
    __syncthreads();
    stage(0, 0);
    if (nt > 1) stage(1, 1);
    const int x7 = fr & 7;
    const int aoff = (wr * 64 + fr) * 128, boff = 32768 + (wc * 64 + fr) * 128;
    int slot = 0;
    for (int kt = 0; kt < nt; ++kt) {
        if (kt + 1 < nt) asm volatile("s_waitcnt vmcnt(6)" ::: "memory");
        else asm volatile("s_waitcnt vmcnt(0)" ::: "memory");
        __builtin_amdgcn_s_barrier();
        if (kt + 2 < nt) stage(kt + 2, slot >= 1 ? slot - 1 : 2);
        const char* S = lds + slot * GEMM_STAGE;
#pragma unroll
        for (int ks = 0; ks < 2; ++ks) {
            const int pc = ((ks * 4 + fq) ^ x7) * 16;
            bf16x8 Af[4], Bf[4];
#pragma unroll
            for (int m = 0; m < 4; ++m) Af[m] = *(const bf16x8*)(S + aoff + m * 2048 + pc);
#pragma unroll
            for (int n = 0; n < 4; ++n) Bf[n] = *(const bf16x8*)(S + boff + n * 2048 + pc);
#pragma unroll
            for (int m = 0; m < 4; ++m)
#pragma unroll
                for (int n = 0; n < 4; ++n) acc[m][n] = __builtin_amdgcn_mfma_f32_16x16x32_bf16(Bf[n], Af[m], acc[m][n], 0, 0, 0);
        }
        slot = slot == 2 ? 0 : slot + 1;
    }
    epi(acc, wr, wc, fr, fq);
}

__device__ __forceinline__ int swz_g(int q) { return (0x1320 >> (4 * q)) & 3; }
__device__ __forceinline__ int stage_col2(int tid) { return ((tid & 3) ^ swz_g((tid >> 4) & 3)) * 8; }

template <int MODE = 0, class Epi>
__device__ __forceinline__ void gemm_tile2(const bf16_t* const (&ap)[2], const bf16_t* const (&bp)[2], int K, char* lds, const Ctx& cx, Epi&& epi) {
    const int tid = cx.tid, lane = cx.lane, wc = cx.wid & 3, fr = lane & 15, fq = lane >> 4;
    const int wr = __builtin_amdgcn_readfirstlane(cx.wid >> 2);
    f32x4 acc[8][4];
#pragma unroll
    for (int m = 0; m < 8; ++m)
#pragma unroll
        for (int n = 0; n < 4; ++n) acc[m][n] = (f32x4){0.f, 0.f, 0.f, 0.f};
    const int nt = K / 32;
    auto stage = [&](int t) {
        char* SA = lds + (t & 3) * 32768 + tid * 16; char* SB = SA + 16384;
        const int ko = t * 32;
        glds16(ap[0] + ko, SA); glds16(ap[1] + ko, SA + 8192);
        glds16(bp[0] + ko, SB); glds16(bp[1] + ko, SB + 8192);
    };
    __syncthreads();
    stage(0);
    if (nt > 1) stage(1);
    if (nt > 2) stage(2);
    const int pc = (fq ^ swz_g((fr >> 2) & 3)) * 16;
    const int aoff = (wr * 128 + fr) * 64 + pc, boff = 16384 + (wc * 64 + fr) * 64 + pc;
    bf16x8 Af[8], Bf[4];
    auto load_frags = [&](int kt) {
        const char* S = lds + (kt & 3) * 32768;
#pragma unroll
        for (int n = 0; n < 4; ++n) Bf[n] = *(const bf16x8*)(S + boff + n * 1024);
#pragma unroll
        for (int m = 0; m < 8; ++m) Af[m] = *(const bf16x8*)(S + aoff + m * 1024);
        asm volatile("s_waitcnt lgkmcnt(0)" ::: "memory");
    };
    auto mma = [&]() {
        __builtin_amdgcn_s_setprio(1);
#pragma unroll
        for (int m = 0; m < 8; ++m)
#pragma unroll
            for (int n = 0; n < 4; ++n) acc[m][n] = __builtin_amdgcn_mfma_f32_16x16x32_bf16(Bf[n], Af[m], acc[m][n], 0, 0, 0);
        __builtin_amdgcn_s_setprio(0);
    };
    if (nt > 2) asm volatile("s_waitcnt vmcnt(8)" ::: "memory");
    else if (nt == 2) asm volatile("s_waitcnt vmcnt(4)" ::: "memory");
    else asm volatile("s_waitcnt vmcnt(0)" ::: "memory");
    if (wr == 1) __builtin_amdgcn_s_barrier();
    for (int kt = 0; kt < nt; ++kt) {
        const int rem = nt - 1 - kt;
        if (rem >= 2) asm volatile("s_waitcnt vmcnt(8)" ::: "memory");
        else if (rem == 1) asm volatile("s_waitcnt vmcnt(4)" ::: "memory");
        else asm volatile("s_waitcnt vmcnt(0)" ::: "memory");
        __builtin_amdgcn_s_barrier();
        if (kt + 3 < nt) stage(kt + 3);
        load_frags(kt);
        if (rem >= 3) asm volatile("s_waitcnt vmcnt(8)" ::: "memory");
        else if (rem == 2) asm volatile("s_waitcnt vmcnt(4)" ::: "memory");
        else asm volatile("s_waitcnt vmcnt(0)" ::: "memory");
        __builtin_amdgcn_s_barrier();
        mma();
    }
    if (wr == 0) __builtin_amdgcn_s_barrier();
    if (MODE == 0) epi(acc, wr, wc, fr, fq);
    else {
#pragma unroll
        for (int m = 0; m < 8; ++m)
#pragma unroll
            for (int n = 0; n < 4; ++n) asm volatile("" :: "v"(acc[m][n]));
    }
}

template <class GetFn, class EpiFn>
__device__ __forceinline__ void gemm_stream2(int my_tiles, int K, char* lds, const Ctx& cx, GetFn&& get, EpiFn&& epi) {
    if (my_tiles <= 0) return;
    const int tid = cx.tid, lane = cx.lane, wc = cx.wid & 3, fr = lane & 15, fq = lane >> 4;
    const int wr = __builtin_amdgcn_readfirstlane(cx.wid >> 2);
    f32x4 acc[8][4];
#pragma unroll
    for (int m = 0; m < 8; ++m)
#pragma unroll
        for (int n = 0; n < 4; ++n) acc[m][n] = (f32x4){0.f, 0.f, 0.f, 0.f};
    const int nt = K / 32, S = my_tiles * nt;
    const bf16_t* sap[2]; const bf16_t* sbp[2];
    int sj = 0, skt = 0, sg = 0;
    get(0, sap, sbp);
    auto stage_next = [&]() {
        char* SA = lds + (sg & 3) * 32768 + tid * 16; char* SB = SA + 16384;
        const int ko = skt * 32;
        glds16(sap[0] + ko, SA); glds16(sap[1] + ko, SA + 8192);
        glds16(sbp[0] + ko, SB); glds16(sbp[1] + ko, SB + 8192);
        ++sg; ++skt;
        if (skt == nt) { skt = 0; ++sj; if (sj < my_tiles) get(sj, sap, sbp); }
    };
    __syncthreads();
    stage_next();
    if (S > 1) stage_next();
    if (S > 2) stage_next();
    const int pc = (fq ^ swz_g((fr >> 2) & 3)) * 16;
    const int aoff = (wr * 128 + fr) * 64 + pc, boff = 16384 + (wc * 64 + fr) * 64 + pc;
    bf16x8 Af[8], Bf[4];
    int g = 0;
    for (int cj = 0; cj < my_tiles; ++cj) {
        {
            const int rem0 = S - 1 - g;
            if (rem0 >= 2) asm volatile("s_waitcnt vmcnt(8)" ::: "memory");
            else if (rem0 == 1) asm volatile("s_waitcnt vmcnt(4)" ::: "memory");
            else asm volatile("s_waitcnt vmcnt(0)" ::: "memory");
        }
        if (wr == 1) __builtin_amdgcn_s_barrier();
        for (int kt = 0; kt < nt; ++kt, ++g) {
            const int rem = S - 1 - g;
            if (rem >= 2) asm volatile("s_waitcnt vmcnt(8)" ::: "memory");
            else if (rem == 1) asm volatile("s_waitcnt vmcnt(4)" ::: "memory");
            else asm volatile("s_waitcnt vmcnt(0)" ::: "memory");
            __builtin_amdgcn_s_barrier();
            if (g + 3 < S) stage_next();
            {
                const char* Sx = lds + (g & 3) * 32768;
#pragma unroll
                for (int n = 0; n < 4; ++n) Bf[n] = *(const bf16x8*)(Sx + boff + n * 1024);
#pragma unroll
                for (int m = 0; m < 8; ++m) Af[m] = *(const bf16x8*)(Sx + aoff + m * 1024);
                asm volatile("s_waitcnt lgkmcnt(0)" ::: "memory");
            }
            if (rem >= 3) asm volatile("s_waitcnt vmcnt(8)" ::: "memory");
            else if (rem == 2) asm volatile("s_waitcnt vmcnt(4)" ::: "memory");
            else asm volatile("s_waitcnt vmcnt(0)" ::: "memory");
            __builtin_amdgcn_s_barrier();
            __builtin_amdgcn_s_setprio(1);
#pragma unroll
            for (int m = 0; m < 8; ++m)
#pragma unroll
                for (int n = 0; n < 4; ++n) acc[m][n] = __builtin_amdgcn_mfma_f32_16x16x32_bf16(Bf[n], Af[m], acc[m][n], 0, 0, 0);
            __builtin_amdgcn_s_setprio(0);
        }
        if (wr == 0) __builtin_amdgcn_s_barrier();
        epi(cj, acc, wr, wc, fr, fq);
#pragma unroll
        for (int m = 0; m < 8; ++m)
#pragma unroll
            for (int n = 0; n < 4; ++n) acc[m][n] = (f32x4){0.f, 0.f, 0.f, 0.f};
    }
}

template <int MODE = 0, class EpiFactory>
__device__ __forceinline__ void gemm_phase_dense2(const bf16_t* A, int lda, const bf16_t* Bt, int K, int nrt, int nct, char* lds, const Ctx& cx, EpiFactory&& mk) {
    const int tid = cx.tid;
    const int ntiles = nrt * nct;
    const int sc = stage_col2(tid), sr = tid >> 2;
    const int my_tiles = cx.vbid < ntiles ? (ntiles - cx.vbid + cx.G - 1) / cx.G : 0;
    const int vb = cx.vbid, G = cx.G;
    gemm_stream2(my_tiles, K, lds, cx,
        [=](int j, const bf16_t* (&ap)[2], const bf16_t* (&bp)[2]) {
            const int tile = vb + j * G, rt = tile / nct, ct = tile % nct;
            ap[0] = A + (size_t)(rt * 256 + sr) * lda + sc; ap[1] = ap[0] + (size_t)128 * lda;
            bp[0] = Bt + (size_t)(ct * 256 + sr) * K + sc; bp[1] = bp[0] + (size_t)128 * K;
        },
        [=](int j, f32x4 (&acc)[8][4], int wr, int wc, int fr, int fq) {
            const int tile = vb + j * G, rt = tile / nct, ct = tile % nct;
            mk(rt * 256, ct * 256)(acc, wr, wc, fr, fq);
        });
}

__device__ __forceinline__ void phase_nsa_inproj(const Params& p, const Ctx& cx, char* lds) {
    const bf16_t* A = (const bf16_t*)(p.ws + OFF_HA);
    const bf16_t* Bt = (const bf16_t*)(p.ws + OFF_W_NSA_IN);
    char* ws = p.ws;
    const float* qg = p.nsa_q_gain;
    const float* kg = p.nsa_k_gain;
    gemm_phase_dense2(A, 1024, Bt, 1024, NTOK / 256, NSA_IN_PAD / 256, lds, cx, [=](int row0, int col0) {
        return [=](f32x4 (&acc)[8][4], int wr, int wc, int fr, int fq) {
            const int gc0 = col0 + wc * 64;
            if (gc0 >= NSA_IN) return;
            if (gc0 < 1024 || (gc0 >= 1536 && gc0 < 1792) || (gc0 >= 2048 && gc0 < 2304)) {
                const float* gain; float post; bf16_t* dstb; size_t rstride; size_t coff; bool tokmajor;
                if (gc0 < 1024) { gain = qg; post = 0.125f * 1.4426950408889634f; }
                else if (gc0 < 1792) { gain = kg + 64; post = 1.f; }
                else { gain = kg + 128; post = 1.f; }
#pragma unroll
                for (int m = 0; m < 8; ++m) {
                    __builtin_amdgcn_sched_barrier(0);
                    float ss = 0.f;
#pragma unroll
                    for (int n = 0; n < 4; ++n) ss += acc[m][n][0] * acc[m][n][0] + acc[m][n][1] * acc[m][n][1] + acc[m][n][2] * acc[m][n][2] + acc[m][n][3] * acc[m][n][3];
                    ss += __shfl_xor(ss, 16); ss += __shfl_xor(ss, 32);
                    const float r = rsqrtf(ss * (1.f / 64.f) + EPS) * post;
                    const int row = row0 + wr * 128 + m * 16 + fr;
                    bf16_t* dst;
                    if (gc0 < 1024) dst = (bf16_t*)(ws + OFF_Q) + (size_t)row * 1024 + gc0;
                    else {
                        const int g = ((gc0 - 1024) & 255) >> 6, b = row >> 11, t = row & 2047;
                        dst = (bf16_t*)(ws + (gc0 < 1792 ? OFF_KS : OFF_KW)) + ((size_t)(b * 4 + g) * 2048 + t) * 64;
                    }
#pragma unroll
                    for (int pp = 0; pp < 2; ++pp) {
                        const int c = pp * 32 + fq * 8;
                        const f32x4 ga = *(const f32x4*)(gain + c), gb = *(const f32x4*)(gain + c + 4);
                        const f32x4 a = acc[m][2 * pp], bb = acc[m][2 * pp + 1];
                        uint4 o; o.x = pack2(a[0] * r * ga[0], a[1] * r * ga[1]); o.y = pack2(a[2] * r * ga[2], a[3] * r * ga[3]);
                        o.z = pack2(bb[0] * r * gb[0], bb[1] * r * gb[1]); o.w = pack2(bb[2] * r * gb[2], bb[3] * r * gb[3]);
                        *(uint4*)(dst + c) = o;
                    }
                }
            } else if (gc0 < 2560) {
                const int seg = (gc0 - 1024) >> 8;
                const int g = ((gc0 - 1024) & 255) >> 6;
                if (seg < 2) {
                    const size_t off = seg == 0 ? OFF_KCRAW : OFF_VCRAW;
#pragma unroll
                    for (int m = 0; m < 8; ++m) {
                        __builtin_amdgcn_sched_barrier(0);
                    __builtin_amdgcn_sched_barrier(0);
                        const int row = row0 + wr * 128 + m * 16 + fr, b = row >> 11, t = row & 2047;
                        bf16_t* dst = (bf16_t*)(ws + off) + ((size_t)(b * 4 + g) * 2048 + t) * 64;
#pragma unroll
                        for (int pp = 0; pp < 2; ++pp) {
                            const f32x4 a = acc[m][2 * pp], bb = acc[m][2 * pp + 1];
                            uint4 o; o.x = pack2(a[0], a[1]); o.y = pack2(a[2], a[3]); o.z = pack2(bb[0], bb[1]); o.w = pack2(bb[2], bb[3]);
                            *(uint4*)(dst + pp * 32 + fq * 8) = o;
                        }
                    }
                } else {
                    const size_t off = seg == 3 ? OFF_VS : OFF_VW;
#pragma unroll
                    for (int m = 0; m < 8; ++m) {
                        __builtin_amdgcn_sched_barrier(0);
                    __builtin_amdgcn_sched_barrier(0);
                        const int row = row0 + wr * 128 + m * 16 + fr, b = row >> 11, t = row & 2047;
                        bf16_t* dst = (bf16_t*)(ws + off) + (size_t)(b * 4 + g) * 64 * 2048 + t;
#pragma unroll
                        for (int n = 0; n < 4; ++n)
#pragma unroll
                            for (int j = 0; j < 4; ++j) dst[(size_t)(pcol(n, fq) + j) * 2048] = f2bf(acc[m][n][j]);
                    }
                }
            } else {
#pragma unroll
                for (int m = 0; m < 8; ++m) {
                    __builtin_amdgcn_sched_barrier(0);
                    const int row = row0 + wr * 128 + m * 16 + fr;
                    float* dst = (float*)(ws + OFF_GATES) + (size_t)row * 48;
#pragma unroll
                    for (int n = 0; n < 4; ++n) {
                        const int c = pcol(n, fq);
                        f32x4 o;
#pragma unroll
                        for (int j = 0; j < 4; ++j) o[j] = sigmoid_f(acc[m][n][j]);
                        if (c < 48) *(f32x4*)(dst + c) = o;
                    }
                }
            }
        };
    });
}

__device__ __forceinline__ void phase_cmp1(const Params& p, const Ctx& cx, char* lds) {
    const int tid = cx.tid;
    const float* peb = (const float*)(p.ws + OFF_PEB);
    float* T1 = (float*)(p.ws + OFF_T1);
    const int sc = stage_col(tid), sr = tid >> 3;
    for (int tile = cx.vbid; tile < 64; tile += cx.G) {
        const int kv = tile >> 5, bg2 = tile & 31;
        const bf16_t* raw = (const bf16_t*)(p.ws + (kv ? OFF_VCRAW : OFF_KCRAW)) + (size_t)bg2 * 2 * 2048 * 64;
        const bf16_t* a0 = raw + (size_t)sr * 1024 + sc;
        const bf16_t* a2 = raw + (size_t)2048 * 64 + (size_t)sr * 1024 + sc;
        const bf16_t* b0 = (const bf16_t*)(p.ws + OFF_W_CMP1) + ((size_t)kv * 128 + sr) * 2048 + sc;
        const bf16_t* const ap[4] = {a0, a0 + (size_t)64 * 1024, a2, a2 + (size_t)64 * 1024};
        const bf16_t* const bp[2] = {b0, b0 + (size_t)64 * 2048};
        gemm_tile(ap, bp, 2048, lds, cx, [=](f32x4 (&acc)[4][4], int wr, int wc, int fr, int fq) {
            if (wc != 0) return;
#pragma unroll
            for (int m = 0; m < 4; ++m) {
                const int r = wr * 64 + m * 16 + fr;
                float* dst = T1 + ((size_t)kv * 8192 + (bg2 * 2 + (r >> 7)) * 128 + (r & 127)) * 64;
#pragma unroll
                for (int n = 0; n < 4; ++n) {
                    const int c = n * 16 + fq * 4;
                    f32x4 pb = *(const f32x4*)(peb + kv * 64 + c);
                    *(f32x4*)(dst + c) = acc[m][n] + pb;
                }
            }
        });
    }
}

__device__ __forceinline__ void phase_cmp2(const Params& p, const Ctx& cx) {
    const int lane = cx.lane;
    const float* T1 = (const float*)(p.ws + OFF_T1);
    for (int r = cx.vbid * NWAVE + cx.wid; r < 2 * 8192; r += cx.G * NWAVE) {
        const int kv = r >> 13, rr = r & 8191, n_ = rr & 127;
        const float s = silu_f(T1[(size_t)r * 64 + lane]);
        const float* w2 = p.nsa_cmp_w2 + kv * 4096 + lane;
        float o = 0.f;
#pragma unroll 8
        for (int j = 0; j < 64; ++j) o += __shfl(s, j) * w2[j * 64];
        if (kv == 0) {
            const float ss = wave_sum(o * o);
            o = o * rsqrtf(ss * (1.f / 64.f) + EPS) * p.nsa_k_gain[lane];
        }
        if (n_ == 127) o = 0.f;
        if (kv == 0) ((bf16_t*)(p.ws + OFF_KC))[(size_t)rr * 64 + lane] = f2bf(o);
        else ((bf16_t*)(p.ws + OFF_VC))[((size_t)(rr >> 7) * 64 + lane) * 128 + n_] = f2bf(o);
    }
}

constexpr int ATT_BUF = 17920, ATT_K_STRIDE = 144, ATT_V_OFF = 9216, ATT_V_STRIDE = 136, ATT_LUT_OFF = 2 * ATT_BUF, LUT_N = 2136, LUT_PAD = 80;
constexpr int ATT_SC_OFF = ATT_LUT_OFF + 4 * LUT_N * 4;
static_assert(ATT_SC_OFF + NWAVE * 8192 <= LDS_TAB_OFF, "attention LDS");
#define MFMA32(a, b, c) __builtin_amdgcn_mfma_f32_32x32x16_bf16((a), (b), (c), 0, 0, 0)
template <int V> struct IC { static constexpr int value = V; };

__device__ __forceinline__ void phase_attn(const Params& p, const Ctx& cx, char* lds) {
    const int tid = cx.tid, lane = cx.lane, wid = cx.wid;
    const int g = cx.vbid & 3;
    const int ql = lane & 7, head = (lane & 31) >> 3, h2 = lane >> 5, l31 = lane & 31;
    float* lut = (float*)(lds + ATT_LUT_OFF);
    for (int i = tid; i < 4 * LUT_N; i += NTHR) {
        const int h = i / LUT_N, dist = i % LUT_N - LUT_PAD;
        lut[i] = dist >= 0 ? p.rel_bias[t5_bucket(dist) * 16 + g * 4 + h] * 1.4426950408889634f : 0.f;
    }
    __syncthreads();
    const float* lutp = lut + head * LUT_N + LUT_PAD;
    const float b31 = lutp[2047];
    const bf16_t* Qb = (const bf16_t*)(p.ws + OFF_Q);
    const bf16_t* KC = (const bf16_t*)(p.ws + OFF_KC);
    const bf16_t* VCT = (const bf16_t*)(p.ws + OFF_VC);
    const bf16_t* KS = (const bf16_t*)(p.ws + OFF_KS);
    const bf16_t* VST = (const bf16_t*)(p.ws + OFF_VS);
    const bf16_t* KW = (const bf16_t*)(p.ws + OFF_KW);
    const bf16_t* VWT = (const bf16_t*)(p.ws + OFF_VW);
    const float* GT = (const float*)(p.ws + OFF_GATES);
    bf16_t* Og = (bf16_t*)(p.ws + OFF_HA);
    float* scw = (float*)(lds + ATT_SC_OFF) + wid * 2048;
    f32x4* outw = (f32x4*)(lds + ATT_SC_OFF + wid * 8192) + lane;
    const bool flip_ok = (cx.G % 128) == 0;
    const int widu = __builtin_amdgcn_readfirstlane(wid);

    for (int it = 0;; ++it) {
        const int u = cx.vbid + it * cx.G;
        if (u >= 2048) break;
        const int rest = u >> 2, b = rest >> 5, qtb = rest & 31;
        const int qt = (flip_ok && (it & 1)) ? 31 - qtb : qtb;
        const int t0 = qt * 64, cur = qt, bg = b * 4 + g;
        const int tq = t0 + wid * 8 + ql;
        const size_t rowtok = (size_t)b * SEQ + tq;
        bf16x8 Qf[4];
        {
            const bf16_t* qp = Qb + rowtok * 1024 + (g * 4 + head) * 64 + 8 * h2;
#pragma unroll
            for (int ks = 0; ks < 4; ++ks) Qf[ks] = *(const bf16x8*)(qp + 16 * ks);
        }
        const float* gt = GT + rowtok * 48 + (g * 4 + head) * 3;
        const float gate_c = gt[0], gate_s = gt[1], gate_w = gt[2];
        const int wlo = max(0, qt - 8);
        const int nW = cur - wlo + 1;
        const int ncp = (t0 + 63 >= 31 + 16 * 64) ? 2 : 1;
        const int NC = ncp;
        const int NT = NC + nW + cur + 1;

        uint4 kr0, vr0;
        auto issue_load = [&](int i) {
            const bf16_t* ksrc; const bf16_t* vsrc; int vstride;
            if (i < NC) { const int ci = i; ksrc = KC + ((size_t)bg * 128 + ci * 64) * 64; vsrc = VCT + (size_t)bg * 64 * 128 + ci * 64; vstride = 128; }
            else if (i < NC + nW) { const int kb = wlo + i - NC; ksrc = KW + ((size_t)bg * 2048 + kb * 64) * 64; vsrc = VWT + (size_t)bg * 64 * 2048 + kb * 64; vstride = 2048; }
            else { const int kb = i - NC - nW; ksrc = KS + ((size_t)bg * 2048 + kb * 64) * 64; vsrc = VST + (size_t)bg * 64 * 2048 + kb * 64; vstride = 2048; }
            kr0 = *(const uint4*)(ksrc + tid * 8);
            vr0 = *(const uint4*)(vsrc + (size_t)(tid >> 3) * vstride + (tid & 7) * 8);
        };
        auto write_lds = [&](int i) {
            char* bufp = lds + (i & 1) * ATT_BUF;
            *(uint4*)(bufp + (tid >> 3) * ATT_K_STRIDE + (tid & 7) * 16) = kr0;
            char* va = bufp + ATT_V_OFF + (tid >> 3) * ATT_V_STRIDE + (tid & 7) * 16;
            uint2 t;
            t.x = vr0.x; t.y = vr0.y; *(uint2*)va = t;
            t.x = vr0.z; t.y = vr0.w; *(uint2*)(va + 8) = t;
        };
        f32x16 O0, O1;
#pragma unroll
        for (int r = 0; r < 16; ++r) { O0[r] = 0.f; O1[r] = 0.f; }
        float lsum = 0.f;

        auto qk = [&](const char* bufp, int kt2, float init) -> f32x16 {
            f32x16 S;
#pragma unroll
            for (int r = 0; r < 16; ++r) S[r] = init;
            const char* kp = bufp + (32 * kt2 + l31) * ATT_K_STRIDE + 16 * h2;
            bf16x8 kf[4];
#pragma unroll
            for (int ks = 0; ks < 4; ++ks) kf[ks] = *(const bf16x8*)(kp + 32 * ks);
            __builtin_amdgcn_sched_barrier(0);
#pragma unroll
            for (int ks = 0; ks < 4; ++ks) S = MFMA32(kf[ks], Qf[ks], S);
            return S;
        };
        auto pv = [&](const char* bufp, int kt2, const f32x16& P) {
            const char* vp = bufp + ATT_V_OFF + l31 * ATT_V_STRIDE + (32 * kt2 + 4 * h2) * 2;
            uint2 va[2][2][2];
#pragma unroll
            for (int s2 = 0; s2 < 2; ++s2)
#pragma unroll
                for (int dt = 0; dt < 2; ++dt) {
                    va[s2][dt][0] = *(const uint2*)(vp + dt * 32 * ATT_V_STRIDE + s2 * 32);
                    va[s2][dt][1] = *(const uint2*)(vp + dt * 32 * ATT_V_STRIDE + s2 * 32 + 16);
                }
            __builtin_amdgcn_sched_barrier(0);
#pragma unroll
            for (int s2 = 0; s2 < 2; ++s2) {
                uint4 pk;
                pk.x = pack2(P[8 * s2 + 0], P[8 * s2 + 1]); pk.y = pack2(P[8 * s2 + 2], P[8 * s2 + 3]);
                pk.z = pack2(P[8 * s2 + 4], P[8 * s2 + 5]); pk.w = pack2(P[8 * s2 + 6], P[8 * s2 + 7]);
                const bf16x8 Pf = __builtin_bit_cast(bf16x8, pk);
                uint4 a0, a1;
                a0.x = va[s2][0][0].x; a0.y = va[s2][0][0].y; a0.z = va[s2][0][1].x; a0.w = va[s2][0][1].y;
                a1.x = va[s2][1][0].x; a1.y = va[s2][1][0].y; a1.z = va[s2][1][1].x; a1.w = va[s2][1][1].y;
                O0 = MFMA32(__builtin_bit_cast(bf16x8, a0), Pf, O0);
                O1 = MFMA32(__builtin_bit_cast(bf16x8, a1), Pf, O1);
            }
        };
        auto finalize = [&](float gate, int mode) {
            const float Z = lsum + __shfl_xor(lsum, 32);
            const float f = Z > 0.f ? gate / Z : 0.f;
#pragma unroll
            for (int v4 = 0; v4 < 4; ++v4) {
                f32x4 a = {f * O0[4 * v4], f * O0[4 * v4 + 1], f * O0[4 * v4 + 2], f * O0[4 * v4 + 3]};
                f32x4 c = {f * O1[4 * v4], f * O1[4 * v4 + 1], f * O1[4 * v4 + 2], f * O1[4 * v4 + 3]};
                if (mode != 0) { a += outw[v4 * 64]; c += outw[(4 + v4) * 64]; }
                if (mode != 2) { outw[v4 * 64] = a; outw[(4 + v4) * 64] = c; }
                else { O0[4 * v4] = a[0]; O0[4 * v4 + 1] = a[1]; O0[4 * v4 + 2] = a[2]; O0[4 * v4 + 3] = a[3];
                       O1[4 * v4] = c[0]; O1[4 * v4 + 1] = c[1]; O1[4 * v4 + 2] = c[2]; O1[4 * v4 + 3] = c[3]; }
            }
            if (mode != 2) {
#pragma unroll
                for (int r = 0; r < 16; ++r) { O0[r] = 0.f; O1[r] = 0.f; }
            }
            lsum = 0.f;
        };
        auto tile_ws = [&](const char* bufp, int kb, float cinit, auto MMc, auto BMc) {
            constexpr int MM = decltype(MMc)::value, BM = decltype(BMc)::value;
#pragma unroll 1
            for (int kt2 = 0; kt2 < 2; ++kt2) {
                const int d0 = tq - (64 * kb + 32 * kt2 + 4 * h2);
                const float* lp = lutp + (d0 - 27);
                float bv[16];
                if (BM == 0) {
#pragma unroll
                    for (int r = 0; r < 16; ++r) bv[r] = lp[27 - ((r & 3) + 8 * (r >> 2))];
                    __builtin_amdgcn_sched_barrier(0);
                }
                f32x16 S = qk(bufp, kt2, cinit);
#pragma unroll
                for (int r = 0; r < 16; ++r) {
                    const int cr = (r & 3) + 8 * (r >> 2);
                    float x = S[r];
                    if (BM == 0) x += bv[r];
                    if (MM == 1) x += (d0 - cr < 512) ? 0.f : -INFINITY;
                    if (MM == 2) x += (d0 - cr >= 0) ? 0.f : -INFINITY;
                    S[r] = __builtin_amdgcn_exp2f(x);
                    lsum += S[r];
                }
                pv(bufp, kt2, S);
            }
        };

        const int nvis = (tq >= 31) ? min((tq - 31) / 16 + 1, 127) : 0;
        unsigned selmask = 0u;
        float* sown = scw + (head * 8 + ql) * 32;
        float* stail = scw + 1024 + (head * 8 + ql) * 32;
        float* ssc = scw + ql * 32;
        issue_load(0);
        __syncthreads();
        write_lds(0);
        issue_load(1);
        for (int i = 0; i < NT; ++i) {
            __syncthreads();
            const char* bufp = lds + (i & 1) * ATT_BUF;
            if (i < NC) {
                const int ci = i;
#pragma unroll 1
                for (int kt2 = 0; kt2 < 2; ++kt2) {
                    const int n0 = 64 * ci + 32 * kt2 + 4 * h2;
                    const int d0 = tq - 31 - 16 * n0;
                    float bv[16];
#pragma unroll
                    for (int r = 0; r < 16; ++r) bv[r] = lutp[max(d0 - 16 * ((r & 3) + 8 * (r >> 2)), -LUT_PAD)];
                    __builtin_amdgcn_sched_barrier(0);
                    f32x16 S = qk(bufp, kt2, 0.f);
#pragma unroll
                    for (int r = 0; r < 16; ++r) {
                        const int cr = (r & 3) + 8 * (r >> 2);
                        S[r] = __builtin_amdgcn_exp2f(S[r] + bv[r] + ((n0 + cr) < nvis ? 0.f : -INFINITY));
                        lsum += S[r];
                    }
                    pv(bufp, kt2, S);
#pragma unroll
                    for (int rq = 0; rq < 4; ++rq) {
                        const int sblk = 8 * (2 * ci + kt2) + 2 * rq + h2;
                        sown[sblk] = S[4 * rq] + S[4 * rq + 1] + S[4 * rq + 2] + 0.5f * S[4 * rq + 3];
                        if (sblk < 31) stail[sblk + 1] = 0.5f * S[4 * rq + 3];
                    }
                }
                if (i == NC - 1) {
                    const float Z = lsum + __shfl_xor(lsum, 32);
                    const float inv_mine = Z > 0.f ? 1.f / Z : 0.f;
                    if (h2 == 0) stail[0] = 0.f;
                    __builtin_amdgcn_wave_barrier();
                    const int j8 = head * 2 + h2;
                    {
                        f32x4 sc = {0.f, 0.f, 0.f, 0.f};
#pragma unroll
                        for (int hh = 0; hh < 4; ++hh) {
                            const float invh = __shfl(inv_mine, hh * 8 + ql);
                            const f32x4 a = *(const f32x4*)(scw + (hh * 8 + ql) * 32 + 4 * j8), t4 = *(const f32x4*)(scw + 1024 + (hh * 8 + ql) * 32 + 4 * j8);
                            sc += (a + t4) * invh;
                        }
#pragma unroll
                        for (int q = 0; q < 4; ++q) {
                            const int sblk = 4 * j8 + q;
                            const bool forced = (sblk == 0) || (sblk == cur) || (sblk == cur - 1);
                            sc[q] = forced ? 1.0e4f : (sblk <= cur ? sc[q] : -1.0f);
                        }
                        __builtin_amdgcn_wave_barrier();
                        *(f32x4*)(ssc + 4 * j8) = sc;
                    }
                    __builtin_amdgcn_wave_barrier();
                    const f32x4 own = *(const f32x4*)(ssc + 4 * j8);
                    int rk0 = 0, rk1 = 0, rk2 = 0, rk3 = 0;
                    const int so0 = 4 * j8;
#pragma unroll
                    for (int m4 = 0; m4 < 8; ++m4) {
                        const f32x4 v = *(const f32x4*)(ssc + 4 * m4);
#pragma unroll
                        for (int q = 0; q < 4; ++q) {
                            const float vm = v[q];
                            rk0 += (vm > own[0]) ? 1 : 0;
                            rk1 += (vm > own[1]) ? 1 : 0;
                            rk2 += (vm > own[2]) ? 1 : 0;
                            rk3 += (vm > own[3]) ? 1 : 0;
                        }
                    }
                    unsigned mk = ((rk0 < 8 ? 1u : 0u) | (rk1 < 8 ? 2u : 0u) | (rk2 < 8 ? 4u : 0u) | (rk3 < 8 ? 8u : 0u)) << so0;
                    mk |= __shfl_xor(mk, 8); mk |= __shfl_xor(mk, 16); mk |= __shfl_xor(mk, 32);
                    selmask = mk;
                    __builtin_amdgcn_wave_barrier();
                    finalize(gate_c, 0);
                }
            } else if (i < NC + nW) {
                const int kb = wlo + i - NC;
                if (kb == cur) tile_ws(bufp, kb, 0.f, IC<2>{}, IC<0>{});
                else if (kb == cur - 8) tile_ws(bufp, kb, 0.f, IC<1>{}, IC<0>{});
                else tile_ws(bufp, kb, 0.f, IC<0>{}, IC<0>{});
                if (i == NC - 1 + nW) finalize(gate_w, 1);
            } else {
                const int kb = i - NC - nW;
                const bool sel = ((selmask >> kb) & 1u) != 0;
                if (__ballot(sel) != 0ull) {
                    const float neg = sel ? 0.f : -INFINITY;
                    if (kb == cur) tile_ws(bufp, kb, neg, IC<2>{}, IC<0>{});
                    else if (t0 + 8 * widu - (64 * kb + 63) >= 790) tile_ws(bufp, kb, neg + b31, IC<0>{}, IC<1>{});
                    else tile_ws(bufp, kb, neg, IC<0>{}, IC<0>{});
                }
            }
            if (i + 1 < NT) {
                write_lds(i + 1);
                if (i + 2 < NT) issue_load(i + 2);
            }
        }
        finalize(gate_s, 2);
        {
            bf16_t* op = Og + rowtok * 1024 + (g * 4 + head) * 64 + 4 * h2;
#pragma unroll
            for (int rq = 0; rq < 4; ++rq) {
                uint2 o0; o0.x = pack2(O0[4 * rq], O0[4 * rq + 1]); o0.y = pack2(O0[4 * rq + 2], O0[4 * rq + 3]);
                uint2 o1; o1.x = pack2(O1[4 * rq], O1[4 * rq + 1]); o1.y = pack2(O1[4 * rq + 2], O1[4 * rq + 3]);
                *(uint2*)(op + 8 * rq) = o0;
                *(uint2*)(op + 32 + 8 * rq) = o1;
            }
        }
    }
}

__device__ __forceinline__ void phase_outproj(const Params& p, const Ctx& cx, char* lds, const bf16_t* A, const bf16_t* Bt, const float* xin, int ls) {
    const float* mod = (const float*)(p.ws + OFF_MOD);
    float* xo = p.out;
    gemm_phase_dense2(A, 1024, Bt, 1024, NTOK / 256, 4, lds, cx, [=](int row0, int col0) {
        return [=](f32x4 (&acc)[8][4], int wr, int wc, int fr, int fq) {
            const int b = row0 >> 11;
            const float* gate = mod + ((size_t)ls * 16 + b) * 3072 + 2048 + col0 + wc * 64;
            f32x4 g[4];
#pragma unroll
            for (int n = 0; n < 4; ++n) g[n] = *(const f32x4*)(gate + pcol(n, fq));
#pragma unroll
            for (int m2 = 0; m2 < 8; m2 += 2) {
                f32x4 xi[2][4];
#pragma unroll
                for (int mm = 0; mm < 2; ++mm)
#pragma unroll
                    for (int n = 0; n < 4; ++n)
                        xi[mm][n] = *(const f32x4*)(xin + (size_t)(row0 + wr * 128 + (m2 + mm) * 16 + fr) * 1024 + col0 + wc * 64 + pcol(n, fq));
                __builtin_amdgcn_sched_barrier(0);
#pragma unroll
                for (int mm = 0; mm < 2; ++mm)
#pragma unroll
                    for (int n = 0; n < 4; ++n) {
                        f32x4 o;
#pragma unroll
                        for (int j = 0; j < 4; ++j) o[j] = xi[mm][n][j] + g[n][j] * acc[m2 + mm][n][j];
                        *(f32x4*)(xo + (size_t)(row0 + wr * 128 + (m2 + mm) * 16 + fr) * 1024 + col0 + wc * 64 + pcol(n, fq)) = o;
                    }
                __builtin_amdgcn_sched_barrier(0);
            }
        };
    });
}

__device__ __forceinline__ void moe_tables(const Params& p, int layer, int tid, int* s_cnt, int* s_off, int* s_toff) {
    __syncthreads();
    if (tid == 0) {
        const int* cnt = (const int*)(p.ws + OFF_CNT) + layer * 16;
        int o = 0, to = 0;
        for (int e = 0; e < 16; ++e) { const int c = cnt[e]; s_cnt[e] = c; s_off[e] = o; s_toff[e] = to; o += c; to += ((c + 255) >> 8) * 4; }
        s_off[16] = o; s_toff[16] = to;
    }
    __syncthreads();
}

constexpr int LDS_ROWIDX_OFF = 131072, LDS_LW_OFF = 131072 + 8192;
static_assert(LDS_LW_OFF + 8192 <= LDS_TAB_OFF, "moe caches");

__device__ __forceinline__ void phase_moe_up(const Params& p, const Ctx& cx, char* lds, int layer) {
    const int tid = cx.tid;
    int* s_cnt = (int*)(lds + LDS_TAB_OFF); int* s_off = s_cnt + 16; int* s_toff = s_off + 17;
    moe_tables(p, layer, tid, s_cnt, s_off, s_toff);
    const int ntiles = s_toff[16];
    const bf16_t* hA = (const bf16_t*)(p.ws + OFF_HA);
    const int* ltok = (const int*)(p.ws + OFF_LTOK);
    bf16_t* H1 = (bf16_t*)(p.ws + OFF_H1);
    int* rowidx = (int*)(lds + LDS_ROWIDX_OFF);
    const int sc = stage_col2(tid), sr = tid >> 2;
    const int vb = cx.vbid, G = cx.G;
    const int my_tiles = min(8, vb < ntiles ? (ntiles - vb + G - 1) / G : 0);
    auto locate = [=](int j, int& e, int& rt, int& ct) { const int tile = vb + j * G; e = 0; while (tile >= s_toff[e + 1]) ++e; const int lt = tile - s_toff[e]; rt = lt >> 2; ct = lt & 3; };
    for (int i = tid; i < my_tiles * 256; i += NTHR) {
        const int j = i >> 8, r = i & 255; int e, rt, ct; locate(j, e, rt, ct);
        rowidx[i] = ltok[(size_t)e * NTOK + min(rt * 256 + r, s_cnt[e] - 1)];
    }
    __syncthreads();
    const bf16_t* Wup = (const bf16_t*)(p.ws + OFF_W_UP) + (size_t)layer * 16 * 1024 * 1024;
    gemm_stream2(my_tiles, 1024, lds, cx,
        [=](int j, const bf16_t* (&ap)[2], const bf16_t* (&bp)[2]) {
            int e, rt, ct; locate(j, e, rt, ct);
            ap[0] = hA + (size_t)rowidx[j * 256 + sr] * 1024 + sc; ap[1] = hA + (size_t)rowidx[j * 256 + sr + 128] * 1024 + sc;
            bp[0] = Wup + ((size_t)e * 1024 + ct * 256 + sr) * 1024 + sc; bp[1] = bp[0] + (size_t)128 * 1024;
        },
        [=](int j, f32x4 (&acc)[8][4], int wr, int wc, int fr, int fq) {
            int e, rt, ct; locate(j, e, rt, ct);
            const int cnt = s_cnt[e], off = s_off[e];
#pragma unroll
            for (int m = 0; m < 8; ++m) {
                const int pos = rt * 256 + wr * 128 + m * 16 + fr;
                if (pos < cnt) {
                    bf16_t* dst = H1 + (size_t)(off + pos) * 512 + ct * 128 + wc * 32 + fq * 8;
                    float h[8];
#pragma unroll
                    for (int n = 0; n < 2; ++n)
#pragma unroll
                        for (int jj = 0; jj < 4; ++jj) h[n * 4 + jj] = silu_f(acc[m][n][jj]) * acc[m][n + 2][jj];
                    uint4 o; o.x = pack2(h[0], h[1]); o.y = pack2(h[2], h[3]); o.z = pack2(h[4], h[5]); o.w = pack2(h[6], h[7]);
                    *(uint4*)dst = o;
                }
            }
        });
}

__device__ __forceinline__ void phase_moe_down(const Params& p, const Ctx& cx, char* lds, int layer) {
    const int tid = cx.tid;
    int* s_cnt = (int*)(lds + LDS_TAB_OFF); int* s_off = s_cnt + 16; int* s_toff = s_off + 17;
    moe_tables(p, layer, tid, s_cnt, s_off, s_toff);
    const int ntiles = s_toff[16];
    const bf16_t* H1 = (const bf16_t*)(p.ws + OFF_H1);
    const float* lw = (const float*)(p.ws + OFF_LW);
    bf16_t* Y = (bf16_t*)(p.ws + OFF_Y);
    float* lwc = (float*)(lds + LDS_LW_OFF);
    const int sc = stage_col2(tid), sr = tid >> 2;
    const int vb = cx.vbid, G = cx.G;
    const int my_tiles = min(8, vb < ntiles ? (ntiles - vb + G - 1) / G : 0);
    auto locate = [=](int j, int& e, int& rt, int& ct) { const int tile = vb + j * G; e = 0; while (tile >= s_toff[e + 1]) ++e; const int lt = tile - s_toff[e]; rt = lt >> 2; ct = lt & 3; };
    for (int i = tid; i < my_tiles * 256; i += NTHR) {
        const int j = i >> 8, r = i & 255; int e, rt, ct; locate(j, e, rt, ct);
        lwc[i] = lw[(size_t)e * NTOK + min(rt * 256 + r, s_cnt[e] - 1)];
    }
    __syncthreads();
    const bf16_t* Wdn = (const bf16_t*)(p.ws + OFF_W_DN) + (size_t)layer * 16 * 1024 * 512;
    gemm_stream2(my_tiles, 512, lds, cx,
        [=](int j, const bf16_t* (&ap)[2], const bf16_t* (&bp)[2]) {
            int e, rt, ct; locate(j, e, rt, ct);
            const int cnt = s_cnt[e], off = s_off[e];
            ap[0] = H1 + (size_t)(off + min(rt * 256 + sr, cnt - 1)) * 512 + sc; ap[1] = H1 + (size_t)(off + min(rt * 256 + sr + 128, cnt - 1)) * 512 + sc;
            bp[0] = Wdn + ((size_t)e * 1024 + ct * 256 + sr) * 512 + sc; bp[1] = bp[0] + (size_t)128 * 512;
        },
        [=](int j, f32x4 (&acc)[8][4], int wr, int wc, int fr, int fq) {
            int e, rt, ct; locate(j, e, rt, ct);
            const int cnt = s_cnt[e], off = s_off[e];
#pragma unroll
            for (int m = 0; m < 8; ++m) {
                const int rl_ = wr * 128 + m * 16 + fr, pos = rt * 256 + rl_;
                if (pos < cnt) {
                    const float w = lwc[j * 256 + rl_];
                    bf16_t* dst = Y + (size_t)(off + pos) * 1024 + ct * 256 + wc * 64;
#pragma unroll
                    for (int pp = 0; pp < 2; ++pp) {
                        const f32x4 a = acc[m][2 * pp], bb = acc[m][2 * pp + 1];
                        uint4 o; o.x = pack2(w * a[0], w * a[1]); o.y = pack2(w * a[2], w * a[3]); o.z = pack2(w * bb[0], w * bb[1]); o.w = pack2(w * bb[2], w * bb[3]);
                        *(uint4*)(dst + pp * 32 + fq * 8) = o;
                    }
                }
            }
        });
}


namespace pg8 {
#define PG8_LAS __attribute__((address_space(3)))
typedef unsigned short bf16_t;
typedef short bf16x8 __attribute__((ext_vector_type(8)));
typedef float f32x4 __attribute__((ext_vector_type(4)));
typedef unsigned u32x4 __attribute__((ext_vector_type(4)));
constexpr int BM = 256, BK = 64, HALF = 128, HTB = HALF * BK * 2  , STAGE_BYTES = 8 * HTB, NXCD = 8, WGM = 8;

__host__ __device__ __forceinline__ int lds_byte(int r, int c) { const int st = (r >> 4) * 2 + (c >> 5), rr = r & 15, cc = c & 31, ob = rr * 64 + cc * 2; return st * 1024 + (ob ^ (((ob >> 9) & 1) << 5)); }
__host__ __device__ __forceinline__ void stage_rc(int b, int& R, int& C) { const int st = b / 1024, sb = b % 1024, swz = sb ^ (((sb >> 9) & 1) << 5); R = (st >> 1) * 16 + swz / 64; C = (st & 1) * 32 + (swz % 64) / 2; }
__host__ __device__ __forceinline__ int perm32(int rho) { const int n = rho >> 4, i = rho & 15; return 8 * (i >> 2) + 4 * n + (i & 3); }

struct Unit { int pm, pn; };
struct Gemm { const bf16_t* A; const bf16_t* Bt; int M, N, K; };

struct StaticOrder {
    int nM, nN, nwg, G, c;
    __host__ __device__ void init(int M, int N, int G_, int c_) { nM = M / BM; nN = N / BM; nwg = nM * nN; G = G_; c = c_; }
    __host__ __device__ bool next(int i, Unit& u) const {
        const long L = (long)i * G + c; if (L >= nwg) return false;
        int wgid = (int)L; { const int q = nwg / NXCD, r = nwg % NXCD, xcd = wgid % NXCD, off = wgid / NXCD; wgid = (xcd < r ? xcd * (q + 1) : r * (q + 1) + (xcd - r) * q) + off; }
        const int nig = WGM * nN, gid = wgid / nig, fm = gid * WGM, gsz = (nM - fm) < WGM ? (nM - fm) : WGM;
        u.pm = fm + ((wgid % nig) % gsz); u.pn = (wgid % nig) / gsz; return true;
    }
    __device__ __forceinline__ void a_ready(const Unit&) const {}
    __device__ __forceinline__ void done(const Unit&) const {}
};

template <class Epi, class Sched, bool ALIGN_EPI = false, bool SP2 = false>
__device__ __forceinline__ void gemm_phase(PG8_LAS unsigned char* lds, const Gemm g, const Sched& S, const Epi& E) {
    const int tid = threadIdx.x, wid = __builtin_amdgcn_readfirstlane(tid >> 6), lane = tid & 63, wr = wid >> 2, wc = wid & 3, fr = lane & 15, fq = lane >> 4;
    const int K = g.K, nt = K / BK;
    unsigned voffA[2], voffB[2];
#pragma unroll
    for (int i = 0; i < 2; ++i) { int R, C; stage_rc(tid * 16 + i * 8192, R, C); const int Rb = Epi::PERM ? ((R & ~31) + perm32(R & 31)) : R;
        voffA[i] = (unsigned)(R * K + C) * 2u; voffB[i] = (unsigned)(Rb * K + C) * 2u; }
    const size_t kstep = (size_t)(BK * 2);
    const size_t hstep = (size_t)HALF * K * 2;
    const size_t tstep = 2 * hstep;
    const unsigned ldsw = (unsigned)wid * 1024u;
    const int aoff = lds_byte(wr * 64 + fr, fq * 8), boff = lds_byte(wc * 32 + fr, fq * 8);
#define PG8_SA(b, h) (((b) * 2 + (h)) * HTB)
#define PG8_SB(b, h) ((4 + (b) * 2 + (h)) * HTB)
#define PG8_STAGE(bufoff, gbase, voff) do { _Pragma("unroll") for (int _i = 0; _i < 2; ++_i) \
        __builtin_amdgcn_global_load_lds((const unsigned*)((const char*)(gbase) + (voff)[_i]), (PG8_LAS unsigned*)(lds + (bufoff) + ldsw + _i * 8192), 16, 0, 0); } while (0)
#define PG8_LDA(dst, b, h) do { _Pragma("unroll") for (int m = 0; m < 4; ++m) _Pragma("unroll") for (int k = 0; k < 2; ++k) dst[m][k] = *(const PG8_LAS bf16x8*)(lds + PG8_SA(b, h) + aoff + m * 2048 + k * 1024); } while (0)
#define PG8_LDB(dst, b, h) do { _Pragma("unroll") for (int n = 0; n < 2; ++n) _Pragma("unroll") for (int k = 0; k < 2; ++k) dst[n][k] = *(const PG8_LAS bf16x8*)(lds + PG8_SB(b, h) + boff + n * 2048 + k * 1024); } while (0)
#define PG8_MMA(ai, bj, At, Bt) do { __builtin_amdgcn_s_setprio(1); _Pragma("unroll") for (int m = 0; m < 4; ++m) _Pragma("unroll") for (int n = 0; n < 2; ++n) _Pragma("unroll") for (int k = 0; k < 2; ++k) \
        acc[ai][bj][m][n] = __builtin_amdgcn_mfma_f32_16x16x32_bf16(Bt[n][k], At[m][k], acc[ai][bj][m][n], 0, 0, 0); __builtin_amdgcn_s_setprio(0); } while (0)
#define PG8_WAIT_V(n) asm volatile("s_waitcnt vmcnt(" #n ")" ::: "memory")
#define PG8_WAIT_L(n) asm volatile("s_waitcnt lgkmcnt(" #n ")" ::: "memory")
#define PG8_BAR __builtin_amdgcn_s_barrier()
#define PG8_SCHED __builtin_amdgcn_sched_barrier(0)
    Unit cur, nxt; int ui = 0;
    if (!S.next(0, cur)) return;
    f32x4 acc[2][2][4][2];
#pragma unroll
    for (int a = 0; a < 2; ++a)
#pragma unroll
        for (int b = 0; b < 2; ++b)
#pragma unroll
            for (int m = 0; m < 4; ++m)
#pragma unroll
                for (int n = 0; n < 2; ++n) acc[a][b][m][n] = (f32x4){0.f, 0.f, 0.f, 0.f};
    bf16x8 At[4][2], B0[2][2], B1[2][2];
    const char* cA = (const char*)g.A + (size_t)cur.pm * tstep; const char* cB = (const char*)g.Bt + (size_t)cur.pn * tstep;
    S.a_ready(cur);
    if constexpr (SP2) {
        PG8_STAGE(PG8_SB(0, 0), cB, voffB); PG8_STAGE(PG8_SB(0, 1), cB + hstep, voffB); PG8_STAGE(PG8_SA(0, 0), cA, voffA); PG8_STAGE(PG8_SA(0, 1), cA + hstep, voffA);
        if (wr == 1) PG8_BAR;
        PG8_WAIT_V(2); PG8_BAR;
        PG8_STAGE(PG8_SB(1, 0), cB + kstep, voffB); PG8_STAGE(PG8_SA(1, 0), cA + kstep, voffA); PG8_STAGE(PG8_SB(1, 1), cB + hstep + kstep, voffB);
        PG8_WAIT_V(6); PG8_BAR;
    } else {
        PG8_STAGE(PG8_SB(0, 0), cB, voffB); PG8_STAGE(PG8_SA(0, 0), cA, voffA); PG8_STAGE(PG8_SB(0, 1), cB + hstep, voffB); PG8_STAGE(PG8_SA(0, 1), cA + hstep, voffA);
        if (wr == 1) PG8_BAR;
        PG8_WAIT_V(4); PG8_BAR;
        PG8_STAGE(PG8_SB(1, 0), cB + kstep, voffB); PG8_STAGE(PG8_SA(1, 0), cA + kstep, voffA); PG8_STAGE(PG8_SB(1, 1), cB + hstep + kstep, voffB);
        PG8_WAIT_V(6); PG8_BAR;
    }
    for (;;) {
        const bool has_next = S.next(ui + 1, nxt);
        const char* nA = has_next ? (const char*)g.A + (size_t)nxt.pm * tstep : cA; const char* nB = has_next ? (const char*)g.Bt + (size_t)nxt.pn * tstep : cB;
        for (int t = 0; t < nt; t += 2) {
            const bool last = (t == nt - 2);
            const char* a1 = cA + (size_t)(t + 1) * kstep;
            const char* a2 = last ? nA : cA + (size_t)(t + 2) * kstep; const char* b2 = last ? nB : cB + (size_t)(t + 2) * kstep;
            const char* a3 = a2 + kstep; const char* b3 = b2 + kstep;
            if (last && has_next) S.a_ready(nxt);
            if constexpr (SP2) {
            PG8_LDB(B0, 0, 0); PG8_LDB(B1, 0, 1); PG8_SCHED; PG8_LDA(At, 0, 0); PG8_STAGE(PG8_SA(1, 1), a1 + hstep, voffA);
            PG8_WAIT_V(8); PG8_WAIT_L(0); PG8_BAR; PG8_MMA(0, 0, At, B0); PG8_MMA(0, 1, At, B1); PG8_BAR; PG8_SCHED;
            PG8_LDA(At, 0, 1); PG8_STAGE(PG8_SB(0, 0), b2, voffB); PG8_STAGE(PG8_SB(0, 1), b2 + hstep, voffB); PG8_STAGE(PG8_SA(0, 0), a2, voffA);
            PG8_WAIT_V(8); PG8_WAIT_L(0); PG8_BAR; PG8_MMA(1, 0, At, B0); PG8_MMA(1, 1, At, B1); PG8_BAR; PG8_SCHED;
            PG8_LDB(B0, 1, 0); PG8_LDB(B1, 1, 1); PG8_SCHED; PG8_LDA(At, 1, 0); PG8_STAGE(PG8_SA(0, 1), a2 + hstep, voffA);
            PG8_WAIT_V(8); PG8_WAIT_L(0); PG8_BAR; PG8_MMA(0, 0, At, B0); PG8_MMA(0, 1, At, B1); PG8_BAR; PG8_SCHED;
            PG8_LDA(At, 1, 1); PG8_STAGE(PG8_SB(1, 0), b3, voffB); PG8_STAGE(PG8_SB(1, 1), b3 + hstep, voffB); PG8_STAGE(PG8_SA(1, 0), a3, voffA);
            PG8_WAIT_V(8); PG8_WAIT_L(0); PG8_BAR; PG8_MMA(1, 0, At, B0); PG8_MMA(1, 1, At, B1); PG8_BAR; PG8_SCHED;
            } else {
            PG8_LDB(B0, 0, 0); PG8_SCHED; PG8_LDA(At, 0, 0); PG8_STAGE(PG8_SA(1, 1), a1 + hstep, voffA);
            PG8_WAIT_L(8); PG8_BAR; PG8_WAIT_L(0); PG8_MMA(0, 0, At, B0); PG8_BAR; PG8_SCHED;
            PG8_LDB(B1, 0, 1); PG8_STAGE(PG8_SB(0, 0), b2, voffB);
            PG8_BAR; PG8_WAIT_L(0); PG8_MMA(0, 1, At, B1); PG8_BAR;
            PG8_LDA(At, 0, 1); PG8_STAGE(PG8_SA(0, 0), a2, voffA);
            PG8_BAR; PG8_WAIT_L(0); PG8_MMA(1, 0, At, B0); PG8_BAR; PG8_SCHED;
            PG8_STAGE(PG8_SB(0, 1), b2 + hstep, voffB);
            PG8_WAIT_V(6); PG8_BAR; PG8_MMA(1, 1, At, B1); PG8_BAR;
            PG8_LDB(B0, 1, 0); PG8_SCHED; PG8_LDA(At, 1, 0); PG8_STAGE(PG8_SA(0, 1), a2 + hstep, voffA);
            PG8_WAIT_L(8); PG8_BAR; PG8_WAIT_L(0); PG8_MMA(0, 0, At, B0); PG8_BAR; PG8_SCHED;
            PG8_LDB(B1, 1, 1); PG8_STAGE(PG8_SB(1, 0), b3, voffB);
            PG8_BAR; PG8_WAIT_L(0); PG8_MMA(0, 1, At, B1); PG8_BAR;
            PG8_LDA(At, 1, 1); PG8_STAGE(PG8_SA(1, 0), a3, voffA);
            PG8_BAR; PG8_WAIT_L(0); PG8_MMA(1, 0, At, B0); PG8_BAR; PG8_SCHED;
            PG8_STAGE(PG8_SB(1, 1), b3 + hstep, voffB);
            PG8_WAIT_V(6); PG8_BAR; PG8_MMA(1, 1, At, B1); PG8_BAR;
            }
        }
        if constexpr (ALIGN_EPI) { if (wr == 0) PG8_BAR; }
        if constexpr (!Epi::AFTER_DRAIN) { E(acc, cur, wr, wc, fr, fq); S.done(cur); }
        if (!has_next) break;
#pragma unroll
        for (int a = 0; a < 2; ++a)
#pragma unroll
            for (int b = 0; b < 2; ++b)
#pragma unroll
                for (int m = 0; m < 4; ++m)
#pragma unroll
                    for (int n = 0; n < 2; ++n) acc[a][b][m][n] = (f32x4){0.f, 0.f, 0.f, 0.f};
        cur = nxt; cA = nA; cB = nB; ++ui;
        if constexpr (ALIGN_EPI) { if (wr == 1) PG8_BAR; }
    }
    PG8_WAIT_V(0);
    if constexpr (!ALIGN_EPI) { if (wr == 0) PG8_BAR; }
    PG8_BAR;
    if constexpr (Epi::AFTER_DRAIN) { E.fused(acc, cur, wr, wc, fr, fq, lds, wid, lane); S.done(cur); }
#undef PG8_SA
#undef PG8_SB
#undef PG8_STAGE
#undef PG8_LDA
#undef PG8_LDB
#undef PG8_MMA
#undef PG8_WAIT_V
#undef PG8_WAIT_L
#undef PG8_BAR
#undef PG8_SCHED
}
}

#ifndef PG8_SP2
#define PG8_SP2 true
#endif
struct EpiHgrnIn {
    static constexpr bool PERM = false, AFTER_DRAIN = false;
    char* ws; const float* lb;
    __device__ __forceinline__ void operator()(const pg8::f32x4 (&acc)[2][2][4][2], const pg8::Unit& u, int wr, int wc, int fr, int fq) const {
#pragma unroll
        for (int ai = 0; ai < 2; ++ai)
#pragma unroll
            for (int m = 0; m < 4; ++m) {
                const int row = u.pm * 256 + ai * 128 + wr * 64 + m * 16 + fr;
#pragma unroll
                for (int bj = 0; bj < 2; ++bj) {
                    const int gc = u.pn * 256 + bj * 128 + wc * 32 + fq * 8, seg = gc >> 10, c = gc & 1023;
                    const f32x4 a0 = acc[ai][bj][m][0], a1 = acc[ai][bj][m][1];
                    float h[8];
                    if (seg == 1) {
                        const f32x4 la = *(const f32x4*)(lb + c), lbb = *(const f32x4*)(lb + c + 4);
#pragma unroll
                        for (int j = 0; j < 4; ++j) {
                            h[j] = __logf(la[j] + (1.f - la[j]) * sigmoid_f(a0[j]));
                            h[4 + j] = __logf(lbb[j] + (1.f - lbb[j]) * sigmoid_f(a1[j]));
                        }
                        uint4 oh; oh.x = packh2(h[0], h[1]); oh.y = packh2(h[2], h[3]); oh.z = packh2(h[4], h[5]); oh.w = packh2(h[6], h[7]);
                        *(uint4*)((unsigned short*)(ws + OFF_LF) + (size_t)row * 1024 + c) = oh;
                    } else {
#pragma unroll
                        for (int j = 0; j < 4; ++j) {
                            h[j] = (seg == 2) ? a0[j] : silu_f(a0[j]);
                            h[4 + j] = (seg == 2) ? a1[j] : silu_f(a1[j]);
                        }
                        uint4 o; o.x = pack2(h[0], h[1]); o.y = pack2(h[2], h[3]); o.z = pack2(h[4], h[5]); o.w = pack2(h[6], h[7]);
                        bf16_t* dst = (bf16_t*)(ws + (seg == 0 ? OFF_QH : seg == 2 ? OFF_V : OFF_G));
                        *(uint4*)(dst + (size_t)row * 1024 + c) = o;
                    }
                }
            }
    }
};

struct EpiOutProj {
    static constexpr bool PERM = false, AFTER_DRAIN = false;
    const float* mod; const float* xin; float* xo; int ls;
    __device__ __forceinline__ void operator()(const pg8::f32x4 (&acc)[2][2][4][2], const pg8::Unit& u, int wr, int wc, int fr, int fq) const {
        const int b = (u.pm * 256) >> 11;
        const float* gate = mod + ((size_t)ls * 16 + b) * 3072 + 2048 + u.pn * 256 + wc * 32 + fq * 8;
        f32x4 g[2][2];
#pragma unroll
        for (int bj = 0; bj < 2; ++bj) { g[bj][0] = *(const f32x4*)(gate + bj * 128); g[bj][1] = *(const f32x4*)(gate + bj * 128 + 4); }
#pragma unroll
        for (int ai = 0; ai < 2; ++ai)
#pragma unroll
            for (int m = 0; m < 4; ++m) {
                const size_t ro = (size_t)(u.pm * 256 + ai * 128 + wr * 64 + m * 16 + fr) * 1024 + u.pn * 256 + wc * 32 + fq * 8;
                f32x4 xi[2][2];
#pragma unroll
                for (int bj = 0; bj < 2; ++bj) { xi[bj][0] = *(const f32x4*)(xin + ro + bj * 128); xi[bj][1] = *(const f32x4*)(xin + ro + bj * 128 + 4); }
#pragma unroll
                for (int bj = 0; bj < 2; ++bj)
#pragma unroll
                    for (int n = 0; n < 2; ++n) {
                        f32x4 o;
#pragma unroll
                        for (int j = 0; j < 4; ++j) o[j] = xi[bj][n][j] + g[bj][n][j] * acc[ai][bj][m][n][j];
                        *(f32x4*)(xo + ro + bj * 128 + n * 4) = o;
                    }
            }
    }
};

__device__ __forceinline__ void phase_outproj8(const Params& p, const Ctx& cx, char* lds, const bf16_t* A, const bf16_t* Bt, const float* xin, int ls) {
    pg8::Gemm g{A, Bt, NTOK, 1024, 1024};
    pg8::StaticOrder S; S.init(NTOK, 1024, cx.G, (int)blockIdx.x);
    EpiOutProj E{(const float*)(p.ws + OFF_MOD), xin, p.out, ls};
    __syncthreads();
    pg8::gemm_phase<EpiOutProj, pg8::StaticOrder, true, PG8_SP2>((PG8_LAS unsigned char*)lds, g, S, E);
    __syncthreads();
}

__device__ __forceinline__ void phase_hgrn_inproj8(const Params& p, const Ctx& cx, char* lds) {
    pg8::Gemm g{(const bf16_t*)(p.ws + OFF_HA), (const bf16_t*)(p.ws + OFF_W_HG_IN), NTOK, 4096, 1024};
    pg8::StaticOrder S; S.init(NTOK, 4096, cx.G, (int)blockIdx.x);
    EpiHgrnIn E{p.ws, (const float*)(p.ws + OFF_LB)};
    __syncthreads();
    pg8::gemm_phase<EpiHgrnIn, pg8::StaticOrder, true, PG8_SP2>((PG8_LAS unsigned char*)lds, g, S, E);
    __syncthreads();
}

template <int MODE = 0>
__device__ __forceinline__ void phase_hgrn_inproj(const Params& p, const Ctx& cx, char* lds) {
    const bf16_t* A = (const bf16_t*)(p.ws + OFF_HA);
    const bf16_t* Bt = (const bf16_t*)(p.ws + OFF_W_HG_IN);
    char* ws = p.ws;
    const float* lb = (const float*)(p.ws + OFF_LB);
    gemm_phase_dense2(A, 1024, Bt, 1024, NTOK / 256, 16, lds, cx, [=](int row0, int col0) {
        return [=](f32x4 (&acc)[8][4], int wr, int wc, int fr, int fq) {
            const int gc0 = col0 + wc * 64, seg = gc0 >> 10, c0 = gc0 & 1023;
#pragma unroll
            for (int m = 0; m < 8; ++m) {
                const int row = row0 + wr * 128 + m * 16 + fr;
#pragma unroll
                for (int pp = 0; pp < 2; ++pp) {
                    const int c = c0 + pp * 32 + fq * 8;
                    float h[8];
                    if (seg == 1) {
                        const f32x4 la = *(const f32x4*)(lb + c), lbb = *(const f32x4*)(lb + c + 4);
#pragma unroll
                        for (int j = 0; j < 4; ++j) {
                            h[j] = __logf(la[j] + (1.f - la[j]) * sigmoid_f(acc[m][2 * pp][j]));
                            h[4 + j] = __logf(lbb[j] + (1.f - lbb[j]) * sigmoid_f(acc[m][2 * pp + 1][j]));
                        }
                        uint4 oh; oh.x = packh2(h[0], h[1]); oh.y = packh2(h[2], h[3]); oh.z = packh2(h[4], h[5]); oh.w = packh2(h[6], h[7]);
                        *(uint4*)((unsigned short*)(ws + OFF_LF) + (size_t)row * 1024 + c) = oh;
                    } else {
#pragma unroll
                        for (int j = 0; j < 4; ++j) {
                            h[j] = (seg == 2) ? acc[m][2 * pp][j] : silu_f(acc[m][2 * pp][j]);
                            h[4 + j] = (seg == 2) ? acc[m][2 * pp + 1][j] : silu_f(acc[m][2 * pp + 1][j]);
                        }
                        uint4 o; o.x = pack2(h[0], h[1]); o.y = pack2(h[2], h[3]); o.z = pack2(h[4], h[5]); o.w = pack2(h[6], h[7]);
                        bf16_t* dst = (bf16_t*)(ws + (seg == 0 ? OFF_QH : seg == 2 ? OFF_V : OFF_G));
                        *(uint4*)(dst + (size_t)row * 1024 + c) = o;
                    }
                }
            }
        };
    });
}

constexpr int HG_QD_OFF = 0, HG_KD_OFF = 8704, HG_K2T_OFF = 17408, HG_VT_OFF = 27648, HG_DEC_OFF = 37888, HG_BUF = 38400, HG_TOT_OFF = 2 * HG_BUF;
constexpr int HG_ROW = 272, HG_TROW = 80;
static_assert(HG_TOT_OFF + 2048 <= LDS_TAB_OFF, "hgrn LDS");

__device__ __forceinline__ void phase_hgrn_rec(const Params& p, const Ctx& cx, char* lds) {
    const int lane = cx.lane;
    const int l31 = lane & 31, h2 = lane >> 5;
    const int widu = __builtin_amdgcn_readfirstlane(cx.wid);
    const bool producer = widu >= 4;
    const int pw = widu & 3;
    const int d0 = 2 * lane;
    const bf16_t* QH = (const bf16_t*)(p.ws + OFF_QH);
    const unsigned short* LF = (const unsigned short*)(p.ws + OFF_LF);
    const bf16_t* V = (const bf16_t*)(p.ws + OFF_V);
    bf16_t* OR = (bf16_t*)(p.ws + OFF_HA);
    float* tot = (float*)(lds + HG_TOT_OFF);
    for (int item = blockIdx.x; item < 128; item += cx.G) {
        const int b = item >> 3, h = item & 7;
        f32x16 S0, S1, S2, S3;
#pragma unroll
        for (int r = 0; r < 16; ++r) { S0[r] = 0.f; S1[r] = 0.f; S2[r] = 0.f; S3[r] = 0.f; }
        unsigned lfA[8], lfB[8], qv[8], vv[8];
        const size_t gbase = (size_t)(b * SEQ + pw * 8) * 1024 + h * 128;
        if (producer) {
#pragma unroll
            for (int i = 0; i < 8; ++i) {
                lfA[i] = *(const unsigned*)(LF + gbase + (size_t)i * 1024 + d0);
                qv[i] = *(const unsigned*)(QH + gbase + (size_t)i * 1024 + d0);
                vv[i] = *(const unsigned*)(V + gbase + (size_t)i * 1024 + d0);
            }
#pragma unroll
            for (int i = 0; i < 8; ++i) lfB[i] = *(const unsigned*)(LF + gbase + (size_t)(32 + i) * 1024 + d0);
        }
        __syncthreads();
        for (int c = 0; c <= SEQ / 32; ++c) {
            unsigned lf[8];
#pragma unroll
            for (int i = 0; i < 8; ++i) lf[i] = (c & 1) ? lfB[i] : lfA[i];
            f2_t run = {0.f, 0.f};
            if (producer && c < SEQ / 32) {
#pragma unroll
                for (int i = 0; i < 8; ++i) run += unpackh2(lf[i]);
                *(f2_t*)(tot + pw * 128 + d0) = run;
            }
            __syncthreads();
            if (producer) {
                if (c < SEQ / 32) {
                    char* bufp = lds + (c & 1) * HG_BUF;
                    f2_t pre = {0.f, 0.f}, last = {0.f, 0.f};
#pragma unroll
                    for (int q = 0; q < 4; ++q) {
                        const f2_t tq_ = *(const f2_t*)(tot + q * 128 + d0);
                        last += tq_;
                        if (q < pw) pre += tq_;
                    }
                    if (pw == 0) { f2_t dv; dv.x = __expf(last.x); dv.y = __expf(last.y); *(f2_t*)(bufp + HG_DEC_OFF + d0 * 4) = dv; }
                    float k2a[8], k2b[8];
                    f2_t rc = pre;
#pragma unroll
                    for (int i = 0; i < 8; ++i) {
                        const f2_t lfi = unpackh2(lf[i]);
                        rc += lfi;
                        const float cu0 = rc.x, cu1 = rc.y;
                        const float kk0 = 1.f - __expf(lfi.x), kk1 = 1.f - __expf(lfi.y);
                        const float q0 = bf2f((unsigned short)(qv[i] & 0xffff)) * __expf(cu0), q1 = bf2f((unsigned short)(qv[i] >> 16)) * __expf(cu1);
                        const float kd0 = kk0 * __expf(-cu0), kd1 = kk1 * __expf(-cu1);
                        k2a[i] = kk0 * __expf(last.x - cu0); k2b[i] = kk1 * __expf(last.y - cu1);
                        const int tl = pw * 8 + i;
                        *(unsigned*)(bufp + HG_QD_OFF + tl * HG_ROW + d0 * 2) = pack2(q0, q1);
                        *(unsigned*)(bufp + HG_KD_OFF + tl * HG_ROW + d0 * 2) = pack2(kd0, kd1);
                    }
                    uint4 a, bq, va, vb;
                    a.x = pack2(k2a[0], k2a[1]); a.y = pack2(k2a[2], k2a[3]); a.z = pack2(k2a[4], k2a[5]); a.w = pack2(k2a[6], k2a[7]);
                    bq.x = pack2(k2b[0], k2b[1]); bq.y = pack2(k2b[2], k2b[3]); bq.z = pack2(k2b[4], k2b[5]); bq.w = pack2(k2b[6], k2b[7]);
                    va.x = (vv[0] & 0xffffu) | (vv[1] << 16); va.y = (vv[2] & 0xffffu) | (vv[3] << 16); va.z = (vv[4] & 0xffffu) | (vv[5] << 16); va.w = (vv[6] & 0xffffu) | (vv[7] << 16);
                    vb.x = (vv[0] >> 16) | (vv[1] & 0xffff0000u); vb.y = (vv[2] >> 16) | (vv[3] & 0xffff0000u); vb.z = (vv[4] >> 16) | (vv[5] & 0xffff0000u); vb.w = (vv[6] >> 16) | (vv[7] & 0xffff0000u);
                    *(uint4*)(bufp + HG_K2T_OFF + d0 * HG_TROW + pw * 16) = a;
                    *(uint4*)(bufp + HG_K2T_OFF + (d0 + 1) * HG_TROW + pw * 16) = bq;
                    *(uint4*)(bufp + HG_VT_OFF + d0 * HG_TROW + pw * 16) = va;
                    *(uint4*)(bufp + HG_VT_OFF + (d0 + 1) * HG_TROW + pw * 16) = vb;
                    __builtin_amdgcn_sched_barrier(0);
                    if (c + 1 < SEQ / 32) {
                        const size_t gn = gbase + (size_t)(c + 1) * 32 * 1024;
#pragma unroll
                        for (int i = 0; i < 8; ++i) {
                            qv[i] = *(const unsigned*)(QH + gn + (size_t)i * 1024 + d0);
                            vv[i] = *(const unsigned*)(V + gn + (size_t)i * 1024 + d0);
                        }
                    }
                    if (c + 2 < SEQ / 32) {
                        const size_t gn = gbase + (size_t)(c + 2) * 32 * 1024;
                        if (c & 1) {
#pragma unroll
                            for (int i = 0; i < 8; ++i) lfB[i] = *(const unsigned*)(LF + gn + (size_t)i * 1024 + d0);
                        } else {
#pragma unroll
                            for (int i = 0; i < 8; ++i) lfA[i] = *(const unsigned*)(LF + gn + (size_t)i * 1024 + d0);
                        }
                    }
                }
            } else if (c >= 1) {
                const int cc = c - 1;
                const char* bufp = lds + (cc & 1) * HG_BUF;
                const float* dec = (const float*)(bufp + HG_DEC_OFF);
                f32x16 X;
#pragma unroll
                for (int r = 0; r < 16; ++r) X[r] = 0.f;
                {
                    const char* ka = bufp + HG_KD_OFF + l31 * HG_ROW + 16 * h2;
                    const char* qa = bufp + HG_QD_OFF + l31 * HG_ROW + 16 * h2;
#pragma unroll 2
                    for (int ks = 0; ks < 8; ++ks) X = MFMA32(*(const bf16x8*)(ka + 32 * ks), *(const bf16x8*)(qa + 32 * ks), X);
#pragma unroll
                    for (int r = 0; r < 16; ++r) { const int srow = (r & 3) + 8 * (r >> 2) + 4 * h2; X[r] = (srow <= l31) ? X[r] : 0.f; }
                }
                f32x16 Oa;
#pragma unroll
                for (int r = 0; r < 16; ++r) Oa[r] = 0.f;
                const int jrow = 32 * pw + l31;
#pragma unroll
                for (int s2 = 0; s2 < 2; ++s2) {
                    uint4 xk;
                    xk.x = pack2(X[8 * s2], X[8 * s2 + 1]); xk.y = pack2(X[8 * s2 + 2], X[8 * s2 + 3]); xk.z = pack2(X[8 * s2 + 4], X[8 * s2 + 5]); xk.w = pack2(X[8 * s2 + 6], X[8 * s2 + 7]);
                    const char* va = bufp + HG_VT_OFF + jrow * HG_TROW + (16 * s2 + 4 * h2) * 2;
                    const uint2 lo = *(const uint2*)va, hi = *(const uint2*)(va + 16);
                    uint4 vb; vb.x = lo.x; vb.y = lo.y; vb.z = hi.x; vb.w = hi.y;
                    Oa = MFMA32(__builtin_bit_cast(bf16x8, xk), __builtin_bit_cast(bf16x8, vb), Oa);
                }
                auto qs_term = [&](const f32x16& St, int dt) {
#pragma unroll
                    for (int s2 = 0; s2 < 2; ++s2) {
                        uint4 sk;
                        sk.x = pack2(St[8 * s2], St[8 * s2 + 1]); sk.y = pack2(St[8 * s2 + 2], St[8 * s2 + 3]); sk.z = pack2(St[8 * s2 + 4], St[8 * s2 + 5]); sk.w = pack2(St[8 * s2 + 6], St[8 * s2 + 7]);
                        const char* qa = bufp + HG_QD_OFF + l31 * HG_ROW + (32 * dt + 16 * s2 + 4 * h2) * 2;
                        const uint2 lo = *(const uint2*)qa, hi = *(const uint2*)(qa + 16);
                        uint4 qb; qb.x = lo.x; qb.y = lo.y; qb.z = hi.x; qb.w = hi.y;
                        Oa = MFMA32(__builtin_bit_cast(bf16x8, qb), __builtin_bit_cast(bf16x8, sk), Oa);
                    }
                };
                __builtin_amdgcn_sched_barrier(0);
                qs_term(S0, 0); qs_term(S1, 1);
                __builtin_amdgcn_sched_barrier(0);
                qs_term(S2, 2); qs_term(S3, 3);
                __builtin_amdgcn_sched_barrier(0);
                {
                    bf16_t* orow = OR + (size_t)(b * SEQ + cc * 32 + 4 * h2) * 1024 + h * 128 + jrow;
#pragma unroll
                    for (int r = 0; r < 16; ++r) orow[(size_t)((r & 3) + 8 * (r >> 2)) * 1024] = f2bf(Oa[r]);
                }
                auto s_update = [&](f32x16& St, int dt) {
#pragma unroll
                    for (int rq = 0; rq < 4; ++rq) {
                        const f32x4 dc = *(const f32x4*)(dec + 32 * dt + 8 * rq + 4 * h2);
                        St[4 * rq] *= dc[0]; St[4 * rq + 1] *= dc[1]; St[4 * rq + 2] *= dc[2]; St[4 * rq + 3] *= dc[3];
                    }
#pragma unroll
                    for (int s2 = 0; s2 < 2; ++s2) {
                        const bf16x8 ka = *(const bf16x8*)(bufp + HG_K2T_OFF + (32 * dt + l31) * HG_TROW + (16 * s2 + 8 * h2) * 2);
                        const bf16x8 vb = *(const bf16x8*)(bufp + HG_VT_OFF + jrow * HG_TROW + (16 * s2 + 8 * h2) * 2);
                        St = MFMA32(ka, vb, St);
                    }
                };
                __builtin_amdgcn_sched_barrier(0);
                s_update(S0, 0); s_update(S1, 1);
                __builtin_amdgcn_sched_barrier(0);
                s_update(S2, 2); s_update(S3, 3);
                __builtin_amdgcn_sched_barrier(0);
            }
            __syncthreads();
        }
    }
}

__device__ __forceinline__ void phase_hgrn_post(const Params& p, const Ctx& cx) {
    const int lane = cx.lane;
    const bf16_t* OR = (const bf16_t*)(p.ws + OFF_HA);
    const bf16_t* Gt = (const bf16_t*)(p.ws + OFF_G);
    bf16_t* OA = (bf16_t*)(p.ws + OFF_QH);
    const int col = lane * 16;
    float gn[16];
#pragma unroll
    for (int i = 0; i < 16; ++i) gn[i] = p.hgrn_out_gain[(col & 127) + i];
    for (int row = cx.vbid * NWAVE + cx.wid; row < NTOK; row += cx.G * NWAVE) {
        const uint4 a0 = *(const uint4*)(OR + (size_t)row * 1024 + col), a1 = *(const uint4*)(OR + (size_t)row * 1024 + col + 8);
        const uint4 g0 = *(const uint4*)(Gt + (size_t)row * 1024 + col), g1 = *(const uint4*)(Gt + (size_t)row * 1024 + col + 8);
        const unsigned aw[8] = {a0.x, a0.y, a0.z, a0.w, a1.x, a1.y, a1.z, a1.w};
        const unsigned gw[8] = {g0.x, g0.y, g0.z, g0.w, g1.x, g1.y, g1.z, g1.w};
        float o[16];
        float ss = 0.f;
#pragma unroll
        for (int i = 0; i < 8; ++i) { o[2 * i] = bf2f((unsigned short)(aw[i] & 0xffff)); o[2 * i + 1] = bf2f((unsigned short)(aw[i] >> 16)); ss += o[2 * i] * o[2 * i] + o[2 * i + 1] * o[2 * i + 1]; }
        ss += __shfl_xor(ss, 1); ss += __shfl_xor(ss, 2); ss += __shfl_xor(ss, 4);
        const float r = rsqrtf(ss * (1.f / 128.f) + EPS);
        unsigned w[8];
#pragma unroll
        for (int i = 0; i < 8; ++i)
            w[i] = pack2(o[2 * i] * r * gn[2 * i] * bf2f((unsigned short)(gw[i] & 0xffff)), o[2 * i + 1] * r * gn[2 * i + 1] * bf2f((unsigned short)(gw[i] >> 16)));
        uint4 o0, o1; o0.x = w[0]; o0.y = w[1]; o0.z = w[2]; o0.w = w[3]; o1.x = w[4]; o1.y = w[5]; o1.z = w[6]; o1.w = w[7];
        *(uint4*)(OA + (size_t)row * 1024 + col) = o0;
        *(uint4*)(OA + (size_t)row * 1024 + col + 8) = o1;
    }
}


#define XB_TMO      128
#define XB_XCNT(j)  (256  + 64 * (j))
#define XB_XSUB(j)  (1280 + 64 * (j))
#define XB_XGEN(j)  (2304 + 64 * (j))
#define XB_TOP      3328
#define XB_TOPGEN   3392
#define XCD_BAR_WORDS 3456
#define XB_SPIN_CAP (1u << 20)
#define LAS __attribute__((address_space(3)))
__device__ __forceinline__ unsigned xb_ld(unsigned* p)              { return __hip_atomic_load(p, __ATOMIC_RELAXED, __HIP_MEMORY_SCOPE_AGENT); }
__device__ __forceinline__ unsigned xb_add(unsigned* p, unsigned v) { return __hip_atomic_fetch_add(p, v, __ATOMIC_RELAXED, __HIP_MEMORY_SCOPE_AGENT); }
__device__ __forceinline__ unsigned xb_xcc_id() { return (unsigned)__builtin_amdgcn_s_getreg((3 << 11) | 20) & 0xFu; }
#define XB_SPIN(cond, bar) do { unsigned _sp = 0; while (cond) { __builtin_amdgcn_s_sleep(1); \
    if ((++_sp & 255u) == 0u) { if (xb_ld(&(bar)[XB_TMO])) break; if (_sp > XB_SPIN_CAP) { atomicAdd(&(bar)[XB_TMO], 1u); break; } } } } while (0)
struct XcdBarrier { unsigned* bar; unsigned x; volatile unsigned* st; };
__device__ __forceinline__ XcdBarrier xcd_barrier_post(unsigned* bar, volatile unsigned* st) {
    XcdBarrier b; b.bar = bar; b.x = xb_xcc_id(); b.st = st;
    if (threadIdx.x == 0) (void)xb_add(&bar[XB_XCNT(b.x)], 1u);
    return b;
}
__device__ __forceinline__ void xcd_barrier_complete(unsigned* bar, unsigned x, unsigned& nloc, unsigned& nx) {
    const unsigned G = gridDim.x * gridDim.y * gridDim.z;
    unsigned sum, cnt, mine, sp = 0u;
    for (;;) {
        sum = 0u; cnt = 0u; mine = 0u;
#pragma unroll
        for (unsigned j = 0; j < 16; ++j) { const unsigned c = xb_ld(&bar[XB_XCNT(j)]); sum += c; cnt += (c > 0u) ? 1u : 0u; mine = (j == x) ? c : mine; }
        if (sum == G) break;
        __builtin_amdgcn_s_sleep(1);
        if ((++sp & 255u) == 0u) { if (xb_ld(&bar[XB_TMO])) break; if (sp > XB_SPIN_CAP) { atomicAdd(&bar[XB_TMO], 1u); break; } }
    }
    nloc = mine > 0u ? mine : 1u; nx = cnt > 0u ? cnt : 1u;
}
__device__ __forceinline__ void xcd_barrier(const XcdBarrier& b) {
    asm volatile("s_waitcnt vmcnt(0)" ::: "memory");
    __syncthreads();
    if (threadIdx.x == 0) {
        unsigned* bar = b.bar;
        __builtin_amdgcn_s_waitcnt(0);
        unsigned nloc = b.st[0], nx = b.st[1];
        if (nloc == 0u) { xcd_barrier_complete(bar, b.x, nloc, nx); b.st[0] = nloc; b.st[1] = nx; }
        const unsigned old = xb_add(&bar[XB_XSUB(b.x)], 1u);
        const unsigned gen = old / nloc;
        if (old + 1u == (gen + 1u) * nloc) {
            __builtin_amdgcn_fence(__ATOMIC_RELEASE, "agent");
            asm volatile("s_waitcnt vmcnt(0)" ::: "memory");
            const unsigned og = xb_add(&bar[XB_TOP], 1u);
            const unsigned tg = og / nx;
            if (og + 1u == (tg + 1u) * nx) xb_add(&bar[XB_TOPGEN], 1u);
            else XB_SPIN(xb_ld(&bar[XB_TOPGEN]) == tg, bar);
            __builtin_amdgcn_fence(__ATOMIC_ACQUIRE, "agent");
            xb_add(&bar[XB_XGEN(b.x)], 1u);
            asm volatile("s_waitcnt vmcnt(0)" ::: "memory");
        } else {
            XB_SPIN(xb_ld(&bar[XB_XGEN(b.x)]) == gen, bar);
            __builtin_amdgcn_fence(__ATOMIC_ACQUIRE, "agent");
            asm volatile("s_waitcnt vmcnt(0)" ::: "memory");
        }
    }
    __syncthreads();
}

template <int PH>
__device__ __forceinline__ void run_phase(const Params& p, const Ctx& cx, char* lds) {
    if constexpr (PH == 0) phase0(p, cx, lds);
    else if constexpr (PH == 1) rows_phase<false, true, false>(p, cx, lds, p.x, nullptr, 0, 0, 0, 0);
    else if constexpr (PH == 2) phase_nsa_inproj(p, cx, lds);
    else if constexpr (PH == 3) {
        phase_cmp1(p, cx, lds);
        const int w = cx.vbid >= 64 ? cx.vbid - 64 : -1, nw = cx.G - 64;
        transpose_range(p, lds, cx.tid, w, nw, TC2, TC4);
        transpose_range(p, lds, cx.tid, w, nw, TC5, TC_UP1);
        transpose_range(p, lds, cx.tid, w, nw, TC6, TC_DN1);
    }
    else if constexpr (PH == 4) phase_cmp2(p, cx);
    else if constexpr (PH == 5) phase_attn(p, cx, lds);
    else if constexpr (PH == 6) phase_outproj8(p, cx, lds, (const bf16_t*)(p.ws + OFF_HA), (const bf16_t*)(p.ws + OFF_W_NSA_OUT), p.x, 0);
    else if constexpr (PH == 7) rows_router_phase(p, cx, lds, p.out, 1, 0);
    else if constexpr (PH == 8) phase_moe_up(p, cx, lds, 0);
    else if constexpr (PH == 9) phase_moe_down(p, cx, lds, 0);
    else if constexpr (PH == 10) { float* xo = p.out; asm volatile("" : "+s"(xo)); rows_phase<true, true, false>(p, cx, lds, xo, xo, 1, 2, 0, 0); }
    else if constexpr (PH == 11) phase_hgrn_inproj8(p, cx, lds);
    else if constexpr (PH == 12) {
        phase_hgrn_rec(p, cx, lds);
        const int w = (int)blockIdx.x >= 128 ? (int)blockIdx.x - 128 : -1, nw = cx.G - 128;
        transpose_range(p, lds, cx.tid, w, nw, TC_UP1, TC6);
        transpose_range(p, lds, cx.tid, w, nw, TC_DN1, TC_END);
    }
    else if constexpr (PH == 13) phase_hgrn_post(p, cx);
    else if constexpr (PH == 14) phase_outproj8(p, cx, lds, (const bf16_t*)(p.ws + OFF_QH), (const bf16_t*)(p.ws + OFF_W_HG_OUT), p.out, 2);
    else if constexpr (PH == 15) rows_router_phase(p, cx, lds, p.out, 3, 1);
    else if constexpr (PH == 16) phase_moe_up(p, cx, lds, 1);
    else if constexpr (PH == 17) phase_moe_down(p, cx, lds, 1);
    else if constexpr (PH == 18) { float* xo = p.out; asm volatile("" : "+s"(xo)); rows_phase<true, false, false>(p, cx, lds, xo, xo, 3, 0, 0, 1); }
}

__device__ __forceinline__ Ctx make_ctx() {
    Ctx cx;
    cx.G = gridDim.x; cx.tid = threadIdx.x; cx.wid = threadIdx.x >> 6; cx.lane = threadIdx.x & 63;
    cx.vbid = (cx.G % 8 == 0) ? (blockIdx.x % 8) * (cx.G / 8) + blockIdx.x / 8 : blockIdx.x;
    return cx;
}

#if MULTI_LAUNCH
template <int PH>
__global__ void __launch_bounds__(NTHR, 2) phase_kernel(Params p) {
    extern __shared__ __attribute__((aligned(16))) char lds[];
    const Ctx cx = make_ctx();
    run_phase<PH>(p, cx, lds);
}
template <int PH>
static void launch_phases(const Params& p, int grid, hipStream_t stream) {
    (void)hipFuncSetAttribute((const void*)phase_kernel<PH>, hipFuncAttributeMaxDynamicSharedMemorySize, LDS_BYTES);
    hipLaunchKernelGGL(phase_kernel<PH>, dim3(grid), dim3(NTHR), LDS_BYTES, stream, p);
    if constexpr (PH + 1 < NPHASE) launch_phases<PH + 1>(p, grid, stream);
}
#else
template <int PH>
__device__ __forceinline__ void run_from(const Params& p, const Ctx& cx, char* lds, cg::grid_group& grid, const XcdBarrier& xb) {
    {
        int t_ = threadIdx.x, b_ = blockIdx.x;
        asm volatile("" : "+v"(t_), "+s"(b_));
        Ctx c2;
        c2.G = gridDim.x; c2.tid = t_; c2.wid = t_ >> 6; c2.lane = t_ & 63;
        c2.vbid = (c2.G % 8 == 0) ? (b_ % 8) * (c2.G / 8) + b_ / 8 : b_;
        run_phase<PH>(p, c2, lds);
#ifdef PROBE_MASK
        if constexpr ((PROBE_MASK >> PH) & 1) { xcd_barrier(xb); run_phase<PH>(p, c2, lds); }
#endif
    }
    if constexpr (PH + 1 < NPHASE) {
        if constexpr (PH == 0) grid.sync();
        else xcd_barrier(xb);
        run_from<PH + 1>(p, cx, lds, grid, xb);
    }
}
__global__ void __launch_bounds__(NTHR, 2) mega_kernel(Params p) {
    extern __shared__ __attribute__((aligned(16))) char lds[];
    cg::grid_group grid = cg::this_grid();
    const Ctx cx = make_ctx();
    volatile unsigned* st = (volatile unsigned*)(lds + LDS_BYTES - 16);
    if (threadIdx.x == 0) { st[0] = 0u; st[1] = 0u; }
    __syncthreads();
    const XcdBarrier xb = xcd_barrier_post((unsigned*)(p.ws + OFF_BAR), st);
    run_from<0>(p, cx, lds, grid, xb);
}
#endif

extern "C" void kernel_launch(void* const* d_in, const int* in_sizes, int n_in, void* d_out, int out_size, void* d_ws, size_t ws_size,
                              hipStream_t stream) {
    static int grid = 0;
    if (!grid) {
        int dev = 0, cus = 0, per_cu = 0;
        (void)hipGetDevice(&dev);
        (void)hipDeviceGetAttribute(&cus, hipDeviceAttributeMultiprocessorCount, dev);
#if MULTI_LAUNCH
        per_cu = 1;
#else
        (void)hipFuncSetAttribute((const void*)mega_kernel, hipFuncAttributeMaxDynamicSharedMemorySize, LDS_BYTES);
        (void)hipOccupancyMaxActiveBlocksPerMultiprocessor(&per_cu, mega_kernel, NTHR, LDS_BYTES);
        if (per_cu > 1) per_cu = 1;
        if (per_cu < 1) { fprintf(stderr, "kernel_launch: occupancy query says 0 blocks per CU (LDS %d B)\n", LDS_BYTES); per_cu = 1; }
#endif
        if (cus <= 0) cus = 256;
        grid = cus * per_cu;
        if (ws_size < WS_NEED) fprintf(stderr, "kernel_launch: workspace too small: %zu < %zu\n", ws_size, (size_t)WS_NEED);
    }
    Params p{};
    p.x = (const float*)d_in[0]; p.c = (const float*)d_in[1]; p.ada_w = (const float*)d_in[2]; p.ada_b = (const float*)d_in[3];
    p.norm_g = (const float*)d_in[4]; p.rel_bias = (const float*)d_in[5]; p.nsa_w_in = (const float*)d_in[6]; p.nsa_q_gain = (const float*)d_in[7];
    p.nsa_k_gain = (const float*)d_in[8]; p.nsa_cmp_pe = (const float*)d_in[9]; p.nsa_cmp_w1 = (const float*)d_in[10]; p.nsa_cmp_w2 = (const float*)d_in[11];
    p.nsa_w_out = (const float*)d_in[12]; p.hgrn_w_in = (const float*)d_in[13]; p.hgrn_lb = (const float*)d_in[14]; p.hgrn_out_gain = (const float*)d_in[15];
    p.hgrn_w_out = (const float*)d_in[16]; p.moe_rg = (const float*)d_in[17]; p.moe_re = (const float*)d_in[18]; p.moe_w1 = (const float*)d_in[19];
    p.moe_w3 = (const float*)d_in[20]; p.moe_w2 = (const float*)d_in[21];
    p.out = (float*)d_out; p.ws = (char*)d_ws;
#if MULTI_LAUNCH
    launch_phases<0>(p, grid, stream);
#else
    p.p_begin = 0; p.p_end = NPHASE;
    (void)hipMemsetAsync((char*)d_ws + OFF_BAR, 0, XCD_BAR_WORDS * 4, stream);
    void* args[] = {&p};
    hipError_t e = hipLaunchCooperativeKernel((void*)mega_kernel, dim3(grid), dim3(NTHR), args, LDS_BYTES, stream);
    if (e != hipSuccess) fprintf(stderr, "cooperative launch failed: %s (grid %d)\n", hipGetErrorString(e), grid);
#endif
}
```

```cpp
#include <hip/hip_runtime.h>
#include <hip/hip_cooperative_groups.h>
#include <cstdio>
#include <cstdint>
namespace cg = cooperative_groups;

#ifndef MULTI_LAUNCH
#define MULTI_LAUNCH 0
#endif

typedef unsigned short bf16_t;
typedef short bf16x8 __attribute__((ext_vector_type(8)));
typedef float f32x4 __attribute__((ext_vector_type(4)));
typedef float f32x16 __attribute__((ext_vector_type(16)));

constexpr int NTOK = 32768, DM = 1024, SEQ = 2048, NBATCH = 16;
constexpr int NSA_IN = 2608, NSA_IN_PAD = 2816;
constexpr float EPS = 1e-6f;
constexpr size_t MiB = 1ull << 20;

constexpr size_t OFF_CNT = 0;
constexpr size_t OFF_MOD = 4096;
constexpr size_t OFF_LB = OFF_MOD + 786432;
constexpr size_t OFF_PEB = OFF_LB + 4096;
constexpr size_t OFF_BAR = 921600;
constexpr size_t OFF_W_NSA_IN = 1 * MiB;
constexpr size_t OFF_W_NSA_OUT = OFF_W_NSA_IN + 2816ull * 1024 * 2;
constexpr size_t OFF_W_HG_IN = OFF_W_NSA_OUT + 1024ull * 1024 * 2;
constexpr size_t OFF_W_HG_OUT = OFF_W_HG_IN + 4096ull * 1024 * 2;
constexpr size_t OFF_W_CMP1 = OFF_W_HG_OUT + 1024ull * 1024 * 2;
constexpr size_t OFF_W_UP = OFF_W_CMP1 + 2ull * 128 * 2048 * 2;
constexpr size_t OFF_W_DN = OFF_W_UP + 32ull * 1024 * 1024 * 2;
constexpr size_t OFF_W_END = OFF_W_DN + 32ull * 1024 * 512 * 2;
constexpr size_t OFF_HA = 116 * MiB;
static_assert(OFF_W_END <= OFF_HA, "weights overflow");
constexpr size_t OFF_SCR = 180 * MiB;
constexpr size_t OFF_Q = OFF_SCR;
constexpr size_t OFF_KCRAW = OFF_Q + 64 * MiB;
constexpr size_t OFF_VCRAW = OFF_KCRAW + 17 * MiB;
constexpr size_t OFF_KS = OFF_VCRAW + 17 * MiB;
constexpr size_t OFF_VS = OFF_KS + 16 * MiB;
constexpr size_t OFF_KW = OFF_VS + 16 * MiB;
constexpr size_t OFF_VW = OFF_KW + 16 * MiB;
constexpr size_t OFF_GATES = OFF_VW + 16 * MiB;
constexpr size_t OFF_T1 = OFF_GATES + 6 * MiB;
constexpr size_t OFF_KC = OFF_T1 + 4 * MiB;
constexpr size_t OFF_VC = OFF_KC + 1 * MiB;
constexpr size_t OFF_H1 = OFF_SCR;
constexpr size_t OFF_Y = OFF_H1 + 64 * MiB;
constexpr size_t OFF_LTOK = OFF_Y + 128 * MiB;
constexpr size_t OFF_LW = OFF_LTOK + 2 * MiB;
constexpr size_t OFF_TSLOT = OFF_LW + 2 * MiB;
constexpr size_t OFF_QH = OFF_SCR;
constexpr size_t OFF_LF = OFF_QH + 64 * MiB;
constexpr size_t OFF_V = OFF_LF + 128 * MiB;
constexpr size_t OFF_G = OFF_V + 64 * MiB;
constexpr size_t WS_NEED = OFF_G + 64 * MiB;
static_assert(WS_NEED <= 512 * MiB, "ws overflow");

constexpr int NTHR = 512, NWAVE = 8;
constexpr int GEMM_STAGE = 49152, GEMM_NSTAGE = 3;
constexpr int LDS_TAB_OFF = GEMM_STAGE * GEMM_NSTAGE;
constexpr int LDS_BYTES = LDS_TAB_OFF + 256 + 16;
constexpr int NPHASE = 19;

struct Params {
    const float *x, *c, *ada_w, *ada_b, *norm_g, *rel_bias, *nsa_w_in, *nsa_q_gain, *nsa_k_gain, *nsa_cmp_pe, *nsa_cmp_w1,
        *nsa_cmp_w2, *nsa_w_out, *hgrn_w_in, *hgrn_lb, *hgrn_out_gain, *hgrn_w_out, *moe_rg, *moe_re, *moe_w1, *moe_w3, *moe_w2;
    float* out;
    char* ws;
    int p_begin, p_end;
};

__device__ __forceinline__ float bf2f(unsigned short h) { return __uint_as_float((unsigned)h << 16); }
__device__ __forceinline__ unsigned short f2bf(float f) {
    unsigned u = __float_as_uint(f);
    u += 0x7fffu + ((u >> 16) & 1u);
    return (unsigned short)(u >> 16);
}
typedef __bf16 bf2_t __attribute__((ext_vector_type(2)));
typedef float f2_t __attribute__((ext_vector_type(2)));
__device__ __forceinline__ unsigned pack2(float a, float b) {
    f2_t v = {a, b};
    return __builtin_bit_cast(unsigned, __builtin_convertvector(v, bf2_t));
}
typedef _Float16 h2_t __attribute__((ext_vector_type(2)));
__device__ __forceinline__ unsigned packh2(float a, float b) { f2_t v = {a, b}; return __builtin_bit_cast(unsigned, __builtin_convertvector(v, h2_t)); }
__device__ __forceinline__ f2_t unpackh2(unsigned u) { return __builtin_convertvector(__builtin_bit_cast(h2_t, u), f2_t); }
__device__ __forceinline__ float wave_sum(float v) {
#pragma unroll
    for (int o = 32; o; o >>= 1) v += __shfl_xor(v, o);
    return v;
}
__device__ __forceinline__ float wave_max(float v) {
#pragma unroll
    for (int o = 32; o; o >>= 1) v = fmaxf(v, __shfl_xor(v, o));
    return v;
}
__device__ __forceinline__ float silu_f(float x) { return x * __builtin_amdgcn_rcpf(1.f + __builtin_amdgcn_exp2f(-1.4426950408889634f * x)); }
__device__ __forceinline__ float sigmoid_f(float x) { return __builtin_amdgcn_rcpf(1.f + __builtin_amdgcn_exp2f(-1.4426950408889634f * x)); }
__device__ __forceinline__ void glds16(const void* g, void* l) {
    __builtin_amdgcn_global_load_lds((const unsigned*)g, (unsigned*)l, 16, 0, 0);
}
__device__ __forceinline__ int t5_bucket(int n) {
    if (n < 16) return n;
    int b = 16;
    b += (n >= 21); b += (n >= 27); b += (n >= 35); b += (n >= 46); b += (n >= 59); b += (n >= 77); b += (n >= 99); b += (n >= 128);
    b += (n >= 166); b += (n >= 216); b += (n >= 280); b += (n >= 363); b += (n >= 470); b += (n >= 609); b += (n >= 790);
    return b;
}

struct Ctx {
    int G, vbid, tid, wid, lane;
};

constexpr int P0_MOD_ITEMS = 192;
constexpr int TS0 = 88 * 16, TS1 = 32 * 16, TS2 = 128 * 16, TS3 = 32 * 16, TS4 = 2 * 4 * 32, TS5 = 32 * 32 * 16, TS6 = 32 * 32 * 8;
constexpr int TC0 = 0, TC1 = TC0 + TS0, TC2 = TC1 + TS1, TC3 = TC2 + TS2, TC4 = TC3 + TS3, TC5 = TC4 + TS4, TC6 = TC5 + TS5, TC_END = TC6 + TS6;

struct TrJob { const float* src; int ld, c0, ncols_valid, k0; bf16_t* dst; int dstld; int perm; };
__device__ __forceinline__ int pcol(int n, int fq) { return (n >> 1) * 32 + fq * 8 + (n & 1) * 4; }
__device__ __forceinline__ void tr_load(const TrJob& j, float* tl, int htid) {
    const int k = htid >> 2, cc = (htid & 3) * 8;
    const float* s = j.src + (size_t)(j.k0 + k) * j.ld + j.c0 + cc;
    f32x4 a = {0.f, 0.f, 0.f, 0.f}, c = a;
    if (j.c0 + 32 <= j.ncols_valid) { a = *(const f32x4*)s; c = *(const f32x4*)(s + 4); }
    else {
#pragma unroll
        for (int i = 0; i < 4; ++i) { if (j.c0 + cc + i < j.ncols_valid) a[i] = s[i]; if (j.c0 + cc + 4 + i < j.ncols_valid) c[i] = s[4 + i]; }
    }
#pragma unroll
    for (int i = 0; i < 4; ++i) { tl[k * 33 + cc + i] = a[i]; tl[k * 33 + cc + 4 + i] = c[i]; }
}
__device__ __forceinline__ void tr_store(const TrJob& j, const float* tl, int htid) {
    const int nsrc = htid >> 3, kc = (htid & 7) * 8;
    const int n = nsrc;
    const int nd = j.perm ? (((nsrc >> 2) & 1) * 16 + (nsrc >> 3) * 4 + (nsrc & 3)) : nsrc;
    uint4 o;
    o.x = pack2(tl[(kc + 0) * 33 + n], tl[(kc + 1) * 33 + n]); o.y = pack2(tl[(kc + 2) * 33 + n], tl[(kc + 3) * 33 + n]);
    o.z = pack2(tl[(kc + 4) * 33 + n], tl[(kc + 5) * 33 + n]); o.w = pack2(tl[(kc + 6) * 33 + n], tl[(kc + 7) * 33 + n]);
    *(uint4*)(j.dst + (size_t)nd * j.dstld + kc) = o;
}
__device__ __forceinline__ TrJob tr_job(const Params& p, int tt) {
    TrJob j;
    if (tt < TC1) {
        const int nt = tt / 16, kt = tt % 16;
        j = {p.nsa_w_in, NSA_IN, nt * 32, NSA_IN, kt * 64, (bf16_t*)(p.ws + OFF_W_NSA_IN) + (size_t)nt * 32 * 1024 + kt * 64, 1024, 1};
    } else if (tt < TC2) {
        const int u = tt - TC1, nt = u / 16, kt = u % 16;
        j = {p.nsa_w_out, 1024, nt * 32, 1024, kt * 64, (bf16_t*)(p.ws + OFF_W_NSA_OUT) + (size_t)nt * 32 * 1024 + kt * 64, 1024, 1};
    } else if (tt < TC3) {
        const int u = tt - TC2, nt = u / 16, kt = u % 16;
        j = {p.hgrn_w_in, 4096, nt * 32, 4096, kt * 64, (bf16_t*)(p.ws + OFF_W_HG_IN) + (size_t)nt * 32 * 1024 + kt * 64, 1024, 1};
    } else if (tt < TC4) {
        const int u = tt - TC3, nt = u / 16, kt = u % 16;
        j = {p.hgrn_w_out, 1024, nt * 32, 1024, kt * 64, (bf16_t*)(p.ws + OFF_W_HG_OUT) + (size_t)nt * 32 * 1024 + kt * 64, 1024, 1};
    } else if (tt < TC5) {
        const int u = tt - TC4, kv = u / 128, r = u % 128, nt = r / 32, kt = r % 32;
        j = {p.nsa_cmp_w1 + (size_t)kv * 2048 * 64, 64, nt * 32, 64, kt * 64, (bf16_t*)(p.ws + OFF_W_CMP1) + ((size_t)kv * 128 + nt * 32) * 2048 + kt * 64, 2048, 0};
    } else if (tt < TC6) {
        const int u = tt - TC5, le = u / 512, r = u % 512, gr = r / 16, kt = r % 16;
        const int ct = gr >> 3, which = (gr >> 2) & 1, sub = gr & 3;
        const float* src = (which ? p.moe_w3 : p.moe_w1) + (size_t)le * 1024 * 512;
        j = {src, 512, (ct * 4 + sub) * 32, 512, kt * 64, (bf16_t*)(p.ws + OFF_W_UP) + ((size_t)le * 1024 + gr * 32) * 1024 + kt * 64, 1024, 1};
    } else {
        const int u = tt - TC6, le = u / 256, r = u % 256, nt = r / 8, kt = r % 8;
        j = {p.moe_w2 + (size_t)le * 512 * 1024, 1024, nt * 32, 1024, kt * 64, (bf16_t*)(p.ws + OFF_W_DN) + ((size_t)le * 1024 + nt * 32) * 512 + kt * 64, 512, 1};
    }
    return j;
}

__device__ __forceinline__ void transpose_range(const Params& p, char* lds, int tid, int worker, int nworkers, int lo, int hi) {
    if (worker < 0) return;
    constexpr int TPH = 4;
    const int half = tid >> 8, htid = tid & 255;
    float* tl = (float*)lds + half * (TPH * 64 * 33);
    for (int base = lo + worker * 2 * TPH; base < hi; base += nworkers * 2 * TPH) {
#pragma unroll
        for (int q = 0; q < TPH; ++q) {
            const int tt = base + half * TPH + q;
            if (tt < hi) { const TrJob j = tr_job(p, tt); tr_load(j, tl + q * (64 * 33), htid); }
        }
        __syncthreads();
#pragma unroll
        for (int q = 0; q < TPH; ++q) {
            const int tt = base + half * TPH + q;
            if (tt < hi) { const TrJob j = tr_job(p, tt); tr_store(j, tl + q * (64 * 33), htid); }
        }
        __syncthreads();
    }
}
constexpr int TC_UP1 = TC5 + 16 * 512, TC_DN1 = TC6 + 16 * 256;

__device__ __forceinline__ void phase0(const Params& p, const Ctx& cx, char* lds) {
    const int tid = cx.tid, wid = cx.wid, lane = cx.lane;
    for (int it = cx.vbid; it < P0_MOD_ITEMS; it += cx.G) {
        const int colbase = it * 64, ls = colbase / 3072, e0 = colbase % 3072;
        const float* W = p.ada_w + (size_t)ls * 1024 * 3072 + e0 + lane;
        float* cs = (float*)lds + wid * 1024;
        float* red = (float*)lds + 8192;
        float acc[16];
#pragma unroll
        for (int b = 0; b < 16; ++b) acc[b] = 0.f;
        for (int sub = 0; sub < 2; ++sub) {
            const int kb = wid * 128 + sub * 64;
#pragma unroll
            for (int b = 0; b < 16; ++b) cs[lane * 16 + b] = silu_f(p.c[b * 1024 + kb + lane]);
            __builtin_amdgcn_wave_barrier();
#pragma unroll 1
            for (int k16 = 0; k16 < 64; k16 += 16) {
                float wv[16];
#pragma unroll
                for (int u = 0; u < 16; ++u) wv[u] = W[(size_t)(kb + k16 + u) * 3072];
#pragma unroll
                for (int u = 0; u < 16; ++u) {
                    const float w = wv[u];
                    const f32x4* cv = (const f32x4*)(cs + (k16 + u) * 16);
#pragma unroll
                    for (int q = 0; q < 4; ++q) {
                        f32x4 c4 = cv[q];
                        acc[q * 4 + 0] += c4[0] * w; acc[q * 4 + 1] += c4[1] * w; acc[q * 4 + 2] += c4[2] * w; acc[q * 4 + 3] += c4[3] * w;
                    }
                }
            }
            __builtin_amdgcn_wave_barrier();
        }
#pragma unroll
        for (int b = 0; b < 16; ++b) red[(wid * 16 + b) * 64 + lane] = acc[b];
        __syncthreads();
        float* mod = (float*)(p.ws + OFF_MOD);
#pragma unroll
        for (int i = 0; i < 2; ++i) {
            const int o = tid + i * NTHR, b = o >> 6, e = o & 63;
            float sm = 0.f;
#pragma unroll
            for (int w = 0; w < 8; ++w) sm += red[(w * 16 + b) * 64 + e];
            mod[((size_t)ls * 16 + b) * 3072 + e0 + e] = sm + p.ada_b[ls * 3072 + e0 + e];
        }
        __syncthreads();
    }
    transpose_range(p, lds, tid, cx.vbid, cx.G, TC0, TC2);
    transpose_range(p, lds, tid, cx.vbid, cx.G, TC4, TC5);
    if (cx.vbid == cx.G - 1) {
        float* lb = (float*)(p.ws + OFF_LB);
        for (int i = tid; i < 1024; i += NTHR) lb[i] = sigmoid_f(p.hgrn_lb[1024 + i] - p.hgrn_lb[i]);
        if (tid < 128) {
            const int kv = tid >> 6, d = tid & 63;
            const float* pe = p.nsa_cmp_pe + kv * 2048;
            const float* w1 = p.nsa_cmp_w1 + (size_t)kv * 2048 * 64 + d;
            float sm = 0.f;
            for (int k = 0; k < 2048; ++k) sm += pe[k] * w1[(size_t)k * 64];
            ((float*)(p.ws + OFF_PEB))[tid] = sm;
        }
        if (tid < 32) ((int*)(p.ws + OFF_CNT))[tid] = 0;
    }
}

template <bool COMBINE, bool NORM, bool ROUTER>
__device__ __forceinline__ void rows_phase(const Params& p, const Ctx& cx, char* lds, const float* __restrict__ src, float* __restrict__ xdst,
                           int ls_comb, int ls_norm, int layer_router, int layer_comb) {
    static_assert(!ROUTER, "router rows use rows_router_phase");
    const int lane = cx.lane;
    const float* mod = (const float*)(p.ws + OFF_MOD);
    int my_off = 0;
    if (COMBINE) {
        const int* cnt = (const int*)(p.ws + OFF_CNT) + layer_comb * 16;
        int cv[15];
#pragma unroll
        for (int e = 0; e < 15; ++e) cv[e] = cnt[e];
#pragma unroll
        for (int e = 0; e < 15; ++e) my_off += (e < lane) ? cv[e] : 0;
    }
    const int rpw = (NTOK + cx.G * NWAVE - 1) / (cx.G * NWAVE);
    const int row_begin = (cx.vbid * NWAVE + cx.wid) * rpw, row_end = min(NTOK, row_begin + rpw);
    if (row_begin >= row_end) return;
    const bf16_t* Y = (const bf16_t*)(p.ws + OFF_Y);
    const int* tsl = (const int*)(p.ws + OFF_TSLOT);
    bf16_t* hA = (bf16_t*)(p.ws + OFF_HA);
    const float* gain = p.norm_g + ls_norm * 1024;
    auto yrow = [&](int sw) -> size_t { return (size_t)(__shfl(my_off, sw >> 16) + (sw & 0xffff)) * 1024; };
    f32x4 vn[4];
    uint2 yan[4], ycn[4];
    int t0n = 0, t1n = 0;
#pragma unroll
    for (int i = 0; i < 4; ++i) vn[i] = *(const f32x4*)(src + (size_t)row_begin * 1024 + (i * 64 + lane) * 4);
    if (COMBINE) {
        const size_t ra = yrow(tsl[row_begin * 2]), rc = yrow(tsl[row_begin * 2 + 1]);
#pragma unroll
        for (int i = 0; i < 4; ++i) { yan[i] = *(const uint2*)(Y + ra + (i * 64 + lane) * 4); ycn[i] = *(const uint2*)(Y + rc + (i * 64 + lane) * 4); }
        if (row_begin + 1 < row_end) { t0n = tsl[(row_begin + 1) * 2]; t1n = tsl[(row_begin + 1) * 2 + 1]; }
    }
    f32x4 gt[4], ca[4], cb[4];
    int bcur = -1;
    for (int row = row_begin; row < row_end; ++row) {
        const int b = row >> 11;
        if (b != bcur) {
            bcur = b;
#pragma unroll
            for (int i = 0; i < 4; ++i) {
                const int col = (i * 64 + lane) * 4;
                if (COMBINE) gt[i] = *(const f32x4*)(mod + ((size_t)ls_comb * 16 + b) * 3072 + 2048 + col);
                if (NORM) {
                    const float* shift = mod + ((size_t)ls_norm * 16 + b) * 3072;
                    const f32x4 g = *(const f32x4*)(gain + col), sc = *(const f32x4*)(shift + 1024 + col);
                    ca[i] = g * (sc + 1.f);
                    cb[i] = *(const f32x4*)(shift + col);
                }
            }
        }
        f32x4 v[4];
        uint2 ya[4], yc[4];
#pragma unroll
        for (int i = 0; i < 4; ++i) { v[i] = vn[i]; if (COMBINE) { ya[i] = yan[i]; yc[i] = ycn[i]; } }
        if (row + 1 < row_end) {
#pragma unroll
            for (int i = 0; i < 4; ++i) vn[i] = *(const f32x4*)(src + (size_t)(row + 1) * 1024 + (i * 64 + lane) * 4);
            if (COMBINE) {
                const size_t ra = yrow(t0n), rc = yrow(t1n);
#pragma unroll
                for (int i = 0; i < 4; ++i) { yan[i] = *(const uint2*)(Y + ra + (i * 64 + lane) * 4); ycn[i] = *(const uint2*)(Y + rc + (i * 64 + lane) * 4); }
                if (row + 2 < row_end) { t0n = tsl[(row + 2) * 2]; t1n = tsl[(row + 2) * 2 + 1]; }
            }
        }
        if (COMBINE) {
#pragma unroll
            for (int i = 0; i < 4; ++i) {
                const int col = (i * 64 + lane) * 4;
                v[i][0] += gt[i][0] * (bf2f(ya[i].x & 0xffff) + bf2f(yc[i].x & 0xffff));
                v[i][1] += gt[i][1] * (bf2f(ya[i].x >> 16) + bf2f(yc[i].x >> 16));
                v[i][2] += gt[i][2] * (bf2f(ya[i].y & 0xffff) + bf2f(yc[i].y & 0xffff));
                v[i][3] += gt[i][3] * (bf2f(ya[i].y >> 16) + bf2f(yc[i].y >> 16));
                *(f32x4*)(xdst + (size_t)row * 1024 + col) = v[i];
            }
        }
        if (NORM) {
            float ss = 0.f;
#pragma unroll
            for (int i = 0; i < 4; ++i) ss += v[i][0] * v[i][0] + v[i][1] * v[i][1] + v[i][2] * v[i][2] + v[i][3] * v[i][3];
            ss = wave_sum(ss);
            const float r = rsqrtf(ss * (1.f / 1024.f) + EPS);
#pragma unroll
            for (int i = 0; i < 4; ++i) {
                const int col = (i * 64 + lane) * 4;
                f32x4 h;
#pragma unroll
                for (int j = 0; j < 4; ++j) h[j] = v[i][j] * r * ca[i][j] + cb[i][j];
                uint2 o; o.x = pack2(h[0], h[1]); o.y = pack2(h[2], h[3]);
                *(uint2*)(hA + (size_t)row * 1024 + col) = o;
            }
        }
    }
}

__device__ __forceinline__ void rows_router_phase(const Params& p, const Ctx& cx, char* lds, const float* __restrict__ src, int ls_norm, int layer) {
    const int lane = cx.lane, tid = cx.tid;
    const int widu = __builtin_amdgcn_readfirstlane(cx.wid);
    const int wq = widu & 3, grp4 = widu >> 2;
    const float* mod = (const float*)(p.ws + OFF_MOD);
    const float* rg = p.moe_rg + (size_t)layer * 1024 * 4;
    const float* re = p.moe_re + (size_t)layer * 1024 * 16;
    float* logit_s = (float*)lds;
    float wr[16][5];
#pragma unroll
    for (int i = 0; i < 4; ++i)
#pragma unroll
        for (int j = 0; j < 4; ++j) {
            const int k = (i * 64 + lane) * 4 + j;
#pragma unroll
            for (int q = 0; q < 5; ++q) {
                const int o = 5 * wq + q;
                wr[i * 4 + j][q] = (o < 4) ? rg[k * 4 + o] : re[k * 16 + o - 4];
            }
            __builtin_amdgcn_sched_barrier(0);
        }
    const float* gain = p.norm_g + ls_norm * 1024;
    bf16_t* hA = (bf16_t*)(p.ws + OFF_HA);
    int* lcnt = (int*)(lds + 16384);
    if (tid < 32) lcnt[tid] = 0;
    int nstep = 0;
    for (int blk = cx.vbid; blk < NTOK / 32; blk += cx.G, ++nstep) {
        const int R0 = blk * 32, b = R0 >> 11;
        const float* shift = mod + ((size_t)ls_norm * 16 + b) * 3072;
        const float* scale = shift + 1024;
        f32x4 ca[4], cb[4];
#pragma unroll
        for (int i = 0; i < 4; ++i) {
            const int col = (i * 64 + lane) * 4;
            const f32x4 g = *(const f32x4*)(gain + col), sc = *(const f32x4*)(scale + col);
            ca[i] = g * (sc + 1.f);
            cb[i] = *(const f32x4*)(shift + col);
        }
        const float* srow = src + (size_t)(R0 + grp4 * 16) * 1024 + lane * 4;
        f32x4 vnA[4], vnB[4];
#pragma unroll
        for (int i = 0; i < 4; ++i) { vnA[i] = *(const f32x4*)(srow + i * 256); vnB[i] = *(const f32x4*)(srow + 1024 + i * 256); }
#pragma unroll 1
        for (int r = 0; r < 16; r += 2) {
            const int rlA = grp4 * 16 + r;
            f32x4 vA[4], vB[4];
#pragma unroll
            for (int i = 0; i < 4; ++i) { vA[i] = vnA[i]; vB[i] = vnB[i]; }
            if (r < 14) {
#pragma unroll
                for (int i = 0; i < 4; ++i) { vnA[i] = *(const f32x4*)(srow + (size_t)(r + 2) * 1024 + i * 256); vnB[i] = *(const f32x4*)(srow + (size_t)(r + 3) * 1024 + i * 256); }
            }
            float ssA = 0.f, ssB = 0.f;
#pragma unroll
            for (int i = 0; i < 4; ++i) {
                ssA += vA[i][0] * vA[i][0] + vA[i][1] * vA[i][1] + vA[i][2] * vA[i][2] + vA[i][3] * vA[i][3];
                ssB += vB[i][0] * vB[i][0] + vB[i][1] * vB[i][1] + vB[i][2] * vB[i][2] + vB[i][3] * vB[i][3];
            }
#pragma unroll
            for (int o = 32; o; o >>= 1) { ssA += __shfl_xor(ssA, o); ssB += __shfl_xor(ssB, o); }
            const float rrA = rsqrtf(ssA * (1.f / 1024.f) + EPS), rrB = rsqrtf(ssB * (1.f / 1024.f) + EPS);
            float accA[5] = {0.f, 0.f, 0.f, 0.f, 0.f}, accB[5] = {0.f, 0.f, 0.f, 0.f, 0.f};
#pragma unroll
            for (int i = 0; i < 4; ++i) {
                const int col = (i * 64 + lane) * 4;
                f32x4 hA_, hB_;
#pragma unroll
                for (int j = 0; j < 4; ++j) {
                    hA_[j] = vA[i][j] * rrA * ca[i][j] + cb[i][j];
                    hB_[j] = vB[i][j] * rrB * ca[i][j] + cb[i][j];
#pragma unroll
                    for (int q = 0; q < 5; ++q) { accA[q] += hA_[j] * wr[i * 4 + j][q]; accB[q] += hB_[j] * wr[i * 4 + j][q]; }
                }
                if ((r & 3) == wq) { uint2 o; o.x = pack2(hA_[0], hA_[1]); o.y = pack2(hA_[2], hA_[3]); *(uint2*)(hA + (size_t)(R0 + rlA) * 1024 + col) = o; }
                if (((r + 1) & 3) == wq) { uint2 o; o.x = pack2(hB_[0], hB_[1]); o.y = pack2(hB_[2], hB_[3]); *(uint2*)(hA + (size_t)(R0 + rlA + 1) * 1024 + col) = o; }
            }
            {
                float v[16];
#pragma unroll
                for (int q = 0; q < 5; ++q) { v[q] = accA[q]; v[5 + q] = accB[q]; }
#pragma unroll
                for (int q = 10; q < 16; ++q) v[q] = 0.f;
#pragma unroll
                for (int t = 0; t < 8; ++t) { const bool up = lane & 32; const float send = up ? v[t] : v[t + 8], keep = up ? v[t + 8] : v[t]; v[t] = keep + __shfl_xor(send, 32); }
#pragma unroll
                for (int t = 0; t < 4; ++t) { const bool up = lane & 16; const float send = up ? v[t] : v[t + 4], keep = up ? v[t + 4] : v[t]; v[t] = keep + __shfl_xor(send, 16); }
#pragma unroll
                for (int t = 0; t < 2; ++t) { const bool up = lane & 8; const float send = up ? v[t] : v[t + 2], keep = up ? v[t + 2] : v[t]; v[t] = keep + __shfl_xor(send, 8); }
                { const bool up = lane & 4; const float send = up ? v[0] : v[1], keep = up ? v[1] : v[0]; v[0] = keep + __shfl_xor(send, 4); }
                v[0] += __shfl_xor(v[0], 2);
                v[0] += __shfl_xor(v[0], 1);
                const int idx = ((lane >> 5) & 1) * 8 + ((lane >> 4) & 1) * 4 + ((lane >> 3) & 1) * 2 + ((lane >> 2) & 1);
                if ((lane & 3) == 0 && idx < 10) {
                    const int rsel = idx >= 5, q = idx - 5 * rsel;
                    logit_s[(nstep * 32 + rlA + rsel) * 20 + 5 * wq + q] = v[0];
                }
            }
        }
    }
    __syncthreads();
    const int nrows = nstep * 32;
    int ea = 0, eb = 0, la = 0, lb_ = 0, row = 0; float wa = 0.f, wb = 0.f;
    if (tid < nrows) {
        row = (cx.vbid + (tid >> 5) * cx.G) * 32 + (tid & 31);
        const float* rl = logit_s + tid * 20;
        const float gm = fmaxf(fmaxf(rl[0], rl[1]), fmaxf(rl[2], rl[3]));
        const float gs = __expf(rl[0] - gm) + __expf(rl[1] - gm) + __expf(rl[2] - gm) + __expf(rl[3] - gm);
        int grp = 0; float best = rl[0];
        if (rl[1] > best) { best = rl[1]; grp = 1; }
        if (rl[2] > best) { best = rl[2]; grp = 2; }
        if (rl[3] > best) { best = rl[3]; grp = 3; }
        const float pg = __expf(best - gm) / gs;
        const f32x4 lsel = *(const f32x4*)(rl + 4 + 4 * grp);
        const float l0 = lsel[0], l1 = lsel[1], l2 = lsel[2], l3 = lsel[3];
        const float em = fmaxf(fmaxf(l0, l1), fmaxf(l2, l3));
        const float q0 = __expf(l0 - em), q1 = __expf(l1 - em), q2 = __expf(l2 - em), q3 = __expf(l3 - em);
        int i1 = 0; float b1 = q0;
        if (q1 > b1) { b1 = q1; i1 = 1; }
        if (q2 > b1) { b1 = q2; i1 = 2; }
        if (q3 > b1) { b1 = q3; i1 = 3; }
        int i2 = -1; float b2 = -1.f;
        if (i1 != 0 && q0 > b2) { b2 = q0; i2 = 0; }
        if (i1 != 1 && q1 > b2) { b2 = q1; i2 = 1; }
        if (i1 != 2 && q2 > b2) { b2 = q2; i2 = 2; }
        if (i1 != 3 && q3 > b2) { b2 = q3; i2 = 3; }
        const float inv = pg / (b1 + b2);
        ea = grp * 4 + i1; eb = grp * 4 + i2; wa = b1 * inv; wb = b2 * inv;
        la = atomicAdd(lcnt + ea, 1);
        lb_ = atomicAdd(lcnt + eb, 1);
    }
    __syncthreads();
    if (tid < 16) lcnt[16 + tid] = atomicAdd((int*)(p.ws + OFF_CNT) + layer * 16 + tid, lcnt[tid]);
    __syncthreads();
    if (tid < nrows) {
        int* ltok = (int*)(p.ws + OFF_LTOK);
        float* lw = (float*)(p.ws + OFF_LW);
        int* ts = (int*)(p.ws + OFF_TSLOT) + row * 2;
        const int pa = lcnt[16 + ea] + la, pb = lcnt[16 + eb] + lb_;
        ltok[(size_t)ea * NTOK + pa] = row; lw[(size_t)ea * NTOK + pa] = wa;
        ltok[(size_t)eb * NTOK + pb] = row; lw[(size_t)eb * NTOK + pb] = wb;
        ts[0] = (ea << 16) | pa; ts[1] = (eb << 16) | pb;
    }
    __syncthreads();
}

__device__ __forceinline__ int stage_col(int tid) { return ((tid & 7) ^ ((tid >> 3) & 7)) * 8; }

template <class Epi>
__device__ __forceinline__ void gemm_tile(const bf16_t* const (&ap)[4], const bf16_t* const (&bp)[2], int K, char* lds, const Ctx& cx, Epi&& epi) {
    const int tid = cx.tid, lane = cx.lane, wr = cx.wid >> 1, wc = cx.wid & 1, fr = lane & 15, fq = lane >> 4;
    f32x4 acc[4][4];
#pragma unroll
    for (int m = 0; m < 4; ++m)
#pragma unroll
        for (int n = 0; n < 4; ++n) acc[m][n] = (f32x4){0.f, 0.f, 0.f, 0.f};
    const int nt = K / 64;
    auto stage = [&](int t, int slot) {
        char* SA = lds + slot * GEMM_STAGE + tid * 16; char* SB = SA + 32768;
        const int ko = t * 64;
#pragma unroll
        for (int i = 0; i < 4; ++i) glds16(ap[i] + ko, SA + i * 8192);
#pragma unroll
        for (int i = 0; i < 2; ++i) glds16(bp[i] + ko, SB + i * 8192);
    };
    __syncthreads();
    stage(0, 0);
    if (nt > 1) stage(1, 1);
    const int x7 = fr & 7;
    const int aoff = (wr * 64 + fr) * 128, boff = 32768 + (wc * 64 + fr) * 128;
    int slot = 0;
    for (int kt = 0; kt < nt; ++kt) {
        if (kt + 1 < nt) asm volatile("s_waitcnt vmcnt(6)" ::: "memory");
        else asm volatile("s_waitcnt vmcnt(0)" ::: "memory");
        __builtin_amdgcn_s_barrier();
        if (kt + 2 < nt) stage(kt + 2, slot >= 1 ? slot - 1 : 2);
        const char* S = lds + slot * GEMM_STAGE;
#pragma unroll
        for (int ks = 0; ks < 2; ++ks) {
            const int pc = ((ks * 4 + fq) ^ x7) * 16;
            bf16x8 Af[4], Bf[4];
#pragma unroll
            for (int m = 0; m < 4; ++m) Af[m] = *(const bf16x8*)(S + aoff + m * 2048 + pc);
#pragma unroll
            for (int n = 0; n < 4; ++n) Bf[n] = *(const bf16x8*)(S + boff + n * 2048 + pc);
#pragma unroll
            for (int m = 0; m < 4; ++m)
#pragma unroll
                for (int n = 0; n < 4; ++n) acc[m][n] = __builtin_amdgcn_mfma_f32_16x16x32_bf16(Bf[n], Af[m], acc[m][n], 0, 0, 0);
        }
        slot = slot == 2 ? 0 : slot + 1;
    }
    epi(acc, wr, wc, fr, fq);
}

__device__ __forceinline__ int swz_g(int q) { return (0x1320 >> (4 * q)) & 3; }
__device__ __forceinline__ int stage_col2(int tid) { return ((tid & 3) ^ swz_g((tid >> 4) & 3)) * 8; }

template <int MODE = 0, class Epi>
__device__ __forceinline__ void gemm_tile2(const bf16_t* const (&ap)[2], const bf16_t* const (&bp)[2], int K, char* lds, const Ctx& cx, Epi&& epi) {
    const int tid = cx.tid, lane = cx.lane, wc = cx.wid & 3, fr = lane & 15, fq = lane >> 4;
    const int wr = __builtin_amdgcn_readfirstlane(cx.wid >> 2);
    f32x4 acc[8][4];
#pragma unroll
    for (int m = 0; m < 8; ++m)
#pragma unroll
        for (int n = 0; n < 4; ++n) acc[m][n] = (f32x4){0.f, 0.f, 0.f, 0.f};
    const int nt = K / 32;
    auto stage = [&](int t) {
        char* SA = lds + (t & 3) * 32768 + tid * 16; char* SB = SA + 16384;
        const int ko = t * 32;
        glds16(ap[0] + ko, SA); glds16(ap[1] + ko, SA + 8192);
        glds16(bp[0] + ko, SB); glds16(bp[1] + ko, SB + 8192);
    };
    __syncthreads();
    stage(0);
    if (nt > 1) stage(1);
    if (nt > 2) stage(2);
    const int pc = (fq ^ swz_g((fr >> 2) & 3)) * 16;
    const int aoff = (wr * 128 + fr) * 64 + pc, boff = 16384 + (wc * 64 + fr) * 64 + pc;
    bf16x8 Af[8], Bf[4];
    auto load_frags = [&](int kt) {
        const char* S = lds + (kt & 3) * 32768;
#pragma unroll
        for (int n = 0; n < 4; ++n) Bf[n] = *(const bf16x8*)(S + boff + n * 1024);
#pragma unroll
        for (int m = 0; m < 8; ++m) Af[m] = *(const bf16x8*)(S + aoff + m * 1024);
        asm volatile("s_waitcnt lgkmcnt(0)" ::: "memory");
    };
    auto mma = [&]() {
        __builtin_amdgcn_s_setprio(1);
#pragma unroll
        for (int m = 0; m < 8; ++m)
#pragma unroll
            for (int n = 0; n < 4; ++n) acc[m][n] = __builtin_amdgcn_mfma_f32_16x16x32_bf16(Bf[n], Af[m], acc[m][n], 0, 0, 0);
        __builtin_amdgcn_s_setprio(0);
    };
    if (nt > 2) asm volatile("s_waitcnt vmcnt(8)" ::: "memory");
    else if (nt == 2) asm volatile("s_waitcnt vmcnt(4)" ::: "memory");
    else asm volatile("s_waitcnt vmcnt(0)" ::: "memory");
    if (wr == 1) __builtin_amdgcn_s_barrier();
    for (int kt = 0; kt < nt; ++kt) {
        const int rem = nt - 1 - kt;
        if (rem >= 2) asm volatile("s_waitcnt vmcnt(8)" ::: "memory");
        else if (rem == 1) asm volatile("s_waitcnt vmcnt(4)" ::: "memory");
        else asm volatile("s_waitcnt vmcnt(0)" ::: "memory");
        __builtin_amdgcn_s_barrier();
        if (kt + 3 < nt) stage(kt + 3);
        load_frags(kt);
        if (rem >= 3) asm volatile("s_waitcnt vmcnt(8)" ::: "memory");
        else if (rem == 2) asm volatile("s_waitcnt vmcnt(4)" ::: "memory");
        else asm volatile("s_waitcnt vmcnt(0)" ::: "memory");
        __builtin_amdgcn_s_barrier();
        mma();
    }
    if (wr == 0) __builtin_amdgcn_s_barrier();
    if (MODE == 0) epi(acc, wr, wc, fr, fq);
    else {
#pragma unroll
        for (int m = 0; m < 8; ++m)
#pragma unroll
            for (int n = 0; n < 4; ++n) asm volatile("" :: "v"(acc[m][n]));
    }
}

template <class GetFn, class EpiFn>
__device__ __forceinline__ void gemm_stream2(int my_tiles, int K, char* lds, const Ctx& cx, GetFn&& get, EpiFn&& epi) {
    if (my_tiles <= 0) return;
    const int tid = cx.tid, lane = cx.lane, wc = cx.wid & 3, fr = lane & 15, fq = lane >> 4;
    const int wr = __builtin_amdgcn_readfirstlane(cx.wid >> 2);
    f32x4 acc[8][4];
#pragma unroll
    for (int m = 0; m < 8; ++m)
#pragma unroll
        for (int n = 0; n < 4; ++n) acc[m][n] = (f32x4){0.f, 0.f, 0.f, 0.f};
    const int nt = K / 32, S = my_tiles * nt;
    const bf16_t* sap[2]; const bf16_t* sbp[2];
    int sj = 0, skt = 0, sg = 0;
    get(0, sap, sbp);
    auto stage_next = [&]() {
        char* SA = lds + (sg & 3) * 32768 + tid * 16; char* SB = SA + 16384;
        const int ko = skt * 32;
        glds16(sap[0] + ko, SA); glds16(sap[1] + ko, SA + 8192);
        glds16(sbp[0] + ko, SB); glds16(sbp[1] + ko, SB + 8192);
        ++sg; ++skt;
        if (skt == nt) { skt = 0; ++sj; if (sj < my_tiles) get(sj, sap, sbp); }
    };
    __syncthreads();
    stage_next();
    if (S > 1) stage_next();
    if (S > 2) stage_next();
    const int pc = (fq ^ swz_g((fr >> 2) & 3)) * 16;
    const int aoff = (wr * 128 + fr) * 64 + pc, boff = 16384 + (wc * 64 + fr) * 64 + pc;
    bf16x8 Af[8], Bf[4];
    int g = 0;
    for (int cj = 0; cj < my_tiles; ++cj) {
        {
            const int rem0 = S - 1 - g;
            if (rem0 >= 2) asm volatile("s_waitcnt vmcnt(8)" ::: "memory");
            else if (rem0 == 1) asm volatile("s_waitcnt vmcnt(4)" ::: "memory");
            else asm volatile("s_waitcnt vmcnt(0)" ::: "memory");
        }
        if (wr == 1) __builtin_amdgcn_s_barrier();
        for (int kt = 0; kt < nt; ++kt, ++g) {
            const int rem = S - 1 - g;
            if (rem >= 2) asm volatile("s_waitcnt vmcnt(8)" ::: "memory");
            else if (rem == 1) asm volatile("s_waitcnt vmcnt(4)" ::: "memory");
            else asm volatile("s_waitcnt vmcnt(0)" ::: "memory");
            __builtin_amdgcn_s_barrier();
            if (g + 3 < S) stage_next();
            {
                const char* Sx = lds + (g & 3) * 32768;
#pragma unroll
                for (int n = 0; n < 4; ++n) Bf[n] = *(const bf16x8*)(Sx + boff + n * 1024);
#pragma unroll
                for (int m = 0; m < 8; ++m) Af[m] = *(const bf16x8*)(Sx + aoff + m * 1024);
                asm volatile("s_waitcnt lgkmcnt(0)" ::: "memory");
            }
            if (rem >= 3) asm volatile("s_waitcnt vmcnt(8)" ::: "memory");
            else if (rem == 2) asm volatile("s_waitcnt vmcnt(4)" ::: "memory");
            else asm volatile("s_waitcnt vmcnt(0)" ::: "memory");
            __builtin_amdgcn_s_barrier();
            __builtin_amdgcn_s_setprio(1);
#pragma unroll
            for (int m = 0; m < 8; ++m)
#pragma unroll
                for (int n = 0; n < 4; ++n) acc[m][n] = __builtin_amdgcn_mfma_f32_16x16x32_bf16(Bf[n], Af[m], acc[m][n], 0, 0, 0);
            __builtin_amdgcn_s_setprio(0);
        }
        if (wr == 0) __builtin_amdgcn_s_barrier();
        epi(cj, acc, wr, wc, fr, fq);
#pragma unroll
        for (int m = 0; m < 8; ++m)
#pragma unroll
            for (int n = 0; n < 4; ++n) acc[m][n] = (f32x4){0.f, 0.f, 0.f, 0.f};
    }
}

template <int MODE = 0, class EpiFactory>
__device__ __forceinline__ void gemm_phase_dense2(const bf16_t* A, int lda, const bf16_t* Bt, int K, int nrt, int nct, char* lds, const Ctx& cx, EpiFactory&& mk) {
    const int tid = cx.tid;
    const int ntiles = nrt * nct;
    const int sc = stage_col2(tid), sr = tid >> 2;
    const int my_tiles = cx.vbid < ntiles ? (ntiles - cx.vbid + cx.G - 1) / cx.G : 0;
    const int vb = cx.vbid, G = cx.G;
    gemm_stream2(my_tiles, K, lds, cx,
        [=](int j, const bf16_t* (&ap)[2], const bf16_t* (&bp)[2]) {
            const int tile = vb + j * G, rt = tile / nct, ct = tile % nct;
            ap[0] = A + (size_t)(rt * 256 + sr) * lda + sc; ap[1] = ap[0] + (size_t)128 * lda;
            bp[0] = Bt + (size_t)(ct * 256 + sr) * K + sc; bp[1] = bp[0] + (size_t)128 * K;
        },
        [=](int j, f32x4 (&acc)[8][4], int wr, int wc, int fr, int fq) {
            const int tile = vb + j * G, rt = tile / nct, ct = tile % nct;
            mk(rt * 256, ct * 256)(acc, wr, wc, fr, fq);
        });
}

__device__ __forceinline__ void phase_nsa_inproj(const Params& p, const Ctx& cx, char* lds) {
    const bf16_t* A = (const bf16_t*)(p.ws + OFF_HA);
    const bf16_t* Bt = (const bf16_t*)(p.ws + OFF_W_NSA_IN);
    char* ws = p.ws;
    const float* qg = p.nsa_q_gain;
    const float* kg = p.nsa_k_gain;
    gemm_phase_dense2(A, 1024, Bt, 1024, NTOK / 256, NSA_IN_PAD / 256, lds, cx, [=](int row0, int col0) {
        return [=](f32x4 (&acc)[8][4], int wr, int wc, int fr, int fq) {
            const int gc0 = col0 + wc * 64;
            if (gc0 >= NSA_IN) return;
            if (gc0 < 1024 || (gc0 >= 1536 && gc0 < 1792) || (gc0 >= 2048 && gc0 < 2304)) {
                const float* gain; float post; bf16_t* dstb; size_t rstride; size_t coff; bool tokmajor;
                if (gc0 < 1024) { gain = qg; post = 0.125f * 1.4426950408889634f; }
                else if (gc0 < 1792) { gain = kg + 64; post = 1.f; }
                else { gain = kg + 128; post = 1.f; }
#pragma unroll
                for (int m = 0; m < 8; ++m) {
                    __builtin_amdgcn_sched_barrier(0);
                    float ss = 0.f;
#pragma unroll
                    for (int n = 0; n < 4; ++n) ss += acc[m][n][0] * acc[m][n][0] + acc[m][n][1] * acc[m][n][1] + acc[m][n][2] * acc[m][n][2] + acc[m][n][3] * acc[m][n][3];
                    ss += __shfl_xor(ss, 16); ss += __shfl_xor(ss, 32);
                    const float r = rsqrtf(ss * (1.f / 64.f) + EPS) * post;
                    const int row = row0 + wr * 128 + m * 16 + fr;
                    bf16_t* dst;
                    if (gc0 < 1024) dst = (bf16_t*)(ws + OFF_Q) + (size_t)row * 1024 + gc0;
                    else {
                        const int g = ((gc0 - 1024) & 255) >> 6, b = row >> 11, t = row & 2047;
                        dst = (bf16_t*)(ws + (gc0 < 1792 ? OFF_KS : OFF_KW)) + ((size_t)(b * 4 + g) * 2048 + t) * 64;
                    }
#pragma unroll
                    for (int pp = 0; pp < 2; ++pp) {
                        const int c = pp * 32 + fq * 8;
                        const f32x4 ga = *(const f32x4*)(gain + c), gb = *(const f32x4*)(gain + c + 4);
                        const f32x4 a = acc[m][2 * pp], bb = acc[m][2 * pp + 1];
                        uint4 o; o.x = pack2(a[0] * r * ga[0], a[1] * r * ga[1]); o.y = pack2(a[2] * r * ga[2], a[3] * r * ga[3]);
                        o.z = pack2(bb[0] * r * gb[0], bb[1] * r * gb[1]); o.w = pack2(bb[2] * r * gb[2], bb[3] * r * gb[3]);
                        *(uint4*)(dst + c) = o;
                    }
                }
            } else if (gc0 < 2560) {
                const int seg = (gc0 - 1024) >> 8;
                const int g = ((gc0 - 1024) & 255) >> 6;
                if (seg < 2) {
                    const size_t off = seg == 0 ? OFF_KCRAW : OFF_VCRAW;
#pragma unroll
                    for (int m = 0; m < 8; ++m) {
                        __builtin_amdgcn_sched_barrier(0);
                    __builtin_amdgcn_sched_barrier(0);
                        const int row = row0 + wr * 128 + m * 16 + fr, b = row >> 11, t = row & 2047;
                        bf16_t* dst = (bf16_t*)(ws + off) + ((size_t)(b * 4 + g) * 2048 + t) * 64;
#pragma unroll
                        for (int pp = 0; pp < 2; ++pp) {
                            const f32x4 a = acc[m][2 * pp], bb = acc[m][2 * pp + 1];
                            uint4 o; o.x = pack2(a[0], a[1]); o.y = pack2(a[2], a[3]); o.z = pack2(bb[0], bb[1]); o.w = pack2(bb[2], bb[3]);
                            *(uint4*)(dst + pp * 32 + fq * 8) = o;
                        }
                    }
                } else {
                    const size_t off = seg == 3 ? OFF_VS : OFF_VW;
#pragma unroll
                    for (int m = 0; m < 8; ++m) {
                        __builtin_amdgcn_sched_barrier(0);
                    __builtin_amdgcn_sched_barrier(0);
                        const int row = row0 + wr * 128 + m * 16 + fr, b = row >> 11, t = row & 2047;
                        bf16_t* dst = (bf16_t*)(ws + off) + (size_t)(b * 4 + g) * 64 * 2048 + t;
#pragma unroll
                        for (int n = 0; n < 4; ++n)
#pragma unroll
                            for (int j = 0; j < 4; ++j) dst[(size_t)(pcol(n, fq) + j) * 2048] = f2bf(acc[m][n][j]);
                    }
                }
            } else {
#pragma unroll
                for (int m = 0; m < 8; ++m) {
                    __builtin_amdgcn_sched_barrier(0);
                    const int row = row0 + wr * 128 + m * 16 + fr;
                    float* dst = (float*)(ws + OFF_GATES) + (size_t)row * 48;
#pragma unroll
                    for (int n = 0; n < 4; ++n) {
                        const int c = pcol(n, fq);
                        f32x4 o;
#pragma unroll
                        for (int j = 0; j < 4; ++j) o[j] = sigmoid_f(acc[m][n][j]);
                        if (c < 48) *(f32x4*)(dst + c) = o;
                    }
                }
            }
        };
    });
}

__device__ __forceinline__ void phase_cmp1(const Params& p, const Ctx& cx, char* lds) {
    const int tid = cx.tid;
    const float* peb = (const float*)(p.ws + OFF_PEB);
    float* T1 = (float*)(p.ws + OFF_T1);
    const int sc = stage_col(tid), sr = tid >> 3;
    for (int tile = cx.vbid; tile < 64; tile += cx.G) {
        const int kv = tile >> 5, bg2 = tile & 31;
        const bf16_t* raw = (const bf16_t*)(p.ws + (kv ? OFF_VCRAW : OFF_KCRAW)) + (size_t)bg2 * 2 * 2048 * 64;
        const bf16_t* a0 = raw + (size_t)sr * 1024 + sc;
        const bf16_t* a2 = raw + (size_t)2048 * 64 + (size_t)sr * 1024 + sc;
        const bf16_t* b0 = (const bf16_t*)(p.ws + OFF_W_CMP1) + ((size_t)kv * 128 + sr) * 2048 + sc;
        const bf16_t* const ap[4] = {a0, a0 + (size_t)64 * 1024, a2, a2 + (size_t)64 * 1024};
        const bf16_t* const bp[2] = {b0, b0 + (size_t)64 * 2048};
        gemm_tile(ap, bp, 2048, lds, cx, [=](f32x4 (&acc)[4][4], int wr, int wc, int fr, int fq) {
            if (wc != 0) return;
#pragma unroll
            for (int m = 0; m < 4; ++m) {
                const int r = wr * 64 + m * 16 + fr;
                float* dst = T1 + ((size_t)kv * 8192 + (bg2 * 2 + (r >> 7)) * 128 + (r & 127)) * 64;
#pragma unroll
                for (int n = 0; n < 4; ++n) {
                    const int c = n * 16 + fq * 4;
                    f32x4 pb = *(const f32x4*)(peb + kv * 64 + c);
                    *(f32x4*)(dst + c) = acc[m][n] + pb;
                }
            }
        });
    }
}

__device__ __forceinline__ void phase_cmp2(const Params& p, const Ctx& cx) {
    const int lane = cx.lane;
    const float* T1 = (const float*)(p.ws + OFF_T1);
    for (int r = cx.vbid * NWAVE + cx.wid; r < 2 * 8192; r += cx.G * NWAVE) {
        const int kv = r >> 13, rr = r & 8191, n_ = rr & 127;
        const float s = silu_f(T1[(size_t)r * 64 + lane]);
        const float* w2 = p.nsa_cmp_w2 + kv * 4096 + lane;
        float o = 0.f;
#pragma unroll 8
        for (int j = 0; j < 64; ++j) o += __shfl(s, j) * w2[j * 64];
        if (kv == 0) {
            const float ss = wave_sum(o * o);
            o = o * rsqrtf(ss * (1.f / 64.f) + EPS) * p.nsa_k_gain[lane];
        }
        if (n_ == 127) o = 0.f;
        if (kv == 0) ((bf16_t*)(p.ws + OFF_KC))[(size_t)rr * 64 + lane] = f2bf(o);
        else ((bf16_t*)(p.ws + OFF_VC))[((size_t)(rr >> 7) * 64 + lane) * 128 + n_] = f2bf(o);
    }
}

constexpr int ATT_BUF = 17920, ATT_K_STRIDE = 144, ATT_V_OFF = 9216, ATT_V_STRIDE = 136, ATT_LUT_OFF = 2 * ATT_BUF, LUT_N = 2136, LUT_PAD = 80;
constexpr int ATT_SC_OFF = ATT_LUT_OFF + 4 * LUT_N * 4;
static_assert(ATT_SC_OFF + NWAVE * 8192 <= LDS_TAB_OFF, "attention LDS");
#define MFMA32(a, b, c) __builtin_amdgcn_mfma_f32_32x32x16_bf16((a), (b), (c), 0, 0, 0)
template <int V> struct IC { static constexpr int value = V; };

__device__ __forceinline__ void phase_attn(const Params& p, const Ctx& cx, char* lds) {
    const int tid = cx.tid, lane = cx.lane, wid = cx.wid;
    const int g = cx.vbid & 3;
    const int ql = lane & 7, head = (lane & 31) >> 3, h2 = lane >> 5, l31 = lane & 31;
    float* lut = (float*)(lds + ATT_LUT_OFF);
    for (int i = tid; i < 4 * LUT_N; i += NTHR) {
        const int h = i / LUT_N, dist = i % LUT_N - LUT_PAD;
        lut[i] = dist >= 0 ? p.rel_bias[t5_bucket(dist) * 16 + g * 4 + h] * 1.4426950408889634f : 0.f;
    }
    __syncthreads();
    const float* lutp = lut + head * LUT_N + LUT_PAD;
    const float b31 = lutp[2047];
    const bf16_t* Qb = (const bf16_t*)(p.ws + OFF_Q);
    const bf16_t* KC = (const bf16_t*)(p.ws + OFF_KC);
    const bf16_t* VCT = (const bf16_t*)(p.ws + OFF_VC);
    const bf16_t* KS = (const bf16_t*)(p.ws + OFF_KS);
    const bf16_t* VST = (const bf16_t*)(p.ws + OFF_VS);
    const bf16_t* KW = (const bf16_t*)(p.ws + OFF_KW);
    const bf16_t* VWT = (const bf16_t*)(p.ws + OFF_VW);
    const float* GT = (const float*)(p.ws + OFF_GATES);
    bf16_t* Og = (bf16_t*)(p.ws + OFF_HA);
    float* scw = (float*)(lds + ATT_SC_OFF) + wid * 2048;
    f32x4* outw = (f32x4*)(lds + ATT_SC_OFF + wid * 8192) + lane;
    const bool flip_ok = (cx.G % 128) == 0;
    const int widu = __builtin_amdgcn_readfirstlane(wid);

    for (int it = 0;; ++it) {
        const int u = cx.vbid + it * cx.G;
        if (u >= 2048) break;
        const int rest = u >> 2, b = rest >> 5, qtb = rest & 31;
        const int qt = (flip_ok && (it & 1)) ? 31 - qtb : qtb;
        const int t0 = qt * 64, cur = qt, bg = b * 4 + g;
        const int tq = t0 + wid * 8 + ql;
        const size_t rowtok = (size_t)b * SEQ + tq;
        bf16x8 Qf[4];
        {
            const bf16_t* qp = Qb + rowtok * 1024 + (g * 4 + head) * 64 + 8 * h2;
#pragma unroll
            for (int ks = 0; ks < 4; ++ks) Qf[ks] = *(const bf16x8*)(qp + 16 * ks);
        }
        const float* gt = GT + rowtok * 48 + (g * 4 + head) * 3;
        const float gate_c = gt[0], gate_s = gt[1], gate_w = gt[2];
        const int wlo = max(0, qt - 8);
        const int nW = cur - wlo + 1;
        const int ncp = (t0 + 63 >= 31 + 16 * 64) ? 2 : 1;
        const int NC = ncp;
        const int NT = NC + nW + cur + 1;

        uint4 kr0, vr0;
        auto issue_load = [&](int i) {
            const bf16_t* ksrc; const bf16_t* vsrc; int vstride;
            if (i < NC) { const int ci = i; ksrc = KC + ((size_t)bg * 128 + ci * 64) * 64; vsrc = VCT + (size_t)bg * 64 * 128 + ci * 64; vstride = 128; }
            else if (i < NC + nW) { const int kb = wlo + i - NC; ksrc = KW + ((size_t)bg * 2048 + kb * 64) * 64; vsrc = VWT + (size_t)bg * 64 * 2048 + kb * 64; vstride = 2048; }
            else { const int kb = i - NC - nW; ksrc = KS + ((size_t)bg * 2048 + kb * 64) * 64; vsrc = VST + (size_t)bg * 64 * 2048 + kb * 64; vstride = 2048; }
            kr0 = *(const uint4*)(ksrc + tid * 8);
            vr0 = *(const uint4*)(vsrc + (size_t)(tid >> 3) * vstride + (tid & 7) * 8);
        };
        auto write_lds = [&](int i) {
            char* bufp = lds + (i & 1) * ATT_BUF;
            *(uint4*)(bufp + (tid >> 3) * ATT_K_STRIDE + (tid & 7) * 16) = kr0;
            char* va = bufp + ATT_V_OFF + (tid >> 3) * ATT_V_STRIDE + (tid & 7) * 16;
            uint2 t;
            t.x = vr0.x; t.y = vr0.y; *(uint2*)va = t;
            t.x = vr0.z; t.y = vr0.w; *(uint2*)(va + 8) = t;
        };
        f32x16 O0, O1;
#pragma unroll
        for (int r = 0; r < 16; ++r) { O0[r] = 0.f; O1[r] = 0.f; }
        float lsum = 0.f;

        auto qk = [&](const char* bufp, int kt2, float init) -> f32x16 {
            f32x16 S;
#pragma unroll
            for (int r = 0; r < 16; ++r) S[r] = init;
            const char* kp = bufp + (32 * kt2 + l31) * ATT_K_STRIDE + 16 * h2;
            bf16x8 kf[4];
#pragma unroll
            for (int ks = 0; ks < 4; ++ks) kf[ks] = *(const bf16x8*)(kp + 32 * ks);
            __builtin_amdgcn_sched_barrier(0);
#pragma unroll
            for (int ks = 0; ks < 4; ++ks) S = MFMA32(kf[ks], Qf[ks], S);
            return S;
        };
        auto pv = [&](const char* bufp, int kt2, const f32x16& P) {
            const char* vp = bufp + ATT_V_OFF + l31 * ATT_V_STRIDE + (32 * kt2 + 4 * h2) * 2;
            uint2 va[2][2][2];
#pragma unroll
            for (int s2 = 0; s2 < 2; ++s2)
#pragma unroll
                for (int dt = 0; dt < 2; ++dt) {
                    va[s2][dt][0] = *(const uint2*)(vp + dt * 32 * ATT_V_STRIDE + s2 * 32);
                    va[s2][dt][1] = *(const uint2*)(vp + dt * 32 * ATT_V_STRIDE + s2 * 32 + 16);
                }
            __builtin_amdgcn_sched_barrier(0);
#pragma unroll
            for (int s2 = 0; s2 < 2; ++s2) {
                uint4 pk;
                pk.x = pack2(P[8 * s2 + 0], P[8 * s2 + 1]); pk.y = pack2(P[8 * s2 + 2], P[8 * s2 + 3]);
                pk.z = pack2(P[8 * s2 + 4], P[8 * s2 + 5]); pk.w = pack2(P[8 * s2 + 6], P[8 * s2 + 7]);
                const bf16x8 Pf = __builtin_bit_cast(bf16x8, pk);
                uint4 a0, a1;
                a0.x = va[s2][0][0].x; a0.y = va[s2][0][0].y; a0.z = va[s2][0][1].x; a0.w = va[s2][0][1].y;
                a1.x = va[s2][1][0].x; a1.y = va[s2][1][0].y; a1.z = va[s2][1][1].x; a1.w = va[s2][1][1].y;
                O0 = MFMA32(__builtin_bit_cast(bf16x8, a0), Pf, O0);
                O1 = MFMA32(__builtin_bit_cast(bf16x8, a1), Pf, O1);
            }
        };
        auto finalize = [&](float gate, int mode) {
            const float Z = lsum + __shfl_xor(lsum, 32);
            const float f = Z > 0.f ? gate / Z : 0.f;
#pragma unroll
            for (int v4 = 0; v4 < 4; ++v4) {
                f32x4 a = {f * O0[4 * v4], f * O0[4 * v4 + 1], f * O0[4 * v4 + 2], f * O0[4 * v4 + 3]};
                f32x4 c = {f * O1[4 * v4], f * O1[4 * v4 + 1], f * O1[4 * v4 + 2], f * O1[4 * v4 + 3]};
                if (mode != 0) { a += outw[v4 * 64]; c += outw[(4 + v4) * 64]; }
                if (mode != 2) { outw[v4 * 64] = a; outw[(4 + v4) * 64] = c; }
                else { O0[4 * v4] = a[0]; O0[4 * v4 + 1] = a[1]; O0[4 * v4 + 2] = a[2]; O0[4 * v4 + 3] = a[3];
                       O1[4 * v4] = c[0]; O1[4 * v4 + 1] = c[1]; O1[4 * v4 + 2] = c[2]; O1[4 * v4 + 3] = c[3]; }
            }
            if (mode != 2) {
#pragma unroll
                for (int r = 0; r < 16; ++r) { O0[r] = 0.f; O1[r] = 0.f; }
            }
            lsum = 0.f;
        };
        auto tile_ws = [&](const char* bufp, int kb, float cinit, auto MMc, auto BMc) {
            constexpr int MM = decltype(MMc)::value, BM = decltype(BMc)::value;
#pragma unroll 1
            for (int kt2 = 0; kt2 < 2; ++kt2) {
                const int d0 = tq - (64 * kb + 32 * kt2 + 4 * h2);
                const float* lp = lutp + (d0 - 27);
                float bv[16];
                if (BM == 0) {
#pragma unroll
                    for (int r = 0; r < 16; ++r) bv[r] = lp[27 - ((r & 3) + 8 * (r >> 2))];
                    __builtin_amdgcn_sched_barrier(0);
                }
                f32x16 S = qk(bufp, kt2, cinit);
#pragma unroll
                for (int r = 0; r < 16; ++r) {
                    const int cr = (r & 3) + 8 * (r >> 2);
                    float x = S[r];
                    if (BM == 0) x += bv[r];
                    if (MM == 1) x += (d0 - cr < 512) ? 0.f : -INFINITY;
                    if (MM == 2) x += (d0 - cr >= 0) ? 0.f : -INFINITY;
                    S[r] = __builtin_amdgcn_exp2f(x);
                    lsum += S[r];
                }
                pv(bufp, kt2, S);
            }
        };

        const int nvis = (tq >= 31) ? min((tq - 31) / 16 + 1, 127) : 0;
        unsigned selmask = 0u;
        float* sown = scw + (head * 8 + ql) * 32;
        float* stail = scw + 1024 + (head * 8 + ql) * 32;
        float* ssc = scw + ql * 32;
        issue_load(0);
        __syncthreads();
        write_lds(0);
        issue_load(1);
        for (int i = 0; i < NT; ++i) {
            __syncthreads();
            const char* bufp = lds + (i & 1) * ATT_BUF;
            if (i < NC) {
                const int ci = i;
#pragma unroll 1
                for (int kt2 = 0; kt2 < 2; ++kt2) {
                    const int n0 = 64 * ci + 32 * kt2 + 4 * h2;
                    const int d0 = tq - 31 - 16 * n0;
                    float bv[16];
#pragma unroll
                    for (int r = 0; r < 16; ++r) bv[r] = lutp[max(d0 - 16 * ((r & 3) + 8 * (r >> 2)), -LUT_PAD)];
                    __builtin_amdgcn_sched_barrier(0);
                    f32x16 S = qk(bufp, kt2, 0.f);
#pragma unroll
                    for (int r = 0; r < 16; ++r) {
                        const int cr = (r & 3) + 8 * (r >> 2);
                        S[r] = __builtin_amdgcn_exp2f(S[r] + bv[r] + ((n0 + cr) < nvis ? 0.f : -INFINITY));
                        lsum += S[r];
                    }
                    pv(bufp, kt2, S);
#pragma unroll
                    for (int rq = 0; rq < 4; ++rq) {
                        const int sblk = 8 * (2 * ci + kt2) + 2 * rq + h2;
                        sown[sblk] = S[4 * rq] + S[4 * rq + 1] + S[4 * rq + 2] + 0.5f * S[4 * rq + 3];
                        if (sblk < 31) stail[sblk + 1] = 0.5f * S[4 * rq + 3];
                    }
                }
                if (i == NC - 1) {
                    const float Z = lsum + __shfl_xor(lsum, 32);
                    const float inv_mine = Z > 0.f ? 1.f / Z : 0.f;
                    if (h2 == 0) stail[0] = 0.f;
                    __builtin_amdgcn_wave_barrier();
                    const int j8 = head * 2 + h2;
                    {
                        f32x4 sc = {0.f, 0.f, 0.f, 0.f};
#pragma unroll
                        for (int hh = 0; hh < 4; ++hh) {
                            const float invh = __shfl(inv_mine, hh * 8 + ql);
                            const f32x4 a = *(const f32x4*)(scw + (hh * 8 + ql) * 32 + 4 * j8), t4 = *(const f32x4*)(scw + 1024 + (hh * 8 + ql) * 32 + 4 * j8);
                            sc += (a + t4) * invh;
                        }
#pragma unroll
                        for (int q = 0; q < 4; ++q) {
                            const int sblk = 4 * j8 + q;
                            const bool forced = (sblk == 0) || (sblk == cur) || (sblk == cur - 1);
                            sc[q] = forced ? 1.0e4f : (sblk <= cur ? sc[q] : -1.0f);
                        }
                        __builtin_amdgcn_wave_barrier();
                        *(f32x4*)(ssc + 4 * j8) = sc;
                    }
                    __builtin_amdgcn_wave_barrier();
                    const f32x4 own = *(const f32x4*)(ssc + 4 * j8);
                    int rk0 = 0, rk1 = 0, rk2 = 0, rk3 = 0;
                    const int so0 = 4 * j8;
#pragma unroll
                    for (int m4 = 0; m4 < 8; ++m4) {
                        const f32x4 v = *(const f32x4*)(ssc + 4 * m4);
#pragma unroll
                        for (int q = 0; q < 4; ++q) {
                            const float vm = v[q];
                            rk0 += (vm > own[0]) ? 1 : 0;
                            rk1 += (vm > own[1]) ? 1 : 0;
                            rk2 += (vm > own[2]) ? 1 : 0;
                            rk3 += (vm > own[3]) ? 1 : 0;
                        }
                    }
                    unsigned mk = ((rk0 < 8 ? 1u : 0u) | (rk1 < 8 ? 2u : 0u) | (rk2 < 8 ? 4u : 0u) | (rk3 < 8 ? 8u : 0u)) << so0;
                    mk |= __shfl_xor(mk, 8); mk |= __shfl_xor(mk, 16); mk |= __shfl_xor(mk, 32);
                    selmask = mk;
                    __builtin_amdgcn_wave_barrier();
                    finalize(gate_c, 0);
                }
            } else if (i < NC + nW) {
                const int kb = wlo + i - NC;
                if (kb == cur) tile_ws(bufp, kb, 0.f, IC<2>{}, IC<0>{});
                else if (kb == cur - 8) tile_ws(bufp, kb, 0.f, IC<1>{}, IC<0>{});
                else tile_ws(bufp, kb, 0.f, IC<0>{}, IC<0>{});
                if (i == NC - 1 + nW) finalize(gate_w, 1);
            } else {
                const int kb = i - NC - nW;
                const bool sel = ((selmask >> kb) & 1u) != 0;
                if (__ballot(sel) != 0ull) {
                    const float neg = sel ? 0.f : -INFINITY;
                    if (kb == cur) tile_ws(bufp, kb, neg, IC<2>{}, IC<0>{});
                    else if (t0 + 8 * widu - (64 * kb + 63) >= 790) tile_ws(bufp, kb, neg + b31, IC<0>{}, IC<1>{});
                    else tile_ws(bufp, kb, neg, IC<0>{}, IC<0>{});
                }
            }
            if (i + 1 < NT) {
                write_lds(i + 1);
                if (i + 2 < NT) issue_load(i + 2);
            }
        }
        finalize(gate_s, 2);
        {
            bf16_t* op = Og + rowtok * 1024 + (g * 4 + head) * 64 + 4 * h2;
#pragma unroll
            for (int rq = 0; rq < 4; ++rq) {
                uint2 o0; o0.x = pack2(O0[4 * rq], O0[4 * rq + 1]); o0.y = pack2(O0[4 * rq + 2], O0[4 * rq + 3]);
                uint2 o1; o1.x = pack2(O1[4 * rq], O1[4 * rq + 1]); o1.y = pack2(O1[4 * rq + 2], O1[4 * rq + 3]);
                *(uint2*)(op + 8 * rq) = o0;
                *(uint2*)(op + 32 + 8 * rq) = o1;
            }
        }
    }
}

__device__ __forceinline__ void phase_outproj(const Params& p, const Ctx& cx, char* lds, const bf16_t* A, const bf16_t* Bt, const float* xin, int ls) {
    const float* mod = (const float*)(p.ws + OFF_MOD);
    float* xo = p.out;
    gemm_phase_dense2(A, 1024, Bt, 1024, NTOK / 256, 4, lds, cx, [=](int row0, int col0) {
        return [=](f32x4 (&acc)[8][4], int wr, int wc, int fr, int fq) {
            const int b = row0 >> 11;
            const float* gate = mod + ((size_t)ls * 16 + b) * 3072 + 2048 + col0 + wc * 64;
            f32x4 g[4];
#pragma unroll
            for (int n = 0; n < 4; ++n) g[n] = *(const f32x4*)(gate + pcol(n, fq));
#pragma unroll
            for (int m2 = 0; m2 < 8; m2 += 2) {
                f32x4 xi[2][4];
#pragma unroll
                for (int mm = 0; mm < 2; ++mm)
#pragma unroll
                    for (int n = 0; n < 4; ++n)
                        xi[mm][n] = *(const f32x4*)(xin + (size_t)(row0 + wr * 128 + (m2 + mm) * 16 + fr) * 1024 + col0 + wc * 64 + pcol(n, fq));
                __builtin_amdgcn_sched_barrier(0);
#pragma unroll
                for (int mm = 0; mm < 2; ++mm)
#pragma unroll
                    for (int n = 0; n < 4; ++n) {
                        f32x4 o;
#pragma unroll
                        for (int j = 0; j < 4; ++j) o[j] = xi[mm][n][j] + g[n][j] * acc[m2 + mm][n][j];
                        *(f32x4*)(xo + (size_t)(row0 + wr * 128 + (m2 + mm) * 16 + fr) * 1024 + col0 + wc * 64 + pcol(n, fq)) = o;
                    }
                __builtin_amdgcn_sched_barrier(0);
            }
        };
    });
}

__device__ __forceinline__ void moe_tables(const Params& p, int layer, int tid, int* s_cnt, int* s_off, int* s_toff) {
    __syncthreads();
    if (tid == 0) {
        const int* cnt = (const int*)(p.ws + OFF_CNT) + layer * 16;
        int o = 0, to = 0;
        for (int e = 0; e < 16; ++e) { const int c = cnt[e]; s_cnt[e] = c; s_off[e] = o; s_toff[e] = to; o += c; to += ((c + 255) >> 8) * 4; }
        s_off[16] = o; s_toff[16] = to;
    }
    __syncthreads();
}

constexpr int LDS_ROWIDX_OFF = 131072, LDS_LW_OFF = 131072 + 8192;
static_assert(LDS_LW_OFF + 8192 <= LDS_TAB_OFF, "moe caches");

__device__ __forceinline__ void phase_moe_up(const Params& p, const Ctx& cx, char* lds, int layer) {
    const int tid = cx.tid;
    int* s_cnt = (int*)(lds + LDS_TAB_OFF); int* s_off = s_cnt + 16; int* s_toff = s_off + 17;
    moe_tables(p, layer, tid, s_cnt, s_off, s_toff);
    const int ntiles = s_toff[16];
    const bf16_t* hA = (const bf16_t*)(p.ws + OFF_HA);
    const int* ltok = (const int*)(p.ws + OFF_LTOK);
    bf16_t* H1 = (bf16_t*)(p.ws + OFF_H1);
    int* rowidx = (int*)(lds + LDS_ROWIDX_OFF);
    const int sc = stage_col2(tid), sr = tid >> 2;
    const int vb = cx.vbid, G = cx.G;
    const int my_tiles = min(8, vb < ntiles ? (ntiles - vb + G - 1) / G : 0);
    auto locate = [=](int j, int& e, int& rt, int& ct) { const int tile = vb + j * G; e = 0; while (tile >= s_toff[e + 1]) ++e; const int lt = tile - s_toff[e]; rt = lt >> 2; ct = lt & 3; };
    for (int i = tid; i < my_tiles * 256; i += NTHR) {
        const int j = i >> 8, r = i & 255; int e, rt, ct; locate(j, e, rt, ct);
        rowidx[i] = ltok[(size_t)e * NTOK + min(rt * 256 + r, s_cnt[e] - 1)];
    }
    __syncthreads();
    const bf16_t* Wup = (const bf16_t*)(p.ws + OFF_W_UP) + (size_t)layer * 16 * 1024 * 1024;
    gemm_stream2(my_tiles, 1024, lds, cx,
        [=](int j, const bf16_t* (&ap)[2], const bf16_t* (&bp)[2]) {
            int e, rt, ct; locate(j, e, rt, ct);
            ap[0] = hA + (size_t)rowidx[j * 256 + sr] * 1024 + sc; ap[1] = hA + (size_t)rowidx[j * 256 + sr + 128] * 1024 + sc;
            bp[0] = Wup + ((size_t)e * 1024 + ct * 256 + sr) * 1024 + sc; bp[1] = bp[0] + (size_t)128 * 1024;
        },
        [=](int j, f32x4 (&acc)[8][4], int wr, int wc, int fr, int fq) {
            int e, rt, ct; locate(j, e, rt, ct);
            const int cnt = s_cnt[e], off = s_off[e];
#pragma unroll
            for (int m = 0; m < 8; ++m) {
                const int pos = rt * 256 + wr * 128 + m * 16 + fr;
                if (pos < cnt) {
                    bf16_t* dst = H1 + (size_t)(off + pos) * 512 + ct * 128 + wc * 32 + fq * 8;
                    float h[8];
#pragma unroll
                    for (int n = 0; n < 2; ++n)
#pragma unroll
                        for (int jj = 0; jj < 4; ++jj) h[n * 4 + jj] = silu_f(acc[m][n][jj]) * acc[m][n + 2][jj];
                    uint4 o; o.x = pack2(h[0], h[1]); o.y = pack2(h[2], h[3]); o.z = pack2(h[4], h[5]); o.w = pack2(h[6], h[7]);
                    *(uint4*)dst = o;
                }
            }
        });
}

__device__ __forceinline__ void phase_moe_down(const Params& p, const Ctx& cx, char* lds, int layer) {
    const int tid = cx.tid;
    int* s_cnt = (int*)(lds + LDS_TAB_OFF); int* s_off = s_cnt + 16; int* s_toff = s_off + 17;
    moe_tables(p, layer, tid, s_cnt, s_off, s_toff);
    const int ntiles = s_toff[16];
    const bf16_t* H1 = (const bf16_t*)(p.ws + OFF_H1);
    const float* lw = (const float*)(p.ws + OFF_LW);
    bf16_t* Y = (bf16_t*)(p.ws + OFF_Y);
    float* lwc = (float*)(lds + LDS_LW_OFF);
    const int sc = stage_col2(tid), sr = tid >> 2;
    const int vb = cx.vbid, G = cx.G;
    const int my_tiles = min(8, vb < ntiles ? (ntiles - vb + G - 1) / G : 0);
    auto locate = [=](int j, int& e, int& rt, int& ct) { const int tile = vb + j * G; e = 0; while (tile >= s_toff[e + 1]) ++e; const int lt = tile - s_toff[e]; rt = lt >> 2; ct = lt & 3; };
    for (int i = tid; i < my_tiles * 256; i += NTHR) {
        const int j = i >> 8, r = i & 255; int e, rt, ct; locate(j, e, rt, ct);
        lwc[i] = lw[(size_t)e * NTOK + min(rt * 256 + r, s_cnt[e] - 1)];
    }
    __syncthreads();
    const bf16_t* Wdn = (const bf16_t*)(p.ws + OFF_W_DN) + (size_t)layer * 16 * 1024 * 512;
    gemm_stream2(my_tiles, 512, lds, cx,
        [=](int j, const bf16_t* (&ap)[2], const bf16_t* (&bp)[2]) {
            int e, rt, ct; locate(j, e, rt, ct);
            const int cnt = s_cnt[e], off = s_off[e];
            ap[0] = H1 + (size_t)(off + min(rt * 256 + sr, cnt - 1)) * 512 + sc; ap[1] = H1 + (size_t)(off + min(rt * 256 + sr + 128, cnt - 1)) * 512 + sc;
            bp[0] = Wdn + ((size_t)e * 1024 + ct * 256 + sr) * 512 + sc; bp[1] = bp[0] + (size_t)128 * 512;
        },
        [=](int j, f32x4 (&acc)[8][4], int wr, int wc, int fr, int fq) {
            int e, rt, ct; locate(j, e, rt, ct);
            const int cnt = s_cnt[e], off = s_off[e];
#pragma unroll
            for (int m = 0; m < 8; ++m) {
                const int rl_ = wr * 128 + m * 16 + fr, pos = rt * 256 + rl_;
                if (pos < cnt) {
                    const float w = lwc[j * 256 + rl_];
                    bf16_t* dst = Y + (size_t)(off + pos) * 1024 + ct * 256 + wc * 64;
#pragma unroll
                    for (int pp = 0; pp < 2; ++pp) {
                        const f32x4 a = acc[m][2 * pp], bb = acc[m][2 * pp + 1];
                        uint4 o; o.x = pack2(w * a[0], w * a[1]); o.y = pack2(w * a[2], w * a[3]); o.z = pack2(w * bb[0], w * bb[1]); o.w = pack2(w * bb[2], w * bb[3]);
                        *(uint4*)(dst + pp * 32 + fq * 8) = o;
                    }
                }
            }
        });
}


namespace pg8 {
#define PG8_LAS __attribute__((address_space(3)))
typedef unsigned short bf16_t;
typedef short bf16x8 __attribute__((ext_vector_type(8)));
typedef float f32x4 __attribute__((ext_vector_type(4)));
typedef unsigned u32x4 __attribute__((ext_vector_type(4)));
constexpr int BM = 256, BK = 64, HALF = 128, HTB = HALF * BK * 2  , STAGE_BYTES = 8 * HTB, NXCD = 8, WGM = 8;

__host__ __device__ __forceinline__ int lds_byte(int r, int c) { const int st = (r >> 4) * 2 + (c >> 5), rr = r & 15, cc = c & 31, ob = rr * 64 + cc * 2; return st * 1024 + (ob ^ (((ob >> 9) & 1) << 5)); }
__host__ __device__ __forceinline__ void stage_rc(int b, int& R, int& C) { const int st = b / 1024, sb = b % 1024, swz = sb ^ (((sb >> 9) & 1) << 5); R = (st >> 1) * 16 + swz / 64; C = (st & 1) * 32 + (swz % 64) / 2; }
__host__ __device__ __forceinline__ int perm32(int rho) { const int n = rho >> 4, i = rho & 15; return 8 * (i >> 2) + 4 * n + (i & 3); }

struct Unit { int pm, pn; };
struct Gemm { const bf16_t* A; const bf16_t* Bt; int M, N, K; };

struct StaticOrder {
    int nM, nN, nwg, G, c;
    __host__ __device__ void init(int M, int N, int G_, int c_) { nM = M / BM; nN = N / BM; nwg = nM * nN; G = G_; c = c_; }
    __host__ __device__ bool next(int i, Unit& u) const {
        const long L = (long)i * G + c; if (L >= nwg) return false;
        int wgid = (int)L; { const int q = nwg / NXCD, r = nwg % NXCD, xcd = wgid % NXCD, off = wgid / NXCD; wgid = (xcd < r ? xcd * (q + 1) : r * (q + 1) + (xcd - r) * q) + off; }
        const int nig = WGM * nN, gid = wgid / nig, fm = gid * WGM, gsz = (nM - fm) < WGM ? (nM - fm) : WGM;
        u.pm = fm + ((wgid % nig) % gsz); u.pn = (wgid % nig) / gsz; return true;
    }
    __device__ __forceinline__ void a_ready(const Unit&) const {}
    __device__ __forceinline__ void done(const Unit&) const {}
};

template <class Epi, class Sched, bool ALIGN_EPI = false, bool SP2 = false>
__device__ __forceinline__ void gemm_phase(PG8_LAS unsigned char* lds, const Gemm g, const Sched& S, const Epi& E) {
    const int tid = threadIdx.x, wid = __builtin_amdgcn_readfirstlane(tid >> 6), lane = tid & 63, wr = wid >> 2, wc = wid & 3, fr = lane & 15, fq = lane >> 4;
    const int K = g.K, nt = K / BK;
    unsigned voffA[2], voffB[2];
#pragma unroll
    for (int i = 0; i < 2; ++i) { int R, C; stage_rc(tid * 16 + i * 8192, R, C); const int Rb = Epi::PERM ? ((R & ~31) + perm32(R & 31)) : R;
        voffA[i] = (unsigned)(R * K + C) * 2u; voffB[i] = (unsigned)(Rb * K + C) * 2u; }
    const size_t kstep = (size_t)(BK * 2);
    const size_t hstep = (size_t)HALF * K * 2;
    const size_t tstep = 2 * hstep;
    const unsigned ldsw = (unsigned)wid * 1024u;
    const int aoff = lds_byte(wr * 64 + fr, fq * 8), boff = lds_byte(wc * 32 + fr, fq * 8);
#define PG8_SA(b, h) (((b) * 2 + (h)) * HTB)
#define PG8_SB(b, h) ((4 + (b) * 2 + (h)) * HTB)
#define PG8_STAGE(bufoff, gbase, voff) do { _Pragma("unroll") for (int _i = 0; _i < 2; ++_i) \
        __builtin_amdgcn_global_load_lds((const unsigned*)((const char*)(gbase) + (voff)[_i]), (PG8_LAS unsigned*)(lds + (bufoff) + ldsw + _i * 8192), 16, 0, 0); } while (0)
#define PG8_LDA(dst, b, h) do { _Pragma("unroll") for (int m = 0; m < 4; ++m) _Pragma("unroll") for (int k = 0; k < 2; ++k) dst[m][k] = *(const PG8_LAS bf16x8*)(lds + PG8_SA(b, h) + aoff + m * 2048 + k * 1024); } while (0)
#define PG8_LDB(dst, b, h) do { _Pragma("unroll") for (int n = 0; n < 2; ++n) _Pragma("unroll") for (int k = 0; k < 2; ++k) dst[n][k] = *(const PG8_LAS bf16x8*)(lds + PG8_SB(b, h) + boff + n * 2048 + k * 1024); } while (0)
#define PG8_MMA(ai, bj, At, Bt) do { __builtin_amdgcn_s_setprio(1); _Pragma("unroll") for (int m = 0; m < 4; ++m) _Pragma("unroll") for (int n = 0; n < 2; ++n) _Pragma("unroll") for (int k = 0; k < 2; ++k) \
        acc[ai][bj][m][n] = __builtin_amdgcn_mfma_f32_16x16x32_bf16(Bt[n][k], At[m][k], acc[ai][bj][m][n], 0, 0, 0); __builtin_amdgcn_s_setprio(0); } while (0)
#define PG8_WAIT_V(n) asm volatile("s_waitcnt vmcnt(" #n ")" ::: "memory")
#define PG8_WAIT_L(n) asm volatile("s_waitcnt lgkmcnt(" #n ")" ::: "memory")
#define PG8_BAR __builtin_amdgcn_s_barrier()
#define PG8_SCHED __builtin_amdgcn_sched_barrier(0)
    Unit cur, nxt; int ui = 0;
    if (!S.next(0, cur)) return;
    f32x4 acc[2][2][4][2];
#pragma unroll
    for (int a = 0; a < 2; ++a)
#pragma unroll
        for (int b = 0; b < 2; ++b)
#pragma unroll
            for (int m = 0; m < 4; ++m)
#pragma unroll
                for (int n = 0; n < 2; ++n) acc[a][b][m][n] = (f32x4){0.f, 0.f, 0.f, 0.f};
    bf16x8 At[4][2], B0[2][2], B1[2][2];
    const char* cA = (const char*)g.A + (size_t)cur.pm * tstep; const char* cB = (const char*)g.Bt + (size_t)cur.pn * tstep;
    S.a_ready(cur);
    if constexpr (SP2) {
        PG8_STAGE(PG8_SB(0, 0), cB, voffB); PG8_STAGE(PG8_SB(0, 1), cB + hstep, voffB); PG8_STAGE(PG8_SA(0, 0), cA, voffA); PG8_STAGE(PG8_SA(0, 1), cA + hstep, voffA);
        if (wr == 1) PG8_BAR;
        PG8_WAIT_V(2); PG8_BAR;
        PG8_STAGE(PG8_SB(1, 0), cB + kstep, voffB); PG8_STAGE(PG8_SA(1, 0), cA + kstep, voffA); PG8_STAGE(PG8_SB(1, 1), cB + hstep + kstep, voffB);
        PG8_WAIT_V(6); PG8_BAR;
    } else {
        PG8_STAGE(PG8_SB(0, 0), cB, voffB); PG8_STAGE(PG8_SA(0, 0), cA, voffA); PG8_STAGE(PG8_SB(0, 1), cB + hstep, voffB); PG8_STAGE(PG8_SA(0, 1), cA + hstep, voffA);
        if (wr == 1) PG8_BAR;
        PG8_WAIT_V(4); PG8_BAR;
        PG8_STAGE(PG8_SB(1, 0), cB + kstep, voffB); PG8_STAGE(PG8_SA(1, 0), cA + kstep, voffA); PG8_STAGE(PG8_SB(1, 1), cB + hstep + kstep, voffB);
        PG8_WAIT_V(6); PG8_BAR;
    }
    for (;;) {
        const bool has_next = S.next(ui + 1, nxt);
        const char* nA = has_next ? (const char*)g.A + (size_t)nxt.pm * tstep : cA; const char* nB = has_next ? (const char*)g.Bt + (size_t)nxt.pn * tstep : cB;
        for (int t = 0; t < nt; t += 2) {
            const bool last = (t == nt - 2);
            const char* a1 = cA + (size_t)(t + 1) * kstep;
            const char* a2 = last ? nA : cA + (size_t)(t + 2) * kstep; const char* b2 = last ? nB : cB + (size_t)(t + 2) * kstep;
            const char* a3 = a2 + kstep; const char* b3 = b2 + kstep;
            if (last && has_next) S.a_ready(nxt);
            if constexpr (SP2) {
            PG8_LDB(B0, 0, 0); PG8_LDB(B1, 0, 1); PG8_SCHED; PG8_LDA(At, 0, 0); PG8_STAGE(PG8_SA(1, 1), a1 + hstep, voffA);
            PG8_WAIT_V(8); PG8_WAIT_L(0); PG8_BAR; PG8_MMA(0, 0, At, B0); PG8_MMA(0, 1, At, B1); PG8_BAR; PG8_SCHED;
            PG8_LDA(At, 0, 1); PG8_STAGE(PG8_SB(0, 0), b2, voffB); PG8_STAGE(PG8_SB(0, 1), b2 + hstep, voffB); PG8_STAGE(PG8_SA(0, 0), a2, voffA);
            PG8_WAIT_V(8); PG8_WAIT_L(0); PG8_BAR; PG8_MMA(1, 0, At, B0); PG8_MMA(1, 1, At, B1); PG8_BAR; PG8_SCHED;
            PG8_LDB(B0, 1, 0); PG8_LDB(B1, 1, 1); PG8_SCHED; PG8_LDA(At, 1, 0); PG8_STAGE(PG8_SA(0, 1), a2 + hstep, voffA);
            PG8_WAIT_V(8); PG8_WAIT_L(0); PG8_BAR; PG8_MMA(0, 0, At, B0); PG8_MMA(0, 1, At, B1); PG8_BAR; PG8_SCHED;
            PG8_LDA(At, 1, 1); PG8_STAGE(PG8_SB(1, 0), b3, voffB); PG8_STAGE(PG8_SB(1, 1), b3 + hstep, voffB); PG8_STAGE(PG8_SA(1, 0), a3, voffA);
            PG8_WAIT_V(8); PG8_WAIT_L(0); PG8_BAR; PG8_MMA(1, 0, At, B0); PG8_MMA(1, 1, At, B1); PG8_BAR; PG8_SCHED;
            } else {
            PG8_LDB(B0, 0, 0); PG8_SCHED; PG8_LDA(At, 0, 0); PG8_STAGE(PG8_SA(1, 1), a1 + hstep, voffA);
            PG8_WAIT_L(8); PG8_BAR; PG8_WAIT_L(0); PG8_MMA(0, 0, At, B0); PG8_BAR; PG8_SCHED;
            PG8_LDB(B1, 0, 1); PG8_STAGE(PG8_SB(0, 0), b2, voffB);
            PG8_BAR; PG8_WAIT_L(0); PG8_MMA(0, 1, At, B1); PG8_BAR;
            PG8_LDA(At, 0, 1); PG8_STAGE(PG8_SA(0, 0), a2, voffA);
            PG8_BAR; PG8_WAIT_L(0); PG8_MMA(1, 0, At, B0); PG8_BAR; PG8_SCHED;
            PG8_STAGE(PG8_SB(0, 1), b2 + hstep, voffB);
            PG8_WAIT_V(6); PG8_BAR; PG8_MMA(1, 1, At, B1); PG8_BAR;
            PG8_LDB(B0, 1, 0); PG8_SCHED; PG8_LDA(At, 1, 0); PG8_STAGE(PG8_SA(0, 1), a2 + hstep, voffA);
            PG8_WAIT_L(8); PG8_BAR; PG8_WAIT_L(0); PG8_MMA(0, 0, At, B0); PG8_BAR; PG8_SCHED;
            PG8_LDB(B1, 1, 1); PG8_STAGE(PG8_SB(1, 0), b3, voffB);
            PG8_BAR; PG8_WAIT_L(0); PG8_MMA(0, 1, At, B1); PG8_BAR;
            PG8_LDA(At, 1, 1); PG8_STAGE(PG8_SA(1, 0), a3, voffA);
            PG8_BAR; PG8_WAIT_L(0); PG8_MMA(1, 0, At, B0); PG8_BAR; PG8_SCHED;
            PG8_STAGE(PG8_SB(1, 1), b3 + hstep, voffB);
            PG8_WAIT_V(6); PG8_BAR; PG8_MMA(1, 1, At, B1); PG8_BAR;
            }
        }
        if constexpr (ALIGN_EPI) { if (wr == 0) PG8_BAR; }
        if constexpr (!Epi::AFTER_DRAIN) { E(acc, cur, wr, wc, fr, fq); S.done(cur); }
        if (!has_next) break;
#pragma unroll
        for (int a = 0; a < 2; ++a)
#pragma unroll
            for (int b = 0; b < 2; ++b)
#pragma unroll
                for (int m = 0; m < 4; ++m)
#pragma unroll
                    for (int n = 0; n < 2; ++n) acc[a][b][m][n] = (f32x4){0.f, 0.f, 0.f, 0.f};
        cur = nxt; cA = nA; cB = nB; ++ui;
        if constexpr (ALIGN_EPI) { if (wr == 1) PG8_BAR; }
    }
    PG8_WAIT_V(0);
    if constexpr (!ALIGN_EPI) { if (wr == 0) PG8_BAR; }
    PG8_BAR;
    if constexpr (Epi::AFTER_DRAIN) { E.fused(acc, cur, wr, wc, fr, fq, lds, wid, lane); S.done(cur); }
#undef PG8_SA
#undef PG8_SB
#undef PG8_STAGE
#undef PG8_LDA
#undef PG8_LDB
#undef PG8_MMA
#undef PG8_WAIT_V
#undef PG8_WAIT_L
#undef PG8_BAR
#undef PG8_SCHED
}

template <class Epi, class Sched>
__device__ __forceinline__ void gemm_phase_rows(PG8_LAS unsigned char* lds, const Gemm g, const Sched& S, const Epi& E, const PG8_LAS int* rows) {
    const int tid = threadIdx.x, wid = __builtin_amdgcn_readfirstlane(tid >> 6), lane = tid & 63, wr = wid >> 2, wc = wid & 3, fr = lane & 15, fq = lane >> 4;
    const int K = g.K, nt = K / BK;
    unsigned voffB[2]; int R0 = 0, C0 = 0;
#pragma unroll
    for (int i = 0; i < 2; ++i) { int R, C; stage_rc(tid * 16 + i * 8192, R, C); voffB[i] = (unsigned)(R * K + C) * 2u; if (i == 0) { R0 = R; C0 = C; } }
    const size_t kstep = (size_t)(BK * 2);
    const size_t hstep = (size_t)HALF * K * 2;
    const size_t tstep = 2 * hstep;
    const unsigned ldsw = (unsigned)wid * 1024u;
    const int aoff = lds_byte(wr * 64 + fr, fq * 8), boff = lds_byte(wc * 32 + fr, fq * 8);
#define PG8_SA(b, h) (((b) * 2 + (h)) * HTB)
#define PG8_SB(b, h) ((4 + (b) * 2 + (h)) * HTB)
#define PG8_STAGE(bufoff, gbase, voff) do { _Pragma("unroll") for (int _i = 0; _i < 2; ++_i) \
        __builtin_amdgcn_global_load_lds((const unsigned*)((const char*)(gbase) + (voff)[_i]), (PG8_LAS unsigned*)(lds + (bufoff) + ldsw + _i * 8192), 16, 0, 0); } while (0)
#define PG8_LDA(dst, b, h) do { _Pragma("unroll") for (int m = 0; m < 4; ++m) _Pragma("unroll") for (int k = 0; k < 2; ++k) dst[m][k] = *(const PG8_LAS bf16x8*)(lds + PG8_SA(b, h) + aoff + m * 2048 + k * 1024); } while (0)
#define PG8_LDB(dst, b, h) do { _Pragma("unroll") for (int n = 0; n < 2; ++n) _Pragma("unroll") for (int k = 0; k < 2; ++k) dst[n][k] = *(const PG8_LAS bf16x8*)(lds + PG8_SB(b, h) + boff + n * 2048 + k * 1024); } while (0)
#define PG8_MMA(ai, bj, At, Bt) do { __builtin_amdgcn_s_setprio(1); _Pragma("unroll") for (int m = 0; m < 4; ++m) _Pragma("unroll") for (int n = 0; n < 2; ++n) _Pragma("unroll") for (int k = 0; k < 2; ++k) \
        acc[ai][bj][m][n] = __builtin_amdgcn_mfma_f32_16x16x32_bf16(Bt[n][k], At[m][k], acc[ai][bj][m][n], 0, 0, 0); __builtin_amdgcn_s_setprio(0); } while (0)
#define PG8_WAIT_V(n) asm volatile("s_waitcnt vmcnt(" #n ")" ::: "memory")
#define PG8_WAIT_L(n) asm volatile("s_waitcnt lgkmcnt(" #n ")" ::: "memory")
#define PG8_BAR __builtin_amdgcn_s_barrier()
#define PG8_SCHED __builtin_amdgcn_sched_barrier(0)
    Unit cur, nxt; int ui = 0;
    if (!S.next(0, cur)) return;
    f32x4 acc[2][2][4][2];
#pragma unroll
    for (int a = 0; a < 2; ++a)
#pragma unroll
        for (int b = 0; b < 2; ++b)
#pragma unroll
            for (int m = 0; m < 4; ++m)
#pragma unroll
                for (int n = 0; n < 2; ++n) acc[a][b][m][n] = (f32x4){0.f, 0.f, 0.f, 0.f};
    bf16x8 At[4][2], B0[2][2], B1[2][2];
    unsigned vc[4], vn[4];
#pragma unroll
    for (int q = 0; q < 4; ++q) vc[q] = ((unsigned)rows[cur.pm * 256 + R0 + 64 * q] * (unsigned)K + (unsigned)C0) * 2u;
    const char* gA = (const char*)g.A; const char* cB = (const char*)g.Bt + (size_t)cur.pn * tstep;
    PG8_STAGE(PG8_SB(0, 0), cB, voffB); PG8_STAGE(PG8_SB(0, 1), cB + hstep, voffB); PG8_STAGE(PG8_SA(0, 0), gA, vc); PG8_STAGE(PG8_SA(0, 1), gA, vc + 2);
    if (wr == 1) PG8_BAR;
    PG8_WAIT_V(2); PG8_BAR;
    PG8_STAGE(PG8_SB(1, 0), cB + kstep, voffB); PG8_STAGE(PG8_SA(1, 0), gA + kstep, vc); PG8_STAGE(PG8_SB(1, 1), cB + hstep + kstep, voffB);
    PG8_WAIT_V(6); PG8_BAR;
    for (;;) {
        const bool has_next = S.next(ui + 1, nxt);
        if (has_next) {
#pragma unroll
            for (int q = 0; q < 4; ++q) vn[q] = ((unsigned)rows[nxt.pm * 256 + R0 + 64 * q] * (unsigned)K + (unsigned)C0) * 2u;
        } else {
#pragma unroll
            for (int q = 0; q < 4; ++q) vn[q] = vc[q];
        }
        const char* nB = has_next ? (const char*)g.Bt + (size_t)nxt.pn * tstep : cB;
        for (int t = 0; t < nt; t += 2) {
            const bool last = (t == nt - 2);
            const char* a1 = gA + (size_t)(t + 1) * kstep;
            const char* a2 = last ? gA : gA + (size_t)(t + 2) * kstep; const char* b2 = last ? nB : cB + (size_t)(t + 2) * kstep;
            const char* a3 = a2 + kstep; const char* b3 = b2 + kstep;
            unsigned v2[4];
#pragma unroll
            for (int q = 0; q < 4; ++q) v2[q] = last ? vn[q] : vc[q];
            PG8_LDB(B0, 0, 0); PG8_LDB(B1, 0, 1); PG8_SCHED; PG8_LDA(At, 0, 0); PG8_STAGE(PG8_SA(1, 1), a1, vc + 2);
            PG8_WAIT_V(8); PG8_WAIT_L(0); PG8_BAR; PG8_MMA(0, 0, At, B0); PG8_MMA(0, 1, At, B1); PG8_BAR; PG8_SCHED;
            PG8_LDA(At, 0, 1); PG8_STAGE(PG8_SB(0, 0), b2, voffB); PG8_STAGE(PG8_SB(0, 1), b2 + hstep, voffB); PG8_STAGE(PG8_SA(0, 0), a2, v2);
            PG8_WAIT_V(8); PG8_WAIT_L(0); PG8_BAR; PG8_MMA(1, 0, At, B0); PG8_MMA(1, 1, At, B1); PG8_BAR; PG8_SCHED;
            PG8_LDB(B0, 1, 0); PG8_LDB(B1, 1, 1); PG8_SCHED; PG8_LDA(At, 1, 0); PG8_STAGE(PG8_SA(0, 1), a2, v2 + 2);
            PG8_WAIT_V(8); PG8_WAIT_L(0); PG8_BAR; PG8_MMA(0, 0, At, B0); PG8_MMA(0, 1, At, B1); PG8_BAR; PG8_SCHED;
            PG8_LDA(At, 1, 1); PG8_STAGE(PG8_SB(1, 0), b3, voffB); PG8_STAGE(PG8_SB(1, 1), b3 + hstep, voffB); PG8_STAGE(PG8_SA(1, 0), a3, v2);
            PG8_WAIT_V(8); PG8_WAIT_L(0); PG8_BAR; PG8_MMA(1, 0, At, B0); PG8_MMA(1, 1, At, B1); PG8_BAR; PG8_SCHED;
        }
        if (wr == 0) PG8_BAR;
        E(acc, cur, wr, wc, fr, fq);
        if (!has_next) break;
#pragma unroll
        for (int a = 0; a < 2; ++a)
#pragma unroll
            for (int b = 0; b < 2; ++b)
#pragma unroll
                for (int m = 0; m < 4; ++m)
#pragma unroll
                    for (int n = 0; n < 2; ++n) acc[a][b][m][n] = (f32x4){0.f, 0.f, 0.f, 0.f};
        cur = nxt; cB = nB; ++ui;
#pragma unroll
        for (int q = 0; q < 4; ++q) vc[q] = vn[q];
        if (wr == 1) PG8_BAR;
    }
    PG8_WAIT_V(0);
    PG8_BAR;
#undef PG8_SA
#undef PG8_SB
#undef PG8_STAGE
#undef PG8_LDA
#undef PG8_LDB
#undef PG8_MMA
#undef PG8_WAIT_V
#undef PG8_WAIT_L
#undef PG8_BAR
#undef PG8_SCHED
}
}

#ifndef PG8_SP2
#define PG8_SP2 true
#endif
struct EpiHgrnIn {
    static constexpr bool PERM = false, AFTER_DRAIN = false;
    char* ws; const float* lb;
    __device__ __forceinline__ void operator()(const pg8::f32x4 (&acc)[2][2][4][2], const pg8::Unit& u, int wr, int wc, int fr, int fq) const {
#pragma unroll
        for (int ai = 0; ai < 2; ++ai)
#pragma unroll
            for (int m = 0; m < 4; ++m) {
                const int row = u.pm * 256 + ai * 128 + wr * 64 + m * 16 + fr;
#pragma unroll
                for (int bj = 0; bj < 2; ++bj) {
                    const int gc = u.pn * 256 + bj * 128 + wc * 32 + fq * 8, seg = gc >> 10, c = gc & 1023;
                    const f32x4 a0 = acc[ai][bj][m][0], a1 = acc[ai][bj][m][1];
                    float h[8];
                    if (seg == 1) {
                        const f32x4 la = *(const f32x4*)(lb + c), lbb = *(const f32x4*)(lb + c + 4);
#pragma unroll
                        for (int j = 0; j < 4; ++j) {
                            h[j] = __logf(la[j] + (1.f - la[j]) * sigmoid_f(a0[j]));
                            h[4 + j] = __logf(lbb[j] + (1.f - lbb[j]) * sigmoid_f(a1[j]));
                        }
                        uint4 oh; oh.x = packh2(h[0], h[1]); oh.y = packh2(h[2], h[3]); oh.z = packh2(h[4], h[5]); oh.w = packh2(h[6], h[7]);
                        *(uint4*)((unsigned short*)(ws + OFF_LF) + (size_t)row * 1024 + c) = oh;
                    } else {
#pragma unroll
                        for (int j = 0; j < 4; ++j) {
                            h[j] = (seg == 2) ? a0[j] : silu_f(a0[j]);
                            h[4 + j] = (seg == 2) ? a1[j] : silu_f(a1[j]);
                        }
                        uint4 o; o.x = pack2(h[0], h[1]); o.y = pack2(h[2], h[3]); o.z = pack2(h[4], h[5]); o.w = pack2(h[6], h[7]);
                        bf16_t* dst = (bf16_t*)(ws + (seg == 0 ? OFF_QH : seg == 2 ? OFF_V : OFF_G));
                        *(uint4*)(dst + (size_t)row * 1024 + c) = o;
                    }
                }
            }
    }
};

struct EpiOutProj {
    static constexpr bool PERM = false, AFTER_DRAIN = false;
    const float* mod; const float* xin; float* xo; int ls;
    __device__ __forceinline__ void operator()(const pg8::f32x4 (&acc)[2][2][4][2], const pg8::Unit& u, int wr, int wc, int fr, int fq) const {
        const int b = (u.pm * 256) >> 11;
        const float* gate = mod + ((size_t)ls * 16 + b) * 3072 + 2048 + u.pn * 256 + wc * 32 + fq * 8;
        f32x4 g[2][2];
#pragma unroll
        for (int bj = 0; bj < 2; ++bj) { g[bj][0] = *(const f32x4*)(gate + bj * 128); g[bj][1] = *(const f32x4*)(gate + bj * 128 + 4); }
#pragma unroll
        for (int ai = 0; ai < 2; ++ai)
#pragma unroll
            for (int m = 0; m < 4; ++m) {
                const size_t ro = (size_t)(u.pm * 256 + ai * 128 + wr * 64 + m * 16 + fr) * 1024 + u.pn * 256 + wc * 32 + fq * 8;
                f32x4 xi[2][2];
#pragma unroll
                for (int bj = 0; bj < 2; ++bj) { xi[bj][0] = *(const f32x4*)(xin + ro + bj * 128); xi[bj][1] = *(const f32x4*)(xin + ro + bj * 128 + 4); }
#pragma unroll
                for (int bj = 0; bj < 2; ++bj)
#pragma unroll
                    for (int n = 0; n < 2; ++n) {
                        f32x4 o;
#pragma unroll
                        for (int j = 0; j < 4; ++j) o[j] = xi[bj][n][j] + g[bj][n][j] * acc[ai][bj][m][n][j];
                        *(f32x4*)(xo + ro + bj * 128 + n * 4) = o;
                    }
            }
    }
};


struct MoeOrder {
    const int* s_toff; int ntiles, vb, G;
    __device__ __forceinline__ bool next(int i, pg8::Unit& u) const {
        const int tile = vb + i * G; if (tile >= ntiles) return false;
        int e = 0; while (tile >= s_toff[e + 1]) ++e;
        u.pm = i; u.pn = e * 4 + ((tile - s_toff[e]) & 3); return true;
    }
};
struct EpiMoeUp {
    static constexpr bool PERM = false, AFTER_DRAIN = false;
    bf16_t* H1; const int* s_cnt; const int* s_off; const int* s_toff; int vb, G;
    __device__ __forceinline__ void operator()(const pg8::f32x4 (&acc)[2][2][4][2], const pg8::Unit& u, int wr, int wc, int fr, int fq) const {
        const int e = u.pn >> 2, ct = u.pn & 3, rt = (vb + u.pm * G - s_toff[e]) >> 2;
        const int cnt = s_cnt[e], off = s_off[e];
#pragma unroll
        for (int ai = 0; ai < 2; ++ai)
#pragma unroll
            for (int m = 0; m < 4; ++m) {
                const int pos = rt * 256 + ai * 128 + wr * 64 + m * 16 + fr;
                if (pos < cnt) {
                    float h[8];
#pragma unroll
                    for (int n = 0; n < 2; ++n)
#pragma unroll
                        for (int jj = 0; jj < 4; ++jj) h[n * 4 + jj] = silu_f(acc[ai][0][m][n][jj]) * acc[ai][1][m][n][jj];
                    uint4 o; o.x = pack2(h[0], h[1]); o.y = pack2(h[2], h[3]); o.z = pack2(h[4], h[5]); o.w = pack2(h[6], h[7]);
                    *(uint4*)(H1 + (size_t)(off + pos) * 512 + ct * 128 + wc * 32 + fq * 8) = o;
                }
            }
    }
};
struct EpiMoeDown {
    static constexpr bool PERM = false, AFTER_DRAIN = false;
    bf16_t* Y; const float* lwc; const int* s_cnt; const int* s_off; const int* s_toff; int vb, G;
    __device__ __forceinline__ void operator()(const pg8::f32x4 (&acc)[2][2][4][2], const pg8::Unit& u, int wr, int wc, int fr, int fq) const {
        const int e = u.pn >> 2, ct = u.pn & 3, rt = (vb + u.pm * G - s_toff[e]) >> 2;
        const int cnt = s_cnt[e], off = s_off[e];
#pragma unroll
        for (int ai = 0; ai < 2; ++ai)
#pragma unroll
            for (int m = 0; m < 4; ++m) {
                const int rl_ = ai * 128 + wr * 64 + m * 16 + fr, pos = rt * 256 + rl_;
                if (pos < cnt) {
                    const float w = lwc[u.pm * 256 + rl_];
                    bf16_t* dst = Y + (size_t)(off + pos) * 1024 + ct * 256 + wc * 32 + fq * 8;
#pragma unroll
                    for (int bj = 0; bj < 2; ++bj) {
                        const pg8::f32x4 a = acc[ai][bj][m][0], bb = acc[ai][bj][m][1];
                        uint4 o; o.x = pack2(w * a[0], w * a[1]); o.y = pack2(w * a[2], w * a[3]); o.z = pack2(w * bb[0], w * bb[1]); o.w = pack2(w * bb[2], w * bb[3]);
                        *(uint4*)(dst + bj * 128) = o;
                    }
                }
            }
    }
};

__device__ __forceinline__ void phase_moe_up8(const Params& p, const Ctx& cx, char* lds, int layer) {
    const int tid = cx.tid;
    int* s_cnt = (int*)(lds + LDS_TAB_OFF); int* s_off = s_cnt + 16; int* s_toff = s_off + 17;
    moe_tables(p, layer, tid, s_cnt, s_off, s_toff);
    const int ntiles = s_toff[16];
    const int* ltok = (const int*)(p.ws + OFF_LTOK);
    int* rowidx = (int*)(lds + LDS_ROWIDX_OFF);
    const int vb = cx.vbid, G = cx.G;
    const int my_tiles = min(8, vb < ntiles ? (ntiles - vb + G - 1) / G : 0);
    for (int i = tid; i < my_tiles * 256; i += NTHR) {
        const int j = i >> 8, r = i & 255; const int tile = vb + j * G; int e = 0; while (tile >= s_toff[e + 1]) ++e; const int rt = (tile - s_toff[e]) >> 2;
        rowidx[i] = ltok[(size_t)e * NTOK + min(rt * 256 + r, s_cnt[e] - 1)];
    }
    __syncthreads();
    pg8::Gemm g{(const bf16_t*)(p.ws + OFF_HA), (const bf16_t*)(p.ws + OFF_W_UP) + (size_t)layer * 16 * 1024 * 1024, 0, 0, 1024};
    MoeOrder S{s_toff, ntiles, vb, G};
    EpiMoeUp E{(bf16_t*)(p.ws + OFF_H1), s_cnt, s_off, s_toff, vb, G};
    pg8::gemm_phase_rows<EpiMoeUp, MoeOrder>((PG8_LAS unsigned char*)lds, g, S, E, (const PG8_LAS int*)((PG8_LAS unsigned char*)lds + LDS_ROWIDX_OFF));
}

__device__ __forceinline__ void phase_moe_down8(const Params& p, const Ctx& cx, char* lds, int layer) {
    const int tid = cx.tid;
    int* s_cnt = (int*)(lds + LDS_TAB_OFF); int* s_off = s_cnt + 16; int* s_toff = s_off + 17;
    moe_tables(p, layer, tid, s_cnt, s_off, s_toff);
    const int ntiles = s_toff[16];
    const float* lw = (const float*)(p.ws + OFF_LW);
    int* rowidx = (int*)(lds + LDS_ROWIDX_OFF);
    float* lwc = (float*)(lds + LDS_LW_OFF);
    const int vb = cx.vbid, G = cx.G;
    const int my_tiles = min(8, vb < ntiles ? (ntiles - vb + G - 1) / G : 0);
    for (int i = tid; i < my_tiles * 256; i += NTHR) {
        const int j = i >> 8, r = i & 255; const int tile = vb + j * G; int e = 0; while (tile >= s_toff[e + 1]) ++e; const int rt = (tile - s_toff[e]) >> 2;
        const int pos = min(rt * 256 + r, s_cnt[e] - 1);
        rowidx[i] = s_off[e] + pos;
        lwc[i] = lw[(size_t)e * NTOK + pos];
    }
    __syncthreads();
    pg8::Gemm g{(const bf16_t*)(p.ws + OFF_H1), (const bf16_t*)(p.ws + OFF_W_DN) + (size_t)layer * 16 * 1024 * 512, 0, 0, 512};
    MoeOrder S{s_toff, ntiles, vb, G};
    EpiMoeDown E{(bf16_t*)(p.ws + OFF_Y), lwc, s_cnt, s_off, s_toff, vb, G};
    pg8::gemm_phase_rows<EpiMoeDown, MoeOrder>((PG8_LAS unsigned char*)lds, g, S, E, (const PG8_LAS int*)((PG8_LAS unsigned char*)lds + LDS_ROWIDX_OFF));
}

__device__ __forceinline__ void phase_outproj8(const Params& p, const Ctx& cx, char* lds, const bf16_t* A, const bf16_t* Bt, const float* xin, int ls) {
    pg8::Gemm g{A, Bt, NTOK, 1024, 1024};
    pg8::StaticOrder S; S.init(NTOK, 1024, cx.G, (int)blockIdx.x);
    EpiOutProj E{(const float*)(p.ws + OFF_MOD), xin, p.out, ls};
    __syncthreads();
    pg8::gemm_phase<EpiOutProj, pg8::StaticOrder, true, PG8_SP2>((PG8_LAS unsigned char*)lds, g, S, E);
    __syncthreads();
}

__device__ __forceinline__ void phase_hgrn_inproj8(const Params& p, const Ctx& cx, char* lds) {
    pg8::Gemm g{(const bf16_t*)(p.ws + OFF_HA), (const bf16_t*)(p.ws + OFF_W_HG_IN), NTOK, 4096, 1024};
    pg8::StaticOrder S; S.init(NTOK, 4096, cx.G, (int)blockIdx.x);
    EpiHgrnIn E{p.ws, (const float*)(p.ws + OFF_LB)};
    __syncthreads();
    pg8::gemm_phase<EpiHgrnIn, pg8::StaticOrder, true, PG8_SP2>((PG8_LAS unsigned char*)lds, g, S, E);
    __syncthreads();
}

template <int MODE = 0>
__device__ __forceinline__ void phase_hgrn_inproj(const Params& p, const Ctx& cx, char* lds) {
    const bf16_t* A = (const bf16_t*)(p.ws + OFF_HA);
    const bf16_t* Bt = (const bf16_t*)(p.ws + OFF_W_HG_IN);
    char* ws = p.ws;
    const float* lb = (const float*)(p.ws + OFF_LB);
    gemm_phase_dense2(A, 1024, Bt, 1024, NTOK / 256, 16, lds, cx, [=](int row0, int col0) {
        return [=](f32x4 (&acc)[8][4], int wr, int wc, int fr, int fq) {
            const int gc0 = col0 + wc * 64, seg = gc0 >> 10, c0 = gc0 & 1023;
#pragma unroll
            for (int m = 0; m < 8; ++m) {
                const int row = row0 + wr * 128 + m * 16 + fr;
#pragma unroll
                for (int pp = 0; pp < 2; ++pp) {
                    const int c = c0 + pp * 32 + fq * 8;
                    float h[8];
                    if (seg == 1) {
                        const f32x4 la = *(const f32x4*)(lb + c), lbb = *(const f32x4*)(lb + c + 4);
#pragma unroll
                        for (int j = 0; j < 4; ++j) {
                            h[j] = __logf(la[j] + (1.f - la[j]) * sigmoid_f(acc[m][2 * pp][j]));
                            h[4 + j] = __logf(lbb[j] + (1.f - lbb[j]) * sigmoid_f(acc[m][2 * pp + 1][j]));
                        }
                        uint4 oh; oh.x = packh2(h[0], h[1]); oh.y = packh2(h[2], h[3]); oh.z = packh2(h[4], h[5]); oh.w = packh2(h[6], h[7]);
                        *(uint4*)((unsigned short*)(ws + OFF_LF) + (size_t)row * 1024 + c) = oh;
                    } else {
#pragma unroll
                        for (int j = 0; j < 4; ++j) {
                            h[j] = (seg == 2) ? acc[m][2 * pp][j] : silu_f(acc[m][2 * pp][j]);
                            h[4 + j] = (seg == 2) ? acc[m][2 * pp + 1][j] : silu_f(acc[m][2 * pp + 1][j]);
                        }
                        uint4 o; o.x = pack2(h[0], h[1]); o.y = pack2(h[2], h[3]); o.z = pack2(h[4], h[5]); o.w = pack2(h[6], h[7]);
                        bf16_t* dst = (bf16_t*)(ws + (seg == 0 ? OFF_QH : seg == 2 ? OFF_V : OFF_G));
                        *(uint4*)(dst + (size_t)row * 1024 + c) = o;
                    }
                }
            }
        };
    });
}

constexpr int HG_QD_OFF = 0, HG_KD_OFF = 8704, HG_K2T_OFF = 17408, HG_VT_OFF = 27648, HG_DEC_OFF = 37888, HG_BUF = 38400, HG_TOT_OFF = 2 * HG_BUF;
constexpr int HG_ROW = 272, HG_TROW = 80;
static_assert(HG_TOT_OFF + 2048 <= LDS_TAB_OFF, "hgrn LDS");

__device__ __forceinline__ void phase_hgrn_rec(const Params& p, const Ctx& cx, char* lds) {
    const int lane = cx.lane;
    const int l31 = lane & 31, h2 = lane >> 5;
    const int widu = __builtin_amdgcn_readfirstlane(cx.wid);
    const bool producer = widu >= 4;
    const int pw = widu & 3;
    const int d0 = 2 * lane;
    const bf16_t* QH = (const bf16_t*)(p.ws + OFF_QH);
    const unsigned short* LF = (const unsigned short*)(p.ws + OFF_LF);
    const bf16_t* V = (const bf16_t*)(p.ws + OFF_V);
    bf16_t* OR = (bf16_t*)(p.ws + OFF_HA);
    float* tot = (float*)(lds + HG_TOT_OFF);
    for (int item = blockIdx.x; item < 128; item += cx.G) {
        const int b = item >> 3, h = item & 7;
        f32x16 S0, S1, S2, S3;
#pragma unroll
        for (int r = 0; r < 16; ++r) { S0[r] = 0.f; S1[r] = 0.f; S2[r] = 0.f; S3[r] = 0.f; }
        unsigned lfA[8], lfB[8], qv[8], vv[8];
        const size_t gbase = (size_t)(b * SEQ + pw * 8) * 1024 + h * 128;
        if (producer) {
#pragma unroll
            for (int i = 0; i < 8; ++i) {
                lfA[i] = *(const unsigned*)(LF + gbase + (size_t)i * 1024 + d0);
                qv[i] = *(const unsigned*)(QH + gbase + (size_t)i * 1024 + d0);
                vv[i] = *(const unsigned*)(V + gbase + (size_t)i * 1024 + d0);
            }
#pragma unroll
            for (int i = 0; i < 8; ++i) lfB[i] = *(const unsigned*)(LF + gbase + (size_t)(32 + i) * 1024 + d0);
        }
        __syncthreads();
        for (int c = 0; c <= SEQ / 32; ++c) {
            unsigned lf[8];
#pragma unroll
            for (int i = 0; i < 8; ++i) lf[i] = (c & 1) ? lfB[i] : lfA[i];
            f2_t run = {0.f, 0.f};
            if (producer && c < SEQ / 32) {
#pragma unroll
                for (int i = 0; i < 8; ++i) run += unpackh2(lf[i]);
                *(f2_t*)(tot + pw * 128 + d0) = run;
            }
            __syncthreads();
            if (producer) {
                if (c < SEQ / 32) {
                    char* bufp = lds + (c & 1) * HG_BUF;
                    f2_t pre = {0.f, 0.f}, last = {0.f, 0.f};
#pragma unroll
                    for (int q = 0; q < 4; ++q) {
                        const f2_t tq_ = *(const f2_t*)(tot + q * 128 + d0);
                        last += tq_;
                        if (q < pw) pre += tq_;
                    }
                    if (pw == 0) { f2_t dv; dv.x = __expf(last.x); dv.y = __expf(last.y); *(f2_t*)(bufp + HG_DEC_OFF + d0 * 4) = dv; }
                    float k2a[8], k2b[8];
                    f2_t rc = pre;
#pragma unroll
                    for (int i = 0; i < 8; ++i) {
                        const f2_t lfi = unpackh2(lf[i]);
                        rc += lfi;
                        const float cu0 = rc.x, cu1 = rc.y;
                        const float kk0 = 1.f - __expf(lfi.x), kk1 = 1.f - __expf(lfi.y);
                        const float q0 = bf2f((unsigned short)(qv[i] & 0xffff)) * __expf(cu0), q1 = bf2f((unsigned short)(qv[i] >> 16)) * __expf(cu1);
                        const float kd0 = kk0 * __expf(-cu0), kd1 = kk1 * __expf(-cu1);
                        k2a[i] = kk0 * __expf(last.x - cu0); k2b[i] = kk1 * __expf(last.y - cu1);
                        const int tl = pw * 8 + i;
                        *(unsigned*)(bufp + HG_QD_OFF + tl * HG_ROW + d0 * 2) = pack2(q0, q1);
                        *(unsigned*)(bufp + HG_KD_OFF + tl * HG_ROW + d0 * 2) = pack2(kd0, kd1);
                    }
                    uint4 a, bq, va, vb;
                    a.x = pack2(k2a[0], k2a[1]); a.y = pack2(k2a[2], k2a[3]); a.z = pack2(k2a[4], k2a[5]); a.w = pack2(k2a[6], k2a[7]);
                    bq.x = pack2(k2b[0], k2b[1]); bq.y = pack2(k2b[2], k2b[3]); bq.z = pack2(k2b[4], k2b[5]); bq.w = pack2(k2b[6], k2b[7]);
                    va.x = (vv[0] & 0xffffu) | (vv[1] << 16); va.y = (vv[2] & 0xffffu) | (vv[3] << 16); va.z = (vv[4] & 0xffffu) | (vv[5] << 16); va.w = (vv[6] & 0xffffu) | (vv[7] << 16);
                    vb.x = (vv[0] >> 16) | (vv[1] & 0xffff0000u); vb.y = (vv[2] >> 16) | (vv[3] & 0xffff0000u); vb.z = (vv[4] >> 16) | (vv[5] & 0xffff0000u); vb.w = (vv[6] >> 16) | (vv[7] & 0xffff0000u);
                    *(uint4*)(bufp + HG_K2T_OFF + d0 * HG_TROW + pw * 16) = a;
                    *(uint4*)(bufp + HG_K2T_OFF + (d0 + 1) * HG_TROW + pw * 16) = bq;
                    *(uint4*)(bufp + HG_VT_OFF + d0 * HG_TROW + pw * 16) = va;
                    *(uint4*)(bufp + HG_VT_OFF + (d0 + 1) * HG_TROW + pw * 16) = vb;
                    __builtin_amdgcn_sched_barrier(0);
                    if (c + 1 < SEQ / 32) {
                        const size_t gn = gbase + (size_t)(c + 1) * 32 * 1024;
#pragma unroll
                        for (int i = 0; i < 8; ++i) {
                            qv[i] = *(const unsigned*)(QH + gn + (size_t)i * 1024 + d0);
                            vv[i] = *(const unsigned*)(V + gn + (size_t)i * 1024 + d0);
                        }
                    }
                    if (c + 2 < SEQ / 32) {
                        const size_t gn = gbase + (size_t)(c + 2) * 32 * 1024;
                        if (c & 1) {
#pragma unroll
                            for (int i = 0; i < 8; ++i) lfB[i] = *(const unsigned*)(LF + gn + (size_t)i * 1024 + d0);
                        } else {
#pragma unroll
                            for (int i = 0; i < 8; ++i) lfA[i] = *(const unsigned*)(LF + gn + (size_t)i * 1024 + d0);
                        }
                    }
                }
            } else if (c >= 1) {
                const int cc = c - 1;
                const char* bufp = lds + (cc & 1) * HG_BUF;
                const float* dec = (const float*)(bufp + HG_DEC_OFF);
                f32x16 X;
#pragma unroll
                for (int r = 0; r < 16; ++r) X[r] = 0.f;
                {
                    const char* ka = bufp + HG_KD_OFF + l31 * HG_ROW + 16 * h2;
                    const char* qa = bufp + HG_QD_OFF + l31 * HG_ROW + 16 * h2;
#pragma unroll 2
                    for (int ks = 0; ks < 8; ++ks) X = MFMA32(*(const bf16x8*)(ka + 32 * ks), *(const bf16x8*)(qa + 32 * ks), X);
#pragma unroll
                    for (int r = 0; r < 16; ++r) { const int srow = (r & 3) + 8 * (r >> 2) + 4 * h2; X[r] = (srow <= l31) ? X[r] : 0.f; }
                }
                f32x16 Oa;
#pragma unroll
                for (int r = 0; r < 16; ++r) Oa[r] = 0.f;
                const int jrow = 32 * pw + l31;
#pragma unroll
                for (int s2 = 0; s2 < 2; ++s2) {
                    uint4 xk;
                    xk.x = pack2(X[8 * s2], X[8 * s2 + 1]); xk.y = pack2(X[8 * s2 + 2], X[8 * s2 + 3]); xk.z = pack2(X[8 * s2 + 4], X[8 * s2 + 5]); xk.w = pack2(X[8 * s2 + 6], X[8 * s2 + 7]);
                    const char* va = bufp + HG_VT_OFF + jrow * HG_TROW + (16 * s2 + 4 * h2) * 2;
                    const uint2 lo = *(const uint2*)va, hi = *(const uint2*)(va + 16);
                    uint4 vb; vb.x = lo.x; vb.y = lo.y; vb.z = hi.x; vb.w = hi.y;
                    Oa = MFMA32(__builtin_bit_cast(bf16x8, xk), __builtin_bit_cast(bf16x8, vb), Oa);
                }
                auto qs_term = [&](const f32x16& St, int dt) {
#pragma unroll
                    for (int s2 = 0; s2 < 2; ++s2) {
                        uint4 sk;
                        sk.x = pack2(St[8 * s2], St[8 * s2 + 1]); sk.y = pack2(St[8 * s2 + 2], St[8 * s2 + 3]); sk.z = pack2(St[8 * s2 + 4], St[8 * s2 + 5]); sk.w = pack2(St[8 * s2 + 6], St[8 * s2 + 7]);
                        const char* qa = bufp + HG_QD_OFF + l31 * HG_ROW + (32 * dt + 16 * s2 + 4 * h2) * 2;
                        const uint2 lo = *(const uint2*)qa, hi = *(const uint2*)(qa + 16);
                        uint4 qb; qb.x = lo.x; qb.y = lo.y; qb.z = hi.x; qb.w = hi.y;
                        Oa = MFMA32(__builtin_bit_cast(bf16x8, qb), __builtin_bit_cast(bf16x8, sk), Oa);
                    }
                };
                __builtin_amdgcn_sched_barrier(0);
                qs_term(S0, 0); qs_term(S1, 1);
                __builtin_amdgcn_sched_barrier(0);
                qs_term(S2, 2); qs_term(S3, 3);
                __builtin_amdgcn_sched_barrier(0);
                {
                    bf16_t* orow = OR + (size_t)(b * SEQ + cc * 32 + 4 * h2) * 1024 + h * 128 + jrow;
#pragma unroll
                    for (int r = 0; r < 16; ++r) orow[(size_t)((r & 3) + 8 * (r >> 2)) * 1024] = f2bf(Oa[r]);
                }
                auto s_update = [&](f32x16& St, int dt) {
#pragma unroll
                    for (int rq = 0; rq < 4; ++rq) {
                        const f32x4 dc = *(const f32x4*)(dec + 32 * dt + 8 * rq + 4 * h2);
                        St[4 * rq] *= dc[0]; St[4 * rq + 1] *= dc[1]; St[4 * rq + 2] *= dc[2]; St[4 * rq + 3] *= dc[3];
                    }
#pragma unroll
                    for (int s2 = 0; s2 < 2; ++s2) {
                        const bf16x8 ka = *(const bf16x8*)(bufp + HG_K2T_OFF + (32 * dt + l31) * HG_TROW + (16 * s2 + 8 * h2) * 2);
                        const bf16x8 vb = *(const bf16x8*)(bufp + HG_VT_OFF + jrow * HG_TROW + (16 * s2 + 8 * h2) * 2);
                        St = MFMA32(ka, vb, St);
                    }
                };
                __builtin_amdgcn_sched_barrier(0);
                s_update(S0, 0); s_update(S1, 1);
                __builtin_amdgcn_sched_barrier(0);
                s_update(S2, 2); s_update(S3, 3);
                __builtin_amdgcn_sched_barrier(0);
            }
            __syncthreads();
        }
    }
}

__device__ __forceinline__ void phase_hgrn_post(const Params& p, const Ctx& cx) {
    const int lane = cx.lane;
    const bf16_t* OR = (const bf16_t*)(p.ws + OFF_HA);
    const bf16_t* Gt = (const bf16_t*)(p.ws + OFF_G);
    bf16_t* OA = (bf16_t*)(p.ws + OFF_QH);
    const int col = lane * 16;
    float gn[16];
#pragma unroll
    for (int i = 0; i < 16; ++i) gn[i] = p.hgrn_out_gain[(col & 127) + i];
    for (int row = cx.vbid * NWAVE + cx.wid; row < NTOK; row += cx.G * NWAVE) {
        const uint4 a0 = *(const uint4*)(OR + (size_t)row * 1024 + col), a1 = *(const uint4*)(OR + (size_t)row * 1024 + col + 8);
        const uint4 g0 = *(const uint4*)(Gt + (size_t)row * 1024 + col), g1 = *(const uint4*)(Gt + (size_t)row * 1024 + col + 8);
        const unsigned aw[8] = {a0.x, a0.y, a0.z, a0.w, a1.x, a1.y, a1.z, a1.w};
        const unsigned gw[8] = {g0.x, g0.y, g0.z, g0.w, g1.x, g1.y, g1.z, g1.w};
        float o[16];
        float ss = 0.f;
#pragma unroll
        for (int i = 0; i < 8; ++i) { o[2 * i] = bf2f((unsigned short)(aw[i] & 0xffff)); o[2 * i + 1] = bf2f((unsigned short)(aw[i] >> 16)); ss += o[2 * i] * o[2 * i] + o[2 * i + 1] * o[2 * i + 1]; }
        ss += __shfl_xor(ss, 1); ss += __shfl_xor(ss, 2); ss += __shfl_xor(ss, 4);
        const float r = rsqrtf(ss * (1.f / 128.f) + EPS);
        unsigned w[8];
#pragma unroll
        for (int i = 0; i < 8; ++i)
            w[i] = pack2(o[2 * i] * r * gn[2 * i] * bf2f((unsigned short)(gw[i] & 0xffff)), o[2 * i + 1] * r * gn[2 * i + 1] * bf2f((unsigned short)(gw[i] >> 16)));
        uint4 o0, o1; o0.x = w[0]; o0.y = w[1]; o0.z = w[2]; o0.w = w[3]; o1.x = w[4]; o1.y = w[5]; o1.z = w[6]; o1.w = w[7];
        *(uint4*)(OA + (size_t)row * 1024 + col) = o0;
        *(uint4*)(OA + (size_t)row * 1024 + col + 8) = o1;
    }
}


#define XB_TMO      128
#define XB_XCNT(j)  (256  + 64 * (j))
#define XB_XSUB(j)  (1280 + 64 * (j))
#define XB_XGEN(j)  (2304 + 64 * (j))
#define XB_TOP      3328
#define XB_TOPGEN   3392
#define XCD_BAR_WORDS 3456
#define XB_SPIN_CAP (1u << 20)
#define LAS __attribute__((address_space(3)))
__device__ __forceinline__ unsigned xb_ld(unsigned* p)              { return __hip_atomic_load(p, __ATOMIC_RELAXED, __HIP_MEMORY_SCOPE_AGENT); }
__device__ __forceinline__ unsigned xb_add(unsigned* p, unsigned v) { return __hip_atomic_fetch_add(p, v, __ATOMIC_RELAXED, __HIP_MEMORY_SCOPE_AGENT); }
__device__ __forceinline__ unsigned xb_xcc_id() { return (unsigned)__builtin_amdgcn_s_getreg((3 << 11) | 20) & 0xFu; }
#define XB_SPIN(cond, bar) do { unsigned _sp = 0; while (cond) { __builtin_amdgcn_s_sleep(1); \
    if ((++_sp & 255u) == 0u) { if (xb_ld(&(bar)[XB_TMO])) break; if (_sp > XB_SPIN_CAP) { atomicAdd(&(bar)[XB_TMO], 1u); break; } } } } while (0)
struct XcdBarrier { unsigned* bar; unsigned x; volatile unsigned* st; };
__device__ __forceinline__ XcdBarrier xcd_barrier_post(unsigned* bar, volatile unsigned* st) {
    XcdBarrier b; b.bar = bar; b.x = xb_xcc_id(); b.st = st;
    if (threadIdx.x == 0) (void)xb_add(&bar[XB_XCNT(b.x)], 1u);
    return b;
}
__device__ __forceinline__ void xcd_barrier_complete(unsigned* bar, unsigned x, unsigned& nloc, unsigned& nx) {
    const unsigned G = gridDim.x * gridDim.y * gridDim.z;
    unsigned sum, cnt, mine, sp = 0u;
    for (;;) {
        sum = 0u; cnt = 0u; mine = 0u;
#pragma unroll
        for (unsigned j = 0; j < 16; ++j) { const unsigned c = xb_ld(&bar[XB_XCNT(j)]); sum += c; cnt += (c > 0u) ? 1u : 0u; mine = (j == x) ? c : mine; }
        if (sum == G) break;
        __builtin_amdgcn_s_sleep(1);
        if ((++sp & 255u) == 0u) { if (xb_ld(&bar[XB_TMO])) break; if (sp > XB_SPIN_CAP) { atomicAdd(&bar[XB_TMO], 1u); break; } }
    }
    nloc = mine > 0u ? mine : 1u; nx = cnt > 0u ? cnt : 1u;
}
__device__ __forceinline__ void xcd_barrier(const XcdBarrier& b) {
    asm volatile("s_waitcnt vmcnt(0)" ::: "memory");
    __syncthreads();
    if (threadIdx.x == 0) {
        unsigned* bar = b.bar;
        __builtin_amdgcn_s_waitcnt(0);
        unsigned nloc = b.st[0], nx = b.st[1];
        if (nloc == 0u) { xcd_barrier_complete(bar, b.x, nloc, nx); b.st[0] = nloc; b.st[1] = nx; }
        const unsigned old = xb_add(&bar[XB_XSUB(b.x)], 1u);
        const unsigned gen = old / nloc;
        if (old + 1u == (gen + 1u) * nloc) {
            __builtin_amdgcn_fence(__ATOMIC_RELEASE, "agent");
            asm volatile("s_waitcnt vmcnt(0)" ::: "memory");
            const unsigned og = xb_add(&bar[XB_TOP], 1u);
            const unsigned tg = og / nx;
            if (og + 1u == (tg + 1u) * nx) xb_add(&bar[XB_TOPGEN], 1u);
            else XB_SPIN(xb_ld(&bar[XB_TOPGEN]) == tg, bar);
            __builtin_amdgcn_fence(__ATOMIC_ACQUIRE, "agent");
            xb_add(&bar[XB_XGEN(b.x)], 1u);
            asm volatile("s_waitcnt vmcnt(0)" ::: "memory");
        } else {
            XB_SPIN(xb_ld(&bar[XB_XGEN(b.x)]) == gen, bar);
            __builtin_amdgcn_fence(__ATOMIC_ACQUIRE, "agent");
            asm volatile("s_waitcnt vmcnt(0)" ::: "memory");
        }
    }
    __syncthreads();
}

template <int PH>
__device__ __forceinline__ void run_phase(const Params& p, const Ctx& cx, char* lds) {
    if constexpr (PH == 0) phase0(p, cx, lds);
    else if constexpr (PH == 1) rows_phase<false, true, false>(p, cx, lds, p.x, nullptr, 0, 0, 0, 0);
    else if constexpr (PH == 2) phase_nsa_inproj(p, cx, lds);
    else if constexpr (PH == 3) {
        phase_cmp1(p, cx, lds);
        const int w = cx.vbid >= 64 ? cx.vbid - 64 : -1, nw = cx.G - 64;
        transpose_range(p, lds, cx.tid, w, nw, TC2, TC4);
        transpose_range(p, lds, cx.tid, w, nw, TC5, TC_UP1);
        transpose_range(p, lds, cx.tid, w, nw, TC6, TC_DN1);
    }
    else if constexpr (PH == 4) phase_cmp2(p, cx);
    else if constexpr (PH == 5) phase_attn(p, cx, lds);
    else if constexpr (PH == 6) phase_outproj8(p, cx, lds, (const bf16_t*)(p.ws + OFF_HA), (const bf16_t*)(p.ws + OFF_W_NSA_OUT), p.x, 0);
    else if constexpr (PH == 7) rows_router_phase(p, cx, lds, p.out, 1, 0);
    else if constexpr (PH == 8) phase_moe_up8(p, cx, lds, 0);
    else if constexpr (PH == 9) phase_moe_down8(p, cx, lds, 0);
    else if constexpr (PH == 10) { float* xo = p.out; asm volatile("" : "+s"(xo)); rows_phase<true, true, false>(p, cx, lds, xo, xo, 1, 2, 0, 0); }
    else if constexpr (PH == 11) phase_hgrn_inproj8(p, cx, lds);
    else if constexpr (PH == 12) {
        phase_hgrn_rec(p, cx, lds);
        const int w = (int)blockIdx.x >= 128 ? (int)blockIdx.x - 128 : -1, nw = cx.G - 128;
        transpose_range(p, lds, cx.tid, w, nw, TC_UP1, TC6);
        transpose_range(p, lds, cx.tid, w, nw, TC_DN1, TC_END);
    }
    else if constexpr (PH == 13) phase_hgrn_post(p, cx);
    else if constexpr (PH == 14) phase_outproj8(p, cx, lds, (const bf16_t*)(p.ws + OFF_QH), (const bf16_t*)(p.ws + OFF_W_HG_OUT), p.out, 2);
    else if constexpr (PH == 15) rows_router_phase(p, cx, lds, p.out, 3, 1);
    else if constexpr (PH == 16) phase_moe_up8(p, cx, lds, 1);
    else if constexpr (PH == 17) phase_moe_down8(p, cx, lds, 1);
    else if constexpr (PH == 18) { float* xo = p.out; asm volatile("" : "+s"(xo)); rows_phase<true, false, false>(p, cx, lds, xo, xo, 3, 0, 0, 1); }
}

__device__ __forceinline__ Ctx make_ctx() {
    Ctx cx;
    cx.G = gridDim.x; cx.tid = threadIdx.x; cx.wid = threadIdx.x >> 6; cx.lane = threadIdx.x & 63;
    cx.vbid = (cx.G % 8 == 0) ? (blockIdx.x % 8) * (cx.G / 8) + blockIdx.x / 8 : blockIdx.x;
    return cx;
}

#if MULTI_LAUNCH
template <int PH>
__global__ void __launch_bounds__(NTHR, 2) phase_kernel(Params p) {
    extern __shared__ __attribute__((aligned(16))) char lds[];
    const Ctx cx = make_ctx();
    run_phase<PH>(p, cx, lds);
}
template <int PH>
static void launch_phases(const Params& p, int grid, hipStream_t stream) {
    (void)hipFuncSetAttribute((const void*)phase_kernel<PH>, hipFuncAttributeMaxDynamicSharedMemorySize, LDS_BYTES);
    hipLaunchKernelGGL(phase_kernel<PH>, dim3(grid), dim3(NTHR), LDS_BYTES, stream, p);
    if constexpr (PH + 1 < NPHASE) launch_phases<PH + 1>(p, grid, stream);
}
#else
template <int PH>
__device__ __forceinline__ void run_from(const Params& p, const Ctx& cx, char* lds, cg::grid_group& grid, const XcdBarrier& xb) {
    {
        int t_ = threadIdx.x, b_ = blockIdx.x;
        asm volatile("" : "+v"(t_), "+s"(b_));
        Ctx c2;
        c2.G = gridDim.x; c2.tid = t_; c2.wid = t_ >> 6; c2.lane = t_ & 63;
        c2.vbid = (c2.G % 8 == 0) ? (b_ % 8) * (c2.G / 8) + b_ / 8 : b_;
        run_phase<PH>(p, c2, lds);
#ifdef PROBE_MASK
        if constexpr ((PROBE_MASK >> PH) & 1) { xcd_barrier(xb); run_phase<PH>(p, c2, lds); }
#endif
    }
    if constexpr (PH + 1 < NPHASE) {
        if constexpr (PH == 0) grid.sync();
        else xcd_barrier(xb);
        run_from<PH + 1>(p, cx, lds, grid, xb);
    }
}
__global__ void __launch_bounds__(NTHR, 2) mega_kernel(Params p) {
    extern __shared__ __attribute__((aligned(16))) char lds[];
    cg::grid_group grid = cg::this_grid();
    const Ctx cx = make_ctx();
    volatile unsigned* st = (volatile unsigned*)(lds + LDS_BYTES - 16);
    if (threadIdx.x == 0) { st[0] = 0u; st[1] = 0u; }
    __syncthreads();
    const XcdBarrier xb = xcd_barrier_post((unsigned*)(p.ws + OFF_BAR), st);
    run_from<0>(p, cx, lds, grid, xb);
}
#endif

extern "C" void kernel_launch(void* const* d_in, const int* in_sizes, int n_in, void* d_out, int out_size, void* d_ws, size_t ws_size,
                              hipStream_t stream) {
    static int grid = 0;
    if (!grid) {
        int dev = 0, cus = 0, per_cu = 0;
        (void)hipGetDevice(&dev);
        (void)hipDeviceGetAttribute(&cus, hipDeviceAttributeMultiprocessorCount, dev);
#if MULTI_LAUNCH
        per_cu = 1;
#else
        (void)hipFuncSetAttribute((const void*)mega_kernel, hipFuncAttributeMaxDynamicSharedMemorySize, LDS_BYTES);
        (void)hipOccupancyMaxActiveBlocksPerMultiprocessor(&per_cu, mega_kernel, NTHR, LDS_BYTES);
        if (per_cu > 1) per_cu = 1;
        if (per_cu < 1) { fprintf(stderr, "kernel_launch: occupancy query says 0 blocks per CU (LDS %d B)\n", LDS_BYTES); per_cu = 1; }
#endif
        if (cus <= 0) cus = 256;
        grid = cus * per_cu;
        if (ws_size < WS_NEED) fprintf(stderr, "kernel_launch: workspace too small: %zu < %zu\n", ws_size, (size_t)WS_NEED);
    }
    Params p{};
    p.x = (const float*)d_in[0]; p.c = (const float*)d_in[1]; p.ada_w = (const float*)d_in[2]; p.ada_b = (const float*)d_in[3];
    p.norm_g = (const float*)d_in[4]; p.rel_bias = (const float*)d_in[5]; p.nsa_w_in = (const float*)d_in[6]; p.nsa_q_gain = (const float*)d_in[7];
    p.nsa_k_gain = (const float*)d_in[8]; p.nsa_cmp_pe = (const float*)d_in[9]; p.nsa_cmp_w1 = (const float*)d_in[10]; p.nsa_cmp_w2 = (const float*)d_in[11];
    p.nsa_w_out = (const float*)d_in[12]; p.hgrn_w_in = (const float*)d_in[13]; p.hgrn_lb = (const float*)d_in[14]; p.hgrn_out_gain = (const float*)d_in[15];
    p.hgrn_w_out = (const float*)d_in[16]; p.moe_rg = (const float*)d_in[17]; p.moe_re = (const float*)d_in[18]; p.moe_w1 = (const float*)d_in[19];
    p.moe_w3 = (const float*)d_in[20]; p.moe_w2 = (const float*)d_in[21];
    p.out = (float*)d_out; p.ws = (char*)d_ws;
#if MULTI_LAUNCH
    launch_phases<0>(p, grid, stream);
#else
    p.p_begin = 0; p.p_end = NPHASE;
    (void)hipMemsetAsync((char*)d_ws + OFF_BAR, 0, XCD_BAR_WORDS * 4, stream);
    void* args[] = {&p};
    hipError_t e = hipLaunchCooperativeKernel((void*)mega_kernel, dim3(grid), dim3(NTHR), args, LDS_BYTES, stream);
    if (e != hipSuccess) fprintf(stderr, "cooperative launch failed: %s (grid %d)\n", hipGetErrorString(e), grid);
#endif
}
```

```cpp
#include <hip/hip_runtime.h>
#include <hip/hip_cooperative_groups.h>
#include <cstdio>
#include <cstdint>
namespace cg = cooperative_groups;

#ifndef MULTI_LAUNCH
#define MULTI_LAUNCH 0
#endif

typedef unsigned short bf16_t;
typedef short bf16x8 __attribute__((ext_vector_type(8)));
typedef float f32x4 __attribute__((ext_vector_type(4)));
typedef float f32x16 __attribute__((ext_vector_type(16)));

constexpr int NTOK = 32768, DM = 1024, SEQ = 2048, NBATCH = 16;
constexpr int NSA_IN = 2608, NSA_IN_PAD = 2816;
constexpr float EPS = 1e-6f;
constexpr size_t MiB = 1ull << 20;

constexpr size_t OFF_CNT = 0;
constexpr size_t OFF_MOD = 4096;
constexpr size_t OFF_LB = OFF_MOD + 786432;
constexpr size_t OFF_PEB = OFF_LB + 4096;
constexpr size_t OFF_BAR = 921600;
constexpr size_t OFF_W_NSA_IN = 1 * MiB;
constexpr size_t OFF_W_NSA_OUT = OFF_W_NSA_IN + 2816ull * 1024 * 2;
constexpr size_t OFF_W_HG_IN = OFF_W_NSA_OUT + 1024ull * 1024 * 2;
constexpr size_t OFF_W_HG_OUT = OFF_W_HG_IN + 4096ull * 1024 * 2;
constexpr size_t OFF_W_CMP1 = OFF_W_HG_OUT + 1024ull * 1024 * 2;
constexpr size_t OFF_W_UP = OFF_W_CMP1 + 2ull * 128 * 2048 * 2;
constexpr size_t OFF_W_DN = OFF_W_UP + 32ull * 1024 * 1024 * 2;
constexpr size_t OFF_W_END = OFF_W_DN + 32ull * 1024 * 512 * 2;
constexpr size_t OFF_HA = 116 * MiB;
static_assert(OFF_W_END <= OFF_HA, "weights overflow");
constexpr size_t OFF_SCR = 180 * MiB;
constexpr size_t OFF_Q = OFF_SCR;
constexpr size_t OFF_KCRAW = OFF_Q + 64 * MiB;
constexpr size_t OFF_VCRAW = OFF_KCRAW + 17 * MiB;
constexpr size_t OFF_KS = OFF_VCRAW + 17 * MiB;
constexpr size_t OFF_VS = OFF_KS + 16 * MiB;
constexpr size_t OFF_KW = OFF_VS + 16 * MiB;
constexpr size_t OFF_VW = OFF_KW + 16 * MiB;
constexpr size_t OFF_GATES = OFF_VW + 16 * MiB;
constexpr size_t OFF_T1 = OFF_GATES + 6 * MiB;
constexpr size_t OFF_KC = OFF_T1 + 4 * MiB;
constexpr size_t OFF_VC = OFF_KC + 1 * MiB;
constexpr size_t OFF_H1 = OFF_SCR;
constexpr size_t OFF_Y = OFF_H1 + 64 * MiB;
constexpr size_t OFF_LTOK = OFF_Y + 128 * MiB;
constexpr size_t OFF_LW = OFF_LTOK + 2 * MiB;
constexpr size_t OFF_TSLOT = OFF_LW + 2 * MiB;
constexpr size_t OFF_QH = OFF_SCR;
constexpr size_t OFF_LF = OFF_QH + 64 * MiB;
constexpr size_t OFF_V = OFF_LF + 128 * MiB;
constexpr size_t OFF_G = OFF_V + 64 * MiB;
constexpr size_t WS_NEED = OFF_G + 64 * MiB;
static_assert(WS_NEED <= 512 * MiB, "ws overflow");

constexpr int NTHR = 512, NWAVE = 8;
constexpr int GEMM_STAGE = 49152, GEMM_NSTAGE = 3;
constexpr int LDS_TAB_OFF = GEMM_STAGE * GEMM_NSTAGE;
constexpr int LDS_BYTES = LDS_TAB_OFF + 256 + 16;
constexpr int NPHASE = 19;

struct Params {
    const float *x, *c, *ada_w, *ada_b, *norm_g, *rel_bias, *nsa_w_in, *nsa_q_gain, *nsa_k_gain, *nsa_cmp_pe, *nsa_cmp_w1,
        *nsa_cmp_w2, *nsa_w_out, *hgrn_w_in, *hgrn_lb, *hgrn_out_gain, *hgrn_w_out, *moe_rg, *moe_re, *moe_w1, *moe_w3, *moe_w2;
    float* out;
    char* ws;
    int p_begin, p_end;
};

__device__ __forceinline__ float bf2f(unsigned short h) { return __uint_as_float((unsigned)h << 16); }
__device__ __forceinline__ unsigned short f2bf(float f) {
    unsigned u = __float_as_uint(f);
    u += 0x7fffu + ((u >> 16) & 1u);
    return (unsigned short)(u >> 16);
}
typedef __bf16 bf2_t __attribute__((ext_vector_type(2)));
typedef float f2_t __attribute__((ext_vector_type(2)));
__device__ __forceinline__ unsigned pack2(float a, float b) {
    f2_t v = {a, b};
    return __builtin_bit_cast(unsigned, __builtin_convertvector(v, bf2_t));
}
typedef _Float16 h2_t __attribute__((ext_vector_type(2)));
__device__ __forceinline__ unsigned packh2(float a, float b) { f2_t v = {a, b}; return __builtin_bit_cast(unsigned, __builtin_convertvector(v, h2_t)); }
__device__ __forceinline__ f2_t unpackh2(unsigned u) { return __builtin_convertvector(__builtin_bit_cast(h2_t, u), f2_t); }
__device__ __forceinline__ float wave_sum(float v) {
#pragma unroll
    for (int o = 32; o; o >>= 1) v += __shfl_xor(v, o);
    return v;
}
__device__ __forceinline__ float wave_max(float v) {
#pragma unroll
    for (int o = 32; o; o >>= 1) v = fmaxf(v, __shfl_xor(v, o));
    return v;
}
__device__ __forceinline__ float silu_f(float x) { return x * __builtin_amdgcn_rcpf(1.f + __builtin_amdgcn_exp2f(-1.4426950408889634f * x)); }
__device__ __forceinline__ float sigmoid_f(float x) { return __builtin_amdgcn_rcpf(1.f + __builtin_amdgcn_exp2f(-1.4426950408889634f * x)); }
__device__ __forceinline__ void glds16(const void* g, void* l) {
    __builtin_amdgcn_global_load_lds((const unsigned*)g, (unsigned*)l, 16, 0, 0);
}
__device__ __forceinline__ int t5_bucket(int n) {
    if (n < 16) return n;
    int b = 16;
    b += (n >= 21); b += (n >= 27); b += (n >= 35); b += (n >= 46); b += (n >= 59); b += (n >= 77); b += (n >= 99); b += (n >= 128);
    b += (n >= 166); b += (n >= 216); b += (n >= 280); b += (n >= 363); b += (n >= 470); b += (n >= 609); b += (n >= 790);
    return b;
}

struct Ctx {
    int G, vbid, tid, wid, lane;
};

constexpr int P0_MOD_ITEMS = 192;
constexpr int TS0 = 88 * 16, TS1 = 32 * 16, TS2 = 128 * 16, TS3 = 32 * 16, TS4 = 2 * 4 * 32, TS5 = 32 * 32 * 16, TS6 = 32 * 32 * 8;
constexpr int TC0 = 0, TC1 = TC0 + TS0, TC2 = TC1 + TS1, TC3 = TC2 + TS2, TC4 = TC3 + TS3, TC5 = TC4 + TS4, TC6 = TC5 + TS5, TC_END = TC6 + TS6;

struct TrJob { const float* src; int ld, c0, ncols_valid, k0; bf16_t* dst; int dstld; int perm; };
__device__ __forceinline__ int pcol(int n, int fq) { return (n >> 1) * 32 + fq * 8 + (n & 1) * 4; }
__device__ __forceinline__ void tr_load(const TrJob& j, float* tl, int htid) {
    const int k = htid >> 2, cc = (htid & 3) * 8;
    const float* s = j.src + (size_t)(j.k0 + k) * j.ld + j.c0 + cc;
    f32x4 a = {0.f, 0.f, 0.f, 0.f}, c = a;
    if (j.c0 + 32 <= j.ncols_valid) { a = *(const f32x4*)s; c = *(const f32x4*)(s + 4); }
    else {
#pragma unroll
        for (int i = 0; i < 4; ++i) { if (j.c0 + cc + i < j.ncols_valid) a[i] = s[i]; if (j.c0 + cc + 4 + i < j.ncols_valid) c[i] = s[4 + i]; }
    }
#pragma unroll
    for (int i = 0; i < 4; ++i) { tl[k * 33 + cc + i] = a[i]; tl[k * 33 + cc + 4 + i] = c[i]; }
}
__device__ __forceinline__ void tr_store(const TrJob& j, const float* tl, int htid) {
    const int nsrc = htid >> 3, kc = (htid & 7) * 8;
    const int n = nsrc;
    const int nd = j.perm ? (((nsrc >> 2) & 1) * 16 + (nsrc >> 3) * 4 + (nsrc & 3)) : nsrc;
    uint4 o;
    o.x = pack2(tl[(kc + 0) * 33 + n], tl[(kc + 1) * 33 + n]); o.y = pack2(tl[(kc + 2) * 33 + n], tl[(kc + 3) * 33 + n]);
    o.z = pack2(tl[(kc + 4) * 33 + n], tl[(kc + 5) * 33 + n]); o.w = pack2(tl[(kc + 6) * 33 + n], tl[(kc + 7) * 33 + n]);
    *(uint4*)(j.dst + (size_t)nd * j.dstld + kc) = o;
}
__device__ __forceinline__ TrJob tr_job(const Params& p, int tt) {
    TrJob j;
    if (tt < TC1) {
        const int nt = tt / 16, kt = tt % 16;
        j = {p.nsa_w_in, NSA_IN, nt * 32, NSA_IN, kt * 64, (bf16_t*)(p.ws + OFF_W_NSA_IN) + (size_t)nt * 32 * 1024 + kt * 64, 1024, 1};
    } else if (tt < TC2) {
        const int u = tt - TC1, nt = u / 16, kt = u % 16;
        j = {p.nsa_w_out, 1024, nt * 32, 1024, kt * 64, (bf16_t*)(p.ws + OFF_W_NSA_OUT) + (size_t)nt * 32 * 1024 + kt * 64, 1024, 1};
    } else if (tt < TC3) {
        const int u = tt - TC2, nt = u / 16, kt = u % 16;
        j = {p.hgrn_w_in, 4096, nt * 32, 4096, kt * 64, (bf16_t*)(p.ws + OFF_W_HG_IN) + (size_t)nt * 32 * 1024 + kt * 64, 1024, 1};
    } else if (tt < TC4) {
        const int u = tt - TC3, nt = u / 16, kt = u % 16;
        j = {p.hgrn_w_out, 1024, nt * 32, 1024, kt * 64, (bf16_t*)(p.ws + OFF_W_HG_OUT) + (size_t)nt * 32 * 1024 + kt * 64, 1024, 1};
    } else if (tt < TC5) {
        const int u = tt - TC4, kv = u / 128, r = u % 128, nt = r / 32, kt = r % 32;
        j = {p.nsa_cmp_w1 + (size_t)kv * 2048 * 64, 64, nt * 32, 64, kt * 64, (bf16_t*)(p.ws + OFF_W_CMP1) + ((size_t)kv * 128 + nt * 32) * 2048 + kt * 64, 2048, 0};
    } else if (tt < TC6) {
        const int u = tt - TC5, le = u / 512, r = u % 512, gr = r / 16, kt = r % 16;
        const int ct = gr >> 3, which = (gr >> 2) & 1, sub = gr & 3;
        const float* src = (which ? p.moe_w3 : p.moe_w1) + (size_t)le * 1024 * 512;
        j = {src, 512, (ct * 4 + sub) * 32, 512, kt * 64, (bf16_t*)(p.ws + OFF_W_UP) + ((size_t)le * 1024 + gr * 32) * 1024 + kt * 64, 1024, 1};
    } else {
        const int u = tt - TC6, le = u / 256, r = u % 256, nt = r / 8, kt = r % 8;
        j = {p.moe_w2 + (size_t)le * 512 * 1024, 1024, nt * 32, 1024, kt * 64, (bf16_t*)(p.ws + OFF_W_DN) + ((size_t)le * 1024 + nt * 32) * 512 + kt * 64, 512, 1};
    }
    return j;
}

__device__ __forceinline__ void transpose_range(const Params& p, char* lds, int tid, int worker, int nworkers, int lo, int hi) {
    if (worker < 0) return;
    constexpr int TPH = 4;
    const int half = tid >> 8, htid = tid & 255;
    float* tl = (float*)lds + half * (TPH * 64 * 33);
    for (int base = lo + worker * 2 * TPH; base < hi; base += nworkers * 2 * TPH) {
#pragma unroll
        for (int q = 0; q < TPH; ++q) {
            const int tt = base + half * TPH + q;
            if (tt < hi) { const TrJob j = tr_job(p, tt); tr_load(j, tl + q * (64 * 33), htid); }
        }
        __syncthreads();
#pragma unroll
        for (int q = 0; q < TPH; ++q) {
            const int tt = base + half * TPH + q;
            if (tt < hi) { const TrJob j = tr_job(p, tt); tr_store(j, tl + q * (64 * 33), htid); }
        }
        __syncthreads();
    }
}
constexpr int TC_UP1 = TC5 + 16 * 512, TC_DN1 = TC6 + 16 * 256;

__device__ __forceinline__ void phase0(const Params& p, const Ctx& cx, char* lds) {
    const int tid = cx.tid, wid = cx.wid, lane = cx.lane;
    for (int it = cx.vbid; it < P0_MOD_ITEMS; it += cx.G) {
        const int colbase = it * 64, ls = colbase / 3072, e0 = colbase % 3072;
        const float* W = p.ada_w + (size_t)ls * 1024 * 3072 + e0 + lane;
        float* cs = (float*)lds + wid * 1024;
        float* red = (float*)lds + 8192;
        float acc[16];
#pragma unroll
        for (int b = 0; b < 16; ++b) acc[b] = 0.f;
        for (int sub = 0; sub < 2; ++sub) {
            const int kb = wid * 128 + sub * 64;
#pragma unroll
            for (int b = 0; b < 16; ++b) cs[lane * 16 + b] = silu_f(p.c[b * 1024 + kb + lane]);
            __builtin_amdgcn_wave_barrier();
#pragma unroll 1
            for (int k16 = 0; k16 < 64; k16 += 16) {
                float wv[16];
#pragma unroll
                for (int u = 0; u < 16; ++u) wv[u] = W[(size_t)(kb + k16 + u) * 3072];
#pragma unroll
                for (int u = 0; u < 16; ++u) {
                    const float w = wv[u];
                    const f32x4* cv = (const f32x4*)(cs + (k16 + u) * 16);
#pragma unroll
                    for (int q = 0; q < 4; ++q) {
                        f32x4 c4 = cv[q];
                        acc[q * 4 + 0] += c4[0] * w; acc[q * 4 + 1] += c4[1] * w; acc[q * 4 + 2] += c4[2] * w; acc[q * 4 + 3] += c4[3] * w;
                    }
                }
            }
            __builtin_amdgcn_wave_barrier();
        }
#pragma unroll
        for (int b = 0; b < 16; ++b) red[(wid * 16 + b) * 64 + lane] = acc[b];
        __syncthreads();
        float* mod = (float*)(p.ws + OFF_MOD);
#pragma unroll
        for (int i = 0; i < 2; ++i) {
            const int o = tid + i * NTHR, b = o >> 6, e = o & 63;
            float sm = 0.f;
#pragma unroll
            for (int w = 0; w < 8; ++w) sm += red[(w * 16 + b) * 64 + e];
            mod[((size_t)ls * 16 + b) * 3072 + e0 + e] = sm + p.ada_b[ls * 3072 + e0 + e];
        }
        __syncthreads();
    }
    transpose_range(p, lds, tid, cx.vbid, cx.G, TC0, TC2);
    transpose_range(p, lds, tid, cx.vbid, cx.G, TC4, TC5);
    if (cx.vbid == cx.G - 1) {
        float* lb = (float*)(p.ws + OFF_LB);
        for (int i = tid; i < 1024; i += NTHR) lb[i] = sigmoid_f(p.hgrn_lb[1024 + i] - p.hgrn_lb[i]);
        if (tid < 128) {
            const int kv = tid >> 6, d = tid & 63;
            const float* pe = p.nsa_cmp_pe + kv * 2048;
            const float* w1 = p.nsa_cmp_w1 + (size_t)kv * 2048 * 64 + d;
            float sm = 0.f;
            for (int k = 0; k < 2048; ++k) sm += pe[k] * w1[(size_t)k * 64];
            ((float*)(p.ws + OFF_PEB))[tid] = sm;
        }
        if (tid < 32) ((int*)(p.ws + OFF_CNT))[tid] = 0;
    }
}

template <bool COMBINE, bool NORM, bool ROUTER>
__device__ __forceinline__ void rows_phase(const Params& p, const Ctx& cx, char* lds, const float* __restrict__ src, float* __restrict__ xdst,
                           int ls_comb, int ls_norm, int layer_router, int layer_comb) {
    static_assert(!ROUTER, "router rows use rows_router_phase");
    const int lane = cx.lane;
    const float* mod = (const float*)(p.ws + OFF_MOD);
    int my_off = 0;
    if (COMBINE) {
        const int* cnt = (const int*)(p.ws + OFF_CNT) + layer_comb * 16;
        int cv[15];
#pragma unroll
        for (int e = 0; e < 15; ++e) cv[e] = cnt[e];
#pragma unroll
        for (int e = 0; e < 15; ++e) my_off += (e < lane) ? cv[e] : 0;
    }
    const int rpw = (NTOK + cx.G * NWAVE - 1) / (cx.G * NWAVE);
    const int row_begin = (cx.vbid * NWAVE + cx.wid) * rpw, row_end = min(NTOK, row_begin + rpw);
    if (row_begin >= row_end) return;
    const bf16_t* Y = (const bf16_t*)(p.ws + OFF_Y);
    const int* tsl = (const int*)(p.ws + OFF_TSLOT);
    bf16_t* hA = (bf16_t*)(p.ws + OFF_HA);
    const float* gain = p.norm_g + ls_norm * 1024;
    auto yrow = [&](int sw) -> size_t { return (size_t)(__shfl(my_off, sw >> 16) + (sw & 0xffff)) * 1024; };
    f32x4 vn[4];
    uint2 yan[4], ycn[4];
    int t0n = 0, t1n = 0;
#pragma unroll
    for (int i = 0; i < 4; ++i) vn[i] = *(const f32x4*)(src + (size_t)row_begin * 1024 + (i * 64 + lane) * 4);
    if (COMBINE) {
        const size_t ra = yrow(tsl[row_begin * 2]), rc = yrow(tsl[row_begin * 2 + 1]);
#pragma unroll
        for (int i = 0; i < 4; ++i) { yan[i] = *(const uint2*)(Y + ra + (i * 64 + lane) * 4); ycn[i] = *(const uint2*)(Y + rc + (i * 64 + lane) * 4); }
        if (row_begin + 1 < row_end) { t0n = tsl[(row_begin + 1) * 2]; t1n = tsl[(row_begin + 1) * 2 + 1]; }
    }
    f32x4 gt[4], ca[4], cb[4];
    int bcur = -1;
    for (int row = row_begin; row < row_end; ++row) {
        const int b = row >> 11;
        if (b != bcur) {
            bcur = b;
#pragma unroll
            for (int i = 0; i < 4; ++i) {
                const int col = (i * 64 + lane) * 4;
                if (COMBINE) gt[i] = *(const f32x4*)(mod + ((size_t)ls_comb * 16 + b) * 3072 + 2048 + col);
                if (NORM) {
                    const float* shift = mod + ((size_t)ls_norm * 16 + b) * 3072;
                    const f32x4 g = *(const f32x4*)(gain + col), sc = *(const f32x4*)(shift + 1024 + col);
                    ca[i] = g * (sc + 1.f);
                    cb[i] = *(const f32x4*)(shift + col);
                }
            }
        }
        f32x4 v[4];
        uint2 ya[4], yc[4];
#pragma unroll
        for (int i = 0; i < 4; ++i) { v[i] = vn[i]; if (COMBINE) { ya[i] = yan[i]; yc[i] = ycn[i]; } }
        if (row + 1 < row_end) {
#pragma unroll
            for (int i = 0; i < 4; ++i) vn[i] = *(const f32x4*)(src + (size_t)(row + 1) * 1024 + (i * 64 + lane) * 4);
            if (COMBINE) {
                const size_t ra = yrow(t0n), rc = yrow(t1n);
#pragma unroll
                for (int i = 0; i < 4; ++i) { yan[i] = *(const uint2*)(Y + ra + (i * 64 + lane) * 4); ycn[i] = *(const uint2*)(Y + rc + (i * 64 + lane) * 4); }
                if (row + 2 < row_end) { t0n = tsl[(row + 2) * 2]; t1n = tsl[(row + 2) * 2 + 1]; }
            }
        }
        if (COMBINE) {
#pragma unroll
            for (int i = 0; i < 4; ++i) {
                const int col = (i * 64 + lane) * 4;
                v[i][0] += gt[i][0] * (bf2f(ya[i].x & 0xffff) + bf2f(yc[i].x & 0xffff));
                v[i][1] += gt[i][1] * (bf2f(ya[i].x >> 16) + bf2f(yc[i].x >> 16));
                v[i][2] += gt[i][2] * (bf2f(ya[i].y & 0xffff) + bf2f(yc[i].y & 0xffff));
                v[i][3] += gt[i][3] * (bf2f(ya[i].y >> 16) + bf2f(yc[i].y >> 16));
                *(f32x4*)(xdst + (size_t)row * 1024 + col) = v[i];
            }
        }
        if (NORM) {
            float ss = 0.f;
#pragma unroll
            for (int i = 0; i < 4; ++i) ss += v[i][0] * v[i][0] + v[i][1] * v[i][1] + v[i][2] * v[i][2] + v[i][3] * v[i][3];
            ss = wave_sum(ss);
            const float r = rsqrtf(ss * (1.f / 1024.f) + EPS);
#pragma unroll
            for (int i = 0; i < 4; ++i) {
                const int col = (i * 64 + lane) * 4;
                f32x4 h;
#pragma unroll
                for (int j = 0; j < 4; ++j) h[j] = v[i][j] * r * ca[i][j] + cb[i][j];
                uint2 o; o.x = pack2(h[0], h[1]); o.y = pack2(h[2], h[3]);
                *(uint2*)(hA + (size_t)row * 1024 + col) = o;
            }
        }
    }
}

__device__ __forceinline__ void rows_router_phase(const Params& p, const Ctx& cx, char* lds, const float* __restrict__ src, int ls_norm, int layer) {
    const int lane = cx.lane, tid = cx.tid;
    const int widu = __builtin_amdgcn_readfirstlane(cx.wid);
    const int wq = widu & 3, grp4 = widu >> 2;
    const float* mod = (const float*)(p.ws + OFF_MOD);
    const float* rg = p.moe_rg + (size_t)layer * 1024 * 4;
    const float* re = p.moe_re + (size_t)layer * 1024 * 16;
    float* logit_s = (float*)lds;
    float wr[16][5];
#pragma unroll
    for (int i = 0; i < 4; ++i)
#pragma unroll
        for (int j = 0; j < 4; ++j) {
            const int k = (i * 64 + lane) * 4 + j;
#pragma unroll
            for (int q = 0; q < 5; ++q) {
                const int o = 5 * wq + q;
                wr[i * 4 + j][q] = (o < 4) ? rg[k * 4 + o] : re[k * 16 + o - 4];
            }
            __builtin_amdgcn_sched_barrier(0);
        }
    const float* gain = p.norm_g + ls_norm * 1024;
    bf16_t* hA = (bf16_t*)(p.ws + OFF_HA);
    int* lcnt = (int*)(lds + 16384);
    if (tid < 32) lcnt[tid] = 0;
    int nstep = 0;
    for (int blk = cx.vbid; blk < NTOK / 32; blk += cx.G, ++nstep) {
        const int R0 = blk * 32, b = R0 >> 11;
        const float* shift = mod + ((size_t)ls_norm * 16 + b) * 3072;
        const float* scale = shift + 1024;
        f32x4 ca[4], cb[4];
#pragma unroll
        for (int i = 0; i < 4; ++i) {
            const int col = (i * 64 + lane) * 4;
            const f32x4 g = *(const f32x4*)(gain + col), sc = *(const f32x4*)(scale + col);
            ca[i] = g * (sc + 1.f);
            cb[i] = *(const f32x4*)(shift + col);
        }
        const float* srow = src + (size_t)(R0 + grp4 * 16) * 1024 + lane * 4;
        f32x4 vnA[4], vnB[4];
#pragma unroll
        for (int i = 0; i < 4; ++i) { vnA[i] = *(const f32x4*)(srow + i * 256); vnB[i] = *(const f32x4*)(srow + 1024 + i * 256); }
#pragma unroll 1
        for (int r = 0; r < 16; r += 2) {
            const int rlA = grp4 * 16 + r;
            f32x4 vA[4], vB[4];
#pragma unroll
            for (int i = 0; i < 4; ++i) { vA[i] = vnA[i]; vB[i] = vnB[i]; }
            if (r < 14) {
#pragma unroll
                for (int i = 0; i < 4; ++i) { vnA[i] = *(const f32x4*)(srow + (size_t)(r + 2) * 1024 + i * 256); vnB[i] = *(const f32x4*)(srow + (size_t)(r + 3) * 1024 + i * 256); }
            }
            float ssA = 0.f, ssB = 0.f;
#pragma unroll
            for (int i = 0; i < 4; ++i) {
                ssA += vA[i][0] * vA[i][0] + vA[i][1] * vA[i][1] + vA[i][2] * vA[i][2] + vA[i][3] * vA[i][3];
                ssB += vB[i][0] * vB[i][0] + vB[i][1] * vB[i][1] + vB[i][2] * vB[i][2] + vB[i][3] * vB[i][3];
            }
#pragma unroll
            for (int o = 32; o; o >>= 1) { ssA += __shfl_xor(ssA, o); ssB += __shfl_xor(ssB, o); }
            const float rrA = rsqrtf(ssA * (1.f / 1024.f) + EPS), rrB = rsqrtf(ssB * (1.f / 1024.f) + EPS);
            float accA[5] = {0.f, 0.f, 0.f, 0.f, 0.f}, accB[5] = {0.f, 0.f, 0.f, 0.f, 0.f};
#pragma unroll
            for (int i = 0; i < 4; ++i) {
                const int col = (i * 64 + lane) * 4;
                f32x4 hA_, hB_;
#pragma unroll
                for (int j = 0; j < 4; ++j) {
                    hA_[j] = vA[i][j] * rrA * ca[i][j] + cb[i][j];
                    hB_[j] = vB[i][j] * rrB * ca[i][j] + cb[i][j];
#pragma unroll
                    for (int q = 0; q < 5; ++q) { accA[q] += hA_[j] * wr[i * 4 + j][q]; accB[q] += hB_[j] * wr[i * 4 + j][q]; }
                }
                if ((r & 3) == wq) { uint2 o; o.x = pack2(hA_[0], hA_[1]); o.y = pack2(hA_[2], hA_[3]); *(uint2*)(hA + (size_t)(R0 + rlA) * 1024 + col) = o; }
                if (((r + 1) & 3) == wq) { uint2 o; o.x = pack2(hB_[0], hB_[1]); o.y = pack2(hB_[2], hB_[3]); *(uint2*)(hA + (size_t)(R0 + rlA + 1) * 1024 + col) = o; }
            }
            {
                float v[16];
#pragma unroll
                for (int q = 0; q < 5; ++q) { v[q] = accA[q]; v[5 + q] = accB[q]; }
#pragma unroll
                for (int q = 10; q < 16; ++q) v[q] = 0.f;
#pragma unroll
                for (int t = 0; t < 8; ++t) { const bool up = lane & 32; const float send = up ? v[t] : v[t + 8], keep = up ? v[t + 8] : v[t]; v[t] = keep + __shfl_xor(send, 32); }
#pragma unroll
                for (int t = 0; t < 4; ++t) { const bool up = lane & 16; const float send = up ? v[t] : v[t + 4], keep = up ? v[t + 4] : v[t]; v[t] = keep + __shfl_xor(send, 16); }
#pragma unroll
                for (int t = 0; t < 2; ++t) { const bool up = lane & 8; const float send = up ? v[t] : v[t + 2], keep = up ? v[t + 2] : v[t]; v[t] = keep + __shfl_xor(send, 8); }
                { const bool up = lane & 4; const float send = up ? v[0] : v[1], keep = up ? v[1] : v[0]; v[0] = keep + __shfl_xor(send, 4); }
                v[0] += __shfl_xor(v[0], 2);
                v[0] += __shfl_xor(v[0], 1);
                const int idx = ((lane >> 5) & 1) * 8 + ((lane >> 4) & 1) * 4 + ((lane >> 3) & 1) * 2 + ((lane >> 2) & 1);
                if ((lane & 3) == 0 && idx < 10) {
                    const int rsel = idx >= 5, q = idx - 5 * rsel;
                    logit_s[(nstep * 32 + rlA + rsel) * 20 + 5 * wq + q] = v[0];
                }
            }
        }
    }
    __syncthreads();
    const int nrows = nstep * 32;
    int ea = 0, eb = 0, la = 0, lb_ = 0, row = 0; float wa = 0.f, wb = 0.f;
    if (tid < nrows) {
        row = (cx.vbid + (tid >> 5) * cx.G) * 32 + (tid & 31);
        const float* rl = logit_s + tid * 20;
        const float gm = fmaxf(fmaxf(rl[0], rl[1]), fmaxf(rl[2], rl[3]));
        const float gs = __expf(rl[0] - gm) + __expf(rl[1] - gm) + __expf(rl[2] - gm) + __expf(rl[3] - gm);
        int grp = 0; float best = rl[0];
        if (rl[1] > best) { best = rl[1]; grp = 1; }
        if (rl[2] > best) { best = rl[2]; grp = 2; }
        if (rl[3] > best) { best = rl[3]; grp = 3; }
        const float pg = __expf(best - gm) / gs;
        const f32x4 lsel = *(const f32x4*)(rl + 4 + 4 * grp);
        const float l0 = lsel[0], l1 = lsel[1], l2 = lsel[2], l3 = lsel[3];
        const float em = fmaxf(fmaxf(l0, l1), fmaxf(l2, l3));
        const float q0 = __expf(l0 - em), q1 = __expf(l1 - em), q2 = __expf(l2 - em), q3 = __expf(l3 - em);
        int i1 = 0; float b1 = q0;
        if (q1 > b1) { b1 = q1; i1 = 1; }
        if (q2 > b1) { b1 = q2; i1 = 2; }
        if (q3 > b1) { b1 = q3; i1 = 3; }
        int i2 = -1; float b2 = -1.f;
        if (i1 != 0 && q0 > b2) { b2 = q0; i2 = 0; }
        if (i1 != 1 && q1 > b2) { b2 = q1; i2 = 1; }
        if (i1 != 2 && q2 > b2) { b2 = q2; i2 = 2; }
        if (i1 != 3 && q3 > b2) { b2 = q3; i2 = 3; }
        const float inv = pg / (b1 + b2);
        ea = grp * 4 + i1; eb = grp * 4 + i2; wa = b1 * inv; wb = b2 * inv;
        la = atomicAdd(lcnt + ea, 1);
        lb_ = atomicAdd(lcnt + eb, 1);
    }
    __syncthreads();
    if (tid < 16) lcnt[16 + tid] = atomicAdd((int*)(p.ws + OFF_CNT) + layer * 16 + tid, lcnt[tid]);
    __syncthreads();
    if (tid < nrows) {
        int* ltok = (int*)(p.ws + OFF_LTOK);
        float* lw = (float*)(p.ws + OFF_LW);
        int* ts = (int*)(p.ws + OFF_TSLOT) + row * 2;
        const int pa = lcnt[16 + ea] + la, pb = lcnt[16 + eb] + lb_;
        ltok[(size_t)ea * NTOK + pa] = row; lw[(size_t)ea * NTOK + pa] = wa;
        ltok[(size_t)eb * NTOK + pb] = row; lw[(size_t)eb * NTOK + pb] = wb;
        ts[0] = (ea << 16) | pa; ts[1] = (eb << 16) | pb;
    }
    __syncthreads();
}

__device__ __forceinline__ int stage_col(int tid) { return ((tid & 7) ^ ((tid >> 3) & 7)) * 8; }

template <class Epi>
__device__ __forceinline__ void gemm_tile(const bf16_t* const (&ap)[4], const bf16_t* const (&bp)[2], int K, char* lds, const Ctx& cx, Epi&& epi) {
    const int tid = cx.tid, lane = cx.lane, wr = cx.wid >> 1, wc = cx.wid & 1, fr = lane & 15, fq = lane >> 4;
    f32x4 acc[4][4];
#pragma unroll
    for (int m = 0; m < 4; ++m)
#pragma unroll
        for (int n = 0; n < 4; ++n) acc[m][n] = (f32x4){0.f, 0.f, 0.f, 0.f};
    const int nt = K / 64;
    auto stage = [&](int t, int slot) {
        char* SA = lds + slot * GEMM_STAGE + tid * 16; char* SB = SA + 32768;
        const int ko = t * 64;
#pragma unroll
        for (int i = 0; i < 4; ++i) glds16(ap[i] + ko, SA + i * 8192);
#pragma unroll
        for (int i = 0; i < 2; ++i) glds16(bp[i] + ko, SB + i * 8192);
    };
    __syncthreads();
    stage(0, 0);
    if (nt > 1) stage(1, 1);
    const int x7 = fr & 7;
    const int aoff = (wr * 64 + fr) * 128, boff = 32768 + (wc * 64 + fr) * 128;
    int slot = 0;
    for (int kt = 0; kt < nt; ++kt) {
        if (kt + 1 < nt) asm volatile("s_waitcnt vmcnt(6)" ::: "memory");
        else asm volatile("s_waitcnt vmcnt(0)" ::: "memory");
        __builtin_amdgcn_s_barrier();
        if (kt + 2 < nt) stage(kt + 2, slot >= 1 ? slot - 1 : 2);
        const char* S = lds + slot * GEMM_STAGE;
#pragma unroll
        for (int ks = 0; ks < 2; ++ks) {
            const int pc = ((ks * 4 + fq) ^ x7) * 16;
            bf16x8 Af[4], Bf[4];
#pragma unroll
            for (int m = 0; m < 4; ++m) Af[m] = *(const bf16x8*)(S + aoff + m * 2048 + pc);
#pragma unroll
            for (int n = 0; n < 4; ++n) Bf[n] = *(const bf16x8*)(S + boff + n * 2048 + pc);
#pragma unroll
            for (int m = 0; m < 4; ++m)
#pragma unroll
                for (int n = 0; n < 4; ++n) acc[m][n] = __builtin_amdgcn_mfma_f32_16x16x32_bf16(Bf[n], Af[m], acc[m][n], 0, 0, 0);
        }
        slot = slot == 2 ? 0 : slot + 1;
    }
    epi(acc, wr, wc, fr, fq);
}

__device__ __forceinline__ int swz_g(int q) { return (0x1320 >> (4 * q)) & 3; }
__device__ __forceinline__ int stage_col2(int tid) { return ((tid & 3) ^ swz_g((tid >> 4) & 3)) * 8; }

template <int MODE = 0, class Epi>
__device__ __forceinline__ void gemm_tile2(const bf16_t* const (&ap)[2], const bf16_t* const (&bp)[2], int K, char* lds, const Ctx& cx, Epi&& epi) {
    const int tid = cx.tid, lane = cx.lane, wc = cx.wid & 3, fr = lane & 15, fq = lane >> 4;
    const int wr = __builtin_amdgcn_readfirstlane(cx.wid >> 2);
    f32x4 acc[8][4];
#pragma unroll
    for (int m = 0; m < 8; ++m)
#pragma unroll
        for (int n = 0; n < 4; ++n) acc[m][n] = (f32x4){0.f, 0.f, 0.f, 0.f};
    const int nt = K / 32;
    auto stage = [&](int t) {
        char* SA = lds + (t & 3) * 32768 + tid * 16; char* SB = SA + 16384;
        const int ko = t * 32;
        glds16(ap[0] + ko, SA); glds16(ap[1] + ko, SA + 8192);
        glds16(bp[0] + ko, SB); glds16(bp[1] + ko, SB + 8192);
    };
    __syncthreads();
    stage(0);
    if (nt > 1) stage(1);
    if (nt > 2) stage(2);
    const int pc = (fq ^ swz_g((fr >> 2) & 3)) * 16;
    const int aoff = (wr * 128 + fr) * 64 + pc, boff = 16384 + (wc * 64 + fr) * 64 + pc;
    bf16x8 Af[8], Bf[4];
    auto load_frags = [&](int kt) {
        const char* S = lds + (kt & 3) * 32768;
#pragma unroll
        for (int n = 0; n < 4; ++n) Bf[n] = *(const bf16x8*)(S + boff + n * 1024);
#pragma unroll
        for (int m = 0; m < 8; ++m) Af[m] = *(const bf16x8*)(S + aoff + m * 1024);
        asm volatile("s_waitcnt lgkmcnt(0)" ::: "memory");
    };
    auto mma = [&]() {
        __builtin_amdgcn_s_setprio(1);
#pragma unroll
        for (int m = 0; m < 8; ++m)
#pragma unroll
            for (int n = 0; n < 4; ++n) acc[m][n] = __builtin_amdgcn_mfma_f32_16x16x32_bf16(Bf[n], Af[m], acc[m][n], 0, 0, 0);
        __builtin_amdgcn_s_setprio(0);
    };
    if (nt > 2) asm volatile("s_waitcnt vmcnt(8)" ::: "memory");
    else if (nt == 2) asm volatile("s_waitcnt vmcnt(4)" ::: "memory");
    else asm volatile("s_waitcnt vmcnt(0)" ::: "memory");
    if (wr == 1) __builtin_amdgcn_s_barrier();
    for (int kt = 0; kt < nt; ++kt) {
        const int rem = nt - 1 - kt;
        if (rem >= 2) asm volatile("s_waitcnt vmcnt(8)" ::: "memory");
        else if (rem == 1) asm volatile("s_waitcnt vmcnt(4)" ::: "memory");
        else asm volatile("s_waitcnt vmcnt(0)" ::: "memory");
        __builtin_amdgcn_s_barrier();
        if (kt + 3 < nt) stage(kt + 3);
        load_frags(kt);
        if (rem >= 3) asm volatile("s_waitcnt vmcnt(8)" ::: "memory");
        else if (rem == 2) asm volatile("s_waitcnt vmcnt(4)" ::: "memory");
        else asm volatile("s_waitcnt vmcnt(0)" ::: "memory");
        __builtin_amdgcn_s_barrier();
        mma();
    }
    if (wr == 0) __builtin_amdgcn_s_barrier();
    if (MODE == 0) epi(acc, wr, wc, fr, fq);
    else {
#pragma unroll
        for (int m = 0; m < 8; ++m)
#pragma unroll
            for (int n = 0; n < 4; ++n) asm volatile("" :: "v"(acc[m][n]));
    }
}

template <class GetFn, class EpiFn>
__device__ __forceinline__ void gemm_stream2(int my_tiles, int K, char* lds, const Ctx& cx, GetFn&& get, EpiFn&& epi) {
    if (my_tiles <= 0) return;
    const int tid = cx.tid, lane = cx.lane, wc = cx.wid & 3, fr = lane & 15, fq = lane >> 4;
    const int wr = __builtin_amdgcn_readfirstlane(cx.wid >> 2);
    f32x4 acc[8][4];
#pragma unroll
    for (int m = 0; m < 8; ++m)
#pragma unroll
        for (int n = 0; n < 4; ++n) acc[m][n] = (f32x4){0.f, 0.f, 0.f, 0.f};
    const int nt = K / 32, S = my_tiles * nt;
    const bf16_t* sap[2]; const bf16_t* sbp[2];
    int sj = 0, skt = 0, sg = 0;
    get(0, sap, sbp);
    auto stage_next = [&]() {
        char* SA = lds + (sg & 3) * 32768 + tid * 16; char* SB = SA + 16384;
        const int ko = skt * 32;
        glds16(sap[0] + ko, SA); glds16(sap[1] + ko, SA + 8192);
        glds16(sbp[0] + ko, SB); glds16(sbp[1] + ko, SB + 8192);
        ++sg; ++skt;
        if (skt == nt) { skt = 0; ++sj; if (sj < my_tiles) get(sj, sap, sbp); }
    };
    __syncthreads();
    stage_next();
    if (S > 1) stage_next();
    if (S > 2) stage_next();
    const int pc = (fq ^ swz_g((fr >> 2) & 3)) * 16;
    const int aoff = (wr * 128 + fr) * 64 + pc, boff = 16384 + (wc * 64 + fr) * 64 + pc;
    bf16x8 Af[8], Bf[4];
    int g = 0;
    for (int cj = 0; cj < my_tiles; ++cj) {
        {
            const int rem0 = S - 1 - g;
            if (rem0 >= 2) asm volatile("s_waitcnt vmcnt(8)" ::: "memory");
            else if (rem0 == 1) asm volatile("s_waitcnt vmcnt(4)" ::: "memory");
            else asm volatile("s_waitcnt vmcnt(0)" ::: "memory");
        }
        if (wr == 1) __builtin_amdgcn_s_barrier();
        for (int kt = 0; kt < nt; ++kt, ++g) {
            const int rem = S - 1 - g;
            if (rem >= 2) asm volatile("s_waitcnt vmcnt(8)" ::: "memory");
            else if (rem == 1) asm volatile("s_waitcnt vmcnt(4)" ::: "memory");
            else asm volatile("s_waitcnt vmcnt(0)" ::: "memory");
            __builtin_amdgcn_s_barrier();
            if (g + 3 < S) stage_next();
            {
                const char* Sx = lds + (g & 3) * 32768;
#pragma unroll
                for (int n = 0; n < 4; ++n) Bf[n] = *(const bf16x8*)(Sx + boff + n * 1024);
#pragma unroll
                for (int m = 0; m < 8; ++m) Af[m] = *(const bf16x8*)(Sx + aoff + m * 1024);
                asm volatile("s_waitcnt lgkmcnt(0)" ::: "memory");
            }
            if (rem >= 3) asm volatile("s_waitcnt vmcnt(8)" ::: "memory");
            else if (rem == 2) asm volatile("s_waitcnt vmcnt(4)" ::: "memory");
            else asm volatile("s_waitcnt vmcnt(0)" ::: "memory");
            __builtin_amdgcn_s_barrier();
            __builtin_amdgcn_s_setprio(1);
#pragma unroll
            for (int m = 0; m < 8; ++m)
#pragma unroll
                for (int n = 0; n < 4; ++n) acc[m][n] = __builtin_amdgcn_mfma_f32_16x16x32_bf16(Bf[n], Af[m], acc[m][n], 0, 0, 0);
            __builtin_amdgcn_s_setprio(0);
        }
        if (wr == 0) __builtin_amdgcn_s_barrier();
        epi(cj, acc, wr, wc, fr, fq);
#pragma unroll
        for (int m = 0; m < 8; ++m)
#pragma unroll
            for (int n = 0; n < 4; ++n) acc[m][n] = (f32x4){0.f, 0.f, 0.f, 0.f};
    }
}

template <int MODE = 0, class EpiFactory>
__device__ __forceinline__ void gemm_phase_dense2(const bf16_t* A, int lda, const bf16_t* Bt, int K, int nrt, int nct, char* lds, const Ctx& cx, EpiFactory&& mk) {
    const int tid = cx.tid;
    const int ntiles = nrt * nct;
    const int sc = stage_col2(tid), sr = tid >> 2;
    const int my_tiles = cx.vbid < ntiles ? (ntiles - cx.vbid + cx.G - 1) / cx.G : 0;
    const int vb = cx.vbid, G = cx.G;
    gemm_stream2(my_tiles, K, lds, cx,
        [=](int j, const bf16_t* (&ap)[2], const bf16_t* (&bp)[2]) {
            const int tile = vb + j * G, rt = tile / nct, ct = tile % nct;
            ap[0] = A + (size_t)(rt * 256 + sr) * lda + sc; ap[1] = ap[0] + (size_t)128 * lda;
            bp[0] = Bt + (size_t)(ct * 256 + sr) * K + sc; bp[1] = bp[0] + (size_t)128 * K;
        },
        [=](int j, f32x4 (&acc)[8][4], int wr, int wc, int fr, int fq) {
            const int tile = vb + j * G, rt = tile / nct, ct = tile % nct;
            mk(rt * 256, ct * 256)(acc, wr, wc, fr, fq);
        });
}

__device__ __forceinline__ void phase_nsa_inproj(const Params& p, const Ctx& cx, char* lds) {
    const bf16_t* A = (const bf16_t*)(p.ws + OFF_HA);
    const bf16_t* Bt = (const bf16_t*)(p.ws + OFF_W_NSA_IN);
    char* ws = p.ws;
    const float* qg = p.nsa_q_gain;
    const float* kg = p.nsa_k_gain;
    gemm_phase_dense2(A, 1024, Bt, 1024, NTOK / 256, NSA_IN_PAD / 256, lds, cx, [=](int row0, int col0) {
        return [=](f32x4 (&acc)[8][4], int wr, int wc, int fr, int fq) {
            const int gc0 = col0 + wc * 64;
            if (gc0 >= NSA_IN) return;
            if (gc0 < 1024 || (gc0 >= 1536 && gc0 < 1792) || (gc0 >= 2048 && gc0 < 2304)) {
                const float* gain; float post; bf16_t* dstb; size_t rstride; size_t coff; bool tokmajor;
                if (gc0 < 1024) { gain = qg; post = 0.125f * 1.4426950408889634f; }
                else if (gc0 < 1792) { gain = kg + 64; post = 1.f; }
                else { gain = kg + 128; post = 1.f; }
#pragma unroll
                for (int m = 0; m < 8; ++m) {
                    __builtin_amdgcn_sched_barrier(0);
                    float ss = 0.f;
#pragma unroll
                    for (int n = 0; n < 4; ++n) ss += acc[m][n][0] * acc[m][n][0] + acc[m][n][1] * acc[m][n][1] + acc[m][n][2] * acc[m][n][2] + acc[m][n][3] * acc[m][n][3];
                    ss += __shfl_xor(ss, 16); ss += __shfl_xor(ss, 32);
                    const float r = rsqrtf(ss * (1.f / 64.f) + EPS) * post;
                    const int row = row0 + wr * 128 + m * 16 + fr;
                    bf16_t* dst;
                    if (gc0 < 1024) dst = (bf16_t*)(ws + OFF_Q) + (size_t)row * 1024 + gc0;
                    else {
                        const int g = ((gc0 - 1024) & 255) >> 6, b = row >> 11, t = row & 2047;
                        dst = (bf16_t*)(ws + (gc0 < 1792 ? OFF_KS : OFF_KW)) + ((size_t)(b * 4 + g) * 2048 + t) * 64;
                    }
#pragma unroll
                    for (int pp = 0; pp < 2; ++pp) {
                        const int c = pp * 32 + fq * 8;
                        const f32x4 ga = *(const f32x4*)(gain + c), gb = *(const f32x4*)(gain + c + 4);
                        const f32x4 a = acc[m][2 * pp], bb = acc[m][2 * pp + 1];
                        uint4 o; o.x = pack2(a[0] * r * ga[0], a[1] * r * ga[1]); o.y = pack2(a[2] * r * ga[2], a[3] * r * ga[3]);
                        o.z = pack2(bb[0] * r * gb[0], bb[1] * r * gb[1]); o.w = pack2(bb[2] * r * gb[2], bb[3] * r * gb[3]);
                        *(uint4*)(dst + c) = o;
                    }
                }
            } else if (gc0 < 2560) {
                const int seg = (gc0 - 1024) >> 8;
                const int g = ((gc0 - 1024) & 255) >> 6;
                if (seg < 2) {
                    const size_t off = seg == 0 ? OFF_KCRAW : OFF_VCRAW;
#pragma unroll
                    for (int m = 0; m < 8; ++m) {
                        __builtin_amdgcn_sched_barrier(0);
                    __builtin_amdgcn_sched_barrier(0);
                        const int row = row0 + wr * 128 + m * 16 + fr, b = row >> 11, t = row & 2047;
                        bf16_t* dst = (bf16_t*)(ws + off) + ((size_t)(b * 4 + g) * 2048 + t) * 64;
#pragma unroll
                        for (int pp = 0; pp < 2; ++pp) {
                            const f32x4 a = acc[m][2 * pp], bb = acc[m][2 * pp + 1];
                            uint4 o; o.x = pack2(a[0], a[1]); o.y = pack2(a[2], a[3]); o.z = pack2(bb[0], bb[1]); o.w = pack2(bb[2], bb[3]);
                            *(uint4*)(dst + pp * 32 + fq * 8) = o;
                        }
                    }
                } else {
                    const size_t off = seg == 3 ? OFF_VS : OFF_VW;
#pragma unroll
                    for (int m = 0; m < 8; ++m) {
                        __builtin_amdgcn_sched_barrier(0);
                    __builtin_amdgcn_sched_barrier(0);
                        const int row = row0 + wr * 128 + m * 16 + fr, b = row >> 11, t = row & 2047;
                        bf16_t* dst = (bf16_t*)(ws + off) + (size_t)(b * 4 + g) * 64 * 2048 + t;
#pragma unroll
                        for (int n = 0; n < 4; ++n)
#pragma unroll
                            for (int j = 0; j < 4; ++j) dst[(size_t)(pcol(n, fq) + j) * 2048] = f2bf(acc[m][n][j]);
                    }
                }
            } else {
#pragma unroll
                for (int m = 0; m < 8; ++m) {
                    __builtin_amdgcn_sched_barrier(0);
                    const int row = row0 + wr * 128 + m * 16 + fr;
                    float* dst = (float*)(ws + OFF_GATES) + (size_t)row * 48;
#pragma unroll
                    for (int n = 0; n < 4; ++n) {
                        const int c = pcol(n, fq);
                        f32x4 o;
#pragma unroll
                        for (int j = 0; j < 4; ++j) o[j] = sigmoid_f(acc[m][n][j]);
                        if (c < 48) *(f32x4*)(dst + c) = o;
                    }
                }
            }
        };
    });
}

__device__ __forceinline__ void phase_cmp1(const Params& p, const Ctx& cx, char* lds) {
    const int tid = cx.tid;
    const float* peb = (const float*)(p.ws + OFF_PEB);
    float* T1 = (float*)(p.ws + OFF_T1);
    const int sc = stage_col(tid), sr = tid >> 3;
    for (int tile = cx.vbid; tile < 64; tile += cx.G) {
        const int kv = tile >> 5, bg2 = tile & 31;
        const bf16_t* raw = (const bf16_t*)(p.ws + (kv ? OFF_VCRAW : OFF_KCRAW)) + (size_t)bg2 * 2 * 2048 * 64;
        const bf16_t* a0 = raw + (size_t)sr * 1024 + sc;
        const bf16_t* a2 = raw + (size_t)2048 * 64 + (size_t)sr * 1024 + sc;
        const bf16_t* b0 = (const bf16_t*)(p.ws + OFF_W_CMP1) + ((size_t)kv * 128 + sr) * 2048 + sc;
        const bf16_t* const ap[4] = {a0, a0 + (size_t)64 * 1024, a2, a2 + (size_t)64 * 1024};
        const bf16_t* const bp[2] = {b0, b0 + (size_t)64 * 2048};
        gemm_tile(ap, bp, 2048, lds, cx, [=](f32x4 (&acc)[4][4], int wr, int wc, int fr, int fq) {
            if (wc != 0) return;
#pragma unroll
            for (int m = 0; m < 4; ++m) {
                const int r = wr * 64 + m * 16 + fr;
                float* dst = T1 + ((size_t)kv * 8192 + (bg2 * 2 + (r >> 7)) * 128 + (r & 127)) * 64;
#pragma unroll
                for (int n = 0; n < 4; ++n) {
                    const int c = n * 16 + fq * 4;
                    f32x4 pb = *(const f32x4*)(peb + kv * 64 + c);
                    *(f32x4*)(dst + c) = acc[m][n] + pb;
                }
            }
        });
    }
}

__device__ __forceinline__ void phase_cmp2(const Params& p, const Ctx& cx) {
    const int lane = cx.lane;
    const float* T1 = (const float*)(p.ws + OFF_T1);
    for (int r = cx.vbid * NWAVE + cx.wid; r < 2 * 8192; r += cx.G * NWAVE) {
        const int kv = r >> 13, rr = r & 8191, n_ = rr & 127;
        const float s = silu_f(T1[(size_t)r * 64 + lane]);
        const float* w2 = p.nsa_cmp_w2 + kv * 4096 + lane;
        float o = 0.f;
#pragma unroll 8
        for (int j = 0; j < 64; ++j) o += __shfl(s, j) * w2[j * 64];
        if (kv == 0) {
            const float ss = wave_sum(o * o);
            o = o * rsqrtf(ss * (1.f / 64.f) + EPS) * p.nsa_k_gain[lane];
        }
        if (n_ == 127) o = 0.f;
        if (kv == 0) ((bf16_t*)(p.ws + OFF_KC))[(size_t)rr * 64 + lane] = f2bf(o);
        else ((bf16_t*)(p.ws + OFF_VC))[((size_t)(rr >> 7) * 64 + lane) * 128 + n_] = f2bf(o);
    }
}

constexpr int ATT_BUF = 17920, ATT_K_STRIDE = 144, ATT_V_OFF = 9216, ATT_V_STRIDE = 136, ATT_LUT_OFF = 2 * ATT_BUF, LUT_N = 2136, LUT_PAD = 80;
constexpr int ATT_SC_OFF = ATT_LUT_OFF + 4 * LUT_N * 4;
static_assert(ATT_SC_OFF + NWAVE * 8192 <= LDS_TAB_OFF, "attention LDS");
#define MFMA32(a, b, c) __builtin_amdgcn_mfma_f32_32x32x16_bf16((a), (b), (c), 0, 0, 0)
template <int V> struct IC { static constexpr int value = V; };

__device__ __forceinline__ void phase_attn(const Params& p, const Ctx& cx, char* lds) {
    const int tid = cx.tid, lane = cx.lane, wid = cx.wid;
    const int g = cx.vbid & 3;
    const int ql = lane & 7, head = (lane & 31) >> 3, h2 = lane >> 5, l31 = lane & 31;
    float* lut = (float*)(lds + ATT_LUT_OFF);
    for (int i = tid; i < 4 * LUT_N; i += NTHR) {
        const int h = i / LUT_N, dist = i % LUT_N - LUT_PAD;
        lut[i] = dist >= 0 ? p.rel_bias[t5_bucket(dist) * 16 + g * 4 + h] * 1.4426950408889634f : 0.f;
    }
    __syncthreads();
    const float* lutp = lut + head * LUT_N + LUT_PAD;
    const float b31 = lutp[2047];
    const bf16_t* Qb = (const bf16_t*)(p.ws + OFF_Q);
    const bf16_t* KC = (const bf16_t*)(p.ws + OFF_KC);
    const bf16_t* VCT = (const bf16_t*)(p.ws + OFF_VC);
    const bf16_t* KS = (const bf16_t*)(p.ws + OFF_KS);
    const bf16_t* VST = (const bf16_t*)(p.ws + OFF_VS);
    const bf16_t* KW = (const bf16_t*)(p.ws + OFF_KW);
    const bf16_t* VWT = (const bf16_t*)(p.ws + OFF_VW);
    const float* GT = (const float*)(p.ws + OFF_GATES);
    bf16_t* Og = (bf16_t*)(p.ws + OFF_HA);
    float* scw = (float*)(lds + ATT_SC_OFF) + wid * 2048;
    f32x4* outw = (f32x4*)(lds + ATT_SC_OFF + wid * 8192) + lane;
    const bool flip_ok = (cx.G % 128) == 0;
    const int widu = __builtin_amdgcn_readfirstlane(wid);

    for (int it = 0;; ++it) {
        const int u = cx.vbid + it * cx.G;
        if (u >= 2048) break;
        const int rest = u >> 2, b = rest >> 5, qtb = rest & 31;
        const int qt = (flip_ok && (it & 1)) ? 31 - qtb : qtb;
        const int t0 = qt * 64, cur = qt, bg = b * 4 + g;
        const int tq = t0 + wid * 8 + ql;
        const size_t rowtok = (size_t)b * SEQ + tq;
        bf16x8 Qf[4];
        {
            const bf16_t* qp = Qb + rowtok * 1024 + (g * 4 + head) * 64 + 8 * h2;
#pragma unroll
            for (int ks = 0; ks < 4; ++ks) Qf[ks] = *(const bf16x8*)(qp + 16 * ks);
        }
        const float* gt = GT + rowtok * 48 + (g * 4 + head) * 3;
        const float gate_c = gt[0], gate_s = gt[1], gate_w = gt[2];
        const int wlo = max(0, qt - 8);
        const int nW = cur - wlo + 1;
        const int ncp = (t0 + 63 >= 31 + 16 * 64) ? 2 : 1;
        const int NC = ncp;
        const int NT = NC + nW + cur + 1;

        uint4 kr0, vr0;
        auto issue_load = [&](int i) {
            const bf16_t* ksrc; const bf16_t* vsrc; int vstride;
            if (i < NC) { const int ci = i; ksrc = KC + ((size_t)bg * 128 + ci * 64) * 64; vsrc = VCT + (size_t)bg * 64 * 128 + ci * 64; vstride = 128; }
            else if (i < NC + nW) { const int kb = wlo + i - NC; ksrc = KW + ((size_t)bg * 2048 + kb * 64) * 64; vsrc = VWT + (size_t)bg * 64 * 2048 + kb * 64; vstride = 2048; }
            else { const int kb = i - NC - nW; ksrc = KS + ((size_t)bg * 2048 + kb * 64) * 64; vsrc = VST + (size_t)bg * 64 * 2048 + kb * 64; vstride = 2048; }
            kr0 = *(const uint4*)(ksrc + tid * 8);
            vr0 = *(const uint4*)(vsrc + (size_t)(tid >> 3) * vstride + (tid & 7) * 8);
        };
        auto write_lds = [&](int i) {
            char* bufp = lds + (i & 1) * ATT_BUF;
            *(uint4*)(bufp + (tid >> 3) * ATT_K_STRIDE + (tid & 7) * 16) = kr0;
            char* va = bufp + ATT_V_OFF + (tid >> 3) * ATT_V_STRIDE + (tid & 7) * 16;
            uint2 t;
            t.x = vr0.x; t.y = vr0.y; *(uint2*)va = t;
            t.x = vr0.z; t.y = vr0.w; *(uint2*)(va + 8) = t;
        };
        f32x16 O0, O1;
#pragma unroll
        for (int r = 0; r < 16; ++r) { O0[r] = 0.f; O1[r] = 0.f; }
        float lsum = 0.f;

        auto qk = [&](const char* bufp, int kt2, float init) -> f32x16 {
            f32x16 S;
#pragma unroll
            for (int r = 0; r < 16; ++r) S[r] = init;
            const char* kp = bufp + (32 * kt2 + l31) * ATT_K_STRIDE + 16 * h2;
            bf16x8 kf[4];
#pragma unroll
            for (int ks = 0; ks < 4; ++ks) kf[ks] = *(const bf16x8*)(kp + 32 * ks);
            __builtin_amdgcn_sched_barrier(0);
#pragma unroll
            for (int ks = 0; ks < 4; ++ks) S = MFMA32(kf[ks], Qf[ks], S);
            return S;
        };
        auto pv = [&](const char* bufp, int kt2, const f32x16& P) {
            const char* vp = bufp + ATT_V_OFF + l31 * ATT_V_STRIDE + (32 * kt2 + 4 * h2) * 2;
            uint2 va[2][2][2];
#pragma unroll
            for (int s2 = 0; s2 < 2; ++s2)
#pragma unroll
                for (int dt = 0; dt < 2; ++dt) {
                    va[s2][dt][0] = *(const uint2*)(vp + dt * 32 * ATT_V_STRIDE + s2 * 32);
                    va[s2][dt][1] = *(const uint2*)(vp + dt * 32 * ATT_V_STRIDE + s2 * 32 + 16);
                }
            __builtin_amdgcn_sched_barrier(0);
#pragma unroll
            for (int s2 = 0; s2 < 2; ++s2) {
                uint4 pk;
                pk.x = pack2(P[8 * s2 + 0], P[8 * s2 + 1]); pk.y = pack2(P[8 * s2 + 2], P[8 * s2 + 3]);
                pk.z = pack2(P[8 * s2 + 4], P[8 * s2 + 5]); pk.w = pack2(P[8 * s2 + 6], P[8 * s2 + 7]);
                const bf16x8 Pf = __builtin_bit_cast(bf16x8, pk);
                uint4 a0, a1;
                a0.x = va[s2][0][0].x; a0.y = va[s2][0][0].y; a0.z = va[s2][0][1].x; a0.w = va[s2][0][1].y;
                a1.x = va[s2][1][0].x; a1.y = va[s2][1][0].y; a1.z = va[s2][1][1].x; a1.w = va[s2][1][1].y;
                O0 = MFMA32(__builtin_bit_cast(bf16x8, a0), Pf, O0);
                O1 = MFMA32(__builtin_bit_cast(bf16x8, a1), Pf, O1);
            }
        };
        auto finalize = [&](float gate, int mode) {
            const float Z = lsum + __shfl_xor(lsum, 32);
            const float f = Z > 0.f ? gate / Z : 0.f;
#pragma unroll
            for (int v4 = 0; v4 < 4; ++v4) {
                f32x4 a = {f * O0[4 * v4], f * O0[4 * v4 + 1], f * O0[4 * v4 + 2], f * O0[4 * v4 + 3]};
                f32x4 c = {f * O1[4 * v4], f * O1[4 * v4 + 1], f * O1[4 * v4 + 2], f * O1[4 * v4 + 3]};
                if (mode != 0) { a += outw[v4 * 64]; c += outw[(4 + v4) * 64]; }
                if (mode != 2) { outw[v4 * 64] = a; outw[(4 + v4) * 64] = c; }
                else { O0[4 * v4] = a[0]; O0[4 * v4 + 1] = a[1]; O0[4 * v4 + 2] = a[2]; O0[4 * v4 + 3] = a[3];
                       O1[4 * v4] = c[0]; O1[4 * v4 + 1] = c[1]; O1[4 * v4 + 2] = c[2]; O1[4 * v4 + 3] = c[3]; }
            }
            if (mode != 2) {
#pragma unroll
                for (int r = 0; r < 16; ++r) { O0[r] = 0.f; O1[r] = 0.f; }
            }
            lsum = 0.f;
        };
        auto tile_ws = [&](const char* bufp, int kb, float cinit, auto MMc, auto BMc) {
            constexpr int MM = decltype(MMc)::value, BM = decltype(BMc)::value;
#pragma unroll 1
            for (int kt2 = 0; kt2 < 2; ++kt2) {
                const int d0 = tq - (64 * kb + 32 * kt2 + 4 * h2);
                const float* lp = lutp + (d0 - 27);
                float bv[16];
                if (BM == 0) {
#pragma unroll
                    for (int r = 0; r < 16; ++r) bv[r] = lp[27 - ((r & 3) + 8 * (r >> 2))];
                    __builtin_amdgcn_sched_barrier(0);
                }
                f32x16 S = qk(bufp, kt2, cinit);
#pragma unroll
                for (int r = 0; r < 16; ++r) {
                    const int cr = (r & 3) + 8 * (r >> 2);
                    float x = S[r];
                    if (BM == 0) x += bv[r];
                    if (MM == 1) x += (d0 - cr < 512) ? 0.f : -INFINITY;
                    if (MM == 2) x += (d0 - cr >= 0) ? 0.f : -INFINITY;
                    S[r] = __builtin_amdgcn_exp2f(x);
                    lsum += S[r];
                }
                pv(bufp, kt2, S);
            }
        };

        const int nvis = (tq >= 31) ? min((tq - 31) / 16 + 1, 127) : 0;
        unsigned selmask = 0u;
        float* sown = scw + (head * 8 + ql) * 32;
        float* stail = scw + 1024 + (head * 8 + ql) * 32;
        float* ssc = scw + ql * 32;
        issue_load(0);
        __syncthreads();
        write_lds(0);
        issue_load(1);
        for (int i = 0; i < NT; ++i) {
            __syncthreads();
            const char* bufp = lds + (i & 1) * ATT_BUF;
            if (i < NC) {
                const int ci = i;
#pragma unroll 1
                for (int kt2 = 0; kt2 < 2; ++kt2) {
                    const int n0 = 64 * ci + 32 * kt2 + 4 * h2;
                    const int d0 = tq - 31 - 16 * n0;
                    float bv[16];
#pragma unroll
                    for (int r = 0; r < 16; ++r) bv[r] = lutp[max(d0 - 16 * ((r & 3) + 8 * (r >> 2)), -LUT_PAD)];
                    __builtin_amdgcn_sched_barrier(0);
                    f32x16 S = qk(bufp, kt2, 0.f);
#pragma unroll
                    for (int r = 0; r < 16; ++r) {
                        const int cr = (r & 3) + 8 * (r >> 2);
                        S[r] = __builtin_amdgcn_exp2f(S[r] + bv[r] + ((n0 + cr) < nvis ? 0.f : -INFINITY));
                        lsum += S[r];
                    }
                    pv(bufp, kt2, S);
#pragma unroll
                    for (int rq = 0; rq < 4; ++rq) {
                        const int sblk = 8 * (2 * ci + kt2) + 2 * rq + h2;
                        sown[sblk] = S[4 * rq] + S[4 * rq + 1] + S[4 * rq + 2] + 0.5f * S[4 * rq + 3];
                        if (sblk < 31) stail[sblk + 1] = 0.5f * S[4 * rq + 3];
                    }
                }
                if (i == NC - 1) {
                    const float Z = lsum + __shfl_xor(lsum, 32);
                    const float inv_mine = Z > 0.f ? 1.f / Z : 0.f;
                    if (h2 == 0) stail[0] = 0.f;
                    __builtin_amdgcn_wave_barrier();
                    const int j8 = head * 2 + h2;
                    {
                        f32x4 sc = {0.f, 0.f, 0.f, 0.f};
#pragma unroll
                        for (int hh = 0; hh < 4; ++hh) {
                            const float invh = __shfl(inv_mine, hh * 8 + ql);
                            const f32x4 a = *(const f32x4*)(scw + (hh * 8 + ql) * 32 + 4 * j8), t4 = *(const f32x4*)(scw + 1024 + (hh * 8 + ql) * 32 + 4 * j8);
                            sc += (a + t4) * invh;
                        }
#pragma unroll
                        for (int q = 0; q < 4; ++q) {
                            const int sblk = 4 * j8 + q;
                            const bool forced = (sblk == 0) || (sblk == cur) || (sblk == cur - 1);
                            sc[q] = forced ? 1.0e4f : (sblk <= cur ? sc[q] : -1.0f);
                        }
                        __builtin_amdgcn_wave_barrier();
                        *(f32x4*)(ssc + 4 * j8) = sc;
                    }
                    __builtin_amdgcn_wave_barrier();
                    const f32x4 own = *(const f32x4*)(ssc + 4 * j8);
                    int rk0 = 0, rk1 = 0, rk2 = 0, rk3 = 0;
                    const int so0 = 4 * j8;
#pragma unroll
                    for (int m4 = 0; m4 < 8; ++m4) {
                        const f32x4 v = *(const f32x4*)(ssc + 4 * m4);
#pragma unroll
                        for (int q = 0; q < 4; ++q) {
                            const float vm = v[q];
                            rk0 += (vm > own[0]) ? 1 : 0;
                            rk1 += (vm > own[1]) ? 1 : 0;
                            rk2 += (vm > own[2]) ? 1 : 0;
                            rk3 += (vm > own[3]) ? 1 : 0;
                        }
                    }
                    unsigned mk = ((rk0 < 8 ? 1u : 0u) | (rk1 < 8 ? 2u : 0u) | (rk2 < 8 ? 4u : 0u) | (rk3 < 8 ? 8u : 0u)) << so0;
                    mk |= __shfl_xor(mk, 8); mk |= __shfl_xor(mk, 16); mk |= __shfl_xor(mk, 32);
                    selmask = mk;
                    __builtin_amdgcn_wave_barrier();
                    finalize(gate_c, 0);
                }
            } else if (i < NC + nW) {
                const int kb = wlo + i - NC;
                if (kb == cur) tile_ws(bufp, kb, 0.f, IC<2>{}, IC<0>{});
                else if (kb == cur - 8) tile_ws(bufp, kb, 0.f, IC<1>{}, IC<0>{});
                else tile_ws(bufp, kb, 0.f, IC<0>{}, IC<0>{});
                if (i == NC - 1 + nW) finalize(gate_w, 1);
            } else {
                const int kb = i - NC - nW;
                const bool sel = ((selmask >> kb) & 1u) != 0;
                if (__ballot(sel) != 0ull) {
                    const float neg = sel ? 0.f : -INFINITY;
                    if (kb == cur) tile_ws(bufp, kb, neg, IC<2>{}, IC<0>{});
                    else if (t0 + 8 * widu - (64 * kb + 63) >= 790) tile_ws(bufp, kb, neg + b31, IC<0>{}, IC<1>{});
                    else tile_ws(bufp, kb, neg, IC<0>{}, IC<0>{});
                }
            }
            if (i + 1 < NT) {
                write_lds(i + 1);
                if (i + 2 < NT) issue_load(i + 2);
            }
        }
        finalize(gate_s, 2);
        {
            bf16_t* op = Og + rowtok * 1024 + (g * 4 + head) * 64 + 4 * h2;
#pragma unroll
            for (int rq = 0; rq < 4; ++rq) {
                uint2 o0; o0.x = pack2(O0[4 * rq], O0[4 * rq + 1]); o0.y = pack2(O0[4 * rq + 2], O0[4 * rq + 3]);
                uint2 o1; o1.x = pack2(O1[4 * rq], O1[4 * rq + 1]); o1.y = pack2(O1[4 * rq + 2], O1[4 * rq + 3]);
                *(uint2*)(op + 8 * rq) = o0;
                *(uint2*)(op + 32 + 8 * rq) = o1;
            }
        }
    }
}

__device__ __forceinline__ void phase_outproj(const Params& p, const Ctx& cx, char* lds, const bf16_t* A, const bf16_t* Bt, const float* xin, int ls) {
    const float* mod = (const float*)(p.ws + OFF_MOD);
    float* xo = p.out;
    gemm_phase_dense2(A, 1024, Bt, 1024, NTOK / 256, 4, lds, cx, [=](int row0, int col0) {
        return [=](f32x4 (&acc)[8][4], int wr, int wc, int fr, int fq) {
            const int b = row0 >> 11;
            const float* gate = mod + ((size_t)ls * 16 + b) * 3072 + 2048 + col0 + wc * 64;
            f32x4 g[4];
#pragma unroll
            for (int n = 0; n < 4; ++n) g[n] = *(const f32x4*)(gate + pcol(n, fq));
#pragma unroll
            for (int m2 = 0; m2 < 8; m2 += 2) {
                f32x4 xi[2][4];
#pragma unroll
                for (int mm = 0; mm < 2; ++mm)
#pragma unroll
                    for (int n = 0; n < 4; ++n)
                        xi[mm][n] = *(const f32x4*)(xin + (size_t)(row0 + wr * 128 + (m2 + mm) * 16 + fr) * 1024 + col0 + wc * 64 + pcol(n, fq));
                __builtin_amdgcn_sched_barrier(0);
#pragma unroll
                for (int mm = 0; mm < 2; ++mm)
#pragma unroll
                    for (int n = 0; n < 4; ++n) {
                        f32x4 o;
#pragma unroll
                        for (int j = 0; j < 4; ++j) o[j] = xi[mm][n][j] + g[n][j] * acc[m2 + mm][n][j];
                        *(f32x4*)(xo + (size_t)(row0 + wr * 128 + (m2 + mm) * 16 + fr) * 1024 + col0 + wc * 64 + pcol(n, fq)) = o;
                    }
                __builtin_amdgcn_sched_barrier(0);
            }
        };
    });
}

__device__ __forceinline__ void moe_tables(const Params& p, int layer, int tid, int* s_off, int* s_toff, int* s_hoff) {
    __syncthreads();
    if (tid == 0) {
        const int* cnt = (const int*)(p.ws + OFF_CNT) + layer * 16;
        int o = 0, to = 0, ho = 0;
        for (int e = 0; e < 16; ++e) {
            const int c = cnt[e], q = c >> 8, r = c & 255;
            s_off[e] = o; s_toff[e] = to; s_hoff[e] = ho;
            o += c; to += (q + (r > 128 ? 1 : 0)) * 4; ho += (r > 0 && r <= 128) ? 4 : 0;
        }
        s_off[16] = o; s_toff[16] = to; s_hoff[16] = ho;
    }
    __syncthreads();
}

constexpr int LDS_ROWIDX_OFF = 131072, LDS_LW_OFF = 131072 + 8192;
static_assert(LDS_LW_OFF + 8192 <= LDS_TAB_OFF, "moe caches");


namespace pg8 {
#define PG8_LAS __attribute__((address_space(3)))
typedef unsigned short bf16_t;
typedef short bf16x8 __attribute__((ext_vector_type(8)));
typedef float f32x4 __attribute__((ext_vector_type(4)));
typedef unsigned u32x4 __attribute__((ext_vector_type(4)));
constexpr int BM = 256, BK = 64, HALF = 128, HTB = HALF * BK * 2  , STAGE_BYTES = 8 * HTB, NXCD = 8, WGM = 8;

__host__ __device__ __forceinline__ int lds_byte(int r, int c) { const int st = (r >> 4) * 2 + (c >> 5), rr = r & 15, cc = c & 31, ob = rr * 64 + cc * 2; return st * 1024 + (ob ^ (((ob >> 9) & 1) << 5)); }
__host__ __device__ __forceinline__ void stage_rc(int b, int& R, int& C) { const int st = b / 1024, sb = b % 1024, swz = sb ^ (((sb >> 9) & 1) << 5); R = (st >> 1) * 16 + swz / 64; C = (st & 1) * 32 + (swz % 64) / 2; }
__host__ __device__ __forceinline__ int perm32(int rho) { const int n = rho >> 4, i = rho & 15; return 8 * (i >> 2) + 4 * n + (i & 3); }

struct Unit { int pm, pn; };
struct Gemm { const bf16_t* A; const bf16_t* Bt; int M, N, K; };

struct StaticOrder {
    int nM, nN, nwg, G, c;
    __host__ __device__ void init(int M, int N, int G_, int c_) { nM = M / BM; nN = N / BM; nwg = nM * nN; G = G_; c = c_; }
    __host__ __device__ bool next(int i, Unit& u) const {
        const long L = (long)i * G + c; if (L >= nwg) return false;
        int wgid = (int)L; { const int q = nwg / NXCD, r = nwg % NXCD, xcd = wgid % NXCD, off = wgid / NXCD; wgid = (xcd < r ? xcd * (q + 1) : r * (q + 1) + (xcd - r) * q) + off; }
        const int nig = WGM * nN, gid = wgid / nig, fm = gid * WGM, gsz = (nM - fm) < WGM ? (nM - fm) : WGM;
        u.pm = fm + ((wgid % nig) % gsz); u.pn = (wgid % nig) / gsz; return true;
    }
    __device__ __forceinline__ void a_ready(const Unit&) const {}
    __device__ __forceinline__ void done(const Unit&) const {}
};

template <class Epi, class Sched, bool ALIGN_EPI = false, bool SP2 = false>
__device__ __forceinline__ void gemm_phase(PG8_LAS unsigned char* lds, const Gemm g, const Sched& S, const Epi& E) {
    const int tid = threadIdx.x, wid = __builtin_amdgcn_readfirstlane(tid >> 6), lane = tid & 63, wr = wid >> 2, wc = wid & 3, fr = lane & 15, fq = lane >> 4;
    const int K = g.K, nt = K / BK;
    unsigned voffA[2], voffB[2];
#pragma unroll
    for (int i = 0; i < 2; ++i) { int R, C; stage_rc(tid * 16 + i * 8192, R, C); const int Rb = Epi::PERM ? ((R & ~31) + perm32(R & 31)) : R;
        voffA[i] = (unsigned)(R * K + C) * 2u; voffB[i] = (unsigned)(Rb * K + C) * 2u; }
    const size_t kstep = (size_t)(BK * 2);
    const size_t hstep = (size_t)HALF * K * 2;
    const size_t tstep = 2 * hstep;
    const unsigned ldsw = (unsigned)wid * 1024u;
    const int aoff = lds_byte(wr * 64 + fr, fq * 8), boff = lds_byte(wc * 32 + fr, fq * 8);
#define PG8_SA(b, h) (((b) * 2 + (h)) * HTB)
#define PG8_SB(b, h) ((4 + (b) * 2 + (h)) * HTB)
#define PG8_STAGE(bufoff, gbase, voff) do { _Pragma("unroll") for (int _i = 0; _i < 2; ++_i) \
        __builtin_amdgcn_global_load_lds((const unsigned*)((const char*)(gbase) + (voff)[_i]), (PG8_LAS unsigned*)(lds + (bufoff) + ldsw + _i * 8192), 16, 0, 0); } while (0)
#define PG8_LDA(dst, b, h) do { _Pragma("unroll") for (int m = 0; m < 4; ++m) _Pragma("unroll") for (int k = 0; k < 2; ++k) dst[m][k] = *(const PG8_LAS bf16x8*)(lds + PG8_SA(b, h) + aoff + m * 2048 + k * 1024); } while (0)
#define PG8_LDB(dst, b, h) do { _Pragma("unroll") for (int n = 0; n < 2; ++n) _Pragma("unroll") for (int k = 0; k < 2; ++k) dst[n][k] = *(const PG8_LAS bf16x8*)(lds + PG8_SB(b, h) + boff + n * 2048 + k * 1024); } while (0)
#define PG8_MMA(ai, bj, At, Bt) do { __builtin_amdgcn_s_setprio(1); _Pragma("unroll") for (int m = 0; m < 4; ++m) _Pragma("unroll") for (int n = 0; n < 2; ++n) _Pragma("unroll") for (int k = 0; k < 2; ++k) \
        acc[ai][bj][m][n] = __builtin_amdgcn_mfma_f32_16x16x32_bf16(Bt[n][k], At[m][k], acc[ai][bj][m][n], 0, 0, 0); __builtin_amdgcn_s_setprio(0); } while (0)
#define PG8_WAIT_V(n) asm volatile("s_waitcnt vmcnt(" #n ")" ::: "memory")
#define PG8_WAIT_L(n) asm volatile("s_waitcnt lgkmcnt(" #n ")" ::: "memory")
#define PG8_BAR __builtin_amdgcn_s_barrier()
#define PG8_SCHED __builtin_amdgcn_sched_barrier(0)
    Unit cur, nxt; int ui = 0;
    if (!S.next(0, cur)) return;
    f32x4 acc[2][2][4][2];
#pragma unroll
    for (int a = 0; a < 2; ++a)
#pragma unroll
        for (int b = 0; b < 2; ++b)
#pragma unroll
            for (int m = 0; m < 4; ++m)
#pragma unroll
                for (int n = 0; n < 2; ++n) acc[a][b][m][n] = (f32x4){0.f, 0.f, 0.f, 0.f};
    bf16x8 At[4][2], B0[2][2], B1[2][2];
    const char* cA = (const char*)g.A + (size_t)cur.pm * tstep; const char* cB = (const char*)g.Bt + (size_t)cur.pn * tstep;
    S.a_ready(cur);
    if constexpr (SP2) {
        PG8_STAGE(PG8_SB(0, 0), cB, voffB); PG8_STAGE(PG8_SB(0, 1), cB + hstep, voffB); PG8_STAGE(PG8_SA(0, 0), cA, voffA); PG8_STAGE(PG8_SA(0, 1), cA + hstep, voffA);
        if (wr == 1) PG8_BAR;
        PG8_WAIT_V(2); PG8_BAR;
        PG8_STAGE(PG8_SB(1, 0), cB + kstep, voffB); PG8_STAGE(PG8_SA(1, 0), cA + kstep, voffA); PG8_STAGE(PG8_SB(1, 1), cB + hstep + kstep, voffB);
        PG8_WAIT_V(6); PG8_BAR;
    } else {
        PG8_STAGE(PG8_SB(0, 0), cB, voffB); PG8_STAGE(PG8_SA(0, 0), cA, voffA); PG8_STAGE(PG8_SB(0, 1), cB + hstep, voffB); PG8_STAGE(PG8_SA(0, 1), cA + hstep, voffA);
        if (wr == 1) PG8_BAR;
        PG8_WAIT_V(4); PG8_BAR;
        PG8_STAGE(PG8_SB(1, 0), cB + kstep, voffB); PG8_STAGE(PG8_SA(1, 0), cA + kstep, voffA); PG8_STAGE(PG8_SB(1, 1), cB + hstep + kstep, voffB);
        PG8_WAIT_V(6); PG8_BAR;
    }
    for (;;) {
        const bool has_next = S.next(ui + 1, nxt);
        const char* nA = has_next ? (const char*)g.A + (size_t)nxt.pm * tstep : cA; const char* nB = has_next ? (const char*)g.Bt + (size_t)nxt.pn * tstep : cB;
        for (int t = 0; t < nt; t += 2) {
            const bool last = (t == nt - 2);
            const char* a1 = cA + (size_t)(t + 1) * kstep;
            const char* a2 = last ? nA : cA + (size_t)(t + 2) * kstep; const char* b2 = last ? nB : cB + (size_t)(t + 2) * kstep;
            const char* a3 = a2 + kstep; const char* b3 = b2 + kstep;
            if (last && has_next) S.a_ready(nxt);
            if constexpr (SP2) {
            PG8_LDB(B0, 0, 0); PG8_LDB(B1, 0, 1); PG8_SCHED; PG8_LDA(At, 0, 0); PG8_STAGE(PG8_SA(1, 1), a1 + hstep, voffA);
            PG8_WAIT_V(8); PG8_WAIT_L(0); PG8_BAR; PG8_MMA(0, 0, At, B0); PG8_MMA(0, 1, At, B1); PG8_BAR; PG8_SCHED;
            PG8_LDA(At, 0, 1); PG8_STAGE(PG8_SB(0, 0), b2, voffB); PG8_STAGE(PG8_SB(0, 1), b2 + hstep, voffB); PG8_STAGE(PG8_SA(0, 0), a2, voffA);
            PG8_WAIT_V(8); PG8_WAIT_L(0); PG8_BAR; PG8_MMA(1, 0, At, B0); PG8_MMA(1, 1, At, B1); PG8_BAR; PG8_SCHED;
            PG8_LDB(B0, 1, 0); PG8_LDB(B1, 1, 1); PG8_SCHED; PG8_LDA(At, 1, 0); PG8_STAGE(PG8_SA(0, 1), a2 + hstep, voffA);
            PG8_WAIT_V(8); PG8_WAIT_L(0); PG8_BAR; PG8_MMA(0, 0, At, B0); PG8_MMA(0, 1, At, B1); PG8_BAR; PG8_SCHED;
            PG8_LDA(At, 1, 1); PG8_STAGE(PG8_SB(1, 0), b3, voffB); PG8_STAGE(PG8_SB(1, 1), b3 + hstep, voffB); PG8_STAGE(PG8_SA(1, 0), a3, voffA);
            PG8_WAIT_V(8); PG8_WAIT_L(0); PG8_BAR; PG8_MMA(1, 0, At, B0); PG8_MMA(1, 1, At, B1); PG8_BAR; PG8_SCHED;
            } else {
            PG8_LDB(B0, 0, 0); PG8_SCHED; PG8_LDA(At, 0, 0); PG8_STAGE(PG8_SA(1, 1), a1 + hstep, voffA);
            PG8_WAIT_L(8); PG8_BAR; PG8_WAIT_L(0); PG8_MMA(0, 0, At, B0); PG8_BAR; PG8_SCHED;
            PG8_LDB(B1, 0, 1); PG8_STAGE(PG8_SB(0, 0), b2, voffB);
            PG8_BAR; PG8_WAIT_L(0); PG8_MMA(0, 1, At, B1); PG8_BAR;
            PG8_LDA(At, 0, 1); PG8_STAGE(PG8_SA(0, 0), a2, voffA);
            PG8_BAR; PG8_WAIT_L(0); PG8_MMA(1, 0, At, B0); PG8_BAR; PG8_SCHED;
            PG8_STAGE(PG8_SB(0, 1), b2 + hstep, voffB);
            PG8_WAIT_V(6); PG8_BAR; PG8_MMA(1, 1, At, B1); PG8_BAR;
            PG8_LDB(B0, 1, 0); PG8_SCHED; PG8_LDA(At, 1, 0); PG8_STAGE(PG8_SA(0, 1), a2 + hstep, voffA);
            PG8_WAIT_L(8); PG8_BAR; PG8_WAIT_L(0); PG8_MMA(0, 0, At, B0); PG8_BAR; PG8_SCHED;
            PG8_LDB(B1, 1, 1); PG8_STAGE(PG8_SB(1, 0), b3, voffB);
            PG8_BAR; PG8_WAIT_L(0); PG8_MMA(0, 1, At, B1); PG8_BAR;
            PG8_LDA(At, 1, 1); PG8_STAGE(PG8_SA(1, 0), a3, voffA);
            PG8_BAR; PG8_WAIT_L(0); PG8_MMA(1, 0, At, B0); PG8_BAR; PG8_SCHED;
            PG8_STAGE(PG8_SB(1, 1), b3 + hstep, voffB);
            PG8_WAIT_V(6); PG8_BAR; PG8_MMA(1, 1, At, B1); PG8_BAR;
            }
        }
        if constexpr (ALIGN_EPI) { if (wr == 0) PG8_BAR; }
        if constexpr (!Epi::AFTER_DRAIN) { E(acc, cur, wr, wc, fr, fq); S.done(cur); }
        if (!has_next) break;
#pragma unroll
        for (int a = 0; a < 2; ++a)
#pragma unroll
            for (int b = 0; b < 2; ++b)
#pragma unroll
                for (int m = 0; m < 4; ++m)
#pragma unroll
                    for (int n = 0; n < 2; ++n) acc[a][b][m][n] = (f32x4){0.f, 0.f, 0.f, 0.f};
        cur = nxt; cA = nA; cB = nB; ++ui;
        if constexpr (ALIGN_EPI) { if (wr == 1) PG8_BAR; }
    }
    PG8_WAIT_V(0);
    if constexpr (!ALIGN_EPI) { if (wr == 0) PG8_BAR; }
    PG8_BAR;
    if constexpr (Epi::AFTER_DRAIN) { E.fused(acc, cur, wr, wc, fr, fq, lds, wid, lane); S.done(cur); }
#undef PG8_SA
#undef PG8_SB
#undef PG8_STAGE
#undef PG8_LDA
#undef PG8_LDB
#undef PG8_MMA
#undef PG8_WAIT_V
#undef PG8_WAIT_L
#undef PG8_BAR
#undef PG8_SCHED
}

template <class Epi, class Sched>
__device__ __forceinline__ void gemm_phase_rows(PG8_LAS unsigned char* lds, const Gemm g, const Sched& S, const Epi& E, const PG8_LAS int* rows) {
    const int tid = threadIdx.x, wid = __builtin_amdgcn_readfirstlane(tid >> 6), lane = tid & 63, wr = wid >> 2, wc = wid & 3, fr = lane & 15, fq = lane >> 4;
    const int K = g.K, nt = K / BK;
    unsigned voffB[2]; int R0 = 0, C0 = 0;
#pragma unroll
    for (int i = 0; i < 2; ++i) { int R, C; stage_rc(tid * 16 + i * 8192, R, C); voffB[i] = (unsigned)(R * K + C) * 2u; if (i == 0) { R0 = R; C0 = C; } }
    const size_t kstep = (size_t)(BK * 2);
    const size_t hstep = (size_t)HALF * K * 2;
    const size_t tstep = 2 * hstep;
    const unsigned ldsw = (unsigned)wid * 1024u;
    const int aoff = lds_byte(wr * 64 + fr, fq * 8), boff = lds_byte(wc * 32 + fr, fq * 8);
#define PG8_SA(b, h) (((b) * 2 + (h)) * HTB)
#define PG8_SB(b, h) ((4 + (b) * 2 + (h)) * HTB)
#define PG8_STAGE(bufoff, gbase, voff) do { _Pragma("unroll") for (int _i = 0; _i < 2; ++_i) \
        __builtin_amdgcn_global_load_lds((const unsigned*)((const char*)(gbase) + (voff)[_i]), (PG8_LAS unsigned*)(lds + (bufoff) + ldsw + _i * 8192), 16, 0, 0); } while (0)
#define PG8_LDA(dst, b, h) do { _Pragma("unroll") for (int m = 0; m < 4; ++m) _Pragma("unroll") for (int k = 0; k < 2; ++k) dst[m][k] = *(const PG8_LAS bf16x8*)(lds + PG8_SA(b, h) + aoff + m * 2048 + k * 1024); } while (0)
#define PG8_LDB(dst, b, h) do { _Pragma("unroll") for (int n = 0; n < 2; ++n) _Pragma("unroll") for (int k = 0; k < 2; ++k) dst[n][k] = *(const PG8_LAS bf16x8*)(lds + PG8_SB(b, h) + boff + n * 2048 + k * 1024); } while (0)
#define PG8_MMA(ai, bj, At, Bt) do { __builtin_amdgcn_s_setprio(1); _Pragma("unroll") for (int m = 0; m < 4; ++m) _Pragma("unroll") for (int n = 0; n < 2; ++n) _Pragma("unroll") for (int k = 0; k < 2; ++k) \
        acc[ai][bj][m][n] = __builtin_amdgcn_mfma_f32_16x16x32_bf16(Bt[n][k], At[m][k], acc[ai][bj][m][n], 0, 0, 0); __builtin_amdgcn_s_setprio(0); } while (0)
#define PG8_WAIT_V(n) asm volatile("s_waitcnt vmcnt(" #n ")" ::: "memory")
#define PG8_WAIT_L(n) asm volatile("s_waitcnt lgkmcnt(" #n ")" ::: "memory")
#define PG8_BAR __builtin_amdgcn_s_barrier()
#define PG8_SCHED __builtin_amdgcn_sched_barrier(0)
    Unit cur, nxt; int ui = 0;
    if (!S.next(0, cur)) return;
    f32x4 acc[2][2][4][2];
#pragma unroll
    for (int a = 0; a < 2; ++a)
#pragma unroll
        for (int b = 0; b < 2; ++b)
#pragma unroll
            for (int m = 0; m < 4; ++m)
#pragma unroll
                for (int n = 0; n < 2; ++n) acc[a][b][m][n] = (f32x4){0.f, 0.f, 0.f, 0.f};
    bf16x8 At[4][2], B0[2][2], B1[2][2];
    unsigned vc[4], vn[4];
#pragma unroll
    for (int q = 0; q < 4; ++q) vc[q] = ((unsigned)rows[cur.pm * 256 + R0 + 64 * q] * (unsigned)K + (unsigned)C0) * 2u;
    const char* gA = (const char*)g.A; const char* cB = (const char*)g.Bt + (size_t)(cur.pn & 0xffff) * tstep;
    PG8_STAGE(PG8_SB(0, 0), cB, voffB); PG8_STAGE(PG8_SB(0, 1), cB + hstep, voffB); PG8_STAGE(PG8_SA(0, 0), gA, vc); PG8_STAGE(PG8_SA(0, 1), gA, vc + 2);
    if (wr == 1) PG8_BAR;
    PG8_WAIT_V(2); PG8_BAR;
    PG8_STAGE(PG8_SB(1, 0), cB + kstep, voffB); PG8_STAGE(PG8_SA(1, 0), gA + kstep, vc); PG8_STAGE(PG8_SB(1, 1), cB + hstep + kstep, voffB);
    PG8_WAIT_V(6); PG8_BAR;
    for (;;) {
        const bool has_next = S.next(ui + 1, nxt);
        if (has_next) {
#pragma unroll
            for (int q = 0; q < 4; ++q) vn[q] = ((unsigned)rows[nxt.pm * 256 + R0 + 64 * q] * (unsigned)K + (unsigned)C0) * 2u;
        } else {
#pragma unroll
            for (int q = 0; q < 4; ++q) vn[q] = vc[q];
        }
        const char* nB = has_next ? (const char*)g.Bt + (size_t)(nxt.pn & 0xffff) * tstep : cB;
        const bool fullu = (cur.pn >> 16) == 0;
        for (int t = 0; t < nt; t += 2) {
            const bool last = (t == nt - 2);
            const char* a1 = gA + (size_t)(t + 1) * kstep;
            const char* a2 = last ? gA : gA + (size_t)(t + 2) * kstep; const char* b2 = last ? nB : cB + (size_t)(t + 2) * kstep;
            const char* a3 = a2 + kstep; const char* b3 = b2 + kstep;
            unsigned v2[4];
#pragma unroll
            for (int q = 0; q < 4; ++q) v2[q] = last ? vn[q] : vc[q];
            PG8_LDB(B0, 0, 0); PG8_LDB(B1, 0, 1); PG8_SCHED; PG8_LDA(At, 0, 0); PG8_STAGE(PG8_SA(1, 1), a1, vc + 2);
            PG8_WAIT_V(8); PG8_WAIT_L(0); PG8_BAR; PG8_MMA(0, 0, At, B0); PG8_MMA(0, 1, At, B1); PG8_BAR; PG8_SCHED;
            if (fullu) PG8_LDA(At, 0, 1); PG8_STAGE(PG8_SB(0, 0), b2, voffB); PG8_STAGE(PG8_SB(0, 1), b2 + hstep, voffB); PG8_STAGE(PG8_SA(0, 0), a2, v2);
            PG8_WAIT_V(8); PG8_WAIT_L(0); PG8_BAR; if (fullu) { PG8_MMA(1, 0, At, B0); PG8_MMA(1, 1, At, B1); } PG8_BAR; PG8_SCHED;
            PG8_LDB(B0, 1, 0); PG8_LDB(B1, 1, 1); PG8_SCHED; PG8_LDA(At, 1, 0); PG8_STAGE(PG8_SA(0, 1), a2, v2 + 2);
            PG8_WAIT_V(8); PG8_WAIT_L(0); PG8_BAR; PG8_MMA(0, 0, At, B0); PG8_MMA(0, 1, At, B1); PG8_BAR; PG8_SCHED;
            if (fullu) PG8_LDA(At, 1, 1); PG8_STAGE(PG8_SB(1, 0), b3, voffB); PG8_STAGE(PG8_SB(1, 1), b3 + hstep, voffB); PG8_STAGE(PG8_SA(1, 0), a3, v2);
            PG8_WAIT_V(8); PG8_WAIT_L(0); PG8_BAR; if (fullu) { PG8_MMA(1, 0, At, B0); PG8_MMA(1, 1, At, B1); } PG8_BAR; PG8_SCHED;
        }
        if (wr == 0) PG8_BAR;
        E(acc, cur, wr, wc, fr, fq);
        if (!has_next) break;
#pragma unroll
        for (int a = 0; a < 2; ++a)
#pragma unroll
            for (int b = 0; b < 2; ++b)
#pragma unroll
                for (int m = 0; m < 4; ++m)
#pragma unroll
                    for (int n = 0; n < 2; ++n) acc[a][b][m][n] = (f32x4){0.f, 0.f, 0.f, 0.f};
        cur = nxt; cB = nB; ++ui;
#pragma unroll
        for (int q = 0; q < 4; ++q) vc[q] = vn[q];
        if (wr == 1) PG8_BAR;
    }
    PG8_WAIT_V(0);
    PG8_BAR;
#undef PG8_SA
#undef PG8_SB
#undef PG8_STAGE
#undef PG8_LDA
#undef PG8_LDB
#undef PG8_MMA
#undef PG8_WAIT_V
#undef PG8_WAIT_L
#undef PG8_BAR
#undef PG8_SCHED
}
}

#ifndef PG8_SP2
#define PG8_SP2 true
#endif
struct EpiHgrnIn {
    static constexpr bool PERM = false, AFTER_DRAIN = false;
    char* ws; const float* lb;
    __device__ __forceinline__ void operator()(const pg8::f32x4 (&acc)[2][2][4][2], const pg8::Unit& u, int wr, int wc, int fr, int fq) const {
#pragma unroll
        for (int ai = 0; ai < 2; ++ai)
#pragma unroll
            for (int m = 0; m < 4; ++m) {
                const int row = u.pm * 256 + ai * 128 + wr * 64 + m * 16 + fr;
#pragma unroll
                for (int bj = 0; bj < 2; ++bj) {
                    const int gc = u.pn * 256 + bj * 128 + wc * 32 + fq * 8, seg = gc >> 10, c = gc & 1023;
                    const f32x4 a0 = acc[ai][bj][m][0], a1 = acc[ai][bj][m][1];
                    float h[8];
                    if (seg == 1) {
                        const f32x4 la = *(const f32x4*)(lb + c), lbb = *(const f32x4*)(lb + c + 4);
#pragma unroll
                        for (int j = 0; j < 4; ++j) {
                            h[j] = __logf(la[j] + (1.f - la[j]) * sigmoid_f(a0[j]));
                            h[4 + j] = __logf(lbb[j] + (1.f - lbb[j]) * sigmoid_f(a1[j]));
                        }
                        uint4 oh; oh.x = packh2(h[0], h[1]); oh.y = packh2(h[2], h[3]); oh.z = packh2(h[4], h[5]); oh.w = packh2(h[6], h[7]);
                        *(uint4*)((unsigned short*)(ws + OFF_LF) + (size_t)row * 1024 + c) = oh;
                    } else {
#pragma unroll
                        for (int j = 0; j < 4; ++j) {
                            h[j] = (seg == 2) ? a0[j] : silu_f(a0[j]);
                            h[4 + j] = (seg == 2) ? a1[j] : silu_f(a1[j]);
                        }
                        uint4 o; o.x = pack2(h[0], h[1]); o.y = pack2(h[2], h[3]); o.z = pack2(h[4], h[5]); o.w = pack2(h[6], h[7]);
                        bf16_t* dst = (bf16_t*)(ws + (seg == 0 ? OFF_QH : seg == 2 ? OFF_V : OFF_G));
                        *(uint4*)(dst + (size_t)row * 1024 + c) = o;
                    }
                }
            }
    }
};

struct EpiOutProj {
    static constexpr bool PERM = false, AFTER_DRAIN = false;
    const float* mod; const float* xin; float* xo; int ls;
    __device__ __forceinline__ void operator()(const pg8::f32x4 (&acc)[2][2][4][2], const pg8::Unit& u, int wr, int wc, int fr, int fq) const {
        const int b = (u.pm * 256) >> 11;
        const float* gate = mod + ((size_t)ls * 16 + b) * 3072 + 2048 + u.pn * 256 + wc * 32 + fq * 8;
        f32x4 g[2][2];
#pragma unroll
        for (int bj = 0; bj < 2; ++bj) { g[bj][0] = *(const f32x4*)(gate + bj * 128); g[bj][1] = *(const f32x4*)(gate + bj * 128 + 4); }
#pragma unroll
        for (int ai = 0; ai < 2; ++ai)
#pragma unroll
            for (int m = 0; m < 4; ++m) {
                const size_t ro = (size_t)(u.pm * 256 + ai * 128 + wr * 64 + m * 16 + fr) * 1024 + u.pn * 256 + wc * 32 + fq * 8;
                f32x4 xi[2][2];
#pragma unroll
                for (int bj = 0; bj < 2; ++bj) { xi[bj][0] = *(const f32x4*)(xin + ro + bj * 128); xi[bj][1] = *(const f32x4*)(xin + ro + bj * 128 + 4); }
#pragma unroll
                for (int bj = 0; bj < 2; ++bj)
#pragma unroll
                    for (int n = 0; n < 2; ++n) {
                        f32x4 o;
#pragma unroll
                        for (int j = 0; j < 4; ++j) o[j] = xi[bj][n][j] + g[bj][n][j] * acc[ai][bj][m][n][j];
                        *(f32x4*)(xo + ro + bj * 128 + n * 4) = o;
                    }
            }
    }
};


struct MoeOrder {
    const int* s_off; const int* s_toff; const int* s_hoff; int ntiles, vb, G;
    __device__ __forceinline__ void locate(int i, int& e, int& rt, int& ct, int& half) const {
        const int tile = vb + i * G, nfull = s_toff[16];
        e = 0;
        if (tile < nfull) { while (tile >= s_toff[e + 1]) ++e; const int lt = tile - s_toff[e]; rt = lt >> 2; ct = lt & 3; half = 0; }
        else { const int h = tile - nfull; while (h >= s_hoff[e + 1]) ++e; ct = h - s_hoff[e]; rt = (s_toff[e + 1] - s_toff[e]) >> 2; half = 1; }
    }
    __device__ __forceinline__ bool next(int i, pg8::Unit& u) const {
        if (vb + i * G >= ntiles) return false;
        int e, rt, ct, half; locate(i, e, rt, ct, half);
        u.pm = i; u.pn = (e * 4 + ct) | (half << 16); return true;
    }
};
struct EpiMoeUp {
    static constexpr bool PERM = false, AFTER_DRAIN = false;
    bf16_t* H1; MoeOrder S;
    __device__ __forceinline__ void operator()(const pg8::f32x4 (&acc)[2][2][4][2], const pg8::Unit& u, int wr, int wc, int fr, int fq) const {
        int e, rt, ct, half; S.locate(u.pm, e, rt, ct, half);
        const int off = S.s_off[e], cnt = S.s_off[e + 1] - off;
#pragma unroll
        for (int ai = 0; ai < 2; ++ai)
#pragma unroll
            for (int m = 0; m < 4; ++m) {
                const int pos = rt * 256 + ai * 128 + wr * 64 + m * 16 + fr;
                if (pos < cnt) {
                    float h[8];
#pragma unroll
                    for (int n = 0; n < 2; ++n)
#pragma unroll
                        for (int jj = 0; jj < 4; ++jj) h[n * 4 + jj] = silu_f(acc[ai][0][m][n][jj]) * acc[ai][1][m][n][jj];
                    uint4 o; o.x = pack2(h[0], h[1]); o.y = pack2(h[2], h[3]); o.z = pack2(h[4], h[5]); o.w = pack2(h[6], h[7]);
                    *(uint4*)(H1 + (size_t)(off + pos) * 512 + ct * 128 + wc * 32 + fq * 8) = o;
                }
            }
    }
};
struct EpiMoeDown {
    static constexpr bool PERM = false, AFTER_DRAIN = false;
    bf16_t* Y; const float* lwc; MoeOrder S;
    __device__ __forceinline__ void operator()(const pg8::f32x4 (&acc)[2][2][4][2], const pg8::Unit& u, int wr, int wc, int fr, int fq) const {
        int e, rt, ct, half; S.locate(u.pm, e, rt, ct, half);
        const int off = S.s_off[e], cnt = S.s_off[e + 1] - off;
#pragma unroll
        for (int ai = 0; ai < 2; ++ai)
#pragma unroll
            for (int m = 0; m < 4; ++m) {
                const int rl_ = ai * 128 + wr * 64 + m * 16 + fr, pos = rt * 256 + rl_;
                if (pos < cnt) {
                    const float w = lwc[u.pm * 256 + rl_];
                    bf16_t* dst = Y + (size_t)(off + pos) * 1024 + ct * 256 + wc * 32 + fq * 8;
#pragma unroll
                    for (int bj = 0; bj < 2; ++bj) {
                        const pg8::f32x4 a = acc[ai][bj][m][0], bb = acc[ai][bj][m][1];
                        uint4 o; o.x = pack2(w * a[0], w * a[1]); o.y = pack2(w * a[2], w * a[3]); o.z = pack2(w * bb[0], w * bb[1]); o.w = pack2(w * bb[2], w * bb[3]);
                        *(uint4*)(dst + bj * 128) = o;
                    }
                }
            }
    }
};

template <bool DOWN>
__device__ __forceinline__ void phase_moe8(const Params& p, const Ctx& cx, char* lds, int layer) {
    const int tid = cx.tid;
    int* s_off = (int*)(lds + LDS_TAB_OFF); int* s_toff = s_off + 17; int* s_hoff = s_toff + 17;
    moe_tables(p, layer, tid, s_off, s_toff, s_hoff);
    const int ntiles = s_toff[16] + s_hoff[16];
    const int vb = cx.vbid, G = cx.G;
    MoeOrder S{s_off, s_toff, s_hoff, ntiles, vb, G};
    const int* ltok = (const int*)(p.ws + OFF_LTOK);
    const float* lw = (const float*)(p.ws + OFF_LW);
    int* rowidx = (int*)(lds + LDS_ROWIDX_OFF);
    float* lwc = (float*)(lds + LDS_LW_OFF);
    const int my_tiles = min(8, vb < ntiles ? (ntiles - vb + G - 1) / G : 0);
    for (int i = tid; i < my_tiles * 256; i += NTHR) {
        const int j = i >> 8, r = i & 255; int e, rt, ct, half; S.locate(j, e, rt, ct, half);
        const int off = s_off[e], pos = min(rt * 256 + r, s_off[e + 1] - off - 1);
        if constexpr (DOWN) { rowidx[i] = off + pos; lwc[i] = lw[(size_t)e * NTOK + pos]; }
        else rowidx[i] = ltok[(size_t)e * NTOK + pos];
    }
    __syncthreads();
    const PG8_LAS int* rows = (const PG8_LAS int*)((PG8_LAS unsigned char*)lds + LDS_ROWIDX_OFF);
    if constexpr (DOWN) {
        pg8::Gemm g{(const bf16_t*)(p.ws + OFF_H1), (const bf16_t*)(p.ws + OFF_W_DN) + (size_t)layer * 16 * 1024 * 512, 0, 0, 512};
        EpiMoeDown E{(bf16_t*)(p.ws + OFF_Y), lwc, S};
        pg8::gemm_phase_rows<EpiMoeDown, MoeOrder>((PG8_LAS unsigned char*)lds, g, S, E, rows);
    } else {
        pg8::Gemm g{(const bf16_t*)(p.ws + OFF_HA), (const bf16_t*)(p.ws + OFF_W_UP) + (size_t)layer * 16 * 1024 * 1024, 0, 0, 1024};
        EpiMoeUp E{(bf16_t*)(p.ws + OFF_H1), S};
        pg8::gemm_phase_rows<EpiMoeUp, MoeOrder>((PG8_LAS unsigned char*)lds, g, S, E, rows);
    }
}

__device__ __forceinline__ void phase_outproj8(const Params& p, const Ctx& cx, char* lds, const bf16_t* A, const bf16_t* Bt, const float* xin, int ls) {
    pg8::Gemm g{A, Bt, NTOK, 1024, 1024};
    pg8::StaticOrder S; S.init(NTOK, 1024, cx.G, (int)blockIdx.x);
    EpiOutProj E{(const float*)(p.ws + OFF_MOD), xin, p.out, ls};
    __syncthreads();
    pg8::gemm_phase<EpiOutProj, pg8::StaticOrder, true, PG8_SP2>((PG8_LAS unsigned char*)lds, g, S, E);
    __syncthreads();
}

__device__ __forceinline__ void phase_hgrn_inproj8(const Params& p, const Ctx& cx, char* lds) {
    pg8::Gemm g{(const bf16_t*)(p.ws + OFF_HA), (const bf16_t*)(p.ws + OFF_W_HG_IN), NTOK, 4096, 1024};
    pg8::StaticOrder S; S.init(NTOK, 4096, cx.G, (int)blockIdx.x);
    EpiHgrnIn E{p.ws, (const float*)(p.ws + OFF_LB)};
    __syncthreads();
    pg8::gemm_phase<EpiHgrnIn, pg8::StaticOrder, true, PG8_SP2>((PG8_LAS unsigned char*)lds, g, S, E);
    __syncthreads();
}

template <int MODE = 0>
__device__ __forceinline__ void phase_hgrn_inproj(const Params& p, const Ctx& cx, char* lds) {
    const bf16_t* A = (const bf16_t*)(p.ws + OFF_HA);
    const bf16_t* Bt = (const bf16_t*)(p.ws + OFF_W_HG_IN);
    char* ws = p.ws;
    const float* lb = (const float*)(p.ws + OFF_LB);
    gemm_phase_dense2(A, 1024, Bt, 1024, NTOK / 256, 16, lds, cx, [=](int row0, int col0) {
        return [=](f32x4 (&acc)[8][4], int wr, int wc, int fr, int fq) {
            const int gc0 = col0 + wc * 64, seg = gc0 >> 10, c0 = gc0 & 1023;
#pragma unroll
            for (int m = 0; m < 8; ++m) {
                const int row = row0 + wr * 128 + m * 16 + fr;
#pragma unroll
                for (int pp = 0; pp < 2; ++pp) {
                    const int c = c0 + pp * 32 + fq * 8;
                    float h[8];
                    if (seg == 1) {
                        const f32x4 la = *(const f32x4*)(lb + c), lbb = *(const f32x4*)(lb + c + 4);
#pragma unroll
                        for (int j = 0; j < 4; ++j) {
                            h[j] = __logf(la[j] + (1.f - la[j]) * sigmoid_f(acc[m][2 * pp][j]));
                            h[4 + j] = __logf(lbb[j] + (1.f - lbb[j]) * sigmoid_f(acc[m][2 * pp + 1][j]));
                        }
                        uint4 oh; oh.x = packh2(h[0], h[1]); oh.y = packh2(h[2], h[3]); oh.z = packh2(h[4], h[5]); oh.w = packh2(h[6], h[7]);
                        *(uint4*)((unsigned short*)(ws + OFF_LF) + (size_t)row * 1024 + c) = oh;
                    } else {
#pragma unroll
                        for (int j = 0; j < 4; ++j) {
                            h[j] = (seg == 2) ? acc[m][2 * pp][j] : silu_f(acc[m][2 * pp][j]);
                            h[4 + j] = (seg == 2) ? acc[m][2 * pp + 1][j] : silu_f(acc[m][2 * pp + 1][j]);
                        }
                        uint4 o; o.x = pack2(h[0], h[1]); o.y = pack2(h[2], h[3]); o.z = pack2(h[4], h[5]); o.w = pack2(h[6], h[7]);
                        bf16_t* dst = (bf16_t*)(ws + (seg == 0 ? OFF_QH : seg == 2 ? OFF_V : OFF_G));
                        *(uint4*)(dst + (size_t)row * 1024 + c) = o;
                    }
                }
            }
        };
    });
}

constexpr int HG_QD_OFF = 0, HG_KD_OFF = 8704, HG_K2T_OFF = 17408, HG_VT_OFF = 27648, HG_DEC_OFF = 37888, HG_BUF = 38400, HG_TOT_OFF = 2 * HG_BUF;
constexpr int HG_ROW = 272, HG_TROW = 80;
static_assert(HG_TOT_OFF + 2048 <= LDS_TAB_OFF, "hgrn LDS");

__device__ __forceinline__ void phase_hgrn_rec(const Params& p, const Ctx& cx, char* lds) {
    const int lane = cx.lane;
    const int l31 = lane & 31, h2 = lane >> 5;
    const int widu = __builtin_amdgcn_readfirstlane(cx.wid);
    const bool producer = widu >= 4;
    const int pw = widu & 3;
    const int d0 = 2 * lane;
    const bf16_t* QH = (const bf16_t*)(p.ws + OFF_QH);
    const unsigned short* LF = (const unsigned short*)(p.ws + OFF_LF);
    const bf16_t* V = (const bf16_t*)(p.ws + OFF_V);
    bf16_t* OR = (bf16_t*)(p.ws + OFF_HA);
    float* tot = (float*)(lds + HG_TOT_OFF);
    for (int item = blockIdx.x; item < 128; item += cx.G) {
        const int b = item >> 3, h = item & 7;
        f32x16 S0, S1, S2, S3;
#pragma unroll
        for (int r = 0; r < 16; ++r) { S0[r] = 0.f; S1[r] = 0.f; S2[r] = 0.f; S3[r] = 0.f; }
        unsigned lfA[8], lfB[8], qv[8], vv[8];
        const size_t gbase = (size_t)(b * SEQ + pw * 8) * 1024 + h * 128;
        if (producer) {
#pragma unroll
            for (int i = 0; i < 8; ++i) {
                lfA[i] = *(const unsigned*)(LF + gbase + (size_t)i * 1024 + d0);
                qv[i] = *(const unsigned*)(QH + gbase + (size_t)i * 1024 + d0);
                vv[i] = *(const unsigned*)(V + gbase + (size_t)i * 1024 + d0);
            }
#pragma unroll
            for (int i = 0; i < 8; ++i) lfB[i] = *(const unsigned*)(LF + gbase + (size_t)(32 + i) * 1024 + d0);
        }
        __syncthreads();
        for (int c = 0; c <= SEQ / 32; ++c) {
            unsigned lf[8];
#pragma unroll
            for (int i = 0; i < 8; ++i) lf[i] = (c & 1) ? lfB[i] : lfA[i];
            f2_t run = {0.f, 0.f};
            if (producer && c < SEQ / 32) {
#pragma unroll
                for (int i = 0; i < 8; ++i) run += unpackh2(lf[i]);
                *(f2_t*)(tot + pw * 128 + d0) = run;
            }
            __syncthreads();
            if (producer) {
                if (c < SEQ / 32) {
                    char* bufp = lds + (c & 1) * HG_BUF;
                    f2_t pre = {0.f, 0.f}, last = {0.f, 0.f};
#pragma unroll
                    for (int q = 0; q < 4; ++q) {
                        const f2_t tq_ = *(const f2_t*)(tot + q * 128 + d0);
                        last += tq_;
                        if (q < pw) pre += tq_;
                    }
                    if (pw == 0) { f2_t dv; dv.x = __expf(last.x); dv.y = __expf(last.y); *(f2_t*)(bufp + HG_DEC_OFF + d0 * 4) = dv; }
                    float k2a[8], k2b[8];
                    f2_t rc = pre;
#pragma unroll
                    for (int i = 0; i < 8; ++i) {
                        const f2_t lfi = unpackh2(lf[i]);
                        rc += lfi;
                        const float cu0 = rc.x, cu1 = rc.y;
                        const float kk0 = 1.f - __expf(lfi.x), kk1 = 1.f - __expf(lfi.y);
                        const float q0 = bf2f((unsigned short)(qv[i] & 0xffff)) * __expf(cu0), q1 = bf2f((unsigned short)(qv[i] >> 16)) * __expf(cu1);
                        const float kd0 = kk0 * __expf(-cu0), kd1 = kk1 * __expf(-cu1);
                        k2a[i] = kk0 * __expf(last.x - cu0); k2b[i] = kk1 * __expf(last.y - cu1);
                        const int tl = pw * 8 + i;
                        *(unsigned*)(bufp + HG_QD_OFF + tl * HG_ROW + d0 * 2) = pack2(q0, q1);
                        *(unsigned*)(bufp + HG_KD_OFF + tl * HG_ROW + d0 * 2) = pack2(kd0, kd1);
                    }
                    uint4 a, bq, va, vb;
                    a.x = pack2(k2a[0], k2a[1]); a.y = pack2(k2a[2], k2a[3]); a.z = pack2(k2a[4], k2a[5]); a.w = pack2(k2a[6], k2a[7]);
                    bq.x = pack2(k2b[0], k2b[1]); bq.y = pack2(k2b[2], k2b[3]); bq.z = pack2(k2b[4], k2b[5]); bq.w = pack2(k2b[6], k2b[7]);
                    va.x = (vv[0] & 0xffffu) | (vv[1] << 16); va.y = (vv[2] & 0xffffu) | (vv[3] << 16); va.z = (vv[4] & 0xffffu) | (vv[5] << 16); va.w = (vv[6] & 0xffffu) | (vv[7] << 16);
                    vb.x = (vv[0] >> 16) | (vv[1] & 0xffff0000u); vb.y = (vv[2] >> 16) | (vv[3] & 0xffff0000u); vb.z = (vv[4] >> 16) | (vv[5] & 0xffff0000u); vb.w = (vv[6] >> 16) | (vv[7] & 0xffff0000u);
                    *(uint4*)(bufp + HG_K2T_OFF + d0 * HG_TROW + pw * 16) = a;
                    *(uint4*)(bufp + HG_K2T_OFF + (d0 + 1) * HG_TROW + pw * 16) = bq;
                    *(uint4*)(bufp + HG_VT_OFF + d0 * HG_TROW + pw * 16) = va;
                    *(uint4*)(bufp + HG_VT_OFF + (d0 + 1) * HG_TROW + pw * 16) = vb;
                    __builtin_amdgcn_sched_barrier(0);
                    if (c + 1 < SEQ / 32) {
                        const size_t gn = gbase + (size_t)(c + 1) * 32 * 1024;
#pragma unroll
                        for (int i = 0; i < 8; ++i) {
                            qv[i] = *(const unsigned*)(QH + gn + (size_t)i * 1024 + d0);
                            vv[i] = *(const unsigned*)(V + gn + (size_t)i * 1024 + d0);
                        }
                    }
                    if (c + 2 < SEQ / 32) {
                        const size_t gn = gbase + (size_t)(c + 2) * 32 * 1024;
                        if (c & 1) {
#pragma unroll
                            for (int i = 0; i < 8; ++i) lfB[i] = *(const unsigned*)(LF + gn + (size_t)i * 1024 + d0);
                        } else {
#pragma unroll
                            for (int i = 0; i < 8; ++i) lfA[i] = *(const unsigned*)(LF + gn + (size_t)i * 1024 + d0);
                        }
                    }
                }
            } else if (c >= 1) {
                const int cc = c - 1;
                const char* bufp = lds + (cc & 1) * HG_BUF;
                const float* dec = (const float*)(bufp + HG_DEC_OFF);
                f32x16 X;
#pragma unroll
                for (int r = 0; r < 16; ++r) X[r] = 0.f;
                {
                    const char* ka = bufp + HG_KD_OFF + l31 * HG_ROW + 16 * h2;
                    const char* qa = bufp + HG_QD_OFF + l31 * HG_ROW + 16 * h2;
#pragma unroll 2
                    for (int ks = 0; ks < 8; ++ks) X = MFMA32(*(const bf16x8*)(ka + 32 * ks), *(const bf16x8*)(qa + 32 * ks), X);
#pragma unroll
                    for (int r = 0; r < 16; ++r) { const int srow = (r & 3) + 8 * (r >> 2) + 4 * h2; X[r] = (srow <= l31) ? X[r] : 0.f; }
                }
                f32x16 Oa;
#pragma unroll
                for (int r = 0; r < 16; ++r) Oa[r] = 0.f;
                const int jrow = 32 * pw + l31;
#pragma unroll
                for (int s2 = 0; s2 < 2; ++s2) {
                    uint4 xk;
                    xk.x = pack2(X[8 * s2], X[8 * s2 + 1]); xk.y = pack2(X[8 * s2 + 2], X[8 * s2 + 3]); xk.z = pack2(X[8 * s2 + 4], X[8 * s2 + 5]); xk.w = pack2(X[8 * s2 + 6], X[8 * s2 + 7]);
                    const char* va = bufp + HG_VT_OFF + jrow * HG_TROW + (16 * s2 + 4 * h2) * 2;
                    const uint2 lo = *(const uint2*)va, hi = *(const uint2*)(va + 16);
                    uint4 vb; vb.x = lo.x; vb.y = lo.y; vb.z = hi.x; vb.w = hi.y;
                    Oa = MFMA32(__builtin_bit_cast(bf16x8, xk), __builtin_bit_cast(bf16x8, vb), Oa);
                }
                auto qs_term = [&](const f32x16& St, int dt) {
#pragma unroll
                    for (int s2 = 0; s2 < 2; ++s2) {
                        uint4 sk;
                        sk.x = pack2(St[8 * s2], St[8 * s2 + 1]); sk.y = pack2(St[8 * s2 + 2], St[8 * s2 + 3]); sk.z = pack2(St[8 * s2 + 4], St[8 * s2 + 5]); sk.w = pack2(St[8 * s2 + 6], St[8 * s2 + 7]);
                        const char* qa = bufp + HG_QD_OFF + l31 * HG_ROW + (32 * dt + 16 * s2 + 4 * h2) * 2;
                        const uint2 lo = *(const uint2*)qa, hi = *(const uint2*)(qa + 16);
                        uint4 qb; qb.x = lo.x; qb.y = lo.y; qb.z = hi.x; qb.w = hi.y;
                        Oa = MFMA32(__builtin_bit_cast(bf16x8, qb), __builtin_bit_cast(bf16x8, sk), Oa);
                    }
                };
                __builtin_amdgcn_sched_barrier(0);
                qs_term(S0, 0); qs_term(S1, 1);
                __builtin_amdgcn_sched_barrier(0);
                qs_term(S2, 2); qs_term(S3, 3);
                __builtin_amdgcn_sched_barrier(0);
                {
                    bf16_t* orow = OR + (size_t)(b * SEQ + cc * 32 + 4 * h2) * 1024 + h * 128 + jrow;
#pragma unroll
                    for (int r = 0; r < 16; ++r) orow[(size_t)((r & 3) + 8 * (r >> 2)) * 1024] = f2bf(Oa[r]);
                }
                auto s_update = [&](f32x16& St, int dt) {
#pragma unroll
                    for (int rq = 0; rq < 4; ++rq) {
                        const f32x4 dc = *(const f32x4*)(dec + 32 * dt + 8 * rq + 4 * h2);
                        St[4 * rq] *= dc[0]; St[4 * rq + 1] *= dc[1]; St[4 * rq + 2] *= dc[2]; St[4 * rq + 3] *= dc[3];
                    }
#pragma unroll
                    for (int s2 = 0; s2 < 2; ++s2) {
                        const bf16x8 ka = *(const bf16x8*)(bufp + HG_K2T_OFF + (32 * dt + l31) * HG_TROW + (16 * s2 + 8 * h2) * 2);
                        const bf16x8 vb = *(const bf16x8*)(bufp + HG_VT_OFF + jrow * HG_TROW + (16 * s2 + 8 * h2) * 2);
                        St = MFMA32(ka, vb, St);
                    }
                };
                __builtin_amdgcn_sched_barrier(0);
                s_update(S0, 0); s_update(S1, 1);
                __builtin_amdgcn_sched_barrier(0);
                s_update(S2, 2); s_update(S3, 3);
                __builtin_amdgcn_sched_barrier(0);
            }
            __syncthreads();
        }
    }
}

__device__ __forceinline__ void phase_hgrn_post(const Params& p, const Ctx& cx) {
    const int lane = cx.lane;
    const bf16_t* OR = (const bf16_t*)(p.ws + OFF_HA);
    const bf16_t* Gt = (const bf16_t*)(p.ws + OFF_G);
    bf16_t* OA = (bf16_t*)(p.ws + OFF_QH);
    const int col = lane * 16;
    float gn[16];
#pragma unroll
    for (int i = 0; i < 16; ++i) gn[i] = p.hgrn_out_gain[(col & 127) + i];
    for (int row = cx.vbid * NWAVE + cx.wid; row < NTOK; row += cx.G * NWAVE) {
        const uint4 a0 = *(const uint4*)(OR + (size_t)row * 1024 + col), a1 = *(const uint4*)(OR + (size_t)row * 1024 + col + 8);
        const uint4 g0 = *(const uint4*)(Gt + (size_t)row * 1024 + col), g1 = *(const uint4*)(Gt + (size_t)row * 1024 + col + 8);
        const unsigned aw[8] = {a0.x, a0.y, a0.z, a0.w, a1.x, a1.y, a1.z, a1.w};
        const unsigned gw[8] = {g0.x, g0.y, g0.z, g0.w, g1.x, g1.y, g1.z, g1.w};
        float o[16];
        float ss = 0.f;
#pragma unroll
        for (int i = 0; i < 8; ++i) { o[2 * i] = bf2f((unsigned short)(aw[i] & 0xffff)); o[2 * i + 1] = bf2f((unsigned short)(aw[i] >> 16)); ss += o[2 * i] * o[2 * i] + o[2 * i + 1] * o[2 * i + 1]; }
        ss += __shfl_xor(ss, 1); ss += __shfl_xor(ss, 2); ss += __shfl_xor(ss, 4);
        const float r = rsqrtf(ss * (1.f / 128.f) + EPS);
        unsigned w[8];
#pragma unroll
        for (int i = 0; i < 8; ++i)
            w[i] = pack2(o[2 * i] * r * gn[2 * i] * bf2f((unsigned short)(gw[i] & 0xffff)), o[2 * i + 1] * r * gn[2 * i + 1] * bf2f((unsigned short)(gw[i] >> 16)));
        uint4 o0, o1; o0.x = w[0]; o0.y = w[1]; o0.z = w[2]; o0.w = w[3]; o1.x = w[4]; o1.y = w[5]; o1.z = w[6]; o1.w = w[7];
        *(uint4*)(OA + (size_t)row * 1024 + col) = o0;
        *(uint4*)(OA + (size_t)row * 1024 + col + 8) = o1;
    }
}


#define XB_TMO      128
#define XB_XCNT(j)  (256  + 64 * (j))
#define XB_XSUB(j)  (1280 + 64 * (j))
#define XB_XGEN(j)  (2304 + 64 * (j))
#define XB_TOP      3328
#define XB_TOPGEN   3392
#define XCD_BAR_WORDS 3456
#define XB_SPIN_CAP (1u << 20)
#define LAS __attribute__((address_space(3)))
__device__ __forceinline__ unsigned xb_ld(unsigned* p)              { return __hip_atomic_load(p, __ATOMIC_RELAXED, __HIP_MEMORY_SCOPE_AGENT); }
__device__ __forceinline__ unsigned xb_add(unsigned* p, unsigned v) { return __hip_atomic_fetch_add(p, v, __ATOMIC_RELAXED, __HIP_MEMORY_SCOPE_AGENT); }
__device__ __forceinline__ unsigned xb_xcc_id() { return (unsigned)__builtin_amdgcn_s_getreg((3 << 11) | 20) & 0xFu; }
#define XB_SPIN(cond, bar) do { unsigned _sp = 0; while (cond) { __builtin_amdgcn_s_sleep(1); \
    if ((++_sp & 255u) == 0u) { if (xb_ld(&(bar)[XB_TMO])) break; if (_sp > XB_SPIN_CAP) { atomicAdd(&(bar)[XB_TMO], 1u); break; } } } } while (0)
struct XcdBarrier { unsigned* bar; unsigned x; volatile unsigned* st; };
__device__ __forceinline__ XcdBarrier xcd_barrier_post(unsigned* bar, volatile unsigned* st) {
    XcdBarrier b; b.bar = bar; b.x = xb_xcc_id(); b.st = st;
    if (threadIdx.x == 0) (void)xb_add(&bar[XB_XCNT(b.x)], 1u);
    return b;
}
__device__ __forceinline__ void xcd_barrier_complete(unsigned* bar, unsigned x, unsigned& nloc, unsigned& nx) {
    const unsigned G = gridDim.x * gridDim.y * gridDim.z;
    unsigned sum, cnt, mine, sp = 0u;
    for (;;) {
        sum = 0u; cnt = 0u; mine = 0u;
#pragma unroll
        for (unsigned j = 0; j < 16; ++j) { const unsigned c = xb_ld(&bar[XB_XCNT(j)]); sum += c; cnt += (c > 0u) ? 1u : 0u; mine = (j == x) ? c : mine; }
        if (sum == G) break;
        __builtin_amdgcn_s_sleep(1);
        if ((++sp & 255u) == 0u) { if (xb_ld(&bar[XB_TMO])) break; if (sp > XB_SPIN_CAP) { atomicAdd(&bar[XB_TMO], 1u); break; } }
    }
    nloc = mine > 0u ? mine : 1u; nx = cnt > 0u ? cnt : 1u;
}
__device__ __forceinline__ void xcd_barrier(const XcdBarrier& b) {
    asm volatile("s_waitcnt vmcnt(0)" ::: "memory");
    __syncthreads();
    if (threadIdx.x == 0) {
        unsigned* bar = b.bar;
        __builtin_amdgcn_s_waitcnt(0);
        unsigned nloc = b.st[0], nx = b.st[1];
        if (nloc == 0u) { xcd_barrier_complete(bar, b.x, nloc, nx); b.st[0] = nloc; b.st[1] = nx; }
        const unsigned old = xb_add(&bar[XB_XSUB(b.x)], 1u);
        const unsigned gen = old / nloc;
        if (old + 1u == (gen + 1u) * nloc) {
            __builtin_amdgcn_fence(__ATOMIC_RELEASE, "agent");
            asm volatile("s_waitcnt vmcnt(0)" ::: "memory");
            const unsigned og = xb_add(&bar[XB_TOP], 1u);
            const unsigned tg = og / nx;
            if (og + 1u == (tg + 1u) * nx) xb_add(&bar[XB_TOPGEN], 1u);
            else XB_SPIN(xb_ld(&bar[XB_TOPGEN]) == tg, bar);
            __builtin_amdgcn_fence(__ATOMIC_ACQUIRE, "agent");
            xb_add(&bar[XB_XGEN(b.x)], 1u);
            asm volatile("s_waitcnt vmcnt(0)" ::: "memory");
        } else {
            XB_SPIN(xb_ld(&bar[XB_XGEN(b.x)]) == gen, bar);
            __builtin_amdgcn_fence(__ATOMIC_ACQUIRE, "agent");
            asm volatile("s_waitcnt vmcnt(0)" ::: "memory");
        }
    }
    __syncthreads();
}

template <int PH>
__device__ __forceinline__ void run_phase(const Params& p, const Ctx& cx, char* lds) {
    if constexpr (PH == 0) phase0(p, cx, lds);
    else if constexpr (PH == 1) rows_phase<false, true, false>(p, cx, lds, p.x, nullptr, 0, 0, 0, 0);
    else if constexpr (PH == 2) phase_nsa_inproj(p, cx, lds);
    else if constexpr (PH == 3) {
        phase_cmp1(p, cx, lds);
        const int w = cx.vbid >= 64 ? cx.vbid - 64 : -1, nw = cx.G - 64;
        transpose_range(p, lds, cx.tid, w, nw, TC2, TC4);
        transpose_range(p, lds, cx.tid, w, nw, TC5, TC_UP1);
        transpose_range(p, lds, cx.tid, w, nw, TC6, TC_DN1);
    }
    else if constexpr (PH == 4) phase_cmp2(p, cx);
    else if constexpr (PH == 5) phase_attn(p, cx, lds);
    else if constexpr (PH == 6) phase_outproj8(p, cx, lds, (const bf16_t*)(p.ws + OFF_HA), (const bf16_t*)(p.ws + OFF_W_NSA_OUT), p.x, 0);
    else if constexpr (PH == 7) rows_router_phase(p, cx, lds, p.out, 1, 0);
    else if constexpr (PH == 8) phase_moe8<false>(p, cx, lds, 0);
    else if constexpr (PH == 9) phase_moe8<true>(p, cx, lds, 0);
    else if constexpr (PH == 10) { float* xo = p.out; asm volatile("" : "+s"(xo)); rows_phase<true, true, false>(p, cx, lds, xo, xo, 1, 2, 0, 0); }
    else if constexpr (PH == 11) phase_hgrn_inproj8(p, cx, lds);
    else if constexpr (PH == 12) {
        phase_hgrn_rec(p, cx, lds);
        const int w = (int)blockIdx.x >= 128 ? (int)blockIdx.x - 128 : -1, nw = cx.G - 128;
        transpose_range(p, lds, cx.tid, w, nw, TC_UP1, TC6);
        transpose_range(p, lds, cx.tid, w, nw, TC_DN1, TC_END);
    }
    else if constexpr (PH == 13) phase_hgrn_post(p, cx);
    else if constexpr (PH == 14) phase_outproj8(p, cx, lds, (const bf16_t*)(p.ws + OFF_QH), (const bf16_t*)(p.ws + OFF_W_HG_OUT), p.out, 2);
    else if constexpr (PH == 15) rows_router_phase(p, cx, lds, p.out, 3, 1);
    else if constexpr (PH == 16) phase_moe8<false>(p, cx, lds, 1);
    else if constexpr (PH == 17) phase_moe8<true>(p, cx, lds, 1);
    else if constexpr (PH == 18) { float* xo = p.out; asm volatile("" : "+s"(xo)); rows_phase<true, false, false>(p, cx, lds, xo, xo, 3, 0, 0, 1); }
}

__device__ __forceinline__ Ctx make_ctx() {
    Ctx cx;
    cx.G = gridDim.x; cx.tid = threadIdx.x; cx.wid = threadIdx.x >> 6; cx.lane = threadIdx.x & 63;
    cx.vbid = (cx.G % 8 == 0) ? (blockIdx.x % 8) * (cx.G / 8) + blockIdx.x / 8 : blockIdx.x;
    return cx;
}

#if MULTI_LAUNCH
template <int PH>
__global__ void __launch_bounds__(NTHR, 2) phase_kernel(Params p) {
    extern __shared__ __attribute__((aligned(16))) char lds[];
    const Ctx cx = make_ctx();
    run_phase<PH>(p, cx, lds);
}
template <int PH>
static void launch_phases(const Params& p, int grid, hipStream_t stream) {
    (void)hipFuncSetAttribute((const void*)phase_kernel<PH>, hipFuncAttributeMaxDynamicSharedMemorySize, LDS_BYTES);
    hipLaunchKernelGGL(phase_kernel<PH>, dim3(grid), dim3(NTHR), LDS_BYTES, stream, p);
    if constexpr (PH + 1 < NPHASE) launch_phases<PH + 1>(p, grid, stream);
}
#else
template <int PH>
__device__ __forceinline__ void run_from(const Params& p, const Ctx& cx, char* lds, cg::grid_group& grid, const XcdBarrier& xb) {
    {
        int t_ = threadIdx.x, b_ = blockIdx.x;
        asm volatile("" : "+v"(t_), "+s"(b_));
        Ctx c2;
        c2.G = gridDim.x; c2.tid = t_; c2.wid = t_ >> 6; c2.lane = t_ & 63;
        c2.vbid = (c2.G % 8 == 0) ? (b_ % 8) * (c2.G / 8) + b_ / 8 : b_;
        run_phase<PH>(p, c2, lds);
#ifdef PROBE_MASK
        if constexpr ((PROBE_MASK >> PH) & 1) { xcd_barrier(xb); run_phase<PH>(p, c2, lds); }
#endif
    }
    if constexpr (PH + 1 < NPHASE) {
        if constexpr (PH == 0) grid.sync();
        else xcd_barrier(xb);
        run_from<PH + 1>(p, cx, lds, grid, xb);
    }
}
__global__ void __launch_bounds__(NTHR, 2) mega_kernel(Params p) {
    extern __shared__ __attribute__((aligned(16))) char lds[];
    cg::grid_group grid = cg::this_grid();
    const Ctx cx = make_ctx();
    volatile unsigned* st = (volatile unsigned*)(lds + LDS_BYTES - 16);
    if (threadIdx.x == 0) { st[0] = 0u; st[1] = 0u; }
    __syncthreads();
    const XcdBarrier xb = xcd_barrier_post((unsigned*)(p.ws + OFF_BAR), st);
    run_from<0>(p, cx, lds, grid, xb);
}
#endif

extern "C" void kernel_launch(void* const* d_in, const int* in_sizes, int n_in, void* d_out, int out_size, void* d_ws, size_t ws_size,
                              hipStream_t stream) {
    static int grid = 0;
    if (!grid) {
        int dev = 0, cus = 0, per_cu = 0;
        (void)hipGetDevice(&dev);
        (void)hipDeviceGetAttribute(&cus, hipDeviceAttributeMultiprocessorCount, dev);
#if MULTI_LAUNCH
        per_cu = 1;
#else
        (void)hipFuncSetAttribute((const void*)mega_kernel, hipFuncAttributeMaxDynamicSharedMemorySize, LDS_BYTES);
        (void)hipOccupancyMaxActiveBlocksPerMultiprocessor(&per_cu, mega_kernel, NTHR, LDS_BYTES);
        if (per_cu > 1) per_cu = 1;
        if (per_cu < 1) { fprintf(stderr, "kernel_launch: occupancy query says 0 blocks per CU (LDS %d B)\n", LDS_BYTES); per_cu = 1; }
#endif
        if (cus <= 0) cus = 256;
        grid = cus * per_cu;
        if (ws_size < WS_NEED) fprintf(stderr, "kernel_launch: workspace too small: %zu < %zu\n", ws_size, (size_t)WS_NEED);
    }
    Params p{};
    p.x = (const float*)d_in[0]; p.c = (const float*)d_in[1]; p.ada_w = (const float*)d_in[2]; p.ada_b = (const float*)d_in[3];
    p.norm_g = (const float*)d_in[4]; p.rel_bias = (const float*)d_in[5]; p.nsa_w_in = (const float*)d_in[6]; p.nsa_q_gain = (const float*)d_in[7];
    p.nsa_k_gain = (const float*)d_in[8]; p.nsa_cmp_pe = (const float*)d_in[9]; p.nsa_cmp_w1 = (const float*)d_in[10]; p.nsa_cmp_w2 = (const float*)d_in[11];
    p.nsa_w_out = (const float*)d_in[12]; p.hgrn_w_in = (const float*)d_in[13]; p.hgrn_lb = (const float*)d_in[14]; p.hgrn_out_gain = (const float*)d_in[15];
    p.hgrn_w_out = (const float*)d_in[16]; p.moe_rg = (const float*)d_in[17]; p.moe_re = (const float*)d_in[18]; p.moe_w1 = (const float*)d_in[19];
    p.moe_w3 = (const float*)d_in[20]; p.moe_w2 = (const float*)d_in[21];
    p.out = (float*)d_out; p.ws = (char*)d_ws;
#if MULTI_LAUNCH
    launch_phases<0>(p, grid, stream);
#else
    p.p_begin = 0; p.p_end = NPHASE;
    (void)hipMemsetAsync((char*)d_ws + OFF_BAR, 0, XCD_BAR_WORDS * 4, stream);
    void* args[] = {&p};
    hipError_t e = hipLaunchCooperativeKernel((void*)mega_kernel, dim3(grid), dim3(NTHR), args, LDS_BYTES, stream);
    if (e != hipSuccess) fprintf(stderr, "cooperative launch failed: %s (grid %d)\n", hipGetErrorString(e), grid);
#endif
}
```

```cpp
#include <hip/hip_runtime.h>
#include <hip/hip_cooperative_groups.h>
#include <cstdio>
#include <cstdint>
namespace cg = cooperative_groups;

#ifndef MULTI_LAUNCH
#define MULTI_LAUNCH 0
#endif

typedef unsigned short bf16_t;
typedef short bf16x8 __attribute__((ext_vector_type(8)));
typedef float f32x4 __attribute__((ext_vector_type(4)));
typedef float f32x16 __attribute__((ext_vector_type(16)));

constexpr int NTOK = 32768, DM = 1024, SEQ = 2048, NBATCH = 16;
constexpr int NSA_IN = 2608, NSA_IN_PAD = 2816;
constexpr float EPS = 1e-6f;
constexpr size_t MiB = 1ull << 20;

constexpr size_t OFF_CNT = 0;
constexpr size_t OFF_MOD = 4096;
constexpr size_t OFF_LB = OFF_MOD + 786432;
constexpr size_t OFF_PEB = OFF_LB + 4096;
constexpr size_t OFF_BAR = 921600;
constexpr size_t OFF_W_NSA_IN = 1 * MiB;
constexpr size_t OFF_W_NSA_OUT = OFF_W_NSA_IN + 2816ull * 1024 * 2;
constexpr size_t OFF_W_HG_IN = OFF_W_NSA_OUT + 1024ull * 1024 * 2;
constexpr size_t OFF_W_HG_OUT = OFF_W_HG_IN + 4096ull * 1024 * 2;
constexpr size_t OFF_W_CMP1 = OFF_W_HG_OUT + 1024ull * 1024 * 2;
constexpr size_t OFF_W_UP = OFF_W_CMP1 + 2ull * 128 * 2048 * 2;
constexpr size_t OFF_W_DN = OFF_W_UP + 32ull * 1024 * 1024 * 2;
constexpr size_t OFF_W_END = OFF_W_DN + 32ull * 1024 * 512 * 2;
constexpr size_t OFF_HA = 116 * MiB;
static_assert(OFF_W_END <= OFF_HA, "weights overflow");
constexpr size_t OFF_SCR = 180 * MiB;
constexpr size_t OFF_Q = OFF_SCR;
constexpr size_t OFF_KCRAW = OFF_Q + 64 * MiB;
constexpr size_t OFF_VCRAW = OFF_KCRAW + 17 * MiB;
constexpr size_t OFF_KS = OFF_VCRAW + 17 * MiB;
constexpr size_t OFF_VS = OFF_KS + 16 * MiB;
constexpr size_t OFF_KW = OFF_VS + 16 * MiB;
constexpr size_t OFF_VW = OFF_KW + 16 * MiB;
constexpr size_t OFF_GATES = OFF_VW + 16 * MiB;
constexpr size_t OFF_T1 = OFF_GATES + 6 * MiB;
constexpr size_t OFF_KC = OFF_T1 + 4 * MiB;
constexpr size_t OFF_VC = OFF_KC + 1 * MiB;
constexpr size_t OFF_H1 = OFF_SCR;
constexpr size_t OFF_Y = OFF_H1 + 64 * MiB;
constexpr size_t OFF_LTOK = OFF_Y + 128 * MiB;
constexpr size_t OFF_LW = OFF_LTOK + 2 * MiB;
constexpr size_t OFF_TSLOT = OFF_LW + 2 * MiB;
constexpr size_t OFF_QH = OFF_SCR;
constexpr size_t OFF_LF = OFF_QH + 64 * MiB;
constexpr size_t OFF_V = OFF_LF + 128 * MiB;
constexpr size_t OFF_G = OFF_V + 64 * MiB;
constexpr size_t WS_NEED = OFF_G + 64 * MiB;
static_assert(WS_NEED <= 512 * MiB, "ws overflow");

constexpr int NTHR = 512, NWAVE = 8;
constexpr int GEMM_STAGE = 49152, GEMM_NSTAGE = 3;
constexpr int LDS_TAB_OFF = GEMM_STAGE * GEMM_NSTAGE;
constexpr int LDS_BYTES = LDS_TAB_OFF + 256 + 16;
constexpr int NPHASE = 19;

struct Params {
    const float *x, *c, *ada_w, *ada_b, *norm_g, *rel_bias, *nsa_w_in, *nsa_q_gain, *nsa_k_gain, *nsa_cmp_pe, *nsa_cmp_w1,
        *nsa_cmp_w2, *nsa_w_out, *hgrn_w_in, *hgrn_lb, *hgrn_out_gain, *hgrn_w_out, *moe_rg, *moe_re, *moe_w1, *moe_w3, *moe_w2;
    float* out;
    char* ws;
    int p_begin, p_end;
};

__device__ __forceinline__ float bf2f(unsigned short h) { return __uint_as_float((unsigned)h << 16); }
__device__ __forceinline__ unsigned short f2bf(float f) {
    unsigned u = __float_as_uint(f);
    u += 0x7fffu + ((u >> 16) & 1u);
    return (unsigned short)(u >> 16);
}
typedef __bf16 bf2_t __attribute__((ext_vector_type(2)));
typedef float f2_t __attribute__((ext_vector_type(2)));
__device__ __forceinline__ unsigned pack2(float a, float b) {
    f2_t v = {a, b};
    return __builtin_bit_cast(unsigned, __builtin_convertvector(v, bf2_t));
}
typedef _Float16 h2_t __attribute__((ext_vector_type(2)));
__device__ __forceinline__ unsigned packh2(float a, float b) { f2_t v = {a, b}; return __builtin_bit_cast(unsigned, __builtin_convertvector(v, h2_t)); }
__device__ __forceinline__ f2_t unpackh2(unsigned u) { return __builtin_convertvector(__builtin_bit_cast(h2_t, u), f2_t); }
__device__ __forceinline__ float wave_sum(float v) {
#pragma unroll
    for (int o = 32; o; o >>= 1) v += __shfl_xor(v, o);
    return v;
}
__device__ __forceinline__ float wave_max(float v) {
#pragma unroll
    for (int o = 32; o; o >>= 1) v = fmaxf(v, __shfl_xor(v, o));
    return v;
}
__device__ __forceinline__ float silu_f(float x) { return x * __builtin_amdgcn_rcpf(1.f + __builtin_amdgcn_exp2f(-1.4426950408889634f * x)); }
__device__ __forceinline__ float sigmoid_f(float x) { return __builtin_amdgcn_rcpf(1.f + __builtin_amdgcn_exp2f(-1.4426950408889634f * x)); }
__device__ __forceinline__ void glds16(const void* g, void* l) {
    __builtin_amdgcn_global_load_lds((const unsigned*)g, (unsigned*)l, 16, 0, 0);
}
__device__ __forceinline__ int t5_bucket(int n) {
    if (n < 16) return n;
    int b = 16;
    b += (n >= 21); b += (n >= 27); b += (n >= 35); b += (n >= 46); b += (n >= 59); b += (n >= 77); b += (n >= 99); b += (n >= 128);
    b += (n >= 166); b += (n >= 216); b += (n >= 280); b += (n >= 363); b += (n >= 470); b += (n >= 609); b += (n >= 790);
    return b;
}

struct Ctx {
    int G, vbid, tid, wid, lane;
};

constexpr int P0_MOD_ITEMS = 192;
constexpr int TS0 = 88 * 16, TS1 = 32 * 16, TS2 = 128 * 16, TS3 = 32 * 16, TS4 = 2 * 4 * 32, TS5 = 32 * 32 * 16, TS6 = 32 * 32 * 8;
constexpr int TC0 = 0, TC1 = TC0 + TS0, TC2 = TC1 + TS1, TC3 = TC2 + TS2, TC4 = TC3 + TS3, TC5 = TC4 + TS4, TC6 = TC5 + TS5, TC_END = TC6 + TS6;

struct TrJob { const float* src; int ld, c0, ncols_valid, k0; bf16_t* dst; int dstld; int perm; };
__device__ __forceinline__ int pcol(int n, int fq) { return (n >> 1) * 32 + fq * 8 + (n & 1) * 4; }
__device__ __forceinline__ void tr_load(const TrJob& j, float* tl, int htid) {
    const int k = htid >> 2, cc = (htid & 3) * 8;
    const float* s = j.src + (size_t)(j.k0 + k) * j.ld + j.c0 + cc;
    f32x4 a = {0.f, 0.f, 0.f, 0.f}, c = a;
    if (j.c0 + 32 <= j.ncols_valid) { a = *(const f32x4*)s; c = *(const f32x4*)(s + 4); }
    else {
#pragma unroll
        for (int i = 0; i < 4; ++i) { if (j.c0 + cc + i < j.ncols_valid) a[i] = s[i]; if (j.c0 + cc + 4 + i < j.ncols_valid) c[i] = s[4 + i]; }
    }
#pragma unroll
    for (int i = 0; i < 4; ++i) { tl[k * 33 + cc + i] = a[i]; tl[k * 33 + cc + 4 + i] = c[i]; }
}
__device__ __forceinline__ void tr_store(const TrJob& j, const float* tl, int htid) {
    const int nsrc = htid >> 3, kc = (htid & 7) * 8;
    const int n = nsrc;
    const int nd = j.perm ? (((nsrc >> 2) & 1) * 16 + (nsrc >> 3) * 4 + (nsrc & 3)) : nsrc;
    uint4 o;
    o.x = pack2(tl[(kc + 0) * 33 + n], tl[(kc + 1) * 33 + n]); o.y = pack2(tl[(kc + 2) * 33 + n], tl[(kc + 3) * 33 + n]);
    o.z = pack2(tl[(kc + 4) * 33 + n], tl[(kc + 5) * 33 + n]); o.w = pack2(tl[(kc + 6) * 33 + n], tl[(kc + 7) * 33 + n]);
    *(uint4*)(j.dst + (size_t)nd * j.dstld + kc) = o;
}
__device__ __forceinline__ TrJob tr_job(const Params& p, int tt) {
    TrJob j;
    if (tt < TC1) {
        const int nt = tt / 16, kt = tt % 16;
        j = {p.nsa_w_in, NSA_IN, nt * 32, NSA_IN, kt * 64, (bf16_t*)(p.ws + OFF_W_NSA_IN) + (size_t)nt * 32 * 1024 + kt * 64, 1024, 1};
    } else if (tt < TC2) {
        const int u = tt - TC1, nt = u / 16, kt = u % 16;
        j = {p.nsa_w_out, 1024, nt * 32, 1024, kt * 64, (bf16_t*)(p.ws + OFF_W_NSA_OUT) + (size_t)nt * 32 * 1024 + kt * 64, 1024, 1};
    } else if (tt < TC3) {
        const int u = tt - TC2, nt = u / 16, kt = u % 16;
        j = {p.hgrn_w_in, 4096, nt * 32, 4096, kt * 64, (bf16_t*)(p.ws + OFF_W_HG_IN) + (size_t)nt * 32 * 1024 + kt * 64, 1024, 1};
    } else if (tt < TC4) {
        const int u = tt - TC3, nt = u / 16, kt = u % 16;
        j = {p.hgrn_w_out, 1024, nt * 32, 1024, kt * 64, (bf16_t*)(p.ws + OFF_W_HG_OUT) + (size_t)nt * 32 * 1024 + kt * 64, 1024, 1};
    } else if (tt < TC5) {
        const int u = tt - TC4, kv = u / 128, r = u % 128, nt = r / 32, kt = r % 32;
        j = {p.nsa_cmp_w1 + (size_t)kv * 2048 * 64, 64, nt * 32, 64, kt * 64, (bf16_t*)(p.ws + OFF_W_CMP1) + ((size_t)kv * 128 + nt * 32) * 2048 + kt * 64, 2048, 0};
    } else if (tt < TC6) {
        const int u = tt - TC5, le = u / 512, r = u % 512, gr = r / 16, kt = r % 16;
        const int ct = gr >> 3, which = (gr >> 2) & 1, sub = gr & 3;
        const float* src = (which ? p.moe_w3 : p.moe_w1) + (size_t)le * 1024 * 512;
        j = {src, 512, (ct * 4 + sub) * 32, 512, kt * 64, (bf16_t*)(p.ws + OFF_W_UP) + ((size_t)le * 1024 + gr * 32) * 1024 + kt * 64, 1024, 1};
    } else {
        const int u = tt - TC6, le = u / 256, r = u % 256, nt = r / 8, kt = r % 8;
        j = {p.moe_w2 + (size_t)le * 512 * 1024, 1024, nt * 32, 1024, kt * 64, (bf16_t*)(p.ws + OFF_W_DN) + ((size_t)le * 1024 + nt * 32) * 512 + kt * 64, 512, 1};
    }
    return j;
}

__device__ __forceinline__ void transpose_range(const Params& p, char* lds, int tid, int worker, int nworkers, int lo, int hi) {
    if (worker < 0) return;
    constexpr int TPH = 4;
    const int half = tid >> 8, htid = tid & 255;
    float* tl = (float*)lds + half * (TPH * 64 * 33);
    for (int base = lo + worker * 2 * TPH; base < hi; base += nworkers * 2 * TPH) {
#pragma unroll
        for (int q = 0; q < TPH; ++q) {
            const int tt = base + half * TPH + q;
            if (tt < hi) { const TrJob j = tr_job(p, tt); tr_load(j, tl + q * (64 * 33), htid); }
        }
        __syncthreads();
#pragma unroll
        for (int q = 0; q < TPH; ++q) {
            const int tt = base + half * TPH + q;
            if (tt < hi) { const TrJob j = tr_job(p, tt); tr_store(j, tl + q * (64 * 33), htid); }
        }
        __syncthreads();
    }
}
constexpr int TC_UP1 = TC5 + 16 * 512, TC_DN1 = TC6 + 16 * 256;

__device__ __forceinline__ void phase0(const Params& p, const Ctx& cx, char* lds) {
    const int tid = cx.tid, wid = cx.wid, lane = cx.lane;
    for (int it = cx.vbid; it < P0_MOD_ITEMS; it += cx.G) {
        const int colbase = it * 64, ls = colbase / 3072, e0 = colbase % 3072;
        const float* W = p.ada_w + (size_t)ls * 1024 * 3072 + e0 + lane;
        float* cs = (float*)lds + wid * 1024;
        float* red = (float*)lds + 8192;
        float acc[16];
#pragma unroll
        for (int b = 0; b < 16; ++b) acc[b] = 0.f;
        for (int sub = 0; sub < 2; ++sub) {
            const int kb = wid * 128 + sub * 64;
#pragma unroll
            for (int b = 0; b < 16; ++b) cs[lane * 16 + b] = silu_f(p.c[b * 1024 + kb + lane]);
            __builtin_amdgcn_wave_barrier();
#pragma unroll 1
            for (int k16 = 0; k16 < 64; k16 += 16) {
                float wv[16];
#pragma unroll
                for (int u = 0; u < 16; ++u) wv[u] = W[(size_t)(kb + k16 + u) * 3072];
#pragma unroll
                for (int u = 0; u < 16; ++u) {
                    const float w = wv[u];
                    const f32x4* cv = (const f32x4*)(cs + (k16 + u) * 16);
#pragma unroll
                    for (int q = 0; q < 4; ++q) {
                        f32x4 c4 = cv[q];
                        acc[q * 4 + 0] += c4[0] * w; acc[q * 4 + 1] += c4[1] * w; acc[q * 4 + 2] += c4[2] * w; acc[q * 4 + 3] += c4[3] * w;
                    }
                }
            }
            __builtin_amdgcn_wave_barrier();
        }
#pragma unroll
        for (int b = 0; b < 16; ++b) red[(wid * 16 + b) * 64 + lane] = acc[b];
        __syncthreads();
        float* mod = (float*)(p.ws + OFF_MOD);
#pragma unroll
        for (int i = 0; i < 2; ++i) {
            const int o = tid + i * NTHR, b = o >> 6, e = o & 63;
            float sm = 0.f;
#pragma unroll
            for (int w = 0; w < 8; ++w) sm += red[(w * 16 + b) * 64 + e];
            mod[((size_t)ls * 16 + b) * 3072 + e0 + e] = sm + p.ada_b[ls * 3072 + e0 + e];
        }
        __syncthreads();
    }
    transpose_range(p, lds, tid, cx.vbid, cx.G, TC0, TC2);
    transpose_range(p, lds, tid, cx.vbid, cx.G, TC4, TC5);
    if (cx.vbid == cx.G - 1) {
        float* lb = (float*)(p.ws + OFF_LB);
        for (int i = tid; i < 1024; i += NTHR) lb[i] = sigmoid_f(p.hgrn_lb[1024 + i] - p.hgrn_lb[i]);
        if (tid < 128) {
            const int kv = tid >> 6, d = tid & 63;
            const float* pe = p.nsa_cmp_pe + kv * 2048;
            const float* w1 = p.nsa_cmp_w1 + (size_t)kv * 2048 * 64 + d;
            float sm = 0.f;
            for (int k = 0; k < 2048; ++k) sm += pe[k] * w1[(size_t)k * 64];
            ((float*)(p.ws + OFF_PEB))[tid] = sm;
        }
        if (tid < 32) ((int*)(p.ws + OFF_CNT))[tid] = 0;
    }
}

template <bool COMBINE, bool NORM, bool ROUTER>
__device__ __forceinline__ void rows_phase(const Params& p, const Ctx& cx, char* lds, const float* __restrict__ src, float* __restrict__ xdst,
                           int ls_comb, int ls_norm, int layer_router, int layer_comb) {
    static_assert(!ROUTER, "router rows use rows_router_phase");
    const int lane = cx.lane;
    const float* mod = (const float*)(p.ws + OFF_MOD);
    int my_off = 0;
    if (COMBINE) {
        const int* cnt = (const int*)(p.ws + OFF_CNT) + layer_comb * 16;
        int cv[15];
#pragma unroll
        for (int e = 0; e < 15; ++e) cv[e] = cnt[e];
#pragma unroll
        for (int e = 0; e < 15; ++e) my_off += (e < lane) ? cv[e] : 0;
    }
    const int rpw = (NTOK + cx.G * NWAVE - 1) / (cx.G * NWAVE);
    const int row_begin = (cx.vbid * NWAVE + cx.wid) * rpw, row_end = min(NTOK, row_begin + rpw);
    if (row_begin >= row_end) return;
    const bf16_t* Y = (const bf16_t*)(p.ws + OFF_Y);
    const int* tsl = (const int*)(p.ws + OFF_TSLOT);
    bf16_t* hA = (bf16_t*)(p.ws + OFF_HA);
    const float* gain = p.norm_g + ls_norm * 1024;
    auto yrow = [&](int sw) -> size_t { return (size_t)(__shfl(my_off, sw >> 16) + (sw & 0xffff)) * 1024; };
    f32x4 vn[4];
    uint2 yan[4], ycn[4];
    int t0n = 0, t1n = 0;
#pragma unroll
    for (int i = 0; i < 4; ++i) vn[i] = *(const f32x4*)(src + (size_t)row_begin * 1024 + (i * 64 + lane) * 4);
    if (COMBINE) {
        const size_t ra = yrow(tsl[row_begin * 2]), rc = yrow(tsl[row_begin * 2 + 1]);
#pragma unroll
        for (int i = 0; i < 4; ++i) { yan[i] = *(const uint2*)(Y + ra + (i * 64 + lane) * 4); ycn[i] = *(const uint2*)(Y + rc + (i * 64 + lane) * 4); }
        if (row_begin + 1 < row_end) { t0n = tsl[(row_begin + 1) * 2]; t1n = tsl[(row_begin + 1) * 2 + 1]; }
    }
    f32x4 gt[4], ca[4], cb[4];
    int bcur = -1;
    for (int row = row_begin; row < row_end; ++row) {
        const int b = row >> 11;
        if (b != bcur) {
            bcur = b;
#pragma unroll
            for (int i = 0; i < 4; ++i) {
                const int col = (i * 64 + lane) * 4;
                if (COMBINE) gt[i] = *(const f32x4*)(mod + ((size_t)ls_comb * 16 + b) * 3072 + 2048 + col);
                if (NORM) {
                    const float* shift = mod + ((size_t)ls_norm * 16 + b) * 3072;
                    const f32x4 g = *(const f32x4*)(gain + col), sc = *(const f32x4*)(shift + 1024 + col);
                    ca[i] = g * (sc + 1.f);
                    cb[i] = *(const f32x4*)(shift + col);
                }
            }
        }
        f32x4 v[4];
        uint2 ya[4], yc[4];
#pragma unroll
        for (int i = 0; i < 4; ++i) { v[i] = vn[i]; if (COMBINE) { ya[i] = yan[i]; yc[i] = ycn[i]; } }
        if (row + 1 < row_end) {
#pragma unroll
            for (int i = 0; i < 4; ++i) vn[i] = *(const f32x4*)(src + (size_t)(row + 1) * 1024 + (i * 64 + lane) * 4);
            if (COMBINE) {
                const size_t ra = yrow(t0n), rc = yrow(t1n);
#pragma unroll
                for (int i = 0; i < 4; ++i) { yan[i] = *(const uint2*)(Y + ra + (i * 64 + lane) * 4); ycn[i] = *(const uint2*)(Y + rc + (i * 64 + lane) * 4); }
                if (row + 2 < row_end) { t0n = tsl[(row + 2) * 2]; t1n = tsl[(row + 2) * 2 + 1]; }
            }
        }
        if (COMBINE) {
#pragma unroll
            for (int i = 0; i < 4; ++i) {
                const int col = (i * 64 + lane) * 4;
                v[i][0] += gt[i][0] * (bf2f(ya[i].x & 0xffff) + bf2f(yc[i].x & 0xffff));
                v[i][1] += gt[i][1] * (bf2f(ya[i].x >> 16) + bf2f(yc[i].x >> 16));
                v[i][2] += gt[i][2] * (bf2f(ya[i].y & 0xffff) + bf2f(yc[i].y & 0xffff));
                v[i][3] += gt[i][3] * (bf2f(ya[i].y >> 16) + bf2f(yc[i].y >> 16));
                *(f32x4*)(xdst + (size_t)row * 1024 + col) = v[i];
            }
        }
        if (NORM) {
            float ss = 0.f;
#pragma unroll
            for (int i = 0; i < 4; ++i) ss += v[i][0] * v[i][0] + v[i][1] * v[i][1] + v[i][2] * v[i][2] + v[i][3] * v[i][3];
            ss = wave_sum(ss);
            const float r = rsqrtf(ss * (1.f / 1024.f) + EPS);
#pragma unroll
            for (int i = 0; i < 4; ++i) {
                const int col = (i * 64 + lane) * 4;
                f32x4 h;
#pragma unroll
                for (int j = 0; j < 4; ++j) h[j] = v[i][j] * r * ca[i][j] + cb[i][j];
                uint2 o; o.x = pack2(h[0], h[1]); o.y = pack2(h[2], h[3]);
                *(uint2*)(hA + (size_t)row * 1024 + col) = o;
            }
        }
    }
}

__device__ __forceinline__ void rows_router_phase(const Params& p, const Ctx& cx, char* lds, const float* __restrict__ src, int ls_norm, int layer) {
    const int lane = cx.lane, tid = cx.tid;
    const int widu = __builtin_amdgcn_readfirstlane(cx.wid);
    const int wq = widu & 3, grp4 = widu >> 2;
    const float* mod = (const float*)(p.ws + OFF_MOD);
    const float* rg = p.moe_rg + (size_t)layer * 1024 * 4;
    const float* re = p.moe_re + (size_t)layer * 1024 * 16;
    float* logit_s = (float*)lds;
    float wr[16][5];
#pragma unroll
    for (int i = 0; i < 4; ++i)
#pragma unroll
        for (int j = 0; j < 4; ++j) {
            const int k = (i * 64 + lane) * 4 + j;
#pragma unroll
            for (int q = 0; q < 5; ++q) {
                const int o = 5 * wq + q;
                wr[i * 4 + j][q] = (o < 4) ? rg[k * 4 + o] : re[k * 16 + o - 4];
            }
            __builtin_amdgcn_sched_barrier(0);
        }
    const float* gain = p.norm_g + ls_norm * 1024;
    bf16_t* hA = (bf16_t*)(p.ws + OFF_HA);
    int* lcnt = (int*)(lds + 16384);
    if (tid < 32) lcnt[tid] = 0;
    int nstep = 0;
    for (int blk = cx.vbid; blk < NTOK / 32; blk += cx.G, ++nstep) {
        const int R0 = blk * 32, b = R0 >> 11;
        const float* shift = mod + ((size_t)ls_norm * 16 + b) * 3072;
        const float* scale = shift + 1024;
        f32x4 ca[4], cb[4];
#pragma unroll
        for (int i = 0; i < 4; ++i) {
            const int col = (i * 64 + lane) * 4;
            const f32x4 g = *(const f32x4*)(gain + col), sc = *(const f32x4*)(scale + col);
            ca[i] = g * (sc + 1.f);
            cb[i] = *(const f32x4*)(shift + col);
        }
        const float* srow = src + (size_t)(R0 + grp4 * 16) * 1024 + lane * 4;
        f32x4 vnA[4], vnB[4];
#pragma unroll
        for (int i = 0; i < 4; ++i) { vnA[i] = *(const f32x4*)(srow + i * 256); vnB[i] = *(const f32x4*)(srow + 1024 + i * 256); }
#pragma unroll 1
        for (int r = 0; r < 16; r += 2) {
            const int rlA = grp4 * 16 + r;
            f32x4 vA[4], vB[4];
#pragma unroll
            for (int i = 0; i < 4; ++i) { vA[i] = vnA[i]; vB[i] = vnB[i]; }
            if (r < 14) {
#pragma unroll
                for (int i = 0; i < 4; ++i) { vnA[i] = *(const f32x4*)(srow + (size_t)(r + 2) * 1024 + i * 256); vnB[i] = *(const f32x4*)(srow + (size_t)(r + 3) * 1024 + i * 256); }
            }
            float ssA = 0.f, ssB = 0.f;
#pragma unroll
            for (int i = 0; i < 4; ++i) {
                ssA += vA[i][0] * vA[i][0] + vA[i][1] * vA[i][1] + vA[i][2] * vA[i][2] + vA[i][3] * vA[i][3];
                ssB += vB[i][0] * vB[i][0] + vB[i][1] * vB[i][1] + vB[i][2] * vB[i][2] + vB[i][3] * vB[i][3];
            }
#pragma unroll
            for (int o = 32; o; o >>= 1) { ssA += __shfl_xor(ssA, o); ssB += __shfl_xor(ssB, o); }
            const float rrA = rsqrtf(ssA * (1.f / 1024.f) + EPS), rrB = rsqrtf(ssB * (1.f / 1024.f) + EPS);
            float accA[5] = {0.f, 0.f, 0.f, 0.f, 0.f}, accB[5] = {0.f, 0.f, 0.f, 0.f, 0.f};
#pragma unroll
            for (int i = 0; i < 4; ++i) {
                const int col = (i * 64 + lane) * 4;
                f32x4 hA_, hB_;
#pragma unroll
                for (int j = 0; j < 4; ++j) {
                    hA_[j] = vA[i][j] * rrA * ca[i][j] + cb[i][j];
                    hB_[j] = vB[i][j] * rrB * ca[i][j] + cb[i][j];
#pragma unroll
                    for (int q = 0; q < 5; ++q) { accA[q] += hA_[j] * wr[i * 4 + j][q]; accB[q] += hB_[j] * wr[i * 4 + j][q]; }
                }
                if ((r & 3) == wq) { uint2 o; o.x = pack2(hA_[0], hA_[1]); o.y = pack2(hA_[2], hA_[3]); *(uint2*)(hA + (size_t)(R0 + rlA) * 1024 + col) = o; }
                if (((r + 1) & 3) == wq) { uint2 o; o.x = pack2(hB_[0], hB_[1]); o.y = pack2(hB_[2], hB_[3]); *(uint2*)(hA + (size_t)(R0 + rlA + 1) * 1024 + col) = o; }
            }
            {
                float v[16];
#pragma unroll
                for (int q = 0; q < 5; ++q) { v[q] = accA[q]; v[5 + q] = accB[q]; }
#pragma unroll
                for (int q = 10; q < 16; ++q) v[q] = 0.f;
#pragma unroll
                for (int t = 0; t < 8; ++t) { const bool up = lane & 32; const float send = up ? v[t] : v[t + 8], keep = up ? v[t + 8] : v[t]; v[t] = keep + __shfl_xor(send, 32); }
#pragma unroll
                for (int t = 0; t < 4; ++t) { const bool up = lane & 16; const float send = up ? v[t] : v[t + 4], keep = up ? v[t + 4] : v[t]; v[t] = keep + __shfl_xor(send, 16); }
#pragma unroll
                for (int t = 0; t < 2; ++t) { const bool up = lane & 8; const float send = up ? v[t] : v[t + 2], keep = up ? v[t + 2] : v[t]; v[t] = keep + __shfl_xor(send, 8); }
                { const bool up = lane & 4; const float send = up ? v[0] : v[1], keep = up ? v[1] : v[0]; v[0] = keep + __shfl_xor(send, 4); }
                v[0] += __shfl_xor(v[0], 2);
                v[0] += __shfl_xor(v[0], 1);
                const int idx = ((lane >> 5) & 1) * 8 + ((lane >> 4) & 1) * 4 + ((lane >> 3) & 1) * 2 + ((lane >> 2) & 1);
                if ((lane & 3) == 0 && idx < 10) {
                    const int rsel = idx >= 5, q = idx - 5 * rsel;
                    logit_s[(nstep * 32 + rlA + rsel) * 20 + 5 * wq + q] = v[0];
                }
            }
        }
    }
    __syncthreads();
    const int nrows = nstep * 32;
    int ea = 0, eb = 0, la = 0, lb_ = 0, row = 0; float wa = 0.f, wb = 0.f;
    if (tid < nrows) {
        row = (cx.vbid + (tid >> 5) * cx.G) * 32 + (tid & 31);
        const float* rl = logit_s + tid * 20;
        const float gm = fmaxf(fmaxf(rl[0], rl[1]), fmaxf(rl[2], rl[3]));
        const float gs = __expf(rl[0] - gm) + __expf(rl[1] - gm) + __expf(rl[2] - gm) + __expf(rl[3] - gm);
        int grp = 0; float best = rl[0];
        if (rl[1] > best) { best = rl[1]; grp = 1; }
        if (rl[2] > best) { best = rl[2]; grp = 2; }
        if (rl[3] > best) { best = rl[3]; grp = 3; }
        const float pg = __expf(best - gm) / gs;
        const f32x4 lsel = *(const f32x4*)(rl + 4 + 4 * grp);
        const float l0 = lsel[0], l1 = lsel[1], l2 = lsel[2], l3 = lsel[3];
        const float em = fmaxf(fmaxf(l0, l1), fmaxf(l2, l3));
        const float q0 = __expf(l0 - em), q1 = __expf(l1 - em), q2 = __expf(l2 - em), q3 = __expf(l3 - em);
        int i1 = 0; float b1 = q0;
        if (q1 > b1) { b1 = q1; i1 = 1; }
        if (q2 > b1) { b1 = q2; i1 = 2; }
        if (q3 > b1) { b1 = q3; i1 = 3; }
        int i2 = -1; float b2 = -1.f;
        if (i1 != 0 && q0 > b2) { b2 = q0; i2 = 0; }
        if (i1 != 1 && q1 > b2) { b2 = q1; i2 = 1; }
        if (i1 != 2 && q2 > b2) { b2 = q2; i2 = 2; }
        if (i1 != 3 && q3 > b2) { b2 = q3; i2 = 3; }
        const float inv = pg / (b1 + b2);
        ea = grp * 4 + i1; eb = grp * 4 + i2; wa = b1 * inv; wb = b2 * inv;
        la = atomicAdd(lcnt + ea, 1);
        lb_ = atomicAdd(lcnt + eb, 1);
    }
    __syncthreads();
    if (tid < 16) lcnt[16 + tid] = atomicAdd((int*)(p.ws + OFF_CNT) + layer * 16 + tid, lcnt[tid]);
    __syncthreads();
    if (tid < nrows) {
        int* ltok = (int*)(p.ws + OFF_LTOK);
        float* lw = (float*)(p.ws + OFF_LW);
        int* ts = (int*)(p.ws + OFF_TSLOT) + row * 2;
        const int pa = lcnt[16 + ea] + la, pb = lcnt[16 + eb] + lb_;
        ltok[(size_t)ea * NTOK + pa] = row; lw[(size_t)ea * NTOK + pa] = wa;
        ltok[(size_t)eb * NTOK + pb] = row; lw[(size_t)eb * NTOK + pb] = wb;
        ts[0] = (ea << 16) | pa; ts[1] = (eb << 16) | pb;
    }
    __syncthreads();
}

__device__ __forceinline__ int stage_col(int tid) { return ((tid & 7) ^ ((tid >> 3) & 7)) * 8; }

template <class Epi>
__device__ __forceinline__ void gemm_tile(const bf16_t* const (&ap)[4], const bf16_t* const (&bp)[2], int K, char* lds, const Ctx& cx, Epi&& epi) {
    const int tid = cx.tid, lane = cx.lane, wr = cx.wid >> 1, wc = cx.wid & 1, fr = lane & 15, fq = lane >> 4;
    f32x4 acc[4][4];
#pragma unroll
    for (int m = 0; m < 4; ++m)
#pragma unroll
        for (int n = 0; n < 4; ++n) acc[m][n] = (f32x4){0.f, 0.f, 0.f, 0.f};
    const int nt = K / 64;
    auto stage = [&](int t, int slot) {
        char* SA = lds + slot * GEMM_STAGE + tid * 16; char* SB = SA + 32768;
        const int ko = t * 64;
#pragma unroll
        for (int i = 0; i < 4; ++i) glds16(ap[i] + ko, SA + i * 8192);
#pragma unroll
        for (int i = 0; i < 2; ++i) glds16(bp[i] + ko, SB + i * 8192);
    };
    __syncthreads();
    stage(0, 0);
    if (nt > 1) stage(1, 1);
    const int x7 = fr & 7;
    const int aoff = (wr * 64 + fr) * 128, boff = 32768 + (wc * 64 + fr) * 128;
    int slot = 0;
    for (int kt = 0; kt < nt; ++kt) {
        if (kt + 1 < nt) asm volatile("s_waitcnt vmcnt(6)" ::: "memory");
        else asm volatile("s_waitcnt vmcnt(0)" ::: "memory");
        __builtin_amdgcn_s_barrier();
        if (kt + 2 < nt) stage(kt + 2, slot >= 1 ? slot - 1 : 2);
        const char* S = lds + slot * GEMM_STAGE;
#pragma unroll
        for (int ks = 0; ks < 2; ++ks) {
            const int pc = ((ks * 4 + fq) ^ x7) * 16;
            bf16x8 Af[4], Bf[4];
#pragma unroll
            for (int m = 0; m < 4; ++m) Af[m] = *(const bf16x8*)(S + aoff + m * 2048 + pc);
#pragma unroll
            for (int n = 0; n < 4; ++n) Bf[n] = *(const bf16x8*)(S + boff + n * 2048 + pc);
#pragma unroll
            for (int m = 0; m < 4; ++m)
#pragma unroll
                for (int n = 0; n < 4; ++n) acc[m][n] = __builtin_amdgcn_mfma_f32_16x16x32_bf16(Bf[n], Af[m], acc[m][n], 0, 0, 0);
        }
        slot = slot == 2 ? 0 : slot + 1;
    }
    epi(acc, wr, wc, fr, fq);
}

__device__ __forceinline__ int swz_g(int q) { return (0x1320 >> (4 * q)) & 3; }
__device__ __forceinline__ int stage_col2(int tid) { return ((tid & 3) ^ swz_g((tid >> 4) & 3)) * 8; }

template <int MODE = 0, class Epi>
__device__ __forceinline__ void gemm_tile2(const bf16_t* const (&ap)[2], const bf16_t* const (&bp)[2], int K, char* lds, const Ctx& cx, Epi&& epi) {
    const int tid = cx.tid, lane = cx.lane, wc = cx.wid & 3, fr = lane & 15, fq = lane >> 4;
    const int wr = __builtin_amdgcn_readfirstlane(cx.wid >> 2);
    f32x4 acc[8][4];
#pragma unroll
    for (int m = 0; m < 8; ++m)
#pragma unroll
        for (int n = 0; n < 4; ++n) acc[m][n] = (f32x4){0.f, 0.f, 0.f, 0.f};
    const int nt = K / 32;
    auto stage = [&](int t) {
        char* SA = lds + (t & 3) * 32768 + tid * 16; char* SB = SA + 16384;
        const int ko = t * 32;
        glds16(ap[0] + ko, SA); glds16(ap[1] + ko, SA + 8192);
        glds16(bp[0] + ko, SB); glds16(bp[1] + ko, SB + 8192);
    };
    __syncthreads();
    stage(0);
    if (nt > 1) stage(1);
    if (nt > 2) stage(2);
    const int pc = (fq ^ swz_g((fr >> 2) & 3)) * 16;
    const int aoff = (wr * 128 + fr) * 64 + pc, boff = 16384 + (wc * 64 + fr) * 64 + pc;
    bf16x8 Af[8], Bf[4];
    auto load_frags = [&](int kt) {
        const char* S = lds + (kt & 3) * 32768;
#pragma unroll
        for (int n = 0; n < 4; ++n) Bf[n] = *(const bf16x8*)(S + boff + n * 1024);
#pragma unroll
        for (int m = 0; m < 8; ++m) Af[m] = *(const bf16x8*)(S + aoff + m * 1024);
        asm volatile("s_waitcnt lgkmcnt(0)" ::: "memory");
    };
    auto mma = [&]() {
        __builtin_amdgcn_s_setprio(1);
#pragma unroll
        for (int m = 0; m < 8; ++m)
#pragma unroll
            for (int n = 0; n < 4; ++n) acc[m][n] = __builtin_amdgcn_mfma_f32_16x16x32_bf16(Bf[n], Af[m], acc[m][n], 0, 0, 0);
        __builtin_amdgcn_s_setprio(0);
    };
    if (nt > 2) asm volatile("s_waitcnt vmcnt(8)" ::: "memory");
    else if (nt == 2) asm volatile("s_waitcnt vmcnt(4)" ::: "memory");
    else asm volatile("s_waitcnt vmcnt(0)" ::: "memory");
    if (wr == 1) __builtin_amdgcn_s_barrier();
    for (int kt = 0; kt < nt; ++kt) {
        const int rem = nt - 1 - kt;
        if (rem >= 2) asm volatile("s_waitcnt vmcnt(8)" ::: "memory");
        else if (rem == 1) asm volatile("s_waitcnt vmcnt(4)" ::: "memory");
        else asm volatile("s_waitcnt vmcnt(0)" ::: "memory");
        __builtin_amdgcn_s_barrier();
        if (kt + 3 < nt) stage(kt + 3);
        load_frags(kt);
        if (rem >= 3) asm volatile("s_waitcnt vmcnt(8)" ::: "memory");
        else if (rem == 2) asm volatile("s_waitcnt vmcnt(4)" ::: "memory");
        else asm volatile("s_waitcnt vmcnt(0)" ::: "memory");
        __builtin_amdgcn_s_barrier();
        mma();
    }
    if (wr == 0) __builtin_amdgcn_s_barrier();
    if (MODE == 0) epi(acc, wr, wc, fr, fq);
    else {
#pragma unroll
        for (int m = 0; m < 8; ++m)
#pragma unroll
            for (int n = 0; n < 4; ++n) asm volatile("" :: "v"(acc[m][n]));
    }
}

template <class GetFn, class EpiFn>
__device__ __forceinline__ void gemm_stream2(int my_tiles, int K, char* lds, const Ctx& cx, GetFn&& get, EpiFn&& epi) {
    if (my_tiles <= 0) return;
    const int tid = cx.tid, lane = cx.lane, wc = cx.wid & 3, fr = lane & 15, fq = lane >> 4;
    const int wr = __builtin_amdgcn_readfirstlane(cx.wid >> 2);
    f32x4 acc[8][4];
#pragma unroll
    for (int m = 0; m < 8; ++m)
#pragma unroll
        for (int n = 0; n < 4; ++n) acc[m][n] = (f32x4){0.f, 0.f, 0.f, 0.f};
    const int nt = K / 32, S = my_tiles * nt;
    const bf16_t* sap[2]; const bf16_t* sbp[2];
    int sj = 0, skt = 0, sg = 0;
    get(0, sap, sbp);
    auto stage_next = [&]() {
        char* SA = lds + (sg & 3) * 32768 + tid * 16; char* SB = SA + 16384;
        const int ko = skt * 32;
        glds16(sap[0] + ko, SA); glds16(sap[1] + ko, SA + 8192);
        glds16(sbp[0] + ko, SB); glds16(sbp[1] + ko, SB + 8192);
        ++sg; ++skt;
        if (skt == nt) { skt = 0; ++sj; if (sj < my_tiles) get(sj, sap, sbp); }
    };
    __syncthreads();
    stage_next();
    if (S > 1) stage_next();
    if (S > 2) stage_next();
    const int pc = (fq ^ swz_g((fr >> 2) & 3)) * 16;
    const int aoff = (wr * 128 + fr) * 64 + pc, boff = 16384 + (wc * 64 + fr) * 64 + pc;
    bf16x8 Af[8], Bf[4];
    int g = 0;
    for (int cj = 0; cj < my_tiles; ++cj) {
        {
            const int rem0 = S - 1 - g;
            if (rem0 >= 2) asm volatile("s_waitcnt vmcnt(8)" ::: "memory");
            else if (rem0 == 1) asm volatile("s_waitcnt vmcnt(4)" ::: "memory");
            else asm volatile("s_waitcnt vmcnt(0)" ::: "memory");
        }
        if (wr == 1) __builtin_amdgcn_s_barrier();
        for (int kt = 0; kt < nt; ++kt, ++g) {
            const int rem = S - 1 - g;
            if (rem >= 2) asm volatile("s_waitcnt vmcnt(8)" ::: "memory");
            else if (rem == 1) asm volatile("s_waitcnt vmcnt(4)" ::: "memory");
            else asm volatile("s_waitcnt vmcnt(0)" ::: "memory");
            __builtin_amdgcn_s_barrier();
            if (g + 3 < S) stage_next();
            {
                const char* Sx = lds + (g & 3) * 32768;
#pragma unroll
                for (int n = 0; n < 4; ++n) Bf[n] = *(const bf16x8*)(Sx + boff + n * 1024);
#pragma unroll
                for (int m = 0; m < 8; ++m) Af[m] = *(const bf16x8*)(Sx + aoff + m * 1024);
                asm volatile("s_waitcnt lgkmcnt(0)" ::: "memory");
            }
            if (rem >= 3) asm volatile("s_waitcnt vmcnt(8)" ::: "memory");
            else if (rem == 2) asm volatile("s_waitcnt vmcnt(4)" ::: "memory");
            else asm volatile("s_waitcnt vmcnt(0)" ::: "memory");
            __builtin_amdgcn_s_barrier();
            __builtin_amdgcn_s_setprio(1);
#pragma unroll
            for (int m = 0; m < 8; ++m)
#pragma unroll
                for (int n = 0; n < 4; ++n) acc[m][n] = __builtin_amdgcn_mfma_f32_16x16x32_bf16(Bf[n], Af[m], acc[m][n], 0, 0, 0);
            __builtin_amdgcn_s_setprio(0);
        }
        if (wr == 0) __builtin_amdgcn_s_barrier();
        epi(cj, acc, wr, wc, fr, fq);
#pragma unroll
        for (int m = 0; m < 8; ++m)
#pragma unroll
            for (int n = 0; n < 4; ++n) acc[m][n] = (f32x4){0.f, 0.f, 0.f, 0.f};
    }
}

template <int MODE = 0, class EpiFactory>
__device__ __forceinline__ void gemm_phase_dense2(const bf16_t* A, int lda, const bf16_t* Bt, int K, int nrt, int nct, char* lds, const Ctx& cx, EpiFactory&& mk) {
    const int tid = cx.tid;
    const int ntiles = nrt * nct;
    const int sc = stage_col2(tid), sr = tid >> 2;
    const int my_tiles = cx.vbid < ntiles ? (ntiles - cx.vbid + cx.G - 1) / cx.G : 0;
    const int vb = cx.vbid, G = cx.G;
    gemm_stream2(my_tiles, K, lds, cx,
        [=](int j, const bf16_t* (&ap)[2], const bf16_t* (&bp)[2]) {
            const int tile = vb + j * G, rt = tile / nct, ct = tile % nct;
            ap[0] = A + (size_t)(rt * 256 + sr) * lda + sc; ap[1] = ap[0] + (size_t)128 * lda;
            bp[0] = Bt + (size_t)(ct * 256 + sr) * K + sc; bp[1] = bp[0] + (size_t)128 * K;
        },
        [=](int j, f32x4 (&acc)[8][4], int wr, int wc, int fr, int fq) {
            const int tile = vb + j * G, rt = tile / nct, ct = tile % nct;
            mk(rt * 256, ct * 256)(acc, wr, wc, fr, fq);
        });
}

__device__ __forceinline__ void phase_nsa_inproj(const Params& p, const Ctx& cx, char* lds) {
    const bf16_t* A = (const bf16_t*)(p.ws + OFF_HA);
    const bf16_t* Bt = (const bf16_t*)(p.ws + OFF_W_NSA_IN);
    char* ws = p.ws;
    const float* qg = p.nsa_q_gain;
    const float* kg = p.nsa_k_gain;
    gemm_phase_dense2(A, 1024, Bt, 1024, NTOK / 256, NSA_IN_PAD / 256, lds, cx, [=](int row0, int col0) {
        return [=](f32x4 (&acc)[8][4], int wr, int wc, int fr, int fq) {
            const int gc0 = col0 + wc * 64;
            if (gc0 >= NSA_IN) return;
            if (gc0 < 1024 || (gc0 >= 1536 && gc0 < 1792) || (gc0 >= 2048 && gc0 < 2304)) {
                const float* gain; float post; bf16_t* dstb; size_t rstride; size_t coff; bool tokmajor;
                if (gc0 < 1024) { gain = qg; post = 0.125f * 1.4426950408889634f; }
                else if (gc0 < 1792) { gain = kg + 64; post = 1.f; }
                else { gain = kg + 128; post = 1.f; }
#pragma unroll
                for (int m = 0; m < 8; ++m) {
                    __builtin_amdgcn_sched_barrier(0);
                    float ss = 0.f;
#pragma unroll
                    for (int n = 0; n < 4; ++n) ss += acc[m][n][0] * acc[m][n][0] + acc[m][n][1] * acc[m][n][1] + acc[m][n][2] * acc[m][n][2] + acc[m][n][3] * acc[m][n][3];
                    ss += __shfl_xor(ss, 16); ss += __shfl_xor(ss, 32);
                    const float r = rsqrtf(ss * (1.f / 64.f) + EPS) * post;
                    const int row = row0 + wr * 128 + m * 16 + fr;
                    bf16_t* dst;
                    if (gc0 < 1024) dst = (bf16_t*)(ws + OFF_Q) + (size_t)row * 1024 + gc0;
                    else {
                        const int g = ((gc0 - 1024) & 255) >> 6, b = row >> 11, t = row & 2047;
                        dst = (bf16_t*)(ws + (gc0 < 1792 ? OFF_KS : OFF_KW)) + ((size_t)(b * 4 + g) * 2048 + t) * 64;
                    }
#pragma unroll
                    for (int pp = 0; pp < 2; ++pp) {
                        const int c = pp * 32 + fq * 8;
                        const f32x4 ga = *(const f32x4*)(gain + c), gb = *(const f32x4*)(gain + c + 4);
                        const f32x4 a = acc[m][2 * pp], bb = acc[m][2 * pp + 1];
                        uint4 o; o.x = pack2(a[0] * r * ga[0], a[1] * r * ga[1]); o.y = pack2(a[2] * r * ga[2], a[3] * r * ga[3]);
                        o.z = pack2(bb[0] * r * gb[0], bb[1] * r * gb[1]); o.w = pack2(bb[2] * r * gb[2], bb[3] * r * gb[3]);
                        *(uint4*)(dst + c) = o;
                    }
                }
            } else if (gc0 < 2560) {
                const int seg = (gc0 - 1024) >> 8;
                const int g = ((gc0 - 1024) & 255) >> 6;
                if (seg < 2) {
                    const size_t off = seg == 0 ? OFF_KCRAW : OFF_VCRAW;
#pragma unroll
                    for (int m = 0; m < 8; ++m) {
                        __builtin_amdgcn_sched_barrier(0);
                    __builtin_amdgcn_sched_barrier(0);
                        const int row = row0 + wr * 128 + m * 16 + fr, b = row >> 11, t = row & 2047;
                        bf16_t* dst = (bf16_t*)(ws + off) + ((size_t)(b * 4 + g) * 2048 + t) * 64;
#pragma unroll
                        for (int pp = 0; pp < 2; ++pp) {
                            const f32x4 a = acc[m][2 * pp], bb = acc[m][2 * pp + 1];
                            uint4 o; o.x = pack2(a[0], a[1]); o.y = pack2(a[2], a[3]); o.z = pack2(bb[0], bb[1]); o.w = pack2(bb[2], bb[3]);
                            *(uint4*)(dst + pp * 32 + fq * 8) = o;
                        }
                    }
                } else {
                    const size_t off = seg == 3 ? OFF_VS : OFF_VW;
#pragma unroll
                    for (int m = 0; m < 8; ++m) {
                        __builtin_amdgcn_sched_barrier(0);
                    __builtin_amdgcn_sched_barrier(0);
                        const int row = row0 + wr * 128 + m * 16 + fr, b = row >> 11, t = row & 2047;
                        bf16_t* dst = (bf16_t*)(ws + off) + (size_t)(b * 4 + g) * 64 * 2048 + t;
#pragma unroll
                        for (int n = 0; n < 4; ++n)
#pragma unroll
                            for (int j = 0; j < 4; ++j) dst[(size_t)(pcol(n, fq) + j) * 2048] = f2bf(acc[m][n][j]);
                    }
                }
            } else {
#pragma unroll
                for (int m = 0; m < 8; ++m) {
                    __builtin_amdgcn_sched_barrier(0);
                    const int row = row0 + wr * 128 + m * 16 + fr;
                    float* dst = (float*)(ws + OFF_GATES) + (size_t)row * 48;
#pragma unroll
                    for (int n = 0; n < 4; ++n) {
                        const int c = pcol(n, fq);
                        f32x4 o;
#pragma unroll
                        for (int j = 0; j < 4; ++j) o[j] = sigmoid_f(acc[m][n][j]);
                        if (c < 48) *(f32x4*)(dst + c) = o;
                    }
                }
            }
        };
    });
}

__device__ __forceinline__ void phase_cmp1(const Params& p, const Ctx& cx, char* lds) {
    const int tid = cx.tid;
    const float* peb = (const float*)(p.ws + OFF_PEB);
    float* T1 = (float*)(p.ws + OFF_T1);
    const int sc = stage_col(tid), sr = tid >> 3;
    for (int tile = cx.vbid; tile < 64; tile += cx.G) {
        const int kv = tile >> 5, bg2 = tile & 31;
        const bf16_t* raw = (const bf16_t*)(p.ws + (kv ? OFF_VCRAW : OFF_KCRAW)) + (size_t)bg2 * 2 * 2048 * 64;
        const bf16_t* a0 = raw + (size_t)sr * 1024 + sc;
        const bf16_t* a2 = raw + (size_t)2048 * 64 + (size_t)sr * 1024 + sc;
        const bf16_t* b0 = (const bf16_t*)(p.ws + OFF_W_CMP1) + ((size_t)kv * 128 + sr) * 2048 + sc;
        const bf16_t* const ap[4] = {a0, a0 + (size_t)64 * 1024, a2, a2 + (size_t)64 * 1024};
        const bf16_t* const bp[2] = {b0, b0 + (size_t)64 * 2048};
        gemm_tile(ap, bp, 2048, lds, cx, [=](f32x4 (&acc)[4][4], int wr, int wc, int fr, int fq) {
            if (wc != 0) return;
#pragma unroll
            for (int m = 0; m < 4; ++m) {
                const int r = wr * 64 + m * 16 + fr;
                float* dst = T1 + ((size_t)kv * 8192 + (bg2 * 2 + (r >> 7)) * 128 + (r & 127)) * 64;
#pragma unroll
                for (int n = 0; n < 4; ++n) {
                    const int c = n * 16 + fq * 4;
                    f32x4 pb = *(const f32x4*)(peb + kv * 64 + c);
                    *(f32x4*)(dst + c) = acc[m][n] + pb;
                }
            }
        });
    }
}

__device__ __forceinline__ void phase_cmp2(const Params& p, const Ctx& cx) {
    const int lane = cx.lane;
    const float* T1 = (const float*)(p.ws + OFF_T1);
    for (int r = cx.vbid * NWAVE + cx.wid; r < 2 * 8192; r += cx.G * NWAVE) {
        const int kv = r >> 13, rr = r & 8191, n_ = rr & 127;
        const float s = silu_f(T1[(size_t)r * 64 + lane]);
        const float* w2 = p.nsa_cmp_w2 + kv * 4096 + lane;
        float o = 0.f;
#pragma unroll 8
        for (int j = 0; j < 64; ++j) o += __shfl(s, j) * w2[j * 64];
        if (kv == 0) {
            const float ss = wave_sum(o * o);
            o = o * rsqrtf(ss * (1.f / 64.f) + EPS) * p.nsa_k_gain[lane];
        }
        if (n_ == 127) o = 0.f;
        if (kv == 0) ((bf16_t*)(p.ws + OFF_KC))[(size_t)rr * 64 + lane] = f2bf(o);
        else ((bf16_t*)(p.ws + OFF_VC))[((size_t)(rr >> 7) * 64 + lane) * 128 + n_] = f2bf(o);
    }
}

constexpr int ATT_BUF = 17920, ATT_K_STRIDE = 144, ATT_V_OFF = 9216, ATT_V_STRIDE = 136, ATT_LUT_OFF = 2 * ATT_BUF, LUT_N = 2136, LUT_PAD = 80;
constexpr int ATT_SC_OFF = ATT_LUT_OFF + 4 * LUT_N * 4;
static_assert(ATT_SC_OFF + NWAVE * 8192 <= LDS_TAB_OFF, "attention LDS");
#define MFMA32(a, b, c) __builtin_amdgcn_mfma_f32_32x32x16_bf16((a), (b), (c), 0, 0, 0)
template <int V> struct IC { static constexpr int value = V; };

__device__ __forceinline__ void phase_attn(const Params& p, const Ctx& cx, char* lds) {
    const int tid = cx.tid, lane = cx.lane, wid = cx.wid;
    const int g = cx.vbid & 3;
    const int ql = lane & 7, head = (lane & 31) >> 3, h2 = lane >> 5, l31 = lane & 31;
    float* lut = (float*)(lds + ATT_LUT_OFF);
    for (int i = tid; i < 4 * LUT_N; i += NTHR) {
        const int h = i / LUT_N, dist = i % LUT_N - LUT_PAD;
        lut[i] = dist >= 0 ? p.rel_bias[t5_bucket(dist) * 16 + g * 4 + h] * 1.4426950408889634f : 0.f;
    }
    __syncthreads();
    const float* lutp = lut + head * LUT_N + LUT_PAD;
    const float b31 = lutp[2047];
    const bf16_t* Qb = (const bf16_t*)(p.ws + OFF_Q);
    const bf16_t* KC = (const bf16_t*)(p.ws + OFF_KC);
    const bf16_t* VCT = (const bf16_t*)(p.ws + OFF_VC);
    const bf16_t* KS = (const bf16_t*)(p.ws + OFF_KS);
    const bf16_t* VST = (const bf16_t*)(p.ws + OFF_VS);
    const bf16_t* KW = (const bf16_t*)(p.ws + OFF_KW);
    const bf16_t* VWT = (const bf16_t*)(p.ws + OFF_VW);
    const float* GT = (const float*)(p.ws + OFF_GATES);
    bf16_t* Og = (bf16_t*)(p.ws + OFF_HA);
    float* scw = (float*)(lds + ATT_SC_OFF) + wid * 2048;
    f32x4* outw = (f32x4*)(lds + ATT_SC_OFF + wid * 8192) + lane;
    const bool flip_ok = (cx.G % 128) == 0;
    const int widu = __builtin_amdgcn_readfirstlane(wid);

    for (int it = 0;; ++it) {
        const int u = cx.vbid + it * cx.G;
        if (u >= 2048) break;
        const int rest = u >> 2, b = rest >> 5, qtb = rest & 31;
        const int qt = (flip_ok && (it & 1)) ? 31 - qtb : qtb;
        const int t0 = qt * 64, cur = qt, bg = b * 4 + g;
        const int tq = t0 + wid * 8 + ql;
        const size_t rowtok = (size_t)b * SEQ + tq;
        bf16x8 Qf[4];
        {
            const bf16_t* qp = Qb + rowtok * 1024 + (g * 4 + head) * 64 + 8 * h2;
#pragma unroll
            for (int ks = 0; ks < 4; ++ks) Qf[ks] = *(const bf16x8*)(qp + 16 * ks);
        }
        const float* gt = GT + rowtok * 48 + (g * 4 + head) * 3;
        const float gate_c = gt[0], gate_s = gt[1], gate_w = gt[2];
        const int wlo = max(0, qt - 8);
        const int nW = cur - wlo + 1;
        const int ncp = (t0 + 63 >= 31 + 16 * 64) ? 2 : 1;
        const int NC = ncp;
        const int NT = NC + nW + cur + 1;

        uint4 kr0, vr0;
        auto issue_load = [&](int i) {
            const bf16_t* ksrc; const bf16_t* vsrc; int vstride;
            if (i < NC) { const int ci = i; ksrc = KC + ((size_t)bg * 128 + ci * 64) * 64; vsrc = VCT + (size_t)bg * 64 * 128 + ci * 64; vstride = 128; }
            else if (i < NC + nW) { const int kb = wlo + i - NC; ksrc = KW + ((size_t)bg * 2048 + kb * 64) * 64; vsrc = VWT + (size_t)bg * 64 * 2048 + kb * 64; vstride = 2048; }
            else { const int kb = i - NC - nW; ksrc = KS + ((size_t)bg * 2048 + kb * 64) * 64; vsrc = VST + (size_t)bg * 64 * 2048 + kb * 64; vstride = 2048; }
            kr0 = *(const uint4*)(ksrc + tid * 8);
            vr0 = *(const uint4*)(vsrc + (size_t)(tid >> 3) * vstride + (tid & 7) * 8);
        };
        auto write_lds = [&](int i) {
            char* bufp = lds + (i & 1) * ATT_BUF;
            *(uint4*)(bufp + (tid >> 3) * ATT_K_STRIDE + (tid & 7) * 16) = kr0;
            char* va = bufp + ATT_V_OFF + (tid >> 3) * ATT_V_STRIDE + (tid & 7) * 16;
            uint2 t;
            t.x = vr0.x; t.y = vr0.y; *(uint2*)va = t;
            t.x = vr0.z; t.y = vr0.w; *(uint2*)(va + 8) = t;
        };
        f32x16 O0, O1;
#pragma unroll
        for (int r = 0; r < 16; ++r) { O0[r] = 0.f; O1[r] = 0.f; }
        float lsum = 0.f;

        auto qk = [&](const char* bufp, int kt2, float init) -> f32x16 {
            f32x16 S;
#pragma unroll
            for (int r = 0; r < 16; ++r) S[r] = init;
            const char* kp = bufp + (32 * kt2 + l31) * ATT_K_STRIDE + 16 * h2;
            bf16x8 kf[4];
#pragma unroll
            for (int ks = 0; ks < 4; ++ks) kf[ks] = *(const bf16x8*)(kp + 32 * ks);
            __builtin_amdgcn_sched_barrier(0);
#pragma unroll
            for (int ks = 0; ks < 4; ++ks) S = MFMA32(kf[ks], Qf[ks], S);
            return S;
        };
        auto pv = [&](const char* bufp, int kt2, const f32x16& P) {
            const char* vp = bufp + ATT_V_OFF + l31 * ATT_V_STRIDE + (32 * kt2 + 4 * h2) * 2;
            uint2 va[2][2][2];
#pragma unroll
            for (int s2 = 0; s2 < 2; ++s2)
#pragma unroll
                for (int dt = 0; dt < 2; ++dt) {
                    va[s2][dt][0] = *(const uint2*)(vp + dt * 32 * ATT_V_STRIDE + s2 * 32);
                    va[s2][dt][1] = *(const uint2*)(vp + dt * 32 * ATT_V_STRIDE + s2 * 32 + 16);
                }
            __builtin_amdgcn_sched_barrier(0);
#pragma unroll
            for (int s2 = 0; s2 < 2; ++s2) {
                uint4 pk;
                pk.x = pack2(P[8 * s2 + 0], P[8 * s2 + 1]); pk.y = pack2(P[8 * s2 + 2], P[8 * s2 + 3]);
                pk.z = pack2(P[8 * s2 + 4], P[8 * s2 + 5]); pk.w = pack2(P[8 * s2 + 6], P[8 * s2 + 7]);
                const bf16x8 Pf = __builtin_bit_cast(bf16x8, pk);
                uint4 a0, a1;
                a0.x = va[s2][0][0].x; a0.y = va[s2][0][0].y; a0.z = va[s2][0][1].x; a0.w = va[s2][0][1].y;
                a1.x = va[s2][1][0].x; a1.y = va[s2][1][0].y; a1.z = va[s2][1][1].x; a1.w = va[s2][1][1].y;
                O0 = MFMA32(__builtin_bit_cast(bf16x8, a0), Pf, O0);
                O1 = MFMA32(__builtin_bit_cast(bf16x8, a1), Pf, O1);
            }
        };
        auto finalize = [&](float gate, int mode) {
            const float Z = lsum + __shfl_xor(lsum, 32);
            const float f = Z > 0.f ? gate / Z : 0.f;
#pragma unroll
            for (int v4 = 0; v4 < 4; ++v4) {
                f32x4 a = {f * O0[4 * v4], f * O0[4 * v4 + 1], f * O0[4 * v4 + 2], f * O0[4 * v4 + 3]};
                f32x4 c = {f * O1[4 * v4], f * O1[4 * v4 + 1], f * O1[4 * v4 + 2], f * O1[4 * v4 + 3]};
                if (mode != 0) { a += outw[v4 * 64]; c += outw[(4 + v4) * 64]; }
                if (mode != 2) { outw[v4 * 64] = a; outw[(4 + v4) * 64] = c; }
                else { O0[4 * v4] = a[0]; O0[4 * v4 + 1] = a[1]; O0[4 * v4 + 2] = a[2]; O0[4 * v4 + 3] = a[3];
                       O1[4 * v4] = c[0]; O1[4 * v4 + 1] = c[1]; O1[4 * v4 + 2] = c[2]; O1[4 * v4 + 3] = c[3]; }
            }
            if (mode != 2) {
#pragma unroll
                for (int r = 0; r < 16; ++r) { O0[r] = 0.f; O1[r] = 0.f; }
            }
            lsum = 0.f;
        };
        auto tile_ws = [&](const char* bufp, int kb, float cinit, auto MMc, auto BMc) {
            constexpr int MM = decltype(MMc)::value, BM = decltype(BMc)::value;
#pragma unroll 1
            for (int kt2 = 0; kt2 < 2; ++kt2) {
                const int d0 = tq - (64 * kb + 32 * kt2 + 4 * h2);
                const float* lp = lutp + (d0 - 27);
                float bv[16];
                if (BM == 0) {
#pragma unroll
                    for (int r = 0; r < 16; ++r) bv[r] = lp[27 - ((r & 3) + 8 * (r >> 2))];
                    __builtin_amdgcn_sched_barrier(0);
                }
                f32x16 S = qk(bufp, kt2, cinit);
#pragma unroll
                for (int r = 0; r < 16; ++r) {
                    const int cr = (r & 3) + 8 * (r >> 2);
                    float x = S[r];
                    if (BM == 0) x += bv[r];
                    if (MM == 1) x += (d0 - cr < 512) ? 0.f : -INFINITY;
                    if (MM == 2) x += (d0 - cr >= 0) ? 0.f : -INFINITY;
                    S[r] = __builtin_amdgcn_exp2f(x);
                    lsum += S[r];
                }
                pv(bufp, kt2, S);
            }
        };

        const int nvis = (tq >= 31) ? min((tq - 31) / 16 + 1, 127) : 0;
        unsigned selmask = 0u;
        float* sown = scw + (head * 8 + ql) * 32;
        float* stail = scw + 1024 + (head * 8 + ql) * 32;
        float* ssc = scw + ql * 32;
        issue_load(0);
        __syncthreads();
        write_lds(0);
        issue_load(1);
        for (int i = 0; i < NT; ++i) {
            __syncthreads();
            const char* bufp = lds + (i & 1) * ATT_BUF;
            if (i < NC) {
                const int ci = i;
#pragma unroll 1
                for (int kt2 = 0; kt2 < 2; ++kt2) {
                    const int n0 = 64 * ci + 32 * kt2 + 4 * h2;
                    const int d0 = tq - 31 - 16 * n0;
                    float bv[16];
#pragma unroll
                    for (int r = 0; r < 16; ++r) bv[r] = lutp[max(d0 - 16 * ((r & 3) + 8 * (r >> 2)), -LUT_PAD)];
                    __builtin_amdgcn_sched_barrier(0);
                    f32x16 S = qk(bufp, kt2, 0.f);
#pragma unroll
                    for (int r = 0; r < 16; ++r) {
                        const int cr = (r & 3) + 8 * (r >> 2);
                        S[r] = __builtin_amdgcn_exp2f(S[r] + bv[r] + ((n0 + cr) < nvis ? 0.f : -INFINITY));
                        lsum += S[r];
                    }
                    pv(bufp, kt2, S);
#pragma unroll
                    for (int rq = 0; rq < 4; ++rq) {
                        const int sblk = 8 * (2 * ci + kt2) + 2 * rq + h2;
                        sown[sblk] = S[4 * rq] + S[4 * rq + 1] + S[4 * rq + 2] + 0.5f * S[4 * rq + 3];
                        if (sblk < 31) stail[sblk + 1] = 0.5f * S[4 * rq + 3];
                    }
                }
                if (i == NC - 1) {
                    const float Z = lsum + __shfl_xor(lsum, 32);
                    const float inv_mine = Z > 0.f ? 1.f / Z : 0.f;
                    if (h2 == 0) stail[0] = 0.f;
                    __builtin_amdgcn_wave_barrier();
                    const int j8 = head * 2 + h2;
                    {
                        f32x4 sc = {0.f, 0.f, 0.f, 0.f};
#pragma unroll
                        for (int hh = 0; hh < 4; ++hh) {
                            const float invh = __shfl(inv_mine, hh * 8 + ql);
                            const f32x4 a = *(const f32x4*)(scw + (hh * 8 + ql) * 32 + 4 * j8), t4 = *(const f32x4*)(scw + 1024 + (hh * 8 + ql) * 32 + 4 * j8);
                            sc += (a + t4) * invh;
                        }
#pragma unroll
                        for (int q = 0; q < 4; ++q) {
                            const int sblk = 4 * j8 + q;
                            const bool forced = (sblk == 0) || (sblk == cur) || (sblk == cur - 1);
                            sc[q] = forced ? 1.0e4f : (sblk <= cur ? sc[q] : -1.0f);
                        }
                        __builtin_amdgcn_wave_barrier();
                        *(f32x4*)(ssc + 4 * j8) = sc;
                    }
                    __builtin_amdgcn_wave_barrier();
                    const f32x4 own = *(const f32x4*)(ssc + 4 * j8);
                    int rk0 = 0, rk1 = 0, rk2 = 0, rk3 = 0;
                    const int so0 = 4 * j8;
#pragma unroll
                    for (int m4 = 0; m4 < 8; ++m4) {
                        const f32x4 v = *(const f32x4*)(ssc + 4 * m4);
#pragma unroll
                        for (int q = 0; q < 4; ++q) {
                            const float vm = v[q];
                            rk0 += (vm > own[0]) ? 1 : 0;
                            rk1 += (vm > own[1]) ? 1 : 0;
                            rk2 += (vm > own[2]) ? 1 : 0;
                            rk3 += (vm > own[3]) ? 1 : 0;
                        }
                    }
                    unsigned mk = ((rk0 < 8 ? 1u : 0u) | (rk1 < 8 ? 2u : 0u) | (rk2 < 8 ? 4u : 0u) | (rk3 < 8 ? 8u : 0u)) << so0;
                    mk |= __shfl_xor(mk, 8); mk |= __shfl_xor(mk, 16); mk |= __shfl_xor(mk, 32);
                    selmask = mk;
                    __builtin_amdgcn_wave_barrier();
                    finalize(gate_c, 0);
                }
            } else if (i < NC + nW) {
                const int kb = wlo + i - NC;
                if (kb == cur) tile_ws(bufp, kb, 0.f, IC<2>{}, IC<0>{});
                else if (kb == cur - 8) tile_ws(bufp, kb, 0.f, IC<1>{}, IC<0>{});
                else tile_ws(bufp, kb, 0.f, IC<0>{}, IC<0>{});
                if (i == NC - 1 + nW) finalize(gate_w, 1);
            } else {
                const int kb = i - NC - nW;
                const bool sel = ((selmask >> kb) & 1u) != 0;
                if (__ballot(sel) != 0ull) {
                    const float neg = sel ? 0.f : -INFINITY;
                    if (kb == cur) tile_ws(bufp, kb, neg, IC<2>{}, IC<0>{});
                    else if (t0 + 8 * widu - (64 * kb + 63) >= 790) tile_ws(bufp, kb, neg + b31, IC<0>{}, IC<1>{});
                    else tile_ws(bufp, kb, neg, IC<0>{}, IC<0>{});
                }
            }
            if (i + 1 < NT) {
                write_lds(i + 1);
                if (i + 2 < NT) issue_load(i + 2);
            }
        }
        finalize(gate_s, 2);
        {
            bf16_t* op = Og + rowtok * 1024 + (g * 4 + head) * 64 + 4 * h2;
#pragma unroll
            for (int rq = 0; rq < 4; ++rq) {
                uint2 o0; o0.x = pack2(O0[4 * rq], O0[4 * rq + 1]); o0.y = pack2(O0[4 * rq + 2], O0[4 * rq + 3]);
                uint2 o1; o1.x = pack2(O1[4 * rq], O1[4 * rq + 1]); o1.y = pack2(O1[4 * rq + 2], O1[4 * rq + 3]);
                *(uint2*)(op + 8 * rq) = o0;
                *(uint2*)(op + 32 + 8 * rq) = o1;
            }
        }
    }
}

__device__ __forceinline__ void phase_outproj(const Params& p, const Ctx& cx, char* lds, const bf16_t* A, const bf16_t* Bt, const float* xin, int ls) {
    const float* mod = (const float*)(p.ws + OFF_MOD);
    float* xo = p.out;
    gemm_phase_dense2(A, 1024, Bt, 1024, NTOK / 256, 4, lds, cx, [=](int row0, int col0) {
        return [=](f32x4 (&acc)[8][4], int wr, int wc, int fr, int fq) {
            const int b = row0 >> 11;
            const float* gate = mod + ((size_t)ls * 16 + b) * 3072 + 2048 + col0 + wc * 64;
            f32x4 g[4];
#pragma unroll
            for (int n = 0; n < 4; ++n) g[n] = *(const f32x4*)(gate + pcol(n, fq));
#pragma unroll
            for (int m2 = 0; m2 < 8; m2 += 2) {
                f32x4 xi[2][4];
#pragma unroll
                for (int mm = 0; mm < 2; ++mm)
#pragma unroll
                    for (int n = 0; n < 4; ++n)
                        xi[mm][n] = *(const f32x4*)(xin + (size_t)(row0 + wr * 128 + (m2 + mm) * 16 + fr) * 1024 + col0 + wc * 64 + pcol(n, fq));
                __builtin_amdgcn_sched_barrier(0);
#pragma unroll
                for (int mm = 0; mm < 2; ++mm)
#pragma unroll
                    for (int n = 0; n < 4; ++n) {
                        f32x4 o;
#pragma unroll
                        for (int j = 0; j < 4; ++j) o[j] = xi[mm][n][j] + g[n][j] * acc[m2 + mm][n][j];
                        *(f32x4*)(xo + (size_t)(row0 + wr * 128 + (m2 + mm) * 16 + fr) * 1024 + col0 + wc * 64 + pcol(n, fq)) = o;
                    }
                __builtin_amdgcn_sched_barrier(0);
            }
        };
    });
}

__device__ __forceinline__ void moe_tables(const Params& p, int layer, int tid, int* s_off, int* s_toff, int* s_hoff) {
    __syncthreads();
    if (tid == 0) {
        const int* cnt = (const int*)(p.ws + OFF_CNT) + layer * 16;
        int o = 0, to = 0, ho = 0;
        for (int e = 0; e < 16; ++e) {
            const int c = cnt[e], q = c >> 8, r = c & 255;
            s_off[e] = o; s_toff[e] = to; s_hoff[e] = ho;
            o += c; to += (q + (r > 128 ? 1 : 0)) * 4; ho += (r > 0 && r <= 128) ? 4 : 0;
        }
        s_off[16] = o; s_toff[16] = to; s_hoff[16] = ho;
    }
    __syncthreads();
}

constexpr int LDS_ROWIDX_OFF = 131072, LDS_LW_OFF = 131072 + 8192;
static_assert(LDS_LW_OFF + 8192 <= LDS_TAB_OFF, "moe caches");


namespace pg8 {
#define PG8_LAS __attribute__((address_space(3)))
typedef unsigned short bf16_t;
typedef short bf16x8 __attribute__((ext_vector_type(8)));
typedef float f32x4 __attribute__((ext_vector_type(4)));
typedef unsigned u32x4 __attribute__((ext_vector_type(4)));
constexpr int BM = 256, BK = 64, HALF = 128, HTB = HALF * BK * 2  , STAGE_BYTES = 8 * HTB, NXCD = 8, WGM = 8;

__host__ __device__ __forceinline__ int lds_byte(int r, int c) { const int st = (r >> 4) * 2 + (c >> 5), rr = r & 15, cc = c & 31, ob = rr * 64 + cc * 2; return st * 1024 + (ob ^ (((ob >> 9) & 1) << 5)); }
__host__ __device__ __forceinline__ void stage_rc(int b, int& R, int& C) { const int st = b / 1024, sb = b % 1024, swz = sb ^ (((sb >> 9) & 1) << 5); R = (st >> 1) * 16 + swz / 64; C = (st & 1) * 32 + (swz % 64) / 2; }
__host__ __device__ __forceinline__ int perm32(int rho) { const int n = rho >> 4, i = rho & 15; return 8 * (i >> 2) + 4 * n + (i & 3); }

struct Unit { int pm, pn; };
struct Gemm { const bf16_t* A; const bf16_t* Bt; int M, N, K; };

struct StaticOrder {
    int nM, nN, nwg, G, c;
    __host__ __device__ void init(int M, int N, int G_, int c_) { nM = M / BM; nN = N / BM; nwg = nM * nN; G = G_; c = c_; }
    __host__ __device__ bool next(int i, Unit& u) const {
        const long L = (long)i * G + c; if (L >= nwg) return false;
        int wgid = (int)L; { const int q = nwg / NXCD, r = nwg % NXCD, xcd = wgid % NXCD, off = wgid / NXCD; wgid = (xcd < r ? xcd * (q + 1) : r * (q + 1) + (xcd - r) * q) + off; }
        const int nig = WGM * nN, gid = wgid / nig, fm = gid * WGM, gsz = (nM - fm) < WGM ? (nM - fm) : WGM;
        u.pm = fm + ((wgid % nig) % gsz); u.pn = (wgid % nig) / gsz; return true;
    }
    __device__ __forceinline__ void a_ready(const Unit&) const {}
    __device__ __forceinline__ void done(const Unit&) const {}
};

template <class Epi, class Sched, bool ALIGN_EPI = false, bool SP2 = false>
__device__ __forceinline__ void gemm_phase(PG8_LAS unsigned char* lds, const Gemm g, const Sched& S, const Epi& E) {
    const int tid = threadIdx.x, wid = __builtin_amdgcn_readfirstlane(tid >> 6), lane = tid & 63, wr = wid >> 2, wc = wid & 3, fr = lane & 15, fq = lane >> 4;
    const int K = g.K, nt = K / BK;
    unsigned voffA[2], voffB[2];
#pragma unroll
    for (int i = 0; i < 2; ++i) { int R, C; stage_rc(tid * 16 + i * 8192, R, C); const int Rb = Epi::PERM ? ((R & ~31) + perm32(R & 31)) : R;
        voffA[i] = (unsigned)(R * K + C) * 2u; voffB[i] = (unsigned)(Rb * K + C) * 2u; }
    const size_t kstep = (size_t)(BK * 2);
    const size_t hstep = (size_t)HALF * K * 2;
    const size_t tstep = 2 * hstep;
    const unsigned ldsw = (unsigned)wid * 1024u;
    const int aoff = lds_byte(wr * 64 + fr, fq * 8), boff = lds_byte(wc * 32 + fr, fq * 8);
#define PG8_SA(b, h) (((b) * 2 + (h)) * HTB)
#define PG8_SB(b, h) ((4 + (b) * 2 + (h)) * HTB)
#define PG8_STAGE(bufoff, gbase, voff) do { _Pragma("unroll") for (int _i = 0; _i < 2; ++_i) \
        __builtin_amdgcn_global_load_lds((const unsigned*)((const char*)(gbase) + (voff)[_i]), (PG8_LAS unsigned*)(lds + (bufoff) + ldsw + _i * 8192), 16, 0, 0); } while (0)
#define PG8_LDA(dst, b, h) do { _Pragma("unroll") for (int m = 0; m < 4; ++m) _Pragma("unroll") for (int k = 0; k < 2; ++k) dst[m][k] = *(const PG8_LAS bf16x8*)(lds + PG8_SA(b, h) + aoff + m * 2048 + k * 1024); } while (0)
#define PG8_LDB(dst, b, h) do { _Pragma("unroll") for (int n = 0; n < 2; ++n) _Pragma("unroll") for (int k = 0; k < 2; ++k) dst[n][k] = *(const PG8_LAS bf16x8*)(lds + PG8_SB(b, h) + boff + n * 2048 + k * 1024); } while (0)
#define PG8_MMA(ai, bj, At, Bt) do { __builtin_amdgcn_s_setprio(1); _Pragma("unroll") for (int m = 0; m < 4; ++m) _Pragma("unroll") for (int n = 0; n < 2; ++n) _Pragma("unroll") for (int k = 0; k < 2; ++k) \
        acc[ai][bj][m][n] = __builtin_amdgcn_mfma_f32_16x16x32_bf16(Bt[n][k], At[m][k], acc[ai][bj][m][n], 0, 0, 0); __builtin_amdgcn_s_setprio(0); } while (0)
#define PG8_WAIT_V(n) asm volatile("s_waitcnt vmcnt(" #n ")" ::: "memory")
#define PG8_WAIT_L(n) asm volatile("s_waitcnt lgkmcnt(" #n ")" ::: "memory")
#define PG8_BAR __builtin_amdgcn_s_barrier()
#define PG8_SCHED __builtin_amdgcn_sched_barrier(0)
    Unit cur, nxt; int ui = 0;
    if (!S.next(0, cur)) return;
    f32x4 acc[2][2][4][2];
#pragma unroll
    for (int a = 0; a < 2; ++a)
#pragma unroll
        for (int b = 0; b < 2; ++b)
#pragma unroll
            for (int m = 0; m < 4; ++m)
#pragma unroll
                for (int n = 0; n < 2; ++n) acc[a][b][m][n] = (f32x4){0.f, 0.f, 0.f, 0.f};
    bf16x8 At[4][2], B0[2][2], B1[2][2];
    const char* cA = (const char*)g.A + (size_t)cur.pm * tstep; const char* cB = (const char*)g.Bt + (size_t)cur.pn * tstep;
    S.a_ready(cur);
    if constexpr (SP2) {
        PG8_STAGE(PG8_SB(0, 0), cB, voffB); PG8_STAGE(PG8_SB(0, 1), cB + hstep, voffB); PG8_STAGE(PG8_SA(0, 0), cA, voffA); PG8_STAGE(PG8_SA(0, 1), cA + hstep, voffA);
        if (wr == 1) PG8_BAR;
        PG8_WAIT_V(2); PG8_BAR;
        PG8_STAGE(PG8_SB(1, 0), cB + kstep, voffB); PG8_STAGE(PG8_SA(1, 0), cA + kstep, voffA); PG8_STAGE(PG8_SB(1, 1), cB + hstep + kstep, voffB);
        PG8_WAIT_V(6); PG8_BAR;
    } else {
        PG8_STAGE(PG8_SB(0, 0), cB, voffB); PG8_STAGE(PG8_SA(0, 0), cA, voffA); PG8_STAGE(PG8_SB(0, 1), cB + hstep, voffB); PG8_STAGE(PG8_SA(0, 1), cA + hstep, voffA);
        if (wr == 1) PG8_BAR;
        PG8_WAIT_V(4); PG8_BAR;
        PG8_STAGE(PG8_SB(1, 0), cB + kstep, voffB); PG8_STAGE(PG8_SA(1, 0), cA + kstep, voffA); PG8_STAGE(PG8_SB(1, 1), cB + hstep + kstep, voffB);
        PG8_WAIT_V(6); PG8_BAR;
    }
    for (;;) {
        const bool has_next = S.next(ui + 1, nxt);
        const char* nA = has_next ? (const char*)g.A + (size_t)nxt.pm * tstep : cA; const char* nB = has_next ? (const char*)g.Bt + (size_t)nxt.pn * tstep : cB;
        for (int t = 0; t < nt; t += 2) {
            const bool last = (t == nt - 2);
            const char* a1 = cA + (size_t)(t + 1) * kstep;
            const char* a2 = last ? nA : cA + (size_t)(t + 2) * kstep; const char* b2 = last ? nB : cB + (size_t)(t + 2) * kstep;
            const char* a3 = a2 + kstep; const char* b3 = b2 + kstep;
            if (last && has_next) S.a_ready(nxt);
            if constexpr (SP2) {
            PG8_LDB(B0, 0, 0); PG8_LDB(B1, 0, 1); PG8_SCHED; PG8_LDA(At, 0, 0); PG8_STAGE(PG8_SA(1, 1), a1 + hstep, voffA);
            PG8_WAIT_V(8); PG8_WAIT_L(0); PG8_BAR; PG8_MMA(0, 0, At, B0); PG8_MMA(0, 1, At, B1); PG8_BAR; PG8_SCHED;
            PG8_LDA(At, 0, 1); PG8_STAGE(PG8_SB(0, 0), b2, voffB); PG8_STAGE(PG8_SB(0, 1), b2 + hstep, voffB); PG8_STAGE(PG8_SA(0, 0), a2, voffA);
            PG8_WAIT_V(8); PG8_WAIT_L(0); PG8_BAR; PG8_MMA(1, 0, At, B0); PG8_MMA(1, 1, At, B1); PG8_BAR; PG8_SCHED;
            PG8_LDB(B0, 1, 0); PG8_LDB(B1, 1, 1); PG8_SCHED; PG8_LDA(At, 1, 0); PG8_STAGE(PG8_SA(0, 1), a2 + hstep, voffA);
            PG8_WAIT_V(8); PG8_WAIT_L(0); PG8_BAR; PG8_MMA(0, 0, At, B0); PG8_MMA(0, 1, At, B1); PG8_BAR; PG8_SCHED;
            PG8_LDA(At, 1, 1); PG8_STAGE(PG8_SB(1, 0), b3, voffB); PG8_STAGE(PG8_SB(1, 1), b3 + hstep, voffB); PG8_STAGE(PG8_SA(1, 0), a3, voffA);
            PG8_WAIT_V(8); PG8_WAIT_L(0); PG8_BAR; PG8_MMA(1, 0, At, B0); PG8_MMA(1, 1, At, B1); PG8_BAR; PG8_SCHED;
            } else {
            PG8_LDB(B0, 0, 0); PG8_SCHED; PG8_LDA(At, 0, 0); PG8_STAGE(PG8_SA(1, 1), a1 + hstep, voffA);
            PG8_WAIT_L(8); PG8_BAR; PG8_WAIT_L(0); PG8_MMA(0, 0, At, B0); PG8_BAR; PG8_SCHED;
            PG8_LDB(B1, 0, 1); PG8_STAGE(PG8_SB(0, 0), b2, voffB);
            PG8_BAR; PG8_WAIT_L(0); PG8_MMA(0, 1, At, B1); PG8_BAR;
            PG8_LDA(At, 0, 1); PG8_STAGE(PG8_SA(0, 0), a2, voffA);
            PG8_BAR; PG8_WAIT_L(0); PG8_MMA(1, 0, At, B0); PG8_BAR; PG8_SCHED;
            PG8_STAGE(PG8_SB(0, 1), b2 + hstep, voffB);
            PG8_WAIT_V(6); PG8_BAR; PG8_MMA(1, 1, At, B1); PG8_BAR;
            PG8_LDB(B0, 1, 0); PG8_SCHED; PG8_LDA(At, 1, 0); PG8_STAGE(PG8_SA(0, 1), a2 + hstep, voffA);
            PG8_WAIT_L(8); PG8_BAR; PG8_WAIT_L(0); PG8_MMA(0, 0, At, B0); PG8_BAR; PG8_SCHED;
            PG8_LDB(B1, 1, 1); PG8_STAGE(PG8_SB(1, 0), b3, voffB);
            PG8_BAR; PG8_WAIT_L(0); PG8_MMA(0, 1, At, B1); PG8_BAR;
            PG8_LDA(At, 1, 1); PG8_STAGE(PG8_SA(1, 0), a3, voffA);
            PG8_BAR; PG8_WAIT_L(0); PG8_MMA(1, 0, At, B0); PG8_BAR; PG8_SCHED;
            PG8_STAGE(PG8_SB(1, 1), b3 + hstep, voffB);
            PG8_WAIT_V(6); PG8_BAR; PG8_MMA(1, 1, At, B1); PG8_BAR;
            }
        }
        if constexpr (ALIGN_EPI) { if (wr == 0) PG8_BAR; }
        if constexpr (!Epi::AFTER_DRAIN) { E(acc, cur, wr, wc, fr, fq); S.done(cur); }
        if (!has_next) break;
#pragma unroll
        for (int a = 0; a < 2; ++a)
#pragma unroll
            for (int b = 0; b < 2; ++b)
#pragma unroll
                for (int m = 0; m < 4; ++m)
#pragma unroll
                    for (int n = 0; n < 2; ++n) acc[a][b][m][n] = (f32x4){0.f, 0.f, 0.f, 0.f};
        cur = nxt; cA = nA; cB = nB; ++ui;
        if constexpr (ALIGN_EPI) { if (wr == 1) PG8_BAR; }
    }
    PG8_WAIT_V(0);
    if constexpr (!ALIGN_EPI) { if (wr == 0) PG8_BAR; }
    PG8_BAR;
    if constexpr (Epi::AFTER_DRAIN) { E.fused(acc, cur, wr, wc, fr, fq, lds, wid, lane); S.done(cur); }
#undef PG8_SA
#undef PG8_SB
#undef PG8_STAGE
#undef PG8_LDA
#undef PG8_LDB
#undef PG8_MMA
#undef PG8_WAIT_V
#undef PG8_WAIT_L
#undef PG8_BAR
#undef PG8_SCHED
}

template <class Epi, class Sched>
__device__ __forceinline__ void gemm_phase_rows(PG8_LAS unsigned char* lds, const Gemm g, const Sched& S, const Epi& E, const PG8_LAS int* rows) {
    const int tid = threadIdx.x, wid = __builtin_amdgcn_readfirstlane(tid >> 6), lane = tid & 63, wr = wid >> 2, wc = wid & 3, fr = lane & 15, fq = lane >> 4;
    const int K = g.K, nt = K / BK;
    unsigned voffB[2]; int R0 = 0, C0 = 0;
#pragma unroll
    for (int i = 0; i < 2; ++i) { int R, C; stage_rc(tid * 16 + i * 8192, R, C); voffB[i] = (unsigned)(R * K + C) * 2u; if (i == 0) { R0 = R; C0 = C; } }
    const size_t kstep = (size_t)(BK * 2);
    const size_t hstep = (size_t)HALF * K * 2;
    const size_t tstep = 2 * hstep;
    const unsigned ldsw = (unsigned)wid * 1024u;
    const int aoff = lds_byte(wr * 64 + fr, fq * 8), boff = lds_byte(wc * 32 + fr, fq * 8);
#define PG8_SA(b, h) (((b) * 2 + (h)) * HTB)
#define PG8_SB(b, h) ((4 + (b) * 2 + (h)) * HTB)
#define PG8_STAGE(bufoff, gbase, voff) do { _Pragma("unroll") for (int _i = 0; _i < 2; ++_i) \
        __builtin_amdgcn_global_load_lds((const unsigned*)((const char*)(gbase) + (voff)[_i]), (PG8_LAS unsigned*)(lds + (bufoff) + ldsw + _i * 8192), 16, 0, 0); } while (0)
#define PG8_LDA(dst, b, h) do { _Pragma("unroll") for (int m = 0; m < 4; ++m) _Pragma("unroll") for (int k = 0; k < 2; ++k) dst[m][k] = *(const PG8_LAS bf16x8*)(lds + PG8_SA(b, h) + aoff + m * 2048 + k * 1024); } while (0)
#define PG8_LDB(dst, b, h) do { _Pragma("unroll") for (int n = 0; n < 2; ++n) _Pragma("unroll") for (int k = 0; k < 2; ++k) dst[n][k] = *(const PG8_LAS bf16x8*)(lds + PG8_SB(b, h) + boff + n * 2048 + k * 1024); } while (0)
#define PG8_MMA(ai, bj, At, Bt) do { __builtin_amdgcn_s_setprio(1); _Pragma("unroll") for (int m = 0; m < 4; ++m) _Pragma("unroll") for (int n = 0; n < 2; ++n) _Pragma("unroll") for (int k = 0; k < 2; ++k) \
        acc[ai][bj][m][n] = __builtin_amdgcn_mfma_f32_16x16x32_bf16(Bt[n][k], At[m][k], acc[ai][bj][m][n], 0, 0, 0); __builtin_amdgcn_s_setprio(0); } while (0)
#define PG8_WAIT_V(n) asm volatile("s_waitcnt vmcnt(" #n ")" ::: "memory")
#define PG8_WAIT_L(n) asm volatile("s_waitcnt lgkmcnt(" #n ")" ::: "memory")
#define PG8_BAR __builtin_amdgcn_s_barrier()
#define PG8_SCHED __builtin_amdgcn_sched_barrier(0)
    Unit cur, nxt; int ui = 0;
    if (!S.next(0, cur)) return;
    f32x4 acc[2][2][4][2];
#pragma unroll
    for (int a = 0; a < 2; ++a)
#pragma unroll
        for (int b = 0; b < 2; ++b)
#pragma unroll
            for (int m = 0; m < 4; ++m)
#pragma unroll
                for (int n = 0; n < 2; ++n) acc[a][b][m][n] = (f32x4){0.f, 0.f, 0.f, 0.f};
    bf16x8 At[4][2], B0[2][2], B1[2][2];
    unsigned vc[4], vn[4];
#pragma unroll
    for (int q = 0; q < 4; ++q) vc[q] = ((unsigned)rows[cur.pm * 256 + R0 + 64 * q] * (unsigned)K + (unsigned)C0) * 2u;
    const char* gA = (const char*)g.A; const char* cB = (const char*)g.Bt + (size_t)(cur.pn & 0xffff) * tstep;
    PG8_STAGE(PG8_SB(0, 0), cB, voffB); PG8_STAGE(PG8_SB(0, 1), cB + hstep, voffB); PG8_STAGE(PG8_SA(0, 0), gA, vc); PG8_STAGE(PG8_SA(0, 1), gA, vc + 2);
    if (wr == 1) PG8_BAR;
    PG8_WAIT_V(2); PG8_BAR;
    PG8_STAGE(PG8_SB(1, 0), cB + kstep, voffB); PG8_STAGE(PG8_SA(1, 0), gA + kstep, vc); PG8_STAGE(PG8_SB(1, 1), cB + hstep + kstep, voffB);
    PG8_WAIT_V(6); PG8_BAR;
    for (;;) {
        const bool has_next = S.next(ui + 1, nxt);
        if (has_next) {
#pragma unroll
            for (int q = 0; q < 4; ++q) vn[q] = ((unsigned)rows[nxt.pm * 256 + R0 + 64 * q] * (unsigned)K + (unsigned)C0) * 2u;
        } else {
#pragma unroll
            for (int q = 0; q < 4; ++q) vn[q] = vc[q];
        }
        const char* nB = has_next ? (const char*)g.Bt + (size_t)(nxt.pn & 0xffff) * tstep : cB;
        const bool fullu = (cur.pn >> 16) == 0;
        for (int t = 0; t < nt; t += 2) {
            const bool last = (t == nt - 2);
            const char* a1 = gA + (size_t)(t + 1) * kstep;
            const char* a2 = last ? gA : gA + (size_t)(t + 2) * kstep; const char* b2 = last ? nB : cB + (size_t)(t + 2) * kstep;
            const char* a3 = a2 + kstep; const char* b3 = b2 + kstep;
            unsigned v2[4];
#pragma unroll
            for (int q = 0; q < 4; ++q) v2[q] = last ? vn[q] : vc[q];
            PG8_LDB(B0, 0, 0); PG8_LDB(B1, 0, 1); PG8_SCHED; PG8_LDA(At, 0, 0); PG8_STAGE(PG8_SA(1, 1), a1, vc + 2);
            PG8_WAIT_V(8); PG8_WAIT_L(0); PG8_BAR; PG8_MMA(0, 0, At, B0); PG8_MMA(0, 1, At, B1); PG8_BAR; PG8_SCHED;
            if (fullu) PG8_LDA(At, 0, 1); PG8_STAGE(PG8_SB(0, 0), b2, voffB); PG8_STAGE(PG8_SB(0, 1), b2 + hstep, voffB); PG8_STAGE(PG8_SA(0, 0), a2, v2);
            PG8_WAIT_V(8); PG8_WAIT_L(0); PG8_BAR; if (fullu) { PG8_MMA(1, 0, At, B0); PG8_MMA(1, 1, At, B1); } PG8_BAR; PG8_SCHED;
            PG8_LDB(B0, 1, 0); PG8_LDB(B1, 1, 1); PG8_SCHED; PG8_LDA(At, 1, 0); PG8_STAGE(PG8_SA(0, 1), a2, v2 + 2);
            PG8_WAIT_V(8); PG8_WAIT_L(0); PG8_BAR; PG8_MMA(0, 0, At, B0); PG8_MMA(0, 1, At, B1); PG8_BAR; PG8_SCHED;
            if (fullu) PG8_LDA(At, 1, 1); PG8_STAGE(PG8_SB(1, 0), b3, voffB); PG8_STAGE(PG8_SB(1, 1), b3 + hstep, voffB); PG8_STAGE(PG8_SA(1, 0), a3, v2);
            PG8_WAIT_V(8); PG8_WAIT_L(0); PG8_BAR; if (fullu) { PG8_MMA(1, 0, At, B0); PG8_MMA(1, 1, At, B1); } PG8_BAR; PG8_SCHED;
        }
        if (wr == 0) PG8_BAR;
        E(acc, cur, wr, wc, fr, fq);
        if (!has_next) break;
#pragma unroll
        for (int a = 0; a < 2; ++a)
#pragma unroll
            for (int b = 0; b < 2; ++b)
#pragma unroll
                for (int m = 0; m < 4; ++m)
#pragma unroll
                    for (int n = 0; n < 2; ++n) acc[a][b][m][n] = (f32x4){0.f, 0.f, 0.f, 0.f};
        cur = nxt; cB = nB; ++ui;
#pragma unroll
        for (int q = 0; q < 4; ++q) vc[q] = vn[q];
        if (wr == 1) PG8_BAR;
    }
    PG8_WAIT_V(0);
    PG8_BAR;
#undef PG8_SA
#undef PG8_SB
#undef PG8_STAGE
#undef PG8_LDA
#undef PG8_LDB
#undef PG8_MMA
#undef PG8_WAIT_V
#undef PG8_WAIT_L
#undef PG8_BAR
#undef PG8_SCHED
}
}

#ifndef PG8_SP2
#define PG8_SP2 true
#endif
struct EpiHgrnIn {
    static constexpr bool PERM = false, AFTER_DRAIN = false;
    char* ws; const float* lb;
    __device__ __forceinline__ void operator()(const pg8::f32x4 (&acc)[2][2][4][2], const pg8::Unit& u, int wr, int wc, int fr, int fq) const {
        const int seg = u.pn >> 2, cbase = (u.pn & 3) * 256 + wc * 32 + fq * 8;
        if (seg == 1) {
            unsigned short* dst = (unsigned short*)(ws + OFF_LF);
#pragma unroll
            for (int bj = 0; bj < 2; ++bj) {
                const f32x4 la0 = *(const f32x4*)(lb + cbase + bj * 128), la1 = *(const f32x4*)(lb + cbase + bj * 128 + 4);
#pragma unroll
                for (int ai = 0; ai < 2; ++ai)
#pragma unroll
                    for (int m = 0; m < 4; ++m) {
                        const size_t row = (size_t)(u.pm * 256 + ai * 128 + wr * 64 + m * 16 + fr);
                        float h[8];
#pragma unroll
                        for (int j = 0; j < 4; ++j) {
                            h[j] = __builtin_amdgcn_logf(la0[j] + (1.f - la0[j]) * sigmoid_f(acc[ai][bj][m][0][j]));
                            h[4 + j] = __builtin_amdgcn_logf(la1[j] + (1.f - la1[j]) * sigmoid_f(acc[ai][bj][m][1][j]));
                        }
                        uint4 oh; oh.x = packh2(h[0], h[1]); oh.y = packh2(h[2], h[3]); oh.z = packh2(h[4], h[5]); oh.w = packh2(h[6], h[7]);
                        *(uint4*)(dst + row * 1024 + cbase + bj * 128) = oh;
                    }
            }
        } else {
            bf16_t* dst = (bf16_t*)(ws + (seg == 0 ? OFF_QH : seg == 2 ? OFF_V : OFF_G));
#pragma unroll
            for (int ai = 0; ai < 2; ++ai)
#pragma unroll
                for (int m = 0; m < 4; ++m) {
                    const size_t row = (size_t)(u.pm * 256 + ai * 128 + wr * 64 + m * 16 + fr);
#pragma unroll
                    for (int bj = 0; bj < 2; ++bj) {
                        float h[8];
#pragma unroll
                        for (int n = 0; n < 2; ++n)
#pragma unroll
                            for (int j = 0; j < 4; ++j) { const float a = acc[ai][bj][m][n][j]; h[n * 4 + j] = (seg == 2) ? a : silu_f(a); }
                        uint4 o; o.x = pack2(h[0], h[1]); o.y = pack2(h[2], h[3]); o.z = pack2(h[4], h[5]); o.w = pack2(h[6], h[7]);
                        *(uint4*)(dst + row * 1024 + cbase + bj * 128) = o;
                    }
                }
        }
    }
};

struct EpiOutProj {
    static constexpr bool PERM = false, AFTER_DRAIN = false;
    const float* mod; const float* xin; float* xo; int ls;
    __device__ __forceinline__ void operator()(const pg8::f32x4 (&acc)[2][2][4][2], const pg8::Unit& u, int wr, int wc, int fr, int fq) const {
        const int b = (u.pm * 256) >> 11;
        const float* gate = mod + ((size_t)ls * 16 + b) * 3072 + 2048 + u.pn * 256 + wc * 32 + fq * 8;
        f32x4 g[2][2];
#pragma unroll
        for (int bj = 0; bj < 2; ++bj) { g[bj][0] = *(const f32x4*)(gate + bj * 128); g[bj][1] = *(const f32x4*)(gate + bj * 128 + 4); }
#pragma unroll
        for (int ai = 0; ai < 2; ++ai)
#pragma unroll
            for (int m = 0; m < 4; ++m) {
                const size_t ro = (size_t)(u.pm * 256 + ai * 128 + wr * 64 + m * 16 + fr) * 1024 + u.pn * 256 + wc * 32 + fq * 8;
                f32x4 xi[2][2];
#pragma unroll
                for (int bj = 0; bj < 2; ++bj) { xi[bj][0] = *(const f32x4*)(xin + ro + bj * 128); xi[bj][1] = *(const f32x4*)(xin + ro + bj * 128 + 4); }
#pragma unroll
                for (int bj = 0; bj < 2; ++bj)
#pragma unroll
                    for (int n = 0; n < 2; ++n) {
                        f32x4 o;
#pragma unroll
                        for (int j = 0; j < 4; ++j) o[j] = xi[bj][n][j] + g[bj][n][j] * acc[ai][bj][m][n][j];
                        *(f32x4*)(xo + ro + bj * 128 + n * 4) = o;
                    }
            }
    }
};


struct MoeOrder {
    const int* s_off; const int* s_toff; const int* s_hoff; int ntiles, vb, G;
    __device__ __forceinline__ void locate(int i, int& e, int& rt, int& ct, int& half) const {
        const int tile = vb + i * G, nfull = s_toff[16];
        e = 0;
        if (tile < nfull) { while (tile >= s_toff[e + 1]) ++e; const int lt = tile - s_toff[e]; rt = lt >> 2; ct = lt & 3; half = 0; }
        else { const int h = tile - nfull; while (h >= s_hoff[e + 1]) ++e; ct = h - s_hoff[e]; rt = (s_toff[e + 1] - s_toff[e]) >> 2; half = 1; }
    }
    __device__ __forceinline__ bool next(int i, pg8::Unit& u) const {
        if (vb + i * G >= ntiles) return false;
        int e, rt, ct, half; locate(i, e, rt, ct, half);
        u.pm = i; u.pn = (e * 4 + ct) | (half << 16); return true;
    }
};
struct EpiMoeUp {
    static constexpr bool PERM = false, AFTER_DRAIN = false;
    bf16_t* H1; MoeOrder S;
    __device__ __forceinline__ void operator()(const pg8::f32x4 (&acc)[2][2][4][2], const pg8::Unit& u, int wr, int wc, int fr, int fq) const {
        int e, rt, ct, half; S.locate(u.pm, e, rt, ct, half);
        const int off = S.s_off[e], cnt = S.s_off[e + 1] - off;
#pragma unroll
        for (int ai = 0; ai < 2; ++ai)
#pragma unroll
            for (int m = 0; m < 4; ++m) {
                const int pos = rt * 256 + ai * 128 + wr * 64 + m * 16 + fr;
                if (pos < cnt) {
                    float h[8];
#pragma unroll
                    for (int n = 0; n < 2; ++n)
#pragma unroll
                        for (int jj = 0; jj < 4; ++jj) h[n * 4 + jj] = silu_f(acc[ai][0][m][n][jj]) * acc[ai][1][m][n][jj];
                    uint4 o; o.x = pack2(h[0], h[1]); o.y = pack2(h[2], h[3]); o.z = pack2(h[4], h[5]); o.w = pack2(h[6], h[7]);
                    *(uint4*)(H1 + (size_t)(off + pos) * 512 + ct * 128 + wc * 32 + fq * 8) = o;
                }
            }
    }
};
struct EpiMoeDown {
    static constexpr bool PERM = false, AFTER_DRAIN = false;
    bf16_t* Y; const float* lwc; MoeOrder S;
    __device__ __forceinline__ void operator()(const pg8::f32x4 (&acc)[2][2][4][2], const pg8::Unit& u, int wr, int wc, int fr, int fq) const {
        int e, rt, ct, half; S.locate(u.pm, e, rt, ct, half);
        const int off = S.s_off[e], cnt = S.s_off[e + 1] - off;
#pragma unroll
        for (int ai = 0; ai < 2; ++ai)
#pragma unroll
            for (int m = 0; m < 4; ++m) {
                const int rl_ = ai * 128 + wr * 64 + m * 16 + fr, pos = rt * 256 + rl_;
                if (pos < cnt) {
                    const float w = lwc[u.pm * 256 + rl_];
                    bf16_t* dst = Y + (size_t)(off + pos) * 1024 + ct * 256 + wc * 32 + fq * 8;
#pragma unroll
                    for (int bj = 0; bj < 2; ++bj) {
                        const pg8::f32x4 a = acc[ai][bj][m][0], bb = acc[ai][bj][m][1];
                        uint4 o; o.x = pack2(w * a[0], w * a[1]); o.y = pack2(w * a[2], w * a[3]); o.z = pack2(w * bb[0], w * bb[1]); o.w = pack2(w * bb[2], w * bb[3]);
                        *(uint4*)(dst + bj * 128) = o;
                    }
                }
            }
    }
};

template <bool DOWN>
__device__ __forceinline__ void phase_moe8(const Params& p, const Ctx& cx, char* lds, int layer) {
    const int tid = cx.tid;
    int* s_off = (int*)(lds + LDS_TAB_OFF); int* s_toff = s_off + 17; int* s_hoff = s_toff + 17;
    moe_tables(p, layer, tid, s_off, s_toff, s_hoff);
    const int ntiles = s_toff[16] + s_hoff[16];
    const int vb = cx.vbid, G = cx.G;
    MoeOrder S{s_off, s_toff, s_hoff, ntiles, vb, G};
    const int* ltok = (const int*)(p.ws + OFF_LTOK);
    const float* lw = (const float*)(p.ws + OFF_LW);
    int* rowidx = (int*)(lds + LDS_ROWIDX_OFF);
    float* lwc = (float*)(lds + LDS_LW_OFF);
    const int my_tiles = min(8, vb < ntiles ? (ntiles - vb + G - 1) / G : 0);
    for (int i = tid; i < my_tiles * 256; i += NTHR) {
        const int j = i >> 8, r = i & 255; int e, rt, ct, half; S.locate(j, e, rt, ct, half);
        const int off = s_off[e], pos = min(rt * 256 + r, s_off[e + 1] - off - 1);
        if constexpr (DOWN) { rowidx[i] = off + pos; lwc[i] = lw[(size_t)e * NTOK + pos]; }
        else rowidx[i] = ltok[(size_t)e * NTOK + pos];
    }
    __syncthreads();
    const PG8_LAS int* rows = (const PG8_LAS int*)((PG8_LAS unsigned char*)lds + LDS_ROWIDX_OFF);
    if constexpr (DOWN) {
        pg8::Gemm g{(const bf16_t*)(p.ws + OFF_H1), (const bf16_t*)(p.ws + OFF_W_DN) + (size_t)layer * 16 * 1024 * 512, 0, 0, 512};
        EpiMoeDown E{(bf16_t*)(p.ws + OFF_Y), lwc, S};
        pg8::gemm_phase_rows<EpiMoeDown, MoeOrder>((PG8_LAS unsigned char*)lds, g, S, E, rows);
    } else {
        pg8::Gemm g{(const bf16_t*)(p.ws + OFF_HA), (const bf16_t*)(p.ws + OFF_W_UP) + (size_t)layer * 16 * 1024 * 1024, 0, 0, 1024};
        EpiMoeUp E{(bf16_t*)(p.ws + OFF_H1), S};
        pg8::gemm_phase_rows<EpiMoeUp, MoeOrder>((PG8_LAS unsigned char*)lds, g, S, E, rows);
    }
}

__device__ __forceinline__ void phase_outproj8(const Params& p, const Ctx& cx, char* lds, const bf16_t* A, const bf16_t* Bt, const float* xin, int ls) {
    pg8::Gemm g{A, Bt, NTOK, 1024, 1024};
    pg8::StaticOrder S; S.init(NTOK, 1024, cx.G, (int)blockIdx.x);
    EpiOutProj E{(const float*)(p.ws + OFF_MOD), xin, p.out, ls};
    __syncthreads();
    pg8::gemm_phase<EpiOutProj, pg8::StaticOrder, true, PG8_SP2>((PG8_LAS unsigned char*)lds, g, S, E);
    __syncthreads();
}

__device__ __forceinline__ void phase_hgrn_inproj8(const Params& p, const Ctx& cx, char* lds) {
    pg8::Gemm g{(const bf16_t*)(p.ws + OFF_HA), (const bf16_t*)(p.ws + OFF_W_HG_IN), NTOK, 4096, 1024};
    pg8::StaticOrder S; S.init(NTOK, 4096, cx.G, (int)blockIdx.x);
    EpiHgrnIn E{p.ws, (const float*)(p.ws + OFF_LB)};
    __syncthreads();
    pg8::gemm_phase<EpiHgrnIn, pg8::StaticOrder, true, PG8_SP2>((PG8_LAS unsigned char*)lds, g, S, E);
    __syncthreads();
}

template <int MODE = 0>
__device__ __forceinline__ void phase_hgrn_inproj(const Params& p, const Ctx& cx, char* lds) {
    const bf16_t* A = (const bf16_t*)(p.ws + OFF_HA);
    const bf16_t* Bt = (const bf16_t*)(p.ws + OFF_W_HG_IN);
    char* ws = p.ws;
    const float* lb = (const float*)(p.ws + OFF_LB);
    gemm_phase_dense2(A, 1024, Bt, 1024, NTOK / 256, 16, lds, cx, [=](int row0, int col0) {
        return [=](f32x4 (&acc)[8][4], int wr, int wc, int fr, int fq) {
            const int gc0 = col0 + wc * 64, seg = gc0 >> 10, c0 = gc0 & 1023;
#pragma unroll
            for (int m = 0; m < 8; ++m) {
                const int row = row0 + wr * 128 + m * 16 + fr;
#pragma unroll
                for (int pp = 0; pp < 2; ++pp) {
                    const int c = c0 + pp * 32 + fq * 8;
                    float h[8];
                    if (seg == 1) {
                        const f32x4 la = *(const f32x4*)(lb + c), lbb = *(const f32x4*)(lb + c + 4);
#pragma unroll
                        for (int j = 0; j < 4; ++j) {
                            h[j] = __logf(la[j] + (1.f - la[j]) * sigmoid_f(acc[m][2 * pp][j]));
                            h[4 + j] = __logf(lbb[j] + (1.f - lbb[j]) * sigmoid_f(acc[m][2 * pp + 1][j]));
                        }
                        uint4 oh; oh.x = packh2(h[0], h[1]); oh.y = packh2(h[2], h[3]); oh.z = packh2(h[4], h[5]); oh.w = packh2(h[6], h[7]);
                        *(uint4*)((unsigned short*)(ws + OFF_LF) + (size_t)row * 1024 + c) = oh;
                    } else {
#pragma unroll
                        for (int j = 0; j < 4; ++j) {
                            h[j] = (seg == 2) ? acc[m][2 * pp][j] : silu_f(acc[m][2 * pp][j]);
                            h[4 + j] = (seg == 2) ? acc[m][2 * pp + 1][j] : silu_f(acc[m][2 * pp + 1][j]);
                        }
                        uint4 o; o.x = pack2(h[0], h[1]); o.y = pack2(h[2], h[3]); o.z = pack2(h[4], h[5]); o.w = pack2(h[6], h[7]);
                        bf16_t* dst = (bf16_t*)(ws + (seg == 0 ? OFF_QH : seg == 2 ? OFF_V : OFF_G));
                        *(uint4*)(dst + (size_t)row * 1024 + c) = o;
                    }
                }
            }
        };
    });
}

constexpr int HG_QD_OFF = 0, HG_KD_OFF = 8704, HG_K2T_OFF = 17408, HG_VT_OFF = 27648, HG_DEC_OFF = 37888, HG_BUF = 38400, HG_TOT_OFF = 2 * HG_BUF;
constexpr int HG_ROW = 272, HG_TROW = 80;
static_assert(HG_TOT_OFF + 2048 <= LDS_TAB_OFF, "hgrn LDS");

__device__ __forceinline__ void phase_hgrn_rec(const Params& p, const Ctx& cx, char* lds) {
    const int lane = cx.lane;
    const int l31 = lane & 31, h2 = lane >> 5;
    const int widu = __builtin_amdgcn_readfirstlane(cx.wid);
    const bool producer = widu >= 4;
    const int pw = widu & 3;
    const int d0 = 2 * lane;
    const bf16_t* QH = (const bf16_t*)(p.ws + OFF_QH);
    const unsigned short* LF = (const unsigned short*)(p.ws + OFF_LF);
    const bf16_t* V = (const bf16_t*)(p.ws + OFF_V);
    bf16_t* OR = (bf16_t*)(p.ws + OFF_HA);
    float* tot = (float*)(lds + HG_TOT_OFF);
    for (int item = blockIdx.x; item < 128; item += cx.G) {
        const int b = item >> 3, h = item & 7;
        f32x16 S0, S1, S2, S3;
#pragma unroll
        for (int r = 0; r < 16; ++r) { S0[r] = 0.f; S1[r] = 0.f; S2[r] = 0.f; S3[r] = 0.f; }
        unsigned lfA[8], lfB[8], qv[8], vv[8];
        const size_t gbase = (size_t)(b * SEQ + pw * 8) * 1024 + h * 128;
        if (producer) {
#pragma unroll
            for (int i = 0; i < 8; ++i) {
                lfA[i] = *(const unsigned*)(LF + gbase + (size_t)i * 1024 + d0);
                qv[i] = *(const unsigned*)(QH + gbase + (size_t)i * 1024 + d0);
                vv[i] = *(const unsigned*)(V + gbase + (size_t)i * 1024 + d0);
            }
#pragma unroll
            for (int i = 0; i < 8; ++i) lfB[i] = *(const unsigned*)(LF + gbase + (size_t)(32 + i) * 1024 + d0);
        }
        __syncthreads();
        for (int c = 0; c <= SEQ / 32; ++c) {
            unsigned lf[8];
#pragma unroll
            for (int i = 0; i < 8; ++i) lf[i] = (c & 1) ? lfB[i] : lfA[i];
            f2_t run = {0.f, 0.f};
            if (producer && c < SEQ / 32) {
#pragma unroll
                for (int i = 0; i < 8; ++i) run += unpackh2(lf[i]);
                *(f2_t*)(tot + pw * 128 + d0) = run;
            }
            __syncthreads();
            if (producer) {
                if (c < SEQ / 32) {
                    char* bufp = lds + (c & 1) * HG_BUF;
                    f2_t pre = {0.f, 0.f}, last = {0.f, 0.f};
#pragma unroll
                    for (int q = 0; q < 4; ++q) {
                        const f2_t tq_ = *(const f2_t*)(tot + q * 128 + d0);
                        last += tq_;
                        if (q < pw) pre += tq_;
                    }
                    if (pw == 0) { f2_t dv; dv.x = __builtin_amdgcn_exp2f(last.x); dv.y = __builtin_amdgcn_exp2f(last.y); *(f2_t*)(bufp + HG_DEC_OFF + d0 * 4) = dv; }
                    float k2a[8], k2b[8];
                    f2_t rc = pre;
#pragma unroll
                    for (int i = 0; i < 8; ++i) {
                        const f2_t lfi = unpackh2(lf[i]);
                        rc += lfi;
                        const float cu0 = rc.x, cu1 = rc.y;
                        const float kk0 = 1.f - __builtin_amdgcn_exp2f(lfi.x), kk1 = 1.f - __builtin_amdgcn_exp2f(lfi.y);
                        const float q0 = bf2f((unsigned short)(qv[i] & 0xffff)) * __builtin_amdgcn_exp2f(cu0), q1 = bf2f((unsigned short)(qv[i] >> 16)) * __builtin_amdgcn_exp2f(cu1);
                        const float kd0 = kk0 * __builtin_amdgcn_exp2f(-cu0), kd1 = kk1 * __builtin_amdgcn_exp2f(-cu1);
                        k2a[i] = kk0 * __builtin_amdgcn_exp2f(last.x - cu0); k2b[i] = kk1 * __builtin_amdgcn_exp2f(last.y - cu1);
                        const int tl = pw * 8 + i;
                        *(unsigned*)(bufp + HG_QD_OFF + tl * HG_ROW + d0 * 2) = pack2(q0, q1);
                        *(unsigned*)(bufp + HG_KD_OFF + tl * HG_ROW + d0 * 2) = pack2(kd0, kd1);
                    }
                    uint4 a, bq, va, vb;
                    a.x = pack2(k2a[0], k2a[1]); a.y = pack2(k2a[2], k2a[3]); a.z = pack2(k2a[4], k2a[5]); a.w = pack2(k2a[6], k2a[7]);
                    bq.x = pack2(k2b[0], k2b[1]); bq.y = pack2(k2b[2], k2b[3]); bq.z = pack2(k2b[4], k2b[5]); bq.w = pack2(k2b[6], k2b[7]);
                    va.x = (vv[0] & 0xffffu) | (vv[1] << 16); va.y = (vv[2] & 0xffffu) | (vv[3] << 16); va.z = (vv[4] & 0xffffu) | (vv[5] << 16); va.w = (vv[6] & 0xffffu) | (vv[7] << 16);
                    vb.x = (vv[0] >> 16) | (vv[1] & 0xffff0000u); vb.y = (vv[2] >> 16) | (vv[3] & 0xffff0000u); vb.z = (vv[4] >> 16) | (vv[5] & 0xffff0000u); vb.w = (vv[6] >> 16) | (vv[7] & 0xffff0000u);
                    *(uint4*)(bufp + HG_K2T_OFF + d0 * HG_TROW + pw * 16) = a;
                    *(uint4*)(bufp + HG_K2T_OFF + (d0 + 1) * HG_TROW + pw * 16) = bq;
                    *(uint4*)(bufp + HG_VT_OFF + d0 * HG_TROW + pw * 16) = va;
                    *(uint4*)(bufp + HG_VT_OFF + (d0 + 1) * HG_TROW + pw * 16) = vb;
                    __builtin_amdgcn_sched_barrier(0);
                    if (c + 1 < SEQ / 32) {
                        const size_t gn = gbase + (size_t)(c + 1) * 32 * 1024;
#pragma unroll
                        for (int i = 0; i < 8; ++i) {
                            qv[i] = *(const unsigned*)(QH + gn + (size_t)i * 1024 + d0);
                            vv[i] = *(const unsigned*)(V + gn + (size_t)i * 1024 + d0);
                        }
                    }
                    if (c + 2 < SEQ / 32) {
                        const size_t gn = gbase + (size_t)(c + 2) * 32 * 1024;
                        if (c & 1) {
#pragma unroll
                            for (int i = 0; i < 8; ++i) lfB[i] = *(const unsigned*)(LF + gn + (size_t)i * 1024 + d0);
                        } else {
#pragma unroll
                            for (int i = 0; i < 8; ++i) lfA[i] = *(const unsigned*)(LF + gn + (size_t)i * 1024 + d0);
                        }
                    }
                }
            } else if (c >= 1) {
                const int cc = c - 1;
                const char* bufp = lds + (cc & 1) * HG_BUF;
                const float* dec = (const float*)(bufp + HG_DEC_OFF);
                f32x16 X;
#pragma unroll
                for (int r = 0; r < 16; ++r) X[r] = 0.f;
                {
                    const char* ka = bufp + HG_KD_OFF + l31 * HG_ROW + 16 * h2;
                    const char* qa = bufp + HG_QD_OFF + l31 * HG_ROW + 16 * h2;
#pragma unroll 2
                    for (int ks = 0; ks < 8; ++ks) X = MFMA32(*(const bf16x8*)(ka + 32 * ks), *(const bf16x8*)(qa + 32 * ks), X);
#pragma unroll
                    for (int r = 0; r < 16; ++r) { const int srow = (r & 3) + 8 * (r >> 2) + 4 * h2; X[r] = (srow <= l31) ? X[r] : 0.f; }
                }
                f32x16 Oa;
#pragma unroll
                for (int r = 0; r < 16; ++r) Oa[r] = 0.f;
                const int jrow = 32 * pw + l31;
#pragma unroll
                for (int s2 = 0; s2 < 2; ++s2) {
                    uint4 xk;
                    xk.x = pack2(X[8 * s2], X[8 * s2 + 1]); xk.y = pack2(X[8 * s2 + 2], X[8 * s2 + 3]); xk.z = pack2(X[8 * s2 + 4], X[8 * s2 + 5]); xk.w = pack2(X[8 * s2 + 6], X[8 * s2 + 7]);
                    const char* va = bufp + HG_VT_OFF + jrow * HG_TROW + (16 * s2 + 4 * h2) * 2;
                    const uint2 lo = *(const uint2*)va, hi = *(const uint2*)(va + 16);
                    uint4 vb; vb.x = lo.x; vb.y = lo.y; vb.z = hi.x; vb.w = hi.y;
                    Oa = MFMA32(__builtin_bit_cast(bf16x8, xk), __builtin_bit_cast(bf16x8, vb), Oa);
                }
                auto qs_term = [&](const f32x16& St, int dt) {
#pragma unroll
                    for (int s2 = 0; s2 < 2; ++s2) {
                        uint4 sk;
                        sk.x = pack2(St[8 * s2], St[8 * s2 + 1]); sk.y = pack2(St[8 * s2 + 2], St[8 * s2 + 3]); sk.z = pack2(St[8 * s2 + 4], St[8 * s2 + 5]); sk.w = pack2(St[8 * s2 + 6], St[8 * s2 + 7]);
                        const char* qa = bufp + HG_QD_OFF + l31 * HG_ROW + (32 * dt + 16 * s2 + 4 * h2) * 2;
                        const uint2 lo = *(const uint2*)qa, hi = *(const uint2*)(qa + 16);
                        uint4 qb; qb.x = lo.x; qb.y = lo.y; qb.z = hi.x; qb.w = hi.y;
                        Oa = MFMA32(__builtin_bit_cast(bf16x8, qb), __builtin_bit_cast(bf16x8, sk), Oa);
                    }
                };
                __builtin_amdgcn_sched_barrier(0);
                qs_term(S0, 0); qs_term(S1, 1);
                __builtin_amdgcn_sched_barrier(0);
                qs_term(S2, 2); qs_term(S3, 3);
                __builtin_amdgcn_sched_barrier(0);
                {
                    bf16_t* orow = OR + (size_t)(b * SEQ + cc * 32 + 4 * h2) * 1024 + h * 128 + jrow;
#pragma unroll
                    for (int r = 0; r < 16; ++r) orow[(size_t)((r & 3) + 8 * (r >> 2)) * 1024] = f2bf(Oa[r]);
                }
                auto s_update = [&](f32x16& St, int dt) {
#pragma unroll
                    for (int rq = 0; rq < 4; ++rq) {
                        const f32x4 dc = *(const f32x4*)(dec + 32 * dt + 8 * rq + 4 * h2);
                        St[4 * rq] *= dc[0]; St[4 * rq + 1] *= dc[1]; St[4 * rq + 2] *= dc[2]; St[4 * rq + 3] *= dc[3];
                    }
#pragma unroll
                    for (int s2 = 0; s2 < 2; ++s2) {
                        const bf16x8 ka = *(const bf16x8*)(bufp + HG_K2T_OFF + (32 * dt + l31) * HG_TROW + (16 * s2 + 8 * h2) * 2);
                        const bf16x8 vb = *(const bf16x8*)(bufp + HG_VT_OFF + jrow * HG_TROW + (16 * s2 + 8 * h2) * 2);
                        St = MFMA32(ka, vb, St);
                    }
                };
                __builtin_amdgcn_sched_barrier(0);
                s_update(S0, 0); s_update(S1, 1);
                __builtin_amdgcn_sched_barrier(0);
                s_update(S2, 2); s_update(S3, 3);
                __builtin_amdgcn_sched_barrier(0);
            }
            __syncthreads();
        }
    }
}

__device__ __forceinline__ void phase_hgrn_post(const Params& p, const Ctx& cx) {
    const int lane = cx.lane;
    const bf16_t* OR = (const bf16_t*)(p.ws + OFF_HA);
    const bf16_t* Gt = (const bf16_t*)(p.ws + OFF_G);
    bf16_t* OA = (bf16_t*)(p.ws + OFF_QH);
    const int col = lane * 16;
    float gn[16];
#pragma unroll
    for (int i = 0; i < 16; ++i) gn[i] = p.hgrn_out_gain[(col & 127) + i];
    for (int row = cx.vbid * NWAVE + cx.wid; row < NTOK; row += cx.G * NWAVE) {
        const uint4 a0 = *(const uint4*)(OR + (size_t)row * 1024 + col), a1 = *(const uint4*)(OR + (size_t)row * 1024 + col + 8);
        const uint4 g0 = *(const uint4*)(Gt + (size_t)row * 1024 + col), g1 = *(const uint4*)(Gt + (size_t)row * 1024 + col + 8);
        const unsigned aw[8] = {a0.x, a0.y, a0.z, a0.w, a1.x, a1.y, a1.z, a1.w};
        const unsigned gw[8] = {g0.x, g0.y, g0.z, g0.w, g1.x, g1.y, g1.z, g1.w};
        float o[16];
        float ss = 0.f;
#pragma unroll
        for (int i = 0; i < 8; ++i) { o[2 * i] = bf2f((unsigned short)(aw[i] & 0xffff)); o[2 * i + 1] = bf2f((unsigned short)(aw[i] >> 16)); ss += o[2 * i] * o[2 * i] + o[2 * i + 1] * o[2 * i + 1]; }
        ss += __shfl_xor(ss, 1); ss += __shfl_xor(ss, 2); ss += __shfl_xor(ss, 4);
        const float r = rsqrtf(ss * (1.f / 128.f) + EPS);
        unsigned w[8];
#pragma unroll
        for (int i = 0; i < 8; ++i)
            w[i] = pack2(o[2 * i] * r * gn[2 * i] * bf2f((unsigned short)(gw[i] & 0xffff)), o[2 * i + 1] * r * gn[2 * i + 1] * bf2f((unsigned short)(gw[i] >> 16)));
        uint4 o0, o1; o0.x = w[0]; o0.y = w[1]; o0.z = w[2]; o0.w = w[3]; o1.x = w[4]; o1.y = w[5]; o1.z = w[6]; o1.w = w[7];
        *(uint4*)(OA + (size_t)row * 1024 + col) = o0;
        *(uint4*)(OA + (size_t)row * 1024 + col + 8) = o1;
    }
}


#define XB_TMO      128
#define XB_XCNT(j)  (256  + 64 * (j))
#define XB_XSUB(j)  (1280 + 64 * (j))
#define XB_XGEN(j)  (2304 + 64 * (j))
#define XB_TOP      3328
#define XB_TOPGEN   3392
#define XCD_BAR_WORDS 3456
#define XB_SPIN_CAP (1u << 20)
#define LAS __attribute__((address_space(3)))
__device__ __forceinline__ unsigned xb_ld(unsigned* p)              { return __hip_atomic_load(p, __ATOMIC_RELAXED, __HIP_MEMORY_SCOPE_AGENT); }
__device__ __forceinline__ unsigned xb_add(unsigned* p, unsigned v) { return __hip_atomic_fetch_add(p, v, __ATOMIC_RELAXED, __HIP_MEMORY_SCOPE_AGENT); }
__device__ __forceinline__ unsigned xb_xcc_id() { return (unsigned)__builtin_amdgcn_s_getreg((3 << 11) | 20) & 0xFu; }
#define XB_SPIN(cond, bar) do { unsigned _sp = 0; while (cond) { __builtin_amdgcn_s_sleep(1); \
    if ((++_sp & 255u) == 0u) { if (xb_ld(&(bar)[XB_TMO])) break; if (_sp > XB_SPIN_CAP) { atomicAdd(&(bar)[XB_TMO], 1u); break; } } } } while (0)
struct XcdBarrier { unsigned* bar; unsigned x; volatile unsigned* st; };
__device__ __forceinline__ XcdBarrier xcd_barrier_post(unsigned* bar, volatile unsigned* st) {
    XcdBarrier b; b.bar = bar; b.x = xb_xcc_id(); b.st = st;
    if (threadIdx.x == 0) (void)xb_add(&bar[XB_XCNT(b.x)], 1u);
    return b;
}
__device__ __forceinline__ void xcd_barrier_complete(unsigned* bar, unsigned x, unsigned& nloc, unsigned& nx) {
    const unsigned G = gridDim.x * gridDim.y * gridDim.z;
    unsigned sum, cnt, mine, sp = 0u;
    for (;;) {
        sum = 0u; cnt = 0u; mine = 0u;
#pragma unroll
        for (unsigned j = 0; j < 16; ++j) { const unsigned c = xb_ld(&bar[XB_XCNT(j)]); sum += c; cnt += (c > 0u) ? 1u : 0u; mine = (j == x) ? c : mine; }
        if (sum == G) break;
        __builtin_amdgcn_s_sleep(1);
        if ((++sp & 255u) == 0u) { if (xb_ld(&bar[XB_TMO])) break; if (sp > XB_SPIN_CAP) { atomicAdd(&bar[XB_TMO], 1u); break; } }
    }
    nloc = mine > 0u ? mine : 1u; nx = cnt > 0u ? cnt : 1u;
}
__device__ __forceinline__ void xcd_barrier(const XcdBarrier& b) {
    asm volatile("s_waitcnt vmcnt(0)" ::: "memory");
    __syncthreads();
    if (threadIdx.x == 0) {
        unsigned* bar = b.bar;
        __builtin_amdgcn_s_waitcnt(0);
        unsigned nloc = b.st[0], nx = b.st[1];
        if (nloc == 0u) { xcd_barrier_complete(bar, b.x, nloc, nx); b.st[0] = nloc; b.st[1] = nx; }
        const unsigned old = xb_add(&bar[XB_XSUB(b.x)], 1u);
        const unsigned gen = old / nloc;
        if (old + 1u == (gen + 1u) * nloc) {
            __builtin_amdgcn_fence(__ATOMIC_RELEASE, "agent");
            asm volatile("s_waitcnt vmcnt(0)" ::: "memory");
            const unsigned og = xb_add(&bar[XB_TOP], 1u);
            const unsigned tg = og / nx;
            if (og + 1u == (tg + 1u) * nx) xb_add(&bar[XB_TOPGEN], 1u);
            else XB_SPIN(xb_ld(&bar[XB_TOPGEN]) == tg, bar);
            __builtin_amdgcn_fence(__ATOMIC_ACQUIRE, "agent");
            xb_add(&bar[XB_XGEN(b.x)], 1u);
            asm volatile("s_waitcnt vmcnt(0)" ::: "memory");
        } else {
            XB_SPIN(xb_ld(&bar[XB_XGEN(b.x)]) == gen, bar);
            __builtin_amdgcn_fence(__ATOMIC_ACQUIRE, "agent");
            asm volatile("s_waitcnt vmcnt(0)" ::: "memory");
        }
    }
    __syncthreads();
}

template <int PH>
__device__ __forceinline__ void run_phase(const Params& p, const Ctx& cx, char* lds) {
    if constexpr (PH == 0) phase0(p, cx, lds);
    else if constexpr (PH == 1) rows_phase<false, true, false>(p, cx, lds, p.x, nullptr, 0, 0, 0, 0);
    else if constexpr (PH == 2) phase_nsa_inproj(p, cx, lds);
    else if constexpr (PH == 3) {
        phase_cmp1(p, cx, lds);
        const int w = cx.vbid >= 64 ? cx.vbid - 64 : -1, nw = cx.G - 64;
        transpose_range(p, lds, cx.tid, w, nw, TC2, TC4);
        transpose_range(p, lds, cx.tid, w, nw, TC5, TC_UP1);
        transpose_range(p, lds, cx.tid, w, nw, TC6, TC_DN1);
    }
    else if constexpr (PH == 4) phase_cmp2(p, cx);
    else if constexpr (PH == 5) phase_attn(p, cx, lds);
    else if constexpr (PH == 6) phase_outproj8(p, cx, lds, (const bf16_t*)(p.ws + OFF_HA), (const bf16_t*)(p.ws + OFF_W_NSA_OUT), p.x, 0);
    else if constexpr (PH == 7) rows_router_phase(p, cx, lds, p.out, 1, 0);
    else if constexpr (PH == 8) phase_moe8<false>(p, cx, lds, 0);
    else if constexpr (PH == 9) phase_moe8<true>(p, cx, lds, 0);
    else if constexpr (PH == 10) { float* xo = p.out; asm volatile("" : "+s"(xo)); rows_phase<true, true, false>(p, cx, lds, xo, xo, 1, 2, 0, 0); }
    else if constexpr (PH == 11) phase_hgrn_inproj8(p, cx, lds);
    else if constexpr (PH == 12) {
        phase_hgrn_rec(p, cx, lds);
        const int w = (int)blockIdx.x >= 128 ? (int)blockIdx.x - 128 : -1, nw = cx.G - 128;
        transpose_range(p, lds, cx.tid, w, nw, TC_UP1, TC6);
        transpose_range(p, lds, cx.tid, w, nw, TC_DN1, TC_END);
    }
    else if constexpr (PH == 13) phase_hgrn_post(p, cx);
    else if constexpr (PH == 14) phase_outproj8(p, cx, lds, (const bf16_t*)(p.ws + OFF_QH), (const bf16_t*)(p.ws + OFF_W_HG_OUT), p.out, 2);
    else if constexpr (PH == 15) rows_router_phase(p, cx, lds, p.out, 3, 1);
    else if constexpr (PH == 16) phase_moe8<false>(p, cx, lds, 1);
    else if constexpr (PH == 17) phase_moe8<true>(p, cx, lds, 1);
    else if constexpr (PH == 18) { float* xo = p.out; asm volatile("" : "+s"(xo)); rows_phase<true, false, false>(p, cx, lds, xo, xo, 3, 0, 0, 1); }
}

__device__ __forceinline__ Ctx make_ctx() {
    Ctx cx;
    cx.G = gridDim.x; cx.tid = threadIdx.x; cx.wid = threadIdx.x >> 6; cx.lane = threadIdx.x & 63;
    cx.vbid = (cx.G % 8 == 0) ? (blockIdx.x % 8) * (cx.G / 8) + blockIdx.x / 8 : blockIdx.x;
    return cx;
}

#if MULTI_LAUNCH
template <int PH>
__global__ void __launch_bounds__(NTHR, 2) phase_kernel(Params p) {
    extern __shared__ __attribute__((aligned(16))) char lds[];
    const Ctx cx = make_ctx();
    run_phase<PH>(p, cx, lds);
}
template <int PH>
static void launch_phases(const Params& p, int grid, hipStream_t stream) {
    (void)hipFuncSetAttribute((const void*)phase_kernel<PH>, hipFuncAttributeMaxDynamicSharedMemorySize, LDS_BYTES);
    hipLaunchKernelGGL(phase_kernel<PH>, dim3(grid), dim3(NTHR), LDS_BYTES, stream, p);
    if constexpr (PH + 1 < NPHASE) launch_phases<PH + 1>(p, grid, stream);
}
#else
template <int PH>
__device__ __forceinline__ void run_from(const Params& p, const Ctx& cx, char* lds, cg::grid_group& grid, const XcdBarrier& xb) {
    {
        int t_ = threadIdx.x, b_ = blockIdx.x;
        asm volatile("" : "+v"(t_), "+s"(b_));
        Ctx c2;
        c2.G = gridDim.x; c2.tid = t_; c2.wid = t_ >> 6; c2.lane = t_ & 63;
        c2.vbid = (c2.G % 8 == 0) ? (b_ % 8) * (c2.G / 8) + b_ / 8 : b_;
        run_phase<PH>(p, c2, lds);
#ifdef PROBE_MASK
        if constexpr ((PROBE_MASK >> PH) & 1) { xcd_barrier(xb); run_phase<PH>(p, c2, lds); }
#endif
    }
    if constexpr (PH + 1 < NPHASE) {
        if constexpr (PH == 0) grid.sync();
        else xcd_barrier(xb);
        run_from<PH + 1>(p, cx, lds, grid, xb);
    }
}
__global__ void __launch_bounds__(NTHR, 2) mega_kernel(Params p) {
    extern __shared__ __attribute__((aligned(16))) char lds[];
    cg::grid_group grid = cg::this_grid();
    const Ctx cx = make_ctx();
    volatile unsigned* st = (volatile unsigned*)(lds + LDS_BYTES - 16);
    if (threadIdx.x == 0) { st[0] = 0u; st[1] = 0u; }
    __syncthreads();
    const XcdBarrier xb = xcd_barrier_post((unsigned*)(p.ws + OFF_BAR), st);
    run_from<0>(p, cx, lds, grid, xb);
}
#endif

extern "C" void kernel_launch(void* const* d_in, const int* in_sizes, int n_in, void* d_out, int out_size, void* d_ws, size_t ws_size,
                              hipStream_t stream) {
    static int grid = 0;
    if (!grid) {
        int dev = 0, cus = 0, per_cu = 0;
        (void)hipGetDevice(&dev);
        (void)hipDeviceGetAttribute(&cus, hipDeviceAttributeMultiprocessorCount, dev);
#if MULTI_LAUNCH
        per_cu = 1;
#else
        (void)hipFuncSetAttribute((const void*)mega_kernel, hipFuncAttributeMaxDynamicSharedMemorySize, LDS_BYTES);
        (void)hipOccupancyMaxActiveBlocksPerMultiprocessor(&per_cu, mega_kernel, NTHR, LDS_BYTES);
        if (per_cu > 1) per_cu = 1;
        if (per_cu < 1) { fprintf(stderr, "kernel_launch: occupancy query says 0 blocks per CU (LDS %d B)\n", LDS_BYTES); per_cu = 1; }
#endif
        if (cus <= 0) cus = 256;
        grid = cus * per_cu;
        if (ws_size < WS_NEED) fprintf(stderr, "kernel_launch: workspace too small: %zu < %zu\n", ws_size, (size_t)WS_NEED);
    }
    Params p{};
    p.x = (const float*)d_in[0]; p.c = (const float*)d_in[1]; p.ada_w = (const float*)d_in[2]; p.ada_b = (const float*)d_in[3];
    p.norm_g = (const float*)d_in[4]; p.rel_bias = (const float*)d_in[5]; p.nsa_w_in = (const float*)d_in[6]; p.nsa_q_gain = (const float*)d_in[7];
    p.nsa_k_gain = (const float*)d_in[8]; p.nsa_cmp_pe = (const float*)d_in[9]; p.nsa_cmp_w1 = (const float*)d_in[10]; p.nsa_cmp_w2 = (const float*)d_in[11];
    p.nsa_w_out = (const float*)d_in[12]; p.hgrn_w_in = (const float*)d_in[13]; p.hgrn_lb = (const float*)d_in[14]; p.hgrn_out_gain = (const float*)d_in[15];
    p.hgrn_w_out = (const float*)d_in[16]; p.moe_rg = (const float*)d_in[17]; p.moe_re = (const float*)d_in[18]; p.moe_w1 = (const float*)d_in[19];
    p.moe_w3 = (const float*)d_in[20]; p.moe_w2 = (const float*)d_in[21];
    p.out = (float*)d_out; p.ws = (char*)d_ws;
#if MULTI_LAUNCH
    launch_phases<0>(p, grid, stream);
#else
    p.p_begin = 0; p.p_end = NPHASE;
    (void)hipMemsetAsync((char*)d_ws + OFF_BAR, 0, XCD_BAR_WORDS * 4, stream);
    void* args[] = {&p};
    hipError_t e = hipLaunchCooperativeKernel((void*)mega_kernel, dim3(grid), dim3(NTHR), args, LDS_BYTES, stream);
    if (e != hipSuccess) fprintf(stderr, "cooperative launch failed: %s (grid %d)\n", hipGetErrorString(e), grid);
#endif
}
```

```cpp
#include <hip/hip_runtime.h>
#include <hip/hip_cooperative_groups.h>
#include <cstdio>
#include <cstdint>
namespace cg = cooperative_groups;

#ifndef MULTI_LAUNCH
#define MULTI_LAUNCH 0
#endif

typedef unsigned short bf16_t;
typedef short bf16x8 __attribute__((ext_vector_type(8)));
typedef float f32x4 __attribute__((ext_vector_type(4)));
typedef float f32x16 __attribute__((ext_vector_type(16)));

constexpr int NTOK = 32768, DM = 1024, SEQ = 2048, NBATCH = 16;
constexpr int NSA_IN = 2608, NSA_IN_PAD = 2816;
constexpr float EPS = 1e-6f;
constexpr size_t MiB = 1ull << 20;

constexpr size_t OFF_CNT = 0;
constexpr size_t OFF_MOD = 4096;
constexpr size_t OFF_LB = OFF_MOD + 786432;
constexpr size_t OFF_PEB = OFF_LB + 4096;
constexpr size_t OFF_BAR = 921600;
constexpr size_t OFF_W_NSA_IN = 1 * MiB;
constexpr size_t OFF_W_NSA_OUT = OFF_W_NSA_IN + 2816ull * 1024 * 2;
constexpr size_t OFF_W_HG_IN = OFF_W_NSA_OUT + 1024ull * 1024 * 2;
constexpr size_t OFF_W_HG_OUT = OFF_W_HG_IN + 4096ull * 1024 * 2;
constexpr size_t OFF_W_CMP1 = OFF_W_HG_OUT + 1024ull * 1024 * 2;
constexpr size_t OFF_W_UP = OFF_W_CMP1 + 2ull * 128 * 2048 * 2;
constexpr size_t OFF_W_DN = OFF_W_UP + 32ull * 1024 * 1024 * 2;
constexpr size_t OFF_W_END = OFF_W_DN + 32ull * 1024 * 512 * 2;
constexpr size_t OFF_HA = 116 * MiB;
static_assert(OFF_W_END <= OFF_HA, "weights overflow");
constexpr size_t OFF_SCR = 180 * MiB;
constexpr size_t OFF_Q = OFF_SCR;
constexpr size_t OFF_KCRAW = OFF_Q + 64 * MiB;
constexpr size_t OFF_VCRAW = OFF_KCRAW + 17 * MiB;
constexpr size_t OFF_KS = OFF_VCRAW + 17 * MiB;
constexpr size_t OFF_VS = OFF_KS + 16 * MiB;
constexpr size_t OFF_KW = OFF_VS + 16 * MiB;
constexpr size_t OFF_VW = OFF_KW + 16 * MiB;
constexpr size_t OFF_GATES = OFF_VW + 16 * MiB;
constexpr size_t OFF_T1 = OFF_GATES + 6 * MiB;
constexpr size_t OFF_KC = OFF_T1 + 4 * MiB;
constexpr size_t OFF_VC = OFF_KC + 1 * MiB;
constexpr size_t OFF_H1 = OFF_SCR;
constexpr size_t OFF_Y = OFF_H1 + 64 * MiB;
constexpr size_t OFF_LTOK = OFF_Y + 128 * MiB;
constexpr size_t OFF_LW = OFF_LTOK + 2 * MiB;
constexpr size_t OFF_TSLOT = OFF_LW + 2 * MiB;
constexpr size_t OFF_QH = OFF_SCR;
constexpr size_t OFF_LF = OFF_QH + 64 * MiB;
constexpr size_t OFF_V = OFF_LF + 128 * MiB;
constexpr size_t OFF_G = OFF_V + 64 * MiB;
constexpr size_t WS_NEED = OFF_G + 64 * MiB;
static_assert(WS_NEED <= 512 * MiB, "ws overflow");

constexpr int NTHR = 512, NWAVE = 8;
constexpr int GEMM_STAGE = 49152, GEMM_NSTAGE = 3;
constexpr int LDS_TAB_OFF = GEMM_STAGE * GEMM_NSTAGE;
constexpr int LDS_BYTES = LDS_TAB_OFF + 256 + 16;
constexpr int NPHASE = 19;

struct Params {
    const float *x, *c, *ada_w, *ada_b, *norm_g, *rel_bias, *nsa_w_in, *nsa_q_gain, *nsa_k_gain, *nsa_cmp_pe, *nsa_cmp_w1,
        *nsa_cmp_w2, *nsa_w_out, *hgrn_w_in, *hgrn_lb, *hgrn_out_gain, *hgrn_w_out, *moe_rg, *moe_re, *moe_w1, *moe_w3, *moe_w2;
    float* out;
    char* ws;
    int p_begin, p_end;
};

__device__ __forceinline__ float bf2f(unsigned short h) { return __uint_as_float((unsigned)h << 16); }
__device__ __forceinline__ unsigned short f2bf(float f) {
    unsigned u = __float_as_uint(f);
    u += 0x7fffu + ((u >> 16) & 1u);
    return (unsigned short)(u >> 16);
}
typedef __bf16 bf2_t __attribute__((ext_vector_type(2)));
typedef float f2_t __attribute__((ext_vector_type(2)));
__device__ __forceinline__ unsigned pack2(float a, float b) {
    f2_t v = {a, b};
    return __builtin_bit_cast(unsigned, __builtin_convertvector(v, bf2_t));
}
typedef _Float16 h2_t __attribute__((ext_vector_type(2)));
__device__ __forceinline__ unsigned packh2(float a, float b) { f2_t v = {a, b}; return __builtin_bit_cast(unsigned, __builtin_convertvector(v, h2_t)); }
__device__ __forceinline__ f2_t unpackh2(unsigned u) { return __builtin_convertvector(__builtin_bit_cast(h2_t, u), f2_t); }
template <int CTRL> __device__ __forceinline__ float dpp_mov(float v) { return __builtin_bit_cast(float, __builtin_amdgcn_update_dpp(0, __builtin_bit_cast(int, v), CTRL, 0xf, 0xf, true)); }
__device__ __forceinline__ float wave_sum(float v) {
    v += dpp_mov<0xB1>(v);
    v += dpp_mov<0x4E>(v);
    v += dpp_mov<0x141>(v);
    v += dpp_mov<0x140>(v);
    const int iv = __builtin_bit_cast(int, v);
    const float s0 = __builtin_bit_cast(float, __builtin_amdgcn_readlane(iv, 0)), s1 = __builtin_bit_cast(float, __builtin_amdgcn_readlane(iv, 16));
    const float s2 = __builtin_bit_cast(float, __builtin_amdgcn_readlane(iv, 32)), s3 = __builtin_bit_cast(float, __builtin_amdgcn_readlane(iv, 48));
    return (s0 + s1) + (s2 + s3);
}
__device__ __forceinline__ float wave_max(float v) {
#pragma unroll
    for (int o = 32; o; o >>= 1) v = fmaxf(v, __shfl_xor(v, o));
    return v;
}
__device__ __forceinline__ float silu_f(float x) { return x * __builtin_amdgcn_rcpf(1.f + __builtin_amdgcn_exp2f(-1.4426950408889634f * x)); }
__device__ __forceinline__ float sigmoid_f(float x) { return __builtin_amdgcn_rcpf(1.f + __builtin_amdgcn_exp2f(-1.4426950408889634f * x)); }
__device__ __forceinline__ void glds16(const void* g, void* l) {
    __builtin_amdgcn_global_load_lds((const unsigned*)g, (unsigned*)l, 16, 0, 0);
}
__device__ __forceinline__ int t5_bucket(int n) {
    if (n < 16) return n;
    int b = 16;
    b += (n >= 21); b += (n >= 27); b += (n >= 35); b += (n >= 46); b += (n >= 59); b += (n >= 77); b += (n >= 99); b += (n >= 128);
    b += (n >= 166); b += (n >= 216); b += (n >= 280); b += (n >= 363); b += (n >= 470); b += (n >= 609); b += (n >= 790);
    return b;
}

struct Ctx {
    int G, vbid, tid, wid, lane;
};

constexpr int P0_MOD_ITEMS = 192;
constexpr int TS0 = 88 * 16, TS1 = 32 * 16, TS2 = 128 * 16, TS3 = 32 * 16, TS4 = 2 * 4 * 32, TS5 = 32 * 32 * 16, TS6 = 32 * 32 * 8;
constexpr int TC0 = 0, TC1 = TC0 + TS0, TC2 = TC1 + TS1, TC3 = TC2 + TS2, TC4 = TC3 + TS3, TC5 = TC4 + TS4, TC6 = TC5 + TS5, TC_END = TC6 + TS6;

struct TrJob { const float* src; int ld, c0, ncols_valid, k0; bf16_t* dst; int dstld; int perm; };
__device__ __forceinline__ int pcol(int n, int fq) { return (n >> 1) * 32 + fq * 8 + (n & 1) * 4; }
__device__ __forceinline__ void tr_load(const TrJob& j, float* tl, int htid) {
    const int k = htid >> 2, cc = (htid & 3) * 8;
    const float* s = j.src + (size_t)(j.k0 + k) * j.ld + j.c0 + cc;
    f32x4 a = {0.f, 0.f, 0.f, 0.f}, c = a;
    if (j.c0 + 32 <= j.ncols_valid) { a = *(const f32x4*)s; c = *(const f32x4*)(s + 4); }
    else {
#pragma unroll
        for (int i = 0; i < 4; ++i) { if (j.c0 + cc + i < j.ncols_valid) a[i] = s[i]; if (j.c0 + cc + 4 + i < j.ncols_valid) c[i] = s[4 + i]; }
    }
#pragma unroll
    for (int i = 0; i < 4; ++i) { tl[k * 33 + cc + i] = a[i]; tl[k * 33 + cc + 4 + i] = c[i]; }
}
__device__ __forceinline__ void tr_store(const TrJob& j, const float* tl, int htid) {
    const int nsrc = htid >> 3, kc = (htid & 7) * 8;
    const int n = nsrc;
    const int nd = j.perm ? (((nsrc >> 2) & 1) * 16 + (nsrc >> 3) * 4 + (nsrc & 3)) : nsrc;
    uint4 o;
    o.x = pack2(tl[(kc + 0) * 33 + n], tl[(kc + 1) * 33 + n]); o.y = pack2(tl[(kc + 2) * 33 + n], tl[(kc + 3) * 33 + n]);
    o.z = pack2(tl[(kc + 4) * 33 + n], tl[(kc + 5) * 33 + n]); o.w = pack2(tl[(kc + 6) * 33 + n], tl[(kc + 7) * 33 + n]);
    *(uint4*)(j.dst + (size_t)nd * j.dstld + kc) = o;
}
__device__ __forceinline__ TrJob tr_job(const Params& p, int tt) {
    TrJob j;
    if (tt < TC1) {
        const int nt = tt / 16, kt = tt % 16;
        j = {p.nsa_w_in, NSA_IN, nt * 32, NSA_IN, kt * 64, (bf16_t*)(p.ws + OFF_W_NSA_IN) + (size_t)nt * 32 * 1024 + kt * 64, 1024, 1};
    } else if (tt < TC2) {
        const int u = tt - TC1, nt = u / 16, kt = u % 16;
        j = {p.nsa_w_out, 1024, nt * 32, 1024, kt * 64, (bf16_t*)(p.ws + OFF_W_NSA_OUT) + (size_t)nt * 32 * 1024 + kt * 64, 1024, 1};
    } else if (tt < TC3) {
        const int u = tt - TC2, nt = u / 16, kt = u % 16;
        j = {p.hgrn_w_in, 4096, nt * 32, 4096, kt * 64, (bf16_t*)(p.ws + OFF_W_HG_IN) + (size_t)nt * 32 * 1024 + kt * 64, 1024, 1};
    } else if (tt < TC4) {
        const int u = tt - TC3, nt = u / 16, kt = u % 16;
        j = {p.hgrn_w_out, 1024, nt * 32, 1024, kt * 64, (bf16_t*)(p.ws + OFF_W_HG_OUT) + (size_t)nt * 32 * 1024 + kt * 64, 1024, 1};
    } else if (tt < TC5) {
        const int u = tt - TC4, kv = u / 128, r = u % 128, nt = r / 32, kt = r % 32;
        j = {p.nsa_cmp_w1 + (size_t)kv * 2048 * 64, 64, nt * 32, 64, kt * 64, (bf16_t*)(p.ws + OFF_W_CMP1) + ((size_t)kv * 128 + nt * 32) * 2048 + kt * 64, 2048, 0};
    } else if (tt < TC6) {
        const int u = tt - TC5, le = u / 512, r = u % 512, gr = r / 16, kt = r % 16;
        const int ct = gr >> 3, which = (gr >> 2) & 1, sub = gr & 3;
        const float* src = (which ? p.moe_w3 : p.moe_w1) + (size_t)le * 1024 * 512;
        j = {src, 512, (ct * 4 + sub) * 32, 512, kt * 64, (bf16_t*)(p.ws + OFF_W_UP) + ((size_t)le * 1024 + gr * 32) * 1024 + kt * 64, 1024, 1};
    } else {
        const int u = tt - TC6, le = u / 256, r = u % 256, nt = r / 8, kt = r % 8;
        j = {p.moe_w2 + (size_t)le * 512 * 1024, 1024, nt * 32, 1024, kt * 64, (bf16_t*)(p.ws + OFF_W_DN) + ((size_t)le * 1024 + nt * 32) * 512 + kt * 64, 512, 1};
    }
    return j;
}

__device__ __forceinline__ void transpose_range(const Params& p, char* lds, int tid, int worker, int nworkers, int lo, int hi) {
    if (worker < 0) return;
    constexpr int TPH = 4;
    const int half = tid >> 8, htid = tid & 255;
    float* tl = (float*)lds + half * (TPH * 64 * 33);
    for (int base = lo + worker * 2 * TPH; base < hi; base += nworkers * 2 * TPH) {
#pragma unroll
        for (int q = 0; q < TPH; ++q) {
            const int tt = base + half * TPH + q;
            if (tt < hi) { const TrJob j = tr_job(p, tt); tr_load(j, tl + q * (64 * 33), htid); }
        }
        __syncthreads();
#pragma unroll
        for (int q = 0; q < TPH; ++q) {
            const int tt = base + half * TPH + q;
            if (tt < hi) { const TrJob j = tr_job(p, tt); tr_store(j, tl + q * (64 * 33), htid); }
        }
        __syncthreads();
    }
}
constexpr int TC_UP1 = TC5 + 16 * 512, TC_DN1 = TC6 + 16 * 256;

__device__ __forceinline__ void phase0(const Params& p, const Ctx& cx, char* lds) {
    const int tid = cx.tid, wid = cx.wid, lane = cx.lane;
    for (int it = cx.vbid; it < P0_MOD_ITEMS; it += cx.G) {
        const int colbase = it * 64, ls = colbase / 3072, e0 = colbase % 3072;
        const float* W = p.ada_w + (size_t)ls * 1024 * 3072 + e0 + lane;
        float* cs = (float*)lds + wid * 1024;
        float* red = (float*)lds + 8192;
        float acc[16];
#pragma unroll
        for (int b = 0; b < 16; ++b) acc[b] = 0.f;
        for (int sub = 0; sub < 2; ++sub) {
            const int kb = wid * 128 + sub * 64;
#pragma unroll
            for (int b = 0; b < 16; ++b) cs[lane * 16 + b] = silu_f(p.c[b * 1024 + kb + lane]);
            __builtin_amdgcn_wave_barrier();
#pragma unroll 1
            for (int k16 = 0; k16 < 64; k16 += 16) {
                float wv[16];
#pragma unroll
                for (int u = 0; u < 16; ++u) wv[u] = W[(size_t)(kb + k16 + u) * 3072];
#pragma unroll
                for (int u = 0; u < 16; ++u) {
                    const float w = wv[u];
                    const f32x4* cv = (const f32x4*)(cs + (k16 + u) * 16);
#pragma unroll
                    for (int q = 0; q < 4; ++q) {
                        f32x4 c4 = cv[q];
                        acc[q * 4 + 0] += c4[0] * w; acc[q * 4 + 1] += c4[1] * w; acc[q * 4 + 2] += c4[2] * w; acc[q * 4 + 3] += c4[3] * w;
                    }
                }
            }
            __builtin_amdgcn_wave_barrier();
        }
#pragma unroll
        for (int b = 0; b < 16; ++b) red[(wid * 16 + b) * 64 + lane] = acc[b];
        __syncthreads();
        float* mod = (float*)(p.ws + OFF_MOD);
#pragma unroll
        for (int i = 0; i < 2; ++i) {
            const int o = tid + i * NTHR, b = o >> 6, e = o & 63;
            float sm = 0.f;
#pragma unroll
            for (int w = 0; w < 8; ++w) sm += red[(w * 16 + b) * 64 + e];
            mod[((size_t)ls * 16 + b) * 3072 + e0 + e] = sm + p.ada_b[ls * 3072 + e0 + e];
        }
        __syncthreads();
    }
    transpose_range(p, lds, tid, cx.vbid, cx.G, TC0, TC2);
    transpose_range(p, lds, tid, cx.vbid, cx.G, TC4, TC5);
    if (cx.vbid == cx.G - 1) {
        float* lb = (float*)(p.ws + OFF_LB);
        for (int i = tid; i < 1024; i += NTHR) lb[i] = sigmoid_f(p.hgrn_lb[1024 + i] - p.hgrn_lb[i]);
        if (tid < 128) {
            const int kv = tid >> 6, d = tid & 63;
            const float* pe = p.nsa_cmp_pe + kv * 2048;
            const float* w1 = p.nsa_cmp_w1 + (size_t)kv * 2048 * 64 + d;
            float sm = 0.f;
            for (int k = 0; k < 2048; ++k) sm += pe[k] * w1[(size_t)k * 64];
            ((float*)(p.ws + OFF_PEB))[tid] = sm;
        }
        if (tid < 32) ((int*)(p.ws + OFF_CNT))[tid] = 0;
    }
}

#ifndef ROWS_D_COMB
#define ROWS_D_COMB 3
#endif
#ifndef ROWS_D_NORM
#define ROWS_D_NORM 4
#endif
template <bool COMBINE, bool NORM, bool ROUTER>
__device__ __forceinline__ void rows_phase(const Params& p, const Ctx& cx, char* lds, const float* __restrict__ src, float* __restrict__ xdst,
                           int ls_comb, int ls_norm, int layer_router, int layer_comb) {
    static_assert(!ROUTER, "router rows use rows_router_phase");
    constexpr int D = COMBINE ? ROWS_D_COMB : ROWS_D_NORM;
    const int lane = cx.lane;
    const float* mod = (const float*)(p.ws + OFF_MOD);
    int my_off = 0;
    if (COMBINE) {
        const int* cnt = (const int*)(p.ws + OFF_CNT) + layer_comb * 16;
        int cv[15];
#pragma unroll
        for (int e = 0; e < 15; ++e) cv[e] = cnt[e];
#pragma unroll
        for (int e = 0; e < 15; ++e) my_off += (e < lane) ? cv[e] : 0;
    }
    const int rpw = (NTOK + cx.G * NWAVE - 1) / (cx.G * NWAVE);
    const int row_begin = (cx.vbid * NWAVE + cx.wid) * rpw, row_end = min(NTOK, row_begin + rpw);
    if (row_begin >= row_end) return;
    const bf16_t* Y = (const bf16_t*)(p.ws + OFF_Y);
    const int* tsl = (const int*)(p.ws + OFF_TSLOT);
    bf16_t* hA = (bf16_t*)(p.ws + OFF_HA);
    const float* gain = p.norm_g + ls_norm * 1024;
    int tw = 0;
    if (COMBINE) tw = (lane < 2 * (row_end - row_begin)) ? tsl[row_begin * 2 + lane] : 0;
    f32x4 vr[D][4];
    uint4 yar[D][2], ycr[D][2];
    auto fill = [&](int k, int row) {
#pragma unroll
        for (int i = 0; i < 4; ++i) vr[k][i] = *(const f32x4*)(src + (size_t)row * 1024 + ((i >> 1) * 64 + lane) * 8 + (i & 1) * 4);
        if (COMBINE) {
            const int li = __builtin_amdgcn_readfirstlane((row - row_begin) * 2);
            const int sa = __builtin_amdgcn_readlane(tw, li), sb = __builtin_amdgcn_readlane(tw, li + 1);
            const size_t ra = (size_t)(__builtin_amdgcn_readlane(my_off, sa >> 16) + (sa & 0xffff)) * 1024;
            const size_t rc = (size_t)(__builtin_amdgcn_readlane(my_off, sb >> 16) + (sb & 0xffff)) * 1024;
#pragma unroll
            for (int h = 0; h < 2; ++h) { yar[k][h] = *(const uint4*)(Y + ra + (h * 64 + lane) * 8); ycr[k][h] = *(const uint4*)(Y + rc + (h * 64 + lane) * 8); }
        }
    };
    f32x4 gt[4], ca[4], cb[4];
    auto load_vectors = [&](int b) {
#pragma unroll
        for (int i = 0; i < 4; ++i) {
            const int col = ((i >> 1) * 64 + lane) * 8 + (i & 1) * 4;
            if (COMBINE) gt[i] = *(const f32x4*)(mod + ((size_t)ls_comb * 16 + b) * 3072 + 2048 + col);
            if (NORM) {
                const float* shift = mod + ((size_t)ls_norm * 16 + b) * 3072;
                const f32x4 g = *(const f32x4*)(gain + col), sc = *(const f32x4*)(shift + 1024 + col);
                ca[i] = g * (sc + 1.f);
                cb[i] = *(const f32x4*)(shift + col);
            }
        }
    };
    auto do_row = [&](int k, int row, bool refill, int rrow) {
        f32x4 v[4];
#pragma unroll
        for (int i = 0; i < 4; ++i) v[i] = vr[k][i];
        if (COMBINE) {
#pragma unroll
            for (int h = 0; h < 2; ++h) {
                const uint4 ya = yar[k][h], yc = ycr[k][h];
                const unsigned aw[4] = {ya.x, ya.y, ya.z, ya.w}, cw[4] = {yc.x, yc.y, yc.z, yc.w};
#pragma unroll
                for (int q = 0; q < 2; ++q) {
                    const int i = h * 2 + q;
                    v[i][0] += gt[i][0] * (bf2f(aw[2 * q] & 0xffff) + bf2f(cw[2 * q] & 0xffff));
                    v[i][1] += gt[i][1] * (bf2f(aw[2 * q] >> 16) + bf2f(cw[2 * q] >> 16));
                    v[i][2] += gt[i][2] * (bf2f(aw[2 * q + 1] & 0xffff) + bf2f(cw[2 * q + 1] & 0xffff));
                    v[i][3] += gt[i][3] * (bf2f(aw[2 * q + 1] >> 16) + bf2f(cw[2 * q + 1] >> 16));
                    *(f32x4*)(xdst + (size_t)row * 1024 + (h * 64 + lane) * 8 + q * 4) = v[i];
                }
            }
        }
        if (refill) fill(k, rrow);
        if (NORM) {
            float ss = 0.f;
#pragma unroll
            for (int i = 0; i < 4; ++i) ss += v[i][0] * v[i][0] + v[i][1] * v[i][1] + v[i][2] * v[i][2] + v[i][3] * v[i][3];
            ss = wave_sum(ss);
            const float r = rsqrtf(ss * (1.f / 1024.f) + EPS);
#pragma unroll
            for (int h = 0; h < 2; ++h) {
                float hh[8];
#pragma unroll
                for (int q = 0; q < 2; ++q)
#pragma unroll
                    for (int j = 0; j < 4; ++j) hh[q * 4 + j] = v[h * 2 + q][j] * r * ca[h * 2 + q][j] + cb[h * 2 + q][j];
                uint4 o; o.x = pack2(hh[0], hh[1]); o.y = pack2(hh[2], hh[3]); o.z = pack2(hh[4], hh[5]); o.w = pack2(hh[6], hh[7]);
                *(uint4*)(hA + (size_t)row * 1024 + (h * 64 + lane) * 8) = o;
            }
        }
    };
    if (rpw == 8 && row_end - row_begin == 8) {
#pragma unroll
        for (int k = 0; k < D; ++k) fill(k, row_begin + k);
        load_vectors(row_begin >> 11);
#pragma unroll
        for (int r = 0; r < 8; ++r) do_row(r % D, row_begin + r, r + D < 8, row_begin + r + D);
        return;
    }
    int bcur = -1;
    fill(0, row_begin);
    for (int row = row_begin; row < row_end; ++row) {
        const int b = row >> 11;
        if (b != bcur) { bcur = b; load_vectors(b); }
        if (row + 1 < row_end) { fill(1, row + 1); do_row(0, row, false, 0);
#pragma unroll
            for (int i = 0; i < 4; ++i) { vr[0][i] = vr[1][i]; if (COMBINE && i < 2) { yar[0][i] = yar[1][i]; ycr[0][i] = ycr[1][i]; } } }
        else do_row(0, row, false, 0);
    }
}

__device__ __forceinline__ void rows_router_phase(const Params& p, const Ctx& cx, char* lds, const float* __restrict__ src, int ls_norm, int layer) {
    const int lane = cx.lane, tid = cx.tid;
    const int widu = __builtin_amdgcn_readfirstlane(cx.wid);
    const int wq = widu & 3, grp4 = widu >> 2;
    const float* mod = (const float*)(p.ws + OFF_MOD);
    const float* rg = p.moe_rg + (size_t)layer * 1024 * 4;
    const float* re = p.moe_re + (size_t)layer * 1024 * 16;
    float* logit_s = (float*)lds;
    float wr[16][5];
#pragma unroll
    for (int i = 0; i < 4; ++i)
#pragma unroll
        for (int j = 0; j < 4; ++j) {
            const int k = (i * 64 + lane) * 4 + j;
#pragma unroll
            for (int q = 0; q < 5; ++q) {
                const int o = 5 * wq + q;
                wr[i * 4 + j][q] = (o < 4) ? rg[k * 4 + o] : re[k * 16 + o - 4];
            }
            __builtin_amdgcn_sched_barrier(0);
        }
    const float* gain = p.norm_g + ls_norm * 1024;
    bf16_t* hA = (bf16_t*)(p.ws + OFF_HA);
    int* lcnt = (int*)(lds + 16384);
    if (tid < 32) lcnt[tid] = 0;
    int nstep = 0;
    for (int blk = cx.vbid; blk < NTOK / 32; blk += cx.G, ++nstep) {
        const int R0 = blk * 32, b = R0 >> 11;
        const float* shift = mod + ((size_t)ls_norm * 16 + b) * 3072;
        const float* scale = shift + 1024;
        f32x4 ca[4], cb[4];
#pragma unroll
        for (int i = 0; i < 4; ++i) {
            const int col = (i * 64 + lane) * 4;
            const f32x4 g = *(const f32x4*)(gain + col), sc = *(const f32x4*)(scale + col);
            ca[i] = g * (sc + 1.f);
            cb[i] = *(const f32x4*)(shift + col);
        }
        const float* srow = src + (size_t)(R0 + grp4 * 16) * 1024 + lane * 4;
        f32x4 vnA[4], vnB[4];
#pragma unroll
        for (int i = 0; i < 4; ++i) { vnA[i] = *(const f32x4*)(srow + i * 256); vnB[i] = *(const f32x4*)(srow + 1024 + i * 256); }
#pragma unroll 1
        for (int r = 0; r < 16; r += 2) {
            const int rlA = grp4 * 16 + r;
            f32x4 vA[4], vB[4];
#pragma unroll
            for (int i = 0; i < 4; ++i) { vA[i] = vnA[i]; vB[i] = vnB[i]; }
            if (r < 14) {
#pragma unroll
                for (int i = 0; i < 4; ++i) { vnA[i] = *(const f32x4*)(srow + (size_t)(r + 2) * 1024 + i * 256); vnB[i] = *(const f32x4*)(srow + (size_t)(r + 3) * 1024 + i * 256); }
            }
            float ssA = 0.f, ssB = 0.f;
#pragma unroll
            for (int i = 0; i < 4; ++i) {
                ssA += vA[i][0] * vA[i][0] + vA[i][1] * vA[i][1] + vA[i][2] * vA[i][2] + vA[i][3] * vA[i][3];
                ssB += vB[i][0] * vB[i][0] + vB[i][1] * vB[i][1] + vB[i][2] * vB[i][2] + vB[i][3] * vB[i][3];
            }
#pragma unroll
            for (int o = 32; o; o >>= 1) { ssA += __shfl_xor(ssA, o); ssB += __shfl_xor(ssB, o); }
            const float rrA = rsqrtf(ssA * (1.f / 1024.f) + EPS), rrB = rsqrtf(ssB * (1.f / 1024.f) + EPS);
            float accA[5] = {0.f, 0.f, 0.f, 0.f, 0.f}, accB[5] = {0.f, 0.f, 0.f, 0.f, 0.f};
#pragma unroll
            for (int i = 0; i < 4; ++i) {
                const int col = (i * 64 + lane) * 4;
                f32x4 hA_, hB_;
#pragma unroll
                for (int j = 0; j < 4; ++j) {
                    hA_[j] = vA[i][j] * rrA * ca[i][j] + cb[i][j];
                    hB_[j] = vB[i][j] * rrB * ca[i][j] + cb[i][j];
#pragma unroll
                    for (int q = 0; q < 5; ++q) { accA[q] += hA_[j] * wr[i * 4 + j][q]; accB[q] += hB_[j] * wr[i * 4 + j][q]; }
                }
                if ((r & 3) == wq) { uint2 o; o.x = pack2(hA_[0], hA_[1]); o.y = pack2(hA_[2], hA_[3]); *(uint2*)(hA + (size_t)(R0 + rlA) * 1024 + col) = o; }
                if (((r + 1) & 3) == wq) { uint2 o; o.x = pack2(hB_[0], hB_[1]); o.y = pack2(hB_[2], hB_[3]); *(uint2*)(hA + (size_t)(R0 + rlA + 1) * 1024 + col) = o; }
            }
            {
                float v[16];
#pragma unroll
                for (int q = 0; q < 5; ++q) { v[q] = accA[q]; v[5 + q] = accB[q]; }
#pragma unroll
                for (int q = 10; q < 16; ++q) v[q] = 0.f;
#pragma unroll
                for (int t = 0; t < 8; ++t) { const bool up = lane & 32; const float send = up ? v[t] : v[t + 8], keep = up ? v[t + 8] : v[t]; v[t] = keep + __shfl_xor(send, 32); }
#pragma unroll
                for (int t = 0; t < 4; ++t) { const bool up = lane & 16; const float send = up ? v[t] : v[t + 4], keep = up ? v[t + 4] : v[t]; v[t] = keep + __shfl_xor(send, 16); }
#pragma unroll
                for (int t = 0; t < 2; ++t) { const bool up = lane & 8; const float send = up ? v[t] : v[t + 2], keep = up ? v[t + 2] : v[t]; v[t] = keep + __shfl_xor(send, 8); }
                { const bool up = lane & 4; const float send = up ? v[0] : v[1], keep = up ? v[1] : v[0]; v[0] = keep + __shfl_xor(send, 4); }
                v[0] += __shfl_xor(v[0], 2);
                v[0] += __shfl_xor(v[0], 1);
                const int idx = ((lane >> 5) & 1) * 8 + ((lane >> 4) & 1) * 4 + ((lane >> 3) & 1) * 2 + ((lane >> 2) & 1);
                if ((lane & 3) == 0 && idx < 10) {
                    const int rsel = idx >= 5, q = idx - 5 * rsel;
                    logit_s[(nstep * 32 + rlA + rsel) * 20 + 5 * wq + q] = v[0];
                }
            }
        }
    }
    __syncthreads();
    const int nrows = nstep * 32;
    int ea = 0, eb = 0, la = 0, lb_ = 0, row = 0; float wa = 0.f, wb = 0.f;
    if (tid < nrows) {
        row = (cx.vbid + (tid >> 5) * cx.G) * 32 + (tid & 31);
        const float* rl = logit_s + tid * 20;
        const float gm = fmaxf(fmaxf(rl[0], rl[1]), fmaxf(rl[2], rl[3]));
        const float gs = __expf(rl[0] - gm) + __expf(rl[1] - gm) + __expf(rl[2] - gm) + __expf(rl[3] - gm);
        int grp = 0; float best = rl[0];
        if (rl[1] > best) { best = rl[1]; grp = 1; }
        if (rl[2] > best) { best = rl[2]; grp = 2; }
        if (rl[3] > best) { best = rl[3]; grp = 3; }
        const float pg = __expf(best - gm) / gs;
        const f32x4 lsel = *(const f32x4*)(rl + 4 + 4 * grp);
        const float l0 = lsel[0], l1 = lsel[1], l2 = lsel[2], l3 = lsel[3];
        const float em = fmaxf(fmaxf(l0, l1), fmaxf(l2, l3));
        const float q0 = __expf(l0 - em), q1 = __expf(l1 - em), q2 = __expf(l2 - em), q3 = __expf(l3 - em);
        int i1 = 0; float b1 = q0;
        if (q1 > b1) { b1 = q1; i1 = 1; }
        if (q2 > b1) { b1 = q2; i1 = 2; }
        if (q3 > b1) { b1 = q3; i1 = 3; }
        int i2 = -1; float b2 = -1.f;
        if (i1 != 0 && q0 > b2) { b2 = q0; i2 = 0; }
        if (i1 != 1 && q1 > b2) { b2 = q1; i2 = 1; }
        if (i1 != 2 && q2 > b2) { b2 = q2; i2 = 2; }
        if (i1 != 3 && q3 > b2) { b2 = q3; i2 = 3; }
        const float inv = pg / (b1 + b2);
        ea = grp * 4 + i1; eb = grp * 4 + i2; wa = b1 * inv; wb = b2 * inv;
        la = atomicAdd(lcnt + ea, 1);
        lb_ = atomicAdd(lcnt + eb, 1);
    }
    __syncthreads();
    if (tid < 16) lcnt[16 + tid] = atomicAdd((int*)(p.ws + OFF_CNT) + layer * 16 + tid, lcnt[tid]);
    __syncthreads();
    if (tid < nrows) {
        int* ltok = (int*)(p.ws + OFF_LTOK);
        float* lw = (float*)(p.ws + OFF_LW);
        int* ts = (int*)(p.ws + OFF_TSLOT) + row * 2;
        const int pa = lcnt[16 + ea] + la, pb = lcnt[16 + eb] + lb_;
        ltok[(size_t)ea * NTOK + pa] = row; lw[(size_t)ea * NTOK + pa] = wa;
        ltok[(size_t)eb * NTOK + pb] = row; lw[(size_t)eb * NTOK + pb] = wb;
        ts[0] = (ea << 16) | pa; ts[1] = (eb << 16) | pb;
    }
    __syncthreads();
}

__device__ __forceinline__ int stage_col(int tid) { return ((tid & 7) ^ ((tid >> 3) & 7)) * 8; }

template <class Epi>
__device__ __forceinline__ void gemm_tile(const bf16_t* const (&ap)[4], const bf16_t* const (&bp)[2], int K, char* lds, const Ctx& cx, Epi&& epi) {
    const int tid = cx.tid, lane = cx.lane, wr = cx.wid >> 1, wc = cx.wid & 1, fr = lane & 15, fq = lane >> 4;
    f32x4 acc[4][4];
#pragma unroll
    for (int m = 0; m < 4; ++m)
#pragma unroll
        for (int n = 0; n < 4; ++n) acc[m][n] = (f32x4){0.f, 0.f, 0.f, 0.f};
    const int nt = K / 64;
    auto stage = [&](int t, int slot) {
        char* SA = lds + slot * GEMM_STAGE + tid * 16; char* SB = SA + 32768;
        const int ko = t * 64;
#pragma unroll
        for (int i = 0; i < 4; ++i) glds16(ap[i] + ko, SA + i * 8192);
#pragma unroll
        for (int i = 0; i < 2; ++i) glds16(bp[i] + ko, SB + i * 8192);
    };
    __syncthreads();
    stage(0, 0);
    if (nt > 1) stage(1, 1);
    const int x7 = fr & 7;
    const int aoff = (wr * 64 + fr) * 128, boff = 32768 + (wc * 64 + fr) * 128;
    int slot = 0;
    for (int kt = 0; kt < nt; ++kt) {
        if (kt + 1 < nt) asm volatile("s_waitcnt vmcnt(6)" ::: "memory");
        else asm volatile("s_waitcnt vmcnt(0)" ::: "memory");
        __builtin_amdgcn_s_barrier();
        if (kt + 2 < nt) stage(kt + 2, slot >= 1 ? slot - 1 : 2);
        const char* S = lds + slot * GEMM_STAGE;
#pragma unroll
        for (int ks = 0; ks < 2; ++ks) {
            const int pc = ((ks * 4 + fq) ^ x7) * 16;
            bf16x8 Af[4], Bf[4];
#pragma unroll
            for (int m = 0; m < 4; ++m) Af[m] = *(const bf16x8*)(S + aoff + m * 2048 + pc);
#pragma unroll
            for (int n = 0; n < 4; ++n) Bf[n] = *(const bf16x8*)(S + boff + n * 2048 + pc);
#pragma unroll
            for (int m = 0; m < 4; ++m)
#pragma unroll
                for (int n = 0; n < 4; ++n) acc[m][n] = __builtin_amdgcn_mfma_f32_16x16x32_bf16(Bf[n], Af[m], acc[m][n], 0, 0, 0);
        }
        slot = slot == 2 ? 0 : slot + 1;
    }
    epi(acc, wr, wc, fr, fq);
}

__device__ __forceinline__ int swz_g(int q) { return (0x1320 >> (4 * q)) & 3; }
__device__ __forceinline__ int stage_col2(int tid) { return ((tid & 3) ^ swz_g((tid >> 4) & 3)) * 8; }

template <int MODE = 0, class Epi>
__device__ __forceinline__ void gemm_tile2(const bf16_t* const (&ap)[2], const bf16_t* const (&bp)[2], int K, char* lds, const Ctx& cx, Epi&& epi) {
    const int tid = cx.tid, lane = cx.lane, wc = cx.wid & 3, fr = lane & 15, fq = lane >> 4;
    const int wr = __builtin_amdgcn_readfirstlane(cx.wid >> 2);
    f32x4 acc[8][4];
#pragma unroll
    for (int m = 0; m < 8; ++m)
#pragma unroll
        for (int n = 0; n < 4; ++n) acc[m][n] = (f32x4){0.f, 0.f, 0.f, 0.f};
    const int nt = K / 32;
    auto stage = [&](int t) {
        char* SA = lds + (t & 3) * 32768 + tid * 16; char* SB = SA + 16384;
        const int ko = t * 32;
        glds16(ap[0] + ko, SA); glds16(ap[1] + ko, SA + 8192);
        glds16(bp[0] + ko, SB); glds16(bp[1] + ko, SB + 8192);
    };
    __syncthreads();
    stage(0);
    if (nt > 1) stage(1);
    if (nt > 2) stage(2);
    const int pc = (fq ^ swz_g((fr >> 2) & 3)) * 16;
    const int aoff = (wr * 128 + fr) * 64 + pc, boff = 16384 + (wc * 64 + fr) * 64 + pc;
    bf16x8 Af[8], Bf[4];
    auto load_frags = [&](int kt) {
        const char* S = lds + (kt & 3) * 32768;
#pragma unroll
        for (int n = 0; n < 4; ++n) Bf[n] = *(const bf16x8*)(S + boff + n * 1024);
#pragma unroll
        for (int m = 0; m < 8; ++m) Af[m] = *(const bf16x8*)(S + aoff + m * 1024);
        asm volatile("s_waitcnt lgkmcnt(0)" ::: "memory");
    };
    auto mma = [&]() {
        __builtin_amdgcn_s_setprio(1);
#pragma unroll
        for (int m = 0; m < 8; ++m)
#pragma unroll
            for (int n = 0; n < 4; ++n) acc[m][n] = __builtin_amdgcn_mfma_f32_16x16x32_bf16(Bf[n], Af[m], acc[m][n], 0, 0, 0);
        __builtin_amdgcn_s_setprio(0);
    };
    if (nt > 2) asm volatile("s_waitcnt vmcnt(8)" ::: "memory");
    else if (nt == 2) asm volatile("s_waitcnt vmcnt(4)" ::: "memory");
    else asm volatile("s_waitcnt vmcnt(0)" ::: "memory");
    if (wr == 1) __builtin_amdgcn_s_barrier();
    for (int kt = 0; kt < nt; ++kt) {
        const int rem = nt - 1 - kt;
        if (rem >= 2) asm volatile("s_waitcnt vmcnt(8)" ::: "memory");
        else if (rem == 1) asm volatile("s_waitcnt vmcnt(4)" ::: "memory");
        else asm volatile("s_waitcnt vmcnt(0)" ::: "memory");
        __builtin_amdgcn_s_barrier();
        if (kt + 3 < nt) stage(kt + 3);
        load_frags(kt);
        if (rem >= 3) asm volatile("s_waitcnt vmcnt(8)" ::: "memory");
        else if (rem == 2) asm volatile("s_waitcnt vmcnt(4)" ::: "memory");
        else asm volatile("s_waitcnt vmcnt(0)" ::: "memory");
        __builtin_amdgcn_s_barrier();
        mma();
    }
    if (wr == 0) __builtin_amdgcn_s_barrier();
    if (MODE == 0) epi(acc, wr, wc, fr, fq);
    else {
#pragma unroll
        for (int m = 0; m < 8; ++m)
#pragma unroll
            for (int n = 0; n < 4; ++n) asm volatile("" :: "v"(acc[m][n]));
    }
}

template <class GetFn, class EpiFn>
__device__ __forceinline__ void gemm_stream2(int my_tiles, int K, char* lds, const Ctx& cx, GetFn&& get, EpiFn&& epi) {
    if (my_tiles <= 0) return;
    const int tid = cx.tid, lane = cx.lane, wc = cx.wid & 3, fr = lane & 15, fq = lane >> 4;
    const int wr = __builtin_amdgcn_readfirstlane(cx.wid >> 2);
    f32x4 acc[8][4];
#pragma unroll
    for (int m = 0; m < 8; ++m)
#pragma unroll
        for (int n = 0; n < 4; ++n) acc[m][n] = (f32x4){0.f, 0.f, 0.f, 0.f};
    const int nt = K / 32, S = my_tiles * nt;
    const bf16_t* sap[2]; const bf16_t* sbp[2];
    int sj = 0, skt = 0, sg = 0;
    get(0, sap, sbp);
    auto stage_next = [&]() {
        char* SA = lds + (sg & 3) * 32768 + tid * 16; char* SB = SA + 16384;
        const int ko = skt * 32;
        glds16(sap[0] + ko, SA); glds16(sap[1] + ko, SA + 8192);
        glds16(sbp[0] + ko, SB); glds16(sbp[1] + ko, SB + 8192);
        ++sg; ++skt;
        if (skt == nt) { skt = 0; ++sj; if (sj < my_tiles) get(sj, sap, sbp); }
    };
    __syncthreads();
    stage_next();
    if (S > 1) stage_next();
    if (S > 2) stage_next();
    const int pc = (fq ^ swz_g((fr >> 2) & 3)) * 16;
    const int aoff = (wr * 128 + fr) * 64 + pc, boff = 16384 + (wc * 64 + fr) * 64 + pc;
    bf16x8 Af[8], Bf[4];
    int g = 0;
    for (int cj = 0; cj < my_tiles; ++cj) {
        {
            const int rem0 = S - 1 - g;
            if (rem0 >= 2) asm volatile("s_waitcnt vmcnt(8)" ::: "memory");
            else if (rem0 == 1) asm volatile("s_waitcnt vmcnt(4)" ::: "memory");
            else asm volatile("s_waitcnt vmcnt(0)" ::: "memory");
        }
        if (wr == 1) __builtin_amdgcn_s_barrier();
        for (int kt = 0; kt < nt; ++kt, ++g) {
            const int rem = S - 1 - g;
            if (rem >= 2) asm volatile("s_waitcnt vmcnt(8)" ::: "memory");
            else if (rem == 1) asm volatile("s_waitcnt vmcnt(4)" ::: "memory");
            else asm volatile("s_waitcnt vmcnt(0)" ::: "memory");
            __builtin_amdgcn_s_barrier();
            if (g + 3 < S) stage_next();
            {
                const char* Sx = lds + (g & 3) * 32768;
#pragma unroll
                for (int n = 0; n < 4; ++n) Bf[n] = *(const bf16x8*)(Sx + boff + n * 1024);
#pragma unroll
                for (int m = 0; m < 8; ++m) Af[m] = *(const bf16x8*)(Sx + aoff + m * 1024);
                asm volatile("s_waitcnt lgkmcnt(0)" ::: "memory");
            }
            if (rem >= 3) asm volatile("s_waitcnt vmcnt(8)" ::: "memory");
            else if (rem == 2) asm volatile("s_waitcnt vmcnt(4)" ::: "memory");
            else asm volatile("s_waitcnt vmcnt(0)" ::: "memory");
            __builtin_amdgcn_s_barrier();
            __builtin_amdgcn_s_setprio(1);
#pragma unroll
            for (int m = 0; m < 8; ++m)
#pragma unroll
                for (int n = 0; n < 4; ++n) acc[m][n] = __builtin_amdgcn_mfma_f32_16x16x32_bf16(Bf[n], Af[m], acc[m][n], 0, 0, 0);
            __builtin_amdgcn_s_setprio(0);
        }
        if (wr == 0) __builtin_amdgcn_s_barrier();
        epi(cj, acc, wr, wc, fr, fq);
#pragma unroll
        for (int m = 0; m < 8; ++m)
#pragma unroll
            for (int n = 0; n < 4; ++n) acc[m][n] = (f32x4){0.f, 0.f, 0.f, 0.f};
    }
}

template <int MODE = 0, class EpiFactory>
__device__ __forceinline__ void gemm_phase_dense2(const bf16_t* A, int lda, const bf16_t* Bt, int K, int nrt, int nct, char* lds, const Ctx& cx, EpiFactory&& mk) {
    const int tid = cx.tid;
    const int ntiles = nrt * nct;
    const int sc = stage_col2(tid), sr = tid >> 2;
    const int my_tiles = cx.vbid < ntiles ? (ntiles - cx.vbid + cx.G - 1) / cx.G : 0;
    const int vb = cx.vbid, G = cx.G;
    gemm_stream2(my_tiles, K, lds, cx,
        [=](int j, const bf16_t* (&ap)[2], const bf16_t* (&bp)[2]) {
            const int tile = vb + j * G, rt = tile / nct, ct = tile % nct;
            ap[0] = A + (size_t)(rt * 256 + sr) * lda + sc; ap[1] = ap[0] + (size_t)128 * lda;
            bp[0] = Bt + (size_t)(ct * 256 + sr) * K + sc; bp[1] = bp[0] + (size_t)128 * K;
        },
        [=](int j, f32x4 (&acc)[8][4], int wr, int wc, int fr, int fq) {
            const int tile = vb + j * G, rt = tile / nct, ct = tile % nct;
            mk(rt * 256, ct * 256)(acc, wr, wc, fr, fq);
        });
}

__device__ __forceinline__ void phase_nsa_inproj(const Params& p, const Ctx& cx, char* lds) {
    const bf16_t* A = (const bf16_t*)(p.ws + OFF_HA);
    const bf16_t* Bt = (const bf16_t*)(p.ws + OFF_W_NSA_IN);
    char* ws = p.ws;
    const float* qg = p.nsa_q_gain;
    const float* kg = p.nsa_k_gain;
    gemm_phase_dense2(A, 1024, Bt, 1024, NTOK / 256, NSA_IN_PAD / 256, lds, cx, [=](int row0, int col0) {
        return [=](f32x4 (&acc)[8][4], int wr, int wc, int fr, int fq) {
            const int gc0 = col0 + wc * 64;
            if (gc0 >= NSA_IN) return;
            if (gc0 < 1024 || (gc0 >= 1536 && gc0 < 1792) || (gc0 >= 2048 && gc0 < 2304)) {
                const float* gain; float post; bf16_t* dstb; size_t rstride; size_t coff; bool tokmajor;
                if (gc0 < 1024) { gain = qg; post = 0.125f * 1.4426950408889634f; }
                else if (gc0 < 1792) { gain = kg + 64; post = 1.f; }
                else { gain = kg + 128; post = 1.f; }
#pragma unroll
                for (int m = 0; m < 8; ++m) {
                    __builtin_amdgcn_sched_barrier(0);
                    float ss = 0.f;
#pragma unroll
                    for (int n = 0; n < 4; ++n) ss += acc[m][n][0] * acc[m][n][0] + acc[m][n][1] * acc[m][n][1] + acc[m][n][2] * acc[m][n][2] + acc[m][n][3] * acc[m][n][3];
                    ss += __shfl_xor(ss, 16); ss += __shfl_xor(ss, 32);
                    const float r = rsqrtf(ss * (1.f / 64.f) + EPS) * post;
                    const int row = row0 + wr * 128 + m * 16 + fr;
                    bf16_t* dst;
                    if (gc0 < 1024) dst = (bf16_t*)(ws + OFF_Q) + (size_t)row * 1024 + gc0;
                    else {
                        const int g = ((gc0 - 1024) & 255) >> 6, b = row >> 11, t = row & 2047;
                        dst = (bf16_t*)(ws + (gc0 < 1792 ? OFF_KS : OFF_KW)) + ((size_t)(b * 4 + g) * 2048 + t) * 64;
                    }
#pragma unroll
                    for (int pp = 0; pp < 2; ++pp) {
                        const int c = pp * 32 + fq * 8;
                        const f32x4 ga = *(const f32x4*)(gain + c), gb = *(const f32x4*)(gain + c + 4);
                        const f32x4 a = acc[m][2 * pp], bb = acc[m][2 * pp + 1];
                        uint4 o; o.x = pack2(a[0] * r * ga[0], a[1] * r * ga[1]); o.y = pack2(a[2] * r * ga[2], a[3] * r * ga[3]);
                        o.z = pack2(bb[0] * r * gb[0], bb[1] * r * gb[1]); o.w = pack2(bb[2] * r * gb[2], bb[3] * r * gb[3]);
                        *(uint4*)(dst + c) = o;
                    }
                }
            } else if (gc0 < 2560) {
                const int seg = (gc0 - 1024) >> 8;
                const int g = ((gc0 - 1024) & 255) >> 6;
                if (seg < 2) {
                    const size_t off = seg == 0 ? OFF_KCRAW : OFF_VCRAW;
#pragma unroll
                    for (int m = 0; m < 8; ++m) {
                        __builtin_amdgcn_sched_barrier(0);
                    __builtin_amdgcn_sched_barrier(0);
                        const int row = row0 + wr * 128 + m * 16 + fr, b = row >> 11, t = row & 2047;
                        bf16_t* dst = (bf16_t*)(ws + off) + ((size_t)(b * 4 + g) * 2048 + t) * 64;
#pragma unroll
                        for (int pp = 0; pp < 2; ++pp) {
                            const f32x4 a = acc[m][2 * pp], bb = acc[m][2 * pp + 1];
                            uint4 o; o.x = pack2(a[0], a[1]); o.y = pack2(a[2], a[3]); o.z = pack2(bb[0], bb[1]); o.w = pack2(bb[2], bb[3]);
                            *(uint4*)(dst + pp * 32 + fq * 8) = o;
                        }
                    }
                } else {
                    const size_t off = seg == 3 ? OFF_VS : OFF_VW;
#pragma unroll
                    for (int m = 0; m < 8; ++m) {
                        __builtin_amdgcn_sched_barrier(0);
                    __builtin_amdgcn_sched_barrier(0);
                        const int row = row0 + wr * 128 + m * 16 + fr, b = row >> 11, t = row & 2047;
                        bf16_t* dst = (bf16_t*)(ws + off) + (size_t)(b * 4 + g) * 64 * 2048 + t;
#pragma unroll
                        for (int n = 0; n < 4; ++n)
#pragma unroll
                            for (int j = 0; j < 4; ++j) dst[(size_t)(pcol(n, fq) + j) * 2048] = f2bf(acc[m][n][j]);
                    }
                }
            } else {
#pragma unroll
                for (int m = 0; m < 8; ++m) {
                    __builtin_amdgcn_sched_barrier(0);
                    const int row = row0 + wr * 128 + m * 16 + fr;
                    float* dst = (float*)(ws + OFF_GATES) + (size_t)row * 48;
#pragma unroll
                    for (int n = 0; n < 4; ++n) {
                        const int c = pcol(n, fq);
                        f32x4 o;
#pragma unroll
                        for (int j = 0; j < 4; ++j) o[j] = sigmoid_f(acc[m][n][j]);
                        if (c < 48) *(f32x4*)(dst + c) = o;
                    }
                }
            }
        };
    });
}

__device__ __forceinline__ void phase_cmp1(const Params& p, const Ctx& cx, char* lds) {
    const int tid = cx.tid;
    const float* peb = (const float*)(p.ws + OFF_PEB);
    float* T1 = (float*)(p.ws + OFF_T1);
    const int sc = stage_col(tid), sr = tid >> 3;
    for (int tile = cx.vbid; tile < 64; tile += cx.G) {
        const int kv = tile >> 5, bg2 = tile & 31;
        const bf16_t* raw = (const bf16_t*)(p.ws + (kv ? OFF_VCRAW : OFF_KCRAW)) + (size_t)bg2 * 2 * 2048 * 64;
        const bf16_t* a0 = raw + (size_t)sr * 1024 + sc;
        const bf16_t* a2 = raw + (size_t)2048 * 64 + (size_t)sr * 1024 + sc;
        const bf16_t* b0 = (const bf16_t*)(p.ws + OFF_W_CMP1) + ((size_t)kv * 128 + sr) * 2048 + sc;
        const bf16_t* const ap[4] = {a0, a0 + (size_t)64 * 1024, a2, a2 + (size_t)64 * 1024};
        const bf16_t* const bp[2] = {b0, b0 + (size_t)64 * 2048};
        gemm_tile(ap, bp, 2048, lds, cx, [=](f32x4 (&acc)[4][4], int wr, int wc, int fr, int fq) {
            if (wc != 0) return;
#pragma unroll
            for (int m = 0; m < 4; ++m) {
                const int r = wr * 64 + m * 16 + fr;
                float* dst = T1 + ((size_t)kv * 8192 + (bg2 * 2 + (r >> 7)) * 128 + (r & 127)) * 64;
#pragma unroll
                for (int n = 0; n < 4; ++n) {
                    const int c = n * 16 + fq * 4;
                    f32x4 pb = *(const f32x4*)(peb + kv * 64 + c);
                    *(f32x4*)(dst + c) = acc[m][n] + pb;
                }
            }
        });
    }
}

__device__ __forceinline__ void phase_cmp2(const Params& p, const Ctx& cx) {
    const int lane = cx.lane;
    const float* T1 = (const float*)(p.ws + OFF_T1);
    for (int r = cx.vbid * NWAVE + cx.wid; r < 2 * 8192; r += cx.G * NWAVE) {
        const int kv = r >> 13, rr = r & 8191, n_ = rr & 127;
        const float s = silu_f(T1[(size_t)r * 64 + lane]);
        const float* w2 = p.nsa_cmp_w2 + kv * 4096 + lane;
        float o = 0.f;
#pragma unroll 8
        for (int j = 0; j < 64; ++j) o += __shfl(s, j) * w2[j * 64];
        if (kv == 0) {
            const float ss = wave_sum(o * o);
            o = o * rsqrtf(ss * (1.f / 64.f) + EPS) * p.nsa_k_gain[lane];
        }
        if (n_ == 127) o = 0.f;
        if (kv == 0) ((bf16_t*)(p.ws + OFF_KC))[(size_t)rr * 64 + lane] = f2bf(o);
        else ((bf16_t*)(p.ws + OFF_VC))[((size_t)(rr >> 7) * 64 + lane) * 128 + n_] = f2bf(o);
    }
}

constexpr int ATT_BUF = 17920, ATT_K_STRIDE = 144, ATT_V_OFF = 9216, ATT_V_STRIDE = 136, ATT_LUT_OFF = 2 * ATT_BUF, LUT_N = 2136, LUT_PAD = 80;
constexpr int ATT_SC_OFF = ATT_LUT_OFF + 4 * LUT_N * 4;
static_assert(ATT_SC_OFF + NWAVE * 8192 <= LDS_TAB_OFF, "attention LDS");
#define MFMA32(a, b, c) __builtin_amdgcn_mfma_f32_32x32x16_bf16((a), (b), (c), 0, 0, 0)
template <int V> struct IC { static constexpr int value = V; };

__device__ __forceinline__ void phase_attn(const Params& p, const Ctx& cx, char* lds) {
    const int tid = cx.tid, lane = cx.lane, wid = cx.wid;
    const int g = cx.vbid & 3;
    const int ql = lane & 7, head = (lane & 31) >> 3, h2 = lane >> 5, l31 = lane & 31;
    float* lut = (float*)(lds + ATT_LUT_OFF);
    for (int i = tid; i < 4 * LUT_N; i += NTHR) {
        const int h = i / LUT_N, dist = i % LUT_N - LUT_PAD;
        lut[i] = dist >= 0 ? p.rel_bias[t5_bucket(dist) * 16 + g * 4 + h] * 1.4426950408889634f : 0.f;
    }
    __syncthreads();
    const float* lutp = lut + head * LUT_N + LUT_PAD;
    const float b31 = lutp[2047];
    const bf16_t* Qb = (const bf16_t*)(p.ws + OFF_Q);
    const bf16_t* KC = (const bf16_t*)(p.ws + OFF_KC);
    const bf16_t* VCT = (const bf16_t*)(p.ws + OFF_VC);
    const bf16_t* KS = (const bf16_t*)(p.ws + OFF_KS);
    const bf16_t* VST = (const bf16_t*)(p.ws + OFF_VS);
    const bf16_t* KW = (const bf16_t*)(p.ws + OFF_KW);
    const bf16_t* VWT = (const bf16_t*)(p.ws + OFF_VW);
    const float* GT = (const float*)(p.ws + OFF_GATES);
    bf16_t* Og = (bf16_t*)(p.ws + OFF_HA);
    float* scw = (float*)(lds + ATT_SC_OFF) + wid * 2048;
    f32x4* outw = (f32x4*)(lds + ATT_SC_OFF + wid * 8192) + lane;
    const bool flip_ok = (cx.G % 128) == 0;
    const int widu = __builtin_amdgcn_readfirstlane(wid);

    for (int it = 0;; ++it) {
        const int u = cx.vbid + it * cx.G;
        if (u >= 2048) break;
        const int rest = u >> 2, b = rest >> 5, qtb = rest & 31;
        const int qt = (flip_ok && (it & 1)) ? 31 - qtb : qtb;
        const int t0 = qt * 64, cur = qt, bg = b * 4 + g;
        const int tq = t0 + wid * 8 + ql;
        const size_t rowtok = (size_t)b * SEQ + tq;
        bf16x8 Qf[4];
        {
            const bf16_t* qp = Qb + rowtok * 1024 + (g * 4 + head) * 64 + 8 * h2;
#pragma unroll
            for (int ks = 0; ks < 4; ++ks) Qf[ks] = *(const bf16x8*)(qp + 16 * ks);
        }
        const float* gt = GT + rowtok * 48 + (g * 4 + head) * 3;
        const float gate_c = gt[0], gate_s = gt[1], gate_w = gt[2];
        const int wlo = max(0, qt - 8);
        const int nW = cur - wlo + 1;
        const int ncp = (t0 + 63 >= 31 + 16 * 64) ? 2 : 1;
        const int NC = ncp;
        const int NT = NC + nW + cur + 1;

        uint4 kr0, vr0;
        auto issue_load = [&](int i) {
            const bf16_t* ksrc; const bf16_t* vsrc; int vstride;
            if (i < NC) { const int ci = i; ksrc = KC + ((size_t)bg * 128 + ci * 64) * 64; vsrc = VCT + (size_t)bg * 64 * 128 + ci * 64; vstride = 128; }
            else if (i < NC + nW) { const int kb = wlo + i - NC; ksrc = KW + ((size_t)bg * 2048 + kb * 64) * 64; vsrc = VWT + (size_t)bg * 64 * 2048 + kb * 64; vstride = 2048; }
            else { const int kb = i - NC - nW; ksrc = KS + ((size_t)bg * 2048 + kb * 64) * 64; vsrc = VST + (size_t)bg * 64 * 2048 + kb * 64; vstride = 2048; }
            kr0 = *(const uint4*)(ksrc + tid * 8);
            vr0 = *(const uint4*)(vsrc + (size_t)(tid >> 3) * vstride + (tid & 7) * 8);
        };
        auto write_lds = [&](int i) {
            char* bufp = lds + (i & 1) * ATT_BUF;
            *(uint4*)(bufp + (tid >> 3) * ATT_K_STRIDE + (tid & 7) * 16) = kr0;
            char* va = bufp + ATT_V_OFF + (tid >> 3) * ATT_V_STRIDE + (tid & 7) * 16;
            uint2 t;
            t.x = vr0.x; t.y = vr0.y; *(uint2*)va = t;
            t.x = vr0.z; t.y = vr0.w; *(uint2*)(va + 8) = t;
        };
        f32x16 O0, O1;
#pragma unroll
        for (int r = 0; r < 16; ++r) { O0[r] = 0.f; O1[r] = 0.f; }
        float lsum = 0.f;

        auto qk = [&](const char* bufp, int kt2, float init) -> f32x16 {
            f32x16 S;
#pragma unroll
            for (int r = 0; r < 16; ++r) S[r] = init;
            const char* kp = bufp + (32 * kt2 + l31) * ATT_K_STRIDE + 16 * h2;
            bf16x8 kf[4];
#pragma unroll
            for (int ks = 0; ks < 4; ++ks) kf[ks] = *(const bf16x8*)(kp + 32 * ks);
            __builtin_amdgcn_sched_barrier(0);
#pragma unroll
            for (int ks = 0; ks < 4; ++ks) S = MFMA32(kf[ks], Qf[ks], S);
            return S;
        };
        auto pv = [&](const char* bufp, int kt2, const f32x16& P) {
            const char* vp = bufp + ATT_V_OFF + l31 * ATT_V_STRIDE + (32 * kt2 + 4 * h2) * 2;
            uint2 va[2][2][2];
#pragma unroll
            for (int s2 = 0; s2 < 2; ++s2)
#pragma unroll
                for (int dt = 0; dt < 2; ++dt) {
                    va[s2][dt][0] = *(const uint2*)(vp + dt * 32 * ATT_V_STRIDE + s2 * 32);
                    va[s2][dt][1] = *(const uint2*)(vp + dt * 32 * ATT_V_STRIDE + s2 * 32 + 16);
                }
            __builtin_amdgcn_sched_barrier(0);
#pragma unroll
            for (int s2 = 0; s2 < 2; ++s2) {
                uint4 pk;
                pk.x = pack2(P[8 * s2 + 0], P[8 * s2 + 1]); pk.y = pack2(P[8 * s2 + 2], P[8 * s2 + 3]);
                pk.z = pack2(P[8 * s2 + 4], P[8 * s2 + 5]); pk.w = pack2(P[8 * s2 + 6], P[8 * s2 + 7]);
                const bf16x8 Pf = __builtin_bit_cast(bf16x8, pk);
                uint4 a0, a1;
                a0.x = va[s2][0][0].x; a0.y = va[s2][0][0].y; a0.z = va[s2][0][1].x; a0.w = va[s2][0][1].y;
                a1.x = va[s2][1][0].x; a1.y = va[s2][1][0].y; a1.z = va[s2][1][1].x; a1.w = va[s2][1][1].y;
                O0 = MFMA32(__builtin_bit_cast(bf16x8, a0), Pf, O0);
                O1 = MFMA32(__builtin_bit_cast(bf16x8, a1), Pf, O1);
            }
        };
        auto finalize = [&](float gate, int mode) {
            const float Z = lsum + __shfl_xor(lsum, 32);
            const float f = Z > 0.f ? gate / Z : 0.f;
#pragma unroll
            for (int v4 = 0; v4 < 4; ++v4) {
                f32x4 a = {f * O0[4 * v4], f * O0[4 * v4 + 1], f * O0[4 * v4 + 2], f * O0[4 * v4 + 3]};
                f32x4 c = {f * O1[4 * v4], f * O1[4 * v4 + 1], f * O1[4 * v4 + 2], f * O1[4 * v4 + 3]};
                if (mode != 0) { a += outw[v4 * 64]; c += outw[(4 + v4) * 64]; }
                if (mode != 2) { outw[v4 * 64] = a; outw[(4 + v4) * 64] = c; }
                else { O0[4 * v4] = a[0]; O0[4 * v4 + 1] = a[1]; O0[4 * v4 + 2] = a[2]; O0[4 * v4 + 3] = a[3];
                       O1[4 * v4] = c[0]; O1[4 * v4 + 1] = c[1]; O1[4 * v4 + 2] = c[2]; O1[4 * v4 + 3] = c[3]; }
            }
            if (mode != 2) {
#pragma unroll
                for (int r = 0; r < 16; ++r) { O0[r] = 0.f; O1[r] = 0.f; }
            }
            lsum = 0.f;
        };
        auto tile_ws = [&](const char* bufp, int kb, float cinit, auto MMc, auto BMc) {
            constexpr int MM = decltype(MMc)::value, BM = decltype(BMc)::value;
#pragma unroll 1
            for (int kt2 = 0; kt2 < 2; ++kt2) {
                const int d0 = tq - (64 * kb + 32 * kt2 + 4 * h2);
                const float* lp = lutp + (d0 - 27);
                float bv[16];
                if (BM == 0) {
#pragma unroll
                    for (int r = 0; r < 16; ++r) bv[r] = lp[27 - ((r & 3) + 8 * (r >> 2))];
                    __builtin_amdgcn_sched_barrier(0);
                }
                f32x16 S = qk(bufp, kt2, cinit);
#pragma unroll
                for (int r = 0; r < 16; ++r) {
                    const int cr = (r & 3) + 8 * (r >> 2);
                    float x = S[r];
                    if (BM == 0) x += bv[r];
                    if (MM == 1) x += (d0 - cr < 512) ? 0.f : -INFINITY;
                    if (MM == 2) x += (d0 - cr >= 0) ? 0.f : -INFINITY;
                    S[r] = __builtin_amdgcn_exp2f(x);
                    lsum += S[r];
                }
                pv(bufp, kt2, S);
            }
        };

        const int nvis = (tq >= 31) ? min((tq - 31) / 16 + 1, 127) : 0;
        unsigned selmask = 0u;
        float* sown = scw + (head * 8 + ql) * 32;
        float* stail = scw + 1024 + (head * 8 + ql) * 32;
        float* ssc = scw + ql * 32;
        issue_load(0);
        __syncthreads();
        write_lds(0);
        issue_load(1);
        for (int i = 0; i < NT; ++i) {
            __syncthreads();
            const char* bufp = lds + (i & 1) * ATT_BUF;
            if (i < NC) {
                const int ci = i;
#pragma unroll 1
                for (int kt2 = 0; kt2 < 2; ++kt2) {
                    const int n0 = 64 * ci + 32 * kt2 + 4 * h2;
                    const int d0 = tq - 31 - 16 * n0;
                    float bv[16];
#pragma unroll
                    for (int r = 0; r < 16; ++r) bv[r] = lutp[max(d0 - 16 * ((r & 3) + 8 * (r >> 2)), -LUT_PAD)];
                    __builtin_amdgcn_sched_barrier(0);
                    f32x16 S = qk(bufp, kt2, 0.f);
#pragma unroll
                    for (int r = 0; r < 16; ++r) {
                        const int cr = (r & 3) + 8 * (r >> 2);
                        S[r] = __builtin_amdgcn_exp2f(S[r] + bv[r] + ((n0 + cr) < nvis ? 0.f : -INFINITY));
                        lsum += S[r];
                    }
                    pv(bufp, kt2, S);
#pragma unroll
                    for (int rq = 0; rq < 4; ++rq) {
                        const int sblk = 8 * (2 * ci + kt2) + 2 * rq + h2;
                        sown[sblk] = S[4 * rq] + S[4 * rq + 1] + S[4 * rq + 2] + 0.5f * S[4 * rq + 3];
                        if (sblk < 31) stail[sblk + 1] = 0.5f * S[4 * rq + 3];
                    }
                }
                if (i == NC - 1) {
                    const float Z = lsum + __shfl_xor(lsum, 32);
                    const float inv_mine = Z > 0.f ? 1.f / Z : 0.f;
                    if (h2 == 0) stail[0] = 0.f;
                    __builtin_amdgcn_wave_barrier();
                    const int j8 = head * 2 + h2;
                    {
                        f32x4 sc = {0.f, 0.f, 0.f, 0.f};
#pragma unroll
                        for (int hh = 0; hh < 4; ++hh) {
                            const float invh = __shfl(inv_mine, hh * 8 + ql);
                            const f32x4 a = *(const f32x4*)(scw + (hh * 8 + ql) * 32 + 4 * j8), t4 = *(const f32x4*)(scw + 1024 + (hh * 8 + ql) * 32 + 4 * j8);
                            sc += (a + t4) * invh;
                        }
#pragma unroll
                        for (int q = 0; q < 4; ++q) {
                            const int sblk = 4 * j8 + q;
                            const bool forced = (sblk == 0) || (sblk == cur) || (sblk == cur - 1);
                            sc[q] = forced ? 1.0e4f : (sblk <= cur ? sc[q] : -1.0f);
                        }
                        __builtin_amdgcn_wave_barrier();
                        *(f32x4*)(ssc + 4 * j8) = sc;
                    }
                    __builtin_amdgcn_wave_barrier();
                    const f32x4 own = *(const f32x4*)(ssc + 4 * j8);
                    int rk0 = 0, rk1 = 0, rk2 = 0, rk3 = 0;
                    const int so0 = 4 * j8;
#pragma unroll
                    for (int m4 = 0; m4 < 8; ++m4) {
                        const f32x4 v = *(const f32x4*)(ssc + 4 * m4);
#pragma unroll
                        for (int q = 0; q < 4; ++q) {
                            const float vm = v[q];
                            rk0 += (vm > own[0]) ? 1 : 0;
                            rk1 += (vm > own[1]) ? 1 : 0;
                            rk2 += (vm > own[2]) ? 1 : 0;
                            rk3 += (vm > own[3]) ? 1 : 0;
                        }
                    }
                    unsigned mk = ((rk0 < 8 ? 1u : 0u) | (rk1 < 8 ? 2u : 0u) | (rk2 < 8 ? 4u : 0u) | (rk3 < 8 ? 8u : 0u)) << so0;
                    mk |= __shfl_xor(mk, 8); mk |= __shfl_xor(mk, 16); mk |= __shfl_xor(mk, 32);
                    selmask = mk;
                    __builtin_amdgcn_wave_barrier();
                    finalize(gate_c, 0);
                }
            } else if (i < NC + nW) {
                const int kb = wlo + i - NC;
                if (kb == cur) tile_ws(bufp, kb, 0.f, IC<2>{}, IC<0>{});
                else if (kb == cur - 8) tile_ws(bufp, kb, 0.f, IC<1>{}, IC<0>{});
                else tile_ws(bufp, kb, 0.f, IC<0>{}, IC<0>{});
                if (i == NC - 1 + nW) finalize(gate_w, 1);
            } else {
                const int kb = i - NC - nW;
                const bool sel = ((selmask >> kb) & 1u) != 0;
                if (__ballot(sel) != 0ull) {
                    const float neg = sel ? 0.f : -INFINITY;
                    if (kb == cur) tile_ws(bufp, kb, neg, IC<2>{}, IC<0>{});
                    else if (t0 + 8 * widu - (64 * kb + 63) >= 790) tile_ws(bufp, kb, neg + b31, IC<0>{}, IC<1>{});
                    else tile_ws(bufp, kb, neg, IC<0>{}, IC<0>{});
                }
            }
            if (i + 1 < NT) {
                write_lds(i + 1);
                if (i + 2 < NT) issue_load(i + 2);
            }
        }
        finalize(gate_s, 2);
        {
            bf16_t* op = Og + rowtok * 1024 + (g * 4 + head) * 64 + 4 * h2;
#pragma unroll
            for (int rq = 0; rq < 4; ++rq) {
                uint2 o0; o0.x = pack2(O0[4 * rq], O0[4 * rq + 1]); o0.y = pack2(O0[4 * rq + 2], O0[4 * rq + 3]);
                uint2 o1; o1.x = pack2(O1[4 * rq], O1[4 * rq + 1]); o1.y = pack2(O1[4 * rq + 2], O1[4 * rq + 3]);
                *(uint2*)(op + 8 * rq) = o0;
                *(uint2*)(op + 32 + 8 * rq) = o1;
            }
        }
    }
}

__device__ __forceinline__ void phase_outproj(const Params& p, const Ctx& cx, char* lds, const bf16_t* A, const bf16_t* Bt, const float* xin, int ls) {
    const float* mod = (const float*)(p.ws + OFF_MOD);
    float* xo = p.out;
    gemm_phase_dense2(A, 1024, Bt, 1024, NTOK / 256, 4, lds, cx, [=](int row0, int col0) {
        return [=](f32x4 (&acc)[8][4], int wr, int wc, int fr, int fq) {
            const int b = row0 >> 11;
            const float* gate = mod + ((size_t)ls * 16 + b) * 3072 + 2048 + col0 + wc * 64;
            f32x4 g[4];
#pragma unroll
            for (int n = 0; n < 4; ++n) g[n] = *(const f32x4*)(gate + pcol(n, fq));
#pragma unroll
            for (int m2 = 0; m2 < 8; m2 += 2) {
                f32x4 xi[2][4];
#pragma unroll
                for (int mm = 0; mm < 2; ++mm)
#pragma unroll
                    for (int n = 0; n < 4; ++n)
                        xi[mm][n] = *(const f32x4*)(xin + (size_t)(row0 + wr * 128 + (m2 + mm) * 16 + fr) * 1024 + col0 + wc * 64 + pcol(n, fq));
                __builtin_amdgcn_sched_barrier(0);
#pragma unroll
                for (int mm = 0; mm < 2; ++mm)
#pragma unroll
                    for (int n = 0; n < 4; ++n) {
                        f32x4 o;
#pragma unroll
                        for (int j = 0; j < 4; ++j) o[j] = xi[mm][n][j] + g[n][j] * acc[m2 + mm][n][j];
                        *(f32x4*)(xo + (size_t)(row0 + wr * 128 + (m2 + mm) * 16 + fr) * 1024 + col0 + wc * 64 + pcol(n, fq)) = o;
                    }
                __builtin_amdgcn_sched_barrier(0);
            }
        };
    });
}

__device__ __forceinline__ void moe_tables(const Params& p, int layer, int tid, int* s_off, int* s_toff, int* s_hoff) {
    __syncthreads();
    if (tid == 0) {
        const int* cnt = (const int*)(p.ws + OFF_CNT) + layer * 16;
        int o = 0, to = 0, ho = 0;
        for (int e = 0; e < 16; ++e) {
            const int c = cnt[e], q = c >> 8, r = c & 255;
            s_off[e] = o; s_toff[e] = to; s_hoff[e] = ho;
            o += c; to += (q + (r > 128 ? 1 : 0)) * 4; ho += (r > 0 && r <= 128) ? 4 : 0;
        }
        s_off[16] = o; s_toff[16] = to; s_hoff[16] = ho;
    }
    __syncthreads();
}

constexpr int LDS_ROWIDX_OFF = 131072, LDS_LW_OFF = 131072 + 8192;
static_assert(LDS_LW_OFF + 8192 <= LDS_TAB_OFF, "moe caches");


namespace pg8 {
#define PG8_LAS __attribute__((address_space(3)))
typedef unsigned short bf16_t;
typedef short bf16x8 __attribute__((ext_vector_type(8)));
typedef float f32x4 __attribute__((ext_vector_type(4)));
typedef unsigned u32x4 __attribute__((ext_vector_type(4)));
constexpr int BM = 256, BK = 64, HALF = 128, HTB = HALF * BK * 2  , STAGE_BYTES = 8 * HTB, NXCD = 8, WGM = 8;

__host__ __device__ __forceinline__ int lds_byte(int r, int c) { const int st = (r >> 4) * 2 + (c >> 5), rr = r & 15, cc = c & 31, ob = rr * 64 + cc * 2; return st * 1024 + (ob ^ (((ob >> 9) & 1) << 5)); }
__host__ __device__ __forceinline__ void stage_rc(int b, int& R, int& C) { const int st = b / 1024, sb = b % 1024, swz = sb ^ (((sb >> 9) & 1) << 5); R = (st >> 1) * 16 + swz / 64; C = (st & 1) * 32 + (swz % 64) / 2; }
__host__ __device__ __forceinline__ int perm32(int rho) { const int n = rho >> 4, i = rho & 15; return 8 * (i >> 2) + 4 * n + (i & 3); }

struct Unit { int pm, pn; };
struct Gemm { const bf16_t* A; const bf16_t* Bt; int M, N, K; };

struct StaticOrder {
    int nM, nN, nwg, G, c;
    __host__ __device__ void init(int M, int N, int G_, int c_) { nM = M / BM; nN = N / BM; nwg = nM * nN; G = G_; c = c_; }
    __host__ __device__ bool next(int i, Unit& u) const {
        const long L = (long)i * G + c; if (L >= nwg) return false;
        int wgid = (int)L; { const int q = nwg / NXCD, r = nwg % NXCD, xcd = wgid % NXCD, off = wgid / NXCD; wgid = (xcd < r ? xcd * (q + 1) : r * (q + 1) + (xcd - r) * q) + off; }
        const int nig = WGM * nN, gid = wgid / nig, fm = gid * WGM, gsz = (nM - fm) < WGM ? (nM - fm) : WGM;
        u.pm = fm + ((wgid % nig) % gsz); u.pn = (wgid % nig) / gsz; return true;
    }
    __device__ __forceinline__ void a_ready(const Unit&) const {}
    __device__ __forceinline__ void done(const Unit&) const {}
};

template <class Epi, class Sched, bool ALIGN_EPI = false, bool SP2 = false>
__device__ __forceinline__ void gemm_phase(PG8_LAS unsigned char* lds, const Gemm g, const Sched& S, const Epi& E) {
    const int tid = threadIdx.x, wid = __builtin_amdgcn_readfirstlane(tid >> 6), lane = tid & 63, wr = wid >> 2, wc = wid & 3, fr = lane & 15, fq = lane >> 4;
    const int K = g.K, nt = K / BK;
    unsigned voffA[2], voffB[2];
#pragma unroll
    for (int i = 0; i < 2; ++i) { int R, C; stage_rc(tid * 16 + i * 8192, R, C); const int Rb = Epi::PERM ? ((R & ~31) + perm32(R & 31)) : R;
        voffA[i] = (unsigned)(R * K + C) * 2u; voffB[i] = (unsigned)(Rb * K + C) * 2u; }
    const size_t kstep = (size_t)(BK * 2);
    const size_t hstep = (size_t)HALF * K * 2;
    const size_t tstep = 2 * hstep;
    const unsigned ldsw = (unsigned)wid * 1024u;
    const int aoff = lds_byte(wr * 64 + fr, fq * 8), boff = lds_byte(wc * 32 + fr, fq * 8);
#define PG8_SA(b, h) (((b) * 2 + (h)) * HTB)
#define PG8_SB(b, h) ((4 + (b) * 2 + (h)) * HTB)
#define PG8_STAGE(bufoff, gbase, voff) do { _Pragma("unroll") for (int _i = 0; _i < 2; ++_i) \
        __builtin_amdgcn_global_load_lds((const unsigned*)((const char*)(gbase) + (voff)[_i]), (PG8_LAS unsigned*)(lds + (bufoff) + ldsw + _i * 8192), 16, 0, 0); } while (0)
#define PG8_LDA(dst, b, h) do { _Pragma("unroll") for (int m = 0; m < 4; ++m) _Pragma("unroll") for (int k = 0; k < 2; ++k) dst[m][k] = *(const PG8_LAS bf16x8*)(lds + PG8_SA(b, h) + aoff + m * 2048 + k * 1024); } while (0)
#define PG8_LDB(dst, b, h) do { _Pragma("unroll") for (int n = 0; n < 2; ++n) _Pragma("unroll") for (int k = 0; k < 2; ++k) dst[n][k] = *(const PG8_LAS bf16x8*)(lds + PG8_SB(b, h) + boff + n * 2048 + k * 1024); } while (0)
#define PG8_MMA(ai, bj, At, Bt) do { __builtin_amdgcn_s_setprio(1); _Pragma("unroll") for (int m = 0; m < 4; ++m) _Pragma("unroll") for (int n = 0; n < 2; ++n) _Pragma("unroll") for (int k = 0; k < 2; ++k) \
        acc[ai][bj][m][n] = __builtin_amdgcn_mfma_f32_16x16x32_bf16(Bt[n][k], At[m][k], acc[ai][bj][m][n], 0, 0, 0); __builtin_amdgcn_s_setprio(0); } while (0)
#define PG8_WAIT_V(n) asm volatile("s_waitcnt vmcnt(" #n ")" ::: "memory")
#define PG8_WAIT_L(n) asm volatile("s_waitcnt lgkmcnt(" #n ")" ::: "memory")
#define PG8_BAR __builtin_amdgcn_s_barrier()
#define PG8_SCHED __builtin_amdgcn_sched_barrier(0)
    Unit cur, nxt; int ui = 0;
    if (!S.next(0, cur)) return;
    f32x4 acc[2][2][4][2];
#pragma unroll
    for (int a = 0; a < 2; ++a)
#pragma unroll
        for (int b = 0; b < 2; ++b)
#pragma unroll
            for (int m = 0; m < 4; ++m)
#pragma unroll
                for (int n = 0; n < 2; ++n) acc[a][b][m][n] = (f32x4){0.f, 0.f, 0.f, 0.f};
    bf16x8 At[4][2], B0[2][2], B1[2][2];
    const char* cA = (const char*)g.A + (size_t)cur.pm * tstep; const char* cB = (const char*)g.Bt + (size_t)cur.pn * tstep;
    S.a_ready(cur);
    if constexpr (SP2) {
        PG8_STAGE(PG8_SB(0, 0), cB, voffB); PG8_STAGE(PG8_SB(0, 1), cB + hstep, voffB); PG8_STAGE(PG8_SA(0, 0), cA, voffA); PG8_STAGE(PG8_SA(0, 1), cA + hstep, voffA);
        if (wr == 1) PG8_BAR;
        PG8_WAIT_V(2); PG8_BAR;
        PG8_STAGE(PG8_SB(1, 0), cB + kstep, voffB); PG8_STAGE(PG8_SA(1, 0), cA + kstep, voffA); PG8_STAGE(PG8_SB(1, 1), cB + hstep + kstep, voffB);
        PG8_WAIT_V(6); PG8_BAR;
    } else {
        PG8_STAGE(PG8_SB(0, 0), cB, voffB); PG8_STAGE(PG8_SA(0, 0), cA, voffA); PG8_STAGE(PG8_SB(0, 1), cB + hstep, voffB); PG8_STAGE(PG8_SA(0, 1), cA + hstep, voffA);
        if (wr == 1) PG8_BAR;
        PG8_WAIT_V(4); PG8_BAR;
        PG8_STAGE(PG8_SB(1, 0), cB + kstep, voffB); PG8_STAGE(PG8_SA(1, 0), cA + kstep, voffA); PG8_STAGE(PG8_SB(1, 1), cB + hstep + kstep, voffB);
        PG8_WAIT_V(6); PG8_BAR;
    }
    for (;;) {
        const bool has_next = S.next(ui + 1, nxt);
        const char* nA = has_next ? (const char*)g.A + (size_t)nxt.pm * tstep : cA; const char* nB = has_next ? (const char*)g.Bt + (size_t)nxt.pn * tstep : cB;
        for (int t = 0; t < nt; t += 2) {
            const bool last = (t == nt - 2);
            const char* a1 = cA + (size_t)(t + 1) * kstep;
            const char* a2 = last ? nA : cA + (size_t)(t + 2) * kstep; const char* b2 = last ? nB : cB + (size_t)(t + 2) * kstep;
            const char* a3 = a2 + kstep; const char* b3 = b2 + kstep;
            if (last && has_next) S.a_ready(nxt);
            if constexpr (SP2) {
            PG8_LDB(B0, 0, 0); PG8_LDB(B1, 0, 1); PG8_SCHED; PG8_LDA(At, 0, 0); PG8_STAGE(PG8_SA(1, 1), a1 + hstep, voffA);
            PG8_WAIT_V(8); PG8_WAIT_L(0); PG8_BAR; PG8_MMA(0, 0, At, B0); PG8_MMA(0, 1, At, B1); PG8_BAR; PG8_SCHED;
            PG8_LDA(At, 0, 1); PG8_STAGE(PG8_SB(0, 0), b2, voffB); PG8_STAGE(PG8_SB(0, 1), b2 + hstep, voffB); PG8_STAGE(PG8_SA(0, 0), a2, voffA);
            PG8_WAIT_V(8); PG8_WAIT_L(0); PG8_BAR; PG8_MMA(1, 0, At, B0); PG8_MMA(1, 1, At, B1); PG8_BAR; PG8_SCHED;
            PG8_LDB(B0, 1, 0); PG8_LDB(B1, 1, 1); PG8_SCHED; PG8_LDA(At, 1, 0); PG8_STAGE(PG8_SA(0, 1), a2 + hstep, voffA);
            PG8_WAIT_V(8); PG8_WAIT_L(0); PG8_BAR; PG8_MMA(0, 0, At, B0); PG8_MMA(0, 1, At, B1); PG8_BAR; PG8_SCHED;
            PG8_LDA(At, 1, 1); PG8_STAGE(PG8_SB(1, 0), b3, voffB); PG8_STAGE(PG8_SB(1, 1), b3 + hstep, voffB); PG8_STAGE(PG8_SA(1, 0), a3, voffA);
            PG8_WAIT_V(8); PG8_WAIT_L(0); PG8_BAR; PG8_MMA(1, 0, At, B0); PG8_MMA(1, 1, At, B1); PG8_BAR; PG8_SCHED;
            } else {
            PG8_LDB(B0, 0, 0); PG8_SCHED; PG8_LDA(At, 0, 0); PG8_STAGE(PG8_SA(1, 1), a1 + hstep, voffA);
            PG8_WAIT_L(8); PG8_BAR; PG8_WAIT_L(0); PG8_MMA(0, 0, At, B0); PG8_BAR; PG8_SCHED;
            PG8_LDB(B1, 0, 1); PG8_STAGE(PG8_SB(0, 0), b2, voffB);
            PG8_BAR; PG8_WAIT_L(0); PG8_MMA(0, 1, At, B1); PG8_BAR;
            PG8_LDA(At, 0, 1); PG8_STAGE(PG8_SA(0, 0), a2, voffA);
            PG8_BAR; PG8_WAIT_L(0); PG8_MMA(1, 0, At, B0); PG8_BAR; PG8_SCHED;
            PG8_STAGE(PG8_SB(0, 1), b2 + hstep, voffB);
            PG8_WAIT_V(6); PG8_BAR; PG8_MMA(1, 1, At, B1); PG8_BAR;
            PG8_LDB(B0, 1, 0); PG8_SCHED; PG8_LDA(At, 1, 0); PG8_STAGE(PG8_SA(0, 1), a2 + hstep, voffA);
            PG8_WAIT_L(8); PG8_BAR; PG8_WAIT_L(0); PG8_MMA(0, 0, At, B0); PG8_BAR; PG8_SCHED;
            PG8_LDB(B1, 1, 1); PG8_STAGE(PG8_SB(1, 0), b3, voffB);
            PG8_BAR; PG8_WAIT_L(0); PG8_MMA(0, 1, At, B1); PG8_BAR;
            PG8_LDA(At, 1, 1); PG8_STAGE(PG8_SA(1, 0), a3, voffA);
            PG8_BAR; PG8_WAIT_L(0); PG8_MMA(1, 0, At, B0); PG8_BAR; PG8_SCHED;
            PG8_STAGE(PG8_SB(1, 1), b3 + hstep, voffB);
            PG8_WAIT_V(6); PG8_BAR; PG8_MMA(1, 1, At, B1); PG8_BAR;
            }
        }
        if constexpr (ALIGN_EPI) { if (wr == 0) PG8_BAR; }
        if constexpr (!Epi::AFTER_DRAIN) { E(acc, cur, wr, wc, fr, fq); S.done(cur); }
        if (!has_next) break;
#pragma unroll
        for (int a = 0; a < 2; ++a)
#pragma unroll
            for (int b = 0; b < 2; ++b)
#pragma unroll
                for (int m = 0; m < 4; ++m)
#pragma unroll
                    for (int n = 0; n < 2; ++n) acc[a][b][m][n] = (f32x4){0.f, 0.f, 0.f, 0.f};
        cur = nxt; cA = nA; cB = nB; ++ui;
        if constexpr (ALIGN_EPI) { if (wr == 1) PG8_BAR; }
    }
    PG8_WAIT_V(0);
    if constexpr (!ALIGN_EPI) { if (wr == 0) PG8_BAR; }
    PG8_BAR;
    if constexpr (Epi::AFTER_DRAIN) { E.fused(acc, cur, wr, wc, fr, fq, lds, wid, lane); S.done(cur); }
#undef PG8_SA
#undef PG8_SB
#undef PG8_STAGE
#undef PG8_LDA
#undef PG8_LDB
#undef PG8_MMA
#undef PG8_WAIT_V
#undef PG8_WAIT_L
#undef PG8_BAR
#undef PG8_SCHED
}

template <class Epi, class Sched>
__device__ __forceinline__ void gemm_phase_rows(PG8_LAS unsigned char* lds, const Gemm g, const Sched& S, const Epi& E, const PG8_LAS int* rows) {
    const int tid = threadIdx.x, wid = __builtin_amdgcn_readfirstlane(tid >> 6), lane = tid & 63, wr = wid >> 2, wc = wid & 3, fr = lane & 15, fq = lane >> 4;
    const int K = g.K, nt = K / BK;
    unsigned voffB[2]; int R0 = 0, C0 = 0;
#pragma unroll
    for (int i = 0; i < 2; ++i) { int R, C; stage_rc(tid * 16 + i * 8192, R, C); voffB[i] = (unsigned)(R * K + C) * 2u; if (i == 0) { R0 = R; C0 = C; } }
    const size_t kstep = (size_t)(BK * 2);
    const size_t hstep = (size_t)HALF * K * 2;
    const size_t tstep = 2 * hstep;
    const unsigned ldsw = (unsigned)wid * 1024u;
    const int aoff = lds_byte(wr * 64 + fr, fq * 8), boff = lds_byte(wc * 32 + fr, fq * 8);
#define PG8_SA(b, h) (((b) * 2 + (h)) * HTB)
#define PG8_SB(b, h) ((4 + (b) * 2 + (h)) * HTB)
#define PG8_STAGE(bufoff, gbase, voff) do { _Pragma("unroll") for (int _i = 0; _i < 2; ++_i) \
        __builtin_amdgcn_global_load_lds((const unsigned*)((const char*)(gbase) + (voff)[_i]), (PG8_LAS unsigned*)(lds + (bufoff) + ldsw + _i * 8192), 16, 0, 0); } while (0)
#define PG8_LDA(dst, b, h) do { _Pragma("unroll") for (int m = 0; m < 4; ++m) _Pragma("unroll") for (int k = 0; k < 2; ++k) dst[m][k] = *(const PG8_LAS bf16x8*)(lds + PG8_SA(b, h) + aoff + m * 2048 + k * 1024); } while (0)
#define PG8_LDB(dst, b, h) do { _Pragma("unroll") for (int n = 0; n < 2; ++n) _Pragma("unroll") for (int k = 0; k < 2; ++k) dst[n][k] = *(const PG8_LAS bf16x8*)(lds + PG8_SB(b, h) + boff + n * 2048 + k * 1024); } while (0)
#define PG8_MMA(ai, bj, At, Bt) do { __builtin_amdgcn_s_setprio(1); _Pragma("unroll") for (int m = 0; m < 4; ++m) _Pragma("unroll") for (int n = 0; n < 2; ++n) _Pragma("unroll") for (int k = 0; k < 2; ++k) \
        acc[ai][bj][m][n] = __builtin_amdgcn_mfma_f32_16x16x32_bf16(Bt[n][k], At[m][k], acc[ai][bj][m][n], 0, 0, 0); __builtin_amdgcn_s_setprio(0); } while (0)
#define PG8_WAIT_V(n) asm volatile("s_waitcnt vmcnt(" #n ")" ::: "memory")
#define PG8_WAIT_L(n) asm volatile("s_waitcnt lgkmcnt(" #n ")" ::: "memory")
#define PG8_BAR __builtin_amdgcn_s_barrier()
#define PG8_SCHED __builtin_amdgcn_sched_barrier(0)
    Unit cur, nxt; int ui = 0;
    if (!S.next(0, cur)) return;
    f32x4 acc[2][2][4][2];
#pragma unroll
    for (int a = 0; a < 2; ++a)
#pragma unroll
        for (int b = 0; b < 2; ++b)
#pragma unroll
            for (int m = 0; m < 4; ++m)
#pragma unroll
                for (int n = 0; n < 2; ++n) acc[a][b][m][n] = (f32x4){0.f, 0.f, 0.f, 0.f};
    bf16x8 At[4][2], B0[2][2], B1[2][2];
    unsigned vc[4], vn[4];
#pragma unroll
    for (int q = 0; q < 4; ++q) vc[q] = ((unsigned)rows[cur.pm * 256 + R0 + 64 * q] * (unsigned)K + (unsigned)C0) * 2u;
    const char* gA = (const char*)g.A; const char* cB = (const char*)g.Bt + (size_t)(cur.pn & 0xffff) * tstep;
    PG8_STAGE(PG8_SB(0, 0), cB, voffB); PG8_STAGE(PG8_SB(0, 1), cB + hstep, voffB); PG8_STAGE(PG8_SA(0, 0), gA, vc); PG8_STAGE(PG8_SA(0, 1), gA, vc + 2);
    if (wr == 1) PG8_BAR;
    PG8_WAIT_V(2); PG8_BAR;
    PG8_STAGE(PG8_SB(1, 0), cB + kstep, voffB); PG8_STAGE(PG8_SA(1, 0), gA + kstep, vc); PG8_STAGE(PG8_SB(1, 1), cB + hstep + kstep, voffB);
    PG8_WAIT_V(6); PG8_BAR;
    for (;;) {
        const bool has_next = S.next(ui + 1, nxt);
        if (has_next) {
#pragma unroll
            for (int q = 0; q < 4; ++q) vn[q] = ((unsigned)rows[nxt.pm * 256 + R0 + 64 * q] * (unsigned)K + (unsigned)C0) * 2u;
        } else {
#pragma unroll
            for (int q = 0; q < 4; ++q) vn[q] = vc[q];
        }
        const char* nB = has_next ? (const char*)g.Bt + (size_t)(nxt.pn & 0xffff) * tstep : cB;
        const bool fullu = (cur.pn >> 16) == 0;
        for (int t = 0; t < nt; t += 2) {
            const bool last = (t == nt - 2);
            const char* a1 = gA + (size_t)(t + 1) * kstep;
            const char* a2 = last ? gA : gA + (size_t)(t + 2) * kstep; const char* b2 = last ? nB : cB + (size_t)(t + 2) * kstep;
            const char* a3 = a2 + kstep; const char* b3 = b2 + kstep;
            unsigned v2[4];
#pragma unroll
            for (int q = 0; q < 4; ++q) v2[q] = last ? vn[q] : vc[q];
            PG8_LDB(B0, 0, 0); PG8_LDB(B1, 0, 1); PG8_SCHED; PG8_LDA(At, 0, 0); PG8_STAGE(PG8_SA(1, 1), a1, vc + 2);
            PG8_WAIT_V(8); PG8_WAIT_L(0); PG8_BAR; PG8_MMA(0, 0, At, B0); PG8_MMA(0, 1, At, B1); PG8_BAR; PG8_SCHED;
            if (fullu) PG8_LDA(At, 0, 1); PG8_STAGE(PG8_SB(0, 0), b2, voffB); PG8_STAGE(PG8_SB(0, 1), b2 + hstep, voffB); PG8_STAGE(PG8_SA(0, 0), a2, v2);
            PG8_WAIT_V(8); PG8_WAIT_L(0); PG8_BAR; if (fullu) { PG8_MMA(1, 0, At, B0); PG8_MMA(1, 1, At, B1); } PG8_BAR; PG8_SCHED;
            PG8_LDB(B0, 1, 0); PG8_LDB(B1, 1, 1); PG8_SCHED; PG8_LDA(At, 1, 0); PG8_STAGE(PG8_SA(0, 1), a2, v2 + 2);
            PG8_WAIT_V(8); PG8_WAIT_L(0); PG8_BAR; PG8_MMA(0, 0, At, B0); PG8_MMA(0, 1, At, B1); PG8_BAR; PG8_SCHED;
            if (fullu) PG8_LDA(At, 1, 1); PG8_STAGE(PG8_SB(1, 0), b3, voffB); PG8_STAGE(PG8_SB(1, 1), b3 + hstep, voffB); PG8_STAGE(PG8_SA(1, 0), a3, v2);
            PG8_WAIT_V(8); PG8_WAIT_L(0); PG8_BAR; if (fullu) { PG8_MMA(1, 0, At, B0); PG8_MMA(1, 1, At, B1); } PG8_BAR; PG8_SCHED;
        }
        if (wr == 0) PG8_BAR;
        E(acc, cur, wr, wc, fr, fq);
        if (!has_next) break;
#pragma unroll
        for (int a = 0; a < 2; ++a)
#pragma unroll
            for (int b = 0; b < 2; ++b)
#pragma unroll
                for (int m = 0; m < 4; ++m)
#pragma unroll
                    for (int n = 0; n < 2; ++n) acc[a][b][m][n] = (f32x4){0.f, 0.f, 0.f, 0.f};
        cur = nxt; cB = nB; ++ui;
#pragma unroll
        for (int q = 0; q < 4; ++q) vc[q] = vn[q];
        if (wr == 1) PG8_BAR;
    }
    PG8_WAIT_V(0);
    PG8_BAR;
#undef PG8_SA
#undef PG8_SB
#undef PG8_STAGE
#undef PG8_LDA
#undef PG8_LDB
#undef PG8_MMA
#undef PG8_WAIT_V
#undef PG8_WAIT_L
#undef PG8_BAR
#undef PG8_SCHED
}
}

#ifndef PG8_SP2
#define PG8_SP2 true
#endif
struct EpiHgrnIn {
    static constexpr bool PERM = false, AFTER_DRAIN = false;
    char* ws; const float* lb;
    __device__ __forceinline__ void operator()(const pg8::f32x4 (&acc)[2][2][4][2], const pg8::Unit& u, int wr, int wc, int fr, int fq) const {
        const int seg = u.pn >> 2, cbase = (u.pn & 3) * 256 + wc * 32 + fq * 8;
        if (seg == 1) {
            unsigned short* dst = (unsigned short*)(ws + OFF_LF);
#pragma unroll
            for (int bj = 0; bj < 2; ++bj) {
                const f32x4 la0 = *(const f32x4*)(lb + cbase + bj * 128), la1 = *(const f32x4*)(lb + cbase + bj * 128 + 4);
#pragma unroll
                for (int ai = 0; ai < 2; ++ai)
#pragma unroll
                    for (int m = 0; m < 4; ++m) {
                        const size_t row = (size_t)(u.pm * 256 + ai * 128 + wr * 64 + m * 16 + fr);
                        float h[8];
#pragma unroll
                        for (int j = 0; j < 4; ++j) {
                            h[j] = __builtin_amdgcn_logf(la0[j] + (1.f - la0[j]) * sigmoid_f(acc[ai][bj][m][0][j]));
                            h[4 + j] = __builtin_amdgcn_logf(la1[j] + (1.f - la1[j]) * sigmoid_f(acc[ai][bj][m][1][j]));
                        }
                        uint4 oh; oh.x = packh2(h[0], h[1]); oh.y = packh2(h[2], h[3]); oh.z = packh2(h[4], h[5]); oh.w = packh2(h[6], h[7]);
                        *(uint4*)(dst + row * 1024 + cbase + bj * 128) = oh;
                    }
            }
        } else {
            bf16_t* dst = (bf16_t*)(ws + (seg == 0 ? OFF_QH : seg == 2 ? OFF_V : OFF_G));
#pragma unroll
            for (int ai = 0; ai < 2; ++ai)
#pragma unroll
                for (int m = 0; m < 4; ++m) {
                    const size_t row = (size_t)(u.pm * 256 + ai * 128 + wr * 64 + m * 16 + fr);
#pragma unroll
                    for (int bj = 0; bj < 2; ++bj) {
                        float h[8];
#pragma unroll
                        for (int n = 0; n < 2; ++n)
#pragma unroll
                            for (int j = 0; j < 4; ++j) { const float a = acc[ai][bj][m][n][j]; h[n * 4 + j] = (seg == 2) ? a : silu_f(a); }
                        uint4 o; o.x = pack2(h[0], h[1]); o.y = pack2(h[2], h[3]); o.z = pack2(h[4], h[5]); o.w = pack2(h[6], h[7]);
                        *(uint4*)(dst + row * 1024 + cbase + bj * 128) = o;
                    }
                }
        }
    }
};

struct EpiOutProj {
    static constexpr bool PERM = false, AFTER_DRAIN = false;
    const float* mod; const float* xin; float* xo; int ls;
    __device__ __forceinline__ void operator()(const pg8::f32x4 (&acc)[2][2][4][2], const pg8::Unit& u, int wr, int wc, int fr, int fq) const {
        const int b = (u.pm * 256) >> 11;
        const float* gate = mod + ((size_t)ls * 16 + b) * 3072 + 2048 + u.pn * 256 + wc * 32 + fq * 8;
        f32x4 g[2][2];
#pragma unroll
        for (int bj = 0; bj < 2; ++bj) { g[bj][0] = *(const f32x4*)(gate + bj * 128); g[bj][1] = *(const f32x4*)(gate + bj * 128 + 4); }
#pragma unroll
        for (int ai = 0; ai < 2; ++ai)
#pragma unroll
            for (int m = 0; m < 4; ++m) {
                const size_t ro = (size_t)(u.pm * 256 + ai * 128 + wr * 64 + m * 16 + fr) * 1024 + u.pn * 256 + wc * 32 + fq * 8;
                f32x4 xi[2][2];
#pragma unroll
                for (int bj = 0; bj < 2; ++bj) { xi[bj][0] = *(const f32x4*)(xin + ro + bj * 128); xi[bj][1] = *(const f32x4*)(xin + ro + bj * 128 + 4); }
#pragma unroll
                for (int bj = 0; bj < 2; ++bj)
#pragma unroll
                    for (int n = 0; n < 2; ++n) {
                        f32x4 o;
#pragma unroll
                        for (int j = 0; j < 4; ++j) o[j] = xi[bj][n][j] + g[bj][n][j] * acc[ai][bj][m][n][j];
                        *(f32x4*)(xo + ro + bj * 128 + n * 4) = o;
                    }
            }
    }
};


struct MoeOrder {
    const int* s_off; const int* s_toff; const int* s_hoff; int ntiles, vb, G;
    __device__ __forceinline__ void locate(int i, int& e, int& rt, int& ct, int& half) const {
        const int tile = vb + i * G, nfull = s_toff[16];
        e = 0;
        if (tile < nfull) { while (tile >= s_toff[e + 1]) ++e; const int lt = tile - s_toff[e]; rt = lt >> 2; ct = lt & 3; half = 0; }
        else { const int h = tile - nfull; while (h >= s_hoff[e + 1]) ++e; ct = h - s_hoff[e]; rt = (s_toff[e + 1] - s_toff[e]) >> 2; half = 1; }
    }
    __device__ __forceinline__ bool next(int i, pg8::Unit& u) const {
        if (vb + i * G >= ntiles) return false;
        int e, rt, ct, half; locate(i, e, rt, ct, half);
        u.pm = i; u.pn = (e * 4 + ct) | (half << 16); return true;
    }
};
struct EpiMoeUp {
    static constexpr bool PERM = false, AFTER_DRAIN = false;
    bf16_t* H1; MoeOrder S;
    __device__ __forceinline__ void operator()(const pg8::f32x4 (&acc)[2][2][4][2], const pg8::Unit& u, int wr, int wc, int fr, int fq) const {
        int e, rt, ct, half; S.locate(u.pm, e, rt, ct, half);
        const int off = S.s_off[e], cnt = S.s_off[e + 1] - off;
#pragma unroll
        for (int ai = 0; ai < 2; ++ai)
#pragma unroll
            for (int m = 0; m < 4; ++m) {
                const int pos = rt * 256 + ai * 128 + wr * 64 + m * 16 + fr;
                if (pos < cnt) {
                    float h[8];
#pragma unroll
                    for (int n = 0; n < 2; ++n)
#pragma unroll
                        for (int jj = 0; jj < 4; ++jj) h[n * 4 + jj] = silu_f(acc[ai][0][m][n][jj]) * acc[ai][1][m][n][jj];
                    uint4 o; o.x = pack2(h[0], h[1]); o.y = pack2(h[2], h[3]); o.z = pack2(h[4], h[5]); o.w = pack2(h[6], h[7]);
                    *(uint4*)(H1 + (size_t)(off + pos) * 512 + ct * 128 + wc * 32 + fq * 8) = o;
                }
            }
    }
};
struct EpiMoeDown {
    static constexpr bool PERM = false, AFTER_DRAIN = false;
    bf16_t* Y; const float* lwc; MoeOrder S;
    __device__ __forceinline__ void operator()(const pg8::f32x4 (&acc)[2][2][4][2], const pg8::Unit& u, int wr, int wc, int fr, int fq) const {
        int e, rt, ct, half; S.locate(u.pm, e, rt, ct, half);
        const int off = S.s_off[e], cnt = S.s_off[e + 1] - off;
#pragma unroll
        for (int ai = 0; ai < 2; ++ai)
#pragma unroll
            for (int m = 0; m < 4; ++m) {
                const int rl_ = ai * 128 + wr * 64 + m * 16 + fr, pos = rt * 256 + rl_;
                if (pos < cnt) {
                    const float w = lwc[u.pm * 256 + rl_];
                    bf16_t* dst = Y + (size_t)(off + pos) * 1024 + ct * 256 + wc * 32 + fq * 8;
#pragma unroll
                    for (int bj = 0; bj < 2; ++bj) {
                        const pg8::f32x4 a = acc[ai][bj][m][0], bb = acc[ai][bj][m][1];
                        uint4 o; o.x = pack2(w * a[0], w * a[1]); o.y = pack2(w * a[2], w * a[3]); o.z = pack2(w * bb[0], w * bb[1]); o.w = pack2(w * bb[2], w * bb[3]);
                        *(uint4*)(dst + bj * 128) = o;
                    }
                }
            }
    }
};

template <bool DOWN>
__device__ __forceinline__ void phase_moe8(const Params& p, const Ctx& cx, char* lds, int layer) {
    const int tid = cx.tid;
    int* s_off = (int*)(lds + LDS_TAB_OFF); int* s_toff = s_off + 17; int* s_hoff = s_toff + 17;
    moe_tables(p, layer, tid, s_off, s_toff, s_hoff);
    const int ntiles = s_toff[16] + s_hoff[16];
    const int vb = cx.vbid, G = cx.G;
    MoeOrder S{s_off, s_toff, s_hoff, ntiles, vb, G};
    const int* ltok = (const int*)(p.ws + OFF_LTOK);
    const float* lw = (const float*)(p.ws + OFF_LW);
    int* rowidx = (int*)(lds + LDS_ROWIDX_OFF);
    float* lwc = (float*)(lds + LDS_LW_OFF);
    const int my_tiles = min(8, vb < ntiles ? (ntiles - vb + G - 1) / G : 0);
    for (int i = tid; i < my_tiles * 256; i += NTHR) {
        const int j = i >> 8, r = i & 255; int e, rt, ct, half; S.locate(j, e, rt, ct, half);
        const int off = s_off[e], pos = min(rt * 256 + r, s_off[e + 1] - off - 1);
        if constexpr (DOWN) { rowidx[i] = off + pos; lwc[i] = lw[(size_t)e * NTOK + pos]; }
        else rowidx[i] = ltok[(size_t)e * NTOK + pos];
    }
    __syncthreads();
    const PG8_LAS int* rows = (const PG8_LAS int*)((PG8_LAS unsigned char*)lds + LDS_ROWIDX_OFF);
    if constexpr (DOWN) {
        pg8::Gemm g{(const bf16_t*)(p.ws + OFF_H1), (const bf16_t*)(p.ws + OFF_W_DN) + (size_t)layer * 16 * 1024 * 512, 0, 0, 512};
        EpiMoeDown E{(bf16_t*)(p.ws + OFF_Y), lwc, S};
        pg8::gemm_phase_rows<EpiMoeDown, MoeOrder>((PG8_LAS unsigned char*)lds, g, S, E, rows);
    } else {
        pg8::Gemm g{(const bf16_t*)(p.ws + OFF_HA), (const bf16_t*)(p.ws + OFF_W_UP) + (size_t)layer * 16 * 1024 * 1024, 0, 0, 1024};
        EpiMoeUp E{(bf16_t*)(p.ws + OFF_H1), S};
        pg8::gemm_phase_rows<EpiMoeUp, MoeOrder>((PG8_LAS unsigned char*)lds, g, S, E, rows);
    }
}

__device__ __forceinline__ void phase_outproj8(const Params& p, const Ctx& cx, char* lds, const bf16_t* A, const bf16_t* Bt, const float* xin, int ls) {
    pg8::Gemm g{A, Bt, NTOK, 1024, 1024};
    pg8::StaticOrder S; S.init(NTOK, 1024, cx.G, (int)blockIdx.x);
    EpiOutProj E{(const float*)(p.ws + OFF_MOD), xin, p.out, ls};
    __syncthreads();
    pg8::gemm_phase<EpiOutProj, pg8::StaticOrder, true, PG8_SP2>((PG8_LAS unsigned char*)lds, g, S, E);
    __syncthreads();
}

__device__ __forceinline__ void phase_hgrn_inproj8(const Params& p, const Ctx& cx, char* lds) {
    pg8::Gemm g{(const bf16_t*)(p.ws + OFF_HA), (const bf16_t*)(p.ws + OFF_W_HG_IN), NTOK, 4096, 1024};
    pg8::StaticOrder S; S.init(NTOK, 4096, cx.G, (int)blockIdx.x);
    EpiHgrnIn E{p.ws, (const float*)(p.ws + OFF_LB)};
    __syncthreads();
    pg8::gemm_phase<EpiHgrnIn, pg8::StaticOrder, true, PG8_SP2>((PG8_LAS unsigned char*)lds, g, S, E);
    __syncthreads();
}

template <int MODE = 0>
__device__ __forceinline__ void phase_hgrn_inproj(const Params& p, const Ctx& cx, char* lds) {
    const bf16_t* A = (const bf16_t*)(p.ws + OFF_HA);
    const bf16_t* Bt = (const bf16_t*)(p.ws + OFF_W_HG_IN);
    char* ws = p.ws;
    const float* lb = (const float*)(p.ws + OFF_LB);
    gemm_phase_dense2(A, 1024, Bt, 1024, NTOK / 256, 16, lds, cx, [=](int row0, int col0) {
        return [=](f32x4 (&acc)[8][4], int wr, int wc, int fr, int fq) {
            const int gc0 = col0 + wc * 64, seg = gc0 >> 10, c0 = gc0 & 1023;
#pragma unroll
            for (int m = 0; m < 8; ++m) {
                const int row = row0 + wr * 128 + m * 16 + fr;
#pragma unroll
                for (int pp = 0; pp < 2; ++pp) {
                    const int c = c0 + pp * 32 + fq * 8;
                    float h[8];
                    if (seg == 1) {
                        const f32x4 la = *(const f32x4*)(lb + c), lbb = *(const f32x4*)(lb + c + 4);
#pragma unroll
                        for (int j = 0; j < 4; ++j) {
                            h[j] = __logf(la[j] + (1.f - la[j]) * sigmoid_f(acc[m][2 * pp][j]));
                            h[4 + j] = __logf(lbb[j] + (1.f - lbb[j]) * sigmoid_f(acc[m][2 * pp + 1][j]));
                        }
                        uint4 oh; oh.x = packh2(h[0], h[1]); oh.y = packh2(h[2], h[3]); oh.z = packh2(h[4], h[5]); oh.w = packh2(h[6], h[7]);
                        *(uint4*)((unsigned short*)(ws + OFF_LF) + (size_t)row * 1024 + c) = oh;
                    } else {
#pragma unroll
                        for (int j = 0; j < 4; ++j) {
                            h[j] = (seg == 2) ? acc[m][2 * pp][j] : silu_f(acc[m][2 * pp][j]);
                            h[4 + j] = (seg == 2) ? acc[m][2 * pp + 1][j] : silu_f(acc[m][2 * pp + 1][j]);
                        }
                        uint4 o; o.x = pack2(h[0], h[1]); o.y = pack2(h[2], h[3]); o.z = pack2(h[4], h[5]); o.w = pack2(h[6], h[7]);
                        bf16_t* dst = (bf16_t*)(ws + (seg == 0 ? OFF_QH : seg == 2 ? OFF_V : OFF_G));
                        *(uint4*)(dst + (size_t)row * 1024 + c) = o;
                    }
                }
            }
        };
    });
}

constexpr int HG_QD_OFF = 0, HG_KD_OFF = 8704, HG_K2T_OFF = 17408, HG_VT_OFF = 27648, HG_DEC_OFF = 37888, HG_BUF = 38400, HG_TOT_OFF = 2 * HG_BUF;
constexpr int HG_ROW = 272, HG_TROW = 80;
static_assert(HG_TOT_OFF + 2048 <= LDS_TAB_OFF, "hgrn LDS");

__device__ __forceinline__ void phase_hgrn_rec(const Params& p, const Ctx& cx, char* lds) {
    const int lane = cx.lane;
    const int l31 = lane & 31, h2 = lane >> 5;
    const int widu = __builtin_amdgcn_readfirstlane(cx.wid);
    const bool producer = widu >= 4;
    const int pw = widu & 3;
    const int d0 = 2 * lane;
    const bf16_t* QH = (const bf16_t*)(p.ws + OFF_QH);
    const unsigned short* LF = (const unsigned short*)(p.ws + OFF_LF);
    const bf16_t* V = (const bf16_t*)(p.ws + OFF_V);
    bf16_t* OR = (bf16_t*)(p.ws + OFF_HA);
    float* tot = (float*)(lds + HG_TOT_OFF);
    for (int item = blockIdx.x; item < 128; item += cx.G) {
        const int b = item >> 3, h = item & 7;
        f32x16 S0, S1, S2, S3;
#pragma unroll
        for (int r = 0; r < 16; ++r) { S0[r] = 0.f; S1[r] = 0.f; S2[r] = 0.f; S3[r] = 0.f; }
        unsigned lfA[8], lfB[8], qv[8], vv[8];
        const size_t gbase = (size_t)(b * SEQ + pw * 8) * 1024 + h * 128;
        if (producer) {
#pragma unroll
            for (int i = 0; i < 8; ++i) {
                lfA[i] = *(const unsigned*)(LF + gbase + (size_t)i * 1024 + d0);
                qv[i] = *(const unsigned*)(QH + gbase + (size_t)i * 1024 + d0);
                vv[i] = *(const unsigned*)(V + gbase + (size_t)i * 1024 + d0);
            }
#pragma unroll
            for (int i = 0; i < 8; ++i) lfB[i] = *(const unsigned*)(LF + gbase + (size_t)(32 + i) * 1024 + d0);
        }
        __syncthreads();
        for (int c = 0; c <= SEQ / 32; ++c) {
            unsigned lf[8];
#pragma unroll
            for (int i = 0; i < 8; ++i) lf[i] = (c & 1) ? lfB[i] : lfA[i];
            f2_t run = {0.f, 0.f};
            if (producer && c < SEQ / 32) {
#pragma unroll
                for (int i = 0; i < 8; ++i) run += unpackh2(lf[i]);
                *(f2_t*)(tot + pw * 128 + d0) = run;
            }
            __syncthreads();
            if (producer) {
                if (c < SEQ / 32) {
                    char* bufp = lds + (c & 1) * HG_BUF;
                    f2_t pre = {0.f, 0.f}, last = {0.f, 0.f};
#pragma unroll
                    for (int q = 0; q < 4; ++q) {
                        const f2_t tq_ = *(const f2_t*)(tot + q * 128 + d0);
                        last += tq_;
                        if (q < pw) pre += tq_;
                    }
                    if (pw == 0) { f2_t dv; dv.x = __builtin_amdgcn_exp2f(last.x); dv.y = __builtin_amdgcn_exp2f(last.y); *(f2_t*)(bufp + HG_DEC_OFF + d0 * 4) = dv; }
                    float k2a[8], k2b[8];
                    f2_t rc = pre;
#pragma unroll
                    for (int i = 0; i < 8; ++i) {
                        const f2_t lfi = unpackh2(lf[i]);
                        rc += lfi;
                        const float cu0 = rc.x, cu1 = rc.y;
                        const float kk0 = 1.f - __builtin_amdgcn_exp2f(lfi.x), kk1 = 1.f - __builtin_amdgcn_exp2f(lfi.y);
                        const float q0 = bf2f((unsigned short)(qv[i] & 0xffff)) * __builtin_amdgcn_exp2f(cu0), q1 = bf2f((unsigned short)(qv[i] >> 16)) * __builtin_amdgcn_exp2f(cu1);
                        const float kd0 = kk0 * __builtin_amdgcn_exp2f(-cu0), kd1 = kk1 * __builtin_amdgcn_exp2f(-cu1);
                        k2a[i] = kk0 * __builtin_amdgcn_exp2f(last.x - cu0); k2b[i] = kk1 * __builtin_amdgcn_exp2f(last.y - cu1);
                        const int tl = pw * 8 + i;
                        *(unsigned*)(bufp + HG_QD_OFF + tl * HG_ROW + d0 * 2) = pack2(q0, q1);
                        *(unsigned*)(bufp + HG_KD_OFF + tl * HG_ROW + d0 * 2) = pack2(kd0, kd1);
                    }
                    uint4 a, bq, va, vb;
                    a.x = pack2(k2a[0], k2a[1]); a.y = pack2(k2a[2], k2a[3]); a.z = pack2(k2a[4], k2a[5]); a.w = pack2(k2a[6], k2a[7]);
                    bq.x = pack2(k2b[0], k2b[1]); bq.y = pack2(k2b[2], k2b[3]); bq.z = pack2(k2b[4], k2b[5]); bq.w = pack2(k2b[6], k2b[7]);
                    va.x = (vv[0] & 0xffffu) | (vv[1] << 16); va.y = (vv[2] & 0xffffu) | (vv[3] << 16); va.z = (vv[4] & 0xffffu) | (vv[5] << 16); va.w = (vv[6] & 0xffffu) | (vv[7] << 16);
                    vb.x = (vv[0] >> 16) | (vv[1] & 0xffff0000u); vb.y = (vv[2] >> 16) | (vv[3] & 0xffff0000u); vb.z = (vv[4] >> 16) | (vv[5] & 0xffff0000u); vb.w = (vv[6] >> 16) | (vv[7] & 0xffff0000u);
                    *(uint4*)(bufp + HG_K2T_OFF + d0 * HG_TROW + pw * 16) = a;
                    *(uint4*)(bufp + HG_K2T_OFF + (d0 + 1) * HG_TROW + pw * 16) = bq;
                    *(uint4*)(bufp + HG_VT_OFF + d0 * HG_TROW + pw * 16) = va;
                    *(uint4*)(bufp + HG_VT_OFF + (d0 + 1) * HG_TROW + pw * 16) = vb;
                    __builtin_amdgcn_sched_barrier(0);
                    if (c + 1 < SEQ / 32) {
                        const size_t gn = gbase + (size_t)(c + 1) * 32 * 1024;
#pragma unroll
                        for (int i = 0; i < 8; ++i) {
                            qv[i] = *(const unsigned*)(QH + gn + (size_t)i * 1024 + d0);
                            vv[i] = *(const unsigned*)(V + gn + (size_t)i * 1024 + d0);
                        }
                    }
                    if (c + 2 < SEQ / 32) {
                        const size_t gn = gbase + (size_t)(c + 2) * 32 * 1024;
                        if (c & 1) {
#pragma unroll
                            for (int i = 0; i < 8; ++i) lfB[i] = *(const unsigned*)(LF + gn + (size_t)i * 1024 + d0);
                        } else {
#pragma unroll
                            for (int i = 0; i < 8; ++i) lfA[i] = *(const unsigned*)(LF + gn + (size_t)i * 1024 + d0);
                        }
                    }
                }
            } else if (c >= 1) {
                const int cc = c - 1;
                const char* bufp = lds + (cc & 1) * HG_BUF;
                const float* dec = (const float*)(bufp + HG_DEC_OFF);
                f32x16 X;
#pragma unroll
                for (int r = 0; r < 16; ++r) X[r] = 0.f;
                {
                    const char* ka = bufp + HG_KD_OFF + l31 * HG_ROW + 16 * h2;
                    const char* qa = bufp + HG_QD_OFF + l31 * HG_ROW + 16 * h2;
#pragma unroll 2
                    for (int ks = 0; ks < 8; ++ks) X = MFMA32(*(const bf16x8*)(ka + 32 * ks), *(const bf16x8*)(qa + 32 * ks), X);
#pragma unroll
                    for (int r = 0; r < 16; ++r) { const int srow = (r & 3) + 8 * (r >> 2) + 4 * h2; X[r] = (srow <= l31) ? X[r] : 0.f; }
                }
                f32x16 Oa;
#pragma unroll
                for (int r = 0; r < 16; ++r) Oa[r] = 0.f;
                const int jrow = 32 * pw + l31;
#pragma unroll
                for (int s2 = 0; s2 < 2; ++s2) {
                    uint4 xk;
                    xk.x = pack2(X[8 * s2], X[8 * s2 + 1]); xk.y = pack2(X[8 * s2 + 2], X[8 * s2 + 3]); xk.z = pack2(X[8 * s2 + 4], X[8 * s2 + 5]); xk.w = pack2(X[8 * s2 + 6], X[8 * s2 + 7]);
                    const char* va = bufp + HG_VT_OFF + jrow * HG_TROW + (16 * s2 + 4 * h2) * 2;
                    const uint2 lo = *(const uint2*)va, hi = *(const uint2*)(va + 16);
                    uint4 vb; vb.x = lo.x; vb.y = lo.y; vb.z = hi.x; vb.w = hi.y;
                    Oa = MFMA32(__builtin_bit_cast(bf16x8, xk), __builtin_bit_cast(bf16x8, vb), Oa);
                }
                auto qs_term = [&](const f32x16& St, int dt) {
#pragma unroll
                    for (int s2 = 0; s2 < 2; ++s2) {
                        uint4 sk;
                        sk.x = pack2(St[8 * s2], St[8 * s2 + 1]); sk.y = pack2(St[8 * s2 + 2], St[8 * s2 + 3]); sk.z = pack2(St[8 * s2 + 4], St[8 * s2 + 5]); sk.w = pack2(St[8 * s2 + 6], St[8 * s2 + 7]);
                        const char* qa = bufp + HG_QD_OFF + l31 * HG_ROW + (32 * dt + 16 * s2 + 4 * h2) * 2;
                        const uint2 lo = *(const uint2*)qa, hi = *(const uint2*)(qa + 16);
                        uint4 qb; qb.x = lo.x; qb.y = lo.y; qb.z = hi.x; qb.w = hi.y;
                        Oa = MFMA32(__builtin_bit_cast(bf16x8, qb), __builtin_bit_cast(bf16x8, sk), Oa);
                    }
                };
                __builtin_amdgcn_sched_barrier(0);
                qs_term(S0, 0); qs_term(S1, 1);
                __builtin_amdgcn_sched_barrier(0);
                qs_term(S2, 2); qs_term(S3, 3);
                __builtin_amdgcn_sched_barrier(0);
                {
                    bf16_t* orow = OR + (size_t)(b * SEQ + cc * 32 + 4 * h2) * 1024 + h * 128 + jrow;
#pragma unroll
                    for (int r = 0; r < 16; ++r) orow[(size_t)((r & 3) + 8 * (r >> 2)) * 1024] = f2bf(Oa[r]);
                }
                auto s_update = [&](f32x16& St, int dt) {
#pragma unroll
                    for (int rq = 0; rq < 4; ++rq) {
                        const f32x4 dc = *(const f32x4*)(dec + 32 * dt + 8 * rq + 4 * h2);
                        St[4 * rq] *= dc[0]; St[4 * rq + 1] *= dc[1]; St[4 * rq + 2] *= dc[2]; St[4 * rq + 3] *= dc[3];
                    }
#pragma unroll
                    for (int s2 = 0; s2 < 2; ++s2) {
                        const bf16x8 ka = *(const bf16x8*)(bufp + HG_K2T_OFF + (32 * dt + l31) * HG_TROW + (16 * s2 + 8 * h2) * 2);
                        const bf16x8 vb = *(const bf16x8*)(bufp + HG_VT_OFF + jrow * HG_TROW + (16 * s2 + 8 * h2) * 2);
                        St = MFMA32(ka, vb, St);
                    }
                };
                __builtin_amdgcn_sched_barrier(0);
                s_update(S0, 0); s_update(S1, 1);
                __builtin_amdgcn_sched_barrier(0);
                s_update(S2, 2); s_update(S3, 3);
                __builtin_amdgcn_sched_barrier(0);
            }
            __syncthreads();
        }
    }
}

__device__ __forceinline__ void phase_hgrn_post(const Params& p, const Ctx& cx) {
    const int lane = cx.lane;
    const bf16_t* OR = (const bf16_t*)(p.ws + OFF_HA);
    const bf16_t* Gt = (const bf16_t*)(p.ws + OFF_G);
    bf16_t* OA = (bf16_t*)(p.ws + OFF_QH);
    const int col = lane * 16;
    float gn[16];
#pragma unroll
    for (int i = 0; i < 16; ++i) gn[i] = p.hgrn_out_gain[(col & 127) + i];
    for (int row = cx.vbid * NWAVE + cx.wid; row < NTOK; row += cx.G * NWAVE) {
        const uint4 a0 = *(const uint4*)(OR + (size_t)row * 1024 + col), a1 = *(const uint4*)(OR + (size_t)row * 1024 + col + 8);
        const uint4 g0 = *(const uint4*)(Gt + (size_t)row * 1024 + col), g1 = *(const uint4*)(Gt + (size_t)row * 1024 + col + 8);
        const unsigned aw[8] = {a0.x, a0.y, a0.z, a0.w, a1.x, a1.y, a1.z, a1.w};
        const unsigned gw[8] = {g0.x, g0.y, g0.z, g0.w, g1.x, g1.y, g1.z, g1.w};
        float o[16];
        float ss = 0.f;
#pragma unroll
        for (int i = 0; i < 8; ++i) { o[2 * i] = bf2f((unsigned short)(aw[i] & 0xffff)); o[2 * i + 1] = bf2f((unsigned short)(aw[i] >> 16)); ss += o[2 * i] * o[2 * i] + o[2 * i + 1] * o[2 * i + 1]; }
        ss += __shfl_xor(ss, 1); ss += __shfl_xor(ss, 2); ss += __shfl_xor(ss, 4);
        const float r = rsqrtf(ss * (1.f / 128.f) + EPS);
        unsigned w[8];
#pragma unroll
        for (int i = 0; i < 8; ++i)
            w[i] = pack2(o[2 * i] * r * gn[2 * i] * bf2f((unsigned short)(gw[i] & 0xffff)), o[2 * i + 1] * r * gn[2 * i + 1] * bf2f((unsigned short)(gw[i] >> 16)));
        uint4 o0, o1; o0.x = w[0]; o0.y = w[1]; o0.z = w[2]; o0.w = w[3]; o1.x = w[4]; o1.y = w[5]; o1.z = w[6]; o1.w = w[7];
        *(uint4*)(OA + (size_t)row * 1024 + col) = o0;
        *(uint4*)(OA + (size_t)row * 1024 + col + 8) = o1;
    }
}


#define XB_TMO      128
#define XB_XCNT(j)  (256  + 64 * (j))
#define XB_XSUB(j)  (1280 + 64 * (j))
#define XB_XGEN(j)  (2304 + 64 * (j))
#define XB_TOP      3328
#define XB_TOPGEN   3392
#define XCD_BAR_WORDS 3456
#define XB_SPIN_CAP (1u << 20)
#define LAS __attribute__((address_space(3)))
__device__ __forceinline__ unsigned xb_ld(unsigned* p)              { return __hip_atomic_load(p, __ATOMIC_RELAXED, __HIP_MEMORY_SCOPE_AGENT); }
__device__ __forceinline__ unsigned xb_add(unsigned* p, unsigned v) { return __hip_atomic_fetch_add(p, v, __ATOMIC_RELAXED, __HIP_MEMORY_SCOPE_AGENT); }
__device__ __forceinline__ unsigned xb_xcc_id() { return (unsigned)__builtin_amdgcn_s_getreg((3 << 11) | 20) & 0xFu; }
#define XB_SPIN(cond, bar) do { unsigned _sp = 0; while (cond) { __builtin_amdgcn_s_sleep(1); \
    if ((++_sp & 255u) == 0u) { if (xb_ld(&(bar)[XB_TMO])) break; if (_sp > XB_SPIN_CAP) { atomicAdd(&(bar)[XB_TMO], 1u); break; } } } } while (0)
struct XcdBarrier { unsigned* bar; unsigned x; volatile unsigned* st; };
__device__ __forceinline__ XcdBarrier xcd_barrier_post(unsigned* bar, volatile unsigned* st) {
    XcdBarrier b; b.bar = bar; b.x = xb_xcc_id(); b.st = st;
    if (threadIdx.x == 0) (void)xb_add(&bar[XB_XCNT(b.x)], 1u);
    return b;
}
__device__ __forceinline__ void xcd_barrier_complete(unsigned* bar, unsigned x, unsigned& nloc, unsigned& nx) {
    const unsigned G = gridDim.x * gridDim.y * gridDim.z;
    unsigned sum, cnt, mine, sp = 0u;
    for (;;) {
        sum = 0u; cnt = 0u; mine = 0u;
#pragma unroll
        for (unsigned j = 0; j < 16; ++j) { const unsigned c = xb_ld(&bar[XB_XCNT(j)]); sum += c; cnt += (c > 0u) ? 1u : 0u; mine = (j == x) ? c : mine; }
        if (sum == G) break;
        __builtin_amdgcn_s_sleep(1);
        if ((++sp & 255u) == 0u) { if (xb_ld(&bar[XB_TMO])) break; if (sp > XB_SPIN_CAP) { atomicAdd(&bar[XB_TMO], 1u); break; } }
    }
    nloc = mine > 0u ? mine : 1u; nx = cnt > 0u ? cnt : 1u;
}
__device__ __forceinline__ void xcd_barrier(const XcdBarrier& b) {
    asm volatile("s_waitcnt vmcnt(0)" ::: "memory");
    __syncthreads();
    if (threadIdx.x == 0) {
        unsigned* bar = b.bar;
        __builtin_amdgcn_s_waitcnt(0);
        unsigned nloc = b.st[0], nx = b.st[1];
        if (nloc == 0u) { xcd_barrier_complete(bar, b.x, nloc, nx); b.st[0] = nloc; b.st[1] = nx; }
        const unsigned old = xb_add(&bar[XB_XSUB(b.x)], 1u);
        const unsigned gen = old / nloc;
        if (old + 1u == (gen + 1u) * nloc) {
            __builtin_amdgcn_fence(__ATOMIC_RELEASE, "agent");
            asm volatile("s_waitcnt vmcnt(0)" ::: "memory");
            const unsigned og = xb_add(&bar[XB_TOP], 1u);
            const unsigned tg = og / nx;
            if (og + 1u == (tg + 1u) * nx) xb_add(&bar[XB_TOPGEN], 1u);
            else XB_SPIN(xb_ld(&bar[XB_TOPGEN]) == tg, bar);
            __builtin_amdgcn_fence(__ATOMIC_ACQUIRE, "agent");
            xb_add(&bar[XB_XGEN(b.x)], 1u);
            asm volatile("s_waitcnt vmcnt(0)" ::: "memory");
        } else {
            XB_SPIN(xb_ld(&bar[XB_XGEN(b.x)]) == gen, bar);
            __builtin_amdgcn_fence(__ATOMIC_ACQUIRE, "agent");
            asm volatile("s_waitcnt vmcnt(0)" ::: "memory");
        }
    }
    __syncthreads();
}

template <int PH>
__device__ __forceinline__ void run_phase(const Params& p, const Ctx& cx, char* lds) {
    if constexpr (PH == 0) phase0(p, cx, lds);
    else if constexpr (PH == 1) rows_phase<false, true, false>(p, cx, lds, p.x, nullptr, 0, 0, 0, 0);
    else if constexpr (PH == 2) phase_nsa_inproj(p, cx, lds);
    else if constexpr (PH == 3) {
        phase_cmp1(p, cx, lds);
        const int w = cx.vbid >= 64 ? cx.vbid - 64 : -1, nw = cx.G - 64;
        transpose_range(p, lds, cx.tid, w, nw, TC2, TC4);
        transpose_range(p, lds, cx.tid, w, nw, TC5, TC_UP1);
        transpose_range(p, lds, cx.tid, w, nw, TC6, TC_DN1);
    }
    else if constexpr (PH == 4) phase_cmp2(p, cx);
    else if constexpr (PH == 5) phase_attn(p, cx, lds);
    else if constexpr (PH == 6) phase_outproj8(p, cx, lds, (const bf16_t*)(p.ws + OFF_HA), (const bf16_t*)(p.ws + OFF_W_NSA_OUT), p.x, 0);
    else if constexpr (PH == 7) rows_router_phase(p, cx, lds, p.out, 1, 0);
    else if constexpr (PH == 8) phase_moe8<false>(p, cx, lds, 0);
    else if constexpr (PH == 9) phase_moe8<true>(p, cx, lds, 0);
    else if constexpr (PH == 10) { float* xo = p.out; asm volatile("" : "+s"(xo)); rows_phase<true, true, false>(p, cx, lds, xo, xo, 1, 2, 0, 0); }
    else if constexpr (PH == 11) phase_hgrn_inproj8(p, cx, lds);
    else if constexpr (PH == 12) {
        phase_hgrn_rec(p, cx, lds);
        const int w = (int)blockIdx.x >= 128 ? (int)blockIdx.x - 128 : -1, nw = cx.G - 128;
        transpose_range(p, lds, cx.tid, w, nw, TC_UP1, TC6);
        transpose_range(p, lds, cx.tid, w, nw, TC_DN1, TC_END);
    }
    else if constexpr (PH == 13) phase_hgrn_post(p, cx);
    else if constexpr (PH == 14) phase_outproj8(p, cx, lds, (const bf16_t*)(p.ws + OFF_QH), (const bf16_t*)(p.ws + OFF_W_HG_OUT), p.out, 2);
    else if constexpr (PH == 15) rows_router_phase(p, cx, lds, p.out, 3, 1);
    else if constexpr (PH == 16) phase_moe8<false>(p, cx, lds, 1);
    else if constexpr (PH == 17) phase_moe8<true>(p, cx, lds, 1);
    else if constexpr (PH == 18) { float* xo = p.out; asm volatile("" : "+s"(xo)); rows_phase<true, false, false>(p, cx, lds, xo, xo, 3, 0, 0, 1); }
}

__device__ __forceinline__ Ctx make_ctx() {
    Ctx cx;
    cx.G = gridDim.x; cx.tid = threadIdx.x; cx.wid = threadIdx.x >> 6; cx.lane = threadIdx.x & 63;
    cx.vbid = (cx.G % 8 == 0) ? (blockIdx.x % 8) * (cx.G / 8) + blockIdx.x / 8 : blockIdx.x;
    return cx;
}

#if MULTI_LAUNCH
template <int PH>
__global__ void __launch_bounds__(NTHR, 2) phase_kernel(Params p) {
    extern __shared__ __attribute__((aligned(16))) char lds[];
    const Ctx cx = make_ctx();
    run_phase<PH>(p, cx, lds);
}
template <int PH>
static void launch_phases(const Params& p, int grid, hipStream_t stream) {
    (void)hipFuncSetAttribute((const void*)phase_kernel<PH>, hipFuncAttributeMaxDynamicSharedMemorySize, LDS_BYTES);
    hipLaunchKernelGGL(phase_kernel<PH>, dim3(grid), dim3(NTHR), LDS_BYTES, stream, p);
    if constexpr (PH + 1 < NPHASE) launch_phases<PH + 1>(p, grid, stream);
}
#else
template <int PH>
__device__ __forceinline__ void run_from(const Params& p, const Ctx& cx, char* lds, cg::grid_group& grid, const XcdBarrier& xb) {
    {
        int t_ = threadIdx.x, b_ = blockIdx.x;
        asm volatile("" : "+v"(t_), "+s"(b_));
        Ctx c2;
        c2.G = gridDim.x; c2.tid = t_; c2.wid = t_ >> 6; c2.lane = t_ & 63;
        c2.vbid = (c2.G % 8 == 0) ? (b_ % 8) * (c2.G / 8) + b_ / 8 : b_;
        run_phase<PH>(p, c2, lds);
#ifdef PROBE_MASK
        if constexpr ((PROBE_MASK >> PH) & 1) { xcd_barrier(xb); run_phase<PH>(p, c2, lds); }
#endif
    }
    if constexpr (PH + 1 < NPHASE) {
        if constexpr (PH == 0) grid.sync();
        else xcd_barrier(xb);
        run_from<PH + 1>(p, cx, lds, grid, xb);
    }
}
__global__ void __launch_bounds__(NTHR, 2) mega_kernel(Params p) {
    extern __shared__ __attribute__((aligned(16))) char lds[];
    cg::grid_group grid = cg::this_grid();
    const Ctx cx = make_ctx();
    volatile unsigned* st = (volatile unsigned*)(lds + LDS_BYTES - 16);
    if (threadIdx.x == 0) { st[0] = 0u; st[1] = 0u; }
    __syncthreads();
    const XcdBarrier xb = xcd_barrier_post((unsigned*)(p.ws + OFF_BAR), st);
    run_from<0>(p, cx, lds, grid, xb);
}
#endif

extern "C" void kernel_launch(void* const* d_in, const int* in_sizes, int n_in, void* d_out, int out_size, void* d_ws, size_t ws_size,
                              hipStream_t stream) {
    static int grid = 0;
    if (!grid) {
        int dev = 0, cus = 0, per_cu = 0;
        (void)hipGetDevice(&dev);
        (void)hipDeviceGetAttribute(&cus, hipDeviceAttributeMultiprocessorCount, dev);
#if MULTI_LAUNCH
        per_cu = 1;
#else
        (void)hipFuncSetAttribute((const void*)mega_kernel, hipFuncAttributeMaxDynamicSharedMemorySize, LDS_BYTES);
        (void)hipOccupancyMaxActiveBlocksPerMultiprocessor(&per_cu, mega_kernel, NTHR, LDS_BYTES);
        if (per_cu > 1) per_cu = 1;
        if (per_cu < 1) { fprintf(stderr, "kernel_launch: occupancy query says 0 blocks per CU (LDS %d B)\n", LDS_BYTES); per_cu = 1; }
#endif
        if (cus <= 0) cus = 256;
        grid = cus * per_cu;
        if (ws_size < WS_NEED) fprintf(stderr, "kernel_launch: workspace too small: %zu < %zu\n", ws_size, (size_t)WS_NEED);
    }
    Params p{};
    p.x = (const float*)d_in[0]; p.c = (const float*)d_in[1]; p.ada_w = (const float*)d_in[2]; p.ada_b = (const float*)d_in[3];
    p.norm_g = (const float*)d_in[4]; p.rel_bias = (const float*)d_in[5]; p.nsa_w_in = (const float*)d_in[6]; p.nsa_q_gain = (const float*)d_in[7];
    p.nsa_k_gain = (const float*)d_in[8]; p.nsa_cmp_pe = (const float*)d_in[9]; p.nsa_cmp_w1 = (const float*)d_in[10]; p.nsa_cmp_w2 = (const float*)d_in[11];
    p.nsa_w_out = (const float*)d_in[12]; p.hgrn_w_in = (const float*)d_in[13]; p.hgrn_lb = (const float*)d_in[14]; p.hgrn_out_gain = (const float*)d_in[15];
    p.hgrn_w_out = (const float*)d_in[16]; p.moe_rg = (const float*)d_in[17]; p.moe_re = (const float*)d_in[18]; p.moe_w1 = (const float*)d_in[19];
    p.moe_w3 = (const float*)d_in[20]; p.moe_w2 = (const float*)d_in[21];
    p.out = (float*)d_out; p.ws = (char*)d_ws;
#if MULTI_LAUNCH
    launch_phases<0>(p, grid, stream);
#else
    p.p_begin = 0; p.p_end = NPHASE;
    (void)hipMemsetAsync((char*)d_ws + OFF_BAR, 0, XCD_BAR_WORDS * 4, stream);
    void* args[] = {&p};
    hipError_t e = hipLaunchCooperativeKernel((void*)mega_kernel, dim3(grid), dim3(NTHR), args, LDS_BYTES, stream);
    if (e != hipSuccess) fprintf(stderr, "cooperative launch failed: %s (grid %d)\n", hipGetErrorString(e), grid);
#endif
}
```

```cpp
#include <hip/hip_runtime.h>
#include <hip/hip_cooperative_groups.h>
#include <cstdio>
#include <cstdint>
namespace cg = cooperative_groups;

#ifndef MULTI_LAUNCH
#define MULTI_LAUNCH 0
#endif

typedef unsigned short bf16_t;
typedef short bf16x8 __attribute__((ext_vector_type(8)));
typedef float f32x4 __attribute__((ext_vector_type(4)));
typedef float f32x16 __attribute__((ext_vector_type(16)));

constexpr int NTOK = 32768, DM = 1024, SEQ = 2048, NBATCH = 16;
constexpr int NSA_IN = 2608, NSA_IN_PAD = 2816;
constexpr float EPS = 1e-6f;
constexpr size_t MiB = 1ull << 20;

constexpr size_t OFF_CNT = 0;
constexpr size_t OFF_MOD = 4096;
constexpr size_t OFF_LB = OFF_MOD + 786432;
constexpr size_t OFF_PEB = OFF_LB + 4096;
constexpr size_t OFF_BAR = 921600;
constexpr size_t OFF_W_NSA_IN = 1 * MiB;
constexpr size_t OFF_W_NSA_OUT = OFF_W_NSA_IN + 2816ull * 1024 * 2;
constexpr size_t OFF_W_HG_IN = OFF_W_NSA_OUT + 1024ull * 1024 * 2;
constexpr size_t OFF_W_HG_OUT = OFF_W_HG_IN + 4096ull * 1024 * 2;
constexpr size_t OFF_W_CMP1 = OFF_W_HG_OUT + 1024ull * 1024 * 2;
constexpr size_t OFF_W_UP = OFF_W_CMP1 + 2ull * 128 * 2048 * 2;
constexpr size_t OFF_W_DN = OFF_W_UP + 32ull * 1024 * 1024 * 2;
constexpr size_t OFF_W_END = OFF_W_DN + 32ull * 1024 * 512 * 2;
constexpr size_t OFF_HA = 116 * MiB;
static_assert(OFF_W_END <= OFF_HA, "weights overflow");
constexpr size_t OFF_SCR = 180 * MiB;
constexpr size_t OFF_Q = OFF_SCR;
constexpr size_t OFF_KCRAW = OFF_Q + 64 * MiB;
constexpr size_t OFF_VCRAW = OFF_KCRAW + 17 * MiB;
constexpr size_t OFF_KS = OFF_VCRAW + 17 * MiB;
constexpr size_t OFF_VS = OFF_KS + 16 * MiB;
constexpr size_t OFF_KW = OFF_VS + 16 * MiB;
constexpr size_t OFF_VW = OFF_KW + 16 * MiB;
constexpr size_t OFF_GATES = OFF_VW + 16 * MiB;
constexpr size_t OFF_T1 = OFF_GATES + 6 * MiB;
constexpr size_t OFF_KC = OFF_T1 + 4 * MiB;
constexpr size_t OFF_VC = OFF_KC + 1 * MiB;
constexpr size_t OFF_H1 = OFF_SCR;
constexpr size_t OFF_Y = OFF_H1 + 64 * MiB;
constexpr size_t OFF_LTOK = OFF_Y + 128 * MiB;
constexpr size_t OFF_LW = OFF_LTOK + 2 * MiB;
constexpr size_t OFF_TSLOT = OFF_LW + 2 * MiB;
constexpr size_t OFF_QH = OFF_SCR;
constexpr size_t OFF_LF = OFF_QH + 64 * MiB;
constexpr size_t OFF_V = OFF_LF + 64 * MiB;
constexpr size_t OFF_G = OFF_V + 64 * MiB;
constexpr size_t OFF_XB = OFF_G + 64 * MiB;
constexpr size_t WS_NEED = OFF_XB + 64 * MiB;
static_assert(WS_NEED <= 512 * MiB, "ws overflow");

constexpr int NTHR = 512, NWAVE = 8;
constexpr int GEMM_STAGE = 49152, GEMM_NSTAGE = 3;
constexpr int LDS_TAB_OFF = GEMM_STAGE * GEMM_NSTAGE;
constexpr int LDS_BYTES = LDS_TAB_OFF + 256 + 16;
constexpr int NPHASE = 19;

struct Params {
    const float *x, *c, *ada_w, *ada_b, *norm_g, *rel_bias, *nsa_w_in, *nsa_q_gain, *nsa_k_gain, *nsa_cmp_pe, *nsa_cmp_w1,
        *nsa_cmp_w2, *nsa_w_out, *hgrn_w_in, *hgrn_lb, *hgrn_out_gain, *hgrn_w_out, *moe_rg, *moe_re, *moe_w1, *moe_w3, *moe_w2;
    float* out;
    char* ws;
    int p_begin, p_end;
};

__device__ __forceinline__ float bf2f(unsigned short h) { return __uint_as_float((unsigned)h << 16); }
__device__ __forceinline__ unsigned short f2bf(float f) {
    unsigned u = __float_as_uint(f);
    u += 0x7fffu + ((u >> 16) & 1u);
    return (unsigned short)(u >> 16);
}
typedef __bf16 bf2_t __attribute__((ext_vector_type(2)));
typedef float f2_t __attribute__((ext_vector_type(2)));
__device__ __forceinline__ unsigned pack2(float a, float b) {
    f2_t v = {a, b};
    return __builtin_bit_cast(unsigned, __builtin_convertvector(v, bf2_t));
}
typedef _Float16 h2_t __attribute__((ext_vector_type(2)));
__device__ __forceinline__ unsigned packh2(float a, float b) { f2_t v = {a, b}; return __builtin_bit_cast(unsigned, __builtin_convertvector(v, h2_t)); }
__device__ __forceinline__ f2_t unpackh2(unsigned u) { return __builtin_convertvector(__builtin_bit_cast(h2_t, u), f2_t); }
template <int CTRL> __device__ __forceinline__ float dpp_mov(float v) { return __builtin_bit_cast(float, __builtin_amdgcn_update_dpp(0, __builtin_bit_cast(int, v), CTRL, 0xf, 0xf, true)); }
__device__ __forceinline__ float wave_sum(float v) {
    v += dpp_mov<0xB1>(v);
    v += dpp_mov<0x4E>(v);
    v += dpp_mov<0x141>(v);
    v += dpp_mov<0x140>(v);
    const int iv = __builtin_bit_cast(int, v);
    const float s0 = __builtin_bit_cast(float, __builtin_amdgcn_readlane(iv, 0)), s1 = __builtin_bit_cast(float, __builtin_amdgcn_readlane(iv, 16));
    const float s2 = __builtin_bit_cast(float, __builtin_amdgcn_readlane(iv, 32)), s3 = __builtin_bit_cast(float, __builtin_amdgcn_readlane(iv, 48));
    return (s0 + s1) + (s2 + s3);
}
__device__ __forceinline__ float wave_max(float v) {
#pragma unroll
    for (int o = 32; o; o >>= 1) v = fmaxf(v, __shfl_xor(v, o));
    return v;
}
__device__ __forceinline__ float silu_f(float x) { return x * __builtin_amdgcn_rcpf(1.f + __builtin_amdgcn_exp2f(-1.4426950408889634f * x)); }
__device__ __forceinline__ float sigmoid_f(float x) { return __builtin_amdgcn_rcpf(1.f + __builtin_amdgcn_exp2f(-1.4426950408889634f * x)); }
__device__ __forceinline__ void glds16(const void* g, void* l) {
    __builtin_amdgcn_global_load_lds((const unsigned*)g, (unsigned*)l, 16, 0, 0);
}
__device__ __forceinline__ int t5_bucket(int n) {
    if (n < 16) return n;
    int b = 16;
    b += (n >= 21); b += (n >= 27); b += (n >= 35); b += (n >= 46); b += (n >= 59); b += (n >= 77); b += (n >= 99); b += (n >= 128);
    b += (n >= 166); b += (n >= 216); b += (n >= 280); b += (n >= 363); b += (n >= 470); b += (n >= 609); b += (n >= 790);
    return b;
}

struct Ctx {
    int G, vbid, tid, wid, lane;
};

constexpr int P0_MOD_ITEMS = 192;
constexpr int TS0 = 88 * 16, TS1 = 32 * 16, TS2 = 128 * 16, TS3 = 32 * 16, TS4 = 2 * 4 * 32, TS5 = 32 * 32 * 16, TS6 = 32 * 32 * 8;
constexpr int TC0 = 0, TC1 = TC0 + TS0, TC2 = TC1 + TS1, TC3 = TC2 + TS2, TC4 = TC3 + TS3, TC5 = TC4 + TS4, TC6 = TC5 + TS5, TC_END = TC6 + TS6;

struct TrJob { const float* src; int ld, c0, ncols_valid, k0; bf16_t* dst; int dstld; int perm; };
__device__ __forceinline__ int pcol(int n, int fq) { return (n >> 1) * 32 + fq * 8 + (n & 1) * 4; }
__device__ __forceinline__ void tr_load(const TrJob& j, float* tl, int htid) {
    const int k = htid >> 2, cc = (htid & 3) * 8;
    const float* s = j.src + (size_t)(j.k0 + k) * j.ld + j.c0 + cc;
    f32x4 a = {0.f, 0.f, 0.f, 0.f}, c = a;
    if (j.c0 + 32 <= j.ncols_valid) { a = *(const f32x4*)s; c = *(const f32x4*)(s + 4); }
    else {
#pragma unroll
        for (int i = 0; i < 4; ++i) { if (j.c0 + cc + i < j.ncols_valid) a[i] = s[i]; if (j.c0 + cc + 4 + i < j.ncols_valid) c[i] = s[4 + i]; }
    }
#pragma unroll
    for (int i = 0; i < 4; ++i) { tl[k * 33 + cc + i] = a[i]; tl[k * 33 + cc + 4 + i] = c[i]; }
}
__device__ __forceinline__ void tr_store(const TrJob& j, const float* tl, int htid) {
    const int nsrc = htid >> 3, kc = (htid & 7) * 8;
    const int n = nsrc;
    const int nd = j.perm ? (((nsrc >> 2) & 1) * 16 + (nsrc >> 3) * 4 + (nsrc & 3)) : nsrc;
    uint4 o;
    o.x = pack2(tl[(kc + 0) * 33 + n], tl[(kc + 1) * 33 + n]); o.y = pack2(tl[(kc + 2) * 33 + n], tl[(kc + 3) * 33 + n]);
    o.z = pack2(tl[(kc + 4) * 33 + n], tl[(kc + 5) * 33 + n]); o.w = pack2(tl[(kc + 6) * 33 + n], tl[(kc + 7) * 33 + n]);
    *(uint4*)(j.dst + (size_t)nd * j.dstld + kc) = o;
}
__device__ __forceinline__ TrJob tr_job(const Params& p, int tt) {
    TrJob j;
    if (tt < TC1) {
        const int nt = tt / 16, kt = tt % 16;
        j = {p.nsa_w_in, NSA_IN, nt * 32, NSA_IN, kt * 64, (bf16_t*)(p.ws + OFF_W_NSA_IN) + (size_t)nt * 32 * 1024 + kt * 64, 1024, 1};
    } else if (tt < TC2) {
        const int u = tt - TC1, nt = u / 16, kt = u % 16;
        j = {p.nsa_w_out, 1024, nt * 32, 1024, kt * 64, (bf16_t*)(p.ws + OFF_W_NSA_OUT) + (size_t)nt * 32 * 1024 + kt * 64, 1024, 1};
    } else if (tt < TC3) {
        const int u = tt - TC2, nt = u / 16, kt = u % 16;
        j = {p.hgrn_w_in, 4096, nt * 32, 4096, kt * 64, (bf16_t*)(p.ws + OFF_W_HG_IN) + (size_t)nt * 32 * 1024 + kt * 64, 1024, 1};
    } else if (tt < TC4) {
        const int u = tt - TC3, nt = u / 16, kt = u % 16;
        j = {p.hgrn_w_out, 1024, nt * 32, 1024, kt * 64, (bf16_t*)(p.ws + OFF_W_HG_OUT) + (size_t)nt * 32 * 1024 + kt * 64, 1024, 1};
    } else if (tt < TC5) {
        const int u = tt - TC4, kv = u / 128, r = u % 128, nt = r / 32, kt = r % 32;
        j = {p.nsa_cmp_w1 + (size_t)kv * 2048 * 64, 64, nt * 32, 64, kt * 64, (bf16_t*)(p.ws + OFF_W_CMP1) + ((size_t)kv * 128 + nt * 32) * 2048 + kt * 64, 2048, 0};
    } else if (tt < TC6) {
        const int u = tt - TC5, le = u / 512, r = u % 512, gr = r / 16, kt = r % 16;
        const int ct = gr >> 3, which = (gr >> 2) & 1, sub = gr & 3;
        const float* src = (which ? p.moe_w3 : p.moe_w1) + (size_t)le * 1024 * 512;
        j = {src, 512, (ct * 4 + sub) * 32, 512, kt * 64, (bf16_t*)(p.ws + OFF_W_UP) + ((size_t)le * 1024 + gr * 32) * 1024 + kt * 64, 1024, 1};
    } else {
        const int u = tt - TC6, le = u / 256, r = u % 256, nt = r / 8, kt = r % 8;
        j = {p.moe_w2 + (size_t)le * 512 * 1024, 1024, nt * 32, 1024, kt * 64, (bf16_t*)(p.ws + OFF_W_DN) + ((size_t)le * 1024 + nt * 32) * 512 + kt * 64, 512, 1};
    }
    return j;
}

__device__ __forceinline__ void transpose_range(const Params& p, char* lds, int tid, int worker, int nworkers, int lo, int hi) {
    if (worker < 0) return;
    constexpr int TPH = 4;
    const int half = tid >> 8, htid = tid & 255;
    float* tl = (float*)lds + half * (TPH * 64 * 33);
    for (int base = lo + worker * 2 * TPH; base < hi; base += nworkers * 2 * TPH) {
#pragma unroll
        for (int q = 0; q < TPH; ++q) {
            const int tt = base + half * TPH + q;
            if (tt < hi) { const TrJob j = tr_job(p, tt); tr_load(j, tl + q * (64 * 33), htid); }
        }
        __syncthreads();
#pragma unroll
        for (int q = 0; q < TPH; ++q) {
            const int tt = base + half * TPH + q;
            if (tt < hi) { const TrJob j = tr_job(p, tt); tr_store(j, tl + q * (64 * 33), htid); }
        }
        __syncthreads();
    }
}
constexpr int TC_UP1 = TC5 + 16 * 512, TC_DN1 = TC6 + 16 * 256;

__device__ __forceinline__ void phase0(const Params& p, const Ctx& cx, char* lds) {
    const int tid = cx.tid, wid = cx.wid, lane = cx.lane;
    for (int it = cx.vbid; it < P0_MOD_ITEMS; it += cx.G) {
        const int colbase = it * 64, ls = colbase / 3072, e0 = colbase % 3072;
        const float* W = p.ada_w + (size_t)ls * 1024 * 3072 + e0 + lane;
        float* cs = (float*)lds + wid * 1024;
        float* red = (float*)lds + 8192;
        float acc[16];
#pragma unroll
        for (int b = 0; b < 16; ++b) acc[b] = 0.f;
        for (int sub = 0; sub < 2; ++sub) {
            const int kb = wid * 128 + sub * 64;
#pragma unroll
            for (int b = 0; b < 16; ++b) cs[lane * 16 + b] = silu_f(p.c[b * 1024 + kb + lane]);
            __builtin_amdgcn_wave_barrier();
#pragma unroll 1
            for (int k16 = 0; k16 < 64; k16 += 16) {
                float wv[16];
#pragma unroll
                for (int u = 0; u < 16; ++u) wv[u] = W[(size_t)(kb + k16 + u) * 3072];
#pragma unroll
                for (int u = 0; u < 16; ++u) {
                    const float w = wv[u];
                    const f32x4* cv = (const f32x4*)(cs + (k16 + u) * 16);
#pragma unroll
                    for (int q = 0; q < 4; ++q) {
                        f32x4 c4 = cv[q];
                        acc[q * 4 + 0] += c4[0] * w; acc[q * 4 + 1] += c4[1] * w; acc[q * 4 + 2] += c4[2] * w; acc[q * 4 + 3] += c4[3] * w;
                    }
                }
            }
            __builtin_amdgcn_wave_barrier();
        }
#pragma unroll
        for (int b = 0; b < 16; ++b) red[(wid * 16 + b) * 64 + lane] = acc[b];
        __syncthreads();
        float* mod = (float*)(p.ws + OFF_MOD);
#pragma unroll
        for (int i = 0; i < 2; ++i) {
            const int o = tid + i * NTHR, b = o >> 6, e = o & 63;
            float sm = 0.f;
#pragma unroll
            for (int w = 0; w < 8; ++w) sm += red[(w * 16 + b) * 64 + e];
            mod[((size_t)ls * 16 + b) * 3072 + e0 + e] = sm + p.ada_b[ls * 3072 + e0 + e];
        }
        __syncthreads();
    }
    transpose_range(p, lds, tid, cx.vbid, cx.G, TC0, TC2);
    transpose_range(p, lds, tid, cx.vbid, cx.G, TC4, TC5);
    if (cx.vbid == cx.G - 1) {
        float* lb = (float*)(p.ws + OFF_LB);
        for (int i = tid; i < 1024; i += NTHR) lb[i] = sigmoid_f(p.hgrn_lb[1024 + i] - p.hgrn_lb[i]);
        if (tid < 128) {
            const int kv = tid >> 6, d = tid & 63;
            const float* pe = p.nsa_cmp_pe + kv * 2048;
            const float* w1 = p.nsa_cmp_w1 + (size_t)kv * 2048 * 64 + d;
            float sm = 0.f;
            for (int k = 0; k < 2048; ++k) sm += pe[k] * w1[(size_t)k * 64];
            ((float*)(p.ws + OFF_PEB))[tid] = sm;
        }
        if (tid < 32) ((int*)(p.ws + OFF_CNT))[tid] = 0;
    }
}

__device__ __forceinline__ void bf8_to_f32(const uint4 u, f32x4& lo, f32x4& hi) {
    lo[0] = __uint_as_float(u.x << 16); lo[1] = __uint_as_float(u.x & 0xffff0000u); lo[2] = __uint_as_float(u.y << 16); lo[3] = __uint_as_float(u.y & 0xffff0000u);
    hi[0] = __uint_as_float(u.z << 16); hi[1] = __uint_as_float(u.z & 0xffff0000u); hi[2] = __uint_as_float(u.w << 16); hi[3] = __uint_as_float(u.w & 0xffff0000u);
}
template <bool COMBINE, bool NORM, bool ROUTER, bool SRCB = false, bool DSTB = false>
__device__ __forceinline__ void rows_phase(const Params& p, const Ctx& cx, char* lds, const void* __restrict__ src_, void* __restrict__ xdst_,
                           int ls_comb, int ls_norm, int layer_router, int layer_comb) {
    static_assert(!ROUTER, "router rows use rows_router_phase");
    const int lane = cx.lane;
    const float* mod = (const float*)(p.ws + OFF_MOD);
    int my_off = 0;
    if (COMBINE) {
        const int* cnt = (const int*)(p.ws + OFF_CNT) + layer_comb * 16;
        int cv[15];
#pragma unroll
        for (int e = 0; e < 15; ++e) cv[e] = cnt[e];
#pragma unroll
        for (int e = 0; e < 15; ++e) my_off += (e < lane) ? cv[e] : 0;
    }
    const int rpw = (NTOK + cx.G * NWAVE - 1) / (cx.G * NWAVE);
    const int row_begin = (cx.vbid * NWAVE + cx.wid) * rpw, row_end = min(NTOK, row_begin + rpw);
    if (row_begin >= row_end) return;
    const bf16_t* Y = (const bf16_t*)(p.ws + OFF_Y);
    const int* tsl = (const int*)(p.ws + OFF_TSLOT);
    bf16_t* hA = (bf16_t*)(p.ws + OFF_HA);
    const float* gain = p.norm_g + ls_norm * 1024;
    const float* srcf = (const float*)src_; const bf16_t* srcb = (const bf16_t*)src_;
    float* dstf = (float*)xdst_; bf16_t* dstb = (bf16_t*)xdst_;
    int tw = 0;
    if (COMBINE) tw = (lane < 2 * (row_end - row_begin)) ? tsl[row_begin * 2 + lane] : 0;
    f32x4 vr[2][4];
    uint4 xr[2][2];
    uint4 yar[2][2], ycr[2][2];
    auto fill = [&](int k, int row) {
        if (SRCB) {
#pragma unroll
            for (int h = 0; h < 2; ++h) xr[k][h] = *(const uint4*)(srcb + (size_t)row * 1024 + (h * 64 + lane) * 8);
        } else {
#pragma unroll
            for (int i = 0; i < 4; ++i) vr[k][i] = *(const f32x4*)(srcf + (size_t)row * 1024 + ((i >> 1) * 64 + lane) * 8 + (i & 1) * 4);
        }
        if (COMBINE) {
            const int li = __builtin_amdgcn_readfirstlane((row - row_begin) * 2);
            const int sa = __builtin_amdgcn_readlane(tw, li), sb = __builtin_amdgcn_readlane(tw, li + 1);
            const size_t ra = (size_t)(__builtin_amdgcn_readlane(my_off, sa >> 16) + (sa & 0xffff)) * 1024;
            const size_t rc = (size_t)(__builtin_amdgcn_readlane(my_off, sb >> 16) + (sb & 0xffff)) * 1024;
#pragma unroll
            for (int h = 0; h < 2; ++h) { yar[k][h] = *(const uint4*)(Y + ra + (h * 64 + lane) * 8); ycr[k][h] = *(const uint4*)(Y + rc + (h * 64 + lane) * 8); }
        }
    };
    f32x4 gt[4], ca[4], cb[4];
    auto load_vectors = [&](int b) {
#pragma unroll
        for (int i = 0; i < 4; ++i) {
            const int col = ((i >> 1) * 64 + lane) * 8 + (i & 1) * 4;
            if (COMBINE) gt[i] = *(const f32x4*)(mod + ((size_t)ls_comb * 16 + b) * 3072 + 2048 + col);
            if (NORM) {
                const float* shift = mod + ((size_t)ls_norm * 16 + b) * 3072;
                const f32x4 g = *(const f32x4*)(gain + col), sc = *(const f32x4*)(shift + 1024 + col);
                ca[i] = g * (sc + 1.f);
                cb[i] = *(const f32x4*)(shift + col);
            }
        }
    };
    auto do_row = [&](int row) {
        f32x4 v[4];
        if (SRCB) { bf8_to_f32(xr[0][0], v[0], v[1]); bf8_to_f32(xr[0][1], v[2], v[3]); }
        else {
#pragma unroll
            for (int i = 0; i < 4; ++i) v[i] = vr[0][i];
        }
        if (COMBINE) {
#pragma unroll
            for (int h = 0; h < 2; ++h) {
                f32x4 a0, a1, c0, c1;
                bf8_to_f32(yar[0][h], a0, a1); bf8_to_f32(ycr[0][h], c0, c1);
#pragma unroll
                for (int j = 0; j < 4; ++j) { v[h * 2][j] += gt[h * 2][j] * (a0[j] + c0[j]); v[h * 2 + 1][j] += gt[h * 2 + 1][j] * (a1[j] + c1[j]); }
                if (DSTB) {
                    uint4 o; o.x = pack2(v[h * 2][0], v[h * 2][1]); o.y = pack2(v[h * 2][2], v[h * 2][3]); o.z = pack2(v[h * 2 + 1][0], v[h * 2 + 1][1]); o.w = pack2(v[h * 2 + 1][2], v[h * 2 + 1][3]);
                    *(uint4*)(dstb + (size_t)row * 1024 + (h * 64 + lane) * 8) = o;
                } else {
                    *(f32x4*)(dstf + (size_t)row * 1024 + (h * 64 + lane) * 8) = v[h * 2];
                    *(f32x4*)(dstf + (size_t)row * 1024 + (h * 64 + lane) * 8 + 4) = v[h * 2 + 1];
                }
            }
        }
        if (NORM) {
            float ss = 0.f;
#pragma unroll
            for (int i = 0; i < 4; ++i) ss += v[i][0] * v[i][0] + v[i][1] * v[i][1] + v[i][2] * v[i][2] + v[i][3] * v[i][3];
            ss = wave_sum(ss);
            const float r = rsqrtf(ss * (1.f / 1024.f) + EPS);
#pragma unroll
            for (int h = 0; h < 2; ++h) {
                float hh[8];
#pragma unroll
                for (int q = 0; q < 2; ++q)
#pragma unroll
                    for (int j = 0; j < 4; ++j) hh[q * 4 + j] = v[h * 2 + q][j] * r * ca[h * 2 + q][j] + cb[h * 2 + q][j];
                uint4 o; o.x = pack2(hh[0], hh[1]); o.y = pack2(hh[2], hh[3]); o.z = pack2(hh[4], hh[5]); o.w = pack2(hh[6], hh[7]);
                *(uint4*)(hA + (size_t)row * 1024 + (h * 64 + lane) * 8) = o;
            }
        }
    };
    int bcur = -1;
    fill(0, row_begin);
    for (int row = row_begin; row < row_end; ++row) {
        const int b = row >> 11;
        if (b != bcur) { bcur = b; load_vectors(b); }
        if (row + 1 < row_end) {
            fill(1, row + 1); do_row(row);
#pragma unroll
            for (int i = 0; i < 4; ++i) vr[0][i] = vr[1][i];
#pragma unroll
            for (int h = 0; h < 2; ++h) { xr[0][h] = xr[1][h]; if (COMBINE) { yar[0][h] = yar[1][h]; ycr[0][h] = ycr[1][h]; } }
        } else do_row(row);
    }
}

__device__ __forceinline__ f32x4 ld_bf4(const bf16_t* q) { const uint2 u = *(const uint2*)q; f32x4 r; r[0] = __uint_as_float(u.x << 16); r[1] = __uint_as_float(u.x & 0xffff0000u); r[2] = __uint_as_float(u.y << 16); r[3] = __uint_as_float(u.y & 0xffff0000u); return r; }
__device__ __forceinline__ void rows_router_phase(const Params& p, const Ctx& cx, char* lds, const bf16_t* __restrict__ src, int ls_norm, int layer) {
    const int lane = cx.lane, tid = cx.tid;
    const int widu = __builtin_amdgcn_readfirstlane(cx.wid);
    const int wq = widu & 3, grp4 = widu >> 2;
    const float* mod = (const float*)(p.ws + OFF_MOD);
    const float* rg = p.moe_rg + (size_t)layer * 1024 * 4;
    const float* re = p.moe_re + (size_t)layer * 1024 * 16;
    float* logit_s = (float*)lds;
    float wr[16][5];
#pragma unroll
    for (int i = 0; i < 4; ++i)
#pragma unroll
        for (int j = 0; j < 4; ++j) {
            const int k = (i * 64 + lane) * 4 + j;
#pragma unroll
            for (int q = 0; q < 5; ++q) {
                const int o = 5 * wq + q;
                wr[i * 4 + j][q] = (o < 4) ? rg[k * 4 + o] : re[k * 16 + o - 4];
            }
            __builtin_amdgcn_sched_barrier(0);
        }
    const float* gain = p.norm_g + ls_norm * 1024;
    bf16_t* hA = (bf16_t*)(p.ws + OFF_HA);
    int* lcnt = (int*)(lds + 16384);
    if (tid < 32) lcnt[tid] = 0;
    int nstep = 0;
    for (int blk = cx.vbid; blk < NTOK / 32; blk += cx.G, ++nstep) {
        const int R0 = blk * 32, b = R0 >> 11;
        const float* shift = mod + ((size_t)ls_norm * 16 + b) * 3072;
        const float* scale = shift + 1024;
        f32x4 ca[4], cb[4];
#pragma unroll
        for (int i = 0; i < 4; ++i) {
            const int col = (i * 64 + lane) * 4;
            const f32x4 g = *(const f32x4*)(gain + col), sc = *(const f32x4*)(scale + col);
            ca[i] = g * (sc + 1.f);
            cb[i] = *(const f32x4*)(shift + col);
        }
        const bf16_t* srow = src + (size_t)(R0 + grp4 * 16) * 1024 + lane * 4;
        f32x4 vnA[4], vnB[4];
#pragma unroll
        for (int i = 0; i < 4; ++i) { vnA[i] = ld_bf4(srow + i * 256); vnB[i] = ld_bf4(srow + 1024 + i * 256); }
#pragma unroll 1
        for (int r = 0; r < 16; r += 2) {
            const int rlA = grp4 * 16 + r;
            f32x4 vA[4], vB[4];
#pragma unroll
            for (int i = 0; i < 4; ++i) { vA[i] = vnA[i]; vB[i] = vnB[i]; }
            if (r < 14) {
#pragma unroll
                for (int i = 0; i < 4; ++i) { vnA[i] = ld_bf4(srow + (size_t)(r + 2) * 1024 + i * 256); vnB[i] = ld_bf4(srow + (size_t)(r + 3) * 1024 + i * 256); }
            }
            float ssA = 0.f, ssB = 0.f;
#pragma unroll
            for (int i = 0; i < 4; ++i) {
                ssA += vA[i][0] * vA[i][0] + vA[i][1] * vA[i][1] + vA[i][2] * vA[i][2] + vA[i][3] * vA[i][3];
                ssB += vB[i][0] * vB[i][0] + vB[i][1] * vB[i][1] + vB[i][2] * vB[i][2] + vB[i][3] * vB[i][3];
            }
#pragma unroll
            for (int o = 32; o; o >>= 1) { ssA += __shfl_xor(ssA, o); ssB += __shfl_xor(ssB, o); }
            const float rrA = rsqrtf(ssA * (1.f / 1024.f) + EPS), rrB = rsqrtf(ssB * (1.f / 1024.f) + EPS);
            float accA[5] = {0.f, 0.f, 0.f, 0.f, 0.f}, accB[5] = {0.f, 0.f, 0.f, 0.f, 0.f};
#pragma unroll
            for (int i = 0; i < 4; ++i) {
                const int col = (i * 64 + lane) * 4;
                f32x4 hA_, hB_;
#pragma unroll
                for (int j = 0; j < 4; ++j) {
                    hA_[j] = vA[i][j] * rrA * ca[i][j] + cb[i][j];
                    hB_[j] = vB[i][j] * rrB * ca[i][j] + cb[i][j];
#pragma unroll
                    for (int q = 0; q < 5; ++q) { accA[q] += hA_[j] * wr[i * 4 + j][q]; accB[q] += hB_[j] * wr[i * 4 + j][q]; }
                }
                if ((r & 3) == wq) { uint2 o; o.x = pack2(hA_[0], hA_[1]); o.y = pack2(hA_[2], hA_[3]); *(uint2*)(hA + (size_t)(R0 + rlA) * 1024 + col) = o; }
                if (((r + 1) & 3) == wq) { uint2 o; o.x = pack2(hB_[0], hB_[1]); o.y = pack2(hB_[2], hB_[3]); *(uint2*)(hA + (size_t)(R0 + rlA + 1) * 1024 + col) = o; }
            }
            {
                float v[16];
#pragma unroll
                for (int q = 0; q < 5; ++q) { v[q] = accA[q]; v[5 + q] = accB[q]; }
#pragma unroll
                for (int q = 10; q < 16; ++q) v[q] = 0.f;
#pragma unroll
                for (int t = 0; t < 8; ++t) { const bool up = lane & 32; const float send = up ? v[t] : v[t + 8], keep = up ? v[t + 8] : v[t]; v[t] = keep + __shfl_xor(send, 32); }
#pragma unroll
                for (int t = 0; t < 4; ++t) { const bool up = lane & 16; const float send = up ? v[t] : v[t + 4], keep = up ? v[t + 4] : v[t]; v[t] = keep + __shfl_xor(send, 16); }
#pragma unroll
                for (int t = 0; t < 2; ++t) { const bool up = lane & 8; const float send = up ? v[t] : v[t + 2], keep = up ? v[t + 2] : v[t]; v[t] = keep + __shfl_xor(send, 8); }
                { const bool up = lane & 4; const float send = up ? v[0] : v[1], keep = up ? v[1] : v[0]; v[0] = keep + __shfl_xor(send, 4); }
                v[0] += __shfl_xor(v[0], 2);
                v[0] += __shfl_xor(v[0], 1);
                const int idx = ((lane >> 5) & 1) * 8 + ((lane >> 4) & 1) * 4 + ((lane >> 3) & 1) * 2 + ((lane >> 2) & 1);
                if ((lane & 3) == 0 && idx < 10) {
                    const int rsel = idx >= 5, q = idx - 5 * rsel;
                    logit_s[(nstep * 32 + rlA + rsel) * 20 + 5 * wq + q] = v[0];
                }
            }
        }
    }
    __syncthreads();
    const int nrows = nstep * 32;
    int ea = 0, eb = 0, la = 0, lb_ = 0, row = 0; float wa = 0.f, wb = 0.f;
    if (tid < nrows) {
        row = (cx.vbid + (tid >> 5) * cx.G) * 32 + (tid & 31);
        const float* rl = logit_s + tid * 20;
        const float gm = fmaxf(fmaxf(rl[0], rl[1]), fmaxf(rl[2], rl[3]));
        const float gs = __expf(rl[0] - gm) + __expf(rl[1] - gm) + __expf(rl[2] - gm) + __expf(rl[3] - gm);
        int grp = 0; float best = rl[0];
        if (rl[1] > best) { best = rl[1]; grp = 1; }
        if (rl[2] > best) { best = rl[2]; grp = 2; }
        if (rl[3] > best) { best = rl[3]; grp = 3; }
        const float pg = __expf(best - gm) / gs;
        const f32x4 lsel = *(const f32x4*)(rl + 4 + 4 * grp);
        const float l0 = lsel[0], l1 = lsel[1], l2 = lsel[2], l3 = lsel[3];
        const float em = fmaxf(fmaxf(l0, l1), fmaxf(l2, l3));
        const float q0 = __expf(l0 - em), q1 = __expf(l1 - em), q2 = __expf(l2 - em), q3 = __expf(l3 - em);
        int i1 = 0; float b1 = q0;
        if (q1 > b1) { b1 = q1; i1 = 1; }
        if (q2 > b1) { b1 = q2; i1 = 2; }
        if (q3 > b1) { b1 = q3; i1 = 3; }
        int i2 = -1; float b2 = -1.f;
        if (i1 != 0 && q0 > b2) { b2 = q0; i2 = 0; }
        if (i1 != 1 && q1 > b2) { b2 = q1; i2 = 1; }
        if (i1 != 2 && q2 > b2) { b2 = q2; i2 = 2; }
        if (i1 != 3 && q3 > b2) { b2 = q3; i2 = 3; }
        const float inv = pg / (b1 + b2);
        ea = grp * 4 + i1; eb = grp * 4 + i2; wa = b1 * inv; wb = b2 * inv;
        la = atomicAdd(lcnt + ea, 1);
        lb_ = atomicAdd(lcnt + eb, 1);
    }
    __syncthreads();
    if (tid < 16) lcnt[16 + tid] = atomicAdd((int*)(p.ws + OFF_CNT) + layer * 16 + tid, lcnt[tid]);
    __syncthreads();
    if (tid < nrows) {
        int* ltok = (int*)(p.ws + OFF_LTOK);
        float* lw = (float*)(p.ws + OFF_LW);
        int* ts = (int*)(p.ws + OFF_TSLOT) + row * 2;
        const int pa = lcnt[16 + ea] + la, pb = lcnt[16 + eb] + lb_;
        ltok[(size_t)ea * NTOK + pa] = row; lw[(size_t)ea * NTOK + pa] = wa;
        ltok[(size_t)eb * NTOK + pb] = row; lw[(size_t)eb * NTOK + pb] = wb;
        ts[0] = (ea << 16) | pa; ts[1] = (eb << 16) | pb;
    }
    __syncthreads();
}

__device__ __forceinline__ int stage_col(int tid) { return ((tid & 7) ^ ((tid >> 3) & 7)) * 8; }

template <class Epi>
__device__ __forceinline__ void gemm_tile(const bf16_t* const (&ap)[4], const bf16_t* const (&bp)[2], int K, char* lds, const Ctx& cx, Epi&& epi) {
    const int tid = cx.tid, lane = cx.lane, wr = cx.wid >> 1, wc = cx.wid & 1, fr = lane & 15, fq = lane >> 4;
    f32x4 acc[4][4];
#pragma unroll
    for (int m = 0; m < 4; ++m)
#pragma unroll
        for (int n = 0; n < 4; ++n) acc[m][n] = (f32x4){0.f, 0.f, 0.f, 0.f};
    const int nt = K / 64;
    auto stage = [&](int t, int slot) {
        char* SA = lds + slot * GEMM_STAGE + tid * 16; char* SB = SA + 32768;
        const int ko = t * 64;
#pragma unroll
        for (int i = 0; i < 4; ++i) glds16(ap[i] + ko, SA + i * 8192);
#pragma unroll
        for (int i = 0; i < 2; ++i) glds16(bp[i] + ko, SB + i * 8192);
    };
    __syncthreads();
    stage(0, 0);
    if (nt > 1) stage(1, 1);
    const int x7 = fr & 7;
    const int aoff = (wr * 64 + fr) * 128, boff = 32768 + (wc * 64 + fr) * 128;
    int slot = 0;
    for (int kt = 0; kt < nt; ++kt) {
        if (kt + 1 < nt) asm volatile("s_waitcnt vmcnt(6)" ::: "memory");
        else asm volatile("s_waitcnt vmcnt(0)" ::: "memory");
        __builtin_amdgcn_s_barrier();
        if (kt + 2 < nt) stage(kt + 2, slot >= 1 ? slot - 1 : 2);
        const char* S = lds + slot * GEMM_STAGE;
#pragma unroll
        for (int ks = 0; ks < 2; ++ks) {
            const int pc = ((ks * 4 + fq) ^ x7) * 16;
            bf16x8 Af[4], Bf[4];
#pragma unroll
            for (int m = 0; m < 4; ++m) Af[m] = *(const bf16x8*)(S + aoff + m * 2048 + pc);
#pragma unroll
            for (int n = 0; n < 4; ++n) Bf[n] = *(const bf16x8*)(S + boff + n * 2048 + pc);
#pragma unroll
            for (int m = 0; m < 4; ++m)
#pragma unroll
                for (int n = 0; n < 4; ++n) acc[m][n] = __builtin_amdgcn_mfma_f32_16x16x32_bf16(Bf[n], Af[m], acc[m][n], 0, 0, 0);
        }
        slot = slot == 2 ? 0 : slot + 1;
    }
    epi(acc, wr, wc, fr, fq);
}

__device__ __forceinline__ int swz_g(int q) { return (0x1320 >> (4 * q)) & 3; }
__device__ __forceinline__ int stage_col2(int tid) { return ((tid & 3) ^ swz_g((tid >> 4) & 3)) * 8; }

template <int MODE = 0, class Epi>
__device__ __forceinline__ void gemm_tile2(const bf16_t* const (&ap)[2], const bf16_t* const (&bp)[2], int K, char* lds, const Ctx& cx, Epi&& epi) {
    const int tid = cx.tid, lane = cx.lane, wc = cx.wid & 3, fr = lane & 15, fq = lane >> 4;
    const int wr = __builtin_amdgcn_readfirstlane(cx.wid >> 2);
    f32x4 acc[8][4];
#pragma unroll
    for (int m = 0; m < 8; ++m)
#pragma unroll
        for (int n = 0; n < 4; ++n) acc[m][n] = (f32x4){0.f, 0.f, 0.f, 0.f};
    const int nt = K / 32;
    auto stage = [&](int t) {
        char* SA = lds + (t & 3) * 32768 + tid * 16; char* SB = SA + 16384;
        const int ko = t * 32;
        glds16(ap[0] + ko, SA); glds16(ap[1] + ko, SA + 8192);
        glds16(bp[0] + ko, SB); glds16(bp[1] + ko, SB + 8192);
    };
    __syncthreads();
    stage(0);
    if (nt > 1) stage(1);
    if (nt > 2) stage(2);
    const int pc = (fq ^ swz_g((fr >> 2) & 3)) * 16;
    const int aoff = (wr * 128 + fr) * 64 + pc, boff = 16384 + (wc * 64 + fr) * 64 + pc;
    bf16x8 Af[8], Bf[4];
    auto load_frags = [&](int kt) {
        const char* S = lds + (kt & 3) * 32768;
#pragma unroll
        for (int n = 0; n < 4; ++n) Bf[n] = *(const bf16x8*)(S + boff + n * 1024);
#pragma unroll
        for (int m = 0; m < 8; ++m) Af[m] = *(const bf16x8*)(S + aoff + m * 1024);
        asm volatile("s_waitcnt lgkmcnt(0)" ::: "memory");
    };
    auto mma = [&]() {
        __builtin_amdgcn_s_setprio(1);
#pragma unroll
        for (int m = 0; m < 8; ++m)
#pragma unroll
            for (int n = 0; n < 4; ++n) acc[m][n] = __builtin_amdgcn_mfma_f32_16x16x32_bf16(Bf[n], Af[m], acc[m][n], 0, 0, 0);
        __builtin_amdgcn_s_setprio(0);
    };
    if (nt > 2) asm volatile("s_waitcnt vmcnt(8)" ::: "memory");
    else if (nt == 2) asm volatile("s_waitcnt vmcnt(4)" ::: "memory");
    else asm volatile("s_waitcnt vmcnt(0)" ::: "memory");
    if (wr == 1) __builtin_amdgcn_s_barrier();
    for (int kt = 0; kt < nt; ++kt) {
        const int rem = nt - 1 - kt;
        if (rem >= 2) asm volatile("s_waitcnt vmcnt(8)" ::: "memory");
        else if (rem == 1) asm volatile("s_waitcnt vmcnt(4)" ::: "memory");
        else asm volatile("s_waitcnt vmcnt(0)" ::: "memory");
        __builtin_amdgcn_s_barrier();
        if (kt + 3 < nt) stage(kt + 3);
        load_frags(kt);
        if (rem >= 3) asm volatile("s_waitcnt vmcnt(8)" ::: "memory");
        else if (rem == 2) asm volatile("s_waitcnt vmcnt(4)" ::: "memory");
        else asm volatile("s_waitcnt vmcnt(0)" ::: "memory");
        __builtin_amdgcn_s_barrier();
        mma();
    }
    if (wr == 0) __builtin_amdgcn_s_barrier();
    if (MODE == 0) epi(acc, wr, wc, fr, fq);
    else {
#pragma unroll
        for (int m = 0; m < 8; ++m)
#pragma unroll
            for (int n = 0; n < 4; ++n) asm volatile("" :: "v"(acc[m][n]));
    }
}

template <class GetFn, class EpiFn>
__device__ __forceinline__ void gemm_stream2(int my_tiles, int K, char* lds, const Ctx& cx, GetFn&& get, EpiFn&& epi) {
    if (my_tiles <= 0) return;
    const int tid = cx.tid, lane = cx.lane, wc = cx.wid & 3, fr = lane & 15, fq = lane >> 4;
    const int wr = __builtin_amdgcn_readfirstlane(cx.wid >> 2);
    f32x4 acc[8][4];
#pragma unroll
    for (int m = 0; m < 8; ++m)
#pragma unroll
        for (int n = 0; n < 4; ++n) acc[m][n] = (f32x4){0.f, 0.f, 0.f, 0.f};
    const int nt = K / 32, S = my_tiles * nt;
    const bf16_t* sap[2]; const bf16_t* sbp[2];
    int sj = 0, skt = 0, sg = 0;
    get(0, sap, sbp);
    auto stage_next = [&]() {
        char* SA = lds + (sg & 3) * 32768 + tid * 16; char* SB = SA + 16384;
        const int ko = skt * 32;
        glds16(sap[0] + ko, SA); glds16(sap[1] + ko, SA + 8192);
        glds16(sbp[0] + ko, SB); glds16(sbp[1] + ko, SB + 8192);
        ++sg; ++skt;
        if (skt == nt) { skt = 0; ++sj; if (sj < my_tiles) get(sj, sap, sbp); }
    };
    __syncthreads();
    stage_next();
    if (S > 1) stage_next();
    if (S > 2) stage_next();
    const int pc = (fq ^ swz_g((fr >> 2) & 3)) * 16;
    const int aoff = (wr * 128 + fr) * 64 + pc, boff = 16384 + (wc * 64 + fr) * 64 + pc;
    bf16x8 Af[8], Bf[4];
    int g = 0;
    for (int cj = 0; cj < my_tiles; ++cj) {
        {
            const int rem0 = S - 1 - g;
            if (rem0 >= 2) asm volatile("s_waitcnt vmcnt(8)" ::: "memory");
            else if (rem0 == 1) asm volatile("s_waitcnt vmcnt(4)" ::: "memory");
            else asm volatile("s_waitcnt vmcnt(0)" ::: "memory");
        }
        if (wr == 1) __builtin_amdgcn_s_barrier();
        for (int kt = 0; kt < nt; ++kt, ++g) {
            const int rem = S - 1 - g;
            if (rem >= 2) asm volatile("s_waitcnt vmcnt(8)" ::: "memory");
            else if (rem == 1) asm volatile("s_waitcnt vmcnt(4)" ::: "memory");
            else asm volatile("s_waitcnt vmcnt(0)" ::: "memory");
            __builtin_amdgcn_s_barrier();
            if (g + 3 < S) stage_next();
            {
                const char* Sx = lds + (g & 3) * 32768;
#pragma unroll
                for (int n = 0; n < 4; ++n) Bf[n] = *(const bf16x8*)(Sx + boff + n * 1024);
#pragma unroll
                for (int m = 0; m < 8; ++m) Af[m] = *(const bf16x8*)(Sx + aoff + m * 1024);
                asm volatile("s_waitcnt lgkmcnt(0)" ::: "memory");
            }
            if (rem >= 3) asm volatile("s_waitcnt vmcnt(8)" ::: "memory");
            else if (rem == 2) asm volatile("s_waitcnt vmcnt(4)" ::: "memory");
            else asm volatile("s_waitcnt vmcnt(0)" ::: "memory");
            __builtin_amdgcn_s_barrier();
            __builtin_amdgcn_s_setprio(1);
#pragma unroll
            for (int m = 0; m < 8; ++m)
#pragma unroll
                for (int n = 0; n < 4; ++n) acc[m][n] = __builtin_amdgcn_mfma_f32_16x16x32_bf16(Bf[n], Af[m], acc[m][n], 0, 0, 0);
            __builtin_amdgcn_s_setprio(0);
        }
        if (wr == 0) __builtin_amdgcn_s_barrier();
        epi(cj, acc, wr, wc, fr, fq);
#pragma unroll
        for (int m = 0; m < 8; ++m)
#pragma unroll
            for (int n = 0; n < 4; ++n) acc[m][n] = (f32x4){0.f, 0.f, 0.f, 0.f};
    }
}

template <int MODE = 0, class EpiFactory>
__device__ __forceinline__ void gemm_phase_dense2(const bf16_t* A, int lda, const bf16_t* Bt, int K, int nrt, int nct, char* lds, const Ctx& cx, EpiFactory&& mk) {
    const int tid = cx.tid;
    const int ntiles = nrt * nct;
    const int sc = stage_col2(tid), sr = tid >> 2;
    const int my_tiles = cx.vbid < ntiles ? (ntiles - cx.vbid + cx.G - 1) / cx.G : 0;
    const int vb = cx.vbid, G = cx.G;
    gemm_stream2(my_tiles, K, lds, cx,
        [=](int j, const bf16_t* (&ap)[2], const bf16_t* (&bp)[2]) {
            const int tile = vb + j * G, rt = tile / nct, ct = tile % nct;
            ap[0] = A + (size_t)(rt * 256 + sr) * lda + sc; ap[1] = ap[0] + (size_t)128 * lda;
            bp[0] = Bt + (size_t)(ct * 256 + sr) * K + sc; bp[1] = bp[0] + (size_t)128 * K;
        },
        [=](int j, f32x4 (&acc)[8][4], int wr, int wc, int fr, int fq) {
            const int tile = vb + j * G, rt = tile / nct, ct = tile % nct;
            mk(rt * 256, ct * 256)(acc, wr, wc, fr, fq);
        });
}

__device__ __forceinline__ void phase_nsa_inproj(const Params& p, const Ctx& cx, char* lds) {
    const bf16_t* A = (const bf16_t*)(p.ws + OFF_HA);
    const bf16_t* Bt = (const bf16_t*)(p.ws + OFF_W_NSA_IN);
    char* ws = p.ws;
    const float* qg = p.nsa_q_gain;
    const float* kg = p.nsa_k_gain;
    gemm_phase_dense2(A, 1024, Bt, 1024, NTOK / 256, NSA_IN_PAD / 256, lds, cx, [=](int row0, int col0) {
        return [=](f32x4 (&acc)[8][4], int wr, int wc, int fr, int fq) {
            const int gc0 = col0 + wc * 64;
            if (gc0 >= NSA_IN) return;
            if (gc0 < 1024 || (gc0 >= 1536 && gc0 < 1792) || (gc0 >= 2048 && gc0 < 2304)) {
                const float* gain; float post; bf16_t* dstb; size_t rstride; size_t coff; bool tokmajor;
                if (gc0 < 1024) { gain = qg; post = 0.125f * 1.4426950408889634f; }
                else if (gc0 < 1792) { gain = kg + 64; post = 1.f; }
                else { gain = kg + 128; post = 1.f; }
#pragma unroll
                for (int m = 0; m < 8; ++m) {
                    __builtin_amdgcn_sched_barrier(0);
                    float ss = 0.f;
#pragma unroll
                    for (int n = 0; n < 4; ++n) ss += acc[m][n][0] * acc[m][n][0] + acc[m][n][1] * acc[m][n][1] + acc[m][n][2] * acc[m][n][2] + acc[m][n][3] * acc[m][n][3];
                    ss += __shfl_xor(ss, 16); ss += __shfl_xor(ss, 32);
                    const float r = rsqrtf(ss * (1.f / 64.f) + EPS) * post;
                    const int row = row0 + wr * 128 + m * 16 + fr;
                    bf16_t* dst;
                    if (gc0 < 1024) dst = (bf16_t*)(ws + OFF_Q) + (size_t)row * 1024 + gc0;
                    else {
                        const int g = ((gc0 - 1024) & 255) >> 6, b = row >> 11, t = row & 2047;
                        dst = (bf16_t*)(ws + (gc0 < 1792 ? OFF_KS : OFF_KW)) + ((size_t)(b * 4 + g) * 2048 + t) * 64;
                    }
#pragma unroll
                    for (int pp = 0; pp < 2; ++pp) {
                        const int c = pp * 32 + fq * 8;
                        const f32x4 ga = *(const f32x4*)(gain + c), gb = *(const f32x4*)(gain + c + 4);
                        const f32x4 a = acc[m][2 * pp], bb = acc[m][2 * pp + 1];
                        uint4 o; o.x = pack2(a[0] * r * ga[0], a[1] * r * ga[1]); o.y = pack2(a[2] * r * ga[2], a[3] * r * ga[3]);
                        o.z = pack2(bb[0] * r * gb[0], bb[1] * r * gb[1]); o.w = pack2(bb[2] * r * gb[2], bb[3] * r * gb[3]);
                        *(uint4*)(dst + c) = o;
                    }
                }
            } else if (gc0 < 2560) {
                const int seg = (gc0 - 1024) >> 8;
                const int g = ((gc0 - 1024) & 255) >> 6;
                if (seg < 2) {
                    const size_t off = seg == 0 ? OFF_KCRAW : OFF_VCRAW;
#pragma unroll
                    for (int m = 0; m < 8; ++m) {
                        __builtin_amdgcn_sched_barrier(0);
                    __builtin_amdgcn_sched_barrier(0);
                        const int row = row0 + wr * 128 + m * 16 + fr, b = row >> 11, t = row & 2047;
                        bf16_t* dst = (bf16_t*)(ws + off) + ((size_t)(b * 4 + g) * 2048 + t) * 64;
#pragma unroll
                        for (int pp = 0; pp < 2; ++pp) {
                            const f32x4 a = acc[m][2 * pp], bb = acc[m][2 * pp + 1];
                            uint4 o; o.x = pack2(a[0], a[1]); o.y = pack2(a[2], a[3]); o.z = pack2(bb[0], bb[1]); o.w = pack2(bb[2], bb[3]);
                            *(uint4*)(dst + pp * 32 + fq * 8) = o;
                        }
                    }
                } else {
                    const size_t off = seg == 3 ? OFF_VS : OFF_VW;
#pragma unroll
                    for (int m = 0; m < 8; ++m) {
                        __builtin_amdgcn_sched_barrier(0);
                    __builtin_amdgcn_sched_barrier(0);
                        const int row = row0 + wr * 128 + m * 16 + fr, b = row >> 11, t = row & 2047;
                        bf16_t* dst = (bf16_t*)(ws + off) + (size_t)(b * 4 + g) * 64 * 2048 + t;
#pragma unroll
                        for (int n = 0; n < 4; ++n)
#pragma unroll
                            for (int j = 0; j < 4; ++j) dst[(size_t)(pcol(n, fq) + j) * 2048] = f2bf(acc[m][n][j]);
                    }
                }
            } else {
#pragma unroll
                for (int m = 0; m < 8; ++m) {
                    __builtin_amdgcn_sched_barrier(0);
                    const int row = row0 + wr * 128 + m * 16 + fr;
                    float* dst = (float*)(ws + OFF_GATES) + (size_t)row * 48;
#pragma unroll
                    for (int n = 0; n < 4; ++n) {
                        const int c = pcol(n, fq);
                        f32x4 o;
#pragma unroll
                        for (int j = 0; j < 4; ++j) o[j] = sigmoid_f(acc[m][n][j]);
                        if (c < 48) *(f32x4*)(dst + c) = o;
                    }
                }
            }
        };
    });
}

__device__ __forceinline__ void phase_cmp1(const Params& p, const Ctx& cx, char* lds) {
    const int tid = cx.tid;
    const float* peb = (const float*)(p.ws + OFF_PEB);
    float* T1 = (float*)(p.ws + OFF_T1);
    const int sc = stage_col(tid), sr = tid >> 3;
    for (int tile = cx.vbid; tile < 64; tile += cx.G) {
        const int kv = tile >> 5, bg2 = tile & 31;
        const bf16_t* raw = (const bf16_t*)(p.ws + (kv ? OFF_VCRAW : OFF_KCRAW)) + (size_t)bg2 * 2 * 2048 * 64;
        const bf16_t* a0 = raw + (size_t)sr * 1024 + sc;
        const bf16_t* a2 = raw + (size_t)2048 * 64 + (size_t)sr * 1024 + sc;
        const bf16_t* b0 = (const bf16_t*)(p.ws + OFF_W_CMP1) + ((size_t)kv * 128 + sr) * 2048 + sc;
        const bf16_t* const ap[4] = {a0, a0 + (size_t)64 * 1024, a2, a2 + (size_t)64 * 1024};
        const bf16_t* const bp[2] = {b0, b0 + (size_t)64 * 2048};
        gemm_tile(ap, bp, 2048, lds, cx, [=](f32x4 (&acc)[4][4], int wr, int wc, int fr, int fq) {
            if (wc != 0) return;
#pragma unroll
            for (int m = 0; m < 4; ++m) {
                const int r = wr * 64 + m * 16 + fr;
                float* dst = T1 + ((size_t)kv * 8192 + (bg2 * 2 + (r >> 7)) * 128 + (r & 127)) * 64;
#pragma unroll
                for (int n = 0; n < 4; ++n) {
                    const int c = n * 16 + fq * 4;
                    f32x4 pb = *(const f32x4*)(peb + kv * 64 + c);
                    *(f32x4*)(dst + c) = acc[m][n] + pb;
                }
            }
        });
    }
}

__device__ __forceinline__ void phase_cmp2(const Params& p, const Ctx& cx) {
    const int lane = cx.lane;
    const float* T1 = (const float*)(p.ws + OFF_T1);
    for (int r = cx.vbid * NWAVE + cx.wid; r < 2 * 8192; r += cx.G * NWAVE) {
        const int kv = r >> 13, rr = r & 8191, n_ = rr & 127;
        const float s = silu_f(T1[(size_t)r * 64 + lane]);
        const float* w2 = p.nsa_cmp_w2 + kv * 4096 + lane;
        float o = 0.f;
#pragma unroll 8
        for (int j = 0; j < 64; ++j) o += __shfl(s, j) * w2[j * 64];
        if (kv == 0) {
            const float ss = wave_sum(o * o);
            o = o * rsqrtf(ss * (1.f / 64.f) + EPS) * p.nsa_k_gain[lane];
        }
        if (n_ == 127) o = 0.f;
        if (kv == 0) ((bf16_t*)(p.ws + OFF_KC))[(size_t)rr * 64 + lane] = f2bf(o);
        else ((bf16_t*)(p.ws + OFF_VC))[((size_t)(rr >> 7) * 64 + lane) * 128 + n_] = f2bf(o);
    }
}

constexpr int ATT_BUF = 17920, ATT_K_STRIDE = 144, ATT_V_OFF = 9216, ATT_V_STRIDE = 136, ATT_LUT_OFF = 2 * ATT_BUF, LUT_N = 2136, LUT_PAD = 80;
constexpr int ATT_SC_OFF = ATT_LUT_OFF + 4 * LUT_N * 4;
static_assert(ATT_SC_OFF + NWAVE * 8192 <= LDS_TAB_OFF, "attention LDS");
#define MFMA32(a, b, c) __builtin_amdgcn_mfma_f32_32x32x16_bf16((a), (b), (c), 0, 0, 0)
template <int V> struct IC { static constexpr int value = V; };

__device__ __forceinline__ void phase_attn(const Params& p, const Ctx& cx, char* lds) {
    const int tid = cx.tid, lane = cx.lane, wid = cx.wid;
    const int g = cx.vbid & 3;
    const int ql = lane & 7, head = (lane & 31) >> 3, h2 = lane >> 5, l31 = lane & 31;
    float* lut = (float*)(lds + ATT_LUT_OFF);
    for (int i = tid; i < 4 * LUT_N; i += NTHR) {
        const int h = i / LUT_N, dist = i % LUT_N - LUT_PAD;
        lut[i] = dist >= 0 ? p.rel_bias[t5_bucket(dist) * 16 + g * 4 + h] * 1.4426950408889634f : 0.f;
    }
    __syncthreads();
    const float* lutp = lut + head * LUT_N + LUT_PAD;
    const float b31 = lutp[2047];
    const bf16_t* Qb = (const bf16_t*)(p.ws + OFF_Q);
    const bf16_t* KC = (const bf16_t*)(p.ws + OFF_KC);
    const bf16_t* VCT = (const bf16_t*)(p.ws + OFF_VC);
    const bf16_t* KS = (const bf16_t*)(p.ws + OFF_KS);
    const bf16_t* VST = (const bf16_t*)(p.ws + OFF_VS);
    const bf16_t* KW = (const bf16_t*)(p.ws + OFF_KW);
    const bf16_t* VWT = (const bf16_t*)(p.ws + OFF_VW);
    const float* GT = (const float*)(p.ws + OFF_GATES);
    bf16_t* Og = (bf16_t*)(p.ws + OFF_HA);
    float* scw = (float*)(lds + ATT_SC_OFF) + wid * 2048;
    f32x4* outw = (f32x4*)(lds + ATT_SC_OFF + wid * 8192) + lane;
    const bool flip_ok = (cx.G % 128) == 0;
    const int widu = __builtin_amdgcn_readfirstlane(wid);

    for (int it = 0;; ++it) {
        const int u = cx.vbid + it * cx.G;
        if (u >= 2048) break;
        const int rest = u >> 2, b = rest >> 5, qtb = rest & 31;
        const int qt = (flip_ok && (it & 1)) ? 31 - qtb : qtb;
        const int t0 = qt * 64, cur = qt, bg = b * 4 + g;
        const int tq = t0 + wid * 8 + ql;
        const size_t rowtok = (size_t)b * SEQ + tq;
        bf16x8 Qf[4];
        {
            const bf16_t* qp = Qb + rowtok * 1024 + (g * 4 + head) * 64 + 8 * h2;
#pragma unroll
            for (int ks = 0; ks < 4; ++ks) Qf[ks] = *(const bf16x8*)(qp + 16 * ks);
        }
        const float* gt = GT + rowtok * 48 + (g * 4 + head) * 3;
        const float gate_c = gt[0], gate_s = gt[1], gate_w = gt[2];
        const int wlo = max(0, qt - 8);
        const int nW = cur - wlo + 1;
        const int ncp = (t0 + 63 >= 31 + 16 * 64) ? 2 : 1;
        const int NC = ncp;
        const int NT = NC + nW + cur + 1;

        uint4 kr0, vr0;
        auto issue_load = [&](int i) {
            const bf16_t* ksrc; const bf16_t* vsrc; int vstride;
            if (i < NC) { const int ci = i; ksrc = KC + ((size_t)bg * 128 + ci * 64) * 64; vsrc = VCT + (size_t)bg * 64 * 128 + ci * 64; vstride = 128; }
            else if (i < NC + nW) { const int kb = wlo + i - NC; ksrc = KW + ((size_t)bg * 2048 + kb * 64) * 64; vsrc = VWT + (size_t)bg * 64 * 2048 + kb * 64; vstride = 2048; }
            else { const int kb = i - NC - nW; ksrc = KS + ((size_t)bg * 2048 + kb * 64) * 64; vsrc = VST + (size_t)bg * 64 * 2048 + kb * 64; vstride = 2048; }
            kr0 = *(const uint4*)(ksrc + tid * 8);
            vr0 = *(const uint4*)(vsrc + (size_t)(tid >> 3) * vstride + (tid & 7) * 8);
        };
        auto write_lds = [&](int i) {
            char* bufp = lds + (i & 1) * ATT_BUF;
            *(uint4*)(bufp + (tid >> 3) * ATT_K_STRIDE + (tid & 7) * 16) = kr0;
            char* va = bufp + ATT_V_OFF + (tid >> 3) * ATT_V_STRIDE + (tid & 7) * 16;
            uint2 t;
            t.x = vr0.x; t.y = vr0.y; *(uint2*)va = t;
            t.x = vr0.z; t.y = vr0.w; *(uint2*)(va + 8) = t;
        };
        f32x16 O0, O1;
#pragma unroll
        for (int r = 0; r < 16; ++r) { O0[r] = 0.f; O1[r] = 0.f; }
        float lsum = 0.f;

        auto qk = [&](const char* bufp, int kt2, float init) -> f32x16 {
            f32x16 S;
#pragma unroll
            for (int r = 0; r < 16; ++r) S[r] = init;
            const char* kp = bufp + (32 * kt2 + l31) * ATT_K_STRIDE + 16 * h2;
            bf16x8 kf[4];
#pragma unroll
            for (int ks = 0; ks < 4; ++ks) kf[ks] = *(const bf16x8*)(kp + 32 * ks);
            __builtin_amdgcn_sched_barrier(0);
#pragma unroll
            for (int ks = 0; ks < 4; ++ks) S = MFMA32(kf[ks], Qf[ks], S);
            return S;
        };
        auto pv = [&](const char* bufp, int kt2, const f32x16& P) {
            const char* vp = bufp + ATT_V_OFF + l31 * ATT_V_STRIDE + (32 * kt2 + 4 * h2) * 2;
            uint2 va[2][2][2];
#pragma unroll
            for (int s2 = 0; s2 < 2; ++s2)
#pragma unroll
                for (int dt = 0; dt < 2; ++dt) {
                    va[s2][dt][0] = *(const uint2*)(vp + dt * 32 * ATT_V_STRIDE + s2 * 32);
                    va[s2][dt][1] = *(const uint2*)(vp + dt * 32 * ATT_V_STRIDE + s2 * 32 + 16);
                }
            __builtin_amdgcn_sched_barrier(0);
#pragma unroll
            for (int s2 = 0; s2 < 2; ++s2) {
                uint4 pk;
                pk.x = pack2(P[8 * s2 + 0], P[8 * s2 + 1]); pk.y = pack2(P[8 * s2 + 2], P[8 * s2 + 3]);
                pk.z = pack2(P[8 * s2 + 4], P[8 * s2 + 5]); pk.w = pack2(P[8 * s2 + 6], P[8 * s2 + 7]);
                const bf16x8 Pf = __builtin_bit_cast(bf16x8, pk);
                uint4 a0, a1;
                a0.x = va[s2][0][0].x; a0.y = va[s2][0][0].y; a0.z = va[s2][0][1].x; a0.w = va[s2][0][1].y;
                a1.x = va[s2][1][0].x; a1.y = va[s2][1][0].y; a1.z = va[s2][1][1].x; a1.w = va[s2][1][1].y;
                O0 = MFMA32(__builtin_bit_cast(bf16x8, a0), Pf, O0);
                O1 = MFMA32(__builtin_bit_cast(bf16x8, a1), Pf, O1);
            }
        };
        auto finalize = [&](float gate, int mode) {
            const float Z = lsum + __shfl_xor(lsum, 32);
            const float f = Z > 0.f ? gate / Z : 0.f;
#pragma unroll
            for (int v4 = 0; v4 < 4; ++v4) {
                f32x4 a = {f * O0[4 * v4], f * O0[4 * v4 + 1], f * O0[4 * v4 + 2], f * O0[4 * v4 + 3]};
                f32x4 c = {f * O1[4 * v4], f * O1[4 * v4 + 1], f * O1[4 * v4 + 2], f * O1[4 * v4 + 3]};
                if (mode != 0) { a += outw[v4 * 64]; c += outw[(4 + v4) * 64]; }
                if (mode != 2) { outw[v4 * 64] = a; outw[(4 + v4) * 64] = c; }
                else { O0[4 * v4] = a[0]; O0[4 * v4 + 1] = a[1]; O0[4 * v4 + 2] = a[2]; O0[4 * v4 + 3] = a[3];
                       O1[4 * v4] = c[0]; O1[4 * v4 + 1] = c[1]; O1[4 * v4 + 2] = c[2]; O1[4 * v4 + 3] = c[3]; }
            }
            if (mode != 2) {
#pragma unroll
                for (int r = 0; r < 16; ++r) { O0[r] = 0.f; O1[r] = 0.f; }
            }
            lsum = 0.f;
        };
        auto tile_ws = [&](const char* bufp, int kb, float cinit, auto MMc, auto BMc) {
            constexpr int MM = decltype(MMc)::value, BM = decltype(BMc)::value;
#pragma unroll 1
            for (int kt2 = 0; kt2 < 2; ++kt2) {
                const int d0 = tq - (64 * kb + 32 * kt2 + 4 * h2);
                const float* lp = lutp + (d0 - 27);
                float bv[16];
                if (BM == 0) {
#pragma unroll
                    for (int r = 0; r < 16; ++r) bv[r] = lp[27 - ((r & 3) + 8 * (r >> 2))];
                    __builtin_amdgcn_sched_barrier(0);
                }
                f32x16 S = qk(bufp, kt2, cinit);
#pragma unroll
                for (int r = 0; r < 16; ++r) {
                    const int cr = (r & 3) + 8 * (r >> 2);
                    float x = S[r];
                    if (BM == 0) x += bv[r];
                    if (MM == 1) x += (d0 - cr < 512) ? 0.f : -INFINITY;
                    if (MM == 2) x += (d0 - cr >= 0) ? 0.f : -INFINITY;
                    S[r] = __builtin_amdgcn_exp2f(x);
                    lsum += S[r];
                }
                pv(bufp, kt2, S);
            }
        };

        const int nvis = (tq >= 31) ? min((tq - 31) / 16 + 1, 127) : 0;
        unsigned selmask = 0u;
        float* sown = scw + (head * 8 + ql) * 32;
        float* stail = scw + 1024 + (head * 8 + ql) * 32;
        float* ssc = scw + ql * 32;
        issue_load(0);
        __syncthreads();
        write_lds(0);
        issue_load(1);
        for (int i = 0; i < NT; ++i) {
            __syncthreads();
            const char* bufp = lds + (i & 1) * ATT_BUF;
            if (i < NC) {
                const int ci = i;
#pragma unroll 1
                for (int kt2 = 0; kt2 < 2; ++kt2) {
                    const int n0 = 64 * ci + 32 * kt2 + 4 * h2;
                    const int d0 = tq - 31 - 16 * n0;
                    float bv[16];
#pragma unroll
                    for (int r = 0; r < 16; ++r) bv[r] = lutp[max(d0 - 16 * ((r & 3) + 8 * (r >> 2)), -LUT_PAD)];
                    __builtin_amdgcn_sched_barrier(0);
                    f32x16 S = qk(bufp, kt2, 0.f);
#pragma unroll
                    for (int r = 0; r < 16; ++r) {
                        const int cr = (r & 3) + 8 * (r >> 2);
                        S[r] = __builtin_amdgcn_exp2f(S[r] + bv[r] + ((n0 + cr) < nvis ? 0.f : -INFINITY));
                        lsum += S[r];
                    }
                    pv(bufp, kt2, S);
#pragma unroll
                    for (int rq = 0; rq < 4; ++rq) {
                        const int sblk = 8 * (2 * ci + kt2) + 2 * rq + h2;
                        sown[sblk] = S[4 * rq] + S[4 * rq + 1] + S[4 * rq + 2] + 0.5f * S[4 * rq + 3];
                        if (sblk < 31) stail[sblk + 1] = 0.5f * S[4 * rq + 3];
                    }
                }
                if (i == NC - 1) {
                    const float Z = lsum + __shfl_xor(lsum, 32);
                    const float inv_mine = Z > 0.f ? 1.f / Z : 0.f;
                    if (h2 == 0) stail[0] = 0.f;
                    __builtin_amdgcn_wave_barrier();
                    const int j8 = head * 2 + h2;
                    {
                        f32x4 sc = {0.f, 0.f, 0.f, 0.f};
#pragma unroll
                        for (int hh = 0; hh < 4; ++hh) {
                            const float invh = __shfl(inv_mine, hh * 8 + ql);
                            const f32x4 a = *(const f32x4*)(scw + (hh * 8 + ql) * 32 + 4 * j8), t4 = *(const f32x4*)(scw + 1024 + (hh * 8 + ql) * 32 + 4 * j8);
                            sc += (a + t4) * invh;
                        }
#pragma unroll
                        for (int q = 0; q < 4; ++q) {
                            const int sblk = 4 * j8 + q;
                            const bool forced = (sblk == 0) || (sblk == cur) || (sblk == cur - 1);
                            sc[q] = forced ? 1.0e4f : (sblk <= cur ? sc[q] : -1.0f);
                        }
                        __builtin_amdgcn_wave_barrier();
                        *(f32x4*)(ssc + 4 * j8) = sc;
                    }
                    __builtin_amdgcn_wave_barrier();
                    const f32x4 own = *(const f32x4*)(ssc + 4 * j8);
                    int rk0 = 0, rk1 = 0, rk2 = 0, rk3 = 0;
                    const int so0 = 4 * j8;
#pragma unroll
                    for (int m4 = 0; m4 < 8; ++m4) {
                        const f32x4 v = *(const f32x4*)(ssc + 4 * m4);
#pragma unroll
                        for (int q = 0; q < 4; ++q) {
                            const float vm = v[q];
                            rk0 += (vm > own[0]) ? 1 : 0;
                            rk1 += (vm > own[1]) ? 1 : 0;
                            rk2 += (vm > own[2]) ? 1 : 0;
                            rk3 += (vm > own[3]) ? 1 : 0;
                        }
                    }
                    unsigned mk = ((rk0 < 8 ? 1u : 0u) | (rk1 < 8 ? 2u : 0u) | (rk2 < 8 ? 4u : 0u) | (rk3 < 8 ? 8u : 0u)) << so0;
                    mk |= __shfl_xor(mk, 8); mk |= __shfl_xor(mk, 16); mk |= __shfl_xor(mk, 32);
                    selmask = mk;
                    __builtin_amdgcn_wave_barrier();
                    finalize(gate_c, 0);
                }
            } else if (i < NC + nW) {
                const int kb = wlo + i - NC;
                if (kb == cur) tile_ws(bufp, kb, 0.f, IC<2>{}, IC<0>{});
                else if (kb == cur - 8) tile_ws(bufp, kb, 0.f, IC<1>{}, IC<0>{});
                else tile_ws(bufp, kb, 0.f, IC<0>{}, IC<0>{});
                if (i == NC - 1 + nW) finalize(gate_w, 1);
            } else {
                const int kb = i - NC - nW;
                const bool sel = ((selmask >> kb) & 1u) != 0;
                if (__ballot(sel) != 0ull) {
                    const float neg = sel ? 0.f : -INFINITY;
                    if (kb == cur) tile_ws(bufp, kb, neg, IC<2>{}, IC<0>{});
                    else if (t0 + 8 * widu - (64 * kb + 63) >= 790) tile_ws(bufp, kb, neg + b31, IC<0>{}, IC<1>{});
                    else tile_ws(bufp, kb, neg, IC<0>{}, IC<0>{});
                }
            }
            if (i + 1 < NT) {
                write_lds(i + 1);
                if (i + 2 < NT) issue_load(i + 2);
            }
        }
        finalize(gate_s, 2);
        {
            bf16_t* op = Og + rowtok * 1024 + (g * 4 + head) * 64 + 4 * h2;
#pragma unroll
            for (int rq = 0; rq < 4; ++rq) {
                uint2 o0; o0.x = pack2(O0[4 * rq], O0[4 * rq + 1]); o0.y = pack2(O0[4 * rq + 2], O0[4 * rq + 3]);
                uint2 o1; o1.x = pack2(O1[4 * rq], O1[4 * rq + 1]); o1.y = pack2(O1[4 * rq + 2], O1[4 * rq + 3]);
                *(uint2*)(op + 8 * rq) = o0;
                *(uint2*)(op + 32 + 8 * rq) = o1;
            }
        }
    }
}

__device__ __forceinline__ void phase_outproj(const Params& p, const Ctx& cx, char* lds, const bf16_t* A, const bf16_t* Bt, const float* xin, int ls) {
    const float* mod = (const float*)(p.ws + OFF_MOD);
    float* xo = p.out;
    gemm_phase_dense2(A, 1024, Bt, 1024, NTOK / 256, 4, lds, cx, [=](int row0, int col0) {
        return [=](f32x4 (&acc)[8][4], int wr, int wc, int fr, int fq) {
            const int b = row0 >> 11;
            const float* gate = mod + ((size_t)ls * 16 + b) * 3072 + 2048 + col0 + wc * 64;
            f32x4 g[4];
#pragma unroll
            for (int n = 0; n < 4; ++n) g[n] = *(const f32x4*)(gate + pcol(n, fq));
#pragma unroll
            for (int m2 = 0; m2 < 8; m2 += 2) {
                f32x4 xi[2][4];
#pragma unroll
                for (int mm = 0; mm < 2; ++mm)
#pragma unroll
                    for (int n = 0; n < 4; ++n)
                        xi[mm][n] = *(const f32x4*)(xin + (size_t)(row0 + wr * 128 + (m2 + mm) * 16 + fr) * 1024 + col0 + wc * 64 + pcol(n, fq));
                __builtin_amdgcn_sched_barrier(0);
#pragma unroll
                for (int mm = 0; mm < 2; ++mm)
#pragma unroll
                    for (int n = 0; n < 4; ++n) {
                        f32x4 o;
#pragma unroll
                        for (int j = 0; j < 4; ++j) o[j] = xi[mm][n][j] + g[n][j] * acc[m2 + mm][n][j];
                        *(f32x4*)(xo + (size_t)(row0 + wr * 128 + (m2 + mm) * 16 + fr) * 1024 + col0 + wc * 64 + pcol(n, fq)) = o;
                    }
                __builtin_amdgcn_sched_barrier(0);
            }
        };
    });
}

__device__ __forceinline__ void moe_tables(const Params& p, int layer, int tid, int* s_off, int* s_toff, int* s_hoff) {
    __syncthreads();
    if (tid == 0) {
        const int* cnt = (const int*)(p.ws + OFF_CNT) + layer * 16;
        int o = 0, to = 0, ho = 0;
        for (int e = 0; e < 16; ++e) {
            const int c = cnt[e], q = c >> 8, r = c & 255;
            s_off[e] = o; s_toff[e] = to; s_hoff[e] = ho;
            o += c; to += (q + (r > 128 ? 1 : 0)) * 4; ho += (r > 0 && r <= 128) ? 4 : 0;
        }
        s_off[16] = o; s_toff[16] = to; s_hoff[16] = ho;
    }
    __syncthreads();
}

constexpr int LDS_ROWIDX_OFF = 131072, LDS_LW_OFF = 131072 + 8192;
static_assert(LDS_LW_OFF + 8192 <= LDS_TAB_OFF, "moe caches");


namespace pg8 {
#define PG8_LAS __attribute__((address_space(3)))
typedef unsigned short bf16_t;
typedef short bf16x8 __attribute__((ext_vector_type(8)));
typedef float f32x4 __attribute__((ext_vector_type(4)));
typedef unsigned u32x4 __attribute__((ext_vector_type(4)));
constexpr int BM = 256, BK = 64, HALF = 128, HTB = HALF * BK * 2  , STAGE_BYTES = 8 * HTB, NXCD = 8, WGM = 8;

__host__ __device__ __forceinline__ int lds_byte(int r, int c) { const int st = (r >> 4) * 2 + (c >> 5), rr = r & 15, cc = c & 31, ob = rr * 64 + cc * 2; return st * 1024 + (ob ^ (((ob >> 9) & 1) << 5)); }
__host__ __device__ __forceinline__ void stage_rc(int b, int& R, int& C) { const int st = b / 1024, sb = b % 1024, swz = sb ^ (((sb >> 9) & 1) << 5); R = (st >> 1) * 16 + swz / 64; C = (st & 1) * 32 + (swz % 64) / 2; }
__host__ __device__ __forceinline__ int perm32(int rho) { const int n = rho >> 4, i = rho & 15; return 8 * (i >> 2) + 4 * n + (i & 3); }

struct Unit { int pm, pn; };
struct Gemm { const bf16_t* A; const bf16_t* Bt; int M, N, K; };

struct StaticOrder {
    int nM, nN, nwg, G, c;
    __host__ __device__ void init(int M, int N, int G_, int c_) { nM = M / BM; nN = N / BM; nwg = nM * nN; G = G_; c = c_; }
    __host__ __device__ bool next(int i, Unit& u) const {
        const long L = (long)i * G + c; if (L >= nwg) return false;
        int wgid = (int)L; { const int q = nwg / NXCD, r = nwg % NXCD, xcd = wgid % NXCD, off = wgid / NXCD; wgid = (xcd < r ? xcd * (q + 1) : r * (q + 1) + (xcd - r) * q) + off; }
        const int nig = WGM * nN, gid = wgid / nig, fm = gid * WGM, gsz = (nM - fm) < WGM ? (nM - fm) : WGM;
        u.pm = fm + ((wgid % nig) % gsz); u.pn = (wgid % nig) / gsz; return true;
    }
    __device__ __forceinline__ void a_ready(const Unit&) const {}
    __device__ __forceinline__ void done(const Unit&) const {}
};

template <class Epi, class Sched, bool ALIGN_EPI = false, bool SP2 = false>
__device__ __forceinline__ void gemm_phase(PG8_LAS unsigned char* lds, const Gemm g, const Sched& S, const Epi& E) {
    const int tid = threadIdx.x, wid = __builtin_amdgcn_readfirstlane(tid >> 6), lane = tid & 63, wr = wid >> 2, wc = wid & 3, fr = lane & 15, fq = lane >> 4;
    const int K = g.K, nt = K / BK;
    unsigned voffA[2], voffB[2];
#pragma unroll
    for (int i = 0; i < 2; ++i) { int R, C; stage_rc(tid * 16 + i * 8192, R, C); const int Rb = Epi::PERM ? ((R & ~31) + perm32(R & 31)) : R;
        voffA[i] = (unsigned)(R * K + C) * 2u; voffB[i] = (unsigned)(Rb * K + C) * 2u; }
    const size_t kstep = (size_t)(BK * 2);
    const size_t hstep = (size_t)HALF * K * 2;
    const size_t tstep = 2 * hstep;
    const unsigned ldsw = (unsigned)wid * 1024u;
    const int aoff = lds_byte(wr * 64 + fr, fq * 8), boff = lds_byte(wc * 32 + fr, fq * 8);
#define PG8_SA(b, h) (((b) * 2 + (h)) * HTB)
#define PG8_SB(b, h) ((4 + (b) * 2 + (h)) * HTB)
#define PG8_STAGE(bufoff, gbase, voff) do { _Pragma("unroll") for (int _i = 0; _i < 2; ++_i) \
        __builtin_amdgcn_global_load_lds((const unsigned*)((const char*)(gbase) + (voff)[_i]), (PG8_LAS unsigned*)(lds + (bufoff) + ldsw + _i * 8192), 16, 0, 0); } while (0)
#define PG8_LDA(dst, b, h) do { _Pragma("unroll") for (int m = 0; m < 4; ++m) _Pragma("unroll") for (int k = 0; k < 2; ++k) dst[m][k] = *(const PG8_LAS bf16x8*)(lds + PG8_SA(b, h) + aoff + m * 2048 + k * 1024); } while (0)
#define PG8_LDB(dst, b, h) do { _Pragma("unroll") for (int n = 0; n < 2; ++n) _Pragma("unroll") for (int k = 0; k < 2; ++k) dst[n][k] = *(const PG8_LAS bf16x8*)(lds + PG8_SB(b, h) + boff + n * 2048 + k * 1024); } while (0)
#define PG8_MMA(ai, bj, At, Bt) do { __builtin_amdgcn_s_setprio(1); _Pragma("unroll") for (int m = 0; m < 4; ++m) _Pragma("unroll") for (int n = 0; n < 2; ++n) _Pragma("unroll") for (int k = 0; k < 2; ++k) \
        acc[ai][bj][m][n] = __builtin_amdgcn_mfma_f32_16x16x32_bf16(Bt[n][k], At[m][k], acc[ai][bj][m][n], 0, 0, 0); __builtin_amdgcn_s_setprio(0); } while (0)
#define PG8_WAIT_V(n) asm volatile("s_waitcnt vmcnt(" #n ")" ::: "memory")
#define PG8_WAIT_L(n) asm volatile("s_waitcnt lgkmcnt(" #n ")" ::: "memory")
#define PG8_BAR __builtin_amdgcn_s_barrier()
#define PG8_SCHED __builtin_amdgcn_sched_barrier(0)
    Unit cur, nxt; int ui = 0;
    if (!S.next(0, cur)) return;
    f32x4 acc[2][2][4][2];
#pragma unroll
    for (int a = 0; a < 2; ++a)
#pragma unroll
        for (int b = 0; b < 2; ++b)
#pragma unroll
            for (int m = 0; m < 4; ++m)
#pragma unroll
                for (int n = 0; n < 2; ++n) acc[a][b][m][n] = (f32x4){0.f, 0.f, 0.f, 0.f};
    bf16x8 At[4][2], B0[2][2], B1[2][2];
    const char* cA = (const char*)g.A + (size_t)cur.pm * tstep; const char* cB = (const char*)g.Bt + (size_t)cur.pn * tstep;
    S.a_ready(cur);
    if constexpr (SP2) {
        PG8_STAGE(PG8_SB(0, 0), cB, voffB); PG8_STAGE(PG8_SB(0, 1), cB + hstep, voffB); PG8_STAGE(PG8_SA(0, 0), cA, voffA); PG8_STAGE(PG8_SA(0, 1), cA + hstep, voffA);
        if (wr == 1) PG8_BAR;
        PG8_WAIT_V(2); PG8_BAR;
        PG8_STAGE(PG8_SB(1, 0), cB + kstep, voffB); PG8_STAGE(PG8_SA(1, 0), cA + kstep, voffA); PG8_STAGE(PG8_SB(1, 1), cB + hstep + kstep, voffB);
        PG8_WAIT_V(6); PG8_BAR;
    } else {
        PG8_STAGE(PG8_SB(0, 0), cB, voffB); PG8_STAGE(PG8_SA(0, 0), cA, voffA); PG8_STAGE(PG8_SB(0, 1), cB + hstep, voffB); PG8_STAGE(PG8_SA(0, 1), cA + hstep, voffA);
        if (wr == 1) PG8_BAR;
        PG8_WAIT_V(4); PG8_BAR;
        PG8_STAGE(PG8_SB(1, 0), cB + kstep, voffB); PG8_STAGE(PG8_SA(1, 0), cA + kstep, voffA); PG8_STAGE(PG8_SB(1, 1), cB + hstep + kstep, voffB);
        PG8_WAIT_V(6); PG8_BAR;
    }
    for (;;) {
        const bool has_next = S.next(ui + 1, nxt);
        const char* nA = has_next ? (const char*)g.A + (size_t)nxt.pm * tstep : cA; const char* nB = has_next ? (const char*)g.Bt + (size_t)nxt.pn * tstep : cB;
        for (int t = 0; t < nt; t += 2) {
            const bool last = (t == nt - 2);
            const char* a1 = cA + (size_t)(t + 1) * kstep;
            const char* a2 = last ? nA : cA + (size_t)(t + 2) * kstep; const char* b2 = last ? nB : cB + (size_t)(t + 2) * kstep;
            const char* a3 = a2 + kstep; const char* b3 = b2 + kstep;
            if (last && has_next) S.a_ready(nxt);
            if constexpr (SP2) {
            PG8_LDB(B0, 0, 0); PG8_LDB(B1, 0, 1); PG8_SCHED; PG8_LDA(At, 0, 0); PG8_STAGE(PG8_SA(1, 1), a1 + hstep, voffA);
            PG8_WAIT_V(8); PG8_WAIT_L(0); PG8_BAR; PG8_MMA(0, 0, At, B0); PG8_MMA(0, 1, At, B1); PG8_BAR; PG8_SCHED;
            PG8_LDA(At, 0, 1); PG8_STAGE(PG8_SB(0, 0), b2, voffB); PG8_STAGE(PG8_SB(0, 1), b2 + hstep, voffB); PG8_STAGE(PG8_SA(0, 0), a2, voffA);
            PG8_WAIT_V(8); PG8_WAIT_L(0); PG8_BAR; PG8_MMA(1, 0, At, B0); PG8_MMA(1, 1, At, B1); PG8_BAR; PG8_SCHED;
            PG8_LDB(B0, 1, 0); PG8_LDB(B1, 1, 1); PG8_SCHED; PG8_LDA(At, 1, 0); PG8_STAGE(PG8_SA(0, 1), a2 + hstep, voffA);
            PG8_WAIT_V(8); PG8_WAIT_L(0); PG8_BAR; PG8_MMA(0, 0, At, B0); PG8_MMA(0, 1, At, B1); PG8_BAR; PG8_SCHED;
            PG8_LDA(At, 1, 1); PG8_STAGE(PG8_SB(1, 0), b3, voffB); PG8_STAGE(PG8_SB(1, 1), b3 + hstep, voffB); PG8_STAGE(PG8_SA(1, 0), a3, voffA);
            PG8_WAIT_V(8); PG8_WAIT_L(0); PG8_BAR; PG8_MMA(1, 0, At, B0); PG8_MMA(1, 1, At, B1); PG8_BAR; PG8_SCHED;
            } else {
            PG8_LDB(B0, 0, 0); PG8_SCHED; PG8_LDA(At, 0, 0); PG8_STAGE(PG8_SA(1, 1), a1 + hstep, voffA);
            PG8_WAIT_L(8); PG8_BAR; PG8_WAIT_L(0); PG8_MMA(0, 0, At, B0); PG8_BAR; PG8_SCHED;
            PG8_LDB(B1, 0, 1); PG8_STAGE(PG8_SB(0, 0), b2, voffB);
            PG8_BAR; PG8_WAIT_L(0); PG8_MMA(0, 1, At, B1); PG8_BAR;
            PG8_LDA(At, 0, 1); PG8_STAGE(PG8_SA(0, 0), a2, voffA);
            PG8_BAR; PG8_WAIT_L(0); PG8_MMA(1, 0, At, B0); PG8_BAR; PG8_SCHED;
            PG8_STAGE(PG8_SB(0, 1), b2 + hstep, voffB);
            PG8_WAIT_V(6); PG8_BAR; PG8_MMA(1, 1, At, B1); PG8_BAR;
            PG8_LDB(B0, 1, 0); PG8_SCHED; PG8_LDA(At, 1, 0); PG8_STAGE(PG8_SA(0, 1), a2 + hstep, voffA);
            PG8_WAIT_L(8); PG8_BAR; PG8_WAIT_L(0); PG8_MMA(0, 0, At, B0); PG8_BAR; PG8_SCHED;
            PG8_LDB(B1, 1, 1); PG8_STAGE(PG8_SB(1, 0), b3, voffB);
            PG8_BAR; PG8_WAIT_L(0); PG8_MMA(0, 1, At, B1); PG8_BAR;
            PG8_LDA(At, 1, 1); PG8_STAGE(PG8_SA(1, 0), a3, voffA);
            PG8_BAR; PG8_WAIT_L(0); PG8_MMA(1, 0, At, B0); PG8_BAR; PG8_SCHED;
            PG8_STAGE(PG8_SB(1, 1), b3 + hstep, voffB);
            PG8_WAIT_V(6); PG8_BAR; PG8_MMA(1, 1, At, B1); PG8_BAR;
            }
        }
        if constexpr (ALIGN_EPI) { if (wr == 0) PG8_BAR; }
        if constexpr (!Epi::AFTER_DRAIN) { E(acc, cur, wr, wc, fr, fq); S.done(cur); }
        if (!has_next) break;
#pragma unroll
        for (int a = 0; a < 2; ++a)
#pragma unroll
            for (int b = 0; b < 2; ++b)
#pragma unroll
                for (int m = 0; m < 4; ++m)
#pragma unroll
                    for (int n = 0; n < 2; ++n) acc[a][b][m][n] = (f32x4){0.f, 0.f, 0.f, 0.f};
        cur = nxt; cA = nA; cB = nB; ++ui;
        if constexpr (ALIGN_EPI) { if (wr == 1) PG8_BAR; }
    }
    PG8_WAIT_V(0);
    if constexpr (!ALIGN_EPI) { if (wr == 0) PG8_BAR; }
    PG8_BAR;
    if constexpr (Epi::AFTER_DRAIN) { E.fused(acc, cur, wr, wc, fr, fq, lds, wid, lane); S.done(cur); }
#undef PG8_SA
#undef PG8_SB
#undef PG8_STAGE
#undef PG8_LDA
#undef PG8_LDB
#undef PG8_MMA
#undef PG8_WAIT_V
#undef PG8_WAIT_L
#undef PG8_BAR
#undef PG8_SCHED
}

template <class Epi, class Sched>
__device__ __forceinline__ void gemm_phase_rows(PG8_LAS unsigned char* lds, const Gemm g, const Sched& S, const Epi& E, const PG8_LAS int* rows) {
    const int tid = threadIdx.x, wid = __builtin_amdgcn_readfirstlane(tid >> 6), lane = tid & 63, wr = wid >> 2, wc = wid & 3, fr = lane & 15, fq = lane >> 4;
    const int K = g.K, nt = K / BK;
    unsigned voffB[2]; int R0 = 0, C0 = 0;
#pragma unroll
    for (int i = 0; i < 2; ++i) { int R, C; stage_rc(tid * 16 + i * 8192, R, C); voffB[i] = (unsigned)(R * K + C) * 2u; if (i == 0) { R0 = R; C0 = C; } }
    const size_t kstep = (size_t)(BK * 2);
    const size_t hstep = (size_t)HALF * K * 2;
    const size_t tstep = 2 * hstep;
    const unsigned ldsw = (unsigned)wid * 1024u;
    const int aoff = lds_byte(wr * 64 + fr, fq * 8), boff = lds_byte(wc * 32 + fr, fq * 8);
#define PG8_SA(b, h) (((b) * 2 + (h)) * HTB)
#define PG8_SB(b, h) ((4 + (b) * 2 + (h)) * HTB)
#define PG8_STAGE(bufoff, gbase, voff) do { _Pragma("unroll") for (int _i = 0; _i < 2; ++_i) \
        __builtin_amdgcn_global_load_lds((const unsigned*)((const char*)(gbase) + (voff)[_i]), (PG8_LAS unsigned*)(lds + (bufoff) + ldsw + _i * 8192), 16, 0, 0); } while (0)
#define PG8_LDA(dst, b, h) do { _Pragma("unroll") for (int m = 0; m < 4; ++m) _Pragma("unroll") for (int k = 0; k < 2; ++k) dst[m][k] = *(const PG8_LAS bf16x8*)(lds + PG8_SA(b, h) + aoff + m * 2048 + k * 1024); } while (0)
#define PG8_LDB(dst, b, h) do { _Pragma("unroll") for (int n = 0; n < 2; ++n) _Pragma("unroll") for (int k = 0; k < 2; ++k) dst[n][k] = *(const PG8_LAS bf16x8*)(lds + PG8_SB(b, h) + boff + n * 2048 + k * 1024); } while (0)
#define PG8_MMA(ai, bj, At, Bt) do { __builtin_amdgcn_s_setprio(1); _Pragma("unroll") for (int m = 0; m < 4; ++m) _Pragma("unroll") for (int n = 0; n < 2; ++n) _Pragma("unroll") for (int k = 0; k < 2; ++k) \
        acc[ai][bj][m][n] = __builtin_amdgcn_mfma_f32_16x16x32_bf16(Bt[n][k], At[m][k], acc[ai][bj][m][n], 0, 0, 0); __builtin_amdgcn_s_setprio(0); } while (0)
#define PG8_WAIT_V(n) asm volatile("s_waitcnt vmcnt(" #n ")" ::: "memory")
#define PG8_WAIT_L(n) asm volatile("s_waitcnt lgkmcnt(" #n ")" ::: "memory")
#define PG8_BAR __builtin_amdgcn_s_barrier()
#define PG8_SCHED __builtin_amdgcn_sched_barrier(0)
    Unit cur, nxt; int ui = 0;
    if (!S.next(0, cur)) return;
    f32x4 acc[2][2][4][2];
#pragma unroll
    for (int a = 0; a < 2; ++a)
#pragma unroll
        for (int b = 0; b < 2; ++b)
#pragma unroll
            for (int m = 0; m < 4; ++m)
#pragma unroll
                for (int n = 0; n < 2; ++n) acc[a][b][m][n] = (f32x4){0.f, 0.f, 0.f, 0.f};
    bf16x8 At[4][2], B0[2][2], B1[2][2];
    unsigned vc[4], vn[4];
#pragma unroll
    for (int q = 0; q < 4; ++q) vc[q] = ((unsigned)rows[cur.pm * 256 + R0 + 64 * q] * (unsigned)K + (unsigned)C0) * 2u;
    const char* gA = (const char*)g.A; const char* cB = (const char*)g.Bt + (size_t)(cur.pn & 0xffff) * tstep;
    PG8_STAGE(PG8_SB(0, 0), cB, voffB); PG8_STAGE(PG8_SB(0, 1), cB + hstep, voffB); PG8_STAGE(PG8_SA(0, 0), gA, vc); PG8_STAGE(PG8_SA(0, 1), gA, vc + 2);
    if (wr == 1) PG8_BAR;
    PG8_WAIT_V(2); PG8_BAR;
    PG8_STAGE(PG8_SB(1, 0), cB + kstep, voffB); PG8_STAGE(PG8_SA(1, 0), gA + kstep, vc); PG8_STAGE(PG8_SB(1, 1), cB + hstep + kstep, voffB);
    PG8_WAIT_V(6); PG8_BAR;
    for (;;) {
        const bool has_next = S.next(ui + 1, nxt);
        if (has_next) {
#pragma unroll
            for (int q = 0; q < 4; ++q) vn[q] = ((unsigned)rows[nxt.pm * 256 + R0 + 64 * q] * (unsigned)K + (unsigned)C0) * 2u;
        } else {
#pragma unroll
            for (int q = 0; q < 4; ++q) vn[q] = vc[q];
        }
        const char* nB = has_next ? (const char*)g.Bt + (size_t)(nxt.pn & 0xffff) * tstep : cB;
        const bool fullu = (cur.pn >> 16) == 0;
        for (int t = 0; t < nt; t += 2) {
            const bool last = (t == nt - 2);
            const char* a1 = gA + (size_t)(t + 1) * kstep;
            const char* a2 = last ? gA : gA + (size_t)(t + 2) * kstep; const char* b2 = last ? nB : cB + (size_t)(t + 2) * kstep;
            const char* a3 = a2 + kstep; const char* b3 = b2 + kstep;
            unsigned v2[4];
#pragma unroll
            for (int q = 0; q < 4; ++q) v2[q] = last ? vn[q] : vc[q];
            PG8_LDB(B0, 0, 0); PG8_LDB(B1, 0, 1); PG8_SCHED; PG8_LDA(At, 0, 0); PG8_STAGE(PG8_SA(1, 1), a1, vc + 2);
            PG8_WAIT_V(8); PG8_WAIT_L(0); PG8_BAR; PG8_MMA(0, 0, At, B0); PG8_MMA(0, 1, At, B1); PG8_BAR; PG8_SCHED;
            if (fullu) PG8_LDA(At, 0, 1); PG8_STAGE(PG8_SB(0, 0), b2, voffB); PG8_STAGE(PG8_SB(0, 1), b2 + hstep, voffB); PG8_STAGE(PG8_SA(0, 0), a2, v2);
            PG8_WAIT_V(8); PG8_WAIT_L(0); PG8_BAR; if (fullu) { PG8_MMA(1, 0, At, B0); PG8_MMA(1, 1, At, B1); } PG8_BAR; PG8_SCHED;
            PG8_LDB(B0, 1, 0); PG8_LDB(B1, 1, 1); PG8_SCHED; PG8_LDA(At, 1, 0); PG8_STAGE(PG8_SA(0, 1), a2, v2 + 2);
            PG8_WAIT_V(8); PG8_WAIT_L(0); PG8_BAR; PG8_MMA(0, 0, At, B0); PG8_MMA(0, 1, At, B1); PG8_BAR; PG8_SCHED;
            if (fullu) PG8_LDA(At, 1, 1); PG8_STAGE(PG8_SB(1, 0), b3, voffB); PG8_STAGE(PG8_SB(1, 1), b3 + hstep, voffB); PG8_STAGE(PG8_SA(1, 0), a3, v2);
            PG8_WAIT_V(8); PG8_WAIT_L(0); PG8_BAR; if (fullu) { PG8_MMA(1, 0, At, B0); PG8_MMA(1, 1, At, B1); } PG8_BAR; PG8_SCHED;
        }
        if (wr == 0) PG8_BAR;
        E(acc, cur, wr, wc, fr, fq);
        if (!has_next) break;
#pragma unroll
        for (int a = 0; a < 2; ++a)
#pragma unroll
            for (int b = 0; b < 2; ++b)
#pragma unroll
                for (int m = 0; m < 4; ++m)
#pragma unroll
                    for (int n = 0; n < 2; ++n) acc[a][b][m][n] = (f32x4){0.f, 0.f, 0.f, 0.f};
        cur = nxt; cB = nB; ++ui;
#pragma unroll
        for (int q = 0; q < 4; ++q) vc[q] = vn[q];
        if (wr == 1) PG8_BAR;
    }
    PG8_WAIT_V(0);
    PG8_BAR;
#undef PG8_SA
#undef PG8_SB
#undef PG8_STAGE
#undef PG8_LDA
#undef PG8_LDB
#undef PG8_MMA
#undef PG8_WAIT_V
#undef PG8_WAIT_L
#undef PG8_BAR
#undef PG8_SCHED
}
}

#ifndef PG8_SP2
#define PG8_SP2 true
#endif
struct EpiHgrnIn {
    static constexpr bool PERM = false, AFTER_DRAIN = false;
    char* ws; const float* lb;
    __device__ __forceinline__ void operator()(const pg8::f32x4 (&acc)[2][2][4][2], const pg8::Unit& u, int wr, int wc, int fr, int fq) const {
        const int seg = u.pn >> 2, cbase = (u.pn & 3) * 256 + wc * 32 + fq * 8;
        if (seg == 1) {
            unsigned short* dst = (unsigned short*)(ws + OFF_LF);
#pragma unroll
            for (int bj = 0; bj < 2; ++bj) {
                const f32x4 la0 = *(const f32x4*)(lb + cbase + bj * 128), la1 = *(const f32x4*)(lb + cbase + bj * 128 + 4);
#pragma unroll
                for (int ai = 0; ai < 2; ++ai)
#pragma unroll
                    for (int m = 0; m < 4; ++m) {
                        const size_t row = (size_t)(u.pm * 256 + ai * 128 + wr * 64 + m * 16 + fr);
                        float h[8];
#pragma unroll
                        for (int j = 0; j < 4; ++j) {
                            h[j] = __builtin_amdgcn_logf(la0[j] + (1.f - la0[j]) * sigmoid_f(acc[ai][bj][m][0][j]));
                            h[4 + j] = __builtin_amdgcn_logf(la1[j] + (1.f - la1[j]) * sigmoid_f(acc[ai][bj][m][1][j]));
                        }
                        uint4 oh; oh.x = packh2(h[0], h[1]); oh.y = packh2(h[2], h[3]); oh.z = packh2(h[4], h[5]); oh.w = packh2(h[6], h[7]);
                        *(uint4*)(dst + row * 1024 + cbase + bj * 128) = oh;
                    }
            }
        } else {
            bf16_t* dst = (bf16_t*)(ws + (seg == 0 ? OFF_QH : seg == 2 ? OFF_V : OFF_G));
#pragma unroll
            for (int ai = 0; ai < 2; ++ai)
#pragma unroll
                for (int m = 0; m < 4; ++m) {
                    const size_t row = (size_t)(u.pm * 256 + ai * 128 + wr * 64 + m * 16 + fr);
#pragma unroll
                    for (int bj = 0; bj < 2; ++bj) {
                        float h[8];
#pragma unroll
                        for (int n = 0; n < 2; ++n)
#pragma unroll
                            for (int j = 0; j < 4; ++j) { const float a = acc[ai][bj][m][n][j]; h[n * 4 + j] = (seg == 2) ? a : silu_f(a); }
                        uint4 o; o.x = pack2(h[0], h[1]); o.y = pack2(h[2], h[3]); o.z = pack2(h[4], h[5]); o.w = pack2(h[6], h[7]);
                        *(uint4*)(dst + row * 1024 + cbase + bj * 128) = o;
                    }
                }
        }
    }
};

template <bool XINB>
struct EpiOutProj {
    static constexpr bool PERM = false, AFTER_DRAIN = false;
    const float* mod; const void* xin; bf16_t* xo; int ls;
    __device__ __forceinline__ void operator()(const pg8::f32x4 (&acc)[2][2][4][2], const pg8::Unit& u, int wr, int wc, int fr, int fq) const {
        const int b = (u.pm * 256) >> 11;
        const float* gate = mod + ((size_t)ls * 16 + b) * 3072 + 2048 + u.pn * 256 + wc * 32 + fq * 8;
        f32x4 g[2][2];
#pragma unroll
        for (int bj = 0; bj < 2; ++bj) { g[bj][0] = *(const f32x4*)(gate + bj * 128); g[bj][1] = *(const f32x4*)(gate + bj * 128 + 4); }
#pragma unroll
        for (int ai = 0; ai < 2; ++ai)
#pragma unroll
            for (int m = 0; m < 4; ++m) {
                const size_t ro = (size_t)(u.pm * 256 + ai * 128 + wr * 64 + m * 16 + fr) * 1024 + u.pn * 256 + wc * 32 + fq * 8;
                f32x4 xi[2][2];
#pragma unroll
                for (int bj = 0; bj < 2; ++bj) {
                    if (XINB) bf8_to_f32(*(const uint4*)((const bf16_t*)xin + ro + bj * 128), xi[bj][0], xi[bj][1]);
                    else { xi[bj][0] = *(const f32x4*)((const float*)xin + ro + bj * 128); xi[bj][1] = *(const f32x4*)((const float*)xin + ro + bj * 128 + 4); }
                }
#pragma unroll
                for (int bj = 0; bj < 2; ++bj) {
                    float o[8];
#pragma unroll
                    for (int n = 0; n < 2; ++n)
#pragma unroll
                        for (int j = 0; j < 4; ++j) o[n * 4 + j] = xi[bj][n][j] + g[bj][n][j] * acc[ai][bj][m][n][j];
                    uint4 ov; ov.x = pack2(o[0], o[1]); ov.y = pack2(o[2], o[3]); ov.z = pack2(o[4], o[5]); ov.w = pack2(o[6], o[7]);
                    *(uint4*)(xo + ro + bj * 128) = ov;
                }
            }
    }
};


struct MoeOrder {
    const int* s_off; const int* s_toff; const int* s_hoff; int ntiles, vb, G;
    __device__ __forceinline__ void locate(int i, int& e, int& rt, int& ct, int& half) const {
        const int tile = vb + i * G, nfull = s_toff[16];
        e = 0;
        if (tile < nfull) { while (tile >= s_toff[e + 1]) ++e; const int lt = tile - s_toff[e]; rt = lt >> 2; ct = lt & 3; half = 0; }
        else { const int h = tile - nfull; while (h >= s_hoff[e + 1]) ++e; ct = h - s_hoff[e]; rt = (s_toff[e + 1] - s_toff[e]) >> 2; half = 1; }
    }
    __device__ __forceinline__ bool next(int i, pg8::Unit& u) const {
        if (vb + i * G >= ntiles) return false;
        int e, rt, ct, half; locate(i, e, rt, ct, half);
        u.pm = i; u.pn = (e * 4 + ct) | (half << 16); return true;
    }
};
struct EpiMoeUp {
    static constexpr bool PERM = false, AFTER_DRAIN = false;
    bf16_t* H1; MoeOrder S;
    __device__ __forceinline__ void operator()(const pg8::f32x4 (&acc)[2][2][4][2], const pg8::Unit& u, int wr, int wc, int fr, int fq) const {
        int e, rt, ct, half; S.locate(u.pm, e, rt, ct, half);
        const int off = S.s_off[e], cnt = S.s_off[e + 1] - off;
#pragma unroll
        for (int ai = 0; ai < 2; ++ai)
#pragma unroll
            for (int m = 0; m < 4; ++m) {
                const int pos = rt * 256 + ai * 128 + wr * 64 + m * 16 + fr;
                if (pos < cnt) {
                    float h[8];
#pragma unroll
                    for (int n = 0; n < 2; ++n)
#pragma unroll
                        for (int jj = 0; jj < 4; ++jj) h[n * 4 + jj] = silu_f(acc[ai][0][m][n][jj]) * acc[ai][1][m][n][jj];
                    uint4 o; o.x = pack2(h[0], h[1]); o.y = pack2(h[2], h[3]); o.z = pack2(h[4], h[5]); o.w = pack2(h[6], h[7]);
                    *(uint4*)(H1 + (size_t)(off + pos) * 512 + ct * 128 + wc * 32 + fq * 8) = o;
                }
            }
    }
};
struct EpiMoeDown {
    static constexpr bool PERM = false, AFTER_DRAIN = false;
    bf16_t* Y; const float* lwc; MoeOrder S;
    __device__ __forceinline__ void operator()(const pg8::f32x4 (&acc)[2][2][4][2], const pg8::Unit& u, int wr, int wc, int fr, int fq) const {
        int e, rt, ct, half; S.locate(u.pm, e, rt, ct, half);
        const int off = S.s_off[e], cnt = S.s_off[e + 1] - off;
#pragma unroll
        for (int ai = 0; ai < 2; ++ai)
#pragma unroll
            for (int m = 0; m < 4; ++m) {
                const int rl_ = ai * 128 + wr * 64 + m * 16 + fr, pos = rt * 256 + rl_;
                if (pos < cnt) {
                    const float w = lwc[u.pm * 256 + rl_];
                    bf16_t* dst = Y + (size_t)(off + pos) * 1024 + ct * 256 + wc * 32 + fq * 8;
#pragma unroll
                    for (int bj = 0; bj < 2; ++bj) {
                        const pg8::f32x4 a = acc[ai][bj][m][0], bb = acc[ai][bj][m][1];
                        uint4 o; o.x = pack2(w * a[0], w * a[1]); o.y = pack2(w * a[2], w * a[3]); o.z = pack2(w * bb[0], w * bb[1]); o.w = pack2(w * bb[2], w * bb[3]);
                        *(uint4*)(dst + bj * 128) = o;
                    }
                }
            }
    }
};

template <bool DOWN>
__device__ __forceinline__ void phase_moe8(const Params& p, const Ctx& cx, char* lds, int layer) {
    const int tid = cx.tid;
    int* s_off = (int*)(lds + LDS_TAB_OFF); int* s_toff = s_off + 17; int* s_hoff = s_toff + 17;
    moe_tables(p, layer, tid, s_off, s_toff, s_hoff);
    const int ntiles = s_toff[16] + s_hoff[16];
    const int vb = cx.vbid, G = cx.G;
    MoeOrder S{s_off, s_toff, s_hoff, ntiles, vb, G};
    const int* ltok = (const int*)(p.ws + OFF_LTOK);
    const float* lw = (const float*)(p.ws + OFF_LW);
    int* rowidx = (int*)(lds + LDS_ROWIDX_OFF);
    float* lwc = (float*)(lds + LDS_LW_OFF);
    const int my_tiles = min(8, vb < ntiles ? (ntiles - vb + G - 1) / G : 0);
    for (int i = tid; i < my_tiles * 256; i += NTHR) {
        const int j = i >> 8, r = i & 255; int e, rt, ct, half; S.locate(j, e, rt, ct, half);
        const int off = s_off[e], pos = min(rt * 256 + r, s_off[e + 1] - off - 1);
        if constexpr (DOWN) { rowidx[i] = off + pos; lwc[i] = lw[(size_t)e * NTOK + pos]; }
        else rowidx[i] = ltok[(size_t)e * NTOK + pos];
    }
    __syncthreads();
    const PG8_LAS int* rows = (const PG8_LAS int*)((PG8_LAS unsigned char*)lds + LDS_ROWIDX_OFF);
    if constexpr (DOWN) {
        pg8::Gemm g{(const bf16_t*)(p.ws + OFF_H1), (const bf16_t*)(p.ws + OFF_W_DN) + (size_t)layer * 16 * 1024 * 512, 0, 0, 512};
        EpiMoeDown E{(bf16_t*)(p.ws + OFF_Y), lwc, S};
        pg8::gemm_phase_rows<EpiMoeDown, MoeOrder>((PG8_LAS unsigned char*)lds, g, S, E, rows);
    } else {
        pg8::Gemm g{(const bf16_t*)(p.ws + OFF_HA), (const bf16_t*)(p.ws + OFF_W_UP) + (size_t)layer * 16 * 1024 * 1024, 0, 0, 1024};
        EpiMoeUp E{(bf16_t*)(p.ws + OFF_H1), S};
        pg8::gemm_phase_rows<EpiMoeUp, MoeOrder>((PG8_LAS unsigned char*)lds, g, S, E, rows);
    }
}

template <bool XINB>
__device__ __forceinline__ void phase_outproj8(const Params& p, const Ctx& cx, char* lds, const bf16_t* A, const bf16_t* Bt, const void* xin, int ls) {
    pg8::Gemm g{A, Bt, NTOK, 1024, 1024};
    pg8::StaticOrder S; S.init(NTOK, 1024, cx.G, (int)blockIdx.x);
    EpiOutProj<XINB> E{(const float*)(p.ws + OFF_MOD), xin, (bf16_t*)(p.ws + OFF_XB), ls};
    __syncthreads();
    pg8::gemm_phase<EpiOutProj<XINB>, pg8::StaticOrder, true, PG8_SP2>((PG8_LAS unsigned char*)lds, g, S, E);
    __syncthreads();
}

__device__ __forceinline__ void phase_hgrn_inproj8(const Params& p, const Ctx& cx, char* lds) {
    pg8::Gemm g{(const bf16_t*)(p.ws + OFF_HA), (const bf16_t*)(p.ws + OFF_W_HG_IN), NTOK, 4096, 1024};
    pg8::StaticOrder S; S.init(NTOK, 4096, cx.G, (int)blockIdx.x);
    EpiHgrnIn E{p.ws, (const float*)(p.ws + OFF_LB)};
    __syncthreads();
    pg8::gemm_phase<EpiHgrnIn, pg8::StaticOrder, true, PG8_SP2>((PG8_LAS unsigned char*)lds, g, S, E);
    __syncthreads();
}

template <int MODE = 0>
__device__ __forceinline__ void phase_hgrn_inproj(const Params& p, const Ctx& cx, char* lds) {
    const bf16_t* A = (const bf16_t*)(p.ws + OFF_HA);
    const bf16_t* Bt = (const bf16_t*)(p.ws + OFF_W_HG_IN);
    char* ws = p.ws;
    const float* lb = (const float*)(p.ws + OFF_LB);
    gemm_phase_dense2(A, 1024, Bt, 1024, NTOK / 256, 16, lds, cx, [=](int row0, int col0) {
        return [=](f32x4 (&acc)[8][4], int wr, int wc, int fr, int fq) {
            const int gc0 = col0 + wc * 64, seg = gc0 >> 10, c0 = gc0 & 1023;
#pragma unroll
            for (int m = 0; m < 8; ++m) {
                const int row = row0 + wr * 128 + m * 16 + fr;
#pragma unroll
                for (int pp = 0; pp < 2; ++pp) {
                    const int c = c0 + pp * 32 + fq * 8;
                    float h[8];
                    if (seg == 1) {
                        const f32x4 la = *(const f32x4*)(lb + c), lbb = *(const f32x4*)(lb + c + 4);
#pragma unroll
                        for (int j = 0; j < 4; ++j) {
                            h[j] = __logf(la[j] + (1.f - la[j]) * sigmoid_f(acc[m][2 * pp][j]));
                            h[4 + j] = __logf(lbb[j] + (1.f - lbb[j]) * sigmoid_f(acc[m][2 * pp + 1][j]));
                        }
                        uint4 oh; oh.x = packh2(h[0], h[1]); oh.y = packh2(h[2], h[3]); oh.z = packh2(h[4], h[5]); oh.w = packh2(h[6], h[7]);
                        *(uint4*)((unsigned short*)(ws + OFF_LF) + (size_t)row * 1024 + c) = oh;
                    } else {
#pragma unroll
                        for (int j = 0; j < 4; ++j) {
                            h[j] = (seg == 2) ? acc[m][2 * pp][j] : silu_f(acc[m][2 * pp][j]);
                            h[4 + j] = (seg == 2) ? acc[m][2 * pp + 1][j] : silu_f(acc[m][2 * pp + 1][j]);
                        }
                        uint4 o; o.x = pack2(h[0], h[1]); o.y = pack2(h[2], h[3]); o.z = pack2(h[4], h[5]); o.w = pack2(h[6], h[7]);
                        bf16_t* dst = (bf16_t*)(ws + (seg == 0 ? OFF_QH : seg == 2 ? OFF_V : OFF_G));
                        *(uint4*)(dst + (size_t)row * 1024 + c) = o;
                    }
                }
            }
        };
    });
}

constexpr int HG_QD_OFF = 0, HG_KD_OFF = 8704, HG_K2T_OFF = 17408, HG_VT_OFF = 27648, HG_DEC_OFF = 37888, HG_BUF = 38400, HG_TOT_OFF = 2 * HG_BUF;
constexpr int HG_ROW = 272, HG_TROW = 80;
static_assert(HG_TOT_OFF + 2048 <= LDS_TAB_OFF, "hgrn LDS");

__device__ __forceinline__ void phase_hgrn_rec(const Params& p, const Ctx& cx, char* lds) {
    const int lane = cx.lane;
    const int l31 = lane & 31, h2 = lane >> 5;
    const int widu = __builtin_amdgcn_readfirstlane(cx.wid);
    const bool producer = widu >= 4;
    const int pw = widu & 3;
    const int d0 = 2 * lane;
    const bf16_t* QH = (const bf16_t*)(p.ws + OFF_QH);
    const unsigned short* LF = (const unsigned short*)(p.ws + OFF_LF);
    const bf16_t* V = (const bf16_t*)(p.ws + OFF_V);
    bf16_t* OR = (bf16_t*)(p.ws + OFF_HA);
    float* tot = (float*)(lds + HG_TOT_OFF);
    for (int item = blockIdx.x; item < 128; item += cx.G) {
        const int b = item >> 3, h = item & 7;
        f32x16 S0, S1, S2, S3;
#pragma unroll
        for (int r = 0; r < 16; ++r) { S0[r] = 0.f; S1[r] = 0.f; S2[r] = 0.f; S3[r] = 0.f; }
        unsigned lfA[8], lfB[8], qv[8], vv[8];
        const size_t gbase = (size_t)(b * SEQ + pw * 8) * 1024 + h * 128;
        if (producer) {
#pragma unroll
            for (int i = 0; i < 8; ++i) {
                lfA[i] = *(const unsigned*)(LF + gbase + (size_t)i * 1024 + d0);
                qv[i] = *(const unsigned*)(QH + gbase + (size_t)i * 1024 + d0);
                vv[i] = *(const unsigned*)(V + gbase + (size_t)i * 1024 + d0);
            }
#pragma unroll
            for (int i = 0; i < 8; ++i) lfB[i] = *(const unsigned*)(LF + gbase + (size_t)(32 + i) * 1024 + d0);
        }
        __syncthreads();
        for (int c = 0; c <= SEQ / 32; ++c) {
            unsigned lf[8];
#pragma unroll
            for (int i = 0; i < 8; ++i) lf[i] = (c & 1) ? lfB[i] : lfA[i];
            f2_t run = {0.f, 0.f};
            if (producer && c < SEQ / 32) {
#pragma unroll
                for (int i = 0; i < 8; ++i) run += unpackh2(lf[i]);
                *(f2_t*)(tot + pw * 128 + d0) = run;
            }
            __syncthreads();
            if (producer) {
                if (c < SEQ / 32) {
                    char* bufp = lds + (c & 1) * HG_BUF;
                    f2_t pre = {0.f, 0.f}, last = {0.f, 0.f};
#pragma unroll
                    for (int q = 0; q < 4; ++q) {
                        const f2_t tq_ = *(const f2_t*)(tot + q * 128 + d0);
                        last += tq_;
                        if (q < pw) pre += tq_;
                    }
                    if (pw == 0) { f2_t dv; dv.x = __builtin_amdgcn_exp2f(last.x); dv.y = __builtin_amdgcn_exp2f(last.y); *(f2_t*)(bufp + HG_DEC_OFF + d0 * 4) = dv; }
                    float k2a[8], k2b[8];
                    f2_t rc = pre;
#pragma unroll
                    for (int i = 0; i < 8; ++i) {
                        const f2_t lfi = unpackh2(lf[i]);
                        rc += lfi;
                        const float cu0 = rc.x, cu1 = rc.y;
                        const float kk0 = 1.f - __builtin_amdgcn_exp2f(lfi.x), kk1 = 1.f - __builtin_amdgcn_exp2f(lfi.y);
                        const float q0 = bf2f((unsigned short)(qv[i] & 0xffff)) * __builtin_amdgcn_exp2f(cu0), q1 = bf2f((unsigned short)(qv[i] >> 16)) * __builtin_amdgcn_exp2f(cu1);
                        const float kd0 = kk0 * __builtin_amdgcn_exp2f(-cu0), kd1 = kk1 * __builtin_amdgcn_exp2f(-cu1);
                        k2a[i] = kk0 * __builtin_amdgcn_exp2f(last.x - cu0); k2b[i] = kk1 * __builtin_amdgcn_exp2f(last.y - cu1);
                        const int tl = pw * 8 + i;
                        *(unsigned*)(bufp + HG_QD_OFF + tl * HG_ROW + d0 * 2) = pack2(q0, q1);
                        *(unsigned*)(bufp + HG_KD_OFF + tl * HG_ROW + d0 * 2) = pack2(kd0, kd1);
                    }
                    uint4 a, bq, va, vb;
                    a.x = pack2(k2a[0], k2a[1]); a.y = pack2(k2a[2], k2a[3]); a.z = pack2(k2a[4], k2a[5]); a.w = pack2(k2a[6], k2a[7]);
                    bq.x = pack2(k2b[0], k2b[1]); bq.y = pack2(k2b[2], k2b[3]); bq.z = pack2(k2b[4], k2b[5]); bq.w = pack2(k2b[6], k2b[7]);
                    va.x = (vv[0] & 0xffffu) | (vv[1] << 16); va.y = (vv[2] & 0xffffu) | (vv[3] << 16); va.z = (vv[4] & 0xffffu) | (vv[5] << 16); va.w = (vv[6] & 0xffffu) | (vv[7] << 16);
                    vb.x = (vv[0] >> 16) | (vv[1] & 0xffff0000u); vb.y = (vv[2] >> 16) | (vv[3] & 0xffff0000u); vb.z = (vv[4] >> 16) | (vv[5] & 0xffff0000u); vb.w = (vv[6] >> 16) | (vv[7] & 0xffff0000u);
                    *(uint4*)(bufp + HG_K2T_OFF + d0 * HG_TROW + pw * 16) = a;
                    *(uint4*)(bufp + HG_K2T_OFF + (d0 + 1) * HG_TROW + pw * 16) = bq;
                    *(uint4*)(bufp + HG_VT_OFF + d0 * HG_TROW + pw * 16) = va;
                    *(uint4*)(bufp + HG_VT_OFF + (d0 + 1) * HG_TROW + pw * 16) = vb;
                    __builtin_amdgcn_sched_barrier(0);
                    if (c + 1 < SEQ / 32) {
                        const size_t gn = gbase + (size_t)(c + 1) * 32 * 1024;
#pragma unroll
                        for (int i = 0; i < 8; ++i) {
                            qv[i] = *(const unsigned*)(QH + gn + (size_t)i * 1024 + d0);
                            vv[i] = *(const unsigned*)(V + gn + (size_t)i * 1024 + d0);
                        }
                    }
                    if (c + 2 < SEQ / 32) {
                        const size_t gn = gbase + (size_t)(c + 2) * 32 * 1024;
                        if (c & 1) {
#pragma unroll
                            for (int i = 0; i < 8; ++i) lfB[i] = *(const unsigned*)(LF + gn + (size_t)i * 1024 + d0);
                        } else {
#pragma unroll
                            for (int i = 0; i < 8; ++i) lfA[i] = *(const unsigned*)(LF + gn + (size_t)i * 1024 + d0);
                        }
                    }
                }
            } else if (c >= 1) {
                const int cc = c - 1;
                const char* bufp = lds + (cc & 1) * HG_BUF;
                const float* dec = (const float*)(bufp + HG_DEC_OFF);
                f32x16 X;
#pragma unroll
                for (int r = 0; r < 16; ++r) X[r] = 0.f;
                {
                    const char* ka = bufp + HG_KD_OFF + l31 * HG_ROW + 16 * h2;
                    const char* qa = bufp + HG_QD_OFF + l31 * HG_ROW + 16 * h2;
#pragma unroll 2
                    for (int ks = 0; ks < 8; ++ks) X = MFMA32(*(const bf16x8*)(ka + 32 * ks), *(const bf16x8*)(qa + 32 * ks), X);
#pragma unroll
                    for (int r = 0; r < 16; ++r) { const int srow = (r & 3) + 8 * (r >> 2) + 4 * h2; X[r] = (srow <= l31) ? X[r] : 0.f; }
                }
                f32x16 Oa;
#pragma unroll
                for (int r = 0; r < 16; ++r) Oa[r] = 0.f;
                const int jrow = 32 * pw + l31;
#pragma unroll
                for (int s2 = 0; s2 < 2; ++s2) {
                    uint4 xk;
                    xk.x = pack2(X[8 * s2], X[8 * s2 + 1]); xk.y = pack2(X[8 * s2 + 2], X[8 * s2 + 3]); xk.z = pack2(X[8 * s2 + 4], X[8 * s2 + 5]); xk.w = pack2(X[8 * s2 + 6], X[8 * s2 + 7]);
                    const char* va = bufp + HG_VT_OFF + jrow * HG_TROW + (16 * s2 + 4 * h2) * 2;
                    const uint2 lo = *(const uint2*)va, hi = *(const uint2*)(va + 16);
                    uint4 vb; vb.x = lo.x; vb.y = lo.y; vb.z = hi.x; vb.w = hi.y;
                    Oa = MFMA32(__builtin_bit_cast(bf16x8, xk), __builtin_bit_cast(bf16x8, vb), Oa);
                }
                auto qs_term = [&](const f32x16& St, int dt) {
#pragma unroll
                    for (int s2 = 0; s2 < 2; ++s2) {
                        uint4 sk;
                        sk.x = pack2(St[8 * s2], St[8 * s2 + 1]); sk.y = pack2(St[8 * s2 + 2], St[8 * s2 + 3]); sk.z = pack2(St[8 * s2 + 4], St[8 * s2 + 5]); sk.w = pack2(St[8 * s2 + 6], St[8 * s2 + 7]);
                        const char* qa = bufp + HG_QD_OFF + l31 * HG_ROW + (32 * dt + 16 * s2 + 4 * h2) * 2;
                        const uint2 lo = *(const uint2*)qa, hi = *(const uint2*)(qa + 16);
                        uint4 qb; qb.x = lo.x; qb.y = lo.y; qb.z = hi.x; qb.w = hi.y;
                        Oa = MFMA32(__builtin_bit_cast(bf16x8, qb), __builtin_bit_cast(bf16x8, sk), Oa);
                    }
                };
                __builtin_amdgcn_sched_barrier(0);
                qs_term(S0, 0); qs_term(S1, 1);
                __builtin_amdgcn_sched_barrier(0);
                qs_term(S2, 2); qs_term(S3, 3);
                __builtin_amdgcn_sched_barrier(0);
                {
                    bf16_t* orow = OR + (size_t)(b * SEQ + cc * 32 + 4 * h2) * 1024 + h * 128 + jrow;
#pragma unroll
                    for (int r = 0; r < 16; ++r) orow[(size_t)((r & 3) + 8 * (r >> 2)) * 1024] = f2bf(Oa[r]);
                }
                auto s_update = [&](f32x16& St, int dt) {
#pragma unroll
                    for (int rq = 0; rq < 4; ++rq) {
                        const f32x4 dc = *(const f32x4*)(dec + 32 * dt + 8 * rq + 4 * h2);
                        St[4 * rq] *= dc[0]; St[4 * rq + 1] *= dc[1]; St[4 * rq + 2] *= dc[2]; St[4 * rq + 3] *= dc[3];
                    }
#pragma unroll
                    for (int s2 = 0; s2 < 2; ++s2) {
                        const bf16x8 ka = *(const bf16x8*)(bufp + HG_K2T_OFF + (32 * dt + l31) * HG_TROW + (16 * s2 + 8 * h2) * 2);
                        const bf16x8 vb = *(const bf16x8*)(bufp + HG_VT_OFF + jrow * HG_TROW + (16 * s2 + 8 * h2) * 2);
                        St = MFMA32(ka, vb, St);
                    }
                };
                __builtin_amdgcn_sched_barrier(0);
                s_update(S0, 0); s_update(S1, 1);
                __builtin_amdgcn_sched_barrier(0);
                s_update(S2, 2); s_update(S3, 3);
                __builtin_amdgcn_sched_barrier(0);
            }
            __syncthreads();
        }
    }
}

__device__ __forceinline__ void phase_hgrn_post(const Params& p, const Ctx& cx) {
    const int lane = cx.lane;
    const bf16_t* OR = (const bf16_t*)(p.ws + OFF_HA);
    const bf16_t* Gt = (const bf16_t*)(p.ws + OFF_G);
    bf16_t* OA = (bf16_t*)(p.ws + OFF_QH);
    const int col = lane * 16;
    float gn[16];
#pragma unroll
    for (int i = 0; i < 16; ++i) gn[i] = p.hgrn_out_gain[(col & 127) + i];
    for (int row = cx.vbid * NWAVE + cx.wid; row < NTOK; row += cx.G * NWAVE) {
        const uint4 a0 = *(const uint4*)(OR + (size_t)row * 1024 + col), a1 = *(const uint4*)(OR + (size_t)row * 1024 + col + 8);
        const uint4 g0 = *(const uint4*)(Gt + (size_t)row * 1024 + col), g1 = *(const uint4*)(Gt + (size_t)row * 1024 + col + 8);
        const unsigned aw[8] = {a0.x, a0.y, a0.z, a0.w, a1.x, a1.y, a1.z, a1.w};
        const unsigned gw[8] = {g0.x, g0.y, g0.z, g0.w, g1.x, g1.y, g1.z, g1.w};
        float o[16];
        float ss = 0.f;
#pragma unroll
        for (int i = 0; i < 8; ++i) { o[2 * i] = bf2f((unsigned short)(aw[i] & 0xffff)); o[2 * i + 1] = bf2f((unsigned short)(aw[i] >> 16)); ss += o[2 * i] * o[2 * i] + o[2 * i + 1] * o[2 * i + 1]; }
        ss += __shfl_xor(ss, 1); ss += __shfl_xor(ss, 2); ss += __shfl_xor(ss, 4);
        const float r = rsqrtf(ss * (1.f / 128.f) + EPS);
        unsigned w[8];
#pragma unroll
        for (int i = 0; i < 8; ++i)
            w[i] = pack2(o[2 * i] * r * gn[2 * i] * bf2f((unsigned short)(gw[i] & 0xffff)), o[2 * i + 1] * r * gn[2 * i + 1] * bf2f((unsigned short)(gw[i] >> 16)));
        uint4 o0, o1; o0.x = w[0]; o0.y = w[1]; o0.z = w[2]; o0.w = w[3]; o1.x = w[4]; o1.y = w[5]; o1.z = w[6]; o1.w = w[7];
        *(uint4*)(OA + (size_t)row * 1024 + col) = o0;
        *(uint4*)(OA + (size_t)row * 1024 + col + 8) = o1;
    }
}


#define XB_TMO      128
#define XB_XCNT(j)  (256  + 64 * (j))
#define XB_XSUB(j)  (1280 + 64 * (j))
#define XB_XGEN(j)  (2304 + 64 * (j))
#define XB_TOP      3328
#define XB_TOPGEN   3392
#define XCD_BAR_WORDS 3456
#define XB_SPIN_CAP (1u << 20)
#define LAS __attribute__((address_space(3)))
__device__ __forceinline__ unsigned xb_ld(unsigned* p)              { return __hip_atomic_load(p, __ATOMIC_RELAXED, __HIP_MEMORY_SCOPE_AGENT); }
__device__ __forceinline__ unsigned xb_add(unsigned* p, unsigned v) { return __hip_atomic_fetch_add(p, v, __ATOMIC_RELAXED, __HIP_MEMORY_SCOPE_AGENT); }
__device__ __forceinline__ unsigned xb_xcc_id() { return (unsigned)__builtin_amdgcn_s_getreg((3 << 11) | 20) & 0xFu; }
#define XB_SPIN(cond, bar) do { unsigned _sp = 0; while (cond) { __builtin_amdgcn_s_sleep(1); \
    if ((++_sp & 255u) == 0u) { if (xb_ld(&(bar)[XB_TMO])) break; if (_sp > XB_SPIN_CAP) { atomicAdd(&(bar)[XB_TMO], 1u); break; } } } } while (0)
struct XcdBarrier { unsigned* bar; unsigned x; volatile unsigned* st; };
__device__ __forceinline__ XcdBarrier xcd_barrier_post(unsigned* bar, volatile unsigned* st) {
    XcdBarrier b; b.bar = bar; b.x = xb_xcc_id(); b.st = st;
    if (threadIdx.x == 0) (void)xb_add(&bar[XB_XCNT(b.x)], 1u);
    return b;
}
__device__ __forceinline__ void xcd_barrier_complete(unsigned* bar, unsigned x, unsigned& nloc, unsigned& nx) {
    const unsigned G = gridDim.x * gridDim.y * gridDim.z;
    unsigned sum, cnt, mine, sp = 0u;
    for (;;) {
        sum = 0u; cnt = 0u; mine = 0u;
#pragma unroll
        for (unsigned j = 0; j < 16; ++j) { const unsigned c = xb_ld(&bar[XB_XCNT(j)]); sum += c; cnt += (c > 0u) ? 1u : 0u; mine = (j == x) ? c : mine; }
        if (sum == G) break;
        __builtin_amdgcn_s_sleep(1);
        if ((++sp & 255u) == 0u) { if (xb_ld(&bar[XB_TMO])) break; if (sp > XB_SPIN_CAP) { atomicAdd(&bar[XB_TMO], 1u); break; } }
    }
    nloc = mine > 0u ? mine : 1u; nx = cnt > 0u ? cnt : 1u;
}
__device__ __forceinline__ void xcd_barrier(const XcdBarrier& b) {
    asm volatile("s_waitcnt vmcnt(0)" ::: "memory");
    __syncthreads();
    if (threadIdx.x == 0) {
        unsigned* bar = b.bar;
        __builtin_amdgcn_s_waitcnt(0);
        unsigned nloc = b.st[0], nx = b.st[1];
        if (nloc == 0u) { xcd_barrier_complete(bar, b.x, nloc, nx); b.st[0] = nloc; b.st[1] = nx; }
        const unsigned old = xb_add(&bar[XB_XSUB(b.x)], 1u);
        const unsigned gen = old / nloc;
        if (old + 1u == (gen + 1u) * nloc) {
            __builtin_amdgcn_fence(__ATOMIC_RELEASE, "agent");
            asm volatile("s_waitcnt vmcnt(0)" ::: "memory");
            const unsigned og = xb_add(&bar[XB_TOP], 1u);
            const unsigned tg = og / nx;
            if (og + 1u == (tg + 1u) * nx) xb_add(&bar[XB_TOPGEN], 1u);
            else XB_SPIN(xb_ld(&bar[XB_TOPGEN]) == tg, bar);
            __builtin_amdgcn_fence(__ATOMIC_ACQUIRE, "agent");
            xb_add(&bar[XB_XGEN(b.x)], 1u);
            asm volatile("s_waitcnt vmcnt(0)" ::: "memory");
        } else {
            XB_SPIN(xb_ld(&bar[XB_XGEN(b.x)]) == gen, bar);
            __builtin_amdgcn_fence(__ATOMIC_ACQUIRE, "agent");
            asm volatile("s_waitcnt vmcnt(0)" ::: "memory");
        }
    }
    __syncthreads();
}

template <int PH>
__device__ __forceinline__ void run_phase(const Params& p, const Ctx& cx, char* lds) {
    if constexpr (PH == 0) phase0(p, cx, lds);
    else if constexpr (PH == 1) rows_phase<false, true, false>(p, cx, lds, p.x, nullptr, 0, 0, 0, 0);
    else if constexpr (PH == 2) phase_nsa_inproj(p, cx, lds);
    else if constexpr (PH == 3) {
        phase_cmp1(p, cx, lds);
        const int w = cx.vbid >= 64 ? cx.vbid - 64 : -1, nw = cx.G - 64;
        transpose_range(p, lds, cx.tid, w, nw, TC2, TC4);
        transpose_range(p, lds, cx.tid, w, nw, TC5, TC_UP1);
        transpose_range(p, lds, cx.tid, w, nw, TC6, TC_DN1);
    }
    else if constexpr (PH == 4) phase_cmp2(p, cx);
    else if constexpr (PH == 5) phase_attn(p, cx, lds);
    else if constexpr (PH == 6) phase_outproj8<false>(p, cx, lds, (const bf16_t*)(p.ws + OFF_HA), (const bf16_t*)(p.ws + OFF_W_NSA_OUT), p.x, 0);
    else if constexpr (PH == 7) rows_router_phase(p, cx, lds, (const bf16_t*)(p.ws + OFF_XB), 1, 0);
    else if constexpr (PH == 8) phase_moe8<false>(p, cx, lds, 0);
    else if constexpr (PH == 9) phase_moe8<true>(p, cx, lds, 0);
    else if constexpr (PH == 10) { char* xb = p.ws + OFF_XB; asm volatile("" : "+s"(xb)); rows_phase<true, true, false, true, true>(p, cx, lds, xb, xb, 1, 2, 0, 0); }
    else if constexpr (PH == 11) phase_hgrn_inproj8(p, cx, lds);
    else if constexpr (PH == 12) {
        phase_hgrn_rec(p, cx, lds);
        const int w = (int)blockIdx.x >= 128 ? (int)blockIdx.x - 128 : -1, nw = cx.G - 128;
        transpose_range(p, lds, cx.tid, w, nw, TC_UP1, TC6);
        transpose_range(p, lds, cx.tid, w, nw, TC_DN1, TC_END);
    }
    else if constexpr (PH == 13) phase_hgrn_post(p, cx);
    else if constexpr (PH == 14) phase_outproj8<true>(p, cx, lds, (const bf16_t*)(p.ws + OFF_QH), (const bf16_t*)(p.ws + OFF_W_HG_OUT), p.ws + OFF_XB, 2);
    else if constexpr (PH == 15) rows_router_phase(p, cx, lds, (const bf16_t*)(p.ws + OFF_XB), 3, 1);
    else if constexpr (PH == 16) phase_moe8<false>(p, cx, lds, 1);
    else if constexpr (PH == 17) phase_moe8<true>(p, cx, lds, 1);
    else if constexpr (PH == 18) { char* xb = p.ws + OFF_XB; asm volatile("" : "+s"(xb)); rows_phase<true, false, false, true, false>(p, cx, lds, xb, p.out, 3, 0, 0, 1); }
}

__device__ __forceinline__ Ctx make_ctx() {
    Ctx cx;
    cx.G = gridDim.x; cx.tid = threadIdx.x; cx.wid = threadIdx.x >> 6; cx.lane = threadIdx.x & 63;
    cx.vbid = (cx.G % 8 == 0) ? (blockIdx.x % 8) * (cx.G / 8) + blockIdx.x / 8 : blockIdx.x;
    return cx;
}

#if MULTI_LAUNCH
template <int PH>
__global__ void __launch_bounds__(NTHR, 2) phase_kernel(Params p) {
    extern __shared__ __attribute__((aligned(16))) char lds[];
    const Ctx cx = make_ctx();
    run_phase<PH>(p, cx, lds);
}
template <int PH>
static void launch_phases(const Params& p, int grid, hipStream_t stream) {
    (void)hipFuncSetAttribute((const void*)phase_kernel<PH>, hipFuncAttributeMaxDynamicSharedMemorySize, LDS_BYTES);
    hipLaunchKernelGGL(phase_kernel<PH>, dim3(grid), dim3(NTHR), LDS_BYTES, stream, p);
    if constexpr (PH + 1 < NPHASE) launch_phases<PH + 1>(p, grid, stream);
}
#else
template <int PH>
__device__ __forceinline__ void run_from(const Params& p, const Ctx& cx, char* lds, cg::grid_group& grid, const XcdBarrier& xb) {
    {
        int t_ = threadIdx.x, b_ = blockIdx.x;
        asm volatile("" : "+v"(t_), "+s"(b_));
        Ctx c2;
        c2.G = gridDim.x; c2.tid = t_; c2.wid = t_ >> 6; c2.lane = t_ & 63;
        c2.vbid = (c2.G % 8 == 0) ? (b_ % 8) * (c2.G / 8) + b_ / 8 : b_;
        run_phase<PH>(p, c2, lds);
#ifdef PROBE_MASK
        if constexpr ((PROBE_MASK >> PH) & 1) { xcd_barrier(xb); run_phase<PH>(p, c2, lds); }
#endif
    }
    if constexpr (PH + 1 < NPHASE) {
        if constexpr (PH == 0) grid.sync();
        else xcd_barrier(xb);
        run_from<PH + 1>(p, cx, lds, grid, xb);
    }
}
__global__ void __launch_bounds__(NTHR, 2) mega_kernel(Params p) {
    extern __shared__ __attribute__((aligned(16))) char lds[];
    cg::grid_group grid = cg::this_grid();
    const Ctx cx = make_ctx();
    volatile unsigned* st = (volatile unsigned*)(lds + LDS_BYTES - 16);
    if (threadIdx.x == 0) { st[0] = 0u; st[1] = 0u; }
    __syncthreads();
    const XcdBarrier xb = xcd_barrier_post((unsigned*)(p.ws + OFF_BAR), st);
    run_from<0>(p, cx, lds, grid, xb);
}
#endif

extern "C" void kernel_launch(void* const* d_in, const int* in_sizes, int n_in, void* d_out, int out_size, void* d_ws, size_t ws_size,
                              hipStream_t stream) {
    static int grid = 0;
    if (!grid) {
        int dev = 0, cus = 0, per_cu = 0;
        (void)hipGetDevice(&dev);
        (void)hipDeviceGetAttribute(&cus, hipDeviceAttributeMultiprocessorCount, dev);
#if MULTI_LAUNCH
        per_cu = 1;
#else
        (void)hipFuncSetAttribute((const void*)mega_kernel, hipFuncAttributeMaxDynamicSharedMemorySize, LDS_BYTES);
        (void)hipOccupancyMaxActiveBlocksPerMultiprocessor(&per_cu, mega_kernel, NTHR, LDS_BYTES);
        if (per_cu > 1) per_cu = 1;
        if (per_cu < 1) { fprintf(stderr, "kernel_launch: occupancy query says 0 blocks per CU (LDS %d B)\n", LDS_BYTES); per_cu = 1; }
#endif
        if (cus <= 0) cus = 256;
        grid = cus * per_cu;
        if (ws_size < WS_NEED) fprintf(stderr, "kernel_launch: workspace too small: %zu < %zu\n", ws_size, (size_t)WS_NEED);
    }
    Params p{};
    p.x = (const float*)d_in[0]; p.c = (const float*)d_in[1]; p.ada_w = (const float*)d_in[2]; p.ada_b = (const float*)d_in[3];
    p.norm_g = (const float*)d_in[4]; p.rel_bias = (const float*)d_in[5]; p.nsa_w_in = (const float*)d_in[6]; p.nsa_q_gain = (const float*)d_in[7];
    p.nsa_k_gain = (const float*)d_in[8]; p.nsa_cmp_pe = (const float*)d_in[9]; p.nsa_cmp_w1 = (const float*)d_in[10]; p.nsa_cmp_w2 = (const float*)d_in[11];
    p.nsa_w_out = (const float*)d_in[12]; p.hgrn_w_in = (const float*)d_in[13]; p.hgrn_lb = (const float*)d_in[14]; p.hgrn_out_gain = (const float*)d_in[15];
    p.hgrn_w_out = (const float*)d_in[16]; p.moe_rg = (const float*)d_in[17]; p.moe_re = (const float*)d_in[18]; p.moe_w1 = (const float*)d_in[19];
    p.moe_w3 = (const float*)d_in[20]; p.moe_w2 = (const float*)d_in[21];
    p.out = (float*)d_out; p.ws = (char*)d_ws;
#if MULTI_LAUNCH
    launch_phases<0>(p, grid, stream);
#else
    p.p_begin = 0; p.p_end = NPHASE;
    (void)hipMemsetAsync((char*)d_ws + OFF_BAR, 0, XCD_BAR_WORDS * 4, stream);
    void* args[] = {&p};
    hipError_t e = hipLaunchCooperativeKernel((void*)mega_kernel, dim3(grid), dim3(NTHR), args, LDS_BYTES, stream);
    if (e != hipSuccess) fprintf(stderr, "cooperative launch failed: %s (grid %d)\n", hipGetErrorString(e), grid);
#endif
}
```
